# Optimizing an MI355X kernel written in HIP

```python
import math, functools
import jax, jax.numpy as jnp
from jax import lax
import numpy as np


D_MODEL = 1024
BATCH = 8
SEQ = 4096
DEPTH = 2

GRID_W = 64
CTX_LEN = 256
HEAD_DIM = 64
ROPE_THETA = 10000.0
NORM_EPS = 1e-6
Q_BLOCK = 128
MIX_WIDTH = D_MODEL

A_HEADS = (MIX_WIDTH // 2) // (2 * HEAD_DIM)
A_QK = A_HEADS * 2 * HEAD_DIM
A_VDIM = 2 * HEAD_DIM
A_WIDTH = A_HEADS * A_VDIM
B_HEADS = (MIX_WIDTH // 2) // HEAD_DIM
B_WIDTH = B_HEADS * HEAD_DIM
NA_ROWS = 8
NA_COLS = 16
EVEN_IN = 2 * A_QK + A_WIDTH + 3 * B_WIDTH

C_HEADS = (MIX_WIDTH // 2) // HEAD_DIM
C_KV_HEADS = 2
C_REP = C_HEADS // C_KV_HEADS
C_Q = C_HEADS * HEAD_DIM
C_KV = C_KV_HEADS * HEAD_DIM
WINDOW = 128
D_HEADDIM = 64
D_INNER = MIX_WIDTH // 2
D_HEADS = D_INNER // D_HEADDIM
D_GROUPS = 2
D_HPG = D_HEADS // D_GROUPS
D_STATE = 128
D_CONV = 5
D_XBC = D_INNER + 2 * D_GROUPS * D_STATE
SSD_CHUNK = 128
ODD_IN = C_Q + 2 * C_KV + D_XBC + D_INNER + 2 * D_HEADS

N_EXPERTS = 16
EXPERT_FF = D_MODEL
CAPACITY_FACTOR = 2

kernel_name = 'hybrid_diffusion_trunk_diffattn_natten_swa_ssd_ecmoe'


def rmsnorm(u, g):
    uf = u.astype(jnp.float32)
    y = uf * lax.rsqrt(jnp.mean(uf * uf, axis=-1, keepdims=True) + NORM_EPS)
    return (y * g.astype(jnp.float32)).astype(u.dtype)


def split_cols(p, sizes):
    return jnp.split(p, np.cumsum(sizes)[:-1].tolist(), axis=-1)


def ada_modulation(cond, w_mod, b_mod):
    mod = jax.nn.silu(cond) @ w_mod + b_mod
    return jnp.split(mod[..., None, :], 6, axis=-1)


def axial_rope_tables(n):
    t = jnp.arange(n, dtype=jnp.int32)
    row = (t // GRID_W).astype(jnp.float32)
    col = (t % GRID_W).astype(jnp.float32)
    n_freq = HEAD_DIM // 4
    inv_freq = ROPE_THETA ** (-jnp.arange(n_freq, dtype=jnp.float32) / n_freq)
    ang = jnp.concatenate([row[:, None] * inv_freq, col[:, None] * inv_freq], axis=-1)
    return jnp.cos(ang), jnp.sin(ang)


def apply_rope(u, cos, sin):
    uf = u.astype(jnp.float32).reshape(u.shape[:-1] + (HEAD_DIM // 2, 2))
    u1, u2 = uf[..., 0], uf[..., 1]
    cs, sn = cos[:, None, :], sin[:, None, :]
    out = jnp.stack([u1 * cs - u2 * sn, u1 * sn + u2 * cs], axis=-1)
    return out.reshape(u.shape).astype(u.dtype)


def differential_attention(q, k, v, lam):
    scale = q.shape[-1] ** -0.5
    s = jnp.einsum('bqhmd,bkhmd->bhmqk', q, k).astype(jnp.float32) * scale
    p = jax.nn.softmax(s, axis=-1)
    a = (p[:, :, 0] - lam * p[:, :, 1]).astype(v.dtype)
    return jnp.einsum('bhqk,bkhe->bqhe', a, v)


def context_attention(q, k, v):
    b, m, _, d = q.shape
    s = jnp.einsum('bqhd,bkhd->bhqk', q, k).astype(jnp.float32) * d ** -0.5
    p = jax.nn.softmax(s, axis=-1).astype(v.dtype)
    return jnp.einsum('bhqk,bkhd->bqhd', p, v).reshape(b, m, -1)


def neighbourhood_attention(q, k, v, k_ctx, v_ctx, rpb):
    b, n, nh, d = q.shape
    rows = n // GRID_W
    kh, kw = min(NA_ROWS, rows), NA_COLS
    qg = q.reshape(b, rows, GRID_W, nh, d)
    kg = k.reshape(b, rows, GRID_W, nh, d)
    vg = v.reshape(b, rows, GRID_W, nh, d)
    r_idx = jnp.arange(rows)
    row_start = jnp.clip(r_idx - kh // 2, 0, rows - kh)
    w_idx = jnp.arange(GRID_W)
    col_idx = jnp.clip(w_idx - kw // 2, 0, GRID_W - kw)[:, None] + jnp.arange(kw)
    rel_c = col_idx - w_idx[:, None] + NA_COLS - 1
    scale = d ** -0.5
    n_keys = kh * kw

    def row_block(args):
        q_r, r, rs = args
        k_rows = lax.dynamic_slice_in_dim(kg, rs, kh, axis=1)
        v_rows = lax.dynamic_slice_in_dim(vg, rs, kh, axis=1)
        k_nb = k_rows[:, :, col_idx].transpose(0, 2, 1, 3, 4, 5).reshape(b, GRID_W, n_keys, nh, d)
        v_nb = v_rows[:, :, col_idx].transpose(0, 2, 1, 3, 4, 5).reshape(b, GRID_W, n_keys, nh, d)
        rel_r = rs + jnp.arange(kh) - r + NA_ROWS - 1
        bias = rpb[:, rel_r[None, :, None], rel_c[:, None, :]].reshape(nh, GRID_W, n_keys)
        s_nb = jnp.einsum('bwhd,bwkhd->bhwk', q_r, k_nb).astype(jnp.float32) * scale + bias.astype(jnp.float32)
        s_cx = jnp.einsum('bwhd,bmhd->bhwm', q_r, k_ctx).astype(jnp.float32) * scale
        p = jax.nn.softmax(jnp.concatenate([s_nb, s_cx], axis=-1), axis=-1).astype(v.dtype)
        return (jnp.einsum('bhwk,bwkhd->bwhd', p[..., :n_keys], v_nb)
                + jnp.einsum('bhwm,bmhd->bwhd', p[..., n_keys:], v_ctx))

    o = lax.map(row_block, (qg.transpose(1, 0, 2, 3, 4), r_idx, row_start))
    return o.transpose(1, 0, 2, 3, 4).reshape(b, n, nh * d)


def window_attention_with_sink(q, k, v, k_ctx, v_ctx, sinks):
    b, n, g, r, d = q.shape
    m = k_ctx.shape[1]
    nb = n // Q_BLOCK
    side = -(-WINDOW // Q_BLOCK)
    span = (2 * side + 1) * Q_BLOCK
    pad = ((0, 0), (side * Q_BLOCK, side * Q_BLOCK), (0, 0), (0, 0))
    kp = jnp.pad(k, pad)
    vp = jnp.pad(v, pad)
    sink = jnp.broadcast_to(sinks.astype(jnp.float32).reshape(1, g, r, 1, 1), (b, g, r, Q_BLOCK, 1))
    scale = d ** -0.5
    q_blocks = q.reshape(b, nb, Q_BLOCK, g, r, d).swapaxes(0, 1)

    def block(args):
        qb, blk = args
        kb = lax.dynamic_slice_in_dim(kp, blk * Q_BLOCK, span, axis=1)
        vb = lax.dynamic_slice_in_dim(vp, blk * Q_BLOCK, span, axis=1)
        qpos = blk * Q_BLOCK + jnp.arange(Q_BLOCK)
        kpos = (blk - side) * Q_BLOCK + jnp.arange(span)
        valid = (jnp.abs(qpos[:, None] - kpos[None, :]) <= WINDOW) & (kpos >= 0) & (kpos < n)
        s_loc = jnp.einsum('bqgrd,bkgd->bgrqk', qb, kb).astype(jnp.float32) * scale
        s_loc = jnp.where(valid, s_loc, -jnp.inf)
        s_ctx = jnp.einsum('bqgrd,bmgd->bgrqm', qb, k_ctx).astype(jnp.float32) * scale
        p = jax.nn.softmax(jnp.concatenate([s_loc, s_ctx, sink], axis=-1), axis=-1).astype(v.dtype)
        return (jnp.einsum('bgrqk,bkgd->bqgrd', p[..., :span], vb)
                + jnp.einsum('bgrqm,bmgd->bqgrd', p[..., span:span + m], v_ctx))

    o = lax.map(block, (q_blocks, jnp.arange(nb)))
    return o.swapaxes(0, 1).reshape(b, n, g * r * d)


def sink_attention(q, k, v, sinks):
    b, m, g, r, d = q.shape
    s = jnp.einsum('bqgrd,bkgd->bgrqk', q, k).astype(jnp.float32) * d ** -0.5
    sk = jnp.broadcast_to(sinks.astype(jnp.float32).reshape(1, g, r, 1, 1), (b, g, r, m, 1))
    p = jax.nn.softmax(jnp.concatenate([s, sk], axis=-1), axis=-1)[..., :m].astype(v.dtype)
    return jnp.einsum('bgrqk,bkgd->bqgrd', p, v).reshape(b, m, g * r * d)


def depthwise_conv_silu(u, w, bias):
    y = lax.conv_general_dilated(u, w.astype(u.dtype), window_strides=(1,),
                                 padding=((D_CONV // 2, D_CONV // 2),),
                                 dimension_numbers=('NWC', 'WIO', 'NWC'),
                                 feature_group_count=u.shape[-1])
    return jax.nn.silu(y + bias)


def ssd_prep(xbc, dt_raw, conv_w, conv_b, dt_bias_f, dt_bias_b):
    b, L, _ = xbc.shape
    u = depthwise_conv_silu(xbc, conv_w, conv_b).astype(jnp.float32)
    xs, bm, cm = split_cols(u, (D_INNER, D_GROUPS * D_STATE, D_GROUPS * D_STATE))
    xs = xs.reshape(b, L, D_GROUPS, D_HPG, D_HEADDIM)
    bm = bm.reshape(b, L, D_GROUPS, D_STATE)
    cm = cm.reshape(b, L, D_GROUPS, D_STATE)
    dt_raw = dt_raw.astype(jnp.float32)
    dtf = jax.nn.softplus(dt_raw[..., :D_HEADS] + dt_bias_f.astype(jnp.float32)).reshape(b, L, D_GROUPS, D_HPG)
    dtb = jax.nn.softplus(dt_raw[..., D_HEADS:] + dt_bias_b.astype(jnp.float32)).reshape(b, L, D_GROUPS, D_HPG)
    return xs, bm, cm, dtf, dtb


def ssd_chunked(x, dt, a, bm, cm, init_state, want_y):
    b, L, g, r, p = x.shape
    nst = bm.shape[-1]
    nc = L // SSD_CHUNK
    x = x.reshape(b, nc, SSD_CHUNK, g, r, p)
    dt = dt.reshape(b, nc, SSD_CHUNK, g, r)
    bm = bm.reshape(b, nc, SSD_CHUNK, g, nst)
    cm = cm.reshape(b, nc, SSD_CHUNK, g, nst)
    cum = jnp.cumsum(dt * a, axis=2)
    last = cum[:, :, -1]
    xdt = x * dt[..., None]
    states = jnp.einsum('bcsgn,bcsgrp->bcgrpn', bm, xdt * jnp.exp(last[:, :, None] - cum)[..., None])

    def step(carry, inp):
        st, dec = inp
        return carry * dec[..., None, None] + st, carry

    final, prev = lax.scan(step, init_state, (states.swapaxes(0, 1), jnp.exp(last).swapaxes(0, 1)))
    if not want_y:
        return None, final
    prev = prev.swapaxes(0, 1)
    diff = cum[:, :, :, None] - cum[:, :, None, :]
    causal = jnp.tril(jnp.ones((SSD_CHUNK, SSD_CHUNK), dtype=bool))[:, :, None, None]
    lmat = jnp.exp(jnp.where(causal, diff, -jnp.inf))
    cb = jnp.einsum('bclgn,bcsgn->bclsg', cm, bm)
    y_diag = jnp.einsum('bclsgr,bcsgrp->bclgrp', cb[..., None] * lmat, xdt)
    y_off = jnp.einsum('bclgn,bcgrpn->bclgrp', cm, prev) * jnp.exp(cum)[..., None]
    return (y_diag + y_off).reshape(b, L, g, r, p), final


def ssd_output(y, xs, z, d_skip, gnorm_g):
    b, L = y.shape[:2]
    y = y + d_skip.astype(jnp.float32).reshape(D_GROUPS, D_HPG)[:, :, None] * xs
    y = y.reshape(b, L, D_INNER) * jax.nn.silu(z.astype(jnp.float32))
    y = y.reshape(b, L, D_GROUPS, D_INNER // D_GROUPS)
    y = y * lax.rsqrt(jnp.mean(y * y, axis=-1, keepdims=True) + NORM_EPS)
    return y.reshape(b, L, D_INNER) * gnorm_g.astype(jnp.float32)


def expert_choice_ffn(h, w_router, w_gate, w_up, w_down):
    b, n, _ = h.shape
    cap = CAPACITY_FACTOR * n // N_EXPERTS
    aff = jax.nn.softmax(jnp.einsum('bnd,de->bne', h, w_router).astype(jnp.float32), axis=-1)
    gate, idx = lax.top_k(jnp.swapaxes(aff, 1, 2), cap)
    bidx = jnp.arange(b)[:, None, None]
    xg = h[bidx, idx]
    hid = jax.nn.silu(jnp.einsum('becd,edf->becf', xg, w_gate)) * jnp.einsum('becd,edf->becf', xg, w_up)
    out = jnp.einsum('becf,efd->becd', hid, w_down) * gate[..., None].astype(h.dtype)
    return jnp.zeros_like(h).at[bidx, idx].add(out)


def mixer_even(h, hc, ctx_out, *, layer_idx, w_in, w_out, lam_q1, lam_k1, lam_q2, lam_k2, subln_g, rpb):
    b, n, _ = h.shape
    m = hc.shape[1]
    sizes = (A_QK, A_QK, A_WIDTH, B_WIDTH, B_WIDTH, B_WIDTH)
    qa, ka, va, qb, kb, vb = split_cols(h @ w_in, sizes)
    qa_c, ka_c, va_c, qb_c, kb_c, vb_c = split_cols(hc @ w_in, sizes)
    cos, sin = axial_rope_tables(n)
    qa = apply_rope(qa.reshape(b, n, 2 * A_HEADS, HEAD_DIM), cos, sin).reshape(b, n, A_HEADS, 2, HEAD_DIM)
    ka = apply_rope(ka.reshape(b, n, 2 * A_HEADS, HEAD_DIM), cos, sin).reshape(b, n, A_HEADS, 2, HEAD_DIM)
    va = va.reshape(b, n, A_HEADS, A_VDIM)
    ka_c = ka_c.reshape(b, m, A_HEADS, 2, HEAD_DIM)
    va_c = va_c.reshape(b, m, A_HEADS, A_VDIM)
    lam_init = 0.8 - 0.6 * math.exp(-0.3 * layer_idx)
    lam = (jnp.exp(jnp.sum(lam_q1.astype(jnp.float32) * lam_k1.astype(jnp.float32)))
           - jnp.exp(jnp.sum(lam_q2.astype(jnp.float32) * lam_k2.astype(jnp.float32))) + lam_init)
    k_all = jnp.concatenate([ka, ka_c], axis=1)
    v_all = jnp.concatenate([va, va_c], axis=1)
    q_blocks = qa.reshape(b, n // Q_BLOCK, Q_BLOCK, A_HEADS, 2, HEAD_DIM).swapaxes(0, 1)
    o_a = lax.map(lambda qblk: differential_attention(qblk, k_all, v_all, lam), q_blocks)
    o_a = o_a.swapaxes(0, 1).reshape(b, n, A_HEADS, A_VDIM)
    o_a = (rmsnorm(o_a, subln_g) * (1.0 - lam_init)).reshape(b, n, A_WIDTH)
    kb_c = kb_c.reshape(b, m, B_HEADS, HEAD_DIM)
    vb_c = vb_c.reshape(b, m, B_HEADS, HEAD_DIM)
    o_b = neighbourhood_attention(qb.reshape(b, n, B_HEADS, HEAD_DIM), kb.reshape(b, n, B_HEADS, HEAD_DIM),
                                  vb.reshape(b, n, B_HEADS, HEAD_DIM), kb_c, vb_c, rpb)
    out = jnp.concatenate([o_a, o_b], axis=-1) @ w_out
    if not ctx_out:
        return out, None
    oc_a = differential_attention(qa_c.reshape(b, m, A_HEADS, 2, HEAD_DIM), ka_c, va_c, lam)
    oc_a = (rmsnorm(oc_a, subln_g) * (1.0 - lam_init)).reshape(b, m, A_WIDTH)
    oc_b = context_attention(qb_c.reshape(b, m, B_HEADS, HEAD_DIM), kb_c, vb_c)
    out_c = jnp.concatenate([oc_a, oc_b], axis=-1) @ w_out
    return out, out_c


def mixer_odd(h, hc, ctx_out, *, w_in, w_out, sinks, conv_w, conv_b, a_log_f, a_log_b,
              dt_bias_f, dt_bias_b, d_skip, gnorm_g):
    b, n, _ = h.shape
    m = hc.shape[1]
    sizes = (C_Q, C_KV, C_KV, D_XBC, D_INNER, 2 * D_HEADS)
    q, k, v, xbc, z, dt = split_cols(h @ w_in, sizes)
    q_c, k_c, v_c, xbc_c, z_c, dt_c = split_cols(hc @ w_in, sizes)
    cos, sin = axial_rope_tables(n)
    q = apply_rope(q.reshape(b, n, C_HEADS, HEAD_DIM), cos, sin).reshape(b, n, C_KV_HEADS, C_REP, HEAD_DIM)
    k = apply_rope(k.reshape(b, n, C_KV_HEADS, HEAD_DIM), cos, sin)
    v = v.reshape(b, n, C_KV_HEADS, HEAD_DIM)
    k_c = k_c.reshape(b, m, C_KV_HEADS, HEAD_DIM)
    v_c = v_c.reshape(b, m, C_KV_HEADS, HEAD_DIM)
    o_c = window_attention_with_sink(q, k, v, k_c, v_c, sinks)
    a_f = -jnp.exp(a_log_f.astype(jnp.float32)).reshape(D_GROUPS, D_HPG)
    a_b = -jnp.exp(a_log_b.astype(jnp.float32)).reshape(D_GROUPS, D_HPG)
    xs, bm, cm, dtf, dtb = ssd_prep(xbc, dt, conv_w, conv_b, dt_bias_f, dt_bias_b)
    xs_c, bm_c, cm_c, dtf_c, dtb_c = ssd_prep(xbc_c, dt_c, conv_w, conv_b, dt_bias_f, dt_bias_b)
    flip = lambda u: jnp.flip(u, axis=1)
    s0 = jnp.zeros((b, D_GROUPS, D_HPG, D_HEADDIM, D_STATE), jnp.float32)
    yc_f, sc_f = ssd_chunked(xs_c, dtf_c, a_f, bm_c, cm_c, s0, ctx_out)
    yc_b, sc_b = ssd_chunked(flip(xs_c), flip(dtb_c), a_b, flip(bm_c), flip(cm_c), s0, ctx_out)
    y_f, _ = ssd_chunked(xs, dtf, a_f, bm, cm, sc_f, True)
    y_b, _ = ssd_chunked(flip(xs), flip(dtb), a_b, flip(bm), flip(cm), sc_b, True)
    o_d = ssd_output(y_f + flip(y_b), xs, z, d_skip, gnorm_g).astype(h.dtype)
    out = jnp.concatenate([o_c, o_d], axis=-1) @ w_out
    if not ctx_out:
        return out, None
    oc_c = sink_attention(q_c.reshape(b, m, C_KV_HEADS, C_REP, HEAD_DIM), k_c, v_c, sinks)
    oc_d = ssd_output(yc_f + flip(yc_b), xs_c, z_c, d_skip, gnorm_g).astype(h.dtype)
    out_c = jnp.concatenate([oc_c, oc_d], axis=-1) @ w_out
    return out, out_c


def trunk_layer(x, ctx, c, c_ctx, common, mixer, ctx_out):
    w_mod, b_mod, g_pre_mix, g_post_mix, g_pre_ffn, g_post_ffn, w_router, w_gate, w_up, w_down = common
    sh1, sc1, gt1, sh2, sc2, gt2 = ada_modulation(c, w_mod, b_mod)
    csh1, csc1, cgt1, csh2, csc2, cgt2 = ada_modulation(c_ctx, w_mod, b_mod)
    h = rmsnorm(x, g_pre_mix) * (1 + sc1) + sh1
    hc = rmsnorm(ctx, g_pre_mix) * (1 + csc1) + csh1
    mix, mix_c = mixer(h, hc, ctx_out)
    x = x + gt1 * rmsnorm(mix, g_post_mix)
    h = rmsnorm(x, g_pre_ffn) * (1 + sc2) + sh2
    x = x + gt2 * rmsnorm(expert_choice_ffn(h, w_router, w_gate, w_up, w_down), g_post_ffn)
    if ctx_out:
        ctx = ctx + cgt1 * rmsnorm(mix_c, g_post_mix)
        hc = rmsnorm(ctx, g_pre_ffn) * (1 + csc2) + csh2
        ctx = ctx + cgt2 * rmsnorm(expert_choice_ffn(hc, w_router, w_gate, w_up, w_down), g_post_ffn)
    return x, ctx


def setup_inputs(seed: int = 0) -> dict:
    key = jax.random.key(seed)
    keys = list(jax.random.split(key, 64))
    d = D_MODEL

    def normal(shape, std):
        return jax.random.normal(keys.pop(), shape, jnp.float32) * std

    def gain(n):
        return 1.0 + normal((n,), 0.05)

    def dt_bias_init():
        u = jax.random.uniform(keys.pop(), (D_HEADS,), jnp.float32)
        dt = jnp.exp(u * (math.log(0.1) - math.log(0.001)) + math.log(0.001))
        return dt + jnp.log(-jnp.expm1(-dt))

    p = {}
    p['x'] = normal((BATCH, SEQ, d), 1.0)
    p['c'] = normal((BATCH, d), 1.0)
    p['ctx'] = normal((BATCH, CTX_LEN, d), 1.0)
    p['c_ctx'] = normal((d,), 1.0)

    def add_common(pre, in_width):
        p[pre + 'w_mod'] = normal((d, 6 * d), 0.5 * d ** -0.5)
        p[pre + 'b_mod'] = normal((6 * d,), 0.02)
        for name in ('g_pre_mix', 'g_post_mix', 'g_pre_ffn', 'g_post_ffn'):
            p[pre + name] = gain(d)
        p[pre + 'w_in'] = normal((d, in_width), d ** -0.5)
        p[pre + 'w_out'] = normal((MIX_WIDTH, d), MIX_WIDTH ** -0.5)

    def add_moe(pre):
        p[pre + 'w_router'] = normal((d, N_EXPERTS), d ** -0.5)
        p[pre + 'w_gate'] = normal((N_EXPERTS, d, EXPERT_FF), d ** -0.5)
        p[pre + 'w_up'] = normal((N_EXPERTS, d, EXPERT_FF), d ** -0.5)
        p[pre + 'w_down'] = normal((N_EXPERTS, EXPERT_FF, d), EXPERT_FF ** -0.5)

    add_common('l0_', EVEN_IN)
    p['l0_lam_q1'] = normal((HEAD_DIM,), 0.1)
    p['l0_lam_k1'] = normal((HEAD_DIM,), 0.1)
    p['l0_lam_q2'] = normal((HEAD_DIM,), 0.1)
    p['l0_lam_k2'] = normal((HEAD_DIM,), 0.1)
    p['l0_subln_g'] = gain(A_VDIM)
    p['l0_rpb'] = normal((B_HEADS, 2 * NA_ROWS - 1, 2 * NA_COLS - 1), 0.1)
    add_moe('l0_')

    add_common('l1_', ODD_IN)
    p['l1_sinks'] = normal((C_HEADS,), 0.5)
    p['l1_conv_w'] = normal((D_CONV, 1, D_XBC), D_CONV ** -0.5)
    p['l1_conv_b'] = normal((D_XBC,), 0.02)
    p['l1_a_log_f'] = jnp.log(jax.random.uniform(keys.pop(), (D_HEADS,), jnp.float32, 1.0, 16.0))
    p['l1_a_log_b'] = jnp.log(jax.random.uniform(keys.pop(), (D_HEADS,), jnp.float32, 1.0, 16.0))
    p['l1_dt_bias_f'] = dt_bias_init()
    p['l1_dt_bias_b'] = dt_bias_init()
    p['l1_d_skip'] = 1.0 + normal((D_HEADS,), 0.1)
    p['l1_gnorm_g'] = gain(D_INNER)
    add_moe('l1_')
    return p


def reference(x, c, ctx, c_ctx,
              l0_w_mod, l0_b_mod, l0_g_pre_mix, l0_g_post_mix, l0_g_pre_ffn, l0_g_post_ffn,
              l0_w_in, l0_w_out, l0_lam_q1, l0_lam_k1, l0_lam_q2, l0_lam_k2, l0_subln_g, l0_rpb,
              l0_w_router, l0_w_gate, l0_w_up, l0_w_down,
              l1_w_mod, l1_b_mod, l1_g_pre_mix, l1_g_post_mix, l1_g_pre_ffn, l1_g_post_ffn,
              l1_w_in, l1_w_out, l1_sinks, l1_conv_w, l1_conv_b, l1_a_log_f, l1_a_log_b,
              l1_dt_bias_f, l1_dt_bias_b, l1_d_skip, l1_gnorm_g,
              l1_w_router, l1_w_gate, l1_w_up, l1_w_down):
    commons = [
        (l0_w_mod, l0_b_mod, l0_g_pre_mix, l0_g_post_mix, l0_g_pre_ffn, l0_g_post_ffn,
         l0_w_router, l0_w_gate, l0_w_up, l0_w_down),
        (l1_w_mod, l1_b_mod, l1_g_pre_mix, l1_g_post_mix, l1_g_pre_ffn, l1_g_post_ffn,
         l1_w_router, l1_w_gate, l1_w_up, l1_w_down),
    ]
    mixers = [
        functools.partial(mixer_even, layer_idx=0, w_in=l0_w_in, w_out=l0_w_out,
                          lam_q1=l0_lam_q1, lam_k1=l0_lam_k1, lam_q2=l0_lam_q2, lam_k2=l0_lam_k2,
                          subln_g=l0_subln_g, rpb=l0_rpb),
        functools.partial(mixer_odd, w_in=l1_w_in, w_out=l1_w_out, sinks=l1_sinks,
                          conv_w=l1_conv_w, conv_b=l1_conv_b, a_log_f=l1_a_log_f, a_log_b=l1_a_log_b,
                          dt_bias_f=l1_dt_bias_f, dt_bias_b=l1_dt_bias_b, d_skip=l1_d_skip,
                          gnorm_g=l1_gnorm_g),
    ]
    for i in range(DEPTH):
        x, ctx = trunk_layer(x, ctx, c, c_ctx, commons[i], mixers[i], i < DEPTH - 1)
    return x
```

```cpp
#include <hip/hip_runtime.h>
#include <hip/hip_cooperative_groups.h>
#include <cstdio>
#include <cstdint>
namespace cg = cooperative_groups;

typedef unsigned short bf16_t;
#define DEVI __device__ __forceinline__

constexpr int NT = 512, NWAVE = 8;
constexpr int NB = 8, SEQ = 4096, DM = 1024, CTXL = 256;
constexpr int NLAT = NB * SEQ, NCTX = NB * CTXL, NROW = NLAT + NCTX;
constexpr int NE = 16;
constexpr int CAP_L = 512, CAP_C = 32;
constexpr int EROWS0 = NB * CAP_L + NB * CAP_C;
constexpr int EROWS1 = NB * CAP_L;
constexpr int N_IN0 = 3072, N_IN1 = 2320, N_IN1P = 2560;
constexpr float EPS = 1e-6f;

constexpr size_t MiB = 1u << 20;
constexpr size_t WS_CTL = 0;
constexpr size_t WS_WIN0 = 1 * MiB;
constexpr size_t WS_WIN1 = 7 * MiB;
constexpr size_t WS_WOUT0 = 12 * MiB, WS_WOUT1 = 14 * MiB;
constexpr size_t WS_WGU = 16 * MiB;
constexpr size_t WS_WD = 80 * MiB;
constexpr size_t WS_XC = 112 * MiB;
constexpr size_t WS_H = 120 * MiB;
constexpr size_t WS_AFF = 188 * MiB;
constexpr size_t WS_SLOT = 191 * MiB;
constexpr size_t WS_IDX = 194 * MiB;
constexpr size_t WS_GATEV = 195 * MiB;
constexpr size_t WS_BIG = 196 * MiB;
constexpr size_t WS_QKV0 = WS_BIG;
constexpr size_t WS_ATT0 = WS_BIG + 204 * MiB;
constexpr size_t WS_MIX0 = WS_BIG + 272 * MiB;
constexpr size_t WS_XG = WS_BIG;
constexpr size_t WS_HID = WS_BIG + 136 * MiB;
constexpr size_t WS_Y = WS_BIG;
constexpr size_t WS_P1 = WS_BIG;
constexpr size_t WS_DT = WS_BIG + 153 * MiB;
constexpr size_t WS_U = WS_BIG + 156 * MiB;
constexpr size_t WS_MIX1 = WS_U;
constexpr size_t WS_ATT1 = WS_BIG + 224 * MiB;
constexpr size_t WS_YS = WS_BIG + 292 * MiB;
constexpr size_t WS_CUMG = WS_BIG + 356 * MiB;
constexpr size_t WS_DTG = WS_BIG + 359 * MiB;
constexpr size_t WS_END = WS_BIG + 362 * MiB;
constexpr size_t CTL_MOD = 4096;
constexpr size_t CTL_ROPE = CTL_MOD + 2 * 9 * 6144 * 4;
constexpr size_t CTL_LAM = CTL_ROPE + 64 * 16 * 2 * 4;
constexpr size_t CTL_QC = CTL_LAM + 64;
constexpr size_t CTL_BAR = 512 * 1024;

struct Params {
  const float* in[43];
  float* out;
  unsigned char* ws;
};

enum {
  I_X = 0, I_C, I_CTX, I_CCTX,
  L0_WMOD, L0_BMOD, L0_GPREMIX, L0_GPOSTMIX, L0_GPREFFN, L0_GPOSTFFN, L0_WIN, L0_WOUT,
  L0_LAMQ1, L0_LAMK1, L0_LAMQ2, L0_LAMK2, L0_SUBLN, L0_RPB, L0_WROUTER, L0_WGATE, L0_WUP, L0_WDOWN,
  L1_WMOD, L1_BMOD, L1_GPREMIX, L1_GPOSTMIX, L1_GPREFFN, L1_GPOSTFFN, L1_WIN, L1_WOUT,
  L1_SINKS, L1_CONVW, L1_CONVB, L1_ALOGF, L1_ALOGB, L1_DTBF, L1_DTBB, L1_DSKIP, L1_GNORM,
  L1_WROUTER, L1_WGATE, L1_WUP, L1_WDOWN
};

DEVI int ftid() { int t = threadIdx.x; asm volatile("" : "+v"(t)); return t; }
DEVI float bf2f(bf16_t v) { return __uint_as_float(((unsigned)v) << 16); }
DEVI bf16_t f2bf(float f) { unsigned u = __float_as_uint(f); return (bf16_t)((u + 0x7fffu + ((u >> 16) & 1u)) >> 16); }
DEVI unsigned pk2(float lo, float hi) { return (unsigned)f2bf(lo) | ((unsigned)f2bf(hi) << 16); }
DEVI float silu_f(float v) { return v / (1.f + __expf(-v)); }
DEVI float wave_sum(float v) {
#pragma unroll
  for (int o = 1; o < 64; o <<= 1) v += __shfl_xor(v, o);
  return v;
}
DEVI float wave_max(float v) {
#pragma unroll
  for (int o = 1; o < 64; o <<= 1) v = fmaxf(v, __shfl_xor(v, o));
  return v;
}
DEVI int row_modrow(int r) { return r < NLAT ? (r >> 12) : 8; }
#ifndef QKV0_FP8
#define QKV0_FP8 1
#endif
#ifndef QKV1_FP8
#define QKV1_FP8 0
#endif
namespace nv {

DEVI void transpose_item(const float* W, int K, int N, bf16_t* WT, int row_off, int row_mul, float* scr, int item, int lane, int Npad) {
  const int nblk = Npad / 32, kb = item / nblk, nb = item % nblk, k0 = 64 * kb, n0 = 32 * nb;
  const int n = n0 + (lane & 31); const bool ok = n < N;
  const float* src = W + (size_t)(k0 + (lane >> 5)) * N + (ok ? n : 0);
  float v[32];
#pragma unroll
  for (int i = 0; i < 32; ++i) v[i] = src[(size_t)(2 * i) * N];
#pragma unroll
  for (int i = 0; i < 32; ++i) scr[(2 * i + (lane >> 5)) * 33 + (lane & 31)] = ok ? v[i] : 0.f;
  __builtin_amdgcn_s_waitcnt(0); __builtin_amdgcn_wave_barrier();
  const int c = lane & 7;
#pragma unroll
  for (int j = 0; j < 4; ++j) {
    const int nn = (lane >> 3) + 8 * j; const float* s = scr + (8 * c) * 33 + nn;
    uint4 o; o.x = pk2(s[0 * 33], s[1 * 33]); o.y = pk2(s[2 * 33], s[3 * 33]); o.z = pk2(s[4 * 33], s[5 * 33]); o.w = pk2(s[6 * 33], s[7 * 33]);
    *(uint4*)(WT + (size_t)(row_off + (n0 + nn) * row_mul) * K + k0 + 8 * c) = o;
  }
  __builtin_amdgcn_s_waitcnt(0); __builtin_amdgcn_wave_barrier();
}

DEVI void convert_moe_part(const Params& p, int layer, int which, float* scr, int gw, int NGW, int lane) {
  const float* wg = p.in[layer ? L1_WGATE : L0_WGATE]; const float* wu = p.in[layer ? L1_WUP : L0_WUP]; const float* wd = p.in[layer ? L1_WDOWN : L0_WDOWN];
  bf16_t* WGU = (bf16_t*)(p.ws + WS_WGU); bf16_t* WD = (bf16_t*)(p.ws + WS_WD);
  constexpr int IPM = 16 * 32;
  if (which == 0) {
    for (int it = gw; it < NE * 2 * IPM; it += NGW) {
      const int e = it / (2 * IPM), r = it % (2 * IPM), gu = r / IPM, item = r % IPM;
      transpose_item((gu ? wu : wg) + (size_t)e * DM * DM, DM, DM, WGU + (size_t)e * 2048 * DM, gu, 2, scr, item, lane, DM);
    }
  } else {
    for (int it = gw; it < NE * IPM; it += NGW) {
      const int e = it / IPM, item = it % IPM;
      transpose_item(wd + (size_t)e * DM * DM, DM, DM, WD + (size_t)e * DM * DM, 0, 1, scr, item, lane, DM);
    }
  }
}
DEVI void convert_moe_tail(const Params& p, int layer, int which, float* lds, int nunits) {
  const int first = nunits % (int)gridDim.x;
  if ((int)blockIdx.x < first) return;
  const int w = ftid() >> 6;
  convert_moe_part(p, layer, which, lds + w * (64 * 33), ((int)blockIdx.x - first) * NWAVE + w, ((int)gridDim.x - first) * NWAVE, ftid() & 63);
}


constexpr float W8_SCALE = 64.f, A8_SCALE = 4.f;
constexpr int W8_E8M0 = 0x79797979, A8_E8M0 = 0x7d7d7d7d;
DEVI unsigned pack4_fp8(float a, float b, float c, float d) {
  a = fminf(fmaxf(a, -448.f), 448.f); b = fminf(fmaxf(b, -448.f), 448.f); c = fminf(fmaxf(c, -448.f), 448.f); d = fminf(fmaxf(d, -448.f), 448.f);
  int w = 0; w = __builtin_amdgcn_cvt_pk_fp8_f32(a, b, w, false); w = __builtin_amdgcn_cvt_pk_fp8_f32(c, d, w, true); return (unsigned)w; }
DEVI void transpose_item8(const float* W, int K, int N, unsigned char* WT, int row_off, int row_mul, float* scr, int item, int lane, int Npad = 0) {
  if (Npad == 0) Npad = N;
  const int nblk = Npad / 32, kb = item / nblk, nb = item % nblk, k0 = 64 * kb, n0 = 32 * nb;
  const int nn0 = n0 + (lane & 31); const bool ok = nn0 < N;
  const float* src = W + (size_t)(k0 + (lane >> 5)) * N + (ok ? nn0 : 0);
  float v[32];
#pragma unroll
  for (int i = 0; i < 32; ++i) v[i] = src[(size_t)(2 * i) * N];
#pragma unroll
  for (int i = 0; i < 32; ++i) scr[(2 * i + (lane >> 5)) * 33 + (lane & 31)] = ok ? v[i] * W8_SCALE : 0.f;
  __builtin_amdgcn_s_waitcnt(0); __builtin_amdgcn_wave_barrier();
  const int c = lane & 7;
#pragma unroll
  for (int j = 0; j < 4; ++j) {
    const int nn = (lane >> 3) + 8 * j; const float* s = scr + (8 * c) * 33 + nn;
    uint2 o; o.x = pack4_fp8(s[0 * 33], s[1 * 33], s[2 * 33], s[3 * 33]); o.y = pack4_fp8(s[4 * 33], s[5 * 33], s[6 * 33], s[7 * 33]);
    *(uint2*)(WT + (size_t)(row_off + (n0 + nn) * row_mul) * K + k0 + 8 * c) = o;
  }
  __builtin_amdgcn_s_waitcnt(0); __builtin_amdgcn_wave_barrier();
}
DEVI void convert_moe_part8(const Params& p, int layer, int which, float* scr, int gw, int NGW, int lane) {
  const float* wg = p.in[layer ? L1_WGATE : L0_WGATE]; const float* wu = p.in[layer ? L1_WUP : L0_WUP]; const float* wd = p.in[layer ? L1_WDOWN : L0_WDOWN];
  unsigned char* WGU = (unsigned char*)(p.ws + WS_WGU); unsigned char* WD = (unsigned char*)(p.ws + WS_WD);
  constexpr int IPM = 16 * 32;
  if (which == 0) {
    for (int it = gw; it < NE * 2 * IPM; it += NGW) { const int e = it / (2 * IPM), r = it % (2 * IPM), gu = r / IPM, item = r % IPM;
      transpose_item8((gu ? wu : wg) + (size_t)e * DM * DM, DM, DM, WGU + (size_t)e * 2048 * DM, gu, 2, scr, item, lane); }
  } else {
    for (int it = gw; it < NE * IPM; it += NGW) { const int e = it / IPM, item = it % IPM;
      transpose_item8(wd + (size_t)e * DM * DM, DM, DM, WD + (size_t)e * DM * DM, 0, 1, scr, item, lane); }
  }
}
DEVI void convert_moe_tail8(const Params& p, int layer, int which, float* lds, int nunits) {
  const int first = nunits % (int)gridDim.x;
  if ((int)blockIdx.x < first) return;
  const int w = ftid() >> 6;
  convert_moe_part8(p, layer, which, lds + w * (64 * 33), ((int)blockIdx.x - first) * NWAVE + w, ((int)gridDim.x - first) * NWAVE, ftid() & 63);
}

DEVI void phase0(const Params& p, float* lds) {
  const int tid = ftid(), lane = tid & 63, wave = tid >> 6;
  const int gw = blockIdx.x * NWAVE + wave, NGW = gridDim.x * NWAVE;
  for (int it = blockIdx.x; it < 2 * 96; it += gridDim.x) {
    const int layer = it / 96, j0 = (it % 96) * 64;
    float* sc = lds;
    float* red = lds + 9 * 1024;
    __syncthreads();
    for (int i = tid; i < 9 * 1024; i += NT) { const int r = i >> 10, k = i & 1023; const float v = (r < 8) ? p.in[I_C][r * 1024 + k] : p.in[I_CCTX][k]; sc[i] = silu_f(v); }
    __syncthreads();
    const float* wm = p.in[layer ? L1_WMOD : L0_WMOD];
    float acc[9];
#pragma unroll
    for (int r = 0; r < 9; ++r) acc[r] = 0.f;
    for (int k0 = wave * 128; k0 < wave * 128 + 128; k0 += 16) {
      float w[16];
#pragma unroll
      for (int i = 0; i < 16; ++i) w[i] = wm[(size_t)(k0 + i) * 6144 + j0 + lane];
#pragma unroll
      for (int i = 0; i < 16; ++i)
#pragma unroll
        for (int r = 0; r < 9; ++r) acc[r] += sc[r * 1024 + k0 + i] * w[i];
    }
#pragma unroll
    for (int r = 0; r < 9; ++r) red[(wave * 9 + r) * 64 + lane] = acc[r];
    __syncthreads();
    for (int i = tid; i < 9 * 64; i += NT) {
      const int r = i >> 6, c = i & 63; float s = 0.f;
      for (int w = 0; w < 8; ++w) s += red[(w * 9 + r) * 64 + c];
      float* MOD = (float*)(p.ws + WS_CTL + CTL_MOD);
      MOD[(layer * 9 + r) * 6144 + j0 + c] = s + p.in[layer ? L1_BMOD : L0_BMOD][j0 + c];
    }
    __syncthreads();
  }
  if (blockIdx.x == gridDim.x - 1) {
    float* ROPE = (float*)(p.ws + WS_CTL + CTL_ROPE);
    for (int i = tid; i < 64 * 16; i += NT) {
      const int pos = i >> 4, f = i & 15;
      const float inv = powf(10000.f, -(float)f / 16.f);
      const float ang = (float)pos * inv;
      ROPE[2 * i] = cosf(ang); ROPE[2 * i + 1] = sinf(ang);
    }
    if (wave == 0) {
      float a = p.in[L0_LAMQ1][lane] * p.in[L0_LAMK1][lane], b = p.in[L0_LAMQ2][lane] * p.in[L0_LAMK2][lane];
      a = wave_sum(a); b = wave_sum(b);
      if (lane == 0) { float* LAM = (float*)(p.ws + WS_CTL + CTL_LAM); LAM[0] = expf(a) - expf(b) + 0.2f; *(int*)(p.ws + WS_CTL + CTL_QC) = 0; }
    }
  }
  __syncthreads();
  float* scr = lds + wave * (64 * 33);
  {
    constexpr int I_IN0 = 16 * (N_IN0 / 32), I_OUT = 16 * 32, I_IN1 = 16 * (N_IN1P / 32);
    constexpr int NITEMS = I_IN0 + I_OUT + I_IN1 + I_OUT;
    for (int it = gw; it < NITEMS; it += NGW) {
      int r = it;
      if (r < I_IN0) { if (QKV0_FP8) transpose_item8(p.in[L0_WIN], DM, N_IN0, (unsigned char*)(p.ws + WS_WIN0), 0, 1, scr, r, lane); else transpose_item(p.in[L0_WIN], DM, N_IN0, (bf16_t*)(p.ws + WS_WIN0), 0, 1, scr, r, lane, N_IN0); continue; } r -= I_IN0;
      if (r < I_OUT) { transpose_item(p.in[L0_WOUT], DM, DM, (bf16_t*)(p.ws + WS_WOUT0), 0, 1, scr, r, lane, DM); continue; } r -= I_OUT;
      if (r < I_IN1) { if (QKV1_FP8) transpose_item8(p.in[L1_WIN], DM, N_IN1, (unsigned char*)(p.ws + WS_WIN1), 0, 1, scr, r, lane, N_IN1P); else transpose_item(p.in[L1_WIN], DM, N_IN1, (bf16_t*)(p.ws + WS_WIN1), 0, 1, scr, r, lane, N_IN1P); continue; } r -= I_IN1;
      transpose_item(p.in[L1_WOUT], DM, DM, (bf16_t*)(p.ws + WS_WOUT1), 0, 1, scr, r, lane, DM);
    }
  }
  convert_moe_part8(p, 0, 0, scr, gw, NGW, lane);
#ifndef TAILFILL
  convert_moe_part8(p, 0, 1, scr, gw, NGW, lane);
#endif
}

struct Row16 { float4 v[4]; };
DEVI Row16 ld_row_f32(const float* r, int lane) { Row16 o; const float4* q = (const float4*)r + lane;
#pragma unroll
  for (int j = 0; j < 4; ++j) o.v[j] = q[64 * j]; return o; }
DEVI Row16 ld_row_bf16(const bf16_t* r, int lane) { Row16 o; const uint2* q = (const uint2*)r + lane;
#pragma unroll
  for (int j = 0; j < 4; ++j) { const uint2 w = q[64 * j]; o.v[j] = make_float4(__uint_as_float(w.x << 16), __uint_as_float(w.x & 0xffff0000u), __uint_as_float(w.y << 16), __uint_as_float(w.y & 0xffff0000u)); }
  return o; }
DEVI void st_row_f32(float* r, int lane, const Row16& o) { float4* q = (float4*)r + lane;
#pragma unroll
  for (int j = 0; j < 4; ++j) q[64 * j] = o.v[j]; }
DEVI void st_row_bf16(bf16_t* r, int lane, const Row16& o) { uint2* q = (uint2*)r + lane;
#pragma unroll
  for (int j = 0; j < 4; ++j) q[64 * j] = make_uint2(pk2(o.v[j].x, o.v[j].y), pk2(o.v[j].z, o.v[j].w)); }
DEVI float row_sumsq(const Row16& o) { float s = 0.f;
#pragma unroll
  for (int j = 0; j < 4; ++j) s += o.v[j].x * o.v[j].x + o.v[j].y * o.v[j].y + o.v[j].z * o.v[j].z + o.v[j].w * o.v[j].w;
  return wave_sum(s); }
#define ROW_FOR4(expr) _Pragma("unroll") for (int j = 0; j < 4; ++j) { { float& e = o.v[j].x; const float a = A.v[j].x, b = Bv.v[j].x, c = Cv.v[j].x; expr; } { float& e = o.v[j].y; const float a = A.v[j].y, b = Bv.v[j].y, c = Cv.v[j].y; expr; } { float& e = o.v[j].z; const float a = A.v[j].z, b = Bv.v[j].z, c = Cv.v[j].z; expr; } { float& e = o.v[j].w; const float a = A.v[j].w, b = Bv.v[j].w, c = Cv.v[j].w; expr; } }

DEVI Row16 norm_mod(const Row16& x, const float* g, const float* sc, const float* sh, int lane) {
  const float r = rsqrtf(row_sumsq(x) * (1.f / DM) + EPS);
  Row16 o = x; const Row16 A = ld_row_f32(g, lane), Bv = ld_row_f32(sc, lane), Cv = ld_row_f32(sh, lane);
  ROW_FOR4(e = e * r * a * (1.f + b) + c);
  return o;
}

DEVI void phase_prenorm0(const Params& p) {
  const int lane = ftid() & 63, gw = blockIdx.x * NWAVE + (ftid() >> 6), NGW = gridDim.x * NWAVE;
  const float* MOD = (const float*)(p.ws + WS_CTL + CTL_MOD);
  bf16_t* H = (bf16_t*)(p.ws + WS_H);
  for (int r = gw; r < NROW; r += NGW) {
    const float* src = r < NLAT ? p.in[I_X] + (size_t)r * DM : p.in[I_CTX] + (size_t)(r - NLAT) * DM;
    const float* m = MOD + (size_t)row_modrow(r) * 6144;
    const Row16 x = ld_row_f32(src, lane);
    const Row16 h = norm_mod(x, p.in[L0_GPREMIX], m + 1024, m, lane);
    st_row_bf16(H + (size_t)r * DM, lane, h);
  }
}

template <class AF, class EF>
DEVI void gemm_tile(float* lds, const bf16_t* Bt, int n0, int K, AF arow, EF epi) {
  const int tid = ftid(), ty = tid >> 4, tx = tid & 15;
  float (*As)[132] = (float (*)[132])lds;
  float (*Bs)[68] = (float (*)[68])(lds + 16 * 132);
  float acc[4][4];
#pragma unroll
  for (int i = 0; i < 4; ++i)
#pragma unroll
    for (int j = 0; j < 4; ++j) acc[i][j] = 0.f;
  const int ar = tid >> 2, ak = (tid & 3) * 4;
  const int br = tid >> 3, bk = (tid & 7) * 2;
  const bf16_t* ap = arow(ar) + ak;
  const bf16_t* bp = Bt + (size_t)(n0 + br) * K + bk;
  for (int k0 = 0; k0 < K; k0 += 16) {
    const uint2 av = *(const uint2*)(ap + k0);
    const unsigned bv = *(const unsigned*)(bp + k0);
    __syncthreads();
    As[ak + 0][ar] = __uint_as_float(av.x << 16); As[ak + 1][ar] = __uint_as_float(av.x & 0xffff0000u);
    As[ak + 2][ar] = __uint_as_float(av.y << 16); As[ak + 3][ar] = __uint_as_float(av.y & 0xffff0000u);
    Bs[bk + 0][br] = __uint_as_float(bv << 16); Bs[bk + 1][br] = __uint_as_float(bv & 0xffff0000u);
    __syncthreads();
#pragma unroll
    for (int kk = 0; kk < 16; ++kk) {
      const float4 a = *(const float4*)&As[kk][ty * 4]; const float4 b = *(const float4*)&Bs[kk][tx * 4];
      const float aa[4] = {a.x, a.y, a.z, a.w}, bb[4] = {b.x, b.y, b.z, b.w};
#pragma unroll
      for (int i = 0; i < 4; ++i)
#pragma unroll
        for (int j = 0; j < 4; ++j) acc[i][j] += aa[i] * bb[j];
    }
  }
#pragma unroll
  for (int i = 0; i < 4; ++i) epi(ty * 4 + i, n0 + tx * 4, acc[i]);
}

DEVI void rope_pair(const float* ROPE, int t, int d, float& u1, float& u2) {
  const int i = d >> 1, f = i & 15, pos = (i < 16) ? (t >> 6) : (t & 63);
  const float cs = ROPE[(pos * 16 + f) * 2], sn = ROPE[(pos * 16 + f) * 2 + 1];
  const float a = u1 * cs - u2 * sn, b = u1 * sn + u2 * cs; u1 = a; u2 = b;
}

DEVI void phase_qkv0(const Params& p, float* lds) {
  const bf16_t* H = (const bf16_t*)(p.ws + WS_H); const bf16_t* W = (const bf16_t*)(p.ws + WS_WIN0);
  bf16_t* Q = (bf16_t*)(p.ws + WS_QKV0); const float* ROPE = (const float*)(p.ws + WS_CTL + CTL_ROPE);
  constexpr int NTN = N_IN0 / 64, NTM = NROW / 128;
  for (int it = blockIdx.x; it < NTN * NTM; it += gridDim.x) {
    const int mt = it / NTN, nt = it % NTN, m0 = mt * 128;
    gemm_tile(lds, W, nt * 64, DM,
      [&](int r) { return H + (size_t)(m0 + r) * DM; },
      [&](int r, int n, float* v) {
        const int row = m0 + r;
        if (row < NLAT && n < 1024) { const int t = row & 4095; rope_pair(ROPE, t, n & 63, v[0], v[1]); rope_pair(ROPE, t, (n + 2) & 63, v[2], v[3]); }
        *(uint2*)(Q + (size_t)row * N_IN0 + n) = make_uint2(pk2(v[0], v[1]), pk2(v[2], v[3]));
      });
  }
}

template <int NS, int VJ, class KF>
DEVI void wave_attn(const float* qs, float* pl  , int* rl  , int nkeys, KF kf, const bf16_t* KV, int ld, int kcol, int vcol,
                    float sink, bool has_sink, float (&o)[NS][VJ], float (&m)[NS], float (&l)[NS], int lane) {
#pragma unroll
  for (int s = 0; s < NS; ++s) { m[s] = -INFINITY; l[s] = 0.f;
#pragma unroll
    for (int j = 0; j < VJ; ++j) o[s][j] = 0.f; }
  for (int c0 = 0; c0 < nkeys; c0 += 64) {
    const int kidx = c0 + lane; int row = -1; float bias = 0.f;
    bool valid = kidx < nkeys; if (valid) valid = kf(kidx, row, bias);
    const int rr = valid ? row : 0;
    rl[lane] = valid ? row : -1;
    float sc[NS];
#pragma unroll
    for (int s = 0; s < NS; ++s) {
      const uint4* kp = (const uint4*)(KV + (size_t)rr * ld + kcol + 64 * s); float d = 0.f;
#pragma unroll
      for (int i = 0; i < 8; ++i) { const uint4 w = kp[i]; const float* q = qs + s * 64 + i * 8;
        d += q[0] * __uint_as_float(w.x << 16) + q[1] * __uint_as_float(w.x & 0xffff0000u) + q[2] * __uint_as_float(w.y << 16) + q[3] * __uint_as_float(w.y & 0xffff0000u)
           + q[4] * __uint_as_float(w.z << 16) + q[5] * __uint_as_float(w.z & 0xffff0000u) + q[6] * __uint_as_float(w.w << 16) + q[7] * __uint_as_float(w.w & 0xffff0000u); }
      sc[s] = valid ? d + bias : -INFINITY;
    }
#pragma unroll
    for (int s = 0; s < NS; ++s) {
      const float cm = wave_max(sc[s]); const float mn = fmaxf(m[s], cm);
      float pv = 0.f, scale = 1.f;
      if (mn > -INFINITY) { pv = __expf(sc[s] - mn); scale = __expf(m[s] - mn); }
      l[s] = l[s] * scale + wave_sum(pv); m[s] = mn;
#pragma unroll
      for (int j = 0; j < VJ; ++j) o[s][j] *= scale;
      pl[s * 64 + lane] = pv;
    }
    __builtin_amdgcn_s_waitcnt(0); __builtin_amdgcn_wave_barrier();
    for (int kk = 0; kk < 64; ++kk) {
      const int rk = rl[kk]; if (rk < 0) continue;
      const bf16_t* vp = KV + (size_t)rk * ld + vcol + lane;
      float vv[VJ];
#pragma unroll
      for (int j = 0; j < VJ; ++j) vv[j] = bf2f(vp[64 * j]);
#pragma unroll
      for (int s = 0; s < NS; ++s) { const float pk = pl[s * 64 + kk];
#pragma unroll
        for (int j = 0; j < VJ; ++j) o[s][j] += pk * vv[j]; }
    }
    __builtin_amdgcn_s_waitcnt(0); __builtin_amdgcn_wave_barrier();
  }
  if (has_sink) {
#pragma unroll
    for (int s = 0; s < NS; ++s) { const float mn = fmaxf(m[s], sink); const float scale = __expf(m[s] - mn);
      l[s] = l[s] * scale + __expf(sink - mn); m[s] = mn;
#pragma unroll
      for (int j = 0; j < VJ; ++j) o[s][j] *= scale; }
  }
}

DEVI void phase_attn0(const Params& p, float* lds) {
  const int tid = ftid(), lane = tid & 63, wave = tid >> 6;
  const int gw = blockIdx.x * NWAVE + wave, NGW = gridDim.x * NWAVE;
  const bf16_t* Q = (const bf16_t*)(p.ws + WS_QKV0); bf16_t* ATT = (bf16_t*)(p.ws + WS_ATT0);
  const float lam = ((const float*)(p.ws + WS_CTL + CTL_LAM))[0];
  float* qs = lds + wave * 128; float* pl = lds + 1024 + wave * 128; int* rl = (int*)(lds + 2048) + wave * 64;
  for (long it = gw; it < (long)NROW * 12; it += NGW) {
    const int row = (int)(it / 12), hs = (int)(it % 12);
    const bool lat = row < NLAT; const int b = lat ? (row >> 12) : ((row - NLAT) >> 8), t = lat ? (row & 4095) : 0;
    __builtin_amdgcn_s_waitcnt(0); __builtin_amdgcn_wave_barrier();
    if (hs < 4) {
      const bf16_t* qp = Q + (size_t)row * N_IN0 + hs * 128;
      qs[lane] = bf2f(qp[lane]) * 0.125f; qs[64 + lane] = bf2f(qp[64 + lane]) * 0.125f;
      __builtin_amdgcn_s_waitcnt(0); __builtin_amdgcn_wave_barrier();
      float o[2][2], m[2], l[2];
      const int nkeys = lat ? SEQ + CTXL : CTXL;
      wave_attn<2, 2>(qs, pl, rl, nkeys, [&](int k, int& r, float& bias) { r = lat ? (k < SEQ ? b * SEQ + k : NLAT + b * CTXL + (k - SEQ)) : NLAT + b * CTXL + k; return true; },
                      Q, N_IN0, 512 + hs * 128, 1024 + hs * 128, 0.f, false, o, m, l, lane);
      float v0 = o[0][0] / l[0] - lam * o[1][0] / l[1], v1 = o[0][1] / l[0] - lam * o[1][1] / l[1];
      const float r = rsqrtf(wave_sum(v0 * v0 + v1 * v1) * (1.f / 128.f) + EPS);
      const float* g = p.in[L0_SUBLN];
      ATT[(size_t)row * DM + hs * 128 + lane] = f2bf(v0 * r * g[lane] * 0.8f);
      ATT[(size_t)row * DM + hs * 128 + 64 + lane] = f2bf(v1 * r * g[64 + lane] * 0.8f);
    } else {
      const int h = hs - 4;
      qs[lane] = bf2f(Q[(size_t)row * N_IN0 + 1536 + h * 64 + lane]) * 0.125f;
      __builtin_amdgcn_s_waitcnt(0); __builtin_amdgcn_wave_barrier();
      float o[1][1], m[1], l[1];
      const int qr = t >> 6, qc = t & 63;
      const int rs = min(max(qr - 4, 0), 56), cs = min(max(qc - 8, 0), 48);
      const float* rpb = p.in[L0_RPB] + h * 15 * 31;
      const int nkeys = lat ? 128 + CTXL : CTXL;
      wave_attn<1, 1>(qs, pl, rl, nkeys, [&](int k, int& r, float& bias) {
          if (!lat) { r = NLAT + b * CTXL + k; return true; }
          if (k < 128) { const int kr = rs + (k >> 4), kc = cs + (k & 15); r = b * SEQ + kr * 64 + kc; bias = rpb[(kr - qr + 7) * 31 + (kc - qc + 15)]; }
          else r = NLAT + b * CTXL + (k - 128);
          return true; },
        Q, N_IN0, 2048 + h * 64, 2560 + h * 64, 0.f, false, o, m, l, lane);
      ATT[(size_t)row * DM + 512 + h * 64 + lane] = f2bf(o[0][0] / l[0]);
    }
  }
}

DEVI void phase_outproj(const Params& p, float* lds, int layer) {
  const bf16_t* A = (const bf16_t*)(p.ws + (layer ? WS_ATT1 : WS_ATT0)); const bf16_t* W = (const bf16_t*)(p.ws + (layer ? WS_WOUT1 : WS_WOUT0));
  bf16_t* MIX = (bf16_t*)(p.ws + (layer ? WS_MIX1 : WS_MIX0));
  const int NTM = (layer ? NLAT : NROW) / 128; constexpr int NTN = DM / 64;
  for (int it = blockIdx.x; it < NTN * NTM; it += gridDim.x) {
    const int mt = it / NTN, nt = it % NTN, m0 = mt * 128;
    gemm_tile(lds, W, nt * 64, DM, [&](int r) { return A + (size_t)(m0 + r) * DM; },
      [&](int r, int n, float* v) { *(uint2*)(MIX + (size_t)(m0 + r) * DM + n) = make_uint2(pk2(v[0], v[1]), pk2(v[2], v[3])); });
  }
}

DEVI void phase_postmix(const Params& p, int layer) {
  const int lane = ftid() & 63, gw = blockIdx.x * NWAVE + (ftid() >> 6), NGW = gridDim.x * NWAVE;
  const float* MOD = (const float*)(p.ws + WS_CTL + CTL_MOD) + (size_t)layer * 9 * 6144;
  const bf16_t* MIX = (const bf16_t*)(p.ws + (layer ? WS_MIX1 : WS_MIX0));
  bf16_t* H = (bf16_t*)(p.ws + WS_H); float* AFF = (float*)(p.ws + WS_AFF); float* XC = (float*)(p.ws + WS_XC);
  const float* gpost = p.in[layer ? L1_GPOSTMIX : L0_GPOSTMIX]; const float* gpre = p.in[layer ? L1_GPREFFN : L0_GPREFFN];
  const float* wr = p.in[layer ? L1_WROUTER : L0_WROUTER];
  const int nrow = layer ? NLAT : NROW;
  for (int r = gw; r < nrow; r += NGW) {
    const float* m = MOD + (size_t)row_modrow(r) * 6144;
    const float* xin = layer ? (p.out + (size_t)r * DM) : (r < NLAT ? p.in[I_X] + (size_t)r * DM : p.in[I_CTX] + (size_t)(r - NLAT) * DM);
    float* xout = r < NLAT ? p.out + (size_t)r * DM : XC + (size_t)(r - NLAT) * DM;
    Row16 o = ld_row_bf16(MIX + (size_t)r * DM, lane);
    const float rr = rsqrtf(row_sumsq(o) * (1.f / DM) + EPS);
    { const Row16 A = ld_row_f32(gpost, lane), Bv = ld_row_f32(m + 2048, lane), Cv = ld_row_f32(xin, lane);
      ROW_FOR4(e = c + b * (e * rr * a)); }
    st_row_f32(xout, lane, o);
    const Row16 h = norm_mod(o, gpre, m + 4096, m + 3072, lane);
    st_row_bf16(H + (size_t)r * DM, lane, h);
    float lg[16];
#pragma unroll
    for (int e = 0; e < 16; ++e) lg[e] = 0.f;
#pragma unroll
    for (int j = 0; j < 4; ++j) {
      const float hv[4] = {h.v[j].x, h.v[j].y, h.v[j].z, h.v[j].w};
#pragma unroll
      for (int q = 0; q < 4; ++q) { const float4* w4 = (const float4*)(wr + (size_t)(lane * 4 + 256 * j + q) * 16);
#pragma unroll
        for (int e4 = 0; e4 < 4; ++e4) { const float4 w = w4[e4]; lg[e4 * 4] += hv[q] * w.x; lg[e4 * 4 + 1] += hv[q] * w.y; lg[e4 * 4 + 2] += hv[q] * w.z; lg[e4 * 4 + 3] += hv[q] * w.w; } }
    }
    float mx = -INFINITY;
#pragma unroll
    for (int e = 0; e < 16; ++e) { lg[e] = wave_sum(lg[e]); mx = fmaxf(mx, lg[e]); }
    float s = 0.f;
#pragma unroll
    for (int e = 0; e < 16; ++e) { lg[e] = expf(lg[e] - mx); s += lg[e]; }
    const float inv = 1.f / s;
    float mine = 0.f;
#pragma unroll
    for (int e = 0; e < 16; ++e) if (lane == e) mine = lg[e] * inv;
    if (lane < 16) AFF[(size_t)lane * NROW + r] = mine;
  }
}

DEVI void phase_topk(const Params& p, float* lds, int layer) {
  const int tid = ftid();
  const float* AFF = (const float*)(p.ws + WS_AFF); int* SLOT = (int*)(p.ws + WS_SLOT); int* IDX = (int*)(p.ws + WS_IDX); float* GV = (float*)(p.ws + WS_GATEV);
  const int erows = layer ? EROWS1 : EROWS0;
  const int nlat_items = NB * NE * 8, nitems = nlat_items + (layer ? 0 : NB * NE);
  for (int it = blockIdx.x; it < nitems; it += gridDim.x) {
    const bool lat = it < nlat_items;
    int b, e, ch, n, cap, row0, slot0;
    if (lat) { b = it / (NE * 8); e = (it / 8) % NE; ch = it % 8; n = SEQ; cap = CAP_L; row0 = b * SEQ; slot0 = b * CAP_L; }
    else { const int i2 = it - nlat_items; b = i2 / NE; e = i2 % NE; ch = 0; n = CTXL; cap = CAP_C; row0 = NLAT + b * CTXL; slot0 = NB * CAP_L + b * CAP_C; }
    __syncthreads();
    for (int i = tid; i < n; i += NT) lds[i] = AFF[(size_t)e * NROW + row0 + i];
    __syncthreads();
    const int t = ch * 512 + tid;
    if (t < n) {
      const float a = lds[t]; int rank = 0;
      for (int j = 0; j < n; ++j) { const float v = lds[j]; rank += (v > a || (v == a && j < t)) ? 1 : 0; }
      if (rank < cap) { IDX[e * erows + slot0 + rank] = row0 + t; GV[e * erows + slot0 + rank] = a; SLOT[(size_t)(row0 + t) * 16 + e] = slot0 + rank; }
      else SLOT[(size_t)(row0 + t) * 16 + e] = -1;
    }
  }
}

DEVI void phase_moe_up(const Params& p, float* lds, int layer) {
  const bf16_t* H = (const bf16_t*)(p.ws + WS_H); const bf16_t* WGU = (const bf16_t*)(p.ws + WS_WGU); bf16_t* HID = (bf16_t*)(p.ws + WS_HID);
  const int* IDX = (const int*)(p.ws + WS_IDX);
  const int erows = layer ? EROWS1 : EROWS0, NTM = erows / 128; constexpr int NTN = 2048 / 64;
  for (int it = blockIdx.x; it < NE * NTM * NTN; it += gridDim.x) {
    const int e = it / (NTM * NTN), r2 = it % (NTM * NTN), mt = r2 / NTN, nt = r2 % NTN, m0 = mt * 128;
    gemm_tile(lds, WGU + (size_t)e * 2048 * DM, nt * 64, DM, [&](int r) { return H + (size_t)IDX[e * erows + m0 + r] * DM; },
      [&](int r, int n, float* v) { *(unsigned*)(HID + ((size_t)e * erows + m0 + r) * DM + (n >> 1)) = pk2(silu_f(v[0]) * v[1], silu_f(v[2]) * v[3]); });
  }
}
DEVI void phase_moe_down(const Params& p, float* lds, int layer) {
  const bf16_t* HID = (const bf16_t*)(p.ws + WS_HID); const bf16_t* WD = (const bf16_t*)(p.ws + WS_WD); bf16_t* Y = (bf16_t*)(p.ws + WS_Y);
  const float* GV = (const float*)(p.ws + WS_GATEV);
  const int erows = layer ? EROWS1 : EROWS0, NTM = erows / 128; constexpr int NTN = DM / 64;
  for (int it = blockIdx.x; it < NE * NTM * NTN; it += gridDim.x) {
    const int e = it / (NTM * NTN), r2 = it % (NTM * NTN), mt = r2 / NTN, nt = r2 % NTN, m0 = mt * 128;
    gemm_tile(lds, WD + (size_t)e * DM * DM, nt * 64, DM, [&](int r) { return HID + ((size_t)e * erows + m0 + r) * DM; },
      [&](int r, int n, float* v) { const float g = GV[e * erows + m0 + r];
        *(uint2*)(Y + ((size_t)e * erows + m0 + r) * DM + n) = make_uint2(pk2(v[0] * g, v[1] * g), pk2(v[2] * g, v[3] * g)); });
  }
}

DEVI void phase_combine(const Params& p, float* lds, int layer) {
  const int lane = ftid() & 63, wave = ftid() >> 6, gw = blockIdx.x * NWAVE + wave, NGW = gridDim.x * NWAVE;
  const float* MOD = (const float*)(p.ws + WS_CTL + CTL_MOD);
  const bf16_t* Y = (const bf16_t*)(p.ws + WS_Y); const int* SLOT = (const int*)(p.ws + WS_SLOT);
  bf16_t* H = (bf16_t*)(p.ws + WS_H); float* XC = (float*)(p.ws + WS_XC);
  const float* gpost = p.in[layer ? L1_GPOSTFFN : L0_GPOSTFFN];
  const int nrow = layer ? NLAT : NROW, erows = layer ? EROWS1 : EROWS0;
  for (int r = gw; r < nrow; r += NGW) {
    const float* m = MOD + (size_t)(layer * 9 + row_modrow(r)) * 6144;
    float* xio = r < NLAT ? p.out + (size_t)r * DM : XC + (size_t)(r - NLAT) * DM;
    Row16 o;
#pragma unroll
    for (int j = 0; j < 4; ++j) o.v[j] = make_float4(0.f, 0.f, 0.f, 0.f);
    for (int e = 0; e < NE; ++e) {
      const int s = SLOT[(size_t)r * 16 + e];
      if (s >= 0) { const Row16 y = ld_row_bf16(Y + ((size_t)e * erows + s) * DM, lane);
#pragma unroll
        for (int j = 0; j < 4; ++j) { o.v[j].x += y.v[j].x; o.v[j].y += y.v[j].y; o.v[j].z += y.v[j].z; o.v[j].w += y.v[j].w; } }
    }
    const float rr = rsqrtf(row_sumsq(o) * (1.f / DM) + EPS);
    { const Row16 A = ld_row_f32(gpost, lane), Bv = ld_row_f32(m + 5120, lane), Cv = ld_row_f32(xio, lane);
      ROW_FOR4(e = c + b * (e * rr * a)); }
    st_row_f32(xio, lane, o);
    if (layer == 0) {
      const float* m1 = MOD + (size_t)(9 + row_modrow(r)) * 6144;
      const Row16 h = norm_mod(o, p.in[L1_GPREMIX], m1 + 1024, m1, lane);
      st_row_bf16(H + (size_t)r * DM, lane, h);
    }
  }
  if (layer == 0) { convert_moe_part(p, 1, 0, lds + wave * (64 * 33), gw, NGW, lane); convert_moe_part(p, 1, 1, lds + wave * (64 * 33), gw, NGW, lane); }
}

DEVI void phase_qkv1(const Params& p, float* lds) {
  const bf16_t* H = (const bf16_t*)(p.ws + WS_H); const bf16_t* W = (const bf16_t*)(p.ws + WS_WIN1);
  bf16_t* P1 = (bf16_t*)(p.ws + WS_P1); float* DT = (float*)(p.ws + WS_DT); const float* ROPE = (const float*)(p.ws + WS_CTL + CTL_ROPE);
  constexpr int NTN = 37, NTM = NROW / 128;
  for (int it = blockIdx.x; it < NTN * NTM; it += gridDim.x) {
    const int mt = it / NTN, nt = it % NTN, m0 = mt * 128;
    gemm_tile(lds, W, nt * 64, DM, [&](int r) { return H + (size_t)(m0 + r) * DM; },
      [&](int r, int n, float* v) {
        const int row = m0 + r;
        if (n >= 2304) { if (n < 2320) *(float4*)(DT + (size_t)row * 16 + (n - 2304)) = make_float4(v[0], v[1], v[2], v[3]); return; }
        if (row < NLAT && n < 640) { const int t = row & 4095; rope_pair(ROPE, t, n & 63, v[0], v[1]); rope_pair(ROPE, t, (n + 2) & 63, v[2], v[3]); }
        *(uint2*)(P1 + (size_t)row * 2304 + n) = make_uint2(pk2(v[0], v[1]), pk2(v[2], v[3]));
      });
  }
}

DEVI void phase_conv_swa(const Params& p, float* lds, bool do_swa) {
  const int tid = ftid(), lane = tid & 63, wave = tid >> 6;
  const int gw = blockIdx.x * NWAVE + wave, NGW = gridDim.x * NWAVE;
  const bf16_t* P1 = (const bf16_t*)(p.ws + WS_P1); bf16_t* U = (bf16_t*)(p.ws + WS_U); bf16_t* ATT = (bf16_t*)(p.ws + WS_ATT1);
  const float* cw = p.in[L1_CONVW]; const float* cb = p.in[L1_CONVB];
  for (long i = (long)blockIdx.x * NT + tid; i < (long)NROW * 1024; i += (long)gridDim.x * NT) {
    const int row = (int)(i >> 10), ch = (int)(i & 1023);
    int s0, len, t; if (row < NLAT) { s0 = row & ~4095; len = SEQ; t = row & 4095; } else { s0 = NLAT + ((row - NLAT) & ~255); len = CTXL; t = (row - NLAT) & 255; }
    float acc = cb[ch];
#pragma unroll
    for (int j = 0; j < 5; ++j) { const int tt = t + j - 2; if (tt >= 0 && tt < len) acc += cw[j * 1024 + ch] * bf2f(P1[(size_t)(s0 + tt) * 2304 + 768 + ch]); }
    U[(size_t)row * 1024 + ch] = f2bf(silu_f(acc));
  }
  if (!do_swa) return;
  float* qs = lds + wave * 128; float* pl = lds + 1024 + wave * 128; int* rl = (int*)(lds + 2048) + wave * 64;
  for (long it = gw; it < (long)NLAT * 8; it += NGW) {
    const int row = (int)(it >> 3), hq = (int)(it & 7), g = hq >> 2, b = row >> 12, t = row & 4095;
    __builtin_amdgcn_s_waitcnt(0); __builtin_amdgcn_wave_barrier();
    qs[lane] = bf2f(P1[(size_t)row * 2304 + hq * 64 + lane]) * 0.125f;
    __builtin_amdgcn_s_waitcnt(0); __builtin_amdgcn_wave_barrier();
    float o[1][1], m[1], l[1];
    wave_attn<1, 1>(qs, pl, rl, 320 + CTXL, [&](int k, int& r, float& bias) {
        if (k < 320) { const int kp = t - 128 + k; if (k > 256 || kp < 0 || kp >= SEQ) return false; r = b * SEQ + kp; return true; }
        r = NLAT + b * CTXL + (k - 320); return true; },
      P1, 2304, 512 + g * 64, 640 + g * 64, p.in[L1_SINKS][hq], true, o, m, l, lane);
    ATT[(size_t)row * DM + hq * 64 + lane] = f2bf(o[0][0] / l[0]);
  }
}

DEVI void phase_ssd(const Params& p, float* lds) {
  const int tid = ftid();
  const bf16_t* U = (const bf16_t*)(p.ws + WS_U); const float* DT = (const float*)(p.ws + WS_DT); float* YS = (float*)(p.ws + WS_YS);
  constexpr int CH = 32;
  float* xb = lds;
  float* bb = lds + CH * 64;
  float* cb = bb + CH * 128;
  float* db = cb + CH * 128;
  float* yb = db + 2 * CH;
  const int pi = tid >> 3, ns = (tid & 7) * 16;
  for (int it = blockIdx.x; it < NB * 8; it += gridDim.x) {
    const int b = it >> 3, hd = it & 7, g = hd >> 2;
    for (int dir = 0; dir < 2; ++dir) {
      const float a = -expf(p.in[dir ? L1_ALOGB : L1_ALOGF][hd]); const float dtb = p.in[dir ? L1_DTBB : L1_DTBF][hd];
      float st[16];
#pragma unroll
      for (int i = 0; i < 16; ++i) st[i] = 0.f;
      for (int seg = 0; seg < 2; ++seg) {
        const int len = seg ? SEQ : CTXL, s0 = seg ? b * SEQ : NLAT + b * CTXL;
        for (int c0 = 0; c0 < len; c0 += CH) {
          __syncthreads();
          for (int i = tid; i < CH * 320; i += NT) {
            const int st_i = i / 320, c = i % 320; const int tk = dir ? (len - 1 - (c0 + st_i)) : (c0 + st_i); const size_t r = (size_t)(s0 + tk);
            if (c < 64) xb[st_i * 64 + c] = bf2f(U[r * 1024 + hd * 64 + c]);
            else if (c < 192) bb[st_i * 128 + (c - 64)] = bf2f(U[r * 1024 + 512 + g * 128 + (c - 64)]);
            else cb[st_i * 128 + (c - 192)] = bf2f(U[r * 1024 + 768 + g * 128 + (c - 192)]);
          }
          if (tid < CH) { const int tk = dir ? (len - 1 - (c0 + tid)) : (c0 + tid); const float raw = DT[(size_t)(s0 + tk) * 16 + dir * 8 + hd] + dtb;
            const float dt = raw > 20.f ? raw : log1pf(expf(raw)); db[tid] = expf(dt * a); db[CH + tid] = dt; }
          __syncthreads();
          for (int i = 0; i < CH; ++i) {
            const float dec = db[i], dx = db[CH + i] * xb[i * 64 + pi]; float y = 0.f;
#pragma unroll
            for (int q = 0; q < 16; ++q) { st[q] = st[q] * dec + dx * bb[i * 128 + ns + q]; y += st[q] * cb[i * 128 + ns + q]; }
            y += __shfl_xor(y, 1); y += __shfl_xor(y, 2); y += __shfl_xor(y, 4);
            if ((tid & 7) == 0) yb[i * 64 + pi] = y;
          }
          __syncthreads();
          if (seg == 1) for (int i = tid; i < CH * 64; i += NT) {
            const int q = i >> 6, c = i & 63; const int tk = (dir ? (len - CH - c0) : c0) + q, st_i = dir ? (CH - 1 - q) : q;
            float* yp = YS + (size_t)(b * SEQ + tk) * 512 + hd * 64 + c;
            if (dir == 0) *yp = yb[st_i * 64 + c]; else *yp = *yp + yb[st_i * 64 + c];
          }
        }
      }
      __syncthreads(); __threadfence();
    }
  }
}

DEVI void phase_ssd_out(const Params& p) {
  const int lane = ftid() & 63, gw = blockIdx.x * NWAVE + (ftid() >> 6), NGW = gridDim.x * NWAVE;
  const bf16_t* U = (const bf16_t*)(p.ws + WS_U); const bf16_t* P1 = (const bf16_t*)(p.ws + WS_P1); const float* YS = (const float*)(p.ws + WS_YS);
  bf16_t* ATT = (bf16_t*)(p.ws + WS_ATT1);
  for (int r = gw; r < NLAT; r += NGW) {
    const int c0 = lane * 8, hd = c0 >> 6; const float dsk = p.in[L1_DSKIP][hd];
    const float4 y0 = *(const float4*)(YS + (size_t)r * 512 + c0), y1 = *(const float4*)(YS + (size_t)r * 512 + c0 + 4);
    const uint4 xw = *(const uint4*)(U + (size_t)r * 1024 + c0), zw = *(const uint4*)(P1 + (size_t)r * 2304 + 1792 + c0);
    float y[8] = {y0.x, y0.y, y0.z, y0.w, y1.x, y1.y, y1.z, y1.w};
    const unsigned xs[4] = {xw.x, xw.y, xw.z, xw.w}, zs[4] = {zw.x, zw.y, zw.z, zw.w};
    float ss = 0.f;
#pragma unroll
    for (int i = 0; i < 4; ++i) {
      const float x0 = __uint_as_float(xs[i] << 16), x1 = __uint_as_float(xs[i] & 0xffff0000u), z0 = __uint_as_float(zs[i] << 16), z1 = __uint_as_float(zs[i] & 0xffff0000u);
      y[2 * i] = (y[2 * i] + dsk * x0) * silu_f(z0); y[2 * i + 1] = (y[2 * i + 1] + dsk * x1) * silu_f(z1);
      ss += y[2 * i] * y[2 * i] + y[2 * i + 1] * y[2 * i + 1];
    }
#pragma unroll
    for (int o = 1; o < 32; o <<= 1) ss += __shfl_xor(ss, o);
    const float rr = rsqrtf(ss * (1.f / 256.f) + EPS);
    const float4 g0 = *(const float4*)(p.in[L1_GNORM] + c0), g1 = *(const float4*)(p.in[L1_GNORM] + c0 + 4);
    uint4 w; w.x = pk2(y[0] * rr * g0.x, y[1] * rr * g0.y); w.y = pk2(y[2] * rr * g0.z, y[3] * rr * g0.w); w.z = pk2(y[4] * rr * g1.x, y[5] * rr * g1.y); w.w = pk2(y[6] * rr * g1.z, y[7] * rr * g1.w);
    *(uint4*)(ATT + (size_t)r * DM + 512 + c0) = w;
  }
}

}
namespace pg8 {
#define PG8_LAS __attribute__((address_space(3)))
typedef unsigned short bf16_t;
typedef short bf16x8 __attribute__((ext_vector_type(8)));
typedef float f32x4 __attribute__((ext_vector_type(4)));
typedef unsigned u32x4 __attribute__((ext_vector_type(4)));
constexpr int BM = 256, BK = 64, HALF = 128, HTB = HALF * BK * 2  , STAGE_BYTES = 8 * HTB, NXCD = 8, WGM = 8;

__host__ __device__ __forceinline__ int lds_byte(int r, int c) { const int st = (r >> 4) * 2 + (c >> 5), rr = r & 15, cc = c & 31, ob = rr * 64 + cc * 2; return st * 1024 + (ob ^ (((ob >> 9) & 1) << 5)); }
__host__ __device__ __forceinline__ void stage_rc(int b, int& R, int& C) { const int st = b / 1024, sb = b % 1024, swz = sb ^ (((sb >> 9) & 1) << 5); R = (st >> 1) * 16 + swz / 64; C = (st & 1) * 32 + (swz % 64) / 2; }
__host__ __device__ __forceinline__ int perm32(int rho) { const int n = rho >> 4, i = rho & 15; return 8 * (i >> 2) + 4 * n + (i & 3); }

struct Unit { int pm, pn; };
struct Gemm { const bf16_t* A; const bf16_t* Bt; int M, N, K; const int* gidx = nullptr; int sw = 0x7f7f7f7f, sa = 0x7f7f7f7f; };

struct StaticOrder {
    int nM, nN, nwg, G, c;
    __host__ __device__ void init(int M, int N, int G_, int c_) { nM = M / BM; nN = N / BM; nwg = nM * nN; G = G_; c = c_; }
    __host__ __device__ bool next(int i, Unit& u) const {
        const long L = (long)i * G + c; if (L >= nwg) return false;
        int wgid = (int)L; { const int q = nwg / NXCD, r = nwg % NXCD, xcd = wgid % NXCD, off = wgid / NXCD; wgid = (xcd < r ? xcd * (q + 1) : r * (q + 1) + (xcd - r) * q) + off; }
        const int nig = WGM * nN, gid = wgid / nig, fm = gid * WGM, gsz = (nM - fm) < WGM ? (nM - fm) : WGM;
        u.pm = fm + ((wgid % nig) % gsz); u.pn = (wgid % nig) / gsz; return true;
    }
    __device__ __forceinline__ void a_ready(const Unit&) const {}
    __device__ __forceinline__ void done(const Unit&) const {}
};

template <class Epi, class Sched, bool ALIGN_EPI = false, bool SP2 = false, bool FP8 = false>
__device__ __forceinline__ void gemm_phase(PG8_LAS unsigned char* lds, const Gemm g, const Sched& S, const Epi& E) {
    const int tid = ftid(), wid = __builtin_amdgcn_readfirstlane(tid >> 6), lane = tid & 63, wr = wid >> 2, wc = wid & 3, fr = lane & 15, fq = lane >> 4;
    const int KB = g.K * (FP8 ? 1 : 2), nt = KB / (BK * 2);
    unsigned voffB[2]; int pR[2], pC[2];
#pragma unroll
    for (int i = 0; i < 2; ++i) { int R, C; stage_rc(tid * 16 + i * 8192, R, C); const int Rb = Epi::PERM ? ((R & ~31) + perm32(R & 31)) : R;
        pR[i] = R; pC[i] = C; voffB[i] = (unsigned)(Rb * KB + C * 2); }
    unsigned cvo[2][2], nvo[2][2];
#define PG8_SETVO(vo, pm_) do { _Pragma("unroll") for (int _h = 0; _h < 2; ++_h) _Pragma("unroll") for (int _i = 0; _i < 2; ++_i) { const int _r = (pm_) * BM + _h * HALF + pR[_i]; \
        const int _g = g.gidx ? g.gidx[_r] : _r; vo[_h][_i] = (unsigned)_g * (unsigned)KB + (unsigned)(pC[_i] * 2); } } while (0)
#define PG8_STAGEA(bufoff, koff, vo) do { _Pragma("unroll") for (int _i = 0; _i < 2; ++_i) \
        __builtin_amdgcn_global_load_lds((const unsigned*)((const char*)g.A + (koff) + (vo)[_i]), (PG8_LAS unsigned*)(lds + (bufoff) + ldsw + _i * 8192), 16, 0, 0); } while (0)
    const size_t kstep = (size_t)(BK * 2);
    const size_t hstep = (size_t)HALF * KB;
    const size_t tstep = 2 * hstep;
    const unsigned ldsw = (unsigned)wid * 1024u;
    const int aoff = lds_byte(wr * 64 + fr, fq * 8), boff = lds_byte(wc * 32 + fr, fq * 8);
#define PG8_SA(b, h) (((b) * 2 + (h)) * HTB)
#define PG8_SB(b, h) ((4 + (b) * 2 + (h)) * HTB)
#define PG8_STAGE(bufoff, gbase, voff) do { _Pragma("unroll") for (int _i = 0; _i < 2; ++_i) \
        __builtin_amdgcn_global_load_lds((const unsigned*)((const char*)(gbase) + (voff)[_i]), (PG8_LAS unsigned*)(lds + (bufoff) + ldsw + _i * 8192), 16, 0, 0); } while (0)
    typedef int v4i_t __attribute__((ext_vector_type(4))); typedef int v8i_t __attribute__((ext_vector_type(8)));
#define PG8_CAT8(x, y) __builtin_shufflevector(__builtin_bit_cast(v4i_t, x), __builtin_bit_cast(v4i_t, y), 0, 1, 2, 3, 4, 5, 6, 7)
#define PG8_LDA(dst, b, h) do { _Pragma("unroll") for (int m = 0; m < 4; ++m) { const bf16x8 f0_ = *(const PG8_LAS bf16x8*)(lds + PG8_SA(b, h) + aoff + m * 2048), f1_ = *(const PG8_LAS bf16x8*)(lds + PG8_SA(b, h) + aoff + m * 2048 + 1024); \
        if constexpr (FP8) dst##8[m] = PG8_CAT8(f0_, f1_); else { dst[m][0] = f0_; dst[m][1] = f1_; } } } while (0)
#define PG8_LDB(dst, b, h) do { _Pragma("unroll") for (int n = 0; n < 2; ++n) { const bf16x8 f0_ = *(const PG8_LAS bf16x8*)(lds + PG8_SB(b, h) + boff + n * 2048), f1_ = *(const PG8_LAS bf16x8*)(lds + PG8_SB(b, h) + boff + n * 2048 + 1024); \
        if constexpr (FP8) dst##8[n] = PG8_CAT8(f0_, f1_); else { dst[n][0] = f0_; dst[n][1] = f1_; } } } while (0)
typedef int v4i_t __attribute__((ext_vector_type(4))); typedef int v8i_t __attribute__((ext_vector_type(8)));
#define PG8_CAT8(x, y) __builtin_shufflevector(__builtin_bit_cast(v4i_t, x), __builtin_bit_cast(v4i_t, y), 0, 1, 2, 3, 4, 5, 6, 7)
#define PG8_MMA(ai, bj, At, Bt) do { __builtin_amdgcn_s_setprio(1); _Pragma("unroll") for (int m = 0; m < 4; ++m) _Pragma("unroll") for (int n = 0; n < 2; ++n) { \
        if constexpr (FP8) asm volatile("v_mfma_scale_f32_16x16x128_f8f6f4 %0, %1, %2, %0, %3, %4 op_sel_hi:[0,0,0]" : "+v"(acc[ai][bj][m][n]) : "v"(Bt##8[n]), "v"(At##8[m]), "v"(sw_), "v"(sa_)); \
        else { _Pragma("unroll") for (int k = 0; k < 2; ++k) acc[ai][bj][m][n] = __builtin_amdgcn_mfma_f32_16x16x32_bf16(Bt[n][k], At[m][k], acc[ai][bj][m][n], 0, 0, 0); } } \
        __builtin_amdgcn_s_setprio(0); } while (0)
#define PG8_WAIT_V(n) asm volatile("s_waitcnt vmcnt(" #n ")" ::: "memory")
#define PG8_WAIT_L(n) asm volatile("s_waitcnt lgkmcnt(" #n ")" ::: "memory")
#define PG8_BAR __builtin_amdgcn_s_barrier()
#define PG8_SCHED __builtin_amdgcn_sched_barrier(0)
    Unit cur, nxt; int ui = 0;
    if (!S.next(0, cur)) return;
    f32x4 acc[2][2][4][2];
#pragma unroll
    for (int a = 0; a < 2; ++a)
#pragma unroll
        for (int b = 0; b < 2; ++b)
#pragma unroll
            for (int m = 0; m < 4; ++m)
#pragma unroll
                for (int n = 0; n < 2; ++n) acc[a][b][m][n] = (f32x4){0.f, 0.f, 0.f, 0.f};
    const int sw_ = g.sw, sa_ = g.sa;
    bf16x8 At[4][2], B0[2][2], B1[2][2]; v8i_t At8[4], B08[2], B18[2];
    PG8_SETVO(cvo, cur.pm); const char* cB = (const char*)g.Bt + (size_t)cur.pn * tstep;
    S.a_ready(cur);
    if constexpr (SP2) {
        PG8_STAGE(PG8_SB(0, 0), cB, voffB); PG8_STAGE(PG8_SB(0, 1), cB + hstep, voffB); PG8_STAGEA(PG8_SA(0, 0), 0, cvo[0]); PG8_STAGEA(PG8_SA(0, 1), 0, cvo[1]);
        if (wr == 1) PG8_BAR;
        PG8_WAIT_V(2); PG8_BAR;
        PG8_STAGE(PG8_SB(1, 0), cB + kstep, voffB); PG8_STAGEA(PG8_SA(1, 0), kstep, cvo[0]); PG8_STAGE(PG8_SB(1, 1), cB + hstep + kstep, voffB);
        PG8_WAIT_V(6); PG8_BAR;
    } else {
        PG8_STAGE(PG8_SB(0, 0), cB, voffB); PG8_STAGEA(PG8_SA(0, 0), 0, cvo[0]); PG8_STAGE(PG8_SB(0, 1), cB + hstep, voffB); PG8_STAGEA(PG8_SA(0, 1), 0, cvo[1]);
        if (wr == 1) PG8_BAR;
        PG8_WAIT_V(4); PG8_BAR;
        PG8_STAGE(PG8_SB(1, 0), cB + kstep, voffB); PG8_STAGEA(PG8_SA(1, 0), kstep, cvo[0]); PG8_STAGE(PG8_SB(1, 1), cB + hstep + kstep, voffB);
        PG8_WAIT_V(6); PG8_BAR;
    }
    for (;;) {
        const bool has_next = S.next(ui + 1, nxt);
        if (has_next) PG8_SETVO(nvo, nxt.pm); else { nvo[0][0] = cvo[0][0]; nvo[0][1] = cvo[0][1]; nvo[1][0] = cvo[1][0]; nvo[1][1] = cvo[1][1]; }
        const char* nB = has_next ? (const char*)g.Bt + (size_t)nxt.pn * tstep : cB;
#pragma unroll 1
        for (int t = 0; t < nt; t += 2) {
            const bool last = (t == nt - 2);
            const size_t k1 = (size_t)(t + 1) * kstep;
            const size_t k2 = last ? 0 : (size_t)(t + 2) * kstep; unsigned v2[2][2];
            v2[0][0] = last ? nvo[0][0] : cvo[0][0]; v2[0][1] = last ? nvo[0][1] : cvo[0][1]; v2[1][0] = last ? nvo[1][0] : cvo[1][0]; v2[1][1] = last ? nvo[1][1] : cvo[1][1];
            const char* b2 = last ? nB : cB + (size_t)(t + 2) * kstep;
            const size_t k3 = k2 + kstep; const char* b3 = b2 + kstep;
            if (last && has_next) S.a_ready(nxt);
            if constexpr (SP2) {
            PG8_LDB(B0, 0, 0); PG8_LDB(B1, 0, 1); PG8_SCHED; PG8_LDA(At, 0, 0); PG8_STAGEA(PG8_SA(1, 1), k1, cvo[1]);
            PG8_WAIT_V(8); PG8_WAIT_L(0); PG8_BAR; PG8_MMA(0, 0, At, B0); PG8_MMA(0, 1, At, B1); PG8_BAR; PG8_SCHED;
            PG8_LDA(At, 0, 1); PG8_STAGE(PG8_SB(0, 0), b2, voffB); PG8_STAGE(PG8_SB(0, 1), b2 + hstep, voffB); PG8_STAGEA(PG8_SA(0, 0), k2, v2[0]);
            PG8_WAIT_V(8); PG8_WAIT_L(0); PG8_BAR; PG8_MMA(1, 0, At, B0); PG8_MMA(1, 1, At, B1); PG8_BAR; PG8_SCHED;
            PG8_LDB(B0, 1, 0); PG8_LDB(B1, 1, 1); PG8_SCHED; PG8_LDA(At, 1, 0); PG8_STAGEA(PG8_SA(0, 1), k2, v2[1]);
            PG8_WAIT_V(8); PG8_WAIT_L(0); PG8_BAR; PG8_MMA(0, 0, At, B0); PG8_MMA(0, 1, At, B1); PG8_BAR; PG8_SCHED;
            PG8_LDA(At, 1, 1); PG8_STAGE(PG8_SB(1, 0), b3, voffB); PG8_STAGE(PG8_SB(1, 1), b3 + hstep, voffB); PG8_STAGEA(PG8_SA(1, 0), k3, v2[0]);
            PG8_WAIT_V(8); PG8_WAIT_L(0); PG8_BAR; PG8_MMA(1, 0, At, B0); PG8_MMA(1, 1, At, B1); PG8_BAR; PG8_SCHED;
            } else {
            PG8_LDB(B0, 0, 0); PG8_SCHED; PG8_LDA(At, 0, 0); PG8_STAGEA(PG8_SA(1, 1), k1, cvo[1]);
            PG8_WAIT_L(8); PG8_BAR; PG8_WAIT_L(0); PG8_MMA(0, 0, At, B0); PG8_BAR; PG8_SCHED;
            PG8_LDB(B1, 0, 1); PG8_STAGE(PG8_SB(0, 0), b2, voffB);
            PG8_BAR; PG8_WAIT_L(0); PG8_MMA(0, 1, At, B1); PG8_BAR;
            PG8_LDA(At, 0, 1); PG8_STAGEA(PG8_SA(0, 0), k2, v2[0]);
            PG8_BAR; PG8_WAIT_L(0); PG8_MMA(1, 0, At, B0); PG8_BAR; PG8_SCHED;
            PG8_STAGE(PG8_SB(0, 1), b2 + hstep, voffB);
            PG8_WAIT_V(6); PG8_BAR; PG8_MMA(1, 1, At, B1); PG8_BAR;
            PG8_LDB(B0, 1, 0); PG8_SCHED; PG8_LDA(At, 1, 0); PG8_STAGEA(PG8_SA(0, 1), k2, v2[1]);
            PG8_WAIT_L(8); PG8_BAR; PG8_WAIT_L(0); PG8_MMA(0, 0, At, B0); PG8_BAR; PG8_SCHED;
            PG8_LDB(B1, 1, 1); PG8_STAGE(PG8_SB(1, 0), b3, voffB);
            PG8_BAR; PG8_WAIT_L(0); PG8_MMA(0, 1, At, B1); PG8_BAR;
            PG8_LDA(At, 1, 1); PG8_STAGEA(PG8_SA(1, 0), k3, v2[0]);
            PG8_BAR; PG8_WAIT_L(0); PG8_MMA(1, 0, At, B0); PG8_BAR; PG8_SCHED;
            PG8_STAGE(PG8_SB(1, 1), b3 + hstep, voffB);
            PG8_WAIT_V(6); PG8_BAR; PG8_MMA(1, 1, At, B1); PG8_BAR;
            }
        }
        if constexpr (ALIGN_EPI) { if (wr == 0) PG8_BAR; }
        if constexpr (FP8) asm volatile("s_nop 15\n\ts_nop 15" ::: "memory");
        if constexpr (!Epi::AFTER_DRAIN) { E(acc, cur, wr, wc, fr, fq); S.done(cur); }
        if (!has_next) break;
#pragma unroll
        for (int a = 0; a < 2; ++a)
#pragma unroll
            for (int b = 0; b < 2; ++b)
#pragma unroll
                for (int m = 0; m < 4; ++m)
#pragma unroll
                    for (int n = 0; n < 2; ++n) acc[a][b][m][n] = (f32x4){0.f, 0.f, 0.f, 0.f};
        cur = nxt; cvo[0][0] = nvo[0][0]; cvo[0][1] = nvo[0][1]; cvo[1][0] = nvo[1][0]; cvo[1][1] = nvo[1][1]; cB = nB; ++ui;
        if constexpr (ALIGN_EPI) { if (wr == 1) PG8_BAR; }
    }
    PG8_WAIT_V(0);
    if constexpr (!ALIGN_EPI) { if (wr == 0) PG8_BAR; }
    PG8_BAR;
    if constexpr (Epi::AFTER_DRAIN) { E.fused(acc, cur, wr, wc, fr, fq, lds, wid, lane); S.done(cur); }
#undef PG8_SA
#undef PG8_SB
#undef PG8_STAGE
#undef PG8_STAGEA
#undef PG8_SETVO
#undef PG8_LDA
#undef PG8_LDB
#undef PG8_MMA
#undef PG8_CAT8
#undef PG8_WAIT_V
#undef PG8_WAIT_L
#undef PG8_BAR
#undef PG8_SCHED
}
}
#ifndef FP8_SP2
#define FP8_SP2 true
#endif
namespace fg {
using pg8::f32x4; using pg8::Unit;
typedef unsigned u32x4 __attribute__((ext_vector_type(4)));
typedef unsigned u32x2 __attribute__((ext_vector_type(2)));
DEVI unsigned cvtpk(float lo, float hi) { typedef float f2_t __attribute__((ext_vector_type(2))); typedef __bf16 b2_t __attribute__((ext_vector_type(2))); const f2_t v = {lo, hi}; const b2_t b = __builtin_convertvector(v, b2_t); return __builtin_bit_cast(unsigned, b); }
template <class TP> DEVI void rope8(TP ROPE, int t, int d0, f32x4& v0, f32x4& v1) {
  const int i0 = d0 >> 1, f0 = i0 & 15, pos = (i0 < 16) ? (t >> 6) : (t & 63);
  const f32x4 r0 = *(const PG8_LAS f32x4*)(ROPE + (pos * 16 + f0) * 2), r1 = *(const PG8_LAS f32x4*)(ROPE + (pos * 16 + f0) * 2 + 4);
  const f32x4 a = v0, b = v1;
  v0[0] = a[0] * r0[0] - a[1] * r0[1]; v0[1] = a[0] * r0[1] + a[1] * r0[0]; v0[2] = a[2] * r0[2] - a[3] * r0[3]; v0[3] = a[2] * r0[3] + a[3] * r0[2];
  v1[0] = b[0] * r1[0] - b[1] * r1[1]; v1[1] = b[0] * r1[1] + b[1] * r1[0]; v1[2] = b[2] * r1[2] - b[3] * r1[3]; v1[3] = b[2] * r1[3] + b[3] * r1[2];
}
#define EPI_LOOP_BEGIN const int row0 = u.pm * 256 + wr * 64 + fr; \
  _Pragma("unroll") for (int ai = 0; ai < 2; ++ai) _Pragma("unroll") for (int m = 0; m < 4; ++m) { const int row = row0 + ai * 128 + m * 16; \
  _Pragma("unroll") for (int bj = 0; bj < 2; ++bj) { f32x4 v0 = acc[ai][bj][m][0], v1 = acc[ai][bj][m][1]; const int cl = bj * 128 + wc * 32 + 8 * fq;
#define EPI_LOOP_END } }

struct EpiQKV0 { static constexpr bool PERM = true, AFTER_DRAIN = false; bf16_t* O; const PG8_LAS float* ROPE;
  DEVI void operator()(const f32x4 (&acc)[2][2][4][2], const Unit& u, int wr, int wc, int fr, int fq) const {
    const int colt = u.pn * 256; const bool rope = (u.pm < NLAT / 256) && (colt < 1024);
    EPI_LOOP_BEGIN
      const int col = colt + cl;
      if (rope) rope8(ROPE, row & 4095, col & 63, v0, v1);
      u32x4 w; w.x = cvtpk(v0[0], v0[1]); w.y = cvtpk(v0[2], v0[3]); w.z = cvtpk(v1[0], v1[1]); w.w = cvtpk(v1[2], v1[3]);
      *(u32x4*)(O + (size_t)row * N_IN0 + col) = w;
    EPI_LOOP_END
  } };
struct EpiQKV1 { static constexpr bool PERM = true, AFTER_DRAIN = false; bf16_t* O; float* DT; const PG8_LAS float* ROPE;
  DEVI void operator()(const f32x4 (&acc)[2][2][4][2], const Unit& u, int wr, int wc, int fr, int fq) const {
    const int colt = u.pn * 256; const bool lat = (u.pm < NLAT / 256);
    EPI_LOOP_BEGIN
      const int col = colt + cl;
      if (col >= 2304) { if (col < 2320) { *(f32x4*)(DT + (size_t)row * 16 + (col - 2304)) = v0; *(f32x4*)(DT + (size_t)row * 16 + (col - 2304) + 4) = v1; } }
      else {
        if (lat && col < 640) rope8(ROPE, row & 4095, col & 63, v0, v1);
        u32x4 w; w.x = cvtpk(v0[0], v0[1]); w.y = cvtpk(v0[2], v0[3]); w.z = cvtpk(v1[0], v1[1]); w.w = cvtpk(v1[2], v1[3]);
        *(u32x4*)(O + (size_t)row * 2304 + col) = w;
      }
    EPI_LOOP_END
  } };
struct EpiPlain { static constexpr bool PERM = true, AFTER_DRAIN = false; bf16_t* O;
  DEVI void operator()(const f32x4 (&acc)[2][2][4][2], const Unit& u, int wr, int wc, int fr, int fq) const {
    const int colt = u.pn * 256;
    EPI_LOOP_BEGIN
      u32x4 w; w.x = cvtpk(v0[0], v0[1]); w.y = cvtpk(v0[2], v0[3]); w.z = cvtpk(v1[0], v1[1]); w.w = cvtpk(v1[2], v1[3]);
      *(u32x4*)(O + (size_t)row * DM + colt + cl) = w;
    EPI_LOOP_END
  } };
DEVI float silu_fast(float v) { return v * __builtin_amdgcn_rcpf(1.f + __expf(-v)); }
struct EpiSwiGLU { static constexpr bool PERM = true, AFTER_DRAIN = false; bf16_t* O;
  DEVI void operator()(const f32x4 (&acc)[2][2][4][2], const Unit& u, int wr, int wc, int fr, int fq) const {
    const int colt = (u.pn & 7) * 256;
    EPI_LOOP_BEGIN
      u32x2 w; w.x = cvtpk(silu_fast(v0[0]) * v0[1], silu_fast(v0[2]) * v0[3]); w.y = cvtpk(silu_fast(v1[0]) * v1[1], silu_fast(v1[2]) * v1[3]);
      *(u32x2*)(O + (size_t)row * DM + ((colt + cl) >> 1)) = w;
    EPI_LOOP_END
  } };
struct EpiSwiGLU8 { static constexpr bool PERM = true, AFTER_DRAIN = false; unsigned char* O;
  DEVI void operator()(const f32x4 (&acc)[2][2][4][2], const Unit& u, int wr, int wc, int fr, int fq) const {
    const int colt = (u.pn & 7) * 256;
    EPI_LOOP_BEGIN
      const unsigned w = nv::pack4_fp8(silu_fast(v0[0]) * v0[1] * nv::A8_SCALE, silu_fast(v0[2]) * v0[3] * nv::A8_SCALE, silu_fast(v1[0]) * v1[1] * nv::A8_SCALE, silu_fast(v1[2]) * v1[3] * nv::A8_SCALE);
      *(unsigned*)(O + (size_t)row * DM + ((colt + cl) >> 1)) = w;
    EPI_LOOP_END
  } };
struct EpiDown { static constexpr bool PERM = true, AFTER_DRAIN = false; bf16_t* O;
  DEVI void operator()(const f32x4 (&acc)[2][2][4][2], const Unit& u, int wr, int wc, int fr, int fq) const {
    const int colt = (u.pn & 3) * 256;
    EPI_LOOP_BEGIN
      u32x4 w; w.x = cvtpk(v0[0], v0[1]); w.y = cvtpk(v0[2], v0[3]); w.z = cvtpk(v1[0], v1[1]); w.w = cvtpk(v1[2], v1[3]);
      *(u32x4*)(O + (size_t)row * DM + colt + cl) = w;
    EPI_LOOP_END
  } };
struct ExpOrder : pg8::StaticOrder { int nMe, nNe;
  __device__ void init2(int erows, int Ne, int G_, int c_) { nMe = erows / 256; nNe = Ne / 256; init(NE * erows, Ne, G_, c_); }
  __device__ bool next(int i, Unit& u) const { if (!pg8::StaticOrder::next(i, u)) return false; u.pn += (u.pm / nMe) * nNe; return true; } };

typedef PG8_LAS unsigned char* ldsp_t;
DEVI void phase_qkv0(const Params& p, ldsp_t lds) {
  pg8::Gemm g{(const bf16_t*)(p.ws + WS_H), (const bf16_t*)(p.ws + WS_WIN0), NROW, N_IN0, DM, nullptr, nv::W8_E8M0, nv::A8_E8M0}; pg8::StaticOrder S; S.init(NROW, N_IN0, gridDim.x, blockIdx.x);
  PG8_LAS float* RL = (PG8_LAS float*)(lds + pg8::STAGE_BYTES);
  for (int i = ftid(); i < 64 * 16 * 2; i += NT) RL[i] = ((const float*)(p.ws + WS_CTL + CTL_ROPE))[i];
  __syncthreads();
  EpiQKV0 E{(bf16_t*)(p.ws + WS_QKV0), RL};
  pg8::gemm_phase<EpiQKV0, pg8::StaticOrder, true, true, (QKV0_FP8 != 0)>(lds, g, S, E);
}
DEVI void phase_qkv1(const Params& p, ldsp_t lds) {
  pg8::Gemm g{(const bf16_t*)(p.ws + WS_H), (const bf16_t*)(p.ws + WS_WIN1), NROW, N_IN1P, DM, nullptr, nv::W8_E8M0, nv::A8_E8M0}; pg8::StaticOrder S; S.init(NROW, N_IN1P, gridDim.x, blockIdx.x);
  PG8_LAS float* RL = (PG8_LAS float*)(lds + pg8::STAGE_BYTES);
  for (int i = ftid(); i < 64 * 16 * 2; i += NT) RL[i] = ((const float*)(p.ws + WS_CTL + CTL_ROPE))[i];
  __syncthreads();
  EpiQKV1 E{(bf16_t*)(p.ws + WS_P1), (float*)(p.ws + WS_DT), RL};
  pg8::gemm_phase<EpiQKV1, pg8::StaticOrder, true, true, (QKV1_FP8 != 0)>(lds, g, S, E);
}
DEVI void phase_outproj(const Params& p, ldsp_t lds, int layer) {
  const int M = layer ? NLAT : NROW;
  pg8::Gemm g{(const bf16_t*)(p.ws + (layer ? WS_ATT1 : WS_ATT0)), (const bf16_t*)(p.ws + (layer ? WS_WOUT1 : WS_WOUT0)), M, DM, DM}; pg8::StaticOrder S; S.init(M, DM, gridDim.x, blockIdx.x);
  EpiPlain E{(bf16_t*)(p.ws + (layer ? WS_MIX1 : WS_MIX0))};
  pg8::gemm_phase<EpiPlain, pg8::StaticOrder, true, true>(lds, g, S, E);
}
DEVI void phase_moe_up(const Params& p, ldsp_t lds, int layer) {
  const int erows = layer ? EROWS1 : EROWS0;
  pg8::Gemm g{(const bf16_t*)(p.ws + WS_H), (const bf16_t*)(p.ws + WS_WGU), NE * erows, 2048, DM, (const int*)(p.ws + WS_IDX)}; ExpOrder S; S.init2(erows, 2048, gridDim.x, blockIdx.x);
  EpiSwiGLU E{(bf16_t*)(p.ws + WS_HID)};
  pg8::gemm_phase<EpiSwiGLU, ExpOrder, true, true>(lds, g, S, E);
}
DEVI void phase_moe_down(const Params& p, ldsp_t lds, int layer) {
  const int erows = layer ? EROWS1 : EROWS0;
  pg8::Gemm g{(const bf16_t*)(p.ws + WS_HID), (const bf16_t*)(p.ws + WS_WD), NE * erows, DM, DM}; ExpOrder S; S.init2(erows, DM, gridDim.x, blockIdx.x);
  EpiDown E{(bf16_t*)(p.ws + WS_Y)};
  pg8::gemm_phase<EpiDown, ExpOrder, true, true>(lds, g, S, E);
}
DEVI void phase_moe_up8(const Params& p, ldsp_t lds, int layer) {
  const int erows = layer ? EROWS1 : EROWS0;
  pg8::Gemm g{(const bf16_t*)(p.ws + WS_H), (const bf16_t*)(p.ws + WS_WGU), NE * erows, 2048, DM, (const int*)(p.ws + WS_IDX), nv::W8_E8M0, nv::A8_E8M0}; ExpOrder S; S.init2(erows, 2048, gridDim.x, blockIdx.x);
  EpiSwiGLU8 E{(unsigned char*)(p.ws + WS_HID)};
  pg8::gemm_phase<EpiSwiGLU8, ExpOrder, true, FP8_SP2, true>(lds, g, S, E);
}
DEVI void phase_moe_down8(const Params& p, ldsp_t lds, int layer) {
  const int erows = layer ? EROWS1 : EROWS0;
  pg8::Gemm g{(const bf16_t*)(p.ws + WS_HID), (const bf16_t*)(p.ws + WS_WD), NE * erows, DM, DM, nullptr, nv::W8_E8M0, nv::A8_E8M0}; ExpOrder S; S.init2(erows, DM, gridDim.x, blockIdx.x);
  EpiDown E{(bf16_t*)(p.ws + WS_Y)};
  pg8::gemm_phase<EpiDown, ExpOrder, true, FP8_SP2, true>(lds, g, S, E);
}
DEVI void phase_gather(const Params& p, int layer) {
  const int lane = ftid() & 63, gw = blockIdx.x * NWAVE + (ftid() >> 6), NGW = gridDim.x * NWAVE;
  const int erows = layer ? EROWS1 : EROWS0; const int* IDX = (const int*)(p.ws + WS_IDX);
  const bf16_t* H = (const bf16_t*)(p.ws + WS_H); bf16_t* XG = (bf16_t*)(p.ws + WS_XG);
  for (int r = gw; r < NE * erows; r += NGW) {
    const uint4* s = (const uint4*)(H + (size_t)IDX[r] * DM) + lane; uint4* d = (uint4*)(XG + (size_t)r * DM) + lane;
    const uint4 a = s[0], b = s[64]; d[0] = a; d[64] = b;
  }
}
}
namespace fa {
#define FA_LAS __attribute__((address_space(3)))
typedef short bf16x8 __attribute__((ext_vector_type(8)));
typedef short s16x4 __attribute__((ext_vector_type(4)));
typedef float f32x16 __attribute__((ext_vector_type(16)));
typedef FA_LAS unsigned char* ldsp_t;
typedef unsigned u32x4 __attribute__((ext_vector_type(4)));
constexpr float LOG2E = 1.4426950408889634f, C2 = 0.125f * LOG2E;
DEVI int crow(int r, int hi) { return (r & 3) + 8 * (r >> 2) + 4 * hi; }
DEVI unsigned cvtpk(float lo, float hi) { typedef float f2_t __attribute__((ext_vector_type(2))); typedef __bf16 b2_t __attribute__((ext_vector_type(2))); const f2_t v = {lo, hi}; const b2_t b = __builtin_convertvector(v, b2_t); return __builtin_bit_cast(unsigned, b); }
DEVI s16x4 vtr(ldsp_t p) { return __builtin_bit_cast(s16x4, __builtin_amdgcn_ds_read_tr16_b64_v4i16((FA_LAS s16x4*)p)); }

DEVI float max3f(float a, float b, float c) { float r; asm("v_max3_f32 %0, %1, %2, %3" : "=v"(r) : "v"(a), "v"(b), "v"(c)); return r; }
template <int KW, int DVB> struct Geo {
  static constexpr int VW = DVB * 32;
  static constexpr int KSTR = KW * 2 + 16, VSTR = VW * 2 + 64;
  static constexpr int KBYTES = 64 * KSTR, VBYTES = 64 * VSTR, STAGE = KBYTES + VBYTES;
  static constexpr int CPR = (KW + VW) / 8, NCH = 64 * CPR / NT;
};

DEVI bf16x8 load_q8(const bf16_t* p, float sc) {
  const uint4 w = *(const uint4*)p; const unsigned u[4] = {w.x, w.y, w.z, w.w}; unsigned o[4];
#pragma unroll
  for (int i = 0; i < 4; ++i) o[i] = cvtpk(__uint_as_float(u[i] << 16) * sc, __uint_as_float(u[i] & 0xffff0000u) * sc);
  uint4 r = make_uint4(o[0], o[1], o[2], o[3]); return __builtin_bit_cast(bf16x8, r);
}

template <int KW, int DVB, class Src, class Act, class Msk>
DEVI void flash_pass(ldsp_t lds, int ntiles, const bf16_t* kv, int ld, int kcol, int vcol, const bf16x8 (&q)[4], int kofs,
                     Src src, Act act, Msk msk, f32x16 (&o)[DVB], float& m, float& l) {
  typedef Geo<KW, DVB> G;
  const int tid = ftid(), lane = tid & 63, r32 = lane & 31, hi = lane >> 5;
  u32x4 stg[G::NCH];
  int crw[G::NCH], ccol[G::NCH], cdst[G::NCH];
#pragma unroll
  for (int i = 0; i < G::NCH; ++i) { const int c = tid + NT * i, row = c / G::CPR, cc = c % G::CPR; crw[i] = row;
    if (cc < KW / 8) { ccol[i] = kcol + cc * 8; cdst[i] = row * G::KSTR + cc * 16; } else { ccol[i] = vcol + (cc - KW / 8) * 8; cdst[i] = G::KBYTES + row * G::VSTR + (cc - KW / 8) * 16; } }
#pragma unroll
  for (int i = 0; i < G::NCH; ++i) stg[i] = *(const u32x4*)(kv + (size_t)src(0, crw[i]) * ld + ccol[i]);
#pragma unroll
  for (int i = 0; i < G::NCH; ++i) *(FA_LAS u32x4*)(lds + cdst[i]) = stg[i];
  __syncthreads();
  const int kroff = r32 * G::KSTR + (kofs + 8 * hi) * 2;
  const int vroff = G::KBYTES + (4 * hi + ((lane & 15) >> 2)) * G::VSTR + 32 * ((lane >> 4) & 1) + 8 * (lane & 3);
  for (int kt = 0; kt < ntiles; ++kt) {
    const int buf = (kt & 1) * G::STAGE;
    const bool more = kt + 1 < ntiles;
    if (more) {
#pragma unroll
      for (int i = 0; i < G::NCH; ++i) stg[i] = *(const u32x4*)(kv + (size_t)src(kt + 1, crw[i]) * ld + ccol[i]);
    }
    if (act(kt)) {
      const ldsp_t kb = lds + buf + kroff;
      f32x16 p0, p1;
#pragma unroll
      for (int r = 0; r < 16; ++r) { p0[r] = 0.f; p1[r] = 0.f; }
#pragma unroll
      for (int d0 = 0; d0 < 4; ++d0) {
        const bf16x8 a0 = *(const FA_LAS bf16x8*)(kb + d0 * 32), a1 = *(const FA_LAS bf16x8*)(kb + 32 * G::KSTR + d0 * 32);
        p0 = __builtin_amdgcn_mfma_f32_32x32x16_bf16(a0, q[d0], p0, 0, 0, 0);
        p1 = __builtin_amdgcn_mfma_f32_32x32x16_bf16(a1, q[d0], p1, 0, 0, 0);
      }
      msk(kt, p0, p1);
      float mx = fmaxf(p0[0], p1[0]);
#pragma unroll
      for (int r = 1; r < 16; ++r) mx = fmaxf(mx, fmaxf(p0[r], p1[r]));
      mx = fmaxf(mx, __shfl_xor(mx, 32));
      if (__any(mx > m)) {
        const float mn = fmaxf(m, mx), alpha = __builtin_amdgcn_exp2f(m - mn);
        l *= alpha; m = mn;
#pragma unroll
        for (int b = 0; b < DVB; ++b)
#pragma unroll
          for (int r = 0; r < 16; ++r) o[b][r] *= alpha;
      }
      float ls = 0.f;
#pragma unroll
      for (int r = 0; r < 16; ++r) { p0[r] = __builtin_amdgcn_exp2f(p0[r] - m); p1[r] = __builtin_amdgcn_exp2f(p1[r] - m); ls += p0[r] + p1[r]; }
      l += ls;
      bf16x8 pa[4];
      { uint4 t;
        t = make_uint4(cvtpk(p0[0], p0[1]), cvtpk(p0[2], p0[3]), cvtpk(p0[4], p0[5]), cvtpk(p0[6], p0[7])); pa[0] = __builtin_bit_cast(bf16x8, t);
        t = make_uint4(cvtpk(p0[8], p0[9]), cvtpk(p0[10], p0[11]), cvtpk(p0[12], p0[13]), cvtpk(p0[14], p0[15])); pa[1] = __builtin_bit_cast(bf16x8, t);
        t = make_uint4(cvtpk(p1[0], p1[1]), cvtpk(p1[2], p1[3]), cvtpk(p1[4], p1[5]), cvtpk(p1[6], p1[7])); pa[2] = __builtin_bit_cast(bf16x8, t);
        t = make_uint4(cvtpk(p1[8], p1[9]), cvtpk(p1[10], p1[11]), cvtpk(p1[12], p1[13]), cvtpk(p1[14], p1[15])); pa[3] = __builtin_bit_cast(bf16x8, t); }
      const ldsp_t vb = lds + buf + vroff;
#pragma unroll
      for (int b = 0; b < DVB; ++b)
#pragma unroll
        for (int ks = 0; ks < 4; ++ks) {
          const s16x4 lo = vtr(vb + (16 * ks) * G::VSTR + b * 64), h8 = vtr(vb + (16 * ks + 8) * G::VSTR + b * 64);
          const bf16x8 vf = {lo[0], lo[1], lo[2], lo[3], h8[0], h8[1], h8[2], h8[3]};
          o[b] = __builtin_amdgcn_mfma_f32_32x32x16_bf16(vf, pa[ks], o[b], 0, 0, 0);
        }
    }
    if (more) {
      const int nb = ((kt + 1) & 1) * G::STAGE;
#pragma unroll
      for (int i = 0; i < G::NCH; ++i) *(FA_LAS u32x4*)(lds + nb + cdst[i]) = stg[i];
    }
    __syncthreads();
  }
}


template <int V> struct IC { static constexpr int value = V; };
template <int KW, int DVB, int ABL, int PF, class Src, class Msk>
DEVI void flash_pass2(ldsp_t lds, int ntiles, const bf16_t* kv, int ld, int kcol, int vcol, const bf16x8 (&q)[4], int kofs,
                      Src src, Msk msk, f32x16 (&o)[DVB], float& m, float& l) {
  typedef Geo<KW, DVB> G;
  const int tid = ftid(), lane = tid & 63, r32 = lane & 31, hi = lane >> 5;
  u32x4 stg[PF][G::NCH];
  int crw[G::NCH], ccol[G::NCH], cdst[G::NCH];
#pragma unroll
  for (int i = 0; i < G::NCH; ++i) { const int c = tid + NT * i, row = c / G::CPR, cc = c % G::CPR; crw[i] = row;
    if (cc < KW / 8) { ccol[i] = kcol + cc * 8; cdst[i] = row * G::KSTR + cc * 16; } else { ccol[i] = vcol + (cc - KW / 8) * 8; cdst[i] = G::KBYTES + row * G::VSTR + (cc - KW / 8) * 16; } }
#define FP2_LOAD(kt, set) _Pragma("unroll") for (int i = 0; i < G::NCH; ++i) stg[set][i] = *(const u32x4*)(kv + (size_t)src((kt), crw[i]) * ld + ccol[i])
#define FP2_STORE(st, set) _Pragma("unroll") for (int i = 0; i < G::NCH; ++i) *(FA_LAS u32x4*)(lds + (st) * G::STAGE + cdst[i]) = stg[set][i]
  FP2_LOAD(0, 0); FP2_STORE(0, 0);
  if (ntiles > 1) { FP2_LOAD(1, 0); FP2_STORE(1, 0); }
  __syncthreads();
  if (ntiles > 2) FP2_LOAD(2, 0);
  if (PF == 2) { if (ntiles > 3) FP2_LOAD(3, PF - 1); }
  const int kroff = r32 * G::KSTR + (kofs + 8 * hi) * 2;
  const int vroff = G::KBYTES + (4 * hi + ((lane & 15) >> 2)) * G::VSTR + 32 * ((lane >> 4) & 1) + 8 * (lane & 3);
  f32x16 c0, c1;
#pragma unroll
  for (int r = 0; r < 16; ++r) { c0[r] = 0.f; c1[r] = 0.f; }
  { const ldsp_t kb = lds + kroff;
#pragma unroll
    for (int d0 = 0; d0 < 4; ++d0) {
      const bf16x8 a0 = *(const FA_LAS bf16x8*)(kb + d0 * 32), a1 = *(const FA_LAS bf16x8*)(kb + 32 * G::KSTR + d0 * 32);
      c0 = __builtin_amdgcn_mfma_f32_32x32x16_bf16(a0, q[d0], c0, 0, 0, 0); c1 = __builtin_amdgcn_mfma_f32_32x32x16_bf16(a1, q[d0], c1, 0, 0, 0); } }
  asm volatile("s_nop 15\n\ts_nop 7" : "+v"(c0), "+v"(c1));
  int st_cur = 0, st_nxt = 1, st_fill = 2;
  auto body = [&](int kt, auto PARC) {
    constexpr int set = (PF == 2) ? decltype(PARC)::value : 0;
    msk(kt, c0, c1);
    __builtin_amdgcn_sched_barrier(0);
    f32x16 n0, n1;
#pragma unroll
    for (int r = 0; r < 16; ++r) { n0[r] = 0.f; n1[r] = 0.f; }
    const ldsp_t kb = lds + st_nxt * G::STAGE + kroff;
    bf16x8 ka[4], kb2[4];
#pragma unroll
    for (int d0 = 0; d0 < 4; ++d0) { ka[d0] = *(const FA_LAS bf16x8*)(kb + d0 * 32); kb2[d0] = *(const FA_LAS bf16x8*)(kb + 32 * G::KSTR + d0 * 32); }
#define FP2_SB() __builtin_amdgcn_sched_barrier(0)
#define FP2_MMA(acc, kf, d0) acc = __builtin_amdgcn_mfma_f32_32x32x16_bf16(kf[d0], q[d0], acc, 0, 0, 0)
#define FP2_EXP(cx, r) { if (ABL != 1) { cx[r] = __builtin_amdgcn_exp2f(cx[r] - mn); ls += cx[r]; } }
    FP2_SB(); FP2_MMA(n0, ka, 0);
    float mxa = max3f(c0[0], c0[1], c1[0]), mxb = max3f(c0[2], c0[3], c1[1]);
    mxa = max3f(mxa, c1[2], c1[3]);
    mxa = max3f(mxa, c0[4], c0[5]); mxb = max3f(mxb, c0[6], c0[7]); mxa = max3f(mxa, c1[4], c1[5]); mxb = max3f(mxb, c1[6], c1[7]);
    FP2_SB(); FP2_MMA(n1, kb2, 0);
    mxa = max3f(mxa, c0[8], c0[9]); mxb = max3f(mxb, c0[10], c0[11]); mxa = max3f(mxa, c1[8], c1[9]); mxb = max3f(mxb, c1[10], c1[11]);
    mxa = max3f(mxa, c0[12], c0[13]); mxb = max3f(mxb, c0[14], c0[15]); mxa = max3f(mxa, c1[12], c1[13]); mxb = max3f(mxb, c1[14], c1[15]);
    float mx = max3f(mxa, mxb, m);
    mx = max3f(mx, __shfl_xor(mx, 32), mx);
    const float mn = mx, alpha = __builtin_amdgcn_exp2f(m - mn);
    const bool resc = __any(mn > m);
    m = mn;
    float ls = 0.f;
    FP2_SB(); FP2_MMA(n0, ka, 1);
    FP2_EXP(c0, 0) FP2_EXP(c0, 1) FP2_EXP(c0, 2) FP2_EXP(c0, 3) FP2_EXP(c0, 4) FP2_EXP(c0, 5)
    FP2_SB(); FP2_MMA(n1, kb2, 1);
    FP2_EXP(c0, 6) FP2_EXP(c0, 7) FP2_EXP(c0, 8) FP2_EXP(c0, 9) FP2_EXP(c0, 10) FP2_EXP(c0, 11)
    FP2_SB(); FP2_MMA(n0, ka, 2);
    FP2_EXP(c0, 12) FP2_EXP(c0, 13) FP2_EXP(c0, 14) FP2_EXP(c0, 15) FP2_EXP(c1, 0) FP2_EXP(c1, 1)
    FP2_SB(); FP2_MMA(n1, kb2, 2);
    FP2_EXP(c1, 2) FP2_EXP(c1, 3) FP2_EXP(c1, 4) FP2_EXP(c1, 5) FP2_EXP(c1, 6) FP2_EXP(c1, 7)
    FP2_SB(); FP2_MMA(n0, ka, 3);
    FP2_EXP(c1, 8) FP2_EXP(c1, 9) FP2_EXP(c1, 10) FP2_EXP(c1, 11) FP2_EXP(c1, 12) FP2_EXP(c1, 13)
    FP2_SB(); FP2_MMA(n1, kb2, 3);
    FP2_EXP(c1, 14) FP2_EXP(c1, 15)
    bf16x8 pa[4];
    { u32x4 t;
      t[0] = cvtpk(c0[0], c0[1]); t[1] = cvtpk(c0[2], c0[3]); t[2] = cvtpk(c0[4], c0[5]); t[3] = cvtpk(c0[6], c0[7]); pa[0] = __builtin_bit_cast(bf16x8, t);
      t[0] = cvtpk(c0[8], c0[9]); t[1] = cvtpk(c0[10], c0[11]); t[2] = cvtpk(c0[12], c0[13]); t[3] = cvtpk(c0[14], c0[15]); pa[1] = __builtin_bit_cast(bf16x8, t);
      t[0] = cvtpk(c1[0], c1[1]); t[1] = cvtpk(c1[2], c1[3]); t[2] = cvtpk(c1[4], c1[5]); t[3] = cvtpk(c1[6], c1[7]); pa[2] = __builtin_bit_cast(bf16x8, t);
      t[0] = cvtpk(c1[8], c1[9]); t[1] = cvtpk(c1[10], c1[11]); t[2] = cvtpk(c1[12], c1[13]); t[3] = cvtpk(c1[14], c1[15]); pa[3] = __builtin_bit_cast(bf16x8, t); }
    asm volatile("" : "+v"(pa[0]), "+v"(pa[1]), "+v"(pa[2]), "+v"(pa[3]));
    FP2_SB();
    l = l * alpha + ls;
    __builtin_amdgcn_sched_barrier(0);
    if (resc) {
#pragma unroll
      for (int b = 0; b < DVB; ++b)
#pragma unroll
        for (int r = 0; r < 16; ++r) o[b][r] *= alpha;
    }
    const ldsp_t vb = lds + st_cur * G::STAGE + vroff;
    s16x4 vl[2][DVB], vh[2][DVB];
#pragma unroll
    for (int b = 0; b < DVB; ++b) { vl[0][b] = vtr(vb + b * 64); vh[0][b] = vtr(vb + 8 * G::VSTR + b * 64); }
#pragma unroll
    for (int ks = 0; ks < 4; ++ks) {
      FP2_SB();
      if (ks < 3) {
#pragma unroll
        for (int b = 0; b < DVB; ++b) { vl[(ks + 1) & 1][b] = vtr(vb + (16 * (ks + 1)) * G::VSTR + b * 64); vh[(ks + 1) & 1][b] = vtr(vb + (16 * (ks + 1) + 8) * G::VSTR + b * 64); }
      }
      FP2_SB();
#pragma unroll
      for (int b = 0; b < DVB; ++b) {
        const s16x4 lo = vl[ks & 1][b], h8 = vh[ks & 1][b];
        const bf16x8 vf = {lo[0], lo[1], lo[2], lo[3], h8[0], h8[1], h8[2], h8[3]};
        if (ABL != 2) o[b] = __builtin_amdgcn_mfma_f32_32x32x16_bf16(vf, pa[ks], o[b], 0, 0, 0); else o[b][0] += __builtin_bit_cast(float, (int)vf[0]);
      }
    }
    FP2_SB();
    if (ABL != 3) { if (kt + 2 < ntiles) FP2_STORE(st_fill, set); }
    __syncthreads();
    if (ABL != 3) { if (kt + 2 + PF < ntiles) FP2_LOAD(kt + 2 + PF, set); }
    c0 = n0; c1 = n1;
    { const int t = st_cur; st_cur = st_nxt; st_nxt = st_fill; st_fill = t; }
  };
  if (PF == 2) { for (int kt = 0; kt < ntiles; kt += 2) { body(kt, IC<0>{}); if (kt + 1 < ntiles) body(kt + 1, IC<1>{}); } }
  else { for (int kt = 0; kt < ntiles; ++kt) body(kt, IC<0>{}); }
#undef FP2_LOAD
#undef FP2_STORE
}

DEVI int vblock() { const int G = gridDim.x, bx = blockIdx.x; return (G % 8 == 0) ? (bx % 8) * (G / 8) + bx / 8 : bx; }

template <int ABL = 0> DEVI void phase_attnA(const Params& p, ldsp_t lds) {
  typedef Geo<128, 4> G;
  const int tid = ftid(), lane = tid & 63, wave = __builtin_amdgcn_readfirstlane(tid >> 6), r32 = lane & 31, hi = lane >> 5;
  const bf16_t* Q = (const bf16_t*)(p.ws + WS_QKV0); bf16_t* ATT = (bf16_t*)(p.ws + (ABL ? WS_MIX0 : WS_ATT0));
  const float lam = ((const float*)(p.ws + WS_CTL + CTL_LAM))[0];
  const int s = wave >> 2, qb = wave & 3;
  constexpr int NU_LAT = NB * 4 * 32, NU_CTX = NB * 4 * 2;
  for (int u = vblock(); u < NU_LAT + NU_CTX; u += gridDim.x) {
    int b, h, row0, ntiles; bool lat = u < NU_LAT;
    if (lat) { b = u >> 7; h = (u >> 5) & 3; row0 = b * SEQ + (u & 31) * 128; ntiles = 68; }
    else { const int v = u - NU_LAT; b = v >> 3; h = (v >> 1) & 3; row0 = NLAT + b * CTXL + (v & 1) * 128; ntiles = 4; }
    const int qrow = row0 + qb * 32 + r32;
    bf16x8 q[4];
#pragma unroll
    for (int d0 = 0; d0 < 4; ++d0) q[d0] = load_q8(Q + (size_t)qrow * N_IN0 + h * 128 + s * 64 + 16 * d0 + 8 * hi, C2);
    f32x16 o[4];
#pragma unroll
    for (int bk = 0; bk < 4; ++bk)
#pragma unroll
      for (int r = 0; r < 16; ++r) o[bk][r] = 0.f;
    float m = -1e30f, l = 0.f;
    const int cbase = NLAT + b * CTXL, lbase = b * SEQ;
    flash_pass2<128, 4, ABL, 1>(lds, ntiles, Q, N_IN0, 512 + h * 128, 1024 + h * 128, q, s * 64,
      [&](int kt, int i) { return lat ? (kt < 64 ? lbase + kt * 64 + i : cbase + (kt - 64) * 64 + i) : cbase + kt * 64 + i; },
      [&](int, f32x16&, f32x16&) {}, o, m, l);
    l += __shfl_xor(l, 32);
    const float inv = 1.f / l;
    FA_LAS float* X = (FA_LAS float*)lds;
    if (s == 1) {
#pragma unroll
      for (int bk = 0; bk < 4; ++bk)
#pragma unroll
        for (int r = 0; r < 16; ++r) X[((qb * 4 + bk) * 16 + r) * 64 + lane] = o[bk][r] * inv;
    }
    __syncthreads();
    if (s == 0) {
      float ss = 0.f;
#pragma unroll
      for (int bk = 0; bk < 4; ++bk)
#pragma unroll
        for (int r = 0; r < 16; ++r) { const float d = o[bk][r] * inv - lam * X[((qb * 4 + bk) * 16 + r) * 64 + lane]; o[bk][r] = d; ss += d * d; }
      ss += __shfl_xor(ss, 32);
      const float rr = rsqrtf(ss * (1.f / 128.f) + EPS) * 0.8f;
      const float* g = p.in[L0_SUBLN];
      bf16_t* orow = ATT + (size_t)qrow * DM + h * 128;
#pragma unroll
      for (int bk = 0; bk < 4; ++bk)
#pragma unroll
        for (int rg = 0; rg < 4; ++rg) { const int dv = bk * 32 + 8 * rg + 4 * hi; const float4 gv = *(const float4*)(g + dv);
          uint2 w; w.x = cvtpk(o[bk][4 * rg] * rr * gv.x, o[bk][4 * rg + 1] * rr * gv.y); w.y = cvtpk(o[bk][4 * rg + 2] * rr * gv.z, o[bk][4 * rg + 3] * rr * gv.w);
          *(uint2*)(orow + dv) = w; }
    }
    __syncthreads();
  }
}

template <int ABL = 0> DEVI void phase_attnB(const Params& p, ldsp_t lds) {
  typedef Geo<64, 2> G;
  const int tid = ftid(), lane = tid & 63, wave = __builtin_amdgcn_readfirstlane(tid >> 6), r32 = lane & 31, hi = lane >> 5;
  const bf16_t* Q = (const bf16_t*)(p.ws + WS_QKV0); bf16_t* ATT = (bf16_t*)(p.ws + (ABL ? WS_MIX0 : WS_ATT0));
  constexpr int NU_LAT = NB * 8 * 16, NU_CTX = NB * 8;
  FA_LAS float* RPB = (FA_LAS float*)(lds + 3 * G::STAGE);
  for (int u = vblock(); u < NU_LAT + NU_CTX; u += gridDim.x) {
    const bool lat = u < NU_LAT;
    int b, h, qrow_g = 0, c0 = 0, rlo = 0, nlat = 0, rs_w = 0, grow;
    if (lat) { b = u >> 7; h = (u >> 4) & 7; const int qr0 = (u & 15) * 4; qrow_g = qr0 + (wave >> 1); c0 = 32 * (wave & 1);
      rlo = min(max(qr0 - 4, 0), 56); const int rhi = min(max(qr0 - 1, 0), 56) + 7; nlat = rhi - rlo + 1; rs_w = min(max(qrow_g - 4, 0), 56);
      grow = b * SEQ + qrow_g * 64 + c0 + r32; }
    else { const int v = u - NU_LAT; b = v >> 3; h = v & 7; grow = NLAT + b * CTXL + wave * 32 + r32; }
    const int ntiles = nlat + 4;
    for (int i = tid; i < 15 * 31; i += NT) RPB[i] = p.in[L0_RPB][h * 465 + i] * LOG2E;
    bf16x8 q[4];
#pragma unroll
    for (int d0 = 0; d0 < 4; ++d0) q[d0] = load_q8(Q + (size_t)grow * N_IN0 + 1536 + h * 64 + 16 * d0 + 8 * hi, C2);
    f32x16 o[2];
#pragma unroll
    for (int bk = 0; bk < 2; ++bk)
#pragma unroll
      for (int r = 0; r < 16; ++r) o[bk][r] = 0.f;
    float m = -1e30f, l = 0.f;
    const int cbase = NLAT + b * CTXL, lbase = b * SEQ;
    const int qc = c0 + r32, cs = min(max(qc - 8, 0), 48);
    flash_pass2<64, 2, (ABL >= 5 ? ABL - 4 : 0), 2>(lds, ntiles, Q, N_IN0, 2048 + h * 64, 2560 + h * 64, q, 0,
      [&](int kt, int i) { return kt < nlat ? lbase + (rlo + kt) * 64 + i : cbase + (kt - nlat) * 64 + i; },
      [&](int kt, f32x16& p0, f32x16& p1) {
        if (ABL != 1 && kt < nlat) { const int kr = rlo + kt; const bool rowok = (kr >= rs_w && kr < rs_w + 8);
          const FA_LAS float* bp = RPB + min(max(kr - qrow_g + 7, 0), 14) * 31;
          float b0[16], b1[16];
#pragma unroll
          for (int r = 0; r < 16; ++r) { const int k0 = crow(r, hi); b0[r] = bp[min(max(k0 - qc + 15, 0), 30)]; b1[r] = bp[min(max(k0 + 32 - qc + 15, 0), 30)]; }
#pragma unroll
          for (int r = 0; r < 16; ++r) { const int k0 = crow(r, hi), k1 = 32 + k0;
            const float v0 = p0[r] + b0[r], v1 = p1[r] + b1[r];
            p0[r] = (rowok && k0 >= cs && k0 < cs + 16) ? v0 : -INFINITY; p1[r] = (rowok && k1 >= cs && k1 < cs + 16) ? v1 : -INFINITY; } } },
      o, m, l);
    l += __shfl_xor(l, 32);
    const float inv = 1.f / l;
    bf16_t* orow = ATT + (size_t)grow * DM + 512 + h * 64;
#pragma unroll
    for (int bk = 0; bk < 2; ++bk)
#pragma unroll
      for (int rg = 0; rg < 4; ++rg) { const int dv = bk * 32 + 8 * rg + 4 * hi;
        uint2 w; w.x = cvtpk(o[bk][4 * rg] * inv, o[bk][4 * rg + 1] * inv); w.y = cvtpk(o[bk][4 * rg + 2] * inv, o[bk][4 * rg + 3] * inv);
        *(uint2*)(orow + dv) = w; }
    __syncthreads();
  }
}

DEVI void phase_attnC(const Params& p, ldsp_t lds, int* ctr) {
  const int tid = ftid(), lane = tid & 63, wave = __builtin_amdgcn_readfirstlane(tid >> 6), r32 = lane & 31, hi = lane >> 5;
  const bf16_t* P1 = (const bf16_t*)(p.ws + WS_P1); bf16_t* ATT = (bf16_t*)(p.ws + WS_ATT1);
  FA_LAS int* uq = (FA_LAS int*)(lds + 3 * Geo<64, 2>::STAGE + 64);
  for (;;) {
    if (tid == 0) *uq = atomicAdd(ctr, 1);
    __syncthreads();
    const int u = *uq;
    __syncthreads();
    if (u >= NB * 2 * 64) break;
    const int b = u >> 7, g = (u >> 6) & 1, tq = u & 63, hq = g * 4 + (wave >> 1), t = tq * 64 + 32 * (wave & 1) + r32, grow = b * SEQ + t;
    const int klo = max(tq - 2, 0), khi = min(tq + 2, 63), nwin = khi - klo + 1, ntiles = nwin + 4;
    bf16x8 q[4];
#pragma unroll
    for (int d0 = 0; d0 < 4; ++d0) q[d0] = load_q8(P1 + (size_t)grow * 2304 + hq * 64 + 16 * d0 + 8 * hi, C2);
    f32x16 o[2];
#pragma unroll
    for (int bk = 0; bk < 2; ++bk)
#pragma unroll
      for (int r = 0; r < 16; ++r) o[bk][r] = 0.f;
    float m = -1e30f, l = 0.f;
    const int cbase = NLAT + b * CTXL, lbase = b * SEQ;
    flash_pass2<64, 2, 0, 2>(lds, ntiles, P1, 2304, 512 + g * 64, 640 + g * 64, q, 0,
      [&](int kt, int i) { return kt < nwin ? lbase + (klo + kt) * 64 + i : cbase + (kt - nwin) * 64 + i; },
      [&](int kt, f32x16& p0, f32x16& p1) {
        if (kt < nwin) { const int kp = (klo + kt) * 64 - t;
#pragma unroll
          for (int r = 0; r < 16; ++r) { const int d0 = kp + crow(r, hi), d1 = d0 + 32;
            if (d0 < -128 || d0 > 128) p0[r] = -INFINITY; if (d1 < -128 || d1 > 128) p1[r] = -INFINITY; } } },
      o, m, l);
    l += __shfl_xor(l, 32);
    { const float sk = p.in[L1_SINKS][hq] * LOG2E, mn = fmaxf(m, sk), alpha = __builtin_amdgcn_exp2f(m - mn);
      l = l * alpha + __builtin_amdgcn_exp2f(sk - mn);
#pragma unroll
      for (int bk = 0; bk < 2; ++bk)
#pragma unroll
        for (int r = 0; r < 16; ++r) o[bk][r] *= alpha; }
    const float inv = 1.f / l;
    bf16_t* orow = ATT + (size_t)grow * DM + hq * 64;
#pragma unroll
    for (int bk = 0; bk < 2; ++bk)
#pragma unroll
      for (int rg = 0; rg < 4; ++rg) { const int dv = bk * 32 + 8 * rg + 4 * hi;
        uint2 w; w.x = cvtpk(o[bk][4 * rg] * inv, o[bk][4 * rg + 1] * inv); w.y = cvtpk(o[bk][4 * rg + 2] * inv, o[bk][4 * rg + 3] * inv);
        *(uint2*)(orow + dv) = w; }
    __syncthreads();
  }
}
}
namespace fs {
using fa::bf16x8; using fa::s16x4; using fa::f32x16; using fa::ldsp_t; using fa::u32x4; using fa::cvtpk; using fa::vtr; using fa::crow; using fa::LOG2E;
typedef unsigned u32x2 __attribute__((ext_vector_type(2)));

DEVI void phase_conv(const Params& p) {
  const bf16_t* P1 = (const bf16_t*)(p.ws + WS_P1); bf16_t* U = (bf16_t*)(p.ws + WS_U);
  const float* cw = p.in[L1_CONVW]; const float* cb = p.in[L1_CONVB];
  const int nitems = (NROW / 16) * 128;
  for (int it = blockIdx.x * NT + ftid(); it < nitems; it += gridDim.x * NT) {
    const int cg = it & 127, rc = it >> 7, r0 = rc * 16, ch = cg * 8;
    int s0, len; if (r0 < NLAT) { s0 = r0 & ~4095; len = SEQ; } else { s0 = NLAT + ((r0 - NLAT) & ~255); len = CTXL; }
    const int t0 = r0 - s0;
    float w[5][8], bias[8];
#pragma unroll
    for (int j = 0; j < 5; ++j) { const float4 a = *(const float4*)(cw + j * 1024 + ch), b = *(const float4*)(cw + j * 1024 + ch + 4);
      w[j][0] = a.x; w[j][1] = a.y; w[j][2] = a.z; w[j][3] = a.w; w[j][4] = b.x; w[j][5] = b.y; w[j][6] = b.z; w[j][7] = b.w; }
    { const float4 a = *(const float4*)(cb + ch), b = *(const float4*)(cb + ch + 4); bias[0] = a.x; bias[1] = a.y; bias[2] = a.z; bias[3] = a.w; bias[4] = b.x; bias[5] = b.y; bias[6] = b.z; bias[7] = b.w; }
    float win[5][8];
    auto ldrow = [&](int t, float (&d)[8]) {
      if (t < 0 || t >= len) {
#pragma unroll
        for (int k = 0; k < 8; ++k) d[k] = 0.f; return; }
      const u32x4 v = *(const u32x4*)(P1 + (size_t)(s0 + t) * 2304 + 768 + ch);
#pragma unroll
      for (int k = 0; k < 4; ++k) { d[2 * k] = __uint_as_float(v[k] << 16); d[2 * k + 1] = __uint_as_float(v[k] & 0xffff0000u); } };
    ldrow(t0 - 2, win[0]); ldrow(t0 - 1, win[1]); ldrow(t0, win[2]); ldrow(t0 + 1, win[3]);
#pragma unroll
    for (int i = 0; i < 16; ++i) {
      ldrow(t0 + i + 2, win[(i + 4) % 5]);
      float o[8];
#pragma unroll
      for (int k = 0; k < 8; ++k) { float a = bias[k];
#pragma unroll
        for (int j = 0; j < 5; ++j) a += w[j][k] * win[(i + j) % 5][k];
        o[k] = a * __builtin_amdgcn_rcpf(1.f + __expf(-a)); }
      u32x4 ov; ov[0] = cvtpk(o[0], o[1]); ov[1] = cvtpk(o[2], o[3]); ov[2] = cvtpk(o[4], o[5]); ov[3] = cvtpk(o[6], o[7]);
      *(u32x4*)(U + (size_t)(r0 + i) * 1024 + ch) = ov;
    }
  }
}

DEVI float softplus_f(float v) { if (v > 20.f) return v; const float x = __expf(v); return x < 1e-3f ? x * (1.f - 0.5f * x) : __logf(1.f + x); }
constexpr int BSTR = 272, XSTR = 192;
constexpr int L_BM = 0, L_XD = 128 * BSTR, L_XW = L_XD + 128 * XSTR, L_HT = L_XW + 128 * XSTR, L_CUM = L_HT + 128 * XSTR, L_DTV = L_CUM + 512, L_XCH = L_DTV + 512, L_TOT = L_XCH + 8 * 4096;

template <int ABL = 0> DEVI void phase_ssd(const Params& p, ldsp_t lds) {
  const int tid = ftid(), lane = tid & 63, wave = __builtin_amdgcn_readfirstlane(tid >> 6), r32 = lane & 31, hi = lane >> 5;
  const int pb = wave >> 2, lb = (wave < 4) ? (wave & 3) : 3 - (wave & 3);
  const bf16_t* U = (const bf16_t*)(p.ws + WS_U); const float* DT = (const float*)(p.ws + WS_DT);
  bf16_t* YFB = (bf16_t*)(p.ws + WS_YS);
  FA_LAS float* CUM = (FA_LAS float*)(lds + L_CUM); FA_LAS float* DTV = (FA_LAS float*)(lds + L_DTV);
  const int trow_off = 4 * hi + ((lane & 15) >> 2), tcol_off = 32 * ((lane >> 4) & 1) + 8 * (lane & 3);
  for (int it = blockIdx.x; it < NB * 2 * 8; it += gridDim.x) {
    const int b = it >> 4, dir = (it >> 3) & 1, hd = it & 7, g = hd >> 2;
    const float a2 = -expf(p.in[dir ? L1_ALOGB : L1_ALOGF][hd]) * LOG2E; const float dtb = p.in[dir ? L1_DTBB : L1_DTBF][hd];
    auto tokrow = [&](int c, int i) { const int seg = c >= 2, len = seg ? SEQ : CTXL, j = (seg ? c - 2 : c) * 128 + i; return (seg ? b * SEQ : NLAT + b * CTXL) + (dir ? len - 1 - j : j); };
    f32x16 hacc;
#pragma unroll
    for (int r = 0; r < 16; ++r) hacc[r] = 0.f;
    for (int i = tid; i < 128 * XSTR / 4; i += NT) ((FA_LAS unsigned*)(lds + L_HT))[i] = 0u;
    u32x4 sb_[4], sx_[2]; float sdt0 = 0.f, sdt1 = 0.f; bf16x8 cfn[8];
    auto prefetch = [&](int c) {
#pragma unroll
      for (int i = 0; i < 4; ++i) { const int ch = tid + NT * i; sb_[i] = *(const u32x4*)(U + (size_t)tokrow(c, ch >> 4) * 1024 + 512 + g * 128 + (ch & 15) * 8); }
#pragma unroll
      for (int i = 0; i < 2; ++i) { const int ch = tid + NT * i; sx_[i] = *(const u32x4*)(U + (size_t)tokrow(c, ch >> 3) * 1024 + hd * 64 + (ch & 7) * 8); }
      if (tid < 64) { sdt0 = DT[(size_t)tokrow(c, 2 * tid) * 16 + dir * 8 + hd]; sdt1 = DT[(size_t)tokrow(c, 2 * tid + 1) * 16 + dir * 8 + hd]; }
      const bf16_t* crowp = U + (size_t)tokrow(c, lb * 32 + r32) * 1024 + 768 + g * 128 + 8 * hi;
#pragma unroll
      for (int ks = 0; ks < 8; ++ks) cfn[ks] = *(const bf16x8*)(crowp + 16 * ks);
    };
    prefetch(0);
    __syncthreads();
    for (int c = 0; c < 34; ++c) {
      if (tid < 64) {
        const float r0 = sdt0 + dtb, r1 = sdt1 + dtb; const float d0 = softplus_f(r0), d1 = softplus_f(r1);
        const float a0 = d0 * a2, a1 = d1 * a2; float v = a0 + a1;
#pragma unroll
        for (int o = 1; o < 64; o <<= 1) { const float t = __shfl_up(v, o); if (lane >= o) v += t; }
        DTV[2 * tid] = d0; DTV[2 * tid + 1] = d1; CUM[2 * tid] = v - a1; CUM[2 * tid + 1] = v;
      }
      __syncthreads();
      const float cl = CUM[127];
#pragma unroll
      for (int i = 0; i < 4; ++i) { const int ch = tid + NT * i; *(FA_LAS u32x4*)(lds + L_BM + (ch >> 4) * BSTR + (ch & 15) * 16) = sb_[i]; }
#pragma unroll
      for (int i = 0; i < 2; ++i) { const int ch = tid + NT * i, s = ch >> 3; const float d = DTV[s], wv = d * __builtin_amdgcn_exp2f(cl - CUM[s]);
        u32x4 xd, xw;
#pragma unroll
        for (int k = 0; k < 4; ++k) { const float x0 = __uint_as_float(sx_[i][k] << 16), x1 = __uint_as_float(sx_[i][k] & 0xffff0000u); xd[k] = cvtpk(x0 * d, x1 * d); xw[k] = cvtpk(x0 * wv, x1 * wv); }
        *(FA_LAS u32x4*)(lds + L_XD + s * XSTR + (ch & 7) * 16) = xd; *(FA_LAS u32x4*)(lds + L_XW + s * XSTR + (ch & 7) * 16) = xw; }
      bf16x8 cf[8];
#pragma unroll
      for (int ks = 0; ks < 8; ++ks) cf[ks] = cfn[ks];
      __syncthreads();
      if (ABL != 3) { if (c + 1 < 34) prefetch(c + 1); }
      if (c >= 2 && ABL != 1) {
        f32x16 y;
#pragma unroll
        for (int r = 0; r < 16; ++r) y[r] = 0.f;
        { const ldsp_t hb = lds + L_HT + (8 * hi + ((lane & 15) >> 2)) * XSTR + pb * 64 + tcol_off;
          f32x16 y2;
#pragma unroll
          for (int r = 0; r < 16; ++r) y2[r] = 0.f;
#pragma unroll
          for (int ks = 0; ks < 8; ++ks) { const s16x4 lo = vtr(hb + (16 * ks) * XSTR), h8 = vtr(hb + (16 * ks + 4) * XSTR);
            const bf16x8 hf = {lo[0], lo[1], lo[2], lo[3], h8[0], h8[1], h8[2], h8[3]};
            if (ks & 1) y2 = __builtin_amdgcn_mfma_f32_32x32x16_bf16(hf, cf[ks], y2, 0, 0, 0); else y = __builtin_amdgcn_mfma_f32_32x32x16_bf16(hf, cf[ks], y, 0, 0, 0); }
          y += y2; }
        const float cuml = CUM[lb * 32 + r32];
        { const float e = __builtin_amdgcn_exp2f(cuml);
#pragma unroll
          for (int r = 0; r < 16; ++r) y[r] *= e; }
        f32x16 yo;
#pragma unroll
        for (int r = 0; r < 16; ++r) yo[r] = 0.f;
        for (int sb = pb; sb <= lb; sb += 2) {
          f32x16 gt, gt2;
#pragma unroll
          for (int r = 0; r < 16; ++r) { gt[r] = 0.f; gt2[r] = 0.f; }
          const ldsp_t bb = lds + L_BM + (sb * 32 + r32) * BSTR + 16 * hi;
#pragma unroll
          for (int ks = 0; ks < 8; ks += 2) { gt = __builtin_amdgcn_mfma_f32_32x32x16_bf16(*(const FA_LAS bf16x8*)(bb + 32 * ks), cf[ks], gt, 0, 0, 0);
            gt2 = __builtin_amdgcn_mfma_f32_32x32x16_bf16(*(const FA_LAS bf16x8*)(bb + 32 * ks + 32), cf[ks + 1], gt2, 0, 0, 0); }
          gt += gt2;
          const bool diag = (sb == lb);
#pragma unroll
          for (int r = 0; r < 16; ++r) { const int sl = crow(r, hi); const float v = gt[r] * __builtin_amdgcn_exp2f(cuml - CUM[sb * 32 + sl]); gt[r] = (diag && sl > r32) ? 0.f : v; }
          u32x4 t0, t1;
          t0[0] = cvtpk(gt[0], gt[1]); t0[1] = cvtpk(gt[2], gt[3]); t0[2] = cvtpk(gt[4], gt[5]); t0[3] = cvtpk(gt[6], gt[7]);
          t1[0] = cvtpk(gt[8], gt[9]); t1[1] = cvtpk(gt[10], gt[11]); t1[2] = cvtpk(gt[12], gt[13]); t1[3] = cvtpk(gt[14], gt[15]);
          const bf16x8 pm0 = __builtin_bit_cast(bf16x8, t0), pm1 = __builtin_bit_cast(bf16x8, t1);
          const ldsp_t xb = lds + L_XD + (sb * 32 + trow_off) * XSTR + pb * 64 + tcol_off;
          const ldsp_t xo = lds + L_XD + (sb * 32 + trow_off) * XSTR + (1 - pb) * 64 + tcol_off;
          const s16x4 a0 = vtr(xb), a1 = vtr(xb + 8 * XSTR), a2 = vtr(xb + 16 * XSTR), a3 = vtr(xb + 24 * XSTR);
          const s16x4 b0 = vtr(xo), b1 = vtr(xo + 8 * XSTR), b2 = vtr(xo + 16 * XSTR), b3 = vtr(xo + 24 * XSTR);
          { const bf16x8 xf = {a0[0], a0[1], a0[2], a0[3], a1[0], a1[1], a1[2], a1[3]}; y = __builtin_amdgcn_mfma_f32_32x32x16_bf16(xf, pm0, y, 0, 0, 0); }
          { const bf16x8 xf = {b0[0], b0[1], b0[2], b0[3], b1[0], b1[1], b1[2], b1[3]}; yo = __builtin_amdgcn_mfma_f32_32x32x16_bf16(xf, pm0, yo, 0, 0, 0); }
          { const bf16x8 xf = {a2[0], a2[1], a2[2], a2[3], a3[0], a3[1], a3[2], a3[3]}; y = __builtin_amdgcn_mfma_f32_32x32x16_bf16(xf, pm1, y, 0, 0, 0); }
          { const bf16x8 xf = {b2[0], b2[1], b2[2], b2[3], b3[0], b3[1], b3[2], b3[3]}; yo = __builtin_amdgcn_mfma_f32_32x32x16_bf16(xf, pm1, yo, 0, 0, 0); }
        }
        { FA_LAS float* X = (FA_LAS float*)(lds + L_XCH) + (pb * 4 + lb) * 1024;
#pragma unroll
          for (int r = 0; r < 16; ++r) X[r * 64 + lane] = yo[r]; }
        __syncthreads();
        { const FA_LAS float* X = (const FA_LAS float*)(lds + L_XCH) + ((1 - pb) * 4 + lb) * 1024;
#pragma unroll
          for (int r = 0; r < 16; ++r) y[r] += X[r * 64 + lane]; }
        const int j = (c - 2) * 128 + lb * 32 + r32, tok = dir ? SEQ - 1 - j : j;
        bf16_t* yp = YFB + ((size_t)dir * NLAT + (size_t)b * SEQ + tok) * 512 + hd * 64 + pb * 32 + 4 * hi;
#pragma unroll
        for (int rg = 0; rg < 4; ++rg) { u32x2 w; w[0] = cvtpk(y[4 * rg], y[4 * rg + 1]); w[1] = cvtpk(y[4 * rg + 2], y[4 * rg + 3]); *(u32x2*)(yp + 8 * rg) = w; }
      }
      if (ABL != 2) { const float e = __builtin_amdgcn_exp2f(cl);
        f32x16 h2;
#pragma unroll
        for (int r = 0; r < 16; ++r) { hacc[r] *= e; h2[r] = 0.f; }
        const ldsp_t xb = lds + L_XW + (8 * hi + ((lane & 15) >> 2)) * XSTR + pb * 64 + tcol_off;
        const ldsp_t bb = lds + L_BM + (8 * hi + ((lane & 15) >> 2)) * BSTR + lb * 64 + tcol_off;
#pragma unroll
        for (int ks = 0; ks < 8; ++ks) {
          const s16x4 xl = vtr(xb + (16 * ks) * XSTR), xh = vtr(xb + (16 * ks + 4) * XSTR), bl = vtr(bb + (16 * ks) * BSTR), bh = vtr(bb + (16 * ks + 4) * BSTR);
          const bf16x8 xf = {xl[0], xl[1], xl[2], xl[3], xh[0], xh[1], xh[2], xh[3]}, bf = {bl[0], bl[1], bl[2], bl[3], bh[0], bh[1], bh[2], bh[3]};
          if (ks & 1) h2 = __builtin_amdgcn_mfma_f32_32x32x16_bf16(xf, bf, h2, 0, 0, 0); else hacc = __builtin_amdgcn_mfma_f32_32x32x16_bf16(xf, bf, hacc, 0, 0, 0);
        }
        hacc += h2; }
      __syncthreads();
      { const ldsp_t hp = lds + L_HT + (lb * 32 + r32) * XSTR + (pb * 32 + 4 * hi) * 2;
#pragma unroll
        for (int rg = 0; rg < 4; ++rg) { u32x2 w; w[0] = cvtpk(hacc[4 * rg], hacc[4 * rg + 1]); w[1] = cvtpk(hacc[4 * rg + 2], hacc[4 * rg + 3]); *(FA_LAS u32x2*)(hp + 16 * rg) = w; } }
    }
    __syncthreads();
  }
}

DEVI void phase_ssd_out(const Params& p) {
  const int lane = ftid() & 63, gw = blockIdx.x * NWAVE + (ftid() >> 6), NGW = gridDim.x * NWAVE;
  const bf16_t* U = (const bf16_t*)(p.ws + WS_U); const bf16_t* P1 = (const bf16_t*)(p.ws + WS_P1); const bf16_t* YFB = (const bf16_t*)(p.ws + WS_YS);
  bf16_t* ATT = (bf16_t*)(p.ws + WS_ATT1);
  for (int r = gw; r < NLAT; r += NGW) {
    const int c0 = lane * 8, hd = c0 >> 6; const float dsk = p.in[L1_DSKIP][hd];
    const u32x4 yf = *(const u32x4*)(YFB + (size_t)r * 512 + c0), yb = *(const u32x4*)(YFB + ((size_t)NLAT + r) * 512 + c0);
    const u32x4 xw = *(const u32x4*)(U + (size_t)r * 1024 + c0), zw = *(const u32x4*)(P1 + (size_t)r * 2304 + 1792 + c0);
    float y[8]; float ss = 0.f;
#pragma unroll
    for (int i = 0; i < 4; ++i) {
      const float x0 = __uint_as_float(xw[i] << 16), x1 = __uint_as_float(xw[i] & 0xffff0000u), z0 = __uint_as_float(zw[i] << 16), z1 = __uint_as_float(zw[i] & 0xffff0000u);
      const float f0 = __uint_as_float(yf[i] << 16) + __uint_as_float(yb[i] << 16), f1 = __uint_as_float(yf[i] & 0xffff0000u) + __uint_as_float(yb[i] & 0xffff0000u);
      y[2 * i] = (f0 + dsk * x0) * silu_f(z0); y[2 * i + 1] = (f1 + dsk * x1) * silu_f(z1);
      ss += y[2 * i] * y[2 * i] + y[2 * i + 1] * y[2 * i + 1];
    }
#pragma unroll
    for (int o = 1; o < 32; o <<= 1) ss += __shfl_xor(ss, o);
    const float rr = rsqrtf(ss * (1.f / 256.f) + EPS);
    const float4 g0 = *(const float4*)(p.in[L1_GNORM] + c0), g1 = *(const float4*)(p.in[L1_GNORM] + c0 + 4);
    u32x4 w; w[0] = cvtpk(y[0] * rr * g0.x, y[1] * rr * g0.y); w[1] = cvtpk(y[2] * rr * g0.z, y[3] * rr * g0.w); w[2] = cvtpk(y[4] * rr * g1.x, y[5] * rr * g1.y); w[3] = cvtpk(y[6] * rr * g1.z, y[7] * rr * g1.w);
    *(u32x4*)(ATT + (size_t)r * DM + 512 + c0) = w;
  }
}
}
#ifndef TOPK_COPY
#define TOPK_COPY false
#endif
namespace ft {
using fa::ldsp_t; using fa::u32x4;

DEVI int block_excl_scan(int v, FA_LAS int* wsum, int tid, int* tot) {
  const int lane = tid & 63, wave = tid >> 6;
  int inc = v;
#pragma unroll
  for (int o = 1; o < 64; o <<= 1) { const int t = __shfl_up(inc, o); if (lane >= o) inc += t; }
  __syncthreads();
  if (lane == 63) wsum[wave] = inc;
  __syncthreads();
  int base = 0, total = 0;
#pragma unroll
  for (int w = 0; w < 8; ++w) { const int s = wsum[w]; if (w < wave) base += s; total += s; }
  *tot = total;
  return base + inc - v;
}

template <int EPT, bool GATHER_COPY>
DEVI void topk_item(const Params& p, ldsp_t lds, int e, int n, int cap, int row0, int slot0, int erows) {
  const int tid = ftid(), lane = tid & 63, wave = tid >> 6;
  const float* AFFT = (const float*)(p.ws + WS_AFF); int* SLOT = (int*)(p.ws + WS_SLOT); float* GV = (float*)(p.ws + WS_GATEV);
  const bf16_t* H = (const bf16_t*)(p.ws + WS_H); bf16_t* XG = (bf16_t*)(p.ws + WS_XG); int* IDX = (int*)(p.ws + WS_IDX);
  FA_LAS unsigned* hist = (FA_LAS unsigned*)lds;
  FA_LAS int* misc = (FA_LAS int*)(lds + 1024);
  FA_LAS int* wsum = (FA_LAS int*)(lds + 1024 + 64);
  FA_LAS int* list = (FA_LAS int*)(lds + 2048);
  const bool act = tid * EPT < n;
  unsigned key[EPT];
#pragma unroll
  for (int j = 0; j < EPT; ++j) key[j] = act ? __float_as_uint(AFFT[(size_t)e * NROW + row0 + tid * EPT + j]) : 0u;
  unsigned prefix = 0u, mask = 0u; int k = cap;
#pragma unroll 1
  for (int pass = 0; pass < 4; ++pass) {
    const int shift = 24 - 8 * pass;
    __syncthreads();
    if (tid < 256) hist[tid] = 0u;
    __syncthreads();
    if (act) {
#pragma unroll
      for (int j = 0; j < EPT; ++j) if ((key[j] & mask) == prefix) atomicAdd((unsigned*)&hist[(key[j] >> shift) & 255u], 1u);
    }
    __syncthreads();
    if (wave == 0) {
      const int h0 = hist[4 * lane], h1 = hist[4 * lane + 1], h2 = hist[4 * lane + 2], h3 = hist[4 * lane + 3];
      const int s = h0 + h1 + h2 + h3; int v = s;
#pragma unroll
      for (int o = 1; o < 64; o <<= 1) { const int t = __shfl_down(v, o); if (lane + o < 64) v += t; }
      int c = v - s;
      const int hh[4] = {h0, h1, h2, h3};
#pragma unroll
      for (int b = 3; b >= 0; --b) { if (c < k && k <= c + hh[b]) { misc[0] = 4 * lane + b; misc[1] = k - c; } c += hh[b]; }
    }
    __syncthreads();
    prefix |= ((unsigned)misc[0]) << shift; mask |= 255u << shift; k = misc[1];
  }
  int ce = 0;
#pragma unroll
  for (int j = 0; j < EPT; ++j) ce += (act && key[j] == prefix) ? 1 : 0;
  int tot; const int eq_before = block_excl_scan(ce, wsum, tid, &tot);
  int cs = 0, eqr = eq_before; bool sel[EPT];
#pragma unroll
  for (int j = 0; j < EPT; ++j) { bool s = false; if (act) { if (key[j] > prefix) s = true; else if (key[j] == prefix) { s = eqr < k; ++eqr; } } sel[j] = s; cs += s ? 1 : 0; }
  int slot = block_excl_scan(cs, wsum, tid, &tot);
  if (act) {
#pragma unroll
    for (int j = 0; j < EPT; ++j) { const int row = row0 + tid * EPT + j;
      if (sel[j]) { if (GATHER_COPY) list[slot] = row; else IDX[e * erows + slot0 + slot] = row; GV[e * erows + slot0 + slot] = __uint_as_float(key[j]); SLOT[(size_t)row * 16 + e] = slot0 + slot; ++slot; }
      else SLOT[(size_t)row * 16 + e] = -1; }
  }
  if (GATHER_COPY) {
    __syncthreads();
    for (int s = wave; s < cap; s += NWAVE) {
      const u32x4* src = (const u32x4*)(H + (size_t)list[s] * DM) + lane; u32x4* dst = (u32x4*)(XG + ((size_t)e * erows + slot0 + s) * DM) + lane;
      const u32x4 a = src[0], b2 = src[64]; dst[0] = a; dst[64] = b2;
    }
  }
  __syncthreads();
}

DEVI void phase_topk(const Params& p, ldsp_t lds, int layer) {
  const int erows = layer ? EROWS1 : EROWS0;
  const int nlat = NB * NE, nitems = nlat + (layer ? 0 : NB * NE);
  const int G = gridDim.x;
  for (int it = blockIdx.x; it < nitems; it += G) {
    if (it < nlat) { const int b = it / NE, e = it % NE; topk_item<8, TOPK_COPY>(p, lds, e, SEQ, CAP_L, b * SEQ, b * CAP_L, erows); }
    else { const int i2 = it - nlat, b = i2 / NE, e = i2 % NE; topk_item<1, TOPK_COPY>(p, lds, e, CTXL, CAP_C, NLAT + b * CTXL, NB * CAP_L + b * CAP_C, erows); }
  }
}
}
#ifndef MOE1_FP8
#define MOE1_FP8 1
#endif
#ifndef MOE0_FP8
#define MOE0_FP8 1
#endif
namespace fr {
using fa::ldsp_t; using fa::u32x4; using fa::cvtpk;
typedef unsigned u32x2 __attribute__((ext_vector_type(2)));
typedef float f32x4 __attribute__((ext_vector_type(4)));
struct V16 { f32x4 v[4]; };
DEVI V16 ldf(const float* r, int lane) { V16 o; const f32x4* q = (const f32x4*)r + lane;
#pragma unroll
  for (int j = 0; j < 4; ++j) o.v[j] = q[64 * j]; return o; }
struct B16 { u32x2 v[4]; };
DEVI B16 ldb_raw(const bf16_t* r, int lane) { B16 o; const u32x2* q = (const u32x2*)r + lane;
#pragma unroll
  for (int j = 0; j < 4; ++j) o.v[j] = q[64 * j]; return o; }
DEVI V16 b2v(const B16& b) { V16 o;
#pragma unroll
  for (int j = 0; j < 4; ++j) { o.v[j][0] = __uint_as_float(b.v[j][0] << 16); o.v[j][1] = __uint_as_float(b.v[j][0] & 0xffff0000u); o.v[j][2] = __uint_as_float(b.v[j][1] << 16); o.v[j][3] = __uint_as_float(b.v[j][1] & 0xffff0000u); }
  return o; }
DEVI void stf(float* r, int lane, const V16& o) { f32x4* q = (f32x4*)r + lane;
#pragma unroll
  for (int j = 0; j < 4; ++j) q[64 * j] = o.v[j]; }
DEVI void stb(bf16_t* r, int lane, const V16& o) { u32x2* q = (u32x2*)r + lane;
#pragma unroll
  for (int j = 0; j < 4; ++j) { u32x2 w; w[0] = cvtpk(o.v[j][0], o.v[j][1]); w[1] = cvtpk(o.v[j][2], o.v[j][3]); q[64 * j] = w; } }
DEVI float sumsq(const V16& o) { f32x4 s = o.v[0] * o.v[0];
#pragma unroll
  for (int j = 1; j < 4; ++j) s += o.v[j] * o.v[j];
  return wave_sum((s[0] + s[1]) + (s[2] + s[3])); }

DEVI void phase_prenorm0(const Params& p) {
  const int lane = ftid() & 63, gw = blockIdx.x * NWAVE + (ftid() >> 6), NGW = gridDim.x * NWAVE;
  const float* MOD = (const float*)(p.ws + WS_CTL + CTL_MOD); bf16_t* H = (bf16_t*)(p.ws + WS_H);
  const int rpw = (NROW + NGW - 1) / NGW;
  const int r0 = gw * rpw, r1 = min(r0 + rpw, NROW);
  if (r0 >= r1) return;
  const V16 g = ldf(p.in[L0_GPREMIX], lane);
  int cur = -1; V16 gs, sh;
  auto src = [&](int r) { return r < NLAT ? p.in[I_X] + (size_t)r * DM : p.in[I_CTX] + (size_t)(r - NLAT) * DM; };
  V16 xn = ldf(src(r0), lane), xn2 = xn;
  if (r0 + 1 < r1) xn2 = ldf(src(r0 + 1), lane);
  for (int r = r0; r < r1; ++r) {
    const V16 x = xn; xn = xn2; if (r + 2 < r1) xn2 = ldf(src(r + 2), lane);
    const int mr = row_modrow(r);
    if (mr != cur) { cur = mr; const float* m = MOD + (size_t)mr * 6144; const V16 sc = ldf(m + 1024, lane); sh = ldf(m, lane);
#pragma unroll
      for (int j = 0; j < 4; ++j) gs.v[j] = g.v[j] * (sc.v[j] + 1.f); }
    const float rr = rsqrtf(sumsq(x) * (1.f / DM) + EPS);
    V16 h;
#pragma unroll
    for (int j = 0; j < 4; ++j) h.v[j] = x.v[j] * rr * gs.v[j] + sh.v[j];
    if (QKV0_FP8) {
      unsigned* q8 = (unsigned*)((unsigned char*)H + (size_t)r * DM) + lane;
#pragma unroll
      for (int j = 0; j < 4; ++j) q8[64 * j] = nv::pack4_fp8(h.v[j][0] * nv::A8_SCALE, h.v[j][1] * nv::A8_SCALE, h.v[j][2] * nv::A8_SCALE, h.v[j][3] * nv::A8_SCALE);
    } else stb(H + (size_t)r * DM, lane, h);
  }
}

template <int ABL = 0> DEVI void phase_postmix(const Params& p, ldsp_t lds, int layer) {
  const int tid = ftid(), lane = tid & 63, gw = blockIdx.x * NWAVE + (tid >> 6), NGW = gridDim.x * NWAVE;
  const float* MOD = (const float*)(p.ws + WS_CTL + CTL_MOD) + (size_t)layer * 9 * 6144;
  const bf16_t* MIX = (const bf16_t*)(p.ws + (layer ? WS_MIX1 : WS_MIX0));
  bf16_t* H = (bf16_t*)(p.ws + WS_H); float* AFFT = (float*)(p.ws + WS_AFF); float* XC = (float*)(p.ws + WS_XC);
  const float* wr = p.in[layer ? L1_WROUTER : L0_WROUTER];
  FA_LAS f32x4* WL = (FA_LAS f32x4*)lds;
  for (int i = tid; i < 1024 * 4; i += NT) { const int k = i >> 2, e4 = i & 3; const int ln = (k & 255) >> 2, q = k & 3, j = k >> 8;
    WL[((j * 4 + q) * 4 + e4) * 64 + ln] = *(const f32x4*)(wr + (size_t)k * 16 + e4 * 4); }
  __syncthreads();
  const int nrow = layer ? NLAT : NROW;
  const int rpw = (nrow + NGW - 1) / NGW;
  const int r0 = gw * rpw, r1 = min(r0 + rpw, nrow);
  if (r0 >= r1) return;
  const V16 gpost = ldf(p.in[layer ? L1_GPOSTMIX : L0_GPOSTMIX], lane), gpre = ldf(p.in[layer ? L1_GPREFFN : L0_GPREFFN], lane);
  int cur = -1; V16 gg, gs, sh;
  auto xsrc = [&](int r) { return layer ? (const float*)(p.out + (size_t)r * DM) : (r < NLAT ? p.in[I_X] + (size_t)r * DM : p.in[I_CTX] + (size_t)(r - NLAT) * DM); };
  B16 mn = ldb_raw(MIX + (size_t)r0 * DM, lane); V16 xn = ldf(xsrc(r0), lane);
  B16 mn2 = mn; V16 xn2 = xn;
  if (r0 + 1 < r1) { mn2 = ldb_raw(MIX + (size_t)(r0 + 1) * DM, lane); xn2 = ldf(xsrc(r0 + 1), lane); }
  for (int r = r0; r < r1; ++r) {
    const B16 mb = mn; const V16 x = xn;
    mn = mn2; xn = xn2;
    if (r + 2 < r1) { mn2 = ldb_raw(MIX + (size_t)(r + 2) * DM, lane); xn2 = ldf(xsrc(r + 2), lane); }
    const int mr = row_modrow(r);
    if (mr != cur) { cur = mr; const float* m = MOD + (size_t)mr * 6144; const V16 gt = ldf(m + 2048, lane), sc = ldf(m + 4096, lane); sh = ldf(m + 3072, lane);
#pragma unroll
      for (int j = 0; j < 4; ++j) { gg.v[j] = gt.v[j] * gpost.v[j]; gs.v[j] = gpre.v[j] * (sc.v[j] + 1.f); } }
    V16 o = b2v(mb);
    const float rr = rsqrtf(sumsq(o) * (1.f / DM) + EPS);
#pragma unroll
    for (int j = 0; j < 4; ++j) o.v[j] = x.v[j] + gg.v[j] * (o.v[j] * rr);
    stf(r < NLAT ? p.out + (size_t)r * DM : XC + (size_t)(r - NLAT) * DM, lane, o);
    const float r2 = rsqrtf(sumsq(o) * (1.f / DM) + EPS);
    V16 h;
#pragma unroll
    for (int j = 0; j < 4; ++j) h.v[j] = o.v[j] * r2 * gs.v[j] + sh.v[j];
    if ((layer == 1 && MOE1_FP8) || (layer == 0 && MOE0_FP8)) {
      unsigned* q8 = (unsigned*)((unsigned char*)H + (size_t)r * DM) + lane;
#pragma unroll
      for (int j = 0; j < 4; ++j) q8[64 * j] = nv::pack4_fp8(h.v[j][0] * nv::A8_SCALE, h.v[j][1] * nv::A8_SCALE, h.v[j][2] * nv::A8_SCALE, h.v[j][3] * nv::A8_SCALE);
    } else stb(H + (size_t)r * DM, lane, h);
    if (ABL == 1) continue;
    f32x4 lg[4];
    int lo = lane; asm volatile("" : "+v"(lo));
#pragma unroll
    for (int e4 = 0; e4 < 4; ++e4) lg[e4] = (f32x4){0.f, 0.f, 0.f, 0.f};
#pragma unroll
    for (int j = 0; j < 4; ++j)
#pragma unroll
      for (int q = 0; q < 4; ++q) { const float hv = h.v[j][q];
#pragma unroll
        for (int e4 = 0; e4 < 4; ++e4) lg[e4] += WL[((j * 4 + q) * 4 + e4) * 64 + lo] * hv; }
    float l16[16]; float mx = -INFINITY;
#pragma unroll
    for (int e = 0; e < 16; ++e) { l16[e] = wave_sum(lg[e >> 2][e & 3]); mx = fmaxf(mx, l16[e]); }
    float s = 0.f;
#pragma unroll
    for (int e = 0; e < 16; ++e) { l16[e] = expf(l16[e] - mx); s += l16[e]; }
    const float inv = 1.f / s; float mine = 0.f;
#pragma unroll
    for (int e = 0; e < 16; ++e) if (lane == e) mine = l16[e] * inv;
    if (lane < 16) AFFT[(size_t)lane * NROW + r] = mine;
  }
}

DEVI void phase_combine(const Params& p, int layer) {
  const int tid = ftid(), lane = tid & 63, gw = blockIdx.x * NWAVE + (tid >> 6), NGW = gridDim.x * NWAVE;
  const float* MOD = (const float*)(p.ws + WS_CTL + CTL_MOD);
  const bf16_t* Y = (const bf16_t*)(p.ws + WS_Y); const int* SLOT = (const int*)(p.ws + WS_SLOT); const float* GV = (const float*)(p.ws + WS_GATEV);
  bf16_t* H = (bf16_t*)(p.ws + WS_H); float* XC = (float*)(p.ws + WS_XC);
  const int nrow = layer ? NLAT : NROW, erows = layer ? EROWS1 : EROWS0;
  const int rpw = (nrow + NGW - 1) / NGW;
  const int r0 = gw * rpw, r1 = min(r0 + rpw, nrow);
  if (r0 >= r1) return;
  const V16 gpost = ldf(p.in[layer ? L1_GPOSTFFN : L0_GPOSTFFN], lane);
  V16 g1; if (layer == 0) g1 = ldf(p.in[L1_GPREMIX], lane);
  int cur = -1; V16 gg, gs, sh;
  int sn = (lane < 16) ? SLOT[(size_t)r0 * 16 + lane] : -1;
  for (int r = r0; r < r1; ++r) {
    const int sl = sn; if (r + 1 < r1) sn = (lane < 16) ? SLOT[(size_t)(r + 1) * 16 + lane] : -1;
    float* xio = r < NLAT ? p.out + (size_t)r * DM : XC + (size_t)(r - NLAT) * DM;
    const V16 x = ldf(xio, lane);
    const int mr = row_modrow(r);
    if (mr != cur) { cur = mr; const float* m = MOD + (size_t)(layer * 9 + mr) * 6144; const V16 gt = ldf(m + 5120, lane);
#pragma unroll
      for (int j = 0; j < 4; ++j) gg.v[j] = gt.v[j] * gpost.v[j];
      if (layer == 0) { const float* m1 = MOD + (size_t)(9 + mr) * 6144; const V16 sc = ldf(m1 + 1024, lane); sh = ldf(m1, lane);
#pragma unroll
        for (int j = 0; j < 4; ++j) gs.v[j] = g1.v[j] * (sc.v[j] + 1.f); } }
    V16 o;
#pragma unroll
    for (int j = 0; j < 4; ++j) o.v[j] = (f32x4){0.f, 0.f, 0.f, 0.f};
    unsigned long long mask = __ballot(sl >= 0);
    while (mask) {
      const int e = __builtin_ctzll(mask); mask &= mask - 1;
      const int s = __shfl(sl, e);
      const float gate = GV[e * erows + s];
      const V16 y = b2v(ldb_raw(Y + ((size_t)e * erows + s) * DM, lane));
#pragma unroll
      for (int j = 0; j < 4; ++j) o.v[j] += y.v[j] * gate;
    }
    const float rr = rsqrtf(sumsq(o) * (1.f / DM) + EPS);
#pragma unroll
    for (int j = 0; j < 4; ++j) o.v[j] = x.v[j] + gg.v[j] * (o.v[j] * rr);
    stf(xio, lane, o);
    if (layer == 0) {
      const float r2 = rsqrtf(sumsq(o) * (1.f / DM) + EPS);
      V16 h;
#pragma unroll
      for (int j = 0; j < 4; ++j) h.v[j] = o.v[j] * r2 * gs.v[j] + sh.v[j];
      if (QKV1_FP8) {
        unsigned* q8 = (unsigned*)((unsigned char*)H + (size_t)r * DM) + lane;
#pragma unroll
        for (int j = 0; j < 4; ++j) q8[64 * j] = nv::pack4_fp8(h.v[j][0] * nv::A8_SCALE, h.v[j][1] * nv::A8_SCALE, h.v[j][2] * nv::A8_SCALE, h.v[j][3] * nv::A8_SCALE);
      } else stb(H + (size_t)r * DM, lane, h);
    }
  }
}
}
#define LAS __attribute__((address_space(3)))
#define XB_TMO      128
#define XB_XCNT(j)  (256  + 64 * (j))
#define XB_XSUB(j)  (1280 + 64 * (j))
#define XB_XGEN(j)  (2304 + 64 * (j))
#define XB_TOP      3328
#define XB_TOPGEN   3392
#define XCD_BAR_WORDS 3456
#define XB_SPIN_CAP (1u << 18)

__device__ __forceinline__ unsigned xb_ld(unsigned* p)              { return __hip_atomic_load(p, __ATOMIC_RELAXED, __HIP_MEMORY_SCOPE_AGENT); }
__device__ __forceinline__ unsigned xb_add(unsigned* p, unsigned v) { return __hip_atomic_fetch_add(p, v, __ATOMIC_RELAXED, __HIP_MEMORY_SCOPE_AGENT); }
__device__ __forceinline__ unsigned xb_xcc_id() { return (unsigned)__builtin_amdgcn_s_getreg((3 << 11) | 20) & 0xFu; }
#define XB_SPIN(cond, bar) do { unsigned _sp = 0; while (cond) { __builtin_amdgcn_s_sleep(1); \
    if ((++_sp & 255u) == 0u) { if (xb_ld(&(bar)[XB_TMO])) break; if (_sp > XB_SPIN_CAP) { atomicAdd(&(bar)[XB_TMO], 1u); break; } } } } while (0)

struct XcdBarrier {
    unsigned* bar; unsigned x;
    volatile LAS unsigned* st;
};

__device__ __forceinline__ XcdBarrier xcd_barrier_post(unsigned* bar, volatile LAS unsigned* st) {
    XcdBarrier b; b.bar = bar; b.x = xb_xcc_id(); b.st = st;
    if (threadIdx.x == 0) (void)xb_add(&bar[XB_XCNT(b.x)], 1u);
    return b;
}
__device__ __forceinline__ void xcd_barrier_complete(unsigned* bar, unsigned x, unsigned& nloc, unsigned& nx) {
    const unsigned G = gridDim.x * gridDim.y * gridDim.z;
    unsigned sum, cnt, mine, sp = 0u;
    for (;;) {
        sum = 0u; cnt = 0u; mine = 0u;
#pragma unroll
        for (unsigned j = 0; j < 16; ++j) { const unsigned c = xb_ld(&bar[XB_XCNT(j)]); sum += c; cnt += (c > 0u) ? 1u : 0u; mine = (j == x) ? c : mine; }
        if (sum == G) break;
        __builtin_amdgcn_s_sleep(1);
        if ((++sp & 255u) == 0u) { if (xb_ld(&bar[XB_TMO])) break; if (sp > XB_SPIN_CAP) { atomicAdd(&bar[XB_TMO], 1u); break; } }
    }
    nloc = mine > 0u ? mine : 1u; nx = cnt > 0u ? cnt : 1u;
}

__device__ __forceinline__ void xcd_barrier(const XcdBarrier& b) {
    asm volatile("s_waitcnt vmcnt(0)" ::: "memory");
    __syncthreads();
    if (threadIdx.x == 0) {
        unsigned* bar = b.bar;
        __builtin_amdgcn_s_waitcnt(0);
        unsigned nloc = b.st[0], nx = b.st[1];
        if (nloc == 0u) { xcd_barrier_complete(bar, b.x, nloc, nx); b.st[0] = nloc; b.st[1] = nx; }
        const unsigned old = xb_add(&bar[XB_XSUB(b.x)], 1u);
        const unsigned gen = old / nloc;
        if (old + 1u == (gen + 1u) * nloc) {
            __builtin_amdgcn_fence(__ATOMIC_RELEASE, "agent");
            asm volatile("s_waitcnt vmcnt(0)" ::: "memory");
            const unsigned og = xb_add(&bar[XB_TOP], 1u);
            const unsigned tg = og / nx;
            if (og + 1u == (tg + 1u) * nx) xb_add(&bar[XB_TOPGEN], 1u);
            else XB_SPIN(xb_ld(&bar[XB_TOPGEN]) == tg, bar);
            __builtin_amdgcn_fence(__ATOMIC_ACQUIRE, "agent");
            xb_add(&bar[XB_XGEN(b.x)], 1u);
            asm volatile("s_waitcnt vmcnt(0)" ::: "memory");
        } else {
            XB_SPIN(xb_ld(&bar[XB_XGEN(b.x)]) == gen, bar);
            __builtin_amdgcn_fence(__ATOMIC_ACQUIRE, "agent");
            asm volatile("s_waitcnt vmcnt(0)" ::: "memory");
        }
    }
    __syncthreads();
}


__device__ __forceinline__ void flat_barrier(unsigned* ctr, unsigned& epoch) {
    asm volatile("s_waitcnt vmcnt(0)" ::: "memory");
    __syncthreads();
    if (threadIdx.x == 0) {
        __builtin_amdgcn_fence(__ATOMIC_RELEASE, "agent");
        asm volatile("s_waitcnt vmcnt(0)" ::: "memory");
        (void)__hip_atomic_fetch_add(ctr, 1u, __ATOMIC_RELAXED, __HIP_MEMORY_SCOPE_AGENT);
        const unsigned target = (epoch + 1u) * (unsigned)gridDim.x; unsigned sp = 0;
        while (__hip_atomic_load(ctr, __ATOMIC_RELAXED, __HIP_MEMORY_SCOPE_AGENT) < target) { __builtin_amdgcn_s_sleep(1); if (++sp > (1u << 22)) break; }
        __builtin_amdgcn_fence(__ATOMIC_ACQUIRE, "agent");
        asm volatile("s_waitcnt vmcnt(0)" ::: "memory");
    }
    ++epoch;
    __syncthreads();
}
constexpr int LDS_BYTES = 147456;
#define TAILFILL 1
#ifndef FAST_GEMM
#define FAST_GEMM 1
#endif
#ifndef FAST_TOPK
#define FAST_TOPK 1
#endif
#ifndef FAST_SSD
#define FAST_SSD 1
#endif
#ifndef FAST_ATTN
#define FAST_ATTN 1
#endif
__global__ void __launch_bounds__(NT) mega(Params p) {
  extern __shared__ __attribute__((aligned(16))) unsigned char lds_raw[];
  float* lds = (float*)lds_raw;
  fg::ldsp_t ldsp = (fg::ldsp_t)lds_raw;
  cg::grid_group grid = cg::this_grid();
  volatile LAS unsigned* bst = (volatile LAS unsigned*)((LAS unsigned char*)lds_raw + (LDS_BYTES - 64));
  if (threadIdx.x < 2) bst[threadIdx.x] = 0u;
  unsigned* barw = (unsigned*)(p.ws + WS_CTL + CTL_BAR);
  if (blockIdx.x == 0) for (int i = threadIdx.x; i < XCD_BAR_WORDS; i += NT) barw[i] = 0u;
  XcdBarrier xbar; xbar.bar = barw; xbar.x = 0; xbar.st = bst;
#ifdef FLATBAR
  unsigned fb_epoch = 0; unsigned* fb_ctr = barw + XCD_BAR_WORDS - 64;
#define GSYNC() flat_barrier(fb_ctr, fb_epoch)
#else
#define GSYNC() xcd_barrier(xbar)
#endif
  nv::phase0(p, lds);                 grid.sync();
  xbar = xcd_barrier_post(barw, bst);
#ifdef DUP_SYNC
  for (int i = 0; i < 20; ++i) GSYNC();
#endif
#ifdef DUP_P0
  nv::phase0(p, lds);                 GSYNC();
#endif
  fr::phase_prenorm0(p);              GSYNC();
#ifdef DUP_PRENORM
  fr::phase_prenorm0(p); GSYNC();
#endif
#if FAST_GEMM
  fg::phase_qkv0(p, ldsp); GSYNC();
#ifdef DUP_QKV0
  fg::phase_qkv0(p, ldsp); GSYNC();
#endif
#else
  nv::phase_qkv0(p, lds);             GSYNC();
#endif
#if FAST_ATTN
  fa::phase_attnA(p, ldsp); fa::phase_attnB(p, ldsp); GSYNC();
#ifdef DUP_A
  fa::phase_attnA<DUP_A>(p, ldsp); GSYNC();
#endif
#ifdef DUP_B
  fa::phase_attnB<DUP_B>(p, ldsp); GSYNC();
#endif
#else
  nv::phase_attn0(p, lds);            GSYNC();
#endif
#if FAST_GEMM
#ifdef TAILFILL
  fg::phase_outproj(p, ldsp, 0); nv::convert_moe_tail8(p, 0, 1, lds, NROW / 256 * (DM / 256)); GSYNC();
#else
  fg::phase_outproj(p, ldsp, 0); GSYNC();
#endif
#ifdef DUP_OUT0
  fg::phase_outproj(p, ldsp, 0); GSYNC();
#endif
#else
  nv::phase_outproj(p, lds, 0);       GSYNC();
#endif
  fr::phase_postmix(p, ldsp, 0);            GSYNC();
#ifdef DUP_POSTMIX0
  fr::phase_postmix<DUP_POSTMIX0>(p, ldsp, 0); GSYNC();
#endif
#if FAST_TOPK
  ft::phase_topk(p, ldsp, 0);         GSYNC();
#ifdef DUP_TOPK0
  ft::phase_topk(p, ldsp, 0);         GSYNC();
#endif
#else
  nv::phase_topk(p, lds, 0);          GSYNC();
  fg::phase_gather(p, 0);             GSYNC();
#endif
#if FAST_GEMM
  fg::phase_moe_up8(p, ldsp, 0);      GSYNC();
#ifdef DUP_UP0
  fg::phase_moe_up(p, ldsp, 0); GSYNC();
#endif
  fg::phase_moe_down8(p, ldsp, 0);    GSYNC();
#ifdef DUP_DOWN0
  fg::phase_moe_down(p, ldsp, 0); GSYNC();
#endif
#else
  nv::phase_moe_up(p, lds, 0);        GSYNC();
  nv::phase_moe_down(p, lds, 0);      GSYNC();
#endif
#ifdef TAILFILL
  fr::phase_combine(p, 0); GSYNC();
#else
  fr::phase_combine(p, 0); nv::convert_moe_tail(p, 1, 0, lds, 0); nv::convert_moe_tail(p, 1, 1, lds, 0); GSYNC();
#endif
#if FAST_GEMM
#ifdef TAILFILL
  fg::phase_qkv1(p, ldsp); nv::convert_moe_tail8(p, 1, 0, lds, NROW / 256 * (N_IN1P / 256)); GSYNC();
#else
  fg::phase_qkv1(p, ldsp); GSYNC();
#endif
#else
  nv::phase_qkv1(p, lds);             GSYNC();
#endif
#if FAST_ATTN
#if FAST_SSD
#ifdef TAILFILL
  fs::phase_conv(p); nv::convert_moe_tail8(p, 1, 1, lds, 0); GSYNC();
#else
  fs::phase_conv(p); GSYNC();
#endif
#else
  nv::phase_conv_swa(p, lds, true); GSYNC();
#endif
#else
  nv::phase_conv_swa(p, lds, true);   GSYNC();
#endif
#if FAST_SSD
  fs::phase_ssd(p, ldsp); fa::phase_attnC(p, ldsp, (int*)(p.ws + WS_CTL + CTL_QC)); GSYNC();
#ifdef DUP_SSD
  fs::phase_ssd<DUP_SSD>(p, ldsp);             GSYNC();
#endif
  fs::phase_ssd_out(p);               GSYNC();
#else
  nv::phase_ssd(p, lds);              GSYNC();
  nv::phase_ssd_out(p);               GSYNC();
#endif
#if FAST_GEMM
  fg::phase_outproj(p, ldsp, 1);      GSYNC();
#else
  nv::phase_outproj(p, lds, 1);       GSYNC();
#endif
  fr::phase_postmix(p, ldsp, 1);            GSYNC();
#if FAST_TOPK
  ft::phase_topk(p, ldsp, 1);         GSYNC();
#ifdef DUP_TOPK1
  ft::phase_topk(p, ldsp, 1);         GSYNC();
#endif
#else
  nv::phase_topk(p, lds, 1);          GSYNC();
  fg::phase_gather(p, 1);             GSYNC();
#endif
#if FAST_GEMM
  fg::phase_moe_up8(p, ldsp, 1);      GSYNC();
  fg::phase_moe_down8(p, ldsp, 1);    GSYNC();
#else
  nv::phase_moe_up(p, lds, 1);        GSYNC();
  nv::phase_moe_down(p, lds, 1);      GSYNC();
#endif
  fr::phase_combine(p, 1);
}


extern "C" void kernel_launch(void* const* d_in, const int* in_sizes, int n_in, void* d_out, int out_size,
                              void* d_ws, size_t ws_size, hipStream_t stream) {
  static int grid_blocks = 0;
  if (!grid_blocks) {
    int dev = 0, cus = 0, per_cu = 0;
    (void)hipGetDevice(&dev);
    (void)hipDeviceGetAttribute(&cus, hipDeviceAttributeMultiprocessorCount, dev);
    (void)hipFuncSetAttribute((const void*)mega, hipFuncAttributeMaxDynamicSharedMemorySize, LDS_BYTES);
    (void)hipOccupancyMaxActiveBlocksPerMultiprocessor(&per_cu, (const void*)mega, NT, LDS_BYTES);
    if (per_cu < 1) { fprintf(stderr, "kernel_launch: occupancy query says %d blocks/CU\n", per_cu); per_cu = 1; }
    grid_blocks = cus;
    if (n_in != 43 || ws_size < WS_END) fprintf(stderr, "kernel_launch: unexpected n_in %d / ws_size %zu (need %zu)\n", n_in, ws_size, (size_t)WS_END);
  }
  Params p{};
  for (int i = 0; i < 43; ++i) p.in[i] = (const float*)d_in[i];
  p.out = (float*)d_out; p.ws = (unsigned char*)d_ws;
  void* args[] = {&p};
  hipError_t e = hipLaunchCooperativeKernel((void*)mega, dim3(grid_blocks), dim3(NT), args, LDS_BYTES, stream);
  if (e != hipSuccess) fprintf(stderr, "cooperative launch failed: %s (grid %d)\n", hipGetErrorString(e), grid_blocks);
}
```

```cpp
#include <hip/hip_runtime.h>
#include <hip/hip_cooperative_groups.h>
#include <cstdio>
#include <cstdint>
namespace cg = cooperative_groups;

typedef unsigned short bf16_t;
#define DEVI __device__ __forceinline__

constexpr int NT = 512, NWAVE = 8;
constexpr int NB = 8, SEQ = 4096, DM = 1024, CTXL = 256;
constexpr int NLAT = NB * SEQ, NCTX = NB * CTXL, NROW = NLAT + NCTX;
constexpr int NE = 16;
constexpr int CAP_L = 512, CAP_C = 32;
constexpr int EROWS0 = NB * CAP_L + NB * CAP_C;
constexpr int EROWS1 = NB * CAP_L;
constexpr int N_IN0 = 3072, N_IN1 = 2320, N_IN1P = 2560;
constexpr float EPS = 1e-6f;

constexpr size_t MiB = 1u << 20;
constexpr size_t WS_CTL = 0;
constexpr size_t WS_WIN0 = 1 * MiB;
constexpr size_t WS_WIN1 = 7 * MiB;
constexpr size_t WS_WOUT0 = 12 * MiB, WS_WOUT1 = 14 * MiB;
constexpr size_t WS_WGU = 16 * MiB;
constexpr size_t WS_WD = 80 * MiB;
constexpr size_t WS_XC = 112 * MiB;
constexpr size_t WS_H = 120 * MiB;
constexpr size_t WS_AFF = 188 * MiB;
constexpr size_t WS_SLOT = 191 * MiB;
constexpr size_t WS_IDX = 194 * MiB;
constexpr size_t WS_GATEV = 195 * MiB;
constexpr size_t WS_BIG = 196 * MiB;
constexpr size_t WS_QKV0 = WS_BIG;
constexpr size_t WS_ATT0 = WS_BIG + 204 * MiB;
constexpr size_t WS_MIX0 = WS_BIG + 272 * MiB;
constexpr size_t WS_XG = WS_BIG;
constexpr size_t WS_HID = WS_BIG + 136 * MiB;
constexpr size_t WS_Y = WS_BIG;
constexpr size_t WS_P1 = WS_BIG;
constexpr size_t WS_DT = WS_BIG + 153 * MiB;
constexpr size_t WS_U = WS_BIG + 156 * MiB;
constexpr size_t WS_MIX1 = WS_U;
constexpr size_t WS_ATT1 = WS_BIG + 224 * MiB;
constexpr size_t WS_YS = WS_BIG + 292 * MiB;
constexpr size_t WS_CUMG = WS_BIG + 356 * MiB;
constexpr size_t WS_DTG = WS_BIG + 359 * MiB;
constexpr size_t WS_VT = WS_BIG + 340 * MiB;
constexpr size_t WS_END = WS_BIG + 362 * MiB;
constexpr size_t CTL_MOD = 4096;
constexpr size_t CTL_ROPE = CTL_MOD + 2 * 9 * 6144 * 4;
constexpr size_t CTL_LAM = CTL_ROPE + 64 * 16 * 2 * 4;
constexpr size_t CTL_QC = CTL_LAM + 64;
constexpr size_t CTL_BAR = 512 * 1024;

struct Params {
  const float* in[43];
  float* out;
  unsigned char* ws;
};

enum {
  I_X = 0, I_C, I_CTX, I_CCTX,
  L0_WMOD, L0_BMOD, L0_GPREMIX, L0_GPOSTMIX, L0_GPREFFN, L0_GPOSTFFN, L0_WIN, L0_WOUT,
  L0_LAMQ1, L0_LAMK1, L0_LAMQ2, L0_LAMK2, L0_SUBLN, L0_RPB, L0_WROUTER, L0_WGATE, L0_WUP, L0_WDOWN,
  L1_WMOD, L1_BMOD, L1_GPREMIX, L1_GPOSTMIX, L1_GPREFFN, L1_GPOSTFFN, L1_WIN, L1_WOUT,
  L1_SINKS, L1_CONVW, L1_CONVB, L1_ALOGF, L1_ALOGB, L1_DTBF, L1_DTBB, L1_DSKIP, L1_GNORM,
  L1_WROUTER, L1_WGATE, L1_WUP, L1_WDOWN
};

DEVI int ftid() { int t = threadIdx.x; asm volatile("" : "+v"(t)); return t; }
DEVI float bf2f(bf16_t v) { return __uint_as_float(((unsigned)v) << 16); }
DEVI bf16_t f2bf(float f) { unsigned u = __float_as_uint(f); return (bf16_t)((u + 0x7fffu + ((u >> 16) & 1u)) >> 16); }
DEVI unsigned pk2(float lo, float hi) { return (unsigned)f2bf(lo) | ((unsigned)f2bf(hi) << 16); }
DEVI float silu_f(float v) { return v / (1.f + __expf(-v)); }
DEVI float wave_sum(float v) {
#pragma unroll
  for (int o = 1; o < 64; o <<= 1) v += __shfl_xor(v, o);
  return v;
}
DEVI float wave_max(float v) {
#pragma unroll
  for (int o = 1; o < 64; o <<= 1) v = fmaxf(v, __shfl_xor(v, o));
  return v;
}
DEVI int row_modrow(int r) { return r < NLAT ? (r >> 12) : 8; }
#ifndef QKV0_FP8
#define QKV0_FP8 1
#endif
#ifndef QKV1_FP8
#define QKV1_FP8 0
#endif
namespace nv {

DEVI void transpose_item(const float* W, int K, int N, bf16_t* WT, int row_off, int row_mul, float* scr, int item, int lane, int Npad) {
  const int nblk = Npad / 32, kb = item / nblk, nb = item % nblk, k0 = 64 * kb, n0 = 32 * nb;
  const int n = n0 + (lane & 31); const bool ok = n < N;
  const float* src = W + (size_t)(k0 + (lane >> 5)) * N + (ok ? n : 0);
  float v[32];
#pragma unroll
  for (int i = 0; i < 32; ++i) v[i] = src[(size_t)(2 * i) * N];
#pragma unroll
  for (int i = 0; i < 32; ++i) scr[(2 * i + (lane >> 5)) * 33 + (lane & 31)] = ok ? v[i] : 0.f;
  __builtin_amdgcn_s_waitcnt(0); __builtin_amdgcn_wave_barrier();
  const int c = lane & 7;
#pragma unroll
  for (int j = 0; j < 4; ++j) {
    const int nn = (lane >> 3) + 8 * j; const float* s = scr + (8 * c) * 33 + nn;
    uint4 o; o.x = pk2(s[0 * 33], s[1 * 33]); o.y = pk2(s[2 * 33], s[3 * 33]); o.z = pk2(s[4 * 33], s[5 * 33]); o.w = pk2(s[6 * 33], s[7 * 33]);
    *(uint4*)(WT + (size_t)(row_off + (n0 + nn) * row_mul) * K + k0 + 8 * c) = o;
  }
  __builtin_amdgcn_s_waitcnt(0); __builtin_amdgcn_wave_barrier();
}

DEVI void convert_moe_part(const Params& p, int layer, int which, float* scr, int gw, int NGW, int lane) {
  const float* wg = p.in[layer ? L1_WGATE : L0_WGATE]; const float* wu = p.in[layer ? L1_WUP : L0_WUP]; const float* wd = p.in[layer ? L1_WDOWN : L0_WDOWN];
  bf16_t* WGU = (bf16_t*)(p.ws + WS_WGU); bf16_t* WD = (bf16_t*)(p.ws + WS_WD);
  constexpr int IPM = 16 * 32;
  if (which == 0) {
    for (int it = gw; it < NE * 2 * IPM; it += NGW) {
      const int e = it / (2 * IPM), r = it % (2 * IPM), gu = r / IPM, item = r % IPM;
      transpose_item((gu ? wu : wg) + (size_t)e * DM * DM, DM, DM, WGU + (size_t)e * 2048 * DM, gu, 2, scr, item, lane, DM);
    }
  } else {
    for (int it = gw; it < NE * IPM; it += NGW) {
      const int e = it / IPM, item = it % IPM;
      transpose_item(wd + (size_t)e * DM * DM, DM, DM, WD + (size_t)e * DM * DM, 0, 1, scr, item, lane, DM);
    }
  }
}
DEVI void convert_moe_tail(const Params& p, int layer, int which, float* lds, int nunits) {
  const int first = nunits % (int)gridDim.x;
  if ((int)blockIdx.x < first) return;
  const int w = ftid() >> 6;
  convert_moe_part(p, layer, which, lds + w * (64 * 33), ((int)blockIdx.x - first) * NWAVE + w, ((int)gridDim.x - first) * NWAVE, ftid() & 63);
}


constexpr float W8_SCALE = 64.f, A8_SCALE = 4.f;
constexpr int W8_E8M0 = 0x79797979, A8_E8M0 = 0x7d7d7d7d;
DEVI unsigned pack4_fp8(float a, float b, float c, float d) {
  a = fminf(fmaxf(a, -448.f), 448.f); b = fminf(fmaxf(b, -448.f), 448.f); c = fminf(fmaxf(c, -448.f), 448.f); d = fminf(fmaxf(d, -448.f), 448.f);
  int w = 0; w = __builtin_amdgcn_cvt_pk_fp8_f32(a, b, w, false); w = __builtin_amdgcn_cvt_pk_fp8_f32(c, d, w, true); return (unsigned)w; }
DEVI void transpose_item8(const float* W, int K, int N, unsigned char* WT, int row_off, int row_mul, float* scr, int item, int lane, int Npad = 0) {
  if (Npad == 0) Npad = N;
  const int nblk = Npad / 32, kb = item / nblk, nb = item % nblk, k0 = 64 * kb, n0 = 32 * nb;
  const int nn0 = n0 + (lane & 31); const bool ok = nn0 < N;
  const float* src = W + (size_t)(k0 + (lane >> 5)) * N + (ok ? nn0 : 0);
  float v[32];
#pragma unroll
  for (int i = 0; i < 32; ++i) v[i] = src[(size_t)(2 * i) * N];
#pragma unroll
  for (int i = 0; i < 32; ++i) scr[(2 * i + (lane >> 5)) * 33 + (lane & 31)] = ok ? v[i] * W8_SCALE : 0.f;
  __builtin_amdgcn_s_waitcnt(0); __builtin_amdgcn_wave_barrier();
  const int c = lane & 7;
#pragma unroll
  for (int j = 0; j < 4; ++j) {
    const int nn = (lane >> 3) + 8 * j; const float* s = scr + (8 * c) * 33 + nn;
    uint2 o; o.x = pack4_fp8(s[0 * 33], s[1 * 33], s[2 * 33], s[3 * 33]); o.y = pack4_fp8(s[4 * 33], s[5 * 33], s[6 * 33], s[7 * 33]);
    *(uint2*)(WT + (size_t)(row_off + (n0 + nn) * row_mul) * K + k0 + 8 * c) = o;
  }
  __builtin_amdgcn_s_waitcnt(0); __builtin_amdgcn_wave_barrier();
}
DEVI void convert_moe_part8(const Params& p, int layer, int which, float* scr, int gw, int NGW, int lane) {
  const float* wg = p.in[layer ? L1_WGATE : L0_WGATE]; const float* wu = p.in[layer ? L1_WUP : L0_WUP]; const float* wd = p.in[layer ? L1_WDOWN : L0_WDOWN];
  unsigned char* WGU = (unsigned char*)(p.ws + WS_WGU); unsigned char* WD = (unsigned char*)(p.ws + WS_WD);
  constexpr int IPM = 16 * 32;
  if (which == 0) {
    for (int it = gw; it < NE * 2 * IPM; it += NGW) { const int e = it / (2 * IPM), r = it % (2 * IPM), gu = r / IPM, item = r % IPM;
      transpose_item8((gu ? wu : wg) + (size_t)e * DM * DM, DM, DM, WGU + (size_t)e * 2048 * DM, gu, 2, scr, item, lane); }
  } else {
    for (int it = gw; it < NE * IPM; it += NGW) { const int e = it / IPM, item = it % IPM;
      transpose_item8(wd + (size_t)e * DM * DM, DM, DM, WD + (size_t)e * DM * DM, 0, 1, scr, item, lane); }
  }
}
DEVI void convert_moe_tail8(const Params& p, int layer, int which, float* lds, int nunits) {
  const int first = nunits % (int)gridDim.x;
  if ((int)blockIdx.x < first) return;
  const int w = ftid() >> 6;
  convert_moe_part8(p, layer, which, lds + w * (64 * 33), ((int)blockIdx.x - first) * NWAVE + w, ((int)gridDim.x - first) * NWAVE, ftid() & 63);
}

DEVI void phase0(const Params& p, float* lds) {
  const int tid = ftid(), lane = tid & 63, wave = tid >> 6;
  const int gw = blockIdx.x * NWAVE + wave, NGW = gridDim.x * NWAVE;
  for (int it = blockIdx.x; it < 2 * 96; it += gridDim.x) {
    const int layer = it / 96, j0 = (it % 96) * 64;
    float* sc = lds;
    float* red = lds + 9 * 1024;
    __syncthreads();
    for (int i = tid; i < 9 * 1024; i += NT) { const int r = i >> 10, k = i & 1023; const float v = (r < 8) ? p.in[I_C][r * 1024 + k] : p.in[I_CCTX][k]; sc[i] = silu_f(v); }
    __syncthreads();
    const float* wm = p.in[layer ? L1_WMOD : L0_WMOD];
    float acc[9];
#pragma unroll
    for (int r = 0; r < 9; ++r) acc[r] = 0.f;
    for (int k0 = wave * 128; k0 < wave * 128 + 128; k0 += 16) {
      float w[16];
#pragma unroll
      for (int i = 0; i < 16; ++i) w[i] = wm[(size_t)(k0 + i) * 6144 + j0 + lane];
#pragma unroll
      for (int i = 0; i < 16; ++i)
#pragma unroll
        for (int r = 0; r < 9; ++r) acc[r] += sc[r * 1024 + k0 + i] * w[i];
    }
#pragma unroll
    for (int r = 0; r < 9; ++r) red[(wave * 9 + r) * 64 + lane] = acc[r];
    __syncthreads();
    for (int i = tid; i < 9 * 64; i += NT) {
      const int r = i >> 6, c = i & 63; float s = 0.f;
      for (int w = 0; w < 8; ++w) s += red[(w * 9 + r) * 64 + c];
      float* MOD = (float*)(p.ws + WS_CTL + CTL_MOD);
      MOD[(layer * 9 + r) * 6144 + j0 + c] = s + p.in[layer ? L1_BMOD : L0_BMOD][j0 + c];
    }
    __syncthreads();
  }
  if (blockIdx.x == gridDim.x - 1) {
    float* ROPE = (float*)(p.ws + WS_CTL + CTL_ROPE);
    for (int i = tid; i < 64 * 16; i += NT) {
      const int pos = i >> 4, f = i & 15;
      const float inv = powf(10000.f, -(float)f / 16.f);
      const float ang = (float)pos * inv;
      ROPE[2 * i] = cosf(ang); ROPE[2 * i + 1] = sinf(ang);
    }
    if (wave == 0) {
      float a = p.in[L0_LAMQ1][lane] * p.in[L0_LAMK1][lane], b = p.in[L0_LAMQ2][lane] * p.in[L0_LAMK2][lane];
      a = wave_sum(a); b = wave_sum(b);
      if (lane == 0) { float* LAM = (float*)(p.ws + WS_CTL + CTL_LAM); LAM[0] = expf(a) - expf(b) + 0.2f; *(int*)(p.ws + WS_CTL + CTL_QC) = 0; }
    }
  }
  __syncthreads();
  float* scr = lds + wave * (64 * 33);
  {
    constexpr int I_IN0 = 16 * (N_IN0 / 32), I_OUT = 16 * 32, I_IN1 = 16 * (N_IN1P / 32);
    constexpr int NITEMS = I_IN0 + I_OUT + I_IN1 + I_OUT;
    for (int it = gw; it < NITEMS; it += NGW) {
      int r = it;
      if (r < I_IN0) { if (QKV0_FP8) transpose_item8(p.in[L0_WIN], DM, N_IN0, (unsigned char*)(p.ws + WS_WIN0), 0, 1, scr, r, lane); else transpose_item(p.in[L0_WIN], DM, N_IN0, (bf16_t*)(p.ws + WS_WIN0), 0, 1, scr, r, lane, N_IN0); continue; } r -= I_IN0;
      if (r < I_OUT) { transpose_item(p.in[L0_WOUT], DM, DM, (bf16_t*)(p.ws + WS_WOUT0), 0, 1, scr, r, lane, DM); continue; } r -= I_OUT;
      if (r < I_IN1) { if (QKV1_FP8) transpose_item8(p.in[L1_WIN], DM, N_IN1, (unsigned char*)(p.ws + WS_WIN1), 0, 1, scr, r, lane, N_IN1P); else transpose_item(p.in[L1_WIN], DM, N_IN1, (bf16_t*)(p.ws + WS_WIN1), 0, 1, scr, r, lane, N_IN1P); continue; } r -= I_IN1;
      transpose_item(p.in[L1_WOUT], DM, DM, (bf16_t*)(p.ws + WS_WOUT1), 0, 1, scr, r, lane, DM);
    }
  }
  convert_moe_part8(p, 0, 0, scr, gw, NGW, lane);
#ifndef TAILFILL
  convert_moe_part8(p, 0, 1, scr, gw, NGW, lane);
#endif
}

struct Row16 { float4 v[4]; };
DEVI Row16 ld_row_f32(const float* r, int lane) { Row16 o; const float4* q = (const float4*)r + lane;
#pragma unroll
  for (int j = 0; j < 4; ++j) o.v[j] = q[64 * j]; return o; }
DEVI Row16 ld_row_bf16(const bf16_t* r, int lane) { Row16 o; const uint2* q = (const uint2*)r + lane;
#pragma unroll
  for (int j = 0; j < 4; ++j) { const uint2 w = q[64 * j]; o.v[j] = make_float4(__uint_as_float(w.x << 16), __uint_as_float(w.x & 0xffff0000u), __uint_as_float(w.y << 16), __uint_as_float(w.y & 0xffff0000u)); }
  return o; }
DEVI void st_row_f32(float* r, int lane, const Row16& o) { float4* q = (float4*)r + lane;
#pragma unroll
  for (int j = 0; j < 4; ++j) q[64 * j] = o.v[j]; }
DEVI void st_row_bf16(bf16_t* r, int lane, const Row16& o) { uint2* q = (uint2*)r + lane;
#pragma unroll
  for (int j = 0; j < 4; ++j) q[64 * j] = make_uint2(pk2(o.v[j].x, o.v[j].y), pk2(o.v[j].z, o.v[j].w)); }
DEVI float row_sumsq(const Row16& o) { float s = 0.f;
#pragma unroll
  for (int j = 0; j < 4; ++j) s += o.v[j].x * o.v[j].x + o.v[j].y * o.v[j].y + o.v[j].z * o.v[j].z + o.v[j].w * o.v[j].w;
  return wave_sum(s); }
#define ROW_FOR4(expr) _Pragma("unroll") for (int j = 0; j < 4; ++j) { { float& e = o.v[j].x; const float a = A.v[j].x, b = Bv.v[j].x, c = Cv.v[j].x; expr; } { float& e = o.v[j].y; const float a = A.v[j].y, b = Bv.v[j].y, c = Cv.v[j].y; expr; } { float& e = o.v[j].z; const float a = A.v[j].z, b = Bv.v[j].z, c = Cv.v[j].z; expr; } { float& e = o.v[j].w; const float a = A.v[j].w, b = Bv.v[j].w, c = Cv.v[j].w; expr; } }

DEVI Row16 norm_mod(const Row16& x, const float* g, const float* sc, const float* sh, int lane) {
  const float r = rsqrtf(row_sumsq(x) * (1.f / DM) + EPS);
  Row16 o = x; const Row16 A = ld_row_f32(g, lane), Bv = ld_row_f32(sc, lane), Cv = ld_row_f32(sh, lane);
  ROW_FOR4(e = e * r * a * (1.f + b) + c);
  return o;
}

DEVI void phase_prenorm0(const Params& p) {
  const int lane = ftid() & 63, gw = blockIdx.x * NWAVE + (ftid() >> 6), NGW = gridDim.x * NWAVE;
  const float* MOD = (const float*)(p.ws + WS_CTL + CTL_MOD);
  bf16_t* H = (bf16_t*)(p.ws + WS_H);
  for (int r = gw; r < NROW; r += NGW) {
    const float* src = r < NLAT ? p.in[I_X] + (size_t)r * DM : p.in[I_CTX] + (size_t)(r - NLAT) * DM;
    const float* m = MOD + (size_t)row_modrow(r) * 6144;
    const Row16 x = ld_row_f32(src, lane);
    const Row16 h = norm_mod(x, p.in[L0_GPREMIX], m + 1024, m, lane);
    st_row_bf16(H + (size_t)r * DM, lane, h);
  }
}

template <class AF, class EF>
DEVI void gemm_tile(float* lds, const bf16_t* Bt, int n0, int K, AF arow, EF epi) {
  const int tid = ftid(), ty = tid >> 4, tx = tid & 15;
  float (*As)[132] = (float (*)[132])lds;
  float (*Bs)[68] = (float (*)[68])(lds + 16 * 132);
  float acc[4][4];
#pragma unroll
  for (int i = 0; i < 4; ++i)
#pragma unroll
    for (int j = 0; j < 4; ++j) acc[i][j] = 0.f;
  const int ar = tid >> 2, ak = (tid & 3) * 4;
  const int br = tid >> 3, bk = (tid & 7) * 2;
  const bf16_t* ap = arow(ar) + ak;
  const bf16_t* bp = Bt + (size_t)(n0 + br) * K + bk;
  for (int k0 = 0; k0 < K; k0 += 16) {
    const uint2 av = *(const uint2*)(ap + k0);
    const unsigned bv = *(const unsigned*)(bp + k0);
    __syncthreads();
    As[ak + 0][ar] = __uint_as_float(av.x << 16); As[ak + 1][ar] = __uint_as_float(av.x & 0xffff0000u);
    As[ak + 2][ar] = __uint_as_float(av.y << 16); As[ak + 3][ar] = __uint_as_float(av.y & 0xffff0000u);
    Bs[bk + 0][br] = __uint_as_float(bv << 16); Bs[bk + 1][br] = __uint_as_float(bv & 0xffff0000u);
    __syncthreads();
#pragma unroll
    for (int kk = 0; kk < 16; ++kk) {
      const float4 a = *(const float4*)&As[kk][ty * 4]; const float4 b = *(const float4*)&Bs[kk][tx * 4];
      const float aa[4] = {a.x, a.y, a.z, a.w}, bb[4] = {b.x, b.y, b.z, b.w};
#pragma unroll
      for (int i = 0; i < 4; ++i)
#pragma unroll
        for (int j = 0; j < 4; ++j) acc[i][j] += aa[i] * bb[j];
    }
  }
#pragma unroll
  for (int i = 0; i < 4; ++i) epi(ty * 4 + i, n0 + tx * 4, acc[i]);
}

DEVI void rope_pair(const float* ROPE, int t, int d, float& u1, float& u2) {
  const int i = d >> 1, f = i & 15, pos = (i < 16) ? (t >> 6) : (t & 63);
  const float cs = ROPE[(pos * 16 + f) * 2], sn = ROPE[(pos * 16 + f) * 2 + 1];
  const float a = u1 * cs - u2 * sn, b = u1 * sn + u2 * cs; u1 = a; u2 = b;
}

DEVI void phase_qkv0(const Params& p, float* lds) {
  const bf16_t* H = (const bf16_t*)(p.ws + WS_H); const bf16_t* W = (const bf16_t*)(p.ws + WS_WIN0);
  bf16_t* Q = (bf16_t*)(p.ws + WS_QKV0); const float* ROPE = (const float*)(p.ws + WS_CTL + CTL_ROPE);
  constexpr int NTN = N_IN0 / 64, NTM = NROW / 128;
  for (int it = blockIdx.x; it < NTN * NTM; it += gridDim.x) {
    const int mt = it / NTN, nt = it % NTN, m0 = mt * 128;
    gemm_tile(lds, W, nt * 64, DM,
      [&](int r) { return H + (size_t)(m0 + r) * DM; },
      [&](int r, int n, float* v) {
        const int row = m0 + r;
        if (row < NLAT && n < 1024) { const int t = row & 4095; rope_pair(ROPE, t, n & 63, v[0], v[1]); rope_pair(ROPE, t, (n + 2) & 63, v[2], v[3]); }
        *(uint2*)(Q + (size_t)row * N_IN0 + n) = make_uint2(pk2(v[0], v[1]), pk2(v[2], v[3]));
      });
  }
}

template <int NS, int VJ, class KF>
DEVI void wave_attn(const float* qs, float* pl  , int* rl  , int nkeys, KF kf, const bf16_t* KV, int ld, int kcol, int vcol,
                    float sink, bool has_sink, float (&o)[NS][VJ], float (&m)[NS], float (&l)[NS], int lane) {
#pragma unroll
  for (int s = 0; s < NS; ++s) { m[s] = -INFINITY; l[s] = 0.f;
#pragma unroll
    for (int j = 0; j < VJ; ++j) o[s][j] = 0.f; }
  for (int c0 = 0; c0 < nkeys; c0 += 64) {
    const int kidx = c0 + lane; int row = -1; float bias = 0.f;
    bool valid = kidx < nkeys; if (valid) valid = kf(kidx, row, bias);
    const int rr = valid ? row : 0;
    rl[lane] = valid ? row : -1;
    float sc[NS];
#pragma unroll
    for (int s = 0; s < NS; ++s) {
      const uint4* kp = (const uint4*)(KV + (size_t)rr * ld + kcol + 64 * s); float d = 0.f;
#pragma unroll
      for (int i = 0; i < 8; ++i) { const uint4 w = kp[i]; const float* q = qs + s * 64 + i * 8;
        d += q[0] * __uint_as_float(w.x << 16) + q[1] * __uint_as_float(w.x & 0xffff0000u) + q[2] * __uint_as_float(w.y << 16) + q[3] * __uint_as_float(w.y & 0xffff0000u)
           + q[4] * __uint_as_float(w.z << 16) + q[5] * __uint_as_float(w.z & 0xffff0000u) + q[6] * __uint_as_float(w.w << 16) + q[7] * __uint_as_float(w.w & 0xffff0000u); }
      sc[s] = valid ? d + bias : -INFINITY;
    }
#pragma unroll
    for (int s = 0; s < NS; ++s) {
      const float cm = wave_max(sc[s]); const float mn = fmaxf(m[s], cm);
      float pv = 0.f, scale = 1.f;
      if (mn > -INFINITY) { pv = __expf(sc[s] - mn); scale = __expf(m[s] - mn); }
      l[s] = l[s] * scale + wave_sum(pv); m[s] = mn;
#pragma unroll
      for (int j = 0; j < VJ; ++j) o[s][j] *= scale;
      pl[s * 64 + lane] = pv;
    }
    __builtin_amdgcn_s_waitcnt(0); __builtin_amdgcn_wave_barrier();
    for (int kk = 0; kk < 64; ++kk) {
      const int rk = rl[kk]; if (rk < 0) continue;
      const bf16_t* vp = KV + (size_t)rk * ld + vcol + lane;
      float vv[VJ];
#pragma unroll
      for (int j = 0; j < VJ; ++j) vv[j] = bf2f(vp[64 * j]);
#pragma unroll
      for (int s = 0; s < NS; ++s) { const float pk = pl[s * 64 + kk];
#pragma unroll
        for (int j = 0; j < VJ; ++j) o[s][j] += pk * vv[j]; }
    }
    __builtin_amdgcn_s_waitcnt(0); __builtin_amdgcn_wave_barrier();
  }
  if (has_sink) {
#pragma unroll
    for (int s = 0; s < NS; ++s) { const float mn = fmaxf(m[s], sink); const float scale = __expf(m[s] - mn);
      l[s] = l[s] * scale + __expf(sink - mn); m[s] = mn;
#pragma unroll
      for (int j = 0; j < VJ; ++j) o[s][j] *= scale; }
  }
}

DEVI void phase_attn0(const Params& p, float* lds) {
  const int tid = ftid(), lane = tid & 63, wave = tid >> 6;
  const int gw = blockIdx.x * NWAVE + wave, NGW = gridDim.x * NWAVE;
  const bf16_t* Q = (const bf16_t*)(p.ws + WS_QKV0); bf16_t* ATT = (bf16_t*)(p.ws + WS_ATT0);
  const float lam = ((const float*)(p.ws + WS_CTL + CTL_LAM))[0];
  float* qs = lds + wave * 128; float* pl = lds + 1024 + wave * 128; int* rl = (int*)(lds + 2048) + wave * 64;
  for (long it = gw; it < (long)NROW * 12; it += NGW) {
    const int row = (int)(it / 12), hs = (int)(it % 12);
    const bool lat = row < NLAT; const int b = lat ? (row >> 12) : ((row - NLAT) >> 8), t = lat ? (row & 4095) : 0;
    __builtin_amdgcn_s_waitcnt(0); __builtin_amdgcn_wave_barrier();
    if (hs < 4) {
      const bf16_t* qp = Q + (size_t)row * N_IN0 + hs * 128;
      qs[lane] = bf2f(qp[lane]) * 0.125f; qs[64 + lane] = bf2f(qp[64 + lane]) * 0.125f;
      __builtin_amdgcn_s_waitcnt(0); __builtin_amdgcn_wave_barrier();
      float o[2][2], m[2], l[2];
      const int nkeys = lat ? SEQ + CTXL : CTXL;
      wave_attn<2, 2>(qs, pl, rl, nkeys, [&](int k, int& r, float& bias) { r = lat ? (k < SEQ ? b * SEQ + k : NLAT + b * CTXL + (k - SEQ)) : NLAT + b * CTXL + k; return true; },
                      Q, N_IN0, 512 + hs * 128, 1024 + hs * 128, 0.f, false, o, m, l, lane);
      float v0 = o[0][0] / l[0] - lam * o[1][0] / l[1], v1 = o[0][1] / l[0] - lam * o[1][1] / l[1];
      const float r = rsqrtf(wave_sum(v0 * v0 + v1 * v1) * (1.f / 128.f) + EPS);
      const float* g = p.in[L0_SUBLN];
      ATT[(size_t)row * DM + hs * 128 + lane] = f2bf(v0 * r * g[lane] * 0.8f);
      ATT[(size_t)row * DM + hs * 128 + 64 + lane] = f2bf(v1 * r * g[64 + lane] * 0.8f);
    } else {
      const int h = hs - 4;
      qs[lane] = bf2f(Q[(size_t)row * N_IN0 + 1536 + h * 64 + lane]) * 0.125f;
      __builtin_amdgcn_s_waitcnt(0); __builtin_amdgcn_wave_barrier();
      float o[1][1], m[1], l[1];
      const int qr = t >> 6, qc = t & 63;
      const int rs = min(max(qr - 4, 0), 56), cs = min(max(qc - 8, 0), 48);
      const float* rpb = p.in[L0_RPB] + h * 15 * 31;
      const int nkeys = lat ? 128 + CTXL : CTXL;
      wave_attn<1, 1>(qs, pl, rl, nkeys, [&](int k, int& r, float& bias) {
          if (!lat) { r = NLAT + b * CTXL + k; return true; }
          if (k < 128) { const int kr = rs + (k >> 4), kc = cs + (k & 15); r = b * SEQ + kr * 64 + kc; bias = rpb[(kr - qr + 7) * 31 + (kc - qc + 15)]; }
          else r = NLAT + b * CTXL + (k - 128);
          return true; },
        Q, N_IN0, 2048 + h * 64, 2560 + h * 64, 0.f, false, o, m, l, lane);
      ATT[(size_t)row * DM + 512 + h * 64 + lane] = f2bf(o[0][0] / l[0]);
    }
  }
}

DEVI void phase_outproj(const Params& p, float* lds, int layer) {
  const bf16_t* A = (const bf16_t*)(p.ws + (layer ? WS_ATT1 : WS_ATT0)); const bf16_t* W = (const bf16_t*)(p.ws + (layer ? WS_WOUT1 : WS_WOUT0));
  bf16_t* MIX = (bf16_t*)(p.ws + (layer ? WS_MIX1 : WS_MIX0));
  const int NTM = (layer ? NLAT : NROW) / 128; constexpr int NTN = DM / 64;
  for (int it = blockIdx.x; it < NTN * NTM; it += gridDim.x) {
    const int mt = it / NTN, nt = it % NTN, m0 = mt * 128;
    gemm_tile(lds, W, nt * 64, DM, [&](int r) { return A + (size_t)(m0 + r) * DM; },
      [&](int r, int n, float* v) { *(uint2*)(MIX + (size_t)(m0 + r) * DM + n) = make_uint2(pk2(v[0], v[1]), pk2(v[2], v[3])); });
  }
}

DEVI void phase_postmix(const Params& p, int layer) {
  const int lane = ftid() & 63, gw = blockIdx.x * NWAVE + (ftid() >> 6), NGW = gridDim.x * NWAVE;
  const float* MOD = (const float*)(p.ws + WS_CTL + CTL_MOD) + (size_t)layer * 9 * 6144;
  const bf16_t* MIX = (const bf16_t*)(p.ws + (layer ? WS_MIX1 : WS_MIX0));
  bf16_t* H = (bf16_t*)(p.ws + WS_H); float* AFF = (float*)(p.ws + WS_AFF); float* XC = (float*)(p.ws + WS_XC);
  const float* gpost = p.in[layer ? L1_GPOSTMIX : L0_GPOSTMIX]; const float* gpre = p.in[layer ? L1_GPREFFN : L0_GPREFFN];
  const float* wr = p.in[layer ? L1_WROUTER : L0_WROUTER];
  const int nrow = layer ? NLAT : NROW;
  for (int r = gw; r < nrow; r += NGW) {
    const float* m = MOD + (size_t)row_modrow(r) * 6144;
    const float* xin = layer ? (p.out + (size_t)r * DM) : (r < NLAT ? p.in[I_X] + (size_t)r * DM : p.in[I_CTX] + (size_t)(r - NLAT) * DM);
    float* xout = r < NLAT ? p.out + (size_t)r * DM : XC + (size_t)(r - NLAT) * DM;
    Row16 o = ld_row_bf16(MIX + (size_t)r * DM, lane);
    const float rr = rsqrtf(row_sumsq(o) * (1.f / DM) + EPS);
    { const Row16 A = ld_row_f32(gpost, lane), Bv = ld_row_f32(m + 2048, lane), Cv = ld_row_f32(xin, lane);
      ROW_FOR4(e = c + b * (e * rr * a)); }
    st_row_f32(xout, lane, o);
    const Row16 h = norm_mod(o, gpre, m + 4096, m + 3072, lane);
    st_row_bf16(H + (size_t)r * DM, lane, h);
    float lg[16];
#pragma unroll
    for (int e = 0; e < 16; ++e) lg[e] = 0.f;
#pragma unroll
    for (int j = 0; j < 4; ++j) {
      const float hv[4] = {h.v[j].x, h.v[j].y, h.v[j].z, h.v[j].w};
#pragma unroll
      for (int q = 0; q < 4; ++q) { const float4* w4 = (const float4*)(wr + (size_t)(lane * 4 + 256 * j + q) * 16);
#pragma unroll
        for (int e4 = 0; e4 < 4; ++e4) { const float4 w = w4[e4]; lg[e4 * 4] += hv[q] * w.x; lg[e4 * 4 + 1] += hv[q] * w.y; lg[e4 * 4 + 2] += hv[q] * w.z; lg[e4 * 4 + 3] += hv[q] * w.w; } }
    }
    float mx = -INFINITY;
#pragma unroll
    for (int e = 0; e < 16; ++e) { lg[e] = wave_sum(lg[e]); mx = fmaxf(mx, lg[e]); }
    float s = 0.f;
#pragma unroll
    for (int e = 0; e < 16; ++e) { lg[e] = expf(lg[e] - mx); s += lg[e]; }
    const float inv = 1.f / s;
    float mine = 0.f;
#pragma unroll
    for (int e = 0; e < 16; ++e) if (lane == e) mine = lg[e] * inv;
    if (lane < 16) AFF[(size_t)lane * NROW + r] = mine;
  }
}

DEVI void phase_topk(const Params& p, float* lds, int layer) {
  const int tid = ftid();
  const float* AFF = (const float*)(p.ws + WS_AFF); int* SLOT = (int*)(p.ws + WS_SLOT); int* IDX = (int*)(p.ws + WS_IDX); float* GV = (float*)(p.ws + WS_GATEV);
  const int erows = layer ? EROWS1 : EROWS0;
  const int nlat_items = NB * NE * 8, nitems = nlat_items + (layer ? 0 : NB * NE);
  for (int it = blockIdx.x; it < nitems; it += gridDim.x) {
    const bool lat = it < nlat_items;
    int b, e, ch, n, cap, row0, slot0;
    if (lat) { b = it / (NE * 8); e = (it / 8) % NE; ch = it % 8; n = SEQ; cap = CAP_L; row0 = b * SEQ; slot0 = b * CAP_L; }
    else { const int i2 = it - nlat_items; b = i2 / NE; e = i2 % NE; ch = 0; n = CTXL; cap = CAP_C; row0 = NLAT + b * CTXL; slot0 = NB * CAP_L + b * CAP_C; }
    __syncthreads();
    for (int i = tid; i < n; i += NT) lds[i] = AFF[(size_t)e * NROW + row0 + i];
    __syncthreads();
    const int t = ch * 512 + tid;
    if (t < n) {
      const float a = lds[t]; int rank = 0;
      for (int j = 0; j < n; ++j) { const float v = lds[j]; rank += (v > a || (v == a && j < t)) ? 1 : 0; }
      if (rank < cap) { IDX[e * erows + slot0 + rank] = row0 + t; GV[e * erows + slot0 + rank] = a; SLOT[(size_t)(row0 + t) * 16 + e] = slot0 + rank; }
      else SLOT[(size_t)(row0 + t) * 16 + e] = -1;
    }
  }
}

DEVI void phase_moe_up(const Params& p, float* lds, int layer) {
  const bf16_t* H = (const bf16_t*)(p.ws + WS_H); const bf16_t* WGU = (const bf16_t*)(p.ws + WS_WGU); bf16_t* HID = (bf16_t*)(p.ws + WS_HID);
  const int* IDX = (const int*)(p.ws + WS_IDX);
  const int erows = layer ? EROWS1 : EROWS0, NTM = erows / 128; constexpr int NTN = 2048 / 64;
  for (int it = blockIdx.x; it < NE * NTM * NTN; it += gridDim.x) {
    const int e = it / (NTM * NTN), r2 = it % (NTM * NTN), mt = r2 / NTN, nt = r2 % NTN, m0 = mt * 128;
    gemm_tile(lds, WGU + (size_t)e * 2048 * DM, nt * 64, DM, [&](int r) { return H + (size_t)IDX[e * erows + m0 + r] * DM; },
      [&](int r, int n, float* v) { *(unsigned*)(HID + ((size_t)e * erows + m0 + r) * DM + (n >> 1)) = pk2(silu_f(v[0]) * v[1], silu_f(v[2]) * v[3]); });
  }
}
DEVI void phase_moe_down(const Params& p, float* lds, int layer) {
  const bf16_t* HID = (const bf16_t*)(p.ws + WS_HID); const bf16_t* WD = (const bf16_t*)(p.ws + WS_WD); bf16_t* Y = (bf16_t*)(p.ws + WS_Y);
  const float* GV = (const float*)(p.ws + WS_GATEV);
  const int erows = layer ? EROWS1 : EROWS0, NTM = erows / 128; constexpr int NTN = DM / 64;
  for (int it = blockIdx.x; it < NE * NTM * NTN; it += gridDim.x) {
    const int e = it / (NTM * NTN), r2 = it % (NTM * NTN), mt = r2 / NTN, nt = r2 % NTN, m0 = mt * 128;
    gemm_tile(lds, WD + (size_t)e * DM * DM, nt * 64, DM, [&](int r) { return HID + ((size_t)e * erows + m0 + r) * DM; },
      [&](int r, int n, float* v) { const float g = GV[e * erows + m0 + r];
        *(uint2*)(Y + ((size_t)e * erows + m0 + r) * DM + n) = make_uint2(pk2(v[0] * g, v[1] * g), pk2(v[2] * g, v[3] * g)); });
  }
}

DEVI void phase_combine(const Params& p, float* lds, int layer) {
  const int lane = ftid() & 63, wave = ftid() >> 6, gw = blockIdx.x * NWAVE + wave, NGW = gridDim.x * NWAVE;
  const float* MOD = (const float*)(p.ws + WS_CTL + CTL_MOD);
  const bf16_t* Y = (const bf16_t*)(p.ws + WS_Y); const int* SLOT = (const int*)(p.ws + WS_SLOT);
  bf16_t* H = (bf16_t*)(p.ws + WS_H); float* XC = (float*)(p.ws + WS_XC);
  const float* gpost = p.in[layer ? L1_GPOSTFFN : L0_GPOSTFFN];
  const int nrow = layer ? NLAT : NROW, erows = layer ? EROWS1 : EROWS0;
  for (int r = gw; r < nrow; r += NGW) {
    const float* m = MOD + (size_t)(layer * 9 + row_modrow(r)) * 6144;
    float* xio = r < NLAT ? p.out + (size_t)r * DM : XC + (size_t)(r - NLAT) * DM;
    Row16 o;
#pragma unroll
    for (int j = 0; j < 4; ++j) o.v[j] = make_float4(0.f, 0.f, 0.f, 0.f);
    for (int e = 0; e < NE; ++e) {
      const int s = SLOT[(size_t)r * 16 + e];
      if (s >= 0) { const Row16 y = ld_row_bf16(Y + ((size_t)e * erows + s) * DM, lane);
#pragma unroll
        for (int j = 0; j < 4; ++j) { o.v[j].x += y.v[j].x; o.v[j].y += y.v[j].y; o.v[j].z += y.v[j].z; o.v[j].w += y.v[j].w; } }
    }
    const float rr = rsqrtf(row_sumsq(o) * (1.f / DM) + EPS);
    { const Row16 A = ld_row_f32(gpost, lane), Bv = ld_row_f32(m + 5120, lane), Cv = ld_row_f32(xio, lane);
      ROW_FOR4(e = c + b * (e * rr * a)); }
    st_row_f32(xio, lane, o);
    if (layer == 0) {
      const float* m1 = MOD + (size_t)(9 + row_modrow(r)) * 6144;
      const Row16 h = norm_mod(o, p.in[L1_GPREMIX], m1 + 1024, m1, lane);
      st_row_bf16(H + (size_t)r * DM, lane, h);
    }
  }
  if (layer == 0) { convert_moe_part(p, 1, 0, lds + wave * (64 * 33), gw, NGW, lane); convert_moe_part(p, 1, 1, lds + wave * (64 * 33), gw, NGW, lane); }
}

DEVI void phase_qkv1(const Params& p, float* lds) {
  const bf16_t* H = (const bf16_t*)(p.ws + WS_H); const bf16_t* W = (const bf16_t*)(p.ws + WS_WIN1);
  bf16_t* P1 = (bf16_t*)(p.ws + WS_P1); float* DT = (float*)(p.ws + WS_DT); const float* ROPE = (const float*)(p.ws + WS_CTL + CTL_ROPE);
  constexpr int NTN = 37, NTM = NROW / 128;
  for (int it = blockIdx.x; it < NTN * NTM; it += gridDim.x) {
    const int mt = it / NTN, nt = it % NTN, m0 = mt * 128;
    gemm_tile(lds, W, nt * 64, DM, [&](int r) { return H + (size_t)(m0 + r) * DM; },
      [&](int r, int n, float* v) {
        const int row = m0 + r;
        if (n >= 2304) { if (n < 2320) *(float4*)(DT + (size_t)row * 16 + (n - 2304)) = make_float4(v[0], v[1], v[2], v[3]); return; }
        if (row < NLAT && n < 640) { const int t = row & 4095; rope_pair(ROPE, t, n & 63, v[0], v[1]); rope_pair(ROPE, t, (n + 2) & 63, v[2], v[3]); }
        *(uint2*)(P1 + (size_t)row * 2304 + n) = make_uint2(pk2(v[0], v[1]), pk2(v[2], v[3]));
      });
  }
}

DEVI void phase_conv_swa(const Params& p, float* lds, bool do_swa) {
  const int tid = ftid(), lane = tid & 63, wave = tid >> 6;
  const int gw = blockIdx.x * NWAVE + wave, NGW = gridDim.x * NWAVE;
  const bf16_t* P1 = (const bf16_t*)(p.ws + WS_P1); bf16_t* U = (bf16_t*)(p.ws + WS_U); bf16_t* ATT = (bf16_t*)(p.ws + WS_ATT1);
  const float* cw = p.in[L1_CONVW]; const float* cb = p.in[L1_CONVB];
  for (long i = (long)blockIdx.x * NT + tid; i < (long)NROW * 1024; i += (long)gridDim.x * NT) {
    const int row = (int)(i >> 10), ch = (int)(i & 1023);
    int s0, len, t; if (row < NLAT) { s0 = row & ~4095; len = SEQ; t = row & 4095; } else { s0 = NLAT + ((row - NLAT) & ~255); len = CTXL; t = (row - NLAT) & 255; }
    float acc = cb[ch];
#pragma unroll
    for (int j = 0; j < 5; ++j) { const int tt = t + j - 2; if (tt >= 0 && tt < len) acc += cw[j * 1024 + ch] * bf2f(P1[(size_t)(s0 + tt) * 2304 + 768 + ch]); }
    U[(size_t)row * 1024 + ch] = f2bf(silu_f(acc));
  }
  if (!do_swa) return;
  float* qs = lds + wave * 128; float* pl = lds + 1024 + wave * 128; int* rl = (int*)(lds + 2048) + wave * 64;
  for (long it = gw; it < (long)NLAT * 8; it += NGW) {
    const int row = (int)(it >> 3), hq = (int)(it & 7), g = hq >> 2, b = row >> 12, t = row & 4095;
    __builtin_amdgcn_s_waitcnt(0); __builtin_amdgcn_wave_barrier();
    qs[lane] = bf2f(P1[(size_t)row * 2304 + hq * 64 + lane]) * 0.125f;
    __builtin_amdgcn_s_waitcnt(0); __builtin_amdgcn_wave_barrier();
    float o[1][1], m[1], l[1];
    wave_attn<1, 1>(qs, pl, rl, 320 + CTXL, [&](int k, int& r, float& bias) {
        if (k < 320) { const int kp = t - 128 + k; if (k > 256 || kp < 0 || kp >= SEQ) return false; r = b * SEQ + kp; return true; }
        r = NLAT + b * CTXL + (k - 320); return true; },
      P1, 2304, 512 + g * 64, 640 + g * 64, p.in[L1_SINKS][hq], true, o, m, l, lane);
    ATT[(size_t)row * DM + hq * 64 + lane] = f2bf(o[0][0] / l[0]);
  }
}

DEVI void phase_ssd(const Params& p, float* lds) {
  const int tid = ftid();
  const bf16_t* U = (const bf16_t*)(p.ws + WS_U); const float* DT = (const float*)(p.ws + WS_DT); float* YS = (float*)(p.ws + WS_YS);
  constexpr int CH = 32;
  float* xb = lds;
  float* bb = lds + CH * 64;
  float* cb = bb + CH * 128;
  float* db = cb + CH * 128;
  float* yb = db + 2 * CH;
  const int pi = tid >> 3, ns = (tid & 7) * 16;
  for (int it = blockIdx.x; it < NB * 8; it += gridDim.x) {
    const int b = it >> 3, hd = it & 7, g = hd >> 2;
    for (int dir = 0; dir < 2; ++dir) {
      const float a = -expf(p.in[dir ? L1_ALOGB : L1_ALOGF][hd]); const float dtb = p.in[dir ? L1_DTBB : L1_DTBF][hd];
      float st[16];
#pragma unroll
      for (int i = 0; i < 16; ++i) st[i] = 0.f;
      for (int seg = 0; seg < 2; ++seg) {
        const int len = seg ? SEQ : CTXL, s0 = seg ? b * SEQ : NLAT + b * CTXL;
        for (int c0 = 0; c0 < len; c0 += CH) {
          __syncthreads();
          for (int i = tid; i < CH * 320; i += NT) {
            const int st_i = i / 320, c = i % 320; const int tk = dir ? (len - 1 - (c0 + st_i)) : (c0 + st_i); const size_t r = (size_t)(s0 + tk);
            if (c < 64) xb[st_i * 64 + c] = bf2f(U[r * 1024 + hd * 64 + c]);
            else if (c < 192) bb[st_i * 128 + (c - 64)] = bf2f(U[r * 1024 + 512 + g * 128 + (c - 64)]);
            else cb[st_i * 128 + (c - 192)] = bf2f(U[r * 1024 + 768 + g * 128 + (c - 192)]);
          }
          if (tid < CH) { const int tk = dir ? (len - 1 - (c0 + tid)) : (c0 + tid); const float raw = DT[(size_t)(s0 + tk) * 16 + dir * 8 + hd] + dtb;
            const float dt = raw > 20.f ? raw : log1pf(expf(raw)); db[tid] = expf(dt * a); db[CH + tid] = dt; }
          __syncthreads();
          for (int i = 0; i < CH; ++i) {
            const float dec = db[i], dx = db[CH + i] * xb[i * 64 + pi]; float y = 0.f;
#pragma unroll
            for (int q = 0; q < 16; ++q) { st[q] = st[q] * dec + dx * bb[i * 128 + ns + q]; y += st[q] * cb[i * 128 + ns + q]; }
            y += __shfl_xor(y, 1); y += __shfl_xor(y, 2); y += __shfl_xor(y, 4);
            if ((tid & 7) == 0) yb[i * 64 + pi] = y;
          }
          __syncthreads();
          if (seg == 1) for (int i = tid; i < CH * 64; i += NT) {
            const int q = i >> 6, c = i & 63; const int tk = (dir ? (len - CH - c0) : c0) + q, st_i = dir ? (CH - 1 - q) : q;
            float* yp = YS + (size_t)(b * SEQ + tk) * 512 + hd * 64 + c;
            if (dir == 0) *yp = yb[st_i * 64 + c]; else *yp = *yp + yb[st_i * 64 + c];
          }
        }
      }
      __syncthreads(); __threadfence();
    }
  }
}

DEVI void phase_ssd_out(const Params& p) {
  const int lane = ftid() & 63, gw = blockIdx.x * NWAVE + (ftid() >> 6), NGW = gridDim.x * NWAVE;
  const bf16_t* U = (const bf16_t*)(p.ws + WS_U); const bf16_t* P1 = (const bf16_t*)(p.ws + WS_P1); const float* YS = (const float*)(p.ws + WS_YS);
  bf16_t* ATT = (bf16_t*)(p.ws + WS_ATT1);
  for (int r = gw; r < NLAT; r += NGW) {
    const int c0 = lane * 8, hd = c0 >> 6; const float dsk = p.in[L1_DSKIP][hd];
    const float4 y0 = *(const float4*)(YS + (size_t)r * 512 + c0), y1 = *(const float4*)(YS + (size_t)r * 512 + c0 + 4);
    const uint4 xw = *(const uint4*)(U + (size_t)r * 1024 + c0), zw = *(const uint4*)(P1 + (size_t)r * 2304 + 1792 + c0);
    float y[8] = {y0.x, y0.y, y0.z, y0.w, y1.x, y1.y, y1.z, y1.w};
    const unsigned xs[4] = {xw.x, xw.y, xw.z, xw.w}, zs[4] = {zw.x, zw.y, zw.z, zw.w};
    float ss = 0.f;
#pragma unroll
    for (int i = 0; i < 4; ++i) {
      const float x0 = __uint_as_float(xs[i] << 16), x1 = __uint_as_float(xs[i] & 0xffff0000u), z0 = __uint_as_float(zs[i] << 16), z1 = __uint_as_float(zs[i] & 0xffff0000u);
      y[2 * i] = (y[2 * i] + dsk * x0) * silu_f(z0); y[2 * i + 1] = (y[2 * i + 1] + dsk * x1) * silu_f(z1);
      ss += y[2 * i] * y[2 * i] + y[2 * i + 1] * y[2 * i + 1];
    }
#pragma unroll
    for (int o = 1; o < 32; o <<= 1) ss += __shfl_xor(ss, o);
    const float rr = rsqrtf(ss * (1.f / 256.f) + EPS);
    const float4 g0 = *(const float4*)(p.in[L1_GNORM] + c0), g1 = *(const float4*)(p.in[L1_GNORM] + c0 + 4);
    uint4 w; w.x = pk2(y[0] * rr * g0.x, y[1] * rr * g0.y); w.y = pk2(y[2] * rr * g0.z, y[3] * rr * g0.w); w.z = pk2(y[4] * rr * g1.x, y[5] * rr * g1.y); w.w = pk2(y[6] * rr * g1.z, y[7] * rr * g1.w);
    *(uint4*)(ATT + (size_t)r * DM + 512 + c0) = w;
  }
}

}
namespace pg8 {
#define PG8_LAS __attribute__((address_space(3)))
typedef unsigned short bf16_t;
typedef short bf16x8 __attribute__((ext_vector_type(8)));
typedef float f32x4 __attribute__((ext_vector_type(4)));
typedef unsigned u32x4 __attribute__((ext_vector_type(4)));
constexpr int BM = 256, BK = 64, HALF = 128, HTB = HALF * BK * 2  , STAGE_BYTES = 8 * HTB, NXCD = 8, WGM = 8;

__host__ __device__ __forceinline__ int lds_byte(int r, int c) { const int st = (r >> 4) * 2 + (c >> 5), rr = r & 15, cc = c & 31, ob = rr * 64 + cc * 2; return st * 1024 + (ob ^ (((ob >> 9) & 1) << 5)); }
__host__ __device__ __forceinline__ void stage_rc(int b, int& R, int& C) { const int st = b / 1024, sb = b % 1024, swz = sb ^ (((sb >> 9) & 1) << 5); R = (st >> 1) * 16 + swz / 64; C = (st & 1) * 32 + (swz % 64) / 2; }
__host__ __device__ __forceinline__ int perm32(int rho) { const int n = rho >> 4, i = rho & 15; return 8 * (i >> 2) + 4 * n + (i & 3); }

struct Unit { int pm, pn; };
struct Gemm { const bf16_t* A; const bf16_t* Bt; int M, N, K; const int* gidx = nullptr; int sw = 0x7f7f7f7f, sa = 0x7f7f7f7f; };

struct StaticOrder {
    int nM, nN, nwg, G, c;
    __host__ __device__ void init(int M, int N, int G_, int c_) { nM = M / BM; nN = N / BM; nwg = nM * nN; G = G_; c = c_; }
    __host__ __device__ bool next(int i, Unit& u) const {
        const long L = (long)i * G + c; if (L >= nwg) return false;
        int wgid = (int)L; { const int q = nwg / NXCD, r = nwg % NXCD, xcd = wgid % NXCD, off = wgid / NXCD; wgid = (xcd < r ? xcd * (q + 1) : r * (q + 1) + (xcd - r) * q) + off; }
        const int nig = WGM * nN, gid = wgid / nig, fm = gid * WGM, gsz = (nM - fm) < WGM ? (nM - fm) : WGM;
        u.pm = fm + ((wgid % nig) % gsz); u.pn = (wgid % nig) / gsz; return true;
    }
    __device__ __forceinline__ void a_ready(const Unit&) const {}
    __device__ __forceinline__ void done(const Unit&) const {}
};

template <class Epi, class Sched, bool ALIGN_EPI = false, bool SP2 = false, bool FP8 = false>
__device__ __forceinline__ void gemm_phase(PG8_LAS unsigned char* lds, const Gemm g, const Sched& S, const Epi& E) {
    const int tid = ftid(), wid = __builtin_amdgcn_readfirstlane(tid >> 6), lane = tid & 63, wr = wid >> 2, wc = wid & 3, fr = lane & 15, fq = lane >> 4;
    const int KB = g.K * (FP8 ? 1 : 2), nt = KB / (BK * 2);
    unsigned voffB[2]; int pR[2], pC[2];
#pragma unroll
    for (int i = 0; i < 2; ++i) { int R, C; stage_rc(tid * 16 + i * 8192, R, C); const int Rb = Epi::PERM ? ((R & ~31) + perm32(R & 31)) : R;
        pR[i] = R; pC[i] = C; voffB[i] = (unsigned)(Rb * KB + C * 2); }
    unsigned cvo[2][2], nvo[2][2];
#define PG8_SETVO(vo, pm_) do { _Pragma("unroll") for (int _h = 0; _h < 2; ++_h) _Pragma("unroll") for (int _i = 0; _i < 2; ++_i) { const int _r = (pm_) * BM + _h * HALF + pR[_i]; \
        const int _g = g.gidx ? g.gidx[_r] : _r; vo[_h][_i] = (unsigned)_g * (unsigned)KB + (unsigned)(pC[_i] * 2); } } while (0)
#define PG8_STAGEA(bufoff, koff, vo) do { _Pragma("unroll") for (int _i = 0; _i < 2; ++_i) \
        __builtin_amdgcn_global_load_lds((const unsigned*)((const char*)g.A + (koff) + (vo)[_i]), (PG8_LAS unsigned*)(lds + (bufoff) + ldsw + _i * 8192), 16, 0, 0); } while (0)
    const size_t kstep = (size_t)(BK * 2);
    const size_t hstep = (size_t)HALF * KB;
    const size_t tstep = 2 * hstep;
    const unsigned ldsw = (unsigned)wid * 1024u;
    const int aoff = lds_byte(wr * 64 + fr, fq * 8), boff = lds_byte(wc * 32 + fr, fq * 8);
#define PG8_SA(b, h) (((b) * 2 + (h)) * HTB)
#define PG8_SB(b, h) ((4 + (b) * 2 + (h)) * HTB)
#define PG8_STAGE(bufoff, gbase, voff) do { _Pragma("unroll") for (int _i = 0; _i < 2; ++_i) \
        __builtin_amdgcn_global_load_lds((const unsigned*)((const char*)(gbase) + (voff)[_i]), (PG8_LAS unsigned*)(lds + (bufoff) + ldsw + _i * 8192), 16, 0, 0); } while (0)
    typedef int v4i_t __attribute__((ext_vector_type(4))); typedef int v8i_t __attribute__((ext_vector_type(8)));
#define PG8_CAT8(x, y) __builtin_shufflevector(__builtin_bit_cast(v4i_t, x), __builtin_bit_cast(v4i_t, y), 0, 1, 2, 3, 4, 5, 6, 7)
#define PG8_LDA(dst, b, h) do { _Pragma("unroll") for (int m = 0; m < 4; ++m) { const bf16x8 f0_ = *(const PG8_LAS bf16x8*)(lds + PG8_SA(b, h) + aoff + m * 2048), f1_ = *(const PG8_LAS bf16x8*)(lds + PG8_SA(b, h) + aoff + m * 2048 + 1024); \
        if constexpr (FP8) dst##8[m] = PG8_CAT8(f0_, f1_); else { dst[m][0] = f0_; dst[m][1] = f1_; } } } while (0)
#define PG8_LDB(dst, b, h) do { _Pragma("unroll") for (int n = 0; n < 2; ++n) { const bf16x8 f0_ = *(const PG8_LAS bf16x8*)(lds + PG8_SB(b, h) + boff + n * 2048), f1_ = *(const PG8_LAS bf16x8*)(lds + PG8_SB(b, h) + boff + n * 2048 + 1024); \
        if constexpr (FP8) dst##8[n] = PG8_CAT8(f0_, f1_); else { dst[n][0] = f0_; dst[n][1] = f1_; } } } while (0)
typedef int v4i_t __attribute__((ext_vector_type(4))); typedef int v8i_t __attribute__((ext_vector_type(8)));
#define PG8_CAT8(x, y) __builtin_shufflevector(__builtin_bit_cast(v4i_t, x), __builtin_bit_cast(v4i_t, y), 0, 1, 2, 3, 4, 5, 6, 7)
#define PG8_MMA(ai, bj, At, Bt) do { __builtin_amdgcn_s_setprio(1); _Pragma("unroll") for (int m = 0; m < 4; ++m) _Pragma("unroll") for (int n = 0; n < 2; ++n) { \
        if constexpr (FP8) asm volatile("v_mfma_scale_f32_16x16x128_f8f6f4 %0, %1, %2, %0, %3, %4 op_sel_hi:[0,0,0]" : "+v"(acc[ai][bj][m][n]) : "v"(Bt##8[n]), "v"(At##8[m]), "v"(sw_), "v"(sa_)); \
        else { _Pragma("unroll") for (int k = 0; k < 2; ++k) acc[ai][bj][m][n] = __builtin_amdgcn_mfma_f32_16x16x32_bf16(Bt[n][k], At[m][k], acc[ai][bj][m][n], 0, 0, 0); } } \
        __builtin_amdgcn_s_setprio(0); } while (0)
#define PG8_WAIT_V(n) asm volatile("s_waitcnt vmcnt(" #n ")" ::: "memory")
#define PG8_WAIT_L(n) asm volatile("s_waitcnt lgkmcnt(" #n ")" ::: "memory")
#define PG8_BAR __builtin_amdgcn_s_barrier()
#define PG8_SCHED __builtin_amdgcn_sched_barrier(0)
    Unit cur, nxt; int ui = 0;
    if (!S.next(0, cur)) return;
    f32x4 acc[2][2][4][2];
#pragma unroll
    for (int a = 0; a < 2; ++a)
#pragma unroll
        for (int b = 0; b < 2; ++b)
#pragma unroll
            for (int m = 0; m < 4; ++m)
#pragma unroll
                for (int n = 0; n < 2; ++n) acc[a][b][m][n] = (f32x4){0.f, 0.f, 0.f, 0.f};
    const int sw_ = g.sw, sa_ = g.sa;
    bf16x8 At[4][2], B0[2][2], B1[2][2]; v8i_t At8[4], B08[2], B18[2];
    PG8_SETVO(cvo, cur.pm); const char* cB = (const char*)g.Bt + (size_t)cur.pn * tstep;
    S.a_ready(cur);
    if constexpr (SP2) {
        PG8_STAGE(PG8_SB(0, 0), cB, voffB); PG8_STAGE(PG8_SB(0, 1), cB + hstep, voffB); PG8_STAGEA(PG8_SA(0, 0), 0, cvo[0]); PG8_STAGEA(PG8_SA(0, 1), 0, cvo[1]);
        if (wr == 1) PG8_BAR;
        PG8_WAIT_V(2); PG8_BAR;
        PG8_STAGE(PG8_SB(1, 0), cB + kstep, voffB); PG8_STAGEA(PG8_SA(1, 0), kstep, cvo[0]); PG8_STAGE(PG8_SB(1, 1), cB + hstep + kstep, voffB);
        PG8_WAIT_V(6); PG8_BAR;
    } else {
        PG8_STAGE(PG8_SB(0, 0), cB, voffB); PG8_STAGEA(PG8_SA(0, 0), 0, cvo[0]); PG8_STAGE(PG8_SB(0, 1), cB + hstep, voffB); PG8_STAGEA(PG8_SA(0, 1), 0, cvo[1]);
        if (wr == 1) PG8_BAR;
        PG8_WAIT_V(4); PG8_BAR;
        PG8_STAGE(PG8_SB(1, 0), cB + kstep, voffB); PG8_STAGEA(PG8_SA(1, 0), kstep, cvo[0]); PG8_STAGE(PG8_SB(1, 1), cB + hstep + kstep, voffB);
        PG8_WAIT_V(6); PG8_BAR;
    }
    for (;;) {
        const bool has_next = S.next(ui + 1, nxt);
        if (has_next) PG8_SETVO(nvo, nxt.pm); else { nvo[0][0] = cvo[0][0]; nvo[0][1] = cvo[0][1]; nvo[1][0] = cvo[1][0]; nvo[1][1] = cvo[1][1]; }
        const char* nB = has_next ? (const char*)g.Bt + (size_t)nxt.pn * tstep : cB;
#pragma unroll 1
        for (int t = 0; t < nt; t += 2) {
            const bool last = (t == nt - 2);
            const size_t k1 = (size_t)(t + 1) * kstep;
            const size_t k2 = last ? 0 : (size_t)(t + 2) * kstep; unsigned v2[2][2];
            v2[0][0] = last ? nvo[0][0] : cvo[0][0]; v2[0][1] = last ? nvo[0][1] : cvo[0][1]; v2[1][0] = last ? nvo[1][0] : cvo[1][0]; v2[1][1] = last ? nvo[1][1] : cvo[1][1];
            const char* b2 = last ? nB : cB + (size_t)(t + 2) * kstep;
            const size_t k3 = k2 + kstep; const char* b3 = b2 + kstep;
            if (last && has_next) S.a_ready(nxt);
            if constexpr (SP2) {
            PG8_LDB(B0, 0, 0); PG8_LDB(B1, 0, 1); PG8_SCHED; PG8_LDA(At, 0, 0); PG8_STAGEA(PG8_SA(1, 1), k1, cvo[1]);
            PG8_WAIT_V(8); PG8_WAIT_L(0); PG8_BAR; PG8_MMA(0, 0, At, B0); PG8_MMA(0, 1, At, B1); PG8_BAR; PG8_SCHED;
            PG8_LDA(At, 0, 1); PG8_STAGE(PG8_SB(0, 0), b2, voffB); PG8_STAGE(PG8_SB(0, 1), b2 + hstep, voffB); PG8_STAGEA(PG8_SA(0, 0), k2, v2[0]);
            PG8_WAIT_V(8); PG8_WAIT_L(0); PG8_BAR; PG8_MMA(1, 0, At, B0); PG8_MMA(1, 1, At, B1); PG8_BAR; PG8_SCHED;
            PG8_LDB(B0, 1, 0); PG8_LDB(B1, 1, 1); PG8_SCHED; PG8_LDA(At, 1, 0); PG8_STAGEA(PG8_SA(0, 1), k2, v2[1]);
            PG8_WAIT_V(8); PG8_WAIT_L(0); PG8_BAR; PG8_MMA(0, 0, At, B0); PG8_MMA(0, 1, At, B1); PG8_BAR; PG8_SCHED;
            PG8_LDA(At, 1, 1); PG8_STAGE(PG8_SB(1, 0), b3, voffB); PG8_STAGE(PG8_SB(1, 1), b3 + hstep, voffB); PG8_STAGEA(PG8_SA(1, 0), k3, v2[0]);
            PG8_WAIT_V(8); PG8_WAIT_L(0); PG8_BAR; PG8_MMA(1, 0, At, B0); PG8_MMA(1, 1, At, B1); PG8_BAR; PG8_SCHED;
            } else {
            PG8_LDB(B0, 0, 0); PG8_SCHED; PG8_LDA(At, 0, 0); PG8_STAGEA(PG8_SA(1, 1), k1, cvo[1]);
            PG8_WAIT_L(8); PG8_BAR; PG8_WAIT_L(0); PG8_MMA(0, 0, At, B0); PG8_BAR; PG8_SCHED;
            PG8_LDB(B1, 0, 1); PG8_STAGE(PG8_SB(0, 0), b2, voffB);
            PG8_BAR; PG8_WAIT_L(0); PG8_MMA(0, 1, At, B1); PG8_BAR;
            PG8_LDA(At, 0, 1); PG8_STAGEA(PG8_SA(0, 0), k2, v2[0]);
            PG8_BAR; PG8_WAIT_L(0); PG8_MMA(1, 0, At, B0); PG8_BAR; PG8_SCHED;
            PG8_STAGE(PG8_SB(0, 1), b2 + hstep, voffB);
            PG8_WAIT_V(6); PG8_BAR; PG8_MMA(1, 1, At, B1); PG8_BAR;
            PG8_LDB(B0, 1, 0); PG8_SCHED; PG8_LDA(At, 1, 0); PG8_STAGEA(PG8_SA(0, 1), k2, v2[1]);
            PG8_WAIT_L(8); PG8_BAR; PG8_WAIT_L(0); PG8_MMA(0, 0, At, B0); PG8_BAR; PG8_SCHED;
            PG8_LDB(B1, 1, 1); PG8_STAGE(PG8_SB(1, 0), b3, voffB);
            PG8_BAR; PG8_WAIT_L(0); PG8_MMA(0, 1, At, B1); PG8_BAR;
            PG8_LDA(At, 1, 1); PG8_STAGEA(PG8_SA(1, 0), k3, v2[0]);
            PG8_BAR; PG8_WAIT_L(0); PG8_MMA(1, 0, At, B0); PG8_BAR; PG8_SCHED;
            PG8_STAGE(PG8_SB(1, 1), b3 + hstep, voffB);
            PG8_WAIT_V(6); PG8_BAR; PG8_MMA(1, 1, At, B1); PG8_BAR;
            }
        }
        if constexpr (ALIGN_EPI) { if (wr == 0) PG8_BAR; }
        if constexpr (FP8) asm volatile("s_nop 15\n\ts_nop 15" ::: "memory");
        if constexpr (!Epi::AFTER_DRAIN) { E(acc, cur, wr, wc, fr, fq); S.done(cur); }
        if (!has_next) break;
#pragma unroll
        for (int a = 0; a < 2; ++a)
#pragma unroll
            for (int b = 0; b < 2; ++b)
#pragma unroll
                for (int m = 0; m < 4; ++m)
#pragma unroll
                    for (int n = 0; n < 2; ++n) acc[a][b][m][n] = (f32x4){0.f, 0.f, 0.f, 0.f};
        cur = nxt; cvo[0][0] = nvo[0][0]; cvo[0][1] = nvo[0][1]; cvo[1][0] = nvo[1][0]; cvo[1][1] = nvo[1][1]; cB = nB; ++ui;
        if constexpr (ALIGN_EPI) { if (wr == 1) PG8_BAR; }
    }
    PG8_WAIT_V(0);
    if constexpr (!ALIGN_EPI) { if (wr == 0) PG8_BAR; }
    PG8_BAR;
    if constexpr (Epi::AFTER_DRAIN) { E.fused(acc, cur, wr, wc, fr, fq, lds, wid, lane); S.done(cur); }
#undef PG8_SA
#undef PG8_SB
#undef PG8_STAGE
#undef PG8_STAGEA
#undef PG8_SETVO
#undef PG8_LDA
#undef PG8_LDB
#undef PG8_MMA
#undef PG8_CAT8
#undef PG8_WAIT_V
#undef PG8_WAIT_L
#undef PG8_BAR
#undef PG8_SCHED
}
}
#ifndef FP8_SP2
#define FP8_SP2 true
#endif
#ifndef ATTNA_FP8
#define ATTNA_FP8 1
#endif
namespace fg {
using pg8::f32x4; using pg8::Unit;
typedef unsigned u32x4 __attribute__((ext_vector_type(4)));
typedef unsigned u32x2 __attribute__((ext_vector_type(2)));
DEVI unsigned cvtpk(float lo, float hi) { typedef float f2_t __attribute__((ext_vector_type(2))); typedef __bf16 b2_t __attribute__((ext_vector_type(2))); const f2_t v = {lo, hi}; const b2_t b = __builtin_convertvector(v, b2_t); return __builtin_bit_cast(unsigned, b); }
template <class TP> DEVI void rope8(TP ROPE, int t, int d0, f32x4& v0, f32x4& v1) {
  const int i0 = d0 >> 1, f0 = i0 & 15, pos = (i0 < 16) ? (t >> 6) : (t & 63);
  const f32x4 r0 = *(const PG8_LAS f32x4*)(ROPE + (pos * 16 + f0) * 2), r1 = *(const PG8_LAS f32x4*)(ROPE + (pos * 16 + f0) * 2 + 4);
  const f32x4 a = v0, b = v1;
  v0[0] = a[0] * r0[0] - a[1] * r0[1]; v0[1] = a[0] * r0[1] + a[1] * r0[0]; v0[2] = a[2] * r0[2] - a[3] * r0[3]; v0[3] = a[2] * r0[3] + a[3] * r0[2];
  v1[0] = b[0] * r1[0] - b[1] * r1[1]; v1[1] = b[0] * r1[1] + b[1] * r1[0]; v1[2] = b[2] * r1[2] - b[3] * r1[3]; v1[3] = b[2] * r1[3] + b[3] * r1[2];
}
#define EPI_LOOP_BEGIN const int row0 = u.pm * 256 + wr * 64 + fr; \
  _Pragma("unroll") for (int ai = 0; ai < 2; ++ai) _Pragma("unroll") for (int m = 0; m < 4; ++m) { const int row = row0 + ai * 128 + m * 16; \
  _Pragma("unroll") for (int bj = 0; bj < 2; ++bj) { f32x4 v0 = acc[ai][bj][m][0], v1 = acc[ai][bj][m][1]; const int cl = bj * 128 + wc * 32 + 8 * fq;
#define EPI_LOOP_END } }

struct EpiQKV0 { static constexpr bool PERM = true, AFTER_DRAIN = false; bf16_t* O; const PG8_LAS float* ROPE; unsigned char* VT;
  DEVI void operator()(const f32x4 (&acc)[2][2][4][2], const Unit& u, int wr, int wc, int fr, int fq) const {
    const int colt = u.pn * 256; const bool rope = (u.pm < NLAT / 256) && (colt < 1024);
    EPI_LOOP_BEGIN
      const int col = colt + cl;
      if (ATTNA_FP8 && colt >= 1024 && colt < 1536) {
        const int hh = (col - 1024) >> 7, dv0 = (col - 1024) & 127;
        int bb, t; if (row < NLAT) { bb = row >> 12; t = row & 4095; } else { bb = (row - NLAT) >> 8; t = 4096 + ((row - NLAT) & 255); }
        const int k = t & 31, gq = k >> 3, wq = k & 7, pos = (wq < 4) ? gq * 4 + wq : 16 + gq * 4 + (wq - 4);
        unsigned char* vp = VT + (size_t)((bb * 4 + hh) * 128 + dv0) * 4352 + (t & ~31) + pos;
        const unsigned w0 = nv::pack4_fp8(v0[0] * 4.f, v0[1] * 4.f, v0[2] * 4.f, v0[3] * 4.f), w1 = nv::pack4_fp8(v1[0] * 4.f, v1[1] * 4.f, v1[2] * 4.f, v1[3] * 4.f);
        vp[0 * 4352] = (unsigned char)w0; vp[1 * 4352] = (unsigned char)(w0 >> 8); vp[2 * 4352] = (unsigned char)(w0 >> 16); vp[3 * 4352] = (unsigned char)(w0 >> 24);
        vp[4 * 4352] = (unsigned char)w1; vp[5 * 4352] = (unsigned char)(w1 >> 8); vp[6 * 4352] = (unsigned char)(w1 >> 16); vp[7 * 4352] = (unsigned char)(w1 >> 24);
        continue;
      }
      if (rope) rope8(ROPE, row & 4095, col & 63, v0, v1);
      u32x4 w; w.x = cvtpk(v0[0], v0[1]); w.y = cvtpk(v0[2], v0[3]); w.z = cvtpk(v1[0], v1[1]); w.w = cvtpk(v1[2], v1[3]);
      *(u32x4*)(O + (size_t)row * N_IN0 + col) = w;
    EPI_LOOP_END
  } };
struct EpiQKV1 { static constexpr bool PERM = true, AFTER_DRAIN = false; bf16_t* O; float* DT; const PG8_LAS float* ROPE;
  DEVI void operator()(const f32x4 (&acc)[2][2][4][2], const Unit& u, int wr, int wc, int fr, int fq) const {
    const int colt = u.pn * 256; const bool lat = (u.pm < NLAT / 256);
    EPI_LOOP_BEGIN
      const int col = colt + cl;
      if (col >= 2304) { if (col < 2320) { *(f32x4*)(DT + (size_t)row * 16 + (col - 2304)) = v0; *(f32x4*)(DT + (size_t)row * 16 + (col - 2304) + 4) = v1; } }
      else {
        if (lat && col < 640) rope8(ROPE, row & 4095, col & 63, v0, v1);
        u32x4 w; w.x = cvtpk(v0[0], v0[1]); w.y = cvtpk(v0[2], v0[3]); w.z = cvtpk(v1[0], v1[1]); w.w = cvtpk(v1[2], v1[3]);
        *(u32x4*)(O + (size_t)row * 2304 + col) = w;
      }
    EPI_LOOP_END
  } };
struct EpiPlain { static constexpr bool PERM = true, AFTER_DRAIN = false; bf16_t* O;
  DEVI void operator()(const f32x4 (&acc)[2][2][4][2], const Unit& u, int wr, int wc, int fr, int fq) const {
    const int colt = u.pn * 256;
    EPI_LOOP_BEGIN
      u32x4 w; w.x = cvtpk(v0[0], v0[1]); w.y = cvtpk(v0[2], v0[3]); w.z = cvtpk(v1[0], v1[1]); w.w = cvtpk(v1[2], v1[3]);
      *(u32x4*)(O + (size_t)row * DM + colt + cl) = w;
    EPI_LOOP_END
  } };
DEVI float silu_fast(float v) { return v * __builtin_amdgcn_rcpf(1.f + __expf(-v)); }
struct EpiSwiGLU { static constexpr bool PERM = true, AFTER_DRAIN = false; bf16_t* O;
  DEVI void operator()(const f32x4 (&acc)[2][2][4][2], const Unit& u, int wr, int wc, int fr, int fq) const {
    const int colt = (u.pn & 7) * 256;
    EPI_LOOP_BEGIN
      u32x2 w; w.x = cvtpk(silu_fast(v0[0]) * v0[1], silu_fast(v0[2]) * v0[3]); w.y = cvtpk(silu_fast(v1[0]) * v1[1], silu_fast(v1[2]) * v1[3]);
      *(u32x2*)(O + (size_t)row * DM + ((colt + cl) >> 1)) = w;
    EPI_LOOP_END
  } };
struct EpiSwiGLU8 { static constexpr bool PERM = true, AFTER_DRAIN = false; unsigned char* O;
  DEVI void operator()(const f32x4 (&acc)[2][2][4][2], const Unit& u, int wr, int wc, int fr, int fq) const {
    const int colt = (u.pn & 7) * 256;
    EPI_LOOP_BEGIN
      const unsigned w = nv::pack4_fp8(silu_fast(v0[0]) * v0[1] * nv::A8_SCALE, silu_fast(v0[2]) * v0[3] * nv::A8_SCALE, silu_fast(v1[0]) * v1[1] * nv::A8_SCALE, silu_fast(v1[2]) * v1[3] * nv::A8_SCALE);
      *(unsigned*)(O + (size_t)row * DM + ((colt + cl) >> 1)) = w;
    EPI_LOOP_END
  } };
struct EpiDown { static constexpr bool PERM = true, AFTER_DRAIN = false; bf16_t* O;
  DEVI void operator()(const f32x4 (&acc)[2][2][4][2], const Unit& u, int wr, int wc, int fr, int fq) const {
    const int colt = (u.pn & 3) * 256;
    EPI_LOOP_BEGIN
      u32x4 w; w.x = cvtpk(v0[0], v0[1]); w.y = cvtpk(v0[2], v0[3]); w.z = cvtpk(v1[0], v1[1]); w.w = cvtpk(v1[2], v1[3]);
      *(u32x4*)(O + (size_t)row * DM + colt + cl) = w;
    EPI_LOOP_END
  } };
struct ExpOrder : pg8::StaticOrder { int nMe, nNe;
  __device__ void init2(int erows, int Ne, int G_, int c_) { nMe = erows / 256; nNe = Ne / 256; init(NE * erows, Ne, G_, c_); }
  __device__ bool next(int i, Unit& u) const { if (!pg8::StaticOrder::next(i, u)) return false; u.pn += (u.pm / nMe) * nNe; return true; } };

typedef PG8_LAS unsigned char* ldsp_t;
DEVI void phase_qkv0(const Params& p, ldsp_t lds) {
  pg8::Gemm g{(const bf16_t*)(p.ws + WS_H), (const bf16_t*)(p.ws + WS_WIN0), NROW, N_IN0, DM, nullptr, nv::W8_E8M0, nv::A8_E8M0}; pg8::StaticOrder S; S.init(NROW, N_IN0, gridDim.x, blockIdx.x);
  PG8_LAS float* RL = (PG8_LAS float*)(lds + pg8::STAGE_BYTES);
  for (int i = ftid(); i < 64 * 16 * 2; i += NT) RL[i] = ((const float*)(p.ws + WS_CTL + CTL_ROPE))[i];
  __syncthreads();
  EpiQKV0 E{(bf16_t*)(p.ws + WS_QKV0), RL, (unsigned char*)(p.ws + WS_VT)};
  pg8::gemm_phase<EpiQKV0, pg8::StaticOrder, true, true, (QKV0_FP8 != 0)>(lds, g, S, E);
}
DEVI void phase_qkv1(const Params& p, ldsp_t lds) {
  pg8::Gemm g{(const bf16_t*)(p.ws + WS_H), (const bf16_t*)(p.ws + WS_WIN1), NROW, N_IN1P, DM, nullptr, nv::W8_E8M0, nv::A8_E8M0}; pg8::StaticOrder S; S.init(NROW, N_IN1P, gridDim.x, blockIdx.x);
  PG8_LAS float* RL = (PG8_LAS float*)(lds + pg8::STAGE_BYTES);
  for (int i = ftid(); i < 64 * 16 * 2; i += NT) RL[i] = ((const float*)(p.ws + WS_CTL + CTL_ROPE))[i];
  __syncthreads();
  EpiQKV1 E{(bf16_t*)(p.ws + WS_P1), (float*)(p.ws + WS_DT), RL};
  pg8::gemm_phase<EpiQKV1, pg8::StaticOrder, true, true, (QKV1_FP8 != 0)>(lds, g, S, E);
}
DEVI void phase_outproj(const Params& p, ldsp_t lds, int layer) {
  const int M = layer ? NLAT : NROW;
  pg8::Gemm g{(const bf16_t*)(p.ws + (layer ? WS_ATT1 : WS_ATT0)), (const bf16_t*)(p.ws + (layer ? WS_WOUT1 : WS_WOUT0)), M, DM, DM}; pg8::StaticOrder S; S.init(M, DM, gridDim.x, blockIdx.x);
  EpiPlain E{(bf16_t*)(p.ws + (layer ? WS_MIX1 : WS_MIX0))};
  pg8::gemm_phase<EpiPlain, pg8::StaticOrder, true, true>(lds, g, S, E);
}
DEVI void phase_moe_up(const Params& p, ldsp_t lds, int layer) {
  const int erows = layer ? EROWS1 : EROWS0;
  pg8::Gemm g{(const bf16_t*)(p.ws + WS_H), (const bf16_t*)(p.ws + WS_WGU), NE * erows, 2048, DM, (const int*)(p.ws + WS_IDX)}; ExpOrder S; S.init2(erows, 2048, gridDim.x, blockIdx.x);
  EpiSwiGLU E{(bf16_t*)(p.ws + WS_HID)};
  pg8::gemm_phase<EpiSwiGLU, ExpOrder, true, true>(lds, g, S, E);
}
DEVI void phase_moe_down(const Params& p, ldsp_t lds, int layer) {
  const int erows = layer ? EROWS1 : EROWS0;
  pg8::Gemm g{(const bf16_t*)(p.ws + WS_HID), (const bf16_t*)(p.ws + WS_WD), NE * erows, DM, DM}; ExpOrder S; S.init2(erows, DM, gridDim.x, blockIdx.x);
  EpiDown E{(bf16_t*)(p.ws + WS_Y)};
  pg8::gemm_phase<EpiDown, ExpOrder, true, true>(lds, g, S, E);
}
DEVI void phase_moe_up8(const Params& p, ldsp_t lds, int layer) {
  const int erows = layer ? EROWS1 : EROWS0;
  pg8::Gemm g{(const bf16_t*)(p.ws + WS_H), (const bf16_t*)(p.ws + WS_WGU), NE * erows, 2048, DM, (const int*)(p.ws + WS_IDX), nv::W8_E8M0, nv::A8_E8M0}; ExpOrder S; S.init2(erows, 2048, gridDim.x, blockIdx.x);
  EpiSwiGLU8 E{(unsigned char*)(p.ws + WS_HID)};
  pg8::gemm_phase<EpiSwiGLU8, ExpOrder, true, FP8_SP2, true>(lds, g, S, E);
}
DEVI void phase_moe_down8(const Params& p, ldsp_t lds, int layer) {
  const int erows = layer ? EROWS1 : EROWS0;
  pg8::Gemm g{(const bf16_t*)(p.ws + WS_HID), (const bf16_t*)(p.ws + WS_WD), NE * erows, DM, DM, nullptr, nv::W8_E8M0, nv::A8_E8M0}; ExpOrder S; S.init2(erows, DM, gridDim.x, blockIdx.x);
  EpiDown E{(bf16_t*)(p.ws + WS_Y)};
  pg8::gemm_phase<EpiDown, ExpOrder, true, FP8_SP2, true>(lds, g, S, E);
}
DEVI void phase_gather(const Params& p, int layer) {
  const int lane = ftid() & 63, gw = blockIdx.x * NWAVE + (ftid() >> 6), NGW = gridDim.x * NWAVE;
  const int erows = layer ? EROWS1 : EROWS0; const int* IDX = (const int*)(p.ws + WS_IDX);
  const bf16_t* H = (const bf16_t*)(p.ws + WS_H); bf16_t* XG = (bf16_t*)(p.ws + WS_XG);
  for (int r = gw; r < NE * erows; r += NGW) {
    const uint4* s = (const uint4*)(H + (size_t)IDX[r] * DM) + lane; uint4* d = (uint4*)(XG + (size_t)r * DM) + lane;
    const uint4 a = s[0], b = s[64]; d[0] = a; d[64] = b;
  }
}
}
#ifndef ATTNA_FP8
#define ATTNA_FP8 1
#endif
namespace fa {
#define FA_LAS __attribute__((address_space(3)))
typedef short bf16x8 __attribute__((ext_vector_type(8)));
typedef short s16x4 __attribute__((ext_vector_type(4)));
typedef float f32x16 __attribute__((ext_vector_type(16)));
typedef FA_LAS unsigned char* ldsp_t;
typedef unsigned u32x4 __attribute__((ext_vector_type(4)));
constexpr float LOG2E = 1.4426950408889634f, C2 = 0.125f * LOG2E;
DEVI int crow(int r, int hi) { return (r & 3) + 8 * (r >> 2) + 4 * hi; }
DEVI unsigned cvtpk(float lo, float hi) { typedef float f2_t __attribute__((ext_vector_type(2))); typedef __bf16 b2_t __attribute__((ext_vector_type(2))); const f2_t v = {lo, hi}; const b2_t b = __builtin_convertvector(v, b2_t); return __builtin_bit_cast(unsigned, b); }
DEVI s16x4 vtr(ldsp_t p) { return __builtin_bit_cast(s16x4, __builtin_amdgcn_ds_read_tr16_b64_v4i16((FA_LAS s16x4*)p)); }

DEVI float max3f(float a, float b, float c) { float r; asm("v_max3_f32 %0, %1, %2, %3" : "=v"(r) : "v"(a), "v"(b), "v"(c)); return r; }
template <int KW, int DVB> struct Geo {
  static constexpr int VW = DVB * 32;
  static constexpr int KSTR = KW * 2 + 16, VSTR = VW * 2 + 64;
  static constexpr int KBYTES = 64 * KSTR, VBYTES = 64 * VSTR, STAGE = KBYTES + VBYTES;
  static constexpr int CPR = (KW + VW) / 8, NCH = 64 * CPR / NT;
};

DEVI bf16x8 load_q8(const bf16_t* p, float sc) {
  const uint4 w = *(const uint4*)p; const unsigned u[4] = {w.x, w.y, w.z, w.w}; unsigned o[4];
#pragma unroll
  for (int i = 0; i < 4; ++i) o[i] = cvtpk(__uint_as_float(u[i] << 16) * sc, __uint_as_float(u[i] & 0xffff0000u) * sc);
  uint4 r = make_uint4(o[0], o[1], o[2], o[3]); return __builtin_bit_cast(bf16x8, r);
}

template <int KW, int DVB, class Src, class Act, class Msk>
DEVI void flash_pass(ldsp_t lds, int ntiles, const bf16_t* kv, int ld, int kcol, int vcol, const bf16x8 (&q)[4], int kofs,
                     Src src, Act act, Msk msk, f32x16 (&o)[DVB], float& m, float& l) {
  typedef Geo<KW, DVB> G;
  const int tid = ftid(), lane = tid & 63, r32 = lane & 31, hi = lane >> 5;
  u32x4 stg[G::NCH];
  int crw[G::NCH], ccol[G::NCH], cdst[G::NCH];
#pragma unroll
  for (int i = 0; i < G::NCH; ++i) { const int c = tid + NT * i, row = c / G::CPR, cc = c % G::CPR; crw[i] = row;
    if (cc < KW / 8) { ccol[i] = kcol + cc * 8; cdst[i] = row * G::KSTR + cc * 16; } else { ccol[i] = vcol + (cc - KW / 8) * 8; cdst[i] = G::KBYTES + row * G::VSTR + (cc - KW / 8) * 16; } }
#pragma unroll
  for (int i = 0; i < G::NCH; ++i) stg[i] = *(const u32x4*)(kv + (size_t)src(0, crw[i]) * ld + ccol[i]);
#pragma unroll
  for (int i = 0; i < G::NCH; ++i) *(FA_LAS u32x4*)(lds + cdst[i]) = stg[i];
  __syncthreads();
  const int kroff = r32 * G::KSTR + (kofs + 8 * hi) * 2;
  const int vroff = G::KBYTES + (4 * hi + ((lane & 15) >> 2)) * G::VSTR + 32 * ((lane >> 4) & 1) + 8 * (lane & 3);
  for (int kt = 0; kt < ntiles; ++kt) {
    const int buf = (kt & 1) * G::STAGE;
    const bool more = kt + 1 < ntiles;
    if (more) {
#pragma unroll
      for (int i = 0; i < G::NCH; ++i) stg[i] = *(const u32x4*)(kv + (size_t)src(kt + 1, crw[i]) * ld + ccol[i]);
    }
    if (act(kt)) {
      const ldsp_t kb = lds + buf + kroff;
      f32x16 p0, p1;
#pragma unroll
      for (int r = 0; r < 16; ++r) { p0[r] = 0.f; p1[r] = 0.f; }
#pragma unroll
      for (int d0 = 0; d0 < 4; ++d0) {
        const bf16x8 a0 = *(const FA_LAS bf16x8*)(kb + d0 * 32), a1 = *(const FA_LAS bf16x8*)(kb + 32 * G::KSTR + d0 * 32);
        p0 = __builtin_amdgcn_mfma_f32_32x32x16_bf16(a0, q[d0], p0, 0, 0, 0);
        p1 = __builtin_amdgcn_mfma_f32_32x32x16_bf16(a1, q[d0], p1, 0, 0, 0);
      }
      msk(kt, p0, p1);
      float mx = fmaxf(p0[0], p1[0]);
#pragma unroll
      for (int r = 1; r < 16; ++r) mx = fmaxf(mx, fmaxf(p0[r], p1[r]));
      mx = fmaxf(mx, __shfl_xor(mx, 32));
      if (__any(mx > m)) {
        const float mn = fmaxf(m, mx), alpha = __builtin_amdgcn_exp2f(m - mn);
        l *= alpha; m = mn;
#pragma unroll
        for (int b = 0; b < DVB; ++b)
#pragma unroll
          for (int r = 0; r < 16; ++r) o[b][r] *= alpha;
      }
      float ls = 0.f;
#pragma unroll
      for (int r = 0; r < 16; ++r) { p0[r] = __builtin_amdgcn_exp2f(p0[r] - m); p1[r] = __builtin_amdgcn_exp2f(p1[r] - m); ls += p0[r] + p1[r]; }
      l += ls;
      bf16x8 pa[4];
      { uint4 t;
        t = make_uint4(cvtpk(p0[0], p0[1]), cvtpk(p0[2], p0[3]), cvtpk(p0[4], p0[5]), cvtpk(p0[6], p0[7])); pa[0] = __builtin_bit_cast(bf16x8, t);
        t = make_uint4(cvtpk(p0[8], p0[9]), cvtpk(p0[10], p0[11]), cvtpk(p0[12], p0[13]), cvtpk(p0[14], p0[15])); pa[1] = __builtin_bit_cast(bf16x8, t);
        t = make_uint4(cvtpk(p1[0], p1[1]), cvtpk(p1[2], p1[3]), cvtpk(p1[4], p1[5]), cvtpk(p1[6], p1[7])); pa[2] = __builtin_bit_cast(bf16x8, t);
        t = make_uint4(cvtpk(p1[8], p1[9]), cvtpk(p1[10], p1[11]), cvtpk(p1[12], p1[13]), cvtpk(p1[14], p1[15])); pa[3] = __builtin_bit_cast(bf16x8, t); }
      const ldsp_t vb = lds + buf + vroff;
#pragma unroll
      for (int b = 0; b < DVB; ++b)
#pragma unroll
        for (int ks = 0; ks < 4; ++ks) {
          const s16x4 lo = vtr(vb + (16 * ks) * G::VSTR + b * 64), h8 = vtr(vb + (16 * ks + 8) * G::VSTR + b * 64);
          const bf16x8 vf = {lo[0], lo[1], lo[2], lo[3], h8[0], h8[1], h8[2], h8[3]};
          o[b] = __builtin_amdgcn_mfma_f32_32x32x16_bf16(vf, pa[ks], o[b], 0, 0, 0);
        }
    }
    if (more) {
      const int nb = ((kt + 1) & 1) * G::STAGE;
#pragma unroll
      for (int i = 0; i < G::NCH; ++i) *(FA_LAS u32x4*)(lds + nb + cdst[i]) = stg[i];
    }
    __syncthreads();
  }
}


template <int V> struct IC { static constexpr int value = V; };
template <int KW, int DVB, int ABL, int PF, class Src, class Msk>
DEVI void flash_pass2(ldsp_t lds, int ntiles, const bf16_t* kv, int ld, int kcol, int vcol, const bf16x8 (&q)[4], int kofs,
                      Src src, Msk msk, f32x16 (&o)[DVB], float& m, float& l) {
  typedef Geo<KW, DVB> G;
  const int tid = ftid(), lane = tid & 63, r32 = lane & 31, hi = lane >> 5;
  u32x4 stg[PF][G::NCH];
  int crw[G::NCH], ccol[G::NCH], cdst[G::NCH];
#pragma unroll
  for (int i = 0; i < G::NCH; ++i) { const int c = tid + NT * i, row = c / G::CPR, cc = c % G::CPR; crw[i] = row;
    if (cc < KW / 8) { ccol[i] = kcol + cc * 8; cdst[i] = row * G::KSTR + cc * 16; } else { ccol[i] = vcol + (cc - KW / 8) * 8; cdst[i] = G::KBYTES + row * G::VSTR + (cc - KW / 8) * 16; } }
#define FP2_LOAD(kt, set) _Pragma("unroll") for (int i = 0; i < G::NCH; ++i) stg[set][i] = *(const u32x4*)(kv + (size_t)src((kt), crw[i]) * ld + ccol[i])
#define FP2_STORE(st, set) _Pragma("unroll") for (int i = 0; i < G::NCH; ++i) *(FA_LAS u32x4*)(lds + (st) * G::STAGE + cdst[i]) = stg[set][i]
  FP2_LOAD(0, 0); FP2_STORE(0, 0);
  if (ntiles > 1) { FP2_LOAD(1, 0); FP2_STORE(1, 0); }
  __syncthreads();
  if (ntiles > 2) FP2_LOAD(2, 0);
  if (PF == 2) { if (ntiles > 3) FP2_LOAD(3, PF - 1); }
  const int kroff = r32 * G::KSTR + (kofs + 8 * hi) * 2;
  const int vroff = G::KBYTES + (4 * hi + ((lane & 15) >> 2)) * G::VSTR + 32 * ((lane >> 4) & 1) + 8 * (lane & 3);
  f32x16 c0, c1;
#pragma unroll
  for (int r = 0; r < 16; ++r) { c0[r] = 0.f; c1[r] = 0.f; }
  { const ldsp_t kb = lds + kroff;
#pragma unroll
    for (int d0 = 0; d0 < 4; ++d0) {
      const bf16x8 a0 = *(const FA_LAS bf16x8*)(kb + d0 * 32), a1 = *(const FA_LAS bf16x8*)(kb + 32 * G::KSTR + d0 * 32);
      c0 = __builtin_amdgcn_mfma_f32_32x32x16_bf16(a0, q[d0], c0, 0, 0, 0); c1 = __builtin_amdgcn_mfma_f32_32x32x16_bf16(a1, q[d0], c1, 0, 0, 0); } }
  asm volatile("s_nop 15\n\ts_nop 7" : "+v"(c0), "+v"(c1));
  int st_cur = 0, st_nxt = 1, st_fill = 2;
  auto body = [&](int kt, auto PARC) {
    constexpr int set = (PF == 2) ? decltype(PARC)::value : 0;
    msk(kt, c0, c1);
    __builtin_amdgcn_sched_barrier(0);
    f32x16 n0, n1;
#pragma unroll
    for (int r = 0; r < 16; ++r) { n0[r] = 0.f; n1[r] = 0.f; }
    const ldsp_t kb = lds + st_nxt * G::STAGE + kroff;
    bf16x8 ka[4], kb2[4];
#pragma unroll
    for (int d0 = 0; d0 < 4; ++d0) { ka[d0] = *(const FA_LAS bf16x8*)(kb + d0 * 32); kb2[d0] = *(const FA_LAS bf16x8*)(kb + 32 * G::KSTR + d0 * 32); }
#define FP2_SB() __builtin_amdgcn_sched_barrier(0)
#define FP2_MMA(acc, kf, d0) acc = __builtin_amdgcn_mfma_f32_32x32x16_bf16(kf[d0], q[d0], acc, 0, 0, 0)
#define FP2_EXP(cx, r) { if (ABL != 1) { cx[r] = __builtin_amdgcn_exp2f(cx[r] - mn); ls += cx[r]; } }
    FP2_SB(); FP2_MMA(n0, ka, 0);
    float mxa = max3f(c0[0], c0[1], c1[0]), mxb = max3f(c0[2], c0[3], c1[1]);
    mxa = max3f(mxa, c1[2], c1[3]);
    mxa = max3f(mxa, c0[4], c0[5]); mxb = max3f(mxb, c0[6], c0[7]); mxa = max3f(mxa, c1[4], c1[5]); mxb = max3f(mxb, c1[6], c1[7]);
    FP2_SB(); FP2_MMA(n1, kb2, 0);
    mxa = max3f(mxa, c0[8], c0[9]); mxb = max3f(mxb, c0[10], c0[11]); mxa = max3f(mxa, c1[8], c1[9]); mxb = max3f(mxb, c1[10], c1[11]);
    mxa = max3f(mxa, c0[12], c0[13]); mxb = max3f(mxb, c0[14], c0[15]); mxa = max3f(mxa, c1[12], c1[13]); mxb = max3f(mxb, c1[14], c1[15]);
    float mx = max3f(mxa, mxb, m);
    mx = max3f(mx, __shfl_xor(mx, 32), mx);
    const float mn = mx, alpha = __builtin_amdgcn_exp2f(m - mn);
    const bool resc = __any(mn > m);
    m = mn;
    float ls = 0.f;
    FP2_SB(); FP2_MMA(n0, ka, 1);
    FP2_EXP(c0, 0) FP2_EXP(c0, 1) FP2_EXP(c0, 2) FP2_EXP(c0, 3) FP2_EXP(c0, 4) FP2_EXP(c0, 5)
    FP2_SB(); FP2_MMA(n1, kb2, 1);
    FP2_EXP(c0, 6) FP2_EXP(c0, 7) FP2_EXP(c0, 8) FP2_EXP(c0, 9) FP2_EXP(c0, 10) FP2_EXP(c0, 11)
    FP2_SB(); FP2_MMA(n0, ka, 2);
    FP2_EXP(c0, 12) FP2_EXP(c0, 13) FP2_EXP(c0, 14) FP2_EXP(c0, 15) FP2_EXP(c1, 0) FP2_EXP(c1, 1)
    FP2_SB(); FP2_MMA(n1, kb2, 2);
    FP2_EXP(c1, 2) FP2_EXP(c1, 3) FP2_EXP(c1, 4) FP2_EXP(c1, 5) FP2_EXP(c1, 6) FP2_EXP(c1, 7)
    FP2_SB(); FP2_MMA(n0, ka, 3);
    FP2_EXP(c1, 8) FP2_EXP(c1, 9) FP2_EXP(c1, 10) FP2_EXP(c1, 11) FP2_EXP(c1, 12) FP2_EXP(c1, 13)
    FP2_SB(); FP2_MMA(n1, kb2, 3);
    FP2_EXP(c1, 14) FP2_EXP(c1, 15)
    bf16x8 pa[4];
    { u32x4 t;
      t[0] = cvtpk(c0[0], c0[1]); t[1] = cvtpk(c0[2], c0[3]); t[2] = cvtpk(c0[4], c0[5]); t[3] = cvtpk(c0[6], c0[7]); pa[0] = __builtin_bit_cast(bf16x8, t);
      t[0] = cvtpk(c0[8], c0[9]); t[1] = cvtpk(c0[10], c0[11]); t[2] = cvtpk(c0[12], c0[13]); t[3] = cvtpk(c0[14], c0[15]); pa[1] = __builtin_bit_cast(bf16x8, t);
      t[0] = cvtpk(c1[0], c1[1]); t[1] = cvtpk(c1[2], c1[3]); t[2] = cvtpk(c1[4], c1[5]); t[3] = cvtpk(c1[6], c1[7]); pa[2] = __builtin_bit_cast(bf16x8, t);
      t[0] = cvtpk(c1[8], c1[9]); t[1] = cvtpk(c1[10], c1[11]); t[2] = cvtpk(c1[12], c1[13]); t[3] = cvtpk(c1[14], c1[15]); pa[3] = __builtin_bit_cast(bf16x8, t); }
    asm volatile("" : "+v"(pa[0]), "+v"(pa[1]), "+v"(pa[2]), "+v"(pa[3]));
    FP2_SB();
    l = l * alpha + ls;
    __builtin_amdgcn_sched_barrier(0);
    if (resc) {
#pragma unroll
      for (int b = 0; b < DVB; ++b)
#pragma unroll
        for (int r = 0; r < 16; ++r) o[b][r] *= alpha;
    }
    const ldsp_t vb = lds + st_cur * G::STAGE + vroff;
    s16x4 vl[2][DVB], vh[2][DVB];
#pragma unroll
    for (int b = 0; b < DVB; ++b) { vl[0][b] = vtr(vb + b * 64); vh[0][b] = vtr(vb + 8 * G::VSTR + b * 64); }
#pragma unroll
    for (int ks = 0; ks < 4; ++ks) {
      FP2_SB();
      if (ks < 3) {
#pragma unroll
        for (int b = 0; b < DVB; ++b) { vl[(ks + 1) & 1][b] = vtr(vb + (16 * (ks + 1)) * G::VSTR + b * 64); vh[(ks + 1) & 1][b] = vtr(vb + (16 * (ks + 1) + 8) * G::VSTR + b * 64); }
      }
      FP2_SB();
#pragma unroll
      for (int b = 0; b < DVB; ++b) {
        const s16x4 lo = vl[ks & 1][b], h8 = vh[ks & 1][b];
        const bf16x8 vf = {lo[0], lo[1], lo[2], lo[3], h8[0], h8[1], h8[2], h8[3]};
        if (ABL != 2) o[b] = __builtin_amdgcn_mfma_f32_32x32x16_bf16(vf, pa[ks], o[b], 0, 0, 0); else o[b][0] += __builtin_bit_cast(float, (int)vf[0]);
      }
    }
    FP2_SB();
    if (ABL != 3) { if (kt + 2 < ntiles) FP2_STORE(st_fill, set); }
    __syncthreads();
    if (ABL != 3) { if (kt + 2 + PF < ntiles) FP2_LOAD(kt + 2 + PF, set); }
    c0 = n0; c1 = n1;
    { const int t = st_cur; st_cur = st_nxt; st_nxt = st_fill; st_fill = t; }
  };
  if (PF == 2) { for (int kt = 0; kt < ntiles; kt += 2) { body(kt, IC<0>{}); if (kt + 1 < ntiles) body(kt + 1, IC<1>{}); } }
  else { for (int kt = 0; kt < ntiles; ++kt) body(kt, IC<0>{}); }
#undef FP2_LOAD
#undef FP2_STORE
}


constexpr int A8_KSTR = 272, A8_VSTR = 80, A8_KB = 64 * A8_KSTR, A8_STAGE = A8_KB + 128 * A8_VSTR;
template <class Src>
DEVI void flash_passA8(ldsp_t lds, int ntiles, const bf16_t* kv, int ld, int kcol, const unsigned char* vt, int vkey0, const bf16x8 (&q)[4], int kofs,
                       Src src, f32x16 (&o)[4], float& m, float& l) {
  typedef int v8i_t __attribute__((ext_vector_type(8)));
  const int tid = ftid(), lane = tid & 63, r32 = lane & 31, hi = lane >> 5;
  u32x4 stk[2], stv;
  const int krow0 = tid >> 4, kcc = tid & 15;
  const int vrow = tid >> 2, vpc = tid & 3;
  const unsigned char* vsrc = vt + (size_t)vrow * 4352 + vkey0 + vpc * 16;
#define A8_LOAD(kt) do { stk[0] = *(const u32x4*)(kv + (size_t)src((kt), krow0) * ld + kcol + kcc * 8); stk[1] = *(const u32x4*)(kv + (size_t)src((kt), krow0 + 32) * ld + kcol + kcc * 8); \
    stv = *(const u32x4*)(vsrc + (kt) * 64); } while (0)
#define A8_STORE(st) do { *(FA_LAS u32x4*)(lds + (st) * A8_STAGE + krow0 * A8_KSTR + kcc * 16) = stk[0]; *(FA_LAS u32x4*)(lds + (st) * A8_STAGE + (krow0 + 32) * A8_KSTR + kcc * 16) = stk[1]; \
    *(FA_LAS u32x4*)(lds + (st) * A8_STAGE + A8_KB + vrow * A8_VSTR + vpc * 16) = stv; } while (0)
  A8_LOAD(0); A8_STORE(0);
  if (ntiles > 1) { A8_LOAD(1); A8_STORE(1); }
  __syncthreads();
  if (ntiles > 2) A8_LOAD(2);
  const int kroff = r32 * A8_KSTR + (kofs + 8 * hi) * 2;
  const int vroff = A8_KB + r32 * A8_VSTR + 32 * hi;
  f32x16 c0, c1;
#pragma unroll
  for (int r = 0; r < 16; ++r) { c0[r] = 0.f; c1[r] = 0.f; }
  { const ldsp_t kb = lds + kroff;
#pragma unroll
    for (int d0 = 0; d0 < 4; ++d0) {
      const bf16x8 a0 = *(const FA_LAS bf16x8*)(kb + d0 * 32), a1 = *(const FA_LAS bf16x8*)(kb + 32 * A8_KSTR + d0 * 32);
      c0 = __builtin_amdgcn_mfma_f32_32x32x16_bf16(a0, q[d0], c0, 0, 0, 0); c1 = __builtin_amdgcn_mfma_f32_32x32x16_bf16(a1, q[d0], c1, 0, 0, 0); } }
  asm volatile("s_nop 15\n\ts_nop 7" : "+v"(c0), "+v"(c1));
  int st_cur = 0, st_nxt = 1, st_fill = 2;
  for (int kt = 0; kt < ntiles; ++kt) {
    __builtin_amdgcn_sched_barrier(0);
    f32x16 n0, n1;
#pragma unroll
    for (int r = 0; r < 16; ++r) { n0[r] = 0.f; n1[r] = 0.f; }
    const ldsp_t kb = lds + st_nxt * A8_STAGE + kroff;
    bf16x8 ka[4], kb2[4];
#pragma unroll
    for (int d0 = 0; d0 < 4; ++d0) { ka[d0] = *(const FA_LAS bf16x8*)(kb + d0 * 32); kb2[d0] = *(const FA_LAS bf16x8*)(kb + 32 * A8_KSTR + d0 * 32); }
#define A8_SB() __builtin_amdgcn_sched_barrier(0)
#define A8_MMA(acc, kf, d0) acc = __builtin_amdgcn_mfma_f32_32x32x16_bf16(kf[d0], q[d0], acc, 0, 0, 0)
#define A8_EXP(cx, r) { cx[r] = __builtin_amdgcn_exp2f(cx[r] - mn); ls += cx[r]; }
    A8_SB(); A8_MMA(n0, ka, 0);
    float mxa = max3f(c0[0], c0[1], c1[0]), mxb = max3f(c0[2], c0[3], c1[1]);
    mxa = max3f(mxa, c1[2], c1[3]);
    mxa = max3f(mxa, c0[4], c0[5]); mxb = max3f(mxb, c0[6], c0[7]); mxa = max3f(mxa, c1[4], c1[5]); mxb = max3f(mxb, c1[6], c1[7]);
    A8_SB(); A8_MMA(n1, kb2, 0);
    mxa = max3f(mxa, c0[8], c0[9]); mxb = max3f(mxb, c0[10], c0[11]); mxa = max3f(mxa, c1[8], c1[9]); mxb = max3f(mxb, c1[10], c1[11]);
    mxa = max3f(mxa, c0[12], c0[13]); mxb = max3f(mxb, c0[14], c0[15]); mxa = max3f(mxa, c1[12], c1[13]); mxb = max3f(mxb, c1[14], c1[15]);
    float mx = max3f(mxa, mxb, m);
    mx = max3f(mx, __shfl_xor(mx, 32), mx);
    const float mn = mx, alpha = __builtin_amdgcn_exp2f(m - mn);
    const bool resc = __any(mn > m);
    m = mn;
    float ls = 0.f;
    A8_SB(); A8_MMA(n0, ka, 1);
    A8_EXP(c0, 0) A8_EXP(c0, 1) A8_EXP(c0, 2) A8_EXP(c0, 3) A8_EXP(c0, 4) A8_EXP(c0, 5)
    A8_SB(); A8_MMA(n1, kb2, 1);
    A8_EXP(c0, 6) A8_EXP(c0, 7) A8_EXP(c0, 8) A8_EXP(c0, 9) A8_EXP(c0, 10) A8_EXP(c0, 11)
    A8_SB(); A8_MMA(n0, ka, 2);
    A8_EXP(c0, 12) A8_EXP(c0, 13) A8_EXP(c0, 14) A8_EXP(c0, 15) A8_EXP(c1, 0) A8_EXP(c1, 1)
    A8_SB(); A8_MMA(n1, kb2, 2);
    A8_EXP(c1, 2) A8_EXP(c1, 3) A8_EXP(c1, 4) A8_EXP(c1, 5) A8_EXP(c1, 6) A8_EXP(c1, 7)
    A8_SB(); A8_MMA(n0, ka, 3);
    A8_EXP(c1, 8) A8_EXP(c1, 9) A8_EXP(c1, 10) A8_EXP(c1, 11) A8_EXP(c1, 12) A8_EXP(c1, 13)
    A8_SB(); A8_MMA(n1, kb2, 3);
    A8_EXP(c1, 14) A8_EXP(c1, 15)
    unsigned X[4], Y[4];
#pragma unroll
    for (int i = 0; i < 4; ++i) {
      int w = 0; w = __builtin_amdgcn_cvt_pk_fp8_f32(c0[4 * i] * 16.f, c0[4 * i + 1] * 16.f, w, false); w = __builtin_amdgcn_cvt_pk_fp8_f32(c0[4 * i + 2] * 16.f, c0[4 * i + 3] * 16.f, w, true); X[i] = (unsigned)w;
      int z = 0; z = __builtin_amdgcn_cvt_pk_fp8_f32(c1[4 * i] * 16.f, c1[4 * i + 1] * 16.f, z, false); z = __builtin_amdgcn_cvt_pk_fp8_f32(c1[4 * i + 2] * 16.f, c1[4 * i + 3] * 16.f, z, true); Y[i] = (unsigned)z; }
#pragma unroll
    for (int i = 0; i < 4; ++i) { const auto rr = __builtin_amdgcn_permlane32_swap(X[i], Y[i], false, false); X[i] = rr[0]; Y[i] = rr[1]; }
    v8i_t pb = {(int)X[0], (int)X[1], (int)X[2], (int)X[3], (int)Y[0], (int)Y[1], (int)Y[2], (int)Y[3]};
    asm volatile("" : "+v"(pb));
    A8_SB();
    l = l * alpha + ls;
    __builtin_amdgcn_sched_barrier(0);
    if (resc) {
#pragma unroll
      for (int b = 0; b < 4; ++b)
#pragma unroll
        for (int r = 0; r < 16; ++r) o[b][r] *= alpha;
    }
    { const ldsp_t vb = lds + st_cur * A8_STAGE + vroff;
      u32x4 v0[4], v1[4];
#pragma unroll
      for (int b = 0; b < 4; ++b) { v0[b] = *(const FA_LAS u32x4*)(vb + b * 32 * A8_VSTR); v1[b] = *(const FA_LAS u32x4*)(vb + b * 32 * A8_VSTR + 16); }
#pragma unroll
      for (int b = 0; b < 4; ++b) {
        const v8i_t va = {(int)v0[b][0], (int)v0[b][1], (int)v0[b][2], (int)v0[b][3], (int)v1[b][0], (int)v1[b][1], (int)v1[b][2], (int)v1[b][3]};
        o[b] = __builtin_amdgcn_mfma_scale_f32_32x32x64_f8f6f4(va, pb, o[b], 0, 0, 0, 0x7d7d7d7d  , 0, 0x7b7b7b7b  );
      } }
    A8_SB();
    if (kt + 2 < ntiles) A8_STORE(st_fill);
    __syncthreads();
    if (kt + 3 < ntiles) A8_LOAD(kt + 3);
    c0 = n0; c1 = n1;
    { const int t = st_cur; st_cur = st_nxt; st_nxt = st_fill; st_fill = t; }
  }
#undef A8_LOAD
#undef A8_STORE
#undef A8_SB
#undef A8_MMA
#undef A8_EXP
}

DEVI int vblock() { const int G = gridDim.x, bx = blockIdx.x; return (G % 8 == 0) ? (bx % 8) * (G / 8) + bx / 8 : bx; }

template <int ABL = 0> DEVI void phase_attnA(const Params& p, ldsp_t lds) {
  typedef Geo<128, 4> G;
  const int tid = ftid(), lane = tid & 63, wave = __builtin_amdgcn_readfirstlane(tid >> 6), r32 = lane & 31, hi = lane >> 5;
  const bf16_t* Q = (const bf16_t*)(p.ws + WS_QKV0); bf16_t* ATT = (bf16_t*)(p.ws + (ABL ? WS_MIX0 : WS_ATT0));
  const float lam = ((const float*)(p.ws + WS_CTL + CTL_LAM))[0];
  const int s = wave >> 2, qb = wave & 3;
  constexpr int NU_LAT = NB * 4 * 32, NU_CTX = NB * 4 * 2;
  for (int u = vblock(); u < NU_LAT + NU_CTX; u += gridDim.x) {
    int b, h, row0, ntiles; bool lat = u < NU_LAT;
    if (lat) { b = u >> 7; h = (u >> 5) & 3; row0 = b * SEQ + (u & 31) * 128; ntiles = 68; }
    else { const int v = u - NU_LAT; b = v >> 3; h = (v >> 1) & 3; row0 = NLAT + b * CTXL + (v & 1) * 128; ntiles = 4; }
    const int qrow = row0 + qb * 32 + r32;
    bf16x8 q[4];
#pragma unroll
    for (int d0 = 0; d0 < 4; ++d0) q[d0] = load_q8(Q + (size_t)qrow * N_IN0 + h * 128 + s * 64 + 16 * d0 + 8 * hi, C2);
    f32x16 o[4];
#pragma unroll
    for (int bk = 0; bk < 4; ++bk)
#pragma unroll
      for (int r = 0; r < 16; ++r) o[bk][r] = 0.f;
    float m = -1e30f, l = 0.f;
    const int cbase = NLAT + b * CTXL, lbase = b * SEQ;
#if ATTNA_FP8
    flash_passA8(lds, ntiles, Q, N_IN0, 512 + h * 128, (const unsigned char*)(p.ws + WS_VT) + (size_t)((b * 4 + h) * 128) * 4352, lat ? 0 : 4096, q, s * 64,
      [&](int kt, int i) { return lat ? (kt < 64 ? lbase + kt * 64 + i : cbase + (kt - 64) * 64 + i) : cbase + kt * 64 + i; }, o, m, l);
#else
    flash_pass2<128, 4, ABL, 1>(lds, ntiles, Q, N_IN0, 512 + h * 128, 1024 + h * 128, q, s * 64,
      [&](int kt, int i) { return lat ? (kt < 64 ? lbase + kt * 64 + i : cbase + (kt - 64) * 64 + i) : cbase + kt * 64 + i; },
      [&](int, f32x16&, f32x16&) {}, o, m, l);
#endif
    l += __shfl_xor(l, 32);
    const float inv = 1.f / l;
    FA_LAS float* X = (FA_LAS float*)lds;
    if (s == 1) {
#pragma unroll
      for (int bk = 0; bk < 4; ++bk)
#pragma unroll
        for (int r = 0; r < 16; ++r) X[((qb * 4 + bk) * 16 + r) * 64 + lane] = o[bk][r] * inv;
    }
    __syncthreads();
    if (s == 0) {
      float ss = 0.f;
#pragma unroll
      for (int bk = 0; bk < 4; ++bk)
#pragma unroll
        for (int r = 0; r < 16; ++r) { const float d = o[bk][r] * inv - lam * X[((qb * 4 + bk) * 16 + r) * 64 + lane]; o[bk][r] = d; ss += d * d; }
      ss += __shfl_xor(ss, 32);
      const float rr = rsqrtf(ss * (1.f / 128.f) + EPS) * 0.8f;
      const float* g = p.in[L0_SUBLN];
      bf16_t* orow = ATT + (size_t)qrow * DM + h * 128;
#pragma unroll
      for (int bk = 0; bk < 4; ++bk)
#pragma unroll
        for (int rg = 0; rg < 4; ++rg) { const int dv = bk * 32 + 8 * rg + 4 * hi; const float4 gv = *(const float4*)(g + dv);
          uint2 w; w.x = cvtpk(o[bk][4 * rg] * rr * gv.x, o[bk][4 * rg + 1] * rr * gv.y); w.y = cvtpk(o[bk][4 * rg + 2] * rr * gv.z, o[bk][4 * rg + 3] * rr * gv.w);
          *(uint2*)(orow + dv) = w; }
    }
    __syncthreads();
  }
}

template <int ABL = 0> DEVI void phase_attnB(const Params& p, ldsp_t lds) {
  typedef Geo<64, 2> G;
  const int tid = ftid(), lane = tid & 63, wave = __builtin_amdgcn_readfirstlane(tid >> 6), r32 = lane & 31, hi = lane >> 5;
  const bf16_t* Q = (const bf16_t*)(p.ws + WS_QKV0); bf16_t* ATT = (bf16_t*)(p.ws + (ABL ? WS_MIX0 : WS_ATT0));
  constexpr int NU_LAT = NB * 8 * 16, NU_CTX = NB * 8;
  FA_LAS float* RPB = (FA_LAS float*)(lds + 3 * G::STAGE);
  for (int u = vblock(); u < NU_LAT + NU_CTX; u += gridDim.x) {
    const bool lat = u < NU_LAT;
    int b, h, qrow_g = 0, c0 = 0, rlo = 0, nlat = 0, rs_w = 0, grow;
    if (lat) { b = u >> 7; h = (u >> 4) & 7; const int qr0 = (u & 15) * 4; qrow_g = qr0 + (wave >> 1); c0 = 32 * (wave & 1);
      rlo = min(max(qr0 - 4, 0), 56); const int rhi = min(max(qr0 - 1, 0), 56) + 7; nlat = rhi - rlo + 1; rs_w = min(max(qrow_g - 4, 0), 56);
      grow = b * SEQ + qrow_g * 64 + c0 + r32; }
    else { const int v = u - NU_LAT; b = v >> 3; h = v & 7; grow = NLAT + b * CTXL + wave * 32 + r32; }
    const int ntiles = nlat + 4;
    for (int i = tid; i < 15 * 31; i += NT) RPB[i] = p.in[L0_RPB][h * 465 + i] * LOG2E;
    bf16x8 q[4];
#pragma unroll
    for (int d0 = 0; d0 < 4; ++d0) q[d0] = load_q8(Q + (size_t)grow * N_IN0 + 1536 + h * 64 + 16 * d0 + 8 * hi, C2);
    f32x16 o[2];
#pragma unroll
    for (int bk = 0; bk < 2; ++bk)
#pragma unroll
      for (int r = 0; r < 16; ++r) o[bk][r] = 0.f;
    float m = -1e30f, l = 0.f;
    const int cbase = NLAT + b * CTXL, lbase = b * SEQ;
    const int qc = c0 + r32, cs = min(max(qc - 8, 0), 48);
    flash_pass2<64, 2, (ABL >= 5 ? ABL - 4 : 0), 2>(lds, ntiles, Q, N_IN0, 2048 + h * 64, 2560 + h * 64, q, 0,
      [&](int kt, int i) { return kt < nlat ? lbase + (rlo + kt) * 64 + i : cbase + (kt - nlat) * 64 + i; },
      [&](int kt, f32x16& p0, f32x16& p1) {
        if (ABL != 1 && kt < nlat) { const int kr = rlo + kt; const bool rowok = (kr >= rs_w && kr < rs_w + 8);
          const FA_LAS float* bp = RPB + min(max(kr - qrow_g + 7, 0), 14) * 31;
          float b0[16], b1[16];
#pragma unroll
          for (int r = 0; r < 16; ++r) { const int k0 = crow(r, hi); b0[r] = bp[min(max(k0 - qc + 15, 0), 30)]; b1[r] = bp[min(max(k0 + 32 - qc + 15, 0), 30)]; }
#pragma unroll
          for (int r = 0; r < 16; ++r) { const int k0 = crow(r, hi), k1 = 32 + k0;
            const float v0 = p0[r] + b0[r], v1 = p1[r] + b1[r];
            p0[r] = (rowok && k0 >= cs && k0 < cs + 16) ? v0 : -INFINITY; p1[r] = (rowok && k1 >= cs && k1 < cs + 16) ? v1 : -INFINITY; } } },
      o, m, l);
    l += __shfl_xor(l, 32);
    const float inv = 1.f / l;
    bf16_t* orow = ATT + (size_t)grow * DM + 512 + h * 64;
#pragma unroll
    for (int bk = 0; bk < 2; ++bk)
#pragma unroll
      for (int rg = 0; rg < 4; ++rg) { const int dv = bk * 32 + 8 * rg + 4 * hi;
        uint2 w; w.x = cvtpk(o[bk][4 * rg] * inv, o[bk][4 * rg + 1] * inv); w.y = cvtpk(o[bk][4 * rg + 2] * inv, o[bk][4 * rg + 3] * inv);
        *(uint2*)(orow + dv) = w; }
    __syncthreads();
  }
}

DEVI void phase_attnC(const Params& p, ldsp_t lds, int* ctr) {
  const int tid = ftid(), lane = tid & 63, wave = __builtin_amdgcn_readfirstlane(tid >> 6), r32 = lane & 31, hi = lane >> 5;
  const bf16_t* P1 = (const bf16_t*)(p.ws + WS_P1); bf16_t* ATT = (bf16_t*)(p.ws + WS_ATT1);
  FA_LAS int* uq = (FA_LAS int*)(lds + 3 * Geo<64, 2>::STAGE + 64);
  for (;;) {
    if (tid == 0) *uq = atomicAdd(ctr, 1);
    __syncthreads();
    const int u = *uq;
    __syncthreads();
    if (u >= NB * 2 * 64) break;
    const int b = u >> 7, g = (u >> 6) & 1, tq = u & 63, hq = g * 4 + (wave >> 1), t = tq * 64 + 32 * (wave & 1) + r32, grow = b * SEQ + t;
    const int klo = max(tq - 2, 0), khi = min(tq + 2, 63), nwin = khi - klo + 1, ntiles = nwin + 4;
    bf16x8 q[4];
#pragma unroll
    for (int d0 = 0; d0 < 4; ++d0) q[d0] = load_q8(P1 + (size_t)grow * 2304 + hq * 64 + 16 * d0 + 8 * hi, C2);
    f32x16 o[2];
#pragma unroll
    for (int bk = 0; bk < 2; ++bk)
#pragma unroll
      for (int r = 0; r < 16; ++r) o[bk][r] = 0.f;
    float m = -1e30f, l = 0.f;
    const int cbase = NLAT + b * CTXL, lbase = b * SEQ;
    flash_pass2<64, 2, 0, 2>(lds, ntiles, P1, 2304, 512 + g * 64, 640 + g * 64, q, 0,
      [&](int kt, int i) { return kt < nwin ? lbase + (klo + kt) * 64 + i : cbase + (kt - nwin) * 64 + i; },
      [&](int kt, f32x16& p0, f32x16& p1) {
        if (kt < nwin) { const int kp = (klo + kt) * 64 - t;
#pragma unroll
          for (int r = 0; r < 16; ++r) { const int d0 = kp + crow(r, hi), d1 = d0 + 32;
            if (d0 < -128 || d0 > 128) p0[r] = -INFINITY; if (d1 < -128 || d1 > 128) p1[r] = -INFINITY; } } },
      o, m, l);
    l += __shfl_xor(l, 32);
    { const float sk = p.in[L1_SINKS][hq] * LOG2E, mn = fmaxf(m, sk), alpha = __builtin_amdgcn_exp2f(m - mn);
      l = l * alpha + __builtin_amdgcn_exp2f(sk - mn);
#pragma unroll
      for (int bk = 0; bk < 2; ++bk)
#pragma unroll
        for (int r = 0; r < 16; ++r) o[bk][r] *= alpha; }
    const float inv = 1.f / l;
    bf16_t* orow = ATT + (size_t)grow * DM + hq * 64;
#pragma unroll
    for (int bk = 0; bk < 2; ++bk)
#pragma unroll
      for (int rg = 0; rg < 4; ++rg) { const int dv = bk * 32 + 8 * rg + 4 * hi;
        uint2 w; w.x = cvtpk(o[bk][4 * rg] * inv, o[bk][4 * rg + 1] * inv); w.y = cvtpk(o[bk][4 * rg + 2] * inv, o[bk][4 * rg + 3] * inv);
        *(uint2*)(orow + dv) = w; }
    __syncthreads();
  }
}
}
namespace fs {
using fa::bf16x8; using fa::s16x4; using fa::f32x16; using fa::ldsp_t; using fa::u32x4; using fa::cvtpk; using fa::vtr; using fa::crow; using fa::LOG2E;
typedef unsigned u32x2 __attribute__((ext_vector_type(2)));

DEVI void phase_conv(const Params& p) {
  const bf16_t* P1 = (const bf16_t*)(p.ws + WS_P1); bf16_t* U = (bf16_t*)(p.ws + WS_U);
  const float* cw = p.in[L1_CONVW]; const float* cb = p.in[L1_CONVB];
  const int nitems = (NROW / 16) * 128;
  for (int it = blockIdx.x * NT + ftid(); it < nitems; it += gridDim.x * NT) {
    const int cg = it & 127, rc = it >> 7, r0 = rc * 16, ch = cg * 8;
    int s0, len; if (r0 < NLAT) { s0 = r0 & ~4095; len = SEQ; } else { s0 = NLAT + ((r0 - NLAT) & ~255); len = CTXL; }
    const int t0 = r0 - s0;
    float w[5][8], bias[8];
#pragma unroll
    for (int j = 0; j < 5; ++j) { const float4 a = *(const float4*)(cw + j * 1024 + ch), b = *(const float4*)(cw + j * 1024 + ch + 4);
      w[j][0] = a.x; w[j][1] = a.y; w[j][2] = a.z; w[j][3] = a.w; w[j][4] = b.x; w[j][5] = b.y; w[j][6] = b.z; w[j][7] = b.w; }
    { const float4 a = *(const float4*)(cb + ch), b = *(const float4*)(cb + ch + 4); bias[0] = a.x; bias[1] = a.y; bias[2] = a.z; bias[3] = a.w; bias[4] = b.x; bias[5] = b.y; bias[6] = b.z; bias[7] = b.w; }
    float win[5][8];
    auto ldrow = [&](int t, float (&d)[8]) {
      if (t < 0 || t >= len) {
#pragma unroll
        for (int k = 0; k < 8; ++k) d[k] = 0.f; return; }
      const u32x4 v = *(const u32x4*)(P1 + (size_t)(s0 + t) * 2304 + 768 + ch);
#pragma unroll
      for (int k = 0; k < 4; ++k) { d[2 * k] = __uint_as_float(v[k] << 16); d[2 * k + 1] = __uint_as_float(v[k] & 0xffff0000u); } };
    ldrow(t0 - 2, win[0]); ldrow(t0 - 1, win[1]); ldrow(t0, win[2]); ldrow(t0 + 1, win[3]);
#pragma unroll
    for (int i = 0; i < 16; ++i) {
      ldrow(t0 + i + 2, win[(i + 4) % 5]);
      float o[8];
#pragma unroll
      for (int k = 0; k < 8; ++k) { float a = bias[k];
#pragma unroll
        for (int j = 0; j < 5; ++j) a += w[j][k] * win[(i + j) % 5][k];
        o[k] = a * __builtin_amdgcn_rcpf(1.f + __expf(-a)); }
      u32x4 ov; ov[0] = cvtpk(o[0], o[1]); ov[1] = cvtpk(o[2], o[3]); ov[2] = cvtpk(o[4], o[5]); ov[3] = cvtpk(o[6], o[7]);
      *(u32x4*)(U + (size_t)(r0 + i) * 1024 + ch) = ov;
    }
  }
}

DEVI float softplus_f(float v) { if (v > 20.f) return v; const float x = __expf(v); return x < 1e-3f ? x * (1.f - 0.5f * x) : __logf(1.f + x); }
constexpr int BSTR = 272, XSTR = 192;
constexpr int L_BM = 0, L_XD = 128 * BSTR, L_XW = L_XD + 128 * XSTR, L_HT = L_XW + 128 * XSTR, L_CUM = L_HT + 128 * XSTR, L_DTV = L_CUM + 512, L_XCH = L_DTV + 512, L_TOT = L_XCH + 8 * 4096;

template <int ABL = 0> DEVI void phase_ssd(const Params& p, ldsp_t lds) {
  const int tid = ftid(), lane = tid & 63, wave = __builtin_amdgcn_readfirstlane(tid >> 6), r32 = lane & 31, hi = lane >> 5;
  const int pb = wave >> 2, lb = (wave < 4) ? (wave & 3) : 3 - (wave & 3);
  const bf16_t* U = (const bf16_t*)(p.ws + WS_U); const float* DT = (const float*)(p.ws + WS_DT);
  bf16_t* YFB = (bf16_t*)(p.ws + WS_YS);
  FA_LAS float* CUM = (FA_LAS float*)(lds + L_CUM); FA_LAS float* DTV = (FA_LAS float*)(lds + L_DTV);
  const int trow_off = 4 * hi + ((lane & 15) >> 2), tcol_off = 32 * ((lane >> 4) & 1) + 8 * (lane & 3);
  for (int it = blockIdx.x; it < NB * 2 * 8; it += gridDim.x) {
    const int b = it >> 4, dir = (it >> 3) & 1, hd = it & 7, g = hd >> 2;
    const float a2 = -expf(p.in[dir ? L1_ALOGB : L1_ALOGF][hd]) * LOG2E; const float dtb = p.in[dir ? L1_DTBB : L1_DTBF][hd];
    auto tokrow = [&](int c, int i) { const int seg = c >= 2, len = seg ? SEQ : CTXL, j = (seg ? c - 2 : c) * 128 + i; return (seg ? b * SEQ : NLAT + b * CTXL) + (dir ? len - 1 - j : j); };
    f32x16 hacc;
#pragma unroll
    for (int r = 0; r < 16; ++r) hacc[r] = 0.f;
    for (int i = tid; i < 128 * XSTR / 4; i += NT) ((FA_LAS unsigned*)(lds + L_HT))[i] = 0u;
    u32x4 sb_[4], sx_[2]; float sdt0 = 0.f, sdt1 = 0.f; bf16x8 cfn[8];
    auto prefetch = [&](int c) {
#pragma unroll
      for (int i = 0; i < 4; ++i) { const int ch = tid + NT * i; sb_[i] = *(const u32x4*)(U + (size_t)tokrow(c, ch >> 4) * 1024 + 512 + g * 128 + (ch & 15) * 8); }
#pragma unroll
      for (int i = 0; i < 2; ++i) { const int ch = tid + NT * i; sx_[i] = *(const u32x4*)(U + (size_t)tokrow(c, ch >> 3) * 1024 + hd * 64 + (ch & 7) * 8); }
      if (tid < 64) { sdt0 = DT[(size_t)tokrow(c, 2 * tid) * 16 + dir * 8 + hd]; sdt1 = DT[(size_t)tokrow(c, 2 * tid + 1) * 16 + dir * 8 + hd]; }
      const bf16_t* crowp = U + (size_t)tokrow(c, lb * 32 + r32) * 1024 + 768 + g * 128 + 8 * hi;
#pragma unroll
      for (int ks = 0; ks < 8; ++ks) cfn[ks] = *(const bf16x8*)(crowp + 16 * ks);
    };
    prefetch(0);
    __syncthreads();
    for (int c = 0; c < 34; ++c) {
      if (tid < 64) {
        const float r0 = sdt0 + dtb, r1 = sdt1 + dtb; const float d0 = softplus_f(r0), d1 = softplus_f(r1);
        const float a0 = d0 * a2, a1 = d1 * a2; float v = a0 + a1;
#pragma unroll
        for (int o = 1; o < 64; o <<= 1) { const float t = __shfl_up(v, o); if (lane >= o) v += t; }
        DTV[2 * tid] = d0; DTV[2 * tid + 1] = d1; CUM[2 * tid] = v - a1; CUM[2 * tid + 1] = v;
      }
      __syncthreads();
      const float cl = CUM[127];
#pragma unroll
      for (int i = 0; i < 4; ++i) { const int ch = tid + NT * i; *(FA_LAS u32x4*)(lds + L_BM + (ch >> 4) * BSTR + (ch & 15) * 16) = sb_[i]; }
#pragma unroll
      for (int i = 0; i < 2; ++i) { const int ch = tid + NT * i, s = ch >> 3; const float d = DTV[s], wv = d * __builtin_amdgcn_exp2f(cl - CUM[s]);
        u32x4 xd, xw;
#pragma unroll
        for (int k = 0; k < 4; ++k) { const float x0 = __uint_as_float(sx_[i][k] << 16), x1 = __uint_as_float(sx_[i][k] & 0xffff0000u); xd[k] = cvtpk(x0 * d, x1 * d); xw[k] = cvtpk(x0 * wv, x1 * wv); }
        *(FA_LAS u32x4*)(lds + L_XD + s * XSTR + (ch & 7) * 16) = xd; *(FA_LAS u32x4*)(lds + L_XW + s * XSTR + (ch & 7) * 16) = xw; }
      bf16x8 cf[8];
#pragma unroll
      for (int ks = 0; ks < 8; ++ks) cf[ks] = cfn[ks];
      __syncthreads();
      if (ABL != 3) { if (c + 1 < 34) prefetch(c + 1); }
      if (c >= 2 && ABL != 1) {
        f32x16 y;
#pragma unroll
        for (int r = 0; r < 16; ++r) y[r] = 0.f;
        { const ldsp_t hb = lds + L_HT + (8 * hi + ((lane & 15) >> 2)) * XSTR + pb * 64 + tcol_off;
          f32x16 y2;
#pragma unroll
          for (int r = 0; r < 16; ++r) y2[r] = 0.f;
#pragma unroll
          for (int ks = 0; ks < 8; ++ks) { const s16x4 lo = vtr(hb + (16 * ks) * XSTR), h8 = vtr(hb + (16 * ks + 4) * XSTR);
            const bf16x8 hf = {lo[0], lo[1], lo[2], lo[3], h8[0], h8[1], h8[2], h8[3]};
            if (ks & 1) y2 = __builtin_amdgcn_mfma_f32_32x32x16_bf16(hf, cf[ks], y2, 0, 0, 0); else y = __builtin_amdgcn_mfma_f32_32x32x16_bf16(hf, cf[ks], y, 0, 0, 0); }
          y += y2; }
        const float cuml = CUM[lb * 32 + r32];
        { const float e = __builtin_amdgcn_exp2f(cuml);
#pragma unroll
          for (int r = 0; r < 16; ++r) y[r] *= e; }
        f32x16 yo;
#pragma unroll
        for (int r = 0; r < 16; ++r) yo[r] = 0.f;
        for (int sb = pb; sb <= lb; sb += 2) {
          f32x16 gt, gt2;
#pragma unroll
          for (int r = 0; r < 16; ++r) { gt[r] = 0.f; gt2[r] = 0.f; }
          const ldsp_t bb = lds + L_BM + (sb * 32 + r32) * BSTR + 16 * hi;
#pragma unroll
          for (int ks = 0; ks < 8; ks += 2) { gt = __builtin_amdgcn_mfma_f32_32x32x16_bf16(*(const FA_LAS bf16x8*)(bb + 32 * ks), cf[ks], gt, 0, 0, 0);
            gt2 = __builtin_amdgcn_mfma_f32_32x32x16_bf16(*(const FA_LAS bf16x8*)(bb + 32 * ks + 32), cf[ks + 1], gt2, 0, 0, 0); }
          gt += gt2;
          const bool diag = (sb == lb);
#pragma unroll
          for (int r = 0; r < 16; ++r) { const int sl = crow(r, hi); const float v = gt[r] * __builtin_amdgcn_exp2f(cuml - CUM[sb * 32 + sl]); gt[r] = (diag && sl > r32) ? 0.f : v; }
          u32x4 t0, t1;
          t0[0] = cvtpk(gt[0], gt[1]); t0[1] = cvtpk(gt[2], gt[3]); t0[2] = cvtpk(gt[4], gt[5]); t0[3] = cvtpk(gt[6], gt[7]);
          t1[0] = cvtpk(gt[8], gt[9]); t1[1] = cvtpk(gt[10], gt[11]); t1[2] = cvtpk(gt[12], gt[13]); t1[3] = cvtpk(gt[14], gt[15]);
          const bf16x8 pm0 = __builtin_bit_cast(bf16x8, t0), pm1 = __builtin_bit_cast(bf16x8, t1);
          const ldsp_t xb = lds + L_XD + (sb * 32 + trow_off) * XSTR + pb * 64 + tcol_off;
          const ldsp_t xo = lds + L_XD + (sb * 32 + trow_off) * XSTR + (1 - pb) * 64 + tcol_off;
          const s16x4 a0 = vtr(xb), a1 = vtr(xb + 8 * XSTR), a2 = vtr(xb + 16 * XSTR), a3 = vtr(xb + 24 * XSTR);
          const s16x4 b0 = vtr(xo), b1 = vtr(xo + 8 * XSTR), b2 = vtr(xo + 16 * XSTR), b3 = vtr(xo + 24 * XSTR);
          { const bf16x8 xf = {a0[0], a0[1], a0[2], a0[3], a1[0], a1[1], a1[2], a1[3]}; y = __builtin_amdgcn_mfma_f32_32x32x16_bf16(xf, pm0, y, 0, 0, 0); }
          { const bf16x8 xf = {b0[0], b0[1], b0[2], b0[3], b1[0], b1[1], b1[2], b1[3]}; yo = __builtin_amdgcn_mfma_f32_32x32x16_bf16(xf, pm0, yo, 0, 0, 0); }
          { const bf16x8 xf = {a2[0], a2[1], a2[2], a2[3], a3[0], a3[1], a3[2], a3[3]}; y = __builtin_amdgcn_mfma_f32_32x32x16_bf16(xf, pm1, y, 0, 0, 0); }
          { const bf16x8 xf = {b2[0], b2[1], b2[2], b2[3], b3[0], b3[1], b3[2], b3[3]}; yo = __builtin_amdgcn_mfma_f32_32x32x16_bf16(xf, pm1, yo, 0, 0, 0); }
        }
        { FA_LAS float* X = (FA_LAS float*)(lds + L_XCH) + (pb * 4 + lb) * 1024;
#pragma unroll
          for (int r = 0; r < 16; ++r) X[r * 64 + lane] = yo[r]; }
        __syncthreads();
        { const FA_LAS float* X = (const FA_LAS float*)(lds + L_XCH) + ((1 - pb) * 4 + lb) * 1024;
#pragma unroll
          for (int r = 0; r < 16; ++r) y[r] += X[r * 64 + lane]; }
        const int j = (c - 2) * 128 + lb * 32 + r32, tok = dir ? SEQ - 1 - j : j;
        bf16_t* yp = YFB + ((size_t)dir * NLAT + (size_t)b * SEQ + tok) * 512 + hd * 64 + pb * 32 + 4 * hi;
#pragma unroll
        for (int rg = 0; rg < 4; ++rg) { u32x2 w; w[0] = cvtpk(y[4 * rg], y[4 * rg + 1]); w[1] = cvtpk(y[4 * rg + 2], y[4 * rg + 3]); *(u32x2*)(yp + 8 * rg) = w; }
      }
      if (ABL != 2) { const float e = __builtin_amdgcn_exp2f(cl);
        f32x16 h2;
#pragma unroll
        for (int r = 0; r < 16; ++r) { hacc[r] *= e; h2[r] = 0.f; }
        const ldsp_t xb = lds + L_XW + (8 * hi + ((lane & 15) >> 2)) * XSTR + pb * 64 + tcol_off;
        const ldsp_t bb = lds + L_BM + (8 * hi + ((lane & 15) >> 2)) * BSTR + lb * 64 + tcol_off;
#pragma unroll
        for (int ks = 0; ks < 8; ++ks) {
          const s16x4 xl = vtr(xb + (16 * ks) * XSTR), xh = vtr(xb + (16 * ks + 4) * XSTR), bl = vtr(bb + (16 * ks) * BSTR), bh = vtr(bb + (16 * ks + 4) * BSTR);
          const bf16x8 xf = {xl[0], xl[1], xl[2], xl[3], xh[0], xh[1], xh[2], xh[3]}, bf = {bl[0], bl[1], bl[2], bl[3], bh[0], bh[1], bh[2], bh[3]};
          if (ks & 1) h2 = __builtin_amdgcn_mfma_f32_32x32x16_bf16(xf, bf, h2, 0, 0, 0); else hacc = __builtin_amdgcn_mfma_f32_32x32x16_bf16(xf, bf, hacc, 0, 0, 0);
        }
        hacc += h2; }
      __syncthreads();
      { const ldsp_t hp = lds + L_HT + (lb * 32 + r32) * XSTR + (pb * 32 + 4 * hi) * 2;
#pragma unroll
        for (int rg = 0; rg < 4; ++rg) { u32x2 w; w[0] = cvtpk(hacc[4 * rg], hacc[4 * rg + 1]); w[1] = cvtpk(hacc[4 * rg + 2], hacc[4 * rg + 3]); *(FA_LAS u32x2*)(hp + 16 * rg) = w; } }
    }
    __syncthreads();
  }
}

DEVI void phase_ssd_out(const Params& p) {
  const int lane = ftid() & 63, gw = blockIdx.x * NWAVE + (ftid() >> 6), NGW = gridDim.x * NWAVE;
  const bf16_t* U = (const bf16_t*)(p.ws + WS_U); const bf16_t* P1 = (const bf16_t*)(p.ws + WS_P1); const bf16_t* YFB = (const bf16_t*)(p.ws + WS_YS);
  bf16_t* ATT = (bf16_t*)(p.ws + WS_ATT1);
  for (int r = gw; r < NLAT; r += NGW) {
    const int c0 = lane * 8, hd = c0 >> 6; const float dsk = p.in[L1_DSKIP][hd];
    const u32x4 yf = *(const u32x4*)(YFB + (size_t)r * 512 + c0), yb = *(const u32x4*)(YFB + ((size_t)NLAT + r) * 512 + c0);
    const u32x4 xw = *(const u32x4*)(U + (size_t)r * 1024 + c0), zw = *(const u32x4*)(P1 + (size_t)r * 2304 + 1792 + c0);
    float y[8]; float ss = 0.f;
#pragma unroll
    for (int i = 0; i < 4; ++i) {
      const float x0 = __uint_as_float(xw[i] << 16), x1 = __uint_as_float(xw[i] & 0xffff0000u), z0 = __uint_as_float(zw[i] << 16), z1 = __uint_as_float(zw[i] & 0xffff0000u);
      const float f0 = __uint_as_float(yf[i] << 16) + __uint_as_float(yb[i] << 16), f1 = __uint_as_float(yf[i] & 0xffff0000u) + __uint_as_float(yb[i] & 0xffff0000u);
      y[2 * i] = (f0 + dsk * x0) * silu_f(z0); y[2 * i + 1] = (f1 + dsk * x1) * silu_f(z1);
      ss += y[2 * i] * y[2 * i] + y[2 * i + 1] * y[2 * i + 1];
    }
#pragma unroll
    for (int o = 1; o < 32; o <<= 1) ss += __shfl_xor(ss, o);
    const float rr = rsqrtf(ss * (1.f / 256.f) + EPS);
    const float4 g0 = *(const float4*)(p.in[L1_GNORM] + c0), g1 = *(const float4*)(p.in[L1_GNORM] + c0 + 4);
    u32x4 w; w[0] = cvtpk(y[0] * rr * g0.x, y[1] * rr * g0.y); w[1] = cvtpk(y[2] * rr * g0.z, y[3] * rr * g0.w); w[2] = cvtpk(y[4] * rr * g1.x, y[5] * rr * g1.y); w[3] = cvtpk(y[6] * rr * g1.z, y[7] * rr * g1.w);
    *(u32x4*)(ATT + (size_t)r * DM + 512 + c0) = w;
  }
}
}
#ifndef TOPK_COPY
#define TOPK_COPY false
#endif
namespace ft {
using fa::ldsp_t; using fa::u32x4;

DEVI int block_excl_scan(int v, FA_LAS int* wsum, int tid, int* tot) {
  const int lane = tid & 63, wave = tid >> 6;
  int inc = v;
#pragma unroll
  for (int o = 1; o < 64; o <<= 1) { const int t = __shfl_up(inc, o); if (lane >= o) inc += t; }
  __syncthreads();
  if (lane == 63) wsum[wave] = inc;
  __syncthreads();
  int base = 0, total = 0;
#pragma unroll
  for (int w = 0; w < 8; ++w) { const int s = wsum[w]; if (w < wave) base += s; total += s; }
  *tot = total;
  return base + inc - v;
}

template <int EPT, bool GATHER_COPY>
DEVI void topk_item(const Params& p, ldsp_t lds, int e, int n, int cap, int row0, int slot0, int erows) {
  const int tid = ftid(), lane = tid & 63, wave = tid >> 6;
  const float* AFFT = (const float*)(p.ws + WS_AFF); int* SLOT = (int*)(p.ws + WS_SLOT); float* GV = (float*)(p.ws + WS_GATEV);
  const bf16_t* H = (const bf16_t*)(p.ws + WS_H); bf16_t* XG = (bf16_t*)(p.ws + WS_XG); int* IDX = (int*)(p.ws + WS_IDX);
  FA_LAS unsigned* hist = (FA_LAS unsigned*)lds;
  FA_LAS int* misc = (FA_LAS int*)(lds + 1024);
  FA_LAS int* wsum = (FA_LAS int*)(lds + 1024 + 64);
  FA_LAS int* list = (FA_LAS int*)(lds + 2048);
  const bool act = tid * EPT < n;
  unsigned key[EPT];
#pragma unroll
  for (int j = 0; j < EPT; ++j) key[j] = act ? __float_as_uint(AFFT[(size_t)e * NROW + row0 + tid * EPT + j]) : 0u;
  unsigned prefix = 0u, mask = 0u; int k = cap;
#pragma unroll 1
  for (int pass = 0; pass < 4; ++pass) {
    const int shift = 24 - 8 * pass;
    __syncthreads();
    if (tid < 256) hist[tid] = 0u;
    __syncthreads();
    if (act) {
#pragma unroll
      for (int j = 0; j < EPT; ++j) if ((key[j] & mask) == prefix) atomicAdd((unsigned*)&hist[(key[j] >> shift) & 255u], 1u);
    }
    __syncthreads();
    if (wave == 0) {
      const int h0 = hist[4 * lane], h1 = hist[4 * lane + 1], h2 = hist[4 * lane + 2], h3 = hist[4 * lane + 3];
      const int s = h0 + h1 + h2 + h3; int v = s;
#pragma unroll
      for (int o = 1; o < 64; o <<= 1) { const int t = __shfl_down(v, o); if (lane + o < 64) v += t; }
      int c = v - s;
      const int hh[4] = {h0, h1, h2, h3};
#pragma unroll
      for (int b = 3; b >= 0; --b) { if (c < k && k <= c + hh[b]) { misc[0] = 4 * lane + b; misc[1] = k - c; } c += hh[b]; }
    }
    __syncthreads();
    prefix |= ((unsigned)misc[0]) << shift; mask |= 255u << shift; k = misc[1];
  }
  int ce = 0;
#pragma unroll
  for (int j = 0; j < EPT; ++j) ce += (act && key[j] == prefix) ? 1 : 0;
  int tot; const int eq_before = block_excl_scan(ce, wsum, tid, &tot);
  int cs = 0, eqr = eq_before; bool sel[EPT];
#pragma unroll
  for (int j = 0; j < EPT; ++j) { bool s = false; if (act) { if (key[j] > prefix) s = true; else if (key[j] == prefix) { s = eqr < k; ++eqr; } } sel[j] = s; cs += s ? 1 : 0; }
  int slot = block_excl_scan(cs, wsum, tid, &tot);
  if (act) {
#pragma unroll
    for (int j = 0; j < EPT; ++j) { const int row = row0 + tid * EPT + j;
      if (sel[j]) { if (GATHER_COPY) list[slot] = row; else IDX[e * erows + slot0 + slot] = row; GV[e * erows + slot0 + slot] = __uint_as_float(key[j]); SLOT[(size_t)row * 16 + e] = slot0 + slot; ++slot; }
      else SLOT[(size_t)row * 16 + e] = -1; }
  }
  if (GATHER_COPY) {
    __syncthreads();
    for (int s = wave; s < cap; s += NWAVE) {
      const u32x4* src = (const u32x4*)(H + (size_t)list[s] * DM) + lane; u32x4* dst = (u32x4*)(XG + ((size_t)e * erows + slot0 + s) * DM) + lane;
      const u32x4 a = src[0], b2 = src[64]; dst[0] = a; dst[64] = b2;
    }
  }
  __syncthreads();
}

DEVI void phase_topk(const Params& p, ldsp_t lds, int layer) {
  const int erows = layer ? EROWS1 : EROWS0;
  const int nlat = NB * NE, nitems = nlat + (layer ? 0 : NB * NE);
  const int G = gridDim.x;
  for (int it = blockIdx.x; it < nitems; it += G) {
    if (it < nlat) { const int b = it / NE, e = it % NE; topk_item<8, TOPK_COPY>(p, lds, e, SEQ, CAP_L, b * SEQ, b * CAP_L, erows); }
    else { const int i2 = it - nlat, b = i2 / NE, e = i2 % NE; topk_item<1, TOPK_COPY>(p, lds, e, CTXL, CAP_C, NLAT + b * CTXL, NB * CAP_L + b * CAP_C, erows); }
  }
}
}
#ifndef MOE1_FP8
#define MOE1_FP8 1
#endif
#ifndef MOE0_FP8
#define MOE0_FP8 1
#endif
namespace fr {
using fa::ldsp_t; using fa::u32x4; using fa::cvtpk;
typedef unsigned u32x2 __attribute__((ext_vector_type(2)));
typedef float f32x4 __attribute__((ext_vector_type(4)));
struct V16 { f32x4 v[4]; };
DEVI V16 ldf(const float* r, int lane) { V16 o; const f32x4* q = (const f32x4*)r + lane;
#pragma unroll
  for (int j = 0; j < 4; ++j) o.v[j] = q[64 * j]; return o; }
struct B16 { u32x2 v[4]; };
DEVI B16 ldb_raw(const bf16_t* r, int lane) { B16 o; const u32x2* q = (const u32x2*)r + lane;
#pragma unroll
  for (int j = 0; j < 4; ++j) o.v[j] = q[64 * j]; return o; }
DEVI V16 b2v(const B16& b) { V16 o;
#pragma unroll
  for (int j = 0; j < 4; ++j) { o.v[j][0] = __uint_as_float(b.v[j][0] << 16); o.v[j][1] = __uint_as_float(b.v[j][0] & 0xffff0000u); o.v[j][2] = __uint_as_float(b.v[j][1] << 16); o.v[j][3] = __uint_as_float(b.v[j][1] & 0xffff0000u); }
  return o; }
DEVI void stf(float* r, int lane, const V16& o) { f32x4* q = (f32x4*)r + lane;
#pragma unroll
  for (int j = 0; j < 4; ++j) q[64 * j] = o.v[j]; }
DEVI void stb(bf16_t* r, int lane, const V16& o) { u32x2* q = (u32x2*)r + lane;
#pragma unroll
  for (int j = 0; j < 4; ++j) { u32x2 w; w[0] = cvtpk(o.v[j][0], o.v[j][1]); w[1] = cvtpk(o.v[j][2], o.v[j][3]); q[64 * j] = w; } }
DEVI float sumsq(const V16& o) { f32x4 s = o.v[0] * o.v[0];
#pragma unroll
  for (int j = 1; j < 4; ++j) s += o.v[j] * o.v[j];
  return wave_sum((s[0] + s[1]) + (s[2] + s[3])); }

DEVI void phase_prenorm0(const Params& p) {
  const int lane = ftid() & 63, gw = blockIdx.x * NWAVE + (ftid() >> 6), NGW = gridDim.x * NWAVE;
  const float* MOD = (const float*)(p.ws + WS_CTL + CTL_MOD); bf16_t* H = (bf16_t*)(p.ws + WS_H);
  const int rpw = (NROW + NGW - 1) / NGW;
  const int r0 = gw * rpw, r1 = min(r0 + rpw, NROW);
  if (r0 >= r1) return;
  const V16 g = ldf(p.in[L0_GPREMIX], lane);
  int cur = -1; V16 gs, sh;
  auto src = [&](int r) { return r < NLAT ? p.in[I_X] + (size_t)r * DM : p.in[I_CTX] + (size_t)(r - NLAT) * DM; };
  V16 xn = ldf(src(r0), lane), xn2 = xn;
  if (r0 + 1 < r1) xn2 = ldf(src(r0 + 1), lane);
  for (int r = r0; r < r1; ++r) {
    const V16 x = xn; xn = xn2; if (r + 2 < r1) xn2 = ldf(src(r + 2), lane);
    const int mr = row_modrow(r);
    if (mr != cur) { cur = mr; const float* m = MOD + (size_t)mr * 6144; const V16 sc = ldf(m + 1024, lane); sh = ldf(m, lane);
#pragma unroll
      for (int j = 0; j < 4; ++j) gs.v[j] = g.v[j] * (sc.v[j] + 1.f); }
    const float rr = rsqrtf(sumsq(x) * (1.f / DM) + EPS);
    V16 h;
#pragma unroll
    for (int j = 0; j < 4; ++j) h.v[j] = x.v[j] * rr * gs.v[j] + sh.v[j];
    if (QKV0_FP8) {
      unsigned* q8 = (unsigned*)((unsigned char*)H + (size_t)r * DM) + lane;
#pragma unroll
      for (int j = 0; j < 4; ++j) q8[64 * j] = nv::pack4_fp8(h.v[j][0] * nv::A8_SCALE, h.v[j][1] * nv::A8_SCALE, h.v[j][2] * nv::A8_SCALE, h.v[j][3] * nv::A8_SCALE);
    } else stb(H + (size_t)r * DM, lane, h);
  }
}

template <int ABL = 0> DEVI void phase_postmix(const Params& p, ldsp_t lds, int layer) {
  const int tid = ftid(), lane = tid & 63, gw = blockIdx.x * NWAVE + (tid >> 6), NGW = gridDim.x * NWAVE;
  const float* MOD = (const float*)(p.ws + WS_CTL + CTL_MOD) + (size_t)layer * 9 * 6144;
  const bf16_t* MIX = (const bf16_t*)(p.ws + (layer ? WS_MIX1 : WS_MIX0));
  bf16_t* H = (bf16_t*)(p.ws + WS_H); float* AFFT = (float*)(p.ws + WS_AFF); float* XC = (float*)(p.ws + WS_XC);
  const float* wr = p.in[layer ? L1_WROUTER : L0_WROUTER];
  FA_LAS f32x4* WL = (FA_LAS f32x4*)lds;
  for (int i = tid; i < 1024 * 4; i += NT) { const int k = i >> 2, e4 = i & 3; const int ln = (k & 255) >> 2, q = k & 3, j = k >> 8;
    WL[((j * 4 + q) * 4 + e4) * 64 + ln] = *(const f32x4*)(wr + (size_t)k * 16 + e4 * 4); }
  __syncthreads();
  const int nrow = layer ? NLAT : NROW;
  const int rpw = (nrow + NGW - 1) / NGW;
  const int r0 = gw * rpw, r1 = min(r0 + rpw, nrow);
  if (r0 >= r1) return;
  const V16 gpost = ldf(p.in[layer ? L1_GPOSTMIX : L0_GPOSTMIX], lane), gpre = ldf(p.in[layer ? L1_GPREFFN : L0_GPREFFN], lane);
  int cur = -1; V16 gg, gs, sh;
  auto xsrc = [&](int r) { return layer ? (const float*)(p.out + (size_t)r * DM) : (r < NLAT ? p.in[I_X] + (size_t)r * DM : p.in[I_CTX] + (size_t)(r - NLAT) * DM); };
  B16 mn = ldb_raw(MIX + (size_t)r0 * DM, lane); V16 xn = ldf(xsrc(r0), lane);
  B16 mn2 = mn; V16 xn2 = xn;
  if (r0 + 1 < r1) { mn2 = ldb_raw(MIX + (size_t)(r0 + 1) * DM, lane); xn2 = ldf(xsrc(r0 + 1), lane); }
  for (int r = r0; r < r1; ++r) {
    const B16 mb = mn; const V16 x = xn;
    mn = mn2; xn = xn2;
    if (r + 2 < r1) { mn2 = ldb_raw(MIX + (size_t)(r + 2) * DM, lane); xn2 = ldf(xsrc(r + 2), lane); }
    const int mr = row_modrow(r);
    if (mr != cur) { cur = mr; const float* m = MOD + (size_t)mr * 6144; const V16 gt = ldf(m + 2048, lane), sc = ldf(m + 4096, lane); sh = ldf(m + 3072, lane);
#pragma unroll
      for (int j = 0; j < 4; ++j) { gg.v[j] = gt.v[j] * gpost.v[j]; gs.v[j] = gpre.v[j] * (sc.v[j] + 1.f); } }
    V16 o = b2v(mb);
    const float rr = rsqrtf(sumsq(o) * (1.f / DM) + EPS);
#pragma unroll
    for (int j = 0; j < 4; ++j) o.v[j] = x.v[j] + gg.v[j] * (o.v[j] * rr);
    stf(r < NLAT ? p.out + (size_t)r * DM : XC + (size_t)(r - NLAT) * DM, lane, o);
    const float r2 = rsqrtf(sumsq(o) * (1.f / DM) + EPS);
    V16 h;
#pragma unroll
    for (int j = 0; j < 4; ++j) h.v[j] = o.v[j] * r2 * gs.v[j] + sh.v[j];
    if ((layer == 1 && MOE1_FP8) || (layer == 0 && MOE0_FP8)) {
      unsigned* q8 = (unsigned*)((unsigned char*)H + (size_t)r * DM) + lane;
#pragma unroll
      for (int j = 0; j < 4; ++j) q8[64 * j] = nv::pack4_fp8(h.v[j][0] * nv::A8_SCALE, h.v[j][1] * nv::A8_SCALE, h.v[j][2] * nv::A8_SCALE, h.v[j][3] * nv::A8_SCALE);
    } else stb(H + (size_t)r * DM, lane, h);
    if (ABL == 1) continue;
    f32x4 lg[4];
    int lo = lane; asm volatile("" : "+v"(lo));
#pragma unroll
    for (int e4 = 0; e4 < 4; ++e4) lg[e4] = (f32x4){0.f, 0.f, 0.f, 0.f};
#pragma unroll
    for (int j = 0; j < 4; ++j)
#pragma unroll
      for (int q = 0; q < 4; ++q) { const float hv = h.v[j][q];
#pragma unroll
        for (int e4 = 0; e4 < 4; ++e4) lg[e4] += WL[((j * 4 + q) * 4 + e4) * 64 + lo] * hv; }
    float l16[16]; float mx = -INFINITY;
#pragma unroll
    for (int e = 0; e < 16; ++e) { l16[e] = wave_sum(lg[e >> 2][e & 3]); mx = fmaxf(mx, l16[e]); }
    float s = 0.f;
#pragma unroll
    for (int e = 0; e < 16; ++e) { l16[e] = expf(l16[e] - mx); s += l16[e]; }
    const float inv = 1.f / s; float mine = 0.f;
#pragma unroll
    for (int e = 0; e < 16; ++e) if (lane == e) mine = l16[e] * inv;
    if (lane < 16) AFFT[(size_t)lane * NROW + r] = mine;
  }
}

DEVI void phase_combine(const Params& p, int layer) {
  const int tid = ftid(), lane = tid & 63, gw = blockIdx.x * NWAVE + (tid >> 6), NGW = gridDim.x * NWAVE;
  const float* MOD = (const float*)(p.ws + WS_CTL + CTL_MOD);
  const bf16_t* Y = (const bf16_t*)(p.ws + WS_Y); const int* SLOT = (const int*)(p.ws + WS_SLOT); const float* GV = (const float*)(p.ws + WS_GATEV);
  bf16_t* H = (bf16_t*)(p.ws + WS_H); float* XC = (float*)(p.ws + WS_XC);
  const int nrow = layer ? NLAT : NROW, erows = layer ? EROWS1 : EROWS0;
  const int rpw = (nrow + NGW - 1) / NGW;
  const int r0 = gw * rpw, r1 = min(r0 + rpw, nrow);
  if (r0 >= r1) return;
  const V16 gpost = ldf(p.in[layer ? L1_GPOSTFFN : L0_GPOSTFFN], lane);
  V16 g1; if (layer == 0) g1 = ldf(p.in[L1_GPREMIX], lane);
  int cur = -1; V16 gg, gs, sh;
  int sn = (lane < 16) ? SLOT[(size_t)r0 * 16 + lane] : -1;
  for (int r = r0; r < r1; ++r) {
    const int sl = sn; if (r + 1 < r1) sn = (lane < 16) ? SLOT[(size_t)(r + 1) * 16 + lane] : -1;
    float* xio = r < NLAT ? p.out + (size_t)r * DM : XC + (size_t)(r - NLAT) * DM;
    const V16 x = ldf(xio, lane);
    const int mr = row_modrow(r);
    if (mr != cur) { cur = mr; const float* m = MOD + (size_t)(layer * 9 + mr) * 6144; const V16 gt = ldf(m + 5120, lane);
#pragma unroll
      for (int j = 0; j < 4; ++j) gg.v[j] = gt.v[j] * gpost.v[j];
      if (layer == 0) { const float* m1 = MOD + (size_t)(9 + mr) * 6144; const V16 sc = ldf(m1 + 1024, lane); sh = ldf(m1, lane);
#pragma unroll
        for (int j = 0; j < 4; ++j) gs.v[j] = g1.v[j] * (sc.v[j] + 1.f); } }
    V16 o;
#pragma unroll
    for (int j = 0; j < 4; ++j) o.v[j] = (f32x4){0.f, 0.f, 0.f, 0.f};
    unsigned long long mask = __ballot(sl >= 0);
    while (mask) {
      const int e = __builtin_ctzll(mask); mask &= mask - 1;
      const int s = __shfl(sl, e);
      const float gate = GV[e * erows + s];
      const V16 y = b2v(ldb_raw(Y + ((size_t)e * erows + s) * DM, lane));
#pragma unroll
      for (int j = 0; j < 4; ++j) o.v[j] += y.v[j] * gate;
    }
    const float rr = rsqrtf(sumsq(o) * (1.f / DM) + EPS);
#pragma unroll
    for (int j = 0; j < 4; ++j) o.v[j] = x.v[j] + gg.v[j] * (o.v[j] * rr);
    stf(xio, lane, o);
    if (layer == 0) {
      const float r2 = rsqrtf(sumsq(o) * (1.f / DM) + EPS);
      V16 h;
#pragma unroll
      for (int j = 0; j < 4; ++j) h.v[j] = o.v[j] * r2 * gs.v[j] + sh.v[j];
      if (QKV1_FP8) {
        unsigned* q8 = (unsigned*)((unsigned char*)H + (size_t)r * DM) + lane;
#pragma unroll
        for (int j = 0; j < 4; ++j) q8[64 * j] = nv::pack4_fp8(h.v[j][0] * nv::A8_SCALE, h.v[j][1] * nv::A8_SCALE, h.v[j][2] * nv::A8_SCALE, h.v[j][3] * nv::A8_SCALE);
      } else stb(H + (size_t)r * DM, lane, h);
    }
  }
}
}
#define LAS __attribute__((address_space(3)))
#define XB_TMO      128
#define XB_XCNT(j)  (256  + 64 * (j))
#define XB_XSUB(j)  (1280 + 64 * (j))
#define XB_XGEN(j)  (2304 + 64 * (j))
#define XB_TOP      3328
#define XB_TOPGEN   3392
#define XCD_BAR_WORDS 3456
#define XB_SPIN_CAP (1u << 18)

__device__ __forceinline__ unsigned xb_ld(unsigned* p)              { return __hip_atomic_load(p, __ATOMIC_RELAXED, __HIP_MEMORY_SCOPE_AGENT); }
__device__ __forceinline__ unsigned xb_add(unsigned* p, unsigned v) { return __hip_atomic_fetch_add(p, v, __ATOMIC_RELAXED, __HIP_MEMORY_SCOPE_AGENT); }
__device__ __forceinline__ unsigned xb_xcc_id() { return (unsigned)__builtin_amdgcn_s_getreg((3 << 11) | 20) & 0xFu; }
#define XB_SPIN(cond, bar) do { unsigned _sp = 0; while (cond) { __builtin_amdgcn_s_sleep(1); \
    if ((++_sp & 255u) == 0u) { if (xb_ld(&(bar)[XB_TMO])) break; if (_sp > XB_SPIN_CAP) { atomicAdd(&(bar)[XB_TMO], 1u); break; } } } } while (0)

struct XcdBarrier {
    unsigned* bar; unsigned x;
    volatile LAS unsigned* st;
};

__device__ __forceinline__ XcdBarrier xcd_barrier_post(unsigned* bar, volatile LAS unsigned* st) {
    XcdBarrier b; b.bar = bar; b.x = xb_xcc_id(); b.st = st;
    if (threadIdx.x == 0) (void)xb_add(&bar[XB_XCNT(b.x)], 1u);
    return b;
}
__device__ __forceinline__ void xcd_barrier_complete(unsigned* bar, unsigned x, unsigned& nloc, unsigned& nx) {
    const unsigned G = gridDim.x * gridDim.y * gridDim.z;
    unsigned sum, cnt, mine, sp = 0u;
    for (;;) {
        sum = 0u; cnt = 0u; mine = 0u;
#pragma unroll
        for (unsigned j = 0; j < 16; ++j) { const unsigned c = xb_ld(&bar[XB_XCNT(j)]); sum += c; cnt += (c > 0u) ? 1u : 0u; mine = (j == x) ? c : mine; }
        if (sum == G) break;
        __builtin_amdgcn_s_sleep(1);
        if ((++sp & 255u) == 0u) { if (xb_ld(&bar[XB_TMO])) break; if (sp > XB_SPIN_CAP) { atomicAdd(&bar[XB_TMO], 1u); break; } }
    }
    nloc = mine > 0u ? mine : 1u; nx = cnt > 0u ? cnt : 1u;
}

__device__ __forceinline__ void xcd_barrier(const XcdBarrier& b) {
    asm volatile("s_waitcnt vmcnt(0)" ::: "memory");
    __syncthreads();
    if (threadIdx.x == 0) {
        unsigned* bar = b.bar;
        __builtin_amdgcn_s_waitcnt(0);
        unsigned nloc = b.st[0], nx = b.st[1];
        if (nloc == 0u) { xcd_barrier_complete(bar, b.x, nloc, nx); b.st[0] = nloc; b.st[1] = nx; }
        const unsigned old = xb_add(&bar[XB_XSUB(b.x)], 1u);
        const unsigned gen = old / nloc;
        if (old + 1u == (gen + 1u) * nloc) {
            __builtin_amdgcn_fence(__ATOMIC_RELEASE, "agent");
            asm volatile("s_waitcnt vmcnt(0)" ::: "memory");
            const unsigned og = xb_add(&bar[XB_TOP], 1u);
            const unsigned tg = og / nx;
            if (og + 1u == (tg + 1u) * nx) xb_add(&bar[XB_TOPGEN], 1u);
            else XB_SPIN(xb_ld(&bar[XB_TOPGEN]) == tg, bar);
            __builtin_amdgcn_fence(__ATOMIC_ACQUIRE, "agent");
            xb_add(&bar[XB_XGEN(b.x)], 1u);
            asm volatile("s_waitcnt vmcnt(0)" ::: "memory");
        } else {
            XB_SPIN(xb_ld(&bar[XB_XGEN(b.x)]) == gen, bar);
            __builtin_amdgcn_fence(__ATOMIC_ACQUIRE, "agent");
            asm volatile("s_waitcnt vmcnt(0)" ::: "memory");
        }
    }
    __syncthreads();
}


__device__ __forceinline__ void flat_barrier(unsigned* ctr, unsigned& epoch) {
    asm volatile("s_waitcnt vmcnt(0)" ::: "memory");
    __syncthreads();
    if (threadIdx.x == 0) {
        __builtin_amdgcn_fence(__ATOMIC_RELEASE, "agent");
        asm volatile("s_waitcnt vmcnt(0)" ::: "memory");
        (void)__hip_atomic_fetch_add(ctr, 1u, __ATOMIC_RELAXED, __HIP_MEMORY_SCOPE_AGENT);
        const unsigned target = (epoch + 1u) * (unsigned)gridDim.x; unsigned sp = 0;
        while (__hip_atomic_load(ctr, __ATOMIC_RELAXED, __HIP_MEMORY_SCOPE_AGENT) < target) { __builtin_amdgcn_s_sleep(1); if (++sp > (1u << 22)) break; }
        __builtin_amdgcn_fence(__ATOMIC_ACQUIRE, "agent");
        asm volatile("s_waitcnt vmcnt(0)" ::: "memory");
    }
    ++epoch;
    __syncthreads();
}
constexpr int LDS_BYTES = 147456;
#define TAILFILL 1
#ifndef FAST_GEMM
#define FAST_GEMM 1
#endif
#ifndef FAST_TOPK
#define FAST_TOPK 1
#endif
#ifndef FAST_SSD
#define FAST_SSD 1
#endif
#ifndef FAST_ATTN
#define FAST_ATTN 1
#endif
__global__ void __launch_bounds__(NT) mega(Params p) {
  extern __shared__ __attribute__((aligned(16))) unsigned char lds_raw[];
  float* lds = (float*)lds_raw;
  fg::ldsp_t ldsp = (fg::ldsp_t)lds_raw;
  cg::grid_group grid = cg::this_grid();
  volatile LAS unsigned* bst = (volatile LAS unsigned*)((LAS unsigned char*)lds_raw + (LDS_BYTES - 64));
  if (threadIdx.x < 2) bst[threadIdx.x] = 0u;
  unsigned* barw = (unsigned*)(p.ws + WS_CTL + CTL_BAR);
  if (blockIdx.x == 0) for (int i = threadIdx.x; i < XCD_BAR_WORDS; i += NT) barw[i] = 0u;
  XcdBarrier xbar; xbar.bar = barw; xbar.x = 0; xbar.st = bst;
#ifdef FLATBAR
  unsigned fb_epoch = 0; unsigned* fb_ctr = barw + XCD_BAR_WORDS - 64;
#define GSYNC() flat_barrier(fb_ctr, fb_epoch)
#else
#define GSYNC() xcd_barrier(xbar)
#endif
  nv::phase0(p, lds);                 grid.sync();
  xbar = xcd_barrier_post(barw, bst);
#ifdef DUP_SYNC
  for (int i = 0; i < 20; ++i) GSYNC();
#endif
#ifdef DUP_P0
  nv::phase0(p, lds);                 GSYNC();
#endif
  fr::phase_prenorm0(p);              GSYNC();
#ifdef DUP_PRENORM
  fr::phase_prenorm0(p); GSYNC();
#endif
#if FAST_GEMM
  fg::phase_qkv0(p, ldsp); GSYNC();
#ifdef DUP_QKV0
  fg::phase_qkv0(p, ldsp); GSYNC();
#endif
#else
  nv::phase_qkv0(p, lds);             GSYNC();
#endif
#if FAST_ATTN
  fa::phase_attnA(p, ldsp); fa::phase_attnB(p, ldsp); GSYNC();
#ifdef DUP_A
  fa::phase_attnA<DUP_A>(p, ldsp); GSYNC();
#endif
#ifdef DUP_B
  fa::phase_attnB<DUP_B>(p, ldsp); GSYNC();
#endif
#else
  nv::phase_attn0(p, lds);            GSYNC();
#endif
#if FAST_GEMM
#ifdef TAILFILL
  fg::phase_outproj(p, ldsp, 0); nv::convert_moe_tail8(p, 0, 1, lds, NROW / 256 * (DM / 256)); GSYNC();
#else
  fg::phase_outproj(p, ldsp, 0); GSYNC();
#endif
#ifdef DUP_OUT0
  fg::phase_outproj(p, ldsp, 0); GSYNC();
#endif
#else
  nv::phase_outproj(p, lds, 0);       GSYNC();
#endif
  fr::phase_postmix(p, ldsp, 0);            GSYNC();
#ifdef DUP_POSTMIX0
  fr::phase_postmix<DUP_POSTMIX0>(p, ldsp, 0); GSYNC();
#endif
#if FAST_TOPK
  ft::phase_topk(p, ldsp, 0);         GSYNC();
#ifdef DUP_TOPK0
  ft::phase_topk(p, ldsp, 0);         GSYNC();
#endif
#else
  nv::phase_topk(p, lds, 0);          GSYNC();
  fg::phase_gather(p, 0);             GSYNC();
#endif
#if FAST_GEMM
  fg::phase_moe_up8(p, ldsp, 0);      GSYNC();
#ifdef DUP_UP0
  fg::phase_moe_up8(p, ldsp, 0); GSYNC();
#endif
  fg::phase_moe_down8(p, ldsp, 0);    GSYNC();
#ifdef DUP_DOWN0
  fg::phase_moe_down8(p, ldsp, 0); GSYNC();
#endif
#else
  nv::phase_moe_up(p, lds, 0);        GSYNC();
  nv::phase_moe_down(p, lds, 0);      GSYNC();
#endif
#ifdef TAILFILL
  fr::phase_combine(p, 0); GSYNC();
#else
  fr::phase_combine(p, 0); nv::convert_moe_tail(p, 1, 0, lds, 0); nv::convert_moe_tail(p, 1, 1, lds, 0); GSYNC();
#endif
#if FAST_GEMM
#ifdef TAILFILL
  fg::phase_qkv1(p, ldsp); nv::convert_moe_tail8(p, 1, 0, lds, NROW / 256 * (N_IN1P / 256)); GSYNC();
#else
  fg::phase_qkv1(p, ldsp); GSYNC();
#endif
#else
  nv::phase_qkv1(p, lds);             GSYNC();
#endif
#if FAST_ATTN
#if FAST_SSD
#ifdef TAILFILL
  fs::phase_conv(p); nv::convert_moe_tail8(p, 1, 1, lds, 0); GSYNC();
#else
  fs::phase_conv(p); GSYNC();
#endif
#else
  nv::phase_conv_swa(p, lds, true); GSYNC();
#endif
#else
  nv::phase_conv_swa(p, lds, true);   GSYNC();
#endif
#if FAST_SSD
  fs::phase_ssd(p, ldsp); fa::phase_attnC(p, ldsp, (int*)(p.ws + WS_CTL + CTL_QC)); GSYNC();
#ifdef DUP_SSD
  fs::phase_ssd<DUP_SSD>(p, ldsp);             GSYNC();
#endif
  fs::phase_ssd_out(p);               GSYNC();
#else
  nv::phase_ssd(p, lds);              GSYNC();
  nv::phase_ssd_out(p);               GSYNC();
#endif
#if FAST_GEMM
  fg::phase_outproj(p, ldsp, 1);      GSYNC();
#else
  nv::phase_outproj(p, lds, 1);       GSYNC();
#endif
  fr::phase_postmix(p, ldsp, 1);            GSYNC();
#if FAST_TOPK
  ft::phase_topk(p, ldsp, 1);         GSYNC();
#ifdef DUP_TOPK1
  ft::phase_topk(p, ldsp, 1);         GSYNC();
#endif
#else
  nv::phase_topk(p, lds, 1);          GSYNC();
  fg::phase_gather(p, 1);             GSYNC();
#endif
#if FAST_GEMM
  fg::phase_moe_up8(p, ldsp, 1);      GSYNC();
  fg::phase_moe_down8(p, ldsp, 1);    GSYNC();
#else
  nv::phase_moe_up(p, lds, 1);        GSYNC();
  nv::phase_moe_down(p, lds, 1);      GSYNC();
#endif
  fr::phase_combine(p, 1);
}


extern "C" void kernel_launch(void* const* d_in, const int* in_sizes, int n_in, void* d_out, int out_size,
                              void* d_ws, size_t ws_size, hipStream_t stream) {
  static int grid_blocks = 0;
  if (!grid_blocks) {
    int dev = 0, cus = 0, per_cu = 0;
    (void)hipGetDevice(&dev);
    (void)hipDeviceGetAttribute(&cus, hipDeviceAttributeMultiprocessorCount, dev);
    (void)hipFuncSetAttribute((const void*)mega, hipFuncAttributeMaxDynamicSharedMemorySize, LDS_BYTES);
    (void)hipOccupancyMaxActiveBlocksPerMultiprocessor(&per_cu, (const void*)mega, NT, LDS_BYTES);
    if (per_cu < 1) { fprintf(stderr, "kernel_launch: occupancy query says %d blocks/CU\n", per_cu); per_cu = 1; }
    grid_blocks = cus;
    if (n_in != 43 || ws_size < WS_END) fprintf(stderr, "kernel_launch: unexpected n_in %d / ws_size %zu (need %zu)\n", n_in, ws_size, (size_t)WS_END);
  }
  Params p{};
  for (int i = 0; i < 43; ++i) p.in[i] = (const float*)d_in[i];
  p.out = (float*)d_out; p.ws = (unsigned char*)d_ws;
  void* args[] = {&p};
  hipError_t e = hipLaunchCooperativeKernel((void*)mega, dim3(grid_blocks), dim3(NT), args, LDS_BYTES, stream);
  if (e != hipSuccess) fprintf(stderr, "cooperative launch failed: %s (grid %d)\n", hipGetErrorString(e), grid_blocks);
}
```

```cpp
#include <hip/hip_runtime.h>
#include <hip/hip_cooperative_groups.h>
#include <cstdio>
#include <cstdint>
namespace cg = cooperative_groups;

typedef unsigned short bf16_t;
#define DEVI __device__ __forceinline__

constexpr int NT = 512, NWAVE = 8;
constexpr int NB = 8, SEQ = 4096, DM = 1024, CTXL = 256;
constexpr int NLAT = NB * SEQ, NCTX = NB * CTXL, NROW = NLAT + NCTX;
constexpr int NE = 16;
constexpr int CAP_L = 512, CAP_C = 32;
constexpr int EROWS0 = NB * CAP_L + NB * CAP_C;
constexpr int EROWS1 = NB * CAP_L;
constexpr int N_IN0 = 3072, N_IN1 = 2320, N_IN1P = 2560;
constexpr float EPS = 1e-6f;

constexpr size_t MiB = 1u << 20;
constexpr size_t WS_CTL = 0;
constexpr size_t WS_WIN0 = 1 * MiB;
constexpr size_t WS_WIN1 = 7 * MiB;
constexpr size_t WS_WOUT0 = 12 * MiB, WS_WOUT1 = 14 * MiB;
constexpr size_t WS_WGU = 16 * MiB;
constexpr size_t WS_WD = 80 * MiB;
constexpr size_t WS_XC = 112 * MiB;
constexpr size_t WS_H = 120 * MiB;
constexpr size_t WS_AFF = 188 * MiB;
constexpr size_t WS_SLOT = 191 * MiB;
constexpr size_t WS_IDX = 194 * MiB;
constexpr size_t WS_GATEV = 195 * MiB;
constexpr size_t WS_BIG = 196 * MiB;
constexpr size_t WS_QKV0 = WS_BIG;
constexpr size_t WS_ATT0 = WS_BIG + 204 * MiB;
constexpr size_t WS_MIX0 = WS_BIG + 272 * MiB;
constexpr size_t WS_XG = WS_BIG;
constexpr size_t WS_HID = WS_BIG + 136 * MiB;
constexpr size_t WS_Y = WS_BIG;
constexpr size_t WS_P1 = WS_BIG;
constexpr size_t WS_DT = WS_BIG + 153 * MiB;
constexpr size_t WS_U = WS_BIG + 156 * MiB;
constexpr size_t WS_MIX1 = WS_U;
constexpr size_t WS_ATT1 = WS_BIG + 224 * MiB;
constexpr size_t WS_YS = WS_BIG + 292 * MiB;
constexpr size_t WS_CUMG = WS_BIG + 356 * MiB;
constexpr size_t WS_DTG = WS_BIG + 359 * MiB;
constexpr size_t WS_VT = WS_BIG + 340 * MiB;
constexpr size_t WS_VTB = WS_BIG + 362 * MiB;
constexpr size_t WS_END = WS_BIG + 380 * MiB;
constexpr size_t CTL_MOD = 4096;
constexpr size_t CTL_ROPE = CTL_MOD + 2 * 9 * 6144 * 4;
constexpr size_t CTL_LAM = CTL_ROPE + 64 * 16 * 2 * 4;
constexpr size_t CTL_QC = CTL_LAM + 64;
constexpr size_t CTL_BAR = 512 * 1024;

struct Params {
  const float* in[43];
  float* out;
  unsigned char* ws;
};

enum {
  I_X = 0, I_C, I_CTX, I_CCTX,
  L0_WMOD, L0_BMOD, L0_GPREMIX, L0_GPOSTMIX, L0_GPREFFN, L0_GPOSTFFN, L0_WIN, L0_WOUT,
  L0_LAMQ1, L0_LAMK1, L0_LAMQ2, L0_LAMK2, L0_SUBLN, L0_RPB, L0_WROUTER, L0_WGATE, L0_WUP, L0_WDOWN,
  L1_WMOD, L1_BMOD, L1_GPREMIX, L1_GPOSTMIX, L1_GPREFFN, L1_GPOSTFFN, L1_WIN, L1_WOUT,
  L1_SINKS, L1_CONVW, L1_CONVB, L1_ALOGF, L1_ALOGB, L1_DTBF, L1_DTBB, L1_DSKIP, L1_GNORM,
  L1_WROUTER, L1_WGATE, L1_WUP, L1_WDOWN
};

DEVI int ftid() { int t = threadIdx.x; asm volatile("" : "+v"(t)); return t; }
DEVI float bf2f(bf16_t v) { return __uint_as_float(((unsigned)v) << 16); }
DEVI bf16_t f2bf(float f) { unsigned u = __float_as_uint(f); return (bf16_t)((u + 0x7fffu + ((u >> 16) & 1u)) >> 16); }
DEVI unsigned pk2(float lo, float hi) { return (unsigned)f2bf(lo) | ((unsigned)f2bf(hi) << 16); }
DEVI float silu_f(float v) { return v / (1.f + __expf(-v)); }
DEVI float wave_sum(float v) {
#pragma unroll
  for (int o = 1; o < 64; o <<= 1) v += __shfl_xor(v, o);
  return v;
}
DEVI float wave_max(float v) {
#pragma unroll
  for (int o = 1; o < 64; o <<= 1) v = fmaxf(v, __shfl_xor(v, o));
  return v;
}
DEVI int row_modrow(int r) { return r < NLAT ? (r >> 12) : 8; }
#ifndef QKV0_FP8
#define QKV0_FP8 1
#endif
#ifndef QKV1_FP8
#define QKV1_FP8 0
#endif
namespace nv {

DEVI void transpose_item(const float* W, int K, int N, bf16_t* WT, int row_off, int row_mul, float* scr, int item, int lane, int Npad) {
  const int nblk = Npad / 32, kb = item / nblk, nb = item % nblk, k0 = 64 * kb, n0 = 32 * nb;
  const int n = n0 + (lane & 31); const bool ok = n < N;
  const float* src = W + (size_t)(k0 + (lane >> 5)) * N + (ok ? n : 0);
  float v[32];
#pragma unroll
  for (int i = 0; i < 32; ++i) v[i] = src[(size_t)(2 * i) * N];
#pragma unroll
  for (int i = 0; i < 32; ++i) scr[(2 * i + (lane >> 5)) * 33 + (lane & 31)] = ok ? v[i] : 0.f;
  __builtin_amdgcn_s_waitcnt(0); __builtin_amdgcn_wave_barrier();
  const int c = lane & 7;
#pragma unroll
  for (int j = 0; j < 4; ++j) {
    const int nn = (lane >> 3) + 8 * j; const float* s = scr + (8 * c) * 33 + nn;
    uint4 o; o.x = pk2(s[0 * 33], s[1 * 33]); o.y = pk2(s[2 * 33], s[3 * 33]); o.z = pk2(s[4 * 33], s[5 * 33]); o.w = pk2(s[6 * 33], s[7 * 33]);
    *(uint4*)(WT + (size_t)(row_off + (n0 + nn) * row_mul) * K + k0 + 8 * c) = o;
  }
  __builtin_amdgcn_s_waitcnt(0); __builtin_amdgcn_wave_barrier();
}

DEVI void convert_moe_part(const Params& p, int layer, int which, float* scr, int gw, int NGW, int lane) {
  const float* wg = p.in[layer ? L1_WGATE : L0_WGATE]; const float* wu = p.in[layer ? L1_WUP : L0_WUP]; const float* wd = p.in[layer ? L1_WDOWN : L0_WDOWN];
  bf16_t* WGU = (bf16_t*)(p.ws + WS_WGU); bf16_t* WD = (bf16_t*)(p.ws + WS_WD);
  constexpr int IPM = 16 * 32;
  if (which == 0) {
    for (int it = gw; it < NE * 2 * IPM; it += NGW) {
      const int e = it / (2 * IPM), r = it % (2 * IPM), gu = r / IPM, item = r % IPM;
      transpose_item((gu ? wu : wg) + (size_t)e * DM * DM, DM, DM, WGU + (size_t)e * 2048 * DM, gu, 2, scr, item, lane, DM);
    }
  } else {
    for (int it = gw; it < NE * IPM; it += NGW) {
      const int e = it / IPM, item = it % IPM;
      transpose_item(wd + (size_t)e * DM * DM, DM, DM, WD + (size_t)e * DM * DM, 0, 1, scr, item, lane, DM);
    }
  }
}
DEVI void convert_moe_tail(const Params& p, int layer, int which, float* lds, int nunits) {
  const int first = nunits % (int)gridDim.x;
  if ((int)blockIdx.x < first) return;
  const int w = ftid() >> 6;
  convert_moe_part(p, layer, which, lds + w * (64 * 33), ((int)blockIdx.x - first) * NWAVE + w, ((int)gridDim.x - first) * NWAVE, ftid() & 63);
}


constexpr float W8_SCALE = 64.f, A8_SCALE = 4.f;
constexpr int W8_E8M0 = 0x79797979, A8_E8M0 = 0x7d7d7d7d;
DEVI unsigned pack4_fp8(float a, float b, float c, float d) {
  a = fminf(fmaxf(a, -448.f), 448.f); b = fminf(fmaxf(b, -448.f), 448.f); c = fminf(fmaxf(c, -448.f), 448.f); d = fminf(fmaxf(d, -448.f), 448.f);
  int w = 0; w = __builtin_amdgcn_cvt_pk_fp8_f32(a, b, w, false); w = __builtin_amdgcn_cvt_pk_fp8_f32(c, d, w, true); return (unsigned)w; }
DEVI void transpose_item8(const float* W, int K, int N, unsigned char* WT, int row_off, int row_mul, float* scr, int item, int lane, int Npad = 0) {
  if (Npad == 0) Npad = N;
  const int nblk = Npad / 32, kb = item / nblk, nb = item % nblk, k0 = 64 * kb, n0 = 32 * nb;
  const int nn0 = n0 + (lane & 31); const bool ok = nn0 < N;
  const float* src = W + (size_t)(k0 + (lane >> 5)) * N + (ok ? nn0 : 0);
  float v[32];
#pragma unroll
  for (int i = 0; i < 32; ++i) v[i] = src[(size_t)(2 * i) * N];
#pragma unroll
  for (int i = 0; i < 32; ++i) scr[(2 * i + (lane >> 5)) * 33 + (lane & 31)] = ok ? v[i] * W8_SCALE : 0.f;
  __builtin_amdgcn_s_waitcnt(0); __builtin_amdgcn_wave_barrier();
  const int c = lane & 7;
#pragma unroll
  for (int j = 0; j < 4; ++j) {
    const int nn = (lane >> 3) + 8 * j; const float* s = scr + (8 * c) * 33 + nn;
    uint2 o; o.x = pack4_fp8(s[0 * 33], s[1 * 33], s[2 * 33], s[3 * 33]); o.y = pack4_fp8(s[4 * 33], s[5 * 33], s[6 * 33], s[7 * 33]);
    *(uint2*)(WT + (size_t)(row_off + (n0 + nn) * row_mul) * K + k0 + 8 * c) = o;
  }
  __builtin_amdgcn_s_waitcnt(0); __builtin_amdgcn_wave_barrier();
}
DEVI void convert_moe_part8(const Params& p, int layer, int which, float* scr, int gw, int NGW, int lane) {
  const float* wg = p.in[layer ? L1_WGATE : L0_WGATE]; const float* wu = p.in[layer ? L1_WUP : L0_WUP]; const float* wd = p.in[layer ? L1_WDOWN : L0_WDOWN];
  unsigned char* WGU = (unsigned char*)(p.ws + WS_WGU); unsigned char* WD = (unsigned char*)(p.ws + WS_WD);
  constexpr int IPM = 16 * 32;
  if (which == 0) {
    for (int it = gw; it < NE * 2 * IPM; it += NGW) { const int e = it / (2 * IPM), r = it % (2 * IPM), gu = r / IPM, item = r % IPM;
      transpose_item8((gu ? wu : wg) + (size_t)e * DM * DM, DM, DM, WGU + (size_t)e * 2048 * DM, gu, 2, scr, item, lane); }
  } else {
    for (int it = gw; it < NE * IPM; it += NGW) { const int e = it / IPM, item = it % IPM;
      transpose_item8(wd + (size_t)e * DM * DM, DM, DM, WD + (size_t)e * DM * DM, 0, 1, scr, item, lane); }
  }
}
DEVI void convert_moe_tail8(const Params& p, int layer, int which, float* lds, int nunits) {
  const int first = nunits % (int)gridDim.x;
  if ((int)blockIdx.x < first) return;
  const int w = ftid() >> 6;
  convert_moe_part8(p, layer, which, lds + w * (64 * 33), ((int)blockIdx.x - first) * NWAVE + w, ((int)gridDim.x - first) * NWAVE, ftid() & 63);
}

DEVI void phase0(const Params& p, float* lds) {
  const int tid = ftid(), lane = tid & 63, wave = tid >> 6;
  const int gw = blockIdx.x * NWAVE + wave, NGW = gridDim.x * NWAVE;
  for (int it = blockIdx.x; it < 2 * 96; it += gridDim.x) {
    const int layer = it / 96, j0 = (it % 96) * 64;
    float* sc = lds;
    float* red = lds + 9 * 1024;
    __syncthreads();
    for (int i = tid; i < 9 * 1024; i += NT) { const int r = i >> 10, k = i & 1023; const float v = (r < 8) ? p.in[I_C][r * 1024 + k] : p.in[I_CCTX][k]; sc[i] = silu_f(v); }
    __syncthreads();
    const float* wm = p.in[layer ? L1_WMOD : L0_WMOD];
    float acc[9];
#pragma unroll
    for (int r = 0; r < 9; ++r) acc[r] = 0.f;
    for (int k0 = wave * 128; k0 < wave * 128 + 128; k0 += 16) {
      float w[16];
#pragma unroll
      for (int i = 0; i < 16; ++i) w[i] = wm[(size_t)(k0 + i) * 6144 + j0 + lane];
#pragma unroll
      for (int i = 0; i < 16; ++i)
#pragma unroll
        for (int r = 0; r < 9; ++r) acc[r] += sc[r * 1024 + k0 + i] * w[i];
    }
#pragma unroll
    for (int r = 0; r < 9; ++r) red[(wave * 9 + r) * 64 + lane] = acc[r];
    __syncthreads();
    for (int i = tid; i < 9 * 64; i += NT) {
      const int r = i >> 6, c = i & 63; float s = 0.f;
      for (int w = 0; w < 8; ++w) s += red[(w * 9 + r) * 64 + c];
      float* MOD = (float*)(p.ws + WS_CTL + CTL_MOD);
      MOD[(layer * 9 + r) * 6144 + j0 + c] = s + p.in[layer ? L1_BMOD : L0_BMOD][j0 + c];
    }
    __syncthreads();
  }
  if (blockIdx.x == gridDim.x - 1) {
    float* ROPE = (float*)(p.ws + WS_CTL + CTL_ROPE);
    for (int i = tid; i < 64 * 16; i += NT) {
      const int pos = i >> 4, f = i & 15;
      const float inv = powf(10000.f, -(float)f / 16.f);
      const float ang = (float)pos * inv;
      ROPE[2 * i] = cosf(ang); ROPE[2 * i + 1] = sinf(ang);
    }
    if (wave == 0) {
      float a = p.in[L0_LAMQ1][lane] * p.in[L0_LAMK1][lane], b = p.in[L0_LAMQ2][lane] * p.in[L0_LAMK2][lane];
      a = wave_sum(a); b = wave_sum(b);
      if (lane == 0) { float* LAM = (float*)(p.ws + WS_CTL + CTL_LAM); LAM[0] = expf(a) - expf(b) + 0.2f; *(int*)(p.ws + WS_CTL + CTL_QC) = 0; }
    }
  }
  __syncthreads();
  float* scr = lds + wave * (64 * 33);
  {
    constexpr int I_IN0 = 16 * (N_IN0 / 32), I_OUT = 16 * 32, I_IN1 = 16 * (N_IN1P / 32);
    constexpr int NITEMS = I_IN0 + I_OUT + I_IN1 + I_OUT;
    for (int it = gw; it < NITEMS; it += NGW) {
      int r = it;
      if (r < I_IN0) { if (QKV0_FP8) transpose_item8(p.in[L0_WIN], DM, N_IN0, (unsigned char*)(p.ws + WS_WIN0), 0, 1, scr, r, lane); else transpose_item(p.in[L0_WIN], DM, N_IN0, (bf16_t*)(p.ws + WS_WIN0), 0, 1, scr, r, lane, N_IN0); continue; } r -= I_IN0;
      if (r < I_OUT) { transpose_item(p.in[L0_WOUT], DM, DM, (bf16_t*)(p.ws + WS_WOUT0), 0, 1, scr, r, lane, DM); continue; } r -= I_OUT;
      if (r < I_IN1) { if (QKV1_FP8) transpose_item8(p.in[L1_WIN], DM, N_IN1, (unsigned char*)(p.ws + WS_WIN1), 0, 1, scr, r, lane, N_IN1P); else transpose_item(p.in[L1_WIN], DM, N_IN1, (bf16_t*)(p.ws + WS_WIN1), 0, 1, scr, r, lane, N_IN1P); continue; } r -= I_IN1;
      transpose_item(p.in[L1_WOUT], DM, DM, (bf16_t*)(p.ws + WS_WOUT1), 0, 1, scr, r, lane, DM);
    }
  }
  convert_moe_part8(p, 0, 0, scr, gw, NGW, lane);
#ifndef TAILFILL
  convert_moe_part8(p, 0, 1, scr, gw, NGW, lane);
#endif
}

struct Row16 { float4 v[4]; };
DEVI Row16 ld_row_f32(const float* r, int lane) { Row16 o; const float4* q = (const float4*)r + lane;
#pragma unroll
  for (int j = 0; j < 4; ++j) o.v[j] = q[64 * j]; return o; }
DEVI Row16 ld_row_bf16(const bf16_t* r, int lane) { Row16 o; const uint2* q = (const uint2*)r + lane;
#pragma unroll
  for (int j = 0; j < 4; ++j) { const uint2 w = q[64 * j]; o.v[j] = make_float4(__uint_as_float(w.x << 16), __uint_as_float(w.x & 0xffff0000u), __uint_as_float(w.y << 16), __uint_as_float(w.y & 0xffff0000u)); }
  return o; }
DEVI void st_row_f32(float* r, int lane, const Row16& o) { float4* q = (float4*)r + lane;
#pragma unroll
  for (int j = 0; j < 4; ++j) q[64 * j] = o.v[j]; }
DEVI void st_row_bf16(bf16_t* r, int lane, const Row16& o) { uint2* q = (uint2*)r + lane;
#pragma unroll
  for (int j = 0; j < 4; ++j) q[64 * j] = make_uint2(pk2(o.v[j].x, o.v[j].y), pk2(o.v[j].z, o.v[j].w)); }
DEVI float row_sumsq(const Row16& o) { float s = 0.f;
#pragma unroll
  for (int j = 0; j < 4; ++j) s += o.v[j].x * o.v[j].x + o.v[j].y * o.v[j].y + o.v[j].z * o.v[j].z + o.v[j].w * o.v[j].w;
  return wave_sum(s); }
#define ROW_FOR4(expr) _Pragma("unroll") for (int j = 0; j < 4; ++j) { { float& e = o.v[j].x; const float a = A.v[j].x, b = Bv.v[j].x, c = Cv.v[j].x; expr; } { float& e = o.v[j].y; const float a = A.v[j].y, b = Bv.v[j].y, c = Cv.v[j].y; expr; } { float& e = o.v[j].z; const float a = A.v[j].z, b = Bv.v[j].z, c = Cv.v[j].z; expr; } { float& e = o.v[j].w; const float a = A.v[j].w, b = Bv.v[j].w, c = Cv.v[j].w; expr; } }

DEVI Row16 norm_mod(const Row16& x, const float* g, const float* sc, const float* sh, int lane) {
  const float r = rsqrtf(row_sumsq(x) * (1.f / DM) + EPS);
  Row16 o = x; const Row16 A = ld_row_f32(g, lane), Bv = ld_row_f32(sc, lane), Cv = ld_row_f32(sh, lane);
  ROW_FOR4(e = e * r * a * (1.f + b) + c);
  return o;
}

DEVI void phase_prenorm0(const Params& p) {
  const int lane = ftid() & 63, gw = blockIdx.x * NWAVE + (ftid() >> 6), NGW = gridDim.x * NWAVE;
  const float* MOD = (const float*)(p.ws + WS_CTL + CTL_MOD);
  bf16_t* H = (bf16_t*)(p.ws + WS_H);
  for (int r = gw; r < NROW; r += NGW) {
    const float* src = r < NLAT ? p.in[I_X] + (size_t)r * DM : p.in[I_CTX] + (size_t)(r - NLAT) * DM;
    const float* m = MOD + (size_t)row_modrow(r) * 6144;
    const Row16 x = ld_row_f32(src, lane);
    const Row16 h = norm_mod(x, p.in[L0_GPREMIX], m + 1024, m, lane);
    st_row_bf16(H + (size_t)r * DM, lane, h);
  }
}

template <class AF, class EF>
DEVI void gemm_tile(float* lds, const bf16_t* Bt, int n0, int K, AF arow, EF epi) {
  const int tid = ftid(), ty = tid >> 4, tx = tid & 15;
  float (*As)[132] = (float (*)[132])lds;
  float (*Bs)[68] = (float (*)[68])(lds + 16 * 132);
  float acc[4][4];
#pragma unroll
  for (int i = 0; i < 4; ++i)
#pragma unroll
    for (int j = 0; j < 4; ++j) acc[i][j] = 0.f;
  const int ar = tid >> 2, ak = (tid & 3) * 4;
  const int br = tid >> 3, bk = (tid & 7) * 2;
  const bf16_t* ap = arow(ar) + ak;
  const bf16_t* bp = Bt + (size_t)(n0 + br) * K + bk;
  for (int k0 = 0; k0 < K; k0 += 16) {
    const uint2 av = *(const uint2*)(ap + k0);
    const unsigned bv = *(const unsigned*)(bp + k0);
    __syncthreads();
    As[ak + 0][ar] = __uint_as_float(av.x << 16); As[ak + 1][ar] = __uint_as_float(av.x & 0xffff0000u);
    As[ak + 2][ar] = __uint_as_float(av.y << 16); As[ak + 3][ar] = __uint_as_float(av.y & 0xffff0000u);
    Bs[bk + 0][br] = __uint_as_float(bv << 16); Bs[bk + 1][br] = __uint_as_float(bv & 0xffff0000u);
    __syncthreads();
#pragma unroll
    for (int kk = 0; kk < 16; ++kk) {
      const float4 a = *(const float4*)&As[kk][ty * 4]; const float4 b = *(const float4*)&Bs[kk][tx * 4];
      const float aa[4] = {a.x, a.y, a.z, a.w}, bb[4] = {b.x, b.y, b.z, b.w};
#pragma unroll
      for (int i = 0; i < 4; ++i)
#pragma unroll
        for (int j = 0; j < 4; ++j) acc[i][j] += aa[i] * bb[j];
    }
  }
#pragma unroll
  for (int i = 0; i < 4; ++i) epi(ty * 4 + i, n0 + tx * 4, acc[i]);
}

DEVI void rope_pair(const float* ROPE, int t, int d, float& u1, float& u2) {
  const int i = d >> 1, f = i & 15, pos = (i < 16) ? (t >> 6) : (t & 63);
  const float cs = ROPE[(pos * 16 + f) * 2], sn = ROPE[(pos * 16 + f) * 2 + 1];
  const float a = u1 * cs - u2 * sn, b = u1 * sn + u2 * cs; u1 = a; u2 = b;
}

DEVI void phase_qkv0(const Params& p, float* lds) {
  const bf16_t* H = (const bf16_t*)(p.ws + WS_H); const bf16_t* W = (const bf16_t*)(p.ws + WS_WIN0);
  bf16_t* Q = (bf16_t*)(p.ws + WS_QKV0); const float* ROPE = (const float*)(p.ws + WS_CTL + CTL_ROPE);
  constexpr int NTN = N_IN0 / 64, NTM = NROW / 128;
  for (int it = blockIdx.x; it < NTN * NTM; it += gridDim.x) {
    const int mt = it / NTN, nt = it % NTN, m0 = mt * 128;
    gemm_tile(lds, W, nt * 64, DM,
      [&](int r) { return H + (size_t)(m0 + r) * DM; },
      [&](int r, int n, float* v) {
        const int row = m0 + r;
        if (row < NLAT && n < 1024) { const int t = row & 4095; rope_pair(ROPE, t, n & 63, v[0], v[1]); rope_pair(ROPE, t, (n + 2) & 63, v[2], v[3]); }
        *(uint2*)(Q + (size_t)row * N_IN0 + n) = make_uint2(pk2(v[0], v[1]), pk2(v[2], v[3]));
      });
  }
}

template <int NS, int VJ, class KF>
DEVI void wave_attn(const float* qs, float* pl  , int* rl  , int nkeys, KF kf, const bf16_t* KV, int ld, int kcol, int vcol,
                    float sink, bool has_sink, float (&o)[NS][VJ], float (&m)[NS], float (&l)[NS], int lane) {
#pragma unroll
  for (int s = 0; s < NS; ++s) { m[s] = -INFINITY; l[s] = 0.f;
#pragma unroll
    for (int j = 0; j < VJ; ++j) o[s][j] = 0.f; }
  for (int c0 = 0; c0 < nkeys; c0 += 64) {
    const int kidx = c0 + lane; int row = -1; float bias = 0.f;
    bool valid = kidx < nkeys; if (valid) valid = kf(kidx, row, bias);
    const int rr = valid ? row : 0;
    rl[lane] = valid ? row : -1;
    float sc[NS];
#pragma unroll
    for (int s = 0; s < NS; ++s) {
      const uint4* kp = (const uint4*)(KV + (size_t)rr * ld + kcol + 64 * s); float d = 0.f;
#pragma unroll
      for (int i = 0; i < 8; ++i) { const uint4 w = kp[i]; const float* q = qs + s * 64 + i * 8;
        d += q[0] * __uint_as_float(w.x << 16) + q[1] * __uint_as_float(w.x & 0xffff0000u) + q[2] * __uint_as_float(w.y << 16) + q[3] * __uint_as_float(w.y & 0xffff0000u)
           + q[4] * __uint_as_float(w.z << 16) + q[5] * __uint_as_float(w.z & 0xffff0000u) + q[6] * __uint_as_float(w.w << 16) + q[7] * __uint_as_float(w.w & 0xffff0000u); }
      sc[s] = valid ? d + bias : -INFINITY;
    }
#pragma unroll
    for (int s = 0; s < NS; ++s) {
      const float cm = wave_max(sc[s]); const float mn = fmaxf(m[s], cm);
      float pv = 0.f, scale = 1.f;
      if (mn > -INFINITY) { pv = __expf(sc[s] - mn); scale = __expf(m[s] - mn); }
      l[s] = l[s] * scale + wave_sum(pv); m[s] = mn;
#pragma unroll
      for (int j = 0; j < VJ; ++j) o[s][j] *= scale;
      pl[s * 64 + lane] = pv;
    }
    __builtin_amdgcn_s_waitcnt(0); __builtin_amdgcn_wave_barrier();
    for (int kk = 0; kk < 64; ++kk) {
      const int rk = rl[kk]; if (rk < 0) continue;
      const bf16_t* vp = KV + (size_t)rk * ld + vcol + lane;
      float vv[VJ];
#pragma unroll
      for (int j = 0; j < VJ; ++j) vv[j] = bf2f(vp[64 * j]);
#pragma unroll
      for (int s = 0; s < NS; ++s) { const float pk = pl[s * 64 + kk];
#pragma unroll
        for (int j = 0; j < VJ; ++j) o[s][j] += pk * vv[j]; }
    }
    __builtin_amdgcn_s_waitcnt(0); __builtin_amdgcn_wave_barrier();
  }
  if (has_sink) {
#pragma unroll
    for (int s = 0; s < NS; ++s) { const float mn = fmaxf(m[s], sink); const float scale = __expf(m[s] - mn);
      l[s] = l[s] * scale + __expf(sink - mn); m[s] = mn;
#pragma unroll
      for (int j = 0; j < VJ; ++j) o[s][j] *= scale; }
  }
}

DEVI void phase_attn0(const Params& p, float* lds) {
  const int tid = ftid(), lane = tid & 63, wave = tid >> 6;
  const int gw = blockIdx.x * NWAVE + wave, NGW = gridDim.x * NWAVE;
  const bf16_t* Q = (const bf16_t*)(p.ws + WS_QKV0); bf16_t* ATT = (bf16_t*)(p.ws + WS_ATT0);
  const float lam = ((const float*)(p.ws + WS_CTL + CTL_LAM))[0];
  float* qs = lds + wave * 128; float* pl = lds + 1024 + wave * 128; int* rl = (int*)(lds + 2048) + wave * 64;
  for (long it = gw; it < (long)NROW * 12; it += NGW) {
    const int row = (int)(it / 12), hs = (int)(it % 12);
    const bool lat = row < NLAT; const int b = lat ? (row >> 12) : ((row - NLAT) >> 8), t = lat ? (row & 4095) : 0;
    __builtin_amdgcn_s_waitcnt(0); __builtin_amdgcn_wave_barrier();
    if (hs < 4) {
      const bf16_t* qp = Q + (size_t)row * N_IN0 + hs * 128;
      qs[lane] = bf2f(qp[lane]) * 0.125f; qs[64 + lane] = bf2f(qp[64 + lane]) * 0.125f;
      __builtin_amdgcn_s_waitcnt(0); __builtin_amdgcn_wave_barrier();
      float o[2][2], m[2], l[2];
      const int nkeys = lat ? SEQ + CTXL : CTXL;
      wave_attn<2, 2>(qs, pl, rl, nkeys, [&](int k, int& r, float& bias) { r = lat ? (k < SEQ ? b * SEQ + k : NLAT + b * CTXL + (k - SEQ)) : NLAT + b * CTXL + k; return true; },
                      Q, N_IN0, 512 + hs * 128, 1024 + hs * 128, 0.f, false, o, m, l, lane);
      float v0 = o[0][0] / l[0] - lam * o[1][0] / l[1], v1 = o[0][1] / l[0] - lam * o[1][1] / l[1];
      const float r = rsqrtf(wave_sum(v0 * v0 + v1 * v1) * (1.f / 128.f) + EPS);
      const float* g = p.in[L0_SUBLN];
      ATT[(size_t)row * DM + hs * 128 + lane] = f2bf(v0 * r * g[lane] * 0.8f);
      ATT[(size_t)row * DM + hs * 128 + 64 + lane] = f2bf(v1 * r * g[64 + lane] * 0.8f);
    } else {
      const int h = hs - 4;
      qs[lane] = bf2f(Q[(size_t)row * N_IN0 + 1536 + h * 64 + lane]) * 0.125f;
      __builtin_amdgcn_s_waitcnt(0); __builtin_amdgcn_wave_barrier();
      float o[1][1], m[1], l[1];
      const int qr = t >> 6, qc = t & 63;
      const int rs = min(max(qr - 4, 0), 56), cs = min(max(qc - 8, 0), 48);
      const float* rpb = p.in[L0_RPB] + h * 15 * 31;
      const int nkeys = lat ? 128 + CTXL : CTXL;
      wave_attn<1, 1>(qs, pl, rl, nkeys, [&](int k, int& r, float& bias) {
          if (!lat) { r = NLAT + b * CTXL + k; return true; }
          if (k < 128) { const int kr = rs + (k >> 4), kc = cs + (k & 15); r = b * SEQ + kr * 64 + kc; bias = rpb[(kr - qr + 7) * 31 + (kc - qc + 15)]; }
          else r = NLAT + b * CTXL + (k - 128);
          return true; },
        Q, N_IN0, 2048 + h * 64, 2560 + h * 64, 0.f, false, o, m, l, lane);
      ATT[(size_t)row * DM + 512 + h * 64 + lane] = f2bf(o[0][0] / l[0]);
    }
  }
}

DEVI void phase_outproj(const Params& p, float* lds, int layer) {
  const bf16_t* A = (const bf16_t*)(p.ws + (layer ? WS_ATT1 : WS_ATT0)); const bf16_t* W = (const bf16_t*)(p.ws + (layer ? WS_WOUT1 : WS_WOUT0));
  bf16_t* MIX = (bf16_t*)(p.ws + (layer ? WS_MIX1 : WS_MIX0));
  const int NTM = (layer ? NLAT : NROW) / 128; constexpr int NTN = DM / 64;
  for (int it = blockIdx.x; it < NTN * NTM; it += gridDim.x) {
    const int mt = it / NTN, nt = it % NTN, m0 = mt * 128;
    gemm_tile(lds, W, nt * 64, DM, [&](int r) { return A + (size_t)(m0 + r) * DM; },
      [&](int r, int n, float* v) { *(uint2*)(MIX + (size_t)(m0 + r) * DM + n) = make_uint2(pk2(v[0], v[1]), pk2(v[2], v[3])); });
  }
}

DEVI void phase_postmix(const Params& p, int layer) {
  const int lane = ftid() & 63, gw = blockIdx.x * NWAVE + (ftid() >> 6), NGW = gridDim.x * NWAVE;
  const float* MOD = (const float*)(p.ws + WS_CTL + CTL_MOD) + (size_t)layer * 9 * 6144;
  const bf16_t* MIX = (const bf16_t*)(p.ws + (layer ? WS_MIX1 : WS_MIX0));
  bf16_t* H = (bf16_t*)(p.ws + WS_H); float* AFF = (float*)(p.ws + WS_AFF); float* XC = (float*)(p.ws + WS_XC);
  const float* gpost = p.in[layer ? L1_GPOSTMIX : L0_GPOSTMIX]; const float* gpre = p.in[layer ? L1_GPREFFN : L0_GPREFFN];
  const float* wr = p.in[layer ? L1_WROUTER : L0_WROUTER];
  const int nrow = layer ? NLAT : NROW;
  for (int r = gw; r < nrow; r += NGW) {
    const float* m = MOD + (size_t)row_modrow(r) * 6144;
    const float* xin = layer ? (p.out + (size_t)r * DM) : (r < NLAT ? p.in[I_X] + (size_t)r * DM : p.in[I_CTX] + (size_t)(r - NLAT) * DM);
    float* xout = r < NLAT ? p.out + (size_t)r * DM : XC + (size_t)(r - NLAT) * DM;
    Row16 o = ld_row_bf16(MIX + (size_t)r * DM, lane);
    const float rr = rsqrtf(row_sumsq(o) * (1.f / DM) + EPS);
    { const Row16 A = ld_row_f32(gpost, lane), Bv = ld_row_f32(m + 2048, lane), Cv = ld_row_f32(xin, lane);
      ROW_FOR4(e = c + b * (e * rr * a)); }
    st_row_f32(xout, lane, o);
    const Row16 h = norm_mod(o, gpre, m + 4096, m + 3072, lane);
    st_row_bf16(H + (size_t)r * DM, lane, h);
    float lg[16];
#pragma unroll
    for (int e = 0; e < 16; ++e) lg[e] = 0.f;
#pragma unroll
    for (int j = 0; j < 4; ++j) {
      const float hv[4] = {h.v[j].x, h.v[j].y, h.v[j].z, h.v[j].w};
#pragma unroll
      for (int q = 0; q < 4; ++q) { const float4* w4 = (const float4*)(wr + (size_t)(lane * 4 + 256 * j + q) * 16);
#pragma unroll
        for (int e4 = 0; e4 < 4; ++e4) { const float4 w = w4[e4]; lg[e4 * 4] += hv[q] * w.x; lg[e4 * 4 + 1] += hv[q] * w.y; lg[e4 * 4 + 2] += hv[q] * w.z; lg[e4 * 4 + 3] += hv[q] * w.w; } }
    }
    float mx = -INFINITY;
#pragma unroll
    for (int e = 0; e < 16; ++e) { lg[e] = wave_sum(lg[e]); mx = fmaxf(mx, lg[e]); }
    float s = 0.f;
#pragma unroll
    for (int e = 0; e < 16; ++e) { lg[e] = expf(lg[e] - mx); s += lg[e]; }
    const float inv = 1.f / s;
    float mine = 0.f;
#pragma unroll
    for (int e = 0; e < 16; ++e) if (lane == e) mine = lg[e] * inv;
    if (lane < 16) AFF[(size_t)lane * NROW + r] = mine;
  }
}

DEVI void phase_topk(const Params& p, float* lds, int layer) {
  const int tid = ftid();
  const float* AFF = (const float*)(p.ws + WS_AFF); int* SLOT = (int*)(p.ws + WS_SLOT); int* IDX = (int*)(p.ws + WS_IDX); float* GV = (float*)(p.ws + WS_GATEV);
  const int erows = layer ? EROWS1 : EROWS0;
  const int nlat_items = NB * NE * 8, nitems = nlat_items + (layer ? 0 : NB * NE);
  for (int it = blockIdx.x; it < nitems; it += gridDim.x) {
    const bool lat = it < nlat_items;
    int b, e, ch, n, cap, row0, slot0;
    if (lat) { b = it / (NE * 8); e = (it / 8) % NE; ch = it % 8; n = SEQ; cap = CAP_L; row0 = b * SEQ; slot0 = b * CAP_L; }
    else { const int i2 = it - nlat_items; b = i2 / NE; e = i2 % NE; ch = 0; n = CTXL; cap = CAP_C; row0 = NLAT + b * CTXL; slot0 = NB * CAP_L + b * CAP_C; }
    __syncthreads();
    for (int i = tid; i < n; i += NT) lds[i] = AFF[(size_t)e * NROW + row0 + i];
    __syncthreads();
    const int t = ch * 512 + tid;
    if (t < n) {
      const float a = lds[t]; int rank = 0;
      for (int j = 0; j < n; ++j) { const float v = lds[j]; rank += (v > a || (v == a && j < t)) ? 1 : 0; }
      if (rank < cap) { IDX[e * erows + slot0 + rank] = row0 + t; GV[e * erows + slot0 + rank] = a; SLOT[(size_t)(row0 + t) * 16 + e] = slot0 + rank; }
      else SLOT[(size_t)(row0 + t) * 16 + e] = -1;
    }
  }
}

DEVI void phase_moe_up(const Params& p, float* lds, int layer) {
  const bf16_t* H = (const bf16_t*)(p.ws + WS_H); const bf16_t* WGU = (const bf16_t*)(p.ws + WS_WGU); bf16_t* HID = (bf16_t*)(p.ws + WS_HID);
  const int* IDX = (const int*)(p.ws + WS_IDX);
  const int erows = layer ? EROWS1 : EROWS0, NTM = erows / 128; constexpr int NTN = 2048 / 64;
  for (int it = blockIdx.x; it < NE * NTM * NTN; it += gridDim.x) {
    const int e = it / (NTM * NTN), r2 = it % (NTM * NTN), mt = r2 / NTN, nt = r2 % NTN, m0 = mt * 128;
    gemm_tile(lds, WGU + (size_t)e * 2048 * DM, nt * 64, DM, [&](int r) { return H + (size_t)IDX[e * erows + m0 + r] * DM; },
      [&](int r, int n, float* v) { *(unsigned*)(HID + ((size_t)e * erows + m0 + r) * DM + (n >> 1)) = pk2(silu_f(v[0]) * v[1], silu_f(v[2]) * v[3]); });
  }
}
DEVI void phase_moe_down(const Params& p, float* lds, int layer) {
  const bf16_t* HID = (const bf16_t*)(p.ws + WS_HID); const bf16_t* WD = (const bf16_t*)(p.ws + WS_WD); bf16_t* Y = (bf16_t*)(p.ws + WS_Y);
  const float* GV = (const float*)(p.ws + WS_GATEV);
  const int erows = layer ? EROWS1 : EROWS0, NTM = erows / 128; constexpr int NTN = DM / 64;
  for (int it = blockIdx.x; it < NE * NTM * NTN; it += gridDim.x) {
    const int e = it / (NTM * NTN), r2 = it % (NTM * NTN), mt = r2 / NTN, nt = r2 % NTN, m0 = mt * 128;
    gemm_tile(lds, WD + (size_t)e * DM * DM, nt * 64, DM, [&](int r) { return HID + ((size_t)e * erows + m0 + r) * DM; },
      [&](int r, int n, float* v) { const float g = GV[e * erows + m0 + r];
        *(uint2*)(Y + ((size_t)e * erows + m0 + r) * DM + n) = make_uint2(pk2(v[0] * g, v[1] * g), pk2(v[2] * g, v[3] * g)); });
  }
}

DEVI void phase_combine(const Params& p, float* lds, int layer) {
  const int lane = ftid() & 63, wave = ftid() >> 6, gw = blockIdx.x * NWAVE + wave, NGW = gridDim.x * NWAVE;
  const float* MOD = (const float*)(p.ws + WS_CTL + CTL_MOD);
  const bf16_t* Y = (const bf16_t*)(p.ws + WS_Y); const int* SLOT = (const int*)(p.ws + WS_SLOT);
  bf16_t* H = (bf16_t*)(p.ws + WS_H); float* XC = (float*)(p.ws + WS_XC);
  const float* gpost = p.in[layer ? L1_GPOSTFFN : L0_GPOSTFFN];
  const int nrow = layer ? NLAT : NROW, erows = layer ? EROWS1 : EROWS0;
  for (int r = gw; r < nrow; r += NGW) {
    const float* m = MOD + (size_t)(layer * 9 + row_modrow(r)) * 6144;
    float* xio = r < NLAT ? p.out + (size_t)r * DM : XC + (size_t)(r - NLAT) * DM;
    Row16 o;
#pragma unroll
    for (int j = 0; j < 4; ++j) o.v[j] = make_float4(0.f, 0.f, 0.f, 0.f);
    for (int e = 0; e < NE; ++e) {
      const int s = SLOT[(size_t)r * 16 + e];
      if (s >= 0) { const Row16 y = ld_row_bf16(Y + ((size_t)e * erows + s) * DM, lane);
#pragma unroll
        for (int j = 0; j < 4; ++j) { o.v[j].x += y.v[j].x; o.v[j].y += y.v[j].y; o.v[j].z += y.v[j].z; o.v[j].w += y.v[j].w; } }
    }
    const float rr = rsqrtf(row_sumsq(o) * (1.f / DM) + EPS);
    { const Row16 A = ld_row_f32(gpost, lane), Bv = ld_row_f32(m + 5120, lane), Cv = ld_row_f32(xio, lane);
      ROW_FOR4(e = c + b * (e * rr * a)); }
    st_row_f32(xio, lane, o);
    if (layer == 0) {
      const float* m1 = MOD + (size_t)(9 + row_modrow(r)) * 6144;
      const Row16 h = norm_mod(o, p.in[L1_GPREMIX], m1 + 1024, m1, lane);
      st_row_bf16(H + (size_t)r * DM, lane, h);
    }
  }
  if (layer == 0) { convert_moe_part(p, 1, 0, lds + wave * (64 * 33), gw, NGW, lane); convert_moe_part(p, 1, 1, lds + wave * (64 * 33), gw, NGW, lane); }
}

DEVI void phase_qkv1(const Params& p, float* lds) {
  const bf16_t* H = (const bf16_t*)(p.ws + WS_H); const bf16_t* W = (const bf16_t*)(p.ws + WS_WIN1);
  bf16_t* P1 = (bf16_t*)(p.ws + WS_P1); float* DT = (float*)(p.ws + WS_DT); const float* ROPE = (const float*)(p.ws + WS_CTL + CTL_ROPE);
  constexpr int NTN = 37, NTM = NROW / 128;
  for (int it = blockIdx.x; it < NTN * NTM; it += gridDim.x) {
    const int mt = it / NTN, nt = it % NTN, m0 = mt * 128;
    gemm_tile(lds, W, nt * 64, DM, [&](int r) { return H + (size_t)(m0 + r) * DM; },
      [&](int r, int n, float* v) {
        const int row = m0 + r;
        if (n >= 2304) { if (n < 2320) *(float4*)(DT + (size_t)row * 16 + (n - 2304)) = make_float4(v[0], v[1], v[2], v[3]); return; }
        if (row < NLAT && n < 640) { const int t = row & 4095; rope_pair(ROPE, t, n & 63, v[0], v[1]); rope_pair(ROPE, t, (n + 2) & 63, v[2], v[3]); }
        *(uint2*)(P1 + (size_t)row * 2304 + n) = make_uint2(pk2(v[0], v[1]), pk2(v[2], v[3]));
      });
  }
}

DEVI void phase_conv_swa(const Params& p, float* lds, bool do_swa) {
  const int tid = ftid(), lane = tid & 63, wave = tid >> 6;
  const int gw = blockIdx.x * NWAVE + wave, NGW = gridDim.x * NWAVE;
  const bf16_t* P1 = (const bf16_t*)(p.ws + WS_P1); bf16_t* U = (bf16_t*)(p.ws + WS_U); bf16_t* ATT = (bf16_t*)(p.ws + WS_ATT1);
  const float* cw = p.in[L1_CONVW]; const float* cb = p.in[L1_CONVB];
  for (long i = (long)blockIdx.x * NT + tid; i < (long)NROW * 1024; i += (long)gridDim.x * NT) {
    const int row = (int)(i >> 10), ch = (int)(i & 1023);
    int s0, len, t; if (row < NLAT) { s0 = row & ~4095; len = SEQ; t = row & 4095; } else { s0 = NLAT + ((row - NLAT) & ~255); len = CTXL; t = (row - NLAT) & 255; }
    float acc = cb[ch];
#pragma unroll
    for (int j = 0; j < 5; ++j) { const int tt = t + j - 2; if (tt >= 0 && tt < len) acc += cw[j * 1024 + ch] * bf2f(P1[(size_t)(s0 + tt) * 2304 + 768 + ch]); }
    U[(size_t)row * 1024 + ch] = f2bf(silu_f(acc));
  }
  if (!do_swa) return;
  float* qs = lds + wave * 128; float* pl = lds + 1024 + wave * 128; int* rl = (int*)(lds + 2048) + wave * 64;
  for (long it = gw; it < (long)NLAT * 8; it += NGW) {
    const int row = (int)(it >> 3), hq = (int)(it & 7), g = hq >> 2, b = row >> 12, t = row & 4095;
    __builtin_amdgcn_s_waitcnt(0); __builtin_amdgcn_wave_barrier();
    qs[lane] = bf2f(P1[(size_t)row * 2304 + hq * 64 + lane]) * 0.125f;
    __builtin_amdgcn_s_waitcnt(0); __builtin_amdgcn_wave_barrier();
    float o[1][1], m[1], l[1];
    wave_attn<1, 1>(qs, pl, rl, 320 + CTXL, [&](int k, int& r, float& bias) {
        if (k < 320) { const int kp = t - 128 + k; if (k > 256 || kp < 0 || kp >= SEQ) return false; r = b * SEQ + kp; return true; }
        r = NLAT + b * CTXL + (k - 320); return true; },
      P1, 2304, 512 + g * 64, 640 + g * 64, p.in[L1_SINKS][hq], true, o, m, l, lane);
    ATT[(size_t)row * DM + hq * 64 + lane] = f2bf(o[0][0] / l[0]);
  }
}

DEVI void phase_ssd(const Params& p, float* lds) {
  const int tid = ftid();
  const bf16_t* U = (const bf16_t*)(p.ws + WS_U); const float* DT = (const float*)(p.ws + WS_DT); float* YS = (float*)(p.ws + WS_YS);
  constexpr int CH = 32;
  float* xb = lds;
  float* bb = lds + CH * 64;
  float* cb = bb + CH * 128;
  float* db = cb + CH * 128;
  float* yb = db + 2 * CH;
  const int pi = tid >> 3, ns = (tid & 7) * 16;
  for (int it = blockIdx.x; it < NB * 8; it += gridDim.x) {
    const int b = it >> 3, hd = it & 7, g = hd >> 2;
    for (int dir = 0; dir < 2; ++dir) {
      const float a = -expf(p.in[dir ? L1_ALOGB : L1_ALOGF][hd]); const float dtb = p.in[dir ? L1_DTBB : L1_DTBF][hd];
      float st[16];
#pragma unroll
      for (int i = 0; i < 16; ++i) st[i] = 0.f;
      for (int seg = 0; seg < 2; ++seg) {
        const int len = seg ? SEQ : CTXL, s0 = seg ? b * SEQ : NLAT + b * CTXL;
        for (int c0 = 0; c0 < len; c0 += CH) {
          __syncthreads();
          for (int i = tid; i < CH * 320; i += NT) {
            const int st_i = i / 320, c = i % 320; const int tk = dir ? (len - 1 - (c0 + st_i)) : (c0 + st_i); const size_t r = (size_t)(s0 + tk);
            if (c < 64) xb[st_i * 64 + c] = bf2f(U[r * 1024 + hd * 64 + c]);
            else if (c < 192) bb[st_i * 128 + (c - 64)] = bf2f(U[r * 1024 + 512 + g * 128 + (c - 64)]);
            else cb[st_i * 128 + (c - 192)] = bf2f(U[r * 1024 + 768 + g * 128 + (c - 192)]);
          }
          if (tid < CH) { const int tk = dir ? (len - 1 - (c0 + tid)) : (c0 + tid); const float raw = DT[(size_t)(s0 + tk) * 16 + dir * 8 + hd] + dtb;
            const float dt = raw > 20.f ? raw : log1pf(expf(raw)); db[tid] = expf(dt * a); db[CH + tid] = dt; }
          __syncthreads();
          for (int i = 0; i < CH; ++i) {
            const float dec = db[i], dx = db[CH + i] * xb[i * 64 + pi]; float y = 0.f;
#pragma unroll
            for (int q = 0; q < 16; ++q) { st[q] = st[q] * dec + dx * bb[i * 128 + ns + q]; y += st[q] * cb[i * 128 + ns + q]; }
            y += __shfl_xor(y, 1); y += __shfl_xor(y, 2); y += __shfl_xor(y, 4);
            if ((tid & 7) == 0) yb[i * 64 + pi] = y;
          }
          __syncthreads();
          if (seg == 1) for (int i = tid; i < CH * 64; i += NT) {
            const int q = i >> 6, c = i & 63; const int tk = (dir ? (len - CH - c0) : c0) + q, st_i = dir ? (CH - 1 - q) : q;
            float* yp = YS + (size_t)(b * SEQ + tk) * 512 + hd * 64 + c;
            if (dir == 0) *yp = yb[st_i * 64 + c]; else *yp = *yp + yb[st_i * 64 + c];
          }
        }
      }
      __syncthreads(); __threadfence();
    }
  }
}

DEVI void phase_ssd_out(const Params& p) {
  const int lane = ftid() & 63, gw = blockIdx.x * NWAVE + (ftid() >> 6), NGW = gridDim.x * NWAVE;
  const bf16_t* U = (const bf16_t*)(p.ws + WS_U); const bf16_t* P1 = (const bf16_t*)(p.ws + WS_P1); const float* YS = (const float*)(p.ws + WS_YS);
  bf16_t* ATT = (bf16_t*)(p.ws + WS_ATT1);
  for (int r = gw; r < NLAT; r += NGW) {
    const int c0 = lane * 8, hd = c0 >> 6; const float dsk = p.in[L1_DSKIP][hd];
    const float4 y0 = *(const float4*)(YS + (size_t)r * 512 + c0), y1 = *(const float4*)(YS + (size_t)r * 512 + c0 + 4);
    const uint4 xw = *(const uint4*)(U + (size_t)r * 1024 + c0), zw = *(const uint4*)(P1 + (size_t)r * 2304 + 1792 + c0);
    float y[8] = {y0.x, y0.y, y0.z, y0.w, y1.x, y1.y, y1.z, y1.w};
    const unsigned xs[4] = {xw.x, xw.y, xw.z, xw.w}, zs[4] = {zw.x, zw.y, zw.z, zw.w};
    float ss = 0.f;
#pragma unroll
    for (int i = 0; i < 4; ++i) {
      const float x0 = __uint_as_float(xs[i] << 16), x1 = __uint_as_float(xs[i] & 0xffff0000u), z0 = __uint_as_float(zs[i] << 16), z1 = __uint_as_float(zs[i] & 0xffff0000u);
      y[2 * i] = (y[2 * i] + dsk * x0) * silu_f(z0); y[2 * i + 1] = (y[2 * i + 1] + dsk * x1) * silu_f(z1);
      ss += y[2 * i] * y[2 * i] + y[2 * i + 1] * y[2 * i + 1];
    }
#pragma unroll
    for (int o = 1; o < 32; o <<= 1) ss += __shfl_xor(ss, o);
    const float rr = rsqrtf(ss * (1.f / 256.f) + EPS);
    const float4 g0 = *(const float4*)(p.in[L1_GNORM] + c0), g1 = *(const float4*)(p.in[L1_GNORM] + c0 + 4);
    uint4 w; w.x = pk2(y[0] * rr * g0.x, y[1] * rr * g0.y); w.y = pk2(y[2] * rr * g0.z, y[3] * rr * g0.w); w.z = pk2(y[4] * rr * g1.x, y[5] * rr * g1.y); w.w = pk2(y[6] * rr * g1.z, y[7] * rr * g1.w);
    *(uint4*)(ATT + (size_t)r * DM + 512 + c0) = w;
  }
}

}
namespace pg8 {
#define PG8_LAS __attribute__((address_space(3)))
typedef unsigned short bf16_t;
typedef short bf16x8 __attribute__((ext_vector_type(8)));
typedef float f32x4 __attribute__((ext_vector_type(4)));
typedef unsigned u32x4 __attribute__((ext_vector_type(4)));
constexpr int BM = 256, BK = 64, HALF = 128, HTB = HALF * BK * 2  , STAGE_BYTES = 8 * HTB, NXCD = 8, WGM = 8;

__host__ __device__ __forceinline__ int lds_byte(int r, int c) { const int st = (r >> 4) * 2 + (c >> 5), rr = r & 15, cc = c & 31, ob = rr * 64 + cc * 2; return st * 1024 + (ob ^ (((ob >> 9) & 1) << 5)); }
__host__ __device__ __forceinline__ void stage_rc(int b, int& R, int& C) { const int st = b / 1024, sb = b % 1024, swz = sb ^ (((sb >> 9) & 1) << 5); R = (st >> 1) * 16 + swz / 64; C = (st & 1) * 32 + (swz % 64) / 2; }
__host__ __device__ __forceinline__ int perm32(int rho) { const int n = rho >> 4, i = rho & 15; return 8 * (i >> 2) + 4 * n + (i & 3); }

struct Unit { int pm, pn; };
struct Gemm { const bf16_t* A; const bf16_t* Bt; int M, N, K; const int* gidx = nullptr; int sw = 0x7f7f7f7f, sa = 0x7f7f7f7f; };

struct StaticOrder {
    int nM, nN, nwg, G, c;
    __host__ __device__ void init(int M, int N, int G_, int c_) { nM = M / BM; nN = N / BM; nwg = nM * nN; G = G_; c = c_; }
    __host__ __device__ bool next(int i, Unit& u) const {
        const long L = (long)i * G + c; if (L >= nwg) return false;
        int wgid = (int)L; { const int q = nwg / NXCD, r = nwg % NXCD, xcd = wgid % NXCD, off = wgid / NXCD; wgid = (xcd < r ? xcd * (q + 1) : r * (q + 1) + (xcd - r) * q) + off; }
        const int nig = WGM * nN, gid = wgid / nig, fm = gid * WGM, gsz = (nM - fm) < WGM ? (nM - fm) : WGM;
        u.pm = fm + ((wgid % nig) % gsz); u.pn = (wgid % nig) / gsz; return true;
    }
    __device__ __forceinline__ void a_ready(const Unit&) const {}
    __device__ __forceinline__ void done(const Unit&) const {}
};

template <class Epi, class Sched, bool ALIGN_EPI = false, bool SP2 = false, bool FP8 = false>
__device__ __forceinline__ void gemm_phase(PG8_LAS unsigned char* lds, const Gemm g, const Sched& S, const Epi& E) {
    const int tid = ftid(), wid = __builtin_amdgcn_readfirstlane(tid >> 6), lane = tid & 63, wr = wid >> 2, wc = wid & 3, fr = lane & 15, fq = lane >> 4;
    const int KB = g.K * (FP8 ? 1 : 2), nt = KB / (BK * 2);
    unsigned voffB[2]; int pR[2], pC[2];
#pragma unroll
    for (int i = 0; i < 2; ++i) { int R, C; stage_rc(tid * 16 + i * 8192, R, C); const int Rb = Epi::PERM ? ((R & ~31) + perm32(R & 31)) : R;
        pR[i] = R; pC[i] = C; voffB[i] = (unsigned)(Rb * KB + C * 2); }
    unsigned cvo[2][2], nvo[2][2];
#define PG8_SETVO(vo, pm_) do { _Pragma("unroll") for (int _h = 0; _h < 2; ++_h) _Pragma("unroll") for (int _i = 0; _i < 2; ++_i) { const int _r = (pm_) * BM + _h * HALF + pR[_i]; \
        const int _g = g.gidx ? g.gidx[_r] : _r; vo[_h][_i] = (unsigned)_g * (unsigned)KB + (unsigned)(pC[_i] * 2); } } while (0)
#define PG8_STAGEA(bufoff, koff, vo) do { _Pragma("unroll") for (int _i = 0; _i < 2; ++_i) \
        __builtin_amdgcn_global_load_lds((const unsigned*)((const char*)g.A + (koff) + (vo)[_i]), (PG8_LAS unsigned*)(lds + (bufoff) + ldsw + _i * 8192), 16, 0, 0); } while (0)
    const size_t kstep = (size_t)(BK * 2);
    const size_t hstep = (size_t)HALF * KB;
    const size_t tstep = 2 * hstep;
    const unsigned ldsw = (unsigned)wid * 1024u;
    const int aoff = lds_byte(wr * 64 + fr, fq * 8), boff = lds_byte(wc * 32 + fr, fq * 8);
#define PG8_SA(b, h) (((b) * 2 + (h)) * HTB)
#define PG8_SB(b, h) ((4 + (b) * 2 + (h)) * HTB)
#define PG8_STAGE(bufoff, gbase, voff) do { _Pragma("unroll") for (int _i = 0; _i < 2; ++_i) \
        __builtin_amdgcn_global_load_lds((const unsigned*)((const char*)(gbase) + (voff)[_i]), (PG8_LAS unsigned*)(lds + (bufoff) + ldsw + _i * 8192), 16, 0, 0); } while (0)
    typedef int v4i_t __attribute__((ext_vector_type(4))); typedef int v8i_t __attribute__((ext_vector_type(8)));
#define PG8_CAT8(x, y) __builtin_shufflevector(__builtin_bit_cast(v4i_t, x), __builtin_bit_cast(v4i_t, y), 0, 1, 2, 3, 4, 5, 6, 7)
#define PG8_LDA(dst, b, h) do { _Pragma("unroll") for (int m = 0; m < 4; ++m) { const bf16x8 f0_ = *(const PG8_LAS bf16x8*)(lds + PG8_SA(b, h) + aoff + m * 2048), f1_ = *(const PG8_LAS bf16x8*)(lds + PG8_SA(b, h) + aoff + m * 2048 + 1024); \
        if constexpr (FP8) dst##8[m] = PG8_CAT8(f0_, f1_); else { dst[m][0] = f0_; dst[m][1] = f1_; } } } while (0)
#define PG8_LDB(dst, b, h) do { _Pragma("unroll") for (int n = 0; n < 2; ++n) { const bf16x8 f0_ = *(const PG8_LAS bf16x8*)(lds + PG8_SB(b, h) + boff + n * 2048), f1_ = *(const PG8_LAS bf16x8*)(lds + PG8_SB(b, h) + boff + n * 2048 + 1024); \
        if constexpr (FP8) dst##8[n] = PG8_CAT8(f0_, f1_); else { dst[n][0] = f0_; dst[n][1] = f1_; } } } while (0)
typedef int v4i_t __attribute__((ext_vector_type(4))); typedef int v8i_t __attribute__((ext_vector_type(8)));
#define PG8_CAT8(x, y) __builtin_shufflevector(__builtin_bit_cast(v4i_t, x), __builtin_bit_cast(v4i_t, y), 0, 1, 2, 3, 4, 5, 6, 7)
#define PG8_MMA(ai, bj, At, Bt) do { __builtin_amdgcn_s_setprio(1); _Pragma("unroll") for (int m = 0; m < 4; ++m) _Pragma("unroll") for (int n = 0; n < 2; ++n) { \
        if constexpr (FP8) asm volatile("v_mfma_scale_f32_16x16x128_f8f6f4 %0, %1, %2, %0, %3, %4 op_sel_hi:[0,0,0]" : "+v"(acc[ai][bj][m][n]) : "v"(Bt##8[n]), "v"(At##8[m]), "v"(sw_), "v"(sa_)); \
        else { _Pragma("unroll") for (int k = 0; k < 2; ++k) acc[ai][bj][m][n] = __builtin_amdgcn_mfma_f32_16x16x32_bf16(Bt[n][k], At[m][k], acc[ai][bj][m][n], 0, 0, 0); } } \
        __builtin_amdgcn_s_setprio(0); } while (0)
#define PG8_WAIT_V(n) asm volatile("s_waitcnt vmcnt(" #n ")" ::: "memory")
#define PG8_WAIT_L(n) asm volatile("s_waitcnt lgkmcnt(" #n ")" ::: "memory")
#define PG8_BAR __builtin_amdgcn_s_barrier()
#define PG8_SCHED __builtin_amdgcn_sched_barrier(0)
    Unit cur, nxt; int ui = 0;
    if (!S.next(0, cur)) return;
    f32x4 acc[2][2][4][2];
#pragma unroll
    for (int a = 0; a < 2; ++a)
#pragma unroll
        for (int b = 0; b < 2; ++b)
#pragma unroll
            for (int m = 0; m < 4; ++m)
#pragma unroll
                for (int n = 0; n < 2; ++n) acc[a][b][m][n] = (f32x4){0.f, 0.f, 0.f, 0.f};
    const int sw_ = g.sw, sa_ = g.sa;
    bf16x8 At[4][2], B0[2][2], B1[2][2]; v8i_t At8[4], B08[2], B18[2];
    PG8_SETVO(cvo, cur.pm); const char* cB = (const char*)g.Bt + (size_t)cur.pn * tstep;
    S.a_ready(cur);
    if constexpr (SP2) {
        PG8_STAGE(PG8_SB(0, 0), cB, voffB); PG8_STAGE(PG8_SB(0, 1), cB + hstep, voffB); PG8_STAGEA(PG8_SA(0, 0), 0, cvo[0]); PG8_STAGEA(PG8_SA(0, 1), 0, cvo[1]);
        if (wr == 1) PG8_BAR;
        PG8_WAIT_V(2); PG8_BAR;
        PG8_STAGE(PG8_SB(1, 0), cB + kstep, voffB); PG8_STAGEA(PG8_SA(1, 0), kstep, cvo[0]); PG8_STAGE(PG8_SB(1, 1), cB + hstep + kstep, voffB);
        PG8_WAIT_V(6); PG8_BAR;
    } else {
        PG8_STAGE(PG8_SB(0, 0), cB, voffB); PG8_STAGEA(PG8_SA(0, 0), 0, cvo[0]); PG8_STAGE(PG8_SB(0, 1), cB + hstep, voffB); PG8_STAGEA(PG8_SA(0, 1), 0, cvo[1]);
        if (wr == 1) PG8_BAR;
        PG8_WAIT_V(4); PG8_BAR;
        PG8_STAGE(PG8_SB(1, 0), cB + kstep, voffB); PG8_STAGEA(PG8_SA(1, 0), kstep, cvo[0]); PG8_STAGE(PG8_SB(1, 1), cB + hstep + kstep, voffB);
        PG8_WAIT_V(6); PG8_BAR;
    }
    for (;;) {
        const bool has_next = S.next(ui + 1, nxt);
        if (has_next) PG8_SETVO(nvo, nxt.pm); else { nvo[0][0] = cvo[0][0]; nvo[0][1] = cvo[0][1]; nvo[1][0] = cvo[1][0]; nvo[1][1] = cvo[1][1]; }
        const char* nB = has_next ? (const char*)g.Bt + (size_t)nxt.pn * tstep : cB;
#pragma unroll 1
        for (int t = 0; t < nt; t += 2) {
            const bool last = (t == nt - 2);
            const size_t k1 = (size_t)(t + 1) * kstep;
            const size_t k2 = last ? 0 : (size_t)(t + 2) * kstep; unsigned v2[2][2];
            v2[0][0] = last ? nvo[0][0] : cvo[0][0]; v2[0][1] = last ? nvo[0][1] : cvo[0][1]; v2[1][0] = last ? nvo[1][0] : cvo[1][0]; v2[1][1] = last ? nvo[1][1] : cvo[1][1];
            const char* b2 = last ? nB : cB + (size_t)(t + 2) * kstep;
            const size_t k3 = k2 + kstep; const char* b3 = b2 + kstep;
            if (last && has_next) S.a_ready(nxt);
            if constexpr (SP2) {
            PG8_LDB(B0, 0, 0); PG8_LDB(B1, 0, 1); PG8_SCHED; PG8_LDA(At, 0, 0); PG8_STAGEA(PG8_SA(1, 1), k1, cvo[1]);
            PG8_WAIT_V(8); PG8_WAIT_L(0); PG8_BAR; PG8_MMA(0, 0, At, B0); PG8_MMA(0, 1, At, B1); PG8_BAR; PG8_SCHED;
            PG8_LDA(At, 0, 1); PG8_STAGE(PG8_SB(0, 0), b2, voffB); PG8_STAGE(PG8_SB(0, 1), b2 + hstep, voffB); PG8_STAGEA(PG8_SA(0, 0), k2, v2[0]);
            PG8_WAIT_V(8); PG8_WAIT_L(0); PG8_BAR; PG8_MMA(1, 0, At, B0); PG8_MMA(1, 1, At, B1); PG8_BAR; PG8_SCHED;
            PG8_LDB(B0, 1, 0); PG8_LDB(B1, 1, 1); PG8_SCHED; PG8_LDA(At, 1, 0); PG8_STAGEA(PG8_SA(0, 1), k2, v2[1]);
            PG8_WAIT_V(8); PG8_WAIT_L(0); PG8_BAR; PG8_MMA(0, 0, At, B0); PG8_MMA(0, 1, At, B1); PG8_BAR; PG8_SCHED;
            PG8_LDA(At, 1, 1); PG8_STAGE(PG8_SB(1, 0), b3, voffB); PG8_STAGE(PG8_SB(1, 1), b3 + hstep, voffB); PG8_STAGEA(PG8_SA(1, 0), k3, v2[0]);
            PG8_WAIT_V(8); PG8_WAIT_L(0); PG8_BAR; PG8_MMA(1, 0, At, B0); PG8_MMA(1, 1, At, B1); PG8_BAR; PG8_SCHED;
            } else {
            PG8_LDB(B0, 0, 0); PG8_SCHED; PG8_LDA(At, 0, 0); PG8_STAGEA(PG8_SA(1, 1), k1, cvo[1]);
            PG8_WAIT_L(8); PG8_BAR; PG8_WAIT_L(0); PG8_MMA(0, 0, At, B0); PG8_BAR; PG8_SCHED;
            PG8_LDB(B1, 0, 1); PG8_STAGE(PG8_SB(0, 0), b2, voffB);
            PG8_BAR; PG8_WAIT_L(0); PG8_MMA(0, 1, At, B1); PG8_BAR;
            PG8_LDA(At, 0, 1); PG8_STAGEA(PG8_SA(0, 0), k2, v2[0]);
            PG8_BAR; PG8_WAIT_L(0); PG8_MMA(1, 0, At, B0); PG8_BAR; PG8_SCHED;
            PG8_STAGE(PG8_SB(0, 1), b2 + hstep, voffB);
            PG8_WAIT_V(6); PG8_BAR; PG8_MMA(1, 1, At, B1); PG8_BAR;
            PG8_LDB(B0, 1, 0); PG8_SCHED; PG8_LDA(At, 1, 0); PG8_STAGEA(PG8_SA(0, 1), k2, v2[1]);
            PG8_WAIT_L(8); PG8_BAR; PG8_WAIT_L(0); PG8_MMA(0, 0, At, B0); PG8_BAR; PG8_SCHED;
            PG8_LDB(B1, 1, 1); PG8_STAGE(PG8_SB(1, 0), b3, voffB);
            PG8_BAR; PG8_WAIT_L(0); PG8_MMA(0, 1, At, B1); PG8_BAR;
            PG8_LDA(At, 1, 1); PG8_STAGEA(PG8_SA(1, 0), k3, v2[0]);
            PG8_BAR; PG8_WAIT_L(0); PG8_MMA(1, 0, At, B0); PG8_BAR; PG8_SCHED;
            PG8_STAGE(PG8_SB(1, 1), b3 + hstep, voffB);
            PG8_WAIT_V(6); PG8_BAR; PG8_MMA(1, 1, At, B1); PG8_BAR;
            }
        }
        if constexpr (ALIGN_EPI) { if (wr == 0) PG8_BAR; }
        if constexpr (FP8) asm volatile("s_nop 15\n\ts_nop 15" ::: "memory");
        if constexpr (!Epi::AFTER_DRAIN) { E(acc, cur, wr, wc, fr, fq); S.done(cur); }
        if (!has_next) break;
#pragma unroll
        for (int a = 0; a < 2; ++a)
#pragma unroll
            for (int b = 0; b < 2; ++b)
#pragma unroll
                for (int m = 0; m < 4; ++m)
#pragma unroll
                    for (int n = 0; n < 2; ++n) acc[a][b][m][n] = (f32x4){0.f, 0.f, 0.f, 0.f};
        cur = nxt; cvo[0][0] = nvo[0][0]; cvo[0][1] = nvo[0][1]; cvo[1][0] = nvo[1][0]; cvo[1][1] = nvo[1][1]; cB = nB; ++ui;
        if constexpr (ALIGN_EPI) { if (wr == 1) PG8_BAR; }
    }
    PG8_WAIT_V(0);
    if constexpr (!ALIGN_EPI) { if (wr == 0) PG8_BAR; }
    PG8_BAR;
    if constexpr (Epi::AFTER_DRAIN) { E.fused(acc, cur, wr, wc, fr, fq, lds, wid, lane); S.done(cur); }
#undef PG8_SA
#undef PG8_SB
#undef PG8_STAGE
#undef PG8_STAGEA
#undef PG8_SETVO
#undef PG8_LDA
#undef PG8_LDB
#undef PG8_MMA
#undef PG8_CAT8
#undef PG8_WAIT_V
#undef PG8_WAIT_L
#undef PG8_BAR
#undef PG8_SCHED
}
}
#ifndef FP8_SP2
#define FP8_SP2 true
#endif
#ifndef ATTNA_FP8
#define ATTNA_FP8 1
#endif
namespace fg {
using pg8::f32x4; using pg8::Unit;
typedef unsigned u32x4 __attribute__((ext_vector_type(4)));
typedef unsigned u32x2 __attribute__((ext_vector_type(2)));
DEVI unsigned cvtpk(float lo, float hi) { typedef float f2_t __attribute__((ext_vector_type(2))); typedef __bf16 b2_t __attribute__((ext_vector_type(2))); const f2_t v = {lo, hi}; const b2_t b = __builtin_convertvector(v, b2_t); return __builtin_bit_cast(unsigned, b); }
template <class TP> DEVI void rope8(TP ROPE, int t, int d0, f32x4& v0, f32x4& v1) {
  const int i0 = d0 >> 1, f0 = i0 & 15, pos = (i0 < 16) ? (t >> 6) : (t & 63);
  const f32x4 r0 = *(const PG8_LAS f32x4*)(ROPE + (pos * 16 + f0) * 2), r1 = *(const PG8_LAS f32x4*)(ROPE + (pos * 16 + f0) * 2 + 4);
  const f32x4 a = v0, b = v1;
  v0[0] = a[0] * r0[0] - a[1] * r0[1]; v0[1] = a[0] * r0[1] + a[1] * r0[0]; v0[2] = a[2] * r0[2] - a[3] * r0[3]; v0[3] = a[2] * r0[3] + a[3] * r0[2];
  v1[0] = b[0] * r1[0] - b[1] * r1[1]; v1[1] = b[0] * r1[1] + b[1] * r1[0]; v1[2] = b[2] * r1[2] - b[3] * r1[3]; v1[3] = b[2] * r1[3] + b[3] * r1[2];
}
#define EPI_LOOP_BEGIN const int row0 = u.pm * 256 + wr * 64 + fr; \
  _Pragma("unroll") for (int ai = 0; ai < 2; ++ai) _Pragma("unroll") for (int m = 0; m < 4; ++m) { const int row = row0 + ai * 128 + m * 16; \
  _Pragma("unroll") for (int bj = 0; bj < 2; ++bj) { f32x4 v0 = acc[ai][bj][m][0], v1 = acc[ai][bj][m][1]; const int cl = bj * 128 + wc * 32 + 8 * fq;
#define EPI_LOOP_END } }

struct EpiQKV0 { static constexpr bool PERM = true, AFTER_DRAIN = false; bf16_t* O; const PG8_LAS float* ROPE; unsigned char* VT; unsigned char* VTB;
  DEVI void operator()(const f32x4 (&acc)[2][2][4][2], const Unit& u, int wr, int wc, int fr, int fq) const {
    const int colt = u.pn * 256; const bool rope = (u.pm < NLAT / 256) && (colt < 1024);
    EPI_LOOP_BEGIN
      const int col = colt + cl;
      if (ATTNA_FP8 && colt >= 1024 && colt < 1536) {
        const int hh = (col - 1024) >> 7, dv0 = (col - 1024) & 127;
        int bb, t; if (row < NLAT) { bb = row >> 12; t = row & 4095; } else { bb = (row - NLAT) >> 8; t = 4096 + ((row - NLAT) & 255); }
        const int k = t & 31, gq = k >> 3, wq = k & 7, pos = (wq < 4) ? gq * 4 + wq : 16 + gq * 4 + (wq - 4);
        unsigned char* vp = VT + (size_t)((bb * 4 + hh) * 128 + dv0) * 4352 + (t & ~31) + pos;
        const unsigned w0 = nv::pack4_fp8(v0[0] * 4.f, v0[1] * 4.f, v0[2] * 4.f, v0[3] * 4.f), w1 = nv::pack4_fp8(v1[0] * 4.f, v1[1] * 4.f, v1[2] * 4.f, v1[3] * 4.f);
        vp[0 * 4352] = (unsigned char)w0; vp[1 * 4352] = (unsigned char)(w0 >> 8); vp[2 * 4352] = (unsigned char)(w0 >> 16); vp[3 * 4352] = (unsigned char)(w0 >> 24);
        vp[4 * 4352] = (unsigned char)w1; vp[5 * 4352] = (unsigned char)(w1 >> 8); vp[6 * 4352] = (unsigned char)(w1 >> 16); vp[7 * 4352] = (unsigned char)(w1 >> 24);
        continue;
      }
      if (ATTNA_FP8 && colt >= 2560) {
        const int hh = (col - 2560) >> 6, dv0 = (col - 2560) & 63;
        int bb, t; if (row < NLAT) { bb = row >> 12; t = row & 4095; } else { bb = (row - NLAT) >> 8; t = 4096 + ((row - NLAT) & 255); }
        const int k = t & 31, gq = k >> 3, wq = k & 7, pos = (wq < 4) ? gq * 4 + wq : 16 + gq * 4 + (wq - 4);
        unsigned char* vp = VTB + (size_t)((bb * 8 + hh) * 64 + dv0) * 4352 + (t & ~31) + pos;
        const unsigned w0 = nv::pack4_fp8(v0[0] * 4.f, v0[1] * 4.f, v0[2] * 4.f, v0[3] * 4.f), w1 = nv::pack4_fp8(v1[0] * 4.f, v1[1] * 4.f, v1[2] * 4.f, v1[3] * 4.f);
        vp[0 * 4352] = (unsigned char)w0; vp[1 * 4352] = (unsigned char)(w0 >> 8); vp[2 * 4352] = (unsigned char)(w0 >> 16); vp[3 * 4352] = (unsigned char)(w0 >> 24);
        vp[4 * 4352] = (unsigned char)w1; vp[5 * 4352] = (unsigned char)(w1 >> 8); vp[6 * 4352] = (unsigned char)(w1 >> 16); vp[7 * 4352] = (unsigned char)(w1 >> 24);
        continue;
      }
      if (rope) rope8(ROPE, row & 4095, col & 63, v0, v1);
      if (ATTNA_FP8 && (colt < 1024 || colt >= 1536)) {
        const float sc = (colt < 512 || (colt >= 1536 && colt < 2048)) ? 16.f * 0.125f * 1.4426950408889634f : 4.f;
        u32x2 w8; w8.x = nv::pack4_fp8(v0[0] * sc, v0[1] * sc, v0[2] * sc, v0[3] * sc); w8.y = nv::pack4_fp8(v1[0] * sc, v1[1] * sc, v1[2] * sc, v1[3] * sc);
        *(u32x2*)((unsigned char*)O + (size_t)row * (N_IN0 * 2) + col) = w8;
        continue;
      }
      u32x4 w; w.x = cvtpk(v0[0], v0[1]); w.y = cvtpk(v0[2], v0[3]); w.z = cvtpk(v1[0], v1[1]); w.w = cvtpk(v1[2], v1[3]);
      *(u32x4*)(O + (size_t)row * N_IN0 + col) = w;
    EPI_LOOP_END
  } };
struct EpiQKV1 { static constexpr bool PERM = true, AFTER_DRAIN = false; bf16_t* O; float* DT; const PG8_LAS float* ROPE;
  DEVI void operator()(const f32x4 (&acc)[2][2][4][2], const Unit& u, int wr, int wc, int fr, int fq) const {
    const int colt = u.pn * 256; const bool lat = (u.pm < NLAT / 256);
    EPI_LOOP_BEGIN
      const int col = colt + cl;
      if (col >= 2304) { if (col < 2320) { *(f32x4*)(DT + (size_t)row * 16 + (col - 2304)) = v0; *(f32x4*)(DT + (size_t)row * 16 + (col - 2304) + 4) = v1; } }
      else {
        if (lat && col < 640) rope8(ROPE, row & 4095, col & 63, v0, v1);
        u32x4 w; w.x = cvtpk(v0[0], v0[1]); w.y = cvtpk(v0[2], v0[3]); w.z = cvtpk(v1[0], v1[1]); w.w = cvtpk(v1[2], v1[3]);
        *(u32x4*)(O + (size_t)row * 2304 + col) = w;
      }
    EPI_LOOP_END
  } };
struct EpiPlain { static constexpr bool PERM = true, AFTER_DRAIN = false; bf16_t* O;
  DEVI void operator()(const f32x4 (&acc)[2][2][4][2], const Unit& u, int wr, int wc, int fr, int fq) const {
    const int colt = u.pn * 256;
    EPI_LOOP_BEGIN
      u32x4 w; w.x = cvtpk(v0[0], v0[1]); w.y = cvtpk(v0[2], v0[3]); w.z = cvtpk(v1[0], v1[1]); w.w = cvtpk(v1[2], v1[3]);
      *(u32x4*)(O + (size_t)row * DM + colt + cl) = w;
    EPI_LOOP_END
  } };
DEVI float silu_fast(float v) { return v * __builtin_amdgcn_rcpf(1.f + __expf(-v)); }
struct EpiSwiGLU { static constexpr bool PERM = true, AFTER_DRAIN = false; bf16_t* O;
  DEVI void operator()(const f32x4 (&acc)[2][2][4][2], const Unit& u, int wr, int wc, int fr, int fq) const {
    const int colt = (u.pn & 7) * 256;
    EPI_LOOP_BEGIN
      u32x2 w; w.x = cvtpk(silu_fast(v0[0]) * v0[1], silu_fast(v0[2]) * v0[3]); w.y = cvtpk(silu_fast(v1[0]) * v1[1], silu_fast(v1[2]) * v1[3]);
      *(u32x2*)(O + (size_t)row * DM + ((colt + cl) >> 1)) = w;
    EPI_LOOP_END
  } };
struct EpiSwiGLU8 { static constexpr bool PERM = true, AFTER_DRAIN = false; unsigned char* O;
  DEVI void operator()(const f32x4 (&acc)[2][2][4][2], const Unit& u, int wr, int wc, int fr, int fq) const {
    const int colt = (u.pn & 7) * 256;
    EPI_LOOP_BEGIN
      const unsigned w = nv::pack4_fp8(silu_fast(v0[0]) * v0[1] * nv::A8_SCALE, silu_fast(v0[2]) * v0[3] * nv::A8_SCALE, silu_fast(v1[0]) * v1[1] * nv::A8_SCALE, silu_fast(v1[2]) * v1[3] * nv::A8_SCALE);
      *(unsigned*)(O + (size_t)row * DM + ((colt + cl) >> 1)) = w;
    EPI_LOOP_END
  } };
struct EpiDown { static constexpr bool PERM = true, AFTER_DRAIN = false; bf16_t* O;
  DEVI void operator()(const f32x4 (&acc)[2][2][4][2], const Unit& u, int wr, int wc, int fr, int fq) const {
    const int colt = (u.pn & 3) * 256;
    EPI_LOOP_BEGIN
      u32x4 w; w.x = cvtpk(v0[0], v0[1]); w.y = cvtpk(v0[2], v0[3]); w.z = cvtpk(v1[0], v1[1]); w.w = cvtpk(v1[2], v1[3]);
      *(u32x4*)(O + (size_t)row * DM + colt + cl) = w;
    EPI_LOOP_END
  } };
struct ExpOrder : pg8::StaticOrder { int nMe, nNe;
  __device__ void init2(int erows, int Ne, int G_, int c_) { nMe = erows / 256; nNe = Ne / 256; init(NE * erows, Ne, G_, c_); }
  __device__ bool next(int i, Unit& u) const { if (!pg8::StaticOrder::next(i, u)) return false; u.pn += (u.pm / nMe) * nNe; return true; } };

typedef PG8_LAS unsigned char* ldsp_t;
DEVI void phase_qkv0(const Params& p, ldsp_t lds) {
  pg8::Gemm g{(const bf16_t*)(p.ws + WS_H), (const bf16_t*)(p.ws + WS_WIN0), NROW, N_IN0, DM, nullptr, nv::W8_E8M0, nv::A8_E8M0}; pg8::StaticOrder S; S.init(NROW, N_IN0, gridDim.x, blockIdx.x);
  PG8_LAS float* RL = (PG8_LAS float*)(lds + pg8::STAGE_BYTES);
  for (int i = ftid(); i < 64 * 16 * 2; i += NT) RL[i] = ((const float*)(p.ws + WS_CTL + CTL_ROPE))[i];
  __syncthreads();
  EpiQKV0 E{(bf16_t*)(p.ws + WS_QKV0), RL, (unsigned char*)(p.ws + WS_VT), (unsigned char*)(p.ws + WS_VTB)};
  pg8::gemm_phase<EpiQKV0, pg8::StaticOrder, true, true, (QKV0_FP8 != 0)>(lds, g, S, E);
}
DEVI void phase_qkv1(const Params& p, ldsp_t lds) {
  pg8::Gemm g{(const bf16_t*)(p.ws + WS_H), (const bf16_t*)(p.ws + WS_WIN1), NROW, N_IN1P, DM, nullptr, nv::W8_E8M0, nv::A8_E8M0}; pg8::StaticOrder S; S.init(NROW, N_IN1P, gridDim.x, blockIdx.x);
  PG8_LAS float* RL = (PG8_LAS float*)(lds + pg8::STAGE_BYTES);
  for (int i = ftid(); i < 64 * 16 * 2; i += NT) RL[i] = ((const float*)(p.ws + WS_CTL + CTL_ROPE))[i];
  __syncthreads();
  EpiQKV1 E{(bf16_t*)(p.ws + WS_P1), (float*)(p.ws + WS_DT), RL};
  pg8::gemm_phase<EpiQKV1, pg8::StaticOrder, true, true, (QKV1_FP8 != 0)>(lds, g, S, E);
}
DEVI void phase_outproj(const Params& p, ldsp_t lds, int layer) {
  const int M = layer ? NLAT : NROW;
  pg8::Gemm g{(const bf16_t*)(p.ws + (layer ? WS_ATT1 : WS_ATT0)), (const bf16_t*)(p.ws + (layer ? WS_WOUT1 : WS_WOUT0)), M, DM, DM}; pg8::StaticOrder S; S.init(M, DM, gridDim.x, blockIdx.x);
  EpiPlain E{(bf16_t*)(p.ws + (layer ? WS_MIX1 : WS_MIX0))};
  pg8::gemm_phase<EpiPlain, pg8::StaticOrder, true, true>(lds, g, S, E);
}
DEVI void phase_moe_up(const Params& p, ldsp_t lds, int layer) {
  const int erows = layer ? EROWS1 : EROWS0;
  pg8::Gemm g{(const bf16_t*)(p.ws + WS_H), (const bf16_t*)(p.ws + WS_WGU), NE * erows, 2048, DM, (const int*)(p.ws + WS_IDX)}; ExpOrder S; S.init2(erows, 2048, gridDim.x, blockIdx.x);
  EpiSwiGLU E{(bf16_t*)(p.ws + WS_HID)};
  pg8::gemm_phase<EpiSwiGLU, ExpOrder, true, true>(lds, g, S, E);
}
DEVI void phase_moe_down(const Params& p, ldsp_t lds, int layer) {
  const int erows = layer ? EROWS1 : EROWS0;
  pg8::Gemm g{(const bf16_t*)(p.ws + WS_HID), (const bf16_t*)(p.ws + WS_WD), NE * erows, DM, DM}; ExpOrder S; S.init2(erows, DM, gridDim.x, blockIdx.x);
  EpiDown E{(bf16_t*)(p.ws + WS_Y)};
  pg8::gemm_phase<EpiDown, ExpOrder, true, true>(lds, g, S, E);
}
DEVI void phase_moe_up8(const Params& p, ldsp_t lds, int layer) {
  const int erows = layer ? EROWS1 : EROWS0;
  pg8::Gemm g{(const bf16_t*)(p.ws + WS_H), (const bf16_t*)(p.ws + WS_WGU), NE * erows, 2048, DM, (const int*)(p.ws + WS_IDX), nv::W8_E8M0, nv::A8_E8M0}; ExpOrder S; S.init2(erows, 2048, gridDim.x, blockIdx.x);
  EpiSwiGLU8 E{(unsigned char*)(p.ws + WS_HID)};
  pg8::gemm_phase<EpiSwiGLU8, ExpOrder, true, FP8_SP2, true>(lds, g, S, E);
}
DEVI void phase_moe_down8(const Params& p, ldsp_t lds, int layer) {
  const int erows = layer ? EROWS1 : EROWS0;
  pg8::Gemm g{(const bf16_t*)(p.ws + WS_HID), (const bf16_t*)(p.ws + WS_WD), NE * erows, DM, DM, nullptr, nv::W8_E8M0, nv::A8_E8M0}; ExpOrder S; S.init2(erows, DM, gridDim.x, blockIdx.x);
  EpiDown E{(bf16_t*)(p.ws + WS_Y)};
  pg8::gemm_phase<EpiDown, ExpOrder, true, FP8_SP2, true>(lds, g, S, E);
}
DEVI void phase_gather(const Params& p, int layer) {
  const int lane = ftid() & 63, gw = blockIdx.x * NWAVE + (ftid() >> 6), NGW = gridDim.x * NWAVE;
  const int erows = layer ? EROWS1 : EROWS0; const int* IDX = (const int*)(p.ws + WS_IDX);
  const bf16_t* H = (const bf16_t*)(p.ws + WS_H); bf16_t* XG = (bf16_t*)(p.ws + WS_XG);
  for (int r = gw; r < NE * erows; r += NGW) {
    const uint4* s = (const uint4*)(H + (size_t)IDX[r] * DM) + lane; uint4* d = (uint4*)(XG + (size_t)r * DM) + lane;
    const uint4 a = s[0], b = s[64]; d[0] = a; d[64] = b;
  }
}
}
#ifndef ATTNA_FP8
#define ATTNA_FP8 1
#endif
namespace fa {
#define FA_LAS __attribute__((address_space(3)))
typedef short bf16x8 __attribute__((ext_vector_type(8)));
typedef short s16x4 __attribute__((ext_vector_type(4)));
typedef float f32x16 __attribute__((ext_vector_type(16)));
typedef FA_LAS unsigned char* ldsp_t;
typedef unsigned u32x4 __attribute__((ext_vector_type(4)));
constexpr float LOG2E = 1.4426950408889634f, C2 = 0.125f * LOG2E;
DEVI int crow(int r, int hi) { return (r & 3) + 8 * (r >> 2) + 4 * hi; }
DEVI unsigned cvtpk(float lo, float hi) { typedef float f2_t __attribute__((ext_vector_type(2))); typedef __bf16 b2_t __attribute__((ext_vector_type(2))); const f2_t v = {lo, hi}; const b2_t b = __builtin_convertvector(v, b2_t); return __builtin_bit_cast(unsigned, b); }
DEVI s16x4 vtr(ldsp_t p) { return __builtin_bit_cast(s16x4, __builtin_amdgcn_ds_read_tr16_b64_v4i16((FA_LAS s16x4*)p)); }

DEVI float max3f(float a, float b, float c) { float r; asm("v_max3_f32 %0, %1, %2, %3" : "=v"(r) : "v"(a), "v"(b), "v"(c)); return r; }
template <int KW, int DVB> struct Geo {
  static constexpr int VW = DVB * 32;
  static constexpr int KSTR = KW * 2 + 16, VSTR = VW * 2 + 64;
  static constexpr int KBYTES = 64 * KSTR, VBYTES = 64 * VSTR, STAGE = KBYTES + VBYTES;
  static constexpr int CPR = (KW + VW) / 8, NCH = 64 * CPR / NT;
};

DEVI bf16x8 load_q8(const bf16_t* p, float sc) {
  const uint4 w = *(const uint4*)p; const unsigned u[4] = {w.x, w.y, w.z, w.w}; unsigned o[4];
#pragma unroll
  for (int i = 0; i < 4; ++i) o[i] = cvtpk(__uint_as_float(u[i] << 16) * sc, __uint_as_float(u[i] & 0xffff0000u) * sc);
  uint4 r = make_uint4(o[0], o[1], o[2], o[3]); return __builtin_bit_cast(bf16x8, r);
}

template <int KW, int DVB, class Src, class Act, class Msk>
DEVI void flash_pass(ldsp_t lds, int ntiles, const bf16_t* kv, int ld, int kcol, int vcol, const bf16x8 (&q)[4], int kofs,
                     Src src, Act act, Msk msk, f32x16 (&o)[DVB], float& m, float& l) {
  typedef Geo<KW, DVB> G;
  const int tid = ftid(), lane = tid & 63, r32 = lane & 31, hi = lane >> 5;
  u32x4 stg[G::NCH];
  int crw[G::NCH], ccol[G::NCH], cdst[G::NCH];
#pragma unroll
  for (int i = 0; i < G::NCH; ++i) { const int c = tid + NT * i, row = c / G::CPR, cc = c % G::CPR; crw[i] = row;
    if (cc < KW / 8) { ccol[i] = kcol + cc * 8; cdst[i] = row * G::KSTR + cc * 16; } else { ccol[i] = vcol + (cc - KW / 8) * 8; cdst[i] = G::KBYTES + row * G::VSTR + (cc - KW / 8) * 16; } }
#pragma unroll
  for (int i = 0; i < G::NCH; ++i) stg[i] = *(const u32x4*)(kv + (size_t)src(0, crw[i]) * ld + ccol[i]);
#pragma unroll
  for (int i = 0; i < G::NCH; ++i) *(FA_LAS u32x4*)(lds + cdst[i]) = stg[i];
  __syncthreads();
  const int kroff = r32 * G::KSTR + (kofs + 8 * hi) * 2;
  const int vroff = G::KBYTES + (4 * hi + ((lane & 15) >> 2)) * G::VSTR + 32 * ((lane >> 4) & 1) + 8 * (lane & 3);
  for (int kt = 0; kt < ntiles; ++kt) {
    const int buf = (kt & 1) * G::STAGE;
    const bool more = kt + 1 < ntiles;
    if (more) {
#pragma unroll
      for (int i = 0; i < G::NCH; ++i) stg[i] = *(const u32x4*)(kv + (size_t)src(kt + 1, crw[i]) * ld + ccol[i]);
    }
    if (act(kt)) {
      const ldsp_t kb = lds + buf + kroff;
      f32x16 p0, p1;
#pragma unroll
      for (int r = 0; r < 16; ++r) { p0[r] = 0.f; p1[r] = 0.f; }
#pragma unroll
      for (int d0 = 0; d0 < 4; ++d0) {
        const bf16x8 a0 = *(const FA_LAS bf16x8*)(kb + d0 * 32), a1 = *(const FA_LAS bf16x8*)(kb + 32 * G::KSTR + d0 * 32);
        p0 = __builtin_amdgcn_mfma_f32_32x32x16_bf16(a0, q[d0], p0, 0, 0, 0);
        p1 = __builtin_amdgcn_mfma_f32_32x32x16_bf16(a1, q[d0], p1, 0, 0, 0);
      }
      msk(kt, p0, p1);
      float mx = fmaxf(p0[0], p1[0]);
#pragma unroll
      for (int r = 1; r < 16; ++r) mx = fmaxf(mx, fmaxf(p0[r], p1[r]));
      mx = fmaxf(mx, __shfl_xor(mx, 32));
      if (__any(mx > m)) {
        const float mn = fmaxf(m, mx), alpha = __builtin_amdgcn_exp2f(m - mn);
        l *= alpha; m = mn;
#pragma unroll
        for (int b = 0; b < DVB; ++b)
#pragma unroll
          for (int r = 0; r < 16; ++r) o[b][r] *= alpha;
      }
      float ls = 0.f;
#pragma unroll
      for (int r = 0; r < 16; ++r) { p0[r] = __builtin_amdgcn_exp2f(p0[r] - m); p1[r] = __builtin_amdgcn_exp2f(p1[r] - m); ls += p0[r] + p1[r]; }
      l += ls;
      bf16x8 pa[4];
      { uint4 t;
        t = make_uint4(cvtpk(p0[0], p0[1]), cvtpk(p0[2], p0[3]), cvtpk(p0[4], p0[5]), cvtpk(p0[6], p0[7])); pa[0] = __builtin_bit_cast(bf16x8, t);
        t = make_uint4(cvtpk(p0[8], p0[9]), cvtpk(p0[10], p0[11]), cvtpk(p0[12], p0[13]), cvtpk(p0[14], p0[15])); pa[1] = __builtin_bit_cast(bf16x8, t);
        t = make_uint4(cvtpk(p1[0], p1[1]), cvtpk(p1[2], p1[3]), cvtpk(p1[4], p1[5]), cvtpk(p1[6], p1[7])); pa[2] = __builtin_bit_cast(bf16x8, t);
        t = make_uint4(cvtpk(p1[8], p1[9]), cvtpk(p1[10], p1[11]), cvtpk(p1[12], p1[13]), cvtpk(p1[14], p1[15])); pa[3] = __builtin_bit_cast(bf16x8, t); }
      const ldsp_t vb = lds + buf + vroff;
#pragma unroll
      for (int b = 0; b < DVB; ++b)
#pragma unroll
        for (int ks = 0; ks < 4; ++ks) {
          const s16x4 lo = vtr(vb + (16 * ks) * G::VSTR + b * 64), h8 = vtr(vb + (16 * ks + 8) * G::VSTR + b * 64);
          const bf16x8 vf = {lo[0], lo[1], lo[2], lo[3], h8[0], h8[1], h8[2], h8[3]};
          o[b] = __builtin_amdgcn_mfma_f32_32x32x16_bf16(vf, pa[ks], o[b], 0, 0, 0);
        }
    }
    if (more) {
      const int nb = ((kt + 1) & 1) * G::STAGE;
#pragma unroll
      for (int i = 0; i < G::NCH; ++i) *(FA_LAS u32x4*)(lds + nb + cdst[i]) = stg[i];
    }
    __syncthreads();
  }
}


template <int V> struct IC { static constexpr int value = V; };
template <int KW, int DVB, int ABL, int PF, class Src, class Msk>
DEVI void flash_pass2(ldsp_t lds, int ntiles, const bf16_t* kv, int ld, int kcol, int vcol, const bf16x8 (&q)[4], int kofs,
                      Src src, Msk msk, f32x16 (&o)[DVB], float& m, float& l) {
  typedef Geo<KW, DVB> G;
  const int tid = ftid(), lane = tid & 63, r32 = lane & 31, hi = lane >> 5;
  u32x4 stg[PF][G::NCH];
  int crw[G::NCH], ccol[G::NCH], cdst[G::NCH];
#pragma unroll
  for (int i = 0; i < G::NCH; ++i) { const int c = tid + NT * i, row = c / G::CPR, cc = c % G::CPR; crw[i] = row;
    if (cc < KW / 8) { ccol[i] = kcol + cc * 8; cdst[i] = row * G::KSTR + cc * 16; } else { ccol[i] = vcol + (cc - KW / 8) * 8; cdst[i] = G::KBYTES + row * G::VSTR + (cc - KW / 8) * 16; } }
#define FP2_LOAD(kt, set) _Pragma("unroll") for (int i = 0; i < G::NCH; ++i) stg[set][i] = *(const u32x4*)(kv + (size_t)src((kt), crw[i]) * ld + ccol[i])
#define FP2_STORE(st, set) _Pragma("unroll") for (int i = 0; i < G::NCH; ++i) *(FA_LAS u32x4*)(lds + (st) * G::STAGE + cdst[i]) = stg[set][i]
  FP2_LOAD(0, 0); FP2_STORE(0, 0);
  if (ntiles > 1) { FP2_LOAD(1, 0); FP2_STORE(1, 0); }
  __syncthreads();
  if (ntiles > 2) FP2_LOAD(2, 0);
  if (PF == 2) { if (ntiles > 3) FP2_LOAD(3, PF - 1); }
  const int kroff = r32 * G::KSTR + (kofs + 8 * hi) * 2;
  const int vroff = G::KBYTES + (4 * hi + ((lane & 15) >> 2)) * G::VSTR + 32 * ((lane >> 4) & 1) + 8 * (lane & 3);
  f32x16 c0, c1;
#pragma unroll
  for (int r = 0; r < 16; ++r) { c0[r] = 0.f; c1[r] = 0.f; }
  { const ldsp_t kb = lds + kroff;
#pragma unroll
    for (int d0 = 0; d0 < 4; ++d0) {
      const bf16x8 a0 = *(const FA_LAS bf16x8*)(kb + d0 * 32), a1 = *(const FA_LAS bf16x8*)(kb + 32 * G::KSTR + d0 * 32);
      c0 = __builtin_amdgcn_mfma_f32_32x32x16_bf16(a0, q[d0], c0, 0, 0, 0); c1 = __builtin_amdgcn_mfma_f32_32x32x16_bf16(a1, q[d0], c1, 0, 0, 0); } }
  asm volatile("s_nop 15\n\ts_nop 7" : "+v"(c0), "+v"(c1));
  int st_cur = 0, st_nxt = 1, st_fill = 2;
  auto body = [&](int kt, auto PARC) {
    constexpr int set = (PF == 2) ? decltype(PARC)::value : 0;
    msk(kt, c0, c1);
    __builtin_amdgcn_sched_barrier(0);
    f32x16 n0, n1;
#pragma unroll
    for (int r = 0; r < 16; ++r) { n0[r] = 0.f; n1[r] = 0.f; }
    const ldsp_t kb = lds + st_nxt * G::STAGE + kroff;
    bf16x8 ka[4], kb2[4];
#pragma unroll
    for (int d0 = 0; d0 < 4; ++d0) { ka[d0] = *(const FA_LAS bf16x8*)(kb + d0 * 32); kb2[d0] = *(const FA_LAS bf16x8*)(kb + 32 * G::KSTR + d0 * 32); }
#define FP2_SB() __builtin_amdgcn_sched_barrier(0)
#define FP2_MMA(acc, kf, d0) acc = __builtin_amdgcn_mfma_f32_32x32x16_bf16(kf[d0], q[d0], acc, 0, 0, 0)
#define FP2_EXP(cx, r) { if (ABL != 1) { cx[r] = __builtin_amdgcn_exp2f(cx[r] - mn); ls += cx[r]; } }
    FP2_SB(); FP2_MMA(n0, ka, 0);
    float mxa = max3f(c0[0], c0[1], c1[0]), mxb = max3f(c0[2], c0[3], c1[1]);
    mxa = max3f(mxa, c1[2], c1[3]);
    mxa = max3f(mxa, c0[4], c0[5]); mxb = max3f(mxb, c0[6], c0[7]); mxa = max3f(mxa, c1[4], c1[5]); mxb = max3f(mxb, c1[6], c1[7]);
    FP2_SB(); FP2_MMA(n1, kb2, 0);
    mxa = max3f(mxa, c0[8], c0[9]); mxb = max3f(mxb, c0[10], c0[11]); mxa = max3f(mxa, c1[8], c1[9]); mxb = max3f(mxb, c1[10], c1[11]);
    mxa = max3f(mxa, c0[12], c0[13]); mxb = max3f(mxb, c0[14], c0[15]); mxa = max3f(mxa, c1[12], c1[13]); mxb = max3f(mxb, c1[14], c1[15]);
    float mx = max3f(mxa, mxb, m);
    mx = max3f(mx, __shfl_xor(mx, 32), mx);
    const float mn = mx, alpha = __builtin_amdgcn_exp2f(m - mn);
    const bool resc = __any(mn > m);
    m = mn;
    float ls = 0.f;
    FP2_SB(); FP2_MMA(n0, ka, 1);
    FP2_EXP(c0, 0) FP2_EXP(c0, 1) FP2_EXP(c0, 2) FP2_EXP(c0, 3) FP2_EXP(c0, 4) FP2_EXP(c0, 5)
    FP2_SB(); FP2_MMA(n1, kb2, 1);
    FP2_EXP(c0, 6) FP2_EXP(c0, 7) FP2_EXP(c0, 8) FP2_EXP(c0, 9) FP2_EXP(c0, 10) FP2_EXP(c0, 11)
    FP2_SB(); FP2_MMA(n0, ka, 2);
    FP2_EXP(c0, 12) FP2_EXP(c0, 13) FP2_EXP(c0, 14) FP2_EXP(c0, 15) FP2_EXP(c1, 0) FP2_EXP(c1, 1)
    FP2_SB(); FP2_MMA(n1, kb2, 2);
    FP2_EXP(c1, 2) FP2_EXP(c1, 3) FP2_EXP(c1, 4) FP2_EXP(c1, 5) FP2_EXP(c1, 6) FP2_EXP(c1, 7)
    FP2_SB(); FP2_MMA(n0, ka, 3);
    FP2_EXP(c1, 8) FP2_EXP(c1, 9) FP2_EXP(c1, 10) FP2_EXP(c1, 11) FP2_EXP(c1, 12) FP2_EXP(c1, 13)
    FP2_SB(); FP2_MMA(n1, kb2, 3);
    FP2_EXP(c1, 14) FP2_EXP(c1, 15)
    bf16x8 pa[4];
    { u32x4 t;
      t[0] = cvtpk(c0[0], c0[1]); t[1] = cvtpk(c0[2], c0[3]); t[2] = cvtpk(c0[4], c0[5]); t[3] = cvtpk(c0[6], c0[7]); pa[0] = __builtin_bit_cast(bf16x8, t);
      t[0] = cvtpk(c0[8], c0[9]); t[1] = cvtpk(c0[10], c0[11]); t[2] = cvtpk(c0[12], c0[13]); t[3] = cvtpk(c0[14], c0[15]); pa[1] = __builtin_bit_cast(bf16x8, t);
      t[0] = cvtpk(c1[0], c1[1]); t[1] = cvtpk(c1[2], c1[3]); t[2] = cvtpk(c1[4], c1[5]); t[3] = cvtpk(c1[6], c1[7]); pa[2] = __builtin_bit_cast(bf16x8, t);
      t[0] = cvtpk(c1[8], c1[9]); t[1] = cvtpk(c1[10], c1[11]); t[2] = cvtpk(c1[12], c1[13]); t[3] = cvtpk(c1[14], c1[15]); pa[3] = __builtin_bit_cast(bf16x8, t); }
    asm volatile("" : "+v"(pa[0]), "+v"(pa[1]), "+v"(pa[2]), "+v"(pa[3]));
    FP2_SB();
    l = l * alpha + ls;
    __builtin_amdgcn_sched_barrier(0);
    if (resc) {
#pragma unroll
      for (int b = 0; b < DVB; ++b)
#pragma unroll
        for (int r = 0; r < 16; ++r) o[b][r] *= alpha;
    }
    const ldsp_t vb = lds + st_cur * G::STAGE + vroff;
    s16x4 vl[2][DVB], vh[2][DVB];
#pragma unroll
    for (int b = 0; b < DVB; ++b) { vl[0][b] = vtr(vb + b * 64); vh[0][b] = vtr(vb + 8 * G::VSTR + b * 64); }
#pragma unroll
    for (int ks = 0; ks < 4; ++ks) {
      FP2_SB();
      if (ks < 3) {
#pragma unroll
        for (int b = 0; b < DVB; ++b) { vl[(ks + 1) & 1][b] = vtr(vb + (16 * (ks + 1)) * G::VSTR + b * 64); vh[(ks + 1) & 1][b] = vtr(vb + (16 * (ks + 1) + 8) * G::VSTR + b * 64); }
      }
      FP2_SB();
#pragma unroll
      for (int b = 0; b < DVB; ++b) {
        const s16x4 lo = vl[ks & 1][b], h8 = vh[ks & 1][b];
        const bf16x8 vf = {lo[0], lo[1], lo[2], lo[3], h8[0], h8[1], h8[2], h8[3]};
        if (ABL != 2) o[b] = __builtin_amdgcn_mfma_f32_32x32x16_bf16(vf, pa[ks], o[b], 0, 0, 0); else o[b][0] += __builtin_bit_cast(float, (int)vf[0]);
      }
    }
    FP2_SB();
    if (ABL != 3) { if (kt + 2 < ntiles) FP2_STORE(st_fill, set); }
    __syncthreads();
    if (ABL != 3) { if (kt + 2 + PF < ntiles) FP2_LOAD(kt + 2 + PF, set); }
    c0 = n0; c1 = n1;
    { const int t = st_cur; st_cur = st_nxt; st_nxt = st_fill; st_fill = t; }
  };
  if (PF == 2) { for (int kt = 0; kt < ntiles; kt += 2) { body(kt, IC<0>{}); if (kt + 1 < ntiles) body(kt + 1, IC<1>{}); } }
  else { for (int kt = 0; kt < ntiles; ++kt) body(kt, IC<0>{}); }
#undef FP2_LOAD
#undef FP2_STORE
}


typedef int v8i_t __attribute__((ext_vector_type(8)));
DEVI v8i_t cat8(const u32x4& x, const u32x4& y) { return (v8i_t){(int)x[0], (int)x[1], (int)x[2], (int)x[3], (int)y[0], (int)y[1], (int)y[2], (int)y[3]}; }
template <int DVB, int KROW, bool PIPE, class Src, class VKey, class Msk>
DEVI void flash_pass8(ldsp_t lds, int ntiles, const unsigned char* k8, int ldb, int kcolb, const unsigned char* vt, const v8i_t& qf, int ksub,
                      Src src, VKey vkey, Msk msk, f32x16 (&o)[DVB], float& m, float& l) {
  constexpr int A8_KSTR = KROW + 16, A8_VSTR = 80, A8_KB = 64 * A8_KSTR, A8_STAGE = A8_KB + DVB * 32 * A8_VSTR;
  constexpr int KPR = KROW / 16, NKC = 64 * KPR, NCHT = (NKC + DVB * 32 * 4) / NT;
  const int tid = ftid(), lane = tid & 63, r32 = lane & 31, hi = lane >> 5;
  u32x4 stg[NCHT];
#define A8_LOAD(kt) do { _Pragma("unroll") for (int i_ = 0; i_ < NCHT; ++i_) { const int c_ = tid + NT * i_; \
      if (c_ < NKC) stg[i_] = *(const u32x4*)(k8 + (size_t)src((kt), c_ / KPR) * ldb + kcolb + (c_ % KPR) * 16); \
      else { const int cv_ = c_ - NKC; stg[i_] = *(const u32x4*)(vt + (size_t)(cv_ >> 2) * 4352 + vkey(kt) + (cv_ & 3) * 16); } } } while (0)
#define A8_STORE(st) do { _Pragma("unroll") for (int i_ = 0; i_ < NCHT; ++i_) { const int c_ = tid + NT * i_; \
      if (c_ < NKC) *(FA_LAS u32x4*)(lds + (st) * A8_STAGE + (c_ / KPR) * A8_KSTR + (c_ % KPR) * 16) = stg[i_]; \
      else { const int cv_ = c_ - NKC; *(FA_LAS u32x4*)(lds + (st) * A8_STAGE + A8_KB + (cv_ >> 2) * A8_VSTR + (cv_ & 3) * 16) = stg[i_]; } } } while (0)
#define A8_QK(dst, st, half) do { const ldsp_t kp_ = lds + (st) * A8_STAGE + kroff + (half) * 32 * A8_KSTR; f32x16 z_; _Pragma("unroll") for (int r_ = 0; r_ < 16; ++r_) z_[r_] = 0.f; \
    const u32x4 k0_ = *(const FA_LAS u32x4*)kp_, k1_ = *(const FA_LAS u32x4*)(kp_ + 16); \
    dst = __builtin_amdgcn_mfma_scale_f32_32x32x64_f8f6f4(cat8(k0_, k1_), qf, z_, 0, 0, 0, 0x7d7d7d7d  , 0, 0x7b7b7b7b  ); } while (0)
  A8_LOAD(0); A8_STORE(0);
  if (ntiles > 1) { A8_LOAD(1); A8_STORE(1); }
  __syncthreads();
  if (ntiles > 2) A8_LOAD(2);
  const int kroff = r32 * A8_KSTR + 64 * ksub + 32 * hi;
  const int vroff = A8_KB + r32 * A8_VSTR + 32 * hi;
  f32x16 c0, c1;
  if (PIPE) { A8_QK(c0, 0, 0); A8_QK(c1, 0, 1);
    asm volatile("s_nop 15\n\ts_nop 7" : "+v"(c0), "+v"(c1)); }
  int st_cur = 0, st_nxt = 1, st_fill = 2;
  for (int kt = 0; kt < ntiles; ++kt) {
    if (!PIPE) { A8_QK(c0, st_cur, 0); A8_QK(c1, st_cur, 1); asm volatile("s_nop 15\n\ts_nop 7" : "+v"(c0), "+v"(c1)); }
    msk(kt, c0, c1);
    __builtin_amdgcn_sched_barrier(0);
    f32x16 n0, n1;
#define A8_SB() __builtin_amdgcn_sched_barrier(0)
#define A8_EXP(cx, r) { cx[r] = __builtin_amdgcn_exp2f(cx[r] - mn); ls += cx[r]; }
    A8_SB(); if (PIPE) A8_QK(n0, st_nxt, 0);
    float mxa = max3f(c0[0], c0[1], c1[0]), mxb = max3f(c0[2], c0[3], c1[1]);
    mxa = max3f(mxa, c1[2], c1[3]);
    mxa = max3f(mxa, c0[4], c0[5]); mxb = max3f(mxb, c0[6], c0[7]); mxa = max3f(mxa, c1[4], c1[5]); mxb = max3f(mxb, c1[6], c1[7]);
    A8_SB(); if (PIPE) A8_QK(n1, st_nxt, 1);
    mxa = max3f(mxa, c0[8], c0[9]); mxb = max3f(mxb, c0[10], c0[11]); mxa = max3f(mxa, c1[8], c1[9]); mxb = max3f(mxb, c1[10], c1[11]);
    mxa = max3f(mxa, c0[12], c0[13]); mxb = max3f(mxb, c0[14], c0[15]); mxa = max3f(mxa, c1[12], c1[13]); mxb = max3f(mxb, c1[14], c1[15]);
    float mx = max3f(mxa, mxb, m);
    mx = max3f(mx, __shfl_xor(mx, 32), mx);
    const float mn = mx, alpha = __builtin_amdgcn_exp2f(m - mn);
    const bool resc = __any(mn > m);
    m = mn;
    float ls = 0.f;
    A8_SB();
#pragma unroll
    for (int r = 0; r < 16; ++r) A8_EXP(c0, r)
#pragma unroll
    for (int r = 0; r < 16; ++r) A8_EXP(c1, r)
    unsigned X[4], Y[4];
#pragma unroll
    for (int i = 0; i < 4; ++i) {
      int w = 0; w = __builtin_amdgcn_cvt_pk_fp8_f32(c0[4 * i] * 16.f, c0[4 * i + 1] * 16.f, w, false); w = __builtin_amdgcn_cvt_pk_fp8_f32(c0[4 * i + 2] * 16.f, c0[4 * i + 3] * 16.f, w, true); X[i] = (unsigned)w;
      int z = 0; z = __builtin_amdgcn_cvt_pk_fp8_f32(c1[4 * i] * 16.f, c1[4 * i + 1] * 16.f, z, false); z = __builtin_amdgcn_cvt_pk_fp8_f32(c1[4 * i + 2] * 16.f, c1[4 * i + 3] * 16.f, z, true); Y[i] = (unsigned)z; }
#pragma unroll
    for (int i = 0; i < 4; ++i) { const auto rr = __builtin_amdgcn_permlane32_swap(X[i], Y[i], false, false); X[i] = rr[0]; Y[i] = rr[1]; }
    v8i_t pb = {(int)X[0], (int)X[1], (int)X[2], (int)X[3], (int)Y[0], (int)Y[1], (int)Y[2], (int)Y[3]};
    asm volatile("" : "+v"(pb));
    A8_SB();
    l = l * alpha + ls;
    __builtin_amdgcn_sched_barrier(0);
    if (resc) {
#pragma unroll
      for (int b = 0; b < DVB; ++b)
#pragma unroll
        for (int r = 0; r < 16; ++r) o[b][r] *= alpha;
    }
    { const ldsp_t vb = lds + st_cur * A8_STAGE + vroff;
      u32x4 v0[DVB], v1[DVB];
#pragma unroll
      for (int b = 0; b < DVB; ++b) { v0[b] = *(const FA_LAS u32x4*)(vb + b * 32 * A8_VSTR); v1[b] = *(const FA_LAS u32x4*)(vb + b * 32 * A8_VSTR + 16); }
#pragma unroll
      for (int b = 0; b < DVB; ++b) o[b] = __builtin_amdgcn_mfma_scale_f32_32x32x64_f8f6f4(cat8(v0[b], v1[b]), pb, o[b], 0, 0, 0, 0x7d7d7d7d  , 0, 0x7b7b7b7b  );
    }
    A8_SB();
    if (kt + 2 < ntiles) A8_STORE(st_fill);
    __syncthreads();
    if (kt + 3 < ntiles) A8_LOAD(kt + 3);
    if (PIPE) { c0 = n0; c1 = n1; }
    { const int t = st_cur; st_cur = st_nxt; st_nxt = st_fill; st_fill = t; }
  }
#undef A8_LOAD
#undef A8_STORE
#undef A8_QK
#undef A8_SB
#undef A8_EXP
}

DEVI int vblock() { const int G = gridDim.x, bx = blockIdx.x; return (G % 8 == 0) ? (bx % 8) * (G / 8) + bx / 8 : bx; }

template <int ABL = 0> DEVI void phase_attnA(const Params& p, ldsp_t lds) {
  typedef Geo<128, 4> G;
  const int tid = ftid(), lane = tid & 63, wave = __builtin_amdgcn_readfirstlane(tid >> 6), r32 = lane & 31, hi = lane >> 5;
  const bf16_t* Q = (const bf16_t*)(p.ws + WS_QKV0); bf16_t* ATT = (bf16_t*)(p.ws + (ABL ? WS_MIX0 : WS_ATT0));
  const float lam = ((const float*)(p.ws + WS_CTL + CTL_LAM))[0];
  const int s = wave >> 2, qb = wave & 3;
  constexpr int NU_LAT = NB * 4 * 32, NU_CTX = NB * 4 * 2;
  for (int u = vblock(); u < NU_LAT + NU_CTX; u += gridDim.x) {
    int b, h, row0, ntiles; bool lat = u < NU_LAT;
    if (lat) { b = u >> 7; h = (u >> 5) & 3; row0 = b * SEQ + (u & 31) * 128; ntiles = 68; }
    else { const int v = u - NU_LAT; b = v >> 3; h = (v >> 1) & 3; row0 = NLAT + b * CTXL + (v & 1) * 128; ntiles = 4; }
    const int qrow = row0 + qb * 32 + r32;
    bf16x8 q[4];
#pragma unroll
    for (int d0 = 0; d0 < 4; ++d0) q[d0] = load_q8(Q + (size_t)qrow * N_IN0 + h * 128 + s * 64 + 16 * d0 + 8 * hi, C2);
    f32x16 o[4];
#pragma unroll
    for (int bk = 0; bk < 4; ++bk)
#pragma unroll
      for (int r = 0; r < 16; ++r) o[bk][r] = 0.f;
    float m = -1e30f, l = 0.f;
    const int cbase = NLAT + b * CTXL, lbase = b * SEQ;
#if ATTNA_FP8
    const unsigned char* QK8 = (const unsigned char*)(p.ws + WS_QKV0);
    v8i_t qf;
    { const unsigned char* qp = QK8 + (size_t)qrow * (N_IN0 * 2) + h * 128 + s * 64 + 32 * hi; const u32x4 q0_ = *(const u32x4*)qp, q1_ = *(const u32x4*)(qp + 16); qf = cat8(q0_, q1_); }
    flash_pass8<4, 128, true>(lds, ntiles, QK8, N_IN0 * 2, 512 + h * 128, (const unsigned char*)(p.ws + WS_VT) + (size_t)((b * 4 + h) * 128) * 4352, qf, s,
      [&](int kt, int i) { return lat ? (kt < 64 ? lbase + kt * 64 + i : cbase + (kt - 64) * 64 + i) : cbase + kt * 64 + i; },
      [&](int kt) { return (lat ? 0 : 4096) + kt * 64; }, [&](int, f32x16&, f32x16&) {}, o, m, l);
#else
    flash_pass2<128, 4, ABL, 1>(lds, ntiles, Q, N_IN0, 512 + h * 128, 1024 + h * 128, q, s * 64,
      [&](int kt, int i) { return lat ? (kt < 64 ? lbase + kt * 64 + i : cbase + (kt - 64) * 64 + i) : cbase + kt * 64 + i; },
      [&](int, f32x16&, f32x16&) {}, o, m, l);
#endif
    l += __shfl_xor(l, 32);
    const float inv = 1.f / l;
    FA_LAS float* X = (FA_LAS float*)lds;
    if (s == 1) {
#pragma unroll
      for (int bk = 0; bk < 4; ++bk)
#pragma unroll
        for (int r = 0; r < 16; ++r) X[((qb * 4 + bk) * 16 + r) * 64 + lane] = o[bk][r] * inv;
    }
    __syncthreads();
    if (s == 0) {
      float ss = 0.f;
#pragma unroll
      for (int bk = 0; bk < 4; ++bk)
#pragma unroll
        for (int r = 0; r < 16; ++r) { const float d = o[bk][r] * inv - lam * X[((qb * 4 + bk) * 16 + r) * 64 + lane]; o[bk][r] = d; ss += d * d; }
      ss += __shfl_xor(ss, 32);
      const float rr = rsqrtf(ss * (1.f / 128.f) + EPS) * 0.8f;
      const float* g = p.in[L0_SUBLN];
      bf16_t* orow = ATT + (size_t)qrow * DM + h * 128;
#pragma unroll
      for (int bk = 0; bk < 4; ++bk)
#pragma unroll
        for (int rg = 0; rg < 4; ++rg) { const int dv = bk * 32 + 8 * rg + 4 * hi; const float4 gv = *(const float4*)(g + dv);
          uint2 w; w.x = cvtpk(o[bk][4 * rg] * rr * gv.x, o[bk][4 * rg + 1] * rr * gv.y); w.y = cvtpk(o[bk][4 * rg + 2] * rr * gv.z, o[bk][4 * rg + 3] * rr * gv.w);
          *(uint2*)(orow + dv) = w; }
    }
    __syncthreads();
  }
}

template <int ABL = 0> DEVI void phase_attnB(const Params& p, ldsp_t lds) {
  typedef Geo<64, 2> G;
  const int tid = ftid(), lane = tid & 63, wave = __builtin_amdgcn_readfirstlane(tid >> 6), r32 = lane & 31, hi = lane >> 5;
  const bf16_t* Q = (const bf16_t*)(p.ws + WS_QKV0); bf16_t* ATT = (bf16_t*)(p.ws + (ABL ? WS_MIX0 : WS_ATT0));
  constexpr int NU_LAT = NB * 8 * 16, NU_CTX = NB * 8;
  FA_LAS float* RPB = (FA_LAS float*)(lds + 3 * (64 * 80 + 64 * 80));
  for (int u = vblock(); u < NU_LAT + NU_CTX; u += gridDim.x) {
    const bool lat = u < NU_LAT;
    int b, h, qrow_g = 0, c0 = 0, rlo = 0, nlat = 0, rs_w = 0, grow;
    if (lat) { b = u >> 7; h = (u >> 4) & 7; const int qr0 = (u & 15) * 4; qrow_g = qr0 + (wave >> 1); c0 = 32 * (wave & 1);
      rlo = min(max(qr0 - 4, 0), 56); const int rhi = min(max(qr0 - 1, 0), 56) + 7; nlat = rhi - rlo + 1; rs_w = min(max(qrow_g - 4, 0), 56);
      grow = b * SEQ + qrow_g * 64 + c0 + r32; }
    else { const int v = u - NU_LAT; b = v >> 3; h = v & 7; grow = NLAT + b * CTXL + wave * 32 + r32; }
    const int ntiles = nlat + 4;
    for (int i = tid; i < 15 * 31; i += NT) RPB[i] = p.in[L0_RPB][h * 465 + i] * LOG2E;
    const unsigned char* QK8 = (const unsigned char*)(p.ws + WS_QKV0);
    v8i_t qf;
    { const unsigned char* qp = QK8 + (size_t)grow * (N_IN0 * 2) + 1536 + h * 64 + 32 * hi; const u32x4 q0_ = *(const u32x4*)qp, q1_ = *(const u32x4*)(qp + 16); qf = cat8(q0_, q1_); }
    f32x16 o[2];
#pragma unroll
    for (int bk = 0; bk < 2; ++bk)
#pragma unroll
      for (int r = 0; r < 16; ++r) o[bk][r] = 0.f;
    float m = -1e30f, l = 0.f;
    const int cbase = NLAT + b * CTXL, lbase = b * SEQ;
    const int qc = c0 + r32, cs = min(max(qc - 8, 0), 48);
    flash_pass8<2, 64, false>(lds, ntiles, QK8, N_IN0 * 2, 2048 + h * 64, (const unsigned char*)(p.ws + WS_VTB) + (size_t)((b * 8 + h) * 64) * 4352, qf, 0,
      [&](int kt, int i) { return kt < nlat ? lbase + (rlo + kt) * 64 + i : cbase + (kt - nlat) * 64 + i; },
      [&](int kt) { return kt < nlat ? (rlo + kt) * 64 : 4096 + (kt - nlat) * 64; },
      [&](int kt, f32x16& p0, f32x16& p1) {
        if (ABL != 1 && kt < nlat) { const int kr = rlo + kt; const bool rowok = (kr >= rs_w && kr < rs_w + 8);
          const FA_LAS float* bp = RPB + min(max(kr - qrow_g + 7, 0), 14) * 31;
          { float b0[16];
#pragma unroll
            for (int r = 0; r < 16; ++r) { const int k0 = crow(r, hi); b0[r] = bp[min(max(k0 - qc + 15, 0), 30)]; }
#pragma unroll
            for (int r = 0; r < 16; ++r) { const int k0 = crow(r, hi); const float v0 = p0[r] + b0[r]; p0[r] = (rowok && k0 >= cs && k0 < cs + 16) ? v0 : -INFINITY; } }
          asm volatile("" ::: "memory");
          { float b1[16];
#pragma unroll
            for (int r = 0; r < 16; ++r) { const int k1 = 32 + crow(r, hi); b1[r] = bp[min(max(k1 - qc + 15, 0), 30)]; }
#pragma unroll
            for (int r = 0; r < 16; ++r) { const int k1 = 32 + crow(r, hi); const float v1 = p1[r] + b1[r]; p1[r] = (rowok && k1 >= cs && k1 < cs + 16) ? v1 : -INFINITY; } } } },
      o, m, l);
    l += __shfl_xor(l, 32);
    const float inv = 1.f / l;
    bf16_t* orow = ATT + (size_t)grow * DM + 512 + h * 64;
#pragma unroll
    for (int bk = 0; bk < 2; ++bk)
#pragma unroll
      for (int rg = 0; rg < 4; ++rg) { const int dv = bk * 32 + 8 * rg + 4 * hi;
        uint2 w; w.x = cvtpk(o[bk][4 * rg] * inv, o[bk][4 * rg + 1] * inv); w.y = cvtpk(o[bk][4 * rg + 2] * inv, o[bk][4 * rg + 3] * inv);
        *(uint2*)(orow + dv) = w; }
    __syncthreads();
  }
}

DEVI void phase_attnC(const Params& p, ldsp_t lds, int* ctr) {
  const int tid = ftid(), lane = tid & 63, wave = __builtin_amdgcn_readfirstlane(tid >> 6), r32 = lane & 31, hi = lane >> 5;
  const bf16_t* P1 = (const bf16_t*)(p.ws + WS_P1); bf16_t* ATT = (bf16_t*)(p.ws + WS_ATT1);
  FA_LAS int* uq = (FA_LAS int*)(lds + 3 * Geo<64, 2>::STAGE + 64);
  for (;;) {
    if (tid == 0) *uq = atomicAdd(ctr, 1);
    __syncthreads();
    const int u = *uq;
    __syncthreads();
    if (u >= NB * 2 * 64) break;
    const int b = u >> 7, g = (u >> 6) & 1, tq = u & 63, hq = g * 4 + (wave >> 1), t = tq * 64 + 32 * (wave & 1) + r32, grow = b * SEQ + t;
    const int klo = max(tq - 2, 0), khi = min(tq + 2, 63), nwin = khi - klo + 1, ntiles = nwin + 4;
    bf16x8 q[4];
#pragma unroll
    for (int d0 = 0; d0 < 4; ++d0) q[d0] = load_q8(P1 + (size_t)grow * 2304 + hq * 64 + 16 * d0 + 8 * hi, C2);
    f32x16 o[2];
#pragma unroll
    for (int bk = 0; bk < 2; ++bk)
#pragma unroll
      for (int r = 0; r < 16; ++r) o[bk][r] = 0.f;
    float m = -1e30f, l = 0.f;
    const int cbase = NLAT + b * CTXL, lbase = b * SEQ;
    flash_pass2<64, 2, 0, 2>(lds, ntiles, P1, 2304, 512 + g * 64, 640 + g * 64, q, 0,
      [&](int kt, int i) { return kt < nwin ? lbase + (klo + kt) * 64 + i : cbase + (kt - nwin) * 64 + i; },
      [&](int kt, f32x16& p0, f32x16& p1) {
        if (kt < nwin) { const int kp = (klo + kt) * 64 - t;
#pragma unroll
          for (int r = 0; r < 16; ++r) { const int d0 = kp + crow(r, hi), d1 = d0 + 32;
            if (d0 < -128 || d0 > 128) p0[r] = -INFINITY; if (d1 < -128 || d1 > 128) p1[r] = -INFINITY; } } },
      o, m, l);
    l += __shfl_xor(l, 32);
    { const float sk = p.in[L1_SINKS][hq] * LOG2E, mn = fmaxf(m, sk), alpha = __builtin_amdgcn_exp2f(m - mn);
      l = l * alpha + __builtin_amdgcn_exp2f(sk - mn);
#pragma unroll
      for (int bk = 0; bk < 2; ++bk)
#pragma unroll
        for (int r = 0; r < 16; ++r) o[bk][r] *= alpha; }
    const float inv = 1.f / l;
    bf16_t* orow = ATT + (size_t)grow * DM + hq * 64;
#pragma unroll
    for (int bk = 0; bk < 2; ++bk)
#pragma unroll
      for (int rg = 0; rg < 4; ++rg) { const int dv = bk * 32 + 8 * rg + 4 * hi;
        uint2 w; w.x = cvtpk(o[bk][4 * rg] * inv, o[bk][4 * rg + 1] * inv); w.y = cvtpk(o[bk][4 * rg + 2] * inv, o[bk][4 * rg + 3] * inv);
        *(uint2*)(orow + dv) = w; }
    __syncthreads();
  }
}
}
namespace fs {
using fa::bf16x8; using fa::s16x4; using fa::f32x16; using fa::ldsp_t; using fa::u32x4; using fa::cvtpk; using fa::vtr; using fa::crow; using fa::LOG2E;
typedef unsigned u32x2 __attribute__((ext_vector_type(2)));

DEVI void phase_conv(const Params& p) {
  const bf16_t* P1 = (const bf16_t*)(p.ws + WS_P1); bf16_t* U = (bf16_t*)(p.ws + WS_U);
  const float* cw = p.in[L1_CONVW]; const float* cb = p.in[L1_CONVB];
  const int nitems = (NROW / 16) * 128;
  for (int it = blockIdx.x * NT + ftid(); it < nitems; it += gridDim.x * NT) {
    const int cg = it & 127, rc = it >> 7, r0 = rc * 16, ch = cg * 8;
    int s0, len; if (r0 < NLAT) { s0 = r0 & ~4095; len = SEQ; } else { s0 = NLAT + ((r0 - NLAT) & ~255); len = CTXL; }
    const int t0 = r0 - s0;
    float w[5][8], bias[8];
#pragma unroll
    for (int j = 0; j < 5; ++j) { const float4 a = *(const float4*)(cw + j * 1024 + ch), b = *(const float4*)(cw + j * 1024 + ch + 4);
      w[j][0] = a.x; w[j][1] = a.y; w[j][2] = a.z; w[j][3] = a.w; w[j][4] = b.x; w[j][5] = b.y; w[j][6] = b.z; w[j][7] = b.w; }
    { const float4 a = *(const float4*)(cb + ch), b = *(const float4*)(cb + ch + 4); bias[0] = a.x; bias[1] = a.y; bias[2] = a.z; bias[3] = a.w; bias[4] = b.x; bias[5] = b.y; bias[6] = b.z; bias[7] = b.w; }
    float win[5][8];
    auto ldrow = [&](int t, float (&d)[8]) {
      if (t < 0 || t >= len) {
#pragma unroll
        for (int k = 0; k < 8; ++k) d[k] = 0.f; return; }
      const u32x4 v = *(const u32x4*)(P1 + (size_t)(s0 + t) * 2304 + 768 + ch);
#pragma unroll
      for (int k = 0; k < 4; ++k) { d[2 * k] = __uint_as_float(v[k] << 16); d[2 * k + 1] = __uint_as_float(v[k] & 0xffff0000u); } };
    ldrow(t0 - 2, win[0]); ldrow(t0 - 1, win[1]); ldrow(t0, win[2]); ldrow(t0 + 1, win[3]);
#pragma unroll
    for (int i = 0; i < 16; ++i) {
      ldrow(t0 + i + 2, win[(i + 4) % 5]);
      float o[8];
#pragma unroll
      for (int k = 0; k < 8; ++k) { float a = bias[k];
#pragma unroll
        for (int j = 0; j < 5; ++j) a += w[j][k] * win[(i + j) % 5][k];
        o[k] = a * __builtin_amdgcn_rcpf(1.f + __expf(-a)); }
      u32x4 ov; ov[0] = cvtpk(o[0], o[1]); ov[1] = cvtpk(o[2], o[3]); ov[2] = cvtpk(o[4], o[5]); ov[3] = cvtpk(o[6], o[7]);
      *(u32x4*)(U + (size_t)(r0 + i) * 1024 + ch) = ov;
    }
  }
}

DEVI float softplus_f(float v) { if (v > 20.f) return v; const float x = __expf(v); return x < 1e-3f ? x * (1.f - 0.5f * x) : __logf(1.f + x); }
constexpr int BSTR = 272, XSTR = 192;
constexpr int L_BM = 0, L_XD = 128 * BSTR, L_XW = L_XD + 128 * XSTR, L_HT = L_XW + 128 * XSTR, L_CUM = L_HT + 128 * XSTR, L_DTV = L_CUM + 512, L_XCH = L_DTV + 512, L_TOT = L_XCH + 8 * 4096;

template <int ABL = 0> DEVI void phase_ssd(const Params& p, ldsp_t lds) {
  const int tid = ftid(), lane = tid & 63, wave = __builtin_amdgcn_readfirstlane(tid >> 6), r32 = lane & 31, hi = lane >> 5;
  const int pb = wave >> 2, lb = (wave < 4) ? (wave & 3) : 3 - (wave & 3);
  const bf16_t* U = (const bf16_t*)(p.ws + WS_U); const float* DT = (const float*)(p.ws + WS_DT);
  bf16_t* YFB = (bf16_t*)(p.ws + WS_YS);
  FA_LAS float* CUM = (FA_LAS float*)(lds + L_CUM); FA_LAS float* DTV = (FA_LAS float*)(lds + L_DTV);
  const int trow_off = 4 * hi + ((lane & 15) >> 2), tcol_off = 32 * ((lane >> 4) & 1) + 8 * (lane & 3);
  for (int it = blockIdx.x; it < NB * 2 * 8; it += gridDim.x) {
    const int b = it >> 4, dir = (it >> 3) & 1, hd = it & 7, g = hd >> 2;
    const float a2 = -expf(p.in[dir ? L1_ALOGB : L1_ALOGF][hd]) * LOG2E; const float dtb = p.in[dir ? L1_DTBB : L1_DTBF][hd];
    auto tokrow = [&](int c, int i) { const int seg = c >= 2, len = seg ? SEQ : CTXL, j = (seg ? c - 2 : c) * 128 + i; return (seg ? b * SEQ : NLAT + b * CTXL) + (dir ? len - 1 - j : j); };
    f32x16 hacc;
#pragma unroll
    for (int r = 0; r < 16; ++r) hacc[r] = 0.f;
    for (int i = tid; i < 128 * XSTR / 4; i += NT) ((FA_LAS unsigned*)(lds + L_HT))[i] = 0u;
    u32x4 sb_[4], sx_[2]; float sdt0 = 0.f, sdt1 = 0.f; bf16x8 cfn[8];
    auto prefetch = [&](int c) {
#pragma unroll
      for (int i = 0; i < 4; ++i) { const int ch = tid + NT * i; sb_[i] = *(const u32x4*)(U + (size_t)tokrow(c, ch >> 4) * 1024 + 512 + g * 128 + (ch & 15) * 8); }
#pragma unroll
      for (int i = 0; i < 2; ++i) { const int ch = tid + NT * i; sx_[i] = *(const u32x4*)(U + (size_t)tokrow(c, ch >> 3) * 1024 + hd * 64 + (ch & 7) * 8); }
      if (tid < 64) { sdt0 = DT[(size_t)tokrow(c, 2 * tid) * 16 + dir * 8 + hd]; sdt1 = DT[(size_t)tokrow(c, 2 * tid + 1) * 16 + dir * 8 + hd]; }
      const bf16_t* crowp = U + (size_t)tokrow(c, lb * 32 + r32) * 1024 + 768 + g * 128 + 8 * hi;
#pragma unroll
      for (int ks = 0; ks < 8; ++ks) cfn[ks] = *(const bf16x8*)(crowp + 16 * ks);
    };
    prefetch(0);
    __syncthreads();
    for (int c = 0; c < 34; ++c) {
      if (tid < 64) {
        const float r0 = sdt0 + dtb, r1 = sdt1 + dtb; const float d0 = softplus_f(r0), d1 = softplus_f(r1);
        const float a0 = d0 * a2, a1 = d1 * a2; float v = a0 + a1;
#pragma unroll
        for (int o = 1; o < 64; o <<= 1) { const float t = __shfl_up(v, o); if (lane >= o) v += t; }
        DTV[2 * tid] = d0; DTV[2 * tid + 1] = d1; CUM[2 * tid] = v - a1; CUM[2 * tid + 1] = v;
      }
      __syncthreads();
      const float cl = CUM[127];
#pragma unroll
      for (int i = 0; i < 4; ++i) { const int ch = tid + NT * i; *(FA_LAS u32x4*)(lds + L_BM + (ch >> 4) * BSTR + (ch & 15) * 16) = sb_[i]; }
#pragma unroll
      for (int i = 0; i < 2; ++i) { const int ch = tid + NT * i, s = ch >> 3; const float d = DTV[s], wv = d * __builtin_amdgcn_exp2f(cl - CUM[s]);
        u32x4 xd, xw;
#pragma unroll
        for (int k = 0; k < 4; ++k) { const float x0 = __uint_as_float(sx_[i][k] << 16), x1 = __uint_as_float(sx_[i][k] & 0xffff0000u); xd[k] = cvtpk(x0 * d, x1 * d); xw[k] = cvtpk(x0 * wv, x1 * wv); }
        *(FA_LAS u32x4*)(lds + L_XD + s * XSTR + (ch & 7) * 16) = xd; *(FA_LAS u32x4*)(lds + L_XW + s * XSTR + (ch & 7) * 16) = xw; }
      bf16x8 cf[8];
#pragma unroll
      for (int ks = 0; ks < 8; ++ks) cf[ks] = cfn[ks];
      __syncthreads();
      if (ABL != 3) { if (c + 1 < 34) prefetch(c + 1); }
      if (c >= 2 && ABL != 1) {
        f32x16 y;
#pragma unroll
        for (int r = 0; r < 16; ++r) y[r] = 0.f;
        { const ldsp_t hb = lds + L_HT + (8 * hi + ((lane & 15) >> 2)) * XSTR + pb * 64 + tcol_off;
          f32x16 y2;
#pragma unroll
          for (int r = 0; r < 16; ++r) y2[r] = 0.f;
#pragma unroll
          for (int ks = 0; ks < 8; ++ks) { const s16x4 lo = vtr(hb + (16 * ks) * XSTR), h8 = vtr(hb + (16 * ks + 4) * XSTR);
            const bf16x8 hf = {lo[0], lo[1], lo[2], lo[3], h8[0], h8[1], h8[2], h8[3]};
            if (ks & 1) y2 = __builtin_amdgcn_mfma_f32_32x32x16_bf16(hf, cf[ks], y2, 0, 0, 0); else y = __builtin_amdgcn_mfma_f32_32x32x16_bf16(hf, cf[ks], y, 0, 0, 0); }
          y += y2; }
        const float cuml = CUM[lb * 32 + r32];
        { const float e = __builtin_amdgcn_exp2f(cuml);
#pragma unroll
          for (int r = 0; r < 16; ++r) y[r] *= e; }
        f32x16 yo;
#pragma unroll
        for (int r = 0; r < 16; ++r) yo[r] = 0.f;
        for (int sb = pb; sb <= lb; sb += 2) {
          f32x16 gt, gt2;
#pragma unroll
          for (int r = 0; r < 16; ++r) { gt[r] = 0.f; gt2[r] = 0.f; }
          const ldsp_t bb = lds + L_BM + (sb * 32 + r32) * BSTR + 16 * hi;
#pragma unroll
          for (int ks = 0; ks < 8; ks += 2) { gt = __builtin_amdgcn_mfma_f32_32x32x16_bf16(*(const FA_LAS bf16x8*)(bb + 32 * ks), cf[ks], gt, 0, 0, 0);
            gt2 = __builtin_amdgcn_mfma_f32_32x32x16_bf16(*(const FA_LAS bf16x8*)(bb + 32 * ks + 32), cf[ks + 1], gt2, 0, 0, 0); }
          gt += gt2;
          const bool diag = (sb == lb);
#pragma unroll
          for (int r = 0; r < 16; ++r) { const int sl = crow(r, hi); const float v = gt[r] * __builtin_amdgcn_exp2f(cuml - CUM[sb * 32 + sl]); gt[r] = (diag && sl > r32) ? 0.f : v; }
          u32x4 t0, t1;
          t0[0] = cvtpk(gt[0], gt[1]); t0[1] = cvtpk(gt[2], gt[3]); t0[2] = cvtpk(gt[4], gt[5]); t0[3] = cvtpk(gt[6], gt[7]);
          t1[0] = cvtpk(gt[8], gt[9]); t1[1] = cvtpk(gt[10], gt[11]); t1[2] = cvtpk(gt[12], gt[13]); t1[3] = cvtpk(gt[14], gt[15]);
          const bf16x8 pm0 = __builtin_bit_cast(bf16x8, t0), pm1 = __builtin_bit_cast(bf16x8, t1);
          const ldsp_t xb = lds + L_XD + (sb * 32 + trow_off) * XSTR + pb * 64 + tcol_off;
          const ldsp_t xo = lds + L_XD + (sb * 32 + trow_off) * XSTR + (1 - pb) * 64 + tcol_off;
          const s16x4 a0 = vtr(xb), a1 = vtr(xb + 8 * XSTR), a2 = vtr(xb + 16 * XSTR), a3 = vtr(xb + 24 * XSTR);
          const s16x4 b0 = vtr(xo), b1 = vtr(xo + 8 * XSTR), b2 = vtr(xo + 16 * XSTR), b3 = vtr(xo + 24 * XSTR);
          { const bf16x8 xf = {a0[0], a0[1], a0[2], a0[3], a1[0], a1[1], a1[2], a1[3]}; y = __builtin_amdgcn_mfma_f32_32x32x16_bf16(xf, pm0, y, 0, 0, 0); }
          { const bf16x8 xf = {b0[0], b0[1], b0[2], b0[3], b1[0], b1[1], b1[2], b1[3]}; yo = __builtin_amdgcn_mfma_f32_32x32x16_bf16(xf, pm0, yo, 0, 0, 0); }
          { const bf16x8 xf = {a2[0], a2[1], a2[2], a2[3], a3[0], a3[1], a3[2], a3[3]}; y = __builtin_amdgcn_mfma_f32_32x32x16_bf16(xf, pm1, y, 0, 0, 0); }
          { const bf16x8 xf = {b2[0], b2[1], b2[2], b2[3], b3[0], b3[1], b3[2], b3[3]}; yo = __builtin_amdgcn_mfma_f32_32x32x16_bf16(xf, pm1, yo, 0, 0, 0); }
        }
        { FA_LAS float* X = (FA_LAS float*)(lds + L_XCH) + (pb * 4 + lb) * 1024;
#pragma unroll
          for (int r = 0; r < 16; ++r) X[r * 64 + lane] = yo[r]; }
        __syncthreads();
        { const FA_LAS float* X = (const FA_LAS float*)(lds + L_XCH) + ((1 - pb) * 4 + lb) * 1024;
#pragma unroll
          for (int r = 0; r < 16; ++r) y[r] += X[r * 64 + lane]; }
        const int j = (c - 2) * 128 + lb * 32 + r32, tok = dir ? SEQ - 1 - j : j;
        bf16_t* yp = YFB + ((size_t)dir * NLAT + (size_t)b * SEQ + tok) * 512 + hd * 64 + pb * 32 + 4 * hi;
#pragma unroll
        for (int rg = 0; rg < 4; ++rg) { u32x2 w; w[0] = cvtpk(y[4 * rg], y[4 * rg + 1]); w[1] = cvtpk(y[4 * rg + 2], y[4 * rg + 3]); *(u32x2*)(yp + 8 * rg) = w; }
      }
      if (ABL != 2) { const float e = __builtin_amdgcn_exp2f(cl);
        f32x16 h2;
#pragma unroll
        for (int r = 0; r < 16; ++r) { hacc[r] *= e; h2[r] = 0.f; }
        const ldsp_t xb = lds + L_XW + (8 * hi + ((lane & 15) >> 2)) * XSTR + pb * 64 + tcol_off;
        const ldsp_t bb = lds + L_BM + (8 * hi + ((lane & 15) >> 2)) * BSTR + lb * 64 + tcol_off;
#pragma unroll
        for (int ks = 0; ks < 8; ++ks) {
          const s16x4 xl = vtr(xb + (16 * ks) * XSTR), xh = vtr(xb + (16 * ks + 4) * XSTR), bl = vtr(bb + (16 * ks) * BSTR), bh = vtr(bb + (16 * ks + 4) * BSTR);
          const bf16x8 xf = {xl[0], xl[1], xl[2], xl[3], xh[0], xh[1], xh[2], xh[3]}, bf = {bl[0], bl[1], bl[2], bl[3], bh[0], bh[1], bh[2], bh[3]};
          if (ks & 1) h2 = __builtin_amdgcn_mfma_f32_32x32x16_bf16(xf, bf, h2, 0, 0, 0); else hacc = __builtin_amdgcn_mfma_f32_32x32x16_bf16(xf, bf, hacc, 0, 0, 0);
        }
        hacc += h2; }
      __syncthreads();
      { const ldsp_t hp = lds + L_HT + (lb * 32 + r32) * XSTR + (pb * 32 + 4 * hi) * 2;
#pragma unroll
        for (int rg = 0; rg < 4; ++rg) { u32x2 w; w[0] = cvtpk(hacc[4 * rg], hacc[4 * rg + 1]); w[1] = cvtpk(hacc[4 * rg + 2], hacc[4 * rg + 3]); *(FA_LAS u32x2*)(hp + 16 * rg) = w; } }
    }
    __syncthreads();
  }
}

DEVI void phase_ssd_out(const Params& p) {
  const int lane = ftid() & 63, gw = blockIdx.x * NWAVE + (ftid() >> 6), NGW = gridDim.x * NWAVE;
  const bf16_t* U = (const bf16_t*)(p.ws + WS_U); const bf16_t* P1 = (const bf16_t*)(p.ws + WS_P1); const bf16_t* YFB = (const bf16_t*)(p.ws + WS_YS);
  bf16_t* ATT = (bf16_t*)(p.ws + WS_ATT1);
  for (int r = gw; r < NLAT; r += NGW) {
    const int c0 = lane * 8, hd = c0 >> 6; const float dsk = p.in[L1_DSKIP][hd];
    const u32x4 yf = *(const u32x4*)(YFB + (size_t)r * 512 + c0), yb = *(const u32x4*)(YFB + ((size_t)NLAT + r) * 512 + c0);
    const u32x4 xw = *(const u32x4*)(U + (size_t)r * 1024 + c0), zw = *(const u32x4*)(P1 + (size_t)r * 2304 + 1792 + c0);
    float y[8]; float ss = 0.f;
#pragma unroll
    for (int i = 0; i < 4; ++i) {
      const float x0 = __uint_as_float(xw[i] << 16), x1 = __uint_as_float(xw[i] & 0xffff0000u), z0 = __uint_as_float(zw[i] << 16), z1 = __uint_as_float(zw[i] & 0xffff0000u);
      const float f0 = __uint_as_float(yf[i] << 16) + __uint_as_float(yb[i] << 16), f1 = __uint_as_float(yf[i] & 0xffff0000u) + __uint_as_float(yb[i] & 0xffff0000u);
      y[2 * i] = (f0 + dsk * x0) * silu_f(z0); y[2 * i + 1] = (f1 + dsk * x1) * silu_f(z1);
      ss += y[2 * i] * y[2 * i] + y[2 * i + 1] * y[2 * i + 1];
    }
#pragma unroll
    for (int o = 1; o < 32; o <<= 1) ss += __shfl_xor(ss, o);
    const float rr = rsqrtf(ss * (1.f / 256.f) + EPS);
    const float4 g0 = *(const float4*)(p.in[L1_GNORM] + c0), g1 = *(const float4*)(p.in[L1_GNORM] + c0 + 4);
    u32x4 w; w[0] = cvtpk(y[0] * rr * g0.x, y[1] * rr * g0.y); w[1] = cvtpk(y[2] * rr * g0.z, y[3] * rr * g0.w); w[2] = cvtpk(y[4] * rr * g1.x, y[5] * rr * g1.y); w[3] = cvtpk(y[6] * rr * g1.z, y[7] * rr * g1.w);
    *(u32x4*)(ATT + (size_t)r * DM + 512 + c0) = w;
  }
}
}
#ifndef TOPK_COPY
#define TOPK_COPY false
#endif
namespace ft {
using fa::ldsp_t; using fa::u32x4;

DEVI int block_excl_scan(int v, FA_LAS int* wsum, int tid, int* tot) {
  const int lane = tid & 63, wave = tid >> 6;
  int inc = v;
#pragma unroll
  for (int o = 1; o < 64; o <<= 1) { const int t = __shfl_up(inc, o); if (lane >= o) inc += t; }
  __syncthreads();
  if (lane == 63) wsum[wave] = inc;
  __syncthreads();
  int base = 0, total = 0;
#pragma unroll
  for (int w = 0; w < 8; ++w) { const int s = wsum[w]; if (w < wave) base += s; total += s; }
  *tot = total;
  return base + inc - v;
}

template <int EPT, bool GATHER_COPY>
DEVI void topk_item(const Params& p, ldsp_t lds, int e, int n, int cap, int row0, int slot0, int erows) {
  const int tid = ftid(), lane = tid & 63, wave = tid >> 6;
  const float* AFFT = (const float*)(p.ws + WS_AFF); int* SLOT = (int*)(p.ws + WS_SLOT); float* GV = (float*)(p.ws + WS_GATEV);
  const bf16_t* H = (const bf16_t*)(p.ws + WS_H); bf16_t* XG = (bf16_t*)(p.ws + WS_XG); int* IDX = (int*)(p.ws + WS_IDX);
  FA_LAS unsigned* hist = (FA_LAS unsigned*)lds;
  FA_LAS int* misc = (FA_LAS int*)(lds + 1024);
  FA_LAS int* wsum = (FA_LAS int*)(lds + 1024 + 64);
  FA_LAS int* list = (FA_LAS int*)(lds + 2048);
  const bool act = tid * EPT < n;
  unsigned key[EPT];
#pragma unroll
  for (int j = 0; j < EPT; ++j) key[j] = act ? __float_as_uint(AFFT[(size_t)e * NROW + row0 + tid * EPT + j]) : 0u;
  unsigned prefix = 0u, mask = 0u; int k = cap;
#pragma unroll 1
  for (int pass = 0; pass < 4; ++pass) {
    const int shift = 24 - 8 * pass;
    __syncthreads();
    if (tid < 256) hist[tid] = 0u;
    __syncthreads();
    if (act) {
#pragma unroll
      for (int j = 0; j < EPT; ++j) if ((key[j] & mask) == prefix) atomicAdd((unsigned*)&hist[(key[j] >> shift) & 255u], 1u);
    }
    __syncthreads();
    if (wave == 0) {
      const int h0 = hist[4 * lane], h1 = hist[4 * lane + 1], h2 = hist[4 * lane + 2], h3 = hist[4 * lane + 3];
      const int s = h0 + h1 + h2 + h3; int v = s;
#pragma unroll
      for (int o = 1; o < 64; o <<= 1) { const int t = __shfl_down(v, o); if (lane + o < 64) v += t; }
      int c = v - s;
      const int hh[4] = {h0, h1, h2, h3};
#pragma unroll
      for (int b = 3; b >= 0; --b) { if (c < k && k <= c + hh[b]) { misc[0] = 4 * lane + b; misc[1] = k - c; } c += hh[b]; }
    }
    __syncthreads();
    prefix |= ((unsigned)misc[0]) << shift; mask |= 255u << shift; k = misc[1];
  }
  int ce = 0;
#pragma unroll
  for (int j = 0; j < EPT; ++j) ce += (act && key[j] == prefix) ? 1 : 0;
  int tot; const int eq_before = block_excl_scan(ce, wsum, tid, &tot);
  int cs = 0, eqr = eq_before; bool sel[EPT];
#pragma unroll
  for (int j = 0; j < EPT; ++j) { bool s = false; if (act) { if (key[j] > prefix) s = true; else if (key[j] == prefix) { s = eqr < k; ++eqr; } } sel[j] = s; cs += s ? 1 : 0; }
  int slot = block_excl_scan(cs, wsum, tid, &tot);
  if (act) {
#pragma unroll
    for (int j = 0; j < EPT; ++j) { const int row = row0 + tid * EPT + j;
      if (sel[j]) { if (GATHER_COPY) list[slot] = row; else IDX[e * erows + slot0 + slot] = row; GV[e * erows + slot0 + slot] = __uint_as_float(key[j]); SLOT[(size_t)row * 16 + e] = slot0 + slot; ++slot; }
      else SLOT[(size_t)row * 16 + e] = -1; }
  }
  if (GATHER_COPY) {
    __syncthreads();
    for (int s = wave; s < cap; s += NWAVE) {
      const u32x4* src = (const u32x4*)(H + (size_t)list[s] * DM) + lane; u32x4* dst = (u32x4*)(XG + ((size_t)e * erows + slot0 + s) * DM) + lane;
      const u32x4 a = src[0], b2 = src[64]; dst[0] = a; dst[64] = b2;
    }
  }
  __syncthreads();
}

DEVI void phase_topk(const Params& p, ldsp_t lds, int layer) {
  const int erows = layer ? EROWS1 : EROWS0;
  const int nlat = NB * NE, nitems = nlat + (layer ? 0 : NB * NE);
  const int G = gridDim.x;
  for (int it = blockIdx.x; it < nitems; it += G) {
    if (it < nlat) { const int b = it / NE, e = it % NE; topk_item<8, TOPK_COPY>(p, lds, e, SEQ, CAP_L, b * SEQ, b * CAP_L, erows); }
    else { const int i2 = it - nlat, b = i2 / NE, e = i2 % NE; topk_item<1, TOPK_COPY>(p, lds, e, CTXL, CAP_C, NLAT + b * CTXL, NB * CAP_L + b * CAP_C, erows); }
  }
}
}
#ifndef MOE1_FP8
#define MOE1_FP8 1
#endif
#ifndef MOE0_FP8
#define MOE0_FP8 1
#endif
namespace fr {
using fa::ldsp_t; using fa::u32x4; using fa::cvtpk;
typedef unsigned u32x2 __attribute__((ext_vector_type(2)));
typedef float f32x4 __attribute__((ext_vector_type(4)));
struct V16 { f32x4 v[4]; };
DEVI V16 ldf(const float* r, int lane) { V16 o; const f32x4* q = (const f32x4*)r + lane;
#pragma unroll
  for (int j = 0; j < 4; ++j) o.v[j] = q[64 * j]; return o; }
struct B16 { u32x2 v[4]; };
DEVI B16 ldb_raw(const bf16_t* r, int lane) { B16 o; const u32x2* q = (const u32x2*)r + lane;
#pragma unroll
  for (int j = 0; j < 4; ++j) o.v[j] = q[64 * j]; return o; }
DEVI V16 b2v(const B16& b) { V16 o;
#pragma unroll
  for (int j = 0; j < 4; ++j) { o.v[j][0] = __uint_as_float(b.v[j][0] << 16); o.v[j][1] = __uint_as_float(b.v[j][0] & 0xffff0000u); o.v[j][2] = __uint_as_float(b.v[j][1] << 16); o.v[j][3] = __uint_as_float(b.v[j][1] & 0xffff0000u); }
  return o; }
DEVI void stf(float* r, int lane, const V16& o) { f32x4* q = (f32x4*)r + lane;
#pragma unroll
  for (int j = 0; j < 4; ++j) q[64 * j] = o.v[j]; }
DEVI void stb(bf16_t* r, int lane, const V16& o) { u32x2* q = (u32x2*)r + lane;
#pragma unroll
  for (int j = 0; j < 4; ++j) { u32x2 w; w[0] = cvtpk(o.v[j][0], o.v[j][1]); w[1] = cvtpk(o.v[j][2], o.v[j][3]); q[64 * j] = w; } }
DEVI float sumsq(const V16& o) { f32x4 s = o.v[0] * o.v[0];
#pragma unroll
  for (int j = 1; j < 4; ++j) s += o.v[j] * o.v[j];
  return wave_sum((s[0] + s[1]) + (s[2] + s[3])); }

DEVI void phase_prenorm0(const Params& p) {
  const int lane = ftid() & 63, gw = blockIdx.x * NWAVE + (ftid() >> 6), NGW = gridDim.x * NWAVE;
  const float* MOD = (const float*)(p.ws + WS_CTL + CTL_MOD); bf16_t* H = (bf16_t*)(p.ws + WS_H);
  const int rpw = (NROW + NGW - 1) / NGW;
  const int r0 = gw * rpw, r1 = min(r0 + rpw, NROW);
  if (r0 >= r1) return;
  const V16 g = ldf(p.in[L0_GPREMIX], lane);
  int cur = -1; V16 gs, sh;
  auto src = [&](int r) { return r < NLAT ? p.in[I_X] + (size_t)r * DM : p.in[I_CTX] + (size_t)(r - NLAT) * DM; };
  V16 xn = ldf(src(r0), lane), xn2 = xn;
  if (r0 + 1 < r1) xn2 = ldf(src(r0 + 1), lane);
  for (int r = r0; r < r1; ++r) {
    const V16 x = xn; xn = xn2; if (r + 2 < r1) xn2 = ldf(src(r + 2), lane);
    const int mr = row_modrow(r);
    if (mr != cur) { cur = mr; const float* m = MOD + (size_t)mr * 6144; const V16 sc = ldf(m + 1024, lane); sh = ldf(m, lane);
#pragma unroll
      for (int j = 0; j < 4; ++j) gs.v[j] = g.v[j] * (sc.v[j] + 1.f); }
    const float rr = rsqrtf(sumsq(x) * (1.f / DM) + EPS);
    V16 h;
#pragma unroll
    for (int j = 0; j < 4; ++j) h.v[j] = x.v[j] * rr * gs.v[j] + sh.v[j];
    if (QKV0_FP8) {
      unsigned* q8 = (unsigned*)((unsigned char*)H + (size_t)r * DM) + lane;
#pragma unroll
      for (int j = 0; j < 4; ++j) q8[64 * j] = nv::pack4_fp8(h.v[j][0] * nv::A8_SCALE, h.v[j][1] * nv::A8_SCALE, h.v[j][2] * nv::A8_SCALE, h.v[j][3] * nv::A8_SCALE);
    } else stb(H + (size_t)r * DM, lane, h);
  }
}

template <int ABL = 0> DEVI void phase_postmix(const Params& p, ldsp_t lds, int layer) {
  const int tid = ftid(), lane = tid & 63, gw = blockIdx.x * NWAVE + (tid >> 6), NGW = gridDim.x * NWAVE;
  const float* MOD = (const float*)(p.ws + WS_CTL + CTL_MOD) + (size_t)layer * 9 * 6144;
  const bf16_t* MIX = (const bf16_t*)(p.ws + (layer ? WS_MIX1 : WS_MIX0));
  bf16_t* H = (bf16_t*)(p.ws + WS_H); float* AFFT = (float*)(p.ws + WS_AFF); float* XC = (float*)(p.ws + WS_XC);
  const float* wr = p.in[layer ? L1_WROUTER : L0_WROUTER];
  FA_LAS f32x4* WL = (FA_LAS f32x4*)lds;
  for (int i = tid; i < 1024 * 4; i += NT) { const int k = i >> 2, e4 = i & 3; const int ln = (k & 255) >> 2, q = k & 3, j = k >> 8;
    WL[((j * 4 + q) * 4 + e4) * 64 + ln] = *(const f32x4*)(wr + (size_t)k * 16 + e4 * 4); }
  __syncthreads();
  const int nrow = layer ? NLAT : NROW;
  const int rpw = (nrow + NGW - 1) / NGW;
  const int r0 = gw * rpw, r1 = min(r0 + rpw, nrow);
  if (r0 >= r1) return;
  const V16 gpost = ldf(p.in[layer ? L1_GPOSTMIX : L0_GPOSTMIX], lane), gpre = ldf(p.in[layer ? L1_GPREFFN : L0_GPREFFN], lane);
  int cur = -1; V16 gg, gs, sh;
  auto xsrc = [&](int r) { return layer ? (const float*)(p.out + (size_t)r * DM) : (r < NLAT ? p.in[I_X] + (size_t)r * DM : p.in[I_CTX] + (size_t)(r - NLAT) * DM); };
  B16 mn = ldb_raw(MIX + (size_t)r0 * DM, lane); V16 xn = ldf(xsrc(r0), lane);
  B16 mn2 = mn; V16 xn2 = xn;
  if (r0 + 1 < r1) { mn2 = ldb_raw(MIX + (size_t)(r0 + 1) * DM, lane); xn2 = ldf(xsrc(r0 + 1), lane); }
  for (int r = r0; r < r1; ++r) {
    const B16 mb = mn; const V16 x = xn;
    mn = mn2; xn = xn2;
    if (r + 2 < r1) { mn2 = ldb_raw(MIX + (size_t)(r + 2) * DM, lane); xn2 = ldf(xsrc(r + 2), lane); }
    const int mr = row_modrow(r);
    if (mr != cur) { cur = mr; const float* m = MOD + (size_t)mr * 6144; const V16 gt = ldf(m + 2048, lane), sc = ldf(m + 4096, lane); sh = ldf(m + 3072, lane);
#pragma unroll
      for (int j = 0; j < 4; ++j) { gg.v[j] = gt.v[j] * gpost.v[j]; gs.v[j] = gpre.v[j] * (sc.v[j] + 1.f); } }
    V16 o = b2v(mb);
    const float rr = rsqrtf(sumsq(o) * (1.f / DM) + EPS);
#pragma unroll
    for (int j = 0; j < 4; ++j) o.v[j] = x.v[j] + gg.v[j] * (o.v[j] * rr);
    stf(r < NLAT ? p.out + (size_t)r * DM : XC + (size_t)(r - NLAT) * DM, lane, o);
    const float r2 = rsqrtf(sumsq(o) * (1.f / DM) + EPS);
    V16 h;
#pragma unroll
    for (int j = 0; j < 4; ++j) h.v[j] = o.v[j] * r2 * gs.v[j] + sh.v[j];
    if ((layer == 1 && MOE1_FP8) || (layer == 0 && MOE0_FP8)) {
      unsigned* q8 = (unsigned*)((unsigned char*)H + (size_t)r * DM) + lane;
#pragma unroll
      for (int j = 0; j < 4; ++j) q8[64 * j] = nv::pack4_fp8(h.v[j][0] * nv::A8_SCALE, h.v[j][1] * nv::A8_SCALE, h.v[j][2] * nv::A8_SCALE, h.v[j][3] * nv::A8_SCALE);
    } else stb(H + (size_t)r * DM, lane, h);
    if (ABL == 1) continue;
    f32x4 lg[4];
    int lo = lane; asm volatile("" : "+v"(lo));
#pragma unroll
    for (int e4 = 0; e4 < 4; ++e4) lg[e4] = (f32x4){0.f, 0.f, 0.f, 0.f};
#pragma unroll
    for (int j = 0; j < 4; ++j)
#pragma unroll
      for (int q = 0; q < 4; ++q) { const float hv = h.v[j][q];
#pragma unroll
        for (int e4 = 0; e4 < 4; ++e4) lg[e4] += WL[((j * 4 + q) * 4 + e4) * 64 + lo] * hv; }
    float l16[16]; float mx = -INFINITY;
#pragma unroll
    for (int e = 0; e < 16; ++e) { l16[e] = wave_sum(lg[e >> 2][e & 3]); mx = fmaxf(mx, l16[e]); }
    float s = 0.f;
#pragma unroll
    for (int e = 0; e < 16; ++e) { l16[e] = expf(l16[e] - mx); s += l16[e]; }
    const float inv = 1.f / s; float mine = 0.f;
#pragma unroll
    for (int e = 0; e < 16; ++e) if (lane == e) mine = l16[e] * inv;
    if (lane < 16) AFFT[(size_t)lane * NROW + r] = mine;
  }
}

DEVI void phase_combine(const Params& p, int layer) {
  const int tid = ftid(), lane = tid & 63, gw = blockIdx.x * NWAVE + (tid >> 6), NGW = gridDim.x * NWAVE;
  const float* MOD = (const float*)(p.ws + WS_CTL + CTL_MOD);
  const bf16_t* Y = (const bf16_t*)(p.ws + WS_Y); const int* SLOT = (const int*)(p.ws + WS_SLOT); const float* GV = (const float*)(p.ws + WS_GATEV);
  bf16_t* H = (bf16_t*)(p.ws + WS_H); float* XC = (float*)(p.ws + WS_XC);
  const int nrow = layer ? NLAT : NROW, erows = layer ? EROWS1 : EROWS0;
  const int rpw = (nrow + NGW - 1) / NGW;
  const int r0 = gw * rpw, r1 = min(r0 + rpw, nrow);
  if (r0 >= r1) return;
  const V16 gpost = ldf(p.in[layer ? L1_GPOSTFFN : L0_GPOSTFFN], lane);
  V16 g1; if (layer == 0) g1 = ldf(p.in[L1_GPREMIX], lane);
  int cur = -1; V16 gg, gs, sh;
  int sn = (lane < 16) ? SLOT[(size_t)r0 * 16 + lane] : -1;
  for (int r = r0; r < r1; ++r) {
    const int sl = sn; if (r + 1 < r1) sn = (lane < 16) ? SLOT[(size_t)(r + 1) * 16 + lane] : -1;
    float* xio = r < NLAT ? p.out + (size_t)r * DM : XC + (size_t)(r - NLAT) * DM;
    const V16 x = ldf(xio, lane);
    const int mr = row_modrow(r);
    if (mr != cur) { cur = mr; const float* m = MOD + (size_t)(layer * 9 + mr) * 6144; const V16 gt = ldf(m + 5120, lane);
#pragma unroll
      for (int j = 0; j < 4; ++j) gg.v[j] = gt.v[j] * gpost.v[j];
      if (layer == 0) { const float* m1 = MOD + (size_t)(9 + mr) * 6144; const V16 sc = ldf(m1 + 1024, lane); sh = ldf(m1, lane);
#pragma unroll
        for (int j = 0; j < 4; ++j) gs.v[j] = g1.v[j] * (sc.v[j] + 1.f); } }
    V16 o;
#pragma unroll
    for (int j = 0; j < 4; ++j) o.v[j] = (f32x4){0.f, 0.f, 0.f, 0.f};
    unsigned long long mask = __ballot(sl >= 0);
    while (mask) {
      const int e = __builtin_ctzll(mask); mask &= mask - 1;
      const int s = __shfl(sl, e);
      const float gate = GV[e * erows + s];
      const V16 y = b2v(ldb_raw(Y + ((size_t)e * erows + s) * DM, lane));
#pragma unroll
      for (int j = 0; j < 4; ++j) o.v[j] += y.v[j] * gate;
    }
    const float rr = rsqrtf(sumsq(o) * (1.f / DM) + EPS);
#pragma unroll
    for (int j = 0; j < 4; ++j) o.v[j] = x.v[j] + gg.v[j] * (o.v[j] * rr);
    stf(xio, lane, o);
    if (layer == 0) {
      const float r2 = rsqrtf(sumsq(o) * (1.f / DM) + EPS);
      V16 h;
#pragma unroll
      for (int j = 0; j < 4; ++j) h.v[j] = o.v[j] * r2 * gs.v[j] + sh.v[j];
      if (QKV1_FP8) {
        unsigned* q8 = (unsigned*)((unsigned char*)H + (size_t)r * DM) + lane;
#pragma unroll
        for (int j = 0; j < 4; ++j) q8[64 * j] = nv::pack4_fp8(h.v[j][0] * nv::A8_SCALE, h.v[j][1] * nv::A8_SCALE, h.v[j][2] * nv::A8_SCALE, h.v[j][3] * nv::A8_SCALE);
      } else stb(H + (size_t)r * DM, lane, h);
    }
  }
}
}
#define LAS __attribute__((address_space(3)))
#define XB_TMO      128
#define XB_XCNT(j)  (256  + 64 * (j))
#define XB_XSUB(j)  (1280 + 64 * (j))
#define XB_XGEN(j)  (2304 + 64 * (j))
#define XB_TOP      3328
#define XB_TOPGEN   3392
#define XCD_BAR_WORDS 3456
#define XB_SPIN_CAP (1u << 18)

__device__ __forceinline__ unsigned xb_ld(unsigned* p)              { return __hip_atomic_load(p, __ATOMIC_RELAXED, __HIP_MEMORY_SCOPE_AGENT); }
__device__ __forceinline__ unsigned xb_add(unsigned* p, unsigned v) { return __hip_atomic_fetch_add(p, v, __ATOMIC_RELAXED, __HIP_MEMORY_SCOPE_AGENT); }
__device__ __forceinline__ unsigned xb_xcc_id() { return (unsigned)__builtin_amdgcn_s_getreg((3 << 11) | 20) & 0xFu; }
#define XB_SPIN(cond, bar) do { unsigned _sp = 0; while (cond) { __builtin_amdgcn_s_sleep(1); \
    if ((++_sp & 255u) == 0u) { if (xb_ld(&(bar)[XB_TMO])) break; if (_sp > XB_SPIN_CAP) { atomicAdd(&(bar)[XB_TMO], 1u); break; } } } } while (0)

struct XcdBarrier {
    unsigned* bar; unsigned x;
    volatile LAS unsigned* st;
};

__device__ __forceinline__ XcdBarrier xcd_barrier_post(unsigned* bar, volatile LAS unsigned* st) {
    XcdBarrier b; b.bar = bar; b.x = xb_xcc_id(); b.st = st;
    if (threadIdx.x == 0) (void)xb_add(&bar[XB_XCNT(b.x)], 1u);
    return b;
}
__device__ __forceinline__ void xcd_barrier_complete(unsigned* bar, unsigned x, unsigned& nloc, unsigned& nx) {
    const unsigned G = gridDim.x * gridDim.y * gridDim.z;
    unsigned sum, cnt, mine, sp = 0u;
    for (;;) {
        sum = 0u; cnt = 0u; mine = 0u;
#pragma unroll
        for (unsigned j = 0; j < 16; ++j) { const unsigned c = xb_ld(&bar[XB_XCNT(j)]); sum += c; cnt += (c > 0u) ? 1u : 0u; mine = (j == x) ? c : mine; }
        if (sum == G) break;
        __builtin_amdgcn_s_sleep(1);
        if ((++sp & 255u) == 0u) { if (xb_ld(&bar[XB_TMO])) break; if (sp > XB_SPIN_CAP) { atomicAdd(&bar[XB_TMO], 1u); break; } }
    }
    nloc = mine > 0u ? mine : 1u; nx = cnt > 0u ? cnt : 1u;
}

__device__ __forceinline__ void xcd_barrier(const XcdBarrier& b) {
    asm volatile("s_waitcnt vmcnt(0)" ::: "memory");
    __syncthreads();
    if (threadIdx.x == 0) {
        unsigned* bar = b.bar;
        __builtin_amdgcn_s_waitcnt(0);
        unsigned nloc = b.st[0], nx = b.st[1];
        if (nloc == 0u) { xcd_barrier_complete(bar, b.x, nloc, nx); b.st[0] = nloc; b.st[1] = nx; }
        const unsigned old = xb_add(&bar[XB_XSUB(b.x)], 1u);
        const unsigned gen = old / nloc;
        if (old + 1u == (gen + 1u) * nloc) {
            __builtin_amdgcn_fence(__ATOMIC_RELEASE, "agent");
            asm volatile("s_waitcnt vmcnt(0)" ::: "memory");
            const unsigned og = xb_add(&bar[XB_TOP], 1u);
            const unsigned tg = og / nx;
            if (og + 1u == (tg + 1u) * nx) xb_add(&bar[XB_TOPGEN], 1u);
            else XB_SPIN(xb_ld(&bar[XB_TOPGEN]) == tg, bar);
            __builtin_amdgcn_fence(__ATOMIC_ACQUIRE, "agent");
            xb_add(&bar[XB_XGEN(b.x)], 1u);
            asm volatile("s_waitcnt vmcnt(0)" ::: "memory");
        } else {
            XB_SPIN(xb_ld(&bar[XB_XGEN(b.x)]) == gen, bar);
            __builtin_amdgcn_fence(__ATOMIC_ACQUIRE, "agent");
            asm volatile("s_waitcnt vmcnt(0)" ::: "memory");
        }
    }
    __syncthreads();
}


__device__ __forceinline__ void flat_barrier(unsigned* ctr, unsigned& epoch) {
    asm volatile("s_waitcnt vmcnt(0)" ::: "memory");
    __syncthreads();
    if (threadIdx.x == 0) {
        __builtin_amdgcn_fence(__ATOMIC_RELEASE, "agent");
        asm volatile("s_waitcnt vmcnt(0)" ::: "memory");
        (void)__hip_atomic_fetch_add(ctr, 1u, __ATOMIC_RELAXED, __HIP_MEMORY_SCOPE_AGENT);
        const unsigned target = (epoch + 1u) * (unsigned)gridDim.x; unsigned sp = 0;
        while (__hip_atomic_load(ctr, __ATOMIC_RELAXED, __HIP_MEMORY_SCOPE_AGENT) < target) { __builtin_amdgcn_s_sleep(1); if (++sp > (1u << 22)) break; }
        __builtin_amdgcn_fence(__ATOMIC_ACQUIRE, "agent");
        asm volatile("s_waitcnt vmcnt(0)" ::: "memory");
    }
    ++epoch;
    __syncthreads();
}
constexpr int LDS_BYTES = 147456;
#define TAILFILL 1
#ifndef FAST_GEMM
#define FAST_GEMM 1
#endif
#ifndef FAST_TOPK
#define FAST_TOPK 1
#endif
#ifndef FAST_SSD
#define FAST_SSD 1
#endif
#ifndef FAST_ATTN
#define FAST_ATTN 1
#endif
__global__ void __launch_bounds__(NT) mega(Params p) {
  extern __shared__ __attribute__((aligned(16))) unsigned char lds_raw[];
  float* lds = (float*)lds_raw;
  fg::ldsp_t ldsp = (fg::ldsp_t)lds_raw;
  cg::grid_group grid = cg::this_grid();
  volatile LAS unsigned* bst = (volatile LAS unsigned*)((LAS unsigned char*)lds_raw + (LDS_BYTES - 64));
  if (threadIdx.x < 2) bst[threadIdx.x] = 0u;
  unsigned* barw = (unsigned*)(p.ws + WS_CTL + CTL_BAR);
  if (blockIdx.x == 0) for (int i = threadIdx.x; i < XCD_BAR_WORDS; i += NT) barw[i] = 0u;
  XcdBarrier xbar; xbar.bar = barw; xbar.x = 0; xbar.st = bst;
#ifdef FLATBAR
  unsigned fb_epoch = 0; unsigned* fb_ctr = barw + XCD_BAR_WORDS - 64;
#define GSYNC() flat_barrier(fb_ctr, fb_epoch)
#else
#define GSYNC() xcd_barrier(xbar)
#endif
  nv::phase0(p, lds);                 grid.sync();
  xbar = xcd_barrier_post(barw, bst);
#ifdef DUP_SYNC
  for (int i = 0; i < 20; ++i) GSYNC();
#endif
#ifdef DUP_P0
  nv::phase0(p, lds);                 GSYNC();
#endif
  fr::phase_prenorm0(p);              GSYNC();
#ifdef DUP_PRENORM
  fr::phase_prenorm0(p); GSYNC();
#endif
#if FAST_GEMM
  fg::phase_qkv0(p, ldsp); GSYNC();
#ifdef DUP_QKV0
  fg::phase_qkv0(p, ldsp); GSYNC();
#endif
#else
  nv::phase_qkv0(p, lds);             GSYNC();
#endif
#if FAST_ATTN
  fa::phase_attnA(p, ldsp); fa::phase_attnB(p, ldsp); GSYNC();
#ifdef DUP_A
  fa::phase_attnA<DUP_A>(p, ldsp); GSYNC();
#endif
#ifdef DUP_B
  fa::phase_attnB<DUP_B>(p, ldsp); GSYNC();
#endif
#else
  nv::phase_attn0(p, lds);            GSYNC();
#endif
#if FAST_GEMM
#ifdef TAILFILL
  fg::phase_outproj(p, ldsp, 0); nv::convert_moe_tail8(p, 0, 1, lds, NROW / 256 * (DM / 256)); GSYNC();
#else
  fg::phase_outproj(p, ldsp, 0); GSYNC();
#endif
#ifdef DUP_OUT0
  fg::phase_outproj(p, ldsp, 0); GSYNC();
#endif
#else
  nv::phase_outproj(p, lds, 0);       GSYNC();
#endif
  fr::phase_postmix(p, ldsp, 0);            GSYNC();
#ifdef DUP_POSTMIX0
  fr::phase_postmix<DUP_POSTMIX0>(p, ldsp, 0); GSYNC();
#endif
#if FAST_TOPK
  ft::phase_topk(p, ldsp, 0);         GSYNC();
#ifdef DUP_TOPK0
  ft::phase_topk(p, ldsp, 0);         GSYNC();
#endif
#else
  nv::phase_topk(p, lds, 0);          GSYNC();
  fg::phase_gather(p, 0);             GSYNC();
#endif
#if FAST_GEMM
  fg::phase_moe_up8(p, ldsp, 0);      GSYNC();
#ifdef DUP_UP0
  fg::phase_moe_up8(p, ldsp, 0); GSYNC();
#endif
  fg::phase_moe_down8(p, ldsp, 0);    GSYNC();
#ifdef DUP_DOWN0
  fg::phase_moe_down8(p, ldsp, 0); GSYNC();
#endif
#else
  nv::phase_moe_up(p, lds, 0);        GSYNC();
  nv::phase_moe_down(p, lds, 0);      GSYNC();
#endif
#ifdef TAILFILL
  fr::phase_combine(p, 0); GSYNC();
#else
  fr::phase_combine(p, 0); nv::convert_moe_tail(p, 1, 0, lds, 0); nv::convert_moe_tail(p, 1, 1, lds, 0); GSYNC();
#endif
#if FAST_GEMM
#ifdef TAILFILL
  fg::phase_qkv1(p, ldsp); nv::convert_moe_tail8(p, 1, 0, lds, NROW / 256 * (N_IN1P / 256)); GSYNC();
#else
  fg::phase_qkv1(p, ldsp); GSYNC();
#endif
#else
  nv::phase_qkv1(p, lds);             GSYNC();
#endif
#if FAST_ATTN
#if FAST_SSD
#ifdef TAILFILL
  fs::phase_conv(p); nv::convert_moe_tail8(p, 1, 1, lds, 0); GSYNC();
#else
  fs::phase_conv(p); GSYNC();
#endif
#else
  nv::phase_conv_swa(p, lds, true); GSYNC();
#endif
#else
  nv::phase_conv_swa(p, lds, true);   GSYNC();
#endif
#if FAST_SSD
  fs::phase_ssd(p, ldsp); fa::phase_attnC(p, ldsp, (int*)(p.ws + WS_CTL + CTL_QC)); GSYNC();
#ifdef DUP_SSD
  fs::phase_ssd<DUP_SSD>(p, ldsp);             GSYNC();
#endif
  fs::phase_ssd_out(p);               GSYNC();
#else
  nv::phase_ssd(p, lds);              GSYNC();
  nv::phase_ssd_out(p);               GSYNC();
#endif
#if FAST_GEMM
  fg::phase_outproj(p, ldsp, 1);      GSYNC();
#else
  nv::phase_outproj(p, lds, 1);       GSYNC();
#endif
  fr::phase_postmix(p, ldsp, 1);            GSYNC();
#if FAST_TOPK
  ft::phase_topk(p, ldsp, 1);         GSYNC();
#ifdef DUP_TOPK1
  ft::phase_topk(p, ldsp, 1);         GSYNC();
#endif
#else
  nv::phase_topk(p, lds, 1);          GSYNC();
  fg::phase_gather(p, 1);             GSYNC();
#endif
#if FAST_GEMM
  fg::phase_moe_up8(p, ldsp, 1);      GSYNC();
  fg::phase_moe_down8(p, ldsp, 1);    GSYNC();
#else
  nv::phase_moe_up(p, lds, 1);        GSYNC();
  nv::phase_moe_down(p, lds, 1);      GSYNC();
#endif
  fr::phase_combine(p, 1);
}


extern "C" void kernel_launch(void* const* d_in, const int* in_sizes, int n_in, void* d_out, int out_size,
                              void* d_ws, size_t ws_size, hipStream_t stream) {
  static int grid_blocks = 0;
  if (!grid_blocks) {
    int dev = 0, cus = 0, per_cu = 0;
    (void)hipGetDevice(&dev);
    (void)hipDeviceGetAttribute(&cus, hipDeviceAttributeMultiprocessorCount, dev);
    (void)hipFuncSetAttribute((const void*)mega, hipFuncAttributeMaxDynamicSharedMemorySize, LDS_BYTES);
    (void)hipOccupancyMaxActiveBlocksPerMultiprocessor(&per_cu, (const void*)mega, NT, LDS_BYTES);
    if (per_cu < 1) { fprintf(stderr, "kernel_launch: occupancy query says %d blocks/CU\n", per_cu); per_cu = 1; }
    grid_blocks = cus;
    if (n_in != 43 || ws_size < WS_END) fprintf(stderr, "kernel_launch: unexpected n_in %d / ws_size %zu (need %zu)\n", n_in, ws_size, (size_t)WS_END);
  }
  Params p{};
  for (int i = 0; i < 43; ++i) p.in[i] = (const float*)d_in[i];
  p.out = (float*)d_out; p.ws = (unsigned char*)d_ws;
  void* args[] = {&p};
  hipError_t e = hipLaunchCooperativeKernel((void*)mega, dim3(grid_blocks), dim3(NT), args, LDS_BYTES, stream);
  if (e != hipSuccess) fprintf(stderr, "cooperative launch failed: %s (grid %d)\n", hipGetErrorString(e), grid_blocks);
}
```

```cpp
#include <hip/hip_runtime.h>
#include <hip/hip_cooperative_groups.h>
#include <cstdio>
#include <cstdint>
namespace cg = cooperative_groups;

typedef unsigned short bf16_t;
#define DEVI __device__ __forceinline__

constexpr int NT = 512, NWAVE = 8;
constexpr int NB = 8, SEQ = 4096, DM = 1024, CTXL = 256;
constexpr int NLAT = NB * SEQ, NCTX = NB * CTXL, NROW = NLAT + NCTX;
constexpr int NE = 16;
constexpr int CAP_L = 512, CAP_C = 32;
constexpr int EROWS0 = NB * CAP_L + NB * CAP_C;
constexpr int EROWS1 = NB * CAP_L;
constexpr int N_IN0 = 3072, N_IN1 = 2320, N_IN1P = 2560;
constexpr float EPS = 1e-6f;

constexpr size_t MiB = 1u << 20;
constexpr size_t WS_CTL = 0;
constexpr size_t WS_WIN0 = 1 * MiB;
constexpr size_t WS_WIN1 = 7 * MiB;
constexpr size_t WS_WOUT0 = 12 * MiB, WS_WOUT1 = 14 * MiB;
constexpr size_t WS_WGU = 16 * MiB;
constexpr size_t WS_WD = 80 * MiB;
constexpr size_t WS_XC = 112 * MiB;
constexpr size_t WS_H = 120 * MiB;
constexpr size_t WS_AFF = 188 * MiB;
constexpr size_t WS_SLOT = 191 * MiB;
constexpr size_t WS_IDX = 194 * MiB;
constexpr size_t WS_GATEV = 195 * MiB;
constexpr size_t WS_BIG = 196 * MiB;
constexpr size_t WS_QKV0 = WS_BIG;
constexpr size_t WS_ATT0 = WS_BIG + 204 * MiB;
constexpr size_t WS_MIX0 = WS_BIG + 272 * MiB;
constexpr size_t WS_XG = WS_BIG;
constexpr size_t WS_HID = WS_BIG + 136 * MiB;
constexpr size_t WS_Y = WS_BIG;
constexpr size_t WS_P1 = WS_BIG;
constexpr size_t WS_DT = WS_BIG + 153 * MiB;
constexpr size_t WS_U = WS_BIG + 156 * MiB;
constexpr size_t WS_MIX1 = WS_U;
constexpr size_t WS_ATT1 = WS_BIG + 224 * MiB;
constexpr size_t WS_YS = WS_BIG + 292 * MiB;
constexpr size_t WS_CUMG = WS_BIG + 356 * MiB;
constexpr size_t WS_DTG = WS_BIG + 359 * MiB;
constexpr size_t WS_VT = WS_BIG + 340 * MiB;
constexpr size_t WS_VTB = WS_BIG + 362 * MiB;
constexpr size_t WS_END = WS_BIG + 380 * MiB;
constexpr size_t CTL_MOD = 4096;
constexpr size_t CTL_ROPE = CTL_MOD + 2 * 9 * 6144 * 4;
constexpr size_t CTL_LAM = CTL_ROPE + 64 * 16 * 2 * 4;
constexpr size_t CTL_QC = CTL_LAM + 64;
constexpr size_t CTL_BAR = 512 * 1024;

struct Params {
  const float* in[43];
  float* out;
  unsigned char* ws;
};

enum {
  I_X = 0, I_C, I_CTX, I_CCTX,
  L0_WMOD, L0_BMOD, L0_GPREMIX, L0_GPOSTMIX, L0_GPREFFN, L0_GPOSTFFN, L0_WIN, L0_WOUT,
  L0_LAMQ1, L0_LAMK1, L0_LAMQ2, L0_LAMK2, L0_SUBLN, L0_RPB, L0_WROUTER, L0_WGATE, L0_WUP, L0_WDOWN,
  L1_WMOD, L1_BMOD, L1_GPREMIX, L1_GPOSTMIX, L1_GPREFFN, L1_GPOSTFFN, L1_WIN, L1_WOUT,
  L1_SINKS, L1_CONVW, L1_CONVB, L1_ALOGF, L1_ALOGB, L1_DTBF, L1_DTBB, L1_DSKIP, L1_GNORM,
  L1_WROUTER, L1_WGATE, L1_WUP, L1_WDOWN
};

DEVI int ftid() { int t = threadIdx.x; asm volatile("" : "+v"(t)); return t; }
DEVI float bf2f(bf16_t v) { return __uint_as_float(((unsigned)v) << 16); }
DEVI bf16_t f2bf(float f) { unsigned u = __float_as_uint(f); return (bf16_t)((u + 0x7fffu + ((u >> 16) & 1u)) >> 16); }
DEVI unsigned pk2(float lo, float hi) { return (unsigned)f2bf(lo) | ((unsigned)f2bf(hi) << 16); }
DEVI float silu_f(float v) { return v / (1.f + __expf(-v)); }
DEVI float wave_sum(float v) {
#pragma unroll
  for (int o = 1; o < 64; o <<= 1) v += __shfl_xor(v, o);
  return v;
}
DEVI float wave_max(float v) {
#pragma unroll
  for (int o = 1; o < 64; o <<= 1) v = fmaxf(v, __shfl_xor(v, o));
  return v;
}
DEVI int row_modrow(int r) { return r < NLAT ? (r >> 12) : 8; }
#ifndef QKV0_FP8
#define QKV0_FP8 1
#endif
#ifndef QKV1_FP8
#define QKV1_FP8 0
#endif
namespace nv {

DEVI void transpose_item(const float* W, int K, int N, bf16_t* WT, int row_off, int row_mul, float* scr, int item, int lane, int Npad) {
  const int nblk = Npad / 32, kb = item / nblk, nb = item % nblk, k0 = 64 * kb, n0 = 32 * nb;
  const int n = n0 + (lane & 31); const bool ok = n < N;
  const float* src = W + (size_t)(k0 + (lane >> 5)) * N + (ok ? n : 0);
  float v[32];
#pragma unroll
  for (int i = 0; i < 32; ++i) v[i] = src[(size_t)(2 * i) * N];
#pragma unroll
  for (int i = 0; i < 32; ++i) scr[(2 * i + (lane >> 5)) * 33 + (lane & 31)] = ok ? v[i] : 0.f;
  __builtin_amdgcn_s_waitcnt(0); __builtin_amdgcn_wave_barrier();
  const int c = lane & 7;
#pragma unroll
  for (int j = 0; j < 4; ++j) {
    const int nn = (lane >> 3) + 8 * j; const float* s = scr + (8 * c) * 33 + nn;
    uint4 o; o.x = pk2(s[0 * 33], s[1 * 33]); o.y = pk2(s[2 * 33], s[3 * 33]); o.z = pk2(s[4 * 33], s[5 * 33]); o.w = pk2(s[6 * 33], s[7 * 33]);
    *(uint4*)(WT + (size_t)(row_off + (n0 + nn) * row_mul) * K + k0 + 8 * c) = o;
  }
  __builtin_amdgcn_s_waitcnt(0); __builtin_amdgcn_wave_barrier();
}

DEVI void convert_moe_part(const Params& p, int layer, int which, float* scr, int gw, int NGW, int lane) {
  const float* wg = p.in[layer ? L1_WGATE : L0_WGATE]; const float* wu = p.in[layer ? L1_WUP : L0_WUP]; const float* wd = p.in[layer ? L1_WDOWN : L0_WDOWN];
  bf16_t* WGU = (bf16_t*)(p.ws + WS_WGU); bf16_t* WD = (bf16_t*)(p.ws + WS_WD);
  constexpr int IPM = 16 * 32;
  if (which == 0) {
    for (int it = gw; it < NE * 2 * IPM; it += NGW) {
      const int e = it / (2 * IPM), r = it % (2 * IPM), gu = r / IPM, item = r % IPM;
      transpose_item((gu ? wu : wg) + (size_t)e * DM * DM, DM, DM, WGU + (size_t)e * 2048 * DM, gu, 2, scr, item, lane, DM);
    }
  } else {
    for (int it = gw; it < NE * IPM; it += NGW) {
      const int e = it / IPM, item = it % IPM;
      transpose_item(wd + (size_t)e * DM * DM, DM, DM, WD + (size_t)e * DM * DM, 0, 1, scr, item, lane, DM);
    }
  }
}
DEVI void convert_moe_tail(const Params& p, int layer, int which, float* lds, int nunits) {
  const int first = nunits % (int)gridDim.x;
  if ((int)blockIdx.x < first) return;
  const int w = ftid() >> 6;
  convert_moe_part(p, layer, which, lds + w * (64 * 33), ((int)blockIdx.x - first) * NWAVE + w, ((int)gridDim.x - first) * NWAVE, ftid() & 63);
}


constexpr float W8_SCALE = 64.f, A8_SCALE = 4.f;
constexpr int W8_E8M0 = 0x79797979, A8_E8M0 = 0x7d7d7d7d;
DEVI unsigned pack4_fp8(float a, float b, float c, float d) {
  a = fminf(fmaxf(a, -448.f), 448.f); b = fminf(fmaxf(b, -448.f), 448.f); c = fminf(fmaxf(c, -448.f), 448.f); d = fminf(fmaxf(d, -448.f), 448.f);
  int w = 0; w = __builtin_amdgcn_cvt_pk_fp8_f32(a, b, w, false); w = __builtin_amdgcn_cvt_pk_fp8_f32(c, d, w, true); return (unsigned)w; }
DEVI void transpose_item8(const float* W, int K, int N, unsigned char* WT, int row_off, int row_mul, float* scr, int item, int lane, int Npad = 0) {
  if (Npad == 0) Npad = N;
  const int nblk = Npad / 32, kb = item / nblk, nb = item % nblk, k0 = 64 * kb, n0 = 32 * nb;
  const int nn0 = n0 + (lane & 31); const bool ok = nn0 < N;
  const float* src = W + (size_t)(k0 + (lane >> 5)) * N + (ok ? nn0 : 0);
  float v[32];
#pragma unroll
  for (int i = 0; i < 32; ++i) v[i] = src[(size_t)(2 * i) * N];
#pragma unroll
  for (int i = 0; i < 32; ++i) scr[(2 * i + (lane >> 5)) * 33 + (lane & 31)] = ok ? v[i] * W8_SCALE : 0.f;
  __builtin_amdgcn_s_waitcnt(0); __builtin_amdgcn_wave_barrier();
  const int c = lane & 7;
#pragma unroll
  for (int j = 0; j < 4; ++j) {
    const int nn = (lane >> 3) + 8 * j; const float* s = scr + (8 * c) * 33 + nn;
    uint2 o; o.x = pack4_fp8(s[0 * 33], s[1 * 33], s[2 * 33], s[3 * 33]); o.y = pack4_fp8(s[4 * 33], s[5 * 33], s[6 * 33], s[7 * 33]);
    *(uint2*)(WT + (size_t)(row_off + (n0 + nn) * row_mul) * K + k0 + 8 * c) = o;
  }
  __builtin_amdgcn_s_waitcnt(0); __builtin_amdgcn_wave_barrier();
}
DEVI void convert_moe_part8(const Params& p, int layer, int which, float* scr, int gw, int NGW, int lane) {
  const float* wg = p.in[layer ? L1_WGATE : L0_WGATE]; const float* wu = p.in[layer ? L1_WUP : L0_WUP]; const float* wd = p.in[layer ? L1_WDOWN : L0_WDOWN];
  unsigned char* WGU = (unsigned char*)(p.ws + WS_WGU); unsigned char* WD = (unsigned char*)(p.ws + WS_WD);
  constexpr int IPM = 16 * 32;
  if (which == 0) {
    for (int it = gw; it < NE * 2 * IPM; it += NGW) { const int e = it / (2 * IPM), r = it % (2 * IPM), gu = r / IPM, item = r % IPM;
      transpose_item8((gu ? wu : wg) + (size_t)e * DM * DM, DM, DM, WGU + (size_t)e * 2048 * DM, gu, 2, scr, item, lane); }
  } else {
    for (int it = gw; it < NE * IPM; it += NGW) { const int e = it / IPM, item = it % IPM;
      transpose_item8(wd + (size_t)e * DM * DM, DM, DM, WD + (size_t)e * DM * DM, 0, 1, scr, item, lane); }
  }
}
DEVI void convert_moe_tail8(const Params& p, int layer, int which, float* lds, int nunits) {
  const int first = nunits % (int)gridDim.x;
  if ((int)blockIdx.x < first) return;
  const int w = ftid() >> 6;
  convert_moe_part8(p, layer, which, lds + w * (64 * 33), ((int)blockIdx.x - first) * NWAVE + w, ((int)gridDim.x - first) * NWAVE, ftid() & 63);
}

DEVI void phase0(const Params& p, float* lds) {
  const int tid = ftid(), lane = tid & 63, wave = tid >> 6;
  const int gw = blockIdx.x * NWAVE + wave, NGW = gridDim.x * NWAVE;
  for (int it = blockIdx.x; it < 2 * 96; it += gridDim.x) {
    const int layer = it / 96, j0 = (it % 96) * 64;
    float* sc = lds;
    float* red = lds + 9 * 1024;
    __syncthreads();
    for (int i = tid; i < 9 * 1024; i += NT) { const int r = i >> 10, k = i & 1023; const float v = (r < 8) ? p.in[I_C][r * 1024 + k] : p.in[I_CCTX][k]; sc[i] = silu_f(v); }
    __syncthreads();
    const float* wm = p.in[layer ? L1_WMOD : L0_WMOD];
    float acc[9];
#pragma unroll
    for (int r = 0; r < 9; ++r) acc[r] = 0.f;
    for (int k0 = wave * 128; k0 < wave * 128 + 128; k0 += 16) {
      float w[16];
#pragma unroll
      for (int i = 0; i < 16; ++i) w[i] = wm[(size_t)(k0 + i) * 6144 + j0 + lane];
#pragma unroll
      for (int i = 0; i < 16; ++i)
#pragma unroll
        for (int r = 0; r < 9; ++r) acc[r] += sc[r * 1024 + k0 + i] * w[i];
    }
#pragma unroll
    for (int r = 0; r < 9; ++r) red[(wave * 9 + r) * 64 + lane] = acc[r];
    __syncthreads();
    for (int i = tid; i < 9 * 64; i += NT) {
      const int r = i >> 6, c = i & 63; float s = 0.f;
      for (int w = 0; w < 8; ++w) s += red[(w * 9 + r) * 64 + c];
      float* MOD = (float*)(p.ws + WS_CTL + CTL_MOD);
      MOD[(layer * 9 + r) * 6144 + j0 + c] = s + p.in[layer ? L1_BMOD : L0_BMOD][j0 + c];
    }
    __syncthreads();
  }
  if (blockIdx.x == gridDim.x - 1) {
    float* ROPE = (float*)(p.ws + WS_CTL + CTL_ROPE);
    for (int i = tid; i < 64 * 16; i += NT) {
      const int pos = i >> 4, f = i & 15;
      const float inv = powf(10000.f, -(float)f / 16.f);
      const float ang = (float)pos * inv;
      ROPE[2 * i] = cosf(ang); ROPE[2 * i + 1] = sinf(ang);
    }
    if (wave == 0) {
      float a = p.in[L0_LAMQ1][lane] * p.in[L0_LAMK1][lane], b = p.in[L0_LAMQ2][lane] * p.in[L0_LAMK2][lane];
      a = wave_sum(a); b = wave_sum(b);
      if (lane == 0) { float* LAM = (float*)(p.ws + WS_CTL + CTL_LAM); LAM[0] = expf(a) - expf(b) + 0.2f; *(int*)(p.ws + WS_CTL + CTL_QC) = 0; }
    }
  }
  __syncthreads();
  float* scr = lds + wave * (64 * 33);
  {
    constexpr int I_IN0 = 16 * (N_IN0 / 32), I_OUT = 16 * 32, I_IN1 = 16 * (N_IN1P / 32);
    constexpr int NITEMS = I_IN0 + I_OUT + I_IN1 + I_OUT;
    for (int it = gw; it < NITEMS; it += NGW) {
      int r = it;
      if (r < I_IN0) { if (QKV0_FP8) transpose_item8(p.in[L0_WIN], DM, N_IN0, (unsigned char*)(p.ws + WS_WIN0), 0, 1, scr, r, lane); else transpose_item(p.in[L0_WIN], DM, N_IN0, (bf16_t*)(p.ws + WS_WIN0), 0, 1, scr, r, lane, N_IN0); continue; } r -= I_IN0;
      if (r < I_OUT) { transpose_item(p.in[L0_WOUT], DM, DM, (bf16_t*)(p.ws + WS_WOUT0), 0, 1, scr, r, lane, DM); continue; } r -= I_OUT;
      if (r < I_IN1) { if (QKV1_FP8) transpose_item8(p.in[L1_WIN], DM, N_IN1, (unsigned char*)(p.ws + WS_WIN1), 0, 1, scr, r, lane, N_IN1P); else transpose_item(p.in[L1_WIN], DM, N_IN1, (bf16_t*)(p.ws + WS_WIN1), 0, 1, scr, r, lane, N_IN1P); continue; } r -= I_IN1;
      transpose_item(p.in[L1_WOUT], DM, DM, (bf16_t*)(p.ws + WS_WOUT1), 0, 1, scr, r, lane, DM);
    }
  }
  convert_moe_part8(p, 0, 0, scr, gw, NGW, lane);
#ifndef TAILFILL
  convert_moe_part8(p, 0, 1, scr, gw, NGW, lane);
#endif
}

struct Row16 { float4 v[4]; };
DEVI Row16 ld_row_f32(const float* r, int lane) { Row16 o; const float4* q = (const float4*)r + lane;
#pragma unroll
  for (int j = 0; j < 4; ++j) o.v[j] = q[64 * j]; return o; }
DEVI Row16 ld_row_bf16(const bf16_t* r, int lane) { Row16 o; const uint2* q = (const uint2*)r + lane;
#pragma unroll
  for (int j = 0; j < 4; ++j) { const uint2 w = q[64 * j]; o.v[j] = make_float4(__uint_as_float(w.x << 16), __uint_as_float(w.x & 0xffff0000u), __uint_as_float(w.y << 16), __uint_as_float(w.y & 0xffff0000u)); }
  return o; }
DEVI void st_row_f32(float* r, int lane, const Row16& o) { float4* q = (float4*)r + lane;
#pragma unroll
  for (int j = 0; j < 4; ++j) q[64 * j] = o.v[j]; }
DEVI void st_row_bf16(bf16_t* r, int lane, const Row16& o) { uint2* q = (uint2*)r + lane;
#pragma unroll
  for (int j = 0; j < 4; ++j) q[64 * j] = make_uint2(pk2(o.v[j].x, o.v[j].y), pk2(o.v[j].z, o.v[j].w)); }
DEVI float row_sumsq(const Row16& o) { float s = 0.f;
#pragma unroll
  for (int j = 0; j < 4; ++j) s += o.v[j].x * o.v[j].x + o.v[j].y * o.v[j].y + o.v[j].z * o.v[j].z + o.v[j].w * o.v[j].w;
  return wave_sum(s); }
#define ROW_FOR4(expr) _Pragma("unroll") for (int j = 0; j < 4; ++j) { { float& e = o.v[j].x; const float a = A.v[j].x, b = Bv.v[j].x, c = Cv.v[j].x; expr; } { float& e = o.v[j].y; const float a = A.v[j].y, b = Bv.v[j].y, c = Cv.v[j].y; expr; } { float& e = o.v[j].z; const float a = A.v[j].z, b = Bv.v[j].z, c = Cv.v[j].z; expr; } { float& e = o.v[j].w; const float a = A.v[j].w, b = Bv.v[j].w, c = Cv.v[j].w; expr; } }

DEVI Row16 norm_mod(const Row16& x, const float* g, const float* sc, const float* sh, int lane) {
  const float r = rsqrtf(row_sumsq(x) * (1.f / DM) + EPS);
  Row16 o = x; const Row16 A = ld_row_f32(g, lane), Bv = ld_row_f32(sc, lane), Cv = ld_row_f32(sh, lane);
  ROW_FOR4(e = e * r * a * (1.f + b) + c);
  return o;
}

DEVI void phase_prenorm0(const Params& p) {
  const int lane = ftid() & 63, gw = blockIdx.x * NWAVE + (ftid() >> 6), NGW = gridDim.x * NWAVE;
  const float* MOD = (const float*)(p.ws + WS_CTL + CTL_MOD);
  bf16_t* H = (bf16_t*)(p.ws + WS_H);
  for (int r = gw; r < NROW; r += NGW) {
    const float* src = r < NLAT ? p.in[I_X] + (size_t)r * DM : p.in[I_CTX] + (size_t)(r - NLAT) * DM;
    const float* m = MOD + (size_t)row_modrow(r) * 6144;
    const Row16 x = ld_row_f32(src, lane);
    const Row16 h = norm_mod(x, p.in[L0_GPREMIX], m + 1024, m, lane);
    st_row_bf16(H + (size_t)r * DM, lane, h);
  }
}

template <class AF, class EF>
DEVI void gemm_tile(float* lds, const bf16_t* Bt, int n0, int K, AF arow, EF epi) {
  const int tid = ftid(), ty = tid >> 4, tx = tid & 15;
  float (*As)[132] = (float (*)[132])lds;
  float (*Bs)[68] = (float (*)[68])(lds + 16 * 132);
  float acc[4][4];
#pragma unroll
  for (int i = 0; i < 4; ++i)
#pragma unroll
    for (int j = 0; j < 4; ++j) acc[i][j] = 0.f;
  const int ar = tid >> 2, ak = (tid & 3) * 4;
  const int br = tid >> 3, bk = (tid & 7) * 2;
  const bf16_t* ap = arow(ar) + ak;
  const bf16_t* bp = Bt + (size_t)(n0 + br) * K + bk;
  for (int k0 = 0; k0 < K; k0 += 16) {
    const uint2 av = *(const uint2*)(ap + k0);
    const unsigned bv = *(const unsigned*)(bp + k0);
    __syncthreads();
    As[ak + 0][ar] = __uint_as_float(av.x << 16); As[ak + 1][ar] = __uint_as_float(av.x & 0xffff0000u);
    As[ak + 2][ar] = __uint_as_float(av.y << 16); As[ak + 3][ar] = __uint_as_float(av.y & 0xffff0000u);
    Bs[bk + 0][br] = __uint_as_float(bv << 16); Bs[bk + 1][br] = __uint_as_float(bv & 0xffff0000u);
    __syncthreads();
#pragma unroll
    for (int kk = 0; kk < 16; ++kk) {
      const float4 a = *(const float4*)&As[kk][ty * 4]; const float4 b = *(const float4*)&Bs[kk][tx * 4];
      const float aa[4] = {a.x, a.y, a.z, a.w}, bb[4] = {b.x, b.y, b.z, b.w};
#pragma unroll
      for (int i = 0; i < 4; ++i)
#pragma unroll
        for (int j = 0; j < 4; ++j) acc[i][j] += aa[i] * bb[j];
    }
  }
#pragma unroll
  for (int i = 0; i < 4; ++i) epi(ty * 4 + i, n0 + tx * 4, acc[i]);
}

DEVI void rope_pair(const float* ROPE, int t, int d, float& u1, float& u2) {
  const int i = d >> 1, f = i & 15, pos = (i < 16) ? (t >> 6) : (t & 63);
  const float cs = ROPE[(pos * 16 + f) * 2], sn = ROPE[(pos * 16 + f) * 2 + 1];
  const float a = u1 * cs - u2 * sn, b = u1 * sn + u2 * cs; u1 = a; u2 = b;
}

DEVI void phase_qkv0(const Params& p, float* lds) {
  const bf16_t* H = (const bf16_t*)(p.ws + WS_H); const bf16_t* W = (const bf16_t*)(p.ws + WS_WIN0);
  bf16_t* Q = (bf16_t*)(p.ws + WS_QKV0); const float* ROPE = (const float*)(p.ws + WS_CTL + CTL_ROPE);
  constexpr int NTN = N_IN0 / 64, NTM = NROW / 128;
  for (int it = blockIdx.x; it < NTN * NTM; it += gridDim.x) {
    const int mt = it / NTN, nt = it % NTN, m0 = mt * 128;
    gemm_tile(lds, W, nt * 64, DM,
      [&](int r) { return H + (size_t)(m0 + r) * DM; },
      [&](int r, int n, float* v) {
        const int row = m0 + r;
        if (row < NLAT && n < 1024) { const int t = row & 4095; rope_pair(ROPE, t, n & 63, v[0], v[1]); rope_pair(ROPE, t, (n + 2) & 63, v[2], v[3]); }
        *(uint2*)(Q + (size_t)row * N_IN0 + n) = make_uint2(pk2(v[0], v[1]), pk2(v[2], v[3]));
      });
  }
}

template <int NS, int VJ, class KF>
DEVI void wave_attn(const float* qs, float* pl  , int* rl  , int nkeys, KF kf, const bf16_t* KV, int ld, int kcol, int vcol,
                    float sink, bool has_sink, float (&o)[NS][VJ], float (&m)[NS], float (&l)[NS], int lane) {
#pragma unroll
  for (int s = 0; s < NS; ++s) { m[s] = -INFINITY; l[s] = 0.f;
#pragma unroll
    for (int j = 0; j < VJ; ++j) o[s][j] = 0.f; }
  for (int c0 = 0; c0 < nkeys; c0 += 64) {
    const int kidx = c0 + lane; int row = -1; float bias = 0.f;
    bool valid = kidx < nkeys; if (valid) valid = kf(kidx, row, bias);
    const int rr = valid ? row : 0;
    rl[lane] = valid ? row : -1;
    float sc[NS];
#pragma unroll
    for (int s = 0; s < NS; ++s) {
      const uint4* kp = (const uint4*)(KV + (size_t)rr * ld + kcol + 64 * s); float d = 0.f;
#pragma unroll
      for (int i = 0; i < 8; ++i) { const uint4 w = kp[i]; const float* q = qs + s * 64 + i * 8;
        d += q[0] * __uint_as_float(w.x << 16) + q[1] * __uint_as_float(w.x & 0xffff0000u) + q[2] * __uint_as_float(w.y << 16) + q[3] * __uint_as_float(w.y & 0xffff0000u)
           + q[4] * __uint_as_float(w.z << 16) + q[5] * __uint_as_float(w.z & 0xffff0000u) + q[6] * __uint_as_float(w.w << 16) + q[7] * __uint_as_float(w.w & 0xffff0000u); }
      sc[s] = valid ? d + bias : -INFINITY;
    }
#pragma unroll
    for (int s = 0; s < NS; ++s) {
      const float cm = wave_max(sc[s]); const float mn = fmaxf(m[s], cm);
      float pv = 0.f, scale = 1.f;
      if (mn > -INFINITY) { pv = __expf(sc[s] - mn); scale = __expf(m[s] - mn); }
      l[s] = l[s] * scale + wave_sum(pv); m[s] = mn;
#pragma unroll
      for (int j = 0; j < VJ; ++j) o[s][j] *= scale;
      pl[s * 64 + lane] = pv;
    }
    __builtin_amdgcn_s_waitcnt(0); __builtin_amdgcn_wave_barrier();
    for (int kk = 0; kk < 64; ++kk) {
      const int rk = rl[kk]; if (rk < 0) continue;
      const bf16_t* vp = KV + (size_t)rk * ld + vcol + lane;
      float vv[VJ];
#pragma unroll
      for (int j = 0; j < VJ; ++j) vv[j] = bf2f(vp[64 * j]);
#pragma unroll
      for (int s = 0; s < NS; ++s) { const float pk = pl[s * 64 + kk];
#pragma unroll
        for (int j = 0; j < VJ; ++j) o[s][j] += pk * vv[j]; }
    }
    __builtin_amdgcn_s_waitcnt(0); __builtin_amdgcn_wave_barrier();
  }
  if (has_sink) {
#pragma unroll
    for (int s = 0; s < NS; ++s) { const float mn = fmaxf(m[s], sink); const float scale = __expf(m[s] - mn);
      l[s] = l[s] * scale + __expf(sink - mn); m[s] = mn;
#pragma unroll
      for (int j = 0; j < VJ; ++j) o[s][j] *= scale; }
  }
}

DEVI void phase_attn0(const Params& p, float* lds) {
  const int tid = ftid(), lane = tid & 63, wave = tid >> 6;
  const int gw = blockIdx.x * NWAVE + wave, NGW = gridDim.x * NWAVE;
  const bf16_t* Q = (const bf16_t*)(p.ws + WS_QKV0); bf16_t* ATT = (bf16_t*)(p.ws + WS_ATT0);
  const float lam = ((const float*)(p.ws + WS_CTL + CTL_LAM))[0];
  float* qs = lds + wave * 128; float* pl = lds + 1024 + wave * 128; int* rl = (int*)(lds + 2048) + wave * 64;
  for (long it = gw; it < (long)NROW * 12; it += NGW) {
    const int row = (int)(it / 12), hs = (int)(it % 12);
    const bool lat = row < NLAT; const int b = lat ? (row >> 12) : ((row - NLAT) >> 8), t = lat ? (row & 4095) : 0;
    __builtin_amdgcn_s_waitcnt(0); __builtin_amdgcn_wave_barrier();
    if (hs < 4) {
      const bf16_t* qp = Q + (size_t)row * N_IN0 + hs * 128;
      qs[lane] = bf2f(qp[lane]) * 0.125f; qs[64 + lane] = bf2f(qp[64 + lane]) * 0.125f;
      __builtin_amdgcn_s_waitcnt(0); __builtin_amdgcn_wave_barrier();
      float o[2][2], m[2], l[2];
      const int nkeys = lat ? SEQ + CTXL : CTXL;
      wave_attn<2, 2>(qs, pl, rl, nkeys, [&](int k, int& r, float& bias) { r = lat ? (k < SEQ ? b * SEQ + k : NLAT + b * CTXL + (k - SEQ)) : NLAT + b * CTXL + k; return true; },
                      Q, N_IN0, 512 + hs * 128, 1024 + hs * 128, 0.f, false, o, m, l, lane);
      float v0 = o[0][0] / l[0] - lam * o[1][0] / l[1], v1 = o[0][1] / l[0] - lam * o[1][1] / l[1];
      const float r = rsqrtf(wave_sum(v0 * v0 + v1 * v1) * (1.f / 128.f) + EPS);
      const float* g = p.in[L0_SUBLN];
      ATT[(size_t)row * DM + hs * 128 + lane] = f2bf(v0 * r * g[lane] * 0.8f);
      ATT[(size_t)row * DM + hs * 128 + 64 + lane] = f2bf(v1 * r * g[64 + lane] * 0.8f);
    } else {
      const int h = hs - 4;
      qs[lane] = bf2f(Q[(size_t)row * N_IN0 + 1536 + h * 64 + lane]) * 0.125f;
      __builtin_amdgcn_s_waitcnt(0); __builtin_amdgcn_wave_barrier();
      float o[1][1], m[1], l[1];
      const int qr = t >> 6, qc = t & 63;
      const int rs = min(max(qr - 4, 0), 56), cs = min(max(qc - 8, 0), 48);
      const float* rpb = p.in[L0_RPB] + h * 15 * 31;
      const int nkeys = lat ? 128 + CTXL : CTXL;
      wave_attn<1, 1>(qs, pl, rl, nkeys, [&](int k, int& r, float& bias) {
          if (!lat) { r = NLAT + b * CTXL + k; return true; }
          if (k < 128) { const int kr = rs + (k >> 4), kc = cs + (k & 15); r = b * SEQ + kr * 64 + kc; bias = rpb[(kr - qr + 7) * 31 + (kc - qc + 15)]; }
          else r = NLAT + b * CTXL + (k - 128);
          return true; },
        Q, N_IN0, 2048 + h * 64, 2560 + h * 64, 0.f, false, o, m, l, lane);
      ATT[(size_t)row * DM + 512 + h * 64 + lane] = f2bf(o[0][0] / l[0]);
    }
  }
}

DEVI void phase_outproj(const Params& p, float* lds, int layer) {
  const bf16_t* A = (const bf16_t*)(p.ws + (layer ? WS_ATT1 : WS_ATT0)); const bf16_t* W = (const bf16_t*)(p.ws + (layer ? WS_WOUT1 : WS_WOUT0));
  bf16_t* MIX = (bf16_t*)(p.ws + (layer ? WS_MIX1 : WS_MIX0));
  const int NTM = (layer ? NLAT : NROW) / 128; constexpr int NTN = DM / 64;
  for (int it = blockIdx.x; it < NTN * NTM; it += gridDim.x) {
    const int mt = it / NTN, nt = it % NTN, m0 = mt * 128;
    gemm_tile(lds, W, nt * 64, DM, [&](int r) { return A + (size_t)(m0 + r) * DM; },
      [&](int r, int n, float* v) { *(uint2*)(MIX + (size_t)(m0 + r) * DM + n) = make_uint2(pk2(v[0], v[1]), pk2(v[2], v[3])); });
  }
}

DEVI void phase_postmix(const Params& p, int layer) {
  const int lane = ftid() & 63, gw = blockIdx.x * NWAVE + (ftid() >> 6), NGW = gridDim.x * NWAVE;
  const float* MOD = (const float*)(p.ws + WS_CTL + CTL_MOD) + (size_t)layer * 9 * 6144;
  const bf16_t* MIX = (const bf16_t*)(p.ws + (layer ? WS_MIX1 : WS_MIX0));
  bf16_t* H = (bf16_t*)(p.ws + WS_H); float* AFF = (float*)(p.ws + WS_AFF); float* XC = (float*)(p.ws + WS_XC);
  const float* gpost = p.in[layer ? L1_GPOSTMIX : L0_GPOSTMIX]; const float* gpre = p.in[layer ? L1_GPREFFN : L0_GPREFFN];
  const float* wr = p.in[layer ? L1_WROUTER : L0_WROUTER];
  const int nrow = layer ? NLAT : NROW;
  for (int r = gw; r < nrow; r += NGW) {
    const float* m = MOD + (size_t)row_modrow(r) * 6144;
    const float* xin = layer ? (p.out + (size_t)r * DM) : (r < NLAT ? p.in[I_X] + (size_t)r * DM : p.in[I_CTX] + (size_t)(r - NLAT) * DM);
    float* xout = r < NLAT ? p.out + (size_t)r * DM : XC + (size_t)(r - NLAT) * DM;
    Row16 o = ld_row_bf16(MIX + (size_t)r * DM, lane);
    const float rr = rsqrtf(row_sumsq(o) * (1.f / DM) + EPS);
    { const Row16 A = ld_row_f32(gpost, lane), Bv = ld_row_f32(m + 2048, lane), Cv = ld_row_f32(xin, lane);
      ROW_FOR4(e = c + b * (e * rr * a)); }
    st_row_f32(xout, lane, o);
    const Row16 h = norm_mod(o, gpre, m + 4096, m + 3072, lane);
    st_row_bf16(H + (size_t)r * DM, lane, h);
    float lg[16];
#pragma unroll
    for (int e = 0; e < 16; ++e) lg[e] = 0.f;
#pragma unroll
    for (int j = 0; j < 4; ++j) {
      const float hv[4] = {h.v[j].x, h.v[j].y, h.v[j].z, h.v[j].w};
#pragma unroll
      for (int q = 0; q < 4; ++q) { const float4* w4 = (const float4*)(wr + (size_t)(lane * 4 + 256 * j + q) * 16);
#pragma unroll
        for (int e4 = 0; e4 < 4; ++e4) { const float4 w = w4[e4]; lg[e4 * 4] += hv[q] * w.x; lg[e4 * 4 + 1] += hv[q] * w.y; lg[e4 * 4 + 2] += hv[q] * w.z; lg[e4 * 4 + 3] += hv[q] * w.w; } }
    }
    float mx = -INFINITY;
#pragma unroll
    for (int e = 0; e < 16; ++e) { lg[e] = wave_sum(lg[e]); mx = fmaxf(mx, lg[e]); }
    float s = 0.f;
#pragma unroll
    for (int e = 0; e < 16; ++e) { lg[e] = expf(lg[e] - mx); s += lg[e]; }
    const float inv = 1.f / s;
    float mine = 0.f;
#pragma unroll
    for (int e = 0; e < 16; ++e) if (lane == e) mine = lg[e] * inv;
    if (lane < 16) AFF[(size_t)lane * NROW + r] = mine;
  }
}

DEVI void phase_topk(const Params& p, float* lds, int layer) {
  const int tid = ftid();
  const float* AFF = (const float*)(p.ws + WS_AFF); int* SLOT = (int*)(p.ws + WS_SLOT); int* IDX = (int*)(p.ws + WS_IDX); float* GV = (float*)(p.ws + WS_GATEV);
  const int erows = layer ? EROWS1 : EROWS0;
  const int nlat_items = NB * NE * 8, nitems = nlat_items + (layer ? 0 : NB * NE);
  for (int it = blockIdx.x; it < nitems; it += gridDim.x) {
    const bool lat = it < nlat_items;
    int b, e, ch, n, cap, row0, slot0;
    if (lat) { b = it / (NE * 8); e = (it / 8) % NE; ch = it % 8; n = SEQ; cap = CAP_L; row0 = b * SEQ; slot0 = b * CAP_L; }
    else { const int i2 = it - nlat_items; b = i2 / NE; e = i2 % NE; ch = 0; n = CTXL; cap = CAP_C; row0 = NLAT + b * CTXL; slot0 = NB * CAP_L + b * CAP_C; }
    __syncthreads();
    for (int i = tid; i < n; i += NT) lds[i] = AFF[(size_t)e * NROW + row0 + i];
    __syncthreads();
    const int t = ch * 512 + tid;
    if (t < n) {
      const float a = lds[t]; int rank = 0;
      for (int j = 0; j < n; ++j) { const float v = lds[j]; rank += (v > a || (v == a && j < t)) ? 1 : 0; }
      if (rank < cap) { IDX[e * erows + slot0 + rank] = row0 + t; GV[e * erows + slot0 + rank] = a; SLOT[(size_t)(row0 + t) * 16 + e] = slot0 + rank; }
      else SLOT[(size_t)(row0 + t) * 16 + e] = -1;
    }
  }
}

DEVI void phase_moe_up(const Params& p, float* lds, int layer) {
  const bf16_t* H = (const bf16_t*)(p.ws + WS_H); const bf16_t* WGU = (const bf16_t*)(p.ws + WS_WGU); bf16_t* HID = (bf16_t*)(p.ws + WS_HID);
  const int* IDX = (const int*)(p.ws + WS_IDX);
  const int erows = layer ? EROWS1 : EROWS0, NTM = erows / 128; constexpr int NTN = 2048 / 64;
  for (int it = blockIdx.x; it < NE * NTM * NTN; it += gridDim.x) {
    const int e = it / (NTM * NTN), r2 = it % (NTM * NTN), mt = r2 / NTN, nt = r2 % NTN, m0 = mt * 128;
    gemm_tile(lds, WGU + (size_t)e * 2048 * DM, nt * 64, DM, [&](int r) { return H + (size_t)IDX[e * erows + m0 + r] * DM; },
      [&](int r, int n, float* v) { *(unsigned*)(HID + ((size_t)e * erows + m0 + r) * DM + (n >> 1)) = pk2(silu_f(v[0]) * v[1], silu_f(v[2]) * v[3]); });
  }
}
DEVI void phase_moe_down(const Params& p, float* lds, int layer) {
  const bf16_t* HID = (const bf16_t*)(p.ws + WS_HID); const bf16_t* WD = (const bf16_t*)(p.ws + WS_WD); bf16_t* Y = (bf16_t*)(p.ws + WS_Y);
  const float* GV = (const float*)(p.ws + WS_GATEV);
  const int erows = layer ? EROWS1 : EROWS0, NTM = erows / 128; constexpr int NTN = DM / 64;
  for (int it = blockIdx.x; it < NE * NTM * NTN; it += gridDim.x) {
    const int e = it / (NTM * NTN), r2 = it % (NTM * NTN), mt = r2 / NTN, nt = r2 % NTN, m0 = mt * 128;
    gemm_tile(lds, WD + (size_t)e * DM * DM, nt * 64, DM, [&](int r) { return HID + ((size_t)e * erows + m0 + r) * DM; },
      [&](int r, int n, float* v) { const float g = GV[e * erows + m0 + r];
        *(uint2*)(Y + ((size_t)e * erows + m0 + r) * DM + n) = make_uint2(pk2(v[0] * g, v[1] * g), pk2(v[2] * g, v[3] * g)); });
  }
}

DEVI void phase_combine(const Params& p, float* lds, int layer) {
  const int lane = ftid() & 63, wave = ftid() >> 6, gw = blockIdx.x * NWAVE + wave, NGW = gridDim.x * NWAVE;
  const float* MOD = (const float*)(p.ws + WS_CTL + CTL_MOD);
  const bf16_t* Y = (const bf16_t*)(p.ws + WS_Y); const int* SLOT = (const int*)(p.ws + WS_SLOT);
  bf16_t* H = (bf16_t*)(p.ws + WS_H); float* XC = (float*)(p.ws + WS_XC);
  const float* gpost = p.in[layer ? L1_GPOSTFFN : L0_GPOSTFFN];
  const int nrow = layer ? NLAT : NROW, erows = layer ? EROWS1 : EROWS0;
  for (int r = gw; r < nrow; r += NGW) {
    const float* m = MOD + (size_t)(layer * 9 + row_modrow(r)) * 6144;
    float* xio = r < NLAT ? p.out + (size_t)r * DM : XC + (size_t)(r - NLAT) * DM;
    Row16 o;
#pragma unroll
    for (int j = 0; j < 4; ++j) o.v[j] = make_float4(0.f, 0.f, 0.f, 0.f);
    for (int e = 0; e < NE; ++e) {
      const int s = SLOT[(size_t)r * 16 + e];
      if (s >= 0) { const Row16 y = ld_row_bf16(Y + ((size_t)e * erows + s) * DM, lane);
#pragma unroll
        for (int j = 0; j < 4; ++j) { o.v[j].x += y.v[j].x; o.v[j].y += y.v[j].y; o.v[j].z += y.v[j].z; o.v[j].w += y.v[j].w; } }
    }
    const float rr = rsqrtf(row_sumsq(o) * (1.f / DM) + EPS);
    { const Row16 A = ld_row_f32(gpost, lane), Bv = ld_row_f32(m + 5120, lane), Cv = ld_row_f32(xio, lane);
      ROW_FOR4(e = c + b * (e * rr * a)); }
    st_row_f32(xio, lane, o);
    if (layer == 0) {
      const float* m1 = MOD + (size_t)(9 + row_modrow(r)) * 6144;
      const Row16 h = norm_mod(o, p.in[L1_GPREMIX], m1 + 1024, m1, lane);
      st_row_bf16(H + (size_t)r * DM, lane, h);
    }
  }
  if (layer == 0) { convert_moe_part(p, 1, 0, lds + wave * (64 * 33), gw, NGW, lane); convert_moe_part(p, 1, 1, lds + wave * (64 * 33), gw, NGW, lane); }
}

DEVI void phase_qkv1(const Params& p, float* lds) {
  const bf16_t* H = (const bf16_t*)(p.ws + WS_H); const bf16_t* W = (const bf16_t*)(p.ws + WS_WIN1);
  bf16_t* P1 = (bf16_t*)(p.ws + WS_P1); float* DT = (float*)(p.ws + WS_DT); const float* ROPE = (const float*)(p.ws + WS_CTL + CTL_ROPE);
  constexpr int NTN = 37, NTM = NROW / 128;
  for (int it = blockIdx.x; it < NTN * NTM; it += gridDim.x) {
    const int mt = it / NTN, nt = it % NTN, m0 = mt * 128;
    gemm_tile(lds, W, nt * 64, DM, [&](int r) { return H + (size_t)(m0 + r) * DM; },
      [&](int r, int n, float* v) {
        const int row = m0 + r;
        if (n >= 2304) { if (n < 2320) *(float4*)(DT + (size_t)row * 16 + (n - 2304)) = make_float4(v[0], v[1], v[2], v[3]); return; }
        if (row < NLAT && n < 640) { const int t = row & 4095; rope_pair(ROPE, t, n & 63, v[0], v[1]); rope_pair(ROPE, t, (n + 2) & 63, v[2], v[3]); }
        *(uint2*)(P1 + (size_t)row * 2304 + n) = make_uint2(pk2(v[0], v[1]), pk2(v[2], v[3]));
      });
  }
}

DEVI void phase_conv_swa(const Params& p, float* lds, bool do_swa) {
  const int tid = ftid(), lane = tid & 63, wave = tid >> 6;
  const int gw = blockIdx.x * NWAVE + wave, NGW = gridDim.x * NWAVE;
  const bf16_t* P1 = (const bf16_t*)(p.ws + WS_P1); bf16_t* U = (bf16_t*)(p.ws + WS_U); bf16_t* ATT = (bf16_t*)(p.ws + WS_ATT1);
  const float* cw = p.in[L1_CONVW]; const float* cb = p.in[L1_CONVB];
  for (long i = (long)blockIdx.x * NT + tid; i < (long)NROW * 1024; i += (long)gridDim.x * NT) {
    const int row = (int)(i >> 10), ch = (int)(i & 1023);
    int s0, len, t; if (row < NLAT) { s0 = row & ~4095; len = SEQ; t = row & 4095; } else { s0 = NLAT + ((row - NLAT) & ~255); len = CTXL; t = (row - NLAT) & 255; }
    float acc = cb[ch];
#pragma unroll
    for (int j = 0; j < 5; ++j) { const int tt = t + j - 2; if (tt >= 0 && tt < len) acc += cw[j * 1024 + ch] * bf2f(P1[(size_t)(s0 + tt) * 2304 + 768 + ch]); }
    U[(size_t)row * 1024 + ch] = f2bf(silu_f(acc));
  }
  if (!do_swa) return;
  float* qs = lds + wave * 128; float* pl = lds + 1024 + wave * 128; int* rl = (int*)(lds + 2048) + wave * 64;
  for (long it = gw; it < (long)NLAT * 8; it += NGW) {
    const int row = (int)(it >> 3), hq = (int)(it & 7), g = hq >> 2, b = row >> 12, t = row & 4095;
    __builtin_amdgcn_s_waitcnt(0); __builtin_amdgcn_wave_barrier();
    qs[lane] = bf2f(P1[(size_t)row * 2304 + hq * 64 + lane]) * 0.125f;
    __builtin_amdgcn_s_waitcnt(0); __builtin_amdgcn_wave_barrier();
    float o[1][1], m[1], l[1];
    wave_attn<1, 1>(qs, pl, rl, 320 + CTXL, [&](int k, int& r, float& bias) {
        if (k < 320) { const int kp = t - 128 + k; if (k > 256 || kp < 0 || kp >= SEQ) return false; r = b * SEQ + kp; return true; }
        r = NLAT + b * CTXL + (k - 320); return true; },
      P1, 2304, 512 + g * 64, 640 + g * 64, p.in[L1_SINKS][hq], true, o, m, l, lane);
    ATT[(size_t)row * DM + hq * 64 + lane] = f2bf(o[0][0] / l[0]);
  }
}

DEVI void phase_ssd(const Params& p, float* lds) {
  const int tid = ftid();
  const bf16_t* U = (const bf16_t*)(p.ws + WS_U); const float* DT = (const float*)(p.ws + WS_DT); float* YS = (float*)(p.ws + WS_YS);
  constexpr int CH = 32;
  float* xb = lds;
  float* bb = lds + CH * 64;
  float* cb = bb + CH * 128;
  float* db = cb + CH * 128;
  float* yb = db + 2 * CH;
  const int pi = tid >> 3, ns = (tid & 7) * 16;
  for (int it = blockIdx.x; it < NB * 8; it += gridDim.x) {
    const int b = it >> 3, hd = it & 7, g = hd >> 2;
    for (int dir = 0; dir < 2; ++dir) {
      const float a = -expf(p.in[dir ? L1_ALOGB : L1_ALOGF][hd]); const float dtb = p.in[dir ? L1_DTBB : L1_DTBF][hd];
      float st[16];
#pragma unroll
      for (int i = 0; i < 16; ++i) st[i] = 0.f;
      for (int seg = 0; seg < 2; ++seg) {
        const int len = seg ? SEQ : CTXL, s0 = seg ? b * SEQ : NLAT + b * CTXL;
        for (int c0 = 0; c0 < len; c0 += CH) {
          __syncthreads();
          for (int i = tid; i < CH * 320; i += NT) {
            const int st_i = i / 320, c = i % 320; const int tk = dir ? (len - 1 - (c0 + st_i)) : (c0 + st_i); const size_t r = (size_t)(s0 + tk);
            if (c < 64) xb[st_i * 64 + c] = bf2f(U[r * 1024 + hd * 64 + c]);
            else if (c < 192) bb[st_i * 128 + (c - 64)] = bf2f(U[r * 1024 + 512 + g * 128 + (c - 64)]);
            else cb[st_i * 128 + (c - 192)] = bf2f(U[r * 1024 + 768 + g * 128 + (c - 192)]);
          }
          if (tid < CH) { const int tk = dir ? (len - 1 - (c0 + tid)) : (c0 + tid); const float raw = DT[(size_t)(s0 + tk) * 16 + dir * 8 + hd] + dtb;
            const float dt = raw > 20.f ? raw : log1pf(expf(raw)); db[tid] = expf(dt * a); db[CH + tid] = dt; }
          __syncthreads();
          for (int i = 0; i < CH; ++i) {
            const float dec = db[i], dx = db[CH + i] * xb[i * 64 + pi]; float y = 0.f;
#pragma unroll
            for (int q = 0; q < 16; ++q) { st[q] = st[q] * dec + dx * bb[i * 128 + ns + q]; y += st[q] * cb[i * 128 + ns + q]; }
            y += __shfl_xor(y, 1); y += __shfl_xor(y, 2); y += __shfl_xor(y, 4);
            if ((tid & 7) == 0) yb[i * 64 + pi] = y;
          }
          __syncthreads();
          if (seg == 1) for (int i = tid; i < CH * 64; i += NT) {
            const int q = i >> 6, c = i & 63; const int tk = (dir ? (len - CH - c0) : c0) + q, st_i = dir ? (CH - 1 - q) : q;
            float* yp = YS + (size_t)(b * SEQ + tk) * 512 + hd * 64 + c;
            if (dir == 0) *yp = yb[st_i * 64 + c]; else *yp = *yp + yb[st_i * 64 + c];
          }
        }
      }
      __syncthreads(); __threadfence();
    }
  }
}

DEVI void phase_ssd_out(const Params& p) {
  const int lane = ftid() & 63, gw = blockIdx.x * NWAVE + (ftid() >> 6), NGW = gridDim.x * NWAVE;
  const bf16_t* U = (const bf16_t*)(p.ws + WS_U); const bf16_t* P1 = (const bf16_t*)(p.ws + WS_P1); const float* YS = (const float*)(p.ws + WS_YS);
  bf16_t* ATT = (bf16_t*)(p.ws + WS_ATT1);
  for (int r = gw; r < NLAT; r += NGW) {
    const int c0 = lane * 8, hd = c0 >> 6; const float dsk = p.in[L1_DSKIP][hd];
    const float4 y0 = *(const float4*)(YS + (size_t)r * 512 + c0), y1 = *(const float4*)(YS + (size_t)r * 512 + c0 + 4);
    const uint4 xw = *(const uint4*)(U + (size_t)r * 1024 + c0), zw = *(const uint4*)(P1 + (size_t)r * 2304 + 1792 + c0);
    float y[8] = {y0.x, y0.y, y0.z, y0.w, y1.x, y1.y, y1.z, y1.w};
    const unsigned xs[4] = {xw.x, xw.y, xw.z, xw.w}, zs[4] = {zw.x, zw.y, zw.z, zw.w};
    float ss = 0.f;
#pragma unroll
    for (int i = 0; i < 4; ++i) {
      const float x0 = __uint_as_float(xs[i] << 16), x1 = __uint_as_float(xs[i] & 0xffff0000u), z0 = __uint_as_float(zs[i] << 16), z1 = __uint_as_float(zs[i] & 0xffff0000u);
      y[2 * i] = (y[2 * i] + dsk * x0) * silu_f(z0); y[2 * i + 1] = (y[2 * i + 1] + dsk * x1) * silu_f(z1);
      ss += y[2 * i] * y[2 * i] + y[2 * i + 1] * y[2 * i + 1];
    }
#pragma unroll
    for (int o = 1; o < 32; o <<= 1) ss += __shfl_xor(ss, o);
    const float rr = rsqrtf(ss * (1.f / 256.f) + EPS);
    const float4 g0 = *(const float4*)(p.in[L1_GNORM] + c0), g1 = *(const float4*)(p.in[L1_GNORM] + c0 + 4);
    uint4 w; w.x = pk2(y[0] * rr * g0.x, y[1] * rr * g0.y); w.y = pk2(y[2] * rr * g0.z, y[3] * rr * g0.w); w.z = pk2(y[4] * rr * g1.x, y[5] * rr * g1.y); w.w = pk2(y[6] * rr * g1.z, y[7] * rr * g1.w);
    *(uint4*)(ATT + (size_t)r * DM + 512 + c0) = w;
  }
}

}
namespace pg8 {
#define PG8_LAS __attribute__((address_space(3)))
typedef unsigned short bf16_t;
typedef short bf16x8 __attribute__((ext_vector_type(8)));
typedef float f32x4 __attribute__((ext_vector_type(4)));
typedef unsigned u32x4 __attribute__((ext_vector_type(4)));
constexpr int BM = 256, BK = 64, HALF = 128, HTB = HALF * BK * 2  , STAGE_BYTES = 8 * HTB, NXCD = 8, WGM = 8;

__host__ __device__ __forceinline__ int lds_byte(int r, int c) { const int st = (r >> 4) * 2 + (c >> 5), rr = r & 15, cc = c & 31, ob = rr * 64 + cc * 2; return st * 1024 + (ob ^ (((ob >> 9) & 1) << 5)); }
__host__ __device__ __forceinline__ void stage_rc(int b, int& R, int& C) { const int st = b / 1024, sb = b % 1024, swz = sb ^ (((sb >> 9) & 1) << 5); R = (st >> 1) * 16 + swz / 64; C = (st & 1) * 32 + (swz % 64) / 2; }
__host__ __device__ __forceinline__ int perm32(int rho) { const int n = rho >> 4, i = rho & 15; return 8 * (i >> 2) + 4 * n + (i & 3); }

struct Unit { int pm, pn; };
struct Gemm { const bf16_t* A; const bf16_t* Bt; int M, N, K; const int* gidx = nullptr; int sw = 0x7f7f7f7f, sa = 0x7f7f7f7f; };

struct StaticOrder {
    int nM, nN, nwg, G, c;
    __host__ __device__ void init(int M, int N, int G_, int c_) { nM = M / BM; nN = N / BM; nwg = nM * nN; G = G_; c = c_; }
    __host__ __device__ bool next(int i, Unit& u) const {
        const long L = (long)i * G + c; if (L >= nwg) return false;
        int wgid = (int)L; { const int q = nwg / NXCD, r = nwg % NXCD, xcd = wgid % NXCD, off = wgid / NXCD; wgid = (xcd < r ? xcd * (q + 1) : r * (q + 1) + (xcd - r) * q) + off; }
        const int nig = WGM * nN, gid = wgid / nig, fm = gid * WGM, gsz = (nM - fm) < WGM ? (nM - fm) : WGM;
        u.pm = fm + ((wgid % nig) % gsz); u.pn = (wgid % nig) / gsz; return true;
    }
    __device__ __forceinline__ void a_ready(const Unit&) const {}
    __device__ __forceinline__ void done(const Unit&) const {}
};

template <class Epi, class Sched, bool ALIGN_EPI = false, bool SP2 = false, bool FP8 = false>
__device__ __forceinline__ void gemm_phase(PG8_LAS unsigned char* lds, const Gemm g, const Sched& S, const Epi& E) {
    const int tid = ftid(), wid = __builtin_amdgcn_readfirstlane(tid >> 6), lane = tid & 63, wr = wid >> 2, wc = wid & 3, fr = lane & 15, fq = lane >> 4;
    const int KB = g.K * (FP8 ? 1 : 2), nt = KB / (BK * 2);
    unsigned voffB[2]; int pR[2], pC[2];
#pragma unroll
    for (int i = 0; i < 2; ++i) { int R, C; stage_rc(tid * 16 + i * 8192, R, C); const int Rb = Epi::PERM ? ((R & ~31) + perm32(R & 31)) : R;
        pR[i] = R; pC[i] = C; voffB[i] = (unsigned)(Rb * KB + C * 2); }
    unsigned cvo[2][2], nvo[2][2];
#define PG8_SETVO(vo, pm_) do { _Pragma("unroll") for (int _h = 0; _h < 2; ++_h) _Pragma("unroll") for (int _i = 0; _i < 2; ++_i) { const int _r = (pm_) * BM + _h * HALF + pR[_i]; \
        const int _g = g.gidx ? g.gidx[_r] : _r; vo[_h][_i] = (unsigned)_g * (unsigned)KB + (unsigned)(pC[_i] * 2); } } while (0)
#define PG8_STAGEA(bufoff, koff, vo) do { _Pragma("unroll") for (int _i = 0; _i < 2; ++_i) \
        __builtin_amdgcn_global_load_lds((const unsigned*)((const char*)g.A + (koff) + (vo)[_i]), (PG8_LAS unsigned*)(lds + (bufoff) + ldsw + _i * 8192), 16, 0, 0); } while (0)
    const size_t kstep = (size_t)(BK * 2);
    const size_t hstep = (size_t)HALF * KB;
    const size_t tstep = 2 * hstep;
    const unsigned ldsw = (unsigned)wid * 1024u;
    const int aoff = lds_byte(wr * 64 + fr, fq * 8), boff = lds_byte(wc * 32 + fr, fq * 8);
#define PG8_SA(b, h) (((b) * 2 + (h)) * HTB)
#define PG8_SB(b, h) ((4 + (b) * 2 + (h)) * HTB)
#define PG8_STAGE(bufoff, gbase, voff) do { _Pragma("unroll") for (int _i = 0; _i < 2; ++_i) \
        __builtin_amdgcn_global_load_lds((const unsigned*)((const char*)(gbase) + (voff)[_i]), (PG8_LAS unsigned*)(lds + (bufoff) + ldsw + _i * 8192), 16, 0, 0); } while (0)
    typedef int v4i_t __attribute__((ext_vector_type(4))); typedef int v8i_t __attribute__((ext_vector_type(8)));
#define PG8_CAT8(x, y) __builtin_shufflevector(__builtin_bit_cast(v4i_t, x), __builtin_bit_cast(v4i_t, y), 0, 1, 2, 3, 4, 5, 6, 7)
#define PG8_LDA(dst, b, h) do { _Pragma("unroll") for (int m = 0; m < 4; ++m) { const bf16x8 f0_ = *(const PG8_LAS bf16x8*)(lds + PG8_SA(b, h) + aoff + m * 2048), f1_ = *(const PG8_LAS bf16x8*)(lds + PG8_SA(b, h) + aoff + m * 2048 + 1024); \
        if constexpr (FP8) dst##8[m] = PG8_CAT8(f0_, f1_); else { dst[m][0] = f0_; dst[m][1] = f1_; } } } while (0)
#define PG8_LDB(dst, b, h) do { _Pragma("unroll") for (int n = 0; n < 2; ++n) { const bf16x8 f0_ = *(const PG8_LAS bf16x8*)(lds + PG8_SB(b, h) + boff + n * 2048), f1_ = *(const PG8_LAS bf16x8*)(lds + PG8_SB(b, h) + boff + n * 2048 + 1024); \
        if constexpr (FP8) dst##8[n] = PG8_CAT8(f0_, f1_); else { dst[n][0] = f0_; dst[n][1] = f1_; } } } while (0)
typedef int v4i_t __attribute__((ext_vector_type(4))); typedef int v8i_t __attribute__((ext_vector_type(8)));
#define PG8_CAT8(x, y) __builtin_shufflevector(__builtin_bit_cast(v4i_t, x), __builtin_bit_cast(v4i_t, y), 0, 1, 2, 3, 4, 5, 6, 7)
#define PG8_MMA(ai, bj, At, Bt) do { __builtin_amdgcn_s_setprio(1); _Pragma("unroll") for (int m = 0; m < 4; ++m) _Pragma("unroll") for (int n = 0; n < 2; ++n) { \
        if constexpr (FP8) asm volatile("v_mfma_scale_f32_16x16x128_f8f6f4 %0, %1, %2, %0, %3, %4 op_sel_hi:[0,0,0]" : "+v"(acc[ai][bj][m][n]) : "v"(Bt##8[n]), "v"(At##8[m]), "v"(sw_), "v"(sa_)); \
        else { _Pragma("unroll") for (int k = 0; k < 2; ++k) acc[ai][bj][m][n] = __builtin_amdgcn_mfma_f32_16x16x32_bf16(Bt[n][k], At[m][k], acc[ai][bj][m][n], 0, 0, 0); } } \
        __builtin_amdgcn_s_setprio(0); } while (0)
#define PG8_WAIT_V(n) asm volatile("s_waitcnt vmcnt(" #n ")" ::: "memory")
#define PG8_WAIT_L(n) asm volatile("s_waitcnt lgkmcnt(" #n ")" ::: "memory")
#define PG8_BAR __builtin_amdgcn_s_barrier()
#define PG8_SCHED __builtin_amdgcn_sched_barrier(0)
    Unit cur, nxt; int ui = 0;
    if (!S.next(0, cur)) return;
    f32x4 acc[2][2][4][2];
#pragma unroll
    for (int a = 0; a < 2; ++a)
#pragma unroll
        for (int b = 0; b < 2; ++b)
#pragma unroll
            for (int m = 0; m < 4; ++m)
#pragma unroll
                for (int n = 0; n < 2; ++n) acc[a][b][m][n] = (f32x4){0.f, 0.f, 0.f, 0.f};
    const int sw_ = g.sw, sa_ = g.sa;
    bf16x8 At[4][2], B0[2][2], B1[2][2]; v8i_t At8[4], B08[2], B18[2];
    PG8_SETVO(cvo, cur.pm); const char* cB = (const char*)g.Bt + (size_t)cur.pn * tstep;
    S.a_ready(cur);
    if constexpr (SP2) {
        PG8_STAGE(PG8_SB(0, 0), cB, voffB); PG8_STAGE(PG8_SB(0, 1), cB + hstep, voffB); PG8_STAGEA(PG8_SA(0, 0), 0, cvo[0]); PG8_STAGEA(PG8_SA(0, 1), 0, cvo[1]);
        if (wr == 1) PG8_BAR;
        PG8_WAIT_V(2); PG8_BAR;
        PG8_STAGE(PG8_SB(1, 0), cB + kstep, voffB); PG8_STAGEA(PG8_SA(1, 0), kstep, cvo[0]); PG8_STAGE(PG8_SB(1, 1), cB + hstep + kstep, voffB);
        PG8_WAIT_V(6); PG8_BAR;
    } else {
        PG8_STAGE(PG8_SB(0, 0), cB, voffB); PG8_STAGEA(PG8_SA(0, 0), 0, cvo[0]); PG8_STAGE(PG8_SB(0, 1), cB + hstep, voffB); PG8_STAGEA(PG8_SA(0, 1), 0, cvo[1]);
        if (wr == 1) PG8_BAR;
        PG8_WAIT_V(4); PG8_BAR;
        PG8_STAGE(PG8_SB(1, 0), cB + kstep, voffB); PG8_STAGEA(PG8_SA(1, 0), kstep, cvo[0]); PG8_STAGE(PG8_SB(1, 1), cB + hstep + kstep, voffB);
        PG8_WAIT_V(6); PG8_BAR;
    }
    for (;;) {
        const bool has_next = S.next(ui + 1, nxt);
        if (has_next) PG8_SETVO(nvo, nxt.pm); else { nvo[0][0] = cvo[0][0]; nvo[0][1] = cvo[0][1]; nvo[1][0] = cvo[1][0]; nvo[1][1] = cvo[1][1]; }
        const char* nB = has_next ? (const char*)g.Bt + (size_t)nxt.pn * tstep : cB;
#pragma unroll 1
        for (int t = 0; t < nt; t += 2) {
            const bool last = (t == nt - 2);
            const size_t k1 = (size_t)(t + 1) * kstep;
            const size_t k2 = last ? 0 : (size_t)(t + 2) * kstep; unsigned v2[2][2];
            v2[0][0] = last ? nvo[0][0] : cvo[0][0]; v2[0][1] = last ? nvo[0][1] : cvo[0][1]; v2[1][0] = last ? nvo[1][0] : cvo[1][0]; v2[1][1] = last ? nvo[1][1] : cvo[1][1];
            const char* b2 = last ? nB : cB + (size_t)(t + 2) * kstep;
            const size_t k3 = k2 + kstep; const char* b3 = b2 + kstep;
            if (last && has_next) S.a_ready(nxt);
            if constexpr (SP2) {
            PG8_LDB(B0, 0, 0); PG8_LDB(B1, 0, 1); PG8_SCHED; PG8_LDA(At, 0, 0); PG8_STAGEA(PG8_SA(1, 1), k1, cvo[1]);
            PG8_WAIT_V(8); PG8_WAIT_L(0); PG8_BAR; PG8_MMA(0, 0, At, B0); PG8_MMA(0, 1, At, B1); PG8_BAR; PG8_SCHED;
            PG8_LDA(At, 0, 1); PG8_STAGE(PG8_SB(0, 0), b2, voffB); PG8_STAGE(PG8_SB(0, 1), b2 + hstep, voffB); PG8_STAGEA(PG8_SA(0, 0), k2, v2[0]);
            PG8_WAIT_V(8); PG8_WAIT_L(0); PG8_BAR; PG8_MMA(1, 0, At, B0); PG8_MMA(1, 1, At, B1); PG8_BAR; PG8_SCHED;
            PG8_LDB(B0, 1, 0); PG8_LDB(B1, 1, 1); PG8_SCHED; PG8_LDA(At, 1, 0); PG8_STAGEA(PG8_SA(0, 1), k2, v2[1]);
            PG8_WAIT_V(8); PG8_WAIT_L(0); PG8_BAR; PG8_MMA(0, 0, At, B0); PG8_MMA(0, 1, At, B1); PG8_BAR; PG8_SCHED;
            PG8_LDA(At, 1, 1); PG8_STAGE(PG8_SB(1, 0), b3, voffB); PG8_STAGE(PG8_SB(1, 1), b3 + hstep, voffB); PG8_STAGEA(PG8_SA(1, 0), k3, v2[0]);
            PG8_WAIT_V(8); PG8_WAIT_L(0); PG8_BAR; PG8_MMA(1, 0, At, B0); PG8_MMA(1, 1, At, B1); PG8_BAR; PG8_SCHED;
            } else {
            PG8_LDB(B0, 0, 0); PG8_SCHED; PG8_LDA(At, 0, 0); PG8_STAGEA(PG8_SA(1, 1), k1, cvo[1]);
            PG8_WAIT_L(8); PG8_BAR; PG8_WAIT_L(0); PG8_MMA(0, 0, At, B0); PG8_BAR; PG8_SCHED;
            PG8_LDB(B1, 0, 1); PG8_STAGE(PG8_SB(0, 0), b2, voffB);
            PG8_BAR; PG8_WAIT_L(0); PG8_MMA(0, 1, At, B1); PG8_BAR;
            PG8_LDA(At, 0, 1); PG8_STAGEA(PG8_SA(0, 0), k2, v2[0]);
            PG8_BAR; PG8_WAIT_L(0); PG8_MMA(1, 0, At, B0); PG8_BAR; PG8_SCHED;
            PG8_STAGE(PG8_SB(0, 1), b2 + hstep, voffB);
            PG8_WAIT_V(6); PG8_BAR; PG8_MMA(1, 1, At, B1); PG8_BAR;
            PG8_LDB(B0, 1, 0); PG8_SCHED; PG8_LDA(At, 1, 0); PG8_STAGEA(PG8_SA(0, 1), k2, v2[1]);
            PG8_WAIT_L(8); PG8_BAR; PG8_WAIT_L(0); PG8_MMA(0, 0, At, B0); PG8_BAR; PG8_SCHED;
            PG8_LDB(B1, 1, 1); PG8_STAGE(PG8_SB(1, 0), b3, voffB);
            PG8_BAR; PG8_WAIT_L(0); PG8_MMA(0, 1, At, B1); PG8_BAR;
            PG8_LDA(At, 1, 1); PG8_STAGEA(PG8_SA(1, 0), k3, v2[0]);
            PG8_BAR; PG8_WAIT_L(0); PG8_MMA(1, 0, At, B0); PG8_BAR; PG8_SCHED;
            PG8_STAGE(PG8_SB(1, 1), b3 + hstep, voffB);
            PG8_WAIT_V(6); PG8_BAR; PG8_MMA(1, 1, At, B1); PG8_BAR;
            }
        }
        if constexpr (ALIGN_EPI) { if (wr == 0) PG8_BAR; }
        if constexpr (FP8) asm volatile("s_nop 15\n\ts_nop 15" ::: "memory");
        if constexpr (!Epi::AFTER_DRAIN) { E(acc, cur, wr, wc, fr, fq); S.done(cur); }
        if (!has_next) break;
#pragma unroll
        for (int a = 0; a < 2; ++a)
#pragma unroll
            for (int b = 0; b < 2; ++b)
#pragma unroll
                for (int m = 0; m < 4; ++m)
#pragma unroll
                    for (int n = 0; n < 2; ++n) acc[a][b][m][n] = (f32x4){0.f, 0.f, 0.f, 0.f};
        cur = nxt; cvo[0][0] = nvo[0][0]; cvo[0][1] = nvo[0][1]; cvo[1][0] = nvo[1][0]; cvo[1][1] = nvo[1][1]; cB = nB; ++ui;
        if constexpr (ALIGN_EPI) { if (wr == 1) PG8_BAR; }
    }
    PG8_WAIT_V(0);
    if constexpr (!ALIGN_EPI) { if (wr == 0) PG8_BAR; }
    PG8_BAR;
    if constexpr (Epi::AFTER_DRAIN) { E.fused(acc, cur, wr, wc, fr, fq, lds, wid, lane); S.done(cur); }
#undef PG8_SA
#undef PG8_SB
#undef PG8_STAGE
#undef PG8_STAGEA
#undef PG8_SETVO
#undef PG8_LDA
#undef PG8_LDB
#undef PG8_MMA
#undef PG8_CAT8
#undef PG8_WAIT_V
#undef PG8_WAIT_L
#undef PG8_BAR
#undef PG8_SCHED
}
}
#ifndef FP8_SP2
#define FP8_SP2 true
#endif
#ifndef ATTNA_FP8
#define ATTNA_FP8 1
#endif
namespace fg {
using pg8::f32x4; using pg8::Unit;
typedef unsigned u32x4 __attribute__((ext_vector_type(4)));
typedef unsigned u32x2 __attribute__((ext_vector_type(2)));
DEVI unsigned cvtpk(float lo, float hi) { typedef float f2_t __attribute__((ext_vector_type(2))); typedef __bf16 b2_t __attribute__((ext_vector_type(2))); const f2_t v = {lo, hi}; const b2_t b = __builtin_convertvector(v, b2_t); return __builtin_bit_cast(unsigned, b); }
template <class TP> DEVI void rope8(TP ROPE, int t, int d0, f32x4& v0, f32x4& v1) {
  const int i0 = d0 >> 1, f0 = i0 & 15, pos = (i0 < 16) ? (t >> 6) : (t & 63);
  const f32x4 r0 = *(const PG8_LAS f32x4*)(ROPE + (pos * 16 + f0) * 2), r1 = *(const PG8_LAS f32x4*)(ROPE + (pos * 16 + f0) * 2 + 4);
  const f32x4 a = v0, b = v1;
  v0[0] = a[0] * r0[0] - a[1] * r0[1]; v0[1] = a[0] * r0[1] + a[1] * r0[0]; v0[2] = a[2] * r0[2] - a[3] * r0[3]; v0[3] = a[2] * r0[3] + a[3] * r0[2];
  v1[0] = b[0] * r1[0] - b[1] * r1[1]; v1[1] = b[0] * r1[1] + b[1] * r1[0]; v1[2] = b[2] * r1[2] - b[3] * r1[3]; v1[3] = b[2] * r1[3] + b[3] * r1[2];
}
#define EPI_LOOP_BEGIN const int row0 = u.pm * 256 + wr * 64 + fr; \
  _Pragma("unroll") for (int ai = 0; ai < 2; ++ai) _Pragma("unroll") for (int m = 0; m < 4; ++m) { const int row = row0 + ai * 128 + m * 16; \
  _Pragma("unroll") for (int bj = 0; bj < 2; ++bj) { f32x4 v0 = acc[ai][bj][m][0], v1 = acc[ai][bj][m][1]; const int cl = bj * 128 + wc * 32 + 8 * fq;
#define EPI_LOOP_END } }

struct EpiQKV0 { static constexpr bool PERM = true, AFTER_DRAIN = false; bf16_t* O; const PG8_LAS float* ROPE; unsigned char* VT; unsigned char* VTB;
  DEVI void operator()(const f32x4 (&acc)[2][2][4][2], const Unit& u, int wr, int wc, int fr, int fq) const {
    const int colt = u.pn * 256; const bool rope = (u.pm < NLAT / 256) && (colt < 1024);
    EPI_LOOP_BEGIN
      const int col = colt + cl;
      if (ATTNA_FP8 && colt >= 1024 && colt < 1536) {
        const int hh = (col - 1024) >> 7, dv0 = (col - 1024) & 127;
        int bb, t; if (row < NLAT) { bb = row >> 12; t = row & 4095; } else { bb = (row - NLAT) >> 8; t = 4096 + ((row - NLAT) & 255); }
        const int k = t & 31, gq = k >> 3, wq = k & 7, pos = (wq < 4) ? gq * 4 + wq : 16 + gq * 4 + (wq - 4);
        unsigned char* vp = VT + (size_t)((bb * 4 + hh) * 128 + dv0) * 4352 + (t & ~31) + pos;
        const unsigned w0 = nv::pack4_fp8(v0[0] * 4.f, v0[1] * 4.f, v0[2] * 4.f, v0[3] * 4.f), w1 = nv::pack4_fp8(v1[0] * 4.f, v1[1] * 4.f, v1[2] * 4.f, v1[3] * 4.f);
        vp[0 * 4352] = (unsigned char)w0; vp[1 * 4352] = (unsigned char)(w0 >> 8); vp[2 * 4352] = (unsigned char)(w0 >> 16); vp[3 * 4352] = (unsigned char)(w0 >> 24);
        vp[4 * 4352] = (unsigned char)w1; vp[5 * 4352] = (unsigned char)(w1 >> 8); vp[6 * 4352] = (unsigned char)(w1 >> 16); vp[7 * 4352] = (unsigned char)(w1 >> 24);
        continue;
      }
      if (ATTNA_FP8 && colt >= 2560) {
        const int hh = (col - 2560) >> 6, dv0 = (col - 2560) & 63;
        int bb, t; if (row < NLAT) { bb = row >> 12; t = row & 4095; } else { bb = (row - NLAT) >> 8; t = 4096 + ((row - NLAT) & 255); }
        const int k = t & 31, gq = k >> 3, wq = k & 7, pos = (wq < 4) ? gq * 4 + wq : 16 + gq * 4 + (wq - 4);
        unsigned char* vp = VTB + (size_t)((bb * 8 + hh) * 64 + dv0) * 4352 + (t & ~31) + pos;
        const unsigned w0 = nv::pack4_fp8(v0[0] * 4.f, v0[1] * 4.f, v0[2] * 4.f, v0[3] * 4.f), w1 = nv::pack4_fp8(v1[0] * 4.f, v1[1] * 4.f, v1[2] * 4.f, v1[3] * 4.f);
        vp[0 * 4352] = (unsigned char)w0; vp[1 * 4352] = (unsigned char)(w0 >> 8); vp[2 * 4352] = (unsigned char)(w0 >> 16); vp[3 * 4352] = (unsigned char)(w0 >> 24);
        vp[4 * 4352] = (unsigned char)w1; vp[5 * 4352] = (unsigned char)(w1 >> 8); vp[6 * 4352] = (unsigned char)(w1 >> 16); vp[7 * 4352] = (unsigned char)(w1 >> 24);
        continue;
      }
      if (rope) rope8(ROPE, row & 4095, col & 63, v0, v1);
      if (ATTNA_FP8 && (colt < 1024 || colt >= 1536)) {
        const float sc = (colt < 512 || (colt >= 1536 && colt < 2048)) ? 16.f * 0.125f * 1.4426950408889634f : 4.f;
        u32x2 w8; w8.x = nv::pack4_fp8(v0[0] * sc, v0[1] * sc, v0[2] * sc, v0[3] * sc); w8.y = nv::pack4_fp8(v1[0] * sc, v1[1] * sc, v1[2] * sc, v1[3] * sc);
        *(u32x2*)((unsigned char*)O + (size_t)row * (N_IN0 * 2) + col) = w8;
        continue;
      }
      u32x4 w; w.x = cvtpk(v0[0], v0[1]); w.y = cvtpk(v0[2], v0[3]); w.z = cvtpk(v1[0], v1[1]); w.w = cvtpk(v1[2], v1[3]);
      *(u32x4*)(O + (size_t)row * N_IN0 + col) = w;
    EPI_LOOP_END
  } };
struct EpiQKV1 { static constexpr bool PERM = true, AFTER_DRAIN = false; bf16_t* O; float* DT; const PG8_LAS float* ROPE;
  DEVI void operator()(const f32x4 (&acc)[2][2][4][2], const Unit& u, int wr, int wc, int fr, int fq) const {
    const int colt = u.pn * 256; const bool lat = (u.pm < NLAT / 256);
    EPI_LOOP_BEGIN
      const int col = colt + cl;
      if (col >= 2304) { if (col < 2320) { *(f32x4*)(DT + (size_t)row * 16 + (col - 2304)) = v0; *(f32x4*)(DT + (size_t)row * 16 + (col - 2304) + 4) = v1; } }
      else {
        if (lat && col < 640) rope8(ROPE, row & 4095, col & 63, v0, v1);
        u32x4 w; w.x = cvtpk(v0[0], v0[1]); w.y = cvtpk(v0[2], v0[3]); w.z = cvtpk(v1[0], v1[1]); w.w = cvtpk(v1[2], v1[3]);
        *(u32x4*)(O + (size_t)row * 2304 + col) = w;
      }
    EPI_LOOP_END
  } };
struct EpiPlain { static constexpr bool PERM = true, AFTER_DRAIN = false; bf16_t* O;
  DEVI void operator()(const f32x4 (&acc)[2][2][4][2], const Unit& u, int wr, int wc, int fr, int fq) const {
    const int colt = u.pn * 256;
    EPI_LOOP_BEGIN
      u32x4 w; w.x = cvtpk(v0[0], v0[1]); w.y = cvtpk(v0[2], v0[3]); w.z = cvtpk(v1[0], v1[1]); w.w = cvtpk(v1[2], v1[3]);
      *(u32x4*)(O + (size_t)row * DM + colt + cl) = w;
    EPI_LOOP_END
  } };
DEVI float silu_fast(float v) { return v * __builtin_amdgcn_rcpf(1.f + __expf(-v)); }
struct EpiSwiGLU { static constexpr bool PERM = true, AFTER_DRAIN = false; bf16_t* O;
  DEVI void operator()(const f32x4 (&acc)[2][2][4][2], const Unit& u, int wr, int wc, int fr, int fq) const {
    const int colt = (u.pn & 7) * 256;
    EPI_LOOP_BEGIN
      u32x2 w; w.x = cvtpk(silu_fast(v0[0]) * v0[1], silu_fast(v0[2]) * v0[3]); w.y = cvtpk(silu_fast(v1[0]) * v1[1], silu_fast(v1[2]) * v1[3]);
      *(u32x2*)(O + (size_t)row * DM + ((colt + cl) >> 1)) = w;
    EPI_LOOP_END
  } };
struct EpiSwiGLU8 { static constexpr bool PERM = true, AFTER_DRAIN = false; unsigned char* O;
  DEVI void operator()(const f32x4 (&acc)[2][2][4][2], const Unit& u, int wr, int wc, int fr, int fq) const {
    const int colt = (u.pn & 7) * 256;
    EPI_LOOP_BEGIN
      const unsigned w = nv::pack4_fp8(silu_fast(v0[0]) * v0[1] * nv::A8_SCALE, silu_fast(v0[2]) * v0[3] * nv::A8_SCALE, silu_fast(v1[0]) * v1[1] * nv::A8_SCALE, silu_fast(v1[2]) * v1[3] * nv::A8_SCALE);
      *(unsigned*)(O + (size_t)row * DM + ((colt + cl) >> 1)) = w;
    EPI_LOOP_END
  } };
struct EpiDown { static constexpr bool PERM = true, AFTER_DRAIN = false; bf16_t* O;
  DEVI void operator()(const f32x4 (&acc)[2][2][4][2], const Unit& u, int wr, int wc, int fr, int fq) const {
    const int colt = (u.pn & 3) * 256;
    EPI_LOOP_BEGIN
      u32x4 w; w.x = cvtpk(v0[0], v0[1]); w.y = cvtpk(v0[2], v0[3]); w.z = cvtpk(v1[0], v1[1]); w.w = cvtpk(v1[2], v1[3]);
      *(u32x4*)(O + (size_t)row * DM + colt + cl) = w;
    EPI_LOOP_END
  } };
struct ExpOrder : pg8::StaticOrder { int nMe, nNe;
  __device__ void init2(int erows, int Ne, int G_, int c_) { nMe = erows / 256; nNe = Ne / 256; init(NE * erows, Ne, G_, c_); }
  __device__ bool next(int i, Unit& u) const { if (!pg8::StaticOrder::next(i, u)) return false; u.pn += (u.pm / nMe) * nNe; return true; } };

typedef PG8_LAS unsigned char* ldsp_t;
DEVI void phase_qkv0(const Params& p, ldsp_t lds) {
  pg8::Gemm g{(const bf16_t*)(p.ws + WS_H), (const bf16_t*)(p.ws + WS_WIN0), NROW, N_IN0, DM, nullptr, nv::W8_E8M0, nv::A8_E8M0}; pg8::StaticOrder S; S.init(NROW, N_IN0, gridDim.x, blockIdx.x);
  PG8_LAS float* RL = (PG8_LAS float*)(lds + pg8::STAGE_BYTES);
  for (int i = ftid(); i < 64 * 16 * 2; i += NT) RL[i] = ((const float*)(p.ws + WS_CTL + CTL_ROPE))[i];
  __syncthreads();
  EpiQKV0 E{(bf16_t*)(p.ws + WS_QKV0), RL, (unsigned char*)(p.ws + WS_VT), (unsigned char*)(p.ws + WS_VTB)};
  pg8::gemm_phase<EpiQKV0, pg8::StaticOrder, true, true, (QKV0_FP8 != 0)>(lds, g, S, E);
}
DEVI void phase_qkv1(const Params& p, ldsp_t lds) {
  pg8::Gemm g{(const bf16_t*)(p.ws + WS_H), (const bf16_t*)(p.ws + WS_WIN1), NROW, N_IN1P, DM, nullptr, nv::W8_E8M0, nv::A8_E8M0}; pg8::StaticOrder S; S.init(NROW, N_IN1P, gridDim.x, blockIdx.x);
  PG8_LAS float* RL = (PG8_LAS float*)(lds + pg8::STAGE_BYTES);
  for (int i = ftid(); i < 64 * 16 * 2; i += NT) RL[i] = ((const float*)(p.ws + WS_CTL + CTL_ROPE))[i];
  __syncthreads();
  EpiQKV1 E{(bf16_t*)(p.ws + WS_P1), (float*)(p.ws + WS_DT), RL};
  pg8::gemm_phase<EpiQKV1, pg8::StaticOrder, true, true, (QKV1_FP8 != 0)>(lds, g, S, E);
}
DEVI void phase_outproj(const Params& p, ldsp_t lds, int layer) {
  const int M = layer ? NLAT : NROW;
  pg8::Gemm g{(const bf16_t*)(p.ws + (layer ? WS_ATT1 : WS_ATT0)), (const bf16_t*)(p.ws + (layer ? WS_WOUT1 : WS_WOUT0)), M, DM, DM}; pg8::StaticOrder S; S.init(M, DM, gridDim.x, blockIdx.x);
  EpiPlain E{(bf16_t*)(p.ws + (layer ? WS_MIX1 : WS_MIX0))};
  pg8::gemm_phase<EpiPlain, pg8::StaticOrder, true, true>(lds, g, S, E);
}
DEVI void phase_moe_up(const Params& p, ldsp_t lds, int layer) {
  const int erows = layer ? EROWS1 : EROWS0;
  pg8::Gemm g{(const bf16_t*)(p.ws + WS_H), (const bf16_t*)(p.ws + WS_WGU), NE * erows, 2048, DM, (const int*)(p.ws + WS_IDX)}; ExpOrder S; S.init2(erows, 2048, gridDim.x, blockIdx.x);
  EpiSwiGLU E{(bf16_t*)(p.ws + WS_HID)};
  pg8::gemm_phase<EpiSwiGLU, ExpOrder, true, true>(lds, g, S, E);
}
DEVI void phase_moe_down(const Params& p, ldsp_t lds, int layer) {
  const int erows = layer ? EROWS1 : EROWS0;
  pg8::Gemm g{(const bf16_t*)(p.ws + WS_HID), (const bf16_t*)(p.ws + WS_WD), NE * erows, DM, DM}; ExpOrder S; S.init2(erows, DM, gridDim.x, blockIdx.x);
  EpiDown E{(bf16_t*)(p.ws + WS_Y)};
  pg8::gemm_phase<EpiDown, ExpOrder, true, true>(lds, g, S, E);
}
DEVI void phase_moe_up8(const Params& p, ldsp_t lds, int layer) {
  const int erows = layer ? EROWS1 : EROWS0;
  pg8::Gemm g{(const bf16_t*)(p.ws + WS_H), (const bf16_t*)(p.ws + WS_WGU), NE * erows, 2048, DM, (const int*)(p.ws + WS_IDX), nv::W8_E8M0, nv::A8_E8M0}; ExpOrder S; S.init2(erows, 2048, gridDim.x, blockIdx.x);
  EpiSwiGLU8 E{(unsigned char*)(p.ws + WS_HID)};
  pg8::gemm_phase<EpiSwiGLU8, ExpOrder, true, FP8_SP2, true>(lds, g, S, E);
}
DEVI void phase_moe_down8(const Params& p, ldsp_t lds, int layer) {
  const int erows = layer ? EROWS1 : EROWS0;
  pg8::Gemm g{(const bf16_t*)(p.ws + WS_HID), (const bf16_t*)(p.ws + WS_WD), NE * erows, DM, DM, nullptr, nv::W8_E8M0, nv::A8_E8M0}; ExpOrder S; S.init2(erows, DM, gridDim.x, blockIdx.x);
  EpiDown E{(bf16_t*)(p.ws + WS_Y)};
  pg8::gemm_phase<EpiDown, ExpOrder, true, FP8_SP2, true>(lds, g, S, E);
}
DEVI void phase_gather(const Params& p, int layer) {
  const int lane = ftid() & 63, gw = blockIdx.x * NWAVE + (ftid() >> 6), NGW = gridDim.x * NWAVE;
  const int erows = layer ? EROWS1 : EROWS0; const int* IDX = (const int*)(p.ws + WS_IDX);
  const bf16_t* H = (const bf16_t*)(p.ws + WS_H); bf16_t* XG = (bf16_t*)(p.ws + WS_XG);
  for (int r = gw; r < NE * erows; r += NGW) {
    const uint4* s = (const uint4*)(H + (size_t)IDX[r] * DM) + lane; uint4* d = (uint4*)(XG + (size_t)r * DM) + lane;
    const uint4 a = s[0], b = s[64]; d[0] = a; d[64] = b;
  }
}
}
#ifndef ATTNA_FP8
#define ATTNA_FP8 1
#endif
namespace fa {
#define FA_LAS __attribute__((address_space(3)))
typedef short bf16x8 __attribute__((ext_vector_type(8)));
typedef short s16x4 __attribute__((ext_vector_type(4)));
typedef float f32x16 __attribute__((ext_vector_type(16)));
typedef FA_LAS unsigned char* ldsp_t;
typedef unsigned u32x4 __attribute__((ext_vector_type(4)));
constexpr float LOG2E = 1.4426950408889634f, C2 = 0.125f * LOG2E;
DEVI int crow(int r, int hi) { return (r & 3) + 8 * (r >> 2) + 4 * hi; }
DEVI unsigned cvtpk(float lo, float hi) { typedef float f2_t __attribute__((ext_vector_type(2))); typedef __bf16 b2_t __attribute__((ext_vector_type(2))); const f2_t v = {lo, hi}; const b2_t b = __builtin_convertvector(v, b2_t); return __builtin_bit_cast(unsigned, b); }
DEVI s16x4 vtr(ldsp_t p) { return __builtin_bit_cast(s16x4, __builtin_amdgcn_ds_read_tr16_b64_v4i16((FA_LAS s16x4*)p)); }

DEVI float max3f(float a, float b, float c) { float r; asm("v_max3_f32 %0, %1, %2, %3" : "=v"(r) : "v"(a), "v"(b), "v"(c)); return r; }
template <int KW, int DVB> struct Geo {
  static constexpr int VW = DVB * 32;
  static constexpr int KSTR = KW * 2 + 16, VSTR = VW * 2 + 64;
  static constexpr int KBYTES = 64 * KSTR, VBYTES = 64 * VSTR, STAGE = KBYTES + VBYTES;
  static constexpr int CPR = (KW + VW) / 8, NCH = 64 * CPR / NT;
};

DEVI bf16x8 load_q8(const bf16_t* p, float sc) {
  const uint4 w = *(const uint4*)p; const unsigned u[4] = {w.x, w.y, w.z, w.w}; unsigned o[4];
#pragma unroll
  for (int i = 0; i < 4; ++i) o[i] = cvtpk(__uint_as_float(u[i] << 16) * sc, __uint_as_float(u[i] & 0xffff0000u) * sc);
  uint4 r = make_uint4(o[0], o[1], o[2], o[3]); return __builtin_bit_cast(bf16x8, r);
}

template <int KW, int DVB, class Src, class Act, class Msk>
DEVI void flash_pass(ldsp_t lds, int ntiles, const bf16_t* kv, int ld, int kcol, int vcol, const bf16x8 (&q)[4], int kofs,
                     Src src, Act act, Msk msk, f32x16 (&o)[DVB], float& m, float& l) {
  typedef Geo<KW, DVB> G;
  const int tid = ftid(), lane = tid & 63, r32 = lane & 31, hi = lane >> 5;
  u32x4 stg[G::NCH];
  int crw[G::NCH], ccol[G::NCH], cdst[G::NCH];
#pragma unroll
  for (int i = 0; i < G::NCH; ++i) { const int c = tid + NT * i, row = c / G::CPR, cc = c % G::CPR; crw[i] = row;
    if (cc < KW / 8) { ccol[i] = kcol + cc * 8; cdst[i] = row * G::KSTR + cc * 16; } else { ccol[i] = vcol + (cc - KW / 8) * 8; cdst[i] = G::KBYTES + row * G::VSTR + (cc - KW / 8) * 16; } }
#pragma unroll
  for (int i = 0; i < G::NCH; ++i) stg[i] = *(const u32x4*)(kv + (size_t)src(0, crw[i]) * ld + ccol[i]);
#pragma unroll
  for (int i = 0; i < G::NCH; ++i) *(FA_LAS u32x4*)(lds + cdst[i]) = stg[i];
  __syncthreads();
  const int kroff = r32 * G::KSTR + (kofs + 8 * hi) * 2;
  const int vroff = G::KBYTES + (4 * hi + ((lane & 15) >> 2)) * G::VSTR + 32 * ((lane >> 4) & 1) + 8 * (lane & 3);
  for (int kt = 0; kt < ntiles; ++kt) {
    const int buf = (kt & 1) * G::STAGE;
    const bool more = kt + 1 < ntiles;
    if (more) {
#pragma unroll
      for (int i = 0; i < G::NCH; ++i) stg[i] = *(const u32x4*)(kv + (size_t)src(kt + 1, crw[i]) * ld + ccol[i]);
    }
    if (act(kt)) {
      const ldsp_t kb = lds + buf + kroff;
      f32x16 p0, p1;
#pragma unroll
      for (int r = 0; r < 16; ++r) { p0[r] = 0.f; p1[r] = 0.f; }
#pragma unroll
      for (int d0 = 0; d0 < 4; ++d0) {
        const bf16x8 a0 = *(const FA_LAS bf16x8*)(kb + d0 * 32), a1 = *(const FA_LAS bf16x8*)(kb + 32 * G::KSTR + d0 * 32);
        p0 = __builtin_amdgcn_mfma_f32_32x32x16_bf16(a0, q[d0], p0, 0, 0, 0);
        p1 = __builtin_amdgcn_mfma_f32_32x32x16_bf16(a1, q[d0], p1, 0, 0, 0);
      }
      msk(kt, p0, p1);
      float mx = fmaxf(p0[0], p1[0]);
#pragma unroll
      for (int r = 1; r < 16; ++r) mx = fmaxf(mx, fmaxf(p0[r], p1[r]));
      mx = fmaxf(mx, __shfl_xor(mx, 32));
      if (__any(mx > m)) {
        const float mn = fmaxf(m, mx), alpha = __builtin_amdgcn_exp2f(m - mn);
        l *= alpha; m = mn;
#pragma unroll
        for (int b = 0; b < DVB; ++b)
#pragma unroll
          for (int r = 0; r < 16; ++r) o[b][r] *= alpha;
      }
      float ls = 0.f;
#pragma unroll
      for (int r = 0; r < 16; ++r) { p0[r] = __builtin_amdgcn_exp2f(p0[r] - m); p1[r] = __builtin_amdgcn_exp2f(p1[r] - m); ls += p0[r] + p1[r]; }
      l += ls;
      bf16x8 pa[4];
      { uint4 t;
        t = make_uint4(cvtpk(p0[0], p0[1]), cvtpk(p0[2], p0[3]), cvtpk(p0[4], p0[5]), cvtpk(p0[6], p0[7])); pa[0] = __builtin_bit_cast(bf16x8, t);
        t = make_uint4(cvtpk(p0[8], p0[9]), cvtpk(p0[10], p0[11]), cvtpk(p0[12], p0[13]), cvtpk(p0[14], p0[15])); pa[1] = __builtin_bit_cast(bf16x8, t);
        t = make_uint4(cvtpk(p1[0], p1[1]), cvtpk(p1[2], p1[3]), cvtpk(p1[4], p1[5]), cvtpk(p1[6], p1[7])); pa[2] = __builtin_bit_cast(bf16x8, t);
        t = make_uint4(cvtpk(p1[8], p1[9]), cvtpk(p1[10], p1[11]), cvtpk(p1[12], p1[13]), cvtpk(p1[14], p1[15])); pa[3] = __builtin_bit_cast(bf16x8, t); }
      const ldsp_t vb = lds + buf + vroff;
#pragma unroll
      for (int b = 0; b < DVB; ++b)
#pragma unroll
        for (int ks = 0; ks < 4; ++ks) {
          const s16x4 lo = vtr(vb + (16 * ks) * G::VSTR + b * 64), h8 = vtr(vb + (16 * ks + 8) * G::VSTR + b * 64);
          const bf16x8 vf = {lo[0], lo[1], lo[2], lo[3], h8[0], h8[1], h8[2], h8[3]};
          o[b] = __builtin_amdgcn_mfma_f32_32x32x16_bf16(vf, pa[ks], o[b], 0, 0, 0);
        }
    }
    if (more) {
      const int nb = ((kt + 1) & 1) * G::STAGE;
#pragma unroll
      for (int i = 0; i < G::NCH; ++i) *(FA_LAS u32x4*)(lds + nb + cdst[i]) = stg[i];
    }
    __syncthreads();
  }
}


template <int V> struct IC { static constexpr int value = V; };
template <int KW, int DVB, int ABL, int PF, class Src, class Msk>
DEVI void flash_pass2(ldsp_t lds, int ntiles, const bf16_t* kv, int ld, int kcol, int vcol, const bf16x8 (&q)[4], int kofs,
                      Src src, Msk msk, f32x16 (&o)[DVB], float& m, float& l) {
  typedef Geo<KW, DVB> G;
  const int tid = ftid(), lane = tid & 63, r32 = lane & 31, hi = lane >> 5;
  u32x4 stg[PF][G::NCH];
  int crw[G::NCH], ccol[G::NCH], cdst[G::NCH];
#pragma unroll
  for (int i = 0; i < G::NCH; ++i) { const int c = tid + NT * i, row = c / G::CPR, cc = c % G::CPR; crw[i] = row;
    if (cc < KW / 8) { ccol[i] = kcol + cc * 8; cdst[i] = row * G::KSTR + cc * 16; } else { ccol[i] = vcol + (cc - KW / 8) * 8; cdst[i] = G::KBYTES + row * G::VSTR + (cc - KW / 8) * 16; } }
#define FP2_LOAD(kt, set) _Pragma("unroll") for (int i = 0; i < G::NCH; ++i) stg[set][i] = *(const u32x4*)(kv + (size_t)src((kt), crw[i]) * ld + ccol[i])
#define FP2_STORE(st, set) _Pragma("unroll") for (int i = 0; i < G::NCH; ++i) *(FA_LAS u32x4*)(lds + (st) * G::STAGE + cdst[i]) = stg[set][i]
  FP2_LOAD(0, 0); FP2_STORE(0, 0);
  if (ntiles > 1) { FP2_LOAD(1, 0); FP2_STORE(1, 0); }
  __syncthreads();
  if (ntiles > 2) FP2_LOAD(2, 0);
  if (PF == 2) { if (ntiles > 3) FP2_LOAD(3, PF - 1); }
  const int kroff = r32 * G::KSTR + (kofs + 8 * hi) * 2;
  const int vroff = G::KBYTES + (4 * hi + ((lane & 15) >> 2)) * G::VSTR + 32 * ((lane >> 4) & 1) + 8 * (lane & 3);
  f32x16 c0, c1;
#pragma unroll
  for (int r = 0; r < 16; ++r) { c0[r] = 0.f; c1[r] = 0.f; }
  { const ldsp_t kb = lds + kroff;
#pragma unroll
    for (int d0 = 0; d0 < 4; ++d0) {
      const bf16x8 a0 = *(const FA_LAS bf16x8*)(kb + d0 * 32), a1 = *(const FA_LAS bf16x8*)(kb + 32 * G::KSTR + d0 * 32);
      c0 = __builtin_amdgcn_mfma_f32_32x32x16_bf16(a0, q[d0], c0, 0, 0, 0); c1 = __builtin_amdgcn_mfma_f32_32x32x16_bf16(a1, q[d0], c1, 0, 0, 0); } }
  asm volatile("s_nop 15\n\ts_nop 7" : "+v"(c0), "+v"(c1));
  int st_cur = 0, st_nxt = 1, st_fill = 2;
  auto body = [&](int kt, auto PARC) {
    constexpr int set = (PF == 2) ? decltype(PARC)::value : 0;
    msk(kt, c0, c1);
    __builtin_amdgcn_sched_barrier(0);
    f32x16 n0, n1;
#pragma unroll
    for (int r = 0; r < 16; ++r) { n0[r] = 0.f; n1[r] = 0.f; }
    const ldsp_t kb = lds + st_nxt * G::STAGE + kroff;
    bf16x8 ka[4], kb2[4];
#pragma unroll
    for (int d0 = 0; d0 < 4; ++d0) { ka[d0] = *(const FA_LAS bf16x8*)(kb + d0 * 32); kb2[d0] = *(const FA_LAS bf16x8*)(kb + 32 * G::KSTR + d0 * 32); }
#define FP2_SB() __builtin_amdgcn_sched_barrier(0)
#define FP2_MMA(acc, kf, d0) acc = __builtin_amdgcn_mfma_f32_32x32x16_bf16(kf[d0], q[d0], acc, 0, 0, 0)
#define FP2_EXP(cx, r) { if (ABL != 1) { cx[r] = __builtin_amdgcn_exp2f(cx[r] - mn); ls += cx[r]; } }
    FP2_SB(); FP2_MMA(n0, ka, 0);
    float mxa = max3f(c0[0], c0[1], c1[0]), mxb = max3f(c0[2], c0[3], c1[1]);
    mxa = max3f(mxa, c1[2], c1[3]);
    mxa = max3f(mxa, c0[4], c0[5]); mxb = max3f(mxb, c0[6], c0[7]); mxa = max3f(mxa, c1[4], c1[5]); mxb = max3f(mxb, c1[6], c1[7]);
    FP2_SB(); FP2_MMA(n1, kb2, 0);
    mxa = max3f(mxa, c0[8], c0[9]); mxb = max3f(mxb, c0[10], c0[11]); mxa = max3f(mxa, c1[8], c1[9]); mxb = max3f(mxb, c1[10], c1[11]);
    mxa = max3f(mxa, c0[12], c0[13]); mxb = max3f(mxb, c0[14], c0[15]); mxa = max3f(mxa, c1[12], c1[13]); mxb = max3f(mxb, c1[14], c1[15]);
    float mx = max3f(mxa, mxb, m);
    mx = max3f(mx, __shfl_xor(mx, 32), mx);
    const float mn = mx, alpha = __builtin_amdgcn_exp2f(m - mn);
    const bool resc = __any(mn > m);
    m = mn;
    float ls = 0.f;
    FP2_SB(); FP2_MMA(n0, ka, 1);
    FP2_EXP(c0, 0) FP2_EXP(c0, 1) FP2_EXP(c0, 2) FP2_EXP(c0, 3) FP2_EXP(c0, 4) FP2_EXP(c0, 5)
    FP2_SB(); FP2_MMA(n1, kb2, 1);
    FP2_EXP(c0, 6) FP2_EXP(c0, 7) FP2_EXP(c0, 8) FP2_EXP(c0, 9) FP2_EXP(c0, 10) FP2_EXP(c0, 11)
    FP2_SB(); FP2_MMA(n0, ka, 2);
    FP2_EXP(c0, 12) FP2_EXP(c0, 13) FP2_EXP(c0, 14) FP2_EXP(c0, 15) FP2_EXP(c1, 0) FP2_EXP(c1, 1)
    FP2_SB(); FP2_MMA(n1, kb2, 2);
    FP2_EXP(c1, 2) FP2_EXP(c1, 3) FP2_EXP(c1, 4) FP2_EXP(c1, 5) FP2_EXP(c1, 6) FP2_EXP(c1, 7)
    FP2_SB(); FP2_MMA(n0, ka, 3);
    FP2_EXP(c1, 8) FP2_EXP(c1, 9) FP2_EXP(c1, 10) FP2_EXP(c1, 11) FP2_EXP(c1, 12) FP2_EXP(c1, 13)
    FP2_SB(); FP2_MMA(n1, kb2, 3);
    FP2_EXP(c1, 14) FP2_EXP(c1, 15)
    bf16x8 pa[4];
    { u32x4 t;
      t[0] = cvtpk(c0[0], c0[1]); t[1] = cvtpk(c0[2], c0[3]); t[2] = cvtpk(c0[4], c0[5]); t[3] = cvtpk(c0[6], c0[7]); pa[0] = __builtin_bit_cast(bf16x8, t);
      t[0] = cvtpk(c0[8], c0[9]); t[1] = cvtpk(c0[10], c0[11]); t[2] = cvtpk(c0[12], c0[13]); t[3] = cvtpk(c0[14], c0[15]); pa[1] = __builtin_bit_cast(bf16x8, t);
      t[0] = cvtpk(c1[0], c1[1]); t[1] = cvtpk(c1[2], c1[3]); t[2] = cvtpk(c1[4], c1[5]); t[3] = cvtpk(c1[6], c1[7]); pa[2] = __builtin_bit_cast(bf16x8, t);
      t[0] = cvtpk(c1[8], c1[9]); t[1] = cvtpk(c1[10], c1[11]); t[2] = cvtpk(c1[12], c1[13]); t[3] = cvtpk(c1[14], c1[15]); pa[3] = __builtin_bit_cast(bf16x8, t); }
    asm volatile("" : "+v"(pa[0]), "+v"(pa[1]), "+v"(pa[2]), "+v"(pa[3]));
    FP2_SB();
    l = l * alpha + ls;
    __builtin_amdgcn_sched_barrier(0);
    if (resc) {
#pragma unroll
      for (int b = 0; b < DVB; ++b)
#pragma unroll
        for (int r = 0; r < 16; ++r) o[b][r] *= alpha;
    }
    const ldsp_t vb = lds + st_cur * G::STAGE + vroff;
    s16x4 vl[2][DVB], vh[2][DVB];
#pragma unroll
    for (int b = 0; b < DVB; ++b) { vl[0][b] = vtr(vb + b * 64); vh[0][b] = vtr(vb + 8 * G::VSTR + b * 64); }
#pragma unroll
    for (int ks = 0; ks < 4; ++ks) {
      FP2_SB();
      if (ks < 3) {
#pragma unroll
        for (int b = 0; b < DVB; ++b) { vl[(ks + 1) & 1][b] = vtr(vb + (16 * (ks + 1)) * G::VSTR + b * 64); vh[(ks + 1) & 1][b] = vtr(vb + (16 * (ks + 1) + 8) * G::VSTR + b * 64); }
      }
      FP2_SB();
#pragma unroll
      for (int b = 0; b < DVB; ++b) {
        const s16x4 lo = vl[ks & 1][b], h8 = vh[ks & 1][b];
        const bf16x8 vf = {lo[0], lo[1], lo[2], lo[3], h8[0], h8[1], h8[2], h8[3]};
        if (ABL != 2) o[b] = __builtin_amdgcn_mfma_f32_32x32x16_bf16(vf, pa[ks], o[b], 0, 0, 0); else o[b][0] += __builtin_bit_cast(float, (int)vf[0]);
      }
    }
    FP2_SB();
    if (ABL != 3) { if (kt + 2 < ntiles) FP2_STORE(st_fill, set); }
    __syncthreads();
    if (ABL != 3) { if (kt + 2 + PF < ntiles) FP2_LOAD(kt + 2 + PF, set); }
    c0 = n0; c1 = n1;
    { const int t = st_cur; st_cur = st_nxt; st_nxt = st_fill; st_fill = t; }
  };
  if (PF == 2) { for (int kt = 0; kt < ntiles; kt += 2) { body(kt, IC<0>{}); if (kt + 1 < ntiles) body(kt + 1, IC<1>{}); } }
  else { for (int kt = 0; kt < ntiles; ++kt) body(kt, IC<0>{}); }
#undef FP2_LOAD
#undef FP2_STORE
}


typedef int v8i_t __attribute__((ext_vector_type(8)));
DEVI v8i_t cat8(const u32x4& x, const u32x4& y) { return (v8i_t){(int)x[0], (int)x[1], (int)x[2], (int)x[3], (int)y[0], (int)y[1], (int)y[2], (int)y[3]}; }
template <int DVB, int KROW, bool PIPE, class Src, class VKey, class Msk>
DEVI void flash_pass8(ldsp_t lds, int ntiles, const unsigned char* k8, int ldb, int kcolb, const unsigned char* vt, const v8i_t& qf, int ksub,
                      Src src, VKey vkey, Msk msk, f32x16 (&o)[DVB], float& m, float& l) {
  constexpr int A8_KSTR = KROW + 16, A8_VSTR = 80, A8_KB = 64 * A8_KSTR, A8_STAGE = A8_KB + DVB * 32 * A8_VSTR;
  constexpr int KPR = KROW / 16, NKC = 64 * KPR, NCHT = (NKC + DVB * 32 * 4) / NT;
  const int tid = ftid(), lane = tid & 63, r32 = lane & 31, hi = lane >> 5;
  u32x4 stg[NCHT];
#define A8_LOAD(kt) do { _Pragma("unroll") for (int i_ = 0; i_ < NCHT; ++i_) { const int c_ = tid + NT * i_; \
      if (c_ < NKC) stg[i_] = *(const u32x4*)(k8 + (size_t)src((kt), c_ / KPR) * ldb + kcolb + (c_ % KPR) * 16); \
      else { const int cv_ = c_ - NKC; stg[i_] = *(const u32x4*)(vt + (size_t)(cv_ >> 2) * 4352 + vkey(kt) + (cv_ & 3) * 16); } } } while (0)
#define A8_STORE(st) do { _Pragma("unroll") for (int i_ = 0; i_ < NCHT; ++i_) { const int c_ = tid + NT * i_; \
      if (c_ < NKC) *(FA_LAS u32x4*)(lds + (st) * A8_STAGE + (c_ / KPR) * A8_KSTR + (c_ % KPR) * 16) = stg[i_]; \
      else { const int cv_ = c_ - NKC; *(FA_LAS u32x4*)(lds + (st) * A8_STAGE + A8_KB + (cv_ >> 2) * A8_VSTR + (cv_ & 3) * 16) = stg[i_]; } } } while (0)
#define A8_QK(dst, st, half) do { const ldsp_t kp_ = lds + (st) * A8_STAGE + kroff + (half) * 32 * A8_KSTR; f32x16 z_; _Pragma("unroll") for (int r_ = 0; r_ < 16; ++r_) z_[r_] = 0.f; \
    const u32x4 k0_ = *(const FA_LAS u32x4*)kp_, k1_ = *(const FA_LAS u32x4*)(kp_ + 16); \
    dst = __builtin_amdgcn_mfma_scale_f32_32x32x64_f8f6f4(cat8(k0_, k1_), qf, z_, 0, 0, 0, 0x7d7d7d7d  , 0, 0x7b7b7b7b  ); } while (0)
  A8_LOAD(0); A8_STORE(0);
  if (ntiles > 1) { A8_LOAD(1); A8_STORE(1); }
  __syncthreads();
  if (ntiles > 2) A8_LOAD(2);
  const int kroff = r32 * A8_KSTR + 64 * ksub + 32 * hi;
  const int vroff = A8_KB + r32 * A8_VSTR + 32 * hi;
  f32x16 c0, c1;
  if (PIPE) { A8_QK(c0, 0, 0); A8_QK(c1, 0, 1);
    asm volatile("s_nop 15\n\ts_nop 7" : "+v"(c0), "+v"(c1)); }
  int st_cur = 0, st_nxt = 1, st_fill = 2;
  for (int kt = 0; kt < ntiles; ++kt) {
    if (!PIPE) { A8_QK(c0, st_cur, 0); A8_QK(c1, st_cur, 1); asm volatile("s_nop 15\n\ts_nop 7" : "+v"(c0), "+v"(c1)); }
    msk(kt, c0, c1);
    __builtin_amdgcn_sched_barrier(0);
    f32x16 n0, n1;
#define A8_SB() __builtin_amdgcn_sched_barrier(0)
#define A8_EXP(cx, r) { cx[r] = __builtin_amdgcn_exp2f(cx[r] - mn); ls += cx[r]; }
    A8_SB(); if (PIPE) A8_QK(n0, st_nxt, 0);
    float mxa = max3f(c0[0], c0[1], c1[0]), mxb = max3f(c0[2], c0[3], c1[1]);
    mxa = max3f(mxa, c1[2], c1[3]);
    mxa = max3f(mxa, c0[4], c0[5]); mxb = max3f(mxb, c0[6], c0[7]); mxa = max3f(mxa, c1[4], c1[5]); mxb = max3f(mxb, c1[6], c1[7]);
    A8_SB(); if (PIPE) A8_QK(n1, st_nxt, 1);
    mxa = max3f(mxa, c0[8], c0[9]); mxb = max3f(mxb, c0[10], c0[11]); mxa = max3f(mxa, c1[8], c1[9]); mxb = max3f(mxb, c1[10], c1[11]);
    mxa = max3f(mxa, c0[12], c0[13]); mxb = max3f(mxb, c0[14], c0[15]); mxa = max3f(mxa, c1[12], c1[13]); mxb = max3f(mxb, c1[14], c1[15]);
    float mx = max3f(mxa, mxb, mxb);
    mx = max3f(mx, __shfl_xor(mx, 32), mx);
    const bool up = mx > m + 4.f;
    const float mn = up ? mx : m, alpha = __builtin_amdgcn_exp2f(m - mn);
    const bool resc = __any(up);
    m = mn;
    float ls = 0.f;
    A8_SB();
#pragma unroll
    for (int r = 0; r < 16; ++r) A8_EXP(c0, r)
#pragma unroll
    for (int r = 0; r < 16; ++r) A8_EXP(c1, r)
    unsigned X[4], Y[4];
#pragma unroll
    for (int i = 0; i < 4; ++i) {
      int w = 0; w = __builtin_amdgcn_cvt_pk_fp8_f32(c0[4 * i] * 16.f, c0[4 * i + 1] * 16.f, w, false); w = __builtin_amdgcn_cvt_pk_fp8_f32(c0[4 * i + 2] * 16.f, c0[4 * i + 3] * 16.f, w, true); X[i] = (unsigned)w;
      int z = 0; z = __builtin_amdgcn_cvt_pk_fp8_f32(c1[4 * i] * 16.f, c1[4 * i + 1] * 16.f, z, false); z = __builtin_amdgcn_cvt_pk_fp8_f32(c1[4 * i + 2] * 16.f, c1[4 * i + 3] * 16.f, z, true); Y[i] = (unsigned)z; }
#pragma unroll
    for (int i = 0; i < 4; ++i) { const auto rr = __builtin_amdgcn_permlane32_swap(X[i], Y[i], false, false); X[i] = rr[0]; Y[i] = rr[1]; }
    v8i_t pb = {(int)X[0], (int)X[1], (int)X[2], (int)X[3], (int)Y[0], (int)Y[1], (int)Y[2], (int)Y[3]};
    asm volatile("" : "+v"(pb));
    A8_SB();
    l = l * alpha + ls;
    __builtin_amdgcn_sched_barrier(0);
    if (resc) {
#pragma unroll
      for (int b = 0; b < DVB; ++b)
#pragma unroll
        for (int r = 0; r < 16; ++r) o[b][r] *= alpha;
    }
    { const ldsp_t vb = lds + st_cur * A8_STAGE + vroff;
      u32x4 v0[DVB], v1[DVB];
#pragma unroll
      for (int b = 0; b < DVB; ++b) { v0[b] = *(const FA_LAS u32x4*)(vb + b * 32 * A8_VSTR); v1[b] = *(const FA_LAS u32x4*)(vb + b * 32 * A8_VSTR + 16); }
#pragma unroll
      for (int b = 0; b < DVB; ++b) o[b] = __builtin_amdgcn_mfma_scale_f32_32x32x64_f8f6f4(cat8(v0[b], v1[b]), pb, o[b], 0, 0, 0, 0x7d7d7d7d  , 0, 0x7b7b7b7b  );
    }
    A8_SB();
    if (kt + 2 < ntiles) A8_STORE(st_fill);
    __syncthreads();
    if (kt + 3 < ntiles) A8_LOAD(kt + 3);
    if (PIPE) { c0 = n0; c1 = n1; }
    { const int t = st_cur; st_cur = st_nxt; st_nxt = st_fill; st_fill = t; }
  }
#undef A8_LOAD
#undef A8_STORE
#undef A8_QK
#undef A8_SB
#undef A8_EXP
}

DEVI int vblock() { const int G = gridDim.x, bx = blockIdx.x; return (G % 8 == 0) ? (bx % 8) * (G / 8) + bx / 8 : bx; }

template <int ABL = 0> DEVI void phase_attnA(const Params& p, ldsp_t lds) {
  typedef Geo<128, 4> G;
  const int tid = ftid(), lane = tid & 63, wave = __builtin_amdgcn_readfirstlane(tid >> 6), r32 = lane & 31, hi = lane >> 5;
  const bf16_t* Q = (const bf16_t*)(p.ws + WS_QKV0); bf16_t* ATT = (bf16_t*)(p.ws + (ABL ? WS_MIX0 : WS_ATT0));
  const float lam = ((const float*)(p.ws + WS_CTL + CTL_LAM))[0];
  const int s = wave >> 2, qb = wave & 3;
  constexpr int NU_LAT = NB * 4 * 32, NU_CTX = NB * 4 * 2;
  for (int u = vblock(); u < NU_LAT + NU_CTX; u += gridDim.x) {
    int b, h, row0, ntiles; bool lat = u < NU_LAT;
    if (lat) { b = u >> 7; h = (u >> 5) & 3; row0 = b * SEQ + (u & 31) * 128; ntiles = 68; }
    else { const int v = u - NU_LAT; b = v >> 3; h = (v >> 1) & 3; row0 = NLAT + b * CTXL + (v & 1) * 128; ntiles = 4; }
    const int qrow = row0 + qb * 32 + r32;
    bf16x8 q[4];
#pragma unroll
    for (int d0 = 0; d0 < 4; ++d0) q[d0] = load_q8(Q + (size_t)qrow * N_IN0 + h * 128 + s * 64 + 16 * d0 + 8 * hi, C2);
    f32x16 o[4];
#pragma unroll
    for (int bk = 0; bk < 4; ++bk)
#pragma unroll
      for (int r = 0; r < 16; ++r) o[bk][r] = 0.f;
    float m = -1e30f, l = 0.f;
    const int cbase = NLAT + b * CTXL, lbase = b * SEQ;
#if ATTNA_FP8
    const unsigned char* QK8 = (const unsigned char*)(p.ws + WS_QKV0);
    v8i_t qf;
    { const unsigned char* qp = QK8 + (size_t)qrow * (N_IN0 * 2) + h * 128 + s * 64 + 32 * hi; const u32x4 q0_ = *(const u32x4*)qp, q1_ = *(const u32x4*)(qp + 16); qf = cat8(q0_, q1_); }
    flash_pass8<4, 128, true>(lds, ntiles, QK8, N_IN0 * 2, 512 + h * 128, (const unsigned char*)(p.ws + WS_VT) + (size_t)((b * 4 + h) * 128) * 4352, qf, s,
      [&](int kt, int i) { return lat ? (kt < 64 ? lbase + kt * 64 + i : cbase + (kt - 64) * 64 + i) : cbase + kt * 64 + i; },
      [&](int kt) { return (lat ? 0 : 4096) + kt * 64; }, [&](int, f32x16&, f32x16&) {}, o, m, l);
#else
    flash_pass2<128, 4, ABL, 1>(lds, ntiles, Q, N_IN0, 512 + h * 128, 1024 + h * 128, q, s * 64,
      [&](int kt, int i) { return lat ? (kt < 64 ? lbase + kt * 64 + i : cbase + (kt - 64) * 64 + i) : cbase + kt * 64 + i; },
      [&](int, f32x16&, f32x16&) {}, o, m, l);
#endif
    l += __shfl_xor(l, 32);
    const float inv = 1.f / l;
    FA_LAS float* X = (FA_LAS float*)lds;
    if (s == 1) {
#pragma unroll
      for (int bk = 0; bk < 4; ++bk)
#pragma unroll
        for (int r = 0; r < 16; ++r) X[((qb * 4 + bk) * 16 + r) * 64 + lane] = o[bk][r] * inv;
    }
    __syncthreads();
    if (s == 0) {
      float ss = 0.f;
#pragma unroll
      for (int bk = 0; bk < 4; ++bk)
#pragma unroll
        for (int r = 0; r < 16; ++r) { const float d = o[bk][r] * inv - lam * X[((qb * 4 + bk) * 16 + r) * 64 + lane]; o[bk][r] = d; ss += d * d; }
      ss += __shfl_xor(ss, 32);
      const float rr = rsqrtf(ss * (1.f / 128.f) + EPS) * 0.8f;
      const float* g = p.in[L0_SUBLN];
      bf16_t* orow = ATT + (size_t)qrow * DM + h * 128;
#pragma unroll
      for (int bk = 0; bk < 4; ++bk)
#pragma unroll
        for (int rg = 0; rg < 4; ++rg) { const int dv = bk * 32 + 8 * rg + 4 * hi; const float4 gv = *(const float4*)(g + dv);
          uint2 w; w.x = cvtpk(o[bk][4 * rg] * rr * gv.x, o[bk][4 * rg + 1] * rr * gv.y); w.y = cvtpk(o[bk][4 * rg + 2] * rr * gv.z, o[bk][4 * rg + 3] * rr * gv.w);
          *(uint2*)(orow + dv) = w; }
    }
    __syncthreads();
  }
}

template <int ABL = 0> DEVI void phase_attnB(const Params& p, ldsp_t lds) {
  typedef Geo<64, 2> G;
  const int tid = ftid(), lane = tid & 63, wave = __builtin_amdgcn_readfirstlane(tid >> 6), r32 = lane & 31, hi = lane >> 5;
  const bf16_t* Q = (const bf16_t*)(p.ws + WS_QKV0); bf16_t* ATT = (bf16_t*)(p.ws + (ABL ? WS_MIX0 : WS_ATT0));
  constexpr int NU_LAT = NB * 8 * 16, NU_CTX = NB * 8;
  FA_LAS float* RPB = (FA_LAS float*)(lds + 3 * (64 * 80 + 64 * 80));
  for (int u = vblock(); u < NU_LAT + NU_CTX; u += gridDim.x) {
    const bool lat = u < NU_LAT;
    int b, h, qrow_g = 0, c0 = 0, rlo = 0, nlat = 0, rs_w = 0, grow;
    if (lat) { b = u >> 7; h = (u >> 4) & 7; const int qr0 = (u & 15) * 4; qrow_g = qr0 + (wave >> 1); c0 = 32 * (wave & 1);
      rlo = min(max(qr0 - 4, 0), 56); const int rhi = min(max(qr0 - 1, 0), 56) + 7; nlat = rhi - rlo + 1; rs_w = min(max(qrow_g - 4, 0), 56);
      grow = b * SEQ + qrow_g * 64 + c0 + r32; }
    else { const int v = u - NU_LAT; b = v >> 3; h = v & 7; grow = NLAT + b * CTXL + wave * 32 + r32; }
    const int ntiles = nlat + 4;
    for (int i = tid; i < 15 * 31; i += NT) RPB[i] = p.in[L0_RPB][h * 465 + i] * LOG2E;
    const unsigned char* QK8 = (const unsigned char*)(p.ws + WS_QKV0);
    v8i_t qf;
    { const unsigned char* qp = QK8 + (size_t)grow * (N_IN0 * 2) + 1536 + h * 64 + 32 * hi; const u32x4 q0_ = *(const u32x4*)qp, q1_ = *(const u32x4*)(qp + 16); qf = cat8(q0_, q1_); }
    f32x16 o[2];
#pragma unroll
    for (int bk = 0; bk < 2; ++bk)
#pragma unroll
      for (int r = 0; r < 16; ++r) o[bk][r] = 0.f;
    float m = -1e30f, l = 0.f;
    const int cbase = NLAT + b * CTXL, lbase = b * SEQ;
    const int qc = c0 + r32, cs = min(max(qc - 8, 0), 48);
    flash_pass8<2, 64, false>(lds, ntiles, QK8, N_IN0 * 2, 2048 + h * 64, (const unsigned char*)(p.ws + WS_VTB) + (size_t)((b * 8 + h) * 64) * 4352, qf, 0,
      [&](int kt, int i) { return kt < nlat ? lbase + (rlo + kt) * 64 + i : cbase + (kt - nlat) * 64 + i; },
      [&](int kt) { return kt < nlat ? (rlo + kt) * 64 : 4096 + (kt - nlat) * 64; },
      [&](int kt, f32x16& p0, f32x16& p1) {
        if (ABL != 1 && kt < nlat) { const int kr = rlo + kt; const bool rowok = (kr >= rs_w && kr < rs_w + 8);
          const FA_LAS float* bp = RPB + min(max(kr - qrow_g + 7, 0), 14) * 31;
          { float b0[16];
#pragma unroll
            for (int r = 0; r < 16; ++r) { const int k0 = crow(r, hi); b0[r] = bp[min(max(k0 - qc + 15, 0), 30)]; }
#pragma unroll
            for (int r = 0; r < 16; ++r) { const int k0 = crow(r, hi); const float v0 = p0[r] + b0[r]; p0[r] = (rowok && k0 >= cs && k0 < cs + 16) ? v0 : -INFINITY; } }
          asm volatile("" ::: "memory");
          { float b1[16];
#pragma unroll
            for (int r = 0; r < 16; ++r) { const int k1 = 32 + crow(r, hi); b1[r] = bp[min(max(k1 - qc + 15, 0), 30)]; }
#pragma unroll
            for (int r = 0; r < 16; ++r) { const int k1 = 32 + crow(r, hi); const float v1 = p1[r] + b1[r]; p1[r] = (rowok && k1 >= cs && k1 < cs + 16) ? v1 : -INFINITY; } } } },
      o, m, l);
    l += __shfl_xor(l, 32);
    const float inv = 1.f / l;
    bf16_t* orow = ATT + (size_t)grow * DM + 512 + h * 64;
#pragma unroll
    for (int bk = 0; bk < 2; ++bk)
#pragma unroll
      for (int rg = 0; rg < 4; ++rg) { const int dv = bk * 32 + 8 * rg + 4 * hi;
        uint2 w; w.x = cvtpk(o[bk][4 * rg] * inv, o[bk][4 * rg + 1] * inv); w.y = cvtpk(o[bk][4 * rg + 2] * inv, o[bk][4 * rg + 3] * inv);
        *(uint2*)(orow + dv) = w; }
    __syncthreads();
  }
}

DEVI void phase_attnC(const Params& p, ldsp_t lds, int* ctr) {
  const int tid = ftid(), lane = tid & 63, wave = __builtin_amdgcn_readfirstlane(tid >> 6), r32 = lane & 31, hi = lane >> 5;
  const bf16_t* P1 = (const bf16_t*)(p.ws + WS_P1); bf16_t* ATT = (bf16_t*)(p.ws + WS_ATT1);
  FA_LAS int* uq = (FA_LAS int*)(lds + 3 * Geo<64, 2>::STAGE + 64);
  for (;;) {
    if (tid == 0) *uq = atomicAdd(ctr, 1);
    __syncthreads();
    const int u = *uq;
    __syncthreads();
    if (u >= NB * 2 * 64) break;
    const int b = u >> 7, g = (u >> 6) & 1, tq = u & 63, hq = g * 4 + (wave >> 1), t = tq * 64 + 32 * (wave & 1) + r32, grow = b * SEQ + t;
    const int klo = max(tq - 2, 0), khi = min(tq + 2, 63), nwin = khi - klo + 1, ntiles = nwin + 4;
    bf16x8 q[4];
#pragma unroll
    for (int d0 = 0; d0 < 4; ++d0) q[d0] = load_q8(P1 + (size_t)grow * 2304 + hq * 64 + 16 * d0 + 8 * hi, C2);
    f32x16 o[2];
#pragma unroll
    for (int bk = 0; bk < 2; ++bk)
#pragma unroll
      for (int r = 0; r < 16; ++r) o[bk][r] = 0.f;
    float m = -1e30f, l = 0.f;
    const int cbase = NLAT + b * CTXL, lbase = b * SEQ;
    flash_pass2<64, 2, 0, 2>(lds, ntiles, P1, 2304, 512 + g * 64, 640 + g * 64, q, 0,
      [&](int kt, int i) { return kt < nwin ? lbase + (klo + kt) * 64 + i : cbase + (kt - nwin) * 64 + i; },
      [&](int kt, f32x16& p0, f32x16& p1) {
        if (kt < nwin) { const int kp = (klo + kt) * 64 - t;
#pragma unroll
          for (int r = 0; r < 16; ++r) { const int d0 = kp + crow(r, hi), d1 = d0 + 32;
            if (d0 < -128 || d0 > 128) p0[r] = -INFINITY; if (d1 < -128 || d1 > 128) p1[r] = -INFINITY; } } },
      o, m, l);
    l += __shfl_xor(l, 32);
    { const float sk = p.in[L1_SINKS][hq] * LOG2E, mn = fmaxf(m, sk), alpha = __builtin_amdgcn_exp2f(m - mn);
      l = l * alpha + __builtin_amdgcn_exp2f(sk - mn);
#pragma unroll
      for (int bk = 0; bk < 2; ++bk)
#pragma unroll
        for (int r = 0; r < 16; ++r) o[bk][r] *= alpha; }
    const float inv = 1.f / l;
    bf16_t* orow = ATT + (size_t)grow * DM + hq * 64;
#pragma unroll
    for (int bk = 0; bk < 2; ++bk)
#pragma unroll
      for (int rg = 0; rg < 4; ++rg) { const int dv = bk * 32 + 8 * rg + 4 * hi;
        uint2 w; w.x = cvtpk(o[bk][4 * rg] * inv, o[bk][4 * rg + 1] * inv); w.y = cvtpk(o[bk][4 * rg + 2] * inv, o[bk][4 * rg + 3] * inv);
        *(uint2*)(orow + dv) = w; }
    __syncthreads();
  }
}
}
namespace fs {
using fa::bf16x8; using fa::s16x4; using fa::f32x16; using fa::ldsp_t; using fa::u32x4; using fa::cvtpk; using fa::vtr; using fa::crow; using fa::LOG2E;
typedef unsigned u32x2 __attribute__((ext_vector_type(2)));

DEVI void phase_conv(const Params& p) {
  const bf16_t* P1 = (const bf16_t*)(p.ws + WS_P1); bf16_t* U = (bf16_t*)(p.ws + WS_U);
  const float* cw = p.in[L1_CONVW]; const float* cb = p.in[L1_CONVB];
  const int nitems = (NROW / 16) * 128;
  for (int it = blockIdx.x * NT + ftid(); it < nitems; it += gridDim.x * NT) {
    const int cg = it & 127, rc = it >> 7, r0 = rc * 16, ch = cg * 8;
    int s0, len; if (r0 < NLAT) { s0 = r0 & ~4095; len = SEQ; } else { s0 = NLAT + ((r0 - NLAT) & ~255); len = CTXL; }
    const int t0 = r0 - s0;
    float w[5][8], bias[8];
#pragma unroll
    for (int j = 0; j < 5; ++j) { const float4 a = *(const float4*)(cw + j * 1024 + ch), b = *(const float4*)(cw + j * 1024 + ch + 4);
      w[j][0] = a.x; w[j][1] = a.y; w[j][2] = a.z; w[j][3] = a.w; w[j][4] = b.x; w[j][5] = b.y; w[j][6] = b.z; w[j][7] = b.w; }
    { const float4 a = *(const float4*)(cb + ch), b = *(const float4*)(cb + ch + 4); bias[0] = a.x; bias[1] = a.y; bias[2] = a.z; bias[3] = a.w; bias[4] = b.x; bias[5] = b.y; bias[6] = b.z; bias[7] = b.w; }
    float win[5][8];
    auto ldrow = [&](int t, float (&d)[8]) {
      if (t < 0 || t >= len) {
#pragma unroll
        for (int k = 0; k < 8; ++k) d[k] = 0.f; return; }
      const u32x4 v = *(const u32x4*)(P1 + (size_t)(s0 + t) * 2304 + 768 + ch);
#pragma unroll
      for (int k = 0; k < 4; ++k) { d[2 * k] = __uint_as_float(v[k] << 16); d[2 * k + 1] = __uint_as_float(v[k] & 0xffff0000u); } };
    ldrow(t0 - 2, win[0]); ldrow(t0 - 1, win[1]); ldrow(t0, win[2]); ldrow(t0 + 1, win[3]);
#pragma unroll
    for (int i = 0; i < 16; ++i) {
      ldrow(t0 + i + 2, win[(i + 4) % 5]);
      float o[8];
#pragma unroll
      for (int k = 0; k < 8; ++k) { float a = bias[k];
#pragma unroll
        for (int j = 0; j < 5; ++j) a += w[j][k] * win[(i + j) % 5][k];
        o[k] = a * __builtin_amdgcn_rcpf(1.f + __expf(-a)); }
      u32x4 ov; ov[0] = cvtpk(o[0], o[1]); ov[1] = cvtpk(o[2], o[3]); ov[2] = cvtpk(o[4], o[5]); ov[3] = cvtpk(o[6], o[7]);
      *(u32x4*)(U + (size_t)(r0 + i) * 1024 + ch) = ov;
    }
  }
}

DEVI float softplus_f(float v) { if (v > 20.f) return v; const float x = __expf(v); return x < 1e-3f ? x * (1.f - 0.5f * x) : __logf(1.f + x); }
constexpr int BSTR = 272, XSTR = 192;
constexpr int L_BM = 0, L_XD = 128 * BSTR, L_XW = L_XD + 128 * XSTR, L_HT = L_XW + 128 * XSTR, L_CUM = L_HT + 128 * XSTR, L_DTV = L_CUM + 512, L_XCH = L_DTV + 512, L_TOT = L_XCH + 8 * 4096;

template <int ABL = 0> DEVI void phase_ssd(const Params& p, ldsp_t lds) {
  const int tid = ftid(), lane = tid & 63, wave = __builtin_amdgcn_readfirstlane(tid >> 6), r32 = lane & 31, hi = lane >> 5;
  const int pb = wave >> 2, lb = (wave < 4) ? (wave & 3) : 3 - (wave & 3);
  const bf16_t* U = (const bf16_t*)(p.ws + WS_U); const float* DT = (const float*)(p.ws + WS_DT);
  bf16_t* YFB = (bf16_t*)(p.ws + WS_YS);
  FA_LAS float* CUM = (FA_LAS float*)(lds + L_CUM); FA_LAS float* DTV = (FA_LAS float*)(lds + L_DTV);
  const int trow_off = 4 * hi + ((lane & 15) >> 2), tcol_off = 32 * ((lane >> 4) & 1) + 8 * (lane & 3);
  for (int it = blockIdx.x; it < NB * 2 * 8; it += gridDim.x) {
    const int b = it >> 4, dir = (it >> 3) & 1, hd = it & 7, g = hd >> 2;
    const float a2 = -expf(p.in[dir ? L1_ALOGB : L1_ALOGF][hd]) * LOG2E; const float dtb = p.in[dir ? L1_DTBB : L1_DTBF][hd];
    auto tokrow = [&](int c, int i) { const int seg = c >= 2, len = seg ? SEQ : CTXL, j = (seg ? c - 2 : c) * 128 + i; return (seg ? b * SEQ : NLAT + b * CTXL) + (dir ? len - 1 - j : j); };
    f32x16 hacc;
#pragma unroll
    for (int r = 0; r < 16; ++r) hacc[r] = 0.f;
    for (int i = tid; i < 128 * XSTR / 4; i += NT) ((FA_LAS unsigned*)(lds + L_HT))[i] = 0u;
    u32x4 sb_[4], sx_[2]; float sdt0 = 0.f, sdt1 = 0.f; bf16x8 cfn[8];
    auto prefetch = [&](int c) {
#pragma unroll
      for (int i = 0; i < 4; ++i) { const int ch = tid + NT * i; sb_[i] = *(const u32x4*)(U + (size_t)tokrow(c, ch >> 4) * 1024 + 512 + g * 128 + (ch & 15) * 8); }
#pragma unroll
      for (int i = 0; i < 2; ++i) { const int ch = tid + NT * i; sx_[i] = *(const u32x4*)(U + (size_t)tokrow(c, ch >> 3) * 1024 + hd * 64 + (ch & 7) * 8); }
      if (tid < 64) { sdt0 = DT[(size_t)tokrow(c, 2 * tid) * 16 + dir * 8 + hd]; sdt1 = DT[(size_t)tokrow(c, 2 * tid + 1) * 16 + dir * 8 + hd]; }
      const bf16_t* crowp = U + (size_t)tokrow(c, lb * 32 + r32) * 1024 + 768 + g * 128 + 8 * hi;
#pragma unroll
      for (int ks = 0; ks < 8; ++ks) cfn[ks] = *(const bf16x8*)(crowp + 16 * ks);
    };
    prefetch(0);
    __syncthreads();
    for (int c = 0; c < 34; ++c) {
      if (tid < 64) {
        const float r0 = sdt0 + dtb, r1 = sdt1 + dtb; const float d0 = softplus_f(r0), d1 = softplus_f(r1);
        const float a0 = d0 * a2, a1 = d1 * a2; float v = a0 + a1;
#pragma unroll
        for (int o = 1; o < 64; o <<= 1) { const float t = __shfl_up(v, o); if (lane >= o) v += t; }
        DTV[2 * tid] = d0; DTV[2 * tid + 1] = d1; CUM[2 * tid] = v - a1; CUM[2 * tid + 1] = v;
      }
      __syncthreads();
      const float cl = CUM[127];
#pragma unroll
      for (int i = 0; i < 4; ++i) { const int ch = tid + NT * i; *(FA_LAS u32x4*)(lds + L_BM + (ch >> 4) * BSTR + (ch & 15) * 16) = sb_[i]; }
#pragma unroll
      for (int i = 0; i < 2; ++i) { const int ch = tid + NT * i, s = ch >> 3; const float d = DTV[s], wv = d * __builtin_amdgcn_exp2f(cl - CUM[s]);
        u32x4 xd, xw;
#pragma unroll
        for (int k = 0; k < 4; ++k) { const float x0 = __uint_as_float(sx_[i][k] << 16), x1 = __uint_as_float(sx_[i][k] & 0xffff0000u); xd[k] = cvtpk(x0 * d, x1 * d); xw[k] = cvtpk(x0 * wv, x1 * wv); }
        *(FA_LAS u32x4*)(lds + L_XD + s * XSTR + (ch & 7) * 16) = xd; *(FA_LAS u32x4*)(lds + L_XW + s * XSTR + (ch & 7) * 16) = xw; }
      bf16x8 cf[8];
#pragma unroll
      for (int ks = 0; ks < 8; ++ks) cf[ks] = cfn[ks];
      __syncthreads();
      if (ABL != 3) { if (c + 1 < 34) prefetch(c + 1); }
      if (c >= 2 && ABL != 1) {
        f32x16 y;
#pragma unroll
        for (int r = 0; r < 16; ++r) y[r] = 0.f;
        { const ldsp_t hb = lds + L_HT + (8 * hi + ((lane & 15) >> 2)) * XSTR + pb * 64 + tcol_off;
          f32x16 y2;
#pragma unroll
          for (int r = 0; r < 16; ++r) y2[r] = 0.f;
#pragma unroll
          for (int ks = 0; ks < 8; ++ks) { const s16x4 lo = vtr(hb + (16 * ks) * XSTR), h8 = vtr(hb + (16 * ks + 4) * XSTR);
            const bf16x8 hf = {lo[0], lo[1], lo[2], lo[3], h8[0], h8[1], h8[2], h8[3]};
            if (ks & 1) y2 = __builtin_amdgcn_mfma_f32_32x32x16_bf16(hf, cf[ks], y2, 0, 0, 0); else y = __builtin_amdgcn_mfma_f32_32x32x16_bf16(hf, cf[ks], y, 0, 0, 0); }
          y += y2; }
        const float cuml = CUM[lb * 32 + r32];
        { const float e = __builtin_amdgcn_exp2f(cuml);
#pragma unroll
          for (int r = 0; r < 16; ++r) y[r] *= e; }
        f32x16 yo;
#pragma unroll
        for (int r = 0; r < 16; ++r) yo[r] = 0.f;
        for (int sb = pb; sb <= lb; sb += 2) {
          f32x16 gt, gt2;
#pragma unroll
          for (int r = 0; r < 16; ++r) { gt[r] = 0.f; gt2[r] = 0.f; }
          const ldsp_t bb = lds + L_BM + (sb * 32 + r32) * BSTR + 16 * hi;
#pragma unroll
          for (int ks = 0; ks < 8; ks += 2) { gt = __builtin_amdgcn_mfma_f32_32x32x16_bf16(*(const FA_LAS bf16x8*)(bb + 32 * ks), cf[ks], gt, 0, 0, 0);
            gt2 = __builtin_amdgcn_mfma_f32_32x32x16_bf16(*(const FA_LAS bf16x8*)(bb + 32 * ks + 32), cf[ks + 1], gt2, 0, 0, 0); }
          gt += gt2;
          const bool diag = (sb == lb);
#pragma unroll
          for (int r = 0; r < 16; ++r) { const int sl = crow(r, hi); const float v = gt[r] * __builtin_amdgcn_exp2f(cuml - CUM[sb * 32 + sl]); gt[r] = (diag && sl > r32) ? 0.f : v; }
          u32x4 t0, t1;
          t0[0] = cvtpk(gt[0], gt[1]); t0[1] = cvtpk(gt[2], gt[3]); t0[2] = cvtpk(gt[4], gt[5]); t0[3] = cvtpk(gt[6], gt[7]);
          t1[0] = cvtpk(gt[8], gt[9]); t1[1] = cvtpk(gt[10], gt[11]); t1[2] = cvtpk(gt[12], gt[13]); t1[3] = cvtpk(gt[14], gt[15]);
          const bf16x8 pm0 = __builtin_bit_cast(bf16x8, t0), pm1 = __builtin_bit_cast(bf16x8, t1);
          const ldsp_t xb = lds + L_XD + (sb * 32 + trow_off) * XSTR + pb * 64 + tcol_off;
          const ldsp_t xo = lds + L_XD + (sb * 32 + trow_off) * XSTR + (1 - pb) * 64 + tcol_off;
          const s16x4 a0 = vtr(xb), a1 = vtr(xb + 8 * XSTR), a2 = vtr(xb + 16 * XSTR), a3 = vtr(xb + 24 * XSTR);
          const s16x4 b0 = vtr(xo), b1 = vtr(xo + 8 * XSTR), b2 = vtr(xo + 16 * XSTR), b3 = vtr(xo + 24 * XSTR);
          { const bf16x8 xf = {a0[0], a0[1], a0[2], a0[3], a1[0], a1[1], a1[2], a1[3]}; y = __builtin_amdgcn_mfma_f32_32x32x16_bf16(xf, pm0, y, 0, 0, 0); }
          { const bf16x8 xf = {b0[0], b0[1], b0[2], b0[3], b1[0], b1[1], b1[2], b1[3]}; yo = __builtin_amdgcn_mfma_f32_32x32x16_bf16(xf, pm0, yo, 0, 0, 0); }
          { const bf16x8 xf = {a2[0], a2[1], a2[2], a2[3], a3[0], a3[1], a3[2], a3[3]}; y = __builtin_amdgcn_mfma_f32_32x32x16_bf16(xf, pm1, y, 0, 0, 0); }
          { const bf16x8 xf = {b2[0], b2[1], b2[2], b2[3], b3[0], b3[1], b3[2], b3[3]}; yo = __builtin_amdgcn_mfma_f32_32x32x16_bf16(xf, pm1, yo, 0, 0, 0); }
        }
        { FA_LAS float* X = (FA_LAS float*)(lds + L_XCH) + (pb * 4 + lb) * 1024;
#pragma unroll
          for (int r = 0; r < 16; ++r) X[r * 64 + lane] = yo[r]; }
        __syncthreads();
        { const FA_LAS float* X = (const FA_LAS float*)(lds + L_XCH) + ((1 - pb) * 4 + lb) * 1024;
#pragma unroll
          for (int r = 0; r < 16; ++r) y[r] += X[r * 64 + lane]; }
        const int j = (c - 2) * 128 + lb * 32 + r32, tok = dir ? SEQ - 1 - j : j;
        bf16_t* yp = YFB + ((size_t)dir * NLAT + (size_t)b * SEQ + tok) * 512 + hd * 64 + pb * 32 + 4 * hi;
#pragma unroll
        for (int rg = 0; rg < 4; ++rg) { u32x2 w; w[0] = cvtpk(y[4 * rg], y[4 * rg + 1]); w[1] = cvtpk(y[4 * rg + 2], y[4 * rg + 3]); *(u32x2*)(yp + 8 * rg) = w; }
      }
      if (ABL != 2) { const float e = __builtin_amdgcn_exp2f(cl);
        f32x16 h2;
#pragma unroll
        for (int r = 0; r < 16; ++r) { hacc[r] *= e; h2[r] = 0.f; }
        const ldsp_t xb = lds + L_XW + (8 * hi + ((lane & 15) >> 2)) * XSTR + pb * 64 + tcol_off;
        const ldsp_t bb = lds + L_BM + (8 * hi + ((lane & 15) >> 2)) * BSTR + lb * 64 + tcol_off;
#pragma unroll
        for (int ks = 0; ks < 8; ++ks) {
          const s16x4 xl = vtr(xb + (16 * ks) * XSTR), xh = vtr(xb + (16 * ks + 4) * XSTR), bl = vtr(bb + (16 * ks) * BSTR), bh = vtr(bb + (16 * ks + 4) * BSTR);
          const bf16x8 xf = {xl[0], xl[1], xl[2], xl[3], xh[0], xh[1], xh[2], xh[3]}, bf = {bl[0], bl[1], bl[2], bl[3], bh[0], bh[1], bh[2], bh[3]};
          if (ks & 1) h2 = __builtin_amdgcn_mfma_f32_32x32x16_bf16(xf, bf, h2, 0, 0, 0); else hacc = __builtin_amdgcn_mfma_f32_32x32x16_bf16(xf, bf, hacc, 0, 0, 0);
        }
        hacc += h2; }
      __syncthreads();
      { const ldsp_t hp = lds + L_HT + (lb * 32 + r32) * XSTR + (pb * 32 + 4 * hi) * 2;
#pragma unroll
        for (int rg = 0; rg < 4; ++rg) { u32x2 w; w[0] = cvtpk(hacc[4 * rg], hacc[4 * rg + 1]); w[1] = cvtpk(hacc[4 * rg + 2], hacc[4 * rg + 3]); *(FA_LAS u32x2*)(hp + 16 * rg) = w; } }
    }
    __syncthreads();
  }
}

DEVI void phase_ssd_out(const Params& p) {
  const int lane = ftid() & 63, gw = blockIdx.x * NWAVE + (ftid() >> 6), NGW = gridDim.x * NWAVE;
  const bf16_t* U = (const bf16_t*)(p.ws + WS_U); const bf16_t* P1 = (const bf16_t*)(p.ws + WS_P1); const bf16_t* YFB = (const bf16_t*)(p.ws + WS_YS);
  bf16_t* ATT = (bf16_t*)(p.ws + WS_ATT1);
  for (int r = gw; r < NLAT; r += NGW) {
    const int c0 = lane * 8, hd = c0 >> 6; const float dsk = p.in[L1_DSKIP][hd];
    const u32x4 yf = *(const u32x4*)(YFB + (size_t)r * 512 + c0), yb = *(const u32x4*)(YFB + ((size_t)NLAT + r) * 512 + c0);
    const u32x4 xw = *(const u32x4*)(U + (size_t)r * 1024 + c0), zw = *(const u32x4*)(P1 + (size_t)r * 2304 + 1792 + c0);
    float y[8]; float ss = 0.f;
#pragma unroll
    for (int i = 0; i < 4; ++i) {
      const float x0 = __uint_as_float(xw[i] << 16), x1 = __uint_as_float(xw[i] & 0xffff0000u), z0 = __uint_as_float(zw[i] << 16), z1 = __uint_as_float(zw[i] & 0xffff0000u);
      const float f0 = __uint_as_float(yf[i] << 16) + __uint_as_float(yb[i] << 16), f1 = __uint_as_float(yf[i] & 0xffff0000u) + __uint_as_float(yb[i] & 0xffff0000u);
      y[2 * i] = (f0 + dsk * x0) * silu_f(z0); y[2 * i + 1] = (f1 + dsk * x1) * silu_f(z1);
      ss += y[2 * i] * y[2 * i] + y[2 * i + 1] * y[2 * i + 1];
    }
#pragma unroll
    for (int o = 1; o < 32; o <<= 1) ss += __shfl_xor(ss, o);
    const float rr = rsqrtf(ss * (1.f / 256.f) + EPS);
    const float4 g0 = *(const float4*)(p.in[L1_GNORM] + c0), g1 = *(const float4*)(p.in[L1_GNORM] + c0 + 4);
    u32x4 w; w[0] = cvtpk(y[0] * rr * g0.x, y[1] * rr * g0.y); w[1] = cvtpk(y[2] * rr * g0.z, y[3] * rr * g0.w); w[2] = cvtpk(y[4] * rr * g1.x, y[5] * rr * g1.y); w[3] = cvtpk(y[6] * rr * g1.z, y[7] * rr * g1.w);
    *(u32x4*)(ATT + (size_t)r * DM + 512 + c0) = w;
  }
}
}
#ifndef TOPK_COPY
#define TOPK_COPY false
#endif
namespace ft {
using fa::ldsp_t; using fa::u32x4;

DEVI int block_excl_scan(int v, FA_LAS int* wsum, int tid, int* tot) {
  const int lane = tid & 63, wave = tid >> 6;
  int inc = v;
#pragma unroll
  for (int o = 1; o < 64; o <<= 1) { const int t = __shfl_up(inc, o); if (lane >= o) inc += t; }
  __syncthreads();
  if (lane == 63) wsum[wave] = inc;
  __syncthreads();
  int base = 0, total = 0;
#pragma unroll
  for (int w = 0; w < 8; ++w) { const int s = wsum[w]; if (w < wave) base += s; total += s; }
  *tot = total;
  return base + inc - v;
}

template <int EPT, bool GATHER_COPY>
DEVI void topk_item(const Params& p, ldsp_t lds, int e, int n, int cap, int row0, int slot0, int erows) {
  const int tid = ftid(), lane = tid & 63, wave = tid >> 6;
  const float* AFFT = (const float*)(p.ws + WS_AFF); int* SLOT = (int*)(p.ws + WS_SLOT); float* GV = (float*)(p.ws + WS_GATEV);
  const bf16_t* H = (const bf16_t*)(p.ws + WS_H); bf16_t* XG = (bf16_t*)(p.ws + WS_XG); int* IDX = (int*)(p.ws + WS_IDX);
  FA_LAS unsigned* hist = (FA_LAS unsigned*)lds;
  FA_LAS int* misc = (FA_LAS int*)(lds + 1024);
  FA_LAS int* wsum = (FA_LAS int*)(lds + 1024 + 64);
  FA_LAS int* list = (FA_LAS int*)(lds + 2048);
  const bool act = tid * EPT < n;
  unsigned key[EPT];
#pragma unroll
  for (int j = 0; j < EPT; ++j) key[j] = act ? __float_as_uint(AFFT[(size_t)e * NROW + row0 + tid * EPT + j]) : 0u;
  unsigned prefix = 0u, mask = 0u; int k = cap;
#pragma unroll 1
  for (int pass = 0; pass < 4; ++pass) {
    const int shift = 24 - 8 * pass;
    __syncthreads();
    if (tid < 256) hist[tid] = 0u;
    __syncthreads();
    if (act) {
#pragma unroll
      for (int j = 0; j < EPT; ++j) if ((key[j] & mask) == prefix) atomicAdd((unsigned*)&hist[(key[j] >> shift) & 255u], 1u);
    }
    __syncthreads();
    if (wave == 0) {
      const int h0 = hist[4 * lane], h1 = hist[4 * lane + 1], h2 = hist[4 * lane + 2], h3 = hist[4 * lane + 3];
      const int s = h0 + h1 + h2 + h3; int v = s;
#pragma unroll
      for (int o = 1; o < 64; o <<= 1) { const int t = __shfl_down(v, o); if (lane + o < 64) v += t; }
      int c = v - s;
      const int hh[4] = {h0, h1, h2, h3};
#pragma unroll
      for (int b = 3; b >= 0; --b) { if (c < k && k <= c + hh[b]) { misc[0] = 4 * lane + b; misc[1] = k - c; } c += hh[b]; }
    }
    __syncthreads();
    prefix |= ((unsigned)misc[0]) << shift; mask |= 255u << shift; k = misc[1];
  }
  int ce = 0;
#pragma unroll
  for (int j = 0; j < EPT; ++j) ce += (act && key[j] == prefix) ? 1 : 0;
  int tot; const int eq_before = block_excl_scan(ce, wsum, tid, &tot);
  int cs = 0, eqr = eq_before; bool sel[EPT];
#pragma unroll
  for (int j = 0; j < EPT; ++j) { bool s = false; if (act) { if (key[j] > prefix) s = true; else if (key[j] == prefix) { s = eqr < k; ++eqr; } } sel[j] = s; cs += s ? 1 : 0; }
  int slot = block_excl_scan(cs, wsum, tid, &tot);
  if (act) {
#pragma unroll
    for (int j = 0; j < EPT; ++j) { const int row = row0 + tid * EPT + j;
      if (sel[j]) { if (GATHER_COPY) list[slot] = row; else IDX[e * erows + slot0 + slot] = row; GV[e * erows + slot0 + slot] = __uint_as_float(key[j]); SLOT[(size_t)row * 16 + e] = slot0 + slot; ++slot; }
      else SLOT[(size_t)row * 16 + e] = -1; }
  }
  if (GATHER_COPY) {
    __syncthreads();
    for (int s = wave; s < cap; s += NWAVE) {
      const u32x4* src = (const u32x4*)(H + (size_t)list[s] * DM) + lane; u32x4* dst = (u32x4*)(XG + ((size_t)e * erows + slot0 + s) * DM) + lane;
      const u32x4 a = src[0], b2 = src[64]; dst[0] = a; dst[64] = b2;
    }
  }
  __syncthreads();
}

DEVI void phase_topk(const Params& p, ldsp_t lds, int layer) {
  const int erows = layer ? EROWS1 : EROWS0;
  const int nlat = NB * NE, nitems = nlat + (layer ? 0 : NB * NE);
  const int G = gridDim.x;
  for (int it = blockIdx.x; it < nitems; it += G) {
    if (it < nlat) { const int b = it / NE, e = it % NE; topk_item<8, TOPK_COPY>(p, lds, e, SEQ, CAP_L, b * SEQ, b * CAP_L, erows); }
    else { const int i2 = it - nlat, b = i2 / NE, e = i2 % NE; topk_item<1, TOPK_COPY>(p, lds, e, CTXL, CAP_C, NLAT + b * CTXL, NB * CAP_L + b * CAP_C, erows); }
  }
}
}
#ifndef MOE1_FP8
#define MOE1_FP8 1
#endif
#ifndef MOE0_FP8
#define MOE0_FP8 1
#endif
namespace fr {
using fa::ldsp_t; using fa::u32x4; using fa::cvtpk;
typedef unsigned u32x2 __attribute__((ext_vector_type(2)));
typedef float f32x4 __attribute__((ext_vector_type(4)));
struct V16 { f32x4 v[4]; };
DEVI V16 ldf(const float* r, int lane) { V16 o; const f32x4* q = (const f32x4*)r + lane;
#pragma unroll
  for (int j = 0; j < 4; ++j) o.v[j] = q[64 * j]; return o; }
struct B16 { u32x2 v[4]; };
DEVI B16 ldb_raw(const bf16_t* r, int lane) { B16 o; const u32x2* q = (const u32x2*)r + lane;
#pragma unroll
  for (int j = 0; j < 4; ++j) o.v[j] = q[64 * j]; return o; }
DEVI V16 b2v(const B16& b) { V16 o;
#pragma unroll
  for (int j = 0; j < 4; ++j) { o.v[j][0] = __uint_as_float(b.v[j][0] << 16); o.v[j][1] = __uint_as_float(b.v[j][0] & 0xffff0000u); o.v[j][2] = __uint_as_float(b.v[j][1] << 16); o.v[j][3] = __uint_as_float(b.v[j][1] & 0xffff0000u); }
  return o; }
DEVI void stf(float* r, int lane, const V16& o) { f32x4* q = (f32x4*)r + lane;
#pragma unroll
  for (int j = 0; j < 4; ++j) q[64 * j] = o.v[j]; }
DEVI void stb(bf16_t* r, int lane, const V16& o) { u32x2* q = (u32x2*)r + lane;
#pragma unroll
  for (int j = 0; j < 4; ++j) { u32x2 w; w[0] = cvtpk(o.v[j][0], o.v[j][1]); w[1] = cvtpk(o.v[j][2], o.v[j][3]); q[64 * j] = w; } }
DEVI float sumsq(const V16& o) { f32x4 s = o.v[0] * o.v[0];
#pragma unroll
  for (int j = 1; j < 4; ++j) s += o.v[j] * o.v[j];
  return wave_sum((s[0] + s[1]) + (s[2] + s[3])); }

DEVI void phase_prenorm0(const Params& p) {
  const int lane = ftid() & 63, gw = blockIdx.x * NWAVE + (ftid() >> 6), NGW = gridDim.x * NWAVE;
  const float* MOD = (const float*)(p.ws + WS_CTL + CTL_MOD); bf16_t* H = (bf16_t*)(p.ws + WS_H);
  const int rpw = (NROW + NGW - 1) / NGW;
  const int r0 = gw * rpw, r1 = min(r0 + rpw, NROW);
  if (r0 >= r1) return;
  const V16 g = ldf(p.in[L0_GPREMIX], lane);
  int cur = -1; V16 gs, sh;
  auto src = [&](int r) { return r < NLAT ? p.in[I_X] + (size_t)r * DM : p.in[I_CTX] + (size_t)(r - NLAT) * DM; };
  V16 xn = ldf(src(r0), lane), xn2 = xn;
  if (r0 + 1 < r1) xn2 = ldf(src(r0 + 1), lane);
  for (int r = r0; r < r1; ++r) {
    const V16 x = xn; xn = xn2; if (r + 2 < r1) xn2 = ldf(src(r + 2), lane);
    const int mr = row_modrow(r);
    if (mr != cur) { cur = mr; const float* m = MOD + (size_t)mr * 6144; const V16 sc = ldf(m + 1024, lane); sh = ldf(m, lane);
#pragma unroll
      for (int j = 0; j < 4; ++j) gs.v[j] = g.v[j] * (sc.v[j] + 1.f); }
    const float rr = rsqrtf(sumsq(x) * (1.f / DM) + EPS);
    V16 h;
#pragma unroll
    for (int j = 0; j < 4; ++j) h.v[j] = x.v[j] * rr * gs.v[j] + sh.v[j];
    if (QKV0_FP8) {
      unsigned* q8 = (unsigned*)((unsigned char*)H + (size_t)r * DM) + lane;
#pragma unroll
      for (int j = 0; j < 4; ++j) q8[64 * j] = nv::pack4_fp8(h.v[j][0] * nv::A8_SCALE, h.v[j][1] * nv::A8_SCALE, h.v[j][2] * nv::A8_SCALE, h.v[j][3] * nv::A8_SCALE);
    } else stb(H + (size_t)r * DM, lane, h);
  }
}

template <int ABL = 0> DEVI void phase_postmix(const Params& p, ldsp_t lds, int layer) {
  const int tid = ftid(), lane = tid & 63, gw = blockIdx.x * NWAVE + (tid >> 6), NGW = gridDim.x * NWAVE;
  const float* MOD = (const float*)(p.ws + WS_CTL + CTL_MOD) + (size_t)layer * 9 * 6144;
  const bf16_t* MIX = (const bf16_t*)(p.ws + (layer ? WS_MIX1 : WS_MIX0));
  bf16_t* H = (bf16_t*)(p.ws + WS_H); float* AFFT = (float*)(p.ws + WS_AFF); float* XC = (float*)(p.ws + WS_XC);
  const float* wr = p.in[layer ? L1_WROUTER : L0_WROUTER];
  FA_LAS f32x4* WL = (FA_LAS f32x4*)lds;
  for (int i = tid; i < 1024 * 4; i += NT) { const int k = i >> 2, e4 = i & 3; const int ln = (k & 255) >> 2, q = k & 3, j = k >> 8;
    WL[((j * 4 + q) * 4 + e4) * 64 + ln] = *(const f32x4*)(wr + (size_t)k * 16 + e4 * 4); }
  __syncthreads();
  const int nrow = layer ? NLAT : NROW;
  const int rpw = (nrow + NGW - 1) / NGW;
  const int r0 = gw * rpw, r1 = min(r0 + rpw, nrow);
  if (r0 >= r1) return;
  const V16 gpost = ldf(p.in[layer ? L1_GPOSTMIX : L0_GPOSTMIX], lane), gpre = ldf(p.in[layer ? L1_GPREFFN : L0_GPREFFN], lane);
  int cur = -1; V16 gg, gs, sh;
  auto xsrc = [&](int r) { return layer ? (const float*)(p.out + (size_t)r * DM) : (r < NLAT ? p.in[I_X] + (size_t)r * DM : p.in[I_CTX] + (size_t)(r - NLAT) * DM); };
  B16 mn = ldb_raw(MIX + (size_t)r0 * DM, lane); V16 xn = ldf(xsrc(r0), lane);
  B16 mn2 = mn; V16 xn2 = xn;
  if (r0 + 1 < r1) { mn2 = ldb_raw(MIX + (size_t)(r0 + 1) * DM, lane); xn2 = ldf(xsrc(r0 + 1), lane); }
  for (int r = r0; r < r1; ++r) {
    const B16 mb = mn; const V16 x = xn;
    mn = mn2; xn = xn2;
    if (r + 2 < r1) { mn2 = ldb_raw(MIX + (size_t)(r + 2) * DM, lane); xn2 = ldf(xsrc(r + 2), lane); }
    const int mr = row_modrow(r);
    if (mr != cur) { cur = mr; const float* m = MOD + (size_t)mr * 6144; const V16 gt = ldf(m + 2048, lane), sc = ldf(m + 4096, lane); sh = ldf(m + 3072, lane);
#pragma unroll
      for (int j = 0; j < 4; ++j) { gg.v[j] = gt.v[j] * gpost.v[j]; gs.v[j] = gpre.v[j] * (sc.v[j] + 1.f); } }
    V16 o = b2v(mb);
    const float rr = rsqrtf(sumsq(o) * (1.f / DM) + EPS);
#pragma unroll
    for (int j = 0; j < 4; ++j) o.v[j] = x.v[j] + gg.v[j] * (o.v[j] * rr);
    stf(r < NLAT ? p.out + (size_t)r * DM : XC + (size_t)(r - NLAT) * DM, lane, o);
    const float r2 = rsqrtf(sumsq(o) * (1.f / DM) + EPS);
    V16 h;
#pragma unroll
    for (int j = 0; j < 4; ++j) h.v[j] = o.v[j] * r2 * gs.v[j] + sh.v[j];
    if ((layer == 1 && MOE1_FP8) || (layer == 0 && MOE0_FP8)) {
      unsigned* q8 = (unsigned*)((unsigned char*)H + (size_t)r * DM) + lane;
#pragma unroll
      for (int j = 0; j < 4; ++j) q8[64 * j] = nv::pack4_fp8(h.v[j][0] * nv::A8_SCALE, h.v[j][1] * nv::A8_SCALE, h.v[j][2] * nv::A8_SCALE, h.v[j][3] * nv::A8_SCALE);
    } else stb(H + (size_t)r * DM, lane, h);
    if (ABL == 1) continue;
    f32x4 lg[4];
    int lo = lane; asm volatile("" : "+v"(lo));
#pragma unroll
    for (int e4 = 0; e4 < 4; ++e4) lg[e4] = (f32x4){0.f, 0.f, 0.f, 0.f};
#pragma unroll
    for (int j = 0; j < 4; ++j)
#pragma unroll
      for (int q = 0; q < 4; ++q) { const float hv = h.v[j][q];
#pragma unroll
        for (int e4 = 0; e4 < 4; ++e4) lg[e4] += WL[((j * 4 + q) * 4 + e4) * 64 + lo] * hv; }
    float l16[16]; float mx = -INFINITY;
#pragma unroll
    for (int e = 0; e < 16; ++e) { l16[e] = wave_sum(lg[e >> 2][e & 3]); mx = fmaxf(mx, l16[e]); }
    float s = 0.f;
#pragma unroll
    for (int e = 0; e < 16; ++e) { l16[e] = expf(l16[e] - mx); s += l16[e]; }
    const float inv = 1.f / s; float mine = 0.f;
#pragma unroll
    for (int e = 0; e < 16; ++e) if (lane == e) mine = l16[e] * inv;
    if (lane < 16) AFFT[(size_t)lane * NROW + r] = mine;
  }
}

DEVI void phase_combine(const Params& p, int layer) {
  const int tid = ftid(), lane = tid & 63, gw = blockIdx.x * NWAVE + (tid >> 6), NGW = gridDim.x * NWAVE;
  const float* MOD = (const float*)(p.ws + WS_CTL + CTL_MOD);
  const bf16_t* Y = (const bf16_t*)(p.ws + WS_Y); const int* SLOT = (const int*)(p.ws + WS_SLOT); const float* GV = (const float*)(p.ws + WS_GATEV);
  bf16_t* H = (bf16_t*)(p.ws + WS_H); float* XC = (float*)(p.ws + WS_XC);
  const int nrow = layer ? NLAT : NROW, erows = layer ? EROWS1 : EROWS0;
  const int rpw = (nrow + NGW - 1) / NGW;
  const int r0 = gw * rpw, r1 = min(r0 + rpw, nrow);
  if (r0 >= r1) return;
  const V16 gpost = ldf(p.in[layer ? L1_GPOSTFFN : L0_GPOSTFFN], lane);
  V16 g1; if (layer == 0) g1 = ldf(p.in[L1_GPREMIX], lane);
  int cur = -1; V16 gg, gs, sh;
  int sn = (lane < 16) ? SLOT[(size_t)r0 * 16 + lane] : -1;
  for (int r = r0; r < r1; ++r) {
    const int sl = sn; if (r + 1 < r1) sn = (lane < 16) ? SLOT[(size_t)(r + 1) * 16 + lane] : -1;
    float* xio = r < NLAT ? p.out + (size_t)r * DM : XC + (size_t)(r - NLAT) * DM;
    const V16 x = ldf(xio, lane);
    const int mr = row_modrow(r);
    if (mr != cur) { cur = mr; const float* m = MOD + (size_t)(layer * 9 + mr) * 6144; const V16 gt = ldf(m + 5120, lane);
#pragma unroll
      for (int j = 0; j < 4; ++j) gg.v[j] = gt.v[j] * gpost.v[j];
      if (layer == 0) { const float* m1 = MOD + (size_t)(9 + mr) * 6144; const V16 sc = ldf(m1 + 1024, lane); sh = ldf(m1, lane);
#pragma unroll
        for (int j = 0; j < 4; ++j) gs.v[j] = g1.v[j] * (sc.v[j] + 1.f); } }
    V16 o;
#pragma unroll
    for (int j = 0; j < 4; ++j) o.v[j] = (f32x4){0.f, 0.f, 0.f, 0.f};
    unsigned long long mask = __ballot(sl >= 0);
    while (mask) {
      const int e = __builtin_ctzll(mask); mask &= mask - 1;
      const int s = __shfl(sl, e);
      const float gate = GV[e * erows + s];
      const V16 y = b2v(ldb_raw(Y + ((size_t)e * erows + s) * DM, lane));
#pragma unroll
      for (int j = 0; j < 4; ++j) o.v[j] += y.v[j] * gate;
    }
    const float rr = rsqrtf(sumsq(o) * (1.f / DM) + EPS);
#pragma unroll
    for (int j = 0; j < 4; ++j) o.v[j] = x.v[j] + gg.v[j] * (o.v[j] * rr);
    stf(xio, lane, o);
    if (layer == 0) {
      const float r2 = rsqrtf(sumsq(o) * (1.f / DM) + EPS);
      V16 h;
#pragma unroll
      for (int j = 0; j < 4; ++j) h.v[j] = o.v[j] * r2 * gs.v[j] + sh.v[j];
      if (QKV1_FP8) {
        unsigned* q8 = (unsigned*)((unsigned char*)H + (size_t)r * DM) + lane;
#pragma unroll
        for (int j = 0; j < 4; ++j) q8[64 * j] = nv::pack4_fp8(h.v[j][0] * nv::A8_SCALE, h.v[j][1] * nv::A8_SCALE, h.v[j][2] * nv::A8_SCALE, h.v[j][3] * nv::A8_SCALE);
      } else stb(H + (size_t)r * DM, lane, h);
    }
  }
}
}
#define LAS __attribute__((address_space(3)))
#define XB_TMO      128
#define XB_XCNT(j)  (256  + 64 * (j))
#define XB_XSUB(j)  (1280 + 64 * (j))
#define XB_XGEN(j)  (2304 + 64 * (j))
#define XB_TOP      3328
#define XB_TOPGEN   3392
#define XCD_BAR_WORDS 3456
#define XB_SPIN_CAP (1u << 18)

__device__ __forceinline__ unsigned xb_ld(unsigned* p)              { return __hip_atomic_load(p, __ATOMIC_RELAXED, __HIP_MEMORY_SCOPE_AGENT); }
__device__ __forceinline__ unsigned xb_add(unsigned* p, unsigned v) { return __hip_atomic_fetch_add(p, v, __ATOMIC_RELAXED, __HIP_MEMORY_SCOPE_AGENT); }
__device__ __forceinline__ unsigned xb_xcc_id() { return (unsigned)__builtin_amdgcn_s_getreg((3 << 11) | 20) & 0xFu; }
#define XB_SPIN(cond, bar) do { unsigned _sp = 0; while (cond) { __builtin_amdgcn_s_sleep(1); \
    if ((++_sp & 255u) == 0u) { if (xb_ld(&(bar)[XB_TMO])) break; if (_sp > XB_SPIN_CAP) { atomicAdd(&(bar)[XB_TMO], 1u); break; } } } } while (0)

struct XcdBarrier {
    unsigned* bar; unsigned x;
    volatile LAS unsigned* st;
};

__device__ __forceinline__ XcdBarrier xcd_barrier_post(unsigned* bar, volatile LAS unsigned* st) {
    XcdBarrier b; b.bar = bar; b.x = xb_xcc_id(); b.st = st;
    if (threadIdx.x == 0) (void)xb_add(&bar[XB_XCNT(b.x)], 1u);
    return b;
}
__device__ __forceinline__ void xcd_barrier_complete(unsigned* bar, unsigned x, unsigned& nloc, unsigned& nx) {
    const unsigned G = gridDim.x * gridDim.y * gridDim.z;
    unsigned sum, cnt, mine, sp = 0u;
    for (;;) {
        sum = 0u; cnt = 0u; mine = 0u;
#pragma unroll
        for (unsigned j = 0; j < 16; ++j) { const unsigned c = xb_ld(&bar[XB_XCNT(j)]); sum += c; cnt += (c > 0u) ? 1u : 0u; mine = (j == x) ? c : mine; }
        if (sum == G) break;
        __builtin_amdgcn_s_sleep(1);
        if ((++sp & 255u) == 0u) { if (xb_ld(&bar[XB_TMO])) break; if (sp > XB_SPIN_CAP) { atomicAdd(&bar[XB_TMO], 1u); break; } }
    }
    nloc = mine > 0u ? mine : 1u; nx = cnt > 0u ? cnt : 1u;
}

__device__ __forceinline__ void xcd_barrier(const XcdBarrier& b) {
    asm volatile("s_waitcnt vmcnt(0)" ::: "memory");
    __syncthreads();
    if (threadIdx.x == 0) {
        unsigned* bar = b.bar;
        __builtin_amdgcn_s_waitcnt(0);
        unsigned nloc = b.st[0], nx = b.st[1];
        if (nloc == 0u) { xcd_barrier_complete(bar, b.x, nloc, nx); b.st[0] = nloc; b.st[1] = nx; }
        const unsigned old = xb_add(&bar[XB_XSUB(b.x)], 1u);
        const unsigned gen = old / nloc;
        if (old + 1u == (gen + 1u) * nloc) {
            __builtin_amdgcn_fence(__ATOMIC_RELEASE, "agent");
            asm volatile("s_waitcnt vmcnt(0)" ::: "memory");
            const unsigned og = xb_add(&bar[XB_TOP], 1u);
            const unsigned tg = og / nx;
            if (og + 1u == (tg + 1u) * nx) xb_add(&bar[XB_TOPGEN], 1u);
            else XB_SPIN(xb_ld(&bar[XB_TOPGEN]) == tg, bar);
            __builtin_amdgcn_fence(__ATOMIC_ACQUIRE, "agent");
            xb_add(&bar[XB_XGEN(b.x)], 1u);
            asm volatile("s_waitcnt vmcnt(0)" ::: "memory");
        } else {
            XB_SPIN(xb_ld(&bar[XB_XGEN(b.x)]) == gen, bar);
            __builtin_amdgcn_fence(__ATOMIC_ACQUIRE, "agent");
            asm volatile("s_waitcnt vmcnt(0)" ::: "memory");
        }
    }
    __syncthreads();
}


__device__ __forceinline__ void flat_barrier(unsigned* ctr, unsigned& epoch) {
    asm volatile("s_waitcnt vmcnt(0)" ::: "memory");
    __syncthreads();
    if (threadIdx.x == 0) {
        __builtin_amdgcn_fence(__ATOMIC_RELEASE, "agent");
        asm volatile("s_waitcnt vmcnt(0)" ::: "memory");
        (void)__hip_atomic_fetch_add(ctr, 1u, __ATOMIC_RELAXED, __HIP_MEMORY_SCOPE_AGENT);
        const unsigned target = (epoch + 1u) * (unsigned)gridDim.x; unsigned sp = 0;
        while (__hip_atomic_load(ctr, __ATOMIC_RELAXED, __HIP_MEMORY_SCOPE_AGENT) < target) { __builtin_amdgcn_s_sleep(1); if (++sp > (1u << 22)) break; }
        __builtin_amdgcn_fence(__ATOMIC_ACQUIRE, "agent");
        asm volatile("s_waitcnt vmcnt(0)" ::: "memory");
    }
    ++epoch;
    __syncthreads();
}

__device__ __forceinline__ void xcd_barrier2(const XcdBarrier& b) {
    asm volatile("s_waitcnt vmcnt(0)" ::: "memory");
    __syncthreads();
    if (threadIdx.x == 0) {
        unsigned* bar = b.bar;
        __builtin_amdgcn_s_waitcnt(0);
        unsigned nloc = b.st[0], nx = b.st[1];
        if (nloc == 0u) { xcd_barrier_complete(bar, b.x, nloc, nx); b.st[0] = nloc; b.st[1] = nx; }
        const unsigned old = xb_add(&bar[XB_XSUB(b.x)], 1u);
        const unsigned gen = old / nloc;
        if (old + 1u == (gen + 1u) * nloc) {
            __builtin_amdgcn_fence(__ATOMIC_RELEASE, "agent");
            asm volatile("s_waitcnt vmcnt(0)" ::: "memory");
            (void)xb_add(&bar[XB_TOP], 1u);
        }
        const unsigned target = (gen + 1u) * nx;
        XB_SPIN(xb_ld(&bar[XB_TOP]) < target, bar);
        __builtin_amdgcn_fence(__ATOMIC_ACQUIRE, "agent");
        asm volatile("s_waitcnt vmcnt(0)" ::: "memory");
    }
    __syncthreads();
}
constexpr int LDS_BYTES = 147456;
#define TAILFILL 1
#ifndef FAST_GEMM
#define FAST_GEMM 1
#endif
#ifndef FAST_TOPK
#define FAST_TOPK 1
#endif
#ifndef FAST_SSD
#define FAST_SSD 1
#endif
#ifndef FAST_ATTN
#define FAST_ATTN 1
#endif
__global__ void __launch_bounds__(NT) mega(Params p) {
  extern __shared__ __attribute__((aligned(16))) unsigned char lds_raw[];
  float* lds = (float*)lds_raw;
  fg::ldsp_t ldsp = (fg::ldsp_t)lds_raw;
  cg::grid_group grid = cg::this_grid();
  volatile LAS unsigned* bst = (volatile LAS unsigned*)((LAS unsigned char*)lds_raw + (LDS_BYTES - 64));
  if (threadIdx.x < 2) bst[threadIdx.x] = 0u;
  unsigned* barw = (unsigned*)(p.ws + WS_CTL + CTL_BAR);
  if (blockIdx.x == 0) for (int i = threadIdx.x; i < XCD_BAR_WORDS; i += NT) barw[i] = 0u;
  XcdBarrier xbar; xbar.bar = barw; xbar.x = 0; xbar.st = bst;
#ifdef FLATBAR
  unsigned fb_epoch = 0; unsigned* fb_ctr = barw + XCD_BAR_WORDS - 64;
#define GSYNC() flat_barrier(fb_ctr, fb_epoch)
#elif defined(XBAR2)
#define GSYNC() xcd_barrier2(xbar)
#else
#define GSYNC() xcd_barrier(xbar)
#endif
  nv::phase0(p, lds);                 grid.sync();
  xbar = xcd_barrier_post(barw, bst);
#ifdef DUP_SYNC
  for (int i = 0; i < 20; ++i) GSYNC();
#endif
#ifdef DUP_P0
  nv::phase0(p, lds);                 GSYNC();
#endif
  fr::phase_prenorm0(p);              GSYNC();
#ifdef DUP_PRENORM
  fr::phase_prenorm0(p); GSYNC();
#endif
#if FAST_GEMM
  fg::phase_qkv0(p, ldsp); GSYNC();
#ifdef DUP_QKV0
  fg::phase_qkv0(p, ldsp); GSYNC();
#endif
#else
  nv::phase_qkv0(p, lds);             GSYNC();
#endif
#if FAST_ATTN
  fa::phase_attnA(p, ldsp); fa::phase_attnB(p, ldsp); GSYNC();
#ifdef DUP_A
  fa::phase_attnA<DUP_A>(p, ldsp); GSYNC();
#endif
#ifdef DUP_B
  fa::phase_attnB<DUP_B>(p, ldsp); GSYNC();
#endif
#else
  nv::phase_attn0(p, lds);            GSYNC();
#endif
#if FAST_GEMM
#ifdef TAILFILL
  fg::phase_outproj(p, ldsp, 0); nv::convert_moe_tail8(p, 0, 1, lds, NROW / 256 * (DM / 256)); GSYNC();
#else
  fg::phase_outproj(p, ldsp, 0); GSYNC();
#endif
#ifdef DUP_OUT0
  fg::phase_outproj(p, ldsp, 0); GSYNC();
#endif
#else
  nv::phase_outproj(p, lds, 0);       GSYNC();
#endif
  fr::phase_postmix(p, ldsp, 0);            GSYNC();
#ifdef DUP_POSTMIX0
  fr::phase_postmix<DUP_POSTMIX0>(p, ldsp, 0); GSYNC();
#endif
#if FAST_TOPK
  ft::phase_topk(p, ldsp, 0);         GSYNC();
#ifdef DUP_TOPK0
  ft::phase_topk(p, ldsp, 0);         GSYNC();
#endif
#else
  nv::phase_topk(p, lds, 0);          GSYNC();
  fg::phase_gather(p, 0);             GSYNC();
#endif
#if FAST_GEMM
  fg::phase_moe_up8(p, ldsp, 0);      GSYNC();
#ifdef DUP_UP0
  fg::phase_moe_up8(p, ldsp, 0); GSYNC();
#endif
  fg::phase_moe_down8(p, ldsp, 0);    GSYNC();
#ifdef DUP_DOWN0
  fg::phase_moe_down8(p, ldsp, 0); GSYNC();
#endif
#else
  nv::phase_moe_up(p, lds, 0);        GSYNC();
  nv::phase_moe_down(p, lds, 0);      GSYNC();
#endif
#ifdef TAILFILL
  fr::phase_combine(p, 0); GSYNC();
#else
  fr::phase_combine(p, 0); nv::convert_moe_tail(p, 1, 0, lds, 0); nv::convert_moe_tail(p, 1, 1, lds, 0); GSYNC();
#endif
#if FAST_GEMM
#ifdef TAILFILL
  fg::phase_qkv1(p, ldsp); nv::convert_moe_tail8(p, 1, 0, lds, NROW / 256 * (N_IN1P / 256)); GSYNC();
#else
  fg::phase_qkv1(p, ldsp); GSYNC();
#endif
#else
  nv::phase_qkv1(p, lds);             GSYNC();
#endif
#if FAST_ATTN
#if FAST_SSD
#ifdef TAILFILL
  fs::phase_conv(p); nv::convert_moe_tail8(p, 1, 1, lds, 0); GSYNC();
#else
  fs::phase_conv(p); GSYNC();
#endif
#else
  nv::phase_conv_swa(p, lds, true); GSYNC();
#endif
#else
  nv::phase_conv_swa(p, lds, true);   GSYNC();
#endif
#if FAST_SSD
  fs::phase_ssd(p, ldsp); fa::phase_attnC(p, ldsp, (int*)(p.ws + WS_CTL + CTL_QC)); GSYNC();
#ifdef DUP_SSD
  fs::phase_ssd<DUP_SSD>(p, ldsp);             GSYNC();
#endif
  fs::phase_ssd_out(p);               GSYNC();
#else
  nv::phase_ssd(p, lds);              GSYNC();
  nv::phase_ssd_out(p);               GSYNC();
#endif
#if FAST_GEMM
  fg::phase_outproj(p, ldsp, 1);      GSYNC();
#else
  nv::phase_outproj(p, lds, 1);       GSYNC();
#endif
  fr::phase_postmix(p, ldsp, 1);            GSYNC();
#if FAST_TOPK
  ft::phase_topk(p, ldsp, 1);         GSYNC();
#ifdef DUP_TOPK1
  ft::phase_topk(p, ldsp, 1);         GSYNC();
#endif
#else
  nv::phase_topk(p, lds, 1);          GSYNC();
  fg::phase_gather(p, 1);             GSYNC();
#endif
#if FAST_GEMM
  fg::phase_moe_up8(p, ldsp, 1);      GSYNC();
  fg::phase_moe_down8(p, ldsp, 1);    GSYNC();
#else
  nv::phase_moe_up(p, lds, 1);        GSYNC();
  nv::phase_moe_down(p, lds, 1);      GSYNC();
#endif
  fr::phase_combine(p, 1);
}


extern "C" void kernel_launch(void* const* d_in, const int* in_sizes, int n_in, void* d_out, int out_size,
                              void* d_ws, size_t ws_size, hipStream_t stream) {
  static int grid_blocks = 0;
  if (!grid_blocks) {
    int dev = 0, cus = 0, per_cu = 0;
    (void)hipGetDevice(&dev);
    (void)hipDeviceGetAttribute(&cus, hipDeviceAttributeMultiprocessorCount, dev);
    (void)hipFuncSetAttribute((const void*)mega, hipFuncAttributeMaxDynamicSharedMemorySize, LDS_BYTES);
    (void)hipOccupancyMaxActiveBlocksPerMultiprocessor(&per_cu, (const void*)mega, NT, LDS_BYTES);
    if (per_cu < 1) { fprintf(stderr, "kernel_launch: occupancy query says %d blocks/CU\n", per_cu); per_cu = 1; }
    grid_blocks = cus;
    if (n_in != 43 || ws_size < WS_END) fprintf(stderr, "kernel_launch: unexpected n_in %d / ws_size %zu (need %zu)\n", n_in, ws_size, (size_t)WS_END);
  }
  Params p{};
  for (int i = 0; i < 43; ++i) p.in[i] = (const float*)d_in[i];
  p.out = (float*)d_out; p.ws = (unsigned char*)d_ws;
  void* args[] = {&p};
  hipError_t e = hipLaunchCooperativeKernel((void*)mega, dim3(grid_blocks), dim3(NT), args, LDS_BYTES, stream);
  if (e != hipSuccess) fprintf(stderr, "cooperative launch failed: %s (grid %d)\n", hipGetErrorString(e), grid_blocks);
}
```

```cpp
#include <hip/hip_runtime.h>
#include <hip/hip_cooperative_groups.h>
#include <cstdio>
#include <cstdint>
namespace cg = cooperative_groups;

typedef unsigned short bf16_t;
#define DEVI __device__ __forceinline__

constexpr int NT = 512, NWAVE = 8;
constexpr int NB = 8, SEQ = 4096, DM = 1024, CTXL = 256;
constexpr int NLAT = NB * SEQ, NCTX = NB * CTXL, NROW = NLAT + NCTX;
constexpr int NE = 16;
constexpr int CAP_L = 512, CAP_C = 32;
constexpr int EROWS0 = NB * CAP_L + NB * CAP_C;
constexpr int EROWS1 = NB * CAP_L;
constexpr int N_IN0 = 3072, N_IN1 = 2320, N_IN1P = 2560;
constexpr float EPS = 1e-6f;

constexpr size_t MiB = 1u << 20;
constexpr size_t WS_CTL = 0;
constexpr size_t WS_WIN0 = 1 * MiB;
constexpr size_t WS_WIN1 = 7 * MiB;
constexpr size_t WS_WOUT0 = 12 * MiB, WS_WOUT1 = 14 * MiB;
constexpr size_t WS_WGU = 16 * MiB;
constexpr size_t WS_WD = 80 * MiB;
constexpr size_t WS_XC = 112 * MiB;
constexpr size_t WS_H = 120 * MiB;
constexpr size_t WS_AFF = 188 * MiB;
constexpr size_t WS_SLOT = 191 * MiB;
constexpr size_t WS_IDX = 194 * MiB;
constexpr size_t WS_GATEV = 195 * MiB;
constexpr size_t WS_BIG = 196 * MiB;
constexpr size_t WS_QKV0 = WS_BIG;
constexpr size_t WS_ATT0 = WS_BIG + 204 * MiB;
constexpr size_t WS_MIX0 = WS_BIG + 272 * MiB;
constexpr size_t WS_XG = WS_BIG;
constexpr size_t WS_HID = WS_BIG + 136 * MiB;
constexpr size_t WS_Y = WS_BIG;
constexpr size_t WS_P1 = WS_BIG;
constexpr size_t WS_DT = WS_BIG + 153 * MiB;
constexpr size_t WS_U = WS_BIG + 156 * MiB;
constexpr size_t WS_MIX1 = WS_U;
constexpr size_t WS_ATT1 = WS_BIG + 224 * MiB;
constexpr size_t WS_YS = WS_BIG + 292 * MiB;
constexpr size_t WS_CUMG = WS_BIG + 356 * MiB;
constexpr size_t WS_DTG = WS_BIG + 359 * MiB;
constexpr size_t WS_VT = WS_BIG + 340 * MiB;
constexpr size_t WS_VTB = WS_BIG + 362 * MiB;
constexpr size_t WS_END = WS_BIG + 380 * MiB;
constexpr size_t CTL_MOD = 4096;
constexpr size_t CTL_ROPE = CTL_MOD + 2 * 9 * 6144 * 4;
constexpr size_t CTL_LAM = CTL_ROPE + 64 * 16 * 2 * 4;
constexpr size_t CTL_QC = CTL_LAM + 64;
constexpr size_t CTL_BAR = 512 * 1024;

struct Params {
  const float* in[43];
  float* out;
  unsigned char* ws;
};

enum {
  I_X = 0, I_C, I_CTX, I_CCTX,
  L0_WMOD, L0_BMOD, L0_GPREMIX, L0_GPOSTMIX, L0_GPREFFN, L0_GPOSTFFN, L0_WIN, L0_WOUT,
  L0_LAMQ1, L0_LAMK1, L0_LAMQ2, L0_LAMK2, L0_SUBLN, L0_RPB, L0_WROUTER, L0_WGATE, L0_WUP, L0_WDOWN,
  L1_WMOD, L1_BMOD, L1_GPREMIX, L1_GPOSTMIX, L1_GPREFFN, L1_GPOSTFFN, L1_WIN, L1_WOUT,
  L1_SINKS, L1_CONVW, L1_CONVB, L1_ALOGF, L1_ALOGB, L1_DTBF, L1_DTBB, L1_DSKIP, L1_GNORM,
  L1_WROUTER, L1_WGATE, L1_WUP, L1_WDOWN
};

DEVI int ftid() { int t = threadIdx.x; asm volatile("" : "+v"(t)); return t; }
DEVI float bf2f(bf16_t v) { return __uint_as_float(((unsigned)v) << 16); }
DEVI bf16_t f2bf(float f) { unsigned u = __float_as_uint(f); return (bf16_t)((u + 0x7fffu + ((u >> 16) & 1u)) >> 16); }
DEVI unsigned pk2(float lo, float hi) { return (unsigned)f2bf(lo) | ((unsigned)f2bf(hi) << 16); }
DEVI float silu_f(float v) { return v / (1.f + __expf(-v)); }
DEVI float wave_sum(float v) {
#pragma unroll
  for (int o = 1; o < 64; o <<= 1) v += __shfl_xor(v, o);
  return v;
}
DEVI float wave_max(float v) {
#pragma unroll
  for (int o = 1; o < 64; o <<= 1) v = fmaxf(v, __shfl_xor(v, o));
  return v;
}
DEVI int row_modrow(int r) { return r < NLAT ? (r >> 12) : 8; }
#ifndef QKV0_FP8
#define QKV0_FP8 1
#endif
#ifndef OUT_FP8
#define OUT_FP8 0
#endif
#ifndef QKV1_FP8
#define QKV1_FP8 0
#endif
namespace nv {

DEVI void transpose_item(const float* W, int K, int N, bf16_t* WT, int row_off, int row_mul, float* scr, int item, int lane, int Npad) {
  const int nblk = Npad / 32, kb = item / nblk, nb = item % nblk, k0 = 64 * kb, n0 = 32 * nb;
  const int n = n0 + (lane & 31); const bool ok = n < N;
  const float* src = W + (size_t)(k0 + (lane >> 5)) * N + (ok ? n : 0);
  float v[32];
#pragma unroll
  for (int i = 0; i < 32; ++i) v[i] = src[(size_t)(2 * i) * N];
#pragma unroll
  for (int i = 0; i < 32; ++i) scr[(2 * i + (lane >> 5)) * 33 + (lane & 31)] = ok ? v[i] : 0.f;
  __builtin_amdgcn_s_waitcnt(0); __builtin_amdgcn_wave_barrier();
  const int c = lane & 7;
#pragma unroll
  for (int j = 0; j < 4; ++j) {
    const int nn = (lane >> 3) + 8 * j; const float* s = scr + (8 * c) * 33 + nn;
    uint4 o; o.x = pk2(s[0 * 33], s[1 * 33]); o.y = pk2(s[2 * 33], s[3 * 33]); o.z = pk2(s[4 * 33], s[5 * 33]); o.w = pk2(s[6 * 33], s[7 * 33]);
    *(uint4*)(WT + (size_t)(row_off + (n0 + nn) * row_mul) * K + k0 + 8 * c) = o;
  }
  __builtin_amdgcn_s_waitcnt(0); __builtin_amdgcn_wave_barrier();
}

DEVI void convert_moe_part(const Params& p, int layer, int which, float* scr, int gw, int NGW, int lane) {
  const float* wg = p.in[layer ? L1_WGATE : L0_WGATE]; const float* wu = p.in[layer ? L1_WUP : L0_WUP]; const float* wd = p.in[layer ? L1_WDOWN : L0_WDOWN];
  bf16_t* WGU = (bf16_t*)(p.ws + WS_WGU); bf16_t* WD = (bf16_t*)(p.ws + WS_WD);
  constexpr int IPM = 16 * 32;
  if (which == 0) {
    for (int it = gw; it < NE * 2 * IPM; it += NGW) {
      const int e = it / (2 * IPM), r = it % (2 * IPM), gu = r / IPM, item = r % IPM;
      transpose_item((gu ? wu : wg) + (size_t)e * DM * DM, DM, DM, WGU + (size_t)e * 2048 * DM, gu, 2, scr, item, lane, DM);
    }
  } else {
    for (int it = gw; it < NE * IPM; it += NGW) {
      const int e = it / IPM, item = it % IPM;
      transpose_item(wd + (size_t)e * DM * DM, DM, DM, WD + (size_t)e * DM * DM, 0, 1, scr, item, lane, DM);
    }
  }
}
DEVI void convert_moe_tail(const Params& p, int layer, int which, float* lds, int nunits) {
  const int first = nunits % (int)gridDim.x;
  if ((int)blockIdx.x < first) return;
  const int w = ftid() >> 6;
  convert_moe_part(p, layer, which, lds + w * (64 * 33), ((int)blockIdx.x - first) * NWAVE + w, ((int)gridDim.x - first) * NWAVE, ftid() & 63);
}


constexpr float W8_SCALE = 64.f, A8_SCALE = 4.f;
constexpr int W8_E8M0 = 0x79797979, A8_E8M0 = 0x7d7d7d7d;
DEVI unsigned pack4_fp8(float a, float b, float c, float d) {
  a = fminf(fmaxf(a, -448.f), 448.f); b = fminf(fmaxf(b, -448.f), 448.f); c = fminf(fmaxf(c, -448.f), 448.f); d = fminf(fmaxf(d, -448.f), 448.f);
  int w = 0; w = __builtin_amdgcn_cvt_pk_fp8_f32(a, b, w, false); w = __builtin_amdgcn_cvt_pk_fp8_f32(c, d, w, true); return (unsigned)w; }
DEVI void transpose_item8(const float* W, int K, int N, unsigned char* WT, int row_off, int row_mul, float* scr, int item, int lane, int Npad = 0) {
  if (Npad == 0) Npad = N;
  const int nblk = Npad / 32, kb = item / nblk, nb = item % nblk, k0 = 64 * kb, n0 = 32 * nb;
  const int nn0 = n0 + (lane & 31); const bool ok = nn0 < N;
  const float* src = W + (size_t)(k0 + (lane >> 5)) * N + (ok ? nn0 : 0);
  float v[32];
#pragma unroll
  for (int i = 0; i < 32; ++i) v[i] = src[(size_t)(2 * i) * N];
#pragma unroll
  for (int i = 0; i < 32; ++i) scr[(2 * i + (lane >> 5)) * 33 + (lane & 31)] = ok ? v[i] * W8_SCALE : 0.f;
  __builtin_amdgcn_s_waitcnt(0); __builtin_amdgcn_wave_barrier();
  const int c = lane & 7;
#pragma unroll
  for (int j = 0; j < 4; ++j) {
    const int nn = (lane >> 3) + 8 * j; const float* s = scr + (8 * c) * 33 + nn;
    uint2 o; o.x = pack4_fp8(s[0 * 33], s[1 * 33], s[2 * 33], s[3 * 33]); o.y = pack4_fp8(s[4 * 33], s[5 * 33], s[6 * 33], s[7 * 33]);
    *(uint2*)(WT + (size_t)(row_off + (n0 + nn) * row_mul) * K + k0 + 8 * c) = o;
  }
  __builtin_amdgcn_s_waitcnt(0); __builtin_amdgcn_wave_barrier();
}
DEVI void convert_moe_part8(const Params& p, int layer, int which, float* scr, int gw, int NGW, int lane) {
  const float* wg = p.in[layer ? L1_WGATE : L0_WGATE]; const float* wu = p.in[layer ? L1_WUP : L0_WUP]; const float* wd = p.in[layer ? L1_WDOWN : L0_WDOWN];
  unsigned char* WGU = (unsigned char*)(p.ws + WS_WGU); unsigned char* WD = (unsigned char*)(p.ws + WS_WD);
  constexpr int IPM = 16 * 32;
  if (which == 0) {
    for (int it = gw; it < NE * 2 * IPM; it += NGW) { const int e = it / (2 * IPM), r = it % (2 * IPM), gu = r / IPM, item = r % IPM;
      transpose_item8((gu ? wu : wg) + (size_t)e * DM * DM, DM, DM, WGU + (size_t)e * 2048 * DM, gu, 2, scr, item, lane); }
  } else {
    for (int it = gw; it < NE * IPM; it += NGW) { const int e = it / IPM, item = it % IPM;
      transpose_item8(wd + (size_t)e * DM * DM, DM, DM, WD + (size_t)e * DM * DM, 0, 1, scr, item, lane); }
  }
}
DEVI void convert_moe_tail8(const Params& p, int layer, int which, float* lds, int nunits) {
  const int first = nunits % (int)gridDim.x;
  if ((int)blockIdx.x < first) return;
  const int w = ftid() >> 6;
  convert_moe_part8(p, layer, which, lds + w * (64 * 33), ((int)blockIdx.x - first) * NWAVE + w, ((int)gridDim.x - first) * NWAVE, ftid() & 63);
}

DEVI void phase0(const Params& p, float* lds) {
  const int tid = ftid(), lane = tid & 63, wave = tid >> 6;
  const int gw = blockIdx.x * NWAVE + wave, NGW = gridDim.x * NWAVE;
  for (int it = blockIdx.x; it < 2 * 96; it += gridDim.x) {
    const int layer = it / 96, j0 = (it % 96) * 64;
    float* sc = lds;
    float* red = lds + 9 * 1024;
    __syncthreads();
    for (int i = tid; i < 9 * 1024; i += NT) { const int r = i >> 10, k = i & 1023; const float v = (r < 8) ? p.in[I_C][r * 1024 + k] : p.in[I_CCTX][k]; sc[i] = silu_f(v); }
    __syncthreads();
    const float* wm = p.in[layer ? L1_WMOD : L0_WMOD];
    float acc[9];
#pragma unroll
    for (int r = 0; r < 9; ++r) acc[r] = 0.f;
    for (int k0 = wave * 128; k0 < wave * 128 + 128; k0 += 16) {
      float w[16];
#pragma unroll
      for (int i = 0; i < 16; ++i) w[i] = wm[(size_t)(k0 + i) * 6144 + j0 + lane];
#pragma unroll
      for (int i = 0; i < 16; ++i)
#pragma unroll
        for (int r = 0; r < 9; ++r) acc[r] += sc[r * 1024 + k0 + i] * w[i];
    }
#pragma unroll
    for (int r = 0; r < 9; ++r) red[(wave * 9 + r) * 64 + lane] = acc[r];
    __syncthreads();
    for (int i = tid; i < 9 * 64; i += NT) {
      const int r = i >> 6, c = i & 63; float s = 0.f;
      for (int w = 0; w < 8; ++w) s += red[(w * 9 + r) * 64 + c];
      float* MOD = (float*)(p.ws + WS_CTL + CTL_MOD);
      MOD[(layer * 9 + r) * 6144 + j0 + c] = s + p.in[layer ? L1_BMOD : L0_BMOD][j0 + c];
    }
    __syncthreads();
  }
  if (blockIdx.x == gridDim.x - 1) {
    float* ROPE = (float*)(p.ws + WS_CTL + CTL_ROPE);
    for (int i = tid; i < 64 * 16; i += NT) {
      const int pos = i >> 4, f = i & 15;
      const float inv = powf(10000.f, -(float)f / 16.f);
      const float ang = (float)pos * inv;
      ROPE[2 * i] = cosf(ang); ROPE[2 * i + 1] = sinf(ang);
    }
    if (wave == 0) {
      float a = p.in[L0_LAMQ1][lane] * p.in[L0_LAMK1][lane], b = p.in[L0_LAMQ2][lane] * p.in[L0_LAMK2][lane];
      a = wave_sum(a); b = wave_sum(b);
      if (lane == 0) { float* LAM = (float*)(p.ws + WS_CTL + CTL_LAM); LAM[0] = expf(a) - expf(b) + 0.2f; *(int*)(p.ws + WS_CTL + CTL_QC) = 0; }
    }
  }
  __syncthreads();
  float* scr = lds + wave * (64 * 33);
  {
    constexpr int I_IN0 = 16 * (N_IN0 / 32), I_OUT = 16 * 32, I_IN1 = 16 * (N_IN1P / 32);
    constexpr int NITEMS = I_IN0 + I_OUT + I_IN1 + I_OUT;
    for (int it = gw; it < NITEMS; it += NGW) {
      int r = it;
      if (r < I_IN0) { if (QKV0_FP8) transpose_item8(p.in[L0_WIN], DM, N_IN0, (unsigned char*)(p.ws + WS_WIN0), 0, 1, scr, r, lane); else transpose_item(p.in[L0_WIN], DM, N_IN0, (bf16_t*)(p.ws + WS_WIN0), 0, 1, scr, r, lane, N_IN0); continue; } r -= I_IN0;
      if (r < I_OUT) { if (OUT_FP8) transpose_item8(p.in[L0_WOUT], DM, DM, (unsigned char*)(p.ws + WS_WOUT0), 0, 1, scr, r, lane); else transpose_item(p.in[L0_WOUT], DM, DM, (bf16_t*)(p.ws + WS_WOUT0), 0, 1, scr, r, lane, DM); continue; } r -= I_OUT;
      if (r < I_IN1) { if (QKV1_FP8) transpose_item8(p.in[L1_WIN], DM, N_IN1, (unsigned char*)(p.ws + WS_WIN1), 0, 1, scr, r, lane, N_IN1P); else transpose_item(p.in[L1_WIN], DM, N_IN1, (bf16_t*)(p.ws + WS_WIN1), 0, 1, scr, r, lane, N_IN1P); continue; } r -= I_IN1;
      if (OUT_FP8) transpose_item8(p.in[L1_WOUT], DM, DM, (unsigned char*)(p.ws + WS_WOUT1), 0, 1, scr, r, lane); else transpose_item(p.in[L1_WOUT], DM, DM, (bf16_t*)(p.ws + WS_WOUT1), 0, 1, scr, r, lane, DM);
    }
  }
  convert_moe_part8(p, 0, 0, scr, gw, NGW, lane);
#ifndef TAILFILL
  convert_moe_part8(p, 0, 1, scr, gw, NGW, lane);
#endif
}

struct Row16 { float4 v[4]; };
DEVI Row16 ld_row_f32(const float* r, int lane) { Row16 o; const float4* q = (const float4*)r + lane;
#pragma unroll
  for (int j = 0; j < 4; ++j) o.v[j] = q[64 * j]; return o; }
DEVI Row16 ld_row_bf16(const bf16_t* r, int lane) { Row16 o; const uint2* q = (const uint2*)r + lane;
#pragma unroll
  for (int j = 0; j < 4; ++j) { const uint2 w = q[64 * j]; o.v[j] = make_float4(__uint_as_float(w.x << 16), __uint_as_float(w.x & 0xffff0000u), __uint_as_float(w.y << 16), __uint_as_float(w.y & 0xffff0000u)); }
  return o; }
DEVI void st_row_f32(float* r, int lane, const Row16& o) { float4* q = (float4*)r + lane;
#pragma unroll
  for (int j = 0; j < 4; ++j) q[64 * j] = o.v[j]; }
DEVI void st_row_bf16(bf16_t* r, int lane, const Row16& o) { uint2* q = (uint2*)r + lane;
#pragma unroll
  for (int j = 0; j < 4; ++j) q[64 * j] = make_uint2(pk2(o.v[j].x, o.v[j].y), pk2(o.v[j].z, o.v[j].w)); }
DEVI float row_sumsq(const Row16& o) { float s = 0.f;
#pragma unroll
  for (int j = 0; j < 4; ++j) s += o.v[j].x * o.v[j].x + o.v[j].y * o.v[j].y + o.v[j].z * o.v[j].z + o.v[j].w * o.v[j].w;
  return wave_sum(s); }
#define ROW_FOR4(expr) _Pragma("unroll") for (int j = 0; j < 4; ++j) { { float& e = o.v[j].x; const float a = A.v[j].x, b = Bv.v[j].x, c = Cv.v[j].x; expr; } { float& e = o.v[j].y; const float a = A.v[j].y, b = Bv.v[j].y, c = Cv.v[j].y; expr; } { float& e = o.v[j].z; const float a = A.v[j].z, b = Bv.v[j].z, c = Cv.v[j].z; expr; } { float& e = o.v[j].w; const float a = A.v[j].w, b = Bv.v[j].w, c = Cv.v[j].w; expr; } }

DEVI Row16 norm_mod(const Row16& x, const float* g, const float* sc, const float* sh, int lane) {
  const float r = rsqrtf(row_sumsq(x) * (1.f / DM) + EPS);
  Row16 o = x; const Row16 A = ld_row_f32(g, lane), Bv = ld_row_f32(sc, lane), Cv = ld_row_f32(sh, lane);
  ROW_FOR4(e = e * r * a * (1.f + b) + c);
  return o;
}

DEVI void phase_prenorm0(const Params& p) {
  const int lane = ftid() & 63, gw = blockIdx.x * NWAVE + (ftid() >> 6), NGW = gridDim.x * NWAVE;
  const float* MOD = (const float*)(p.ws + WS_CTL + CTL_MOD);
  bf16_t* H = (bf16_t*)(p.ws + WS_H);
  for (int r = gw; r < NROW; r += NGW) {
    const float* src = r < NLAT ? p.in[I_X] + (size_t)r * DM : p.in[I_CTX] + (size_t)(r - NLAT) * DM;
    const float* m = MOD + (size_t)row_modrow(r) * 6144;
    const Row16 x = ld_row_f32(src, lane);
    const Row16 h = norm_mod(x, p.in[L0_GPREMIX], m + 1024, m, lane);
    st_row_bf16(H + (size_t)r * DM, lane, h);
  }
}

template <class AF, class EF>
DEVI void gemm_tile(float* lds, const bf16_t* Bt, int n0, int K, AF arow, EF epi) {
  const int tid = ftid(), ty = tid >> 4, tx = tid & 15;
  float (*As)[132] = (float (*)[132])lds;
  float (*Bs)[68] = (float (*)[68])(lds + 16 * 132);
  float acc[4][4];
#pragma unroll
  for (int i = 0; i < 4; ++i)
#pragma unroll
    for (int j = 0; j < 4; ++j) acc[i][j] = 0.f;
  const int ar = tid >> 2, ak = (tid & 3) * 4;
  const int br = tid >> 3, bk = (tid & 7) * 2;
  const bf16_t* ap = arow(ar) + ak;
  const bf16_t* bp = Bt + (size_t)(n0 + br) * K + bk;
  for (int k0 = 0; k0 < K; k0 += 16) {
    const uint2 av = *(const uint2*)(ap + k0);
    const unsigned bv = *(const unsigned*)(bp + k0);
    __syncthreads();
    As[ak + 0][ar] = __uint_as_float(av.x << 16); As[ak + 1][ar] = __uint_as_float(av.x & 0xffff0000u);
    As[ak + 2][ar] = __uint_as_float(av.y << 16); As[ak + 3][ar] = __uint_as_float(av.y & 0xffff0000u);
    Bs[bk + 0][br] = __uint_as_float(bv << 16); Bs[bk + 1][br] = __uint_as_float(bv & 0xffff0000u);
    __syncthreads();
#pragma unroll
    for (int kk = 0; kk < 16; ++kk) {
      const float4 a = *(const float4*)&As[kk][ty * 4]; const float4 b = *(const float4*)&Bs[kk][tx * 4];
      const float aa[4] = {a.x, a.y, a.z, a.w}, bb[4] = {b.x, b.y, b.z, b.w};
#pragma unroll
      for (int i = 0; i < 4; ++i)
#pragma unroll
        for (int j = 0; j < 4; ++j) acc[i][j] += aa[i] * bb[j];
    }
  }
#pragma unroll
  for (int i = 0; i < 4; ++i) epi(ty * 4 + i, n0 + tx * 4, acc[i]);
}

DEVI void rope_pair(const float* ROPE, int t, int d, float& u1, float& u2) {
  const int i = d >> 1, f = i & 15, pos = (i < 16) ? (t >> 6) : (t & 63);
  const float cs = ROPE[(pos * 16 + f) * 2], sn = ROPE[(pos * 16 + f) * 2 + 1];
  const float a = u1 * cs - u2 * sn, b = u1 * sn + u2 * cs; u1 = a; u2 = b;
}

DEVI void phase_qkv0(const Params& p, float* lds) {
  const bf16_t* H = (const bf16_t*)(p.ws + WS_H); const bf16_t* W = (const bf16_t*)(p.ws + WS_WIN0);
  bf16_t* Q = (bf16_t*)(p.ws + WS_QKV0); const float* ROPE = (const float*)(p.ws + WS_CTL + CTL_ROPE);
  constexpr int NTN = N_IN0 / 64, NTM = NROW / 128;
  for (int it = blockIdx.x; it < NTN * NTM; it += gridDim.x) {
    const int mt = it / NTN, nt = it % NTN, m0 = mt * 128;
    gemm_tile(lds, W, nt * 64, DM,
      [&](int r) { return H + (size_t)(m0 + r) * DM; },
      [&](int r, int n, float* v) {
        const int row = m0 + r;
        if (row < NLAT && n < 1024) { const int t = row & 4095; rope_pair(ROPE, t, n & 63, v[0], v[1]); rope_pair(ROPE, t, (n + 2) & 63, v[2], v[3]); }
        *(uint2*)(Q + (size_t)row * N_IN0 + n) = make_uint2(pk2(v[0], v[1]), pk2(v[2], v[3]));
      });
  }
}

template <int NS, int VJ, class KF>
DEVI void wave_attn(const float* qs, float* pl  , int* rl  , int nkeys, KF kf, const bf16_t* KV, int ld, int kcol, int vcol,
                    float sink, bool has_sink, float (&o)[NS][VJ], float (&m)[NS], float (&l)[NS], int lane) {
#pragma unroll
  for (int s = 0; s < NS; ++s) { m[s] = -INFINITY; l[s] = 0.f;
#pragma unroll
    for (int j = 0; j < VJ; ++j) o[s][j] = 0.f; }
  for (int c0 = 0; c0 < nkeys; c0 += 64) {
    const int kidx = c0 + lane; int row = -1; float bias = 0.f;
    bool valid = kidx < nkeys; if (valid) valid = kf(kidx, row, bias);
    const int rr = valid ? row : 0;
    rl[lane] = valid ? row : -1;
    float sc[NS];
#pragma unroll
    for (int s = 0; s < NS; ++s) {
      const uint4* kp = (const uint4*)(KV + (size_t)rr * ld + kcol + 64 * s); float d = 0.f;
#pragma unroll
      for (int i = 0; i < 8; ++i) { const uint4 w = kp[i]; const float* q = qs + s * 64 + i * 8;
        d += q[0] * __uint_as_float(w.x << 16) + q[1] * __uint_as_float(w.x & 0xffff0000u) + q[2] * __uint_as_float(w.y << 16) + q[3] * __uint_as_float(w.y & 0xffff0000u)
           + q[4] * __uint_as_float(w.z << 16) + q[5] * __uint_as_float(w.z & 0xffff0000u) + q[6] * __uint_as_float(w.w << 16) + q[7] * __uint_as_float(w.w & 0xffff0000u); }
      sc[s] = valid ? d + bias : -INFINITY;
    }
#pragma unroll
    for (int s = 0; s < NS; ++s) {
      const float cm = wave_max(sc[s]); const float mn = fmaxf(m[s], cm);
      float pv = 0.f, scale = 1.f;
      if (mn > -INFINITY) { pv = __expf(sc[s] - mn); scale = __expf(m[s] - mn); }
      l[s] = l[s] * scale + wave_sum(pv); m[s] = mn;
#pragma unroll
      for (int j = 0; j < VJ; ++j) o[s][j] *= scale;
      pl[s * 64 + lane] = pv;
    }
    __builtin_amdgcn_s_waitcnt(0); __builtin_amdgcn_wave_barrier();
    for (int kk = 0; kk < 64; ++kk) {
      const int rk = rl[kk]; if (rk < 0) continue;
      const bf16_t* vp = KV + (size_t)rk * ld + vcol + lane;
      float vv[VJ];
#pragma unroll
      for (int j = 0; j < VJ; ++j) vv[j] = bf2f(vp[64 * j]);
#pragma unroll
      for (int s = 0; s < NS; ++s) { const float pk = pl[s * 64 + kk];
#pragma unroll
        for (int j = 0; j < VJ; ++j) o[s][j] += pk * vv[j]; }
    }
    __builtin_amdgcn_s_waitcnt(0); __builtin_amdgcn_wave_barrier();
  }
  if (has_sink) {
#pragma unroll
    for (int s = 0; s < NS; ++s) { const float mn = fmaxf(m[s], sink); const float scale = __expf(m[s] - mn);
      l[s] = l[s] * scale + __expf(sink - mn); m[s] = mn;
#pragma unroll
      for (int j = 0; j < VJ; ++j) o[s][j] *= scale; }
  }
}

DEVI void phase_attn0(const Params& p, float* lds) {
  const int tid = ftid(), lane = tid & 63, wave = tid >> 6;
  const int gw = blockIdx.x * NWAVE + wave, NGW = gridDim.x * NWAVE;
  const bf16_t* Q = (const bf16_t*)(p.ws + WS_QKV0); bf16_t* ATT = (bf16_t*)(p.ws + WS_ATT0);
  const float lam = ((const float*)(p.ws + WS_CTL + CTL_LAM))[0];
  float* qs = lds + wave * 128; float* pl = lds + 1024 + wave * 128; int* rl = (int*)(lds + 2048) + wave * 64;
  for (long it = gw; it < (long)NROW * 12; it += NGW) {
    const int row = (int)(it / 12), hs = (int)(it % 12);
    const bool lat = row < NLAT; const int b = lat ? (row >> 12) : ((row - NLAT) >> 8), t = lat ? (row & 4095) : 0;
    __builtin_amdgcn_s_waitcnt(0); __builtin_amdgcn_wave_barrier();
    if (hs < 4) {
      const bf16_t* qp = Q + (size_t)row * N_IN0 + hs * 128;
      qs[lane] = bf2f(qp[lane]) * 0.125f; qs[64 + lane] = bf2f(qp[64 + lane]) * 0.125f;
      __builtin_amdgcn_s_waitcnt(0); __builtin_amdgcn_wave_barrier();
      float o[2][2], m[2], l[2];
      const int nkeys = lat ? SEQ + CTXL : CTXL;
      wave_attn<2, 2>(qs, pl, rl, nkeys, [&](int k, int& r, float& bias) { r = lat ? (k < SEQ ? b * SEQ + k : NLAT + b * CTXL + (k - SEQ)) : NLAT + b * CTXL + k; return true; },
                      Q, N_IN0, 512 + hs * 128, 1024 + hs * 128, 0.f, false, o, m, l, lane);
      float v0 = o[0][0] / l[0] - lam * o[1][0] / l[1], v1 = o[0][1] / l[0] - lam * o[1][1] / l[1];
      const float r = rsqrtf(wave_sum(v0 * v0 + v1 * v1) * (1.f / 128.f) + EPS);
      const float* g = p.in[L0_SUBLN];
      ATT[(size_t)row * DM + hs * 128 + lane] = f2bf(v0 * r * g[lane] * 0.8f);
      ATT[(size_t)row * DM + hs * 128 + 64 + lane] = f2bf(v1 * r * g[64 + lane] * 0.8f);
    } else {
      const int h = hs - 4;
      qs[lane] = bf2f(Q[(size_t)row * N_IN0 + 1536 + h * 64 + lane]) * 0.125f;
      __builtin_amdgcn_s_waitcnt(0); __builtin_amdgcn_wave_barrier();
      float o[1][1], m[1], l[1];
      const int qr = t >> 6, qc = t & 63;
      const int rs = min(max(qr - 4, 0), 56), cs = min(max(qc - 8, 0), 48);
      const float* rpb = p.in[L0_RPB] + h * 15 * 31;
      const int nkeys = lat ? 128 + CTXL : CTXL;
      wave_attn<1, 1>(qs, pl, rl, nkeys, [&](int k, int& r, float& bias) {
          if (!lat) { r = NLAT + b * CTXL + k; return true; }
          if (k < 128) { const int kr = rs + (k >> 4), kc = cs + (k & 15); r = b * SEQ + kr * 64 + kc; bias = rpb[(kr - qr + 7) * 31 + (kc - qc + 15)]; }
          else r = NLAT + b * CTXL + (k - 128);
          return true; },
        Q, N_IN0, 2048 + h * 64, 2560 + h * 64, 0.f, false, o, m, l, lane);
      ATT[(size_t)row * DM + 512 + h * 64 + lane] = f2bf(o[0][0] / l[0]);
    }
  }
}

DEVI void phase_outproj(const Params& p, float* lds, int layer) {
  const bf16_t* A = (const bf16_t*)(p.ws + (layer ? WS_ATT1 : WS_ATT0)); const bf16_t* W = (const bf16_t*)(p.ws + (layer ? WS_WOUT1 : WS_WOUT0));
  bf16_t* MIX = (bf16_t*)(p.ws + (layer ? WS_MIX1 : WS_MIX0));
  const int NTM = (layer ? NLAT : NROW) / 128; constexpr int NTN = DM / 64;
  for (int it = blockIdx.x; it < NTN * NTM; it += gridDim.x) {
    const int mt = it / NTN, nt = it % NTN, m0 = mt * 128;
    gemm_tile(lds, W, nt * 64, DM, [&](int r) { return A + (size_t)(m0 + r) * DM; },
      [&](int r, int n, float* v) { *(uint2*)(MIX + (size_t)(m0 + r) * DM + n) = make_uint2(pk2(v[0], v[1]), pk2(v[2], v[3])); });
  }
}

DEVI void phase_postmix(const Params& p, int layer) {
  const int lane = ftid() & 63, gw = blockIdx.x * NWAVE + (ftid() >> 6), NGW = gridDim.x * NWAVE;
  const float* MOD = (const float*)(p.ws + WS_CTL + CTL_MOD) + (size_t)layer * 9 * 6144;
  const bf16_t* MIX = (const bf16_t*)(p.ws + (layer ? WS_MIX1 : WS_MIX0));
  bf16_t* H = (bf16_t*)(p.ws + WS_H); float* AFF = (float*)(p.ws + WS_AFF); float* XC = (float*)(p.ws + WS_XC);
  const float* gpost = p.in[layer ? L1_GPOSTMIX : L0_GPOSTMIX]; const float* gpre = p.in[layer ? L1_GPREFFN : L0_GPREFFN];
  const float* wr = p.in[layer ? L1_WROUTER : L0_WROUTER];
  const int nrow = layer ? NLAT : NROW;
  for (int r = gw; r < nrow; r += NGW) {
    const float* m = MOD + (size_t)row_modrow(r) * 6144;
    const float* xin = layer ? (p.out + (size_t)r * DM) : (r < NLAT ? p.in[I_X] + (size_t)r * DM : p.in[I_CTX] + (size_t)(r - NLAT) * DM);
    float* xout = r < NLAT ? p.out + (size_t)r * DM : XC + (size_t)(r - NLAT) * DM;
    Row16 o = ld_row_bf16(MIX + (size_t)r * DM, lane);
    const float rr = rsqrtf(row_sumsq(o) * (1.f / DM) + EPS);
    { const Row16 A = ld_row_f32(gpost, lane), Bv = ld_row_f32(m + 2048, lane), Cv = ld_row_f32(xin, lane);
      ROW_FOR4(e = c + b * (e * rr * a)); }
    st_row_f32(xout, lane, o);
    const Row16 h = norm_mod(o, gpre, m + 4096, m + 3072, lane);
    st_row_bf16(H + (size_t)r * DM, lane, h);
    float lg[16];
#pragma unroll
    for (int e = 0; e < 16; ++e) lg[e] = 0.f;
#pragma unroll
    for (int j = 0; j < 4; ++j) {
      const float hv[4] = {h.v[j].x, h.v[j].y, h.v[j].z, h.v[j].w};
#pragma unroll
      for (int q = 0; q < 4; ++q) { const float4* w4 = (const float4*)(wr + (size_t)(lane * 4 + 256 * j + q) * 16);
#pragma unroll
        for (int e4 = 0; e4 < 4; ++e4) { const float4 w = w4[e4]; lg[e4 * 4] += hv[q] * w.x; lg[e4 * 4 + 1] += hv[q] * w.y; lg[e4 * 4 + 2] += hv[q] * w.z; lg[e4 * 4 + 3] += hv[q] * w.w; } }
    }
    float mx = -INFINITY;
#pragma unroll
    for (int e = 0; e < 16; ++e) { lg[e] = wave_sum(lg[e]); mx = fmaxf(mx, lg[e]); }
    float s = 0.f;
#pragma unroll
    for (int e = 0; e < 16; ++e) { lg[e] = expf(lg[e] - mx); s += lg[e]; }
    const float inv = 1.f / s;
    float mine = 0.f;
#pragma unroll
    for (int e = 0; e < 16; ++e) if (lane == e) mine = lg[e] * inv;
    if (lane < 16) AFF[(size_t)lane * NROW + r] = mine;
  }
}

DEVI void phase_topk(const Params& p, float* lds, int layer) {
  const int tid = ftid();
  const float* AFF = (const float*)(p.ws + WS_AFF); int* SLOT = (int*)(p.ws + WS_SLOT); int* IDX = (int*)(p.ws + WS_IDX); float* GV = (float*)(p.ws + WS_GATEV);
  const int erows = layer ? EROWS1 : EROWS0;
  const int nlat_items = NB * NE * 8, nitems = nlat_items + (layer ? 0 : NB * NE);
  for (int it = blockIdx.x; it < nitems; it += gridDim.x) {
    const bool lat = it < nlat_items;
    int b, e, ch, n, cap, row0, slot0;
    if (lat) { b = it / (NE * 8); e = (it / 8) % NE; ch = it % 8; n = SEQ; cap = CAP_L; row0 = b * SEQ; slot0 = b * CAP_L; }
    else { const int i2 = it - nlat_items; b = i2 / NE; e = i2 % NE; ch = 0; n = CTXL; cap = CAP_C; row0 = NLAT + b * CTXL; slot0 = NB * CAP_L + b * CAP_C; }
    __syncthreads();
    for (int i = tid; i < n; i += NT) lds[i] = AFF[(size_t)e * NROW + row0 + i];
    __syncthreads();
    const int t = ch * 512 + tid;
    if (t < n) {
      const float a = lds[t]; int rank = 0;
      for (int j = 0; j < n; ++j) { const float v = lds[j]; rank += (v > a || (v == a && j < t)) ? 1 : 0; }
      if (rank < cap) { IDX[e * erows + slot0 + rank] = row0 + t; GV[e * erows + slot0 + rank] = a; SLOT[(size_t)(row0 + t) * 16 + e] = slot0 + rank; }
      else SLOT[(size_t)(row0 + t) * 16 + e] = -1;
    }
  }
}

DEVI void phase_moe_up(const Params& p, float* lds, int layer) {
  const bf16_t* H = (const bf16_t*)(p.ws + WS_H); const bf16_t* WGU = (const bf16_t*)(p.ws + WS_WGU); bf16_t* HID = (bf16_t*)(p.ws + WS_HID);
  const int* IDX = (const int*)(p.ws + WS_IDX);
  const int erows = layer ? EROWS1 : EROWS0, NTM = erows / 128; constexpr int NTN = 2048 / 64;
  for (int it = blockIdx.x; it < NE * NTM * NTN; it += gridDim.x) {
    const int e = it / (NTM * NTN), r2 = it % (NTM * NTN), mt = r2 / NTN, nt = r2 % NTN, m0 = mt * 128;
    gemm_tile(lds, WGU + (size_t)e * 2048 * DM, nt * 64, DM, [&](int r) { return H + (size_t)IDX[e * erows + m0 + r] * DM; },
      [&](int r, int n, float* v) { *(unsigned*)(HID + ((size_t)e * erows + m0 + r) * DM + (n >> 1)) = pk2(silu_f(v[0]) * v[1], silu_f(v[2]) * v[3]); });
  }
}
DEVI void phase_moe_down(const Params& p, float* lds, int layer) {
  const bf16_t* HID = (const bf16_t*)(p.ws + WS_HID); const bf16_t* WD = (const bf16_t*)(p.ws + WS_WD); bf16_t* Y = (bf16_t*)(p.ws + WS_Y);
  const float* GV = (const float*)(p.ws + WS_GATEV);
  const int erows = layer ? EROWS1 : EROWS0, NTM = erows / 128; constexpr int NTN = DM / 64;
  for (int it = blockIdx.x; it < NE * NTM * NTN; it += gridDim.x) {
    const int e = it / (NTM * NTN), r2 = it % (NTM * NTN), mt = r2 / NTN, nt = r2 % NTN, m0 = mt * 128;
    gemm_tile(lds, WD + (size_t)e * DM * DM, nt * 64, DM, [&](int r) { return HID + ((size_t)e * erows + m0 + r) * DM; },
      [&](int r, int n, float* v) { const float g = GV[e * erows + m0 + r];
        *(uint2*)(Y + ((size_t)e * erows + m0 + r) * DM + n) = make_uint2(pk2(v[0] * g, v[1] * g), pk2(v[2] * g, v[3] * g)); });
  }
}

DEVI void phase_combine(const Params& p, float* lds, int layer) {
  const int lane = ftid() & 63, wave = ftid() >> 6, gw = blockIdx.x * NWAVE + wave, NGW = gridDim.x * NWAVE;
  const float* MOD = (const float*)(p.ws + WS_CTL + CTL_MOD);
  const bf16_t* Y = (const bf16_t*)(p.ws + WS_Y); const int* SLOT = (const int*)(p.ws + WS_SLOT);
  bf16_t* H = (bf16_t*)(p.ws + WS_H); float* XC = (float*)(p.ws + WS_XC);
  const float* gpost = p.in[layer ? L1_GPOSTFFN : L0_GPOSTFFN];
  const int nrow = layer ? NLAT : NROW, erows = layer ? EROWS1 : EROWS0;
  for (int r = gw; r < nrow; r += NGW) {
    const float* m = MOD + (size_t)(layer * 9 + row_modrow(r)) * 6144;
    float* xio = r < NLAT ? p.out + (size_t)r * DM : XC + (size_t)(r - NLAT) * DM;
    Row16 o;
#pragma unroll
    for (int j = 0; j < 4; ++j) o.v[j] = make_float4(0.f, 0.f, 0.f, 0.f);
    for (int e = 0; e < NE; ++e) {
      const int s = SLOT[(size_t)r * 16 + e];
      if (s >= 0) { const Row16 y = ld_row_bf16(Y + ((size_t)e * erows + s) * DM, lane);
#pragma unroll
        for (int j = 0; j < 4; ++j) { o.v[j].x += y.v[j].x; o.v[j].y += y.v[j].y; o.v[j].z += y.v[j].z; o.v[j].w += y.v[j].w; } }
    }
    const float rr = rsqrtf(row_sumsq(o) * (1.f / DM) + EPS);
    { const Row16 A = ld_row_f32(gpost, lane), Bv = ld_row_f32(m + 5120, lane), Cv = ld_row_f32(xio, lane);
      ROW_FOR4(e = c + b * (e * rr * a)); }
    st_row_f32(xio, lane, o);
    if (layer == 0) {
      const float* m1 = MOD + (size_t)(9 + row_modrow(r)) * 6144;
      const Row16 h = norm_mod(o, p.in[L1_GPREMIX], m1 + 1024, m1, lane);
      st_row_bf16(H + (size_t)r * DM, lane, h);
    }
  }
  if (layer == 0) { convert_moe_part(p, 1, 0, lds + wave * (64 * 33), gw, NGW, lane); convert_moe_part(p, 1, 1, lds + wave * (64 * 33), gw, NGW, lane); }
}

DEVI void phase_qkv1(const Params& p, float* lds) {
  const bf16_t* H = (const bf16_t*)(p.ws + WS_H); const bf16_t* W = (const bf16_t*)(p.ws + WS_WIN1);
  bf16_t* P1 = (bf16_t*)(p.ws + WS_P1); float* DT = (float*)(p.ws + WS_DT); const float* ROPE = (const float*)(p.ws + WS_CTL + CTL_ROPE);
  constexpr int NTN = 37, NTM = NROW / 128;
  for (int it = blockIdx.x; it < NTN * NTM; it += gridDim.x) {
    const int mt = it / NTN, nt = it % NTN, m0 = mt * 128;
    gemm_tile(lds, W, nt * 64, DM, [&](int r) { return H + (size_t)(m0 + r) * DM; },
      [&](int r, int n, float* v) {
        const int row = m0 + r;
        if (n >= 2304) { if (n < 2320) *(float4*)(DT + (size_t)row * 16 + (n - 2304)) = make_float4(v[0], v[1], v[2], v[3]); return; }
        if (row < NLAT && n < 640) { const int t = row & 4095; rope_pair(ROPE, t, n & 63, v[0], v[1]); rope_pair(ROPE, t, (n + 2) & 63, v[2], v[3]); }
        *(uint2*)(P1 + (size_t)row * 2304 + n) = make_uint2(pk2(v[0], v[1]), pk2(v[2], v[3]));
      });
  }
}

DEVI void phase_conv_swa(const Params& p, float* lds, bool do_swa) {
  const int tid = ftid(), lane = tid & 63, wave = tid >> 6;
  const int gw = blockIdx.x * NWAVE + wave, NGW = gridDim.x * NWAVE;
  const bf16_t* P1 = (const bf16_t*)(p.ws + WS_P1); bf16_t* U = (bf16_t*)(p.ws + WS_U); bf16_t* ATT = (bf16_t*)(p.ws + WS_ATT1);
  const float* cw = p.in[L1_CONVW]; const float* cb = p.in[L1_CONVB];
  for (long i = (long)blockIdx.x * NT + tid; i < (long)NROW * 1024; i += (long)gridDim.x * NT) {
    const int row = (int)(i >> 10), ch = (int)(i & 1023);
    int s0, len, t; if (row < NLAT) { s0 = row & ~4095; len = SEQ; t = row & 4095; } else { s0 = NLAT + ((row - NLAT) & ~255); len = CTXL; t = (row - NLAT) & 255; }
    float acc = cb[ch];
#pragma unroll
    for (int j = 0; j < 5; ++j) { const int tt = t + j - 2; if (tt >= 0 && tt < len) acc += cw[j * 1024 + ch] * bf2f(P1[(size_t)(s0 + tt) * 2304 + 768 + ch]); }
    U[(size_t)row * 1024 + ch] = f2bf(silu_f(acc));
  }
  if (!do_swa) return;
  float* qs = lds + wave * 128; float* pl = lds + 1024 + wave * 128; int* rl = (int*)(lds + 2048) + wave * 64;
  for (long it = gw; it < (long)NLAT * 8; it += NGW) {
    const int row = (int)(it >> 3), hq = (int)(it & 7), g = hq >> 2, b = row >> 12, t = row & 4095;
    __builtin_amdgcn_s_waitcnt(0); __builtin_amdgcn_wave_barrier();
    qs[lane] = bf2f(P1[(size_t)row * 2304 + hq * 64 + lane]) * 0.125f;
    __builtin_amdgcn_s_waitcnt(0); __builtin_amdgcn_wave_barrier();
    float o[1][1], m[1], l[1];
    wave_attn<1, 1>(qs, pl, rl, 320 + CTXL, [&](int k, int& r, float& bias) {
        if (k < 320) { const int kp = t - 128 + k; if (k > 256 || kp < 0 || kp >= SEQ) return false; r = b * SEQ + kp; return true; }
        r = NLAT + b * CTXL + (k - 320); return true; },
      P1, 2304, 512 + g * 64, 640 + g * 64, p.in[L1_SINKS][hq], true, o, m, l, lane);
    ATT[(size_t)row * DM + hq * 64 + lane] = f2bf(o[0][0] / l[0]);
  }
}

DEVI void phase_ssd(const Params& p, float* lds) {
  const int tid = ftid();
  const bf16_t* U = (const bf16_t*)(p.ws + WS_U); const float* DT = (const float*)(p.ws + WS_DT); float* YS = (float*)(p.ws + WS_YS);
  constexpr int CH = 32;
  float* xb = lds;
  float* bb = lds + CH * 64;
  float* cb = bb + CH * 128;
  float* db = cb + CH * 128;
  float* yb = db + 2 * CH;
  const int pi = tid >> 3, ns = (tid & 7) * 16;
  for (int it = blockIdx.x; it < NB * 8; it += gridDim.x) {
    const int b = it >> 3, hd = it & 7, g = hd >> 2;
    for (int dir = 0; dir < 2; ++dir) {
      const float a = -expf(p.in[dir ? L1_ALOGB : L1_ALOGF][hd]); const float dtb = p.in[dir ? L1_DTBB : L1_DTBF][hd];
      float st[16];
#pragma unroll
      for (int i = 0; i < 16; ++i) st[i] = 0.f;
      for (int seg = 0; seg < 2; ++seg) {
        const int len = seg ? SEQ : CTXL, s0 = seg ? b * SEQ : NLAT + b * CTXL;
        for (int c0 = 0; c0 < len; c0 += CH) {
          __syncthreads();
          for (int i = tid; i < CH * 320; i += NT) {
            const int st_i = i / 320, c = i % 320; const int tk = dir ? (len - 1 - (c0 + st_i)) : (c0 + st_i); const size_t r = (size_t)(s0 + tk);
            if (c < 64) xb[st_i * 64 + c] = bf2f(U[r * 1024 + hd * 64 + c]);
            else if (c < 192) bb[st_i * 128 + (c - 64)] = bf2f(U[r * 1024 + 512 + g * 128 + (c - 64)]);
            else cb[st_i * 128 + (c - 192)] = bf2f(U[r * 1024 + 768 + g * 128 + (c - 192)]);
          }
          if (tid < CH) { const int tk = dir ? (len - 1 - (c0 + tid)) : (c0 + tid); const float raw = DT[(size_t)(s0 + tk) * 16 + dir * 8 + hd] + dtb;
            const float dt = raw > 20.f ? raw : log1pf(expf(raw)); db[tid] = expf(dt * a); db[CH + tid] = dt; }
          __syncthreads();
          for (int i = 0; i < CH; ++i) {
            const float dec = db[i], dx = db[CH + i] * xb[i * 64 + pi]; float y = 0.f;
#pragma unroll
            for (int q = 0; q < 16; ++q) { st[q] = st[q] * dec + dx * bb[i * 128 + ns + q]; y += st[q] * cb[i * 128 + ns + q]; }
            y += __shfl_xor(y, 1); y += __shfl_xor(y, 2); y += __shfl_xor(y, 4);
            if ((tid & 7) == 0) yb[i * 64 + pi] = y;
          }
          __syncthreads();
          if (seg == 1) for (int i = tid; i < CH * 64; i += NT) {
            const int q = i >> 6, c = i & 63; const int tk = (dir ? (len - CH - c0) : c0) + q, st_i = dir ? (CH - 1 - q) : q;
            float* yp = YS + (size_t)(b * SEQ + tk) * 512 + hd * 64 + c;
            if (dir == 0) *yp = yb[st_i * 64 + c]; else *yp = *yp + yb[st_i * 64 + c];
          }
        }
      }
      __syncthreads(); __threadfence();
    }
  }
}

DEVI void phase_ssd_out(const Params& p) {
  const int lane = ftid() & 63, gw = blockIdx.x * NWAVE + (ftid() >> 6), NGW = gridDim.x * NWAVE;
  const bf16_t* U = (const bf16_t*)(p.ws + WS_U); const bf16_t* P1 = (const bf16_t*)(p.ws + WS_P1); const float* YS = (const float*)(p.ws + WS_YS);
  bf16_t* ATT = (bf16_t*)(p.ws + WS_ATT1);
  for (int r = gw; r < NLAT; r += NGW) {
    const int c0 = lane * 8, hd = c0 >> 6; const float dsk = p.in[L1_DSKIP][hd];
    const float4 y0 = *(const float4*)(YS + (size_t)r * 512 + c0), y1 = *(const float4*)(YS + (size_t)r * 512 + c0 + 4);
    const uint4 xw = *(const uint4*)(U + (size_t)r * 1024 + c0), zw = *(const uint4*)(P1 + (size_t)r * 2304 + 1792 + c0);
    float y[8] = {y0.x, y0.y, y0.z, y0.w, y1.x, y1.y, y1.z, y1.w};
    const unsigned xs[4] = {xw.x, xw.y, xw.z, xw.w}, zs[4] = {zw.x, zw.y, zw.z, zw.w};
    float ss = 0.f;
#pragma unroll
    for (int i = 0; i < 4; ++i) {
      const float x0 = __uint_as_float(xs[i] << 16), x1 = __uint_as_float(xs[i] & 0xffff0000u), z0 = __uint_as_float(zs[i] << 16), z1 = __uint_as_float(zs[i] & 0xffff0000u);
      y[2 * i] = (y[2 * i] + dsk * x0) * silu_f(z0); y[2 * i + 1] = (y[2 * i + 1] + dsk * x1) * silu_f(z1);
      ss += y[2 * i] * y[2 * i] + y[2 * i + 1] * y[2 * i + 1];
    }
#pragma unroll
    for (int o = 1; o < 32; o <<= 1) ss += __shfl_xor(ss, o);
    const float rr = rsqrtf(ss * (1.f / 256.f) + EPS);
    const float4 g0 = *(const float4*)(p.in[L1_GNORM] + c0), g1 = *(const float4*)(p.in[L1_GNORM] + c0 + 4);
    uint4 w; w.x = pk2(y[0] * rr * g0.x, y[1] * rr * g0.y); w.y = pk2(y[2] * rr * g0.z, y[3] * rr * g0.w); w.z = pk2(y[4] * rr * g1.x, y[5] * rr * g1.y); w.w = pk2(y[6] * rr * g1.z, y[7] * rr * g1.w);
    *(uint4*)(ATT + (size_t)r * DM + 512 + c0) = w;
  }
}

}
namespace pg8 {
#define PG8_LAS __attribute__((address_space(3)))
typedef unsigned short bf16_t;
typedef short bf16x8 __attribute__((ext_vector_type(8)));
typedef float f32x4 __attribute__((ext_vector_type(4)));
typedef unsigned u32x4 __attribute__((ext_vector_type(4)));
constexpr int BM = 256, BK = 64, HALF = 128, HTB = HALF * BK * 2  , STAGE_BYTES = 8 * HTB, NXCD = 8, WGM = 8;

__host__ __device__ __forceinline__ int lds_byte(int r, int c) { const int st = (r >> 4) * 2 + (c >> 5), rr = r & 15, cc = c & 31, ob = rr * 64 + cc * 2; return st * 1024 + (ob ^ (((ob >> 9) & 1) << 5)); }
__host__ __device__ __forceinline__ void stage_rc(int b, int& R, int& C) { const int st = b / 1024, sb = b % 1024, swz = sb ^ (((sb >> 9) & 1) << 5); R = (st >> 1) * 16 + swz / 64; C = (st & 1) * 32 + (swz % 64) / 2; }
__host__ __device__ __forceinline__ int perm32(int rho) { const int n = rho >> 4, i = rho & 15; return 8 * (i >> 2) + 4 * n + (i & 3); }

struct Unit { int pm, pn; };
struct Gemm { const bf16_t* A; const bf16_t* Bt; int M, N, K; const int* gidx = nullptr; int sw = 0x7f7f7f7f, sa = 0x7f7f7f7f; };

struct StaticOrder {
    int nM, nN, nwg, G, c;
    __host__ __device__ void init(int M, int N, int G_, int c_) { nM = M / BM; nN = N / BM; nwg = nM * nN; G = G_; c = c_; }
    __host__ __device__ bool next(int i, Unit& u) const {
        const long L = (long)i * G + c; if (L >= nwg) return false;
        int wgid = (int)L; { const int q = nwg / NXCD, r = nwg % NXCD, xcd = wgid % NXCD, off = wgid / NXCD; wgid = (xcd < r ? xcd * (q + 1) : r * (q + 1) + (xcd - r) * q) + off; }
        const int nig = WGM * nN, gid = wgid / nig, fm = gid * WGM, gsz = (nM - fm) < WGM ? (nM - fm) : WGM;
        u.pm = fm + ((wgid % nig) % gsz); u.pn = (wgid % nig) / gsz; return true;
    }
    __device__ __forceinline__ void a_ready(const Unit&) const {}
    __device__ __forceinline__ void done(const Unit&) const {}
};

template <class Epi, class Sched, bool ALIGN_EPI = false, bool SP2 = false, bool FP8 = false>
__device__ __forceinline__ void gemm_phase(PG8_LAS unsigned char* lds, const Gemm g, const Sched& S, const Epi& E) {
    const int tid = ftid(), wid = __builtin_amdgcn_readfirstlane(tid >> 6), lane = tid & 63, wr = wid >> 2, wc = wid & 3, fr = lane & 15, fq = lane >> 4;
    const int KB = g.K * (FP8 ? 1 : 2), nt = KB / (BK * 2);
    unsigned voffB[2]; int pR[2], pC[2];
#pragma unroll
    for (int i = 0; i < 2; ++i) { int R, C; stage_rc(tid * 16 + i * 8192, R, C); const int Rb = Epi::PERM ? ((R & ~31) + perm32(R & 31)) : R;
        pR[i] = R; pC[i] = C; voffB[i] = (unsigned)(Rb * KB + C * 2); }
    unsigned cvo[2][2], nvo[2][2];
#define PG8_SETVO(vo, pm_) do { _Pragma("unroll") for (int _h = 0; _h < 2; ++_h) _Pragma("unroll") for (int _i = 0; _i < 2; ++_i) { const int _r = (pm_) * BM + _h * HALF + pR[_i]; \
        const int _g = g.gidx ? g.gidx[_r] : _r; vo[_h][_i] = (unsigned)_g * (unsigned)KB + (unsigned)(pC[_i] * 2); } } while (0)
#define PG8_STAGEA(bufoff, koff, vo) do { _Pragma("unroll") for (int _i = 0; _i < 2; ++_i) \
        __builtin_amdgcn_global_load_lds((const unsigned*)((const char*)g.A + (koff) + (vo)[_i]), (PG8_LAS unsigned*)(lds + (bufoff) + ldsw + _i * 8192), 16, 0, 0); } while (0)
    const size_t kstep = (size_t)(BK * 2);
    const size_t hstep = (size_t)HALF * KB;
    const size_t tstep = 2 * hstep;
    const unsigned ldsw = (unsigned)wid * 1024u;
    const int aoff = lds_byte(wr * 64 + fr, fq * 8), boff = lds_byte(wc * 32 + fr, fq * 8);
#define PG8_SA(b, h) (((b) * 2 + (h)) * HTB)
#define PG8_SB(b, h) ((4 + (b) * 2 + (h)) * HTB)
#define PG8_STAGE(bufoff, gbase, voff) do { _Pragma("unroll") for (int _i = 0; _i < 2; ++_i) \
        __builtin_amdgcn_global_load_lds((const unsigned*)((const char*)(gbase) + (voff)[_i]), (PG8_LAS unsigned*)(lds + (bufoff) + ldsw + _i * 8192), 16, 0, 0); } while (0)
    typedef int v4i_t __attribute__((ext_vector_type(4))); typedef int v8i_t __attribute__((ext_vector_type(8)));
#define PG8_CAT8(x, y) __builtin_shufflevector(__builtin_bit_cast(v4i_t, x), __builtin_bit_cast(v4i_t, y), 0, 1, 2, 3, 4, 5, 6, 7)
#define PG8_LDA(dst, b, h) do { _Pragma("unroll") for (int m = 0; m < 4; ++m) { const bf16x8 f0_ = *(const PG8_LAS bf16x8*)(lds + PG8_SA(b, h) + aoff + m * 2048), f1_ = *(const PG8_LAS bf16x8*)(lds + PG8_SA(b, h) + aoff + m * 2048 + 1024); \
        if constexpr (FP8) dst##8[m] = PG8_CAT8(f0_, f1_); else { dst[m][0] = f0_; dst[m][1] = f1_; } } } while (0)
#define PG8_LDB(dst, b, h) do { _Pragma("unroll") for (int n = 0; n < 2; ++n) { const bf16x8 f0_ = *(const PG8_LAS bf16x8*)(lds + PG8_SB(b, h) + boff + n * 2048), f1_ = *(const PG8_LAS bf16x8*)(lds + PG8_SB(b, h) + boff + n * 2048 + 1024); \
        if constexpr (FP8) dst##8[n] = PG8_CAT8(f0_, f1_); else { dst[n][0] = f0_; dst[n][1] = f1_; } } } while (0)
typedef int v4i_t __attribute__((ext_vector_type(4))); typedef int v8i_t __attribute__((ext_vector_type(8)));
#define PG8_CAT8(x, y) __builtin_shufflevector(__builtin_bit_cast(v4i_t, x), __builtin_bit_cast(v4i_t, y), 0, 1, 2, 3, 4, 5, 6, 7)
#define PG8_MMA(ai, bj, At, Bt) do { __builtin_amdgcn_s_setprio(1); _Pragma("unroll") for (int m = 0; m < 4; ++m) _Pragma("unroll") for (int n = 0; n < 2; ++n) { \
        if constexpr (FP8) asm volatile("v_mfma_scale_f32_16x16x128_f8f6f4 %0, %1, %2, %0, %3, %4 op_sel_hi:[0,0,0]" : "+v"(acc[ai][bj][m][n]) : "v"(Bt##8[n]), "v"(At##8[m]), "v"(sw_), "v"(sa_)); \
        else { _Pragma("unroll") for (int k = 0; k < 2; ++k) acc[ai][bj][m][n] = __builtin_amdgcn_mfma_f32_16x16x32_bf16(Bt[n][k], At[m][k], acc[ai][bj][m][n], 0, 0, 0); } } \
        __builtin_amdgcn_s_setprio(0); } while (0)
#define PG8_WAIT_V(n) asm volatile("s_waitcnt vmcnt(" #n ")" ::: "memory")
#define PG8_WAIT_L(n) asm volatile("s_waitcnt lgkmcnt(" #n ")" ::: "memory")
#define PG8_BAR __builtin_amdgcn_s_barrier()
#define PG8_SCHED __builtin_amdgcn_sched_barrier(0)
    Unit cur, nxt; int ui = 0;
    if (!S.next(0, cur)) return;
    f32x4 acc[2][2][4][2];
#pragma unroll
    for (int a = 0; a < 2; ++a)
#pragma unroll
        for (int b = 0; b < 2; ++b)
#pragma unroll
            for (int m = 0; m < 4; ++m)
#pragma unroll
                for (int n = 0; n < 2; ++n) acc[a][b][m][n] = (f32x4){0.f, 0.f, 0.f, 0.f};
    const int sw_ = g.sw, sa_ = g.sa;
    bf16x8 At[4][2], B0[2][2], B1[2][2]; v8i_t At8[4], B08[2], B18[2];
    PG8_SETVO(cvo, cur.pm); const char* cB = (const char*)g.Bt + (size_t)cur.pn * tstep;
    S.a_ready(cur);
    if constexpr (SP2) {
        PG8_STAGE(PG8_SB(0, 0), cB, voffB); PG8_STAGE(PG8_SB(0, 1), cB + hstep, voffB); PG8_STAGEA(PG8_SA(0, 0), 0, cvo[0]); PG8_STAGEA(PG8_SA(0, 1), 0, cvo[1]);
        if (wr == 1) PG8_BAR;
        PG8_WAIT_V(2); PG8_BAR;
        PG8_STAGE(PG8_SB(1, 0), cB + kstep, voffB); PG8_STAGEA(PG8_SA(1, 0), kstep, cvo[0]); PG8_STAGE(PG8_SB(1, 1), cB + hstep + kstep, voffB);
        PG8_WAIT_V(6); PG8_BAR;
    } else {
        PG8_STAGE(PG8_SB(0, 0), cB, voffB); PG8_STAGEA(PG8_SA(0, 0), 0, cvo[0]); PG8_STAGE(PG8_SB(0, 1), cB + hstep, voffB); PG8_STAGEA(PG8_SA(0, 1), 0, cvo[1]);
        if (wr == 1) PG8_BAR;
        PG8_WAIT_V(4); PG8_BAR;
        PG8_STAGE(PG8_SB(1, 0), cB + kstep, voffB); PG8_STAGEA(PG8_SA(1, 0), kstep, cvo[0]); PG8_STAGE(PG8_SB(1, 1), cB + hstep + kstep, voffB);
        PG8_WAIT_V(6); PG8_BAR;
    }
    for (;;) {
        const bool has_next = S.next(ui + 1, nxt);
        if (has_next) PG8_SETVO(nvo, nxt.pm); else { nvo[0][0] = cvo[0][0]; nvo[0][1] = cvo[0][1]; nvo[1][0] = cvo[1][0]; nvo[1][1] = cvo[1][1]; }
        const char* nB = has_next ? (const char*)g.Bt + (size_t)nxt.pn * tstep : cB;
#pragma unroll 1
        for (int t = 0; t < nt; t += 2) {
            const bool last = (t == nt - 2);
            const size_t k1 = (size_t)(t + 1) * kstep;
            const size_t k2 = last ? 0 : (size_t)(t + 2) * kstep; unsigned v2[2][2];
            v2[0][0] = last ? nvo[0][0] : cvo[0][0]; v2[0][1] = last ? nvo[0][1] : cvo[0][1]; v2[1][0] = last ? nvo[1][0] : cvo[1][0]; v2[1][1] = last ? nvo[1][1] : cvo[1][1];
            const char* b2 = last ? nB : cB + (size_t)(t + 2) * kstep;
            const size_t k3 = k2 + kstep; const char* b3 = b2 + kstep;
            if (last && has_next) S.a_ready(nxt);
            if constexpr (SP2) {
            PG8_LDB(B0, 0, 0); PG8_LDB(B1, 0, 1); PG8_SCHED; PG8_LDA(At, 0, 0); PG8_STAGEA(PG8_SA(1, 1), k1, cvo[1]);
            PG8_WAIT_V(8); PG8_WAIT_L(0); PG8_BAR; PG8_MMA(0, 0, At, B0); PG8_MMA(0, 1, At, B1); PG8_BAR; PG8_SCHED;
            PG8_LDA(At, 0, 1); PG8_STAGE(PG8_SB(0, 0), b2, voffB); PG8_STAGE(PG8_SB(0, 1), b2 + hstep, voffB); PG8_STAGEA(PG8_SA(0, 0), k2, v2[0]);
            PG8_WAIT_V(8); PG8_WAIT_L(0); PG8_BAR; PG8_MMA(1, 0, At, B0); PG8_MMA(1, 1, At, B1); PG8_BAR; PG8_SCHED;
            PG8_LDB(B0, 1, 0); PG8_LDB(B1, 1, 1); PG8_SCHED; PG8_LDA(At, 1, 0); PG8_STAGEA(PG8_SA(0, 1), k2, v2[1]);
            PG8_WAIT_V(8); PG8_WAIT_L(0); PG8_BAR; PG8_MMA(0, 0, At, B0); PG8_MMA(0, 1, At, B1); PG8_BAR; PG8_SCHED;
            PG8_LDA(At, 1, 1); PG8_STAGE(PG8_SB(1, 0), b3, voffB); PG8_STAGE(PG8_SB(1, 1), b3 + hstep, voffB); PG8_STAGEA(PG8_SA(1, 0), k3, v2[0]);
            PG8_WAIT_V(8); PG8_WAIT_L(0); PG8_BAR; PG8_MMA(1, 0, At, B0); PG8_MMA(1, 1, At, B1); PG8_BAR; PG8_SCHED;
            } else {
            PG8_LDB(B0, 0, 0); PG8_SCHED; PG8_LDA(At, 0, 0); PG8_STAGEA(PG8_SA(1, 1), k1, cvo[1]);
            PG8_WAIT_L(8); PG8_BAR; PG8_WAIT_L(0); PG8_MMA(0, 0, At, B0); PG8_BAR; PG8_SCHED;
            PG8_LDB(B1, 0, 1); PG8_STAGE(PG8_SB(0, 0), b2, voffB);
            PG8_BAR; PG8_WAIT_L(0); PG8_MMA(0, 1, At, B1); PG8_BAR;
            PG8_LDA(At, 0, 1); PG8_STAGEA(PG8_SA(0, 0), k2, v2[0]);
            PG8_BAR; PG8_WAIT_L(0); PG8_MMA(1, 0, At, B0); PG8_BAR; PG8_SCHED;
            PG8_STAGE(PG8_SB(0, 1), b2 + hstep, voffB);
            PG8_WAIT_V(6); PG8_BAR; PG8_MMA(1, 1, At, B1); PG8_BAR;
            PG8_LDB(B0, 1, 0); PG8_SCHED; PG8_LDA(At, 1, 0); PG8_STAGEA(PG8_SA(0, 1), k2, v2[1]);
            PG8_WAIT_L(8); PG8_BAR; PG8_WAIT_L(0); PG8_MMA(0, 0, At, B0); PG8_BAR; PG8_SCHED;
            PG8_LDB(B1, 1, 1); PG8_STAGE(PG8_SB(1, 0), b3, voffB);
            PG8_BAR; PG8_WAIT_L(0); PG8_MMA(0, 1, At, B1); PG8_BAR;
            PG8_LDA(At, 1, 1); PG8_STAGEA(PG8_SA(1, 0), k3, v2[0]);
            PG8_BAR; PG8_WAIT_L(0); PG8_MMA(1, 0, At, B0); PG8_BAR; PG8_SCHED;
            PG8_STAGE(PG8_SB(1, 1), b3 + hstep, voffB);
            PG8_WAIT_V(6); PG8_BAR; PG8_MMA(1, 1, At, B1); PG8_BAR;
            }
        }
        if constexpr (ALIGN_EPI) { if (wr == 0) PG8_BAR; }
        if constexpr (FP8) asm volatile("s_nop 15\n\ts_nop 15" ::: "memory");
        if constexpr (!Epi::AFTER_DRAIN) { E(acc, cur, wr, wc, fr, fq); S.done(cur); }
        if (!has_next) break;
#pragma unroll
        for (int a = 0; a < 2; ++a)
#pragma unroll
            for (int b = 0; b < 2; ++b)
#pragma unroll
                for (int m = 0; m < 4; ++m)
#pragma unroll
                    for (int n = 0; n < 2; ++n) acc[a][b][m][n] = (f32x4){0.f, 0.f, 0.f, 0.f};
        cur = nxt; cvo[0][0] = nvo[0][0]; cvo[0][1] = nvo[0][1]; cvo[1][0] = nvo[1][0]; cvo[1][1] = nvo[1][1]; cB = nB; ++ui;
        if constexpr (ALIGN_EPI) { if (wr == 1) PG8_BAR; }
    }
    PG8_WAIT_V(0);
    if constexpr (!ALIGN_EPI) { if (wr == 0) PG8_BAR; }
    PG8_BAR;
    if constexpr (Epi::AFTER_DRAIN) { E.fused(acc, cur, wr, wc, fr, fq, lds, wid, lane); S.done(cur); }
#undef PG8_SA
#undef PG8_SB
#undef PG8_STAGE
#undef PG8_STAGEA
#undef PG8_SETVO
#undef PG8_LDA
#undef PG8_LDB
#undef PG8_MMA
#undef PG8_CAT8
#undef PG8_WAIT_V
#undef PG8_WAIT_L
#undef PG8_BAR
#undef PG8_SCHED
}
}
#ifndef FP8_SP2
#define FP8_SP2 true
#endif
#ifndef ATTNA_FP8
#define ATTNA_FP8 1
#endif
namespace fg {
using pg8::f32x4; using pg8::Unit;
typedef unsigned u32x4 __attribute__((ext_vector_type(4)));
typedef unsigned u32x2 __attribute__((ext_vector_type(2)));
DEVI unsigned cvtpk(float lo, float hi) { typedef float f2_t __attribute__((ext_vector_type(2))); typedef __bf16 b2_t __attribute__((ext_vector_type(2))); const f2_t v = {lo, hi}; const b2_t b = __builtin_convertvector(v, b2_t); return __builtin_bit_cast(unsigned, b); }
template <class TP> DEVI void rope8(TP ROPE, int t, int d0, f32x4& v0, f32x4& v1) {
  const int i0 = d0 >> 1, f0 = i0 & 15, pos = (i0 < 16) ? (t >> 6) : (t & 63);
  const f32x4 r0 = *(const PG8_LAS f32x4*)(ROPE + (pos * 16 + f0) * 2), r1 = *(const PG8_LAS f32x4*)(ROPE + (pos * 16 + f0) * 2 + 4);
  const f32x4 a = v0, b = v1;
  v0[0] = a[0] * r0[0] - a[1] * r0[1]; v0[1] = a[0] * r0[1] + a[1] * r0[0]; v0[2] = a[2] * r0[2] - a[3] * r0[3]; v0[3] = a[2] * r0[3] + a[3] * r0[2];
  v1[0] = b[0] * r1[0] - b[1] * r1[1]; v1[1] = b[0] * r1[1] + b[1] * r1[0]; v1[2] = b[2] * r1[2] - b[3] * r1[3]; v1[3] = b[2] * r1[3] + b[3] * r1[2];
}
#define EPI_LOOP_BEGIN const int row0 = u.pm * 256 + wr * 64 + fr; \
  _Pragma("unroll") for (int ai = 0; ai < 2; ++ai) _Pragma("unroll") for (int m = 0; m < 4; ++m) { const int row = row0 + ai * 128 + m * 16; \
  _Pragma("unroll") for (int bj = 0; bj < 2; ++bj) { f32x4 v0 = acc[ai][bj][m][0], v1 = acc[ai][bj][m][1]; const int cl = bj * 128 + wc * 32 + 8 * fq;
#define EPI_LOOP_END } }

struct EpiQKV0 { static constexpr bool PERM = true, AFTER_DRAIN = false; bf16_t* O; const PG8_LAS float* ROPE; unsigned char* VT; unsigned char* VTB;
  DEVI void operator()(const f32x4 (&acc)[2][2][4][2], const Unit& u, int wr, int wc, int fr, int fq) const {
    const int colt = u.pn * 256; const bool rope = (u.pm < NLAT / 256) && (colt < 1024);
    EPI_LOOP_BEGIN
      const int col = colt + cl;
      if (ATTNA_FP8 && colt >= 1024 && colt < 1536) {
        const int hh = (col - 1024) >> 7, dv0 = (col - 1024) & 127;
        int bb, t; if (row < NLAT) { bb = row >> 12; t = row & 4095; } else { bb = (row - NLAT) >> 8; t = 4096 + ((row - NLAT) & 255); }
        const int k = t & 31, gq = k >> 3, wq = k & 7, pos = (wq < 4) ? gq * 4 + wq : 16 + gq * 4 + (wq - 4);
        unsigned char* vp = VT + (size_t)((bb * 4 + hh) * 128 + dv0) * 4352 + (t & ~31) + pos;
        const unsigned w0 = nv::pack4_fp8(v0[0] * 4.f, v0[1] * 4.f, v0[2] * 4.f, v0[3] * 4.f), w1 = nv::pack4_fp8(v1[0] * 4.f, v1[1] * 4.f, v1[2] * 4.f, v1[3] * 4.f);
        vp[0 * 4352] = (unsigned char)w0; vp[1 * 4352] = (unsigned char)(w0 >> 8); vp[2 * 4352] = (unsigned char)(w0 >> 16); vp[3 * 4352] = (unsigned char)(w0 >> 24);
        vp[4 * 4352] = (unsigned char)w1; vp[5 * 4352] = (unsigned char)(w1 >> 8); vp[6 * 4352] = (unsigned char)(w1 >> 16); vp[7 * 4352] = (unsigned char)(w1 >> 24);
        continue;
      }
      if (ATTNA_FP8 && colt >= 2560) {
        const int hh = (col - 2560) >> 6, dv0 = (col - 2560) & 63;
        int bb, t; if (row < NLAT) { bb = row >> 12; t = row & 4095; } else { bb = (row - NLAT) >> 8; t = 4096 + ((row - NLAT) & 255); }
        const int k = t & 31, gq = k >> 3, wq = k & 7, pos = (wq < 4) ? gq * 4 + wq : 16 + gq * 4 + (wq - 4);
        unsigned char* vp = VTB + (size_t)((bb * 8 + hh) * 64 + dv0) * 4352 + (t & ~31) + pos;
        const unsigned w0 = nv::pack4_fp8(v0[0] * 4.f, v0[1] * 4.f, v0[2] * 4.f, v0[3] * 4.f), w1 = nv::pack4_fp8(v1[0] * 4.f, v1[1] * 4.f, v1[2] * 4.f, v1[3] * 4.f);
        vp[0 * 4352] = (unsigned char)w0; vp[1 * 4352] = (unsigned char)(w0 >> 8); vp[2 * 4352] = (unsigned char)(w0 >> 16); vp[3 * 4352] = (unsigned char)(w0 >> 24);
        vp[4 * 4352] = (unsigned char)w1; vp[5 * 4352] = (unsigned char)(w1 >> 8); vp[6 * 4352] = (unsigned char)(w1 >> 16); vp[7 * 4352] = (unsigned char)(w1 >> 24);
        continue;
      }
      if (rope) rope8(ROPE, row & 4095, col & 63, v0, v1);
      if (ATTNA_FP8 && (colt < 1024 || colt >= 1536)) {
        const float sc = (colt < 512 || (colt >= 1536 && colt < 2048)) ? 16.f * 0.125f * 1.4426950408889634f : 4.f;
        u32x2 w8; w8.x = nv::pack4_fp8(v0[0] * sc, v0[1] * sc, v0[2] * sc, v0[3] * sc); w8.y = nv::pack4_fp8(v1[0] * sc, v1[1] * sc, v1[2] * sc, v1[3] * sc);
        *(u32x2*)((unsigned char*)O + (size_t)row * (N_IN0 * 2) + col) = w8;
        continue;
      }
      u32x4 w; w.x = cvtpk(v0[0], v0[1]); w.y = cvtpk(v0[2], v0[3]); w.z = cvtpk(v1[0], v1[1]); w.w = cvtpk(v1[2], v1[3]);
      *(u32x4*)(O + (size_t)row * N_IN0 + col) = w;
    EPI_LOOP_END
  } };
struct EpiQKV1 { static constexpr bool PERM = true, AFTER_DRAIN = false; bf16_t* O; float* DT; const PG8_LAS float* ROPE;
  DEVI void operator()(const f32x4 (&acc)[2][2][4][2], const Unit& u, int wr, int wc, int fr, int fq) const {
    const int colt = u.pn * 256; const bool lat = (u.pm < NLAT / 256);
    EPI_LOOP_BEGIN
      const int col = colt + cl;
      if (col >= 2304) { if (col < 2320) { *(f32x4*)(DT + (size_t)row * 16 + (col - 2304)) = v0; *(f32x4*)(DT + (size_t)row * 16 + (col - 2304) + 4) = v1; } }
      else {
        if (lat && col < 640) rope8(ROPE, row & 4095, col & 63, v0, v1);
        u32x4 w; w.x = cvtpk(v0[0], v0[1]); w.y = cvtpk(v0[2], v0[3]); w.z = cvtpk(v1[0], v1[1]); w.w = cvtpk(v1[2], v1[3]);
        *(u32x4*)(O + (size_t)row * 2304 + col) = w;
      }
    EPI_LOOP_END
  } };
struct EpiPlain { static constexpr bool PERM = true, AFTER_DRAIN = false; bf16_t* O;
  DEVI void operator()(const f32x4 (&acc)[2][2][4][2], const Unit& u, int wr, int wc, int fr, int fq) const {
    const int colt = u.pn * 256;
    EPI_LOOP_BEGIN
      u32x4 w; w.x = cvtpk(v0[0], v0[1]); w.y = cvtpk(v0[2], v0[3]); w.z = cvtpk(v1[0], v1[1]); w.w = cvtpk(v1[2], v1[3]);
      *(u32x4*)(O + (size_t)row * DM + colt + cl) = w;
    EPI_LOOP_END
  } };
DEVI float silu_fast(float v) { return v * __builtin_amdgcn_rcpf(1.f + __expf(-v)); }
struct EpiSwiGLU { static constexpr bool PERM = true, AFTER_DRAIN = false; bf16_t* O;
  DEVI void operator()(const f32x4 (&acc)[2][2][4][2], const Unit& u, int wr, int wc, int fr, int fq) const {
    const int colt = (u.pn & 7) * 256;
    EPI_LOOP_BEGIN
      u32x2 w; w.x = cvtpk(silu_fast(v0[0]) * v0[1], silu_fast(v0[2]) * v0[3]); w.y = cvtpk(silu_fast(v1[0]) * v1[1], silu_fast(v1[2]) * v1[3]);
      *(u32x2*)(O + (size_t)row * DM + ((colt + cl) >> 1)) = w;
    EPI_LOOP_END
  } };
struct EpiSwiGLU8 { static constexpr bool PERM = true, AFTER_DRAIN = false; unsigned char* O;
  DEVI void operator()(const f32x4 (&acc)[2][2][4][2], const Unit& u, int wr, int wc, int fr, int fq) const {
    const int colt = (u.pn & 7) * 256;
    EPI_LOOP_BEGIN
      const unsigned w = nv::pack4_fp8(silu_fast(v0[0]) * v0[1] * nv::A8_SCALE, silu_fast(v0[2]) * v0[3] * nv::A8_SCALE, silu_fast(v1[0]) * v1[1] * nv::A8_SCALE, silu_fast(v1[2]) * v1[3] * nv::A8_SCALE);
      *(unsigned*)(O + (size_t)row * DM + ((colt + cl) >> 1)) = w;
    EPI_LOOP_END
  } };
struct EpiDown { static constexpr bool PERM = true, AFTER_DRAIN = false; bf16_t* O;
  DEVI void operator()(const f32x4 (&acc)[2][2][4][2], const Unit& u, int wr, int wc, int fr, int fq) const {
    const int colt = (u.pn & 3) * 256;
    EPI_LOOP_BEGIN
      u32x4 w; w.x = cvtpk(v0[0], v0[1]); w.y = cvtpk(v0[2], v0[3]); w.z = cvtpk(v1[0], v1[1]); w.w = cvtpk(v1[2], v1[3]);
      *(u32x4*)(O + (size_t)row * DM + colt + cl) = w;
    EPI_LOOP_END
  } };
struct ExpOrder : pg8::StaticOrder { int nMe, nNe;
  __device__ void init2(int erows, int Ne, int G_, int c_) { nMe = erows / 256; nNe = Ne / 256; init(NE * erows, Ne, G_, c_); }
  __device__ bool next(int i, Unit& u) const { if (!pg8::StaticOrder::next(i, u)) return false; u.pn += (u.pm / nMe) * nNe; return true; } };

typedef PG8_LAS unsigned char* ldsp_t;
DEVI void phase_qkv0(const Params& p, ldsp_t lds) {
  pg8::Gemm g{(const bf16_t*)(p.ws + WS_H), (const bf16_t*)(p.ws + WS_WIN0), NROW, N_IN0, DM, nullptr, nv::W8_E8M0, nv::A8_E8M0}; pg8::StaticOrder S; S.init(NROW, N_IN0, gridDim.x, blockIdx.x);
  PG8_LAS float* RL = (PG8_LAS float*)(lds + pg8::STAGE_BYTES);
  for (int i = ftid(); i < 64 * 16 * 2; i += NT) RL[i] = ((const float*)(p.ws + WS_CTL + CTL_ROPE))[i];
  __syncthreads();
  EpiQKV0 E{(bf16_t*)(p.ws + WS_QKV0), RL, (unsigned char*)(p.ws + WS_VT), (unsigned char*)(p.ws + WS_VTB)};
  pg8::gemm_phase<EpiQKV0, pg8::StaticOrder, true, true, (QKV0_FP8 != 0)>(lds, g, S, E);
}
DEVI void phase_qkv1(const Params& p, ldsp_t lds) {
  pg8::Gemm g{(const bf16_t*)(p.ws + WS_H), (const bf16_t*)(p.ws + WS_WIN1), NROW, N_IN1P, DM, nullptr, nv::W8_E8M0, nv::A8_E8M0}; pg8::StaticOrder S; S.init(NROW, N_IN1P, gridDim.x, blockIdx.x);
  PG8_LAS float* RL = (PG8_LAS float*)(lds + pg8::STAGE_BYTES);
  for (int i = ftid(); i < 64 * 16 * 2; i += NT) RL[i] = ((const float*)(p.ws + WS_CTL + CTL_ROPE))[i];
  __syncthreads();
  EpiQKV1 E{(bf16_t*)(p.ws + WS_P1), (float*)(p.ws + WS_DT), RL};
  pg8::gemm_phase<EpiQKV1, pg8::StaticOrder, true, true, (QKV1_FP8 != 0)>(lds, g, S, E);
}
DEVI void phase_outproj(const Params& p, ldsp_t lds, int layer) {
  const int M = layer ? NLAT : NROW;
  pg8::Gemm g{(const bf16_t*)(p.ws + (layer ? WS_ATT1 : WS_ATT0)), (const bf16_t*)(p.ws + (layer ? WS_WOUT1 : WS_WOUT0)), M, DM, DM, nullptr, nv::W8_E8M0, nv::A8_E8M0}; pg8::StaticOrder S; S.init(M, DM, gridDim.x, blockIdx.x);
  EpiPlain E{(bf16_t*)(p.ws + (layer ? WS_MIX1 : WS_MIX0))};
  pg8::gemm_phase<EpiPlain, pg8::StaticOrder, true, true, (OUT_FP8 != 0)>(lds, g, S, E);
}
DEVI void phase_moe_up(const Params& p, ldsp_t lds, int layer) {
  const int erows = layer ? EROWS1 : EROWS0;
  pg8::Gemm g{(const bf16_t*)(p.ws + WS_H), (const bf16_t*)(p.ws + WS_WGU), NE * erows, 2048, DM, (const int*)(p.ws + WS_IDX)}; ExpOrder S; S.init2(erows, 2048, gridDim.x, blockIdx.x);
  EpiSwiGLU E{(bf16_t*)(p.ws + WS_HID)};
  pg8::gemm_phase<EpiSwiGLU, ExpOrder, true, true>(lds, g, S, E);
}
DEVI void phase_moe_down(const Params& p, ldsp_t lds, int layer) {
  const int erows = layer ? EROWS1 : EROWS0;
  pg8::Gemm g{(const bf16_t*)(p.ws + WS_HID), (const bf16_t*)(p.ws + WS_WD), NE * erows, DM, DM}; ExpOrder S; S.init2(erows, DM, gridDim.x, blockIdx.x);
  EpiDown E{(bf16_t*)(p.ws + WS_Y)};
  pg8::gemm_phase<EpiDown, ExpOrder, true, true>(lds, g, S, E);
}
DEVI void phase_moe_up8(const Params& p, ldsp_t lds, int layer) {
  const int erows = layer ? EROWS1 : EROWS0;
  pg8::Gemm g{(const bf16_t*)(p.ws + WS_H), (const bf16_t*)(p.ws + WS_WGU), NE * erows, 2048, DM, (const int*)(p.ws + WS_IDX), nv::W8_E8M0, nv::A8_E8M0}; ExpOrder S; S.init2(erows, 2048, gridDim.x, blockIdx.x);
  EpiSwiGLU8 E{(unsigned char*)(p.ws + WS_HID)};
  pg8::gemm_phase<EpiSwiGLU8, ExpOrder, true, FP8_SP2, true>(lds, g, S, E);
}
DEVI void phase_moe_down8(const Params& p, ldsp_t lds, int layer) {
  const int erows = layer ? EROWS1 : EROWS0;
  pg8::Gemm g{(const bf16_t*)(p.ws + WS_HID), (const bf16_t*)(p.ws + WS_WD), NE * erows, DM, DM, nullptr, nv::W8_E8M0, nv::A8_E8M0}; ExpOrder S; S.init2(erows, DM, gridDim.x, blockIdx.x);
  EpiDown E{(bf16_t*)(p.ws + WS_Y)};
  pg8::gemm_phase<EpiDown, ExpOrder, true, FP8_SP2, true>(lds, g, S, E);
}
DEVI void phase_gather(const Params& p, int layer) {
  const int lane = ftid() & 63, gw = blockIdx.x * NWAVE + (ftid() >> 6), NGW = gridDim.x * NWAVE;
  const int erows = layer ? EROWS1 : EROWS0; const int* IDX = (const int*)(p.ws + WS_IDX);
  const bf16_t* H = (const bf16_t*)(p.ws + WS_H); bf16_t* XG = (bf16_t*)(p.ws + WS_XG);
  for (int r = gw; r < NE * erows; r += NGW) {
    const uint4* s = (const uint4*)(H + (size_t)IDX[r] * DM) + lane; uint4* d = (uint4*)(XG + (size_t)r * DM) + lane;
    const uint4 a = s[0], b = s[64]; d[0] = a; d[64] = b;
  }
}
}
#ifndef ATTNA_FP8
#define ATTNA_FP8 1
#endif
namespace fa {
#define FA_LAS __attribute__((address_space(3)))
typedef short bf16x8 __attribute__((ext_vector_type(8)));
typedef short s16x4 __attribute__((ext_vector_type(4)));
typedef float f32x16 __attribute__((ext_vector_type(16)));
typedef FA_LAS unsigned char* ldsp_t;
typedef unsigned u32x4 __attribute__((ext_vector_type(4)));
constexpr float LOG2E = 1.4426950408889634f, C2 = 0.125f * LOG2E;
DEVI int crow(int r, int hi) { return (r & 3) + 8 * (r >> 2) + 4 * hi; }
DEVI unsigned cvtpk(float lo, float hi) { typedef float f2_t __attribute__((ext_vector_type(2))); typedef __bf16 b2_t __attribute__((ext_vector_type(2))); const f2_t v = {lo, hi}; const b2_t b = __builtin_convertvector(v, b2_t); return __builtin_bit_cast(unsigned, b); }
DEVI s16x4 vtr(ldsp_t p) { return __builtin_bit_cast(s16x4, __builtin_amdgcn_ds_read_tr16_b64_v4i16((FA_LAS s16x4*)p)); }

DEVI float max3f(float a, float b, float c) { float r; asm("v_max3_f32 %0, %1, %2, %3" : "=v"(r) : "v"(a), "v"(b), "v"(c)); return r; }
template <int KW, int DVB> struct Geo {
  static constexpr int VW = DVB * 32;
  static constexpr int KSTR = KW * 2 + 16, VSTR = VW * 2 + 64;
  static constexpr int KBYTES = 64 * KSTR, VBYTES = 64 * VSTR, STAGE = KBYTES + VBYTES;
  static constexpr int CPR = (KW + VW) / 8, NCH = 64 * CPR / NT;
};

DEVI bf16x8 load_q8(const bf16_t* p, float sc) {
  const uint4 w = *(const uint4*)p; const unsigned u[4] = {w.x, w.y, w.z, w.w}; unsigned o[4];
#pragma unroll
  for (int i = 0; i < 4; ++i) o[i] = cvtpk(__uint_as_float(u[i] << 16) * sc, __uint_as_float(u[i] & 0xffff0000u) * sc);
  uint4 r = make_uint4(o[0], o[1], o[2], o[3]); return __builtin_bit_cast(bf16x8, r);
}

template <int KW, int DVB, class Src, class Act, class Msk>
DEVI void flash_pass(ldsp_t lds, int ntiles, const bf16_t* kv, int ld, int kcol, int vcol, const bf16x8 (&q)[4], int kofs,
                     Src src, Act act, Msk msk, f32x16 (&o)[DVB], float& m, float& l) {
  typedef Geo<KW, DVB> G;
  const int tid = ftid(), lane = tid & 63, r32 = lane & 31, hi = lane >> 5;
  u32x4 stg[G::NCH];
  int crw[G::NCH], ccol[G::NCH], cdst[G::NCH];
#pragma unroll
  for (int i = 0; i < G::NCH; ++i) { const int c = tid + NT * i, row = c / G::CPR, cc = c % G::CPR; crw[i] = row;
    if (cc < KW / 8) { ccol[i] = kcol + cc * 8; cdst[i] = row * G::KSTR + cc * 16; } else { ccol[i] = vcol + (cc - KW / 8) * 8; cdst[i] = G::KBYTES + row * G::VSTR + (cc - KW / 8) * 16; } }
#pragma unroll
  for (int i = 0; i < G::NCH; ++i) stg[i] = *(const u32x4*)(kv + (size_t)src(0, crw[i]) * ld + ccol[i]);
#pragma unroll
  for (int i = 0; i < G::NCH; ++i) *(FA_LAS u32x4*)(lds + cdst[i]) = stg[i];
  __syncthreads();
  const int kroff = r32 * G::KSTR + (kofs + 8 * hi) * 2;
  const int vroff = G::KBYTES + (4 * hi + ((lane & 15) >> 2)) * G::VSTR + 32 * ((lane >> 4) & 1) + 8 * (lane & 3);
  for (int kt = 0; kt < ntiles; ++kt) {
    const int buf = (kt & 1) * G::STAGE;
    const bool more = kt + 1 < ntiles;
    if (more) {
#pragma unroll
      for (int i = 0; i < G::NCH; ++i) stg[i] = *(const u32x4*)(kv + (size_t)src(kt + 1, crw[i]) * ld + ccol[i]);
    }
    if (act(kt)) {
      const ldsp_t kb = lds + buf + kroff;
      f32x16 p0, p1;
#pragma unroll
      for (int r = 0; r < 16; ++r) { p0[r] = 0.f; p1[r] = 0.f; }
#pragma unroll
      for (int d0 = 0; d0 < 4; ++d0) {
        const bf16x8 a0 = *(const FA_LAS bf16x8*)(kb + d0 * 32), a1 = *(const FA_LAS bf16x8*)(kb + 32 * G::KSTR + d0 * 32);
        p0 = __builtin_amdgcn_mfma_f32_32x32x16_bf16(a0, q[d0], p0, 0, 0, 0);
        p1 = __builtin_amdgcn_mfma_f32_32x32x16_bf16(a1, q[d0], p1, 0, 0, 0);
      }
      msk(kt, p0, p1);
      float mx = fmaxf(p0[0], p1[0]);
#pragma unroll
      for (int r = 1; r < 16; ++r) mx = fmaxf(mx, fmaxf(p0[r], p1[r]));
      mx = fmaxf(mx, __shfl_xor(mx, 32));
      if (__any(mx > m)) {
        const float mn = fmaxf(m, mx), alpha = __builtin_amdgcn_exp2f(m - mn);
        l *= alpha; m = mn;
#pragma unroll
        for (int b = 0; b < DVB; ++b)
#pragma unroll
          for (int r = 0; r < 16; ++r) o[b][r] *= alpha;
      }
      float ls = 0.f;
#pragma unroll
      for (int r = 0; r < 16; ++r) { p0[r] = __builtin_amdgcn_exp2f(p0[r] - m); p1[r] = __builtin_amdgcn_exp2f(p1[r] - m); ls += p0[r] + p1[r]; }
      l += ls;
      bf16x8 pa[4];
      { uint4 t;
        t = make_uint4(cvtpk(p0[0], p0[1]), cvtpk(p0[2], p0[3]), cvtpk(p0[4], p0[5]), cvtpk(p0[6], p0[7])); pa[0] = __builtin_bit_cast(bf16x8, t);
        t = make_uint4(cvtpk(p0[8], p0[9]), cvtpk(p0[10], p0[11]), cvtpk(p0[12], p0[13]), cvtpk(p0[14], p0[15])); pa[1] = __builtin_bit_cast(bf16x8, t);
        t = make_uint4(cvtpk(p1[0], p1[1]), cvtpk(p1[2], p1[3]), cvtpk(p1[4], p1[5]), cvtpk(p1[6], p1[7])); pa[2] = __builtin_bit_cast(bf16x8, t);
        t = make_uint4(cvtpk(p1[8], p1[9]), cvtpk(p1[10], p1[11]), cvtpk(p1[12], p1[13]), cvtpk(p1[14], p1[15])); pa[3] = __builtin_bit_cast(bf16x8, t); }
      const ldsp_t vb = lds + buf + vroff;
#pragma unroll
      for (int b = 0; b < DVB; ++b)
#pragma unroll
        for (int ks = 0; ks < 4; ++ks) {
          const s16x4 lo = vtr(vb + (16 * ks) * G::VSTR + b * 64), h8 = vtr(vb + (16 * ks + 8) * G::VSTR + b * 64);
          const bf16x8 vf = {lo[0], lo[1], lo[2], lo[3], h8[0], h8[1], h8[2], h8[3]};
          o[b] = __builtin_amdgcn_mfma_f32_32x32x16_bf16(vf, pa[ks], o[b], 0, 0, 0);
        }
    }
    if (more) {
      const int nb = ((kt + 1) & 1) * G::STAGE;
#pragma unroll
      for (int i = 0; i < G::NCH; ++i) *(FA_LAS u32x4*)(lds + nb + cdst[i]) = stg[i];
    }
    __syncthreads();
  }
}


template <int V> struct IC { static constexpr int value = V; };
template <int KW, int DVB, int ABL, int PF, class Src, class Msk>
DEVI void flash_pass2(ldsp_t lds, int ntiles, const bf16_t* kv, int ld, int kcol, int vcol, const bf16x8 (&q)[4], int kofs,
                      Src src, Msk msk, f32x16 (&o)[DVB], float& m, float& l) {
  typedef Geo<KW, DVB> G;
  const int tid = ftid(), lane = tid & 63, r32 = lane & 31, hi = lane >> 5;
  u32x4 stg[PF][G::NCH];
  int crw[G::NCH], ccol[G::NCH], cdst[G::NCH];
#pragma unroll
  for (int i = 0; i < G::NCH; ++i) { const int c = tid + NT * i, row = c / G::CPR, cc = c % G::CPR; crw[i] = row;
    if (cc < KW / 8) { ccol[i] = kcol + cc * 8; cdst[i] = row * G::KSTR + cc * 16; } else { ccol[i] = vcol + (cc - KW / 8) * 8; cdst[i] = G::KBYTES + row * G::VSTR + (cc - KW / 8) * 16; } }
#define FP2_LOAD(kt, set) _Pragma("unroll") for (int i = 0; i < G::NCH; ++i) stg[set][i] = *(const u32x4*)(kv + (size_t)src((kt), crw[i]) * ld + ccol[i])
#define FP2_STORE(st, set) _Pragma("unroll") for (int i = 0; i < G::NCH; ++i) *(FA_LAS u32x4*)(lds + (st) * G::STAGE + cdst[i]) = stg[set][i]
  FP2_LOAD(0, 0); FP2_STORE(0, 0);
  if (ntiles > 1) { FP2_LOAD(1, 0); FP2_STORE(1, 0); }
  __syncthreads();
  if (ntiles > 2) FP2_LOAD(2, 0);
  if (PF == 2) { if (ntiles > 3) FP2_LOAD(3, PF - 1); }
  const int kroff = r32 * G::KSTR + (kofs + 8 * hi) * 2;
  const int vroff = G::KBYTES + (4 * hi + ((lane & 15) >> 2)) * G::VSTR + 32 * ((lane >> 4) & 1) + 8 * (lane & 3);
  f32x16 c0, c1;
#pragma unroll
  for (int r = 0; r < 16; ++r) { c0[r] = 0.f; c1[r] = 0.f; }
  { const ldsp_t kb = lds + kroff;
#pragma unroll
    for (int d0 = 0; d0 < 4; ++d0) {
      const bf16x8 a0 = *(const FA_LAS bf16x8*)(kb + d0 * 32), a1 = *(const FA_LAS bf16x8*)(kb + 32 * G::KSTR + d0 * 32);
      c0 = __builtin_amdgcn_mfma_f32_32x32x16_bf16(a0, q[d0], c0, 0, 0, 0); c1 = __builtin_amdgcn_mfma_f32_32x32x16_bf16(a1, q[d0], c1, 0, 0, 0); } }
  asm volatile("s_nop 15\n\ts_nop 7" : "+v"(c0), "+v"(c1));
  int st_cur = 0, st_nxt = 1, st_fill = 2;
  auto body = [&](int kt, auto PARC) {
    constexpr int set = (PF == 2) ? decltype(PARC)::value : 0;
    msk(kt, c0, c1);
    __builtin_amdgcn_sched_barrier(0);
    f32x16 n0, n1;
#pragma unroll
    for (int r = 0; r < 16; ++r) { n0[r] = 0.f; n1[r] = 0.f; }
    const ldsp_t kb = lds + st_nxt * G::STAGE + kroff;
    bf16x8 ka[4], kb2[4];
#pragma unroll
    for (int d0 = 0; d0 < 4; ++d0) { ka[d0] = *(const FA_LAS bf16x8*)(kb + d0 * 32); kb2[d0] = *(const FA_LAS bf16x8*)(kb + 32 * G::KSTR + d0 * 32); }
#define FP2_SB() __builtin_amdgcn_sched_barrier(0)
#define FP2_MMA(acc, kf, d0) acc = __builtin_amdgcn_mfma_f32_32x32x16_bf16(kf[d0], q[d0], acc, 0, 0, 0)
#define FP2_EXP(cx, r) { if (ABL != 1) { cx[r] = __builtin_amdgcn_exp2f(cx[r] - mn); ls += cx[r]; } }
    FP2_SB(); FP2_MMA(n0, ka, 0);
    float mxa = max3f(c0[0], c0[1], c1[0]), mxb = max3f(c0[2], c0[3], c1[1]);
    mxa = max3f(mxa, c1[2], c1[3]);
    mxa = max3f(mxa, c0[4], c0[5]); mxb = max3f(mxb, c0[6], c0[7]); mxa = max3f(mxa, c1[4], c1[5]); mxb = max3f(mxb, c1[6], c1[7]);
    FP2_SB(); FP2_MMA(n1, kb2, 0);
    mxa = max3f(mxa, c0[8], c0[9]); mxb = max3f(mxb, c0[10], c0[11]); mxa = max3f(mxa, c1[8], c1[9]); mxb = max3f(mxb, c1[10], c1[11]);
    mxa = max3f(mxa, c0[12], c0[13]); mxb = max3f(mxb, c0[14], c0[15]); mxa = max3f(mxa, c1[12], c1[13]); mxb = max3f(mxb, c1[14], c1[15]);
    float mx = max3f(mxa, mxb, m);
    mx = max3f(mx, __shfl_xor(mx, 32), mx);
    const float mn = mx, alpha = __builtin_amdgcn_exp2f(m - mn);
    const bool resc = __any(mn > m);
    m = mn;
    float ls = 0.f;
    FP2_SB(); FP2_MMA(n0, ka, 1);
    FP2_EXP(c0, 0) FP2_EXP(c0, 1) FP2_EXP(c0, 2) FP2_EXP(c0, 3) FP2_EXP(c0, 4) FP2_EXP(c0, 5)
    FP2_SB(); FP2_MMA(n1, kb2, 1);
    FP2_EXP(c0, 6) FP2_EXP(c0, 7) FP2_EXP(c0, 8) FP2_EXP(c0, 9) FP2_EXP(c0, 10) FP2_EXP(c0, 11)
    FP2_SB(); FP2_MMA(n0, ka, 2);
    FP2_EXP(c0, 12) FP2_EXP(c0, 13) FP2_EXP(c0, 14) FP2_EXP(c0, 15) FP2_EXP(c1, 0) FP2_EXP(c1, 1)
    FP2_SB(); FP2_MMA(n1, kb2, 2);
    FP2_EXP(c1, 2) FP2_EXP(c1, 3) FP2_EXP(c1, 4) FP2_EXP(c1, 5) FP2_EXP(c1, 6) FP2_EXP(c1, 7)
    FP2_SB(); FP2_MMA(n0, ka, 3);
    FP2_EXP(c1, 8) FP2_EXP(c1, 9) FP2_EXP(c1, 10) FP2_EXP(c1, 11) FP2_EXP(c1, 12) FP2_EXP(c1, 13)
    FP2_SB(); FP2_MMA(n1, kb2, 3);
    FP2_EXP(c1, 14) FP2_EXP(c1, 15)
    bf16x8 pa[4];
    { u32x4 t;
      t[0] = cvtpk(c0[0], c0[1]); t[1] = cvtpk(c0[2], c0[3]); t[2] = cvtpk(c0[4], c0[5]); t[3] = cvtpk(c0[6], c0[7]); pa[0] = __builtin_bit_cast(bf16x8, t);
      t[0] = cvtpk(c0[8], c0[9]); t[1] = cvtpk(c0[10], c0[11]); t[2] = cvtpk(c0[12], c0[13]); t[3] = cvtpk(c0[14], c0[15]); pa[1] = __builtin_bit_cast(bf16x8, t);
      t[0] = cvtpk(c1[0], c1[1]); t[1] = cvtpk(c1[2], c1[3]); t[2] = cvtpk(c1[4], c1[5]); t[3] = cvtpk(c1[6], c1[7]); pa[2] = __builtin_bit_cast(bf16x8, t);
      t[0] = cvtpk(c1[8], c1[9]); t[1] = cvtpk(c1[10], c1[11]); t[2] = cvtpk(c1[12], c1[13]); t[3] = cvtpk(c1[14], c1[15]); pa[3] = __builtin_bit_cast(bf16x8, t); }
    asm volatile("" : "+v"(pa[0]), "+v"(pa[1]), "+v"(pa[2]), "+v"(pa[3]));
    FP2_SB();
    l = l * alpha + ls;
    __builtin_amdgcn_sched_barrier(0);
    if (resc) {
#pragma unroll
      for (int b = 0; b < DVB; ++b)
#pragma unroll
        for (int r = 0; r < 16; ++r) o[b][r] *= alpha;
    }
    const ldsp_t vb = lds + st_cur * G::STAGE + vroff;
    s16x4 vl[2][DVB], vh[2][DVB];
#pragma unroll
    for (int b = 0; b < DVB; ++b) { vl[0][b] = vtr(vb + b * 64); vh[0][b] = vtr(vb + 8 * G::VSTR + b * 64); }
#pragma unroll
    for (int ks = 0; ks < 4; ++ks) {
      FP2_SB();
      if (ks < 3) {
#pragma unroll
        for (int b = 0; b < DVB; ++b) { vl[(ks + 1) & 1][b] = vtr(vb + (16 * (ks + 1)) * G::VSTR + b * 64); vh[(ks + 1) & 1][b] = vtr(vb + (16 * (ks + 1) + 8) * G::VSTR + b * 64); }
      }
      FP2_SB();
#pragma unroll
      for (int b = 0; b < DVB; ++b) {
        const s16x4 lo = vl[ks & 1][b], h8 = vh[ks & 1][b];
        const bf16x8 vf = {lo[0], lo[1], lo[2], lo[3], h8[0], h8[1], h8[2], h8[3]};
        if (ABL != 2) o[b] = __builtin_amdgcn_mfma_f32_32x32x16_bf16(vf, pa[ks], o[b], 0, 0, 0); else o[b][0] += __builtin_bit_cast(float, (int)vf[0]);
      }
    }
    FP2_SB();
    if (ABL != 3) { if (kt + 2 < ntiles) FP2_STORE(st_fill, set); }
    __syncthreads();
    if (ABL != 3) { if (kt + 2 + PF < ntiles) FP2_LOAD(kt + 2 + PF, set); }
    c0 = n0; c1 = n1;
    { const int t = st_cur; st_cur = st_nxt; st_nxt = st_fill; st_fill = t; }
  };
  if (PF == 2) { for (int kt = 0; kt < ntiles; kt += 2) { body(kt, IC<0>{}); if (kt + 1 < ntiles) body(kt + 1, IC<1>{}); } }
  else { for (int kt = 0; kt < ntiles; ++kt) body(kt, IC<0>{}); }
#undef FP2_LOAD
#undef FP2_STORE
}


typedef int v8i_t __attribute__((ext_vector_type(8)));
DEVI v8i_t cat8(const u32x4& x, const u32x4& y) { return (v8i_t){(int)x[0], (int)x[1], (int)x[2], (int)x[3], (int)y[0], (int)y[1], (int)y[2], (int)y[3]}; }
template <int DVB, int KROW, bool PIPE, class Src, class VKey, class Msk>
DEVI void flash_pass8(ldsp_t lds, int ntiles, const unsigned char* k8, int ldb, int kcolb, const unsigned char* vt, const v8i_t& qf, int ksub,
                      Src src, VKey vkey, Msk msk, f32x16 (&o)[DVB], float& m, float& l) {
  constexpr int A8_KSTR = KROW + 16, A8_VSTR = 80, A8_KB = 64 * A8_KSTR, A8_STAGE = A8_KB + DVB * 32 * A8_VSTR;
  constexpr int KPR = KROW / 16, NKC = 64 * KPR, NCHT = (NKC + DVB * 32 * 4) / NT;
  const int tid = ftid(), lane = tid & 63, r32 = lane & 31, hi = lane >> 5;
  u32x4 stg[NCHT];
#define A8_LOAD(kt) do { _Pragma("unroll") for (int i_ = 0; i_ < NCHT; ++i_) { const int c_ = tid + NT * i_; \
      if (c_ < NKC) stg[i_] = *(const u32x4*)(k8 + (size_t)src((kt), c_ / KPR) * ldb + kcolb + (c_ % KPR) * 16); \
      else { const int cv_ = c_ - NKC; stg[i_] = *(const u32x4*)(vt + (size_t)(cv_ >> 2) * 4352 + vkey(kt) + (cv_ & 3) * 16); } } } while (0)
#define A8_STORE(st) do { _Pragma("unroll") for (int i_ = 0; i_ < NCHT; ++i_) { const int c_ = tid + NT * i_; \
      if (c_ < NKC) *(FA_LAS u32x4*)(lds + (st) * A8_STAGE + (c_ / KPR) * A8_KSTR + (c_ % KPR) * 16) = stg[i_]; \
      else { const int cv_ = c_ - NKC; *(FA_LAS u32x4*)(lds + (st) * A8_STAGE + A8_KB + (cv_ >> 2) * A8_VSTR + (cv_ & 3) * 16) = stg[i_]; } } } while (0)
#define A8_QK(dst, st, half) do { const ldsp_t kp_ = lds + (st) * A8_STAGE + kroff + (half) * 32 * A8_KSTR; f32x16 z_; _Pragma("unroll") for (int r_ = 0; r_ < 16; ++r_) z_[r_] = 0.f; \
    const u32x4 k0_ = *(const FA_LAS u32x4*)kp_, k1_ = *(const FA_LAS u32x4*)(kp_ + 16); \
    dst = __builtin_amdgcn_mfma_scale_f32_32x32x64_f8f6f4(cat8(k0_, k1_), qf, z_, 0, 0, 0, 0x7d7d7d7d  , 0, 0x7b7b7b7b  ); } while (0)
  A8_LOAD(0); A8_STORE(0);
  if (ntiles > 1) { A8_LOAD(1); A8_STORE(1); }
  __syncthreads();
  if (ntiles > 2) A8_LOAD(2);
  const int kroff = r32 * A8_KSTR + 64 * ksub + 32 * hi;
  const int vroff = A8_KB + r32 * A8_VSTR + 32 * hi;
  f32x16 c0, c1;
  if (PIPE) { A8_QK(c0, 0, 0); A8_QK(c1, 0, 1);
    asm volatile("s_nop 15\n\ts_nop 7" : "+v"(c0), "+v"(c1)); }
  int st_cur = 0, st_nxt = 1, st_fill = 2;
  for (int kt = 0; kt < ntiles; ++kt) {
    if (!PIPE) { A8_QK(c0, st_cur, 0); A8_QK(c1, st_cur, 1); asm volatile("s_nop 15\n\ts_nop 7" : "+v"(c0), "+v"(c1)); }
    msk(kt, c0, c1);
    __builtin_amdgcn_sched_barrier(0);
    f32x16 n0, n1;
#define A8_SB() __builtin_amdgcn_sched_barrier(0)
#define A8_EXP(cx, r) { cx[r] = __builtin_amdgcn_exp2f(cx[r] - mn); ls += cx[r]; }
    A8_SB(); if (PIPE) A8_QK(n0, st_nxt, 0);
    float mxa = max3f(c0[0], c0[1], c1[0]), mxb = max3f(c0[2], c0[3], c1[1]);
    mxa = max3f(mxa, c1[2], c1[3]);
    mxa = max3f(mxa, c0[4], c0[5]); mxb = max3f(mxb, c0[6], c0[7]); mxa = max3f(mxa, c1[4], c1[5]); mxb = max3f(mxb, c1[6], c1[7]);
    A8_SB(); if (PIPE) A8_QK(n1, st_nxt, 1);
    mxa = max3f(mxa, c0[8], c0[9]); mxb = max3f(mxb, c0[10], c0[11]); mxa = max3f(mxa, c1[8], c1[9]); mxb = max3f(mxb, c1[10], c1[11]);
    mxa = max3f(mxa, c0[12], c0[13]); mxb = max3f(mxb, c0[14], c0[15]); mxa = max3f(mxa, c1[12], c1[13]); mxb = max3f(mxb, c1[14], c1[15]);
    float mx = max3f(mxa, mxb, mxb);
    mx = max3f(mx, __shfl_xor(mx, 32), mx);
    const bool up = mx > m + 4.f;
    const float mn = up ? mx : m, alpha = __builtin_amdgcn_exp2f(m - mn);
    const bool resc = __any(up);
    m = mn;
    float ls = 0.f;
    A8_SB();
#pragma unroll
    for (int r = 0; r < 16; ++r) A8_EXP(c0, r)
#pragma unroll
    for (int r = 0; r < 16; ++r) A8_EXP(c1, r)
    unsigned X[4], Y[4];
#pragma unroll
    for (int i = 0; i < 4; ++i) {
      int w = 0; w = __builtin_amdgcn_cvt_pk_fp8_f32(c0[4 * i] * 16.f, c0[4 * i + 1] * 16.f, w, false); w = __builtin_amdgcn_cvt_pk_fp8_f32(c0[4 * i + 2] * 16.f, c0[4 * i + 3] * 16.f, w, true); X[i] = (unsigned)w;
      int z = 0; z = __builtin_amdgcn_cvt_pk_fp8_f32(c1[4 * i] * 16.f, c1[4 * i + 1] * 16.f, z, false); z = __builtin_amdgcn_cvt_pk_fp8_f32(c1[4 * i + 2] * 16.f, c1[4 * i + 3] * 16.f, z, true); Y[i] = (unsigned)z; }
#pragma unroll
    for (int i = 0; i < 4; ++i) { const auto rr = __builtin_amdgcn_permlane32_swap(X[i], Y[i], false, false); X[i] = rr[0]; Y[i] = rr[1]; }
    v8i_t pb = {(int)X[0], (int)X[1], (int)X[2], (int)X[3], (int)Y[0], (int)Y[1], (int)Y[2], (int)Y[3]};
    asm volatile("" : "+v"(pb));
    A8_SB();
    l = l * alpha + ls;
    __builtin_amdgcn_sched_barrier(0);
    if (resc) {
#pragma unroll
      for (int b = 0; b < DVB; ++b)
#pragma unroll
        for (int r = 0; r < 16; ++r) o[b][r] *= alpha;
    }
    { const ldsp_t vb = lds + st_cur * A8_STAGE + vroff;
      u32x4 v0[DVB], v1[DVB];
#pragma unroll
      for (int b = 0; b < DVB; ++b) { v0[b] = *(const FA_LAS u32x4*)(vb + b * 32 * A8_VSTR); v1[b] = *(const FA_LAS u32x4*)(vb + b * 32 * A8_VSTR + 16); }
#pragma unroll
      for (int b = 0; b < DVB; ++b) o[b] = __builtin_amdgcn_mfma_scale_f32_32x32x64_f8f6f4(cat8(v0[b], v1[b]), pb, o[b], 0, 0, 0, 0x7d7d7d7d  , 0, 0x7b7b7b7b  );
    }
    A8_SB();
    if (kt + 2 < ntiles) A8_STORE(st_fill);
    __syncthreads();
    if (kt + 3 < ntiles) A8_LOAD(kt + 3);
    if (PIPE) { c0 = n0; c1 = n1; }
    { const int t = st_cur; st_cur = st_nxt; st_nxt = st_fill; st_fill = t; }
  }
#undef A8_LOAD
#undef A8_STORE
#undef A8_QK
#undef A8_SB
#undef A8_EXP
}

#ifndef OUT_FP8
#define OUT_FP8 1
#endif
DEVI void st_att4(bf16_t* ATT, size_t row, int col, float a, float b, float c, float d) {
  if (OUT_FP8) *(unsigned*)((unsigned char*)ATT + row * DM + col) = nv::pack4_fp8(a * 4.f, b * 4.f, c * 4.f, d * 4.f);
  else { uint2 w; w.x = cvtpk(a, b); w.y = cvtpk(c, d); *(uint2*)(ATT + row * DM + col) = w; }
}
DEVI int vblock() { const int G = gridDim.x, bx = blockIdx.x; return (G % 8 == 0) ? (bx % 8) * (G / 8) + bx / 8 : bx; }

template <int ABL = 0> DEVI void phase_attnA(const Params& p, ldsp_t lds) {
  typedef Geo<128, 4> G;
  const int tid = ftid(), lane = tid & 63, wave = __builtin_amdgcn_readfirstlane(tid >> 6), r32 = lane & 31, hi = lane >> 5;
  const bf16_t* Q = (const bf16_t*)(p.ws + WS_QKV0); bf16_t* ATT = (bf16_t*)(p.ws + (ABL ? WS_MIX0 : WS_ATT0));
  const float lam = ((const float*)(p.ws + WS_CTL + CTL_LAM))[0];
  const int s = wave >> 2, qb = wave & 3;
  constexpr int NU_LAT = NB * 4 * 32, NU_CTX = NB * 4 * 2;
  for (int u = vblock(); u < NU_LAT + NU_CTX; u += gridDim.x) {
    int b, h, row0, ntiles; bool lat = u < NU_LAT;
    if (lat) { b = u >> 7; h = (u >> 5) & 3; row0 = b * SEQ + (u & 31) * 128; ntiles = 68; }
    else { const int v = u - NU_LAT; b = v >> 3; h = (v >> 1) & 3; row0 = NLAT + b * CTXL + (v & 1) * 128; ntiles = 4; }
    const int qrow = row0 + qb * 32 + r32;
    bf16x8 q[4];
#pragma unroll
    for (int d0 = 0; d0 < 4; ++d0) q[d0] = load_q8(Q + (size_t)qrow * N_IN0 + h * 128 + s * 64 + 16 * d0 + 8 * hi, C2);
    f32x16 o[4];
#pragma unroll
    for (int bk = 0; bk < 4; ++bk)
#pragma unroll
      for (int r = 0; r < 16; ++r) o[bk][r] = 0.f;
    float m = -1e30f, l = 0.f;
    const int cbase = NLAT + b * CTXL, lbase = b * SEQ;
#if ATTNA_FP8
    const unsigned char* QK8 = (const unsigned char*)(p.ws + WS_QKV0);
    v8i_t qf;
    { const unsigned char* qp = QK8 + (size_t)qrow * (N_IN0 * 2) + h * 128 + s * 64 + 32 * hi; const u32x4 q0_ = *(const u32x4*)qp, q1_ = *(const u32x4*)(qp + 16); qf = cat8(q0_, q1_); }
    flash_pass8<4, 128, true>(lds, ntiles, QK8, N_IN0 * 2, 512 + h * 128, (const unsigned char*)(p.ws + WS_VT) + (size_t)((b * 4 + h) * 128) * 4352, qf, s,
      [&](int kt, int i) { return lat ? (kt < 64 ? lbase + kt * 64 + i : cbase + (kt - 64) * 64 + i) : cbase + kt * 64 + i; },
      [&](int kt) { return (lat ? 0 : 4096) + kt * 64; }, [&](int, f32x16&, f32x16&) {}, o, m, l);
#else
    flash_pass2<128, 4, ABL, 1>(lds, ntiles, Q, N_IN0, 512 + h * 128, 1024 + h * 128, q, s * 64,
      [&](int kt, int i) { return lat ? (kt < 64 ? lbase + kt * 64 + i : cbase + (kt - 64) * 64 + i) : cbase + kt * 64 + i; },
      [&](int, f32x16&, f32x16&) {}, o, m, l);
#endif
    l += __shfl_xor(l, 32);
    const float inv = 1.f / l;
    FA_LAS float* X = (FA_LAS float*)lds;
    if (s == 1) {
#pragma unroll
      for (int bk = 0; bk < 4; ++bk)
#pragma unroll
        for (int r = 0; r < 16; ++r) X[((qb * 4 + bk) * 16 + r) * 64 + lane] = o[bk][r] * inv;
    }
    __syncthreads();
    if (s == 0) {
      float ss = 0.f;
#pragma unroll
      for (int bk = 0; bk < 4; ++bk)
#pragma unroll
        for (int r = 0; r < 16; ++r) { const float d = o[bk][r] * inv - lam * X[((qb * 4 + bk) * 16 + r) * 64 + lane]; o[bk][r] = d; ss += d * d; }
      ss += __shfl_xor(ss, 32);
      const float rr = rsqrtf(ss * (1.f / 128.f) + EPS) * 0.8f;
      const float* g = p.in[L0_SUBLN];
#pragma unroll
      for (int bk = 0; bk < 4; ++bk)
#pragma unroll
        for (int rg = 0; rg < 4; ++rg) { const int dv = bk * 32 + 8 * rg + 4 * hi; const float4 gv = *(const float4*)(g + dv);
          st_att4(ATT, (size_t)qrow, h * 128 + dv, o[bk][4 * rg] * rr * gv.x, o[bk][4 * rg + 1] * rr * gv.y, o[bk][4 * rg + 2] * rr * gv.z, o[bk][4 * rg + 3] * rr * gv.w); }
    }
    __syncthreads();
  }
}

template <int ABL = 0> DEVI void phase_attnB(const Params& p, ldsp_t lds) {
  typedef Geo<64, 2> G;
  const int tid = ftid(), lane = tid & 63, wave = __builtin_amdgcn_readfirstlane(tid >> 6), r32 = lane & 31, hi = lane >> 5;
  const bf16_t* Q = (const bf16_t*)(p.ws + WS_QKV0); bf16_t* ATT = (bf16_t*)(p.ws + (ABL ? WS_MIX0 : WS_ATT0));
  constexpr int NU_LAT = NB * 8 * 16, NU_CTX = NB * 8;
  FA_LAS float* RPB = (FA_LAS float*)(lds + 3 * (64 * 80 + 64 * 80));
  for (int u = vblock(); u < NU_LAT + NU_CTX; u += gridDim.x) {
    const bool lat = u < NU_LAT;
    int b, h, qrow_g = 0, c0 = 0, rlo = 0, nlat = 0, rs_w = 0, grow;
    if (lat) { b = u >> 7; h = (u >> 4) & 7; const int qr0 = (u & 15) * 4; qrow_g = qr0 + (wave >> 1); c0 = 32 * (wave & 1);
      rlo = min(max(qr0 - 4, 0), 56); const int rhi = min(max(qr0 - 1, 0), 56) + 7; nlat = rhi - rlo + 1; rs_w = min(max(qrow_g - 4, 0), 56);
      grow = b * SEQ + qrow_g * 64 + c0 + r32; }
    else { const int v = u - NU_LAT; b = v >> 3; h = v & 7; grow = NLAT + b * CTXL + wave * 32 + r32; }
    const int ntiles = nlat + 4;
    for (int i = tid; i < 15 * 31; i += NT) RPB[i] = p.in[L0_RPB][h * 465 + i] * LOG2E;
    const unsigned char* QK8 = (const unsigned char*)(p.ws + WS_QKV0);
    v8i_t qf;
    { const unsigned char* qp = QK8 + (size_t)grow * (N_IN0 * 2) + 1536 + h * 64 + 32 * hi; const u32x4 q0_ = *(const u32x4*)qp, q1_ = *(const u32x4*)(qp + 16); qf = cat8(q0_, q1_); }
    f32x16 o[2];
#pragma unroll
    for (int bk = 0; bk < 2; ++bk)
#pragma unroll
      for (int r = 0; r < 16; ++r) o[bk][r] = 0.f;
    float m = -1e30f, l = 0.f;
    const int cbase = NLAT + b * CTXL, lbase = b * SEQ;
    const int qc = c0 + r32, cs = min(max(qc - 8, 0), 48);
    flash_pass8<2, 64, false>(lds, ntiles, QK8, N_IN0 * 2, 2048 + h * 64, (const unsigned char*)(p.ws + WS_VTB) + (size_t)((b * 8 + h) * 64) * 4352, qf, 0,
      [&](int kt, int i) { return kt < nlat ? lbase + (rlo + kt) * 64 + i : cbase + (kt - nlat) * 64 + i; },
      [&](int kt) { return kt < nlat ? (rlo + kt) * 64 : 4096 + (kt - nlat) * 64; },
      [&](int kt, f32x16& p0, f32x16& p1) {
        if (ABL != 1 && kt < nlat) { const int kr = rlo + kt; const bool rowok = (kr >= rs_w && kr < rs_w + 8);
          const FA_LAS float* bp = RPB + min(max(kr - qrow_g + 7, 0), 14) * 31;
          { float b0[16];
#pragma unroll
            for (int r = 0; r < 16; ++r) { const int k0 = crow(r, hi); b0[r] = bp[min(max(k0 - qc + 15, 0), 30)]; }
#pragma unroll
            for (int r = 0; r < 16; ++r) { const int k0 = crow(r, hi); const float v0 = p0[r] + b0[r]; p0[r] = (rowok && k0 >= cs && k0 < cs + 16) ? v0 : -INFINITY; } }
          asm volatile("" ::: "memory");
          { float b1[16];
#pragma unroll
            for (int r = 0; r < 16; ++r) { const int k1 = 32 + crow(r, hi); b1[r] = bp[min(max(k1 - qc + 15, 0), 30)]; }
#pragma unroll
            for (int r = 0; r < 16; ++r) { const int k1 = 32 + crow(r, hi); const float v1 = p1[r] + b1[r]; p1[r] = (rowok && k1 >= cs && k1 < cs + 16) ? v1 : -INFINITY; } } } },
      o, m, l);
    l += __shfl_xor(l, 32);
    const float inv = 1.f / l;
#pragma unroll
    for (int bk = 0; bk < 2; ++bk)
#pragma unroll
      for (int rg = 0; rg < 4; ++rg) { const int dv = bk * 32 + 8 * rg + 4 * hi;
        st_att4(ATT, (size_t)grow, 512 + h * 64 + dv, o[bk][4 * rg] * inv, o[bk][4 * rg + 1] * inv, o[bk][4 * rg + 2] * inv, o[bk][4 * rg + 3] * inv); }
    __syncthreads();
  }
}

DEVI void phase_attnC(const Params& p, ldsp_t lds, int* ctr) {
  const int tid = ftid(), lane = tid & 63, wave = __builtin_amdgcn_readfirstlane(tid >> 6), r32 = lane & 31, hi = lane >> 5;
  const bf16_t* P1 = (const bf16_t*)(p.ws + WS_P1); bf16_t* ATT = (bf16_t*)(p.ws + WS_ATT1);
  FA_LAS int* uq = (FA_LAS int*)(lds + 3 * Geo<64, 2>::STAGE + 64);
  for (;;) {
    if (tid == 0) *uq = atomicAdd(ctr, 1);
    __syncthreads();
    const int u = *uq;
    __syncthreads();
    if (u >= NB * 2 * 64) break;
    const int b = u >> 7, g = (u >> 6) & 1, tq = u & 63, hq = g * 4 + (wave >> 1), t = tq * 64 + 32 * (wave & 1) + r32, grow = b * SEQ + t;
    const int klo = max(tq - 2, 0), khi = min(tq + 2, 63), nwin = khi - klo + 1, ntiles = nwin + 4;
    bf16x8 q[4];
#pragma unroll
    for (int d0 = 0; d0 < 4; ++d0) q[d0] = load_q8(P1 + (size_t)grow * 2304 + hq * 64 + 16 * d0 + 8 * hi, C2);
    f32x16 o[2];
#pragma unroll
    for (int bk = 0; bk < 2; ++bk)
#pragma unroll
      for (int r = 0; r < 16; ++r) o[bk][r] = 0.f;
    float m = -1e30f, l = 0.f;
    const int cbase = NLAT + b * CTXL, lbase = b * SEQ;
    flash_pass2<64, 2, 0, 2>(lds, ntiles, P1, 2304, 512 + g * 64, 640 + g * 64, q, 0,
      [&](int kt, int i) { return kt < nwin ? lbase + (klo + kt) * 64 + i : cbase + (kt - nwin) * 64 + i; },
      [&](int kt, f32x16& p0, f32x16& p1) {
        if (kt < nwin) { const int kp = (klo + kt) * 64 - t;
#pragma unroll
          for (int r = 0; r < 16; ++r) { const int d0 = kp + crow(r, hi), d1 = d0 + 32;
            if (d0 < -128 || d0 > 128) p0[r] = -INFINITY; if (d1 < -128 || d1 > 128) p1[r] = -INFINITY; } } },
      o, m, l);
    l += __shfl_xor(l, 32);
    { const float sk = p.in[L1_SINKS][hq] * LOG2E, mn = fmaxf(m, sk), alpha = __builtin_amdgcn_exp2f(m - mn);
      l = l * alpha + __builtin_amdgcn_exp2f(sk - mn);
#pragma unroll
      for (int bk = 0; bk < 2; ++bk)
#pragma unroll
        for (int r = 0; r < 16; ++r) o[bk][r] *= alpha; }
    const float inv = 1.f / l;
#pragma unroll
    for (int bk = 0; bk < 2; ++bk)
#pragma unroll
      for (int rg = 0; rg < 4; ++rg) { const int dv = bk * 32 + 8 * rg + 4 * hi;
        st_att4(ATT, (size_t)grow, hq * 64 + dv, o[bk][4 * rg] * inv, o[bk][4 * rg + 1] * inv, o[bk][4 * rg + 2] * inv, o[bk][4 * rg + 3] * inv); }
    __syncthreads();
  }
}
}
namespace fs {
using fa::bf16x8; using fa::s16x4; using fa::f32x16; using fa::ldsp_t; using fa::u32x4; using fa::cvtpk; using fa::vtr; using fa::crow; using fa::LOG2E;
typedef unsigned u32x2 __attribute__((ext_vector_type(2)));

DEVI void phase_conv(const Params& p) {
  const bf16_t* P1 = (const bf16_t*)(p.ws + WS_P1); bf16_t* U = (bf16_t*)(p.ws + WS_U);
  const float* cw = p.in[L1_CONVW]; const float* cb = p.in[L1_CONVB];
  const int nitems = (NROW / 16) * 128;
  for (int it = blockIdx.x * NT + ftid(); it < nitems; it += gridDim.x * NT) {
    const int cg = it & 127, rc = it >> 7, r0 = rc * 16, ch = cg * 8;
    int s0, len; if (r0 < NLAT) { s0 = r0 & ~4095; len = SEQ; } else { s0 = NLAT + ((r0 - NLAT) & ~255); len = CTXL; }
    const int t0 = r0 - s0;
    float w[5][8], bias[8];
#pragma unroll
    for (int j = 0; j < 5; ++j) { const float4 a = *(const float4*)(cw + j * 1024 + ch), b = *(const float4*)(cw + j * 1024 + ch + 4);
      w[j][0] = a.x; w[j][1] = a.y; w[j][2] = a.z; w[j][3] = a.w; w[j][4] = b.x; w[j][5] = b.y; w[j][6] = b.z; w[j][7] = b.w; }
    { const float4 a = *(const float4*)(cb + ch), b = *(const float4*)(cb + ch + 4); bias[0] = a.x; bias[1] = a.y; bias[2] = a.z; bias[3] = a.w; bias[4] = b.x; bias[5] = b.y; bias[6] = b.z; bias[7] = b.w; }
    float win[5][8];
    auto ldrow = [&](int t, float (&d)[8]) {
      if (t < 0 || t >= len) {
#pragma unroll
        for (int k = 0; k < 8; ++k) d[k] = 0.f; return; }
      const u32x4 v = *(const u32x4*)(P1 + (size_t)(s0 + t) * 2304 + 768 + ch);
#pragma unroll
      for (int k = 0; k < 4; ++k) { d[2 * k] = __uint_as_float(v[k] << 16); d[2 * k + 1] = __uint_as_float(v[k] & 0xffff0000u); } };
    ldrow(t0 - 2, win[0]); ldrow(t0 - 1, win[1]); ldrow(t0, win[2]); ldrow(t0 + 1, win[3]);
#pragma unroll
    for (int i = 0; i < 16; ++i) {
      ldrow(t0 + i + 2, win[(i + 4) % 5]);
      float o[8];
#pragma unroll
      for (int k = 0; k < 8; ++k) { float a = bias[k];
#pragma unroll
        for (int j = 0; j < 5; ++j) a += w[j][k] * win[(i + j) % 5][k];
        o[k] = a * __builtin_amdgcn_rcpf(1.f + __expf(-a)); }
      u32x4 ov; ov[0] = cvtpk(o[0], o[1]); ov[1] = cvtpk(o[2], o[3]); ov[2] = cvtpk(o[4], o[5]); ov[3] = cvtpk(o[6], o[7]);
      *(u32x4*)(U + (size_t)(r0 + i) * 1024 + ch) = ov;
    }
  }
}

DEVI float softplus_f(float v) { if (v > 20.f) return v; const float x = __expf(v); return x < 1e-3f ? x * (1.f - 0.5f * x) : __logf(1.f + x); }
constexpr int BSTR = 272, XSTR = 192;
constexpr int L_BM = 0, L_XD = 128 * BSTR, L_XW = L_XD + 128 * XSTR, L_HT = L_XW + 128 * XSTR, L_CUM = L_HT + 128 * XSTR, L_DTV = L_CUM + 512, L_XCH = L_DTV + 512, L_TOT = L_XCH + 8 * 4096;

template <int ABL = 0> DEVI void phase_ssd(const Params& p, ldsp_t lds) {
  const int tid = ftid(), lane = tid & 63, wave = __builtin_amdgcn_readfirstlane(tid >> 6), r32 = lane & 31, hi = lane >> 5;
  const int pb = wave >> 2, lb = (wave < 4) ? (wave & 3) : 3 - (wave & 3);
  const bf16_t* U = (const bf16_t*)(p.ws + WS_U); const float* DT = (const float*)(p.ws + WS_DT);
  bf16_t* YFB = (bf16_t*)(p.ws + WS_YS);
  FA_LAS float* CUM = (FA_LAS float*)(lds + L_CUM); FA_LAS float* DTV = (FA_LAS float*)(lds + L_DTV);
  const int trow_off = 4 * hi + ((lane & 15) >> 2), tcol_off = 32 * ((lane >> 4) & 1) + 8 * (lane & 3);
  for (int it = blockIdx.x; it < NB * 2 * 8; it += gridDim.x) {
    const int b = it >> 4, dir = (it >> 3) & 1, hd = it & 7, g = hd >> 2;
    const float a2 = -expf(p.in[dir ? L1_ALOGB : L1_ALOGF][hd]) * LOG2E; const float dtb = p.in[dir ? L1_DTBB : L1_DTBF][hd];
    auto tokrow = [&](int c, int i) { const int seg = c >= 2, len = seg ? SEQ : CTXL, j = (seg ? c - 2 : c) * 128 + i; return (seg ? b * SEQ : NLAT + b * CTXL) + (dir ? len - 1 - j : j); };
    f32x16 hacc;
#pragma unroll
    for (int r = 0; r < 16; ++r) hacc[r] = 0.f;
    for (int i = tid; i < 128 * XSTR / 4; i += NT) ((FA_LAS unsigned*)(lds + L_HT))[i] = 0u;
    u32x4 sb_[4], sx_[2]; float sdt0 = 0.f, sdt1 = 0.f; bf16x8 cfn[8];
    auto prefetch = [&](int c) {
#pragma unroll
      for (int i = 0; i < 4; ++i) { const int ch = tid + NT * i; sb_[i] = *(const u32x4*)(U + (size_t)tokrow(c, ch >> 4) * 1024 + 512 + g * 128 + (ch & 15) * 8); }
#pragma unroll
      for (int i = 0; i < 2; ++i) { const int ch = tid + NT * i; sx_[i] = *(const u32x4*)(U + (size_t)tokrow(c, ch >> 3) * 1024 + hd * 64 + (ch & 7) * 8); }
      if (tid < 64) { sdt0 = DT[(size_t)tokrow(c, 2 * tid) * 16 + dir * 8 + hd]; sdt1 = DT[(size_t)tokrow(c, 2 * tid + 1) * 16 + dir * 8 + hd]; }
      const bf16_t* crowp = U + (size_t)tokrow(c, lb * 32 + r32) * 1024 + 768 + g * 128 + 8 * hi;
#pragma unroll
      for (int ks = 0; ks < 8; ++ks) cfn[ks] = *(const bf16x8*)(crowp + 16 * ks);
    };
    prefetch(0);
    __syncthreads();
    for (int c = 0; c < 34; ++c) {
      if (tid < 64) {
        const float r0 = sdt0 + dtb, r1 = sdt1 + dtb; const float d0 = softplus_f(r0), d1 = softplus_f(r1);
        const float a0 = d0 * a2, a1 = d1 * a2; float v = a0 + a1;
#pragma unroll
        for (int o = 1; o < 64; o <<= 1) { const float t = __shfl_up(v, o); if (lane >= o) v += t; }
        DTV[2 * tid] = d0; DTV[2 * tid + 1] = d1; CUM[2 * tid] = v - a1; CUM[2 * tid + 1] = v;
      }
      __syncthreads();
      const float cl = CUM[127];
#pragma unroll
      for (int i = 0; i < 4; ++i) { const int ch = tid + NT * i; *(FA_LAS u32x4*)(lds + L_BM + (ch >> 4) * BSTR + (ch & 15) * 16) = sb_[i]; }
#pragma unroll
      for (int i = 0; i < 2; ++i) { const int ch = tid + NT * i, s = ch >> 3; const float d = DTV[s], wv = d * __builtin_amdgcn_exp2f(cl - CUM[s]);
        u32x4 xd, xw;
#pragma unroll
        for (int k = 0; k < 4; ++k) { const float x0 = __uint_as_float(sx_[i][k] << 16), x1 = __uint_as_float(sx_[i][k] & 0xffff0000u); xd[k] = cvtpk(x0 * d, x1 * d); xw[k] = cvtpk(x0 * wv, x1 * wv); }
        *(FA_LAS u32x4*)(lds + L_XD + s * XSTR + (ch & 7) * 16) = xd; *(FA_LAS u32x4*)(lds + L_XW + s * XSTR + (ch & 7) * 16) = xw; }
      bf16x8 cf[8];
#pragma unroll
      for (int ks = 0; ks < 8; ++ks) cf[ks] = cfn[ks];
      __syncthreads();
      if (ABL != 3) { if (c + 1 < 34) prefetch(c + 1); }
      if (c >= 2 && ABL != 1) {
        f32x16 y;
#pragma unroll
        for (int r = 0; r < 16; ++r) y[r] = 0.f;
        { const ldsp_t hb = lds + L_HT + (8 * hi + ((lane & 15) >> 2)) * XSTR + pb * 64 + tcol_off;
          f32x16 y2;
#pragma unroll
          for (int r = 0; r < 16; ++r) y2[r] = 0.f;
#pragma unroll
          for (int ks = 0; ks < 8; ++ks) { const s16x4 lo = vtr(hb + (16 * ks) * XSTR), h8 = vtr(hb + (16 * ks + 4) * XSTR);
            const bf16x8 hf = {lo[0], lo[1], lo[2], lo[3], h8[0], h8[1], h8[2], h8[3]};
            if (ks & 1) y2 = __builtin_amdgcn_mfma_f32_32x32x16_bf16(hf, cf[ks], y2, 0, 0, 0); else y = __builtin_amdgcn_mfma_f32_32x32x16_bf16(hf, cf[ks], y, 0, 0, 0); }
          y += y2; }
        const float cuml = CUM[lb * 32 + r32];
        { const float e = __builtin_amdgcn_exp2f(cuml);
#pragma unroll
          for (int r = 0; r < 16; ++r) y[r] *= e; }
        f32x16 yo;
#pragma unroll
        for (int r = 0; r < 16; ++r) yo[r] = 0.f;
        for (int sb = pb; sb <= lb; sb += 2) {
          f32x16 gt, gt2;
#pragma unroll
          for (int r = 0; r < 16; ++r) { gt[r] = 0.f; gt2[r] = 0.f; }
          const ldsp_t bb = lds + L_BM + (sb * 32 + r32) * BSTR + 16 * hi;
#pragma unroll
          for (int ks = 0; ks < 8; ks += 2) { gt = __builtin_amdgcn_mfma_f32_32x32x16_bf16(*(const FA_LAS bf16x8*)(bb + 32 * ks), cf[ks], gt, 0, 0, 0);
            gt2 = __builtin_amdgcn_mfma_f32_32x32x16_bf16(*(const FA_LAS bf16x8*)(bb + 32 * ks + 32), cf[ks + 1], gt2, 0, 0, 0); }
          gt += gt2;
          const bool diag = (sb == lb);
#pragma unroll
          for (int r = 0; r < 16; ++r) { const int sl = crow(r, hi); const float v = gt[r] * __builtin_amdgcn_exp2f(cuml - CUM[sb * 32 + sl]); gt[r] = (diag && sl > r32) ? 0.f : v; }
          u32x4 t0, t1;
          t0[0] = cvtpk(gt[0], gt[1]); t0[1] = cvtpk(gt[2], gt[3]); t0[2] = cvtpk(gt[4], gt[5]); t0[3] = cvtpk(gt[6], gt[7]);
          t1[0] = cvtpk(gt[8], gt[9]); t1[1] = cvtpk(gt[10], gt[11]); t1[2] = cvtpk(gt[12], gt[13]); t1[3] = cvtpk(gt[14], gt[15]);
          const bf16x8 pm0 = __builtin_bit_cast(bf16x8, t0), pm1 = __builtin_bit_cast(bf16x8, t1);
          const ldsp_t xb = lds + L_XD + (sb * 32 + trow_off) * XSTR + pb * 64 + tcol_off;
          const ldsp_t xo = lds + L_XD + (sb * 32 + trow_off) * XSTR + (1 - pb) * 64 + tcol_off;
          const s16x4 a0 = vtr(xb), a1 = vtr(xb + 8 * XSTR), a2 = vtr(xb + 16 * XSTR), a3 = vtr(xb + 24 * XSTR);
          const s16x4 b0 = vtr(xo), b1 = vtr(xo + 8 * XSTR), b2 = vtr(xo + 16 * XSTR), b3 = vtr(xo + 24 * XSTR);
          { const bf16x8 xf = {a0[0], a0[1], a0[2], a0[3], a1[0], a1[1], a1[2], a1[3]}; y = __builtin_amdgcn_mfma_f32_32x32x16_bf16(xf, pm0, y, 0, 0, 0); }
          { const bf16x8 xf = {b0[0], b0[1], b0[2], b0[3], b1[0], b1[1], b1[2], b1[3]}; yo = __builtin_amdgcn_mfma_f32_32x32x16_bf16(xf, pm0, yo, 0, 0, 0); }
          { const bf16x8 xf = {a2[0], a2[1], a2[2], a2[3], a3[0], a3[1], a3[2], a3[3]}; y = __builtin_amdgcn_mfma_f32_32x32x16_bf16(xf, pm1, y, 0, 0, 0); }
          { const bf16x8 xf = {b2[0], b2[1], b2[2], b2[3], b3[0], b3[1], b3[2], b3[3]}; yo = __builtin_amdgcn_mfma_f32_32x32x16_bf16(xf, pm1, yo, 0, 0, 0); }
        }
        { FA_LAS float* X = (FA_LAS float*)(lds + L_XCH) + (pb * 4 + lb) * 1024;
#pragma unroll
          for (int r = 0; r < 16; ++r) X[r * 64 + lane] = yo[r]; }
        __syncthreads();
        { const FA_LAS float* X = (const FA_LAS float*)(lds + L_XCH) + ((1 - pb) * 4 + lb) * 1024;
#pragma unroll
          for (int r = 0; r < 16; ++r) y[r] += X[r * 64 + lane]; }
        const int j = (c - 2) * 128 + lb * 32 + r32, tok = dir ? SEQ - 1 - j : j;
        bf16_t* yp = YFB + ((size_t)dir * NLAT + (size_t)b * SEQ + tok) * 512 + hd * 64 + pb * 32 + 4 * hi;
#pragma unroll
        for (int rg = 0; rg < 4; ++rg) { u32x2 w; w[0] = cvtpk(y[4 * rg], y[4 * rg + 1]); w[1] = cvtpk(y[4 * rg + 2], y[4 * rg + 3]); *(u32x2*)(yp + 8 * rg) = w; }
      }
      if (ABL != 2) { const float e = __builtin_amdgcn_exp2f(cl);
        f32x16 h2;
#pragma unroll
        for (int r = 0; r < 16; ++r) { hacc[r] *= e; h2[r] = 0.f; }
        const ldsp_t xb = lds + L_XW + (8 * hi + ((lane & 15) >> 2)) * XSTR + pb * 64 + tcol_off;
        const ldsp_t bb = lds + L_BM + (8 * hi + ((lane & 15) >> 2)) * BSTR + lb * 64 + tcol_off;
#pragma unroll
        for (int ks = 0; ks < 8; ++ks) {
          const s16x4 xl = vtr(xb + (16 * ks) * XSTR), xh = vtr(xb + (16 * ks + 4) * XSTR), bl = vtr(bb + (16 * ks) * BSTR), bh = vtr(bb + (16 * ks + 4) * BSTR);
          const bf16x8 xf = {xl[0], xl[1], xl[2], xl[3], xh[0], xh[1], xh[2], xh[3]}, bf = {bl[0], bl[1], bl[2], bl[3], bh[0], bh[1], bh[2], bh[3]};
          if (ks & 1) h2 = __builtin_amdgcn_mfma_f32_32x32x16_bf16(xf, bf, h2, 0, 0, 0); else hacc = __builtin_amdgcn_mfma_f32_32x32x16_bf16(xf, bf, hacc, 0, 0, 0);
        }
        hacc += h2; }
      __syncthreads();
      { const ldsp_t hp = lds + L_HT + (lb * 32 + r32) * XSTR + (pb * 32 + 4 * hi) * 2;
#pragma unroll
        for (int rg = 0; rg < 4; ++rg) { u32x2 w; w[0] = cvtpk(hacc[4 * rg], hacc[4 * rg + 1]); w[1] = cvtpk(hacc[4 * rg + 2], hacc[4 * rg + 3]); *(FA_LAS u32x2*)(hp + 16 * rg) = w; } }
    }
    __syncthreads();
  }
}

DEVI void phase_ssd_out(const Params& p) {
  const int lane = ftid() & 63, gw = blockIdx.x * NWAVE + (ftid() >> 6), NGW = gridDim.x * NWAVE;
  const bf16_t* U = (const bf16_t*)(p.ws + WS_U); const bf16_t* P1 = (const bf16_t*)(p.ws + WS_P1); const bf16_t* YFB = (const bf16_t*)(p.ws + WS_YS);
  bf16_t* ATT = (bf16_t*)(p.ws + WS_ATT1);
  for (int r = gw; r < NLAT; r += NGW) {
    const int c0 = lane * 8, hd = c0 >> 6; const float dsk = p.in[L1_DSKIP][hd];
    const u32x4 yf = *(const u32x4*)(YFB + (size_t)r * 512 + c0), yb = *(const u32x4*)(YFB + ((size_t)NLAT + r) * 512 + c0);
    const u32x4 xw = *(const u32x4*)(U + (size_t)r * 1024 + c0), zw = *(const u32x4*)(P1 + (size_t)r * 2304 + 1792 + c0);
    float y[8]; float ss = 0.f;
#pragma unroll
    for (int i = 0; i < 4; ++i) {
      const float x0 = __uint_as_float(xw[i] << 16), x1 = __uint_as_float(xw[i] & 0xffff0000u), z0 = __uint_as_float(zw[i] << 16), z1 = __uint_as_float(zw[i] & 0xffff0000u);
      const float f0 = __uint_as_float(yf[i] << 16) + __uint_as_float(yb[i] << 16), f1 = __uint_as_float(yf[i] & 0xffff0000u) + __uint_as_float(yb[i] & 0xffff0000u);
      y[2 * i] = (f0 + dsk * x0) * silu_f(z0); y[2 * i + 1] = (f1 + dsk * x1) * silu_f(z1);
      ss += y[2 * i] * y[2 * i] + y[2 * i + 1] * y[2 * i + 1];
    }
#pragma unroll
    for (int o = 1; o < 32; o <<= 1) ss += __shfl_xor(ss, o);
    const float rr = rsqrtf(ss * (1.f / 256.f) + EPS);
    const float4 g0 = *(const float4*)(p.in[L1_GNORM] + c0), g1 = *(const float4*)(p.in[L1_GNORM] + c0 + 4);
    u32x4 w; w[0] = cvtpk(y[0] * rr * g0.x, y[1] * rr * g0.y); w[1] = cvtpk(y[2] * rr * g0.z, y[3] * rr * g0.w); w[2] = cvtpk(y[4] * rr * g1.x, y[5] * rr * g1.y); w[3] = cvtpk(y[6] * rr * g1.z, y[7] * rr * g1.w);
    *(u32x4*)(ATT + (size_t)r * DM + 512 + c0) = w;
  }
}
}
#ifndef TOPK_COPY
#define TOPK_COPY false
#endif
namespace ft {
using fa::ldsp_t; using fa::u32x4;

DEVI int block_excl_scan(int v, FA_LAS int* wsum, int tid, int* tot) {
  const int lane = tid & 63, wave = tid >> 6;
  int inc = v;
#pragma unroll
  for (int o = 1; o < 64; o <<= 1) { const int t = __shfl_up(inc, o); if (lane >= o) inc += t; }
  __syncthreads();
  if (lane == 63) wsum[wave] = inc;
  __syncthreads();
  int base = 0, total = 0;
#pragma unroll
  for (int w = 0; w < 8; ++w) { const int s = wsum[w]; if (w < wave) base += s; total += s; }
  *tot = total;
  return base + inc - v;
}

template <int EPT, bool GATHER_COPY>
DEVI void topk_item(const Params& p, ldsp_t lds, int e, int n, int cap, int row0, int slot0, int erows) {
  const int tid = ftid(), lane = tid & 63, wave = tid >> 6;
  const float* AFFT = (const float*)(p.ws + WS_AFF); int* SLOT = (int*)(p.ws + WS_SLOT); float* GV = (float*)(p.ws + WS_GATEV);
  const bf16_t* H = (const bf16_t*)(p.ws + WS_H); bf16_t* XG = (bf16_t*)(p.ws + WS_XG); int* IDX = (int*)(p.ws + WS_IDX);
  FA_LAS unsigned* hist = (FA_LAS unsigned*)lds;
  FA_LAS int* misc = (FA_LAS int*)(lds + 1024);
  FA_LAS int* wsum = (FA_LAS int*)(lds + 1024 + 64);
  FA_LAS int* list = (FA_LAS int*)(lds + 2048);
  const bool act = tid * EPT < n;
  unsigned key[EPT];
#pragma unroll
  for (int j = 0; j < EPT; ++j) key[j] = act ? __float_as_uint(AFFT[(size_t)e * NROW + row0 + tid * EPT + j]) : 0u;
  unsigned prefix = 0u, mask = 0u; int k = cap;
#pragma unroll 1
  for (int pass = 0; pass < 4; ++pass) {
    const int shift = 24 - 8 * pass;
    __syncthreads();
    if (tid < 256) hist[tid] = 0u;
    __syncthreads();
    if (act) {
#pragma unroll
      for (int j = 0; j < EPT; ++j) if ((key[j] & mask) == prefix) atomicAdd((unsigned*)&hist[(key[j] >> shift) & 255u], 1u);
    }
    __syncthreads();
    if (wave == 0) {
      const int h0 = hist[4 * lane], h1 = hist[4 * lane + 1], h2 = hist[4 * lane + 2], h3 = hist[4 * lane + 3];
      const int s = h0 + h1 + h2 + h3; int v = s;
#pragma unroll
      for (int o = 1; o < 64; o <<= 1) { const int t = __shfl_down(v, o); if (lane + o < 64) v += t; }
      int c = v - s;
      const int hh[4] = {h0, h1, h2, h3};
#pragma unroll
      for (int b = 3; b >= 0; --b) { if (c < k && k <= c + hh[b]) { misc[0] = 4 * lane + b; misc[1] = k - c; } c += hh[b]; }
    }
    __syncthreads();
    prefix |= ((unsigned)misc[0]) << shift; mask |= 255u << shift; k = misc[1];
  }
  int ce = 0;
#pragma unroll
  for (int j = 0; j < EPT; ++j) ce += (act && key[j] == prefix) ? 1 : 0;
  int tot; const int eq_before = block_excl_scan(ce, wsum, tid, &tot);
  int cs = 0, eqr = eq_before; bool sel[EPT];
#pragma unroll
  for (int j = 0; j < EPT; ++j) { bool s = false; if (act) { if (key[j] > prefix) s = true; else if (key[j] == prefix) { s = eqr < k; ++eqr; } } sel[j] = s; cs += s ? 1 : 0; }
  int slot = block_excl_scan(cs, wsum, tid, &tot);
  if (act) {
#pragma unroll
    for (int j = 0; j < EPT; ++j) { const int row = row0 + tid * EPT + j;
      if (sel[j]) { if (GATHER_COPY) list[slot] = row; else IDX[e * erows + slot0 + slot] = row; GV[e * erows + slot0 + slot] = __uint_as_float(key[j]); SLOT[(size_t)row * 16 + e] = slot0 + slot; ++slot; }
      else SLOT[(size_t)row * 16 + e] = -1; }
  }
  if (GATHER_COPY) {
    __syncthreads();
    for (int s = wave; s < cap; s += NWAVE) {
      const u32x4* src = (const u32x4*)(H + (size_t)list[s] * DM) + lane; u32x4* dst = (u32x4*)(XG + ((size_t)e * erows + slot0 + s) * DM) + lane;
      const u32x4 a = src[0], b2 = src[64]; dst[0] = a; dst[64] = b2;
    }
  }
  __syncthreads();
}

DEVI void phase_topk(const Params& p, ldsp_t lds, int layer) {
  const int erows = layer ? EROWS1 : EROWS0;
  const int nlat = NB * NE, nitems = nlat + (layer ? 0 : NB * NE);
  const int G = gridDim.x;
  for (int it = blockIdx.x; it < nitems; it += G) {
    if (it < nlat) { const int b = it / NE, e = it % NE; topk_item<8, TOPK_COPY>(p, lds, e, SEQ, CAP_L, b * SEQ, b * CAP_L, erows); }
    else { const int i2 = it - nlat, b = i2 / NE, e = i2 % NE; topk_item<1, TOPK_COPY>(p, lds, e, CTXL, CAP_C, NLAT + b * CTXL, NB * CAP_L + b * CAP_C, erows); }
  }
}
}
#ifndef MOE1_FP8
#define MOE1_FP8 1
#endif
#ifndef MOE0_FP8
#define MOE0_FP8 1
#endif
namespace fr {
using fa::ldsp_t; using fa::u32x4; using fa::cvtpk;
typedef unsigned u32x2 __attribute__((ext_vector_type(2)));
typedef float f32x4 __attribute__((ext_vector_type(4)));
struct V16 { f32x4 v[4]; };
DEVI V16 ldf(const float* r, int lane) { V16 o; const f32x4* q = (const f32x4*)r + lane;
#pragma unroll
  for (int j = 0; j < 4; ++j) o.v[j] = q[64 * j]; return o; }
struct B16 { u32x2 v[4]; };
DEVI B16 ldb_raw(const bf16_t* r, int lane) { B16 o; const u32x2* q = (const u32x2*)r + lane;
#pragma unroll
  for (int j = 0; j < 4; ++j) o.v[j] = q[64 * j]; return o; }
DEVI V16 b2v(const B16& b) { V16 o;
#pragma unroll
  for (int j = 0; j < 4; ++j) { o.v[j][0] = __uint_as_float(b.v[j][0] << 16); o.v[j][1] = __uint_as_float(b.v[j][0] & 0xffff0000u); o.v[j][2] = __uint_as_float(b.v[j][1] << 16); o.v[j][3] = __uint_as_float(b.v[j][1] & 0xffff0000u); }
  return o; }
DEVI void stf(float* r, int lane, const V16& o) { f32x4* q = (f32x4*)r + lane;
#pragma unroll
  for (int j = 0; j < 4; ++j) q[64 * j] = o.v[j]; }
DEVI void stb(bf16_t* r, int lane, const V16& o) { u32x2* q = (u32x2*)r + lane;
#pragma unroll
  for (int j = 0; j < 4; ++j) { u32x2 w; w[0] = cvtpk(o.v[j][0], o.v[j][1]); w[1] = cvtpk(o.v[j][2], o.v[j][3]); q[64 * j] = w; } }
DEVI float sumsq(const V16& o) { f32x4 s = o.v[0] * o.v[0];
#pragma unroll
  for (int j = 1; j < 4; ++j) s += o.v[j] * o.v[j];
  return wave_sum((s[0] + s[1]) + (s[2] + s[3])); }

DEVI void phase_prenorm0(const Params& p) {
  const int lane = ftid() & 63, gw = blockIdx.x * NWAVE + (ftid() >> 6), NGW = gridDim.x * NWAVE;
  const float* MOD = (const float*)(p.ws + WS_CTL + CTL_MOD); bf16_t* H = (bf16_t*)(p.ws + WS_H);
  const int rpw = (NROW + NGW - 1) / NGW;
  const int r0 = gw * rpw, r1 = min(r0 + rpw, NROW);
  if (r0 >= r1) return;
  const V16 g = ldf(p.in[L0_GPREMIX], lane);
  int cur = -1; V16 gs, sh;
  auto src = [&](int r) { return r < NLAT ? p.in[I_X] + (size_t)r * DM : p.in[I_CTX] + (size_t)(r - NLAT) * DM; };
  V16 xn = ldf(src(r0), lane), xn2 = xn;
  if (r0 + 1 < r1) xn2 = ldf(src(r0 + 1), lane);
  for (int r = r0; r < r1; ++r) {
    const V16 x = xn; xn = xn2; if (r + 2 < r1) xn2 = ldf(src(r + 2), lane);
    const int mr = row_modrow(r);
    if (mr != cur) { cur = mr; const float* m = MOD + (size_t)mr * 6144; const V16 sc = ldf(m + 1024, lane); sh = ldf(m, lane);
#pragma unroll
      for (int j = 0; j < 4; ++j) gs.v[j] = g.v[j] * (sc.v[j] + 1.f); }
    const float rr = rsqrtf(sumsq(x) * (1.f / DM) + EPS);
    V16 h;
#pragma unroll
    for (int j = 0; j < 4; ++j) h.v[j] = x.v[j] * rr * gs.v[j] + sh.v[j];
    if (QKV0_FP8) {
      unsigned* q8 = (unsigned*)((unsigned char*)H + (size_t)r * DM) + lane;
#pragma unroll
      for (int j = 0; j < 4; ++j) q8[64 * j] = nv::pack4_fp8(h.v[j][0] * nv::A8_SCALE, h.v[j][1] * nv::A8_SCALE, h.v[j][2] * nv::A8_SCALE, h.v[j][3] * nv::A8_SCALE);
    } else stb(H + (size_t)r * DM, lane, h);
  }
}

template <int ABL = 0> DEVI void phase_postmix(const Params& p, ldsp_t lds, int layer) {
  const int tid = ftid(), lane = tid & 63, gw = blockIdx.x * NWAVE + (tid >> 6), NGW = gridDim.x * NWAVE;
  const float* MOD = (const float*)(p.ws + WS_CTL + CTL_MOD) + (size_t)layer * 9 * 6144;
  const bf16_t* MIX = (const bf16_t*)(p.ws + (layer ? WS_MIX1 : WS_MIX0));
  bf16_t* H = (bf16_t*)(p.ws + WS_H); float* AFFT = (float*)(p.ws + WS_AFF); float* XC = (float*)(p.ws + WS_XC);
  const float* wr = p.in[layer ? L1_WROUTER : L0_WROUTER];
  FA_LAS f32x4* WL = (FA_LAS f32x4*)lds;
  for (int i = tid; i < 1024 * 4; i += NT) { const int k = i >> 2, e4 = i & 3; const int ln = (k & 255) >> 2, q = k & 3, j = k >> 8;
    WL[((j * 4 + q) * 4 + e4) * 64 + ln] = *(const f32x4*)(wr + (size_t)k * 16 + e4 * 4); }
  __syncthreads();
  const int nrow = layer ? NLAT : NROW;
  const int rpw = (nrow + NGW - 1) / NGW;
  const int r0 = gw * rpw, r1 = min(r0 + rpw, nrow);
  if (r0 >= r1) return;
  const V16 gpost = ldf(p.in[layer ? L1_GPOSTMIX : L0_GPOSTMIX], lane), gpre = ldf(p.in[layer ? L1_GPREFFN : L0_GPREFFN], lane);
  int cur = -1; V16 gg, gs, sh;
  auto xsrc = [&](int r) { return layer ? (const float*)(p.out + (size_t)r * DM) : (r < NLAT ? p.in[I_X] + (size_t)r * DM : p.in[I_CTX] + (size_t)(r - NLAT) * DM); };
  B16 mn = ldb_raw(MIX + (size_t)r0 * DM, lane); V16 xn = ldf(xsrc(r0), lane);
  B16 mn2 = mn; V16 xn2 = xn;
  if (r0 + 1 < r1) { mn2 = ldb_raw(MIX + (size_t)(r0 + 1) * DM, lane); xn2 = ldf(xsrc(r0 + 1), lane); }
  for (int r = r0; r < r1; ++r) {
    const B16 mb = mn; const V16 x = xn;
    mn = mn2; xn = xn2;
    if (r + 2 < r1) { mn2 = ldb_raw(MIX + (size_t)(r + 2) * DM, lane); xn2 = ldf(xsrc(r + 2), lane); }
    const int mr = row_modrow(r);
    if (mr != cur) { cur = mr; const float* m = MOD + (size_t)mr * 6144; const V16 gt = ldf(m + 2048, lane), sc = ldf(m + 4096, lane); sh = ldf(m + 3072, lane);
#pragma unroll
      for (int j = 0; j < 4; ++j) { gg.v[j] = gt.v[j] * gpost.v[j]; gs.v[j] = gpre.v[j] * (sc.v[j] + 1.f); } }
    V16 o = b2v(mb);
    const float rr = rsqrtf(sumsq(o) * (1.f / DM) + EPS);
#pragma unroll
    for (int j = 0; j < 4; ++j) o.v[j] = x.v[j] + gg.v[j] * (o.v[j] * rr);
    stf(r < NLAT ? p.out + (size_t)r * DM : XC + (size_t)(r - NLAT) * DM, lane, o);
    const float r2 = rsqrtf(sumsq(o) * (1.f / DM) + EPS);
    V16 h;
#pragma unroll
    for (int j = 0; j < 4; ++j) h.v[j] = o.v[j] * r2 * gs.v[j] + sh.v[j];
    if ((layer == 1 && MOE1_FP8) || (layer == 0 && MOE0_FP8)) {
      unsigned* q8 = (unsigned*)((unsigned char*)H + (size_t)r * DM) + lane;
#pragma unroll
      for (int j = 0; j < 4; ++j) q8[64 * j] = nv::pack4_fp8(h.v[j][0] * nv::A8_SCALE, h.v[j][1] * nv::A8_SCALE, h.v[j][2] * nv::A8_SCALE, h.v[j][3] * nv::A8_SCALE);
    } else stb(H + (size_t)r * DM, lane, h);
    if (ABL == 1) continue;
    f32x4 lg[4];
    int lo = lane; asm volatile("" : "+v"(lo));
#pragma unroll
    for (int e4 = 0; e4 < 4; ++e4) lg[e4] = (f32x4){0.f, 0.f, 0.f, 0.f};
#pragma unroll
    for (int j = 0; j < 4; ++j)
#pragma unroll
      for (int q = 0; q < 4; ++q) { const float hv = h.v[j][q];
#pragma unroll
        for (int e4 = 0; e4 < 4; ++e4) lg[e4] += WL[((j * 4 + q) * 4 + e4) * 64 + lo] * hv; }
    float l16[16]; float mx = -INFINITY;
#pragma unroll
    for (int e = 0; e < 16; ++e) { l16[e] = wave_sum(lg[e >> 2][e & 3]); mx = fmaxf(mx, l16[e]); }
    float s = 0.f;
#pragma unroll
    for (int e = 0; e < 16; ++e) { l16[e] = expf(l16[e] - mx); s += l16[e]; }
    const float inv = 1.f / s; float mine = 0.f;
#pragma unroll
    for (int e = 0; e < 16; ++e) if (lane == e) mine = l16[e] * inv;
    if (lane < 16) AFFT[(size_t)lane * NROW + r] = mine;
  }
}

DEVI void phase_combine(const Params& p, int layer) {
  const int tid = ftid(), lane = tid & 63, gw = blockIdx.x * NWAVE + (tid >> 6), NGW = gridDim.x * NWAVE;
  const float* MOD = (const float*)(p.ws + WS_CTL + CTL_MOD);
  const bf16_t* Y = (const bf16_t*)(p.ws + WS_Y); const int* SLOT = (const int*)(p.ws + WS_SLOT); const float* GV = (const float*)(p.ws + WS_GATEV);
  bf16_t* H = (bf16_t*)(p.ws + WS_H); float* XC = (float*)(p.ws + WS_XC);
  const int nrow = layer ? NLAT : NROW, erows = layer ? EROWS1 : EROWS0;
  const int rpw = (nrow + NGW - 1) / NGW;
  const int r0 = gw * rpw, r1 = min(r0 + rpw, nrow);
  if (r0 >= r1) return;
  const V16 gpost = ldf(p.in[layer ? L1_GPOSTFFN : L0_GPOSTFFN], lane);
  V16 g1; if (layer == 0) g1 = ldf(p.in[L1_GPREMIX], lane);
  int cur = -1; V16 gg, gs, sh;
  int sn = (lane < 16) ? SLOT[(size_t)r0 * 16 + lane] : -1;
  for (int r = r0; r < r1; ++r) {
    const int sl = sn; if (r + 1 < r1) sn = (lane < 16) ? SLOT[(size_t)(r + 1) * 16 + lane] : -1;
    float* xio = r < NLAT ? p.out + (size_t)r * DM : XC + (size_t)(r - NLAT) * DM;
    const V16 x = ldf(xio, lane);
    const int mr = row_modrow(r);
    if (mr != cur) { cur = mr; const float* m = MOD + (size_t)(layer * 9 + mr) * 6144; const V16 gt = ldf(m + 5120, lane);
#pragma unroll
      for (int j = 0; j < 4; ++j) gg.v[j] = gt.v[j] * gpost.v[j];
      if (layer == 0) { const float* m1 = MOD + (size_t)(9 + mr) * 6144; const V16 sc = ldf(m1 + 1024, lane); sh = ldf(m1, lane);
#pragma unroll
        for (int j = 0; j < 4; ++j) gs.v[j] = g1.v[j] * (sc.v[j] + 1.f); } }
    V16 o;
#pragma unroll
    for (int j = 0; j < 4; ++j) o.v[j] = (f32x4){0.f, 0.f, 0.f, 0.f};
    unsigned long long mask = __ballot(sl >= 0);
    while (mask) {
      const int e = __builtin_ctzll(mask); mask &= mask - 1;
      const int s = __shfl(sl, e);
      const float gate = GV[e * erows + s];
      const V16 y = b2v(ldb_raw(Y + ((size_t)e * erows + s) * DM, lane));
#pragma unroll
      for (int j = 0; j < 4; ++j) o.v[j] += y.v[j] * gate;
    }
    const float rr = rsqrtf(sumsq(o) * (1.f / DM) + EPS);
#pragma unroll
    for (int j = 0; j < 4; ++j) o.v[j] = x.v[j] + gg.v[j] * (o.v[j] * rr);
    stf(xio, lane, o);
    if (layer == 0) {
      const float r2 = rsqrtf(sumsq(o) * (1.f / DM) + EPS);
      V16 h;
#pragma unroll
      for (int j = 0; j < 4; ++j) h.v[j] = o.v[j] * r2 * gs.v[j] + sh.v[j];
      if (QKV1_FP8) {
        unsigned* q8 = (unsigned*)((unsigned char*)H + (size_t)r * DM) + lane;
#pragma unroll
        for (int j = 0; j < 4; ++j) q8[64 * j] = nv::pack4_fp8(h.v[j][0] * nv::A8_SCALE, h.v[j][1] * nv::A8_SCALE, h.v[j][2] * nv::A8_SCALE, h.v[j][3] * nv::A8_SCALE);
      } else stb(H + (size_t)r * DM, lane, h);
    }
  }
}
}
#define LAS __attribute__((address_space(3)))
#define XB_TMO      128
#define XB_XCNT(j)  (256  + 64 * (j))
#define XB_XSUB(j)  (1280 + 64 * (j))
#define XB_XGEN(j)  (2304 + 64 * (j))
#define XB_TOP      3328
#define XB_TOPGEN   3392
#define XCD_BAR_WORDS 3456
#define XB_SPIN_CAP (1u << 18)

__device__ __forceinline__ unsigned xb_ld(unsigned* p)              { return __hip_atomic_load(p, __ATOMIC_RELAXED, __HIP_MEMORY_SCOPE_AGENT); }
__device__ __forceinline__ unsigned xb_add(unsigned* p, unsigned v) { return __hip_atomic_fetch_add(p, v, __ATOMIC_RELAXED, __HIP_MEMORY_SCOPE_AGENT); }
__device__ __forceinline__ unsigned xb_xcc_id() { return (unsigned)__builtin_amdgcn_s_getreg((3 << 11) | 20) & 0xFu; }
#define XB_SPIN(cond, bar) do { unsigned _sp = 0; while (cond) { __builtin_amdgcn_s_sleep(1); \
    if ((++_sp & 255u) == 0u) { if (xb_ld(&(bar)[XB_TMO])) break; if (_sp > XB_SPIN_CAP) { atomicAdd(&(bar)[XB_TMO], 1u); break; } } } } while (0)

struct XcdBarrier {
    unsigned* bar; unsigned x;
    volatile LAS unsigned* st;
};

__device__ __forceinline__ XcdBarrier xcd_barrier_post(unsigned* bar, volatile LAS unsigned* st) {
    XcdBarrier b; b.bar = bar; b.x = xb_xcc_id(); b.st = st;
    if (threadIdx.x == 0) (void)xb_add(&bar[XB_XCNT(b.x)], 1u);
    return b;
}
__device__ __forceinline__ void xcd_barrier_complete(unsigned* bar, unsigned x, unsigned& nloc, unsigned& nx) {
    const unsigned G = gridDim.x * gridDim.y * gridDim.z;
    unsigned sum, cnt, mine, sp = 0u;
    for (;;) {
        sum = 0u; cnt = 0u; mine = 0u;
#pragma unroll
        for (unsigned j = 0; j < 16; ++j) { const unsigned c = xb_ld(&bar[XB_XCNT(j)]); sum += c; cnt += (c > 0u) ? 1u : 0u; mine = (j == x) ? c : mine; }
        if (sum == G) break;
        __builtin_amdgcn_s_sleep(1);
        if ((++sp & 255u) == 0u) { if (xb_ld(&bar[XB_TMO])) break; if (sp > XB_SPIN_CAP) { atomicAdd(&bar[XB_TMO], 1u); break; } }
    }
    nloc = mine > 0u ? mine : 1u; nx = cnt > 0u ? cnt : 1u;
}

__device__ __forceinline__ void xcd_barrier(const XcdBarrier& b) {
    asm volatile("s_waitcnt vmcnt(0)" ::: "memory");
    __syncthreads();
    if (threadIdx.x == 0) {
        unsigned* bar = b.bar;
        __builtin_amdgcn_s_waitcnt(0);
        unsigned nloc = b.st[0], nx = b.st[1];
        if (nloc == 0u) { xcd_barrier_complete(bar, b.x, nloc, nx); b.st[0] = nloc; b.st[1] = nx; }
        const unsigned old = xb_add(&bar[XB_XSUB(b.x)], 1u);
        const unsigned gen = old / nloc;
        if (old + 1u == (gen + 1u) * nloc) {
            __builtin_amdgcn_fence(__ATOMIC_RELEASE, "agent");
            asm volatile("s_waitcnt vmcnt(0)" ::: "memory");
            const unsigned og = xb_add(&bar[XB_TOP], 1u);
            const unsigned tg = og / nx;
            if (og + 1u == (tg + 1u) * nx) xb_add(&bar[XB_TOPGEN], 1u);
            else XB_SPIN(xb_ld(&bar[XB_TOPGEN]) == tg, bar);
            __builtin_amdgcn_fence(__ATOMIC_ACQUIRE, "agent");
            xb_add(&bar[XB_XGEN(b.x)], 1u);
            asm volatile("s_waitcnt vmcnt(0)" ::: "memory");
        } else {
            XB_SPIN(xb_ld(&bar[XB_XGEN(b.x)]) == gen, bar);
            __builtin_amdgcn_fence(__ATOMIC_ACQUIRE, "agent");
            asm volatile("s_waitcnt vmcnt(0)" ::: "memory");
        }
    }
    __syncthreads();
}


__device__ __forceinline__ void flat_barrier(unsigned* ctr, unsigned& epoch) {
    asm volatile("s_waitcnt vmcnt(0)" ::: "memory");
    __syncthreads();
    if (threadIdx.x == 0) {
        __builtin_amdgcn_fence(__ATOMIC_RELEASE, "agent");
        asm volatile("s_waitcnt vmcnt(0)" ::: "memory");
        (void)__hip_atomic_fetch_add(ctr, 1u, __ATOMIC_RELAXED, __HIP_MEMORY_SCOPE_AGENT);
        const unsigned target = (epoch + 1u) * (unsigned)gridDim.x; unsigned sp = 0;
        while (__hip_atomic_load(ctr, __ATOMIC_RELAXED, __HIP_MEMORY_SCOPE_AGENT) < target) { __builtin_amdgcn_s_sleep(1); if (++sp > (1u << 22)) break; }
        __builtin_amdgcn_fence(__ATOMIC_ACQUIRE, "agent");
        asm volatile("s_waitcnt vmcnt(0)" ::: "memory");
    }
    ++epoch;
    __syncthreads();
}

__device__ __forceinline__ void xcd_barrier2(const XcdBarrier& b) {
    asm volatile("s_waitcnt vmcnt(0)" ::: "memory");
    __syncthreads();
    if (threadIdx.x == 0) {
        unsigned* bar = b.bar;
        __builtin_amdgcn_s_waitcnt(0);
        unsigned nloc = b.st[0], nx = b.st[1];
        if (nloc == 0u) { xcd_barrier_complete(bar, b.x, nloc, nx); b.st[0] = nloc; b.st[1] = nx; }
        const unsigned old = xb_add(&bar[XB_XSUB(b.x)], 1u);
        const unsigned gen = old / nloc;
        if (old + 1u == (gen + 1u) * nloc) {
            __builtin_amdgcn_fence(__ATOMIC_RELEASE, "agent");
            asm volatile("s_waitcnt vmcnt(0)" ::: "memory");
            (void)xb_add(&bar[XB_TOP], 1u);
        }
        const unsigned target = (gen + 1u) * nx;
        XB_SPIN(xb_ld(&bar[XB_TOP]) < target, bar);
        __builtin_amdgcn_fence(__ATOMIC_ACQUIRE, "agent");
        asm volatile("s_waitcnt vmcnt(0)" ::: "memory");
    }
    __syncthreads();
}
constexpr int LDS_BYTES = 147456;
#define TAILFILL 1
#ifndef FAST_GEMM
#define FAST_GEMM 1
#endif
#ifndef FAST_TOPK
#define FAST_TOPK 1
#endif
#ifndef FAST_SSD
#define FAST_SSD 1
#endif
#ifndef FAST_ATTN
#define FAST_ATTN 1
#endif
__global__ void __launch_bounds__(NT) mega(Params p) {
  extern __shared__ __attribute__((aligned(16))) unsigned char lds_raw[];
  float* lds = (float*)lds_raw;
  fg::ldsp_t ldsp = (fg::ldsp_t)lds_raw;
  cg::grid_group grid = cg::this_grid();
  volatile LAS unsigned* bst = (volatile LAS unsigned*)((LAS unsigned char*)lds_raw + (LDS_BYTES - 64));
  if (threadIdx.x < 2) bst[threadIdx.x] = 0u;
  unsigned* barw = (unsigned*)(p.ws + WS_CTL + CTL_BAR);
  if (blockIdx.x == 0) for (int i = threadIdx.x; i < XCD_BAR_WORDS; i += NT) barw[i] = 0u;
  XcdBarrier xbar; xbar.bar = barw; xbar.x = 0; xbar.st = bst;
#ifdef FLATBAR
  unsigned fb_epoch = 0; unsigned* fb_ctr = barw + XCD_BAR_WORDS - 64;
#define GSYNC() flat_barrier(fb_ctr, fb_epoch)
#elif defined(XBAR2)
#define GSYNC() xcd_barrier2(xbar)
#else
#define GSYNC() xcd_barrier(xbar)
#endif
  nv::phase0(p, lds);                 grid.sync();
  xbar = xcd_barrier_post(barw, bst);
#ifdef DUP_SYNC
  for (int i = 0; i < 20; ++i) GSYNC();
#endif
#ifdef DUP_P0
  nv::phase0(p, lds);                 GSYNC();
#endif
  fr::phase_prenorm0(p);              GSYNC();
#ifdef DUP_PRENORM
  fr::phase_prenorm0(p); GSYNC();
#endif
#if FAST_GEMM
  fg::phase_qkv0(p, ldsp); GSYNC();
#ifdef DUP_QKV0
  fg::phase_qkv0(p, ldsp); GSYNC();
#endif
#else
  nv::phase_qkv0(p, lds);             GSYNC();
#endif
#if FAST_ATTN
  fa::phase_attnA(p, ldsp); fa::phase_attnB(p, ldsp); GSYNC();
#ifdef DUP_A
  fa::phase_attnA<DUP_A>(p, ldsp); GSYNC();
#endif
#ifdef DUP_B
  fa::phase_attnB<DUP_B>(p, ldsp); GSYNC();
#endif
#else
  nv::phase_attn0(p, lds);            GSYNC();
#endif
#if FAST_GEMM
#ifdef TAILFILL
  fg::phase_outproj(p, ldsp, 0); nv::convert_moe_tail8(p, 0, 1, lds, NROW / 256 * (DM / 256)); GSYNC();
#else
  fg::phase_outproj(p, ldsp, 0); GSYNC();
#endif
#ifdef DUP_OUT0
  fg::phase_outproj(p, ldsp, 0); GSYNC();
#endif
#else
  nv::phase_outproj(p, lds, 0);       GSYNC();
#endif
  fr::phase_postmix(p, ldsp, 0);            GSYNC();
#ifdef DUP_POSTMIX0
  fr::phase_postmix<DUP_POSTMIX0>(p, ldsp, 0); GSYNC();
#endif
#if FAST_TOPK
  ft::phase_topk(p, ldsp, 0);         GSYNC();
#ifdef DUP_TOPK0
  ft::phase_topk(p, ldsp, 0);         GSYNC();
#endif
#else
  nv::phase_topk(p, lds, 0);          GSYNC();
  fg::phase_gather(p, 0);             GSYNC();
#endif
#if FAST_GEMM
  fg::phase_moe_up8(p, ldsp, 0);      GSYNC();
#ifdef DUP_UP0
  fg::phase_moe_up8(p, ldsp, 0); GSYNC();
#endif
  fg::phase_moe_down8(p, ldsp, 0);    GSYNC();
#ifdef DUP_DOWN0
  fg::phase_moe_down8(p, ldsp, 0); GSYNC();
#endif
#else
  nv::phase_moe_up(p, lds, 0);        GSYNC();
  nv::phase_moe_down(p, lds, 0);      GSYNC();
#endif
#ifdef TAILFILL
  fr::phase_combine(p, 0); GSYNC();
#else
  fr::phase_combine(p, 0); nv::convert_moe_tail(p, 1, 0, lds, 0); nv::convert_moe_tail(p, 1, 1, lds, 0); GSYNC();
#endif
#if FAST_GEMM
#ifdef TAILFILL
  fg::phase_qkv1(p, ldsp); GSYNC();
#else
  fg::phase_qkv1(p, ldsp); GSYNC();
#endif
#else
  nv::phase_qkv1(p, lds);             GSYNC();
#endif
#if FAST_ATTN
#if FAST_SSD
#ifdef TAILFILL
  fs::phase_conv(p); GSYNC();
#else
  fs::phase_conv(p); GSYNC();
#endif
#else
  nv::phase_conv_swa(p, lds, true); GSYNC();
#endif
#else
  nv::phase_conv_swa(p, lds, true);   GSYNC();
#endif
#if FAST_SSD
  fs::phase_ssd(p, ldsp); fa::phase_attnC(p, ldsp, (int*)(p.ws + WS_CTL + CTL_QC));
  nv::convert_moe_tail8(p, 1, 0, lds, NB * 2 * 8); nv::convert_moe_tail8(p, 1, 1, lds, NB * 2 * 8); GSYNC();
#ifdef DUP_SSD
  fs::phase_ssd<DUP_SSD>(p, ldsp);             GSYNC();
#endif
  fs::phase_ssd_out(p);               GSYNC();
#else
  nv::phase_ssd(p, lds);              GSYNC();
  nv::phase_ssd_out(p);               GSYNC();
#endif
#if FAST_GEMM
  fg::phase_outproj(p, ldsp, 1);      GSYNC();
#else
  nv::phase_outproj(p, lds, 1);       GSYNC();
#endif
  fr::phase_postmix(p, ldsp, 1);            GSYNC();
#if FAST_TOPK
  ft::phase_topk(p, ldsp, 1);         GSYNC();
#ifdef DUP_TOPK1
  ft::phase_topk(p, ldsp, 1);         GSYNC();
#endif
#else
  nv::phase_topk(p, lds, 1);          GSYNC();
  fg::phase_gather(p, 1);             GSYNC();
#endif
#if FAST_GEMM
  fg::phase_moe_up8(p, ldsp, 1);      GSYNC();
  fg::phase_moe_down8(p, ldsp, 1);    GSYNC();
#else
  nv::phase_moe_up(p, lds, 1);        GSYNC();
  nv::phase_moe_down(p, lds, 1);      GSYNC();
#endif
  fr::phase_combine(p, 1);
}


extern "C" void kernel_launch(void* const* d_in, const int* in_sizes, int n_in, void* d_out, int out_size,
                              void* d_ws, size_t ws_size, hipStream_t stream) {
  static int grid_blocks = 0;
  if (!grid_blocks) {
    int dev = 0, cus = 0, per_cu = 0;
    (void)hipGetDevice(&dev);
    (void)hipDeviceGetAttribute(&cus, hipDeviceAttributeMultiprocessorCount, dev);
    (void)hipFuncSetAttribute((const void*)mega, hipFuncAttributeMaxDynamicSharedMemorySize, LDS_BYTES);
    (void)hipOccupancyMaxActiveBlocksPerMultiprocessor(&per_cu, (const void*)mega, NT, LDS_BYTES);
    if (per_cu < 1) { fprintf(stderr, "kernel_launch: occupancy query says %d blocks/CU\n", per_cu); per_cu = 1; }
    grid_blocks = cus;
    if (n_in != 43 || ws_size < WS_END) fprintf(stderr, "kernel_launch: unexpected n_in %d / ws_size %zu (need %zu)\n", n_in, ws_size, (size_t)WS_END);
  }
  Params p{};
  for (int i = 0; i < 43; ++i) p.in[i] = (const float*)d_in[i];
  p.out = (float*)d_out; p.ws = (unsigned char*)d_ws;
  void* args[] = {&p};
  hipError_t e = hipLaunchCooperativeKernel((void*)mega, dim3(grid_blocks), dim3(NT), args, LDS_BYTES, stream);
  if (e != hipSuccess) fprintf(stderr, "cooperative launch failed: %s (grid %d)\n", hipGetErrorString(e), grid_blocks);
}
```

```cpp
#include <hip/hip_runtime.h>
#include <hip/hip_cooperative_groups.h>
#include <cstdio>
#include <cstdint>
namespace cg = cooperative_groups;

typedef unsigned short bf16_t;
#define DEVI __device__ __forceinline__

constexpr int NT = 512, NWAVE = 8;
constexpr int NB = 8, SEQ = 4096, DM = 1024, CTXL = 256;
constexpr int NLAT = NB * SEQ, NCTX = NB * CTXL, NROW = NLAT + NCTX;
constexpr int NE = 16;
constexpr int CAP_L = 512, CAP_C = 32;
constexpr int EROWS0 = NB * CAP_L + NB * CAP_C;
constexpr int EROWS1 = NB * CAP_L;
constexpr int N_IN0 = 3072, N_IN1 = 2320, N_IN1P = 2560;
constexpr float EPS = 1e-6f;

constexpr size_t MiB = 1u << 20;
constexpr size_t WS_CTL = 0;
constexpr size_t WS_WIN0 = 1 * MiB;
constexpr size_t WS_WIN1 = 7 * MiB;
constexpr size_t WS_WOUT0 = 12 * MiB, WS_WOUT1 = 14 * MiB;
constexpr size_t WS_WGU = 16 * MiB;
constexpr size_t WS_WD = 80 * MiB;
constexpr size_t WS_XC = 112 * MiB;
constexpr size_t WS_H = 120 * MiB;
constexpr size_t WS_AFF = 188 * MiB;
constexpr size_t WS_SLOT = 191 * MiB;
constexpr size_t WS_IDX = 194 * MiB;
constexpr size_t WS_GATEV = 195 * MiB;
constexpr size_t WS_BIG = 196 * MiB;
constexpr size_t WS_QKV0 = WS_BIG;
constexpr size_t WS_ATT0 = WS_BIG + 204 * MiB;
constexpr size_t WS_MIX0 = WS_BIG + 272 * MiB;
constexpr size_t WS_XG = WS_BIG;
constexpr size_t WS_HID = WS_BIG + 136 * MiB;
constexpr size_t WS_Y = WS_BIG;
constexpr size_t WS_P1 = WS_BIG;
constexpr size_t WS_DT = WS_BIG + 153 * MiB;
constexpr size_t WS_U = WS_BIG + 156 * MiB;
constexpr size_t WS_MIX1 = WS_U;
constexpr size_t WS_ATT1 = WS_BIG + 224 * MiB;
constexpr size_t WS_YS = WS_BIG + 292 * MiB;
constexpr size_t WS_CUMG = WS_BIG + 356 * MiB;
constexpr size_t WS_DTG = WS_BIG + 359 * MiB;
constexpr size_t WS_VT = WS_BIG + 340 * MiB;
constexpr size_t WS_VTB = WS_BIG + 362 * MiB;
constexpr size_t WS_END = WS_BIG + 380 * MiB;
constexpr size_t CTL_MOD = 4096;
constexpr size_t CTL_ROPE = CTL_MOD + 2 * 9 * 6144 * 4;
constexpr size_t CTL_LAM = CTL_ROPE + 64 * 16 * 2 * 4;
constexpr size_t CTL_QC = CTL_LAM + 64;
constexpr size_t CTL_BAR = 512 * 1024;

struct Params {
  const float* in[43];
  float* out;
  unsigned char* ws;
};

enum {
  I_X = 0, I_C, I_CTX, I_CCTX,
  L0_WMOD, L0_BMOD, L0_GPREMIX, L0_GPOSTMIX, L0_GPREFFN, L0_GPOSTFFN, L0_WIN, L0_WOUT,
  L0_LAMQ1, L0_LAMK1, L0_LAMQ2, L0_LAMK2, L0_SUBLN, L0_RPB, L0_WROUTER, L0_WGATE, L0_WUP, L0_WDOWN,
  L1_WMOD, L1_BMOD, L1_GPREMIX, L1_GPOSTMIX, L1_GPREFFN, L1_GPOSTFFN, L1_WIN, L1_WOUT,
  L1_SINKS, L1_CONVW, L1_CONVB, L1_ALOGF, L1_ALOGB, L1_DTBF, L1_DTBB, L1_DSKIP, L1_GNORM,
  L1_WROUTER, L1_WGATE, L1_WUP, L1_WDOWN
};

DEVI int ftid() { int t = threadIdx.x; asm volatile("" : "+v"(t)); return t; }
DEVI float bf2f(bf16_t v) { return __uint_as_float(((unsigned)v) << 16); }
DEVI bf16_t f2bf(float f) { unsigned u = __float_as_uint(f); return (bf16_t)((u + 0x7fffu + ((u >> 16) & 1u)) >> 16); }
DEVI unsigned pk2(float lo, float hi) { return (unsigned)f2bf(lo) | ((unsigned)f2bf(hi) << 16); }
DEVI float silu_f(float v) { return v / (1.f + __expf(-v)); }
DEVI float wave_sum(float v) {
#pragma unroll
  for (int o = 1; o < 64; o <<= 1) v += __shfl_xor(v, o);
  return v;
}
DEVI float wave_max(float v) {
#pragma unroll
  for (int o = 1; o < 64; o <<= 1) v = fmaxf(v, __shfl_xor(v, o));
  return v;
}
DEVI int row_modrow(int r) { return r < NLAT ? (r >> 12) : 8; }
#ifndef QKV0_FP8
#define QKV0_FP8 1
#endif
#ifndef OUT_FP8
#define OUT_FP8 0
#endif
#ifndef QKV1_FP8
#define QKV1_FP8 0
#endif
namespace nv {

DEVI void transpose_item(const float* W, int K, int N, bf16_t* WT, int row_off, int row_mul, float* scr, int item, int lane, int Npad) {
  const int nblk = Npad / 32, kb = item / nblk, nb = item % nblk, k0 = 64 * kb, n0 = 32 * nb;
  const int n = n0 + (lane & 31); const bool ok = n < N;
  const float* src = W + (size_t)(k0 + (lane >> 5)) * N + (ok ? n : 0);
  float v[32];
#pragma unroll
  for (int i = 0; i < 32; ++i) v[i] = src[(size_t)(2 * i) * N];
#pragma unroll
  for (int i = 0; i < 32; ++i) scr[(2 * i + (lane >> 5)) * 33 + (lane & 31)] = ok ? v[i] : 0.f;
  __builtin_amdgcn_s_waitcnt(0); __builtin_amdgcn_wave_barrier();
  const int c = lane & 7;
#pragma unroll
  for (int j = 0; j < 4; ++j) {
    const int nn = (lane >> 3) + 8 * j; const float* s = scr + (8 * c) * 33 + nn;
    uint4 o; o.x = pk2(s[0 * 33], s[1 * 33]); o.y = pk2(s[2 * 33], s[3 * 33]); o.z = pk2(s[4 * 33], s[5 * 33]); o.w = pk2(s[6 * 33], s[7 * 33]);
    *(uint4*)(WT + (size_t)(row_off + (n0 + nn) * row_mul) * K + k0 + 8 * c) = o;
  }
  __builtin_amdgcn_s_waitcnt(0); __builtin_amdgcn_wave_barrier();
}

DEVI void convert_moe_part(const Params& p, int layer, int which, float* scr, int gw, int NGW, int lane) {
  const float* wg = p.in[layer ? L1_WGATE : L0_WGATE]; const float* wu = p.in[layer ? L1_WUP : L0_WUP]; const float* wd = p.in[layer ? L1_WDOWN : L0_WDOWN];
  bf16_t* WGU = (bf16_t*)(p.ws + WS_WGU); bf16_t* WD = (bf16_t*)(p.ws + WS_WD);
  constexpr int IPM = 16 * 32;
  if (which == 0) {
    for (int it = gw; it < NE * 2 * IPM; it += NGW) {
      const int e = it / (2 * IPM), r = it % (2 * IPM), gu = r / IPM, item = r % IPM;
      transpose_item((gu ? wu : wg) + (size_t)e * DM * DM, DM, DM, WGU + (size_t)e * 2048 * DM, gu, 2, scr, item, lane, DM);
    }
  } else {
    for (int it = gw; it < NE * IPM; it += NGW) {
      const int e = it / IPM, item = it % IPM;
      transpose_item(wd + (size_t)e * DM * DM, DM, DM, WD + (size_t)e * DM * DM, 0, 1, scr, item, lane, DM);
    }
  }
}
DEVI void convert_moe_tail(const Params& p, int layer, int which, float* lds, int nunits) {
  const int first = nunits % (int)gridDim.x;
  if ((int)blockIdx.x < first) return;
  const int w = ftid() >> 6;
  convert_moe_part(p, layer, which, lds + w * (64 * 33), ((int)blockIdx.x - first) * NWAVE + w, ((int)gridDim.x - first) * NWAVE, ftid() & 63);
}


constexpr float W8_SCALE = 64.f, A8_SCALE = 4.f;
constexpr int W8_E8M0 = 0x79797979, A8_E8M0 = 0x7d7d7d7d;
DEVI unsigned pack4_fp8(float a, float b, float c, float d) {
  a = fminf(fmaxf(a, -448.f), 448.f); b = fminf(fmaxf(b, -448.f), 448.f); c = fminf(fmaxf(c, -448.f), 448.f); d = fminf(fmaxf(d, -448.f), 448.f);
  int w = 0; w = __builtin_amdgcn_cvt_pk_fp8_f32(a, b, w, false); w = __builtin_amdgcn_cvt_pk_fp8_f32(c, d, w, true); return (unsigned)w; }
DEVI void transpose_item8(const float* W, int K, int N, unsigned char* WT, int row_off, int row_mul, float* scr, int item, int lane, int Npad = 0) {
  if (Npad == 0) Npad = N;
  const int nblk = Npad / 32, kb = item / nblk, nb = item % nblk, k0 = 64 * kb, n0 = 32 * nb;
  const int nn0 = n0 + (lane & 31); const bool ok = nn0 < N;
  const float* src = W + (size_t)(k0 + (lane >> 5)) * N + (ok ? nn0 : 0);
  float v[32];
#pragma unroll
  for (int i = 0; i < 32; ++i) v[i] = src[(size_t)(2 * i) * N];
#pragma unroll
  for (int i = 0; i < 32; ++i) scr[(2 * i + (lane >> 5)) * 33 + (lane & 31)] = ok ? v[i] * W8_SCALE : 0.f;
  __builtin_amdgcn_s_waitcnt(0); __builtin_amdgcn_wave_barrier();
  const int c = lane & 7;
#pragma unroll
  for (int j = 0; j < 4; ++j) {
    const int nn = (lane >> 3) + 8 * j; const float* s = scr + (8 * c) * 33 + nn;
    uint2 o; o.x = pack4_fp8(s[0 * 33], s[1 * 33], s[2 * 33], s[3 * 33]); o.y = pack4_fp8(s[4 * 33], s[5 * 33], s[6 * 33], s[7 * 33]);
    *(uint2*)(WT + (size_t)(row_off + (n0 + nn) * row_mul) * K + k0 + 8 * c) = o;
  }
  __builtin_amdgcn_s_waitcnt(0); __builtin_amdgcn_wave_barrier();
}
DEVI void convert_moe_part8(const Params& p, int layer, int which, float* scr, int gw, int NGW, int lane) {
  const float* wg = p.in[layer ? L1_WGATE : L0_WGATE]; const float* wu = p.in[layer ? L1_WUP : L0_WUP]; const float* wd = p.in[layer ? L1_WDOWN : L0_WDOWN];
  unsigned char* WGU = (unsigned char*)(p.ws + WS_WGU); unsigned char* WD = (unsigned char*)(p.ws + WS_WD);
  constexpr int IPM = 16 * 32;
  if (which == 0) {
    for (int it = gw; it < NE * 2 * IPM; it += NGW) { const int e = it / (2 * IPM), r = it % (2 * IPM), gu = r / IPM, item = r % IPM;
      transpose_item8((gu ? wu : wg) + (size_t)e * DM * DM, DM, DM, WGU + (size_t)e * 2048 * DM, gu, 2, scr, item, lane); }
  } else {
    for (int it = gw; it < NE * IPM; it += NGW) { const int e = it / IPM, item = it % IPM;
      transpose_item8(wd + (size_t)e * DM * DM, DM, DM, WD + (size_t)e * DM * DM, 0, 1, scr, item, lane); }
  }
}
DEVI void convert_moe_tail8(const Params& p, int layer, int which, float* lds, int nunits) {
  const int first = nunits % (int)gridDim.x;
  if ((int)blockIdx.x < first) return;
  const int w = ftid() >> 6;
  convert_moe_part8(p, layer, which, lds + w * (64 * 33), ((int)blockIdx.x - first) * NWAVE + w, ((int)gridDim.x - first) * NWAVE, ftid() & 63);
}

DEVI void phase0(const Params& p, float* lds) {
  const int tid = ftid(), lane = tid & 63, wave = tid >> 6;
  const int gw = blockIdx.x * NWAVE + wave, NGW = gridDim.x * NWAVE;
  for (int it = blockIdx.x; it < 2 * 96; it += gridDim.x) {
    const int layer = it / 96, j0 = (it % 96) * 64;
    float* sc = lds;
    float* red = lds + 9 * 1024;
    __syncthreads();
    for (int i = tid; i < 9 * 1024; i += NT) { const int r = i >> 10, k = i & 1023; const float v = (r < 8) ? p.in[I_C][r * 1024 + k] : p.in[I_CCTX][k]; sc[i] = silu_f(v); }
    __syncthreads();
    const float* wm = p.in[layer ? L1_WMOD : L0_WMOD];
    float acc[9];
#pragma unroll
    for (int r = 0; r < 9; ++r) acc[r] = 0.f;
    for (int k0 = wave * 128; k0 < wave * 128 + 128; k0 += 16) {
      float w[16];
#pragma unroll
      for (int i = 0; i < 16; ++i) w[i] = wm[(size_t)(k0 + i) * 6144 + j0 + lane];
#pragma unroll
      for (int i = 0; i < 16; ++i)
#pragma unroll
        for (int r = 0; r < 9; ++r) acc[r] += sc[r * 1024 + k0 + i] * w[i];
    }
#pragma unroll
    for (int r = 0; r < 9; ++r) red[(wave * 9 + r) * 64 + lane] = acc[r];
    __syncthreads();
    for (int i = tid; i < 9 * 64; i += NT) {
      const int r = i >> 6, c = i & 63; float s = 0.f;
      for (int w = 0; w < 8; ++w) s += red[(w * 9 + r) * 64 + c];
      float* MOD = (float*)(p.ws + WS_CTL + CTL_MOD);
      MOD[(layer * 9 + r) * 6144 + j0 + c] = s + p.in[layer ? L1_BMOD : L0_BMOD][j0 + c];
    }
    __syncthreads();
  }
  if (blockIdx.x == gridDim.x - 1) {
    float* ROPE = (float*)(p.ws + WS_CTL + CTL_ROPE);
    for (int i = tid; i < 64 * 16; i += NT) {
      const int pos = i >> 4, f = i & 15;
      const float inv = powf(10000.f, -(float)f / 16.f);
      const float ang = (float)pos * inv;
      ROPE[2 * i] = cosf(ang); ROPE[2 * i + 1] = sinf(ang);
    }
    if (wave == 0) {
      float a = p.in[L0_LAMQ1][lane] * p.in[L0_LAMK1][lane], b = p.in[L0_LAMQ2][lane] * p.in[L0_LAMK2][lane];
      a = wave_sum(a); b = wave_sum(b);
      if (lane == 0) { float* LAM = (float*)(p.ws + WS_CTL + CTL_LAM); LAM[0] = expf(a) - expf(b) + 0.2f; *(int*)(p.ws + WS_CTL + CTL_QC) = 0; }
    }
  }
  __syncthreads();
  float* scr = lds + wave * (64 * 33);
  {
    constexpr int I_IN0 = 16 * (N_IN0 / 32), I_OUT = 16 * 32, I_IN1 = 16 * (N_IN1P / 32);
    constexpr int NITEMS = I_IN0 + I_OUT + I_IN1 + I_OUT;
    for (int it = gw; it < NITEMS; it += NGW) {
      int r = it;
      if (r < I_IN0) { if (QKV0_FP8) transpose_item8(p.in[L0_WIN], DM, N_IN0, (unsigned char*)(p.ws + WS_WIN0), 0, 1, scr, r, lane); else transpose_item(p.in[L0_WIN], DM, N_IN0, (bf16_t*)(p.ws + WS_WIN0), 0, 1, scr, r, lane, N_IN0); continue; } r -= I_IN0;
      if (r < I_OUT) { if (OUT_FP8) transpose_item8(p.in[L0_WOUT], DM, DM, (unsigned char*)(p.ws + WS_WOUT0), 0, 1, scr, r, lane); else transpose_item(p.in[L0_WOUT], DM, DM, (bf16_t*)(p.ws + WS_WOUT0), 0, 1, scr, r, lane, DM); continue; } r -= I_OUT;
      if (r < I_IN1) { if (QKV1_FP8) transpose_item8(p.in[L1_WIN], DM, N_IN1, (unsigned char*)(p.ws + WS_WIN1), 0, 1, scr, r, lane, N_IN1P); else transpose_item(p.in[L1_WIN], DM, N_IN1, (bf16_t*)(p.ws + WS_WIN1), 0, 1, scr, r, lane, N_IN1P); continue; } r -= I_IN1;
      if (OUT_FP8) transpose_item8(p.in[L1_WOUT], DM, DM, (unsigned char*)(p.ws + WS_WOUT1), 0, 1, scr, r, lane); else transpose_item(p.in[L1_WOUT], DM, DM, (bf16_t*)(p.ws + WS_WOUT1), 0, 1, scr, r, lane, DM);
    }
  }
  convert_moe_part8(p, 0, 0, scr, gw, NGW, lane);
#ifndef TAILFILL
  convert_moe_part8(p, 0, 1, scr, gw, NGW, lane);
#endif
}

struct Row16 { float4 v[4]; };
DEVI Row16 ld_row_f32(const float* r, int lane) { Row16 o; const float4* q = (const float4*)r + lane;
#pragma unroll
  for (int j = 0; j < 4; ++j) o.v[j] = q[64 * j]; return o; }
DEVI Row16 ld_row_bf16(const bf16_t* r, int lane) { Row16 o; const uint2* q = (const uint2*)r + lane;
#pragma unroll
  for (int j = 0; j < 4; ++j) { const uint2 w = q[64 * j]; o.v[j] = make_float4(__uint_as_float(w.x << 16), __uint_as_float(w.x & 0xffff0000u), __uint_as_float(w.y << 16), __uint_as_float(w.y & 0xffff0000u)); }
  return o; }
DEVI void st_row_f32(float* r, int lane, const Row16& o) { float4* q = (float4*)r + lane;
#pragma unroll
  for (int j = 0; j < 4; ++j) q[64 * j] = o.v[j]; }
DEVI void st_row_bf16(bf16_t* r, int lane, const Row16& o) { uint2* q = (uint2*)r + lane;
#pragma unroll
  for (int j = 0; j < 4; ++j) q[64 * j] = make_uint2(pk2(o.v[j].x, o.v[j].y), pk2(o.v[j].z, o.v[j].w)); }
DEVI float row_sumsq(const Row16& o) { float s = 0.f;
#pragma unroll
  for (int j = 0; j < 4; ++j) s += o.v[j].x * o.v[j].x + o.v[j].y * o.v[j].y + o.v[j].z * o.v[j].z + o.v[j].w * o.v[j].w;
  return wave_sum(s); }
#define ROW_FOR4(expr) _Pragma("unroll") for (int j = 0; j < 4; ++j) { { float& e = o.v[j].x; const float a = A.v[j].x, b = Bv.v[j].x, c = Cv.v[j].x; expr; } { float& e = o.v[j].y; const float a = A.v[j].y, b = Bv.v[j].y, c = Cv.v[j].y; expr; } { float& e = o.v[j].z; const float a = A.v[j].z, b = Bv.v[j].z, c = Cv.v[j].z; expr; } { float& e = o.v[j].w; const float a = A.v[j].w, b = Bv.v[j].w, c = Cv.v[j].w; expr; } }

DEVI Row16 norm_mod(const Row16& x, const float* g, const float* sc, const float* sh, int lane) {
  const float r = rsqrtf(row_sumsq(x) * (1.f / DM) + EPS);
  Row16 o = x; const Row16 A = ld_row_f32(g, lane), Bv = ld_row_f32(sc, lane), Cv = ld_row_f32(sh, lane);
  ROW_FOR4(e = e * r * a * (1.f + b) + c);
  return o;
}

DEVI void phase_prenorm0(const Params& p) {
  const int lane = ftid() & 63, gw = blockIdx.x * NWAVE + (ftid() >> 6), NGW = gridDim.x * NWAVE;
  const float* MOD = (const float*)(p.ws + WS_CTL + CTL_MOD);
  bf16_t* H = (bf16_t*)(p.ws + WS_H);
  for (int r = gw; r < NROW; r += NGW) {
    const float* src = r < NLAT ? p.in[I_X] + (size_t)r * DM : p.in[I_CTX] + (size_t)(r - NLAT) * DM;
    const float* m = MOD + (size_t)row_modrow(r) * 6144;
    const Row16 x = ld_row_f32(src, lane);
    const Row16 h = norm_mod(x, p.in[L0_GPREMIX], m + 1024, m, lane);
    st_row_bf16(H + (size_t)r * DM, lane, h);
  }
}

template <class AF, class EF>
DEVI void gemm_tile(float* lds, const bf16_t* Bt, int n0, int K, AF arow, EF epi) {
  const int tid = ftid(), ty = tid >> 4, tx = tid & 15;
  float (*As)[132] = (float (*)[132])lds;
  float (*Bs)[68] = (float (*)[68])(lds + 16 * 132);
  float acc[4][4];
#pragma unroll
  for (int i = 0; i < 4; ++i)
#pragma unroll
    for (int j = 0; j < 4; ++j) acc[i][j] = 0.f;
  const int ar = tid >> 2, ak = (tid & 3) * 4;
  const int br = tid >> 3, bk = (tid & 7) * 2;
  const bf16_t* ap = arow(ar) + ak;
  const bf16_t* bp = Bt + (size_t)(n0 + br) * K + bk;
  for (int k0 = 0; k0 < K; k0 += 16) {
    const uint2 av = *(const uint2*)(ap + k0);
    const unsigned bv = *(const unsigned*)(bp + k0);
    __syncthreads();
    As[ak + 0][ar] = __uint_as_float(av.x << 16); As[ak + 1][ar] = __uint_as_float(av.x & 0xffff0000u);
    As[ak + 2][ar] = __uint_as_float(av.y << 16); As[ak + 3][ar] = __uint_as_float(av.y & 0xffff0000u);
    Bs[bk + 0][br] = __uint_as_float(bv << 16); Bs[bk + 1][br] = __uint_as_float(bv & 0xffff0000u);
    __syncthreads();
#pragma unroll
    for (int kk = 0; kk < 16; ++kk) {
      const float4 a = *(const float4*)&As[kk][ty * 4]; const float4 b = *(const float4*)&Bs[kk][tx * 4];
      const float aa[4] = {a.x, a.y, a.z, a.w}, bb[4] = {b.x, b.y, b.z, b.w};
#pragma unroll
      for (int i = 0; i < 4; ++i)
#pragma unroll
        for (int j = 0; j < 4; ++j) acc[i][j] += aa[i] * bb[j];
    }
  }
#pragma unroll
  for (int i = 0; i < 4; ++i) epi(ty * 4 + i, n0 + tx * 4, acc[i]);
}

DEVI void rope_pair(const float* ROPE, int t, int d, float& u1, float& u2) {
  const int i = d >> 1, f = i & 15, pos = (i < 16) ? (t >> 6) : (t & 63);
  const float cs = ROPE[(pos * 16 + f) * 2], sn = ROPE[(pos * 16 + f) * 2 + 1];
  const float a = u1 * cs - u2 * sn, b = u1 * sn + u2 * cs; u1 = a; u2 = b;
}

DEVI void phase_qkv0(const Params& p, float* lds) {
  const bf16_t* H = (const bf16_t*)(p.ws + WS_H); const bf16_t* W = (const bf16_t*)(p.ws + WS_WIN0);
  bf16_t* Q = (bf16_t*)(p.ws + WS_QKV0); const float* ROPE = (const float*)(p.ws + WS_CTL + CTL_ROPE);
  constexpr int NTN = N_IN0 / 64, NTM = NROW / 128;
  for (int it = blockIdx.x; it < NTN * NTM; it += gridDim.x) {
    const int mt = it / NTN, nt = it % NTN, m0 = mt * 128;
    gemm_tile(lds, W, nt * 64, DM,
      [&](int r) { return H + (size_t)(m0 + r) * DM; },
      [&](int r, int n, float* v) {
        const int row = m0 + r;
        if (row < NLAT && n < 1024) { const int t = row & 4095; rope_pair(ROPE, t, n & 63, v[0], v[1]); rope_pair(ROPE, t, (n + 2) & 63, v[2], v[3]); }
        *(uint2*)(Q + (size_t)row * N_IN0 + n) = make_uint2(pk2(v[0], v[1]), pk2(v[2], v[3]));
      });
  }
}

template <int NS, int VJ, class KF>
DEVI void wave_attn(const float* qs, float* pl  , int* rl  , int nkeys, KF kf, const bf16_t* KV, int ld, int kcol, int vcol,
                    float sink, bool has_sink, float (&o)[NS][VJ], float (&m)[NS], float (&l)[NS], int lane) {
#pragma unroll
  for (int s = 0; s < NS; ++s) { m[s] = -INFINITY; l[s] = 0.f;
#pragma unroll
    for (int j = 0; j < VJ; ++j) o[s][j] = 0.f; }
  for (int c0 = 0; c0 < nkeys; c0 += 64) {
    const int kidx = c0 + lane; int row = -1; float bias = 0.f;
    bool valid = kidx < nkeys; if (valid) valid = kf(kidx, row, bias);
    const int rr = valid ? row : 0;
    rl[lane] = valid ? row : -1;
    float sc[NS];
#pragma unroll
    for (int s = 0; s < NS; ++s) {
      const uint4* kp = (const uint4*)(KV + (size_t)rr * ld + kcol + 64 * s); float d = 0.f;
#pragma unroll
      for (int i = 0; i < 8; ++i) { const uint4 w = kp[i]; const float* q = qs + s * 64 + i * 8;
        d += q[0] * __uint_as_float(w.x << 16) + q[1] * __uint_as_float(w.x & 0xffff0000u) + q[2] * __uint_as_float(w.y << 16) + q[3] * __uint_as_float(w.y & 0xffff0000u)
           + q[4] * __uint_as_float(w.z << 16) + q[5] * __uint_as_float(w.z & 0xffff0000u) + q[6] * __uint_as_float(w.w << 16) + q[7] * __uint_as_float(w.w & 0xffff0000u); }
      sc[s] = valid ? d + bias : -INFINITY;
    }
#pragma unroll
    for (int s = 0; s < NS; ++s) {
      const float cm = wave_max(sc[s]); const float mn = fmaxf(m[s], cm);
      float pv = 0.f, scale = 1.f;
      if (mn > -INFINITY) { pv = __expf(sc[s] - mn); scale = __expf(m[s] - mn); }
      l[s] = l[s] * scale + wave_sum(pv); m[s] = mn;
#pragma unroll
      for (int j = 0; j < VJ; ++j) o[s][j] *= scale;
      pl[s * 64 + lane] = pv;
    }
    __builtin_amdgcn_s_waitcnt(0); __builtin_amdgcn_wave_barrier();
    for (int kk = 0; kk < 64; ++kk) {
      const int rk = rl[kk]; if (rk < 0) continue;
      const bf16_t* vp = KV + (size_t)rk * ld + vcol + lane;
      float vv[VJ];
#pragma unroll
      for (int j = 0; j < VJ; ++j) vv[j] = bf2f(vp[64 * j]);
#pragma unroll
      for (int s = 0; s < NS; ++s) { const float pk = pl[s * 64 + kk];
#pragma unroll
        for (int j = 0; j < VJ; ++j) o[s][j] += pk * vv[j]; }
    }
    __builtin_amdgcn_s_waitcnt(0); __builtin_amdgcn_wave_barrier();
  }
  if (has_sink) {
#pragma unroll
    for (int s = 0; s < NS; ++s) { const float mn = fmaxf(m[s], sink); const float scale = __expf(m[s] - mn);
      l[s] = l[s] * scale + __expf(sink - mn); m[s] = mn;
#pragma unroll
      for (int j = 0; j < VJ; ++j) o[s][j] *= scale; }
  }
}

DEVI void phase_attn0(const Params& p, float* lds) {
  const int tid = ftid(), lane = tid & 63, wave = tid >> 6;
  const int gw = blockIdx.x * NWAVE + wave, NGW = gridDim.x * NWAVE;
  const bf16_t* Q = (const bf16_t*)(p.ws + WS_QKV0); bf16_t* ATT = (bf16_t*)(p.ws + WS_ATT0);
  const float lam = ((const float*)(p.ws + WS_CTL + CTL_LAM))[0];
  float* qs = lds + wave * 128; float* pl = lds + 1024 + wave * 128; int* rl = (int*)(lds + 2048) + wave * 64;
  for (long it = gw; it < (long)NROW * 12; it += NGW) {
    const int row = (int)(it / 12), hs = (int)(it % 12);
    const bool lat = row < NLAT; const int b = lat ? (row >> 12) : ((row - NLAT) >> 8), t = lat ? (row & 4095) : 0;
    __builtin_amdgcn_s_waitcnt(0); __builtin_amdgcn_wave_barrier();
    if (hs < 4) {
      const bf16_t* qp = Q + (size_t)row * N_IN0 + hs * 128;
      qs[lane] = bf2f(qp[lane]) * 0.125f; qs[64 + lane] = bf2f(qp[64 + lane]) * 0.125f;
      __builtin_amdgcn_s_waitcnt(0); __builtin_amdgcn_wave_barrier();
      float o[2][2], m[2], l[2];
      const int nkeys = lat ? SEQ + CTXL : CTXL;
      wave_attn<2, 2>(qs, pl, rl, nkeys, [&](int k, int& r, float& bias) { r = lat ? (k < SEQ ? b * SEQ + k : NLAT + b * CTXL + (k - SEQ)) : NLAT + b * CTXL + k; return true; },
                      Q, N_IN0, 512 + hs * 128, 1024 + hs * 128, 0.f, false, o, m, l, lane);
      float v0 = o[0][0] / l[0] - lam * o[1][0] / l[1], v1 = o[0][1] / l[0] - lam * o[1][1] / l[1];
      const float r = rsqrtf(wave_sum(v0 * v0 + v1 * v1) * (1.f / 128.f) + EPS);
      const float* g = p.in[L0_SUBLN];
      ATT[(size_t)row * DM + hs * 128 + lane] = f2bf(v0 * r * g[lane] * 0.8f);
      ATT[(size_t)row * DM + hs * 128 + 64 + lane] = f2bf(v1 * r * g[64 + lane] * 0.8f);
    } else {
      const int h = hs - 4;
      qs[lane] = bf2f(Q[(size_t)row * N_IN0 + 1536 + h * 64 + lane]) * 0.125f;
      __builtin_amdgcn_s_waitcnt(0); __builtin_amdgcn_wave_barrier();
      float o[1][1], m[1], l[1];
      const int qr = t >> 6, qc = t & 63;
      const int rs = min(max(qr - 4, 0), 56), cs = min(max(qc - 8, 0), 48);
      const float* rpb = p.in[L0_RPB] + h * 15 * 31;
      const int nkeys = lat ? 128 + CTXL : CTXL;
      wave_attn<1, 1>(qs, pl, rl, nkeys, [&](int k, int& r, float& bias) {
          if (!lat) { r = NLAT + b * CTXL + k; return true; }
          if (k < 128) { const int kr = rs + (k >> 4), kc = cs + (k & 15); r = b * SEQ + kr * 64 + kc; bias = rpb[(kr - qr + 7) * 31 + (kc - qc + 15)]; }
          else r = NLAT + b * CTXL + (k - 128);
          return true; },
        Q, N_IN0, 2048 + h * 64, 2560 + h * 64, 0.f, false, o, m, l, lane);
      ATT[(size_t)row * DM + 512 + h * 64 + lane] = f2bf(o[0][0] / l[0]);
    }
  }
}

DEVI void phase_outproj(const Params& p, float* lds, int layer) {
  const bf16_t* A = (const bf16_t*)(p.ws + (layer ? WS_ATT1 : WS_ATT0)); const bf16_t* W = (const bf16_t*)(p.ws + (layer ? WS_WOUT1 : WS_WOUT0));
  bf16_t* MIX = (bf16_t*)(p.ws + (layer ? WS_MIX1 : WS_MIX0));
  const int NTM = (layer ? NLAT : NROW) / 128; constexpr int NTN = DM / 64;
  for (int it = blockIdx.x; it < NTN * NTM; it += gridDim.x) {
    const int mt = it / NTN, nt = it % NTN, m0 = mt * 128;
    gemm_tile(lds, W, nt * 64, DM, [&](int r) { return A + (size_t)(m0 + r) * DM; },
      [&](int r, int n, float* v) { *(uint2*)(MIX + (size_t)(m0 + r) * DM + n) = make_uint2(pk2(v[0], v[1]), pk2(v[2], v[3])); });
  }
}

DEVI void phase_postmix(const Params& p, int layer) {
  const int lane = ftid() & 63, gw = blockIdx.x * NWAVE + (ftid() >> 6), NGW = gridDim.x * NWAVE;
  const float* MOD = (const float*)(p.ws + WS_CTL + CTL_MOD) + (size_t)layer * 9 * 6144;
  const bf16_t* MIX = (const bf16_t*)(p.ws + (layer ? WS_MIX1 : WS_MIX0));
  bf16_t* H = (bf16_t*)(p.ws + WS_H); float* AFF = (float*)(p.ws + WS_AFF); float* XC = (float*)(p.ws + WS_XC);
  const float* gpost = p.in[layer ? L1_GPOSTMIX : L0_GPOSTMIX]; const float* gpre = p.in[layer ? L1_GPREFFN : L0_GPREFFN];
  const float* wr = p.in[layer ? L1_WROUTER : L0_WROUTER];
  const int nrow = layer ? NLAT : NROW;
  for (int r = gw; r < nrow; r += NGW) {
    const float* m = MOD + (size_t)row_modrow(r) * 6144;
    const float* xin = layer ? (p.out + (size_t)r * DM) : (r < NLAT ? p.in[I_X] + (size_t)r * DM : p.in[I_CTX] + (size_t)(r - NLAT) * DM);
    float* xout = r < NLAT ? p.out + (size_t)r * DM : XC + (size_t)(r - NLAT) * DM;
    Row16 o = ld_row_bf16(MIX + (size_t)r * DM, lane);
    const float rr = rsqrtf(row_sumsq(o) * (1.f / DM) + EPS);
    { const Row16 A = ld_row_f32(gpost, lane), Bv = ld_row_f32(m + 2048, lane), Cv = ld_row_f32(xin, lane);
      ROW_FOR4(e = c + b * (e * rr * a)); }
    st_row_f32(xout, lane, o);
    const Row16 h = norm_mod(o, gpre, m + 4096, m + 3072, lane);
    st_row_bf16(H + (size_t)r * DM, lane, h);
    float lg[16];
#pragma unroll
    for (int e = 0; e < 16; ++e) lg[e] = 0.f;
#pragma unroll
    for (int j = 0; j < 4; ++j) {
      const float hv[4] = {h.v[j].x, h.v[j].y, h.v[j].z, h.v[j].w};
#pragma unroll
      for (int q = 0; q < 4; ++q) { const float4* w4 = (const float4*)(wr + (size_t)(lane * 4 + 256 * j + q) * 16);
#pragma unroll
        for (int e4 = 0; e4 < 4; ++e4) { const float4 w = w4[e4]; lg[e4 * 4] += hv[q] * w.x; lg[e4 * 4 + 1] += hv[q] * w.y; lg[e4 * 4 + 2] += hv[q] * w.z; lg[e4 * 4 + 3] += hv[q] * w.w; } }
    }
    float mx = -INFINITY;
#pragma unroll
    for (int e = 0; e < 16; ++e) { lg[e] = wave_sum(lg[e]); mx = fmaxf(mx, lg[e]); }
    float s = 0.f;
#pragma unroll
    for (int e = 0; e < 16; ++e) { lg[e] = expf(lg[e] - mx); s += lg[e]; }
    const float inv = 1.f / s;
    float mine = 0.f;
#pragma unroll
    for (int e = 0; e < 16; ++e) if (lane == e) mine = lg[e] * inv;
    if (lane < 16) AFF[(size_t)lane * NROW + r] = mine;
  }
}

DEVI void phase_topk(const Params& p, float* lds, int layer) {
  const int tid = ftid();
  const float* AFF = (const float*)(p.ws + WS_AFF); int* SLOT = (int*)(p.ws + WS_SLOT); int* IDX = (int*)(p.ws + WS_IDX); float* GV = (float*)(p.ws + WS_GATEV);
  const int erows = layer ? EROWS1 : EROWS0;
  const int nlat_items = NB * NE * 8, nitems = nlat_items + (layer ? 0 : NB * NE);
  for (int it = blockIdx.x; it < nitems; it += gridDim.x) {
    const bool lat = it < nlat_items;
    int b, e, ch, n, cap, row0, slot0;
    if (lat) { b = it / (NE * 8); e = (it / 8) % NE; ch = it % 8; n = SEQ; cap = CAP_L; row0 = b * SEQ; slot0 = b * CAP_L; }
    else { const int i2 = it - nlat_items; b = i2 / NE; e = i2 % NE; ch = 0; n = CTXL; cap = CAP_C; row0 = NLAT + b * CTXL; slot0 = NB * CAP_L + b * CAP_C; }
    __syncthreads();
    for (int i = tid; i < n; i += NT) lds[i] = AFF[(size_t)e * NROW + row0 + i];
    __syncthreads();
    const int t = ch * 512 + tid;
    if (t < n) {
      const float a = lds[t]; int rank = 0;
      for (int j = 0; j < n; ++j) { const float v = lds[j]; rank += (v > a || (v == a && j < t)) ? 1 : 0; }
      if (rank < cap) { IDX[e * erows + slot0 + rank] = row0 + t; GV[e * erows + slot0 + rank] = a; SLOT[(size_t)(row0 + t) * 16 + e] = slot0 + rank; }
      else SLOT[(size_t)(row0 + t) * 16 + e] = -1;
    }
  }
}

DEVI void phase_moe_up(const Params& p, float* lds, int layer) {
  const bf16_t* H = (const bf16_t*)(p.ws + WS_H); const bf16_t* WGU = (const bf16_t*)(p.ws + WS_WGU); bf16_t* HID = (bf16_t*)(p.ws + WS_HID);
  const int* IDX = (const int*)(p.ws + WS_IDX);
  const int erows = layer ? EROWS1 : EROWS0, NTM = erows / 128; constexpr int NTN = 2048 / 64;
  for (int it = blockIdx.x; it < NE * NTM * NTN; it += gridDim.x) {
    const int e = it / (NTM * NTN), r2 = it % (NTM * NTN), mt = r2 / NTN, nt = r2 % NTN, m0 = mt * 128;
    gemm_tile(lds, WGU + (size_t)e * 2048 * DM, nt * 64, DM, [&](int r) { return H + (size_t)IDX[e * erows + m0 + r] * DM; },
      [&](int r, int n, float* v) { *(unsigned*)(HID + ((size_t)e * erows + m0 + r) * DM + (n >> 1)) = pk2(silu_f(v[0]) * v[1], silu_f(v[2]) * v[3]); });
  }
}
DEVI void phase_moe_down(const Params& p, float* lds, int layer) {
  const bf16_t* HID = (const bf16_t*)(p.ws + WS_HID); const bf16_t* WD = (const bf16_t*)(p.ws + WS_WD); bf16_t* Y = (bf16_t*)(p.ws + WS_Y);
  const float* GV = (const float*)(p.ws + WS_GATEV);
  const int erows = layer ? EROWS1 : EROWS0, NTM = erows / 128; constexpr int NTN = DM / 64;
  for (int it = blockIdx.x; it < NE * NTM * NTN; it += gridDim.x) {
    const int e = it / (NTM * NTN), r2 = it % (NTM * NTN), mt = r2 / NTN, nt = r2 % NTN, m0 = mt * 128;
    gemm_tile(lds, WD + (size_t)e * DM * DM, nt * 64, DM, [&](int r) { return HID + ((size_t)e * erows + m0 + r) * DM; },
      [&](int r, int n, float* v) { const float g = GV[e * erows + m0 + r];
        *(uint2*)(Y + ((size_t)e * erows + m0 + r) * DM + n) = make_uint2(pk2(v[0] * g, v[1] * g), pk2(v[2] * g, v[3] * g)); });
  }
}

DEVI void phase_combine(const Params& p, float* lds, int layer) {
  const int lane = ftid() & 63, wave = ftid() >> 6, gw = blockIdx.x * NWAVE + wave, NGW = gridDim.x * NWAVE;
  const float* MOD = (const float*)(p.ws + WS_CTL + CTL_MOD);
  const bf16_t* Y = (const bf16_t*)(p.ws + WS_Y); const int* SLOT = (const int*)(p.ws + WS_SLOT);
  bf16_t* H = (bf16_t*)(p.ws + WS_H); float* XC = (float*)(p.ws + WS_XC);
  const float* gpost = p.in[layer ? L1_GPOSTFFN : L0_GPOSTFFN];
  const int nrow = layer ? NLAT : NROW, erows = layer ? EROWS1 : EROWS0;
  for (int r = gw; r < nrow; r += NGW) {
    const float* m = MOD + (size_t)(layer * 9 + row_modrow(r)) * 6144;
    float* xio = r < NLAT ? p.out + (size_t)r * DM : XC + (size_t)(r - NLAT) * DM;
    Row16 o;
#pragma unroll
    for (int j = 0; j < 4; ++j) o.v[j] = make_float4(0.f, 0.f, 0.f, 0.f);
    for (int e = 0; e < NE; ++e) {
      const int s = SLOT[(size_t)r * 16 + e];
      if (s >= 0) { const Row16 y = ld_row_bf16(Y + ((size_t)e * erows + s) * DM, lane);
#pragma unroll
        for (int j = 0; j < 4; ++j) { o.v[j].x += y.v[j].x; o.v[j].y += y.v[j].y; o.v[j].z += y.v[j].z; o.v[j].w += y.v[j].w; } }
    }
    const float rr = rsqrtf(row_sumsq(o) * (1.f / DM) + EPS);
    { const Row16 A = ld_row_f32(gpost, lane), Bv = ld_row_f32(m + 5120, lane), Cv = ld_row_f32(xio, lane);
      ROW_FOR4(e = c + b * (e * rr * a)); }
    st_row_f32(xio, lane, o);
    if (layer == 0) {
      const float* m1 = MOD + (size_t)(9 + row_modrow(r)) * 6144;
      const Row16 h = norm_mod(o, p.in[L1_GPREMIX], m1 + 1024, m1, lane);
      st_row_bf16(H + (size_t)r * DM, lane, h);
    }
  }
  if (layer == 0) { convert_moe_part(p, 1, 0, lds + wave * (64 * 33), gw, NGW, lane); convert_moe_part(p, 1, 1, lds + wave * (64 * 33), gw, NGW, lane); }
}

DEVI void phase_qkv1(const Params& p, float* lds) {
  const bf16_t* H = (const bf16_t*)(p.ws + WS_H); const bf16_t* W = (const bf16_t*)(p.ws + WS_WIN1);
  bf16_t* P1 = (bf16_t*)(p.ws + WS_P1); float* DT = (float*)(p.ws + WS_DT); const float* ROPE = (const float*)(p.ws + WS_CTL + CTL_ROPE);
  constexpr int NTN = 37, NTM = NROW / 128;
  for (int it = blockIdx.x; it < NTN * NTM; it += gridDim.x) {
    const int mt = it / NTN, nt = it % NTN, m0 = mt * 128;
    gemm_tile(lds, W, nt * 64, DM, [&](int r) { return H + (size_t)(m0 + r) * DM; },
      [&](int r, int n, float* v) {
        const int row = m0 + r;
        if (n >= 2304) { if (n < 2320) *(float4*)(DT + (size_t)row * 16 + (n - 2304)) = make_float4(v[0], v[1], v[2], v[3]); return; }
        if (row < NLAT && n < 640) { const int t = row & 4095; rope_pair(ROPE, t, n & 63, v[0], v[1]); rope_pair(ROPE, t, (n + 2) & 63, v[2], v[3]); }
        *(uint2*)(P1 + (size_t)row * 2304 + n) = make_uint2(pk2(v[0], v[1]), pk2(v[2], v[3]));
      });
  }
}

DEVI void phase_conv_swa(const Params& p, float* lds, bool do_swa) {
  const int tid = ftid(), lane = tid & 63, wave = tid >> 6;
  const int gw = blockIdx.x * NWAVE + wave, NGW = gridDim.x * NWAVE;
  const bf16_t* P1 = (const bf16_t*)(p.ws + WS_P1); bf16_t* U = (bf16_t*)(p.ws + WS_U); bf16_t* ATT = (bf16_t*)(p.ws + WS_ATT1);
  const float* cw = p.in[L1_CONVW]; const float* cb = p.in[L1_CONVB];
  for (long i = (long)blockIdx.x * NT + tid; i < (long)NROW * 1024; i += (long)gridDim.x * NT) {
    const int row = (int)(i >> 10), ch = (int)(i & 1023);
    int s0, len, t; if (row < NLAT) { s0 = row & ~4095; len = SEQ; t = row & 4095; } else { s0 = NLAT + ((row - NLAT) & ~255); len = CTXL; t = (row - NLAT) & 255; }
    float acc = cb[ch];
#pragma unroll
    for (int j = 0; j < 5; ++j) { const int tt = t + j - 2; if (tt >= 0 && tt < len) acc += cw[j * 1024 + ch] * bf2f(P1[(size_t)(s0 + tt) * 2304 + 768 + ch]); }
    U[(size_t)row * 1024 + ch] = f2bf(silu_f(acc));
  }
  if (!do_swa) return;
  float* qs = lds + wave * 128; float* pl = lds + 1024 + wave * 128; int* rl = (int*)(lds + 2048) + wave * 64;
  for (long it = gw; it < (long)NLAT * 8; it += NGW) {
    const int row = (int)(it >> 3), hq = (int)(it & 7), g = hq >> 2, b = row >> 12, t = row & 4095;
    __builtin_amdgcn_s_waitcnt(0); __builtin_amdgcn_wave_barrier();
    qs[lane] = bf2f(P1[(size_t)row * 2304 + hq * 64 + lane]) * 0.125f;
    __builtin_amdgcn_s_waitcnt(0); __builtin_amdgcn_wave_barrier();
    float o[1][1], m[1], l[1];
    wave_attn<1, 1>(qs, pl, rl, 320 + CTXL, [&](int k, int& r, float& bias) {
        if (k < 320) { const int kp = t - 128 + k; if (k > 256 || kp < 0 || kp >= SEQ) return false; r = b * SEQ + kp; return true; }
        r = NLAT + b * CTXL + (k - 320); return true; },
      P1, 2304, 512 + g * 64, 640 + g * 64, p.in[L1_SINKS][hq], true, o, m, l, lane);
    ATT[(size_t)row * DM + hq * 64 + lane] = f2bf(o[0][0] / l[0]);
  }
}

DEVI void phase_ssd(const Params& p, float* lds) {
  const int tid = ftid();
  const bf16_t* U = (const bf16_t*)(p.ws + WS_U); const float* DT = (const float*)(p.ws + WS_DT); float* YS = (float*)(p.ws + WS_YS);
  constexpr int CH = 32;
  float* xb = lds;
  float* bb = lds + CH * 64;
  float* cb = bb + CH * 128;
  float* db = cb + CH * 128;
  float* yb = db + 2 * CH;
  const int pi = tid >> 3, ns = (tid & 7) * 16;
  for (int it = blockIdx.x; it < NB * 8; it += gridDim.x) {
    const int b = it >> 3, hd = it & 7, g = hd >> 2;
    for (int dir = 0; dir < 2; ++dir) {
      const float a = -expf(p.in[dir ? L1_ALOGB : L1_ALOGF][hd]); const float dtb = p.in[dir ? L1_DTBB : L1_DTBF][hd];
      float st[16];
#pragma unroll
      for (int i = 0; i < 16; ++i) st[i] = 0.f;
      for (int seg = 0; seg < 2; ++seg) {
        const int len = seg ? SEQ : CTXL, s0 = seg ? b * SEQ : NLAT + b * CTXL;
        for (int c0 = 0; c0 < len; c0 += CH) {
          __syncthreads();
          for (int i = tid; i < CH * 320; i += NT) {
            const int st_i = i / 320, c = i % 320; const int tk = dir ? (len - 1 - (c0 + st_i)) : (c0 + st_i); const size_t r = (size_t)(s0 + tk);
            if (c < 64) xb[st_i * 64 + c] = bf2f(U[r * 1024 + hd * 64 + c]);
            else if (c < 192) bb[st_i * 128 + (c - 64)] = bf2f(U[r * 1024 + 512 + g * 128 + (c - 64)]);
            else cb[st_i * 128 + (c - 192)] = bf2f(U[r * 1024 + 768 + g * 128 + (c - 192)]);
          }
          if (tid < CH) { const int tk = dir ? (len - 1 - (c0 + tid)) : (c0 + tid); const float raw = DT[(size_t)(s0 + tk) * 16 + dir * 8 + hd] + dtb;
            const float dt = raw > 20.f ? raw : log1pf(expf(raw)); db[tid] = expf(dt * a); db[CH + tid] = dt; }
          __syncthreads();
          for (int i = 0; i < CH; ++i) {
            const float dec = db[i], dx = db[CH + i] * xb[i * 64 + pi]; float y = 0.f;
#pragma unroll
            for (int q = 0; q < 16; ++q) { st[q] = st[q] * dec + dx * bb[i * 128 + ns + q]; y += st[q] * cb[i * 128 + ns + q]; }
            y += __shfl_xor(y, 1); y += __shfl_xor(y, 2); y += __shfl_xor(y, 4);
            if ((tid & 7) == 0) yb[i * 64 + pi] = y;
          }
          __syncthreads();
          if (seg == 1) for (int i = tid; i < CH * 64; i += NT) {
            const int q = i >> 6, c = i & 63; const int tk = (dir ? (len - CH - c0) : c0) + q, st_i = dir ? (CH - 1 - q) : q;
            float* yp = YS + (size_t)(b * SEQ + tk) * 512 + hd * 64 + c;
            if (dir == 0) *yp = yb[st_i * 64 + c]; else *yp = *yp + yb[st_i * 64 + c];
          }
        }
      }
      __syncthreads(); __threadfence();
    }
  }
}

DEVI void phase_ssd_out(const Params& p) {
  const int lane = ftid() & 63, gw = blockIdx.x * NWAVE + (ftid() >> 6), NGW = gridDim.x * NWAVE;
  const bf16_t* U = (const bf16_t*)(p.ws + WS_U); const bf16_t* P1 = (const bf16_t*)(p.ws + WS_P1); const float* YS = (const float*)(p.ws + WS_YS);
  bf16_t* ATT = (bf16_t*)(p.ws + WS_ATT1);
  for (int r = gw; r < NLAT; r += NGW) {
    const int c0 = lane * 8, hd = c0 >> 6; const float dsk = p.in[L1_DSKIP][hd];
    const float4 y0 = *(const float4*)(YS + (size_t)r * 512 + c0), y1 = *(const float4*)(YS + (size_t)r * 512 + c0 + 4);
    const uint4 xw = *(const uint4*)(U + (size_t)r * 1024 + c0), zw = *(const uint4*)(P1 + (size_t)r * 2304 + 1792 + c0);
    float y[8] = {y0.x, y0.y, y0.z, y0.w, y1.x, y1.y, y1.z, y1.w};
    const unsigned xs[4] = {xw.x, xw.y, xw.z, xw.w}, zs[4] = {zw.x, zw.y, zw.z, zw.w};
    float ss = 0.f;
#pragma unroll
    for (int i = 0; i < 4; ++i) {
      const float x0 = __uint_as_float(xs[i] << 16), x1 = __uint_as_float(xs[i] & 0xffff0000u), z0 = __uint_as_float(zs[i] << 16), z1 = __uint_as_float(zs[i] & 0xffff0000u);
      y[2 * i] = (y[2 * i] + dsk * x0) * silu_f(z0); y[2 * i + 1] = (y[2 * i + 1] + dsk * x1) * silu_f(z1);
      ss += y[2 * i] * y[2 * i] + y[2 * i + 1] * y[2 * i + 1];
    }
#pragma unroll
    for (int o = 1; o < 32; o <<= 1) ss += __shfl_xor(ss, o);
    const float rr = rsqrtf(ss * (1.f / 256.f) + EPS);
    const float4 g0 = *(const float4*)(p.in[L1_GNORM] + c0), g1 = *(const float4*)(p.in[L1_GNORM] + c0 + 4);
    uint4 w; w.x = pk2(y[0] * rr * g0.x, y[1] * rr * g0.y); w.y = pk2(y[2] * rr * g0.z, y[3] * rr * g0.w); w.z = pk2(y[4] * rr * g1.x, y[5] * rr * g1.y); w.w = pk2(y[6] * rr * g1.z, y[7] * rr * g1.w);
    *(uint4*)(ATT + (size_t)r * DM + 512 + c0) = w;
  }
}

}
namespace pg8 {
#define PG8_LAS __attribute__((address_space(3)))
typedef unsigned short bf16_t;
typedef short bf16x8 __attribute__((ext_vector_type(8)));
typedef float f32x4 __attribute__((ext_vector_type(4)));
typedef unsigned u32x4 __attribute__((ext_vector_type(4)));
constexpr int BM = 256, BK = 64, HALF = 128, HTB = HALF * BK * 2  , STAGE_BYTES = 8 * HTB, NXCD = 8, WGM = 8;

__host__ __device__ __forceinline__ int lds_byte(int r, int c) { const int st = (r >> 4) * 2 + (c >> 5), rr = r & 15, cc = c & 31, ob = rr * 64 + cc * 2; return st * 1024 + (ob ^ (((ob >> 9) & 1) << 5)); }
__host__ __device__ __forceinline__ void stage_rc(int b, int& R, int& C) { const int st = b / 1024, sb = b % 1024, swz = sb ^ (((sb >> 9) & 1) << 5); R = (st >> 1) * 16 + swz / 64; C = (st & 1) * 32 + (swz % 64) / 2; }
__host__ __device__ __forceinline__ int perm32(int rho) { const int n = rho >> 4, i = rho & 15; return 8 * (i >> 2) + 4 * n + (i & 3); }

struct Unit { int pm, pn; };
struct Gemm { const bf16_t* A; const bf16_t* Bt; int M, N, K; const int* gidx = nullptr; int sw = 0x7f7f7f7f, sa = 0x7f7f7f7f; };

struct StaticOrder {
    int nM, nN, nwg, G, c;
    __host__ __device__ void init(int M, int N, int G_, int c_) { nM = M / BM; nN = N / BM; nwg = nM * nN; G = G_; c = c_; }
    __host__ __device__ bool next(int i, Unit& u) const {
        const long L = (long)i * G + c; if (L >= nwg) return false;
        int wgid = (int)L; { const int q = nwg / NXCD, r = nwg % NXCD, xcd = wgid % NXCD, off = wgid / NXCD; wgid = (xcd < r ? xcd * (q + 1) : r * (q + 1) + (xcd - r) * q) + off; }
        const int nig = WGM * nN, gid = wgid / nig, fm = gid * WGM, gsz = (nM - fm) < WGM ? (nM - fm) : WGM;
        u.pm = fm + ((wgid % nig) % gsz); u.pn = (wgid % nig) / gsz; return true;
    }
    __device__ __forceinline__ void a_ready(const Unit&) const {}
    __device__ __forceinline__ void done(const Unit&) const {}
};

template <class Epi, class Sched, bool ALIGN_EPI = false, bool SP2 = false, bool FP8 = false>
__device__ __forceinline__ void gemm_phase(PG8_LAS unsigned char* lds, const Gemm g, const Sched& S, const Epi& E) {
    const int tid = ftid(), wid = __builtin_amdgcn_readfirstlane(tid >> 6), lane = tid & 63, wr = wid >> 2, wc = wid & 3, fr = lane & 15, fq = lane >> 4;
    const int KB = g.K * (FP8 ? 1 : 2), nt = KB / (BK * 2);
    unsigned voffB[2]; int pR[2], pC[2];
#pragma unroll
    for (int i = 0; i < 2; ++i) { int R, C; stage_rc(tid * 16 + i * 8192, R, C); const int Rb = Epi::PERM ? ((R & ~31) + perm32(R & 31)) : R;
        pR[i] = R; pC[i] = C; voffB[i] = (unsigned)(Rb * KB + C * 2); }
    unsigned cvo[2][2], nvo[2][2];
#define PG8_SETVO(vo, pm_) do { _Pragma("unroll") for (int _h = 0; _h < 2; ++_h) _Pragma("unroll") for (int _i = 0; _i < 2; ++_i) { const int _r = (pm_) * BM + _h * HALF + pR[_i]; \
        const int _g = g.gidx ? g.gidx[_r] : _r; vo[_h][_i] = (unsigned)_g * (unsigned)KB + (unsigned)(pC[_i] * 2); } } while (0)
#define PG8_STAGEA(bufoff, koff, vo) do { _Pragma("unroll") for (int _i = 0; _i < 2; ++_i) \
        __builtin_amdgcn_global_load_lds((const unsigned*)((const char*)g.A + (koff) + (vo)[_i]), (PG8_LAS unsigned*)(lds + (bufoff) + ldsw + _i * 8192), 16, 0, 0); } while (0)
    const size_t kstep = (size_t)(BK * 2);
    const size_t hstep = (size_t)HALF * KB;
    const size_t tstep = 2 * hstep;
    const unsigned ldsw = (unsigned)wid * 1024u;
    const int aoff = lds_byte(wr * 64 + fr, fq * 8), boff = lds_byte(wc * 32 + fr, fq * 8);
#define PG8_SA(b, h) (((b) * 2 + (h)) * HTB)
#define PG8_SB(b, h) ((4 + (b) * 2 + (h)) * HTB)
#define PG8_STAGE(bufoff, gbase, voff) do { _Pragma("unroll") for (int _i = 0; _i < 2; ++_i) \
        __builtin_amdgcn_global_load_lds((const unsigned*)((const char*)(gbase) + (voff)[_i]), (PG8_LAS unsigned*)(lds + (bufoff) + ldsw + _i * 8192), 16, 0, 0); } while (0)
    typedef int v4i_t __attribute__((ext_vector_type(4))); typedef int v8i_t __attribute__((ext_vector_type(8)));
#define PG8_CAT8(x, y) __builtin_shufflevector(__builtin_bit_cast(v4i_t, x), __builtin_bit_cast(v4i_t, y), 0, 1, 2, 3, 4, 5, 6, 7)
#define PG8_LDA(dst, b, h) do { _Pragma("unroll") for (int m = 0; m < 4; ++m) { const bf16x8 f0_ = *(const PG8_LAS bf16x8*)(lds + PG8_SA(b, h) + aoff + m * 2048), f1_ = *(const PG8_LAS bf16x8*)(lds + PG8_SA(b, h) + aoff + m * 2048 + 1024); \
        if constexpr (FP8) dst##8[m] = PG8_CAT8(f0_, f1_); else { dst[m][0] = f0_; dst[m][1] = f1_; } } } while (0)
#define PG8_LDB(dst, b, h) do { _Pragma("unroll") for (int n = 0; n < 2; ++n) { const bf16x8 f0_ = *(const PG8_LAS bf16x8*)(lds + PG8_SB(b, h) + boff + n * 2048), f1_ = *(const PG8_LAS bf16x8*)(lds + PG8_SB(b, h) + boff + n * 2048 + 1024); \
        if constexpr (FP8) dst##8[n] = PG8_CAT8(f0_, f1_); else { dst[n][0] = f0_; dst[n][1] = f1_; } } } while (0)
typedef int v4i_t __attribute__((ext_vector_type(4))); typedef int v8i_t __attribute__((ext_vector_type(8)));
#define PG8_CAT8(x, y) __builtin_shufflevector(__builtin_bit_cast(v4i_t, x), __builtin_bit_cast(v4i_t, y), 0, 1, 2, 3, 4, 5, 6, 7)
#define PG8_MMA(ai, bj, At, Bt) do { __builtin_amdgcn_s_setprio(1); _Pragma("unroll") for (int m = 0; m < 4; ++m) _Pragma("unroll") for (int n = 0; n < 2; ++n) { \
        if constexpr (FP8) asm volatile("v_mfma_scale_f32_16x16x128_f8f6f4 %0, %1, %2, %0, %3, %4 op_sel_hi:[0,0,0]" : "+v"(acc[ai][bj][m][n]) : "v"(Bt##8[n]), "v"(At##8[m]), "v"(sw_), "v"(sa_)); \
        else { _Pragma("unroll") for (int k = 0; k < 2; ++k) acc[ai][bj][m][n] = __builtin_amdgcn_mfma_f32_16x16x32_bf16(Bt[n][k], At[m][k], acc[ai][bj][m][n], 0, 0, 0); } } \
        __builtin_amdgcn_s_setprio(0); } while (0)
#define PG8_WAIT_V(n) asm volatile("s_waitcnt vmcnt(" #n ")" ::: "memory")
#define PG8_WAIT_L(n) asm volatile("s_waitcnt lgkmcnt(" #n ")" ::: "memory")
#define PG8_BAR __builtin_amdgcn_s_barrier()
#define PG8_SCHED __builtin_amdgcn_sched_barrier(0)
    Unit cur, nxt; int ui = 0;
    if (!S.next(0, cur)) return;
    f32x4 acc[2][2][4][2];
#pragma unroll
    for (int a = 0; a < 2; ++a)
#pragma unroll
        for (int b = 0; b < 2; ++b)
#pragma unroll
            for (int m = 0; m < 4; ++m)
#pragma unroll
                for (int n = 0; n < 2; ++n) acc[a][b][m][n] = (f32x4){0.f, 0.f, 0.f, 0.f};
    const int sw_ = g.sw, sa_ = g.sa;
    bf16x8 At[4][2], B0[2][2], B1[2][2]; v8i_t At8[4], B08[2], B18[2];
    PG8_SETVO(cvo, cur.pm); const char* cB = (const char*)g.Bt + (size_t)cur.pn * tstep;
    S.a_ready(cur);
    if constexpr (SP2) {
        PG8_STAGE(PG8_SB(0, 0), cB, voffB); PG8_STAGE(PG8_SB(0, 1), cB + hstep, voffB); PG8_STAGEA(PG8_SA(0, 0), 0, cvo[0]); PG8_STAGEA(PG8_SA(0, 1), 0, cvo[1]);
        if (wr == 1) PG8_BAR;
        PG8_WAIT_V(2); PG8_BAR;
        PG8_STAGE(PG8_SB(1, 0), cB + kstep, voffB); PG8_STAGEA(PG8_SA(1, 0), kstep, cvo[0]); PG8_STAGE(PG8_SB(1, 1), cB + hstep + kstep, voffB);
        PG8_WAIT_V(6); PG8_BAR;
    } else {
        PG8_STAGE(PG8_SB(0, 0), cB, voffB); PG8_STAGEA(PG8_SA(0, 0), 0, cvo[0]); PG8_STAGE(PG8_SB(0, 1), cB + hstep, voffB); PG8_STAGEA(PG8_SA(0, 1), 0, cvo[1]);
        if (wr == 1) PG8_BAR;
        PG8_WAIT_V(4); PG8_BAR;
        PG8_STAGE(PG8_SB(1, 0), cB + kstep, voffB); PG8_STAGEA(PG8_SA(1, 0), kstep, cvo[0]); PG8_STAGE(PG8_SB(1, 1), cB + hstep + kstep, voffB);
        PG8_WAIT_V(6); PG8_BAR;
    }
    for (;;) {
        const bool has_next = S.next(ui + 1, nxt);
        if (has_next) PG8_SETVO(nvo, nxt.pm); else { nvo[0][0] = cvo[0][0]; nvo[0][1] = cvo[0][1]; nvo[1][0] = cvo[1][0]; nvo[1][1] = cvo[1][1]; }
        const char* nB = has_next ? (const char*)g.Bt + (size_t)nxt.pn * tstep : cB;
#pragma unroll 1
        for (int t = 0; t < nt; t += 2) {
            const bool last = (t == nt - 2);
            const size_t k1 = (size_t)(t + 1) * kstep;
            const size_t k2 = last ? 0 : (size_t)(t + 2) * kstep; unsigned v2[2][2];
            v2[0][0] = last ? nvo[0][0] : cvo[0][0]; v2[0][1] = last ? nvo[0][1] : cvo[0][1]; v2[1][0] = last ? nvo[1][0] : cvo[1][0]; v2[1][1] = last ? nvo[1][1] : cvo[1][1];
            const char* b2 = last ? nB : cB + (size_t)(t + 2) * kstep;
            const size_t k3 = k2 + kstep; const char* b3 = b2 + kstep;
            if (last && has_next) S.a_ready(nxt);
            if constexpr (SP2) {
            PG8_LDB(B0, 0, 0); PG8_LDB(B1, 0, 1); PG8_SCHED; PG8_LDA(At, 0, 0); PG8_STAGEA(PG8_SA(1, 1), k1, cvo[1]);
            PG8_WAIT_V(8); PG8_WAIT_L(0); PG8_BAR; PG8_MMA(0, 0, At, B0); PG8_MMA(0, 1, At, B1); PG8_BAR; PG8_SCHED;
            PG8_LDA(At, 0, 1); PG8_STAGE(PG8_SB(0, 0), b2, voffB); PG8_STAGE(PG8_SB(0, 1), b2 + hstep, voffB); PG8_STAGEA(PG8_SA(0, 0), k2, v2[0]);
            PG8_WAIT_V(8); PG8_WAIT_L(0); PG8_BAR; PG8_MMA(1, 0, At, B0); PG8_MMA(1, 1, At, B1); PG8_BAR; PG8_SCHED;
            PG8_LDB(B0, 1, 0); PG8_LDB(B1, 1, 1); PG8_SCHED; PG8_LDA(At, 1, 0); PG8_STAGEA(PG8_SA(0, 1), k2, v2[1]);
            PG8_WAIT_V(8); PG8_WAIT_L(0); PG8_BAR; PG8_MMA(0, 0, At, B0); PG8_MMA(0, 1, At, B1); PG8_BAR; PG8_SCHED;
            PG8_LDA(At, 1, 1); PG8_STAGE(PG8_SB(1, 0), b3, voffB); PG8_STAGE(PG8_SB(1, 1), b3 + hstep, voffB); PG8_STAGEA(PG8_SA(1, 0), k3, v2[0]);
            PG8_WAIT_V(8); PG8_WAIT_L(0); PG8_BAR; PG8_MMA(1, 0, At, B0); PG8_MMA(1, 1, At, B1); PG8_BAR; PG8_SCHED;
            } else {
            PG8_LDB(B0, 0, 0); PG8_SCHED; PG8_LDA(At, 0, 0); PG8_STAGEA(PG8_SA(1, 1), k1, cvo[1]);
            PG8_WAIT_L(8); PG8_BAR; PG8_WAIT_L(0); PG8_MMA(0, 0, At, B0); PG8_BAR; PG8_SCHED;
            PG8_LDB(B1, 0, 1); PG8_STAGE(PG8_SB(0, 0), b2, voffB);
            PG8_BAR; PG8_WAIT_L(0); PG8_MMA(0, 1, At, B1); PG8_BAR;
            PG8_LDA(At, 0, 1); PG8_STAGEA(PG8_SA(0, 0), k2, v2[0]);
            PG8_BAR; PG8_WAIT_L(0); PG8_MMA(1, 0, At, B0); PG8_BAR; PG8_SCHED;
            PG8_STAGE(PG8_SB(0, 1), b2 + hstep, voffB);
            PG8_WAIT_V(6); PG8_BAR; PG8_MMA(1, 1, At, B1); PG8_BAR;
            PG8_LDB(B0, 1, 0); PG8_SCHED; PG8_LDA(At, 1, 0); PG8_STAGEA(PG8_SA(0, 1), k2, v2[1]);
            PG8_WAIT_L(8); PG8_BAR; PG8_WAIT_L(0); PG8_MMA(0, 0, At, B0); PG8_BAR; PG8_SCHED;
            PG8_LDB(B1, 1, 1); PG8_STAGE(PG8_SB(1, 0), b3, voffB);
            PG8_BAR; PG8_WAIT_L(0); PG8_MMA(0, 1, At, B1); PG8_BAR;
            PG8_LDA(At, 1, 1); PG8_STAGEA(PG8_SA(1, 0), k3, v2[0]);
            PG8_BAR; PG8_WAIT_L(0); PG8_MMA(1, 0, At, B0); PG8_BAR; PG8_SCHED;
            PG8_STAGE(PG8_SB(1, 1), b3 + hstep, voffB);
            PG8_WAIT_V(6); PG8_BAR; PG8_MMA(1, 1, At, B1); PG8_BAR;
            }
        }
        if constexpr (ALIGN_EPI) { if (wr == 0) PG8_BAR; }
        if constexpr (FP8) asm volatile("s_nop 15\n\ts_nop 15" ::: "memory");
        if constexpr (!Epi::AFTER_DRAIN) { E(acc, cur, wr, wc, fr, fq); S.done(cur); }
        if (!has_next) break;
#pragma unroll
        for (int a = 0; a < 2; ++a)
#pragma unroll
            for (int b = 0; b < 2; ++b)
#pragma unroll
                for (int m = 0; m < 4; ++m)
#pragma unroll
                    for (int n = 0; n < 2; ++n) acc[a][b][m][n] = (f32x4){0.f, 0.f, 0.f, 0.f};
        cur = nxt; cvo[0][0] = nvo[0][0]; cvo[0][1] = nvo[0][1]; cvo[1][0] = nvo[1][0]; cvo[1][1] = nvo[1][1]; cB = nB; ++ui;
        if constexpr (ALIGN_EPI) { if (wr == 1) PG8_BAR; }
    }
    PG8_WAIT_V(0);
    if constexpr (!ALIGN_EPI) { if (wr == 0) PG8_BAR; }
    PG8_BAR;
    if constexpr (Epi::AFTER_DRAIN) { E.fused(acc, cur, wr, wc, fr, fq, lds, wid, lane); S.done(cur); }
#undef PG8_SA
#undef PG8_SB
#undef PG8_STAGE
#undef PG8_STAGEA
#undef PG8_SETVO
#undef PG8_LDA
#undef PG8_LDB
#undef PG8_MMA
#undef PG8_CAT8
#undef PG8_WAIT_V
#undef PG8_WAIT_L
#undef PG8_BAR
#undef PG8_SCHED
}
}
#ifndef FP8_SP2
#define FP8_SP2 true
#endif
#ifndef ATTNA_FP8
#define ATTNA_FP8 1
#endif
namespace fg {
using pg8::f32x4; using pg8::Unit;
typedef unsigned u32x4 __attribute__((ext_vector_type(4)));
typedef unsigned u32x2 __attribute__((ext_vector_type(2)));
DEVI unsigned cvtpk(float lo, float hi) { typedef float f2_t __attribute__((ext_vector_type(2))); typedef __bf16 b2_t __attribute__((ext_vector_type(2))); const f2_t v = {lo, hi}; const b2_t b = __builtin_convertvector(v, b2_t); return __builtin_bit_cast(unsigned, b); }
template <class TP> DEVI void rope8(TP ROPE, int t, int d0, f32x4& v0, f32x4& v1) {
  const int i0 = d0 >> 1, f0 = i0 & 15, pos = (i0 < 16) ? (t >> 6) : (t & 63);
  const f32x4 r0 = *(const PG8_LAS f32x4*)(ROPE + (pos * 16 + f0) * 2), r1 = *(const PG8_LAS f32x4*)(ROPE + (pos * 16 + f0) * 2 + 4);
  const f32x4 a = v0, b = v1;
  v0[0] = a[0] * r0[0] - a[1] * r0[1]; v0[1] = a[0] * r0[1] + a[1] * r0[0]; v0[2] = a[2] * r0[2] - a[3] * r0[3]; v0[3] = a[2] * r0[3] + a[3] * r0[2];
  v1[0] = b[0] * r1[0] - b[1] * r1[1]; v1[1] = b[0] * r1[1] + b[1] * r1[0]; v1[2] = b[2] * r1[2] - b[3] * r1[3]; v1[3] = b[2] * r1[3] + b[3] * r1[2];
}
#define EPI_LOOP_BEGIN const int row0 = u.pm * 256 + wr * 64 + fr; \
  _Pragma("unroll") for (int ai = 0; ai < 2; ++ai) _Pragma("unroll") for (int m = 0; m < 4; ++m) { const int row = row0 + ai * 128 + m * 16; \
  _Pragma("unroll") for (int bj = 0; bj < 2; ++bj) { f32x4 v0 = acc[ai][bj][m][0], v1 = acc[ai][bj][m][1]; const int cl = bj * 128 + wc * 32 + 8 * fq;
#define EPI_LOOP_END } }

struct EpiQKV0 { static constexpr bool PERM = true, AFTER_DRAIN = false; bf16_t* O; const PG8_LAS float* ROPE; unsigned char* VT; unsigned char* VTB;
  DEVI void operator()(const f32x4 (&acc)[2][2][4][2], const Unit& u, int wr, int wc, int fr, int fq) const {
    const int colt = u.pn * 256; const bool rope = (u.pm < NLAT / 256) && (colt < 1024);
    EPI_LOOP_BEGIN
      const int col = colt + cl;
      if (ATTNA_FP8 && colt >= 1024 && colt < 1536) {
        const int hh = (col - 1024) >> 7, dv0 = (col - 1024) & 127;
        int bb, t; if (row < NLAT) { bb = row >> 12; t = row & 4095; } else { bb = (row - NLAT) >> 8; t = 4096 + ((row - NLAT) & 255); }
        const int k = t & 31, gq = k >> 3, wq = k & 7, pos = (wq < 4) ? gq * 4 + wq : 16 + gq * 4 + (wq - 4);
        unsigned char* vp = VT + (size_t)((bb * 4 + hh) * 128 + dv0) * 4352 + (t & ~31) + pos;
        const unsigned w0 = nv::pack4_fp8(v0[0] * 4.f, v0[1] * 4.f, v0[2] * 4.f, v0[3] * 4.f), w1 = nv::pack4_fp8(v1[0] * 4.f, v1[1] * 4.f, v1[2] * 4.f, v1[3] * 4.f);
        vp[0 * 4352] = (unsigned char)w0; vp[1 * 4352] = (unsigned char)(w0 >> 8); vp[2 * 4352] = (unsigned char)(w0 >> 16); vp[3 * 4352] = (unsigned char)(w0 >> 24);
        vp[4 * 4352] = (unsigned char)w1; vp[5 * 4352] = (unsigned char)(w1 >> 8); vp[6 * 4352] = (unsigned char)(w1 >> 16); vp[7 * 4352] = (unsigned char)(w1 >> 24);
        continue;
      }
      if (ATTNA_FP8 && colt >= 2560) {
        const int hh = (col - 2560) >> 6, dv0 = (col - 2560) & 63;
        int bb, t; if (row < NLAT) { bb = row >> 12; t = row & 4095; } else { bb = (row - NLAT) >> 8; t = 4096 + ((row - NLAT) & 255); }
        const int k = t & 31, gq = k >> 3, wq = k & 7, pos = (wq < 4) ? gq * 4 + wq : 16 + gq * 4 + (wq - 4);
        unsigned char* vp = VTB + (size_t)((bb * 8 + hh) * 64 + dv0) * 4352 + (t & ~31) + pos;
        const unsigned w0 = nv::pack4_fp8(v0[0] * 4.f, v0[1] * 4.f, v0[2] * 4.f, v0[3] * 4.f), w1 = nv::pack4_fp8(v1[0] * 4.f, v1[1] * 4.f, v1[2] * 4.f, v1[3] * 4.f);
        vp[0 * 4352] = (unsigned char)w0; vp[1 * 4352] = (unsigned char)(w0 >> 8); vp[2 * 4352] = (unsigned char)(w0 >> 16); vp[3 * 4352] = (unsigned char)(w0 >> 24);
        vp[4 * 4352] = (unsigned char)w1; vp[5 * 4352] = (unsigned char)(w1 >> 8); vp[6 * 4352] = (unsigned char)(w1 >> 16); vp[7 * 4352] = (unsigned char)(w1 >> 24);
        continue;
      }
      if (rope) rope8(ROPE, row & 4095, col & 63, v0, v1);
      if (ATTNA_FP8 && (colt < 1024 || colt >= 1536)) {
        const float sc = (colt < 512 || (colt >= 1536 && colt < 2048)) ? 16.f * 0.125f * 1.4426950408889634f : 4.f;
        u32x2 w8; w8.x = nv::pack4_fp8(v0[0] * sc, v0[1] * sc, v0[2] * sc, v0[3] * sc); w8.y = nv::pack4_fp8(v1[0] * sc, v1[1] * sc, v1[2] * sc, v1[3] * sc);
        *(u32x2*)((unsigned char*)O + (size_t)row * (N_IN0 * 2) + col) = w8;
        continue;
      }
      u32x4 w; w.x = cvtpk(v0[0], v0[1]); w.y = cvtpk(v0[2], v0[3]); w.z = cvtpk(v1[0], v1[1]); w.w = cvtpk(v1[2], v1[3]);
      *(u32x4*)(O + (size_t)row * N_IN0 + col) = w;
    EPI_LOOP_END
  } };
struct EpiQKV1 { static constexpr bool PERM = true, AFTER_DRAIN = false; bf16_t* O; float* DT; const PG8_LAS float* ROPE;
  DEVI void operator()(const f32x4 (&acc)[2][2][4][2], const Unit& u, int wr, int wc, int fr, int fq) const {
    const int colt = u.pn * 256; const bool lat = (u.pm < NLAT / 256);
    EPI_LOOP_BEGIN
      const int col = colt + cl;
      if (col >= 2304) { if (col < 2320) { *(f32x4*)(DT + (size_t)row * 16 + (col - 2304)) = v0; *(f32x4*)(DT + (size_t)row * 16 + (col - 2304) + 4) = v1; } }
      else {
        if (lat && col < 640) rope8(ROPE, row & 4095, col & 63, v0, v1);
        u32x4 w; w.x = cvtpk(v0[0], v0[1]); w.y = cvtpk(v0[2], v0[3]); w.z = cvtpk(v1[0], v1[1]); w.w = cvtpk(v1[2], v1[3]);
        *(u32x4*)(O + (size_t)row * 2304 + col) = w;
      }
    EPI_LOOP_END
  } };
struct EpiPlain { static constexpr bool PERM = true, AFTER_DRAIN = false; bf16_t* O;
  DEVI void operator()(const f32x4 (&acc)[2][2][4][2], const Unit& u, int wr, int wc, int fr, int fq) const {
    const int colt = u.pn * 256;
    EPI_LOOP_BEGIN
      u32x4 w; w.x = cvtpk(v0[0], v0[1]); w.y = cvtpk(v0[2], v0[3]); w.z = cvtpk(v1[0], v1[1]); w.w = cvtpk(v1[2], v1[3]);
      *(u32x4*)(O + (size_t)row * DM + colt + cl) = w;
    EPI_LOOP_END
  } };
DEVI float silu_fast(float v) { return v * __builtin_amdgcn_rcpf(1.f + __expf(-v)); }
struct EpiSwiGLU { static constexpr bool PERM = true, AFTER_DRAIN = false; bf16_t* O;
  DEVI void operator()(const f32x4 (&acc)[2][2][4][2], const Unit& u, int wr, int wc, int fr, int fq) const {
    const int colt = (u.pn & 7) * 256;
    EPI_LOOP_BEGIN
      u32x2 w; w.x = cvtpk(silu_fast(v0[0]) * v0[1], silu_fast(v0[2]) * v0[3]); w.y = cvtpk(silu_fast(v1[0]) * v1[1], silu_fast(v1[2]) * v1[3]);
      *(u32x2*)(O + (size_t)row * DM + ((colt + cl) >> 1)) = w;
    EPI_LOOP_END
  } };
struct EpiSwiGLU8 { static constexpr bool PERM = true, AFTER_DRAIN = false; unsigned char* O;
  DEVI void operator()(const f32x4 (&acc)[2][2][4][2], const Unit& u, int wr, int wc, int fr, int fq) const {
    const int colt = (u.pn & 7) * 256;
    EPI_LOOP_BEGIN
      const unsigned w = nv::pack4_fp8(silu_fast(v0[0]) * v0[1] * nv::A8_SCALE, silu_fast(v0[2]) * v0[3] * nv::A8_SCALE, silu_fast(v1[0]) * v1[1] * nv::A8_SCALE, silu_fast(v1[2]) * v1[3] * nv::A8_SCALE);
      *(unsigned*)(O + (size_t)row * DM + ((colt + cl) >> 1)) = w;
    EPI_LOOP_END
  } };
struct EpiDown { static constexpr bool PERM = true, AFTER_DRAIN = false; bf16_t* O;
  DEVI void operator()(const f32x4 (&acc)[2][2][4][2], const Unit& u, int wr, int wc, int fr, int fq) const {
    const int colt = (u.pn & 3) * 256;
    EPI_LOOP_BEGIN
      u32x4 w; w.x = cvtpk(v0[0], v0[1]); w.y = cvtpk(v0[2], v0[3]); w.z = cvtpk(v1[0], v1[1]); w.w = cvtpk(v1[2], v1[3]);
      *(u32x4*)(O + (size_t)row * DM + colt + cl) = w;
    EPI_LOOP_END
  } };
struct ExpOrder : pg8::StaticOrder { int nMe, nNe;
  __device__ void init2(int erows, int Ne, int G_, int c_) { nMe = erows / 256; nNe = Ne / 256; init(NE * erows, Ne, G_, c_); }
  __device__ bool next(int i, Unit& u) const { if (!pg8::StaticOrder::next(i, u)) return false; u.pn += (u.pm / nMe) * nNe; return true; } };

typedef PG8_LAS unsigned char* ldsp_t;
DEVI void phase_qkv0(const Params& p, ldsp_t lds) {
  pg8::Gemm g{(const bf16_t*)(p.ws + WS_H), (const bf16_t*)(p.ws + WS_WIN0), NROW, N_IN0, DM, nullptr, nv::W8_E8M0, nv::A8_E8M0}; pg8::StaticOrder S; S.init(NROW, N_IN0, gridDim.x, blockIdx.x);
  PG8_LAS float* RL = (PG8_LAS float*)(lds + pg8::STAGE_BYTES);
  for (int i = ftid(); i < 64 * 16 * 2; i += NT) RL[i] = ((const float*)(p.ws + WS_CTL + CTL_ROPE))[i];
  __syncthreads();
  EpiQKV0 E{(bf16_t*)(p.ws + WS_QKV0), RL, (unsigned char*)(p.ws + WS_VT), (unsigned char*)(p.ws + WS_VTB)};
  pg8::gemm_phase<EpiQKV0, pg8::StaticOrder, true, true, (QKV0_FP8 != 0)>(lds, g, S, E);
}
DEVI void phase_qkv1(const Params& p, ldsp_t lds) {
  pg8::Gemm g{(const bf16_t*)(p.ws + WS_H), (const bf16_t*)(p.ws + WS_WIN1), NROW, N_IN1P, DM, nullptr, nv::W8_E8M0, nv::A8_E8M0}; pg8::StaticOrder S; S.init(NROW, N_IN1P, gridDim.x, blockIdx.x);
  PG8_LAS float* RL = (PG8_LAS float*)(lds + pg8::STAGE_BYTES);
  for (int i = ftid(); i < 64 * 16 * 2; i += NT) RL[i] = ((const float*)(p.ws + WS_CTL + CTL_ROPE))[i];
  __syncthreads();
  EpiQKV1 E{(bf16_t*)(p.ws + WS_P1), (float*)(p.ws + WS_DT), RL};
  pg8::gemm_phase<EpiQKV1, pg8::StaticOrder, true, true, (QKV1_FP8 != 0)>(lds, g, S, E);
}
DEVI void phase_outproj(const Params& p, ldsp_t lds, int layer) {
  const int M = layer ? NLAT : NROW;
  pg8::Gemm g{(const bf16_t*)(p.ws + (layer ? WS_ATT1 : WS_ATT0)), (const bf16_t*)(p.ws + (layer ? WS_WOUT1 : WS_WOUT0)), M, DM, DM, nullptr, nv::W8_E8M0, nv::A8_E8M0}; pg8::StaticOrder S; S.init(M, DM, gridDim.x, blockIdx.x);
  EpiPlain E{(bf16_t*)(p.ws + (layer ? WS_MIX1 : WS_MIX0))};
  pg8::gemm_phase<EpiPlain, pg8::StaticOrder, true, true, (OUT_FP8 != 0)>(lds, g, S, E);
}
DEVI void phase_moe_up(const Params& p, ldsp_t lds, int layer) {
  const int erows = layer ? EROWS1 : EROWS0;
  pg8::Gemm g{(const bf16_t*)(p.ws + WS_H), (const bf16_t*)(p.ws + WS_WGU), NE * erows, 2048, DM, (const int*)(p.ws + WS_IDX)}; ExpOrder S; S.init2(erows, 2048, gridDim.x, blockIdx.x);
  EpiSwiGLU E{(bf16_t*)(p.ws + WS_HID)};
  pg8::gemm_phase<EpiSwiGLU, ExpOrder, true, true>(lds, g, S, E);
}
DEVI void phase_moe_down(const Params& p, ldsp_t lds, int layer) {
  const int erows = layer ? EROWS1 : EROWS0;
  pg8::Gemm g{(const bf16_t*)(p.ws + WS_HID), (const bf16_t*)(p.ws + WS_WD), NE * erows, DM, DM}; ExpOrder S; S.init2(erows, DM, gridDim.x, blockIdx.x);
  EpiDown E{(bf16_t*)(p.ws + WS_Y)};
  pg8::gemm_phase<EpiDown, ExpOrder, true, true>(lds, g, S, E);
}
DEVI void phase_moe_up8(const Params& p, ldsp_t lds, int layer) {
  const int erows = layer ? EROWS1 : EROWS0;
  pg8::Gemm g{(const bf16_t*)(p.ws + WS_H), (const bf16_t*)(p.ws + WS_WGU), NE * erows, 2048, DM, (const int*)(p.ws + WS_IDX), nv::W8_E8M0, nv::A8_E8M0}; ExpOrder S; S.init2(erows, 2048, gridDim.x, blockIdx.x);
  EpiSwiGLU8 E{(unsigned char*)(p.ws + WS_HID)};
  pg8::gemm_phase<EpiSwiGLU8, ExpOrder, true, FP8_SP2, true>(lds, g, S, E);
}
DEVI void phase_moe_down8(const Params& p, ldsp_t lds, int layer) {
  const int erows = layer ? EROWS1 : EROWS0;
  pg8::Gemm g{(const bf16_t*)(p.ws + WS_HID), (const bf16_t*)(p.ws + WS_WD), NE * erows, DM, DM, nullptr, nv::W8_E8M0, nv::A8_E8M0}; ExpOrder S; S.init2(erows, DM, gridDim.x, blockIdx.x);
  EpiDown E{(bf16_t*)(p.ws + WS_Y)};
  pg8::gemm_phase<EpiDown, ExpOrder, true, FP8_SP2, true>(lds, g, S, E);
}
DEVI void phase_gather(const Params& p, int layer) {
  const int lane = ftid() & 63, gw = blockIdx.x * NWAVE + (ftid() >> 6), NGW = gridDim.x * NWAVE;
  const int erows = layer ? EROWS1 : EROWS0; const int* IDX = (const int*)(p.ws + WS_IDX);
  const bf16_t* H = (const bf16_t*)(p.ws + WS_H); bf16_t* XG = (bf16_t*)(p.ws + WS_XG);
  for (int r = gw; r < NE * erows; r += NGW) {
    const uint4* s = (const uint4*)(H + (size_t)IDX[r] * DM) + lane; uint4* d = (uint4*)(XG + (size_t)r * DM) + lane;
    const uint4 a = s[0], b = s[64]; d[0] = a; d[64] = b;
  }
}
}
#ifndef ATTNA_FP8
#define ATTNA_FP8 1
#endif
namespace fa {
#define FA_LAS __attribute__((address_space(3)))
typedef short bf16x8 __attribute__((ext_vector_type(8)));
typedef short s16x4 __attribute__((ext_vector_type(4)));
typedef float f32x16 __attribute__((ext_vector_type(16)));
typedef FA_LAS unsigned char* ldsp_t;
typedef unsigned u32x4 __attribute__((ext_vector_type(4)));
constexpr float LOG2E = 1.4426950408889634f, C2 = 0.125f * LOG2E;
DEVI int crow(int r, int hi) { return (r & 3) + 8 * (r >> 2) + 4 * hi; }
DEVI unsigned cvtpk(float lo, float hi) { typedef float f2_t __attribute__((ext_vector_type(2))); typedef __bf16 b2_t __attribute__((ext_vector_type(2))); const f2_t v = {lo, hi}; const b2_t b = __builtin_convertvector(v, b2_t); return __builtin_bit_cast(unsigned, b); }
DEVI s16x4 vtr(ldsp_t p) { return __builtin_bit_cast(s16x4, __builtin_amdgcn_ds_read_tr16_b64_v4i16((FA_LAS s16x4*)p)); }

DEVI float max3f(float a, float b, float c) { float r; asm("v_max3_f32 %0, %1, %2, %3" : "=v"(r) : "v"(a), "v"(b), "v"(c)); return r; }
template <int KW, int DVB> struct Geo {
  static constexpr int VW = DVB * 32;
  static constexpr int KSTR = KW * 2 + 16, VSTR = VW * 2 + 64;
  static constexpr int KBYTES = 64 * KSTR, VBYTES = 64 * VSTR, STAGE = KBYTES + VBYTES;
  static constexpr int CPR = (KW + VW) / 8, NCH = 64 * CPR / NT;
};

DEVI bf16x8 load_q8(const bf16_t* p, float sc) {
  const uint4 w = *(const uint4*)p; const unsigned u[4] = {w.x, w.y, w.z, w.w}; unsigned o[4];
#pragma unroll
  for (int i = 0; i < 4; ++i) o[i] = cvtpk(__uint_as_float(u[i] << 16) * sc, __uint_as_float(u[i] & 0xffff0000u) * sc);
  uint4 r = make_uint4(o[0], o[1], o[2], o[3]); return __builtin_bit_cast(bf16x8, r);
}

template <int KW, int DVB, class Src, class Act, class Msk>
DEVI void flash_pass(ldsp_t lds, int ntiles, const bf16_t* kv, int ld, int kcol, int vcol, const bf16x8 (&q)[4], int kofs,
                     Src src, Act act, Msk msk, f32x16 (&o)[DVB], float& m, float& l) {
  typedef Geo<KW, DVB> G;
  const int tid = ftid(), lane = tid & 63, r32 = lane & 31, hi = lane >> 5;
  u32x4 stg[G::NCH];
  int crw[G::NCH], ccol[G::NCH], cdst[G::NCH];
#pragma unroll
  for (int i = 0; i < G::NCH; ++i) { const int c = tid + NT * i, row = c / G::CPR, cc = c % G::CPR; crw[i] = row;
    if (cc < KW / 8) { ccol[i] = kcol + cc * 8; cdst[i] = row * G::KSTR + cc * 16; } else { ccol[i] = vcol + (cc - KW / 8) * 8; cdst[i] = G::KBYTES + row * G::VSTR + (cc - KW / 8) * 16; } }
#pragma unroll
  for (int i = 0; i < G::NCH; ++i) stg[i] = *(const u32x4*)(kv + (size_t)src(0, crw[i]) * ld + ccol[i]);
#pragma unroll
  for (int i = 0; i < G::NCH; ++i) *(FA_LAS u32x4*)(lds + cdst[i]) = stg[i];
  __syncthreads();
  const int kroff = r32 * G::KSTR + (kofs + 8 * hi) * 2;
  const int vroff = G::KBYTES + (4 * hi + ((lane & 15) >> 2)) * G::VSTR + 32 * ((lane >> 4) & 1) + 8 * (lane & 3);
  for (int kt = 0; kt < ntiles; ++kt) {
    const int buf = (kt & 1) * G::STAGE;
    const bool more = kt + 1 < ntiles;
    if (more) {
#pragma unroll
      for (int i = 0; i < G::NCH; ++i) stg[i] = *(const u32x4*)(kv + (size_t)src(kt + 1, crw[i]) * ld + ccol[i]);
    }
    if (act(kt)) {
      const ldsp_t kb = lds + buf + kroff;
      f32x16 p0, p1;
#pragma unroll
      for (int r = 0; r < 16; ++r) { p0[r] = 0.f; p1[r] = 0.f; }
#pragma unroll
      for (int d0 = 0; d0 < 4; ++d0) {
        const bf16x8 a0 = *(const FA_LAS bf16x8*)(kb + d0 * 32), a1 = *(const FA_LAS bf16x8*)(kb + 32 * G::KSTR + d0 * 32);
        p0 = __builtin_amdgcn_mfma_f32_32x32x16_bf16(a0, q[d0], p0, 0, 0, 0);
        p1 = __builtin_amdgcn_mfma_f32_32x32x16_bf16(a1, q[d0], p1, 0, 0, 0);
      }
      msk(kt, p0, p1);
      float mx = fmaxf(p0[0], p1[0]);
#pragma unroll
      for (int r = 1; r < 16; ++r) mx = fmaxf(mx, fmaxf(p0[r], p1[r]));
      mx = fmaxf(mx, __shfl_xor(mx, 32));
      if (__any(mx > m)) {
        const float mn = fmaxf(m, mx), alpha = __builtin_amdgcn_exp2f(m - mn);
        l *= alpha; m = mn;
#pragma unroll
        for (int b = 0; b < DVB; ++b)
#pragma unroll
          for (int r = 0; r < 16; ++r) o[b][r] *= alpha;
      }
      float ls = 0.f;
#pragma unroll
      for (int r = 0; r < 16; ++r) { p0[r] = __builtin_amdgcn_exp2f(p0[r] - m); p1[r] = __builtin_amdgcn_exp2f(p1[r] - m); ls += p0[r] + p1[r]; }
      l += ls;
      bf16x8 pa[4];
      { uint4 t;
        t = make_uint4(cvtpk(p0[0], p0[1]), cvtpk(p0[2], p0[3]), cvtpk(p0[4], p0[5]), cvtpk(p0[6], p0[7])); pa[0] = __builtin_bit_cast(bf16x8, t);
        t = make_uint4(cvtpk(p0[8], p0[9]), cvtpk(p0[10], p0[11]), cvtpk(p0[12], p0[13]), cvtpk(p0[14], p0[15])); pa[1] = __builtin_bit_cast(bf16x8, t);
        t = make_uint4(cvtpk(p1[0], p1[1]), cvtpk(p1[2], p1[3]), cvtpk(p1[4], p1[5]), cvtpk(p1[6], p1[7])); pa[2] = __builtin_bit_cast(bf16x8, t);
        t = make_uint4(cvtpk(p1[8], p1[9]), cvtpk(p1[10], p1[11]), cvtpk(p1[12], p1[13]), cvtpk(p1[14], p1[15])); pa[3] = __builtin_bit_cast(bf16x8, t); }
      const ldsp_t vb = lds + buf + vroff;
#pragma unroll
      for (int b = 0; b < DVB; ++b)
#pragma unroll
        for (int ks = 0; ks < 4; ++ks) {
          const s16x4 lo = vtr(vb + (16 * ks) * G::VSTR + b * 64), h8 = vtr(vb + (16 * ks + 8) * G::VSTR + b * 64);
          const bf16x8 vf = {lo[0], lo[1], lo[2], lo[3], h8[0], h8[1], h8[2], h8[3]};
          o[b] = __builtin_amdgcn_mfma_f32_32x32x16_bf16(vf, pa[ks], o[b], 0, 0, 0);
        }
    }
    if (more) {
      const int nb = ((kt + 1) & 1) * G::STAGE;
#pragma unroll
      for (int i = 0; i < G::NCH; ++i) *(FA_LAS u32x4*)(lds + nb + cdst[i]) = stg[i];
    }
    __syncthreads();
  }
}


template <int V> struct IC { static constexpr int value = V; };
template <int KW, int DVB, int ABL, int PF, class Src, class Msk>
DEVI void flash_pass2(ldsp_t lds, int ntiles, const bf16_t* kv, int ld, int kcol, int vcol, const bf16x8 (&q)[4], int kofs,
                      Src src, Msk msk, f32x16 (&o)[DVB], float& m, float& l) {
  typedef Geo<KW, DVB> G;
  const int tid = ftid(), lane = tid & 63, r32 = lane & 31, hi = lane >> 5;
  u32x4 stg[PF][G::NCH];
  int crw[G::NCH], ccol[G::NCH], cdst[G::NCH];
#pragma unroll
  for (int i = 0; i < G::NCH; ++i) { const int c = tid + NT * i, row = c / G::CPR, cc = c % G::CPR; crw[i] = row;
    if (cc < KW / 8) { ccol[i] = kcol + cc * 8; cdst[i] = row * G::KSTR + cc * 16; } else { ccol[i] = vcol + (cc - KW / 8) * 8; cdst[i] = G::KBYTES + row * G::VSTR + (cc - KW / 8) * 16; } }
#define FP2_LOAD(kt, set) _Pragma("unroll") for (int i = 0; i < G::NCH; ++i) stg[set][i] = *(const u32x4*)(kv + (size_t)src((kt), crw[i]) * ld + ccol[i])
#define FP2_STORE(st, set) _Pragma("unroll") for (int i = 0; i < G::NCH; ++i) *(FA_LAS u32x4*)(lds + (st) * G::STAGE + cdst[i]) = stg[set][i]
  FP2_LOAD(0, 0); FP2_STORE(0, 0);
  if (ntiles > 1) { FP2_LOAD(1, 0); FP2_STORE(1, 0); }
  __syncthreads();
  if (ntiles > 2) FP2_LOAD(2, 0);
  if (PF == 2) { if (ntiles > 3) FP2_LOAD(3, PF - 1); }
  const int kroff = r32 * G::KSTR + (kofs + 8 * hi) * 2;
  const int vroff = G::KBYTES + (4 * hi + ((lane & 15) >> 2)) * G::VSTR + 32 * ((lane >> 4) & 1) + 8 * (lane & 3);
  f32x16 c0, c1;
#pragma unroll
  for (int r = 0; r < 16; ++r) { c0[r] = 0.f; c1[r] = 0.f; }
  { const ldsp_t kb = lds + kroff;
#pragma unroll
    for (int d0 = 0; d0 < 4; ++d0) {
      const bf16x8 a0 = *(const FA_LAS bf16x8*)(kb + d0 * 32), a1 = *(const FA_LAS bf16x8*)(kb + 32 * G::KSTR + d0 * 32);
      c0 = __builtin_amdgcn_mfma_f32_32x32x16_bf16(a0, q[d0], c0, 0, 0, 0); c1 = __builtin_amdgcn_mfma_f32_32x32x16_bf16(a1, q[d0], c1, 0, 0, 0); } }
  asm volatile("s_nop 15\n\ts_nop 7" : "+v"(c0), "+v"(c1));
  int st_cur = 0, st_nxt = 1, st_fill = 2;
  auto body = [&](int kt, auto PARC) {
    constexpr int set = (PF == 2) ? decltype(PARC)::value : 0;
    msk(kt, c0, c1);
    __builtin_amdgcn_sched_barrier(0);
    f32x16 n0, n1;
#pragma unroll
    for (int r = 0; r < 16; ++r) { n0[r] = 0.f; n1[r] = 0.f; }
    const ldsp_t kb = lds + st_nxt * G::STAGE + kroff;
    bf16x8 ka[4], kb2[4];
#pragma unroll
    for (int d0 = 0; d0 < 4; ++d0) { ka[d0] = *(const FA_LAS bf16x8*)(kb + d0 * 32); kb2[d0] = *(const FA_LAS bf16x8*)(kb + 32 * G::KSTR + d0 * 32); }
#define FP2_SB() __builtin_amdgcn_sched_barrier(0)
#define FP2_MMA(acc, kf, d0) acc = __builtin_amdgcn_mfma_f32_32x32x16_bf16(kf[d0], q[d0], acc, 0, 0, 0)
#define FP2_EXP(cx, r) { if (ABL != 1) { cx[r] = __builtin_amdgcn_exp2f(cx[r] - mn); ls += cx[r]; } }
    FP2_SB(); FP2_MMA(n0, ka, 0);
    float mxa = max3f(c0[0], c0[1], c1[0]), mxb = max3f(c0[2], c0[3], c1[1]);
    mxa = max3f(mxa, c1[2], c1[3]);
    mxa = max3f(mxa, c0[4], c0[5]); mxb = max3f(mxb, c0[6], c0[7]); mxa = max3f(mxa, c1[4], c1[5]); mxb = max3f(mxb, c1[6], c1[7]);
    FP2_SB(); FP2_MMA(n1, kb2, 0);
    mxa = max3f(mxa, c0[8], c0[9]); mxb = max3f(mxb, c0[10], c0[11]); mxa = max3f(mxa, c1[8], c1[9]); mxb = max3f(mxb, c1[10], c1[11]);
    mxa = max3f(mxa, c0[12], c0[13]); mxb = max3f(mxb, c0[14], c0[15]); mxa = max3f(mxa, c1[12], c1[13]); mxb = max3f(mxb, c1[14], c1[15]);
    float mx = max3f(mxa, mxb, m);
    mx = max3f(mx, __shfl_xor(mx, 32), mx);
    const float mn = mx, alpha = __builtin_amdgcn_exp2f(m - mn);
    const bool resc = __any(mn > m);
    m = mn;
    float ls = 0.f;
    FP2_SB(); FP2_MMA(n0, ka, 1);
    FP2_EXP(c0, 0) FP2_EXP(c0, 1) FP2_EXP(c0, 2) FP2_EXP(c0, 3) FP2_EXP(c0, 4) FP2_EXP(c0, 5)
    FP2_SB(); FP2_MMA(n1, kb2, 1);
    FP2_EXP(c0, 6) FP2_EXP(c0, 7) FP2_EXP(c0, 8) FP2_EXP(c0, 9) FP2_EXP(c0, 10) FP2_EXP(c0, 11)
    FP2_SB(); FP2_MMA(n0, ka, 2);
    FP2_EXP(c0, 12) FP2_EXP(c0, 13) FP2_EXP(c0, 14) FP2_EXP(c0, 15) FP2_EXP(c1, 0) FP2_EXP(c1, 1)
    FP2_SB(); FP2_MMA(n1, kb2, 2);
    FP2_EXP(c1, 2) FP2_EXP(c1, 3) FP2_EXP(c1, 4) FP2_EXP(c1, 5) FP2_EXP(c1, 6) FP2_EXP(c1, 7)
    FP2_SB(); FP2_MMA(n0, ka, 3);
    FP2_EXP(c1, 8) FP2_EXP(c1, 9) FP2_EXP(c1, 10) FP2_EXP(c1, 11) FP2_EXP(c1, 12) FP2_EXP(c1, 13)
    FP2_SB(); FP2_MMA(n1, kb2, 3);
    FP2_EXP(c1, 14) FP2_EXP(c1, 15)
    bf16x8 pa[4];
    { u32x4 t;
      t[0] = cvtpk(c0[0], c0[1]); t[1] = cvtpk(c0[2], c0[3]); t[2] = cvtpk(c0[4], c0[5]); t[3] = cvtpk(c0[6], c0[7]); pa[0] = __builtin_bit_cast(bf16x8, t);
      t[0] = cvtpk(c0[8], c0[9]); t[1] = cvtpk(c0[10], c0[11]); t[2] = cvtpk(c0[12], c0[13]); t[3] = cvtpk(c0[14], c0[15]); pa[1] = __builtin_bit_cast(bf16x8, t);
      t[0] = cvtpk(c1[0], c1[1]); t[1] = cvtpk(c1[2], c1[3]); t[2] = cvtpk(c1[4], c1[5]); t[3] = cvtpk(c1[6], c1[7]); pa[2] = __builtin_bit_cast(bf16x8, t);
      t[0] = cvtpk(c1[8], c1[9]); t[1] = cvtpk(c1[10], c1[11]); t[2] = cvtpk(c1[12], c1[13]); t[3] = cvtpk(c1[14], c1[15]); pa[3] = __builtin_bit_cast(bf16x8, t); }
    asm volatile("" : "+v"(pa[0]), "+v"(pa[1]), "+v"(pa[2]), "+v"(pa[3]));
    FP2_SB();
    l = l * alpha + ls;
    __builtin_amdgcn_sched_barrier(0);
    if (resc) {
#pragma unroll
      for (int b = 0; b < DVB; ++b)
#pragma unroll
        for (int r = 0; r < 16; ++r) o[b][r] *= alpha;
    }
    const ldsp_t vb = lds + st_cur * G::STAGE + vroff;
    s16x4 vl[2][DVB], vh[2][DVB];
#pragma unroll
    for (int b = 0; b < DVB; ++b) { vl[0][b] = vtr(vb + b * 64); vh[0][b] = vtr(vb + 8 * G::VSTR + b * 64); }
#pragma unroll
    for (int ks = 0; ks < 4; ++ks) {
      FP2_SB();
      if (ks < 3) {
#pragma unroll
        for (int b = 0; b < DVB; ++b) { vl[(ks + 1) & 1][b] = vtr(vb + (16 * (ks + 1)) * G::VSTR + b * 64); vh[(ks + 1) & 1][b] = vtr(vb + (16 * (ks + 1) + 8) * G::VSTR + b * 64); }
      }
      FP2_SB();
#pragma unroll
      for (int b = 0; b < DVB; ++b) {
        const s16x4 lo = vl[ks & 1][b], h8 = vh[ks & 1][b];
        const bf16x8 vf = {lo[0], lo[1], lo[2], lo[3], h8[0], h8[1], h8[2], h8[3]};
        if (ABL != 2) o[b] = __builtin_amdgcn_mfma_f32_32x32x16_bf16(vf, pa[ks], o[b], 0, 0, 0); else o[b][0] += __builtin_bit_cast(float, (int)vf[0]);
      }
    }
    FP2_SB();
    if (ABL != 3) { if (kt + 2 < ntiles) FP2_STORE(st_fill, set); }
    __syncthreads();
    if (ABL != 3) { if (kt + 2 + PF < ntiles) FP2_LOAD(kt + 2 + PF, set); }
    c0 = n0; c1 = n1;
    { const int t = st_cur; st_cur = st_nxt; st_nxt = st_fill; st_fill = t; }
  };
  if (PF == 2) { for (int kt = 0; kt < ntiles; kt += 2) { body(kt, IC<0>{}); if (kt + 1 < ntiles) body(kt + 1, IC<1>{}); } }
  else { for (int kt = 0; kt < ntiles; ++kt) body(kt, IC<0>{}); }
#undef FP2_LOAD
#undef FP2_STORE
}


typedef int v8i_t __attribute__((ext_vector_type(8)));
DEVI v8i_t cat8(const u32x4& x, const u32x4& y) { return (v8i_t){(int)x[0], (int)x[1], (int)x[2], (int)x[3], (int)y[0], (int)y[1], (int)y[2], (int)y[3]}; }
template <int DVB, int KROW, bool PIPE, class Src, class VKey, class Msk>
DEVI void flash_pass8(ldsp_t lds, int ntiles, const unsigned char* k8, int ldb, int kcolb, const unsigned char* vt, const v8i_t& qf, int ksub,
                      Src src, VKey vkey, Msk msk, f32x16 (&o)[DVB], float& m, float& l) {
  constexpr int A8_KSTR = KROW + 16, A8_VSTR = 80, A8_KB = 64 * A8_KSTR, A8_STAGE = A8_KB + DVB * 32 * A8_VSTR;
  constexpr int KPR = KROW / 16, NKC = 64 * KPR, NCHT = (NKC + DVB * 32 * 4) / NT;
  const int tid = ftid(), lane = tid & 63, r32 = lane & 31, hi = lane >> 5;
  u32x4 stg[NCHT];
#define A8_ISK(i_, c_) ((NKC % NT == 0) ? ((i_) < NKC / NT) : ((c_) < NKC))
#define A8_LOAD(kt) do { const int sb_ = src((kt), 0), vk_ = vkey(kt); _Pragma("unroll") for (int i_ = 0; i_ < NCHT; ++i_) { const int c_ = tid + NT * i_; \
      if (A8_ISK(i_, c_)) stg[i_] = *(const u32x4*)(k8 + (size_t)(sb_ + c_ / KPR) * ldb + kcolb + (c_ % KPR) * 16); \
      else { const int cv_ = c_ - NKC; stg[i_] = *(const u32x4*)(vt + (size_t)(cv_ >> 2) * 4352 + vk_ + (cv_ & 3) * 16); } } } while (0)
#define A8_STORE(st) do { _Pragma("unroll") for (int i_ = 0; i_ < NCHT; ++i_) { const int c_ = tid + NT * i_; \
      if (A8_ISK(i_, c_)) *(FA_LAS u32x4*)(lds + (st) * A8_STAGE + (c_ / KPR) * A8_KSTR + (c_ % KPR) * 16) = stg[i_]; \
      else { const int cv_ = c_ - NKC; *(FA_LAS u32x4*)(lds + (st) * A8_STAGE + A8_KB + (cv_ >> 2) * A8_VSTR + (cv_ & 3) * 16) = stg[i_]; } } } while (0)
#define A8_QK(dst, st, half) do { const ldsp_t kp_ = lds + (st) * A8_STAGE + kroff + (half) * 32 * A8_KSTR; f32x16 z_; _Pragma("unroll") for (int r_ = 0; r_ < 16; ++r_) z_[r_] = 0.f; \
    const u32x4 k0_ = *(const FA_LAS u32x4*)kp_, k1_ = *(const FA_LAS u32x4*)(kp_ + 16); \
    dst = __builtin_amdgcn_mfma_scale_f32_32x32x64_f8f6f4(cat8(k0_, k1_), qf, z_, 0, 0, 0, 0x7d7d7d7d  , 0, 0x7b7b7b7b  ); } while (0)
  A8_LOAD(0); A8_STORE(0);
  if (ntiles > 1) { A8_LOAD(1); A8_STORE(1); }
  __syncthreads();
  if (ntiles > 2) A8_LOAD(2);
  const int kroff = r32 * A8_KSTR + 64 * ksub + 32 * hi;
  const int vroff = A8_KB + r32 * A8_VSTR + 32 * hi;
  f32x16 c0, c1;
  if (PIPE) { A8_QK(c0, 0, 0); A8_QK(c1, 0, 1);
    asm volatile("s_nop 15\n\ts_nop 7" : "+v"(c0), "+v"(c1)); }
  int st_cur = 0, st_nxt = 1, st_fill = 2;
  for (int kt = 0; kt < ntiles; ++kt) {
    if (!PIPE) { A8_QK(c0, st_cur, 0); A8_QK(c1, st_cur, 1); asm volatile("s_nop 15\n\ts_nop 7" : "+v"(c0), "+v"(c1)); }
    msk(kt, c0, c1);
    __builtin_amdgcn_sched_barrier(0);
    f32x16 n0, n1;
#define A8_SB() __builtin_amdgcn_sched_barrier(0)
#define A8_EXP(cx, r) { cx[r] = __builtin_amdgcn_exp2f(cx[r] - mn); ls += cx[r]; }
    A8_SB(); if (PIPE) A8_QK(n0, st_nxt, 0);
    float mxa = max3f(c0[0], c0[1], c1[0]), mxb = max3f(c0[2], c0[3], c1[1]);
    mxa = max3f(mxa, c1[2], c1[3]);
    mxa = max3f(mxa, c0[4], c0[5]); mxb = max3f(mxb, c0[6], c0[7]); mxa = max3f(mxa, c1[4], c1[5]); mxb = max3f(mxb, c1[6], c1[7]);
    A8_SB(); if (PIPE) A8_QK(n1, st_nxt, 1);
    mxa = max3f(mxa, c0[8], c0[9]); mxb = max3f(mxb, c0[10], c0[11]); mxa = max3f(mxa, c1[8], c1[9]); mxb = max3f(mxb, c1[10], c1[11]);
    mxa = max3f(mxa, c0[12], c0[13]); mxb = max3f(mxb, c0[14], c0[15]); mxa = max3f(mxa, c1[12], c1[13]); mxb = max3f(mxb, c1[14], c1[15]);
    float mx = max3f(mxa, mxb, mxb);
    mx = max3f(mx, __shfl_xor(mx, 32), mx);
    const bool up = mx > m + 8.f;
    const float mn = up ? mx - 4.f : m, alpha = __builtin_amdgcn_exp2f(m - mn);
    const bool resc = __any(up);
    m = mn;
    float ls = 0.f;
    A8_SB();
#pragma unroll
    for (int r = 0; r < 16; ++r) A8_EXP(c0, r)
#pragma unroll
    for (int r = 0; r < 16; ++r) A8_EXP(c1, r)
    unsigned X[4], Y[4];
#pragma unroll
    for (int i = 0; i < 4; ++i) {
      int w, z; asm volatile("" : "=v"(w)); asm volatile("" : "=v"(z));
      w = __builtin_amdgcn_cvt_pk_fp8_f32(c0[4 * i], c0[4 * i + 1], w, false); w = __builtin_amdgcn_cvt_pk_fp8_f32(c0[4 * i + 2], c0[4 * i + 3], w, true); X[i] = (unsigned)w;
      z = __builtin_amdgcn_cvt_pk_fp8_f32(c1[4 * i], c1[4 * i + 1], z, false); z = __builtin_amdgcn_cvt_pk_fp8_f32(c1[4 * i + 2], c1[4 * i + 3], z, true); Y[i] = (unsigned)z; }
#pragma unroll
    for (int i = 0; i < 4; ++i) { const auto rr = __builtin_amdgcn_permlane32_swap(X[i], Y[i], false, false); X[i] = rr[0]; Y[i] = rr[1]; }
    v8i_t pb = {(int)X[0], (int)X[1], (int)X[2], (int)X[3], (int)Y[0], (int)Y[1], (int)Y[2], (int)Y[3]};
    asm volatile("" : "+v"(pb));
    A8_SB();
    l = l * alpha + ls;
    __builtin_amdgcn_sched_barrier(0);
    if (resc) {
#pragma unroll
      for (int b = 0; b < DVB; ++b)
#pragma unroll
        for (int r = 0; r < 16; ++r) o[b][r] *= alpha;
    }
    { const ldsp_t vb = lds + st_cur * A8_STAGE + vroff;
      u32x4 v0[DVB], v1[DVB];
#pragma unroll
      for (int b = 0; b < DVB; ++b) { v0[b] = *(const FA_LAS u32x4*)(vb + b * 32 * A8_VSTR); v1[b] = *(const FA_LAS u32x4*)(vb + b * 32 * A8_VSTR + 16); }
#pragma unroll
      for (int b = 0; b < DVB; ++b) o[b] = __builtin_amdgcn_mfma_scale_f32_32x32x64_f8f6f4(cat8(v0[b], v1[b]), pb, o[b], 0, 0, 0, 0x7d7d7d7d  , 0, 0x7b7b7b7b  );
    }
    A8_SB();
    if (kt + 2 < ntiles) A8_STORE(st_fill);
    __syncthreads();
    if (kt + 3 < ntiles) A8_LOAD(kt + 3);
    if (PIPE) { c0 = n0; c1 = n1; }
    { const int t = st_cur; st_cur = st_nxt; st_nxt = st_fill; st_fill = t; }
  }
  l *= 0.0625f;
#undef A8_ISK
#undef A8_LOAD
#undef A8_STORE
#undef A8_QK
#undef A8_SB
#undef A8_EXP
}

#ifndef OUT_FP8
#define OUT_FP8 1
#endif
DEVI void st_att4(bf16_t* ATT, size_t row, int col, float a, float b, float c, float d) {
  if (OUT_FP8) *(unsigned*)((unsigned char*)ATT + row * DM + col) = nv::pack4_fp8(a * 4.f, b * 4.f, c * 4.f, d * 4.f);
  else { uint2 w; w.x = cvtpk(a, b); w.y = cvtpk(c, d); *(uint2*)(ATT + row * DM + col) = w; }
}
DEVI int vblock() { const int G = gridDim.x, bx = blockIdx.x; return (G % 8 == 0) ? (bx % 8) * (G / 8) + bx / 8 : bx; }

template <int ABL = 0> DEVI void phase_attnA(const Params& p, ldsp_t lds) {
  typedef Geo<128, 4> G;
  const int tid = ftid(), lane = tid & 63, wave = __builtin_amdgcn_readfirstlane(tid >> 6), r32 = lane & 31, hi = lane >> 5;
  const bf16_t* Q = (const bf16_t*)(p.ws + WS_QKV0); bf16_t* ATT = (bf16_t*)(p.ws + (ABL ? WS_MIX0 : WS_ATT0));
  const float lam = ((const float*)(p.ws + WS_CTL + CTL_LAM))[0];
  const int s = wave >> 2, qb = wave & 3;
  constexpr int NU_LAT = NB * 4 * 32, NU_CTX = NB * 4 * 2;
  for (int u = vblock(); u < NU_LAT + NU_CTX; u += gridDim.x) {
    int b, h, row0, ntiles; bool lat = u < NU_LAT;
    if (lat) { b = u >> 7; h = (u >> 5) & 3; row0 = b * SEQ + (u & 31) * 128; ntiles = 68; }
    else { const int v = u - NU_LAT; b = v >> 3; h = (v >> 1) & 3; row0 = NLAT + b * CTXL + (v & 1) * 128; ntiles = 4; }
    const int qrow = row0 + qb * 32 + r32;
    bf16x8 q[4];
#pragma unroll
    for (int d0 = 0; d0 < 4; ++d0) q[d0] = load_q8(Q + (size_t)qrow * N_IN0 + h * 128 + s * 64 + 16 * d0 + 8 * hi, C2);
    f32x16 o[4];
#pragma unroll
    for (int bk = 0; bk < 4; ++bk)
#pragma unroll
      for (int r = 0; r < 16; ++r) o[bk][r] = 0.f;
    float m = -1e30f, l = 0.f;
    const int cbase = NLAT + b * CTXL, lbase = b * SEQ;
#if ATTNA_FP8
    const unsigned char* QK8 = (const unsigned char*)(p.ws + WS_QKV0);
    v8i_t qf;
    { const unsigned char* qp = QK8 + (size_t)qrow * (N_IN0 * 2) + h * 128 + s * 64 + 32 * hi; const u32x4 q0_ = *(const u32x4*)qp, q1_ = *(const u32x4*)(qp + 16); qf = cat8(q0_, q1_); }
    flash_pass8<4, 128, true>(lds, ntiles, QK8, N_IN0 * 2, 512 + h * 128, (const unsigned char*)(p.ws + WS_VT) + (size_t)((b * 4 + h) * 128) * 4352, qf, s,
      [&](int kt, int i) { return lat ? (kt < 64 ? lbase + kt * 64 + i : cbase + (kt - 64) * 64 + i) : cbase + kt * 64 + i; },
      [&](int kt) { return (lat ? 0 : 4096) + kt * 64; }, [&](int, f32x16&, f32x16&) {}, o, m, l);
#else
    flash_pass2<128, 4, ABL, 1>(lds, ntiles, Q, N_IN0, 512 + h * 128, 1024 + h * 128, q, s * 64,
      [&](int kt, int i) { return lat ? (kt < 64 ? lbase + kt * 64 + i : cbase + (kt - 64) * 64 + i) : cbase + kt * 64 + i; },
      [&](int, f32x16&, f32x16&) {}, o, m, l);
#endif
    l += __shfl_xor(l, 32);
    const float inv = 1.f / l;
    FA_LAS float* X = (FA_LAS float*)lds;
    if (s == 1) {
#pragma unroll
      for (int bk = 0; bk < 4; ++bk)
#pragma unroll
        for (int r = 0; r < 16; ++r) X[((qb * 4 + bk) * 16 + r) * 64 + lane] = o[bk][r] * inv;
    }
    __syncthreads();
    if (s == 0) {
      float ss = 0.f;
#pragma unroll
      for (int bk = 0; bk < 4; ++bk)
#pragma unroll
        for (int r = 0; r < 16; ++r) { const float d = o[bk][r] * inv - lam * X[((qb * 4 + bk) * 16 + r) * 64 + lane]; o[bk][r] = d; ss += d * d; }
      ss += __shfl_xor(ss, 32);
      const float rr = rsqrtf(ss * (1.f / 128.f) + EPS) * 0.8f;
      const float* g = p.in[L0_SUBLN];
#pragma unroll
      for (int bk = 0; bk < 4; ++bk)
#pragma unroll
        for (int rg = 0; rg < 4; ++rg) { const int dv = bk * 32 + 8 * rg + 4 * hi; const float4 gv = *(const float4*)(g + dv);
          st_att4(ATT, (size_t)qrow, h * 128 + dv, o[bk][4 * rg] * rr * gv.x, o[bk][4 * rg + 1] * rr * gv.y, o[bk][4 * rg + 2] * rr * gv.z, o[bk][4 * rg + 3] * rr * gv.w); }
    }
    __syncthreads();
  }
}

template <int ABL = 0> DEVI void phase_attnB(const Params& p, ldsp_t lds) {
  typedef Geo<64, 2> G;
  const int tid = ftid(), lane = tid & 63, wave = __builtin_amdgcn_readfirstlane(tid >> 6), r32 = lane & 31, hi = lane >> 5;
  const bf16_t* Q = (const bf16_t*)(p.ws + WS_QKV0); bf16_t* ATT = (bf16_t*)(p.ws + (ABL ? WS_MIX0 : WS_ATT0));
  constexpr int NU_LAT = NB * 8 * 16, NU_CTX = NB * 8;
  FA_LAS float* RPB = (FA_LAS float*)(lds + 3 * (64 * 80 + 64 * 80));
  for (int u = vblock(); u < NU_LAT + NU_CTX; u += gridDim.x) {
    const bool lat = u < NU_LAT;
    int b, h, qrow_g = 0, c0 = 0, rlo = 0, nlat = 0, rs_w = 0, grow;
    if (lat) { b = u >> 7; h = (u >> 4) & 7; const int qr0 = (u & 15) * 4; qrow_g = qr0 + (wave >> 1); c0 = 32 * (wave & 1);
      rlo = min(max(qr0 - 4, 0), 56); const int rhi = min(max(qr0 - 1, 0), 56) + 7; nlat = rhi - rlo + 1; rs_w = min(max(qrow_g - 4, 0), 56);
      grow = b * SEQ + qrow_g * 64 + c0 + r32; }
    else { const int v = u - NU_LAT; b = v >> 3; h = v & 7; grow = NLAT + b * CTXL + wave * 32 + r32; }
    const int ntiles = nlat + 4;
    for (int i = tid; i < 15 * 31; i += NT) RPB[i] = p.in[L0_RPB][h * 465 + i] * LOG2E;
    const unsigned char* QK8 = (const unsigned char*)(p.ws + WS_QKV0);
    v8i_t qf;
    { const unsigned char* qp = QK8 + (size_t)grow * (N_IN0 * 2) + 1536 + h * 64 + 32 * hi; const u32x4 q0_ = *(const u32x4*)qp, q1_ = *(const u32x4*)(qp + 16); qf = cat8(q0_, q1_); }
    f32x16 o[2];
#pragma unroll
    for (int bk = 0; bk < 2; ++bk)
#pragma unroll
      for (int r = 0; r < 16; ++r) o[bk][r] = 0.f;
    float m = -1e30f, l = 0.f;
    const int cbase = NLAT + b * CTXL, lbase = b * SEQ;
    const int qc = c0 + r32, cs = min(max(qc - 8, 0), 48);
    flash_pass8<2, 64, false>(lds, ntiles, QK8, N_IN0 * 2, 2048 + h * 64, (const unsigned char*)(p.ws + WS_VTB) + (size_t)((b * 8 + h) * 64) * 4352, qf, 0,
      [&](int kt, int i) { return kt < nlat ? lbase + (rlo + kt) * 64 + i : cbase + (kt - nlat) * 64 + i; },
      [&](int kt) { return kt < nlat ? (rlo + kt) * 64 : 4096 + (kt - nlat) * 64; },
      [&](int kt, f32x16& p0, f32x16& p1) {
        if (ABL != 1 && kt < nlat) { const int kr = rlo + kt; const bool rowok = (kr >= rs_w && kr < rs_w + 8);
          const FA_LAS float* bp = RPB + min(max(kr - qrow_g + 7, 0), 14) * 31;
          { float b0[16];
#pragma unroll
            for (int r = 0; r < 16; ++r) { const int k0 = crow(r, hi); b0[r] = bp[min(max(k0 - qc + 15, 0), 30)]; }
#pragma unroll
            for (int r = 0; r < 16; ++r) { const int k0 = crow(r, hi); const float v0 = p0[r] + b0[r]; p0[r] = (rowok && k0 >= cs && k0 < cs + 16) ? v0 : -INFINITY; } }
          asm volatile("" ::: "memory");
          { float b1[16];
#pragma unroll
            for (int r = 0; r < 16; ++r) { const int k1 = 32 + crow(r, hi); b1[r] = bp[min(max(k1 - qc + 15, 0), 30)]; }
#pragma unroll
            for (int r = 0; r < 16; ++r) { const int k1 = 32 + crow(r, hi); const float v1 = p1[r] + b1[r]; p1[r] = (rowok && k1 >= cs && k1 < cs + 16) ? v1 : -INFINITY; } } } },
      o, m, l);
    l += __shfl_xor(l, 32);
    const float inv = 1.f / l;
#pragma unroll
    for (int bk = 0; bk < 2; ++bk)
#pragma unroll
      for (int rg = 0; rg < 4; ++rg) { const int dv = bk * 32 + 8 * rg + 4 * hi;
        st_att4(ATT, (size_t)grow, 512 + h * 64 + dv, o[bk][4 * rg] * inv, o[bk][4 * rg + 1] * inv, o[bk][4 * rg + 2] * inv, o[bk][4 * rg + 3] * inv); }
    __syncthreads();
  }
}

DEVI void phase_attnC(const Params& p, ldsp_t lds, int* ctr) {
  const int tid = ftid(), lane = tid & 63, wave = __builtin_amdgcn_readfirstlane(tid >> 6), r32 = lane & 31, hi = lane >> 5;
  const bf16_t* P1 = (const bf16_t*)(p.ws + WS_P1); bf16_t* ATT = (bf16_t*)(p.ws + WS_ATT1);
  FA_LAS int* uq = (FA_LAS int*)(lds + 3 * Geo<64, 2>::STAGE + 64);
  for (;;) {
    if (tid == 0) *uq = atomicAdd(ctr, 1);
    __syncthreads();
    const int u = *uq;
    __syncthreads();
    if (u >= NB * 2 * 64) break;
    const int b = u >> 7, g = (u >> 6) & 1, tq = u & 63, hq = g * 4 + (wave >> 1), t = tq * 64 + 32 * (wave & 1) + r32, grow = b * SEQ + t;
    const int klo = max(tq - 2, 0), khi = min(tq + 2, 63), nwin = khi - klo + 1, ntiles = nwin + 4;
    bf16x8 q[4];
#pragma unroll
    for (int d0 = 0; d0 < 4; ++d0) q[d0] = load_q8(P1 + (size_t)grow * 2304 + hq * 64 + 16 * d0 + 8 * hi, C2);
    f32x16 o[2];
#pragma unroll
    for (int bk = 0; bk < 2; ++bk)
#pragma unroll
      for (int r = 0; r < 16; ++r) o[bk][r] = 0.f;
    float m = -1e30f, l = 0.f;
    const int cbase = NLAT + b * CTXL, lbase = b * SEQ;
    flash_pass2<64, 2, 0, 2>(lds, ntiles, P1, 2304, 512 + g * 64, 640 + g * 64, q, 0,
      [&](int kt, int i) { return kt < nwin ? lbase + (klo + kt) * 64 + i : cbase + (kt - nwin) * 64 + i; },
      [&](int kt, f32x16& p0, f32x16& p1) {
        if (kt < nwin) { const int kp = (klo + kt) * 64 - t;
#pragma unroll
          for (int r = 0; r < 16; ++r) { const int d0 = kp + crow(r, hi), d1 = d0 + 32;
            if (d0 < -128 || d0 > 128) p0[r] = -INFINITY; if (d1 < -128 || d1 > 128) p1[r] = -INFINITY; } } },
      o, m, l);
    l += __shfl_xor(l, 32);
    { const float sk = p.in[L1_SINKS][hq] * LOG2E, mn = fmaxf(m, sk), alpha = __builtin_amdgcn_exp2f(m - mn);
      l = l * alpha + __builtin_amdgcn_exp2f(sk - mn);
#pragma unroll
      for (int bk = 0; bk < 2; ++bk)
#pragma unroll
        for (int r = 0; r < 16; ++r) o[bk][r] *= alpha; }
    const float inv = 1.f / l;
#pragma unroll
    for (int bk = 0; bk < 2; ++bk)
#pragma unroll
      for (int rg = 0; rg < 4; ++rg) { const int dv = bk * 32 + 8 * rg + 4 * hi;
        st_att4(ATT, (size_t)grow, hq * 64 + dv, o[bk][4 * rg] * inv, o[bk][4 * rg + 1] * inv, o[bk][4 * rg + 2] * inv, o[bk][4 * rg + 3] * inv); }
    __syncthreads();
  }
}
}
namespace fs {
using fa::bf16x8; using fa::s16x4; using fa::f32x16; using fa::ldsp_t; using fa::u32x4; using fa::cvtpk; using fa::vtr; using fa::crow; using fa::LOG2E;
typedef unsigned u32x2 __attribute__((ext_vector_type(2)));

DEVI void phase_conv(const Params& p) {
  const bf16_t* P1 = (const bf16_t*)(p.ws + WS_P1); bf16_t* U = (bf16_t*)(p.ws + WS_U);
  const float* cw = p.in[L1_CONVW]; const float* cb = p.in[L1_CONVB];
  const int nitems = (NROW / 16) * 128;
  for (int it = blockIdx.x * NT + ftid(); it < nitems; it += gridDim.x * NT) {
    const int cg = it & 127, rc = it >> 7, r0 = rc * 16, ch = cg * 8;
    int s0, len; if (r0 < NLAT) { s0 = r0 & ~4095; len = SEQ; } else { s0 = NLAT + ((r0 - NLAT) & ~255); len = CTXL; }
    const int t0 = r0 - s0;
    float w[5][8], bias[8];
#pragma unroll
    for (int j = 0; j < 5; ++j) { const float4 a = *(const float4*)(cw + j * 1024 + ch), b = *(const float4*)(cw + j * 1024 + ch + 4);
      w[j][0] = a.x; w[j][1] = a.y; w[j][2] = a.z; w[j][3] = a.w; w[j][4] = b.x; w[j][5] = b.y; w[j][6] = b.z; w[j][7] = b.w; }
    { const float4 a = *(const float4*)(cb + ch), b = *(const float4*)(cb + ch + 4); bias[0] = a.x; bias[1] = a.y; bias[2] = a.z; bias[3] = a.w; bias[4] = b.x; bias[5] = b.y; bias[6] = b.z; bias[7] = b.w; }
    float win[5][8];
    auto ldrow = [&](int t, float (&d)[8]) {
      if (t < 0 || t >= len) {
#pragma unroll
        for (int k = 0; k < 8; ++k) d[k] = 0.f; return; }
      const u32x4 v = *(const u32x4*)(P1 + (size_t)(s0 + t) * 2304 + 768 + ch);
#pragma unroll
      for (int k = 0; k < 4; ++k) { d[2 * k] = __uint_as_float(v[k] << 16); d[2 * k + 1] = __uint_as_float(v[k] & 0xffff0000u); } };
    ldrow(t0 - 2, win[0]); ldrow(t0 - 1, win[1]); ldrow(t0, win[2]); ldrow(t0 + 1, win[3]);
#pragma unroll
    for (int i = 0; i < 16; ++i) {
      ldrow(t0 + i + 2, win[(i + 4) % 5]);
      float o[8];
#pragma unroll
      for (int k = 0; k < 8; ++k) { float a = bias[k];
#pragma unroll
        for (int j = 0; j < 5; ++j) a += w[j][k] * win[(i + j) % 5][k];
        o[k] = a * __builtin_amdgcn_rcpf(1.f + __expf(-a)); }
      u32x4 ov; ov[0] = cvtpk(o[0], o[1]); ov[1] = cvtpk(o[2], o[3]); ov[2] = cvtpk(o[4], o[5]); ov[3] = cvtpk(o[6], o[7]);
      *(u32x4*)(U + (size_t)(r0 + i) * 1024 + ch) = ov;
    }
  }
}

DEVI float softplus_f(float v) { if (v > 20.f) return v; const float x = __expf(v); return x < 1e-3f ? x * (1.f - 0.5f * x) : __logf(1.f + x); }
constexpr int BSTR = 272, XSTR = 192;
constexpr int L_BM = 0, L_XD = 128 * BSTR, L_XW = L_XD + 128 * XSTR, L_HT = L_XW + 128 * XSTR, L_CUM = L_HT + 128 * XSTR, L_DTV = L_CUM + 512, L_XCH = L_DTV + 512, L_TOT = L_XCH + 8 * 4096;

template <int ABL = 0> DEVI void phase_ssd(const Params& p, ldsp_t lds) {
  const int tid = ftid(), lane = tid & 63, wave = __builtin_amdgcn_readfirstlane(tid >> 6), r32 = lane & 31, hi = lane >> 5;
  const int pb = wave >> 2, lb = (wave < 4) ? (wave & 3) : 3 - (wave & 3);
  const bf16_t* U = (const bf16_t*)(p.ws + WS_U); const float* DT = (const float*)(p.ws + WS_DT);
  bf16_t* YFB = (bf16_t*)(p.ws + WS_YS);
  FA_LAS float* CUM = (FA_LAS float*)(lds + L_CUM); FA_LAS float* DTV = (FA_LAS float*)(lds + L_DTV);
  const int trow_off = 4 * hi + ((lane & 15) >> 2), tcol_off = 32 * ((lane >> 4) & 1) + 8 * (lane & 3);
  for (int it = blockIdx.x; it < NB * 2 * 8; it += gridDim.x) {
    const int b = it >> 4, dir = (it >> 3) & 1, hd = it & 7, g = hd >> 2;
    const float a2 = -expf(p.in[dir ? L1_ALOGB : L1_ALOGF][hd]) * LOG2E; const float dtb = p.in[dir ? L1_DTBB : L1_DTBF][hd];
    auto tokrow = [&](int c, int i) { const int seg = c >= 2, len = seg ? SEQ : CTXL, j = (seg ? c - 2 : c) * 128 + i; return (seg ? b * SEQ : NLAT + b * CTXL) + (dir ? len - 1 - j : j); };
    f32x16 hacc;
#pragma unroll
    for (int r = 0; r < 16; ++r) hacc[r] = 0.f;
    for (int i = tid; i < 128 * XSTR / 4; i += NT) ((FA_LAS unsigned*)(lds + L_HT))[i] = 0u;
    u32x4 sb_[4], sx_[2]; float sdt0 = 0.f, sdt1 = 0.f; bf16x8 cfn[8];
    auto prefetch = [&](int c) {
#pragma unroll
      for (int i = 0; i < 4; ++i) { const int ch = tid + NT * i; sb_[i] = *(const u32x4*)(U + (size_t)tokrow(c, ch >> 4) * 1024 + 512 + g * 128 + (ch & 15) * 8); }
#pragma unroll
      for (int i = 0; i < 2; ++i) { const int ch = tid + NT * i; sx_[i] = *(const u32x4*)(U + (size_t)tokrow(c, ch >> 3) * 1024 + hd * 64 + (ch & 7) * 8); }
      if (tid < 64) { sdt0 = DT[(size_t)tokrow(c, 2 * tid) * 16 + dir * 8 + hd]; sdt1 = DT[(size_t)tokrow(c, 2 * tid + 1) * 16 + dir * 8 + hd]; }
      const bf16_t* crowp = U + (size_t)tokrow(c, lb * 32 + r32) * 1024 + 768 + g * 128 + 8 * hi;
#pragma unroll
      for (int ks = 0; ks < 8; ++ks) cfn[ks] = *(const bf16x8*)(crowp + 16 * ks);
    };
    prefetch(0);
    __syncthreads();
    for (int c = 0; c < 34; ++c) {
      if (tid < 64) {
        const float r0 = sdt0 + dtb, r1 = sdt1 + dtb; const float d0 = softplus_f(r0), d1 = softplus_f(r1);
        const float a0 = d0 * a2, a1 = d1 * a2; float v = a0 + a1;
#pragma unroll
        for (int o = 1; o < 64; o <<= 1) { const float t = __shfl_up(v, o); if (lane >= o) v += t; }
        DTV[2 * tid] = d0; DTV[2 * tid + 1] = d1; CUM[2 * tid] = v - a1; CUM[2 * tid + 1] = v;
      }
      __syncthreads();
      const float cl = CUM[127];
#pragma unroll
      for (int i = 0; i < 4; ++i) { const int ch = tid + NT * i; *(FA_LAS u32x4*)(lds + L_BM + (ch >> 4) * BSTR + (ch & 15) * 16) = sb_[i]; }
#pragma unroll
      for (int i = 0; i < 2; ++i) { const int ch = tid + NT * i, s = ch >> 3; const float d = DTV[s], wv = d * __builtin_amdgcn_exp2f(cl - CUM[s]);
        u32x4 xd, xw;
#pragma unroll
        for (int k = 0; k < 4; ++k) { const float x0 = __uint_as_float(sx_[i][k] << 16), x1 = __uint_as_float(sx_[i][k] & 0xffff0000u); xd[k] = cvtpk(x0 * d, x1 * d); xw[k] = cvtpk(x0 * wv, x1 * wv); }
        *(FA_LAS u32x4*)(lds + L_XD + s * XSTR + (ch & 7) * 16) = xd; *(FA_LAS u32x4*)(lds + L_XW + s * XSTR + (ch & 7) * 16) = xw; }
      bf16x8 cf[8];
#pragma unroll
      for (int ks = 0; ks < 8; ++ks) cf[ks] = cfn[ks];
      __syncthreads();
      if (ABL != 3) { if (c + 1 < 34) prefetch(c + 1); }
      if (c >= 2 && ABL != 1) {
        f32x16 y;
#pragma unroll
        for (int r = 0; r < 16; ++r) y[r] = 0.f;
        { const ldsp_t hb = lds + L_HT + (8 * hi + ((lane & 15) >> 2)) * XSTR + pb * 64 + tcol_off;
          f32x16 y2;
#pragma unroll
          for (int r = 0; r < 16; ++r) y2[r] = 0.f;
#pragma unroll
          for (int ks = 0; ks < 8; ++ks) { const s16x4 lo = vtr(hb + (16 * ks) * XSTR), h8 = vtr(hb + (16 * ks + 4) * XSTR);
            const bf16x8 hf = {lo[0], lo[1], lo[2], lo[3], h8[0], h8[1], h8[2], h8[3]};
            if (ks & 1) y2 = __builtin_amdgcn_mfma_f32_32x32x16_bf16(hf, cf[ks], y2, 0, 0, 0); else y = __builtin_amdgcn_mfma_f32_32x32x16_bf16(hf, cf[ks], y, 0, 0, 0); }
          y += y2; }
        const float cuml = CUM[lb * 32 + r32];
        { const float e = __builtin_amdgcn_exp2f(cuml);
#pragma unroll
          for (int r = 0; r < 16; ++r) y[r] *= e; }
        f32x16 yo;
#pragma unroll
        for (int r = 0; r < 16; ++r) yo[r] = 0.f;
        for (int sb = pb; sb <= lb; sb += 2) {
          f32x16 gt, gt2;
#pragma unroll
          for (int r = 0; r < 16; ++r) { gt[r] = 0.f; gt2[r] = 0.f; }
          const ldsp_t bb = lds + L_BM + (sb * 32 + r32) * BSTR + 16 * hi;
#pragma unroll
          for (int ks = 0; ks < 8; ks += 2) { gt = __builtin_amdgcn_mfma_f32_32x32x16_bf16(*(const FA_LAS bf16x8*)(bb + 32 * ks), cf[ks], gt, 0, 0, 0);
            gt2 = __builtin_amdgcn_mfma_f32_32x32x16_bf16(*(const FA_LAS bf16x8*)(bb + 32 * ks + 32), cf[ks + 1], gt2, 0, 0, 0); }
          gt += gt2;
          const bool diag = (sb == lb);
#pragma unroll
          for (int r = 0; r < 16; ++r) { const int sl = crow(r, hi); const float v = gt[r] * __builtin_amdgcn_exp2f(cuml - CUM[sb * 32 + sl]); gt[r] = (diag && sl > r32) ? 0.f : v; }
          u32x4 t0, t1;
          t0[0] = cvtpk(gt[0], gt[1]); t0[1] = cvtpk(gt[2], gt[3]); t0[2] = cvtpk(gt[4], gt[5]); t0[3] = cvtpk(gt[6], gt[7]);
          t1[0] = cvtpk(gt[8], gt[9]); t1[1] = cvtpk(gt[10], gt[11]); t1[2] = cvtpk(gt[12], gt[13]); t1[3] = cvtpk(gt[14], gt[15]);
          const bf16x8 pm0 = __builtin_bit_cast(bf16x8, t0), pm1 = __builtin_bit_cast(bf16x8, t1);
          const ldsp_t xb = lds + L_XD + (sb * 32 + trow_off) * XSTR + pb * 64 + tcol_off;
          const ldsp_t xo = lds + L_XD + (sb * 32 + trow_off) * XSTR + (1 - pb) * 64 + tcol_off;
          const s16x4 a0 = vtr(xb), a1 = vtr(xb + 8 * XSTR), a2 = vtr(xb + 16 * XSTR), a3 = vtr(xb + 24 * XSTR);
          const s16x4 b0 = vtr(xo), b1 = vtr(xo + 8 * XSTR), b2 = vtr(xo + 16 * XSTR), b3 = vtr(xo + 24 * XSTR);
          { const bf16x8 xf = {a0[0], a0[1], a0[2], a0[3], a1[0], a1[1], a1[2], a1[3]}; y = __builtin_amdgcn_mfma_f32_32x32x16_bf16(xf, pm0, y, 0, 0, 0); }
          { const bf16x8 xf = {b0[0], b0[1], b0[2], b0[3], b1[0], b1[1], b1[2], b1[3]}; yo = __builtin_amdgcn_mfma_f32_32x32x16_bf16(xf, pm0, yo, 0, 0, 0); }
          { const bf16x8 xf = {a2[0], a2[1], a2[2], a2[3], a3[0], a3[1], a3[2], a3[3]}; y = __builtin_amdgcn_mfma_f32_32x32x16_bf16(xf, pm1, y, 0, 0, 0); }
          { const bf16x8 xf = {b2[0], b2[1], b2[2], b2[3], b3[0], b3[1], b3[2], b3[3]}; yo = __builtin_amdgcn_mfma_f32_32x32x16_bf16(xf, pm1, yo, 0, 0, 0); }
        }
        { FA_LAS float* X = (FA_LAS float*)(lds + L_XCH) + (pb * 4 + lb) * 1024;
#pragma unroll
          for (int r = 0; r < 16; ++r) X[r * 64 + lane] = yo[r]; }
        __syncthreads();
        { const FA_LAS float* X = (const FA_LAS float*)(lds + L_XCH) + ((1 - pb) * 4 + lb) * 1024;
#pragma unroll
          for (int r = 0; r < 16; ++r) y[r] += X[r * 64 + lane]; }
        const int j = (c - 2) * 128 + lb * 32 + r32, tok = dir ? SEQ - 1 - j : j;
        bf16_t* yp = YFB + ((size_t)dir * NLAT + (size_t)b * SEQ + tok) * 512 + hd * 64 + pb * 32 + 4 * hi;
#pragma unroll
        for (int rg = 0; rg < 4; ++rg) { u32x2 w; w[0] = cvtpk(y[4 * rg], y[4 * rg + 1]); w[1] = cvtpk(y[4 * rg + 2], y[4 * rg + 3]); *(u32x2*)(yp + 8 * rg) = w; }
      }
      if (ABL != 2) { const float e = __builtin_amdgcn_exp2f(cl);
        f32x16 h2;
#pragma unroll
        for (int r = 0; r < 16; ++r) { hacc[r] *= e; h2[r] = 0.f; }
        const ldsp_t xb = lds + L_XW + (8 * hi + ((lane & 15) >> 2)) * XSTR + pb * 64 + tcol_off;
        const ldsp_t bb = lds + L_BM + (8 * hi + ((lane & 15) >> 2)) * BSTR + lb * 64 + tcol_off;
#pragma unroll
        for (int ks = 0; ks < 8; ++ks) {
          const s16x4 xl = vtr(xb + (16 * ks) * XSTR), xh = vtr(xb + (16 * ks + 4) * XSTR), bl = vtr(bb + (16 * ks) * BSTR), bh = vtr(bb + (16 * ks + 4) * BSTR);
          const bf16x8 xf = {xl[0], xl[1], xl[2], xl[3], xh[0], xh[1], xh[2], xh[3]}, bf = {bl[0], bl[1], bl[2], bl[3], bh[0], bh[1], bh[2], bh[3]};
          if (ks & 1) h2 = __builtin_amdgcn_mfma_f32_32x32x16_bf16(xf, bf, h2, 0, 0, 0); else hacc = __builtin_amdgcn_mfma_f32_32x32x16_bf16(xf, bf, hacc, 0, 0, 0);
        }
        hacc += h2; }
      __syncthreads();
      { const ldsp_t hp = lds + L_HT + (lb * 32 + r32) * XSTR + (pb * 32 + 4 * hi) * 2;
#pragma unroll
        for (int rg = 0; rg < 4; ++rg) { u32x2 w; w[0] = cvtpk(hacc[4 * rg], hacc[4 * rg + 1]); w[1] = cvtpk(hacc[4 * rg + 2], hacc[4 * rg + 3]); *(FA_LAS u32x2*)(hp + 16 * rg) = w; } }
    }
    __syncthreads();
  }
}

DEVI void phase_ssd_out(const Params& p) {
  const int lane = ftid() & 63, gw = blockIdx.x * NWAVE + (ftid() >> 6), NGW = gridDim.x * NWAVE;
  const bf16_t* U = (const bf16_t*)(p.ws + WS_U); const bf16_t* P1 = (const bf16_t*)(p.ws + WS_P1); const bf16_t* YFB = (const bf16_t*)(p.ws + WS_YS);
  bf16_t* ATT = (bf16_t*)(p.ws + WS_ATT1);
  for (int r = gw; r < NLAT; r += NGW) {
    const int c0 = lane * 8, hd = c0 >> 6; const float dsk = p.in[L1_DSKIP][hd];
    const u32x4 yf = *(const u32x4*)(YFB + (size_t)r * 512 + c0), yb = *(const u32x4*)(YFB + ((size_t)NLAT + r) * 512 + c0);
    const u32x4 xw = *(const u32x4*)(U + (size_t)r * 1024 + c0), zw = *(const u32x4*)(P1 + (size_t)r * 2304 + 1792 + c0);
    float y[8]; float ss = 0.f;
#pragma unroll
    for (int i = 0; i < 4; ++i) {
      const float x0 = __uint_as_float(xw[i] << 16), x1 = __uint_as_float(xw[i] & 0xffff0000u), z0 = __uint_as_float(zw[i] << 16), z1 = __uint_as_float(zw[i] & 0xffff0000u);
      const float f0 = __uint_as_float(yf[i] << 16) + __uint_as_float(yb[i] << 16), f1 = __uint_as_float(yf[i] & 0xffff0000u) + __uint_as_float(yb[i] & 0xffff0000u);
      y[2 * i] = (f0 + dsk * x0) * silu_f(z0); y[2 * i + 1] = (f1 + dsk * x1) * silu_f(z1);
      ss += y[2 * i] * y[2 * i] + y[2 * i + 1] * y[2 * i + 1];
    }
#pragma unroll
    for (int o = 1; o < 32; o <<= 1) ss += __shfl_xor(ss, o);
    const float rr = rsqrtf(ss * (1.f / 256.f) + EPS);
    const float4 g0 = *(const float4*)(p.in[L1_GNORM] + c0), g1 = *(const float4*)(p.in[L1_GNORM] + c0 + 4);
    u32x4 w; w[0] = cvtpk(y[0] * rr * g0.x, y[1] * rr * g0.y); w[1] = cvtpk(y[2] * rr * g0.z, y[3] * rr * g0.w); w[2] = cvtpk(y[4] * rr * g1.x, y[5] * rr * g1.y); w[3] = cvtpk(y[6] * rr * g1.z, y[7] * rr * g1.w);
    *(u32x4*)(ATT + (size_t)r * DM + 512 + c0) = w;
  }
}
}
#ifndef TOPK_COPY
#define TOPK_COPY false
#endif
namespace ft {
using fa::ldsp_t; using fa::u32x4;

DEVI int block_excl_scan(int v, FA_LAS int* wsum, int tid, int* tot) {
  const int lane = tid & 63, wave = tid >> 6;
  int inc = v;
#pragma unroll
  for (int o = 1; o < 64; o <<= 1) { const int t = __shfl_up(inc, o); if (lane >= o) inc += t; }
  __syncthreads();
  if (lane == 63) wsum[wave] = inc;
  __syncthreads();
  int base = 0, total = 0;
#pragma unroll
  for (int w = 0; w < 8; ++w) { const int s = wsum[w]; if (w < wave) base += s; total += s; }
  *tot = total;
  return base + inc - v;
}

template <int EPT, bool GATHER_COPY>
DEVI void topk_item(const Params& p, ldsp_t lds, int e, int n, int cap, int row0, int slot0, int erows) {
  const int tid = ftid(), lane = tid & 63, wave = tid >> 6;
  const float* AFFT = (const float*)(p.ws + WS_AFF); int* SLOT = (int*)(p.ws + WS_SLOT); float* GV = (float*)(p.ws + WS_GATEV);
  const bf16_t* H = (const bf16_t*)(p.ws + WS_H); bf16_t* XG = (bf16_t*)(p.ws + WS_XG); int* IDX = (int*)(p.ws + WS_IDX);
  FA_LAS unsigned* hist = (FA_LAS unsigned*)lds;
  FA_LAS int* misc = (FA_LAS int*)(lds + 1024);
  FA_LAS int* wsum = (FA_LAS int*)(lds + 1024 + 64);
  FA_LAS int* list = (FA_LAS int*)(lds + 2048);
  const bool act = tid * EPT < n;
  unsigned key[EPT];
#pragma unroll
  for (int j = 0; j < EPT; ++j) key[j] = act ? __float_as_uint(AFFT[(size_t)e * NROW + row0 + tid * EPT + j]) : 0u;
  unsigned prefix = 0u, mask = 0u; int k = cap;
#pragma unroll 1
  for (int pass = 0; pass < 4; ++pass) {
    const int shift = 24 - 8 * pass;
    __syncthreads();
    if (tid < 256) hist[tid] = 0u;
    __syncthreads();
    if (act) {
#pragma unroll
      for (int j = 0; j < EPT; ++j) if ((key[j] & mask) == prefix) atomicAdd((unsigned*)&hist[(key[j] >> shift) & 255u], 1u);
    }
    __syncthreads();
    if (wave == 0) {
      const int h0 = hist[4 * lane], h1 = hist[4 * lane + 1], h2 = hist[4 * lane + 2], h3 = hist[4 * lane + 3];
      const int s = h0 + h1 + h2 + h3; int v = s;
#pragma unroll
      for (int o = 1; o < 64; o <<= 1) { const int t = __shfl_down(v, o); if (lane + o < 64) v += t; }
      int c = v - s;
      const int hh[4] = {h0, h1, h2, h3};
#pragma unroll
      for (int b = 3; b >= 0; --b) { if (c < k && k <= c + hh[b]) { misc[0] = 4 * lane + b; misc[1] = k - c; } c += hh[b]; }
    }
    __syncthreads();
    prefix |= ((unsigned)misc[0]) << shift; mask |= 255u << shift; k = misc[1];
  }
  int ce = 0;
#pragma unroll
  for (int j = 0; j < EPT; ++j) ce += (act && key[j] == prefix) ? 1 : 0;
  int tot; const int eq_before = block_excl_scan(ce, wsum, tid, &tot);
  int cs = 0, eqr = eq_before; bool sel[EPT];
#pragma unroll
  for (int j = 0; j < EPT; ++j) { bool s = false; if (act) { if (key[j] > prefix) s = true; else if (key[j] == prefix) { s = eqr < k; ++eqr; } } sel[j] = s; cs += s ? 1 : 0; }
  int slot = block_excl_scan(cs, wsum, tid, &tot);
  if (act) {
#pragma unroll
    for (int j = 0; j < EPT; ++j) { const int row = row0 + tid * EPT + j;
      if (sel[j]) { if (GATHER_COPY) list[slot] = row; else IDX[e * erows + slot0 + slot] = row; GV[e * erows + slot0 + slot] = __uint_as_float(key[j]); SLOT[(size_t)row * 16 + e] = slot0 + slot; ++slot; }
      else SLOT[(size_t)row * 16 + e] = -1; }
  }
  if (GATHER_COPY) {
    __syncthreads();
    for (int s = wave; s < cap; s += NWAVE) {
      const u32x4* src = (const u32x4*)(H + (size_t)list[s] * DM) + lane; u32x4* dst = (u32x4*)(XG + ((size_t)e * erows + slot0 + s) * DM) + lane;
      const u32x4 a = src[0], b2 = src[64]; dst[0] = a; dst[64] = b2;
    }
  }
  __syncthreads();
}

DEVI void phase_topk(const Params& p, ldsp_t lds, int layer) {
  const int erows = layer ? EROWS1 : EROWS0;
  const int nlat = NB * NE, nitems = nlat + (layer ? 0 : NB * NE);
  const int G = gridDim.x;
  for (int it = blockIdx.x; it < nitems; it += G) {
    if (it < nlat) { const int b = it / NE, e = it % NE; topk_item<8, TOPK_COPY>(p, lds, e, SEQ, CAP_L, b * SEQ, b * CAP_L, erows); }
    else { const int i2 = it - nlat, b = i2 / NE, e = i2 % NE; topk_item<1, TOPK_COPY>(p, lds, e, CTXL, CAP_C, NLAT + b * CTXL, NB * CAP_L + b * CAP_C, erows); }
  }
}
}
#ifndef MOE1_FP8
#define MOE1_FP8 1
#endif
#ifndef MOE0_FP8
#define MOE0_FP8 1
#endif
namespace fr {
using fa::ldsp_t; using fa::u32x4; using fa::cvtpk;
typedef unsigned u32x2 __attribute__((ext_vector_type(2)));
typedef float f32x4 __attribute__((ext_vector_type(4)));
struct V16 { f32x4 v[4]; };
DEVI V16 ldf(const float* r, int lane) { V16 o; const f32x4* q = (const f32x4*)r + lane;
#pragma unroll
  for (int j = 0; j < 4; ++j) o.v[j] = q[64 * j]; return o; }
struct B16 { u32x2 v[4]; };
DEVI B16 ldb_raw(const bf16_t* r, int lane) { B16 o; const u32x2* q = (const u32x2*)r + lane;
#pragma unroll
  for (int j = 0; j < 4; ++j) o.v[j] = q[64 * j]; return o; }
DEVI V16 b2v(const B16& b) { V16 o;
#pragma unroll
  for (int j = 0; j < 4; ++j) { o.v[j][0] = __uint_as_float(b.v[j][0] << 16); o.v[j][1] = __uint_as_float(b.v[j][0] & 0xffff0000u); o.v[j][2] = __uint_as_float(b.v[j][1] << 16); o.v[j][3] = __uint_as_float(b.v[j][1] & 0xffff0000u); }
  return o; }
DEVI void stf(float* r, int lane, const V16& o) { f32x4* q = (f32x4*)r + lane;
#pragma unroll
  for (int j = 0; j < 4; ++j) q[64 * j] = o.v[j]; }
DEVI void stb(bf16_t* r, int lane, const V16& o) { u32x2* q = (u32x2*)r + lane;
#pragma unroll
  for (int j = 0; j < 4; ++j) { u32x2 w; w[0] = cvtpk(o.v[j][0], o.v[j][1]); w[1] = cvtpk(o.v[j][2], o.v[j][3]); q[64 * j] = w; } }
DEVI float sumsq(const V16& o) { f32x4 s = o.v[0] * o.v[0];
#pragma unroll
  for (int j = 1; j < 4; ++j) s += o.v[j] * o.v[j];
  return wave_sum((s[0] + s[1]) + (s[2] + s[3])); }

DEVI void phase_prenorm0(const Params& p) {
  const int lane = ftid() & 63, gw = blockIdx.x * NWAVE + (ftid() >> 6), NGW = gridDim.x * NWAVE;
  const float* MOD = (const float*)(p.ws + WS_CTL + CTL_MOD); bf16_t* H = (bf16_t*)(p.ws + WS_H);
  const int rpw = (NROW + NGW - 1) / NGW;
  const int r0 = gw * rpw, r1 = min(r0 + rpw, NROW);
  if (r0 >= r1) return;
  const V16 g = ldf(p.in[L0_GPREMIX], lane);
  int cur = -1; V16 gs, sh;
  auto src = [&](int r) { return r < NLAT ? p.in[I_X] + (size_t)r * DM : p.in[I_CTX] + (size_t)(r - NLAT) * DM; };
  V16 xn = ldf(src(r0), lane), xn2 = xn;
  if (r0 + 1 < r1) xn2 = ldf(src(r0 + 1), lane);
  for (int r = r0; r < r1; ++r) {
    const V16 x = xn; xn = xn2; if (r + 2 < r1) xn2 = ldf(src(r + 2), lane);
    const int mr = row_modrow(r);
    if (mr != cur) { cur = mr; const float* m = MOD + (size_t)mr * 6144; const V16 sc = ldf(m + 1024, lane); sh = ldf(m, lane);
#pragma unroll
      for (int j = 0; j < 4; ++j) gs.v[j] = g.v[j] * (sc.v[j] + 1.f); }
    const float rr = rsqrtf(sumsq(x) * (1.f / DM) + EPS);
    V16 h;
#pragma unroll
    for (int j = 0; j < 4; ++j) h.v[j] = x.v[j] * rr * gs.v[j] + sh.v[j];
    if (QKV0_FP8) {
      unsigned* q8 = (unsigned*)((unsigned char*)H + (size_t)r * DM) + lane;
#pragma unroll
      for (int j = 0; j < 4; ++j) q8[64 * j] = nv::pack4_fp8(h.v[j][0] * nv::A8_SCALE, h.v[j][1] * nv::A8_SCALE, h.v[j][2] * nv::A8_SCALE, h.v[j][3] * nv::A8_SCALE);
    } else stb(H + (size_t)r * DM, lane, h);
  }
}

template <int ABL = 0> DEVI void phase_postmix(const Params& p, ldsp_t lds, int layer) {
  const int tid = ftid(), lane = tid & 63, gw = blockIdx.x * NWAVE + (tid >> 6), NGW = gridDim.x * NWAVE;
  const float* MOD = (const float*)(p.ws + WS_CTL + CTL_MOD) + (size_t)layer * 9 * 6144;
  const bf16_t* MIX = (const bf16_t*)(p.ws + (layer ? WS_MIX1 : WS_MIX0));
  bf16_t* H = (bf16_t*)(p.ws + WS_H); float* AFFT = (float*)(p.ws + WS_AFF); float* XC = (float*)(p.ws + WS_XC);
  const float* wr = p.in[layer ? L1_WROUTER : L0_WROUTER];
  FA_LAS f32x4* WL = (FA_LAS f32x4*)lds;
  for (int i = tid; i < 1024 * 4; i += NT) { const int k = i >> 2, e4 = i & 3; const int ln = (k & 255) >> 2, q = k & 3, j = k >> 8;
    WL[((j * 4 + q) * 4 + e4) * 64 + ln] = *(const f32x4*)(wr + (size_t)k * 16 + e4 * 4); }
  __syncthreads();
  const int nrow = layer ? NLAT : NROW;
  const int rpw = (nrow + NGW - 1) / NGW;
  const int r0 = gw * rpw, r1 = min(r0 + rpw, nrow);
  if (r0 >= r1) return;
  const V16 gpost = ldf(p.in[layer ? L1_GPOSTMIX : L0_GPOSTMIX], lane), gpre = ldf(p.in[layer ? L1_GPREFFN : L0_GPREFFN], lane);
  int cur = -1; V16 gg, gs, sh;
  auto xsrc = [&](int r) { return layer ? (const float*)(p.out + (size_t)r * DM) : (r < NLAT ? p.in[I_X] + (size_t)r * DM : p.in[I_CTX] + (size_t)(r - NLAT) * DM); };
  B16 mn = ldb_raw(MIX + (size_t)r0 * DM, lane); V16 xn = ldf(xsrc(r0), lane);
  B16 mn2 = mn; V16 xn2 = xn;
  if (r0 + 1 < r1) { mn2 = ldb_raw(MIX + (size_t)(r0 + 1) * DM, lane); xn2 = ldf(xsrc(r0 + 1), lane); }
  for (int r = r0; r < r1; ++r) {
    const B16 mb = mn; const V16 x = xn;
    mn = mn2; xn = xn2;
    if (r + 2 < r1) { mn2 = ldb_raw(MIX + (size_t)(r + 2) * DM, lane); xn2 = ldf(xsrc(r + 2), lane); }
    const int mr = row_modrow(r);
    if (mr != cur) { cur = mr; const float* m = MOD + (size_t)mr * 6144; const V16 gt = ldf(m + 2048, lane), sc = ldf(m + 4096, lane); sh = ldf(m + 3072, lane);
#pragma unroll
      for (int j = 0; j < 4; ++j) { gg.v[j] = gt.v[j] * gpost.v[j]; gs.v[j] = gpre.v[j] * (sc.v[j] + 1.f); } }
    V16 o = b2v(mb);
    const float rr = rsqrtf(sumsq(o) * (1.f / DM) + EPS);
#pragma unroll
    for (int j = 0; j < 4; ++j) o.v[j] = x.v[j] + gg.v[j] * (o.v[j] * rr);
    stf(r < NLAT ? p.out + (size_t)r * DM : XC + (size_t)(r - NLAT) * DM, lane, o);
    const float r2 = rsqrtf(sumsq(o) * (1.f / DM) + EPS);
    V16 h;
#pragma unroll
    for (int j = 0; j < 4; ++j) h.v[j] = o.v[j] * r2 * gs.v[j] + sh.v[j];
    if ((layer == 1 && MOE1_FP8) || (layer == 0 && MOE0_FP8)) {
      unsigned* q8 = (unsigned*)((unsigned char*)H + (size_t)r * DM) + lane;
#pragma unroll
      for (int j = 0; j < 4; ++j) q8[64 * j] = nv::pack4_fp8(h.v[j][0] * nv::A8_SCALE, h.v[j][1] * nv::A8_SCALE, h.v[j][2] * nv::A8_SCALE, h.v[j][3] * nv::A8_SCALE);
    } else stb(H + (size_t)r * DM, lane, h);
    if (ABL == 1) continue;
    f32x4 lg[4];
    int lo = lane; asm volatile("" : "+v"(lo));
#pragma unroll
    for (int e4 = 0; e4 < 4; ++e4) lg[e4] = (f32x4){0.f, 0.f, 0.f, 0.f};
#pragma unroll
    for (int j = 0; j < 4; ++j)
#pragma unroll
      for (int q = 0; q < 4; ++q) { const float hv = h.v[j][q];
#pragma unroll
        for (int e4 = 0; e4 < 4; ++e4) lg[e4] += WL[((j * 4 + q) * 4 + e4) * 64 + lo] * hv; }
    float l16[16]; float mx = -INFINITY;
#pragma unroll
    for (int e = 0; e < 16; ++e) { l16[e] = wave_sum(lg[e >> 2][e & 3]); mx = fmaxf(mx, l16[e]); }
    float s = 0.f;
#pragma unroll
    for (int e = 0; e < 16; ++e) { l16[e] = expf(l16[e] - mx); s += l16[e]; }
    const float inv = 1.f / s; float mine = 0.f;
#pragma unroll
    for (int e = 0; e < 16; ++e) if (lane == e) mine = l16[e] * inv;
    if (lane < 16) AFFT[(size_t)lane * NROW + r] = mine;
  }
}

DEVI void phase_combine(const Params& p, int layer) {
  const int tid = ftid(), lane = tid & 63, gw = blockIdx.x * NWAVE + (tid >> 6), NGW = gridDim.x * NWAVE;
  const float* MOD = (const float*)(p.ws + WS_CTL + CTL_MOD);
  const bf16_t* Y = (const bf16_t*)(p.ws + WS_Y); const int* SLOT = (const int*)(p.ws + WS_SLOT); const float* GV = (const float*)(p.ws + WS_GATEV);
  bf16_t* H = (bf16_t*)(p.ws + WS_H); float* XC = (float*)(p.ws + WS_XC);
  const int nrow = layer ? NLAT : NROW, erows = layer ? EROWS1 : EROWS0;
  const int rpw = (nrow + NGW - 1) / NGW;
  const int r0 = gw * rpw, r1 = min(r0 + rpw, nrow);
  if (r0 >= r1) return;
  const V16 gpost = ldf(p.in[layer ? L1_GPOSTFFN : L0_GPOSTFFN], lane);
  V16 g1; if (layer == 0) g1 = ldf(p.in[L1_GPREMIX], lane);
  int cur = -1; V16 gg, gs, sh;
  int sn = (lane < 16) ? SLOT[(size_t)r0 * 16 + lane] : -1;
  for (int r = r0; r < r1; ++r) {
    const int sl = sn; if (r + 1 < r1) sn = (lane < 16) ? SLOT[(size_t)(r + 1) * 16 + lane] : -1;
    float* xio = r < NLAT ? p.out + (size_t)r * DM : XC + (size_t)(r - NLAT) * DM;
    const V16 x = ldf(xio, lane);
    const int mr = row_modrow(r);
    if (mr != cur) { cur = mr; const float* m = MOD + (size_t)(layer * 9 + mr) * 6144; const V16 gt = ldf(m + 5120, lane);
#pragma unroll
      for (int j = 0; j < 4; ++j) gg.v[j] = gt.v[j] * gpost.v[j];
      if (layer == 0) { const float* m1 = MOD + (size_t)(9 + mr) * 6144; const V16 sc = ldf(m1 + 1024, lane); sh = ldf(m1, lane);
#pragma unroll
        for (int j = 0; j < 4; ++j) gs.v[j] = g1.v[j] * (sc.v[j] + 1.f); } }
    V16 o;
#pragma unroll
    for (int j = 0; j < 4; ++j) o.v[j] = (f32x4){0.f, 0.f, 0.f, 0.f};
    unsigned long long mask = __ballot(sl >= 0);
    while (mask) {
      const int e = __builtin_ctzll(mask); mask &= mask - 1;
      const int s = __shfl(sl, e);
      const float gate = GV[e * erows + s];
      const V16 y = b2v(ldb_raw(Y + ((size_t)e * erows + s) * DM, lane));
#pragma unroll
      for (int j = 0; j < 4; ++j) o.v[j] += y.v[j] * gate;
    }
    const float rr = rsqrtf(sumsq(o) * (1.f / DM) + EPS);
#pragma unroll
    for (int j = 0; j < 4; ++j) o.v[j] = x.v[j] + gg.v[j] * (o.v[j] * rr);
    stf(xio, lane, o);
    if (layer == 0) {
      const float r2 = rsqrtf(sumsq(o) * (1.f / DM) + EPS);
      V16 h;
#pragma unroll
      for (int j = 0; j < 4; ++j) h.v[j] = o.v[j] * r2 * gs.v[j] + sh.v[j];
      if (QKV1_FP8) {
        unsigned* q8 = (unsigned*)((unsigned char*)H + (size_t)r * DM) + lane;
#pragma unroll
        for (int j = 0; j < 4; ++j) q8[64 * j] = nv::pack4_fp8(h.v[j][0] * nv::A8_SCALE, h.v[j][1] * nv::A8_SCALE, h.v[j][2] * nv::A8_SCALE, h.v[j][3] * nv::A8_SCALE);
      } else stb(H + (size_t)r * DM, lane, h);
    }
  }
}
}
#define LAS __attribute__((address_space(3)))
#define XB_TMO      128
#define XB_XCNT(j)  (256  + 64 * (j))
#define XB_XSUB(j)  (1280 + 64 * (j))
#define XB_XGEN(j)  (2304 + 64 * (j))
#define XB_TOP      3328
#define XB_TOPGEN   3392
#define XCD_BAR_WORDS 3456
#define XB_SPIN_CAP (1u << 18)

__device__ __forceinline__ unsigned xb_ld(unsigned* p)              { return __hip_atomic_load(p, __ATOMIC_RELAXED, __HIP_MEMORY_SCOPE_AGENT); }
__device__ __forceinline__ unsigned xb_add(unsigned* p, unsigned v) { return __hip_atomic_fetch_add(p, v, __ATOMIC_RELAXED, __HIP_MEMORY_SCOPE_AGENT); }
__device__ __forceinline__ unsigned xb_xcc_id() { return (unsigned)__builtin_amdgcn_s_getreg((3 << 11) | 20) & 0xFu; }
#define XB_SPIN(cond, bar) do { unsigned _sp = 0; while (cond) { __builtin_amdgcn_s_sleep(1); \
    if ((++_sp & 255u) == 0u) { if (xb_ld(&(bar)[XB_TMO])) break; if (_sp > XB_SPIN_CAP) { atomicAdd(&(bar)[XB_TMO], 1u); break; } } } } while (0)

struct XcdBarrier {
    unsigned* bar; unsigned x;
    volatile LAS unsigned* st;
};

__device__ __forceinline__ XcdBarrier xcd_barrier_post(unsigned* bar, volatile LAS unsigned* st) {
    XcdBarrier b; b.bar = bar; b.x = xb_xcc_id(); b.st = st;
    if (threadIdx.x == 0) (void)xb_add(&bar[XB_XCNT(b.x)], 1u);
    return b;
}
__device__ __forceinline__ void xcd_barrier_complete(unsigned* bar, unsigned x, unsigned& nloc, unsigned& nx) {
    const unsigned G = gridDim.x * gridDim.y * gridDim.z;
    unsigned sum, cnt, mine, sp = 0u;
    for (;;) {
        sum = 0u; cnt = 0u; mine = 0u;
#pragma unroll
        for (unsigned j = 0; j < 16; ++j) { const unsigned c = xb_ld(&bar[XB_XCNT(j)]); sum += c; cnt += (c > 0u) ? 1u : 0u; mine = (j == x) ? c : mine; }
        if (sum == G) break;
        __builtin_amdgcn_s_sleep(1);
        if ((++sp & 255u) == 0u) { if (xb_ld(&bar[XB_TMO])) break; if (sp > XB_SPIN_CAP) { atomicAdd(&bar[XB_TMO], 1u); break; } }
    }
    nloc = mine > 0u ? mine : 1u; nx = cnt > 0u ? cnt : 1u;
}

__device__ __forceinline__ void xcd_barrier(const XcdBarrier& b) {
    asm volatile("s_waitcnt vmcnt(0)" ::: "memory");
    __syncthreads();
    if (threadIdx.x == 0) {
        unsigned* bar = b.bar;
        __builtin_amdgcn_s_waitcnt(0);
        unsigned nloc = b.st[0], nx = b.st[1];
        if (nloc == 0u) { xcd_barrier_complete(bar, b.x, nloc, nx); b.st[0] = nloc; b.st[1] = nx; }
        const unsigned old = xb_add(&bar[XB_XSUB(b.x)], 1u);
        const unsigned gen = old / nloc;
        if (old + 1u == (gen + 1u) * nloc) {
            __builtin_amdgcn_fence(__ATOMIC_RELEASE, "agent");
            asm volatile("s_waitcnt vmcnt(0)" ::: "memory");
            const unsigned og = xb_add(&bar[XB_TOP], 1u);
            const unsigned tg = og / nx;
            if (og + 1u == (tg + 1u) * nx) xb_add(&bar[XB_TOPGEN], 1u);
            else XB_SPIN(xb_ld(&bar[XB_TOPGEN]) == tg, bar);
            __builtin_amdgcn_fence(__ATOMIC_ACQUIRE, "agent");
            xb_add(&bar[XB_XGEN(b.x)], 1u);
            asm volatile("s_waitcnt vmcnt(0)" ::: "memory");
        } else {
            XB_SPIN(xb_ld(&bar[XB_XGEN(b.x)]) == gen, bar);
            __builtin_amdgcn_fence(__ATOMIC_ACQUIRE, "agent");
            asm volatile("s_waitcnt vmcnt(0)" ::: "memory");
        }
    }
    __syncthreads();
}


__device__ __forceinline__ void flat_barrier(unsigned* ctr, unsigned& epoch) {
    asm volatile("s_waitcnt vmcnt(0)" ::: "memory");
    __syncthreads();
    if (threadIdx.x == 0) {
        __builtin_amdgcn_fence(__ATOMIC_RELEASE, "agent");
        asm volatile("s_waitcnt vmcnt(0)" ::: "memory");
        (void)__hip_atomic_fetch_add(ctr, 1u, __ATOMIC_RELAXED, __HIP_MEMORY_SCOPE_AGENT);
        const unsigned target = (epoch + 1u) * (unsigned)gridDim.x; unsigned sp = 0;
        while (__hip_atomic_load(ctr, __ATOMIC_RELAXED, __HIP_MEMORY_SCOPE_AGENT) < target) { __builtin_amdgcn_s_sleep(1); if (++sp > (1u << 22)) break; }
        __builtin_amdgcn_fence(__ATOMIC_ACQUIRE, "agent");
        asm volatile("s_waitcnt vmcnt(0)" ::: "memory");
    }
    ++epoch;
    __syncthreads();
}

__device__ __forceinline__ void xcd_barrier2(const XcdBarrier& b) {
    asm volatile("s_waitcnt vmcnt(0)" ::: "memory");
    __syncthreads();
    if (threadIdx.x == 0) {
        unsigned* bar = b.bar;
        __builtin_amdgcn_s_waitcnt(0);
        unsigned nloc = b.st[0], nx = b.st[1];
        if (nloc == 0u) { xcd_barrier_complete(bar, b.x, nloc, nx); b.st[0] = nloc; b.st[1] = nx; }
        const unsigned old = xb_add(&bar[XB_XSUB(b.x)], 1u);
        const unsigned gen = old / nloc;
        if (old + 1u == (gen + 1u) * nloc) {
            __builtin_amdgcn_fence(__ATOMIC_RELEASE, "agent");
            asm volatile("s_waitcnt vmcnt(0)" ::: "memory");
            (void)xb_add(&bar[XB_TOP], 1u);
        }
        const unsigned target = (gen + 1u) * nx;
        XB_SPIN(xb_ld(&bar[XB_TOP]) < target, bar);
        __builtin_amdgcn_fence(__ATOMIC_ACQUIRE, "agent");
        asm volatile("s_waitcnt vmcnt(0)" ::: "memory");
    }
    __syncthreads();
}
constexpr int LDS_BYTES = 147456;
#define TAILFILL 1
#ifndef FAST_GEMM
#define FAST_GEMM 1
#endif
#ifndef FAST_TOPK
#define FAST_TOPK 1
#endif
#ifndef FAST_SSD
#define FAST_SSD 1
#endif
#ifndef FAST_ATTN
#define FAST_ATTN 1
#endif
__global__ void __launch_bounds__(NT) mega(Params p) {
  extern __shared__ __attribute__((aligned(16))) unsigned char lds_raw[];
  float* lds = (float*)lds_raw;
  fg::ldsp_t ldsp = (fg::ldsp_t)lds_raw;
  cg::grid_group grid = cg::this_grid();
  volatile LAS unsigned* bst = (volatile LAS unsigned*)((LAS unsigned char*)lds_raw + (LDS_BYTES - 64));
  if (threadIdx.x < 2) bst[threadIdx.x] = 0u;
  unsigned* barw = (unsigned*)(p.ws + WS_CTL + CTL_BAR);
  if (blockIdx.x == 0) { const int t0 = ftid(); for (int i = t0; i < XCD_BAR_WORDS; i += NT) barw[i] = 0u; }
  XcdBarrier xbar; xbar.bar = barw; xbar.x = 0; xbar.st = bst;
#ifdef FLATBAR
  unsigned fb_epoch = 0; unsigned* fb_ctr = barw + XCD_BAR_WORDS - 64;
#define GSYNC() flat_barrier(fb_ctr, fb_epoch)
#elif defined(XBAR2)
#define GSYNC() xcd_barrier2(xbar)
#else
#define GSYNC() xcd_barrier(xbar)
#endif
  nv::phase0(p, lds);                 grid.sync();
  xbar = xcd_barrier_post(barw, bst);
#ifdef DUP_SYNC
  for (int i = 0; i < 20; ++i) GSYNC();
#endif
#ifdef DUP_P0
  nv::phase0(p, lds);                 GSYNC();
#endif
  fr::phase_prenorm0(p);              GSYNC();
#ifdef DUP_PRENORM
  fr::phase_prenorm0(p); GSYNC();
#endif
#if FAST_GEMM
  fg::phase_qkv0(p, ldsp); GSYNC();
#ifdef DUP_QKV0
  fg::phase_qkv0(p, ldsp); GSYNC();
#endif
#else
  nv::phase_qkv0(p, lds);             GSYNC();
#endif
#if FAST_ATTN
  fa::phase_attnA(p, ldsp); fa::phase_attnB(p, ldsp); GSYNC();
#ifdef DUP_A
  fa::phase_attnA<DUP_A>(p, ldsp); GSYNC();
#endif
#ifdef DUP_B
  fa::phase_attnB<DUP_B>(p, ldsp); GSYNC();
#endif
#else
  nv::phase_attn0(p, lds);            GSYNC();
#endif
#if FAST_GEMM
#ifdef TAILFILL
  fg::phase_outproj(p, ldsp, 0); nv::convert_moe_tail8(p, 0, 1, lds, NROW / 256 * (DM / 256)); GSYNC();
#else
  fg::phase_outproj(p, ldsp, 0); GSYNC();
#endif
#ifdef DUP_OUT0
  fg::phase_outproj(p, ldsp, 0); GSYNC();
#endif
#else
  nv::phase_outproj(p, lds, 0);       GSYNC();
#endif
  fr::phase_postmix(p, ldsp, 0);            GSYNC();
#ifdef DUP_POSTMIX0
  fr::phase_postmix<DUP_POSTMIX0>(p, ldsp, 0); GSYNC();
#endif
#if FAST_TOPK
  ft::phase_topk(p, ldsp, 0);         GSYNC();
#ifdef DUP_TOPK0
  ft::phase_topk(p, ldsp, 0);         GSYNC();
#endif
#else
  nv::phase_topk(p, lds, 0);          GSYNC();
  fg::phase_gather(p, 0);             GSYNC();
#endif
#if FAST_GEMM
  fg::phase_moe_up8(p, ldsp, 0);      GSYNC();
#ifdef DUP_UP0
  fg::phase_moe_up8(p, ldsp, 0); GSYNC();
#endif
  fg::phase_moe_down8(p, ldsp, 0);    GSYNC();
#ifdef DUP_DOWN0
  fg::phase_moe_down8(p, ldsp, 0); GSYNC();
#endif
#else
  nv::phase_moe_up(p, lds, 0);        GSYNC();
  nv::phase_moe_down(p, lds, 0);      GSYNC();
#endif
#ifdef TAILFILL
  fr::phase_combine(p, 0); GSYNC();
#else
  fr::phase_combine(p, 0); nv::convert_moe_tail(p, 1, 0, lds, 0); nv::convert_moe_tail(p, 1, 1, lds, 0); GSYNC();
#endif
#if FAST_GEMM
#ifdef TAILFILL
  fg::phase_qkv1(p, ldsp); GSYNC();
#else
  fg::phase_qkv1(p, ldsp); GSYNC();
#endif
#else
  nv::phase_qkv1(p, lds);             GSYNC();
#endif
#if FAST_ATTN
#if FAST_SSD
#ifdef TAILFILL
  fs::phase_conv(p); GSYNC();
#else
  fs::phase_conv(p); GSYNC();
#endif
#else
  nv::phase_conv_swa(p, lds, true); GSYNC();
#endif
#else
  nv::phase_conv_swa(p, lds, true);   GSYNC();
#endif
#if FAST_SSD
  fs::phase_ssd(p, ldsp); fa::phase_attnC(p, ldsp, (int*)(p.ws + WS_CTL + CTL_QC));
  nv::convert_moe_tail8(p, 1, 0, lds, NB * 2 * 8); nv::convert_moe_tail8(p, 1, 1, lds, NB * 2 * 8); GSYNC();
#ifdef DUP_SSD
  fs::phase_ssd<DUP_SSD>(p, ldsp);             GSYNC();
#endif
  fs::phase_ssd_out(p);               GSYNC();
#else
  nv::phase_ssd(p, lds);              GSYNC();
  nv::phase_ssd_out(p);               GSYNC();
#endif
#if FAST_GEMM
  fg::phase_outproj(p, ldsp, 1);      GSYNC();
#else
  nv::phase_outproj(p, lds, 1);       GSYNC();
#endif
  fr::phase_postmix(p, ldsp, 1);            GSYNC();
#if FAST_TOPK
  ft::phase_topk(p, ldsp, 1);         GSYNC();
#ifdef DUP_TOPK1
  ft::phase_topk(p, ldsp, 1);         GSYNC();
#endif
#else
  nv::phase_topk(p, lds, 1);          GSYNC();
  fg::phase_gather(p, 1);             GSYNC();
#endif
#if FAST_GEMM
  fg::phase_moe_up8(p, ldsp, 1);      GSYNC();
  fg::phase_moe_down8(p, ldsp, 1);    GSYNC();
#else
  nv::phase_moe_up(p, lds, 1);        GSYNC();
  nv::phase_moe_down(p, lds, 1);      GSYNC();
#endif
  fr::phase_combine(p, 1);
}


extern "C" void kernel_launch(void* const* d_in, const int* in_sizes, int n_in, void* d_out, int out_size,
                              void* d_ws, size_t ws_size, hipStream_t stream) {
  static int grid_blocks = 0;
  if (!grid_blocks) {
    int dev = 0, cus = 0, per_cu = 0;
    (void)hipGetDevice(&dev);
    (void)hipDeviceGetAttribute(&cus, hipDeviceAttributeMultiprocessorCount, dev);
    (void)hipFuncSetAttribute((const void*)mega, hipFuncAttributeMaxDynamicSharedMemorySize, LDS_BYTES);
    (void)hipOccupancyMaxActiveBlocksPerMultiprocessor(&per_cu, (const void*)mega, NT, LDS_BYTES);
    if (per_cu < 1) { fprintf(stderr, "kernel_launch: occupancy query says %d blocks/CU\n", per_cu); per_cu = 1; }
    grid_blocks = cus;
    if (n_in != 43 || ws_size < WS_END) fprintf(stderr, "kernel_launch: unexpected n_in %d / ws_size %zu (need %zu)\n", n_in, ws_size, (size_t)WS_END);
  }
  Params p{};
  for (int i = 0; i < 43; ++i) p.in[i] = (const float*)d_in[i];
  p.out = (float*)d_out; p.ws = (unsigned char*)d_ws;
  void* args[] = {&p};
  hipError_t e = hipLaunchCooperativeKernel((void*)mega, dim3(grid_blocks), dim3(NT), args, LDS_BYTES, stream);
  if (e != hipSuccess) fprintf(stderr, "cooperative launch failed: %s (grid %d)\n", hipGetErrorString(e), grid_blocks);
}
```

```cpp
#include <hip/hip_runtime.h>
#include <hip/hip_cooperative_groups.h>
#include <cstdio>
#include <cstdint>
namespace cg = cooperative_groups;

typedef unsigned short bf16_t;
#define DEVI __device__ __forceinline__

constexpr int NT = 512, NWAVE = 8;
constexpr int NB = 8, SEQ = 4096, DM = 1024, CTXL = 256;
constexpr int NLAT = NB * SEQ, NCTX = NB * CTXL, NROW = NLAT + NCTX;
constexpr int NE = 16;
constexpr int CAP_L = 512, CAP_C = 32;
constexpr int EROWS0 = NB * CAP_L + NB * CAP_C;
constexpr int EROWS1 = NB * CAP_L;
constexpr int N_IN0 = 3072, N_IN1 = 2320, N_IN1P = 2560;
constexpr float EPS = 1e-6f;

constexpr size_t MiB = 1u << 20;
constexpr size_t WS_CTL = 0;
constexpr size_t WS_WIN0 = 1 * MiB;
constexpr size_t WS_WIN1 = 7 * MiB;
constexpr size_t WS_WOUT0 = 12 * MiB, WS_WOUT1 = 14 * MiB;
constexpr size_t WS_WGU = 16 * MiB;
constexpr size_t WS_WD = 80 * MiB;
constexpr size_t WS_XC = 112 * MiB;
constexpr size_t WS_H = 120 * MiB;
constexpr size_t WS_AFF = 188 * MiB;
constexpr size_t WS_SLOT = 191 * MiB;
constexpr size_t WS_IDX = 194 * MiB;
constexpr size_t WS_GATEV = 195 * MiB;
constexpr size_t WS_BIG = 196 * MiB;
constexpr size_t WS_QKV0 = WS_BIG;
constexpr size_t WS_ATT0 = WS_BIG + 204 * MiB;
constexpr size_t WS_MIX0 = WS_BIG + 272 * MiB;
constexpr size_t WS_XG = WS_BIG;
constexpr size_t WS_HID = WS_BIG + 136 * MiB;
constexpr size_t WS_Y = WS_BIG;
constexpr size_t WS_P1 = WS_BIG;
constexpr size_t WS_DT = WS_BIG + 153 * MiB;
constexpr size_t WS_U = WS_BIG + 156 * MiB;
constexpr size_t WS_MIX1 = WS_U;
constexpr size_t WS_ATT1 = WS_BIG + 224 * MiB;
constexpr size_t WS_YS = WS_BIG + 292 * MiB;
constexpr size_t WS_CUMG = WS_BIG + 356 * MiB;
constexpr size_t WS_DTG = WS_BIG + 359 * MiB;
constexpr size_t WS_VT = WS_BIG + 340 * MiB;
constexpr size_t WS_VTB = WS_BIG + 362 * MiB;
constexpr size_t WS_END = WS_BIG + 380 * MiB;
constexpr size_t CTL_MOD = 4096;
constexpr size_t CTL_ROPE = CTL_MOD + 2 * 9 * 6144 * 4;
constexpr size_t CTL_LAM = CTL_ROPE + 64 * 16 * 2 * 4;
constexpr size_t CTL_QC = CTL_LAM + 64;
constexpr size_t CTL_BAR = 512 * 1024;

struct Params {
  const float* in[43];
  float* out;
  unsigned char* ws;
};

enum {
  I_X = 0, I_C, I_CTX, I_CCTX,
  L0_WMOD, L0_BMOD, L0_GPREMIX, L0_GPOSTMIX, L0_GPREFFN, L0_GPOSTFFN, L0_WIN, L0_WOUT,
  L0_LAMQ1, L0_LAMK1, L0_LAMQ2, L0_LAMK2, L0_SUBLN, L0_RPB, L0_WROUTER, L0_WGATE, L0_WUP, L0_WDOWN,
  L1_WMOD, L1_BMOD, L1_GPREMIX, L1_GPOSTMIX, L1_GPREFFN, L1_GPOSTFFN, L1_WIN, L1_WOUT,
  L1_SINKS, L1_CONVW, L1_CONVB, L1_ALOGF, L1_ALOGB, L1_DTBF, L1_DTBB, L1_DSKIP, L1_GNORM,
  L1_WROUTER, L1_WGATE, L1_WUP, L1_WDOWN
};

DEVI int ftid() { int t = threadIdx.x; asm volatile("" : "+v"(t)); return t; }
DEVI float bf2f(bf16_t v) { return __uint_as_float(((unsigned)v) << 16); }
DEVI bf16_t f2bf(float f) { unsigned u = __float_as_uint(f); return (bf16_t)((u + 0x7fffu + ((u >> 16) & 1u)) >> 16); }
DEVI unsigned pk2(float lo, float hi) { return (unsigned)f2bf(lo) | ((unsigned)f2bf(hi) << 16); }
DEVI float silu_f(float v) { return v / (1.f + __expf(-v)); }
DEVI float wave_sum(float v) {
#pragma unroll
  for (int o = 1; o < 64; o <<= 1) v += __shfl_xor(v, o);
  return v;
}
DEVI float wave_max(float v) {
#pragma unroll
  for (int o = 1; o < 64; o <<= 1) v = fmaxf(v, __shfl_xor(v, o));
  return v;
}
DEVI int row_modrow(int r) { return r < NLAT ? (r >> 12) : 8; }
#ifndef QKV0_FP8
#define QKV0_FP8 1
#endif
#ifndef OUT_FP8
#define OUT_FP8 0
#endif
#ifndef QKV1_FP8
#define QKV1_FP8 0
#endif
namespace nv {

DEVI void transpose_item(const float* W, int K, int N, bf16_t* WT, int row_off, int row_mul, float* scr, int item, int lane, int Npad) {
  const int nblk = Npad / 32, kb = item / nblk, nb = item % nblk, k0 = 64 * kb, n0 = 32 * nb;
  const int n = n0 + (lane & 31); const bool ok = n < N;
  const float* src = W + (size_t)(k0 + (lane >> 5)) * N + (ok ? n : 0);
  float v[32];
#pragma unroll
  for (int i = 0; i < 32; ++i) v[i] = src[(size_t)(2 * i) * N];
#pragma unroll
  for (int i = 0; i < 32; ++i) scr[(2 * i + (lane >> 5)) * 33 + (lane & 31)] = ok ? v[i] : 0.f;
  __builtin_amdgcn_s_waitcnt(0); __builtin_amdgcn_wave_barrier();
  const int c = lane & 7;
#pragma unroll
  for (int j = 0; j < 4; ++j) {
    const int nn = (lane >> 3) + 8 * j; const float* s = scr + (8 * c) * 33 + nn;
    uint4 o; o.x = pk2(s[0 * 33], s[1 * 33]); o.y = pk2(s[2 * 33], s[3 * 33]); o.z = pk2(s[4 * 33], s[5 * 33]); o.w = pk2(s[6 * 33], s[7 * 33]);
    *(uint4*)(WT + (size_t)(row_off + (n0 + nn) * row_mul) * K + k0 + 8 * c) = o;
  }
  __builtin_amdgcn_s_waitcnt(0); __builtin_amdgcn_wave_barrier();
}

DEVI void convert_moe_part(const Params& p, int layer, int which, float* scr, int gw, int NGW, int lane) {
  const float* wg = p.in[layer ? L1_WGATE : L0_WGATE]; const float* wu = p.in[layer ? L1_WUP : L0_WUP]; const float* wd = p.in[layer ? L1_WDOWN : L0_WDOWN];
  bf16_t* WGU = (bf16_t*)(p.ws + WS_WGU); bf16_t* WD = (bf16_t*)(p.ws + WS_WD);
  constexpr int IPM = 16 * 32;
  if (which == 0) {
    for (int it = gw; it < NE * 2 * IPM; it += NGW) {
      const int e = it / (2 * IPM), r = it % (2 * IPM), gu = r / IPM, item = r % IPM;
      transpose_item((gu ? wu : wg) + (size_t)e * DM * DM, DM, DM, WGU + (size_t)e * 2048 * DM, gu, 2, scr, item, lane, DM);
    }
  } else {
    for (int it = gw; it < NE * IPM; it += NGW) {
      const int e = it / IPM, item = it % IPM;
      transpose_item(wd + (size_t)e * DM * DM, DM, DM, WD + (size_t)e * DM * DM, 0, 1, scr, item, lane, DM);
    }
  }
}
DEVI void convert_moe_tail(const Params& p, int layer, int which, float* lds, int nunits) {
  const int first = nunits % (int)gridDim.x;
  if ((int)blockIdx.x < first) return;
  const int w = ftid() >> 6;
  convert_moe_part(p, layer, which, lds + w * (64 * 33), ((int)blockIdx.x - first) * NWAVE + w, ((int)gridDim.x - first) * NWAVE, ftid() & 63);
}


constexpr float W8_SCALE = 64.f, A8_SCALE = 4.f;
constexpr int W8_E8M0 = 0x79797979, A8_E8M0 = 0x7d7d7d7d;
DEVI unsigned pack4_fp8(float a, float b, float c, float d) {
  a = fminf(fmaxf(a, -448.f), 448.f); b = fminf(fmaxf(b, -448.f), 448.f); c = fminf(fmaxf(c, -448.f), 448.f); d = fminf(fmaxf(d, -448.f), 448.f);
  int w = 0; w = __builtin_amdgcn_cvt_pk_fp8_f32(a, b, w, false); w = __builtin_amdgcn_cvt_pk_fp8_f32(c, d, w, true); return (unsigned)w; }
DEVI void transpose_item8(const float* W, int K, int N, unsigned char* WT, int row_off, int row_mul, float* scr, int item, int lane, int Npad = 0) {
  if (Npad == 0) Npad = N;
  const int nblk = Npad / 32, kb = item / nblk, nb = item % nblk, k0 = 64 * kb, n0 = 32 * nb;
  const int nn0 = n0 + (lane & 31); const bool ok = nn0 < N;
  const float* src = W + (size_t)(k0 + (lane >> 5)) * N + (ok ? nn0 : 0);
  float v[32];
#pragma unroll
  for (int i = 0; i < 32; ++i) v[i] = src[(size_t)(2 * i) * N];
#pragma unroll
  for (int i = 0; i < 32; ++i) scr[(2 * i + (lane >> 5)) * 33 + (lane & 31)] = ok ? v[i] * W8_SCALE : 0.f;
  __builtin_amdgcn_s_waitcnt(0); __builtin_amdgcn_wave_barrier();
  const int c = lane & 7;
#pragma unroll
  for (int j = 0; j < 4; ++j) {
    const int nn = (lane >> 3) + 8 * j; const float* s = scr + (8 * c) * 33 + nn;
    uint2 o; o.x = pack4_fp8(s[0 * 33], s[1 * 33], s[2 * 33], s[3 * 33]); o.y = pack4_fp8(s[4 * 33], s[5 * 33], s[6 * 33], s[7 * 33]);
    *(uint2*)(WT + (size_t)(row_off + (n0 + nn) * row_mul) * K + k0 + 8 * c) = o;
  }
  __builtin_amdgcn_s_waitcnt(0); __builtin_amdgcn_wave_barrier();
}
DEVI void convert_moe_part8(const Params& p, int layer, int which, float* scr, int gw, int NGW, int lane) {
  const float* wg = p.in[layer ? L1_WGATE : L0_WGATE]; const float* wu = p.in[layer ? L1_WUP : L0_WUP]; const float* wd = p.in[layer ? L1_WDOWN : L0_WDOWN];
  unsigned char* WGU = (unsigned char*)(p.ws + WS_WGU); unsigned char* WD = (unsigned char*)(p.ws + WS_WD);
  constexpr int IPM = 16 * 32;
  if (which == 0) {
    for (int it = gw; it < NE * 2 * IPM; it += NGW) { const int e = it / (2 * IPM), r = it % (2 * IPM), gu = r / IPM, item = r % IPM;
      transpose_item8((gu ? wu : wg) + (size_t)e * DM * DM, DM, DM, WGU + (size_t)e * 2048 * DM, gu, 2, scr, item, lane); }
  } else {
    for (int it = gw; it < NE * IPM; it += NGW) { const int e = it / IPM, item = it % IPM;
      transpose_item8(wd + (size_t)e * DM * DM, DM, DM, WD + (size_t)e * DM * DM, 0, 1, scr, item, lane); }
  }
}
DEVI void convert_moe_tail8(const Params& p, int layer, int which, float* lds, int nunits) {
  const int first = nunits % (int)gridDim.x;
  if ((int)blockIdx.x < first) return;
  const int w = ftid() >> 6;
  convert_moe_part8(p, layer, which, lds + w * (64 * 33), ((int)blockIdx.x - first) * NWAVE + w, ((int)gridDim.x - first) * NWAVE, ftid() & 63);
}

DEVI void phase0(const Params& p, float* lds) {
  const int tid = ftid(), lane = tid & 63, wave = tid >> 6;
  const int gw = blockIdx.x * NWAVE + wave, NGW = gridDim.x * NWAVE;
  for (int it = blockIdx.x; it < 2 * 96; it += gridDim.x) {
    const int layer = it / 96, j0 = (it % 96) * 64;
    float* sc = lds;
    float* red = lds + 9 * 1024;
    __syncthreads();
    for (int i = tid; i < 9 * 1024; i += NT) { const int r = i >> 10, k = i & 1023; const float v = (r < 8) ? p.in[I_C][r * 1024 + k] : p.in[I_CCTX][k]; sc[i] = silu_f(v); }
    __syncthreads();
    const float* wm = p.in[layer ? L1_WMOD : L0_WMOD];
    float acc[9];
#pragma unroll
    for (int r = 0; r < 9; ++r) acc[r] = 0.f;
    for (int k0 = wave * 128; k0 < wave * 128 + 128; k0 += 16) {
      float w[16];
#pragma unroll
      for (int i = 0; i < 16; ++i) w[i] = wm[(size_t)(k0 + i) * 6144 + j0 + lane];
#pragma unroll
      for (int i = 0; i < 16; ++i)
#pragma unroll
        for (int r = 0; r < 9; ++r) acc[r] += sc[r * 1024 + k0 + i] * w[i];
    }
#pragma unroll
    for (int r = 0; r < 9; ++r) red[(wave * 9 + r) * 64 + lane] = acc[r];
    __syncthreads();
    for (int i = tid; i < 9 * 64; i += NT) {
      const int r = i >> 6, c = i & 63; float s = 0.f;
      for (int w = 0; w < 8; ++w) s += red[(w * 9 + r) * 64 + c];
      float* MOD = (float*)(p.ws + WS_CTL + CTL_MOD);
      MOD[(layer * 9 + r) * 6144 + j0 + c] = s + p.in[layer ? L1_BMOD : L0_BMOD][j0 + c];
    }
    __syncthreads();
  }
  if (blockIdx.x == gridDim.x - 1) {
    float* ROPE = (float*)(p.ws + WS_CTL + CTL_ROPE);
    for (int i = tid; i < 64 * 16; i += NT) {
      const int pos = i >> 4, f = i & 15;
      const float inv = powf(10000.f, -(float)f / 16.f);
      const float ang = (float)pos * inv;
      ROPE[2 * i] = cosf(ang); ROPE[2 * i + 1] = sinf(ang);
    }
    if (wave == 0) {
      float a = p.in[L0_LAMQ1][lane] * p.in[L0_LAMK1][lane], b = p.in[L0_LAMQ2][lane] * p.in[L0_LAMK2][lane];
      a = wave_sum(a); b = wave_sum(b);
      if (lane == 0) { float* LAM = (float*)(p.ws + WS_CTL + CTL_LAM); LAM[0] = expf(a) - expf(b) + 0.2f; *(int*)(p.ws + WS_CTL + CTL_QC) = 0; }
    }
  }
  __syncthreads();
  float* scr = lds + wave * (64 * 33);
  {
    constexpr int I_IN0 = 16 * (N_IN0 / 32), I_OUT = 16 * 32, I_IN1 = 16 * (N_IN1P / 32);
    constexpr int NITEMS = I_IN0 + I_OUT + I_IN1 + I_OUT;
    for (int it = gw; it < NITEMS; it += NGW) {
      int r = it;
      if (r < I_IN0) { if (QKV0_FP8) transpose_item8(p.in[L0_WIN], DM, N_IN0, (unsigned char*)(p.ws + WS_WIN0), 0, 1, scr, r, lane); else transpose_item(p.in[L0_WIN], DM, N_IN0, (bf16_t*)(p.ws + WS_WIN0), 0, 1, scr, r, lane, N_IN0); continue; } r -= I_IN0;
      if (r < I_OUT) { if (OUT_FP8) transpose_item8(p.in[L0_WOUT], DM, DM, (unsigned char*)(p.ws + WS_WOUT0), 0, 1, scr, r, lane); else transpose_item(p.in[L0_WOUT], DM, DM, (bf16_t*)(p.ws + WS_WOUT0), 0, 1, scr, r, lane, DM); continue; } r -= I_OUT;
      if (r < I_IN1) { if (QKV1_FP8) transpose_item8(p.in[L1_WIN], DM, N_IN1, (unsigned char*)(p.ws + WS_WIN1), 0, 1, scr, r, lane, N_IN1P); else transpose_item(p.in[L1_WIN], DM, N_IN1, (bf16_t*)(p.ws + WS_WIN1), 0, 1, scr, r, lane, N_IN1P); continue; } r -= I_IN1;
      if (OUT_FP8) transpose_item8(p.in[L1_WOUT], DM, DM, (unsigned char*)(p.ws + WS_WOUT1), 0, 1, scr, r, lane); else transpose_item(p.in[L1_WOUT], DM, DM, (bf16_t*)(p.ws + WS_WOUT1), 0, 1, scr, r, lane, DM);
    }
  }
  convert_moe_part8(p, 0, 0, scr, gw, NGW, lane);
#ifndef TAILFILL
  convert_moe_part8(p, 0, 1, scr, gw, NGW, lane);
#endif
}

struct Row16 { float4 v[4]; };
DEVI Row16 ld_row_f32(const float* r, int lane) { Row16 o; const float4* q = (const float4*)r + lane;
#pragma unroll
  for (int j = 0; j < 4; ++j) o.v[j] = q[64 * j]; return o; }
DEVI Row16 ld_row_bf16(const bf16_t* r, int lane) { Row16 o; const uint2* q = (const uint2*)r + lane;
#pragma unroll
  for (int j = 0; j < 4; ++j) { const uint2 w = q[64 * j]; o.v[j] = make_float4(__uint_as_float(w.x << 16), __uint_as_float(w.x & 0xffff0000u), __uint_as_float(w.y << 16), __uint_as_float(w.y & 0xffff0000u)); }
  return o; }
DEVI void st_row_f32(float* r, int lane, const Row16& o) { float4* q = (float4*)r + lane;
#pragma unroll
  for (int j = 0; j < 4; ++j) q[64 * j] = o.v[j]; }
DEVI void st_row_bf16(bf16_t* r, int lane, const Row16& o) { uint2* q = (uint2*)r + lane;
#pragma unroll
  for (int j = 0; j < 4; ++j) q[64 * j] = make_uint2(pk2(o.v[j].x, o.v[j].y), pk2(o.v[j].z, o.v[j].w)); }
DEVI float row_sumsq(const Row16& o) { float s = 0.f;
#pragma unroll
  for (int j = 0; j < 4; ++j) s += o.v[j].x * o.v[j].x + o.v[j].y * o.v[j].y + o.v[j].z * o.v[j].z + o.v[j].w * o.v[j].w;
  return wave_sum(s); }
#define ROW_FOR4(expr) _Pragma("unroll") for (int j = 0; j < 4; ++j) { { float& e = o.v[j].x; const float a = A.v[j].x, b = Bv.v[j].x, c = Cv.v[j].x; expr; } { float& e = o.v[j].y; const float a = A.v[j].y, b = Bv.v[j].y, c = Cv.v[j].y; expr; } { float& e = o.v[j].z; const float a = A.v[j].z, b = Bv.v[j].z, c = Cv.v[j].z; expr; } { float& e = o.v[j].w; const float a = A.v[j].w, b = Bv.v[j].w, c = Cv.v[j].w; expr; } }

DEVI Row16 norm_mod(const Row16& x, const float* g, const float* sc, const float* sh, int lane) {
  const float r = rsqrtf(row_sumsq(x) * (1.f / DM) + EPS);
  Row16 o = x; const Row16 A = ld_row_f32(g, lane), Bv = ld_row_f32(sc, lane), Cv = ld_row_f32(sh, lane);
  ROW_FOR4(e = e * r * a * (1.f + b) + c);
  return o;
}

DEVI void phase_prenorm0(const Params& p) {
  const int lane = ftid() & 63, gw = blockIdx.x * NWAVE + (ftid() >> 6), NGW = gridDim.x * NWAVE;
  const float* MOD = (const float*)(p.ws + WS_CTL + CTL_MOD);
  bf16_t* H = (bf16_t*)(p.ws + WS_H);
  for (int r = gw; r < NROW; r += NGW) {
    const float* src = r < NLAT ? p.in[I_X] + (size_t)r * DM : p.in[I_CTX] + (size_t)(r - NLAT) * DM;
    const float* m = MOD + (size_t)row_modrow(r) * 6144;
    const Row16 x = ld_row_f32(src, lane);
    const Row16 h = norm_mod(x, p.in[L0_GPREMIX], m + 1024, m, lane);
    st_row_bf16(H + (size_t)r * DM, lane, h);
  }
}

template <class AF, class EF>
DEVI void gemm_tile(float* lds, const bf16_t* Bt, int n0, int K, AF arow, EF epi) {
  const int tid = ftid(), ty = tid >> 4, tx = tid & 15;
  float (*As)[132] = (float (*)[132])lds;
  float (*Bs)[68] = (float (*)[68])(lds + 16 * 132);
  float acc[4][4];
#pragma unroll
  for (int i = 0; i < 4; ++i)
#pragma unroll
    for (int j = 0; j < 4; ++j) acc[i][j] = 0.f;
  const int ar = tid >> 2, ak = (tid & 3) * 4;
  const int br = tid >> 3, bk = (tid & 7) * 2;
  const bf16_t* ap = arow(ar) + ak;
  const bf16_t* bp = Bt + (size_t)(n0 + br) * K + bk;
  for (int k0 = 0; k0 < K; k0 += 16) {
    const uint2 av = *(const uint2*)(ap + k0);
    const unsigned bv = *(const unsigned*)(bp + k0);
    __syncthreads();
    As[ak + 0][ar] = __uint_as_float(av.x << 16); As[ak + 1][ar] = __uint_as_float(av.x & 0xffff0000u);
    As[ak + 2][ar] = __uint_as_float(av.y << 16); As[ak + 3][ar] = __uint_as_float(av.y & 0xffff0000u);
    Bs[bk + 0][br] = __uint_as_float(bv << 16); Bs[bk + 1][br] = __uint_as_float(bv & 0xffff0000u);
    __syncthreads();
#pragma unroll
    for (int kk = 0; kk < 16; ++kk) {
      const float4 a = *(const float4*)&As[kk][ty * 4]; const float4 b = *(const float4*)&Bs[kk][tx * 4];
      const float aa[4] = {a.x, a.y, a.z, a.w}, bb[4] = {b.x, b.y, b.z, b.w};
#pragma unroll
      for (int i = 0; i < 4; ++i)
#pragma unroll
        for (int j = 0; j < 4; ++j) acc[i][j] += aa[i] * bb[j];
    }
  }
#pragma unroll
  for (int i = 0; i < 4; ++i) epi(ty * 4 + i, n0 + tx * 4, acc[i]);
}

DEVI void rope_pair(const float* ROPE, int t, int d, float& u1, float& u2) {
  const int i = d >> 1, f = i & 15, pos = (i < 16) ? (t >> 6) : (t & 63);
  const float cs = ROPE[(pos * 16 + f) * 2], sn = ROPE[(pos * 16 + f) * 2 + 1];
  const float a = u1 * cs - u2 * sn, b = u1 * sn + u2 * cs; u1 = a; u2 = b;
}

DEVI void phase_qkv0(const Params& p, float* lds) {
  const bf16_t* H = (const bf16_t*)(p.ws + WS_H); const bf16_t* W = (const bf16_t*)(p.ws + WS_WIN0);
  bf16_t* Q = (bf16_t*)(p.ws + WS_QKV0); const float* ROPE = (const float*)(p.ws + WS_CTL + CTL_ROPE);
  constexpr int NTN = N_IN0 / 64, NTM = NROW / 128;
  for (int it = blockIdx.x; it < NTN * NTM; it += gridDim.x) {
    const int mt = it / NTN, nt = it % NTN, m0 = mt * 128;
    gemm_tile(lds, W, nt * 64, DM,
      [&](int r) { return H + (size_t)(m0 + r) * DM; },
      [&](int r, int n, float* v) {
        const int row = m0 + r;
        if (row < NLAT && n < 1024) { const int t = row & 4095; rope_pair(ROPE, t, n & 63, v[0], v[1]); rope_pair(ROPE, t, (n + 2) & 63, v[2], v[3]); }
        *(uint2*)(Q + (size_t)row * N_IN0 + n) = make_uint2(pk2(v[0], v[1]), pk2(v[2], v[3]));
      });
  }
}

template <int NS, int VJ, class KF>
DEVI void wave_attn(const float* qs, float* pl  , int* rl  , int nkeys, KF kf, const bf16_t* KV, int ld, int kcol, int vcol,
                    float sink, bool has_sink, float (&o)[NS][VJ], float (&m)[NS], float (&l)[NS], int lane) {
#pragma unroll
  for (int s = 0; s < NS; ++s) { m[s] = -INFINITY; l[s] = 0.f;
#pragma unroll
    for (int j = 0; j < VJ; ++j) o[s][j] = 0.f; }
  for (int c0 = 0; c0 < nkeys; c0 += 64) {
    const int kidx = c0 + lane; int row = -1; float bias = 0.f;
    bool valid = kidx < nkeys; if (valid) valid = kf(kidx, row, bias);
    const int rr = valid ? row : 0;
    rl[lane] = valid ? row : -1;
    float sc[NS];
#pragma unroll
    for (int s = 0; s < NS; ++s) {
      const uint4* kp = (const uint4*)(KV + (size_t)rr * ld + kcol + 64 * s); float d = 0.f;
#pragma unroll
      for (int i = 0; i < 8; ++i) { const uint4 w = kp[i]; const float* q = qs + s * 64 + i * 8;
        d += q[0] * __uint_as_float(w.x << 16) + q[1] * __uint_as_float(w.x & 0xffff0000u) + q[2] * __uint_as_float(w.y << 16) + q[3] * __uint_as_float(w.y & 0xffff0000u)
           + q[4] * __uint_as_float(w.z << 16) + q[5] * __uint_as_float(w.z & 0xffff0000u) + q[6] * __uint_as_float(w.w << 16) + q[7] * __uint_as_float(w.w & 0xffff0000u); }
      sc[s] = valid ? d + bias : -INFINITY;
    }
#pragma unroll
    for (int s = 0; s < NS; ++s) {
      const float cm = wave_max(sc[s]); const float mn = fmaxf(m[s], cm);
      float pv = 0.f, scale = 1.f;
      if (mn > -INFINITY) { pv = __expf(sc[s] - mn); scale = __expf(m[s] - mn); }
      l[s] = l[s] * scale + wave_sum(pv); m[s] = mn;
#pragma unroll
      for (int j = 0; j < VJ; ++j) o[s][j] *= scale;
      pl[s * 64 + lane] = pv;
    }
    __builtin_amdgcn_s_waitcnt(0); __builtin_amdgcn_wave_barrier();
    for (int kk = 0; kk < 64; ++kk) {
      const int rk = rl[kk]; if (rk < 0) continue;
      const bf16_t* vp = KV + (size_t)rk * ld + vcol + lane;
      float vv[VJ];
#pragma unroll
      for (int j = 0; j < VJ; ++j) vv[j] = bf2f(vp[64 * j]);
#pragma unroll
      for (int s = 0; s < NS; ++s) { const float pk = pl[s * 64 + kk];
#pragma unroll
        for (int j = 0; j < VJ; ++j) o[s][j] += pk * vv[j]; }
    }
    __builtin_amdgcn_s_waitcnt(0); __builtin_amdgcn_wave_barrier();
  }
  if (has_sink) {
#pragma unroll
    for (int s = 0; s < NS; ++s) { const float mn = fmaxf(m[s], sink); const float scale = __expf(m[s] - mn);
      l[s] = l[s] * scale + __expf(sink - mn); m[s] = mn;
#pragma unroll
      for (int j = 0; j < VJ; ++j) o[s][j] *= scale; }
  }
}

DEVI void phase_attn0(const Params& p, float* lds) {
  const int tid = ftid(), lane = tid & 63, wave = tid >> 6;
  const int gw = blockIdx.x * NWAVE + wave, NGW = gridDim.x * NWAVE;
  const bf16_t* Q = (const bf16_t*)(p.ws + WS_QKV0); bf16_t* ATT = (bf16_t*)(p.ws + WS_ATT0);
  const float lam = ((const float*)(p.ws + WS_CTL + CTL_LAM))[0];
  float* qs = lds + wave * 128; float* pl = lds + 1024 + wave * 128; int* rl = (int*)(lds + 2048) + wave * 64;
  for (long it = gw; it < (long)NROW * 12; it += NGW) {
    const int row = (int)(it / 12), hs = (int)(it % 12);
    const bool lat = row < NLAT; const int b = lat ? (row >> 12) : ((row - NLAT) >> 8), t = lat ? (row & 4095) : 0;
    __builtin_amdgcn_s_waitcnt(0); __builtin_amdgcn_wave_barrier();
    if (hs < 4) {
      const bf16_t* qp = Q + (size_t)row * N_IN0 + hs * 128;
      qs[lane] = bf2f(qp[lane]) * 0.125f; qs[64 + lane] = bf2f(qp[64 + lane]) * 0.125f;
      __builtin_amdgcn_s_waitcnt(0); __builtin_amdgcn_wave_barrier();
      float o[2][2], m[2], l[2];
      const int nkeys = lat ? SEQ + CTXL : CTXL;
      wave_attn<2, 2>(qs, pl, rl, nkeys, [&](int k, int& r, float& bias) { r = lat ? (k < SEQ ? b * SEQ + k : NLAT + b * CTXL + (k - SEQ)) : NLAT + b * CTXL + k; return true; },
                      Q, N_IN0, 512 + hs * 128, 1024 + hs * 128, 0.f, false, o, m, l, lane);
      float v0 = o[0][0] / l[0] - lam * o[1][0] / l[1], v1 = o[0][1] / l[0] - lam * o[1][1] / l[1];
      const float r = rsqrtf(wave_sum(v0 * v0 + v1 * v1) * (1.f / 128.f) + EPS);
      const float* g = p.in[L0_SUBLN];
      ATT[(size_t)row * DM + hs * 128 + lane] = f2bf(v0 * r * g[lane] * 0.8f);
      ATT[(size_t)row * DM + hs * 128 + 64 + lane] = f2bf(v1 * r * g[64 + lane] * 0.8f);
    } else {
      const int h = hs - 4;
      qs[lane] = bf2f(Q[(size_t)row * N_IN0 + 1536 + h * 64 + lane]) * 0.125f;
      __builtin_amdgcn_s_waitcnt(0); __builtin_amdgcn_wave_barrier();
      float o[1][1], m[1], l[1];
      const int qr = t >> 6, qc = t & 63;
      const int rs = min(max(qr - 4, 0), 56), cs = min(max(qc - 8, 0), 48);
      const float* rpb = p.in[L0_RPB] + h * 15 * 31;
      const int nkeys = lat ? 128 + CTXL : CTXL;
      wave_attn<1, 1>(qs, pl, rl, nkeys, [&](int k, int& r, float& bias) {
          if (!lat) { r = NLAT + b * CTXL + k; return true; }
          if (k < 128) { const int kr = rs + (k >> 4), kc = cs + (k & 15); r = b * SEQ + kr * 64 + kc; bias = rpb[(kr - qr + 7) * 31 + (kc - qc + 15)]; }
          else r = NLAT + b * CTXL + (k - 128);
          return true; },
        Q, N_IN0, 2048 + h * 64, 2560 + h * 64, 0.f, false, o, m, l, lane);
      ATT[(size_t)row * DM + 512 + h * 64 + lane] = f2bf(o[0][0] / l[0]);
    }
  }
}

DEVI void phase_outproj(const Params& p, float* lds, int layer) {
  const bf16_t* A = (const bf16_t*)(p.ws + (layer ? WS_ATT1 : WS_ATT0)); const bf16_t* W = (const bf16_t*)(p.ws + (layer ? WS_WOUT1 : WS_WOUT0));
  bf16_t* MIX = (bf16_t*)(p.ws + (layer ? WS_MIX1 : WS_MIX0));
  const int NTM = (layer ? NLAT : NROW) / 128; constexpr int NTN = DM / 64;
  for (int it = blockIdx.x; it < NTN * NTM; it += gridDim.x) {
    const int mt = it / NTN, nt = it % NTN, m0 = mt * 128;
    gemm_tile(lds, W, nt * 64, DM, [&](int r) { return A + (size_t)(m0 + r) * DM; },
      [&](int r, int n, float* v) { *(uint2*)(MIX + (size_t)(m0 + r) * DM + n) = make_uint2(pk2(v[0], v[1]), pk2(v[2], v[3])); });
  }
}

DEVI void phase_postmix(const Params& p, int layer) {
  const int lane = ftid() & 63, gw = blockIdx.x * NWAVE + (ftid() >> 6), NGW = gridDim.x * NWAVE;
  const float* MOD = (const float*)(p.ws + WS_CTL + CTL_MOD) + (size_t)layer * 9 * 6144;
  const bf16_t* MIX = (const bf16_t*)(p.ws + (layer ? WS_MIX1 : WS_MIX0));
  bf16_t* H = (bf16_t*)(p.ws + WS_H); float* AFF = (float*)(p.ws + WS_AFF); float* XC = (float*)(p.ws + WS_XC);
  const float* gpost = p.in[layer ? L1_GPOSTMIX : L0_GPOSTMIX]; const float* gpre = p.in[layer ? L1_GPREFFN : L0_GPREFFN];
  const float* wr = p.in[layer ? L1_WROUTER : L0_WROUTER];
  const int nrow = layer ? NLAT : NROW;
  for (int r = gw; r < nrow; r += NGW) {
    const float* m = MOD + (size_t)row_modrow(r) * 6144;
    const float* xin = layer ? (p.out + (size_t)r * DM) : (r < NLAT ? p.in[I_X] + (size_t)r * DM : p.in[I_CTX] + (size_t)(r - NLAT) * DM);
    float* xout = r < NLAT ? p.out + (size_t)r * DM : XC + (size_t)(r - NLAT) * DM;
    Row16 o = ld_row_bf16(MIX + (size_t)r * DM, lane);
    const float rr = rsqrtf(row_sumsq(o) * (1.f / DM) + EPS);
    { const Row16 A = ld_row_f32(gpost, lane), Bv = ld_row_f32(m + 2048, lane), Cv = ld_row_f32(xin, lane);
      ROW_FOR4(e = c + b * (e * rr * a)); }
    st_row_f32(xout, lane, o);
    const Row16 h = norm_mod(o, gpre, m + 4096, m + 3072, lane);
    st_row_bf16(H + (size_t)r * DM, lane, h);
    float lg[16];
#pragma unroll
    for (int e = 0; e < 16; ++e) lg[e] = 0.f;
#pragma unroll
    for (int j = 0; j < 4; ++j) {
      const float hv[4] = {h.v[j].x, h.v[j].y, h.v[j].z, h.v[j].w};
#pragma unroll
      for (int q = 0; q < 4; ++q) { const float4* w4 = (const float4*)(wr + (size_t)(lane * 4 + 256 * j + q) * 16);
#pragma unroll
        for (int e4 = 0; e4 < 4; ++e4) { const float4 w = w4[e4]; lg[e4 * 4] += hv[q] * w.x; lg[e4 * 4 + 1] += hv[q] * w.y; lg[e4 * 4 + 2] += hv[q] * w.z; lg[e4 * 4 + 3] += hv[q] * w.w; } }
    }
    float mx = -INFINITY;
#pragma unroll
    for (int e = 0; e < 16; ++e) { lg[e] = wave_sum(lg[e]); mx = fmaxf(mx, lg[e]); }
    float s = 0.f;
#pragma unroll
    for (int e = 0; e < 16; ++e) { lg[e] = expf(lg[e] - mx); s += lg[e]; }
    const float inv = 1.f / s;
    float mine = 0.f;
#pragma unroll
    for (int e = 0; e < 16; ++e) if (lane == e) mine = lg[e] * inv;
    if (lane < 16) AFF[(size_t)lane * NROW + r] = mine;
  }
}

DEVI void phase_topk(const Params& p, float* lds, int layer) {
  const int tid = ftid();
  const float* AFF = (const float*)(p.ws + WS_AFF); int* SLOT = (int*)(p.ws + WS_SLOT); int* IDX = (int*)(p.ws + WS_IDX); float* GV = (float*)(p.ws + WS_GATEV);
  const int erows = layer ? EROWS1 : EROWS0;
  const int nlat_items = NB * NE * 8, nitems = nlat_items + (layer ? 0 : NB * NE);
  for (int it = blockIdx.x; it < nitems; it += gridDim.x) {
    const bool lat = it < nlat_items;
    int b, e, ch, n, cap, row0, slot0;
    if (lat) { b = it / (NE * 8); e = (it / 8) % NE; ch = it % 8; n = SEQ; cap = CAP_L; row0 = b * SEQ; slot0 = b * CAP_L; }
    else { const int i2 = it - nlat_items; b = i2 / NE; e = i2 % NE; ch = 0; n = CTXL; cap = CAP_C; row0 = NLAT + b * CTXL; slot0 = NB * CAP_L + b * CAP_C; }
    __syncthreads();
    for (int i = tid; i < n; i += NT) lds[i] = AFF[(size_t)e * NROW + row0 + i];
    __syncthreads();
    const int t = ch * 512 + tid;
    if (t < n) {
      const float a = lds[t]; int rank = 0;
      for (int j = 0; j < n; ++j) { const float v = lds[j]; rank += (v > a || (v == a && j < t)) ? 1 : 0; }
      if (rank < cap) { IDX[e * erows + slot0 + rank] = row0 + t; GV[e * erows + slot0 + rank] = a; SLOT[(size_t)(row0 + t) * 16 + e] = slot0 + rank; }
      else SLOT[(size_t)(row0 + t) * 16 + e] = -1;
    }
  }
}

DEVI void phase_moe_up(const Params& p, float* lds, int layer) {
  const bf16_t* H = (const bf16_t*)(p.ws + WS_H); const bf16_t* WGU = (const bf16_t*)(p.ws + WS_WGU); bf16_t* HID = (bf16_t*)(p.ws + WS_HID);
  const int* IDX = (const int*)(p.ws + WS_IDX);
  const int erows = layer ? EROWS1 : EROWS0, NTM = erows / 128; constexpr int NTN = 2048 / 64;
  for (int it = blockIdx.x; it < NE * NTM * NTN; it += gridDim.x) {
    const int e = it / (NTM * NTN), r2 = it % (NTM * NTN), mt = r2 / NTN, nt = r2 % NTN, m0 = mt * 128;
    gemm_tile(lds, WGU + (size_t)e * 2048 * DM, nt * 64, DM, [&](int r) { return H + (size_t)IDX[e * erows + m0 + r] * DM; },
      [&](int r, int n, float* v) { *(unsigned*)(HID + ((size_t)e * erows + m0 + r) * DM + (n >> 1)) = pk2(silu_f(v[0]) * v[1], silu_f(v[2]) * v[3]); });
  }
}
DEVI void phase_moe_down(const Params& p, float* lds, int layer) {
  const bf16_t* HID = (const bf16_t*)(p.ws + WS_HID); const bf16_t* WD = (const bf16_t*)(p.ws + WS_WD); bf16_t* Y = (bf16_t*)(p.ws + WS_Y);
  const float* GV = (const float*)(p.ws + WS_GATEV);
  const int erows = layer ? EROWS1 : EROWS0, NTM = erows / 128; constexpr int NTN = DM / 64;
  for (int it = blockIdx.x; it < NE * NTM * NTN; it += gridDim.x) {
    const int e = it / (NTM * NTN), r2 = it % (NTM * NTN), mt = r2 / NTN, nt = r2 % NTN, m0 = mt * 128;
    gemm_tile(lds, WD + (size_t)e * DM * DM, nt * 64, DM, [&](int r) { return HID + ((size_t)e * erows + m0 + r) * DM; },
      [&](int r, int n, float* v) { const float g = GV[e * erows + m0 + r];
        *(uint2*)(Y + ((size_t)e * erows + m0 + r) * DM + n) = make_uint2(pk2(v[0] * g, v[1] * g), pk2(v[2] * g, v[3] * g)); });
  }
}

DEVI void phase_combine(const Params& p, float* lds, int layer) {
  const int lane = ftid() & 63, wave = ftid() >> 6, gw = blockIdx.x * NWAVE + wave, NGW = gridDim.x * NWAVE;
  const float* MOD = (const float*)(p.ws + WS_CTL + CTL_MOD);
  const bf16_t* Y = (const bf16_t*)(p.ws + WS_Y); const int* SLOT = (const int*)(p.ws + WS_SLOT);
  bf16_t* H = (bf16_t*)(p.ws + WS_H); float* XC = (float*)(p.ws + WS_XC);
  const float* gpost = p.in[layer ? L1_GPOSTFFN : L0_GPOSTFFN];
  const int nrow = layer ? NLAT : NROW, erows = layer ? EROWS1 : EROWS0;
  for (int r = gw; r < nrow; r += NGW) {
    const float* m = MOD + (size_t)(layer * 9 + row_modrow(r)) * 6144;
    float* xio = r < NLAT ? p.out + (size_t)r * DM : XC + (size_t)(r - NLAT) * DM;
    Row16 o;
#pragma unroll
    for (int j = 0; j < 4; ++j) o.v[j] = make_float4(0.f, 0.f, 0.f, 0.f);
    for (int e = 0; e < NE; ++e) {
      const int s = SLOT[(size_t)r * 16 + e];
      if (s >= 0) { const Row16 y = ld_row_bf16(Y + ((size_t)e * erows + s) * DM, lane);
#pragma unroll
        for (int j = 0; j < 4; ++j) { o.v[j].x += y.v[j].x; o.v[j].y += y.v[j].y; o.v[j].z += y.v[j].z; o.v[j].w += y.v[j].w; } }
    }
    const float rr = rsqrtf(row_sumsq(o) * (1.f / DM) + EPS);
    { const Row16 A = ld_row_f32(gpost, lane), Bv = ld_row_f32(m + 5120, lane), Cv = ld_row_f32(xio, lane);
      ROW_FOR4(e = c + b * (e * rr * a)); }
    st_row_f32(xio, lane, o);
    if (layer == 0) {
      const float* m1 = MOD + (size_t)(9 + row_modrow(r)) * 6144;
      const Row16 h = norm_mod(o, p.in[L1_GPREMIX], m1 + 1024, m1, lane);
      st_row_bf16(H + (size_t)r * DM, lane, h);
    }
  }
  if (layer == 0) { convert_moe_part(p, 1, 0, lds + wave * (64 * 33), gw, NGW, lane); convert_moe_part(p, 1, 1, lds + wave * (64 * 33), gw, NGW, lane); }
}

DEVI void phase_qkv1(const Params& p, float* lds) {
  const bf16_t* H = (const bf16_t*)(p.ws + WS_H); const bf16_t* W = (const bf16_t*)(p.ws + WS_WIN1);
  bf16_t* P1 = (bf16_t*)(p.ws + WS_P1); float* DT = (float*)(p.ws + WS_DT); const float* ROPE = (const float*)(p.ws + WS_CTL + CTL_ROPE);
  constexpr int NTN = 37, NTM = NROW / 128;
  for (int it = blockIdx.x; it < NTN * NTM; it += gridDim.x) {
    const int mt = it / NTN, nt = it % NTN, m0 = mt * 128;
    gemm_tile(lds, W, nt * 64, DM, [&](int r) { return H + (size_t)(m0 + r) * DM; },
      [&](int r, int n, float* v) {
        const int row = m0 + r;
        if (n >= 2304) { if (n < 2320) *(float4*)(DT + (size_t)row * 16 + (n - 2304)) = make_float4(v[0], v[1], v[2], v[3]); return; }
        if (row < NLAT && n < 640) { const int t = row & 4095; rope_pair(ROPE, t, n & 63, v[0], v[1]); rope_pair(ROPE, t, (n + 2) & 63, v[2], v[3]); }
        *(uint2*)(P1 + (size_t)row * 2304 + n) = make_uint2(pk2(v[0], v[1]), pk2(v[2], v[3]));
      });
  }
}

DEVI void phase_conv_swa(const Params& p, float* lds, bool do_swa) {
  const int tid = ftid(), lane = tid & 63, wave = tid >> 6;
  const int gw = blockIdx.x * NWAVE + wave, NGW = gridDim.x * NWAVE;
  const bf16_t* P1 = (const bf16_t*)(p.ws + WS_P1); bf16_t* U = (bf16_t*)(p.ws + WS_U); bf16_t* ATT = (bf16_t*)(p.ws + WS_ATT1);
  const float* cw = p.in[L1_CONVW]; const float* cb = p.in[L1_CONVB];
  for (long i = (long)blockIdx.x * NT + tid; i < (long)NROW * 1024; i += (long)gridDim.x * NT) {
    const int row = (int)(i >> 10), ch = (int)(i & 1023);
    int s0, len, t; if (row < NLAT) { s0 = row & ~4095; len = SEQ; t = row & 4095; } else { s0 = NLAT + ((row - NLAT) & ~255); len = CTXL; t = (row - NLAT) & 255; }
    float acc = cb[ch];
#pragma unroll
    for (int j = 0; j < 5; ++j) { const int tt = t + j - 2; if (tt >= 0 && tt < len) acc += cw[j * 1024 + ch] * bf2f(P1[(size_t)(s0 + tt) * 2304 + 768 + ch]); }
    U[(size_t)row * 1024 + ch] = f2bf(silu_f(acc));
  }
  if (!do_swa) return;
  float* qs = lds + wave * 128; float* pl = lds + 1024 + wave * 128; int* rl = (int*)(lds + 2048) + wave * 64;
  for (long it = gw; it < (long)NLAT * 8; it += NGW) {
    const int row = (int)(it >> 3), hq = (int)(it & 7), g = hq >> 2, b = row >> 12, t = row & 4095;
    __builtin_amdgcn_s_waitcnt(0); __builtin_amdgcn_wave_barrier();
    qs[lane] = bf2f(P1[(size_t)row * 2304 + hq * 64 + lane]) * 0.125f;
    __builtin_amdgcn_s_waitcnt(0); __builtin_amdgcn_wave_barrier();
    float o[1][1], m[1], l[1];
    wave_attn<1, 1>(qs, pl, rl, 320 + CTXL, [&](int k, int& r, float& bias) {
        if (k < 320) { const int kp = t - 128 + k; if (k > 256 || kp < 0 || kp >= SEQ) return false; r = b * SEQ + kp; return true; }
        r = NLAT + b * CTXL + (k - 320); return true; },
      P1, 2304, 512 + g * 64, 640 + g * 64, p.in[L1_SINKS][hq], true, o, m, l, lane);
    ATT[(size_t)row * DM + hq * 64 + lane] = f2bf(o[0][0] / l[0]);
  }
}

DEVI void phase_ssd(const Params& p, float* lds) {
  const int tid = ftid();
  const bf16_t* U = (const bf16_t*)(p.ws + WS_U); const float* DT = (const float*)(p.ws + WS_DT); float* YS = (float*)(p.ws + WS_YS);
  constexpr int CH = 32;
  float* xb = lds;
  float* bb = lds + CH * 64;
  float* cb = bb + CH * 128;
  float* db = cb + CH * 128;
  float* yb = db + 2 * CH;
  const int pi = tid >> 3, ns = (tid & 7) * 16;
  for (int it = blockIdx.x; it < NB * 8; it += gridDim.x) {
    const int b = it >> 3, hd = it & 7, g = hd >> 2;
    for (int dir = 0; dir < 2; ++dir) {
      const float a = -expf(p.in[dir ? L1_ALOGB : L1_ALOGF][hd]); const float dtb = p.in[dir ? L1_DTBB : L1_DTBF][hd];
      float st[16];
#pragma unroll
      for (int i = 0; i < 16; ++i) st[i] = 0.f;
      for (int seg = 0; seg < 2; ++seg) {
        const int len = seg ? SEQ : CTXL, s0 = seg ? b * SEQ : NLAT + b * CTXL;
        for (int c0 = 0; c0 < len; c0 += CH) {
          __syncthreads();
          for (int i = tid; i < CH * 320; i += NT) {
            const int st_i = i / 320, c = i % 320; const int tk = dir ? (len - 1 - (c0 + st_i)) : (c0 + st_i); const size_t r = (size_t)(s0 + tk);
            if (c < 64) xb[st_i * 64 + c] = bf2f(U[r * 1024 + hd * 64 + c]);
            else if (c < 192) bb[st_i * 128 + (c - 64)] = bf2f(U[r * 1024 + 512 + g * 128 + (c - 64)]);
            else cb[st_i * 128 + (c - 192)] = bf2f(U[r * 1024 + 768 + g * 128 + (c - 192)]);
          }
          if (tid < CH) { const int tk = dir ? (len - 1 - (c0 + tid)) : (c0 + tid); const float raw = DT[(size_t)(s0 + tk) * 16 + dir * 8 + hd] + dtb;
            const float dt = raw > 20.f ? raw : log1pf(expf(raw)); db[tid] = expf(dt * a); db[CH + tid] = dt; }
          __syncthreads();
          for (int i = 0; i < CH; ++i) {
            const float dec = db[i], dx = db[CH + i] * xb[i * 64 + pi]; float y = 0.f;
#pragma unroll
            for (int q = 0; q < 16; ++q) { st[q] = st[q] * dec + dx * bb[i * 128 + ns + q]; y += st[q] * cb[i * 128 + ns + q]; }
            y += __shfl_xor(y, 1); y += __shfl_xor(y, 2); y += __shfl_xor(y, 4);
            if ((tid & 7) == 0) yb[i * 64 + pi] = y;
          }
          __syncthreads();
          if (seg == 1) for (int i = tid; i < CH * 64; i += NT) {
            const int q = i >> 6, c = i & 63; const int tk = (dir ? (len - CH - c0) : c0) + q, st_i = dir ? (CH - 1 - q) : q;
            float* yp = YS + (size_t)(b * SEQ + tk) * 512 + hd * 64 + c;
            if (dir == 0) *yp = yb[st_i * 64 + c]; else *yp = *yp + yb[st_i * 64 + c];
          }
        }
      }
      __syncthreads(); __threadfence();
    }
  }
}

DEVI void phase_ssd_out(const Params& p) {
  const int lane = ftid() & 63, gw = blockIdx.x * NWAVE + (ftid() >> 6), NGW = gridDim.x * NWAVE;
  const bf16_t* U = (const bf16_t*)(p.ws + WS_U); const bf16_t* P1 = (const bf16_t*)(p.ws + WS_P1); const float* YS = (const float*)(p.ws + WS_YS);
  bf16_t* ATT = (bf16_t*)(p.ws + WS_ATT1);
  for (int r = gw; r < NLAT; r += NGW) {
    const int c0 = lane * 8, hd = c0 >> 6; const float dsk = p.in[L1_DSKIP][hd];
    const float4 y0 = *(const float4*)(YS + (size_t)r * 512 + c0), y1 = *(const float4*)(YS + (size_t)r * 512 + c0 + 4);
    const uint4 xw = *(const uint4*)(U + (size_t)r * 1024 + c0), zw = *(const uint4*)(P1 + (size_t)r * 2304 + 1792 + c0);
    float y[8] = {y0.x, y0.y, y0.z, y0.w, y1.x, y1.y, y1.z, y1.w};
    const unsigned xs[4] = {xw.x, xw.y, xw.z, xw.w}, zs[4] = {zw.x, zw.y, zw.z, zw.w};
    float ss = 0.f;
#pragma unroll
    for (int i = 0; i < 4; ++i) {
      const float x0 = __uint_as_float(xs[i] << 16), x1 = __uint_as_float(xs[i] & 0xffff0000u), z0 = __uint_as_float(zs[i] << 16), z1 = __uint_as_float(zs[i] & 0xffff0000u);
      y[2 * i] = (y[2 * i] + dsk * x0) * silu_f(z0); y[2 * i + 1] = (y[2 * i + 1] + dsk * x1) * silu_f(z1);
      ss += y[2 * i] * y[2 * i] + y[2 * i + 1] * y[2 * i + 1];
    }
#pragma unroll
    for (int o = 1; o < 32; o <<= 1) ss += __shfl_xor(ss, o);
    const float rr = rsqrtf(ss * (1.f / 256.f) + EPS);
    const float4 g0 = *(const float4*)(p.in[L1_GNORM] + c0), g1 = *(const float4*)(p.in[L1_GNORM] + c0 + 4);
    uint4 w; w.x = pk2(y[0] * rr * g0.x, y[1] * rr * g0.y); w.y = pk2(y[2] * rr * g0.z, y[3] * rr * g0.w); w.z = pk2(y[4] * rr * g1.x, y[5] * rr * g1.y); w.w = pk2(y[6] * rr * g1.z, y[7] * rr * g1.w);
    *(uint4*)(ATT + (size_t)r * DM + 512 + c0) = w;
  }
}

}
namespace pg8 {
#define PG8_LAS __attribute__((address_space(3)))
typedef unsigned short bf16_t;
typedef short bf16x8 __attribute__((ext_vector_type(8)));
typedef float f32x4 __attribute__((ext_vector_type(4)));
typedef unsigned u32x4 __attribute__((ext_vector_type(4)));
constexpr int BM = 256, BK = 64, HALF = 128, HTB = HALF * BK * 2  , STAGE_BYTES = 8 * HTB, NXCD = 8, WGM = 8;

__host__ __device__ __forceinline__ int lds_byte(int r, int c) { const int st = (r >> 4) * 2 + (c >> 5), rr = r & 15, cc = c & 31, ob = rr * 64 + cc * 2; return st * 1024 + (ob ^ (((ob >> 9) & 1) << 5)); }
__host__ __device__ __forceinline__ void stage_rc(int b, int& R, int& C) { const int st = b / 1024, sb = b % 1024, swz = sb ^ (((sb >> 9) & 1) << 5); R = (st >> 1) * 16 + swz / 64; C = (st & 1) * 32 + (swz % 64) / 2; }
__host__ __device__ __forceinline__ int perm32(int rho) { const int n = rho >> 4, i = rho & 15; return 8 * (i >> 2) + 4 * n + (i & 3); }

struct Unit { int pm, pn; };
struct Gemm { const bf16_t* A; const bf16_t* Bt; int M, N, K; const int* gidx = nullptr; int sw = 0x7f7f7f7f, sa = 0x7f7f7f7f; };

struct StaticOrder {
    int nM, nN, nwg, G, c;
    __host__ __device__ void init(int M, int N, int G_, int c_) { nM = M / BM; nN = N / BM; nwg = nM * nN; G = G_; c = c_; }
    __host__ __device__ bool next(int i, Unit& u) const {
        const long L = (long)i * G + c; if (L >= nwg) return false;
        int wgid = (int)L; { const int q = nwg / NXCD, r = nwg % NXCD, xcd = wgid % NXCD, off = wgid / NXCD; wgid = (xcd < r ? xcd * (q + 1) : r * (q + 1) + (xcd - r) * q) + off; }
        const int nig = WGM * nN, gid = wgid / nig, fm = gid * WGM, gsz = (nM - fm) < WGM ? (nM - fm) : WGM;
        u.pm = fm + ((wgid % nig) % gsz); u.pn = (wgid % nig) / gsz; return true;
    }
    __device__ __forceinline__ void a_ready(const Unit&) const {}
    __device__ __forceinline__ void done(const Unit&) const {}
};

template <class Epi, class Sched, bool ALIGN_EPI = false, bool SP2 = false, bool FP8 = false>
__device__ __forceinline__ void gemm_phase(PG8_LAS unsigned char* lds, const Gemm g, const Sched& S, const Epi& E) {
    const int tid = ftid(), wid = __builtin_amdgcn_readfirstlane(tid >> 6), lane = tid & 63, wr = wid >> 2, wc = wid & 3, fr = lane & 15, fq = lane >> 4;
    const int KB = g.K * (FP8 ? 1 : 2), nt = KB / (BK * 2);
    unsigned voffB[2]; int pR[2], pC[2];
#pragma unroll
    for (int i = 0; i < 2; ++i) { int R, C; stage_rc(tid * 16 + i * 8192, R, C); const int Rb = Epi::PERM ? ((R & ~31) + perm32(R & 31)) : R;
        pR[i] = R; pC[i] = C; voffB[i] = (unsigned)(Rb * KB + C * 2); }
    unsigned cvo[2][2], nvo[2][2];
#define PG8_SETVO(vo, pm_) do { _Pragma("unroll") for (int _h = 0; _h < 2; ++_h) _Pragma("unroll") for (int _i = 0; _i < 2; ++_i) { const int _r = (pm_) * BM + _h * HALF + pR[_i]; \
        const int _g = g.gidx ? g.gidx[_r] : _r; vo[_h][_i] = (unsigned)_g * (unsigned)KB + (unsigned)(pC[_i] * 2); } } while (0)
#define PG8_STAGEA(bufoff, koff, vo) do { _Pragma("unroll") for (int _i = 0; _i < 2; ++_i) \
        __builtin_amdgcn_global_load_lds((const unsigned*)((const char*)g.A + (koff) + (vo)[_i]), (PG8_LAS unsigned*)(lds + (bufoff) + ldsw + _i * 8192), 16, 0, 0); } while (0)
    const size_t kstep = (size_t)(BK * 2);
    const size_t hstep = (size_t)HALF * KB;
    const size_t tstep = 2 * hstep;
    const unsigned ldsw = (unsigned)wid * 1024u;
    const int aoff = lds_byte(wr * 64 + fr, fq * 8), boff = lds_byte(wc * 32 + fr, fq * 8);
#define PG8_SA(b, h) (((b) * 2 + (h)) * HTB)
#define PG8_SB(b, h) ((4 + (b) * 2 + (h)) * HTB)
#define PG8_STAGE(bufoff, gbase, voff) do { _Pragma("unroll") for (int _i = 0; _i < 2; ++_i) \
        __builtin_amdgcn_global_load_lds((const unsigned*)((const char*)(gbase) + (voff)[_i]), (PG8_LAS unsigned*)(lds + (bufoff) + ldsw + _i * 8192), 16, 0, 0); } while (0)
    typedef int v4i_t __attribute__((ext_vector_type(4))); typedef int v8i_t __attribute__((ext_vector_type(8)));
#define PG8_CAT8(x, y) __builtin_shufflevector(__builtin_bit_cast(v4i_t, x), __builtin_bit_cast(v4i_t, y), 0, 1, 2, 3, 4, 5, 6, 7)
#define PG8_LDA(dst, b, h) do { _Pragma("unroll") for (int m = 0; m < 4; ++m) { const bf16x8 f0_ = *(const PG8_LAS bf16x8*)(lds + PG8_SA(b, h) + aoff + m * 2048), f1_ = *(const PG8_LAS bf16x8*)(lds + PG8_SA(b, h) + aoff + m * 2048 + 1024); \
        if constexpr (FP8) dst##8[m] = PG8_CAT8(f0_, f1_); else { dst[m][0] = f0_; dst[m][1] = f1_; } } } while (0)
#define PG8_LDB(dst, b, h) do { _Pragma("unroll") for (int n = 0; n < 2; ++n) { const bf16x8 f0_ = *(const PG8_LAS bf16x8*)(lds + PG8_SB(b, h) + boff + n * 2048), f1_ = *(const PG8_LAS bf16x8*)(lds + PG8_SB(b, h) + boff + n * 2048 + 1024); \
        if constexpr (FP8) dst##8[n] = PG8_CAT8(f0_, f1_); else { dst[n][0] = f0_; dst[n][1] = f1_; } } } while (0)
typedef int v4i_t __attribute__((ext_vector_type(4))); typedef int v8i_t __attribute__((ext_vector_type(8)));
#define PG8_CAT8(x, y) __builtin_shufflevector(__builtin_bit_cast(v4i_t, x), __builtin_bit_cast(v4i_t, y), 0, 1, 2, 3, 4, 5, 6, 7)
#define PG8_MMA(ai, bj, At, Bt) do { __builtin_amdgcn_s_setprio(1); _Pragma("unroll") for (int m = 0; m < 4; ++m) _Pragma("unroll") for (int n = 0; n < 2; ++n) { \
        if constexpr (FP8) asm volatile("v_mfma_scale_f32_16x16x128_f8f6f4 %0, %1, %2, %0, %3, %4 op_sel_hi:[0,0,0]" : "+v"(acc[ai][bj][m][n]) : "v"(Bt##8[n]), "v"(At##8[m]), "v"(sw_), "v"(sa_)); \
        else { _Pragma("unroll") for (int k = 0; k < 2; ++k) acc[ai][bj][m][n] = __builtin_amdgcn_mfma_f32_16x16x32_bf16(Bt[n][k], At[m][k], acc[ai][bj][m][n], 0, 0, 0); } } \
        __builtin_amdgcn_s_setprio(0); } while (0)
#define PG8_WAIT_V(n) asm volatile("s_waitcnt vmcnt(" #n ")" ::: "memory")
#define PG8_WAIT_L(n) asm volatile("s_waitcnt lgkmcnt(" #n ")" ::: "memory")
#define PG8_BAR __builtin_amdgcn_s_barrier()
#define PG8_SCHED __builtin_amdgcn_sched_barrier(0)
    Unit cur, nxt; int ui = 0;
    if (!S.next(0, cur)) return;
    f32x4 acc[2][2][4][2];
#pragma unroll
    for (int a = 0; a < 2; ++a)
#pragma unroll
        for (int b = 0; b < 2; ++b)
#pragma unroll
            for (int m = 0; m < 4; ++m)
#pragma unroll
                for (int n = 0; n < 2; ++n) acc[a][b][m][n] = (f32x4){0.f, 0.f, 0.f, 0.f};
    const int sw_ = g.sw, sa_ = g.sa;
    bf16x8 At[4][2], B0[2][2], B1[2][2]; v8i_t At8[4], B08[2], B18[2];
    PG8_SETVO(cvo, cur.pm); const char* cB = (const char*)g.Bt + (size_t)cur.pn * tstep;
    S.a_ready(cur);
    if constexpr (SP2) {
        PG8_STAGE(PG8_SB(0, 0), cB, voffB); PG8_STAGE(PG8_SB(0, 1), cB + hstep, voffB); PG8_STAGEA(PG8_SA(0, 0), 0, cvo[0]); PG8_STAGEA(PG8_SA(0, 1), 0, cvo[1]);
        if (wr == 1) PG8_BAR;
        PG8_WAIT_V(2); PG8_BAR;
        PG8_STAGE(PG8_SB(1, 0), cB + kstep, voffB); PG8_STAGEA(PG8_SA(1, 0), kstep, cvo[0]); PG8_STAGE(PG8_SB(1, 1), cB + hstep + kstep, voffB);
        PG8_WAIT_V(6); PG8_BAR;
    } else {
        PG8_STAGE(PG8_SB(0, 0), cB, voffB); PG8_STAGEA(PG8_SA(0, 0), 0, cvo[0]); PG8_STAGE(PG8_SB(0, 1), cB + hstep, voffB); PG8_STAGEA(PG8_SA(0, 1), 0, cvo[1]);
        if (wr == 1) PG8_BAR;
        PG8_WAIT_V(4); PG8_BAR;
        PG8_STAGE(PG8_SB(1, 0), cB + kstep, voffB); PG8_STAGEA(PG8_SA(1, 0), kstep, cvo[0]); PG8_STAGE(PG8_SB(1, 1), cB + hstep + kstep, voffB);
        PG8_WAIT_V(6); PG8_BAR;
    }
    for (;;) {
        const bool has_next = S.next(ui + 1, nxt);
        if (has_next) PG8_SETVO(nvo, nxt.pm); else { nvo[0][0] = cvo[0][0]; nvo[0][1] = cvo[0][1]; nvo[1][0] = cvo[1][0]; nvo[1][1] = cvo[1][1]; }
        const char* nB = has_next ? (const char*)g.Bt + (size_t)nxt.pn * tstep : cB;
#pragma unroll 1
        for (int t = 0; t < nt; t += 2) {
            const bool last = (t == nt - 2);
            const size_t k1 = (size_t)(t + 1) * kstep;
            const size_t k2 = last ? 0 : (size_t)(t + 2) * kstep; unsigned v2[2][2];
            v2[0][0] = last ? nvo[0][0] : cvo[0][0]; v2[0][1] = last ? nvo[0][1] : cvo[0][1]; v2[1][0] = last ? nvo[1][0] : cvo[1][0]; v2[1][1] = last ? nvo[1][1] : cvo[1][1];
            const char* b2 = last ? nB : cB + (size_t)(t + 2) * kstep;
            const size_t k3 = k2 + kstep; const char* b3 = b2 + kstep;
            if (last && has_next) S.a_ready(nxt);
            if constexpr (SP2) {
            PG8_LDB(B0, 0, 0); PG8_LDB(B1, 0, 1); PG8_SCHED; PG8_LDA(At, 0, 0); PG8_STAGEA(PG8_SA(1, 1), k1, cvo[1]);
            PG8_WAIT_V(8); PG8_WAIT_L(0); PG8_BAR; PG8_MMA(0, 0, At, B0); PG8_MMA(0, 1, At, B1); PG8_BAR; PG8_SCHED;
            PG8_LDA(At, 0, 1); PG8_STAGE(PG8_SB(0, 0), b2, voffB); PG8_STAGE(PG8_SB(0, 1), b2 + hstep, voffB); PG8_STAGEA(PG8_SA(0, 0), k2, v2[0]);
            PG8_WAIT_V(8); PG8_WAIT_L(0); PG8_BAR; PG8_MMA(1, 0, At, B0); PG8_MMA(1, 1, At, B1); PG8_BAR; PG8_SCHED;
            PG8_LDB(B0, 1, 0); PG8_LDB(B1, 1, 1); PG8_SCHED; PG8_LDA(At, 1, 0); PG8_STAGEA(PG8_SA(0, 1), k2, v2[1]);
            PG8_WAIT_V(8); PG8_WAIT_L(0); PG8_BAR; PG8_MMA(0, 0, At, B0); PG8_MMA(0, 1, At, B1); PG8_BAR; PG8_SCHED;
            PG8_LDA(At, 1, 1); PG8_STAGE(PG8_SB(1, 0), b3, voffB); PG8_STAGE(PG8_SB(1, 1), b3 + hstep, voffB); PG8_STAGEA(PG8_SA(1, 0), k3, v2[0]);
            PG8_WAIT_V(8); PG8_WAIT_L(0); PG8_BAR; PG8_MMA(1, 0, At, B0); PG8_MMA(1, 1, At, B1); PG8_BAR; PG8_SCHED;
            } else {
            PG8_LDB(B0, 0, 0); PG8_SCHED; PG8_LDA(At, 0, 0); PG8_STAGEA(PG8_SA(1, 1), k1, cvo[1]);
            PG8_WAIT_L(8); PG8_BAR; PG8_WAIT_L(0); PG8_MMA(0, 0, At, B0); PG8_BAR; PG8_SCHED;
            PG8_LDB(B1, 0, 1); PG8_STAGE(PG8_SB(0, 0), b2, voffB);
            PG8_BAR; PG8_WAIT_L(0); PG8_MMA(0, 1, At, B1); PG8_BAR;
            PG8_LDA(At, 0, 1); PG8_STAGEA(PG8_SA(0, 0), k2, v2[0]);
            PG8_BAR; PG8_WAIT_L(0); PG8_MMA(1, 0, At, B0); PG8_BAR; PG8_SCHED;
            PG8_STAGE(PG8_SB(0, 1), b2 + hstep, voffB);
            PG8_WAIT_V(6); PG8_BAR; PG8_MMA(1, 1, At, B1); PG8_BAR;
            PG8_LDB(B0, 1, 0); PG8_SCHED; PG8_LDA(At, 1, 0); PG8_STAGEA(PG8_SA(0, 1), k2, v2[1]);
            PG8_WAIT_L(8); PG8_BAR; PG8_WAIT_L(0); PG8_MMA(0, 0, At, B0); PG8_BAR; PG8_SCHED;
            PG8_LDB(B1, 1, 1); PG8_STAGE(PG8_SB(1, 0), b3, voffB);
            PG8_BAR; PG8_WAIT_L(0); PG8_MMA(0, 1, At, B1); PG8_BAR;
            PG8_LDA(At, 1, 1); PG8_STAGEA(PG8_SA(1, 0), k3, v2[0]);
            PG8_BAR; PG8_WAIT_L(0); PG8_MMA(1, 0, At, B0); PG8_BAR; PG8_SCHED;
            PG8_STAGE(PG8_SB(1, 1), b3 + hstep, voffB);
            PG8_WAIT_V(6); PG8_BAR; PG8_MMA(1, 1, At, B1); PG8_BAR;
            }
        }
        if constexpr (ALIGN_EPI) { if (wr == 0) PG8_BAR; }
        if constexpr (FP8) asm volatile("s_nop 15\n\ts_nop 15" ::: "memory");
        if constexpr (!Epi::AFTER_DRAIN) { E(acc, cur, wr, wc, fr, fq); S.done(cur); }
        if (!has_next) break;
#pragma unroll
        for (int a = 0; a < 2; ++a)
#pragma unroll
            for (int b = 0; b < 2; ++b)
#pragma unroll
                for (int m = 0; m < 4; ++m)
#pragma unroll
                    for (int n = 0; n < 2; ++n) acc[a][b][m][n] = (f32x4){0.f, 0.f, 0.f, 0.f};
        cur = nxt; cvo[0][0] = nvo[0][0]; cvo[0][1] = nvo[0][1]; cvo[1][0] = nvo[1][0]; cvo[1][1] = nvo[1][1]; cB = nB; ++ui;
        if constexpr (ALIGN_EPI) { if (wr == 1) PG8_BAR; }
    }
    PG8_WAIT_V(0);
    if constexpr (!ALIGN_EPI) { if (wr == 0) PG8_BAR; }
    PG8_BAR;
    if constexpr (Epi::AFTER_DRAIN) { E.fused(acc, cur, wr, wc, fr, fq, lds, wid, lane); S.done(cur); }
#undef PG8_SA
#undef PG8_SB
#undef PG8_STAGE
#undef PG8_STAGEA
#undef PG8_SETVO
#undef PG8_LDA
#undef PG8_LDB
#undef PG8_MMA
#undef PG8_CAT8
#undef PG8_WAIT_V
#undef PG8_WAIT_L
#undef PG8_BAR
#undef PG8_SCHED
}
}
#ifndef FP8_SP2
#define FP8_SP2 true
#endif
#ifndef ATTNA_FP8
#define ATTNA_FP8 1
#endif
namespace fg {
using pg8::f32x4; using pg8::Unit;
typedef unsigned u32x4 __attribute__((ext_vector_type(4)));
typedef unsigned u32x2 __attribute__((ext_vector_type(2)));
DEVI unsigned cvtpk(float lo, float hi) { typedef float f2_t __attribute__((ext_vector_type(2))); typedef __bf16 b2_t __attribute__((ext_vector_type(2))); const f2_t v = {lo, hi}; const b2_t b = __builtin_convertvector(v, b2_t); return __builtin_bit_cast(unsigned, b); }
template <class TP> DEVI void rope8(TP ROPE, int t, int d0, f32x4& v0, f32x4& v1) {
  const int i0 = d0 >> 1, f0 = i0 & 15, pos = (i0 < 16) ? (t >> 6) : (t & 63);
  const f32x4 r0 = *(const PG8_LAS f32x4*)(ROPE + (pos * 16 + f0) * 2), r1 = *(const PG8_LAS f32x4*)(ROPE + (pos * 16 + f0) * 2 + 4);
  const f32x4 a = v0, b = v1;
  v0[0] = a[0] * r0[0] - a[1] * r0[1]; v0[1] = a[0] * r0[1] + a[1] * r0[0]; v0[2] = a[2] * r0[2] - a[3] * r0[3]; v0[3] = a[2] * r0[3] + a[3] * r0[2];
  v1[0] = b[0] * r1[0] - b[1] * r1[1]; v1[1] = b[0] * r1[1] + b[1] * r1[0]; v1[2] = b[2] * r1[2] - b[3] * r1[3]; v1[3] = b[2] * r1[3] + b[3] * r1[2];
}
#define EPI_LOOP_BEGIN const int row0 = u.pm * 256 + wr * 64 + fr; \
  _Pragma("unroll") for (int ai = 0; ai < 2; ++ai) _Pragma("unroll") for (int m = 0; m < 4; ++m) { const int row = row0 + ai * 128 + m * 16; \
  _Pragma("unroll") for (int bj = 0; bj < 2; ++bj) { f32x4 v0 = acc[ai][bj][m][0], v1 = acc[ai][bj][m][1]; const int cl = bj * 128 + wc * 32 + 8 * fq;
#define EPI_LOOP_END } }

struct EpiQKV0 { static constexpr bool PERM = true, AFTER_DRAIN = false; bf16_t* O; const PG8_LAS float* ROPE; unsigned char* VT; unsigned char* VTB;
  DEVI void operator()(const f32x4 (&acc)[2][2][4][2], const Unit& u, int wr, int wc, int fr, int fq) const {
    const int colt = u.pn * 256; const bool rope = (u.pm < NLAT / 256) && (colt < 1024);
    EPI_LOOP_BEGIN
      const int col = colt + cl;
      if (ATTNA_FP8 && colt >= 1024 && colt < 1536) {
        const int hh = (col - 1024) >> 7, dv0 = (col - 1024) & 127;
        int bb, t; if (row < NLAT) { bb = row >> 12; t = row & 4095; } else { bb = (row - NLAT) >> 8; t = 4096 + ((row - NLAT) & 255); }
        const int k = t & 31, gq = k >> 3, wq = k & 7, pos = (wq < 4) ? gq * 4 + wq : 16 + gq * 4 + (wq - 4);
        unsigned char* vp = VT + (size_t)((bb * 4 + hh) * 128 + dv0) * 4352 + (t & ~31) + pos;
        const unsigned w0 = nv::pack4_fp8(v0[0] * 4.f, v0[1] * 4.f, v0[2] * 4.f, v0[3] * 4.f), w1 = nv::pack4_fp8(v1[0] * 4.f, v1[1] * 4.f, v1[2] * 4.f, v1[3] * 4.f);
        vp[0 * 4352] = (unsigned char)w0; vp[1 * 4352] = (unsigned char)(w0 >> 8); vp[2 * 4352] = (unsigned char)(w0 >> 16); vp[3 * 4352] = (unsigned char)(w0 >> 24);
        vp[4 * 4352] = (unsigned char)w1; vp[5 * 4352] = (unsigned char)(w1 >> 8); vp[6 * 4352] = (unsigned char)(w1 >> 16); vp[7 * 4352] = (unsigned char)(w1 >> 24);
        continue;
      }
      if (ATTNA_FP8 && colt >= 2560) {
        const int hh = (col - 2560) >> 6, dv0 = (col - 2560) & 63;
        int bb, t; if (row < NLAT) { bb = row >> 12; t = row & 4095; } else { bb = (row - NLAT) >> 8; t = 4096 + ((row - NLAT) & 255); }
        const int k = t & 31, gq = k >> 3, wq = k & 7, pos = (wq < 4) ? gq * 4 + wq : 16 + gq * 4 + (wq - 4);
        unsigned char* vp = VTB + (size_t)((bb * 8 + hh) * 64 + dv0) * 4352 + (t & ~31) + pos;
        const unsigned w0 = nv::pack4_fp8(v0[0] * 4.f, v0[1] * 4.f, v0[2] * 4.f, v0[3] * 4.f), w1 = nv::pack4_fp8(v1[0] * 4.f, v1[1] * 4.f, v1[2] * 4.f, v1[3] * 4.f);
        vp[0 * 4352] = (unsigned char)w0; vp[1 * 4352] = (unsigned char)(w0 >> 8); vp[2 * 4352] = (unsigned char)(w0 >> 16); vp[3 * 4352] = (unsigned char)(w0 >> 24);
        vp[4 * 4352] = (unsigned char)w1; vp[5 * 4352] = (unsigned char)(w1 >> 8); vp[6 * 4352] = (unsigned char)(w1 >> 16); vp[7 * 4352] = (unsigned char)(w1 >> 24);
        continue;
      }
      if (rope) rope8(ROPE, row & 4095, col & 63, v0, v1);
      if (ATTNA_FP8 && (colt < 1024 || colt >= 1536)) {
        const float sc = (colt < 512 || (colt >= 1536 && colt < 2048)) ? 16.f * 0.125f * 1.4426950408889634f : 4.f;
        u32x2 w8; w8.x = nv::pack4_fp8(v0[0] * sc, v0[1] * sc, v0[2] * sc, v0[3] * sc); w8.y = nv::pack4_fp8(v1[0] * sc, v1[1] * sc, v1[2] * sc, v1[3] * sc);
        *(u32x2*)((unsigned char*)O + (size_t)row * (N_IN0 * 2) + col) = w8;
        continue;
      }
      u32x4 w; w.x = cvtpk(v0[0], v0[1]); w.y = cvtpk(v0[2], v0[3]); w.z = cvtpk(v1[0], v1[1]); w.w = cvtpk(v1[2], v1[3]);
      *(u32x4*)(O + (size_t)row * N_IN0 + col) = w;
    EPI_LOOP_END
  } };
struct EpiQKV1 { static constexpr bool PERM = true, AFTER_DRAIN = false; bf16_t* O; float* DT; const PG8_LAS float* ROPE;
  DEVI void operator()(const f32x4 (&acc)[2][2][4][2], const Unit& u, int wr, int wc, int fr, int fq) const {
    const int colt = u.pn * 256; const bool lat = (u.pm < NLAT / 256);
    EPI_LOOP_BEGIN
      const int col = colt + cl;
      if (col >= 2304) { if (col < 2320) { *(f32x4*)(DT + (size_t)row * 16 + (col - 2304)) = v0; *(f32x4*)(DT + (size_t)row * 16 + (col - 2304) + 4) = v1; } }
      else {
        if (lat && col < 640) rope8(ROPE, row & 4095, col & 63, v0, v1);
        u32x4 w; w.x = cvtpk(v0[0], v0[1]); w.y = cvtpk(v0[2], v0[3]); w.z = cvtpk(v1[0], v1[1]); w.w = cvtpk(v1[2], v1[3]);
        *(u32x4*)(O + (size_t)row * 2304 + col) = w;
      }
    EPI_LOOP_END
  } };
struct EpiPlain { static constexpr bool PERM = true, AFTER_DRAIN = false; bf16_t* O;
  DEVI void operator()(const f32x4 (&acc)[2][2][4][2], const Unit& u, int wr, int wc, int fr, int fq) const {
    const int colt = u.pn * 256;
    EPI_LOOP_BEGIN
      u32x4 w; w.x = cvtpk(v0[0], v0[1]); w.y = cvtpk(v0[2], v0[3]); w.z = cvtpk(v1[0], v1[1]); w.w = cvtpk(v1[2], v1[3]);
      *(u32x4*)(O + (size_t)row * DM + colt + cl) = w;
    EPI_LOOP_END
  } };
DEVI float silu_fast(float v) { return v * __builtin_amdgcn_rcpf(1.f + __expf(-v)); }
struct EpiSwiGLU { static constexpr bool PERM = true, AFTER_DRAIN = false; bf16_t* O;
  DEVI void operator()(const f32x4 (&acc)[2][2][4][2], const Unit& u, int wr, int wc, int fr, int fq) const {
    const int colt = (u.pn & 7) * 256;
    EPI_LOOP_BEGIN
      u32x2 w; w.x = cvtpk(silu_fast(v0[0]) * v0[1], silu_fast(v0[2]) * v0[3]); w.y = cvtpk(silu_fast(v1[0]) * v1[1], silu_fast(v1[2]) * v1[3]);
      *(u32x2*)(O + (size_t)row * DM + ((colt + cl) >> 1)) = w;
    EPI_LOOP_END
  } };
struct EpiSwiGLU8 { static constexpr bool PERM = true, AFTER_DRAIN = false; unsigned char* O;
  DEVI void operator()(const f32x4 (&acc)[2][2][4][2], const Unit& u, int wr, int wc, int fr, int fq) const {
    const int colt = (u.pn & 7) * 256;
    EPI_LOOP_BEGIN
      const unsigned w = nv::pack4_fp8(silu_fast(v0[0]) * v0[1] * nv::A8_SCALE, silu_fast(v0[2]) * v0[3] * nv::A8_SCALE, silu_fast(v1[0]) * v1[1] * nv::A8_SCALE, silu_fast(v1[2]) * v1[3] * nv::A8_SCALE);
      *(unsigned*)(O + (size_t)row * DM + ((colt + cl) >> 1)) = w;
    EPI_LOOP_END
  } };
struct EpiDown { static constexpr bool PERM = true, AFTER_DRAIN = false; bf16_t* O;
  DEVI void operator()(const f32x4 (&acc)[2][2][4][2], const Unit& u, int wr, int wc, int fr, int fq) const {
    const int colt = (u.pn & 3) * 256;
    EPI_LOOP_BEGIN
      u32x4 w; w.x = cvtpk(v0[0], v0[1]); w.y = cvtpk(v0[2], v0[3]); w.z = cvtpk(v1[0], v1[1]); w.w = cvtpk(v1[2], v1[3]);
      *(u32x4*)(O + (size_t)row * DM + colt + cl) = w;
    EPI_LOOP_END
  } };
struct ExpOrder : pg8::StaticOrder { int nMe, nNe;
  __device__ void init2(int erows, int Ne, int G_, int c_) { nMe = erows / 256; nNe = Ne / 256; init(NE * erows, Ne, G_, c_); }
  __device__ bool next(int i, Unit& u) const { if (!pg8::StaticOrder::next(i, u)) return false; u.pn += (u.pm / nMe) * nNe; return true; } };

typedef PG8_LAS unsigned char* ldsp_t;
DEVI void phase_qkv0(const Params& p, ldsp_t lds) {
  pg8::Gemm g{(const bf16_t*)(p.ws + WS_H), (const bf16_t*)(p.ws + WS_WIN0), NROW, N_IN0, DM, nullptr, nv::W8_E8M0, nv::A8_E8M0}; pg8::StaticOrder S; S.init(NROW, N_IN0, gridDim.x, blockIdx.x);
  PG8_LAS float* RL = (PG8_LAS float*)(lds + pg8::STAGE_BYTES);
  for (int i = ftid(); i < 64 * 16 * 2; i += NT) RL[i] = ((const float*)(p.ws + WS_CTL + CTL_ROPE))[i];
  __syncthreads();
  EpiQKV0 E{(bf16_t*)(p.ws + WS_QKV0), RL, (unsigned char*)(p.ws + WS_VT), (unsigned char*)(p.ws + WS_VTB)};
  pg8::gemm_phase<EpiQKV0, pg8::StaticOrder, true, true, (QKV0_FP8 != 0)>(lds, g, S, E);
}
DEVI void phase_qkv1(const Params& p, ldsp_t lds) {
  pg8::Gemm g{(const bf16_t*)(p.ws + WS_H), (const bf16_t*)(p.ws + WS_WIN1), NROW, N_IN1P, DM, nullptr, nv::W8_E8M0, nv::A8_E8M0}; pg8::StaticOrder S; S.init(NROW, N_IN1P, gridDim.x, blockIdx.x);
  PG8_LAS float* RL = (PG8_LAS float*)(lds + pg8::STAGE_BYTES);
  for (int i = ftid(); i < 64 * 16 * 2; i += NT) RL[i] = ((const float*)(p.ws + WS_CTL + CTL_ROPE))[i];
  __syncthreads();
  EpiQKV1 E{(bf16_t*)(p.ws + WS_P1), (float*)(p.ws + WS_DT), RL};
  pg8::gemm_phase<EpiQKV1, pg8::StaticOrder, true, true, (QKV1_FP8 != 0)>(lds, g, S, E);
}
DEVI void phase_outproj(const Params& p, ldsp_t lds, int layer) {
  const int M = layer ? NLAT : NROW;
  pg8::Gemm g{(const bf16_t*)(p.ws + (layer ? WS_ATT1 : WS_ATT0)), (const bf16_t*)(p.ws + (layer ? WS_WOUT1 : WS_WOUT0)), M, DM, DM, nullptr, nv::W8_E8M0, nv::A8_E8M0}; pg8::StaticOrder S; S.init(M, DM, gridDim.x, blockIdx.x);
  EpiPlain E{(bf16_t*)(p.ws + (layer ? WS_MIX1 : WS_MIX0))};
  pg8::gemm_phase<EpiPlain, pg8::StaticOrder, true, true, (OUT_FP8 != 0)>(lds, g, S, E);
}
DEVI void phase_moe_up(const Params& p, ldsp_t lds, int layer) {
  const int erows = layer ? EROWS1 : EROWS0;
  pg8::Gemm g{(const bf16_t*)(p.ws + WS_H), (const bf16_t*)(p.ws + WS_WGU), NE * erows, 2048, DM, (const int*)(p.ws + WS_IDX)}; ExpOrder S; S.init2(erows, 2048, gridDim.x, blockIdx.x);
  EpiSwiGLU E{(bf16_t*)(p.ws + WS_HID)};
  pg8::gemm_phase<EpiSwiGLU, ExpOrder, true, true>(lds, g, S, E);
}
DEVI void phase_moe_down(const Params& p, ldsp_t lds, int layer) {
  const int erows = layer ? EROWS1 : EROWS0;
  pg8::Gemm g{(const bf16_t*)(p.ws + WS_HID), (const bf16_t*)(p.ws + WS_WD), NE * erows, DM, DM}; ExpOrder S; S.init2(erows, DM, gridDim.x, blockIdx.x);
  EpiDown E{(bf16_t*)(p.ws + WS_Y)};
  pg8::gemm_phase<EpiDown, ExpOrder, true, true>(lds, g, S, E);
}
DEVI void phase_moe_up8(const Params& p, ldsp_t lds, int layer) {
  const int erows = layer ? EROWS1 : EROWS0;
  pg8::Gemm g{(const bf16_t*)(p.ws + WS_H), (const bf16_t*)(p.ws + WS_WGU), NE * erows, 2048, DM, (const int*)(p.ws + WS_IDX), nv::W8_E8M0, nv::A8_E8M0}; ExpOrder S; S.init2(erows, 2048, gridDim.x, blockIdx.x);
  EpiSwiGLU8 E{(unsigned char*)(p.ws + WS_HID)};
  pg8::gemm_phase<EpiSwiGLU8, ExpOrder, true, FP8_SP2, true>(lds, g, S, E);
}
DEVI void phase_moe_down8(const Params& p, ldsp_t lds, int layer) {
  const int erows = layer ? EROWS1 : EROWS0;
  pg8::Gemm g{(const bf16_t*)(p.ws + WS_HID), (const bf16_t*)(p.ws + WS_WD), NE * erows, DM, DM, nullptr, nv::W8_E8M0, nv::A8_E8M0}; ExpOrder S; S.init2(erows, DM, gridDim.x, blockIdx.x);
  EpiDown E{(bf16_t*)(p.ws + WS_Y)};
  pg8::gemm_phase<EpiDown, ExpOrder, true, FP8_SP2, true>(lds, g, S, E);
}
DEVI void phase_gather(const Params& p, int layer) {
  const int lane = ftid() & 63, gw = blockIdx.x * NWAVE + (ftid() >> 6), NGW = gridDim.x * NWAVE;
  const int erows = layer ? EROWS1 : EROWS0; const int* IDX = (const int*)(p.ws + WS_IDX);
  const bf16_t* H = (const bf16_t*)(p.ws + WS_H); bf16_t* XG = (bf16_t*)(p.ws + WS_XG);
  for (int r = gw; r < NE * erows; r += NGW) {
    const uint4* s = (const uint4*)(H + (size_t)IDX[r] * DM) + lane; uint4* d = (uint4*)(XG + (size_t)r * DM) + lane;
    const uint4 a = s[0], b = s[64]; d[0] = a; d[64] = b;
  }
}
}
#ifndef ATTNA_FP8
#define ATTNA_FP8 1
#endif
namespace fa {
#define FA_LAS __attribute__((address_space(3)))
typedef short bf16x8 __attribute__((ext_vector_type(8)));
typedef short s16x4 __attribute__((ext_vector_type(4)));
typedef float f32x16 __attribute__((ext_vector_type(16)));
typedef FA_LAS unsigned char* ldsp_t;
typedef unsigned u32x4 __attribute__((ext_vector_type(4)));
constexpr float LOG2E = 1.4426950408889634f, C2 = 0.125f * LOG2E;
DEVI int crow(int r, int hi) { return (r & 3) + 8 * (r >> 2) + 4 * hi; }
DEVI unsigned cvtpk(float lo, float hi) { typedef float f2_t __attribute__((ext_vector_type(2))); typedef __bf16 b2_t __attribute__((ext_vector_type(2))); const f2_t v = {lo, hi}; const b2_t b = __builtin_convertvector(v, b2_t); return __builtin_bit_cast(unsigned, b); }
DEVI s16x4 vtr(ldsp_t p) { return __builtin_bit_cast(s16x4, __builtin_amdgcn_ds_read_tr16_b64_v4i16((FA_LAS s16x4*)p)); }

DEVI float max3f(float a, float b, float c) { float r; asm("v_max3_f32 %0, %1, %2, %3" : "=v"(r) : "v"(a), "v"(b), "v"(c)); return r; }
template <int KW, int DVB> struct Geo {
  static constexpr int VW = DVB * 32;
  static constexpr int KSTR = KW * 2 + 16, VSTR = VW * 2 + 64;
  static constexpr int KBYTES = 64 * KSTR, VBYTES = 64 * VSTR, STAGE = KBYTES + VBYTES;
  static constexpr int CPR = (KW + VW) / 8, NCH = 64 * CPR / NT;
};

DEVI bf16x8 load_q8(const bf16_t* p, float sc) {
  const uint4 w = *(const uint4*)p; const unsigned u[4] = {w.x, w.y, w.z, w.w}; unsigned o[4];
#pragma unroll
  for (int i = 0; i < 4; ++i) o[i] = cvtpk(__uint_as_float(u[i] << 16) * sc, __uint_as_float(u[i] & 0xffff0000u) * sc);
  uint4 r = make_uint4(o[0], o[1], o[2], o[3]); return __builtin_bit_cast(bf16x8, r);
}

template <int KW, int DVB, class Src, class Act, class Msk>
DEVI void flash_pass(ldsp_t lds, int ntiles, const bf16_t* kv, int ld, int kcol, int vcol, const bf16x8 (&q)[4], int kofs,
                     Src src, Act act, Msk msk, f32x16 (&o)[DVB], float& m, float& l) {
  typedef Geo<KW, DVB> G;
  const int tid = ftid(), lane = tid & 63, r32 = lane & 31, hi = lane >> 5;
  u32x4 stg[G::NCH];
  int crw[G::NCH], ccol[G::NCH], cdst[G::NCH];
#pragma unroll
  for (int i = 0; i < G::NCH; ++i) { const int c = tid + NT * i, row = c / G::CPR, cc = c % G::CPR; crw[i] = row;
    if (cc < KW / 8) { ccol[i] = kcol + cc * 8; cdst[i] = row * G::KSTR + cc * 16; } else { ccol[i] = vcol + (cc - KW / 8) * 8; cdst[i] = G::KBYTES + row * G::VSTR + (cc - KW / 8) * 16; } }
#pragma unroll
  for (int i = 0; i < G::NCH; ++i) stg[i] = *(const u32x4*)(kv + (size_t)src(0, crw[i]) * ld + ccol[i]);
#pragma unroll
  for (int i = 0; i < G::NCH; ++i) *(FA_LAS u32x4*)(lds + cdst[i]) = stg[i];
  __syncthreads();
  const int kroff = r32 * G::KSTR + (kofs + 8 * hi) * 2;
  const int vroff = G::KBYTES + (4 * hi + ((lane & 15) >> 2)) * G::VSTR + 32 * ((lane >> 4) & 1) + 8 * (lane & 3);
  for (int kt = 0; kt < ntiles; ++kt) {
    const int buf = (kt & 1) * G::STAGE;
    const bool more = kt + 1 < ntiles;
    if (more) {
#pragma unroll
      for (int i = 0; i < G::NCH; ++i) stg[i] = *(const u32x4*)(kv + (size_t)src(kt + 1, crw[i]) * ld + ccol[i]);
    }
    if (act(kt)) {
      const ldsp_t kb = lds + buf + kroff;
      f32x16 p0, p1;
#pragma unroll
      for (int r = 0; r < 16; ++r) { p0[r] = 0.f; p1[r] = 0.f; }
#pragma unroll
      for (int d0 = 0; d0 < 4; ++d0) {
        const bf16x8 a0 = *(const FA_LAS bf16x8*)(kb + d0 * 32), a1 = *(const FA_LAS bf16x8*)(kb + 32 * G::KSTR + d0 * 32);
        p0 = __builtin_amdgcn_mfma_f32_32x32x16_bf16(a0, q[d0], p0, 0, 0, 0);
        p1 = __builtin_amdgcn_mfma_f32_32x32x16_bf16(a1, q[d0], p1, 0, 0, 0);
      }
      msk(kt, p0, p1);
      float mx = fmaxf(p0[0], p1[0]);
#pragma unroll
      for (int r = 1; r < 16; ++r) mx = fmaxf(mx, fmaxf(p0[r], p1[r]));
      mx = fmaxf(mx, __shfl_xor(mx, 32));
      if (__any(mx > m)) {
        const float mn = fmaxf(m, mx), alpha = __builtin_amdgcn_exp2f(m - mn);
        l *= alpha; m = mn;
#pragma unroll
        for (int b = 0; b < DVB; ++b)
#pragma unroll
          for (int r = 0; r < 16; ++r) o[b][r] *= alpha;
      }
      float ls = 0.f;
#pragma unroll
      for (int r = 0; r < 16; ++r) { p0[r] = __builtin_amdgcn_exp2f(p0[r] - m); p1[r] = __builtin_amdgcn_exp2f(p1[r] - m); ls += p0[r] + p1[r]; }
      l += ls;
      bf16x8 pa[4];
      { uint4 t;
        t = make_uint4(cvtpk(p0[0], p0[1]), cvtpk(p0[2], p0[3]), cvtpk(p0[4], p0[5]), cvtpk(p0[6], p0[7])); pa[0] = __builtin_bit_cast(bf16x8, t);
        t = make_uint4(cvtpk(p0[8], p0[9]), cvtpk(p0[10], p0[11]), cvtpk(p0[12], p0[13]), cvtpk(p0[14], p0[15])); pa[1] = __builtin_bit_cast(bf16x8, t);
        t = make_uint4(cvtpk(p1[0], p1[1]), cvtpk(p1[2], p1[3]), cvtpk(p1[4], p1[5]), cvtpk(p1[6], p1[7])); pa[2] = __builtin_bit_cast(bf16x8, t);
        t = make_uint4(cvtpk(p1[8], p1[9]), cvtpk(p1[10], p1[11]), cvtpk(p1[12], p1[13]), cvtpk(p1[14], p1[15])); pa[3] = __builtin_bit_cast(bf16x8, t); }
      const ldsp_t vb = lds + buf + vroff;
#pragma unroll
      for (int b = 0; b < DVB; ++b)
#pragma unroll
        for (int ks = 0; ks < 4; ++ks) {
          const s16x4 lo = vtr(vb + (16 * ks) * G::VSTR + b * 64), h8 = vtr(vb + (16 * ks + 8) * G::VSTR + b * 64);
          const bf16x8 vf = {lo[0], lo[1], lo[2], lo[3], h8[0], h8[1], h8[2], h8[3]};
          o[b] = __builtin_amdgcn_mfma_f32_32x32x16_bf16(vf, pa[ks], o[b], 0, 0, 0);
        }
    }
    if (more) {
      const int nb = ((kt + 1) & 1) * G::STAGE;
#pragma unroll
      for (int i = 0; i < G::NCH; ++i) *(FA_LAS u32x4*)(lds + nb + cdst[i]) = stg[i];
    }
    __syncthreads();
  }
}


template <int V> struct IC { static constexpr int value = V; };
template <int KW, int DVB, int ABL, int PF, class Src, class Msk>
DEVI void flash_pass2(ldsp_t lds, int ntiles, const bf16_t* kv, int ld, int kcol, int vcol, const bf16x8 (&q)[4], int kofs,
                      Src src, Msk msk, f32x16 (&o)[DVB], float& m, float& l) {
  typedef Geo<KW, DVB> G;
  const int tid = ftid(), lane = tid & 63, r32 = lane & 31, hi = lane >> 5;
  u32x4 stg[PF][G::NCH];
  int crw[G::NCH], ccol[G::NCH], cdst[G::NCH];
#pragma unroll
  for (int i = 0; i < G::NCH; ++i) { const int c = tid + NT * i, row = c / G::CPR, cc = c % G::CPR; crw[i] = row;
    if (cc < KW / 8) { ccol[i] = kcol + cc * 8; cdst[i] = row * G::KSTR + cc * 16; } else { ccol[i] = vcol + (cc - KW / 8) * 8; cdst[i] = G::KBYTES + row * G::VSTR + (cc - KW / 8) * 16; } }
#define FP2_LOAD(kt, set) _Pragma("unroll") for (int i = 0; i < G::NCH; ++i) stg[set][i] = *(const u32x4*)(kv + (size_t)src((kt), crw[i]) * ld + ccol[i])
#define FP2_STORE(st, set) _Pragma("unroll") for (int i = 0; i < G::NCH; ++i) *(FA_LAS u32x4*)(lds + (st) * G::STAGE + cdst[i]) = stg[set][i]
  FP2_LOAD(0, 0); FP2_STORE(0, 0);
  if (ntiles > 1) { FP2_LOAD(1, 0); FP2_STORE(1, 0); }
  __syncthreads();
  if (ntiles > 2) FP2_LOAD(2, 0);
  if (PF == 2) { if (ntiles > 3) FP2_LOAD(3, PF - 1); }
  const int kroff = r32 * G::KSTR + (kofs + 8 * hi) * 2;
  const int vroff = G::KBYTES + (4 * hi + ((lane & 15) >> 2)) * G::VSTR + 32 * ((lane >> 4) & 1) + 8 * (lane & 3);
  f32x16 c0, c1;
#pragma unroll
  for (int r = 0; r < 16; ++r) { c0[r] = 0.f; c1[r] = 0.f; }
  { const ldsp_t kb = lds + kroff;
#pragma unroll
    for (int d0 = 0; d0 < 4; ++d0) {
      const bf16x8 a0 = *(const FA_LAS bf16x8*)(kb + d0 * 32), a1 = *(const FA_LAS bf16x8*)(kb + 32 * G::KSTR + d0 * 32);
      c0 = __builtin_amdgcn_mfma_f32_32x32x16_bf16(a0, q[d0], c0, 0, 0, 0); c1 = __builtin_amdgcn_mfma_f32_32x32x16_bf16(a1, q[d0], c1, 0, 0, 0); } }
  asm volatile("s_nop 15\n\ts_nop 7" : "+v"(c0), "+v"(c1));
  int st_cur = 0, st_nxt = 1, st_fill = 2;
  auto body = [&](int kt, auto PARC) {
    constexpr int set = (PF == 2) ? decltype(PARC)::value : 0;
    msk(kt, c0, c1);
    __builtin_amdgcn_sched_barrier(0);
    f32x16 n0, n1;
#pragma unroll
    for (int r = 0; r < 16; ++r) { n0[r] = 0.f; n1[r] = 0.f; }
    const ldsp_t kb = lds + st_nxt * G::STAGE + kroff;
    bf16x8 ka[4], kb2[4];
#pragma unroll
    for (int d0 = 0; d0 < 4; ++d0) { ka[d0] = *(const FA_LAS bf16x8*)(kb + d0 * 32); kb2[d0] = *(const FA_LAS bf16x8*)(kb + 32 * G::KSTR + d0 * 32); }
#define FP2_SB() __builtin_amdgcn_sched_barrier(0)
#define FP2_MMA(acc, kf, d0) acc = __builtin_amdgcn_mfma_f32_32x32x16_bf16(kf[d0], q[d0], acc, 0, 0, 0)
#define FP2_EXP(cx, r) { if (ABL != 1) { cx[r] = __builtin_amdgcn_exp2f(cx[r] - mn); ls += cx[r]; } }
    FP2_SB(); FP2_MMA(n0, ka, 0);
    float mxa = max3f(c0[0], c0[1], c1[0]), mxb = max3f(c0[2], c0[3], c1[1]);
    mxa = max3f(mxa, c1[2], c1[3]);
    mxa = max3f(mxa, c0[4], c0[5]); mxb = max3f(mxb, c0[6], c0[7]); mxa = max3f(mxa, c1[4], c1[5]); mxb = max3f(mxb, c1[6], c1[7]);
    FP2_SB(); FP2_MMA(n1, kb2, 0);
    mxa = max3f(mxa, c0[8], c0[9]); mxb = max3f(mxb, c0[10], c0[11]); mxa = max3f(mxa, c1[8], c1[9]); mxb = max3f(mxb, c1[10], c1[11]);
    mxa = max3f(mxa, c0[12], c0[13]); mxb = max3f(mxb, c0[14], c0[15]); mxa = max3f(mxa, c1[12], c1[13]); mxb = max3f(mxb, c1[14], c1[15]);
    float mx = max3f(mxa, mxb, m);
    mx = max3f(mx, __shfl_xor(mx, 32), mx);
    const float mn = mx, alpha = __builtin_amdgcn_exp2f(m - mn);
    const bool resc = __any(mn > m);
    m = mn;
    float ls = 0.f;
    FP2_SB(); FP2_MMA(n0, ka, 1);
    FP2_EXP(c0, 0) FP2_EXP(c0, 1) FP2_EXP(c0, 2) FP2_EXP(c0, 3) FP2_EXP(c0, 4) FP2_EXP(c0, 5)
    FP2_SB(); FP2_MMA(n1, kb2, 1);
    FP2_EXP(c0, 6) FP2_EXP(c0, 7) FP2_EXP(c0, 8) FP2_EXP(c0, 9) FP2_EXP(c0, 10) FP2_EXP(c0, 11)
    FP2_SB(); FP2_MMA(n0, ka, 2);
    FP2_EXP(c0, 12) FP2_EXP(c0, 13) FP2_EXP(c0, 14) FP2_EXP(c0, 15) FP2_EXP(c1, 0) FP2_EXP(c1, 1)
    FP2_SB(); FP2_MMA(n1, kb2, 2);
    FP2_EXP(c1, 2) FP2_EXP(c1, 3) FP2_EXP(c1, 4) FP2_EXP(c1, 5) FP2_EXP(c1, 6) FP2_EXP(c1, 7)
    FP2_SB(); FP2_MMA(n0, ka, 3);
    FP2_EXP(c1, 8) FP2_EXP(c1, 9) FP2_EXP(c1, 10) FP2_EXP(c1, 11) FP2_EXP(c1, 12) FP2_EXP(c1, 13)
    FP2_SB(); FP2_MMA(n1, kb2, 3);
    FP2_EXP(c1, 14) FP2_EXP(c1, 15)
    bf16x8 pa[4];
    { u32x4 t;
      t[0] = cvtpk(c0[0], c0[1]); t[1] = cvtpk(c0[2], c0[3]); t[2] = cvtpk(c0[4], c0[5]); t[3] = cvtpk(c0[6], c0[7]); pa[0] = __builtin_bit_cast(bf16x8, t);
      t[0] = cvtpk(c0[8], c0[9]); t[1] = cvtpk(c0[10], c0[11]); t[2] = cvtpk(c0[12], c0[13]); t[3] = cvtpk(c0[14], c0[15]); pa[1] = __builtin_bit_cast(bf16x8, t);
      t[0] = cvtpk(c1[0], c1[1]); t[1] = cvtpk(c1[2], c1[3]); t[2] = cvtpk(c1[4], c1[5]); t[3] = cvtpk(c1[6], c1[7]); pa[2] = __builtin_bit_cast(bf16x8, t);
      t[0] = cvtpk(c1[8], c1[9]); t[1] = cvtpk(c1[10], c1[11]); t[2] = cvtpk(c1[12], c1[13]); t[3] = cvtpk(c1[14], c1[15]); pa[3] = __builtin_bit_cast(bf16x8, t); }
    asm volatile("" : "+v"(pa[0]), "+v"(pa[1]), "+v"(pa[2]), "+v"(pa[3]));
    FP2_SB();
    l = l * alpha + ls;
    __builtin_amdgcn_sched_barrier(0);
    if (resc) {
#pragma unroll
      for (int b = 0; b < DVB; ++b)
#pragma unroll
        for (int r = 0; r < 16; ++r) o[b][r] *= alpha;
    }
    const ldsp_t vb = lds + st_cur * G::STAGE + vroff;
    s16x4 vl[2][DVB], vh[2][DVB];
#pragma unroll
    for (int b = 0; b < DVB; ++b) { vl[0][b] = vtr(vb + b * 64); vh[0][b] = vtr(vb + 8 * G::VSTR + b * 64); }
#pragma unroll
    for (int ks = 0; ks < 4; ++ks) {
      FP2_SB();
      if (ks < 3) {
#pragma unroll
        for (int b = 0; b < DVB; ++b) { vl[(ks + 1) & 1][b] = vtr(vb + (16 * (ks + 1)) * G::VSTR + b * 64); vh[(ks + 1) & 1][b] = vtr(vb + (16 * (ks + 1) + 8) * G::VSTR + b * 64); }
      }
      FP2_SB();
#pragma unroll
      for (int b = 0; b < DVB; ++b) {
        const s16x4 lo = vl[ks & 1][b], h8 = vh[ks & 1][b];
        const bf16x8 vf = {lo[0], lo[1], lo[2], lo[3], h8[0], h8[1], h8[2], h8[3]};
        if (ABL != 2) o[b] = __builtin_amdgcn_mfma_f32_32x32x16_bf16(vf, pa[ks], o[b], 0, 0, 0); else o[b][0] += __builtin_bit_cast(float, (int)vf[0]);
      }
    }
    FP2_SB();
    if (ABL != 3) { if (kt + 2 < ntiles) FP2_STORE(st_fill, set); }
    __syncthreads();
    if (ABL != 3) { if (kt + 2 + PF < ntiles) FP2_LOAD(kt + 2 + PF, set); }
    c0 = n0; c1 = n1;
    { const int t = st_cur; st_cur = st_nxt; st_nxt = st_fill; st_fill = t; }
  };
  if (PF == 2) { for (int kt = 0; kt < ntiles; kt += 2) { body(kt, IC<0>{}); if (kt + 1 < ntiles) body(kt + 1, IC<1>{}); } }
  else { for (int kt = 0; kt < ntiles; ++kt) body(kt, IC<0>{}); }
#undef FP2_LOAD
#undef FP2_STORE
}


typedef int v8i_t __attribute__((ext_vector_type(8)));
DEVI v8i_t cat8(const u32x4& x, const u32x4& y) { return (v8i_t){(int)x[0], (int)x[1], (int)x[2], (int)x[3], (int)y[0], (int)y[1], (int)y[2], (int)y[3]}; }
template <int DVB, int KROW, int AB8 = 0, class Src, class VKey, class Msk, class Act>
DEVI void flash_pass8(ldsp_t lds, int ntiles, const unsigned char* k8, int ldb, int kcolb, const unsigned char* vt, const v8i_t& qf, int ksub, bool late,
                      Src src, VKey vkey, Msk msk, Act act, f32x16 (&o)[DVB], float& m, float& l) {
  constexpr int A8_KSTR = KROW + 16, A8_VSTR = 80, A8_KB = 64 * A8_KSTR, A8_STAGE = A8_KB + DVB * 32 * A8_VSTR;
  constexpr int KPR = KROW / 16, NKC = 64 * KPR, NCHT = (NKC + DVB * 32 * 4) / NT;
  const int tid = ftid(), lane = tid & 63, r32 = lane & 31, hi = lane >> 5;
  u32x4 stg[NCHT];
#define A8_ISK(i_, c_) ((NKC % NT == 0) ? ((i_) < NKC / NT) : ((c_) < NKC))
#define A8_LOAD(kt) do { const int sb_ = src((kt), 0), vk_ = vkey(kt); _Pragma("unroll") for (int i_ = 0; i_ < NCHT; ++i_) { const int c_ = tid + NT * i_; \
      if (A8_ISK(i_, c_)) stg[i_] = *(const u32x4*)(k8 + (size_t)(sb_ + c_ / KPR) * ldb + kcolb + (c_ % KPR) * 16); \
      else { const int cv_ = c_ - NKC; stg[i_] = *(const u32x4*)(vt + (size_t)(cv_ >> 2) * 4352 + vk_ + (cv_ & 3) * 16); } } } while (0)
#define A8_STORE(st) do { _Pragma("unroll") for (int i_ = 0; i_ < NCHT; ++i_) { const int c_ = tid + NT * i_; \
      if (A8_ISK(i_, c_)) *(FA_LAS u32x4*)(lds + (st) * A8_STAGE + (c_ / KPR) * A8_KSTR + (c_ % KPR) * 16) = stg[i_]; \
      else { const int cv_ = c_ - NKC; *(FA_LAS u32x4*)(lds + (st) * A8_STAGE + A8_KB + (cv_ >> 2) * A8_VSTR + (cv_ & 3) * 16) = stg[i_]; } } } while (0)
#define A8_SB() __builtin_amdgcn_sched_barrier(0)
#define A8_EXP(cx, r) { if (AB8 & 2) {} else { cx[r] = __builtin_amdgcn_exp2f(cx[r] - mn); ls += cx[r]; } }
#define A8_KREAD(st) do { const ldsp_t kp_ = lds + (st) * A8_STAGE + kroff; \
    kf[0] = *(const volatile FA_LAS u32x4*)kp_; kf[1] = *(const volatile FA_LAS u32x4*)(kp_ + 16); kf[2] = *(const volatile FA_LAS u32x4*)(kp_ + 32 * A8_KSTR); kf[3] = *(const volatile FA_LAS u32x4*)(kp_ + 32 * A8_KSTR + 16); } while (0)
#define A8_VREAD(st) do { const ldsp_t vb_ = lds + (st) * A8_STAGE + vroff; _Pragma("unroll") for (int b = 0; b < DVB; ++b) { \
    vf0[b] = *(const volatile FA_LAS u32x4*)(vb_ + b * 32 * A8_VSTR); vf1[b] = *(const volatile FA_LAS u32x4*)(vb_ + b * 32 * A8_VSTR + 16); } } while (0)
#define A8_QKM() do { f32x16 z_; _Pragma("unroll") for (int r_ = 0; r_ < 16; ++r_) z_[r_] = 0.f; \
    c0 = __builtin_amdgcn_mfma_scale_f32_32x32x64_f8f6f4(cat8(kf[0], kf[1]), qf, z_, 0, 0, 0, 0x7d7d7d7d  , 0, 0x7b7b7b7b  ); \
    c1 = __builtin_amdgcn_mfma_scale_f32_32x32x64_f8f6f4(cat8(kf[2], kf[3]), qf, z_, 0, 0, 0, 0x7d7d7d7d, 0, 0x7b7b7b7b); } while (0)
#define A8_PVM() do { _Pragma("unroll") for (int b = 0; b < DVB; ++b) if (!(AB8 & 16)) o[b] = __builtin_amdgcn_mfma_scale_f32_32x32x64_f8f6f4(cat8(vf0[b], vf1[b]), pb, o[b], 0, 0, 0, 0x7d7d7d7d  , 0, 0x7b7b7b7b  ); } while (0)
  A8_LOAD(0); A8_STORE(0);
  if (ntiles > 1) { A8_LOAD(1); A8_STORE(1); }
  __syncthreads();
  if (ntiles > 2) A8_LOAD(2);
  const int kroff = r32 * A8_KSTR + 64 * ksub + 32 * hi;
  const int vroff = A8_KB + r32 * A8_VSTR + 32 * hi;
  f32x16 c0, c1;
  u32x4 kf[4], vf0[DVB], vf1[DVB];
  v8i_t pb = {0, 0, 0, 0, 0, 0, 0, 0};
  if (act(0)) { A8_KREAD(0); A8_QKM(); }
  asm volatile("s_nop 15\n\ts_nop 7" : "+v"(c0), "+v"(c1));
  int st_cur = 0, st_nxt = 1, st_fill = 2;
  for (int kt = 0; kt < ntiles; ++kt) {
    const bool on = act(kt), on_nxt = kt + 1 < ntiles && act(kt + 1);
    if (late && kt > 0) {
      if (on) A8_QKM();
      if (act(kt - 1)) A8_PVM();
#pragma unroll
      for (int b = 0; b < DVB; ++b) asm volatile("" : "+v"(o[b]));
      asm volatile("s_nop 15\n\ts_nop 7" : "+v"(c0), "+v"(c1));
    }
    A8_SB();
    if (on) A8_VREAD(st_cur);
    if (on_nxt) A8_KREAD(st_nxt);
    A8_SB();
    if (on) {
    msk(kt, c0, c1);
    A8_SB();
    float mxa = 0.f, mxb = 0.f;
    if (!(AB8 & 2)) {
    mxa = max3f(c0[0], c0[1], c1[0]), mxb = max3f(c0[2], c0[3], c1[1]);
    mxa = max3f(mxa, c1[2], c1[3]);
    mxa = max3f(mxa, c0[4], c0[5]); mxb = max3f(mxb, c0[6], c0[7]); mxa = max3f(mxa, c1[4], c1[5]); mxb = max3f(mxb, c1[6], c1[7]);
    mxa = max3f(mxa, c0[8], c0[9]); mxb = max3f(mxb, c0[10], c0[11]); mxa = max3f(mxa, c1[8], c1[9]); mxb = max3f(mxb, c1[10], c1[11]);
    mxa = max3f(mxa, c0[12], c0[13]); mxb = max3f(mxb, c0[14], c0[15]); mxa = max3f(mxa, c1[12], c1[13]); mxb = max3f(mxb, c1[14], c1[15]);
    }
    float mx = max3f(mxa, mxb, mxb);
    { const auto sw = __builtin_amdgcn_permlane32_swap(__float_as_uint(mx), __float_as_uint(mx), false, false);
      mx = fmaxf(__uint_as_float(sw[0]), __uint_as_float(sw[1])); }
    const bool up = mx > m + 8.f;
    const float mn = up ? mx - 4.f : m, alpha = __builtin_amdgcn_exp2f(m - mn);
    const bool resc = __any(up);
    m = mn;
    float ls = 0.f;
    A8_SB();
#pragma unroll
    for (int r = 0; r < 16; ++r) A8_EXP(c0, r)
#pragma unroll
    for (int r = 0; r < 16; ++r) A8_EXP(c1, r)
    A8_SB();
    unsigned X[4], Y[4];
#pragma unroll
    for (int i = 0; i < 4; ++i) {
      int w, z; asm volatile("" : "=v"(w)); asm volatile("" : "=v"(z));
      w = __builtin_amdgcn_cvt_pk_fp8_f32(c0[4 * i], c0[4 * i + 1], w, false); w = __builtin_amdgcn_cvt_pk_fp8_f32(c0[4 * i + 2], c0[4 * i + 3], w, true); X[i] = (unsigned)w;
      z = __builtin_amdgcn_cvt_pk_fp8_f32(c1[4 * i], c1[4 * i + 1], z, false); z = __builtin_amdgcn_cvt_pk_fp8_f32(c1[4 * i + 2], c1[4 * i + 3], z, true); Y[i] = (unsigned)z; }
#pragma unroll
    for (int i = 0; i < 4; ++i) { const auto rr = __builtin_amdgcn_permlane32_swap(X[i], Y[i], false, false); X[i] = rr[0]; Y[i] = rr[1]; }
    pb = (v8i_t){(int)X[0], (int)X[1], (int)X[2], (int)X[3], (int)Y[0], (int)Y[1], (int)Y[2], (int)Y[3]};
    asm volatile("" : "+v"(pb));
    l = l * alpha + ls;
    A8_SB();
    if (resc) {
#pragma unroll
      for (int b = 0; b < DVB; ++b)
#pragma unroll
        for (int r = 0; r < 16; ++r) o[b][r] *= alpha;
    }
    }
    A8_SB();
    if (!late) {
      if (on_nxt) A8_QKM();
      if (on) A8_PVM();
#pragma unroll
      for (int b = 0; b < DVB; ++b) asm volatile("" : "+v"(o[b]));
      asm volatile("" : "+v"(c0), "+v"(c1));
    }
    A8_SB();
    if (!(AB8 & 4)) { if (kt + 2 < ntiles) A8_STORE(st_fill); }
    if (!(AB8 & 8)) __syncthreads();
    if (!(AB8 & 4)) { if (kt + 3 < ntiles) A8_LOAD(kt + 3); }
    { const int t = st_cur; st_cur = st_nxt; st_nxt = st_fill; st_fill = t; }
  }
  if (late && act(ntiles - 1)) A8_PVM();
  l *= 0.0625f;
#undef A8_ISK
#undef A8_LOAD
#undef A8_STORE
#undef A8_SB
#undef A8_EXP
#undef A8_KREAD
#undef A8_VREAD
#undef A8_QKM
#undef A8_PVM
}

#ifndef OUT_FP8
#define OUT_FP8 1
#endif
DEVI void st_att4(bf16_t* ATT, size_t row, int col, float a, float b, float c, float d) {
  if (OUT_FP8) *(unsigned*)((unsigned char*)ATT + row * DM + col) = nv::pack4_fp8(a * 4.f, b * 4.f, c * 4.f, d * 4.f);
  else { uint2 w; w.x = cvtpk(a, b); w.y = cvtpk(c, d); *(uint2*)(ATT + row * DM + col) = w; }
}
DEVI int vblock() { const int G = gridDim.x, bx = blockIdx.x; return (G % 8 == 0) ? (bx % 8) * (G / 8) + bx / 8 : bx; }

template <int ABL = 0> DEVI void phase_attnA(const Params& p, ldsp_t lds) {
  typedef Geo<128, 4> G;
  const int tid = ftid(), lane = tid & 63, wave = __builtin_amdgcn_readfirstlane(tid >> 6), r32 = lane & 31, hi = lane >> 5;
  const bf16_t* Q = (const bf16_t*)(p.ws + WS_QKV0); bf16_t* ATT = (bf16_t*)(p.ws + (ABL ? WS_MIX0 : WS_ATT0));
  const float lam = ((const float*)(p.ws + WS_CTL + CTL_LAM))[0];
  const int s = wave >> 2, qb = wave & 3;
  constexpr int NU_LAT = NB * 4 * 32, NU_CTX = NB * 4 * 2;
  for (int u = vblock(); u < NU_LAT + NU_CTX; u += gridDim.x) {
    int b, h, row0, ntiles; bool lat = u < NU_LAT;
    if (lat) { b = u >> 7; h = (u >> 5) & 3; row0 = b * SEQ + (u & 31) * 128; ntiles = 68; }
    else { const int v = u - NU_LAT; b = v >> 3; h = (v >> 1) & 3; row0 = NLAT + b * CTXL + (v & 1) * 128; ntiles = 4; }
    const int qrow = row0 + qb * 32 + r32;
    bf16x8 q[4];
#pragma unroll
    for (int d0 = 0; d0 < 4; ++d0) q[d0] = load_q8(Q + (size_t)qrow * N_IN0 + h * 128 + s * 64 + 16 * d0 + 8 * hi, C2);
    f32x16 o[4];
#pragma unroll
    for (int bk = 0; bk < 4; ++bk)
#pragma unroll
      for (int r = 0; r < 16; ++r) o[bk][r] = 0.f;
    float m = -1e30f, l = 0.f;
    const int cbase = NLAT + b * CTXL, lbase = b * SEQ;
#if ATTNA_FP8
    const unsigned char* QK8 = (const unsigned char*)(p.ws + WS_QKV0);
    v8i_t qf;
    { const unsigned char* qp = QK8 + (size_t)qrow * (N_IN0 * 2) + h * 128 + s * 64 + 32 * hi; const u32x4 q0_ = *(const u32x4*)qp, q1_ = *(const u32x4*)(qp + 16); qf = cat8(q0_, q1_); }
    flash_pass8<4, 128, ABL>(lds, ntiles, QK8, N_IN0 * 2, 512 + h * 128, (const unsigned char*)(p.ws + WS_VT) + (size_t)((b * 4 + h) * 128) * 4352, qf, s, s != 0,
      [&](int kt, int i) { return lat ? (kt < 64 ? lbase + kt * 64 + i : cbase + (kt - 64) * 64 + i) : cbase + kt * 64 + i; },
      [&](int kt) { return (lat ? 0 : 4096) + kt * 64; }, [&](int, f32x16&, f32x16&) {}, [&](int) { return true; }, o, m, l);
#else
    flash_pass2<128, 4, ABL, 1>(lds, ntiles, Q, N_IN0, 512 + h * 128, 1024 + h * 128, q, s * 64,
      [&](int kt, int i) { return lat ? (kt < 64 ? lbase + kt * 64 + i : cbase + (kt - 64) * 64 + i) : cbase + kt * 64 + i; },
      [&](int, f32x16&, f32x16&) {}, o, m, l);
#endif
    l += __shfl_xor(l, 32);
    const float inv = 1.f / l;
    FA_LAS float* X = (FA_LAS float*)lds;
    if (s == 1) {
#pragma unroll
      for (int bk = 0; bk < 4; ++bk)
#pragma unroll
        for (int r = 0; r < 16; ++r) X[((qb * 4 + bk) * 16 + r) * 64 + lane] = o[bk][r] * inv;
    }
    __syncthreads();
    if (s == 0) {
      float ss = 0.f;
#pragma unroll
      for (int bk = 0; bk < 4; ++bk)
#pragma unroll
        for (int r = 0; r < 16; ++r) { const float d = o[bk][r] * inv - lam * X[((qb * 4 + bk) * 16 + r) * 64 + lane]; o[bk][r] = d; ss += d * d; }
      ss += __shfl_xor(ss, 32);
      const float rr = rsqrtf(ss * (1.f / 128.f) + EPS) * 0.8f;
      const float* g = p.in[L0_SUBLN];
#pragma unroll
      for (int bk = 0; bk < 4; ++bk)
#pragma unroll
        for (int rg = 0; rg < 4; ++rg) { const int dv = bk * 32 + 8 * rg + 4 * hi; const float4 gv = *(const float4*)(g + dv);
          st_att4(ATT, (size_t)qrow, h * 128 + dv, o[bk][4 * rg] * rr * gv.x, o[bk][4 * rg + 1] * rr * gv.y, o[bk][4 * rg + 2] * rr * gv.z, o[bk][4 * rg + 3] * rr * gv.w); }
    }
    __syncthreads();
  }
}

template <int ABL = 0> DEVI void phase_attnB(const Params& p, ldsp_t lds) {
  typedef Geo<64, 2> G;
  const int tid = ftid(), lane = tid & 63, wave = __builtin_amdgcn_readfirstlane(tid >> 6), r32 = lane & 31, hi = lane >> 5;
  const bf16_t* Q = (const bf16_t*)(p.ws + WS_QKV0); bf16_t* ATT = (bf16_t*)(p.ws + (ABL ? WS_MIX0 : WS_ATT0));
  constexpr int NU_LAT = NB * 8 * 16, NU_CTX = NB * 8;
  FA_LAS float* RPB = (FA_LAS float*)(lds + 3 * (64 * 80 + 64 * 80));
  for (int u = vblock(); u < NU_LAT + NU_CTX; u += gridDim.x) {
    const bool lat = u < NU_LAT;
    int b, h, qrow_g = 0, c0 = 0, rlo = 0, nlat = 0, rs_w = 0, grow;
    if (lat) { b = u >> 7; h = (u >> 4) & 7; const int qr0 = (u & 15) * 4; qrow_g = qr0 + (wave >> 1); c0 = 32 * (wave & 1);
      rlo = min(max(qr0 - 4, 0), 56); const int rhi = min(max(qr0 - 1, 0), 56) + 7; nlat = rhi - rlo + 1; rs_w = min(max(qrow_g - 4, 0), 56);
      grow = b * SEQ + qrow_g * 64 + c0 + r32; }
    else { const int v = u - NU_LAT; b = v >> 3; h = v & 7; grow = NLAT + b * CTXL + wave * 32 + r32; }
    const int ntiles = nlat + 4;
    for (int i = tid; i < 15 * 31; i += NT) RPB[i] = p.in[L0_RPB][h * 465 + i] * LOG2E;
    const unsigned char* QK8 = (const unsigned char*)(p.ws + WS_QKV0);
    v8i_t qf;
    { const unsigned char* qp = QK8 + (size_t)grow * (N_IN0 * 2) + 1536 + h * 64 + 32 * hi; const u32x4 q0_ = *(const u32x4*)qp, q1_ = *(const u32x4*)(qp + 16); qf = cat8(q0_, q1_); }
    f32x16 o[2];
#pragma unroll
    for (int bk = 0; bk < 2; ++bk)
#pragma unroll
      for (int r = 0; r < 16; ++r) o[bk][r] = 0.f;
    float m = -1e30f, l = 0.f;
    const int cbase = NLAT + b * CTXL, lbase = b * SEQ;
    const int qc = c0 + r32, cs = min(max(qc - 8, 0), 48);
    flash_pass8<2, 64>(lds, ntiles, QK8, N_IN0 * 2, 2048 + h * 64, (const unsigned char*)(p.ws + WS_VTB) + (size_t)((b * 8 + h) * 64) * 4352, qf, 0, wave >= 4,
      [&](int kt, int i) { return kt < nlat ? lbase + (rlo + kt) * 64 + i : cbase + (kt - nlat) * 64 + i; },
      [&](int kt) { return kt < nlat ? (rlo + kt) * 64 : 4096 + (kt - nlat) * 64; },
      [&](int kt, f32x16& p0, f32x16& p1) {
        if (ABL != 1 && kt < nlat) { const int kr = rlo + kt; const bool rowok = (kr >= rs_w && kr < rs_w + 8);
          const FA_LAS float* bp = RPB + min(max(kr - qrow_g + 7, 0), 14) * 31;
          { float b0[16];
#pragma unroll
            for (int r = 0; r < 16; ++r) { const int k0 = crow(r, hi); b0[r] = bp[min(max(k0 - qc + 15, 0), 30)]; }
#pragma unroll
            for (int r = 0; r < 16; ++r) { const int k0 = crow(r, hi); const float v0 = p0[r] + b0[r]; p0[r] = (rowok && k0 >= cs && k0 < cs + 16) ? v0 : -INFINITY; } }
          asm volatile("" ::: "memory");
          { float b1[16];
#pragma unroll
            for (int r = 0; r < 16; ++r) { const int k1 = 32 + crow(r, hi); b1[r] = bp[min(max(k1 - qc + 15, 0), 30)]; }
#pragma unroll
            for (int r = 0; r < 16; ++r) { const int k1 = 32 + crow(r, hi); const float v1 = p1[r] + b1[r]; p1[r] = (rowok && k1 >= cs && k1 < cs + 16) ? v1 : -INFINITY; } } } },
      [&](int kt) { const int kr = rlo + kt; return kt >= nlat || (kr >= rs_w && kr < rs_w + 8); },
      o, m, l);
    l += __shfl_xor(l, 32);
    const float inv = 1.f / l;
#pragma unroll
    for (int bk = 0; bk < 2; ++bk)
#pragma unroll
      for (int rg = 0; rg < 4; ++rg) { const int dv = bk * 32 + 8 * rg + 4 * hi;
        st_att4(ATT, (size_t)grow, 512 + h * 64 + dv, o[bk][4 * rg] * inv, o[bk][4 * rg + 1] * inv, o[bk][4 * rg + 2] * inv, o[bk][4 * rg + 3] * inv); }
    __syncthreads();
  }
}

DEVI void phase_attnC(const Params& p, ldsp_t lds, int* ctr) {
  const int tid = ftid(), lane = tid & 63, wave = __builtin_amdgcn_readfirstlane(tid >> 6), r32 = lane & 31, hi = lane >> 5;
  const bf16_t* P1 = (const bf16_t*)(p.ws + WS_P1); bf16_t* ATT = (bf16_t*)(p.ws + WS_ATT1);
  FA_LAS int* uq = (FA_LAS int*)(lds + 3 * Geo<64, 2>::STAGE + 64);
  for (;;) {
    if (tid == 0) *uq = atomicAdd(ctr, 1);
    __syncthreads();
    const int u = *uq;
    __syncthreads();
    if (u >= NB * 2 * 64) break;
    const int b = u >> 7, g = (u >> 6) & 1, tq = u & 63, hq = g * 4 + (wave >> 1), t = tq * 64 + 32 * (wave & 1) + r32, grow = b * SEQ + t;
    const int klo = max(tq - 2, 0), khi = min(tq + 2, 63), nwin = khi - klo + 1, ntiles = nwin + 4;
    bf16x8 q[4];
#pragma unroll
    for (int d0 = 0; d0 < 4; ++d0) q[d0] = load_q8(P1 + (size_t)grow * 2304 + hq * 64 + 16 * d0 + 8 * hi, C2);
    f32x16 o[2];
#pragma unroll
    for (int bk = 0; bk < 2; ++bk)
#pragma unroll
      for (int r = 0; r < 16; ++r) o[bk][r] = 0.f;
    float m = -1e30f, l = 0.f;
    const int cbase = NLAT + b * CTXL, lbase = b * SEQ;
    flash_pass2<64, 2, 0, 2>(lds, ntiles, P1, 2304, 512 + g * 64, 640 + g * 64, q, 0,
      [&](int kt, int i) { return kt < nwin ? lbase + (klo + kt) * 64 + i : cbase + (kt - nwin) * 64 + i; },
      [&](int kt, f32x16& p0, f32x16& p1) {
        if (kt < nwin) { const int kp = (klo + kt) * 64 - t;
#pragma unroll
          for (int r = 0; r < 16; ++r) { const int d0 = kp + crow(r, hi), d1 = d0 + 32;
            if (d0 < -128 || d0 > 128) p0[r] = -INFINITY; if (d1 < -128 || d1 > 128) p1[r] = -INFINITY; } } },
      o, m, l);
    l += __shfl_xor(l, 32);
    { const float sk = p.in[L1_SINKS][hq] * LOG2E, mn = fmaxf(m, sk), alpha = __builtin_amdgcn_exp2f(m - mn);
      l = l * alpha + __builtin_amdgcn_exp2f(sk - mn);
#pragma unroll
      for (int bk = 0; bk < 2; ++bk)
#pragma unroll
        for (int r = 0; r < 16; ++r) o[bk][r] *= alpha; }
    const float inv = 1.f / l;
#pragma unroll
    for (int bk = 0; bk < 2; ++bk)
#pragma unroll
      for (int rg = 0; rg < 4; ++rg) { const int dv = bk * 32 + 8 * rg + 4 * hi;
        st_att4(ATT, (size_t)grow, hq * 64 + dv, o[bk][4 * rg] * inv, o[bk][4 * rg + 1] * inv, o[bk][4 * rg + 2] * inv, o[bk][4 * rg + 3] * inv); }
    __syncthreads();
  }
}
}
namespace fs {
using fa::bf16x8; using fa::s16x4; using fa::f32x16; using fa::ldsp_t; using fa::u32x4; using fa::cvtpk; using fa::vtr; using fa::crow; using fa::LOG2E;
typedef unsigned u32x2 __attribute__((ext_vector_type(2)));

DEVI void phase_conv(const Params& p) {
  const bf16_t* P1 = (const bf16_t*)(p.ws + WS_P1); bf16_t* U = (bf16_t*)(p.ws + WS_U);
  const float* cw = p.in[L1_CONVW]; const float* cb = p.in[L1_CONVB];
  const int nitems = (NROW / 16) * 128;
  for (int it = blockIdx.x * NT + ftid(); it < nitems; it += gridDim.x * NT) {
    const int cg = it & 127, rc = it >> 7, r0 = rc * 16, ch = cg * 8;
    int s0, len; if (r0 < NLAT) { s0 = r0 & ~4095; len = SEQ; } else { s0 = NLAT + ((r0 - NLAT) & ~255); len = CTXL; }
    const int t0 = r0 - s0;
    float w[5][8], bias[8];
#pragma unroll
    for (int j = 0; j < 5; ++j) { const float4 a = *(const float4*)(cw + j * 1024 + ch), b = *(const float4*)(cw + j * 1024 + ch + 4);
      w[j][0] = a.x; w[j][1] = a.y; w[j][2] = a.z; w[j][3] = a.w; w[j][4] = b.x; w[j][5] = b.y; w[j][6] = b.z; w[j][7] = b.w; }
    { const float4 a = *(const float4*)(cb + ch), b = *(const float4*)(cb + ch + 4); bias[0] = a.x; bias[1] = a.y; bias[2] = a.z; bias[3] = a.w; bias[4] = b.x; bias[5] = b.y; bias[6] = b.z; bias[7] = b.w; }
    float win[5][8];
    auto ldrow = [&](int t, float (&d)[8]) {
      if (t < 0 || t >= len) {
#pragma unroll
        for (int k = 0; k < 8; ++k) d[k] = 0.f; return; }
      const u32x4 v = *(const u32x4*)(P1 + (size_t)(s0 + t) * 2304 + 768 + ch);
#pragma unroll
      for (int k = 0; k < 4; ++k) { d[2 * k] = __uint_as_float(v[k] << 16); d[2 * k + 1] = __uint_as_float(v[k] & 0xffff0000u); } };
    ldrow(t0 - 2, win[0]); ldrow(t0 - 1, win[1]); ldrow(t0, win[2]); ldrow(t0 + 1, win[3]);
#pragma unroll
    for (int i = 0; i < 16; ++i) {
      ldrow(t0 + i + 2, win[(i + 4) % 5]);
      float o[8];
#pragma unroll
      for (int k = 0; k < 8; ++k) { float a = bias[k];
#pragma unroll
        for (int j = 0; j < 5; ++j) a += w[j][k] * win[(i + j) % 5][k];
        o[k] = a * __builtin_amdgcn_rcpf(1.f + __expf(-a)); }
      u32x4 ov; ov[0] = cvtpk(o[0], o[1]); ov[1] = cvtpk(o[2], o[3]); ov[2] = cvtpk(o[4], o[5]); ov[3] = cvtpk(o[6], o[7]);
      *(u32x4*)(U + (size_t)(r0 + i) * 1024 + ch) = ov;
    }
  }
}

DEVI float softplus_f(float v) { if (v > 20.f) return v; const float x = __expf(v); return x < 1e-3f ? x * (1.f - 0.5f * x) : __logf(1.f + x); }
constexpr int BSTR = 272, XSTR = 192;
constexpr int L_BM = 0, L_XD = 128 * BSTR, L_XW = L_XD + 128 * XSTR, L_HT = L_XW + 128 * XSTR, L_CUM = L_HT + 128 * XSTR, L_DTV = L_CUM + 512, L_XCH = L_DTV + 512, L_TOT = L_XCH + 8 * 4096;

template <int ABL = 0> DEVI void phase_ssd(const Params& p, ldsp_t lds) {
  const int tid = ftid(), lane = tid & 63, wave = __builtin_amdgcn_readfirstlane(tid >> 6), r32 = lane & 31, hi = lane >> 5;
  const int pb = wave >> 2, lb = (wave < 4) ? (wave & 3) : 3 - (wave & 3);
  const bf16_t* U = (const bf16_t*)(p.ws + WS_U); const float* DT = (const float*)(p.ws + WS_DT);
  bf16_t* YFB = (bf16_t*)(p.ws + WS_YS);
  FA_LAS float* CUM = (FA_LAS float*)(lds + L_CUM); FA_LAS float* DTV = (FA_LAS float*)(lds + L_DTV);
  const int trow_off = 4 * hi + ((lane & 15) >> 2), tcol_off = 32 * ((lane >> 4) & 1) + 8 * (lane & 3);
  for (int it = blockIdx.x; it < NB * 2 * 8; it += gridDim.x) {
    const int b = it >> 4, dir = (it >> 3) & 1, hd = it & 7, g = hd >> 2;
    const float a2 = -expf(p.in[dir ? L1_ALOGB : L1_ALOGF][hd]) * LOG2E; const float dtb = p.in[dir ? L1_DTBB : L1_DTBF][hd];
    auto tokrow = [&](int c, int i) { const int seg = c >= 2, len = seg ? SEQ : CTXL, j = (seg ? c - 2 : c) * 128 + i; return (seg ? b * SEQ : NLAT + b * CTXL) + (dir ? len - 1 - j : j); };
    f32x16 hacc;
#pragma unroll
    for (int r = 0; r < 16; ++r) hacc[r] = 0.f;
    for (int i = tid; i < 128 * XSTR / 4; i += NT) ((FA_LAS unsigned*)(lds + L_HT))[i] = 0u;
    u32x4 sb_[4], sx_[2]; float sdt0 = 0.f, sdt1 = 0.f; bf16x8 cfn[8];
    auto prefetch = [&](int c) {
#pragma unroll
      for (int i = 0; i < 4; ++i) { const int ch = tid + NT * i; sb_[i] = *(const u32x4*)(U + (size_t)tokrow(c, ch >> 4) * 1024 + 512 + g * 128 + (ch & 15) * 8); }
#pragma unroll
      for (int i = 0; i < 2; ++i) { const int ch = tid + NT * i; sx_[i] = *(const u32x4*)(U + (size_t)tokrow(c, ch >> 3) * 1024 + hd * 64 + (ch & 7) * 8); }
      if (tid < 64) { sdt0 = DT[(size_t)tokrow(c, 2 * tid) * 16 + dir * 8 + hd]; sdt1 = DT[(size_t)tokrow(c, 2 * tid + 1) * 16 + dir * 8 + hd]; }
      const bf16_t* crowp = U + (size_t)tokrow(c, lb * 32 + r32) * 1024 + 768 + g * 128 + 8 * hi;
#pragma unroll
      for (int ks = 0; ks < 8; ++ks) cfn[ks] = *(const bf16x8*)(crowp + 16 * ks);
    };
    prefetch(0);
    __syncthreads();
    for (int c = 0; c < 34; ++c) {
      if (tid < 64) {
        const float r0 = sdt0 + dtb, r1 = sdt1 + dtb; const float d0 = softplus_f(r0), d1 = softplus_f(r1);
        const float a0 = d0 * a2, a1 = d1 * a2; float v = a0 + a1;
#pragma unroll
        for (int o = 1; o < 64; o <<= 1) { const float t = __shfl_up(v, o); if (lane >= o) v += t; }
        DTV[2 * tid] = d0; DTV[2 * tid + 1] = d1; CUM[2 * tid] = v - a1; CUM[2 * tid + 1] = v;
      }
      __syncthreads();
      const float cl = CUM[127];
#pragma unroll
      for (int i = 0; i < 4; ++i) { const int ch = tid + NT * i; *(FA_LAS u32x4*)(lds + L_BM + (ch >> 4) * BSTR + (ch & 15) * 16) = sb_[i]; }
#pragma unroll
      for (int i = 0; i < 2; ++i) { const int ch = tid + NT * i, s = ch >> 3; const float d = DTV[s], wv = d * __builtin_amdgcn_exp2f(cl - CUM[s]);
        u32x4 xd, xw;
#pragma unroll
        for (int k = 0; k < 4; ++k) { const float x0 = __uint_as_float(sx_[i][k] << 16), x1 = __uint_as_float(sx_[i][k] & 0xffff0000u); xd[k] = cvtpk(x0 * d, x1 * d); xw[k] = cvtpk(x0 * wv, x1 * wv); }
        *(FA_LAS u32x4*)(lds + L_XD + s * XSTR + (ch & 7) * 16) = xd; *(FA_LAS u32x4*)(lds + L_XW + s * XSTR + (ch & 7) * 16) = xw; }
      bf16x8 cf[8];
#pragma unroll
      for (int ks = 0; ks < 8; ++ks) cf[ks] = cfn[ks];
      __syncthreads();
      if (ABL != 3) { if (c + 1 < 34) prefetch(c + 1); }
      if (c >= 2 && ABL != 1) {
        f32x16 y;
#pragma unroll
        for (int r = 0; r < 16; ++r) y[r] = 0.f;
        { const ldsp_t hb = lds + L_HT + (8 * hi + ((lane & 15) >> 2)) * XSTR + pb * 64 + tcol_off;
          f32x16 y2;
#pragma unroll
          for (int r = 0; r < 16; ++r) y2[r] = 0.f;
#pragma unroll
          for (int ks = 0; ks < 8; ++ks) { const s16x4 lo = vtr(hb + (16 * ks) * XSTR), h8 = vtr(hb + (16 * ks + 4) * XSTR);
            const bf16x8 hf = {lo[0], lo[1], lo[2], lo[3], h8[0], h8[1], h8[2], h8[3]};
            if (ks & 1) y2 = __builtin_amdgcn_mfma_f32_32x32x16_bf16(hf, cf[ks], y2, 0, 0, 0); else y = __builtin_amdgcn_mfma_f32_32x32x16_bf16(hf, cf[ks], y, 0, 0, 0); }
          y += y2; }
        const float cuml = CUM[lb * 32 + r32];
        { const float e = __builtin_amdgcn_exp2f(cuml);
#pragma unroll
          for (int r = 0; r < 16; ++r) y[r] *= e; }
        f32x16 yo;
#pragma unroll
        for (int r = 0; r < 16; ++r) yo[r] = 0.f;
        for (int sb = pb; sb <= lb; sb += 2) {
          f32x16 gt, gt2;
#pragma unroll
          for (int r = 0; r < 16; ++r) { gt[r] = 0.f; gt2[r] = 0.f; }
          const ldsp_t bb = lds + L_BM + (sb * 32 + r32) * BSTR + 16 * hi;
#pragma unroll
          for (int ks = 0; ks < 8; ks += 2) { gt = __builtin_amdgcn_mfma_f32_32x32x16_bf16(*(const FA_LAS bf16x8*)(bb + 32 * ks), cf[ks], gt, 0, 0, 0);
            gt2 = __builtin_amdgcn_mfma_f32_32x32x16_bf16(*(const FA_LAS bf16x8*)(bb + 32 * ks + 32), cf[ks + 1], gt2, 0, 0, 0); }
          gt += gt2;
          const bool diag = (sb == lb);
#pragma unroll
          for (int r = 0; r < 16; ++r) { const int sl = crow(r, hi); const float v = gt[r] * __builtin_amdgcn_exp2f(cuml - CUM[sb * 32 + sl]); gt[r] = (diag && sl > r32) ? 0.f : v; }
          u32x4 t0, t1;
          t0[0] = cvtpk(gt[0], gt[1]); t0[1] = cvtpk(gt[2], gt[3]); t0[2] = cvtpk(gt[4], gt[5]); t0[3] = cvtpk(gt[6], gt[7]);
          t1[0] = cvtpk(gt[8], gt[9]); t1[1] = cvtpk(gt[10], gt[11]); t1[2] = cvtpk(gt[12], gt[13]); t1[3] = cvtpk(gt[14], gt[15]);
          const bf16x8 pm0 = __builtin_bit_cast(bf16x8, t0), pm1 = __builtin_bit_cast(bf16x8, t1);
          const ldsp_t xb = lds + L_XD + (sb * 32 + trow_off) * XSTR + pb * 64 + tcol_off;
          const ldsp_t xo = lds + L_XD + (sb * 32 + trow_off) * XSTR + (1 - pb) * 64 + tcol_off;
          const s16x4 a0 = vtr(xb), a1 = vtr(xb + 8 * XSTR), a2 = vtr(xb + 16 * XSTR), a3 = vtr(xb + 24 * XSTR);
          const s16x4 b0 = vtr(xo), b1 = vtr(xo + 8 * XSTR), b2 = vtr(xo + 16 * XSTR), b3 = vtr(xo + 24 * XSTR);
          { const bf16x8 xf = {a0[0], a0[1], a0[2], a0[3], a1[0], a1[1], a1[2], a1[3]}; y = __builtin_amdgcn_mfma_f32_32x32x16_bf16(xf, pm0, y, 0, 0, 0); }
          { const bf16x8 xf = {b0[0], b0[1], b0[2], b0[3], b1[0], b1[1], b1[2], b1[3]}; yo = __builtin_amdgcn_mfma_f32_32x32x16_bf16(xf, pm0, yo, 0, 0, 0); }
          { const bf16x8 xf = {a2[0], a2[1], a2[2], a2[3], a3[0], a3[1], a3[2], a3[3]}; y = __builtin_amdgcn_mfma_f32_32x32x16_bf16(xf, pm1, y, 0, 0, 0); }
          { const bf16x8 xf = {b2[0], b2[1], b2[2], b2[3], b3[0], b3[1], b3[2], b3[3]}; yo = __builtin_amdgcn_mfma_f32_32x32x16_bf16(xf, pm1, yo, 0, 0, 0); }
        }
        { FA_LAS float* X = (FA_LAS float*)(lds + L_XCH) + (pb * 4 + lb) * 1024;
#pragma unroll
          for (int r = 0; r < 16; ++r) X[r * 64 + lane] = yo[r]; }
        __syncthreads();
        { const FA_LAS float* X = (const FA_LAS float*)(lds + L_XCH) + ((1 - pb) * 4 + lb) * 1024;
#pragma unroll
          for (int r = 0; r < 16; ++r) y[r] += X[r * 64 + lane]; }
        const int j = (c - 2) * 128 + lb * 32 + r32, tok = dir ? SEQ - 1 - j : j;
        bf16_t* yp = YFB + ((size_t)dir * NLAT + (size_t)b * SEQ + tok) * 512 + hd * 64 + pb * 32 + 4 * hi;
#pragma unroll
        for (int rg = 0; rg < 4; ++rg) { u32x2 w; w[0] = cvtpk(y[4 * rg], y[4 * rg + 1]); w[1] = cvtpk(y[4 * rg + 2], y[4 * rg + 3]); *(u32x2*)(yp + 8 * rg) = w; }
      }
      if (ABL != 2) { const float e = __builtin_amdgcn_exp2f(cl);
        f32x16 h2;
#pragma unroll
        for (int r = 0; r < 16; ++r) { hacc[r] *= e; h2[r] = 0.f; }
        const ldsp_t xb = lds + L_XW + (8 * hi + ((lane & 15) >> 2)) * XSTR + pb * 64 + tcol_off;
        const ldsp_t bb = lds + L_BM + (8 * hi + ((lane & 15) >> 2)) * BSTR + lb * 64 + tcol_off;
#pragma unroll
        for (int ks = 0; ks < 8; ++ks) {
          const s16x4 xl = vtr(xb + (16 * ks) * XSTR), xh = vtr(xb + (16 * ks + 4) * XSTR), bl = vtr(bb + (16 * ks) * BSTR), bh = vtr(bb + (16 * ks + 4) * BSTR);
          const bf16x8 xf = {xl[0], xl[1], xl[2], xl[3], xh[0], xh[1], xh[2], xh[3]}, bf = {bl[0], bl[1], bl[2], bl[3], bh[0], bh[1], bh[2], bh[3]};
          if (ks & 1) h2 = __builtin_amdgcn_mfma_f32_32x32x16_bf16(xf, bf, h2, 0, 0, 0); else hacc = __builtin_amdgcn_mfma_f32_32x32x16_bf16(xf, bf, hacc, 0, 0, 0);
        }
        hacc += h2; }
      __syncthreads();
      { const ldsp_t hp = lds + L_HT + (lb * 32 + r32) * XSTR + (pb * 32 + 4 * hi) * 2;
#pragma unroll
        for (int rg = 0; rg < 4; ++rg) { u32x2 w; w[0] = cvtpk(hacc[4 * rg], hacc[4 * rg + 1]); w[1] = cvtpk(hacc[4 * rg + 2], hacc[4 * rg + 3]); *(FA_LAS u32x2*)(hp + 16 * rg) = w; } }
    }
    __syncthreads();
  }
}

DEVI void phase_ssd_out(const Params& p) {
  const int lane = ftid() & 63, gw = blockIdx.x * NWAVE + (ftid() >> 6), NGW = gridDim.x * NWAVE;
  const bf16_t* U = (const bf16_t*)(p.ws + WS_U); const bf16_t* P1 = (const bf16_t*)(p.ws + WS_P1); const bf16_t* YFB = (const bf16_t*)(p.ws + WS_YS);
  bf16_t* ATT = (bf16_t*)(p.ws + WS_ATT1);
  for (int r = gw; r < NLAT; r += NGW) {
    const int c0 = lane * 8, hd = c0 >> 6; const float dsk = p.in[L1_DSKIP][hd];
    const u32x4 yf = *(const u32x4*)(YFB + (size_t)r * 512 + c0), yb = *(const u32x4*)(YFB + ((size_t)NLAT + r) * 512 + c0);
    const u32x4 xw = *(const u32x4*)(U + (size_t)r * 1024 + c0), zw = *(const u32x4*)(P1 + (size_t)r * 2304 + 1792 + c0);
    float y[8]; float ss = 0.f;
#pragma unroll
    for (int i = 0; i < 4; ++i) {
      const float x0 = __uint_as_float(xw[i] << 16), x1 = __uint_as_float(xw[i] & 0xffff0000u), z0 = __uint_as_float(zw[i] << 16), z1 = __uint_as_float(zw[i] & 0xffff0000u);
      const float f0 = __uint_as_float(yf[i] << 16) + __uint_as_float(yb[i] << 16), f1 = __uint_as_float(yf[i] & 0xffff0000u) + __uint_as_float(yb[i] & 0xffff0000u);
      y[2 * i] = (f0 + dsk * x0) * silu_f(z0); y[2 * i + 1] = (f1 + dsk * x1) * silu_f(z1);
      ss += y[2 * i] * y[2 * i] + y[2 * i + 1] * y[2 * i + 1];
    }
#pragma unroll
    for (int o = 1; o < 32; o <<= 1) ss += __shfl_xor(ss, o);
    const float rr = rsqrtf(ss * (1.f / 256.f) + EPS);
    const float4 g0 = *(const float4*)(p.in[L1_GNORM] + c0), g1 = *(const float4*)(p.in[L1_GNORM] + c0 + 4);
    u32x4 w; w[0] = cvtpk(y[0] * rr * g0.x, y[1] * rr * g0.y); w[1] = cvtpk(y[2] * rr * g0.z, y[3] * rr * g0.w); w[2] = cvtpk(y[4] * rr * g1.x, y[5] * rr * g1.y); w[3] = cvtpk(y[6] * rr * g1.z, y[7] * rr * g1.w);
    *(u32x4*)(ATT + (size_t)r * DM + 512 + c0) = w;
  }
}
}
#ifndef TOPK_COPY
#define TOPK_COPY false
#endif
namespace ft {
using fa::ldsp_t; using fa::u32x4;

DEVI int block_excl_scan(int v, FA_LAS int* wsum, int tid, int* tot) {
  const int lane = tid & 63, wave = tid >> 6;
  int inc = v;
#pragma unroll
  for (int o = 1; o < 64; o <<= 1) { const int t = __shfl_up(inc, o); if (lane >= o) inc += t; }
  __syncthreads();
  if (lane == 63) wsum[wave] = inc;
  __syncthreads();
  int base = 0, total = 0;
#pragma unroll
  for (int w = 0; w < 8; ++w) { const int s = wsum[w]; if (w < wave) base += s; total += s; }
  *tot = total;
  return base + inc - v;
}

template <int EPT, bool GATHER_COPY>
DEVI void topk_item(const Params& p, ldsp_t lds, int e, int n, int cap, int row0, int slot0, int erows) {
  const int tid = ftid(), lane = tid & 63, wave = tid >> 6;
  const float* AFFT = (const float*)(p.ws + WS_AFF); int* SLOT = (int*)(p.ws + WS_SLOT); float* GV = (float*)(p.ws + WS_GATEV);
  const bf16_t* H = (const bf16_t*)(p.ws + WS_H); bf16_t* XG = (bf16_t*)(p.ws + WS_XG); int* IDX = (int*)(p.ws + WS_IDX);
  FA_LAS unsigned* hist = (FA_LAS unsigned*)lds;
  FA_LAS int* misc = (FA_LAS int*)(lds + 1024);
  FA_LAS int* wsum = (FA_LAS int*)(lds + 1024 + 64);
  FA_LAS int* list = (FA_LAS int*)(lds + 2048);
  const bool act = tid * EPT < n;
  unsigned key[EPT];
#pragma unroll
  for (int j = 0; j < EPT; ++j) key[j] = act ? __float_as_uint(AFFT[(size_t)e * NROW + row0 + tid * EPT + j]) : 0u;
  unsigned prefix = 0u, mask = 0u; int k = cap;
#pragma unroll 1
  for (int pass = 0; pass < 4; ++pass) {
    const int shift = 24 - 8 * pass;
    __syncthreads();
    if (tid < 256) hist[tid] = 0u;
    __syncthreads();
    if (act) {
#pragma unroll
      for (int j = 0; j < EPT; ++j) if ((key[j] & mask) == prefix) atomicAdd((unsigned*)&hist[(key[j] >> shift) & 255u], 1u);
    }
    __syncthreads();
    if (wave == 0) {
      const int h0 = hist[4 * lane], h1 = hist[4 * lane + 1], h2 = hist[4 * lane + 2], h3 = hist[4 * lane + 3];
      const int s = h0 + h1 + h2 + h3; int v = s;
#pragma unroll
      for (int o = 1; o < 64; o <<= 1) { const int t = __shfl_down(v, o); if (lane + o < 64) v += t; }
      int c = v - s;
      const int hh[4] = {h0, h1, h2, h3};
#pragma unroll
      for (int b = 3; b >= 0; --b) { if (c < k && k <= c + hh[b]) { misc[0] = 4 * lane + b; misc[1] = k - c; } c += hh[b]; }
    }
    __syncthreads();
    prefix |= ((unsigned)misc[0]) << shift; mask |= 255u << shift; k = misc[1];
  }
  int ce = 0;
#pragma unroll
  for (int j = 0; j < EPT; ++j) ce += (act && key[j] == prefix) ? 1 : 0;
  int tot; const int eq_before = block_excl_scan(ce, wsum, tid, &tot);
  int cs = 0, eqr = eq_before; bool sel[EPT];
#pragma unroll
  for (int j = 0; j < EPT; ++j) { bool s = false; if (act) { if (key[j] > prefix) s = true; else if (key[j] == prefix) { s = eqr < k; ++eqr; } } sel[j] = s; cs += s ? 1 : 0; }
  int slot = block_excl_scan(cs, wsum, tid, &tot);
  if (act) {
#pragma unroll
    for (int j = 0; j < EPT; ++j) { const int row = row0 + tid * EPT + j;
      if (sel[j]) { if (GATHER_COPY) list[slot] = row; else IDX[e * erows + slot0 + slot] = row; GV[e * erows + slot0 + slot] = __uint_as_float(key[j]); SLOT[(size_t)row * 16 + e] = slot0 + slot; ++slot; }
      else SLOT[(size_t)row * 16 + e] = -1; }
  }
  if (GATHER_COPY) {
    __syncthreads();
    for (int s = wave; s < cap; s += NWAVE) {
      const u32x4* src = (const u32x4*)(H + (size_t)list[s] * DM) + lane; u32x4* dst = (u32x4*)(XG + ((size_t)e * erows + slot0 + s) * DM) + lane;
      const u32x4 a = src[0], b2 = src[64]; dst[0] = a; dst[64] = b2;
    }
  }
  __syncthreads();
}

DEVI void phase_topk(const Params& p, ldsp_t lds, int layer) {
  const int erows = layer ? EROWS1 : EROWS0;
  const int nlat = NB * NE, nitems = nlat + (layer ? 0 : NB * NE);
  const int G = gridDim.x;
  for (int it = blockIdx.x; it < nitems; it += G) {
    if (it < nlat) { const int b = it / NE, e = it % NE; topk_item<8, TOPK_COPY>(p, lds, e, SEQ, CAP_L, b * SEQ, b * CAP_L, erows); }
    else { const int i2 = it - nlat, b = i2 / NE, e = i2 % NE; topk_item<1, TOPK_COPY>(p, lds, e, CTXL, CAP_C, NLAT + b * CTXL, NB * CAP_L + b * CAP_C, erows); }
  }
}
}
#ifndef MOE1_FP8
#define MOE1_FP8 1
#endif
#ifndef MOE0_FP8
#define MOE0_FP8 1
#endif
namespace fr {
using fa::ldsp_t; using fa::u32x4; using fa::cvtpk;
typedef unsigned u32x2 __attribute__((ext_vector_type(2)));
typedef float f32x4 __attribute__((ext_vector_type(4)));
struct V16 { f32x4 v[4]; };
DEVI V16 ldf(const float* r, int lane) { V16 o; const f32x4* q = (const f32x4*)r + lane;
#pragma unroll
  for (int j = 0; j < 4; ++j) o.v[j] = q[64 * j]; return o; }
struct B16 { u32x2 v[4]; };
DEVI B16 ldb_raw(const bf16_t* r, int lane) { B16 o; const u32x2* q = (const u32x2*)r + lane;
#pragma unroll
  for (int j = 0; j < 4; ++j) o.v[j] = q[64 * j]; return o; }
DEVI V16 b2v(const B16& b) { V16 o;
#pragma unroll
  for (int j = 0; j < 4; ++j) { o.v[j][0] = __uint_as_float(b.v[j][0] << 16); o.v[j][1] = __uint_as_float(b.v[j][0] & 0xffff0000u); o.v[j][2] = __uint_as_float(b.v[j][1] << 16); o.v[j][3] = __uint_as_float(b.v[j][1] & 0xffff0000u); }
  return o; }
DEVI void stf(float* r, int lane, const V16& o) { f32x4* q = (f32x4*)r + lane;
#pragma unroll
  for (int j = 0; j < 4; ++j) q[64 * j] = o.v[j]; }
DEVI void stb(bf16_t* r, int lane, const V16& o) { u32x2* q = (u32x2*)r + lane;
#pragma unroll
  for (int j = 0; j < 4; ++j) { u32x2 w; w[0] = cvtpk(o.v[j][0], o.v[j][1]); w[1] = cvtpk(o.v[j][2], o.v[j][3]); q[64 * j] = w; } }
DEVI float sumsq(const V16& o) { f32x4 s = o.v[0] * o.v[0];
#pragma unroll
  for (int j = 1; j < 4; ++j) s += o.v[j] * o.v[j];
  return wave_sum((s[0] + s[1]) + (s[2] + s[3])); }

DEVI void phase_prenorm0(const Params& p) {
  const int lane = ftid() & 63, gw = blockIdx.x * NWAVE + (ftid() >> 6), NGW = gridDim.x * NWAVE;
  const float* MOD = (const float*)(p.ws + WS_CTL + CTL_MOD); bf16_t* H = (bf16_t*)(p.ws + WS_H);
  const int rpw = (NROW + NGW - 1) / NGW;
  const int r0 = gw * rpw, r1 = min(r0 + rpw, NROW);
  if (r0 >= r1) return;
  const V16 g = ldf(p.in[L0_GPREMIX], lane);
  int cur = -1; V16 gs, sh;
  auto src = [&](int r) { return r < NLAT ? p.in[I_X] + (size_t)r * DM : p.in[I_CTX] + (size_t)(r - NLAT) * DM; };
  V16 xn = ldf(src(r0), lane), xn2 = xn;
  if (r0 + 1 < r1) xn2 = ldf(src(r0 + 1), lane);
  for (int r = r0; r < r1; ++r) {
    const V16 x = xn; xn = xn2; if (r + 2 < r1) xn2 = ldf(src(r + 2), lane);
    const int mr = row_modrow(r);
    if (mr != cur) { cur = mr; const float* m = MOD + (size_t)mr * 6144; const V16 sc = ldf(m + 1024, lane); sh = ldf(m, lane);
#pragma unroll
      for (int j = 0; j < 4; ++j) gs.v[j] = g.v[j] * (sc.v[j] + 1.f); }
    const float rr = rsqrtf(sumsq(x) * (1.f / DM) + EPS);
    V16 h;
#pragma unroll
    for (int j = 0; j < 4; ++j) h.v[j] = x.v[j] * rr * gs.v[j] + sh.v[j];
    if (QKV0_FP8) {
      unsigned* q8 = (unsigned*)((unsigned char*)H + (size_t)r * DM) + lane;
#pragma unroll
      for (int j = 0; j < 4; ++j) q8[64 * j] = nv::pack4_fp8(h.v[j][0] * nv::A8_SCALE, h.v[j][1] * nv::A8_SCALE, h.v[j][2] * nv::A8_SCALE, h.v[j][3] * nv::A8_SCALE);
    } else stb(H + (size_t)r * DM, lane, h);
  }
}

template <int ABL = 0> DEVI void phase_postmix(const Params& p, ldsp_t lds, int layer) {
  const int tid = ftid(), lane = tid & 63, gw = blockIdx.x * NWAVE + (tid >> 6), NGW = gridDim.x * NWAVE;
  const float* MOD = (const float*)(p.ws + WS_CTL + CTL_MOD) + (size_t)layer * 9 * 6144;
  const bf16_t* MIX = (const bf16_t*)(p.ws + (layer ? WS_MIX1 : WS_MIX0));
  bf16_t* H = (bf16_t*)(p.ws + WS_H); float* AFFT = (float*)(p.ws + WS_AFF); float* XC = (float*)(p.ws + WS_XC);
  const float* wr = p.in[layer ? L1_WROUTER : L0_WROUTER];
  FA_LAS f32x4* WL = (FA_LAS f32x4*)lds;
  for (int i = tid; i < 1024 * 4; i += NT) { const int k = i >> 2, e4 = i & 3; const int ln = (k & 255) >> 2, q = k & 3, j = k >> 8;
    WL[((j * 4 + q) * 4 + e4) * 64 + ln] = *(const f32x4*)(wr + (size_t)k * 16 + e4 * 4); }
  __syncthreads();
  const int nrow = layer ? NLAT : NROW;
  const int rpw = (nrow + NGW - 1) / NGW;
  const int r0 = gw * rpw, r1 = min(r0 + rpw, nrow);
  if (r0 >= r1) return;
  const V16 gpost = ldf(p.in[layer ? L1_GPOSTMIX : L0_GPOSTMIX], lane), gpre = ldf(p.in[layer ? L1_GPREFFN : L0_GPREFFN], lane);
  int cur = -1; V16 gg, gs, sh;
  auto xsrc = [&](int r) { return layer ? (const float*)(p.out + (size_t)r * DM) : (r < NLAT ? p.in[I_X] + (size_t)r * DM : p.in[I_CTX] + (size_t)(r - NLAT) * DM); };
  B16 mn = ldb_raw(MIX + (size_t)r0 * DM, lane); V16 xn = ldf(xsrc(r0), lane);
  B16 mn2 = mn; V16 xn2 = xn;
  if (r0 + 1 < r1) { mn2 = ldb_raw(MIX + (size_t)(r0 + 1) * DM, lane); xn2 = ldf(xsrc(r0 + 1), lane); }
  for (int r = r0; r < r1; ++r) {
    const B16 mb = mn; const V16 x = xn;
    mn = mn2; xn = xn2;
    if (r + 2 < r1) { mn2 = ldb_raw(MIX + (size_t)(r + 2) * DM, lane); xn2 = ldf(xsrc(r + 2), lane); }
    const int mr = row_modrow(r);
    if (mr != cur) { cur = mr; const float* m = MOD + (size_t)mr * 6144; const V16 gt = ldf(m + 2048, lane), sc = ldf(m + 4096, lane); sh = ldf(m + 3072, lane);
#pragma unroll
      for (int j = 0; j < 4; ++j) { gg.v[j] = gt.v[j] * gpost.v[j]; gs.v[j] = gpre.v[j] * (sc.v[j] + 1.f); } }
    V16 o = b2v(mb);
    const float rr = rsqrtf(sumsq(o) * (1.f / DM) + EPS);
#pragma unroll
    for (int j = 0; j < 4; ++j) o.v[j] = x.v[j] + gg.v[j] * (o.v[j] * rr);
    stf(r < NLAT ? p.out + (size_t)r * DM : XC + (size_t)(r - NLAT) * DM, lane, o);
    const float r2 = rsqrtf(sumsq(o) * (1.f / DM) + EPS);
    V16 h;
#pragma unroll
    for (int j = 0; j < 4; ++j) h.v[j] = o.v[j] * r2 * gs.v[j] + sh.v[j];
    if ((layer == 1 && MOE1_FP8) || (layer == 0 && MOE0_FP8)) {
      unsigned* q8 = (unsigned*)((unsigned char*)H + (size_t)r * DM) + lane;
#pragma unroll
      for (int j = 0; j < 4; ++j) q8[64 * j] = nv::pack4_fp8(h.v[j][0] * nv::A8_SCALE, h.v[j][1] * nv::A8_SCALE, h.v[j][2] * nv::A8_SCALE, h.v[j][3] * nv::A8_SCALE);
    } else stb(H + (size_t)r * DM, lane, h);
    if (ABL == 1) continue;
    f32x4 lg[4];
    int lo = lane; asm volatile("" : "+v"(lo));
#pragma unroll
    for (int e4 = 0; e4 < 4; ++e4) lg[e4] = (f32x4){0.f, 0.f, 0.f, 0.f};
#pragma unroll
    for (int j = 0; j < 4; ++j)
#pragma unroll
      for (int q = 0; q < 4; ++q) { const float hv = h.v[j][q];
#pragma unroll
        for (int e4 = 0; e4 < 4; ++e4) lg[e4] += WL[((j * 4 + q) * 4 + e4) * 64 + lo] * hv; }
    float l16[16]; float mx = -INFINITY;
#pragma unroll
    for (int e = 0; e < 16; ++e) { l16[e] = wave_sum(lg[e >> 2][e & 3]); mx = fmaxf(mx, l16[e]); }
    float s = 0.f;
#pragma unroll
    for (int e = 0; e < 16; ++e) { l16[e] = expf(l16[e] - mx); s += l16[e]; }
    const float inv = 1.f / s; float mine = 0.f;
#pragma unroll
    for (int e = 0; e < 16; ++e) if (lane == e) mine = l16[e] * inv;
    if (lane < 16) AFFT[(size_t)lane * NROW + r] = mine;
  }
}

DEVI void phase_combine(const Params& p, int layer) {
  const int tid = ftid(), lane = tid & 63, gw = blockIdx.x * NWAVE + (tid >> 6), NGW = gridDim.x * NWAVE;
  const float* MOD = (const float*)(p.ws + WS_CTL + CTL_MOD);
  const bf16_t* Y = (const bf16_t*)(p.ws + WS_Y); const int* SLOT = (const int*)(p.ws + WS_SLOT); const float* GV = (const float*)(p.ws + WS_GATEV);
  bf16_t* H = (bf16_t*)(p.ws + WS_H); float* XC = (float*)(p.ws + WS_XC);
  const int nrow = layer ? NLAT : NROW, erows = layer ? EROWS1 : EROWS0;
  const int rpw = (nrow + NGW - 1) / NGW;
  const int r0 = gw * rpw, r1 = min(r0 + rpw, nrow);
  if (r0 >= r1) return;
  const V16 gpost = ldf(p.in[layer ? L1_GPOSTFFN : L0_GPOSTFFN], lane);
  V16 g1; if (layer == 0) g1 = ldf(p.in[L1_GPREMIX], lane);
  int cur = -1; V16 gg, gs, sh;
  int sn = (lane < 16) ? SLOT[(size_t)r0 * 16 + lane] : -1;
  for (int r = r0; r < r1; ++r) {
    const int sl = sn; if (r + 1 < r1) sn = (lane < 16) ? SLOT[(size_t)(r + 1) * 16 + lane] : -1;
    float* xio = r < NLAT ? p.out + (size_t)r * DM : XC + (size_t)(r - NLAT) * DM;
    const V16 x = ldf(xio, lane);
    const int mr = row_modrow(r);
    if (mr != cur) { cur = mr; const float* m = MOD + (size_t)(layer * 9 + mr) * 6144; const V16 gt = ldf(m + 5120, lane);
#pragma unroll
      for (int j = 0; j < 4; ++j) gg.v[j] = gt.v[j] * gpost.v[j];
      if (layer == 0) { const float* m1 = MOD + (size_t)(9 + mr) * 6144; const V16 sc = ldf(m1 + 1024, lane); sh = ldf(m1, lane);
#pragma unroll
        for (int j = 0; j < 4; ++j) gs.v[j] = g1.v[j] * (sc.v[j] + 1.f); } }
    V16 o;
#pragma unroll
    for (int j = 0; j < 4; ++j) o.v[j] = (f32x4){0.f, 0.f, 0.f, 0.f};
    unsigned long long mask = __ballot(sl >= 0);
    while (mask) {
      const int e = __builtin_ctzll(mask); mask &= mask - 1;
      const int s = __shfl(sl, e);
      const float gate = GV[e * erows + s];
      const V16 y = b2v(ldb_raw(Y + ((size_t)e * erows + s) * DM, lane));
#pragma unroll
      for (int j = 0; j < 4; ++j) o.v[j] += y.v[j] * gate;
    }
    const float rr = rsqrtf(sumsq(o) * (1.f / DM) + EPS);
#pragma unroll
    for (int j = 0; j < 4; ++j) o.v[j] = x.v[j] + gg.v[j] * (o.v[j] * rr);
    stf(xio, lane, o);
    if (layer == 0) {
      const float r2 = rsqrtf(sumsq(o) * (1.f / DM) + EPS);
      V16 h;
#pragma unroll
      for (int j = 0; j < 4; ++j) h.v[j] = o.v[j] * r2 * gs.v[j] + sh.v[j];
      if (QKV1_FP8) {
        unsigned* q8 = (unsigned*)((unsigned char*)H + (size_t)r * DM) + lane;
#pragma unroll
        for (int j = 0; j < 4; ++j) q8[64 * j] = nv::pack4_fp8(h.v[j][0] * nv::A8_SCALE, h.v[j][1] * nv::A8_SCALE, h.v[j][2] * nv::A8_SCALE, h.v[j][3] * nv::A8_SCALE);
      } else stb(H + (size_t)r * DM, lane, h);
    }
  }
}
}
#define LAS __attribute__((address_space(3)))
#define XB_TMO      128
#define XB_XCNT(j)  (256  + 64 * (j))
#define XB_XSUB(j)  (1280 + 64 * (j))
#define XB_XGEN(j)  (2304 + 64 * (j))
#define XB_TOP      3328
#define XB_TOPGEN   3392
#define XCD_BAR_WORDS 3456
#define XB_SPIN_CAP (1u << 18)

__device__ __forceinline__ unsigned xb_ld(unsigned* p)              { return __hip_atomic_load(p, __ATOMIC_RELAXED, __HIP_MEMORY_SCOPE_AGENT); }
__device__ __forceinline__ unsigned xb_add(unsigned* p, unsigned v) { return __hip_atomic_fetch_add(p, v, __ATOMIC_RELAXED, __HIP_MEMORY_SCOPE_AGENT); }
__device__ __forceinline__ unsigned xb_xcc_id() { return (unsigned)__builtin_amdgcn_s_getreg((3 << 11) | 20) & 0xFu; }
#define XB_SPIN(cond, bar) do { unsigned _sp = 0; while (cond) { __builtin_amdgcn_s_sleep(1); \
    if ((++_sp & 255u) == 0u) { if (xb_ld(&(bar)[XB_TMO])) break; if (_sp > XB_SPIN_CAP) { atomicAdd(&(bar)[XB_TMO], 1u); break; } } } } while (0)

struct XcdBarrier {
    unsigned* bar; unsigned x;
    volatile LAS unsigned* st;
};

__device__ __forceinline__ XcdBarrier xcd_barrier_post(unsigned* bar, volatile LAS unsigned* st) {
    XcdBarrier b; b.bar = bar; b.x = xb_xcc_id(); b.st = st;
    if (threadIdx.x == 0) (void)xb_add(&bar[XB_XCNT(b.x)], 1u);
    return b;
}
__device__ __forceinline__ void xcd_barrier_complete(unsigned* bar, unsigned x, unsigned& nloc, unsigned& nx) {
    const unsigned G = gridDim.x * gridDim.y * gridDim.z;
    unsigned sum, cnt, mine, sp = 0u;
    for (;;) {
        sum = 0u; cnt = 0u; mine = 0u;
#pragma unroll
        for (unsigned j = 0; j < 16; ++j) { const unsigned c = xb_ld(&bar[XB_XCNT(j)]); sum += c; cnt += (c > 0u) ? 1u : 0u; mine = (j == x) ? c : mine; }
        if (sum == G) break;
        __builtin_amdgcn_s_sleep(1);
        if ((++sp & 255u) == 0u) { if (xb_ld(&bar[XB_TMO])) break; if (sp > XB_SPIN_CAP) { atomicAdd(&bar[XB_TMO], 1u); break; } }
    }
    nloc = mine > 0u ? mine : 1u; nx = cnt > 0u ? cnt : 1u;
}

__device__ __forceinline__ void xcd_barrier(const XcdBarrier& b) {
    asm volatile("s_waitcnt vmcnt(0)" ::: "memory");
    __syncthreads();
    if (threadIdx.x == 0) {
        unsigned* bar = b.bar;
        __builtin_amdgcn_s_waitcnt(0);
        unsigned nloc = b.st[0], nx = b.st[1];
        if (nloc == 0u) { xcd_barrier_complete(bar, b.x, nloc, nx); b.st[0] = nloc; b.st[1] = nx; }
        const unsigned old = xb_add(&bar[XB_XSUB(b.x)], 1u);
        const unsigned gen = old / nloc;
        if (old + 1u == (gen + 1u) * nloc) {
            __builtin_amdgcn_fence(__ATOMIC_RELEASE, "agent");
            asm volatile("s_waitcnt vmcnt(0)" ::: "memory");
            const unsigned og = xb_add(&bar[XB_TOP], 1u);
            const unsigned tg = og / nx;
            if (og + 1u == (tg + 1u) * nx) xb_add(&bar[XB_TOPGEN], 1u);
            else XB_SPIN(xb_ld(&bar[XB_TOPGEN]) == tg, bar);
            __builtin_amdgcn_fence(__ATOMIC_ACQUIRE, "agent");
            xb_add(&bar[XB_XGEN(b.x)], 1u);
            asm volatile("s_waitcnt vmcnt(0)" ::: "memory");
        } else {
            XB_SPIN(xb_ld(&bar[XB_XGEN(b.x)]) == gen, bar);
            __builtin_amdgcn_fence(__ATOMIC_ACQUIRE, "agent");
            asm volatile("s_waitcnt vmcnt(0)" ::: "memory");
        }
    }
    __syncthreads();
}


__device__ __forceinline__ void flat_barrier(unsigned* ctr, unsigned& epoch) {
    asm volatile("s_waitcnt vmcnt(0)" ::: "memory");
    __syncthreads();
    if (threadIdx.x == 0) {
        __builtin_amdgcn_fence(__ATOMIC_RELEASE, "agent");
        asm volatile("s_waitcnt vmcnt(0)" ::: "memory");
        (void)__hip_atomic_fetch_add(ctr, 1u, __ATOMIC_RELAXED, __HIP_MEMORY_SCOPE_AGENT);
        const unsigned target = (epoch + 1u) * (unsigned)gridDim.x; unsigned sp = 0;
        while (__hip_atomic_load(ctr, __ATOMIC_RELAXED, __HIP_MEMORY_SCOPE_AGENT) < target) { __builtin_amdgcn_s_sleep(1); if (++sp > (1u << 22)) break; }
        __builtin_amdgcn_fence(__ATOMIC_ACQUIRE, "agent");
        asm volatile("s_waitcnt vmcnt(0)" ::: "memory");
    }
    ++epoch;
    __syncthreads();
}

__device__ __forceinline__ void xcd_barrier2(const XcdBarrier& b) {
    asm volatile("s_waitcnt vmcnt(0)" ::: "memory");
    __syncthreads();
    if (threadIdx.x == 0) {
        unsigned* bar = b.bar;
        __builtin_amdgcn_s_waitcnt(0);
        unsigned nloc = b.st[0], nx = b.st[1];
        if (nloc == 0u) { xcd_barrier_complete(bar, b.x, nloc, nx); b.st[0] = nloc; b.st[1] = nx; }
        const unsigned old = xb_add(&bar[XB_XSUB(b.x)], 1u);
        const unsigned gen = old / nloc;
        if (old + 1u == (gen + 1u) * nloc) {
            __builtin_amdgcn_fence(__ATOMIC_RELEASE, "agent");
            asm volatile("s_waitcnt vmcnt(0)" ::: "memory");
            (void)xb_add(&bar[XB_TOP], 1u);
        }
        const unsigned target = (gen + 1u) * nx;
        XB_SPIN(xb_ld(&bar[XB_TOP]) < target, bar);
        __builtin_amdgcn_fence(__ATOMIC_ACQUIRE, "agent");
        asm volatile("s_waitcnt vmcnt(0)" ::: "memory");
    }
    __syncthreads();
}
constexpr int LDS_BYTES = 147456;
#define TAILFILL 1
#ifndef FAST_GEMM
#define FAST_GEMM 1
#endif
#ifndef FAST_TOPK
#define FAST_TOPK 1
#endif
#ifndef FAST_SSD
#define FAST_SSD 1
#endif
#ifndef FAST_ATTN
#define FAST_ATTN 1
#endif
__global__ void __launch_bounds__(NT) mega(Params p) {
  extern __shared__ __attribute__((aligned(16))) unsigned char lds_raw[];
  float* lds = (float*)lds_raw;
  fg::ldsp_t ldsp = (fg::ldsp_t)lds_raw;
  cg::grid_group grid = cg::this_grid();
  volatile LAS unsigned* bst = (volatile LAS unsigned*)((LAS unsigned char*)lds_raw + (LDS_BYTES - 64));
  if (threadIdx.x < 2) bst[threadIdx.x] = 0u;
  unsigned* barw = (unsigned*)(p.ws + WS_CTL + CTL_BAR);
  if (blockIdx.x == 0) { const int t0 = ftid(); for (int i = t0; i < XCD_BAR_WORDS; i += NT) barw[i] = 0u; }
  XcdBarrier xbar; xbar.bar = barw; xbar.x = 0; xbar.st = bst;
#ifdef FLATBAR
  unsigned fb_epoch = 0; unsigned* fb_ctr = barw + XCD_BAR_WORDS - 64;
#define GSYNC() flat_barrier(fb_ctr, fb_epoch)
#elif defined(XBAR2)
#define GSYNC() xcd_barrier2(xbar)
#else
#define GSYNC() xcd_barrier(xbar)
#endif
  nv::phase0(p, lds);                 grid.sync();
  xbar = xcd_barrier_post(barw, bst);
#ifdef DUP_SYNC
  for (int i = 0; i < 20; ++i) GSYNC();
#endif
#ifdef DUP_P0
  nv::phase0(p, lds);                 GSYNC();
#endif
  fr::phase_prenorm0(p);              GSYNC();
#ifdef DUP_PRENORM
  fr::phase_prenorm0(p); GSYNC();
#endif
#if FAST_GEMM
  fg::phase_qkv0(p, ldsp); GSYNC();
#ifdef DUP_QKV0
  fg::phase_qkv0(p, ldsp); GSYNC();
#endif
#else
  nv::phase_qkv0(p, lds);             GSYNC();
#endif
#if FAST_ATTN
  fa::phase_attnA(p, ldsp); fa::phase_attnB(p, ldsp); GSYNC();
#ifdef DUP_A
  fa::phase_attnA<DUP_A>(p, ldsp); GSYNC();
#endif
#ifdef DUP_B
  fa::phase_attnB<DUP_B>(p, ldsp); GSYNC();
#endif
#else
  nv::phase_attn0(p, lds);            GSYNC();
#endif
#if FAST_GEMM
#ifdef TAILFILL
  fg::phase_outproj(p, ldsp, 0); nv::convert_moe_tail8(p, 0, 1, lds, NROW / 256 * (DM / 256)); GSYNC();
#else
  fg::phase_outproj(p, ldsp, 0); GSYNC();
#endif
#ifdef DUP_OUT0
  fg::phase_outproj(p, ldsp, 0); GSYNC();
#endif
#else
  nv::phase_outproj(p, lds, 0);       GSYNC();
#endif
  fr::phase_postmix(p, ldsp, 0);            GSYNC();
#ifdef DUP_POSTMIX0
  fr::phase_postmix<DUP_POSTMIX0>(p, ldsp, 0); GSYNC();
#endif
#if FAST_TOPK
  ft::phase_topk(p, ldsp, 0);         GSYNC();
#ifdef DUP_TOPK0
  ft::phase_topk(p, ldsp, 0);         GSYNC();
#endif
#else
  nv::phase_topk(p, lds, 0);          GSYNC();
  fg::phase_gather(p, 0);             GSYNC();
#endif
#if FAST_GEMM
  fg::phase_moe_up8(p, ldsp, 0);      GSYNC();
#ifdef DUP_UP0
  fg::phase_moe_up8(p, ldsp, 0); GSYNC();
#endif
  fg::phase_moe_down8(p, ldsp, 0);    GSYNC();
#ifdef DUP_DOWN0
  fg::phase_moe_down8(p, ldsp, 0); GSYNC();
#endif
#else
  nv::phase_moe_up(p, lds, 0);        GSYNC();
  nv::phase_moe_down(p, lds, 0);      GSYNC();
#endif
#ifdef TAILFILL
  fr::phase_combine(p, 0); GSYNC();
#else
  fr::phase_combine(p, 0); nv::convert_moe_tail(p, 1, 0, lds, 0); nv::convert_moe_tail(p, 1, 1, lds, 0); GSYNC();
#endif
#if FAST_GEMM
#ifdef TAILFILL
  fg::phase_qkv1(p, ldsp); GSYNC();
#else
  fg::phase_qkv1(p, ldsp); GSYNC();
#endif
#else
  nv::phase_qkv1(p, lds);             GSYNC();
#endif
#if FAST_ATTN
#if FAST_SSD
#ifdef TAILFILL
  fs::phase_conv(p); GSYNC();
#else
  fs::phase_conv(p); GSYNC();
#endif
#else
  nv::phase_conv_swa(p, lds, true); GSYNC();
#endif
#else
  nv::phase_conv_swa(p, lds, true);   GSYNC();
#endif
#if FAST_SSD
  fs::phase_ssd(p, ldsp); fa::phase_attnC(p, ldsp, (int*)(p.ws + WS_CTL + CTL_QC));
  nv::convert_moe_tail8(p, 1, 0, lds, NB * 2 * 8); nv::convert_moe_tail8(p, 1, 1, lds, NB * 2 * 8); GSYNC();
#ifdef DUP_SSD
  fs::phase_ssd<DUP_SSD>(p, ldsp);             GSYNC();
#endif
  fs::phase_ssd_out(p);               GSYNC();
#else
  nv::phase_ssd(p, lds);              GSYNC();
  nv::phase_ssd_out(p);               GSYNC();
#endif
#if FAST_GEMM
  fg::phase_outproj(p, ldsp, 1);      GSYNC();
#else
  nv::phase_outproj(p, lds, 1);       GSYNC();
#endif
  fr::phase_postmix(p, ldsp, 1);            GSYNC();
#if FAST_TOPK
  ft::phase_topk(p, ldsp, 1);         GSYNC();
#ifdef DUP_TOPK1
  ft::phase_topk(p, ldsp, 1);         GSYNC();
#endif
#else
  nv::phase_topk(p, lds, 1);          GSYNC();
  fg::phase_gather(p, 1);             GSYNC();
#endif
#if FAST_GEMM
  fg::phase_moe_up8(p, ldsp, 1);      GSYNC();
  fg::phase_moe_down8(p, ldsp, 1);    GSYNC();
#else
  nv::phase_moe_up(p, lds, 1);        GSYNC();
  nv::phase_moe_down(p, lds, 1);      GSYNC();
#endif
  fr::phase_combine(p, 1);
}


extern "C" void kernel_launch(void* const* d_in, const int* in_sizes, int n_in, void* d_out, int out_size,
                              void* d_ws, size_t ws_size, hipStream_t stream) {
  static int grid_blocks = 0;
  if (!grid_blocks) {
    int dev = 0, cus = 0, per_cu = 0;
    (void)hipGetDevice(&dev);
    (void)hipDeviceGetAttribute(&cus, hipDeviceAttributeMultiprocessorCount, dev);
    (void)hipFuncSetAttribute((const void*)mega, hipFuncAttributeMaxDynamicSharedMemorySize, LDS_BYTES);
    (void)hipOccupancyMaxActiveBlocksPerMultiprocessor(&per_cu, (const void*)mega, NT, LDS_BYTES);
    if (per_cu < 1) { fprintf(stderr, "kernel_launch: occupancy query says %d blocks/CU\n", per_cu); per_cu = 1; }
    grid_blocks = cus;
    if (n_in != 43 || ws_size < WS_END) fprintf(stderr, "kernel_launch: unexpected n_in %d / ws_size %zu (need %zu)\n", n_in, ws_size, (size_t)WS_END);
  }
  Params p{};
  for (int i = 0; i < 43; ++i) p.in[i] = (const float*)d_in[i];
  p.out = (float*)d_out; p.ws = (unsigned char*)d_ws;
  void* args[] = {&p};
  hipError_t e = hipLaunchCooperativeKernel((void*)mega, dim3(grid_blocks), dim3(NT), args, LDS_BYTES, stream);
  if (e != hipSuccess) fprintf(stderr, "cooperative launch failed: %s (grid %d)\n", hipGetErrorString(e), grid_blocks);
}
```

```cpp
#include <hip/hip_runtime.h>
#include <hip/hip_cooperative_groups.h>
#include <cstdio>
#include <cstdint>
namespace cg = cooperative_groups;

typedef unsigned short bf16_t;
#define DEVI __device__ __forceinline__

constexpr int NT = 512, NWAVE = 8;
constexpr int NB = 8, SEQ = 4096, DM = 1024, CTXL = 256;
constexpr int NLAT = NB * SEQ, NCTX = NB * CTXL, NROW = NLAT + NCTX;
constexpr int NE = 16;
constexpr int CAP_L = 512, CAP_C = 32;
constexpr int EROWS0 = NB * CAP_L + NB * CAP_C;
constexpr int EROWS1 = NB * CAP_L;
constexpr int N_IN0 = 3072, N_IN1 = 2320, N_IN1P = 2560;
constexpr float EPS = 1e-6f;

constexpr size_t MiB = 1u << 20;
constexpr size_t WS_CTL = 0;
constexpr size_t WS_WIN0 = 1 * MiB;
constexpr size_t WS_WIN1 = 7 * MiB;
constexpr size_t WS_WOUT0 = 12 * MiB, WS_WOUT1 = 14 * MiB;
constexpr size_t WS_WGU = 16 * MiB;
constexpr size_t WS_WD = 80 * MiB;
constexpr size_t WS_XC = 112 * MiB;
constexpr size_t WS_H = 120 * MiB;
constexpr size_t WS_AFF = 188 * MiB;
constexpr size_t WS_SLOT = 191 * MiB;
constexpr size_t WS_IDX = 194 * MiB;
constexpr size_t WS_GATEV = 195 * MiB;
constexpr size_t WS_BIG = 196 * MiB;
constexpr size_t WS_QKV0 = WS_BIG;
constexpr size_t WS_ATT0 = WS_BIG + 204 * MiB;
constexpr size_t WS_MIX0 = WS_BIG + 272 * MiB;
constexpr size_t WS_XG = WS_BIG;
constexpr size_t WS_HID = WS_BIG + 136 * MiB;
constexpr size_t WS_Y = WS_BIG;
constexpr size_t WS_P1 = WS_BIG;
constexpr size_t WS_DT = WS_BIG + 153 * MiB;
constexpr size_t WS_U = WS_BIG + 156 * MiB;
constexpr size_t WS_MIX1 = WS_U;
constexpr size_t WS_ATT1 = WS_BIG + 224 * MiB;
constexpr size_t WS_YS = WS_BIG + 292 * MiB;
constexpr size_t WS_CUMG = WS_BIG + 356 * MiB;
constexpr size_t WS_DTG = WS_BIG + 359 * MiB;
constexpr size_t WS_VT = WS_BIG + 340 * MiB;
constexpr size_t WS_VTB = WS_BIG + 362 * MiB;
constexpr size_t WS_END = WS_BIG + 380 * MiB;
constexpr size_t CTL_MOD = 4096;
constexpr size_t CTL_ROPE = CTL_MOD + 2 * 9 * 6144 * 4;
constexpr size_t CTL_LAM = CTL_ROPE + 64 * 16 * 2 * 4;
constexpr size_t CTL_QC = CTL_LAM + 64;
constexpr size_t CTL_BAR = 512 * 1024;

struct Params {
  const float* in[43];
  float* out;
  unsigned char* ws;
};

enum {
  I_X = 0, I_C, I_CTX, I_CCTX,
  L0_WMOD, L0_BMOD, L0_GPREMIX, L0_GPOSTMIX, L0_GPREFFN, L0_GPOSTFFN, L0_WIN, L0_WOUT,
  L0_LAMQ1, L0_LAMK1, L0_LAMQ2, L0_LAMK2, L0_SUBLN, L0_RPB, L0_WROUTER, L0_WGATE, L0_WUP, L0_WDOWN,
  L1_WMOD, L1_BMOD, L1_GPREMIX, L1_GPOSTMIX, L1_GPREFFN, L1_GPOSTFFN, L1_WIN, L1_WOUT,
  L1_SINKS, L1_CONVW, L1_CONVB, L1_ALOGF, L1_ALOGB, L1_DTBF, L1_DTBB, L1_DSKIP, L1_GNORM,
  L1_WROUTER, L1_WGATE, L1_WUP, L1_WDOWN
};

DEVI int ftid() { int t = threadIdx.x; asm volatile("" : "+v"(t)); return t; }
DEVI float bf2f(bf16_t v) { return __uint_as_float(((unsigned)v) << 16); }
DEVI bf16_t f2bf(float f) { unsigned u = __float_as_uint(f); return (bf16_t)((u + 0x7fffu + ((u >> 16) & 1u)) >> 16); }
DEVI unsigned pk2(float lo, float hi) { return (unsigned)f2bf(lo) | ((unsigned)f2bf(hi) << 16); }
DEVI float silu_f(float v) { return v / (1.f + __expf(-v)); }
template <int CTRL> DEVI float dppf(float v) { return __uint_as_float((unsigned)__builtin_amdgcn_update_dpp(0, (int)__float_as_uint(v), CTRL, 0xf, 0xf, true)); }
constexpr int DPP_XOR1 = 0xB1, DPP_XOR2 = 0x4E, DPP_HMIRROR = 0x141, DPP_MIRROR = 0x140;
DEVI float wave_sum(float v) {
  v += dppf<DPP_XOR1>(v); v += dppf<DPP_XOR2>(v); v += dppf<DPP_HMIRROR>(v); v += dppf<DPP_MIRROR>(v);
  { const auto s = __builtin_amdgcn_permlane16_swap(__float_as_uint(v), __float_as_uint(v), false, false); v = __uint_as_float(s[0]) + __uint_as_float(s[1]); }
  { const auto s = __builtin_amdgcn_permlane32_swap(__float_as_uint(v), __float_as_uint(v), false, false); v = __uint_as_float(s[0]) + __uint_as_float(s[1]); }
  return v;
}
DEVI float quad_sum(float v) {
  v += dppf<DPP_HMIRROR>(v); v += dppf<DPP_MIRROR>(v);
  { const auto s = __builtin_amdgcn_permlane16_swap(__float_as_uint(v), __float_as_uint(v), false, false); v = __uint_as_float(s[0]) + __uint_as_float(s[1]); }
  { const auto s = __builtin_amdgcn_permlane32_swap(__float_as_uint(v), __float_as_uint(v), false, false); v = __uint_as_float(s[0]) + __uint_as_float(s[1]); }
  return v;
}
DEVI float quad_max(float v) {
  v = fmaxf(v, dppf<DPP_HMIRROR>(v)); v = fmaxf(v, dppf<DPP_MIRROR>(v));
  { const auto s = __builtin_amdgcn_permlane16_swap(__float_as_uint(v), __float_as_uint(v), false, false); v = fmaxf(__uint_as_float(s[0]), __uint_as_float(s[1])); }
  { const auto s = __builtin_amdgcn_permlane32_swap(__float_as_uint(v), __float_as_uint(v), false, false); v = fmaxf(__uint_as_float(s[0]), __uint_as_float(s[1])); }
  return v;
}
DEVI float wave_max(float v) {
  v = fmaxf(v, dppf<DPP_XOR1>(v)); v = fmaxf(v, dppf<DPP_XOR2>(v)); v = fmaxf(v, dppf<DPP_HMIRROR>(v)); v = fmaxf(v, dppf<DPP_MIRROR>(v));
  { const auto s = __builtin_amdgcn_permlane16_swap(__float_as_uint(v), __float_as_uint(v), false, false); v = fmaxf(__uint_as_float(s[0]), __uint_as_float(s[1])); }
  { const auto s = __builtin_amdgcn_permlane32_swap(__float_as_uint(v), __float_as_uint(v), false, false); v = fmaxf(__uint_as_float(s[0]), __uint_as_float(s[1])); }
  return v;
}
DEVI int row_modrow(int r) { return r < NLAT ? (r >> 12) : 8; }
#ifndef QKV0_FP8
#define QKV0_FP8 1
#endif
#ifndef OUT_FP8
#define OUT_FP8 0
#endif
#ifndef QKV1_FP8
#define QKV1_FP8 0
#endif
namespace nv {

DEVI void transpose_item(const float* W, int K, int N, bf16_t* WT, int row_off, int row_mul, float* scr, int item, int lane, int Npad) {
  const int nblk = Npad / 32, kb = item / nblk, nb = item % nblk, k0 = 64 * kb, n0 = 32 * nb;
  const int n = n0 + (lane & 31); const bool ok = n < N;
  const float* src = W + (size_t)(k0 + (lane >> 5)) * N + (ok ? n : 0);
  float v[32];
#pragma unroll
  for (int i = 0; i < 32; ++i) v[i] = src[(size_t)(2 * i) * N];
#pragma unroll
  for (int i = 0; i < 32; ++i) scr[(2 * i + (lane >> 5)) * 33 + (lane & 31)] = ok ? v[i] : 0.f;
  __builtin_amdgcn_s_waitcnt(0); __builtin_amdgcn_wave_barrier();
  const int c = lane & 7;
#pragma unroll
  for (int j = 0; j < 4; ++j) {
    const int nn = (lane >> 3) + 8 * j; const float* s = scr + (8 * c) * 33 + nn;
    uint4 o; o.x = pk2(s[0 * 33], s[1 * 33]); o.y = pk2(s[2 * 33], s[3 * 33]); o.z = pk2(s[4 * 33], s[5 * 33]); o.w = pk2(s[6 * 33], s[7 * 33]);
    *(uint4*)(WT + (size_t)(row_off + (n0 + nn) * row_mul) * K + k0 + 8 * c) = o;
  }
  __builtin_amdgcn_s_waitcnt(0); __builtin_amdgcn_wave_barrier();
}

DEVI void convert_moe_part(const Params& p, int layer, int which, float* scr, int gw, int NGW, int lane) {
  const float* wg = p.in[layer ? L1_WGATE : L0_WGATE]; const float* wu = p.in[layer ? L1_WUP : L0_WUP]; const float* wd = p.in[layer ? L1_WDOWN : L0_WDOWN];
  bf16_t* WGU = (bf16_t*)(p.ws + WS_WGU); bf16_t* WD = (bf16_t*)(p.ws + WS_WD);
  constexpr int IPM = 16 * 32;
  if (which == 0) {
    for (int it = gw; it < NE * 2 * IPM; it += NGW) {
      const int e = it / (2 * IPM), r = it % (2 * IPM), gu = r / IPM, item = r % IPM;
      transpose_item((gu ? wu : wg) + (size_t)e * DM * DM, DM, DM, WGU + (size_t)e * 2048 * DM, gu, 2, scr, item, lane, DM);
    }
  } else {
    for (int it = gw; it < NE * IPM; it += NGW) {
      const int e = it / IPM, item = it % IPM;
      transpose_item(wd + (size_t)e * DM * DM, DM, DM, WD + (size_t)e * DM * DM, 0, 1, scr, item, lane, DM);
    }
  }
}
DEVI void convert_moe_tail(const Params& p, int layer, int which, float* lds, int nunits) {
  const int first = nunits % (int)gridDim.x;
  if ((int)blockIdx.x < first) return;
  const int w = ftid() >> 6;
  convert_moe_part(p, layer, which, lds + w * (64 * 33), ((int)blockIdx.x - first) * NWAVE + w, ((int)gridDim.x - first) * NWAVE, ftid() & 63);
}


constexpr float W8_SCALE = 64.f, A8_SCALE = 4.f;
constexpr int W8_E8M0 = 0x79797979, A8_E8M0 = 0x7d7d7d7d;
DEVI unsigned pack4_fp8(float a, float b, float c, float d) {
  a = fminf(fmaxf(a, -448.f), 448.f); b = fminf(fmaxf(b, -448.f), 448.f); c = fminf(fmaxf(c, -448.f), 448.f); d = fminf(fmaxf(d, -448.f), 448.f);
  int w = 0; w = __builtin_amdgcn_cvt_pk_fp8_f32(a, b, w, false); w = __builtin_amdgcn_cvt_pk_fp8_f32(c, d, w, true); return (unsigned)w; }
DEVI void transpose_item8(const float* W, int K, int N, unsigned char* WT, int row_off, int row_mul, float* scr, int item, int lane, int Npad = 0) {
  if (Npad == 0) Npad = N;
  const int nblk = Npad / 32, kb = item / nblk, nb = item % nblk, k0 = 64 * kb, n0 = 32 * nb;
  const int nn0 = n0 + (lane & 31); const bool ok = nn0 < N;
  const float* src = W + (size_t)(k0 + (lane >> 5)) * N + (ok ? nn0 : 0);
  float v[32];
#pragma unroll
  for (int i = 0; i < 32; ++i) v[i] = src[(size_t)(2 * i) * N];
#pragma unroll
  for (int i = 0; i < 32; ++i) scr[(2 * i + (lane >> 5)) * 33 + (lane & 31)] = ok ? v[i] * W8_SCALE : 0.f;
  __builtin_amdgcn_s_waitcnt(0); __builtin_amdgcn_wave_barrier();
  const int c = lane & 7;
#pragma unroll
  for (int j = 0; j < 4; ++j) {
    const int nn = (lane >> 3) + 8 * j; const float* s = scr + (8 * c) * 33 + nn;
    uint2 o; o.x = pack4_fp8(s[0 * 33], s[1 * 33], s[2 * 33], s[3 * 33]); o.y = pack4_fp8(s[4 * 33], s[5 * 33], s[6 * 33], s[7 * 33]);
    *(uint2*)(WT + (size_t)(row_off + (n0 + nn) * row_mul) * K + k0 + 8 * c) = o;
  }
  __builtin_amdgcn_s_waitcnt(0); __builtin_amdgcn_wave_barrier();
}
DEVI void convert_moe_part8(const Params& p, int layer, int which, float* scr, int gw, int NGW, int lane) {
  const float* wg = p.in[layer ? L1_WGATE : L0_WGATE]; const float* wu = p.in[layer ? L1_WUP : L0_WUP]; const float* wd = p.in[layer ? L1_WDOWN : L0_WDOWN];
  unsigned char* WGU = (unsigned char*)(p.ws + WS_WGU); unsigned char* WD = (unsigned char*)(p.ws + WS_WD);
  constexpr int IPM = 16 * 32;
  if (which == 0) {
    for (int it = gw; it < NE * 2 * IPM; it += NGW) { const int e = it / (2 * IPM), r = it % (2 * IPM), gu = r / IPM, item = r % IPM;
      transpose_item8((gu ? wu : wg) + (size_t)e * DM * DM, DM, DM, WGU + (size_t)e * 2048 * DM, gu, 2, scr, item, lane); }
  } else {
    for (int it = gw; it < NE * IPM; it += NGW) { const int e = it / IPM, item = it % IPM;
      transpose_item8(wd + (size_t)e * DM * DM, DM, DM, WD + (size_t)e * DM * DM, 0, 1, scr, item, lane); }
  }
}
DEVI void convert_moe_tail8(const Params& p, int layer, int which, float* lds, int nunits) {
  const int first = nunits % (int)gridDim.x;
  if ((int)blockIdx.x < first) return;
  const int w = ftid() >> 6;
  convert_moe_part8(p, layer, which, lds + w * (64 * 33), ((int)blockIdx.x - first) * NWAVE + w, ((int)gridDim.x - first) * NWAVE, ftid() & 63);
}

DEVI void phase0(const Params& p, float* lds) {
  const int tid = ftid(), lane = tid & 63, wave = tid >> 6;
  const int gw = blockIdx.x * NWAVE + wave, NGW = gridDim.x * NWAVE;
  for (int it = blockIdx.x; it < 2 * 96; it += gridDim.x) {
    const int layer = it / 96, j0 = (it % 96) * 64;
    float* sc = lds;
    float* red = lds + 9 * 1024;
    __syncthreads();
    for (int i = tid; i < 9 * 1024; i += NT) { const int r = i >> 10, k = i & 1023; const float v = (r < 8) ? p.in[I_C][r * 1024 + k] : p.in[I_CCTX][k]; sc[i] = silu_f(v); }
    __syncthreads();
    const float* wm = p.in[layer ? L1_WMOD : L0_WMOD];
    float acc[9];
#pragma unroll
    for (int r = 0; r < 9; ++r) acc[r] = 0.f;
    for (int k0 = wave * 128; k0 < wave * 128 + 128; k0 += 16) {
      float w[16];
#pragma unroll
      for (int i = 0; i < 16; ++i) w[i] = wm[(size_t)(k0 + i) * 6144 + j0 + lane];
#pragma unroll
      for (int i = 0; i < 16; ++i)
#pragma unroll
        for (int r = 0; r < 9; ++r) acc[r] += sc[r * 1024 + k0 + i] * w[i];
    }
#pragma unroll
    for (int r = 0; r < 9; ++r) red[(wave * 9 + r) * 64 + lane] = acc[r];
    __syncthreads();
    for (int i = tid; i < 9 * 64; i += NT) {
      const int r = i >> 6, c = i & 63; float s = 0.f;
      for (int w = 0; w < 8; ++w) s += red[(w * 9 + r) * 64 + c];
      float* MOD = (float*)(p.ws + WS_CTL + CTL_MOD);
      MOD[(layer * 9 + r) * 6144 + j0 + c] = s + p.in[layer ? L1_BMOD : L0_BMOD][j0 + c];
    }
    __syncthreads();
  }
  if (blockIdx.x == gridDim.x - 1) {
    float* ROPE = (float*)(p.ws + WS_CTL + CTL_ROPE);
    for (int i = tid; i < 64 * 16; i += NT) {
      const int pos = i >> 4, f = i & 15;
      const float inv = powf(10000.f, -(float)f / 16.f);
      const float ang = (float)pos * inv;
      ROPE[2 * i] = cosf(ang); ROPE[2 * i + 1] = sinf(ang);
    }
    if (wave == 0) {
      float a = p.in[L0_LAMQ1][lane] * p.in[L0_LAMK1][lane], b = p.in[L0_LAMQ2][lane] * p.in[L0_LAMK2][lane];
      a = wave_sum(a); b = wave_sum(b);
      if (lane == 0) { float* LAM = (float*)(p.ws + WS_CTL + CTL_LAM); LAM[0] = expf(a) - expf(b) + 0.2f; *(int*)(p.ws + WS_CTL + CTL_QC) = 0; }
    }
  }
  __syncthreads();
  float* scr = lds + wave * (64 * 33);
  {
    constexpr int I_IN0 = 16 * (N_IN0 / 32), I_OUT = 16 * 32, I_IN1 = 16 * (N_IN1P / 32);
    constexpr int NITEMS = I_IN0 + I_OUT + I_IN1 + I_OUT;
    for (int it = gw; it < NITEMS; it += NGW) {
      int r = it;
      if (r < I_IN0) { if (QKV0_FP8) transpose_item8(p.in[L0_WIN], DM, N_IN0, (unsigned char*)(p.ws + WS_WIN0), 0, 1, scr, r, lane); else transpose_item(p.in[L0_WIN], DM, N_IN0, (bf16_t*)(p.ws + WS_WIN0), 0, 1, scr, r, lane, N_IN0); continue; } r -= I_IN0;
      if (r < I_OUT) { if (OUT_FP8) transpose_item8(p.in[L0_WOUT], DM, DM, (unsigned char*)(p.ws + WS_WOUT0), 0, 1, scr, r, lane); else transpose_item(p.in[L0_WOUT], DM, DM, (bf16_t*)(p.ws + WS_WOUT0), 0, 1, scr, r, lane, DM); continue; } r -= I_OUT;
      if (r < I_IN1) { if (QKV1_FP8) transpose_item8(p.in[L1_WIN], DM, N_IN1, (unsigned char*)(p.ws + WS_WIN1), 0, 1, scr, r, lane, N_IN1P); else transpose_item(p.in[L1_WIN], DM, N_IN1, (bf16_t*)(p.ws + WS_WIN1), 0, 1, scr, r, lane, N_IN1P); continue; } r -= I_IN1;
      if (OUT_FP8) transpose_item8(p.in[L1_WOUT], DM, DM, (unsigned char*)(p.ws + WS_WOUT1), 0, 1, scr, r, lane); else transpose_item(p.in[L1_WOUT], DM, DM, (bf16_t*)(p.ws + WS_WOUT1), 0, 1, scr, r, lane, DM);
    }
  }
  convert_moe_part8(p, 0, 0, scr, gw, NGW, lane);
#ifndef TAILFILL
  convert_moe_part8(p, 0, 1, scr, gw, NGW, lane);
#endif
}

struct Row16 { float4 v[4]; };
DEVI Row16 ld_row_f32(const float* r, int lane) { Row16 o; const float4* q = (const float4*)r + lane;
#pragma unroll
  for (int j = 0; j < 4; ++j) o.v[j] = q[64 * j]; return o; }
DEVI Row16 ld_row_bf16(const bf16_t* r, int lane) { Row16 o; const uint2* q = (const uint2*)r + lane;
#pragma unroll
  for (int j = 0; j < 4; ++j) { const uint2 w = q[64 * j]; o.v[j] = make_float4(__uint_as_float(w.x << 16), __uint_as_float(w.x & 0xffff0000u), __uint_as_float(w.y << 16), __uint_as_float(w.y & 0xffff0000u)); }
  return o; }
DEVI void st_row_f32(float* r, int lane, const Row16& o) { float4* q = (float4*)r + lane;
#pragma unroll
  for (int j = 0; j < 4; ++j) q[64 * j] = o.v[j]; }
DEVI void st_row_bf16(bf16_t* r, int lane, const Row16& o) { uint2* q = (uint2*)r + lane;
#pragma unroll
  for (int j = 0; j < 4; ++j) q[64 * j] = make_uint2(pk2(o.v[j].x, o.v[j].y), pk2(o.v[j].z, o.v[j].w)); }
DEVI float row_sumsq(const Row16& o) { float s = 0.f;
#pragma unroll
  for (int j = 0; j < 4; ++j) s += o.v[j].x * o.v[j].x + o.v[j].y * o.v[j].y + o.v[j].z * o.v[j].z + o.v[j].w * o.v[j].w;
  return wave_sum(s); }
#define ROW_FOR4(expr) _Pragma("unroll") for (int j = 0; j < 4; ++j) { { float& e = o.v[j].x; const float a = A.v[j].x, b = Bv.v[j].x, c = Cv.v[j].x; expr; } { float& e = o.v[j].y; const float a = A.v[j].y, b = Bv.v[j].y, c = Cv.v[j].y; expr; } { float& e = o.v[j].z; const float a = A.v[j].z, b = Bv.v[j].z, c = Cv.v[j].z; expr; } { float& e = o.v[j].w; const float a = A.v[j].w, b = Bv.v[j].w, c = Cv.v[j].w; expr; } }

DEVI Row16 norm_mod(const Row16& x, const float* g, const float* sc, const float* sh, int lane) {
  const float r = rsqrtf(row_sumsq(x) * (1.f / DM) + EPS);
  Row16 o = x; const Row16 A = ld_row_f32(g, lane), Bv = ld_row_f32(sc, lane), Cv = ld_row_f32(sh, lane);
  ROW_FOR4(e = e * r * a * (1.f + b) + c);
  return o;
}

DEVI void phase_prenorm0(const Params& p) {
  const int lane = ftid() & 63, gw = blockIdx.x * NWAVE + (ftid() >> 6), NGW = gridDim.x * NWAVE;
  const float* MOD = (const float*)(p.ws + WS_CTL + CTL_MOD);
  bf16_t* H = (bf16_t*)(p.ws + WS_H);
  for (int r = gw; r < NROW; r += NGW) {
    const float* src = r < NLAT ? p.in[I_X] + (size_t)r * DM : p.in[I_CTX] + (size_t)(r - NLAT) * DM;
    const float* m = MOD + (size_t)row_modrow(r) * 6144;
    const Row16 x = ld_row_f32(src, lane);
    const Row16 h = norm_mod(x, p.in[L0_GPREMIX], m + 1024, m, lane);
    st_row_bf16(H + (size_t)r * DM, lane, h);
  }
}

template <class AF, class EF>
DEVI void gemm_tile(float* lds, const bf16_t* Bt, int n0, int K, AF arow, EF epi) {
  const int tid = ftid(), ty = tid >> 4, tx = tid & 15;
  float (*As)[132] = (float (*)[132])lds;
  float (*Bs)[68] = (float (*)[68])(lds + 16 * 132);
  float acc[4][4];
#pragma unroll
  for (int i = 0; i < 4; ++i)
#pragma unroll
    for (int j = 0; j < 4; ++j) acc[i][j] = 0.f;
  const int ar = tid >> 2, ak = (tid & 3) * 4;
  const int br = tid >> 3, bk = (tid & 7) * 2;
  const bf16_t* ap = arow(ar) + ak;
  const bf16_t* bp = Bt + (size_t)(n0 + br) * K + bk;
  for (int k0 = 0; k0 < K; k0 += 16) {
    const uint2 av = *(const uint2*)(ap + k0);
    const unsigned bv = *(const unsigned*)(bp + k0);
    __syncthreads();
    As[ak + 0][ar] = __uint_as_float(av.x << 16); As[ak + 1][ar] = __uint_as_float(av.x & 0xffff0000u);
    As[ak + 2][ar] = __uint_as_float(av.y << 16); As[ak + 3][ar] = __uint_as_float(av.y & 0xffff0000u);
    Bs[bk + 0][br] = __uint_as_float(bv << 16); Bs[bk + 1][br] = __uint_as_float(bv & 0xffff0000u);
    __syncthreads();
#pragma unroll
    for (int kk = 0; kk < 16; ++kk) {
      const float4 a = *(const float4*)&As[kk][ty * 4]; const float4 b = *(const float4*)&Bs[kk][tx * 4];
      const float aa[4] = {a.x, a.y, a.z, a.w}, bb[4] = {b.x, b.y, b.z, b.w};
#pragma unroll
      for (int i = 0; i < 4; ++i)
#pragma unroll
        for (int j = 0; j < 4; ++j) acc[i][j] += aa[i] * bb[j];
    }
  }
#pragma unroll
  for (int i = 0; i < 4; ++i) epi(ty * 4 + i, n0 + tx * 4, acc[i]);
}

DEVI void rope_pair(const float* ROPE, int t, int d, float& u1, float& u2) {
  const int i = d >> 1, f = i & 15, pos = (i < 16) ? (t >> 6) : (t & 63);
  const float cs = ROPE[(pos * 16 + f) * 2], sn = ROPE[(pos * 16 + f) * 2 + 1];
  const float a = u1 * cs - u2 * sn, b = u1 * sn + u2 * cs; u1 = a; u2 = b;
}

DEVI void phase_qkv0(const Params& p, float* lds) {
  const bf16_t* H = (const bf16_t*)(p.ws + WS_H); const bf16_t* W = (const bf16_t*)(p.ws + WS_WIN0);
  bf16_t* Q = (bf16_t*)(p.ws + WS_QKV0); const float* ROPE = (const float*)(p.ws + WS_CTL + CTL_ROPE);
  constexpr int NTN = N_IN0 / 64, NTM = NROW / 128;
  for (int it = blockIdx.x; it < NTN * NTM; it += gridDim.x) {
    const int mt = it / NTN, nt = it % NTN, m0 = mt * 128;
    gemm_tile(lds, W, nt * 64, DM,
      [&](int r) { return H + (size_t)(m0 + r) * DM; },
      [&](int r, int n, float* v) {
        const int row = m0 + r;
        if (row < NLAT && n < 1024) { const int t = row & 4095; rope_pair(ROPE, t, n & 63, v[0], v[1]); rope_pair(ROPE, t, (n + 2) & 63, v[2], v[3]); }
        *(uint2*)(Q + (size_t)row * N_IN0 + n) = make_uint2(pk2(v[0], v[1]), pk2(v[2], v[3]));
      });
  }
}

template <int NS, int VJ, class KF>
DEVI void wave_attn(const float* qs, float* pl  , int* rl  , int nkeys, KF kf, const bf16_t* KV, int ld, int kcol, int vcol,
                    float sink, bool has_sink, float (&o)[NS][VJ], float (&m)[NS], float (&l)[NS], int lane) {
#pragma unroll
  for (int s = 0; s < NS; ++s) { m[s] = -INFINITY; l[s] = 0.f;
#pragma unroll
    for (int j = 0; j < VJ; ++j) o[s][j] = 0.f; }
  for (int c0 = 0; c0 < nkeys; c0 += 64) {
    const int kidx = c0 + lane; int row = -1; float bias = 0.f;
    bool valid = kidx < nkeys; if (valid) valid = kf(kidx, row, bias);
    const int rr = valid ? row : 0;
    rl[lane] = valid ? row : -1;
    float sc[NS];
#pragma unroll
    for (int s = 0; s < NS; ++s) {
      const uint4* kp = (const uint4*)(KV + (size_t)rr * ld + kcol + 64 * s); float d = 0.f;
#pragma unroll
      for (int i = 0; i < 8; ++i) { const uint4 w = kp[i]; const float* q = qs + s * 64 + i * 8;
        d += q[0] * __uint_as_float(w.x << 16) + q[1] * __uint_as_float(w.x & 0xffff0000u) + q[2] * __uint_as_float(w.y << 16) + q[3] * __uint_as_float(w.y & 0xffff0000u)
           + q[4] * __uint_as_float(w.z << 16) + q[5] * __uint_as_float(w.z & 0xffff0000u) + q[6] * __uint_as_float(w.w << 16) + q[7] * __uint_as_float(w.w & 0xffff0000u); }
      sc[s] = valid ? d + bias : -INFINITY;
    }
#pragma unroll
    for (int s = 0; s < NS; ++s) {
      const float cm = wave_max(sc[s]); const float mn = fmaxf(m[s], cm);
      float pv = 0.f, scale = 1.f;
      if (mn > -INFINITY) { pv = __expf(sc[s] - mn); scale = __expf(m[s] - mn); }
      l[s] = l[s] * scale + wave_sum(pv); m[s] = mn;
#pragma unroll
      for (int j = 0; j < VJ; ++j) o[s][j] *= scale;
      pl[s * 64 + lane] = pv;
    }
    __builtin_amdgcn_s_waitcnt(0); __builtin_amdgcn_wave_barrier();
    for (int kk = 0; kk < 64; ++kk) {
      const int rk = rl[kk]; if (rk < 0) continue;
      const bf16_t* vp = KV + (size_t)rk * ld + vcol + lane;
      float vv[VJ];
#pragma unroll
      for (int j = 0; j < VJ; ++j) vv[j] = bf2f(vp[64 * j]);
#pragma unroll
      for (int s = 0; s < NS; ++s) { const float pk = pl[s * 64 + kk];
#pragma unroll
        for (int j = 0; j < VJ; ++j) o[s][j] += pk * vv[j]; }
    }
    __builtin_amdgcn_s_waitcnt(0); __builtin_amdgcn_wave_barrier();
  }
  if (has_sink) {
#pragma unroll
    for (int s = 0; s < NS; ++s) { const float mn = fmaxf(m[s], sink); const float scale = __expf(m[s] - mn);
      l[s] = l[s] * scale + __expf(sink - mn); m[s] = mn;
#pragma unroll
      for (int j = 0; j < VJ; ++j) o[s][j] *= scale; }
  }
}

DEVI void phase_attn0(const Params& p, float* lds) {
  const int tid = ftid(), lane = tid & 63, wave = tid >> 6;
  const int gw = blockIdx.x * NWAVE + wave, NGW = gridDim.x * NWAVE;
  const bf16_t* Q = (const bf16_t*)(p.ws + WS_QKV0); bf16_t* ATT = (bf16_t*)(p.ws + WS_ATT0);
  const float lam = ((const float*)(p.ws + WS_CTL + CTL_LAM))[0];
  float* qs = lds + wave * 128; float* pl = lds + 1024 + wave * 128; int* rl = (int*)(lds + 2048) + wave * 64;
  for (long it = gw; it < (long)NROW * 12; it += NGW) {
    const int row = (int)(it / 12), hs = (int)(it % 12);
    const bool lat = row < NLAT; const int b = lat ? (row >> 12) : ((row - NLAT) >> 8), t = lat ? (row & 4095) : 0;
    __builtin_amdgcn_s_waitcnt(0); __builtin_amdgcn_wave_barrier();
    if (hs < 4) {
      const bf16_t* qp = Q + (size_t)row * N_IN0 + hs * 128;
      qs[lane] = bf2f(qp[lane]) * 0.125f; qs[64 + lane] = bf2f(qp[64 + lane]) * 0.125f;
      __builtin_amdgcn_s_waitcnt(0); __builtin_amdgcn_wave_barrier();
      float o[2][2], m[2], l[2];
      const int nkeys = lat ? SEQ + CTXL : CTXL;
      wave_attn<2, 2>(qs, pl, rl, nkeys, [&](int k, int& r, float& bias) { r = lat ? (k < SEQ ? b * SEQ + k : NLAT + b * CTXL + (k - SEQ)) : NLAT + b * CTXL + k; return true; },
                      Q, N_IN0, 512 + hs * 128, 1024 + hs * 128, 0.f, false, o, m, l, lane);
      float v0 = o[0][0] / l[0] - lam * o[1][0] / l[1], v1 = o[0][1] / l[0] - lam * o[1][1] / l[1];
      const float r = rsqrtf(wave_sum(v0 * v0 + v1 * v1) * (1.f / 128.f) + EPS);
      const float* g = p.in[L0_SUBLN];
      ATT[(size_t)row * DM + hs * 128 + lane] = f2bf(v0 * r * g[lane] * 0.8f);
      ATT[(size_t)row * DM + hs * 128 + 64 + lane] = f2bf(v1 * r * g[64 + lane] * 0.8f);
    } else {
      const int h = hs - 4;
      qs[lane] = bf2f(Q[(size_t)row * N_IN0 + 1536 + h * 64 + lane]) * 0.125f;
      __builtin_amdgcn_s_waitcnt(0); __builtin_amdgcn_wave_barrier();
      float o[1][1], m[1], l[1];
      const int qr = t >> 6, qc = t & 63;
      const int rs = min(max(qr - 4, 0), 56), cs = min(max(qc - 8, 0), 48);
      const float* rpb = p.in[L0_RPB] + h * 15 * 31;
      const int nkeys = lat ? 128 + CTXL : CTXL;
      wave_attn<1, 1>(qs, pl, rl, nkeys, [&](int k, int& r, float& bias) {
          if (!lat) { r = NLAT + b * CTXL + k; return true; }
          if (k < 128) { const int kr = rs + (k >> 4), kc = cs + (k & 15); r = b * SEQ + kr * 64 + kc; bias = rpb[(kr - qr + 7) * 31 + (kc - qc + 15)]; }
          else r = NLAT + b * CTXL + (k - 128);
          return true; },
        Q, N_IN0, 2048 + h * 64, 2560 + h * 64, 0.f, false, o, m, l, lane);
      ATT[(size_t)row * DM + 512 + h * 64 + lane] = f2bf(o[0][0] / l[0]);
    }
  }
}

DEVI void phase_outproj(const Params& p, float* lds, int layer) {
  const bf16_t* A = (const bf16_t*)(p.ws + (layer ? WS_ATT1 : WS_ATT0)); const bf16_t* W = (const bf16_t*)(p.ws + (layer ? WS_WOUT1 : WS_WOUT0));
  bf16_t* MIX = (bf16_t*)(p.ws + (layer ? WS_MIX1 : WS_MIX0));
  const int NTM = (layer ? NLAT : NROW) / 128; constexpr int NTN = DM / 64;
  for (int it = blockIdx.x; it < NTN * NTM; it += gridDim.x) {
    const int mt = it / NTN, nt = it % NTN, m0 = mt * 128;
    gemm_tile(lds, W, nt * 64, DM, [&](int r) { return A + (size_t)(m0 + r) * DM; },
      [&](int r, int n, float* v) { *(uint2*)(MIX + (size_t)(m0 + r) * DM + n) = make_uint2(pk2(v[0], v[1]), pk2(v[2], v[3])); });
  }
}

DEVI void phase_postmix(const Params& p, int layer) {
  const int lane = ftid() & 63, gw = blockIdx.x * NWAVE + (ftid() >> 6), NGW = gridDim.x * NWAVE;
  const float* MOD = (const float*)(p.ws + WS_CTL + CTL_MOD) + (size_t)layer * 9 * 6144;
  const bf16_t* MIX = (const bf16_t*)(p.ws + (layer ? WS_MIX1 : WS_MIX0));
  bf16_t* H = (bf16_t*)(p.ws + WS_H); float* AFF = (float*)(p.ws + WS_AFF); float* XC = (float*)(p.ws + WS_XC);
  const float* gpost = p.in[layer ? L1_GPOSTMIX : L0_GPOSTMIX]; const float* gpre = p.in[layer ? L1_GPREFFN : L0_GPREFFN];
  const float* wr = p.in[layer ? L1_WROUTER : L0_WROUTER];
  const int nrow = layer ? NLAT : NROW;
  for (int r = gw; r < nrow; r += NGW) {
    const float* m = MOD + (size_t)row_modrow(r) * 6144;
    const float* xin = layer ? (p.out + (size_t)r * DM) : (r < NLAT ? p.in[I_X] + (size_t)r * DM : p.in[I_CTX] + (size_t)(r - NLAT) * DM);
    float* xout = r < NLAT ? p.out + (size_t)r * DM : XC + (size_t)(r - NLAT) * DM;
    Row16 o = ld_row_bf16(MIX + (size_t)r * DM, lane);
    const float rr = rsqrtf(row_sumsq(o) * (1.f / DM) + EPS);
    { const Row16 A = ld_row_f32(gpost, lane), Bv = ld_row_f32(m + 2048, lane), Cv = ld_row_f32(xin, lane);
      ROW_FOR4(e = c + b * (e * rr * a)); }
    st_row_f32(xout, lane, o);
    const Row16 h = norm_mod(o, gpre, m + 4096, m + 3072, lane);
    st_row_bf16(H + (size_t)r * DM, lane, h);
    float lg[16];
#pragma unroll
    for (int e = 0; e < 16; ++e) lg[e] = 0.f;
#pragma unroll
    for (int j = 0; j < 4; ++j) {
      const float hv[4] = {h.v[j].x, h.v[j].y, h.v[j].z, h.v[j].w};
#pragma unroll
      for (int q = 0; q < 4; ++q) { const float4* w4 = (const float4*)(wr + (size_t)(lane * 4 + 256 * j + q) * 16);
#pragma unroll
        for (int e4 = 0; e4 < 4; ++e4) { const float4 w = w4[e4]; lg[e4 * 4] += hv[q] * w.x; lg[e4 * 4 + 1] += hv[q] * w.y; lg[e4 * 4 + 2] += hv[q] * w.z; lg[e4 * 4 + 3] += hv[q] * w.w; } }
    }
    float mx = -INFINITY;
#pragma unroll
    for (int e = 0; e < 16; ++e) { lg[e] = wave_sum(lg[e]); mx = fmaxf(mx, lg[e]); }
    float s = 0.f;
#pragma unroll
    for (int e = 0; e < 16; ++e) { lg[e] = expf(lg[e] - mx); s += lg[e]; }
    const float inv = 1.f / s;
    float mine = 0.f;
#pragma unroll
    for (int e = 0; e < 16; ++e) if (lane == e) mine = lg[e] * inv;
    if (lane < 16) AFF[(size_t)lane * NROW + r] = mine;
  }
}

DEVI void phase_topk(const Params& p, float* lds, int layer) {
  const int tid = ftid();
  const float* AFF = (const float*)(p.ws + WS_AFF); int* SLOT = (int*)(p.ws + WS_SLOT); int* IDX = (int*)(p.ws + WS_IDX); float* GV = (float*)(p.ws + WS_GATEV);
  const int erows = layer ? EROWS1 : EROWS0;
  const int nlat_items = NB * NE * 8, nitems = nlat_items + (layer ? 0 : NB * NE);
  for (int it = blockIdx.x; it < nitems; it += gridDim.x) {
    const bool lat = it < nlat_items;
    int b, e, ch, n, cap, row0, slot0;
    if (lat) { b = it / (NE * 8); e = (it / 8) % NE; ch = it % 8; n = SEQ; cap = CAP_L; row0 = b * SEQ; slot0 = b * CAP_L; }
    else { const int i2 = it - nlat_items; b = i2 / NE; e = i2 % NE; ch = 0; n = CTXL; cap = CAP_C; row0 = NLAT + b * CTXL; slot0 = NB * CAP_L + b * CAP_C; }
    __syncthreads();
    for (int i = tid; i < n; i += NT) lds[i] = AFF[(size_t)e * NROW + row0 + i];
    __syncthreads();
    const int t = ch * 512 + tid;
    if (t < n) {
      const float a = lds[t]; int rank = 0;
      for (int j = 0; j < n; ++j) { const float v = lds[j]; rank += (v > a || (v == a && j < t)) ? 1 : 0; }
      if (rank < cap) { IDX[e * erows + slot0 + rank] = row0 + t; GV[e * erows + slot0 + rank] = a; SLOT[(size_t)(row0 + t) * 16 + e] = slot0 + rank; }
      else SLOT[(size_t)(row0 + t) * 16 + e] = -1;
    }
  }
}

DEVI void phase_moe_up(const Params& p, float* lds, int layer) {
  const bf16_t* H = (const bf16_t*)(p.ws + WS_H); const bf16_t* WGU = (const bf16_t*)(p.ws + WS_WGU); bf16_t* HID = (bf16_t*)(p.ws + WS_HID);
  const int* IDX = (const int*)(p.ws + WS_IDX);
  const int erows = layer ? EROWS1 : EROWS0, NTM = erows / 128; constexpr int NTN = 2048 / 64;
  for (int it = blockIdx.x; it < NE * NTM * NTN; it += gridDim.x) {
    const int e = it / (NTM * NTN), r2 = it % (NTM * NTN), mt = r2 / NTN, nt = r2 % NTN, m0 = mt * 128;
    gemm_tile(lds, WGU + (size_t)e * 2048 * DM, nt * 64, DM, [&](int r) { return H + (size_t)IDX[e * erows + m0 + r] * DM; },
      [&](int r, int n, float* v) { *(unsigned*)(HID + ((size_t)e * erows + m0 + r) * DM + (n >> 1)) = pk2(silu_f(v[0]) * v[1], silu_f(v[2]) * v[3]); });
  }
}
DEVI void phase_moe_down(const Params& p, float* lds, int layer) {
  const bf16_t* HID = (const bf16_t*)(p.ws + WS_HID); const bf16_t* WD = (const bf16_t*)(p.ws + WS_WD); bf16_t* Y = (bf16_t*)(p.ws + WS_Y);
  const float* GV = (const float*)(p.ws + WS_GATEV);
  const int erows = layer ? EROWS1 : EROWS0, NTM = erows / 128; constexpr int NTN = DM / 64;
  for (int it = blockIdx.x; it < NE * NTM * NTN; it += gridDim.x) {
    const int e = it / (NTM * NTN), r2 = it % (NTM * NTN), mt = r2 / NTN, nt = r2 % NTN, m0 = mt * 128;
    gemm_tile(lds, WD + (size_t)e * DM * DM, nt * 64, DM, [&](int r) { return HID + ((size_t)e * erows + m0 + r) * DM; },
      [&](int r, int n, float* v) { const float g = GV[e * erows + m0 + r];
        *(uint2*)(Y + ((size_t)e * erows + m0 + r) * DM + n) = make_uint2(pk2(v[0] * g, v[1] * g), pk2(v[2] * g, v[3] * g)); });
  }
}

DEVI void phase_combine(const Params& p, float* lds, int layer) {
  const int lane = ftid() & 63, wave = ftid() >> 6, gw = blockIdx.x * NWAVE + wave, NGW = gridDim.x * NWAVE;
  const float* MOD = (const float*)(p.ws + WS_CTL + CTL_MOD);
  const bf16_t* Y = (const bf16_t*)(p.ws + WS_Y); const int* SLOT = (const int*)(p.ws + WS_SLOT);
  bf16_t* H = (bf16_t*)(p.ws + WS_H); float* XC = (float*)(p.ws + WS_XC);
  const float* gpost = p.in[layer ? L1_GPOSTFFN : L0_GPOSTFFN];
  const int nrow = layer ? NLAT : NROW, erows = layer ? EROWS1 : EROWS0;
  for (int r = gw; r < nrow; r += NGW) {
    const float* m = MOD + (size_t)(layer * 9 + row_modrow(r)) * 6144;
    float* xio = r < NLAT ? p.out + (size_t)r * DM : XC + (size_t)(r - NLAT) * DM;
    Row16 o;
#pragma unroll
    for (int j = 0; j < 4; ++j) o.v[j] = make_float4(0.f, 0.f, 0.f, 0.f);
    for (int e = 0; e < NE; ++e) {
      const int s = SLOT[(size_t)r * 16 + e];
      if (s >= 0) { const Row16 y = ld_row_bf16(Y + ((size_t)e * erows + s) * DM, lane);
#pragma unroll
        for (int j = 0; j < 4; ++j) { o.v[j].x += y.v[j].x; o.v[j].y += y.v[j].y; o.v[j].z += y.v[j].z; o.v[j].w += y.v[j].w; } }
    }
    const float rr = rsqrtf(row_sumsq(o) * (1.f / DM) + EPS);
    { const Row16 A = ld_row_f32(gpost, lane), Bv = ld_row_f32(m + 5120, lane), Cv = ld_row_f32(xio, lane);
      ROW_FOR4(e = c + b * (e * rr * a)); }
    st_row_f32(xio, lane, o);
    if (layer == 0) {
      const float* m1 = MOD + (size_t)(9 + row_modrow(r)) * 6144;
      const Row16 h = norm_mod(o, p.in[L1_GPREMIX], m1 + 1024, m1, lane);
      st_row_bf16(H + (size_t)r * DM, lane, h);
    }
  }
  if (layer == 0) { convert_moe_part(p, 1, 0, lds + wave * (64 * 33), gw, NGW, lane); convert_moe_part(p, 1, 1, lds + wave * (64 * 33), gw, NGW, lane); }
}

DEVI void phase_qkv1(const Params& p, float* lds) {
  const bf16_t* H = (const bf16_t*)(p.ws + WS_H); const bf16_t* W = (const bf16_t*)(p.ws + WS_WIN1);
  bf16_t* P1 = (bf16_t*)(p.ws + WS_P1); float* DT = (float*)(p.ws + WS_DT); const float* ROPE = (const float*)(p.ws + WS_CTL + CTL_ROPE);
  constexpr int NTN = 37, NTM = NROW / 128;
  for (int it = blockIdx.x; it < NTN * NTM; it += gridDim.x) {
    const int mt = it / NTN, nt = it % NTN, m0 = mt * 128;
    gemm_tile(lds, W, nt * 64, DM, [&](int r) { return H + (size_t)(m0 + r) * DM; },
      [&](int r, int n, float* v) {
        const int row = m0 + r;
        if (n >= 2304) { if (n < 2320) *(float4*)(DT + (size_t)row * 16 + (n - 2304)) = make_float4(v[0], v[1], v[2], v[3]); return; }
        if (row < NLAT && n < 640) { const int t = row & 4095; rope_pair(ROPE, t, n & 63, v[0], v[1]); rope_pair(ROPE, t, (n + 2) & 63, v[2], v[3]); }
        *(uint2*)(P1 + (size_t)row * 2304 + n) = make_uint2(pk2(v[0], v[1]), pk2(v[2], v[3]));
      });
  }
}

DEVI void phase_conv_swa(const Params& p, float* lds, bool do_swa) {
  const int tid = ftid(), lane = tid & 63, wave = tid >> 6;
  const int gw = blockIdx.x * NWAVE + wave, NGW = gridDim.x * NWAVE;
  const bf16_t* P1 = (const bf16_t*)(p.ws + WS_P1); bf16_t* U = (bf16_t*)(p.ws + WS_U); bf16_t* ATT = (bf16_t*)(p.ws + WS_ATT1);
  const float* cw = p.in[L1_CONVW]; const float* cb = p.in[L1_CONVB];
  for (long i = (long)blockIdx.x * NT + tid; i < (long)NROW * 1024; i += (long)gridDim.x * NT) {
    const int row = (int)(i >> 10), ch = (int)(i & 1023);
    int s0, len, t; if (row < NLAT) { s0 = row & ~4095; len = SEQ; t = row & 4095; } else { s0 = NLAT + ((row - NLAT) & ~255); len = CTXL; t = (row - NLAT) & 255; }
    float acc = cb[ch];
#pragma unroll
    for (int j = 0; j < 5; ++j) { const int tt = t + j - 2; if (tt >= 0 && tt < len) acc += cw[j * 1024 + ch] * bf2f(P1[(size_t)(s0 + tt) * 2304 + 768 + ch]); }
    U[(size_t)row * 1024 + ch] = f2bf(silu_f(acc));
  }
  if (!do_swa) return;
  float* qs = lds + wave * 128; float* pl = lds + 1024 + wave * 128; int* rl = (int*)(lds + 2048) + wave * 64;
  for (long it = gw; it < (long)NLAT * 8; it += NGW) {
    const int row = (int)(it >> 3), hq = (int)(it & 7), g = hq >> 2, b = row >> 12, t = row & 4095;
    __builtin_amdgcn_s_waitcnt(0); __builtin_amdgcn_wave_barrier();
    qs[lane] = bf2f(P1[(size_t)row * 2304 + hq * 64 + lane]) * 0.125f;
    __builtin_amdgcn_s_waitcnt(0); __builtin_amdgcn_wave_barrier();
    float o[1][1], m[1], l[1];
    wave_attn<1, 1>(qs, pl, rl, 320 + CTXL, [&](int k, int& r, float& bias) {
        if (k < 320) { const int kp = t - 128 + k; if (k > 256 || kp < 0 || kp >= SEQ) return false; r = b * SEQ + kp; return true; }
        r = NLAT + b * CTXL + (k - 320); return true; },
      P1, 2304, 512 + g * 64, 640 + g * 64, p.in[L1_SINKS][hq], true, o, m, l, lane);
    ATT[(size_t)row * DM + hq * 64 + lane] = f2bf(o[0][0] / l[0]);
  }
}

DEVI void phase_ssd(const Params& p, float* lds) {
  const int tid = ftid();
  const bf16_t* U = (const bf16_t*)(p.ws + WS_U); const float* DT = (const float*)(p.ws + WS_DT); float* YS = (float*)(p.ws + WS_YS);
  constexpr int CH = 32;
  float* xb = lds;
  float* bb = lds + CH * 64;
  float* cb = bb + CH * 128;
  float* db = cb + CH * 128;
  float* yb = db + 2 * CH;
  const int pi = tid >> 3, ns = (tid & 7) * 16;
  for (int it = blockIdx.x; it < NB * 8; it += gridDim.x) {
    const int b = it >> 3, hd = it & 7, g = hd >> 2;
    for (int dir = 0; dir < 2; ++dir) {
      const float a = -expf(p.in[dir ? L1_ALOGB : L1_ALOGF][hd]); const float dtb = p.in[dir ? L1_DTBB : L1_DTBF][hd];
      float st[16];
#pragma unroll
      for (int i = 0; i < 16; ++i) st[i] = 0.f;
      for (int seg = 0; seg < 2; ++seg) {
        const int len = seg ? SEQ : CTXL, s0 = seg ? b * SEQ : NLAT + b * CTXL;
        for (int c0 = 0; c0 < len; c0 += CH) {
          __syncthreads();
          for (int i = tid; i < CH * 320; i += NT) {
            const int st_i = i / 320, c = i % 320; const int tk = dir ? (len - 1 - (c0 + st_i)) : (c0 + st_i); const size_t r = (size_t)(s0 + tk);
            if (c < 64) xb[st_i * 64 + c] = bf2f(U[r * 1024 + hd * 64 + c]);
            else if (c < 192) bb[st_i * 128 + (c - 64)] = bf2f(U[r * 1024 + 512 + g * 128 + (c - 64)]);
            else cb[st_i * 128 + (c - 192)] = bf2f(U[r * 1024 + 768 + g * 128 + (c - 192)]);
          }
          if (tid < CH) { const int tk = dir ? (len - 1 - (c0 + tid)) : (c0 + tid); const float raw = DT[(size_t)(s0 + tk) * 16 + dir * 8 + hd] + dtb;
            const float dt = raw > 20.f ? raw : log1pf(expf(raw)); db[tid] = expf(dt * a); db[CH + tid] = dt; }
          __syncthreads();
          for (int i = 0; i < CH; ++i) {
            const float dec = db[i], dx = db[CH + i] * xb[i * 64 + pi]; float y = 0.f;
#pragma unroll
            for (int q = 0; q < 16; ++q) { st[q] = st[q] * dec + dx * bb[i * 128 + ns + q]; y += st[q] * cb[i * 128 + ns + q]; }
            y += __shfl_xor(y, 1); y += __shfl_xor(y, 2); y += __shfl_xor(y, 4);
            if ((tid & 7) == 0) yb[i * 64 + pi] = y;
          }
          __syncthreads();
          if (seg == 1) for (int i = tid; i < CH * 64; i += NT) {
            const int q = i >> 6, c = i & 63; const int tk = (dir ? (len - CH - c0) : c0) + q, st_i = dir ? (CH - 1 - q) : q;
            float* yp = YS + (size_t)(b * SEQ + tk) * 512 + hd * 64 + c;
            if (dir == 0) *yp = yb[st_i * 64 + c]; else *yp = *yp + yb[st_i * 64 + c];
          }
        }
      }
      __syncthreads(); __threadfence();
    }
  }
}

DEVI void phase_ssd_out(const Params& p) {
  const int lane = ftid() & 63, gw = blockIdx.x * NWAVE + (ftid() >> 6), NGW = gridDim.x * NWAVE;
  const bf16_t* U = (const bf16_t*)(p.ws + WS_U); const bf16_t* P1 = (const bf16_t*)(p.ws + WS_P1); const float* YS = (const float*)(p.ws + WS_YS);
  bf16_t* ATT = (bf16_t*)(p.ws + WS_ATT1);
  for (int r = gw; r < NLAT; r += NGW) {
    const int c0 = lane * 8, hd = c0 >> 6; const float dsk = p.in[L1_DSKIP][hd];
    const float4 y0 = *(const float4*)(YS + (size_t)r * 512 + c0), y1 = *(const float4*)(YS + (size_t)r * 512 + c0 + 4);
    const uint4 xw = *(const uint4*)(U + (size_t)r * 1024 + c0), zw = *(const uint4*)(P1 + (size_t)r * 2304 + 1792 + c0);
    float y[8] = {y0.x, y0.y, y0.z, y0.w, y1.x, y1.y, y1.z, y1.w};
    const unsigned xs[4] = {xw.x, xw.y, xw.z, xw.w}, zs[4] = {zw.x, zw.y, zw.z, zw.w};
    float ss = 0.f;
#pragma unroll
    for (int i = 0; i < 4; ++i) {
      const float x0 = __uint_as_float(xs[i] << 16), x1 = __uint_as_float(xs[i] & 0xffff0000u), z0 = __uint_as_float(zs[i] << 16), z1 = __uint_as_float(zs[i] & 0xffff0000u);
      y[2 * i] = (y[2 * i] + dsk * x0) * silu_f(z0); y[2 * i + 1] = (y[2 * i + 1] + dsk * x1) * silu_f(z1);
      ss += y[2 * i] * y[2 * i] + y[2 * i + 1] * y[2 * i + 1];
    }
#pragma unroll
    for (int o = 1; o < 32; o <<= 1) ss += __shfl_xor(ss, o);
    const float rr = rsqrtf(ss * (1.f / 256.f) + EPS);
    const float4 g0 = *(const float4*)(p.in[L1_GNORM] + c0), g1 = *(const float4*)(p.in[L1_GNORM] + c0 + 4);
    uint4 w; w.x = pk2(y[0] * rr * g0.x, y[1] * rr * g0.y); w.y = pk2(y[2] * rr * g0.z, y[3] * rr * g0.w); w.z = pk2(y[4] * rr * g1.x, y[5] * rr * g1.y); w.w = pk2(y[6] * rr * g1.z, y[7] * rr * g1.w);
    *(uint4*)(ATT + (size_t)r * DM + 512 + c0) = w;
  }
}

}
namespace pg8 {
#define PG8_LAS __attribute__((address_space(3)))
typedef unsigned short bf16_t;
typedef short bf16x8 __attribute__((ext_vector_type(8)));
typedef float f32x4 __attribute__((ext_vector_type(4)));
typedef unsigned u32x4 __attribute__((ext_vector_type(4)));
constexpr int BM = 256, BK = 64, HALF = 128, HTB = HALF * BK * 2  , STAGE_BYTES = 8 * HTB, NXCD = 8, WGM = 8;

__host__ __device__ __forceinline__ int lds_byte(int r, int c) { const int st = (r >> 4) * 2 + (c >> 5), rr = r & 15, cc = c & 31, ob = rr * 64 + cc * 2; return st * 1024 + (ob ^ (((ob >> 9) & 1) << 5)); }
__host__ __device__ __forceinline__ void stage_rc(int b, int& R, int& C) { const int st = b / 1024, sb = b % 1024, swz = sb ^ (((sb >> 9) & 1) << 5); R = (st >> 1) * 16 + swz / 64; C = (st & 1) * 32 + (swz % 64) / 2; }
__host__ __device__ __forceinline__ int perm32(int rho) { const int n = rho >> 4, i = rho & 15; return 8 * (i >> 2) + 4 * n + (i & 3); }

struct Unit { int pm, pn; };
struct Gemm { const bf16_t* A; const bf16_t* Bt; int M, N, K; const int* gidx = nullptr; int sw = 0x7f7f7f7f, sa = 0x7f7f7f7f; };

struct StaticOrder {
    int nM, nN, nwg, G, c;
    __host__ __device__ void init(int M, int N, int G_, int c_) { nM = M / BM; nN = N / BM; nwg = nM * nN; G = G_; c = c_; }
    __host__ __device__ bool next(int i, Unit& u) const {
        const long L = (long)i * G + c; if (L >= nwg) return false;
        int wgid = (int)L; { const int q = nwg / NXCD, r = nwg % NXCD, xcd = wgid % NXCD, off = wgid / NXCD; wgid = (xcd < r ? xcd * (q + 1) : r * (q + 1) + (xcd - r) * q) + off; }
        const int nig = WGM * nN, gid = wgid / nig, fm = gid * WGM, gsz = (nM - fm) < WGM ? (nM - fm) : WGM;
        u.pm = fm + ((wgid % nig) % gsz); u.pn = (wgid % nig) / gsz; return true;
    }
    __device__ __forceinline__ void a_ready(const Unit&) const {}
    __device__ __forceinline__ void done(const Unit&) const {}
};

template <class Epi, class Sched, bool ALIGN_EPI = false, bool SP2 = false, bool FP8 = false>
__device__ __forceinline__ void gemm_phase(PG8_LAS unsigned char* lds, const Gemm g, const Sched& S, const Epi& E) {
    const int tid = ftid(), wid = __builtin_amdgcn_readfirstlane(tid >> 6), lane = tid & 63, wr = wid >> 2, wc = wid & 3, fr = lane & 15, fq = lane >> 4;
    const int KB = g.K * (FP8 ? 1 : 2), nt = KB / (BK * 2);
    unsigned voffB[2]; int pR[2], pC[2];
#pragma unroll
    for (int i = 0; i < 2; ++i) { int R, C; stage_rc(tid * 16 + i * 8192, R, C); const int Rb = Epi::PERM ? ((R & ~31) + perm32(R & 31)) : R;
        pR[i] = R; pC[i] = C; voffB[i] = (unsigned)(Rb * KB + C * 2); }
    unsigned cvo[2][2], nvo[2][2];
#define PG8_SETVO(vo, pm_) do { _Pragma("unroll") for (int _h = 0; _h < 2; ++_h) _Pragma("unroll") for (int _i = 0; _i < 2; ++_i) { const int _r = (pm_) * BM + _h * HALF + pR[_i]; \
        const int _g = g.gidx ? g.gidx[_r] : _r; vo[_h][_i] = (unsigned)_g * (unsigned)KB + (unsigned)(pC[_i] * 2); } } while (0)
#define PG8_STAGEA(bufoff, koff, vo) do { _Pragma("unroll") for (int _i = 0; _i < 2; ++_i) \
        __builtin_amdgcn_global_load_lds((const unsigned*)((const char*)g.A + (koff) + (vo)[_i]), (PG8_LAS unsigned*)(lds + (bufoff) + ldsw + _i * 8192), 16, 0, 0); } while (0)
    const size_t kstep = (size_t)(BK * 2);
    const size_t hstep = (size_t)HALF * KB;
    const size_t tstep = 2 * hstep;
    const unsigned ldsw = (unsigned)wid * 1024u;
    const int aoff = lds_byte(wr * 64 + fr, fq * 8), boff = lds_byte(wc * 32 + fr, fq * 8);
#define PG8_SA(b, h) (((b) * 2 + (h)) * HTB)
#define PG8_SB(b, h) ((4 + (b) * 2 + (h)) * HTB)
#define PG8_STAGE(bufoff, gbase, voff) do { _Pragma("unroll") for (int _i = 0; _i < 2; ++_i) \
        __builtin_amdgcn_global_load_lds((const unsigned*)((const char*)(gbase) + (voff)[_i]), (PG8_LAS unsigned*)(lds + (bufoff) + ldsw + _i * 8192), 16, 0, 0); } while (0)
    typedef int v4i_t __attribute__((ext_vector_type(4))); typedef int v8i_t __attribute__((ext_vector_type(8)));
#define PG8_CAT8(x, y) __builtin_shufflevector(__builtin_bit_cast(v4i_t, x), __builtin_bit_cast(v4i_t, y), 0, 1, 2, 3, 4, 5, 6, 7)
#define PG8_LDA(dst, b, h) do { _Pragma("unroll") for (int m = 0; m < 4; ++m) { const bf16x8 f0_ = *(const PG8_LAS bf16x8*)(lds + PG8_SA(b, h) + aoff + m * 2048), f1_ = *(const PG8_LAS bf16x8*)(lds + PG8_SA(b, h) + aoff + m * 2048 + 1024); \
        if constexpr (FP8) dst##8[m] = PG8_CAT8(f0_, f1_); else { dst[m][0] = f0_; dst[m][1] = f1_; } } } while (0)
#define PG8_LDB(dst, b, h) do { _Pragma("unroll") for (int n = 0; n < 2; ++n) { const bf16x8 f0_ = *(const PG8_LAS bf16x8*)(lds + PG8_SB(b, h) + boff + n * 2048), f1_ = *(const PG8_LAS bf16x8*)(lds + PG8_SB(b, h) + boff + n * 2048 + 1024); \
        if constexpr (FP8) dst##8[n] = PG8_CAT8(f0_, f1_); else { dst[n][0] = f0_; dst[n][1] = f1_; } } } while (0)
typedef int v4i_t __attribute__((ext_vector_type(4))); typedef int v8i_t __attribute__((ext_vector_type(8)));
#define PG8_CAT8(x, y) __builtin_shufflevector(__builtin_bit_cast(v4i_t, x), __builtin_bit_cast(v4i_t, y), 0, 1, 2, 3, 4, 5, 6, 7)
#define PG8_MMA(ai, bj, At, Bt) do { __builtin_amdgcn_s_setprio(1); _Pragma("unroll") for (int m = 0; m < 4; ++m) _Pragma("unroll") for (int n = 0; n < 2; ++n) { \
        if constexpr (FP8) asm volatile("v_mfma_scale_f32_16x16x128_f8f6f4 %0, %1, %2, %0, %3, %4 op_sel_hi:[0,0,0]" : "+v"(acc[ai][bj][m][n]) : "v"(Bt##8[n]), "v"(At##8[m]), "v"(sw_), "v"(sa_)); \
        else { _Pragma("unroll") for (int k = 0; k < 2; ++k) acc[ai][bj][m][n] = __builtin_amdgcn_mfma_f32_16x16x32_bf16(Bt[n][k], At[m][k], acc[ai][bj][m][n], 0, 0, 0); } } \
        __builtin_amdgcn_s_setprio(0); } while (0)
#define PG8_WAIT_V(n) asm volatile("s_waitcnt vmcnt(" #n ")" ::: "memory")
#define PG8_WAIT_L(n) asm volatile("s_waitcnt lgkmcnt(" #n ")" ::: "memory")
#define PG8_BAR __builtin_amdgcn_s_barrier()
#define PG8_SCHED __builtin_amdgcn_sched_barrier(0)
    Unit cur, nxt; int ui = 0;
    if (!S.next(0, cur)) return;
    f32x4 acc[2][2][4][2];
#pragma unroll
    for (int a = 0; a < 2; ++a)
#pragma unroll
        for (int b = 0; b < 2; ++b)
#pragma unroll
            for (int m = 0; m < 4; ++m)
#pragma unroll
                for (int n = 0; n < 2; ++n) acc[a][b][m][n] = (f32x4){0.f, 0.f, 0.f, 0.f};
    const int sw_ = g.sw, sa_ = g.sa;
    bf16x8 At[4][2], B0[2][2], B1[2][2]; v8i_t At8[4], B08[2], B18[2];
    PG8_SETVO(cvo, cur.pm); const char* cB = (const char*)g.Bt + (size_t)cur.pn * tstep;
    S.a_ready(cur);
    if constexpr (SP2) {
        PG8_STAGE(PG8_SB(0, 0), cB, voffB); PG8_STAGE(PG8_SB(0, 1), cB + hstep, voffB); PG8_STAGEA(PG8_SA(0, 0), 0, cvo[0]); PG8_STAGEA(PG8_SA(0, 1), 0, cvo[1]);
        if (wr == 1) PG8_BAR;
        PG8_WAIT_V(2); PG8_BAR;
        PG8_STAGE(PG8_SB(1, 0), cB + kstep, voffB); PG8_STAGEA(PG8_SA(1, 0), kstep, cvo[0]); PG8_STAGE(PG8_SB(1, 1), cB + hstep + kstep, voffB);
        PG8_WAIT_V(6); PG8_BAR;
    } else {
        PG8_STAGE(PG8_SB(0, 0), cB, voffB); PG8_STAGEA(PG8_SA(0, 0), 0, cvo[0]); PG8_STAGE(PG8_SB(0, 1), cB + hstep, voffB); PG8_STAGEA(PG8_SA(0, 1), 0, cvo[1]);
        if (wr == 1) PG8_BAR;
        PG8_WAIT_V(4); PG8_BAR;
        PG8_STAGE(PG8_SB(1, 0), cB + kstep, voffB); PG8_STAGEA(PG8_SA(1, 0), kstep, cvo[0]); PG8_STAGE(PG8_SB(1, 1), cB + hstep + kstep, voffB);
        PG8_WAIT_V(6); PG8_BAR;
    }
    for (;;) {
        const bool has_next = S.next(ui + 1, nxt);
        if (has_next) PG8_SETVO(nvo, nxt.pm); else { nvo[0][0] = cvo[0][0]; nvo[0][1] = cvo[0][1]; nvo[1][0] = cvo[1][0]; nvo[1][1] = cvo[1][1]; }
        const char* nB = has_next ? (const char*)g.Bt + (size_t)nxt.pn * tstep : cB;
#pragma unroll 1
        for (int t = 0; t < nt; t += 2) {
            const bool last = (t == nt - 2);
            const size_t k1 = (size_t)(t + 1) * kstep;
            const size_t k2 = last ? 0 : (size_t)(t + 2) * kstep; unsigned v2[2][2];
            v2[0][0] = last ? nvo[0][0] : cvo[0][0]; v2[0][1] = last ? nvo[0][1] : cvo[0][1]; v2[1][0] = last ? nvo[1][0] : cvo[1][0]; v2[1][1] = last ? nvo[1][1] : cvo[1][1];
            const char* b2 = last ? nB : cB + (size_t)(t + 2) * kstep;
            const size_t k3 = k2 + kstep; const char* b3 = b2 + kstep;
            if (last && has_next) S.a_ready(nxt);
            if constexpr (SP2) {
            PG8_LDB(B0, 0, 0); PG8_LDB(B1, 0, 1); PG8_SCHED; PG8_LDA(At, 0, 0); PG8_STAGEA(PG8_SA(1, 1), k1, cvo[1]);
            PG8_WAIT_V(8); PG8_WAIT_L(0); PG8_BAR; PG8_MMA(0, 0, At, B0); PG8_MMA(0, 1, At, B1); PG8_BAR; PG8_SCHED;
            PG8_LDA(At, 0, 1); PG8_STAGE(PG8_SB(0, 0), b2, voffB); PG8_STAGE(PG8_SB(0, 1), b2 + hstep, voffB); PG8_STAGEA(PG8_SA(0, 0), k2, v2[0]);
            PG8_WAIT_V(8); PG8_WAIT_L(0); PG8_BAR; PG8_MMA(1, 0, At, B0); PG8_MMA(1, 1, At, B1); PG8_BAR; PG8_SCHED;
            PG8_LDB(B0, 1, 0); PG8_LDB(B1, 1, 1); PG8_SCHED; PG8_LDA(At, 1, 0); PG8_STAGEA(PG8_SA(0, 1), k2, v2[1]);
            PG8_WAIT_V(8); PG8_WAIT_L(0); PG8_BAR; PG8_MMA(0, 0, At, B0); PG8_MMA(0, 1, At, B1); PG8_BAR; PG8_SCHED;
            PG8_LDA(At, 1, 1); PG8_STAGE(PG8_SB(1, 0), b3, voffB); PG8_STAGE(PG8_SB(1, 1), b3 + hstep, voffB); PG8_STAGEA(PG8_SA(1, 0), k3, v2[0]);
            PG8_WAIT_V(8); PG8_WAIT_L(0); PG8_BAR; PG8_MMA(1, 0, At, B0); PG8_MMA(1, 1, At, B1); PG8_BAR; PG8_SCHED;
            } else {
            PG8_LDB(B0, 0, 0); PG8_SCHED; PG8_LDA(At, 0, 0); PG8_STAGEA(PG8_SA(1, 1), k1, cvo[1]);
            PG8_WAIT_L(8); PG8_BAR; PG8_WAIT_L(0); PG8_MMA(0, 0, At, B0); PG8_BAR; PG8_SCHED;
            PG8_LDB(B1, 0, 1); PG8_STAGE(PG8_SB(0, 0), b2, voffB);
            PG8_BAR; PG8_WAIT_L(0); PG8_MMA(0, 1, At, B1); PG8_BAR;
            PG8_LDA(At, 0, 1); PG8_STAGEA(PG8_SA(0, 0), k2, v2[0]);
            PG8_BAR; PG8_WAIT_L(0); PG8_MMA(1, 0, At, B0); PG8_BAR; PG8_SCHED;
            PG8_STAGE(PG8_SB(0, 1), b2 + hstep, voffB);
            PG8_WAIT_V(6); PG8_BAR; PG8_MMA(1, 1, At, B1); PG8_BAR;
            PG8_LDB(B0, 1, 0); PG8_SCHED; PG8_LDA(At, 1, 0); PG8_STAGEA(PG8_SA(0, 1), k2, v2[1]);
            PG8_WAIT_L(8); PG8_BAR; PG8_WAIT_L(0); PG8_MMA(0, 0, At, B0); PG8_BAR; PG8_SCHED;
            PG8_LDB(B1, 1, 1); PG8_STAGE(PG8_SB(1, 0), b3, voffB);
            PG8_BAR; PG8_WAIT_L(0); PG8_MMA(0, 1, At, B1); PG8_BAR;
            PG8_LDA(At, 1, 1); PG8_STAGEA(PG8_SA(1, 0), k3, v2[0]);
            PG8_BAR; PG8_WAIT_L(0); PG8_MMA(1, 0, At, B0); PG8_BAR; PG8_SCHED;
            PG8_STAGE(PG8_SB(1, 1), b3 + hstep, voffB);
            PG8_WAIT_V(6); PG8_BAR; PG8_MMA(1, 1, At, B1); PG8_BAR;
            }
        }
        if constexpr (ALIGN_EPI) { if (wr == 0) PG8_BAR; }
        if constexpr (FP8) asm volatile("s_nop 15\n\ts_nop 15" ::: "memory");
        if constexpr (!Epi::AFTER_DRAIN) { E(acc, cur, wr, wc, fr, fq); S.done(cur); }
        if (!has_next) break;
#pragma unroll
        for (int a = 0; a < 2; ++a)
#pragma unroll
            for (int b = 0; b < 2; ++b)
#pragma unroll
                for (int m = 0; m < 4; ++m)
#pragma unroll
                    for (int n = 0; n < 2; ++n) acc[a][b][m][n] = (f32x4){0.f, 0.f, 0.f, 0.f};
        cur = nxt; cvo[0][0] = nvo[0][0]; cvo[0][1] = nvo[0][1]; cvo[1][0] = nvo[1][0]; cvo[1][1] = nvo[1][1]; cB = nB; ++ui;
        if constexpr (ALIGN_EPI) { if (wr == 1) PG8_BAR; }
    }
    PG8_WAIT_V(0);
    if constexpr (!ALIGN_EPI) { if (wr == 0) PG8_BAR; }
    PG8_BAR;
    if constexpr (Epi::AFTER_DRAIN) { E.fused(acc, cur, wr, wc, fr, fq, lds, wid, lane); S.done(cur); }
#undef PG8_SA
#undef PG8_SB
#undef PG8_STAGE
#undef PG8_STAGEA
#undef PG8_SETVO
#undef PG8_LDA
#undef PG8_LDB
#undef PG8_MMA
#undef PG8_CAT8
#undef PG8_WAIT_V
#undef PG8_WAIT_L
#undef PG8_BAR
#undef PG8_SCHED
}
}
#ifndef FP8_SP2
#define FP8_SP2 true
#endif
#ifndef ATTNA_FP8
#define ATTNA_FP8 1
#endif
namespace fg {
using pg8::f32x4; using pg8::Unit;
typedef unsigned u32x4 __attribute__((ext_vector_type(4)));
typedef unsigned u32x2 __attribute__((ext_vector_type(2)));
DEVI unsigned cvtpk(float lo, float hi) { typedef float f2_t __attribute__((ext_vector_type(2))); typedef __bf16 b2_t __attribute__((ext_vector_type(2))); const f2_t v = {lo, hi}; const b2_t b = __builtin_convertvector(v, b2_t); return __builtin_bit_cast(unsigned, b); }
template <class TP> DEVI void rope8(TP ROPE, int t, int d0, f32x4& v0, f32x4& v1) {
  const int i0 = d0 >> 1, f0 = i0 & 15, pos = (i0 < 16) ? (t >> 6) : (t & 63);
  const f32x4 r0 = *(const PG8_LAS f32x4*)(ROPE + (pos * 16 + f0) * 2), r1 = *(const PG8_LAS f32x4*)(ROPE + (pos * 16 + f0) * 2 + 4);
  const f32x4 a = v0, b = v1;
  v0[0] = a[0] * r0[0] - a[1] * r0[1]; v0[1] = a[0] * r0[1] + a[1] * r0[0]; v0[2] = a[2] * r0[2] - a[3] * r0[3]; v0[3] = a[2] * r0[3] + a[3] * r0[2];
  v1[0] = b[0] * r1[0] - b[1] * r1[1]; v1[1] = b[0] * r1[1] + b[1] * r1[0]; v1[2] = b[2] * r1[2] - b[3] * r1[3]; v1[3] = b[2] * r1[3] + b[3] * r1[2];
}
#define EPI_LOOP_BEGIN const int row0 = u.pm * 256 + wr * 64 + fr; \
  _Pragma("unroll") for (int ai = 0; ai < 2; ++ai) _Pragma("unroll") for (int m = 0; m < 4; ++m) { const int row = row0 + ai * 128 + m * 16; \
  _Pragma("unroll") for (int bj = 0; bj < 2; ++bj) { f32x4 v0 = acc[ai][bj][m][0], v1 = acc[ai][bj][m][1]; const int cl = bj * 128 + wc * 32 + 8 * fq;
#define EPI_LOOP_END } }

struct EpiQKV0 { static constexpr bool PERM = true, AFTER_DRAIN = false; bf16_t* O; const PG8_LAS float* ROPE; unsigned char* VT; unsigned char* VTB;
  DEVI void operator()(const f32x4 (&acc)[2][2][4][2], const Unit& u, int wr, int wc, int fr, int fq) const {
    const int colt = u.pn * 256; const bool rope = (u.pm < NLAT / 256) && (colt < 1024);
    EPI_LOOP_BEGIN
      const int col = colt + cl;
      if (ATTNA_FP8 && colt >= 1024 && colt < 1536) {
        const int hh = (col - 1024) >> 7, dv0 = (col - 1024) & 127;
        int bb, t; if (row < NLAT) { bb = row >> 12; t = row & 4095; } else { bb = (row - NLAT) >> 8; t = 4096 + ((row - NLAT) & 255); }
        const int k = t & 31, gq = k >> 3, wq = k & 7, pos = (wq < 4) ? gq * 4 + wq : 16 + gq * 4 + (wq - 4);
        unsigned char* vp = VT + (size_t)((bb * 4 + hh) * 128 + dv0) * 4352 + (t & ~31) + pos;
        const unsigned w0 = nv::pack4_fp8(v0[0] * 4.f, v0[1] * 4.f, v0[2] * 4.f, v0[3] * 4.f), w1 = nv::pack4_fp8(v1[0] * 4.f, v1[1] * 4.f, v1[2] * 4.f, v1[3] * 4.f);
        vp[0 * 4352] = (unsigned char)w0; vp[1 * 4352] = (unsigned char)(w0 >> 8); vp[2 * 4352] = (unsigned char)(w0 >> 16); vp[3 * 4352] = (unsigned char)(w0 >> 24);
        vp[4 * 4352] = (unsigned char)w1; vp[5 * 4352] = (unsigned char)(w1 >> 8); vp[6 * 4352] = (unsigned char)(w1 >> 16); vp[7 * 4352] = (unsigned char)(w1 >> 24);
        continue;
      }
      if (ATTNA_FP8 && colt >= 2560) {
        const int hh = (col - 2560) >> 6, dv0 = (col - 2560) & 63;
        int bb, t; if (row < NLAT) { bb = row >> 12; t = row & 4095; } else { bb = (row - NLAT) >> 8; t = 4096 + ((row - NLAT) & 255); }
        const int k = t & 31, gq = k >> 3, wq = k & 7, pos = (wq < 4) ? gq * 4 + wq : 16 + gq * 4 + (wq - 4);
        unsigned char* vp = VTB + (size_t)((bb * 8 + hh) * 64 + dv0) * 4352 + (t & ~31) + pos;
        const unsigned w0 = nv::pack4_fp8(v0[0] * 4.f, v0[1] * 4.f, v0[2] * 4.f, v0[3] * 4.f), w1 = nv::pack4_fp8(v1[0] * 4.f, v1[1] * 4.f, v1[2] * 4.f, v1[3] * 4.f);
        vp[0 * 4352] = (unsigned char)w0; vp[1 * 4352] = (unsigned char)(w0 >> 8); vp[2 * 4352] = (unsigned char)(w0 >> 16); vp[3 * 4352] = (unsigned char)(w0 >> 24);
        vp[4 * 4352] = (unsigned char)w1; vp[5 * 4352] = (unsigned char)(w1 >> 8); vp[6 * 4352] = (unsigned char)(w1 >> 16); vp[7 * 4352] = (unsigned char)(w1 >> 24);
        continue;
      }
      if (rope) rope8(ROPE, row & 4095, col & 63, v0, v1);
      if (ATTNA_FP8 && (colt < 1024 || colt >= 1536)) {
        const float sc = (colt < 512 || (colt >= 1536 && colt < 2048)) ? 16.f * 0.125f * 1.4426950408889634f : 4.f;
        u32x2 w8; w8.x = nv::pack4_fp8(v0[0] * sc, v0[1] * sc, v0[2] * sc, v0[3] * sc); w8.y = nv::pack4_fp8(v1[0] * sc, v1[1] * sc, v1[2] * sc, v1[3] * sc);
        *(u32x2*)((unsigned char*)O + (size_t)row * (N_IN0 * 2) + col) = w8;
        continue;
      }
      u32x4 w; w.x = cvtpk(v0[0], v0[1]); w.y = cvtpk(v0[2], v0[3]); w.z = cvtpk(v1[0], v1[1]); w.w = cvtpk(v1[2], v1[3]);
      *(u32x4*)(O + (size_t)row * N_IN0 + col) = w;
    EPI_LOOP_END
  } };
struct EpiQKV1 { static constexpr bool PERM = true, AFTER_DRAIN = false; bf16_t* O; float* DT; const PG8_LAS float* ROPE;
  DEVI void operator()(const f32x4 (&acc)[2][2][4][2], const Unit& u, int wr, int wc, int fr, int fq) const {
    const int colt = u.pn * 256; const bool lat = (u.pm < NLAT / 256);
    EPI_LOOP_BEGIN
      const int col = colt + cl;
      if (col >= 2304) { if (col < 2320) { *(f32x4*)(DT + (size_t)row * 16 + (col - 2304)) = v0; *(f32x4*)(DT + (size_t)row * 16 + (col - 2304) + 4) = v1; } }
      else {
        if (lat && col < 640) rope8(ROPE, row & 4095, col & 63, v0, v1);
        u32x4 w; w.x = cvtpk(v0[0], v0[1]); w.y = cvtpk(v0[2], v0[3]); w.z = cvtpk(v1[0], v1[1]); w.w = cvtpk(v1[2], v1[3]);
        *(u32x4*)(O + (size_t)row * 2304 + col) = w;
      }
    EPI_LOOP_END
  } };
struct EpiPlain { static constexpr bool PERM = true, AFTER_DRAIN = false; bf16_t* O;
  DEVI void operator()(const f32x4 (&acc)[2][2][4][2], const Unit& u, int wr, int wc, int fr, int fq) const {
    const int colt = u.pn * 256;
    EPI_LOOP_BEGIN
      u32x4 w; w.x = cvtpk(v0[0], v0[1]); w.y = cvtpk(v0[2], v0[3]); w.z = cvtpk(v1[0], v1[1]); w.w = cvtpk(v1[2], v1[3]);
      *(u32x4*)(O + (size_t)row * DM + colt + cl) = w;
    EPI_LOOP_END
  } };
DEVI float silu_fast(float v) { return v * __builtin_amdgcn_rcpf(1.f + __expf(-v)); }
struct EpiSwiGLU { static constexpr bool PERM = true, AFTER_DRAIN = false; bf16_t* O;
  DEVI void operator()(const f32x4 (&acc)[2][2][4][2], const Unit& u, int wr, int wc, int fr, int fq) const {
    const int colt = (u.pn & 7) * 256;
    EPI_LOOP_BEGIN
      u32x2 w; w.x = cvtpk(silu_fast(v0[0]) * v0[1], silu_fast(v0[2]) * v0[3]); w.y = cvtpk(silu_fast(v1[0]) * v1[1], silu_fast(v1[2]) * v1[3]);
      *(u32x2*)(O + (size_t)row * DM + ((colt + cl) >> 1)) = w;
    EPI_LOOP_END
  } };
struct EpiSwiGLU8 { static constexpr bool PERM = true, AFTER_DRAIN = false; unsigned char* O;
  DEVI void operator()(const f32x4 (&acc)[2][2][4][2], const Unit& u, int wr, int wc, int fr, int fq) const {
    const int colt = (u.pn & 7) * 256;
    EPI_LOOP_BEGIN
      const unsigned w = nv::pack4_fp8(silu_fast(v0[0]) * v0[1] * nv::A8_SCALE, silu_fast(v0[2]) * v0[3] * nv::A8_SCALE, silu_fast(v1[0]) * v1[1] * nv::A8_SCALE, silu_fast(v1[2]) * v1[3] * nv::A8_SCALE);
      *(unsigned*)(O + (size_t)row * DM + ((colt + cl) >> 1)) = w;
    EPI_LOOP_END
  } };
struct EpiDown { static constexpr bool PERM = true, AFTER_DRAIN = false; bf16_t* O;
  DEVI void operator()(const f32x4 (&acc)[2][2][4][2], const Unit& u, int wr, int wc, int fr, int fq) const {
    const int colt = (u.pn & 3) * 256;
    EPI_LOOP_BEGIN
      u32x4 w; w.x = cvtpk(v0[0], v0[1]); w.y = cvtpk(v0[2], v0[3]); w.z = cvtpk(v1[0], v1[1]); w.w = cvtpk(v1[2], v1[3]);
      *(u32x4*)(O + (size_t)row * DM + colt + cl) = w;
    EPI_LOOP_END
  } };
struct ExpOrder : pg8::StaticOrder { int nMe, nNe;
  __device__ void init2(int erows, int Ne, int G_, int c_) { nMe = erows / 256; nNe = Ne / 256; init(NE * erows, Ne, G_, c_); }
  __device__ bool next(int i, Unit& u) const { if (!pg8::StaticOrder::next(i, u)) return false; u.pn += (u.pm / nMe) * nNe; return true; } };

typedef PG8_LAS unsigned char* ldsp_t;
DEVI void phase_qkv0(const Params& p, ldsp_t lds) {
  pg8::Gemm g{(const bf16_t*)(p.ws + WS_H), (const bf16_t*)(p.ws + WS_WIN0), NROW, N_IN0, DM, nullptr, nv::W8_E8M0, nv::A8_E8M0}; pg8::StaticOrder S; S.init(NROW, N_IN0, gridDim.x, blockIdx.x);
  PG8_LAS float* RL = (PG8_LAS float*)(lds + pg8::STAGE_BYTES);
  for (int i = ftid(); i < 64 * 16 * 2; i += NT) RL[i] = ((const float*)(p.ws + WS_CTL + CTL_ROPE))[i];
  __syncthreads();
  EpiQKV0 E{(bf16_t*)(p.ws + WS_QKV0), RL, (unsigned char*)(p.ws + WS_VT), (unsigned char*)(p.ws + WS_VTB)};
  pg8::gemm_phase<EpiQKV0, pg8::StaticOrder, true, true, (QKV0_FP8 != 0)>(lds, g, S, E);
}
DEVI void phase_qkv1(const Params& p, ldsp_t lds) {
  pg8::Gemm g{(const bf16_t*)(p.ws + WS_H), (const bf16_t*)(p.ws + WS_WIN1), NROW, N_IN1P, DM, nullptr, nv::W8_E8M0, nv::A8_E8M0}; pg8::StaticOrder S; S.init(NROW, N_IN1P, gridDim.x, blockIdx.x);
  PG8_LAS float* RL = (PG8_LAS float*)(lds + pg8::STAGE_BYTES);
  for (int i = ftid(); i < 64 * 16 * 2; i += NT) RL[i] = ((const float*)(p.ws + WS_CTL + CTL_ROPE))[i];
  __syncthreads();
  EpiQKV1 E{(bf16_t*)(p.ws + WS_P1), (float*)(p.ws + WS_DT), RL};
  pg8::gemm_phase<EpiQKV1, pg8::StaticOrder, true, true, (QKV1_FP8 != 0)>(lds, g, S, E);
}
DEVI void phase_outproj(const Params& p, ldsp_t lds, int layer) {
  const int M = layer ? NLAT : NROW;
  pg8::Gemm g{(const bf16_t*)(p.ws + (layer ? WS_ATT1 : WS_ATT0)), (const bf16_t*)(p.ws + (layer ? WS_WOUT1 : WS_WOUT0)), M, DM, DM, nullptr, nv::W8_E8M0, nv::A8_E8M0}; pg8::StaticOrder S; S.init(M, DM, gridDim.x, blockIdx.x);
  EpiPlain E{(bf16_t*)(p.ws + (layer ? WS_MIX1 : WS_MIX0))};
  pg8::gemm_phase<EpiPlain, pg8::StaticOrder, true, true, (OUT_FP8 != 0)>(lds, g, S, E);
}
DEVI void phase_moe_up(const Params& p, ldsp_t lds, int layer) {
  const int erows = layer ? EROWS1 : EROWS0;
  pg8::Gemm g{(const bf16_t*)(p.ws + WS_H), (const bf16_t*)(p.ws + WS_WGU), NE * erows, 2048, DM, (const int*)(p.ws + WS_IDX)}; ExpOrder S; S.init2(erows, 2048, gridDim.x, blockIdx.x);
  EpiSwiGLU E{(bf16_t*)(p.ws + WS_HID)};
  pg8::gemm_phase<EpiSwiGLU, ExpOrder, true, true>(lds, g, S, E);
}
DEVI void phase_moe_down(const Params& p, ldsp_t lds, int layer) {
  const int erows = layer ? EROWS1 : EROWS0;
  pg8::Gemm g{(const bf16_t*)(p.ws + WS_HID), (const bf16_t*)(p.ws + WS_WD), NE * erows, DM, DM}; ExpOrder S; S.init2(erows, DM, gridDim.x, blockIdx.x);
  EpiDown E{(bf16_t*)(p.ws + WS_Y)};
  pg8::gemm_phase<EpiDown, ExpOrder, true, true>(lds, g, S, E);
}
DEVI void phase_moe_up8(const Params& p, ldsp_t lds, int layer) {
  const int erows = layer ? EROWS1 : EROWS0;
  pg8::Gemm g{(const bf16_t*)(p.ws + WS_H), (const bf16_t*)(p.ws + WS_WGU), NE * erows, 2048, DM, (const int*)(p.ws + WS_IDX), nv::W8_E8M0, nv::A8_E8M0}; ExpOrder S; S.init2(erows, 2048, gridDim.x, blockIdx.x);
  EpiSwiGLU8 E{(unsigned char*)(p.ws + WS_HID)};
  pg8::gemm_phase<EpiSwiGLU8, ExpOrder, true, FP8_SP2, true>(lds, g, S, E);
}
DEVI void phase_moe_down8(const Params& p, ldsp_t lds, int layer) {
  const int erows = layer ? EROWS1 : EROWS0;
  pg8::Gemm g{(const bf16_t*)(p.ws + WS_HID), (const bf16_t*)(p.ws + WS_WD), NE * erows, DM, DM, nullptr, nv::W8_E8M0, nv::A8_E8M0}; ExpOrder S; S.init2(erows, DM, gridDim.x, blockIdx.x);
  EpiDown E{(bf16_t*)(p.ws + WS_Y)};
  pg8::gemm_phase<EpiDown, ExpOrder, true, FP8_SP2, true>(lds, g, S, E);
}
DEVI void phase_gather(const Params& p, int layer) {
  const int lane = ftid() & 63, gw = blockIdx.x * NWAVE + (ftid() >> 6), NGW = gridDim.x * NWAVE;
  const int erows = layer ? EROWS1 : EROWS0; const int* IDX = (const int*)(p.ws + WS_IDX);
  const bf16_t* H = (const bf16_t*)(p.ws + WS_H); bf16_t* XG = (bf16_t*)(p.ws + WS_XG);
  for (int r = gw; r < NE * erows; r += NGW) {
    const uint4* s = (const uint4*)(H + (size_t)IDX[r] * DM) + lane; uint4* d = (uint4*)(XG + (size_t)r * DM) + lane;
    const uint4 a = s[0], b = s[64]; d[0] = a; d[64] = b;
  }
}
}
#ifndef ATTNA_FP8
#define ATTNA_FP8 1
#endif
namespace fa {
#define FA_LAS __attribute__((address_space(3)))
typedef short bf16x8 __attribute__((ext_vector_type(8)));
typedef short s16x4 __attribute__((ext_vector_type(4)));
typedef float f32x16 __attribute__((ext_vector_type(16)));
typedef FA_LAS unsigned char* ldsp_t;
typedef unsigned u32x4 __attribute__((ext_vector_type(4)));
constexpr float LOG2E = 1.4426950408889634f, C2 = 0.125f * LOG2E;
DEVI int crow(int r, int hi) { return (r & 3) + 8 * (r >> 2) + 4 * hi; }
DEVI unsigned cvtpk(float lo, float hi) { typedef float f2_t __attribute__((ext_vector_type(2))); typedef __bf16 b2_t __attribute__((ext_vector_type(2))); const f2_t v = {lo, hi}; const b2_t b = __builtin_convertvector(v, b2_t); return __builtin_bit_cast(unsigned, b); }
DEVI s16x4 vtr(ldsp_t p) { return __builtin_bit_cast(s16x4, __builtin_amdgcn_ds_read_tr16_b64_v4i16((FA_LAS s16x4*)p)); }

DEVI float max3f(float a, float b, float c) { float r; asm("v_max3_f32 %0, %1, %2, %3" : "=v"(r) : "v"(a), "v"(b), "v"(c)); return r; }
template <int KW, int DVB> struct Geo {
  static constexpr int VW = DVB * 32;
  static constexpr int KSTR = KW * 2 + 16, VSTR = VW * 2 + 64;
  static constexpr int KBYTES = 64 * KSTR, VBYTES = 64 * VSTR, STAGE = KBYTES + VBYTES;
  static constexpr int CPR = (KW + VW) / 8, NCH = 64 * CPR / NT;
};

DEVI bf16x8 load_q8(const bf16_t* p, float sc) {
  const uint4 w = *(const uint4*)p; const unsigned u[4] = {w.x, w.y, w.z, w.w}; unsigned o[4];
#pragma unroll
  for (int i = 0; i < 4; ++i) o[i] = cvtpk(__uint_as_float(u[i] << 16) * sc, __uint_as_float(u[i] & 0xffff0000u) * sc);
  uint4 r = make_uint4(o[0], o[1], o[2], o[3]); return __builtin_bit_cast(bf16x8, r);
}

template <int KW, int DVB, class Src, class Act, class Msk>
DEVI void flash_pass(ldsp_t lds, int ntiles, const bf16_t* kv, int ld, int kcol, int vcol, const bf16x8 (&q)[4], int kofs,
                     Src src, Act act, Msk msk, f32x16 (&o)[DVB], float& m, float& l) {
  typedef Geo<KW, DVB> G;
  const int tid = ftid(), lane = tid & 63, r32 = lane & 31, hi = lane >> 5;
  u32x4 stg[G::NCH];
  int crw[G::NCH], ccol[G::NCH], cdst[G::NCH];
#pragma unroll
  for (int i = 0; i < G::NCH; ++i) { const int c = tid + NT * i, row = c / G::CPR, cc = c % G::CPR; crw[i] = row;
    if (cc < KW / 8) { ccol[i] = kcol + cc * 8; cdst[i] = row * G::KSTR + cc * 16; } else { ccol[i] = vcol + (cc - KW / 8) * 8; cdst[i] = G::KBYTES + row * G::VSTR + (cc - KW / 8) * 16; } }
#pragma unroll
  for (int i = 0; i < G::NCH; ++i) stg[i] = *(const u32x4*)(kv + (size_t)src(0, crw[i]) * ld + ccol[i]);
#pragma unroll
  for (int i = 0; i < G::NCH; ++i) *(FA_LAS u32x4*)(lds + cdst[i]) = stg[i];
  __syncthreads();
  const int kroff = r32 * G::KSTR + (kofs + 8 * hi) * 2;
  const int vroff = G::KBYTES + (4 * hi + ((lane & 15) >> 2)) * G::VSTR + 32 * ((lane >> 4) & 1) + 8 * (lane & 3);
  for (int kt = 0; kt < ntiles; ++kt) {
    const int buf = (kt & 1) * G::STAGE;
    const bool more = kt + 1 < ntiles;
    if (more) {
#pragma unroll
      for (int i = 0; i < G::NCH; ++i) stg[i] = *(const u32x4*)(kv + (size_t)src(kt + 1, crw[i]) * ld + ccol[i]);
    }
    if (act(kt)) {
      const ldsp_t kb = lds + buf + kroff;
      f32x16 p0, p1;
#pragma unroll
      for (int r = 0; r < 16; ++r) { p0[r] = 0.f; p1[r] = 0.f; }
#pragma unroll
      for (int d0 = 0; d0 < 4; ++d0) {
        const bf16x8 a0 = *(const FA_LAS bf16x8*)(kb + d0 * 32), a1 = *(const FA_LAS bf16x8*)(kb + 32 * G::KSTR + d0 * 32);
        p0 = __builtin_amdgcn_mfma_f32_32x32x16_bf16(a0, q[d0], p0, 0, 0, 0);
        p1 = __builtin_amdgcn_mfma_f32_32x32x16_bf16(a1, q[d0], p1, 0, 0, 0);
      }
      msk(kt, p0, p1);
      float mx = fmaxf(p0[0], p1[0]);
#pragma unroll
      for (int r = 1; r < 16; ++r) mx = fmaxf(mx, fmaxf(p0[r], p1[r]));
      mx = fmaxf(mx, __shfl_xor(mx, 32));
      if (__any(mx > m)) {
        const float mn = fmaxf(m, mx), alpha = __builtin_amdgcn_exp2f(m - mn);
        l *= alpha; m = mn;
#pragma unroll
        for (int b = 0; b < DVB; ++b)
#pragma unroll
          for (int r = 0; r < 16; ++r) o[b][r] *= alpha;
      }
      float ls = 0.f;
#pragma unroll
      for (int r = 0; r < 16; ++r) { p0[r] = __builtin_amdgcn_exp2f(p0[r] - m); p1[r] = __builtin_amdgcn_exp2f(p1[r] - m); ls += p0[r] + p1[r]; }
      l += ls;
      bf16x8 pa[4];
      { uint4 t;
        t = make_uint4(cvtpk(p0[0], p0[1]), cvtpk(p0[2], p0[3]), cvtpk(p0[4], p0[5]), cvtpk(p0[6], p0[7])); pa[0] = __builtin_bit_cast(bf16x8, t);
        t = make_uint4(cvtpk(p0[8], p0[9]), cvtpk(p0[10], p0[11]), cvtpk(p0[12], p0[13]), cvtpk(p0[14], p0[15])); pa[1] = __builtin_bit_cast(bf16x8, t);
        t = make_uint4(cvtpk(p1[0], p1[1]), cvtpk(p1[2], p1[3]), cvtpk(p1[4], p1[5]), cvtpk(p1[6], p1[7])); pa[2] = __builtin_bit_cast(bf16x8, t);
        t = make_uint4(cvtpk(p1[8], p1[9]), cvtpk(p1[10], p1[11]), cvtpk(p1[12], p1[13]), cvtpk(p1[14], p1[15])); pa[3] = __builtin_bit_cast(bf16x8, t); }
      const ldsp_t vb = lds + buf + vroff;
#pragma unroll
      for (int b = 0; b < DVB; ++b)
#pragma unroll
        for (int ks = 0; ks < 4; ++ks) {
          const s16x4 lo = vtr(vb + (16 * ks) * G::VSTR + b * 64), h8 = vtr(vb + (16 * ks + 8) * G::VSTR + b * 64);
          const bf16x8 vf = {lo[0], lo[1], lo[2], lo[3], h8[0], h8[1], h8[2], h8[3]};
          o[b] = __builtin_amdgcn_mfma_f32_32x32x16_bf16(vf, pa[ks], o[b], 0, 0, 0);
        }
    }
    if (more) {
      const int nb = ((kt + 1) & 1) * G::STAGE;
#pragma unroll
      for (int i = 0; i < G::NCH; ++i) *(FA_LAS u32x4*)(lds + nb + cdst[i]) = stg[i];
    }
    __syncthreads();
  }
}


template <int V> struct IC { static constexpr int value = V; };
template <int KW, int DVB, int ABL, int PF, class Src, class Msk>
DEVI void flash_pass2(ldsp_t lds, int ntiles, const bf16_t* kv, int ld, int kcol, int vcol, const bf16x8 (&q)[4], int kofs,
                      Src src, Msk msk, f32x16 (&o)[DVB], float& m, float& l) {
  typedef Geo<KW, DVB> G;
  const int tid = ftid(), lane = tid & 63, r32 = lane & 31, hi = lane >> 5;
  u32x4 stg[PF][G::NCH];
  int crw[G::NCH], ccol[G::NCH], cdst[G::NCH];
#pragma unroll
  for (int i = 0; i < G::NCH; ++i) { const int c = tid + NT * i, row = c / G::CPR, cc = c % G::CPR; crw[i] = row;
    if (cc < KW / 8) { ccol[i] = kcol + cc * 8; cdst[i] = row * G::KSTR + cc * 16; } else { ccol[i] = vcol + (cc - KW / 8) * 8; cdst[i] = G::KBYTES + row * G::VSTR + (cc - KW / 8) * 16; } }
#define FP2_LOAD(kt, set) _Pragma("unroll") for (int i = 0; i < G::NCH; ++i) stg[set][i] = *(const u32x4*)(kv + (size_t)src((kt), crw[i]) * ld + ccol[i])
#define FP2_STORE(st, set) _Pragma("unroll") for (int i = 0; i < G::NCH; ++i) *(FA_LAS u32x4*)(lds + (st) * G::STAGE + cdst[i]) = stg[set][i]
  FP2_LOAD(0, 0); FP2_STORE(0, 0);
  if (ntiles > 1) { FP2_LOAD(1, 0); FP2_STORE(1, 0); }
  __syncthreads();
  if (ntiles > 2) FP2_LOAD(2, 0);
  if (PF == 2) { if (ntiles > 3) FP2_LOAD(3, PF - 1); }
  const int kroff = r32 * G::KSTR + (kofs + 8 * hi) * 2;
  const int vroff = G::KBYTES + (4 * hi + ((lane & 15) >> 2)) * G::VSTR + 32 * ((lane >> 4) & 1) + 8 * (lane & 3);
  f32x16 c0, c1;
#pragma unroll
  for (int r = 0; r < 16; ++r) { c0[r] = 0.f; c1[r] = 0.f; }
  { const ldsp_t kb = lds + kroff;
#pragma unroll
    for (int d0 = 0; d0 < 4; ++d0) {
      const bf16x8 a0 = *(const FA_LAS bf16x8*)(kb + d0 * 32), a1 = *(const FA_LAS bf16x8*)(kb + 32 * G::KSTR + d0 * 32);
      c0 = __builtin_amdgcn_mfma_f32_32x32x16_bf16(a0, q[d0], c0, 0, 0, 0); c1 = __builtin_amdgcn_mfma_f32_32x32x16_bf16(a1, q[d0], c1, 0, 0, 0); } }
  asm volatile("s_nop 15\n\ts_nop 7" : "+v"(c0), "+v"(c1));
  int st_cur = 0, st_nxt = 1, st_fill = 2;
  auto body = [&](int kt, auto PARC) {
    constexpr int set = (PF == 2) ? decltype(PARC)::value : 0;
    msk(kt, c0, c1);
    __builtin_amdgcn_sched_barrier(0);
    f32x16 n0, n1;
#pragma unroll
    for (int r = 0; r < 16; ++r) { n0[r] = 0.f; n1[r] = 0.f; }
    const ldsp_t kb = lds + st_nxt * G::STAGE + kroff;
    bf16x8 ka[4], kb2[4];
#pragma unroll
    for (int d0 = 0; d0 < 4; ++d0) { ka[d0] = *(const FA_LAS bf16x8*)(kb + d0 * 32); kb2[d0] = *(const FA_LAS bf16x8*)(kb + 32 * G::KSTR + d0 * 32); }
#define FP2_SB() __builtin_amdgcn_sched_barrier(0)
#define FP2_MMA(acc, kf, d0) acc = __builtin_amdgcn_mfma_f32_32x32x16_bf16(kf[d0], q[d0], acc, 0, 0, 0)
#define FP2_EXP(cx, r) { if (ABL != 1) { cx[r] = __builtin_amdgcn_exp2f(cx[r] - mn); ls += cx[r]; } }
    FP2_SB(); FP2_MMA(n0, ka, 0);
    float mxa = max3f(c0[0], c0[1], c1[0]), mxb = max3f(c0[2], c0[3], c1[1]);
    mxa = max3f(mxa, c1[2], c1[3]);
    mxa = max3f(mxa, c0[4], c0[5]); mxb = max3f(mxb, c0[6], c0[7]); mxa = max3f(mxa, c1[4], c1[5]); mxb = max3f(mxb, c1[6], c1[7]);
    FP2_SB(); FP2_MMA(n1, kb2, 0);
    mxa = max3f(mxa, c0[8], c0[9]); mxb = max3f(mxb, c0[10], c0[11]); mxa = max3f(mxa, c1[8], c1[9]); mxb = max3f(mxb, c1[10], c1[11]);
    mxa = max3f(mxa, c0[12], c0[13]); mxb = max3f(mxb, c0[14], c0[15]); mxa = max3f(mxa, c1[12], c1[13]); mxb = max3f(mxb, c1[14], c1[15]);
    float mx = max3f(mxa, mxb, m);
    mx = max3f(mx, __shfl_xor(mx, 32), mx);
    const float mn = mx, alpha = __builtin_amdgcn_exp2f(m - mn);
    const bool resc = __any(mn > m);
    m = mn;
    float ls = 0.f;
    FP2_SB(); FP2_MMA(n0, ka, 1);
    FP2_EXP(c0, 0) FP2_EXP(c0, 1) FP2_EXP(c0, 2) FP2_EXP(c0, 3) FP2_EXP(c0, 4) FP2_EXP(c0, 5)
    FP2_SB(); FP2_MMA(n1, kb2, 1);
    FP2_EXP(c0, 6) FP2_EXP(c0, 7) FP2_EXP(c0, 8) FP2_EXP(c0, 9) FP2_EXP(c0, 10) FP2_EXP(c0, 11)
    FP2_SB(); FP2_MMA(n0, ka, 2);
    FP2_EXP(c0, 12) FP2_EXP(c0, 13) FP2_EXP(c0, 14) FP2_EXP(c0, 15) FP2_EXP(c1, 0) FP2_EXP(c1, 1)
    FP2_SB(); FP2_MMA(n1, kb2, 2);
    FP2_EXP(c1, 2) FP2_EXP(c1, 3) FP2_EXP(c1, 4) FP2_EXP(c1, 5) FP2_EXP(c1, 6) FP2_EXP(c1, 7)
    FP2_SB(); FP2_MMA(n0, ka, 3);
    FP2_EXP(c1, 8) FP2_EXP(c1, 9) FP2_EXP(c1, 10) FP2_EXP(c1, 11) FP2_EXP(c1, 12) FP2_EXP(c1, 13)
    FP2_SB(); FP2_MMA(n1, kb2, 3);
    FP2_EXP(c1, 14) FP2_EXP(c1, 15)
    bf16x8 pa[4];
    { u32x4 t;
      t[0] = cvtpk(c0[0], c0[1]); t[1] = cvtpk(c0[2], c0[3]); t[2] = cvtpk(c0[4], c0[5]); t[3] = cvtpk(c0[6], c0[7]); pa[0] = __builtin_bit_cast(bf16x8, t);
      t[0] = cvtpk(c0[8], c0[9]); t[1] = cvtpk(c0[10], c0[11]); t[2] = cvtpk(c0[12], c0[13]); t[3] = cvtpk(c0[14], c0[15]); pa[1] = __builtin_bit_cast(bf16x8, t);
      t[0] = cvtpk(c1[0], c1[1]); t[1] = cvtpk(c1[2], c1[3]); t[2] = cvtpk(c1[4], c1[5]); t[3] = cvtpk(c1[6], c1[7]); pa[2] = __builtin_bit_cast(bf16x8, t);
      t[0] = cvtpk(c1[8], c1[9]); t[1] = cvtpk(c1[10], c1[11]); t[2] = cvtpk(c1[12], c1[13]); t[3] = cvtpk(c1[14], c1[15]); pa[3] = __builtin_bit_cast(bf16x8, t); }
    asm volatile("" : "+v"(pa[0]), "+v"(pa[1]), "+v"(pa[2]), "+v"(pa[3]));
    FP2_SB();
    l = l * alpha + ls;
    __builtin_amdgcn_sched_barrier(0);
    if (resc) {
#pragma unroll
      for (int b = 0; b < DVB; ++b)
#pragma unroll
        for (int r = 0; r < 16; ++r) o[b][r] *= alpha;
    }
    const ldsp_t vb = lds + st_cur * G::STAGE + vroff;
    s16x4 vl[2][DVB], vh[2][DVB];
#pragma unroll
    for (int b = 0; b < DVB; ++b) { vl[0][b] = vtr(vb + b * 64); vh[0][b] = vtr(vb + 8 * G::VSTR + b * 64); }
#pragma unroll
    for (int ks = 0; ks < 4; ++ks) {
      FP2_SB();
      if (ks < 3) {
#pragma unroll
        for (int b = 0; b < DVB; ++b) { vl[(ks + 1) & 1][b] = vtr(vb + (16 * (ks + 1)) * G::VSTR + b * 64); vh[(ks + 1) & 1][b] = vtr(vb + (16 * (ks + 1) + 8) * G::VSTR + b * 64); }
      }
      FP2_SB();
#pragma unroll
      for (int b = 0; b < DVB; ++b) {
        const s16x4 lo = vl[ks & 1][b], h8 = vh[ks & 1][b];
        const bf16x8 vf = {lo[0], lo[1], lo[2], lo[3], h8[0], h8[1], h8[2], h8[3]};
        if (ABL != 2) o[b] = __builtin_amdgcn_mfma_f32_32x32x16_bf16(vf, pa[ks], o[b], 0, 0, 0); else o[b][0] += __builtin_bit_cast(float, (int)vf[0]);
      }
    }
    FP2_SB();
    if (ABL != 3) { if (kt + 2 < ntiles) FP2_STORE(st_fill, set); }
    __syncthreads();
    if (ABL != 3) { if (kt + 2 + PF < ntiles) FP2_LOAD(kt + 2 + PF, set); }
    c0 = n0; c1 = n1;
    { const int t = st_cur; st_cur = st_nxt; st_nxt = st_fill; st_fill = t; }
  };
  if (PF == 2) { for (int kt = 0; kt < ntiles; kt += 2) { body(kt, IC<0>{}); if (kt + 1 < ntiles) body(kt + 1, IC<1>{}); } }
  else { for (int kt = 0; kt < ntiles; ++kt) body(kt, IC<0>{}); }
#undef FP2_LOAD
#undef FP2_STORE
}


typedef int v8i_t __attribute__((ext_vector_type(8)));
DEVI v8i_t cat8(const u32x4& x, const u32x4& y) { return (v8i_t){(int)x[0], (int)x[1], (int)x[2], (int)x[3], (int)y[0], (int)y[1], (int)y[2], (int)y[3]}; }
template <int DVB, int KROW, int AB8 = 0, class Src, class VKey, class Msk, class Act>
DEVI void flash_pass8(ldsp_t lds, int ntiles, const unsigned char* k8, int ldb, int kcolb, const unsigned char* vt, const v8i_t& qf, int ksub, bool late,
                      Src src, VKey vkey, Msk msk, Act act, f32x16 (&o)[DVB], float& m, float& l) {
  constexpr int A8_KSTR = KROW + 16, A8_VSTR = 80, A8_KB = 64 * A8_KSTR, A8_STAGE = A8_KB + DVB * 32 * A8_VSTR;
  constexpr int KPR = KROW / 16, NKC = 64 * KPR, NCHT = (NKC + DVB * 32 * 4) / NT;
  const int tid = ftid(), lane = tid & 63, r32 = lane & 31, hi = lane >> 5;
  u32x4 stg[NCHT];
#define A8_ISK(i_, c_) ((NKC % NT == 0) ? ((i_) < NKC / NT) : ((c_) < NKC))
#define A8_LOAD(kt) do { const int sb_ = src((kt), 0), vk_ = vkey(kt); _Pragma("unroll") for (int i_ = 0; i_ < NCHT; ++i_) { const int c_ = tid + NT * i_; \
      if (A8_ISK(i_, c_)) stg[i_] = *(const u32x4*)(k8 + (size_t)(sb_ + c_ / KPR) * ldb + kcolb + (c_ % KPR) * 16); \
      else { const int cv_ = c_ - NKC; stg[i_] = *(const u32x4*)(vt + (size_t)(cv_ >> 2) * 4352 + vk_ + (cv_ & 3) * 16); } } } while (0)
#define A8_STORE(st) do { _Pragma("unroll") for (int i_ = 0; i_ < NCHT; ++i_) { const int c_ = tid + NT * i_; \
      if (A8_ISK(i_, c_)) *(FA_LAS u32x4*)(lds + (st) * A8_STAGE + (c_ / KPR) * A8_KSTR + (c_ % KPR) * 16) = stg[i_]; \
      else { const int cv_ = c_ - NKC; *(FA_LAS u32x4*)(lds + (st) * A8_STAGE + A8_KB + (cv_ >> 2) * A8_VSTR + (cv_ & 3) * 16) = stg[i_]; } } } while (0)
#define A8_SB() __builtin_amdgcn_sched_barrier(0)
#define A8_EXP(cx, r) { if (AB8 & 2) {} else { cx[r] = __builtin_amdgcn_exp2f(cx[r] - mn); ls += cx[r]; } }
#define A8_KREAD(st) do { const ldsp_t kp_ = lds + (st) * A8_STAGE + kroff; \
    kf[0] = *(const volatile FA_LAS u32x4*)kp_; kf[1] = *(const volatile FA_LAS u32x4*)(kp_ + 16); kf[2] = *(const volatile FA_LAS u32x4*)(kp_ + 32 * A8_KSTR); kf[3] = *(const volatile FA_LAS u32x4*)(kp_ + 32 * A8_KSTR + 16); } while (0)
#define A8_VREAD(st) do { const ldsp_t vb_ = lds + (st) * A8_STAGE + vroff; _Pragma("unroll") for (int b = 0; b < DVB; ++b) { \
    vf0[b] = *(const volatile FA_LAS u32x4*)(vb_ + b * 32 * A8_VSTR); vf1[b] = *(const volatile FA_LAS u32x4*)(vb_ + b * 32 * A8_VSTR + 16); } } while (0)
#define A8_QKM() do { f32x16 z_; _Pragma("unroll") for (int r_ = 0; r_ < 16; ++r_) z_[r_] = 0.f; \
    c0 = __builtin_amdgcn_mfma_scale_f32_32x32x64_f8f6f4(cat8(kf[0], kf[1]), qf, z_, 0, 0, 0, 0x7d7d7d7d  , 0, 0x7b7b7b7b  ); \
    c1 = __builtin_amdgcn_mfma_scale_f32_32x32x64_f8f6f4(cat8(kf[2], kf[3]), qf, z_, 0, 0, 0, 0x7d7d7d7d, 0, 0x7b7b7b7b); } while (0)
#define A8_PVM() do { _Pragma("unroll") for (int b = 0; b < DVB; ++b) if (!(AB8 & 16)) o[b] = __builtin_amdgcn_mfma_scale_f32_32x32x64_f8f6f4(cat8(vf0[b], vf1[b]), pb, o[b], 0, 0, 0, 0x7d7d7d7d  , 0, 0x7b7b7b7b  ); } while (0)
  A8_LOAD(0); A8_STORE(0);
  if (ntiles > 1) { A8_LOAD(1); A8_STORE(1); }
  __syncthreads();
  if (ntiles > 2) A8_LOAD(2);
  const int kroff = r32 * A8_KSTR + 64 * ksub + 32 * hi;
  const int vroff = A8_KB + r32 * A8_VSTR + 32 * hi;
  f32x16 c0, c1;
  u32x4 kf[4], vf0[DVB], vf1[DVB];
  v8i_t pb = {0, 0, 0, 0, 0, 0, 0, 0};
  if (act(0)) { A8_KREAD(0); A8_QKM(); }
  asm volatile("s_nop 15\n\ts_nop 7" : "+v"(c0), "+v"(c1));
  int st_cur = 0, st_nxt = 1, st_fill = 2;
  for (int kt = 0; kt < ntiles; ++kt) {
    const bool on = act(kt), on_nxt = kt + 1 < ntiles && act(kt + 1);
    if (late && kt > 0) {
      if (on) A8_QKM();
      if (act(kt - 1)) A8_PVM();
#pragma unroll
      for (int b = 0; b < DVB; ++b) asm volatile("" : "+v"(o[b]));
      asm volatile("s_nop 15\n\ts_nop 7" : "+v"(c0), "+v"(c1));
    }
    A8_SB();
    if (on) A8_VREAD(st_cur);
    if (on_nxt) A8_KREAD(st_nxt);
    A8_SB();
    if (on) {
    msk(kt, c0, c1);
    A8_SB();
    float mxa = 0.f, mxb = 0.f;
    if (!(AB8 & 2)) {
    mxa = max3f(c0[0], c0[1], c1[0]), mxb = max3f(c0[2], c0[3], c1[1]);
    mxa = max3f(mxa, c1[2], c1[3]);
    mxa = max3f(mxa, c0[4], c0[5]); mxb = max3f(mxb, c0[6], c0[7]); mxa = max3f(mxa, c1[4], c1[5]); mxb = max3f(mxb, c1[6], c1[7]);
    mxa = max3f(mxa, c0[8], c0[9]); mxb = max3f(mxb, c0[10], c0[11]); mxa = max3f(mxa, c1[8], c1[9]); mxb = max3f(mxb, c1[10], c1[11]);
    mxa = max3f(mxa, c0[12], c0[13]); mxb = max3f(mxb, c0[14], c0[15]); mxa = max3f(mxa, c1[12], c1[13]); mxb = max3f(mxb, c1[14], c1[15]);
    }
    float mx = max3f(mxa, mxb, mxb);
    { const auto sw = __builtin_amdgcn_permlane32_swap(__float_as_uint(mx), __float_as_uint(mx), false, false);
      mx = fmaxf(__uint_as_float(sw[0]), __uint_as_float(sw[1])); }
    const bool up = mx > m + 8.f;
    const float mn = up ? mx - 4.f : m, alpha = __builtin_amdgcn_exp2f(m - mn);
    const bool resc = __any(up);
    m = mn;
    float ls = 0.f;
    A8_SB();
#pragma unroll
    for (int r = 0; r < 16; ++r) A8_EXP(c0, r)
#pragma unroll
    for (int r = 0; r < 16; ++r) A8_EXP(c1, r)
    A8_SB();
    unsigned X[4], Y[4];
#pragma unroll
    for (int i = 0; i < 4; ++i) {
      int w, z; asm volatile("" : "=v"(w)); asm volatile("" : "=v"(z));
      w = __builtin_amdgcn_cvt_pk_fp8_f32(c0[4 * i], c0[4 * i + 1], w, false); w = __builtin_amdgcn_cvt_pk_fp8_f32(c0[4 * i + 2], c0[4 * i + 3], w, true); X[i] = (unsigned)w;
      z = __builtin_amdgcn_cvt_pk_fp8_f32(c1[4 * i], c1[4 * i + 1], z, false); z = __builtin_amdgcn_cvt_pk_fp8_f32(c1[4 * i + 2], c1[4 * i + 3], z, true); Y[i] = (unsigned)z; }
#pragma unroll
    for (int i = 0; i < 4; ++i) { const auto rr = __builtin_amdgcn_permlane32_swap(X[i], Y[i], false, false); X[i] = rr[0]; Y[i] = rr[1]; }
    pb = (v8i_t){(int)X[0], (int)X[1], (int)X[2], (int)X[3], (int)Y[0], (int)Y[1], (int)Y[2], (int)Y[3]};
    asm volatile("" : "+v"(pb));
    l = l * alpha + ls;
    A8_SB();
    if (resc) {
#pragma unroll
      for (int b = 0; b < DVB; ++b)
#pragma unroll
        for (int r = 0; r < 16; ++r) o[b][r] *= alpha;
    }
    }
    A8_SB();
    if (!late) {
      if (on_nxt) A8_QKM();
      if (on) A8_PVM();
#pragma unroll
      for (int b = 0; b < DVB; ++b) asm volatile("" : "+v"(o[b]));
      asm volatile("" : "+v"(c0), "+v"(c1));
    }
    A8_SB();
    if (!(AB8 & 4)) { if (kt + 2 < ntiles) A8_STORE(st_fill); }
    if (!(AB8 & 8)) __syncthreads();
    if (!(AB8 & 4)) { if (kt + 3 < ntiles) A8_LOAD(kt + 3); }
    { const int t = st_cur; st_cur = st_nxt; st_nxt = st_fill; st_fill = t; }
  }
  if (late && act(ntiles - 1)) A8_PVM();
  l *= 0.0625f;
#undef A8_ISK
#undef A8_LOAD
#undef A8_STORE
#undef A8_SB
#undef A8_EXP
#undef A8_KREAD
#undef A8_VREAD
#undef A8_QKM
#undef A8_PVM
}

#ifndef OUT_FP8
#define OUT_FP8 1
#endif
DEVI void st_att4(bf16_t* ATT, size_t row, int col, float a, float b, float c, float d) {
  if (OUT_FP8) *(unsigned*)((unsigned char*)ATT + row * DM + col) = nv::pack4_fp8(a * 4.f, b * 4.f, c * 4.f, d * 4.f);
  else { uint2 w; w.x = cvtpk(a, b); w.y = cvtpk(c, d); *(uint2*)(ATT + row * DM + col) = w; }
}
DEVI int vblock() { const int G = gridDim.x, bx = blockIdx.x; return (G % 8 == 0) ? (bx % 8) * (G / 8) + bx / 8 : bx; }

template <int ABL = 0> DEVI void phase_attnA(const Params& p, ldsp_t lds) {
  typedef Geo<128, 4> G;
  const int tid = ftid(), lane = tid & 63, wave = __builtin_amdgcn_readfirstlane(tid >> 6), r32 = lane & 31, hi = lane >> 5;
  const bf16_t* Q = (const bf16_t*)(p.ws + WS_QKV0); bf16_t* ATT = (bf16_t*)(p.ws + (ABL ? WS_MIX0 : WS_ATT0));
  const float lam = ((const float*)(p.ws + WS_CTL + CTL_LAM))[0];
  const int s = wave >> 2, qb = wave & 3;
  constexpr int NU_LAT = NB * 4 * 32, NU_CTX = NB * 4 * 2;
  for (int u = vblock(); u < NU_LAT + NU_CTX; u += gridDim.x) {
    int b, h, row0, ntiles; bool lat = u < NU_LAT;
    if (lat) { b = u >> 7; h = (u >> 5) & 3; row0 = b * SEQ + (u & 31) * 128; ntiles = 68; }
    else { const int v = u - NU_LAT; b = v >> 3; h = (v >> 1) & 3; row0 = NLAT + b * CTXL + (v & 1) * 128; ntiles = 4; }
    const int qrow = row0 + qb * 32 + r32;
    bf16x8 q[4];
#pragma unroll
    for (int d0 = 0; d0 < 4; ++d0) q[d0] = load_q8(Q + (size_t)qrow * N_IN0 + h * 128 + s * 64 + 16 * d0 + 8 * hi, C2);
    f32x16 o[4];
#pragma unroll
    for (int bk = 0; bk < 4; ++bk)
#pragma unroll
      for (int r = 0; r < 16; ++r) o[bk][r] = 0.f;
    float m = -1e30f, l = 0.f;
    const int cbase = NLAT + b * CTXL, lbase = b * SEQ;
#if ATTNA_FP8
    const unsigned char* QK8 = (const unsigned char*)(p.ws + WS_QKV0);
    v8i_t qf;
    { const unsigned char* qp = QK8 + (size_t)qrow * (N_IN0 * 2) + h * 128 + s * 64 + 32 * hi; const u32x4 q0_ = *(const u32x4*)qp, q1_ = *(const u32x4*)(qp + 16); qf = cat8(q0_, q1_); }
    flash_pass8<4, 128, ABL>(lds, ntiles, QK8, N_IN0 * 2, 512 + h * 128, (const unsigned char*)(p.ws + WS_VT) + (size_t)((b * 4 + h) * 128) * 4352, qf, s, s != 0,
      [&](int kt, int i) { return lat ? (kt < 64 ? lbase + kt * 64 + i : cbase + (kt - 64) * 64 + i) : cbase + kt * 64 + i; },
      [&](int kt) { return (lat ? 0 : 4096) + kt * 64; }, [&](int, f32x16&, f32x16&) {}, [&](int) { return true; }, o, m, l);
#else
    flash_pass2<128, 4, ABL, 1>(lds, ntiles, Q, N_IN0, 512 + h * 128, 1024 + h * 128, q, s * 64,
      [&](int kt, int i) { return lat ? (kt < 64 ? lbase + kt * 64 + i : cbase + (kt - 64) * 64 + i) : cbase + kt * 64 + i; },
      [&](int, f32x16&, f32x16&) {}, o, m, l);
#endif
    l += __shfl_xor(l, 32);
    const float inv = 1.f / l;
    FA_LAS float* X = (FA_LAS float*)lds;
    if (s == 1) {
#pragma unroll
      for (int bk = 0; bk < 4; ++bk)
#pragma unroll
        for (int r = 0; r < 16; ++r) X[((qb * 4 + bk) * 16 + r) * 64 + lane] = o[bk][r] * inv;
    }
    __syncthreads();
    if (s == 0) {
      float ss = 0.f;
#pragma unroll
      for (int bk = 0; bk < 4; ++bk)
#pragma unroll
        for (int r = 0; r < 16; ++r) { const float d = o[bk][r] * inv - lam * X[((qb * 4 + bk) * 16 + r) * 64 + lane]; o[bk][r] = d; ss += d * d; }
      ss += __shfl_xor(ss, 32);
      const float rr = rsqrtf(ss * (1.f / 128.f) + EPS) * 0.8f;
      const float* g = p.in[L0_SUBLN];
#pragma unroll
      for (int bk = 0; bk < 4; ++bk)
#pragma unroll
        for (int rg = 0; rg < 4; ++rg) { const int dv = bk * 32 + 8 * rg + 4 * hi; const float4 gv = *(const float4*)(g + dv);
          st_att4(ATT, (size_t)qrow, h * 128 + dv, o[bk][4 * rg] * rr * gv.x, o[bk][4 * rg + 1] * rr * gv.y, o[bk][4 * rg + 2] * rr * gv.z, o[bk][4 * rg + 3] * rr * gv.w); }
    }
    __syncthreads();
  }
}

template <int ABL = 0> DEVI void phase_attnB(const Params& p, ldsp_t lds) {
  typedef Geo<64, 2> G;
  const int tid = ftid(), lane = tid & 63, wave = __builtin_amdgcn_readfirstlane(tid >> 6), r32 = lane & 31, hi = lane >> 5;
  const bf16_t* Q = (const bf16_t*)(p.ws + WS_QKV0); bf16_t* ATT = (bf16_t*)(p.ws + (ABL ? WS_MIX0 : WS_ATT0));
  constexpr int NU_LAT = NB * 8 * 16, NU_CTX = NB * 8;
  FA_LAS float* RPB = (FA_LAS float*)(lds + 3 * (64 * 80 + 64 * 80));
  for (int u = vblock(); u < NU_LAT + NU_CTX; u += gridDim.x) {
    const bool lat = u < NU_LAT;
    int b, h, qrow_g = 0, c0 = 0, rlo = 0, nlat = 0, rs_w = 0, grow;
    if (lat) { b = u >> 7; h = (u >> 4) & 7; const int qr0 = (u & 15) * 4; qrow_g = qr0 + (wave >> 1); c0 = 32 * (wave & 1);
      rlo = min(max(qr0 - 4, 0), 56); const int rhi = min(max(qr0 - 1, 0), 56) + 7; nlat = rhi - rlo + 1; rs_w = min(max(qrow_g - 4, 0), 56);
      grow = b * SEQ + qrow_g * 64 + c0 + r32; }
    else { const int v = u - NU_LAT; b = v >> 3; h = v & 7; grow = NLAT + b * CTXL + wave * 32 + r32; }
    const int ntiles = nlat + 4;
    for (int i = tid; i < 15 * 31; i += NT) RPB[i] = p.in[L0_RPB][h * 465 + i] * LOG2E;
    const unsigned char* QK8 = (const unsigned char*)(p.ws + WS_QKV0);
    v8i_t qf;
    { const unsigned char* qp = QK8 + (size_t)grow * (N_IN0 * 2) + 1536 + h * 64 + 32 * hi; const u32x4 q0_ = *(const u32x4*)qp, q1_ = *(const u32x4*)(qp + 16); qf = cat8(q0_, q1_); }
    f32x16 o[2];
#pragma unroll
    for (int bk = 0; bk < 2; ++bk)
#pragma unroll
      for (int r = 0; r < 16; ++r) o[bk][r] = 0.f;
    float m = -1e30f, l = 0.f;
    const int cbase = NLAT + b * CTXL, lbase = b * SEQ;
    const int qc = c0 + r32, cs = min(max(qc - 8, 0), 48);
    flash_pass8<2, 64>(lds, ntiles, QK8, N_IN0 * 2, 2048 + h * 64, (const unsigned char*)(p.ws + WS_VTB) + (size_t)((b * 8 + h) * 64) * 4352, qf, 0, wave >= 4,
      [&](int kt, int i) { return kt < nlat ? lbase + (rlo + kt) * 64 + i : cbase + (kt - nlat) * 64 + i; },
      [&](int kt) { return kt < nlat ? (rlo + kt) * 64 : 4096 + (kt - nlat) * 64; },
      [&](int kt, f32x16& p0, f32x16& p1) {
        if (ABL != 1 && kt < nlat) { const int kr = rlo + kt; const bool rowok = (kr >= rs_w && kr < rs_w + 8);
          const FA_LAS float* bp = RPB + min(max(kr - qrow_g + 7, 0), 14) * 31;
          { float b0[16];
#pragma unroll
            for (int r = 0; r < 16; ++r) { const int k0 = crow(r, hi); b0[r] = bp[min(max(k0 - qc + 15, 0), 30)]; }
#pragma unroll
            for (int r = 0; r < 16; ++r) { const int k0 = crow(r, hi); const float v0 = p0[r] + b0[r]; p0[r] = (rowok && k0 >= cs && k0 < cs + 16) ? v0 : -INFINITY; } }
          asm volatile("" ::: "memory");
          { float b1[16];
#pragma unroll
            for (int r = 0; r < 16; ++r) { const int k1 = 32 + crow(r, hi); b1[r] = bp[min(max(k1 - qc + 15, 0), 30)]; }
#pragma unroll
            for (int r = 0; r < 16; ++r) { const int k1 = 32 + crow(r, hi); const float v1 = p1[r] + b1[r]; p1[r] = (rowok && k1 >= cs && k1 < cs + 16) ? v1 : -INFINITY; } } } },
      [&](int kt) { const int kr = rlo + kt; return kt >= nlat || (kr >= rs_w && kr < rs_w + 8); },
      o, m, l);
    l += __shfl_xor(l, 32);
    const float inv = 1.f / l;
#pragma unroll
    for (int bk = 0; bk < 2; ++bk)
#pragma unroll
      for (int rg = 0; rg < 4; ++rg) { const int dv = bk * 32 + 8 * rg + 4 * hi;
        st_att4(ATT, (size_t)grow, 512 + h * 64 + dv, o[bk][4 * rg] * inv, o[bk][4 * rg + 1] * inv, o[bk][4 * rg + 2] * inv, o[bk][4 * rg + 3] * inv); }
    __syncthreads();
  }
}

DEVI void phase_attnC(const Params& p, ldsp_t lds, int* ctr) {
  const int tid = ftid(), lane = tid & 63, wave = __builtin_amdgcn_readfirstlane(tid >> 6), r32 = lane & 31, hi = lane >> 5;
  const bf16_t* P1 = (const bf16_t*)(p.ws + WS_P1); bf16_t* ATT = (bf16_t*)(p.ws + WS_ATT1);
  FA_LAS int* uq = (FA_LAS int*)(lds + 3 * Geo<64, 2>::STAGE + 64);
  for (;;) {
    if (tid == 0) *uq = atomicAdd(ctr, 1);
    __syncthreads();
    const int u = *uq;
    __syncthreads();
    if (u >= NB * 2 * 64) break;
    const int b = u >> 7, g = (u >> 6) & 1, tq = u & 63, hq = g * 4 + (wave >> 1), t = tq * 64 + 32 * (wave & 1) + r32, grow = b * SEQ + t;
    const int klo = max(tq - 2, 0), khi = min(tq + 2, 63), nwin = khi - klo + 1, ntiles = nwin + 4;
    bf16x8 q[4];
#pragma unroll
    for (int d0 = 0; d0 < 4; ++d0) q[d0] = load_q8(P1 + (size_t)grow * 2304 + hq * 64 + 16 * d0 + 8 * hi, C2);
    f32x16 o[2];
#pragma unroll
    for (int bk = 0; bk < 2; ++bk)
#pragma unroll
      for (int r = 0; r < 16; ++r) o[bk][r] = 0.f;
    float m = -1e30f, l = 0.f;
    const int cbase = NLAT + b * CTXL, lbase = b * SEQ;
    flash_pass2<64, 2, 0, 2>(lds, ntiles, P1, 2304, 512 + g * 64, 640 + g * 64, q, 0,
      [&](int kt, int i) { return kt < nwin ? lbase + (klo + kt) * 64 + i : cbase + (kt - nwin) * 64 + i; },
      [&](int kt, f32x16& p0, f32x16& p1) {
        if (kt < nwin) { const int kp = (klo + kt) * 64 - t;
#pragma unroll
          for (int r = 0; r < 16; ++r) { const int d0 = kp + crow(r, hi), d1 = d0 + 32;
            if (d0 < -128 || d0 > 128) p0[r] = -INFINITY; if (d1 < -128 || d1 > 128) p1[r] = -INFINITY; } } },
      o, m, l);
    l += __shfl_xor(l, 32);
    { const float sk = p.in[L1_SINKS][hq] * LOG2E, mn = fmaxf(m, sk), alpha = __builtin_amdgcn_exp2f(m - mn);
      l = l * alpha + __builtin_amdgcn_exp2f(sk - mn);
#pragma unroll
      for (int bk = 0; bk < 2; ++bk)
#pragma unroll
        for (int r = 0; r < 16; ++r) o[bk][r] *= alpha; }
    const float inv = 1.f / l;
#pragma unroll
    for (int bk = 0; bk < 2; ++bk)
#pragma unroll
      for (int rg = 0; rg < 4; ++rg) { const int dv = bk * 32 + 8 * rg + 4 * hi;
        st_att4(ATT, (size_t)grow, hq * 64 + dv, o[bk][4 * rg] * inv, o[bk][4 * rg + 1] * inv, o[bk][4 * rg + 2] * inv, o[bk][4 * rg + 3] * inv); }
    __syncthreads();
  }
}
}
namespace fs {
using fa::bf16x8; using fa::s16x4; using fa::f32x16; using fa::ldsp_t; using fa::u32x4; using fa::cvtpk; using fa::vtr; using fa::crow; using fa::LOG2E;
typedef unsigned u32x2 __attribute__((ext_vector_type(2)));

DEVI void phase_conv(const Params& p) {
  const bf16_t* P1 = (const bf16_t*)(p.ws + WS_P1); bf16_t* U = (bf16_t*)(p.ws + WS_U);
  const float* cw = p.in[L1_CONVW]; const float* cb = p.in[L1_CONVB];
  const int nitems = (NROW / 16) * 128;
  for (int it = blockIdx.x * NT + ftid(); it < nitems; it += gridDim.x * NT) {
    const int cg = it & 127, rc = it >> 7, r0 = rc * 16, ch = cg * 8;
    int s0, len; if (r0 < NLAT) { s0 = r0 & ~4095; len = SEQ; } else { s0 = NLAT + ((r0 - NLAT) & ~255); len = CTXL; }
    const int t0 = r0 - s0;
    float w[5][8], bias[8];
#pragma unroll
    for (int j = 0; j < 5; ++j) { const float4 a = *(const float4*)(cw + j * 1024 + ch), b = *(const float4*)(cw + j * 1024 + ch + 4);
      w[j][0] = a.x; w[j][1] = a.y; w[j][2] = a.z; w[j][3] = a.w; w[j][4] = b.x; w[j][5] = b.y; w[j][6] = b.z; w[j][7] = b.w; }
    { const float4 a = *(const float4*)(cb + ch), b = *(const float4*)(cb + ch + 4); bias[0] = a.x; bias[1] = a.y; bias[2] = a.z; bias[3] = a.w; bias[4] = b.x; bias[5] = b.y; bias[6] = b.z; bias[7] = b.w; }
    float win[5][8];
    auto ldrow = [&](int t, float (&d)[8]) {
      if (t < 0 || t >= len) {
#pragma unroll
        for (int k = 0; k < 8; ++k) d[k] = 0.f; return; }
      const u32x4 v = *(const u32x4*)(P1 + (size_t)(s0 + t) * 2304 + 768 + ch);
#pragma unroll
      for (int k = 0; k < 4; ++k) { d[2 * k] = __uint_as_float(v[k] << 16); d[2 * k + 1] = __uint_as_float(v[k] & 0xffff0000u); } };
    ldrow(t0 - 2, win[0]); ldrow(t0 - 1, win[1]); ldrow(t0, win[2]); ldrow(t0 + 1, win[3]);
#pragma unroll
    for (int i = 0; i < 16; ++i) {
      ldrow(t0 + i + 2, win[(i + 4) % 5]);
      float o[8];
#pragma unroll
      for (int k = 0; k < 8; ++k) { float a = bias[k];
#pragma unroll
        for (int j = 0; j < 5; ++j) a += w[j][k] * win[(i + j) % 5][k];
        o[k] = a * __builtin_amdgcn_rcpf(1.f + __expf(-a)); }
      u32x4 ov; ov[0] = cvtpk(o[0], o[1]); ov[1] = cvtpk(o[2], o[3]); ov[2] = cvtpk(o[4], o[5]); ov[3] = cvtpk(o[6], o[7]);
      *(u32x4*)(U + (size_t)(r0 + i) * 1024 + ch) = ov;
    }
  }
}

DEVI float softplus_f(float v) { if (v > 20.f) return v; const float x = __expf(v); return x < 1e-3f ? x * (1.f - 0.5f * x) : __logf(1.f + x); }
constexpr int BSTR = 272, XSTR = 192;
constexpr int L_BM = 0, L_XD = 128 * BSTR, L_XW = L_XD + 128 * XSTR, L_HT = L_XW + 128 * XSTR, L_CUM = L_HT + 128 * XSTR, L_DTV = L_CUM + 512, L_XCH = L_DTV + 512, L_TOT = L_XCH + 8 * 4096;

template <int ABL = 0> DEVI void phase_ssd(const Params& p, ldsp_t lds) {
  const int tid = ftid(), lane = tid & 63, wave = __builtin_amdgcn_readfirstlane(tid >> 6), r32 = lane & 31, hi = lane >> 5;
  const int pb = wave >> 2, lb = (wave < 4) ? (wave & 3) : 3 - (wave & 3);
  const bf16_t* U = (const bf16_t*)(p.ws + WS_U); const float* DT = (const float*)(p.ws + WS_DT);
  bf16_t* YFB = (bf16_t*)(p.ws + WS_YS);
  FA_LAS float* CUM = (FA_LAS float*)(lds + L_CUM); FA_LAS float* DTV = (FA_LAS float*)(lds + L_DTV);
  const int trow_off = 4 * hi + ((lane & 15) >> 2), tcol_off = 32 * ((lane >> 4) & 1) + 8 * (lane & 3);
  for (int it = blockIdx.x; it < NB * 2 * 8; it += gridDim.x) {
    const int b = it >> 4, dir = (it >> 3) & 1, hd = it & 7, g = hd >> 2;
    const float a2 = -expf(p.in[dir ? L1_ALOGB : L1_ALOGF][hd]) * LOG2E; const float dtb = p.in[dir ? L1_DTBB : L1_DTBF][hd];
    auto tokrow = [&](int c, int i) { const int seg = c >= 2, len = seg ? SEQ : CTXL, j = (seg ? c - 2 : c) * 128 + i; return (seg ? b * SEQ : NLAT + b * CTXL) + (dir ? len - 1 - j : j); };
    f32x16 hacc;
#pragma unroll
    for (int r = 0; r < 16; ++r) hacc[r] = 0.f;
    for (int i = tid; i < 128 * XSTR / 4; i += NT) ((FA_LAS unsigned*)(lds + L_HT))[i] = 0u;
    u32x4 sb_[4], sx_[2]; float sdt0 = 0.f, sdt1 = 0.f; bf16x8 cfn[8];
    auto prefetch = [&](int c) {
#pragma unroll
      for (int i = 0; i < 4; ++i) { const int ch = tid + NT * i; sb_[i] = *(const u32x4*)(U + (size_t)tokrow(c, ch >> 4) * 1024 + 512 + g * 128 + (ch & 15) * 8); }
#pragma unroll
      for (int i = 0; i < 2; ++i) { const int ch = tid + NT * i; sx_[i] = *(const u32x4*)(U + (size_t)tokrow(c, ch >> 3) * 1024 + hd * 64 + (ch & 7) * 8); }
      if (tid < 64) { sdt0 = DT[(size_t)tokrow(c, 2 * tid) * 16 + dir * 8 + hd]; sdt1 = DT[(size_t)tokrow(c, 2 * tid + 1) * 16 + dir * 8 + hd]; }
      const bf16_t* crowp = U + (size_t)tokrow(c, lb * 32 + r32) * 1024 + 768 + g * 128 + 8 * hi;
#pragma unroll
      for (int ks = 0; ks < 8; ++ks) cfn[ks] = *(const bf16x8*)(crowp + 16 * ks);
    };
    prefetch(0);
    __syncthreads();
    for (int c = 0; c < 34; ++c) {
      if (tid < 64) {
        const float r0 = sdt0 + dtb, r1 = sdt1 + dtb; const float d0 = softplus_f(r0), d1 = softplus_f(r1);
        const float a0 = d0 * a2, a1 = d1 * a2; float v = a0 + a1;
#pragma unroll
        for (int o = 1; o < 64; o <<= 1) { const float t = __shfl_up(v, o); if (lane >= o) v += t; }
        DTV[2 * tid] = d0; DTV[2 * tid + 1] = d1; CUM[2 * tid] = v - a1; CUM[2 * tid + 1] = v;
      }
      __syncthreads();
      const float cl = CUM[127];
#pragma unroll
      for (int i = 0; i < 4; ++i) { const int ch = tid + NT * i; *(FA_LAS u32x4*)(lds + L_BM + (ch >> 4) * BSTR + (ch & 15) * 16) = sb_[i]; }
#pragma unroll
      for (int i = 0; i < 2; ++i) { const int ch = tid + NT * i, s = ch >> 3; const float d = DTV[s], wv = d * __builtin_amdgcn_exp2f(cl - CUM[s]);
        u32x4 xd, xw;
#pragma unroll
        for (int k = 0; k < 4; ++k) { const float x0 = __uint_as_float(sx_[i][k] << 16), x1 = __uint_as_float(sx_[i][k] & 0xffff0000u); xd[k] = cvtpk(x0 * d, x1 * d); xw[k] = cvtpk(x0 * wv, x1 * wv); }
        *(FA_LAS u32x4*)(lds + L_XD + s * XSTR + (ch & 7) * 16) = xd; *(FA_LAS u32x4*)(lds + L_XW + s * XSTR + (ch & 7) * 16) = xw; }
      bf16x8 cf[8];
#pragma unroll
      for (int ks = 0; ks < 8; ++ks) cf[ks] = cfn[ks];
      __syncthreads();
      if (ABL != 3) { if (c + 1 < 34) prefetch(c + 1); }
      if (c >= 2 && ABL != 1) {
        f32x16 y;
#pragma unroll
        for (int r = 0; r < 16; ++r) y[r] = 0.f;
        { const ldsp_t hb = lds + L_HT + (8 * hi + ((lane & 15) >> 2)) * XSTR + pb * 64 + tcol_off;
          f32x16 y2;
#pragma unroll
          for (int r = 0; r < 16; ++r) y2[r] = 0.f;
#pragma unroll
          for (int ks = 0; ks < 8; ++ks) { const s16x4 lo = vtr(hb + (16 * ks) * XSTR), h8 = vtr(hb + (16 * ks + 4) * XSTR);
            const bf16x8 hf = {lo[0], lo[1], lo[2], lo[3], h8[0], h8[1], h8[2], h8[3]};
            if (ks & 1) y2 = __builtin_amdgcn_mfma_f32_32x32x16_bf16(hf, cf[ks], y2, 0, 0, 0); else y = __builtin_amdgcn_mfma_f32_32x32x16_bf16(hf, cf[ks], y, 0, 0, 0); }
          y += y2; }
        const float cuml = CUM[lb * 32 + r32];
        { const float e = __builtin_amdgcn_exp2f(cuml);
#pragma unroll
          for (int r = 0; r < 16; ++r) y[r] *= e; }
        f32x16 yo;
#pragma unroll
        for (int r = 0; r < 16; ++r) yo[r] = 0.f;
        for (int sb = pb; sb <= lb; sb += 2) {
          f32x16 gt, gt2;
#pragma unroll
          for (int r = 0; r < 16; ++r) { gt[r] = 0.f; gt2[r] = 0.f; }
          const ldsp_t bb = lds + L_BM + (sb * 32 + r32) * BSTR + 16 * hi;
#pragma unroll
          for (int ks = 0; ks < 8; ks += 2) { gt = __builtin_amdgcn_mfma_f32_32x32x16_bf16(*(const FA_LAS bf16x8*)(bb + 32 * ks), cf[ks], gt, 0, 0, 0);
            gt2 = __builtin_amdgcn_mfma_f32_32x32x16_bf16(*(const FA_LAS bf16x8*)(bb + 32 * ks + 32), cf[ks + 1], gt2, 0, 0, 0); }
          gt += gt2;
          const bool diag = (sb == lb);
#pragma unroll
          for (int r = 0; r < 16; ++r) { const int sl = crow(r, hi); const float v = gt[r] * __builtin_amdgcn_exp2f(cuml - CUM[sb * 32 + sl]); gt[r] = (diag && sl > r32) ? 0.f : v; }
          u32x4 t0, t1;
          t0[0] = cvtpk(gt[0], gt[1]); t0[1] = cvtpk(gt[2], gt[3]); t0[2] = cvtpk(gt[4], gt[5]); t0[3] = cvtpk(gt[6], gt[7]);
          t1[0] = cvtpk(gt[8], gt[9]); t1[1] = cvtpk(gt[10], gt[11]); t1[2] = cvtpk(gt[12], gt[13]); t1[3] = cvtpk(gt[14], gt[15]);
          const bf16x8 pm0 = __builtin_bit_cast(bf16x8, t0), pm1 = __builtin_bit_cast(bf16x8, t1);
          const ldsp_t xb = lds + L_XD + (sb * 32 + trow_off) * XSTR + pb * 64 + tcol_off;
          const ldsp_t xo = lds + L_XD + (sb * 32 + trow_off) * XSTR + (1 - pb) * 64 + tcol_off;
          const s16x4 a0 = vtr(xb), a1 = vtr(xb + 8 * XSTR), a2 = vtr(xb + 16 * XSTR), a3 = vtr(xb + 24 * XSTR);
          const s16x4 b0 = vtr(xo), b1 = vtr(xo + 8 * XSTR), b2 = vtr(xo + 16 * XSTR), b3 = vtr(xo + 24 * XSTR);
          { const bf16x8 xf = {a0[0], a0[1], a0[2], a0[3], a1[0], a1[1], a1[2], a1[3]}; y = __builtin_amdgcn_mfma_f32_32x32x16_bf16(xf, pm0, y, 0, 0, 0); }
          { const bf16x8 xf = {b0[0], b0[1], b0[2], b0[3], b1[0], b1[1], b1[2], b1[3]}; yo = __builtin_amdgcn_mfma_f32_32x32x16_bf16(xf, pm0, yo, 0, 0, 0); }
          { const bf16x8 xf = {a2[0], a2[1], a2[2], a2[3], a3[0], a3[1], a3[2], a3[3]}; y = __builtin_amdgcn_mfma_f32_32x32x16_bf16(xf, pm1, y, 0, 0, 0); }
          { const bf16x8 xf = {b2[0], b2[1], b2[2], b2[3], b3[0], b3[1], b3[2], b3[3]}; yo = __builtin_amdgcn_mfma_f32_32x32x16_bf16(xf, pm1, yo, 0, 0, 0); }
        }
        { FA_LAS float* X = (FA_LAS float*)(lds + L_XCH) + (pb * 4 + lb) * 1024;
#pragma unroll
          for (int r = 0; r < 16; ++r) X[r * 64 + lane] = yo[r]; }
        __syncthreads();
        { const FA_LAS float* X = (const FA_LAS float*)(lds + L_XCH) + ((1 - pb) * 4 + lb) * 1024;
#pragma unroll
          for (int r = 0; r < 16; ++r) y[r] += X[r * 64 + lane]; }
        const int j = (c - 2) * 128 + lb * 32 + r32, tok = dir ? SEQ - 1 - j : j;
        bf16_t* yp = YFB + ((size_t)dir * NLAT + (size_t)b * SEQ + tok) * 512 + hd * 64 + pb * 32 + 4 * hi;
#pragma unroll
        for (int rg = 0; rg < 4; ++rg) { u32x2 w; w[0] = cvtpk(y[4 * rg], y[4 * rg + 1]); w[1] = cvtpk(y[4 * rg + 2], y[4 * rg + 3]); *(u32x2*)(yp + 8 * rg) = w; }
      }
      if (ABL != 2) { const float e = __builtin_amdgcn_exp2f(cl);
        f32x16 h2;
#pragma unroll
        for (int r = 0; r < 16; ++r) { hacc[r] *= e; h2[r] = 0.f; }
        const ldsp_t xb = lds + L_XW + (8 * hi + ((lane & 15) >> 2)) * XSTR + pb * 64 + tcol_off;
        const ldsp_t bb = lds + L_BM + (8 * hi + ((lane & 15) >> 2)) * BSTR + lb * 64 + tcol_off;
#pragma unroll
        for (int ks = 0; ks < 8; ++ks) {
          const s16x4 xl = vtr(xb + (16 * ks) * XSTR), xh = vtr(xb + (16 * ks + 4) * XSTR), bl = vtr(bb + (16 * ks) * BSTR), bh = vtr(bb + (16 * ks + 4) * BSTR);
          const bf16x8 xf = {xl[0], xl[1], xl[2], xl[3], xh[0], xh[1], xh[2], xh[3]}, bf = {bl[0], bl[1], bl[2], bl[3], bh[0], bh[1], bh[2], bh[3]};
          if (ks & 1) h2 = __builtin_amdgcn_mfma_f32_32x32x16_bf16(xf, bf, h2, 0, 0, 0); else hacc = __builtin_amdgcn_mfma_f32_32x32x16_bf16(xf, bf, hacc, 0, 0, 0);
        }
        hacc += h2; }
      __syncthreads();
      { const ldsp_t hp = lds + L_HT + (lb * 32 + r32) * XSTR + (pb * 32 + 4 * hi) * 2;
#pragma unroll
        for (int rg = 0; rg < 4; ++rg) { u32x2 w; w[0] = cvtpk(hacc[4 * rg], hacc[4 * rg + 1]); w[1] = cvtpk(hacc[4 * rg + 2], hacc[4 * rg + 3]); *(FA_LAS u32x2*)(hp + 16 * rg) = w; } }
    }
    __syncthreads();
  }
}

DEVI void phase_ssd_out(const Params& p) {
  const int lane = ftid() & 63, gw = blockIdx.x * NWAVE + (ftid() >> 6), NGW = gridDim.x * NWAVE;
  const bf16_t* U = (const bf16_t*)(p.ws + WS_U); const bf16_t* P1 = (const bf16_t*)(p.ws + WS_P1); const bf16_t* YFB = (const bf16_t*)(p.ws + WS_YS);
  bf16_t* ATT = (bf16_t*)(p.ws + WS_ATT1);
  for (int r = gw; r < NLAT; r += NGW) {
    const int c0 = lane * 8, hd = c0 >> 6; const float dsk = p.in[L1_DSKIP][hd];
    const u32x4 yf = *(const u32x4*)(YFB + (size_t)r * 512 + c0), yb = *(const u32x4*)(YFB + ((size_t)NLAT + r) * 512 + c0);
    const u32x4 xw = *(const u32x4*)(U + (size_t)r * 1024 + c0), zw = *(const u32x4*)(P1 + (size_t)r * 2304 + 1792 + c0);
    float y[8]; float ss = 0.f;
#pragma unroll
    for (int i = 0; i < 4; ++i) {
      const float x0 = __uint_as_float(xw[i] << 16), x1 = __uint_as_float(xw[i] & 0xffff0000u), z0 = __uint_as_float(zw[i] << 16), z1 = __uint_as_float(zw[i] & 0xffff0000u);
      const float f0 = __uint_as_float(yf[i] << 16) + __uint_as_float(yb[i] << 16), f1 = __uint_as_float(yf[i] & 0xffff0000u) + __uint_as_float(yb[i] & 0xffff0000u);
      y[2 * i] = (f0 + dsk * x0) * silu_f(z0); y[2 * i + 1] = (f1 + dsk * x1) * silu_f(z1);
      ss += y[2 * i] * y[2 * i] + y[2 * i + 1] * y[2 * i + 1];
    }
#pragma unroll
    for (int o = 1; o < 32; o <<= 1) ss += __shfl_xor(ss, o);
    const float rr = rsqrtf(ss * (1.f / 256.f) + EPS);
    const float4 g0 = *(const float4*)(p.in[L1_GNORM] + c0), g1 = *(const float4*)(p.in[L1_GNORM] + c0 + 4);
    u32x4 w; w[0] = cvtpk(y[0] * rr * g0.x, y[1] * rr * g0.y); w[1] = cvtpk(y[2] * rr * g0.z, y[3] * rr * g0.w); w[2] = cvtpk(y[4] * rr * g1.x, y[5] * rr * g1.y); w[3] = cvtpk(y[6] * rr * g1.z, y[7] * rr * g1.w);
    *(u32x4*)(ATT + (size_t)r * DM + 512 + c0) = w;
  }
}
}
#ifndef TOPK_COPY
#define TOPK_COPY false
#endif
namespace ft {
using fa::ldsp_t; using fa::u32x4;

DEVI int block_excl_scan(int v, FA_LAS int* wsum, int tid, int* tot) {
  const int lane = tid & 63, wave = tid >> 6;
  int inc = v;
#pragma unroll
  for (int o = 1; o < 64; o <<= 1) { const int t = __shfl_up(inc, o); if (lane >= o) inc += t; }
  __syncthreads();
  if (lane == 63) wsum[wave] = inc;
  __syncthreads();
  int base = 0, total = 0;
#pragma unroll
  for (int w = 0; w < 8; ++w) { const int s = wsum[w]; if (w < wave) base += s; total += s; }
  *tot = total;
  return base + inc - v;
}

template <int EPT, bool GATHER_COPY>
DEVI void topk_item(const Params& p, ldsp_t lds, int e, int n, int cap, int row0, int slot0, int erows) {
  const int tid = ftid(), lane = tid & 63, wave = tid >> 6;
  const float* AFFT = (const float*)(p.ws + WS_AFF); int* SLOT = (int*)(p.ws + WS_SLOT); float* GV = (float*)(p.ws + WS_GATEV);
  const bf16_t* H = (const bf16_t*)(p.ws + WS_H); bf16_t* XG = (bf16_t*)(p.ws + WS_XG); int* IDX = (int*)(p.ws + WS_IDX);
  FA_LAS unsigned* hist = (FA_LAS unsigned*)lds;
  FA_LAS int* misc = (FA_LAS int*)(lds + 1024);
  FA_LAS int* wsum = (FA_LAS int*)(lds + 1024 + 64);
  FA_LAS int* list = (FA_LAS int*)(lds + 2048);
  const bool act = tid * EPT < n;
  unsigned key[EPT];
#pragma unroll
  for (int j = 0; j < EPT; ++j) key[j] = act ? __float_as_uint(AFFT[(size_t)e * NROW + row0 + tid * EPT + j]) : 0u;
  unsigned prefix = 0u, mask = 0u; int k = cap;
#pragma unroll 1
  for (int pass = 0; pass < 4; ++pass) {
    const int shift = 24 - 8 * pass;
    __syncthreads();
    if (tid < 256) hist[tid] = 0u;
    __syncthreads();
    if (act) {
#pragma unroll
      for (int j = 0; j < EPT; ++j) if ((key[j] & mask) == prefix) atomicAdd((unsigned*)&hist[(key[j] >> shift) & 255u], 1u);
    }
    __syncthreads();
    if (wave == 0) {
      const int h0 = hist[4 * lane], h1 = hist[4 * lane + 1], h2 = hist[4 * lane + 2], h3 = hist[4 * lane + 3];
      const int s = h0 + h1 + h2 + h3; int v = s;
#pragma unroll
      for (int o = 1; o < 64; o <<= 1) { const int t = __shfl_down(v, o); if (lane + o < 64) v += t; }
      int c = v - s;
      const int hh[4] = {h0, h1, h2, h3};
#pragma unroll
      for (int b = 3; b >= 0; --b) { if (c < k && k <= c + hh[b]) { misc[0] = 4 * lane + b; misc[1] = k - c; } c += hh[b]; }
    }
    __syncthreads();
    prefix |= ((unsigned)misc[0]) << shift; mask |= 255u << shift; k = misc[1];
  }
  int ce = 0;
#pragma unroll
  for (int j = 0; j < EPT; ++j) ce += (act && key[j] == prefix) ? 1 : 0;
  int tot; const int eq_before = block_excl_scan(ce, wsum, tid, &tot);
  int cs = 0, eqr = eq_before; bool sel[EPT];
#pragma unroll
  for (int j = 0; j < EPT; ++j) { bool s = false; if (act) { if (key[j] > prefix) s = true; else if (key[j] == prefix) { s = eqr < k; ++eqr; } } sel[j] = s; cs += s ? 1 : 0; }
  int slot = block_excl_scan(cs, wsum, tid, &tot);
  if (act) {
#pragma unroll
    for (int j = 0; j < EPT; ++j) { const int row = row0 + tid * EPT + j;
      if (sel[j]) { if (GATHER_COPY) list[slot] = row; else IDX[e * erows + slot0 + slot] = row; GV[e * erows + slot0 + slot] = __uint_as_float(key[j]); SLOT[(size_t)row * 16 + e] = slot0 + slot; ++slot; }
      else SLOT[(size_t)row * 16 + e] = -1; }
  }
  if (GATHER_COPY) {
    __syncthreads();
    for (int s = wave; s < cap; s += NWAVE) {
      const u32x4* src = (const u32x4*)(H + (size_t)list[s] * DM) + lane; u32x4* dst = (u32x4*)(XG + ((size_t)e * erows + slot0 + s) * DM) + lane;
      const u32x4 a = src[0], b2 = src[64]; dst[0] = a; dst[64] = b2;
    }
  }
  __syncthreads();
}

DEVI void phase_topk(const Params& p, ldsp_t lds, int layer) {
  const int erows = layer ? EROWS1 : EROWS0;
  const int nlat = NB * NE, nitems = nlat + (layer ? 0 : NB * NE);
  const int G = gridDim.x;
  for (int it = blockIdx.x; it < nitems; it += G) {
    if (it < nlat) { const int b = it / NE, e = it % NE; topk_item<8, TOPK_COPY>(p, lds, e, SEQ, CAP_L, b * SEQ, b * CAP_L, erows); }
    else { const int i2 = it - nlat, b = i2 / NE, e = i2 % NE; topk_item<1, TOPK_COPY>(p, lds, e, CTXL, CAP_C, NLAT + b * CTXL, NB * CAP_L + b * CAP_C, erows); }
  }
}
}
#ifndef MOE1_FP8
#define MOE1_FP8 1
#endif
#ifndef MOE0_FP8
#define MOE0_FP8 1
#endif
namespace fr {
using fa::ldsp_t; using fa::u32x4; using fa::cvtpk;
typedef unsigned u32x2 __attribute__((ext_vector_type(2)));
typedef float f32x4 __attribute__((ext_vector_type(4)));
struct V16 { f32x4 v[4]; };
DEVI V16 ldf(const float* r, int lane) { V16 o; const f32x4* q = (const f32x4*)r + lane;
#pragma unroll
  for (int j = 0; j < 4; ++j) o.v[j] = q[64 * j]; return o; }
struct B16 { u32x2 v[4]; };
DEVI B16 ldb_raw(const bf16_t* r, int lane) { B16 o; const u32x2* q = (const u32x2*)r + lane;
#pragma unroll
  for (int j = 0; j < 4; ++j) o.v[j] = q[64 * j]; return o; }
DEVI V16 b2v(const B16& b) { V16 o;
#pragma unroll
  for (int j = 0; j < 4; ++j) { o.v[j][0] = __uint_as_float(b.v[j][0] << 16); o.v[j][1] = __uint_as_float(b.v[j][0] & 0xffff0000u); o.v[j][2] = __uint_as_float(b.v[j][1] << 16); o.v[j][3] = __uint_as_float(b.v[j][1] & 0xffff0000u); }
  return o; }
DEVI void stf(float* r, int lane, const V16& o) { f32x4* q = (f32x4*)r + lane;
#pragma unroll
  for (int j = 0; j < 4; ++j) q[64 * j] = o.v[j]; }
DEVI void stb(bf16_t* r, int lane, const V16& o) { u32x2* q = (u32x2*)r + lane;
#pragma unroll
  for (int j = 0; j < 4; ++j) { u32x2 w; w[0] = cvtpk(o.v[j][0], o.v[j][1]); w[1] = cvtpk(o.v[j][2], o.v[j][3]); q[64 * j] = w; } }
DEVI float sumsq(const V16& o) { f32x4 s = o.v[0] * o.v[0];
#pragma unroll
  for (int j = 1; j < 4; ++j) s += o.v[j] * o.v[j];
  return wave_sum((s[0] + s[1]) + (s[2] + s[3])); }

DEVI void phase_prenorm0(const Params& p) {
  const int lane = ftid() & 63, gw = blockIdx.x * NWAVE + (ftid() >> 6), NGW = gridDim.x * NWAVE;
  const float* MOD = (const float*)(p.ws + WS_CTL + CTL_MOD); bf16_t* H = (bf16_t*)(p.ws + WS_H);
  const int rpw = (NROW + NGW - 1) / NGW;
  const int r0 = gw * rpw, r1 = min(r0 + rpw, NROW);
  if (r0 >= r1) return;
  const V16 g = ldf(p.in[L0_GPREMIX], lane);
  int cur = -1; V16 gs, sh;
  auto src = [&](int r) { return r < NLAT ? p.in[I_X] + (size_t)r * DM : p.in[I_CTX] + (size_t)(r - NLAT) * DM; };
  V16 xn = ldf(src(r0), lane), xn2 = xn;
  if (r0 + 1 < r1) xn2 = ldf(src(r0 + 1), lane);
  for (int r = r0; r < r1; ++r) {
    const V16 x = xn; xn = xn2; if (r + 2 < r1) xn2 = ldf(src(r + 2), lane);
    const int mr = row_modrow(r);
    if (mr != cur) { cur = mr; const float* m = MOD + (size_t)mr * 6144; const V16 sc = ldf(m + 1024, lane); sh = ldf(m, lane);
#pragma unroll
      for (int j = 0; j < 4; ++j) gs.v[j] = g.v[j] * (sc.v[j] + 1.f); }
    const float rr = rsqrtf(sumsq(x) * (1.f / DM) + EPS);
    V16 h;
#pragma unroll
    for (int j = 0; j < 4; ++j) h.v[j] = x.v[j] * rr * gs.v[j] + sh.v[j];
    if (QKV0_FP8) {
      unsigned* q8 = (unsigned*)((unsigned char*)H + (size_t)r * DM) + lane;
#pragma unroll
      for (int j = 0; j < 4; ++j) q8[64 * j] = nv::pack4_fp8(h.v[j][0] * nv::A8_SCALE, h.v[j][1] * nv::A8_SCALE, h.v[j][2] * nv::A8_SCALE, h.v[j][3] * nv::A8_SCALE);
    } else stb(H + (size_t)r * DM, lane, h);
  }
}

template <int ABL = 0> DEVI void phase_postmix(const Params& p, ldsp_t lds, int layer) {
  const int tid = ftid(), lane = tid & 63, gw = blockIdx.x * NWAVE + (tid >> 6), NGW = gridDim.x * NWAVE;
  const float* MOD = (const float*)(p.ws + WS_CTL + CTL_MOD) + (size_t)layer * 9 * 6144;
  const bf16_t* MIX = (const bf16_t*)(p.ws + (layer ? WS_MIX1 : WS_MIX0));
  bf16_t* H = (bf16_t*)(p.ws + WS_H); float* AFFT = (float*)(p.ws + WS_AFF); float* XC = (float*)(p.ws + WS_XC);
  const float* wr = p.in[layer ? L1_WROUTER : L0_WROUTER];
  FA_LAS f32x4* WL = (FA_LAS f32x4*)lds;
  for (int i = tid; i < 1024 * 4; i += NT) { const int k = i >> 2, e4 = i & 3; const int ln = (k & 255) >> 2, q = k & 3, j = k >> 8;
    WL[((j * 4 + q) * 4 + e4) * 64 + ln] = *(const f32x4*)(wr + (size_t)k * 16 + e4 * 4); }
  __syncthreads();
  const int nrow = layer ? NLAT : NROW;
  const int rpw = (nrow + NGW - 1) / NGW;
  const int r0 = gw * rpw, r1 = min(r0 + rpw, nrow);
  if (r0 >= r1) return;
  const V16 gpost = ldf(p.in[layer ? L1_GPOSTMIX : L0_GPOSTMIX], lane), gpre = ldf(p.in[layer ? L1_GPREFFN : L0_GPREFFN], lane);
  int cur = -1; V16 gg, gs, sh;
  auto xsrc = [&](int r) { return layer ? (const float*)(p.out + (size_t)r * DM) : (r < NLAT ? p.in[I_X] + (size_t)r * DM : p.in[I_CTX] + (size_t)(r - NLAT) * DM); };
  B16 mn = ldb_raw(MIX + (size_t)r0 * DM, lane); V16 xn = ldf(xsrc(r0), lane);
  B16 mn2 = mn; V16 xn2 = xn;
  if (r0 + 1 < r1) { mn2 = ldb_raw(MIX + (size_t)(r0 + 1) * DM, lane); xn2 = ldf(xsrc(r0 + 1), lane); }
  for (int r = r0; r < r1; ++r) {
    const B16 mb = mn; const V16 x = xn;
    mn = mn2; xn = xn2;
    if (r + 2 < r1) { mn2 = ldb_raw(MIX + (size_t)(r + 2) * DM, lane); xn2 = ldf(xsrc(r + 2), lane); }
    const int mr = row_modrow(r);
    if (mr != cur) { cur = mr; const float* m = MOD + (size_t)mr * 6144; const V16 gt = ldf(m + 2048, lane), sc = ldf(m + 4096, lane); sh = ldf(m + 3072, lane);
#pragma unroll
      for (int j = 0; j < 4; ++j) { gg.v[j] = gt.v[j] * gpost.v[j]; gs.v[j] = gpre.v[j] * (sc.v[j] + 1.f); } }
    V16 o = b2v(mb);
    const float rr = rsqrtf(sumsq(o) * (1.f / DM) + EPS);
#pragma unroll
    for (int j = 0; j < 4; ++j) o.v[j] = x.v[j] + gg.v[j] * (o.v[j] * rr);
    stf(r < NLAT ? p.out + (size_t)r * DM : XC + (size_t)(r - NLAT) * DM, lane, o);
    const float r2 = rsqrtf(sumsq(o) * (1.f / DM) + EPS);
    V16 h;
#pragma unroll
    for (int j = 0; j < 4; ++j) h.v[j] = o.v[j] * r2 * gs.v[j] + sh.v[j];
    if ((layer == 1 && MOE1_FP8) || (layer == 0 && MOE0_FP8)) {
      unsigned* q8 = (unsigned*)((unsigned char*)H + (size_t)r * DM) + lane;
#pragma unroll
      for (int j = 0; j < 4; ++j) q8[64 * j] = nv::pack4_fp8(h.v[j][0] * nv::A8_SCALE, h.v[j][1] * nv::A8_SCALE, h.v[j][2] * nv::A8_SCALE, h.v[j][3] * nv::A8_SCALE);
    } else stb(H + (size_t)r * DM, lane, h);
    if (ABL == 1) continue;
    f32x4 lg[4];
    int lo = lane; asm volatile("" : "+v"(lo));
#pragma unroll
    for (int e4 = 0; e4 < 4; ++e4) lg[e4] = (f32x4){0.f, 0.f, 0.f, 0.f};
#pragma unroll
    for (int j = 0; j < 4; ++j)
#pragma unroll
      for (int q = 0; q < 4; ++q) { const float hv = h.v[j][q];
#pragma unroll
        for (int e4 = 0; e4 < 4; ++e4) lg[e4] += WL[((j * 4 + q) * 4 + e4) * 64 + lo] * hv; }
    float a8[8], b4[4], c2[2], d;
#pragma unroll
    for (int i = 0; i < 8; ++i) { const auto s = __builtin_amdgcn_permlane32_swap(__float_as_uint(lg[i >> 2][i & 3]), __float_as_uint(lg[2 + (i >> 2)][i & 3]), false, false);
      a8[i] = __uint_as_float(s[0]) + __uint_as_float(s[1]); }
#pragma unroll
    for (int i = 0; i < 4; ++i) { const auto s = __builtin_amdgcn_permlane16_swap(__float_as_uint(a8[i]), __float_as_uint(a8[i + 4]), false, false);
      b4[i] = __uint_as_float(s[0]) + __uint_as_float(s[1]); }
    { const bool b3 = (lane & 8) != 0, b2 = (lane & 4) != 0;
#pragma unroll
      for (int i = 0; i < 2; ++i) { const float keep = b3 ? b4[i + 2] : b4[i], send = b3 ? b4[i] : b4[i + 2]; c2[i] = keep + dppf<DPP_MIRROR>(send); }
      const float keep = b2 ? c2[1] : c2[0], send = b2 ? c2[0] : c2[1]; d = keep + dppf<DPP_HMIRROR>(send); }
    d += dppf<DPP_XOR1>(d); d += dppf<DPP_XOR2>(d);
    const float mx = quad_max(d), ex = expf(d - mx), ssum = quad_sum(ex);
    if ((lane & 3) == 0) AFFT[(size_t)(lane >> 2) * NROW + r] = ex / ssum;
  }
}

DEVI void phase_combine(const Params& p, int layer) {
  const int tid = ftid(), lane = tid & 63, gw = blockIdx.x * NWAVE + (tid >> 6), NGW = gridDim.x * NWAVE;
  const float* MOD = (const float*)(p.ws + WS_CTL + CTL_MOD);
  const bf16_t* Y = (const bf16_t*)(p.ws + WS_Y); const int* SLOT = (const int*)(p.ws + WS_SLOT); const float* GV = (const float*)(p.ws + WS_GATEV);
  bf16_t* H = (bf16_t*)(p.ws + WS_H); float* XC = (float*)(p.ws + WS_XC);
  const int nrow = layer ? NLAT : NROW, erows = layer ? EROWS1 : EROWS0;
  const int rpw = (nrow + NGW - 1) / NGW;
  const int r0 = gw * rpw, r1 = min(r0 + rpw, nrow);
  if (r0 >= r1) return;
  const V16 gpost = ldf(p.in[layer ? L1_GPOSTFFN : L0_GPOSTFFN], lane);
  V16 g1; if (layer == 0) g1 = ldf(p.in[L1_GPREMIX], lane);
  int cur = -1; V16 gg, gs, sh;
  int sn = (lane < 16) ? SLOT[(size_t)r0 * 16 + lane] : -1;
  for (int r = r0; r < r1; ++r) {
    const int sl = sn; if (r + 1 < r1) sn = (lane < 16) ? SLOT[(size_t)(r + 1) * 16 + lane] : -1;
    float* xio = r < NLAT ? p.out + (size_t)r * DM : XC + (size_t)(r - NLAT) * DM;
    const V16 x = ldf(xio, lane);
    const int mr = row_modrow(r);
    if (mr != cur) { cur = mr; const float* m = MOD + (size_t)(layer * 9 + mr) * 6144; const V16 gt = ldf(m + 5120, lane);
#pragma unroll
      for (int j = 0; j < 4; ++j) gg.v[j] = gt.v[j] * gpost.v[j];
      if (layer == 0) { const float* m1 = MOD + (size_t)(9 + mr) * 6144; const V16 sc = ldf(m1 + 1024, lane); sh = ldf(m1, lane);
#pragma unroll
        for (int j = 0; j < 4; ++j) gs.v[j] = g1.v[j] * (sc.v[j] + 1.f); } }
    V16 o;
#pragma unroll
    for (int j = 0; j < 4; ++j) o.v[j] = (f32x4){0.f, 0.f, 0.f, 0.f};
    unsigned long long mask = __ballot(sl >= 0);
    while (mask) {
      const int e = __builtin_ctzll(mask); mask &= mask - 1;
      const int s = __shfl(sl, e);
      const float gate = GV[e * erows + s];
      const V16 y = b2v(ldb_raw(Y + ((size_t)e * erows + s) * DM, lane));
#pragma unroll
      for (int j = 0; j < 4; ++j) o.v[j] += y.v[j] * gate;
    }
    const float rr = rsqrtf(sumsq(o) * (1.f / DM) + EPS);
#pragma unroll
    for (int j = 0; j < 4; ++j) o.v[j] = x.v[j] + gg.v[j] * (o.v[j] * rr);
    stf(xio, lane, o);
    if (layer == 0) {
      const float r2 = rsqrtf(sumsq(o) * (1.f / DM) + EPS);
      V16 h;
#pragma unroll
      for (int j = 0; j < 4; ++j) h.v[j] = o.v[j] * r2 * gs.v[j] + sh.v[j];
      if (QKV1_FP8) {
        unsigned* q8 = (unsigned*)((unsigned char*)H + (size_t)r * DM) + lane;
#pragma unroll
        for (int j = 0; j < 4; ++j) q8[64 * j] = nv::pack4_fp8(h.v[j][0] * nv::A8_SCALE, h.v[j][1] * nv::A8_SCALE, h.v[j][2] * nv::A8_SCALE, h.v[j][3] * nv::A8_SCALE);
      } else stb(H + (size_t)r * DM, lane, h);
    }
  }
}
}
#define LAS __attribute__((address_space(3)))
#define XB_TMO      128
#define XB_XCNT(j)  (256  + 64 * (j))
#define XB_XSUB(j)  (1280 + 64 * (j))
#define XB_XGEN(j)  (2304 + 64 * (j))
#define XB_TOP      3328
#define XB_TOPGEN   3392
#define XCD_BAR_WORDS 3456
#define XB_SPIN_CAP (1u << 18)

__device__ __forceinline__ unsigned xb_ld(unsigned* p)              { return __hip_atomic_load(p, __ATOMIC_RELAXED, __HIP_MEMORY_SCOPE_AGENT); }
__device__ __forceinline__ unsigned xb_add(unsigned* p, unsigned v) { return __hip_atomic_fetch_add(p, v, __ATOMIC_RELAXED, __HIP_MEMORY_SCOPE_AGENT); }
__device__ __forceinline__ unsigned xb_xcc_id() { return (unsigned)__builtin_amdgcn_s_getreg((3 << 11) | 20) & 0xFu; }
#define XB_SPIN(cond, bar) do { unsigned _sp = 0; while (cond) { __builtin_amdgcn_s_sleep(1); \
    if ((++_sp & 255u) == 0u) { if (xb_ld(&(bar)[XB_TMO])) break; if (_sp > XB_SPIN_CAP) { atomicAdd(&(bar)[XB_TMO], 1u); break; } } } } while (0)

struct XcdBarrier {
    unsigned* bar; unsigned x;
    volatile LAS unsigned* st;
};

__device__ __forceinline__ XcdBarrier xcd_barrier_post(unsigned* bar, volatile LAS unsigned* st) {
    XcdBarrier b; b.bar = bar; b.x = xb_xcc_id(); b.st = st;
    if (threadIdx.x == 0) (void)xb_add(&bar[XB_XCNT(b.x)], 1u);
    return b;
}
__device__ __forceinline__ void xcd_barrier_complete(unsigned* bar, unsigned x, unsigned& nloc, unsigned& nx) {
    const unsigned G = gridDim.x * gridDim.y * gridDim.z;
    unsigned sum, cnt, mine, sp = 0u;
    for (;;) {
        sum = 0u; cnt = 0u; mine = 0u;
#pragma unroll
        for (unsigned j = 0; j < 16; ++j) { const unsigned c = xb_ld(&bar[XB_XCNT(j)]); sum += c; cnt += (c > 0u) ? 1u : 0u; mine = (j == x) ? c : mine; }
        if (sum == G) break;
        __builtin_amdgcn_s_sleep(1);
        if ((++sp & 255u) == 0u) { if (xb_ld(&bar[XB_TMO])) break; if (sp > XB_SPIN_CAP) { atomicAdd(&bar[XB_TMO], 1u); break; } }
    }
    nloc = mine > 0u ? mine : 1u; nx = cnt > 0u ? cnt : 1u;
}

__device__ __forceinline__ void xcd_barrier(const XcdBarrier& b) {
    asm volatile("s_waitcnt vmcnt(0)" ::: "memory");
    __syncthreads();
    if (threadIdx.x == 0) {
        unsigned* bar = b.bar;
        __builtin_amdgcn_s_waitcnt(0);
        unsigned nloc = b.st[0], nx = b.st[1];
        if (nloc == 0u) { xcd_barrier_complete(bar, b.x, nloc, nx); b.st[0] = nloc; b.st[1] = nx; }
        const unsigned old = xb_add(&bar[XB_XSUB(b.x)], 1u);
        const unsigned gen = old / nloc;
        if (old + 1u == (gen + 1u) * nloc) {
            __builtin_amdgcn_fence(__ATOMIC_RELEASE, "agent");
            asm volatile("s_waitcnt vmcnt(0)" ::: "memory");
            const unsigned og = xb_add(&bar[XB_TOP], 1u);
            const unsigned tg = og / nx;
            if (og + 1u == (tg + 1u) * nx) xb_add(&bar[XB_TOPGEN], 1u);
            else XB_SPIN(xb_ld(&bar[XB_TOPGEN]) == tg, bar);
            __builtin_amdgcn_fence(__ATOMIC_ACQUIRE, "agent");
            xb_add(&bar[XB_XGEN(b.x)], 1u);
            asm volatile("s_waitcnt vmcnt(0)" ::: "memory");
        } else {
            XB_SPIN(xb_ld(&bar[XB_XGEN(b.x)]) == gen, bar);
            __builtin_amdgcn_fence(__ATOMIC_ACQUIRE, "agent");
            asm volatile("s_waitcnt vmcnt(0)" ::: "memory");
        }
    }
    __syncthreads();
}


__device__ __forceinline__ void flat_barrier(unsigned* ctr, unsigned& epoch) {
    asm volatile("s_waitcnt vmcnt(0)" ::: "memory");
    __syncthreads();
    if (threadIdx.x == 0) {
        __builtin_amdgcn_fence(__ATOMIC_RELEASE, "agent");
        asm volatile("s_waitcnt vmcnt(0)" ::: "memory");
        (void)__hip_atomic_fetch_add(ctr, 1u, __ATOMIC_RELAXED, __HIP_MEMORY_SCOPE_AGENT);
        const unsigned target = (epoch + 1u) * (unsigned)gridDim.x; unsigned sp = 0;
        while (__hip_atomic_load(ctr, __ATOMIC_RELAXED, __HIP_MEMORY_SCOPE_AGENT) < target) { __builtin_amdgcn_s_sleep(1); if (++sp > (1u << 22)) break; }
        __builtin_amdgcn_fence(__ATOMIC_ACQUIRE, "agent");
        asm volatile("s_waitcnt vmcnt(0)" ::: "memory");
    }
    ++epoch;
    __syncthreads();
}

__device__ __forceinline__ void xcd_barrier2(const XcdBarrier& b) {
    asm volatile("s_waitcnt vmcnt(0)" ::: "memory");
    __syncthreads();
    if (threadIdx.x == 0) {
        unsigned* bar = b.bar;
        __builtin_amdgcn_s_waitcnt(0);
        unsigned nloc = b.st[0], nx = b.st[1];
        if (nloc == 0u) { xcd_barrier_complete(bar, b.x, nloc, nx); b.st[0] = nloc; b.st[1] = nx; }
        const unsigned old = xb_add(&bar[XB_XSUB(b.x)], 1u);
        const unsigned gen = old / nloc;
        if (old + 1u == (gen + 1u) * nloc) {
            __builtin_amdgcn_fence(__ATOMIC_RELEASE, "agent");
            asm volatile("s_waitcnt vmcnt(0)" ::: "memory");
            (void)xb_add(&bar[XB_TOP], 1u);
        }
        const unsigned target = (gen + 1u) * nx;
        XB_SPIN(xb_ld(&bar[XB_TOP]) < target, bar);
        __builtin_amdgcn_fence(__ATOMIC_ACQUIRE, "agent");
        asm volatile("s_waitcnt vmcnt(0)" ::: "memory");
    }
    __syncthreads();
}
constexpr int LDS_BYTES = 147456;
#define TAILFILL 1
#ifndef FAST_GEMM
#define FAST_GEMM 1
#endif
#ifndef FAST_TOPK
#define FAST_TOPK 1
#endif
#ifndef FAST_SSD
#define FAST_SSD 1
#endif
#ifndef FAST_ATTN
#define FAST_ATTN 1
#endif
__global__ void __launch_bounds__(NT) mega(Params p) {
  extern __shared__ __attribute__((aligned(16))) unsigned char lds_raw[];
  float* lds = (float*)lds_raw;
  fg::ldsp_t ldsp = (fg::ldsp_t)lds_raw;
  cg::grid_group grid = cg::this_grid();
  volatile LAS unsigned* bst = (volatile LAS unsigned*)((LAS unsigned char*)lds_raw + (LDS_BYTES - 64));
  if (threadIdx.x < 2) bst[threadIdx.x] = 0u;
  unsigned* barw = (unsigned*)(p.ws + WS_CTL + CTL_BAR);
  if (blockIdx.x == 0) { const int t0 = ftid(); for (int i = t0; i < XCD_BAR_WORDS; i += NT) barw[i] = 0u; }
  XcdBarrier xbar; xbar.bar = barw; xbar.x = 0; xbar.st = bst;
#ifdef FLATBAR
  unsigned fb_epoch = 0; unsigned* fb_ctr = barw + XCD_BAR_WORDS - 64;
#define GSYNC() flat_barrier(fb_ctr, fb_epoch)
#elif defined(XBAR2)
#define GSYNC() xcd_barrier2(xbar)
#else
#define GSYNC() xcd_barrier(xbar)
#endif
  nv::phase0(p, lds);                 grid.sync();
  xbar = xcd_barrier_post(barw, bst);
#ifdef DUP_SYNC
  for (int i = 0; i < 20; ++i) GSYNC();
#endif
#ifdef DUP_P0
  nv::phase0(p, lds);                 GSYNC();
#endif
  fr::phase_prenorm0(p);              GSYNC();
#ifdef DUP_PRENORM
  fr::phase_prenorm0(p); GSYNC();
#endif
#if FAST_GEMM
  fg::phase_qkv0(p, ldsp); GSYNC();
#ifdef DUP_QKV0
  fg::phase_qkv0(p, ldsp); GSYNC();
#endif
#else
  nv::phase_qkv0(p, lds);             GSYNC();
#endif
#if FAST_ATTN
  fa::phase_attnA(p, ldsp); fa::phase_attnB(p, ldsp); GSYNC();
#ifdef DUP_A
  fa::phase_attnA<DUP_A>(p, ldsp); GSYNC();
#endif
#ifdef DUP_B
  fa::phase_attnB<DUP_B>(p, ldsp); GSYNC();
#endif
#else
  nv::phase_attn0(p, lds);            GSYNC();
#endif
#if FAST_GEMM
#ifdef TAILFILL
  fg::phase_outproj(p, ldsp, 0); nv::convert_moe_tail8(p, 0, 1, lds, NROW / 256 * (DM / 256)); GSYNC();
#else
  fg::phase_outproj(p, ldsp, 0); GSYNC();
#endif
#ifdef DUP_OUT0
  fg::phase_outproj(p, ldsp, 0); GSYNC();
#endif
#else
  nv::phase_outproj(p, lds, 0);       GSYNC();
#endif
  fr::phase_postmix(p, ldsp, 0);            GSYNC();
#ifdef DUP_POSTMIX0
  fr::phase_postmix<DUP_POSTMIX0>(p, ldsp, 0); GSYNC();
#endif
#if FAST_TOPK
  ft::phase_topk(p, ldsp, 0);         GSYNC();
#ifdef DUP_TOPK0
  ft::phase_topk(p, ldsp, 0);         GSYNC();
#endif
#else
  nv::phase_topk(p, lds, 0);          GSYNC();
  fg::phase_gather(p, 0);             GSYNC();
#endif
#if FAST_GEMM
  fg::phase_moe_up8(p, ldsp, 0);      GSYNC();
#ifdef DUP_UP0
  fg::phase_moe_up8(p, ldsp, 0); GSYNC();
#endif
  fg::phase_moe_down8(p, ldsp, 0);    GSYNC();
#ifdef DUP_DOWN0
  fg::phase_moe_down8(p, ldsp, 0); GSYNC();
#endif
#else
  nv::phase_moe_up(p, lds, 0);        GSYNC();
  nv::phase_moe_down(p, lds, 0);      GSYNC();
#endif
#ifdef TAILFILL
  fr::phase_combine(p, 0); GSYNC();
#else
  fr::phase_combine(p, 0); nv::convert_moe_tail(p, 1, 0, lds, 0); nv::convert_moe_tail(p, 1, 1, lds, 0); GSYNC();
#endif
#if FAST_GEMM
#ifdef TAILFILL
  fg::phase_qkv1(p, ldsp); GSYNC();
#else
  fg::phase_qkv1(p, ldsp); GSYNC();
#endif
#else
  nv::phase_qkv1(p, lds);             GSYNC();
#endif
#if FAST_ATTN
#if FAST_SSD
#ifdef TAILFILL
  fs::phase_conv(p); GSYNC();
#else
  fs::phase_conv(p); GSYNC();
#endif
#else
  nv::phase_conv_swa(p, lds, true); GSYNC();
#endif
#else
  nv::phase_conv_swa(p, lds, true);   GSYNC();
#endif
#if FAST_SSD
  fs::phase_ssd(p, ldsp); fa::phase_attnC(p, ldsp, (int*)(p.ws + WS_CTL + CTL_QC));
  nv::convert_moe_tail8(p, 1, 0, lds, NB * 2 * 8); nv::convert_moe_tail8(p, 1, 1, lds, NB * 2 * 8); GSYNC();
#ifdef DUP_SSD
  fs::phase_ssd<DUP_SSD>(p, ldsp);             GSYNC();
#endif
  fs::phase_ssd_out(p);               GSYNC();
#else
  nv::phase_ssd(p, lds);              GSYNC();
  nv::phase_ssd_out(p);               GSYNC();
#endif
#if FAST_GEMM
  fg::phase_outproj(p, ldsp, 1);      GSYNC();
#else
  nv::phase_outproj(p, lds, 1);       GSYNC();
#endif
  fr::phase_postmix(p, ldsp, 1);            GSYNC();
#if FAST_TOPK
  ft::phase_topk(p, ldsp, 1);         GSYNC();
#ifdef DUP_TOPK1
  ft::phase_topk(p, ldsp, 1);         GSYNC();
#endif
#else
  nv::phase_topk(p, lds, 1);          GSYNC();
  fg::phase_gather(p, 1);             GSYNC();
#endif
#if FAST_GEMM
  fg::phase_moe_up8(p, ldsp, 1);      GSYNC();
  fg::phase_moe_down8(p, ldsp, 1);    GSYNC();
#else
  nv::phase_moe_up(p, lds, 1);        GSYNC();
  nv::phase_moe_down(p, lds, 1);      GSYNC();
#endif
  fr::phase_combine(p, 1);
}


extern "C" void kernel_launch(void* const* d_in, const int* in_sizes, int n_in, void* d_out, int out_size,
                              void* d_ws, size_t ws_size, hipStream_t stream) {
  static int grid_blocks = 0;
  if (!grid_blocks) {
    int dev = 0, cus = 0, per_cu = 0;
    (void)hipGetDevice(&dev);
    (void)hipDeviceGetAttribute(&cus, hipDeviceAttributeMultiprocessorCount, dev);
    (void)hipFuncSetAttribute((const void*)mega, hipFuncAttributeMaxDynamicSharedMemorySize, LDS_BYTES);
    (void)hipOccupancyMaxActiveBlocksPerMultiprocessor(&per_cu, (const void*)mega, NT, LDS_BYTES);
    if (per_cu < 1) { fprintf(stderr, "kernel_launch: occupancy query says %d blocks/CU\n", per_cu); per_cu = 1; }
    grid_blocks = cus;
    if (n_in != 43 || ws_size < WS_END) fprintf(stderr, "kernel_launch: unexpected n_in %d / ws_size %zu (need %zu)\n", n_in, ws_size, (size_t)WS_END);
  }
  Params p{};
  for (int i = 0; i < 43; ++i) p.in[i] = (const float*)d_in[i];
  p.out = (float*)d_out; p.ws = (unsigned char*)d_ws;
  void* args[] = {&p};
  hipError_t e = hipLaunchCooperativeKernel((void*)mega, dim3(grid_blocks), dim3(NT), args, LDS_BYTES, stream);
  if (e != hipSuccess) fprintf(stderr, "cooperative launch failed: %s (grid %d)\n", hipGetErrorString(e), grid_blocks);
}
```

```cpp
#include <hip/hip_runtime.h>
#include <hip/hip_cooperative_groups.h>
#include <cstdio>
#include <cstdint>
namespace cg = cooperative_groups;

typedef unsigned short bf16_t;
#define DEVI __device__ __forceinline__

constexpr int NT = 512, NWAVE = 8;
constexpr int NB = 8, SEQ = 4096, DM = 1024, CTXL = 256;
constexpr int NLAT = NB * SEQ, NCTX = NB * CTXL, NROW = NLAT + NCTX;
constexpr int NE = 16;
constexpr int CAP_L = 512, CAP_C = 32;
constexpr int EROWS0 = NB * CAP_L + NB * CAP_C;
constexpr int EROWS1 = NB * CAP_L;
constexpr int N_IN0 = 3072, N_IN1 = 2320, N_IN1P = 2560;
constexpr float EPS = 1e-6f;

constexpr size_t MiB = 1u << 20;
constexpr size_t WS_CTL = 0;
constexpr size_t WS_WIN0 = 1 * MiB;
constexpr size_t WS_WIN1 = 7 * MiB;
constexpr size_t WS_WOUT0 = 12 * MiB, WS_WOUT1 = 14 * MiB;
constexpr size_t WS_WGU = 16 * MiB;
constexpr size_t WS_WD = 80 * MiB;
constexpr size_t WS_XC = 112 * MiB;
constexpr size_t WS_H = 120 * MiB;
constexpr size_t WS_AFF = 188 * MiB;
constexpr size_t WS_SLOT = 191 * MiB;
constexpr size_t WS_IDX = 194 * MiB;
constexpr size_t WS_GATEV = 195 * MiB;
constexpr size_t WS_BIG = 196 * MiB;
constexpr size_t WS_QKV0 = WS_BIG;
constexpr size_t WS_ATT0 = WS_BIG + 204 * MiB;
constexpr size_t WS_MIX0 = WS_BIG + 272 * MiB;
constexpr size_t WS_XG = WS_BIG;
constexpr size_t WS_HID = WS_BIG + 136 * MiB;
constexpr size_t WS_Y = WS_BIG;
constexpr size_t WS_P1 = WS_BIG;
constexpr size_t WS_DT = WS_BIG + 153 * MiB;
constexpr size_t WS_U = WS_BIG + 156 * MiB;
constexpr size_t WS_MIX1 = WS_U;
constexpr size_t WS_ATT1 = WS_BIG + 224 * MiB;
constexpr size_t WS_YS = WS_BIG + 292 * MiB;
constexpr size_t WS_CUMG = WS_BIG + 356 * MiB;
constexpr size_t WS_DTG = WS_BIG + 359 * MiB;
constexpr size_t WS_VT = WS_BIG + 340 * MiB;
constexpr size_t WS_VTB = WS_BIG + 362 * MiB;
constexpr size_t WS_END = WS_BIG + 380 * MiB;
constexpr size_t CTL_MOD = 4096;
constexpr size_t CTL_ROPE = CTL_MOD + 2 * 9 * 6144 * 4;
constexpr size_t CTL_LAM = CTL_ROPE + 64 * 16 * 2 * 4;
constexpr size_t CTL_QC = CTL_LAM + 64;
constexpr size_t CTL_BAR = 512 * 1024;

struct Params {
  const float* in[43];
  float* out;
  unsigned char* ws;
};

enum {
  I_X = 0, I_C, I_CTX, I_CCTX,
  L0_WMOD, L0_BMOD, L0_GPREMIX, L0_GPOSTMIX, L0_GPREFFN, L0_GPOSTFFN, L0_WIN, L0_WOUT,
  L0_LAMQ1, L0_LAMK1, L0_LAMQ2, L0_LAMK2, L0_SUBLN, L0_RPB, L0_WROUTER, L0_WGATE, L0_WUP, L0_WDOWN,
  L1_WMOD, L1_BMOD, L1_GPREMIX, L1_GPOSTMIX, L1_GPREFFN, L1_GPOSTFFN, L1_WIN, L1_WOUT,
  L1_SINKS, L1_CONVW, L1_CONVB, L1_ALOGF, L1_ALOGB, L1_DTBF, L1_DTBB, L1_DSKIP, L1_GNORM,
  L1_WROUTER, L1_WGATE, L1_WUP, L1_WDOWN
};

DEVI int ftid() { int t = threadIdx.x; asm volatile("" : "+v"(t)); return t; }
DEVI float bf2f(bf16_t v) { return __uint_as_float(((unsigned)v) << 16); }
DEVI bf16_t f2bf(float f) { unsigned u = __float_as_uint(f); return (bf16_t)((u + 0x7fffu + ((u >> 16) & 1u)) >> 16); }
DEVI unsigned pk2(float lo, float hi) { return (unsigned)f2bf(lo) | ((unsigned)f2bf(hi) << 16); }
DEVI float silu_f(float v) { return v / (1.f + __expf(-v)); }
template <int CTRL> DEVI float dppf(float v) { return __uint_as_float((unsigned)__builtin_amdgcn_update_dpp(0, (int)__float_as_uint(v), CTRL, 0xf, 0xf, true)); }
constexpr int DPP_XOR1 = 0xB1, DPP_XOR2 = 0x4E, DPP_HMIRROR = 0x141, DPP_MIRROR = 0x140;
DEVI float wave_sum(float v) {
  v += dppf<DPP_XOR1>(v); v += dppf<DPP_XOR2>(v); v += dppf<DPP_HMIRROR>(v); v += dppf<DPP_MIRROR>(v);
  { const auto s = __builtin_amdgcn_permlane16_swap(__float_as_uint(v), __float_as_uint(v), false, false); v = __uint_as_float(s[0]) + __uint_as_float(s[1]); }
  { const auto s = __builtin_amdgcn_permlane32_swap(__float_as_uint(v), __float_as_uint(v), false, false); v = __uint_as_float(s[0]) + __uint_as_float(s[1]); }
  return v;
}
DEVI float half_sum(float v) {
  v += dppf<DPP_XOR1>(v); v += dppf<DPP_XOR2>(v); v += dppf<DPP_HMIRROR>(v); v += dppf<DPP_MIRROR>(v);
  { const auto s = __builtin_amdgcn_permlane16_swap(__float_as_uint(v), __float_as_uint(v), false, false); v = __uint_as_float(s[0]) + __uint_as_float(s[1]); }
  return v;
}
template <int CTRL, int ROWMASK> DEVI float dppf0(float v) { return __uint_as_float((unsigned)__builtin_amdgcn_update_dpp(0, (int)__float_as_uint(v), CTRL, ROWMASK, 0xf, false)); }
DEVI float wave_scan_incl(float v) {
  v += dppf0<0x111, 0xf>(v); v += dppf0<0x112, 0xf>(v); v += dppf0<0x114, 0xf>(v); v += dppf0<0x118, 0xf>(v);
  v += dppf0<0x142, 0xa>(v); v += dppf0<0x143, 0xc>(v);
  return v;
}
template <int CTRL, int ROWMASK> DEVI int dppi0(int v) { return __builtin_amdgcn_update_dpp(0, v, CTRL, ROWMASK, 0xf, false); }
DEVI int wave_scan_incl_i(int v) {
  v += dppi0<0x111, 0xf>(v); v += dppi0<0x112, 0xf>(v); v += dppi0<0x114, 0xf>(v); v += dppi0<0x118, 0xf>(v);
  v += dppi0<0x142, 0xa>(v); v += dppi0<0x143, 0xc>(v);
  return v;
}
DEVI float quad_sum(float v) {
  v += dppf<DPP_HMIRROR>(v); v += dppf<DPP_MIRROR>(v);
  { const auto s = __builtin_amdgcn_permlane16_swap(__float_as_uint(v), __float_as_uint(v), false, false); v = __uint_as_float(s[0]) + __uint_as_float(s[1]); }
  { const auto s = __builtin_amdgcn_permlane32_swap(__float_as_uint(v), __float_as_uint(v), false, false); v = __uint_as_float(s[0]) + __uint_as_float(s[1]); }
  return v;
}
DEVI float quad_max(float v) {
  v = fmaxf(v, dppf<DPP_HMIRROR>(v)); v = fmaxf(v, dppf<DPP_MIRROR>(v));
  { const auto s = __builtin_amdgcn_permlane16_swap(__float_as_uint(v), __float_as_uint(v), false, false); v = fmaxf(__uint_as_float(s[0]), __uint_as_float(s[1])); }
  { const auto s = __builtin_amdgcn_permlane32_swap(__float_as_uint(v), __float_as_uint(v), false, false); v = fmaxf(__uint_as_float(s[0]), __uint_as_float(s[1])); }
  return v;
}
DEVI float wave_max(float v) {
  v = fmaxf(v, dppf<DPP_XOR1>(v)); v = fmaxf(v, dppf<DPP_XOR2>(v)); v = fmaxf(v, dppf<DPP_HMIRROR>(v)); v = fmaxf(v, dppf<DPP_MIRROR>(v));
  { const auto s = __builtin_amdgcn_permlane16_swap(__float_as_uint(v), __float_as_uint(v), false, false); v = fmaxf(__uint_as_float(s[0]), __uint_as_float(s[1])); }
  { const auto s = __builtin_amdgcn_permlane32_swap(__float_as_uint(v), __float_as_uint(v), false, false); v = fmaxf(__uint_as_float(s[0]), __uint_as_float(s[1])); }
  return v;
}
DEVI int row_modrow(int r) { return r < NLAT ? (r >> 12) : 8; }
#ifndef QKV0_FP8
#define QKV0_FP8 1
#endif
#ifndef OUT_FP8
#define OUT_FP8 0
#endif
#ifndef QKV1_FP8
#define QKV1_FP8 0
#endif
namespace nv {

DEVI void transpose_item(const float* W, int K, int N, bf16_t* WT, int row_off, int row_mul, float* scr, int item, int lane, int Npad) {
  const int nblk = Npad / 32, kb = item / nblk, nb = item % nblk, k0 = 64 * kb, n0 = 32 * nb;
  const int n = n0 + (lane & 31); const bool ok = n < N;
  const float* src = W + (size_t)(k0 + (lane >> 5)) * N + (ok ? n : 0);
  float v[32];
#pragma unroll
  for (int i = 0; i < 32; ++i) v[i] = src[(size_t)(2 * i) * N];
#pragma unroll
  for (int i = 0; i < 32; ++i) scr[(2 * i + (lane >> 5)) * 33 + (lane & 31)] = ok ? v[i] : 0.f;
  __builtin_amdgcn_s_waitcnt(0); __builtin_amdgcn_wave_barrier();
  const int c = lane & 7;
#pragma unroll
  for (int j = 0; j < 4; ++j) {
    const int nn = (lane >> 3) + 8 * j; const float* s = scr + (8 * c) * 33 + nn;
    uint4 o; o.x = pk2(s[0 * 33], s[1 * 33]); o.y = pk2(s[2 * 33], s[3 * 33]); o.z = pk2(s[4 * 33], s[5 * 33]); o.w = pk2(s[6 * 33], s[7 * 33]);
    *(uint4*)(WT + (size_t)(row_off + (n0 + nn) * row_mul) * K + k0 + 8 * c) = o;
  }
  __builtin_amdgcn_s_waitcnt(0); __builtin_amdgcn_wave_barrier();
}

DEVI void convert_moe_part(const Params& p, int layer, int which, float* scr, int gw, int NGW, int lane) {
  const float* wg = p.in[layer ? L1_WGATE : L0_WGATE]; const float* wu = p.in[layer ? L1_WUP : L0_WUP]; const float* wd = p.in[layer ? L1_WDOWN : L0_WDOWN];
  bf16_t* WGU = (bf16_t*)(p.ws + WS_WGU); bf16_t* WD = (bf16_t*)(p.ws + WS_WD);
  constexpr int IPM = 16 * 32;
  if (which == 0) {
    for (int it = gw; it < NE * 2 * IPM; it += NGW) {
      const int e = it / (2 * IPM), r = it % (2 * IPM), gu = r / IPM, item = r % IPM;
      transpose_item((gu ? wu : wg) + (size_t)e * DM * DM, DM, DM, WGU + (size_t)e * 2048 * DM, gu, 2, scr, item, lane, DM);
    }
  } else {
    for (int it = gw; it < NE * IPM; it += NGW) {
      const int e = it / IPM, item = it % IPM;
      transpose_item(wd + (size_t)e * DM * DM, DM, DM, WD + (size_t)e * DM * DM, 0, 1, scr, item, lane, DM);
    }
  }
}
DEVI void convert_moe_tail(const Params& p, int layer, int which, float* lds, int nunits) {
  const int first = nunits % (int)gridDim.x;
  if ((int)blockIdx.x < first) return;
  const int w = ftid() >> 6;
  convert_moe_part(p, layer, which, lds + w * (64 * 33), ((int)blockIdx.x - first) * NWAVE + w, ((int)gridDim.x - first) * NWAVE, ftid() & 63);
}


constexpr float W8_SCALE = 64.f, A8_SCALE = 4.f;
constexpr int W8_E8M0 = 0x79797979, A8_E8M0 = 0x7d7d7d7d;
DEVI unsigned pack4_fp8(float a, float b, float c, float d) {
  a = fminf(fmaxf(a, -448.f), 448.f); b = fminf(fmaxf(b, -448.f), 448.f); c = fminf(fmaxf(c, -448.f), 448.f); d = fminf(fmaxf(d, -448.f), 448.f);
  int w = 0; w = __builtin_amdgcn_cvt_pk_fp8_f32(a, b, w, false); w = __builtin_amdgcn_cvt_pk_fp8_f32(c, d, w, true); return (unsigned)w; }
DEVI void transpose_item8(const float* W, int K, int N, unsigned char* WT, int row_off, int row_mul, float* scr, int item, int lane, int Npad = 0) {
  if (Npad == 0) Npad = N;
  const int nblk = Npad / 32, kb = item / nblk, nb = item % nblk, k0 = 64 * kb, n0 = 32 * nb;
  const int nn0 = n0 + (lane & 31); const bool ok = nn0 < N;
  const float* src = W + (size_t)(k0 + (lane >> 5)) * N + (ok ? nn0 : 0);
  float v[32];
#pragma unroll
  for (int i = 0; i < 32; ++i) v[i] = src[(size_t)(2 * i) * N];
#pragma unroll
  for (int i = 0; i < 32; ++i) scr[(2 * i + (lane >> 5)) * 33 + (lane & 31)] = ok ? v[i] * W8_SCALE : 0.f;
  __builtin_amdgcn_s_waitcnt(0); __builtin_amdgcn_wave_barrier();
  const int c = lane & 7;
#pragma unroll
  for (int j = 0; j < 4; ++j) {
    const int nn = (lane >> 3) + 8 * j; const float* s = scr + (8 * c) * 33 + nn;
    uint2 o; o.x = pack4_fp8(s[0 * 33], s[1 * 33], s[2 * 33], s[3 * 33]); o.y = pack4_fp8(s[4 * 33], s[5 * 33], s[6 * 33], s[7 * 33]);
    *(uint2*)(WT + (size_t)(row_off + (n0 + nn) * row_mul) * K + k0 + 8 * c) = o;
  }
  __builtin_amdgcn_s_waitcnt(0); __builtin_amdgcn_wave_barrier();
}
DEVI void convert_moe_part8(const Params& p, int layer, int which, float* scr, int gw, int NGW, int lane) {
  const float* wg = p.in[layer ? L1_WGATE : L0_WGATE]; const float* wu = p.in[layer ? L1_WUP : L0_WUP]; const float* wd = p.in[layer ? L1_WDOWN : L0_WDOWN];
  unsigned char* WGU = (unsigned char*)(p.ws + WS_WGU); unsigned char* WD = (unsigned char*)(p.ws + WS_WD);
  constexpr int IPM = 16 * 32;
  if (which == 0) {
    for (int it = gw; it < NE * 2 * IPM; it += NGW) { const int e = it / (2 * IPM), r = it % (2 * IPM), gu = r / IPM, item = r % IPM;
      transpose_item8((gu ? wu : wg) + (size_t)e * DM * DM, DM, DM, WGU + (size_t)e * 2048 * DM, gu, 2, scr, item, lane); }
  } else {
    for (int it = gw; it < NE * IPM; it += NGW) { const int e = it / IPM, item = it % IPM;
      transpose_item8(wd + (size_t)e * DM * DM, DM, DM, WD + (size_t)e * DM * DM, 0, 1, scr, item, lane); }
  }
}
DEVI void convert_moe_tail8(const Params& p, int layer, int which, float* lds, int nunits) {
  const int first = nunits % (int)gridDim.x;
  if ((int)blockIdx.x < first) return;
  const int w = ftid() >> 6;
  convert_moe_part8(p, layer, which, lds + w * (64 * 33), ((int)blockIdx.x - first) * NWAVE + w, ((int)gridDim.x - first) * NWAVE, ftid() & 63);
}

DEVI void phase0(const Params& p, float* lds) {
  const int tid = ftid(), lane = tid & 63, wave = tid >> 6;
  const int gw = blockIdx.x * NWAVE + wave, NGW = gridDim.x * NWAVE;
  for (int it = blockIdx.x; it < 2 * 96; it += gridDim.x) {
    const int layer = it / 96, j0 = (it % 96) * 64;
    float* sc = lds;
    float* red = lds + 9 * 1024;
    __syncthreads();
    for (int i = tid; i < 9 * 1024; i += NT) { const int r = i >> 10, k = i & 1023; const float v = (r < 8) ? p.in[I_C][r * 1024 + k] : p.in[I_CCTX][k]; sc[i] = silu_f(v); }
    __syncthreads();
    const float* wm = p.in[layer ? L1_WMOD : L0_WMOD];
    float acc[9];
#pragma unroll
    for (int r = 0; r < 9; ++r) acc[r] = 0.f;
    for (int k0 = wave * 128; k0 < wave * 128 + 128; k0 += 16) {
      float w[16];
#pragma unroll
      for (int i = 0; i < 16; ++i) w[i] = wm[(size_t)(k0 + i) * 6144 + j0 + lane];
#pragma unroll
      for (int i = 0; i < 16; ++i)
#pragma unroll
        for (int r = 0; r < 9; ++r) acc[r] += sc[r * 1024 + k0 + i] * w[i];
    }
#pragma unroll
    for (int r = 0; r < 9; ++r) red[(wave * 9 + r) * 64 + lane] = acc[r];
    __syncthreads();
    for (int i = tid; i < 9 * 64; i += NT) {
      const int r = i >> 6, c = i & 63; float s = 0.f;
      for (int w = 0; w < 8; ++w) s += red[(w * 9 + r) * 64 + c];
      float* MOD = (float*)(p.ws + WS_CTL + CTL_MOD);
      MOD[(layer * 9 + r) * 6144 + j0 + c] = s + p.in[layer ? L1_BMOD : L0_BMOD][j0 + c];
    }
    __syncthreads();
  }
  if (blockIdx.x == gridDim.x - 1) {
    float* ROPE = (float*)(p.ws + WS_CTL + CTL_ROPE);
    for (int i = tid; i < 64 * 16; i += NT) {
      const int pos = i >> 4, f = i & 15;
      const float inv = powf(10000.f, -(float)f / 16.f);
      const float ang = (float)pos * inv;
      ROPE[2 * i] = cosf(ang); ROPE[2 * i + 1] = sinf(ang);
    }
    if (wave == 0) {
      float a = p.in[L0_LAMQ1][lane] * p.in[L0_LAMK1][lane], b = p.in[L0_LAMQ2][lane] * p.in[L0_LAMK2][lane];
      a = wave_sum(a); b = wave_sum(b);
      if (lane == 0) { float* LAM = (float*)(p.ws + WS_CTL + CTL_LAM); LAM[0] = expf(a) - expf(b) + 0.2f; *(int*)(p.ws + WS_CTL + CTL_QC) = 0; }
    }
  }
  __syncthreads();
  float* scr = lds + wave * (64 * 33);
  {
    constexpr int I_IN0 = 16 * (N_IN0 / 32), I_OUT = 16 * 32, I_IN1 = 16 * (N_IN1P / 32);
    constexpr int NITEMS = I_IN0 + I_OUT + I_IN1 + I_OUT;
    for (int it = gw; it < NITEMS; it += NGW) {
      int r = it;
      if (r < I_IN0) { if (QKV0_FP8) transpose_item8(p.in[L0_WIN], DM, N_IN0, (unsigned char*)(p.ws + WS_WIN0), 0, 1, scr, r, lane); else transpose_item(p.in[L0_WIN], DM, N_IN0, (bf16_t*)(p.ws + WS_WIN0), 0, 1, scr, r, lane, N_IN0); continue; } r -= I_IN0;
      if (r < I_OUT) { if (OUT_FP8) transpose_item8(p.in[L0_WOUT], DM, DM, (unsigned char*)(p.ws + WS_WOUT0), 0, 1, scr, r, lane); else transpose_item(p.in[L0_WOUT], DM, DM, (bf16_t*)(p.ws + WS_WOUT0), 0, 1, scr, r, lane, DM); continue; } r -= I_OUT;
      if (r < I_IN1) { if (QKV1_FP8) transpose_item8(p.in[L1_WIN], DM, N_IN1, (unsigned char*)(p.ws + WS_WIN1), 0, 1, scr, r, lane, N_IN1P); else transpose_item(p.in[L1_WIN], DM, N_IN1, (bf16_t*)(p.ws + WS_WIN1), 0, 1, scr, r, lane, N_IN1P); continue; } r -= I_IN1;
      if (OUT_FP8) transpose_item8(p.in[L1_WOUT], DM, DM, (unsigned char*)(p.ws + WS_WOUT1), 0, 1, scr, r, lane); else transpose_item(p.in[L1_WOUT], DM, DM, (bf16_t*)(p.ws + WS_WOUT1), 0, 1, scr, r, lane, DM);
    }
  }
  convert_moe_part8(p, 0, 0, scr, gw, NGW, lane);
#ifndef TAILFILL
  convert_moe_part8(p, 0, 1, scr, gw, NGW, lane);
#endif
}

struct Row16 { float4 v[4]; };
DEVI Row16 ld_row_f32(const float* r, int lane) { Row16 o; const float4* q = (const float4*)r + lane;
#pragma unroll
  for (int j = 0; j < 4; ++j) o.v[j] = q[64 * j]; return o; }
DEVI Row16 ld_row_bf16(const bf16_t* r, int lane) { Row16 o; const uint2* q = (const uint2*)r + lane;
#pragma unroll
  for (int j = 0; j < 4; ++j) { const uint2 w = q[64 * j]; o.v[j] = make_float4(__uint_as_float(w.x << 16), __uint_as_float(w.x & 0xffff0000u), __uint_as_float(w.y << 16), __uint_as_float(w.y & 0xffff0000u)); }
  return o; }
DEVI void st_row_f32(float* r, int lane, const Row16& o) { float4* q = (float4*)r + lane;
#pragma unroll
  for (int j = 0; j < 4; ++j) q[64 * j] = o.v[j]; }
DEVI void st_row_bf16(bf16_t* r, int lane, const Row16& o) { uint2* q = (uint2*)r + lane;
#pragma unroll
  for (int j = 0; j < 4; ++j) q[64 * j] = make_uint2(pk2(o.v[j].x, o.v[j].y), pk2(o.v[j].z, o.v[j].w)); }
DEVI float row_sumsq(const Row16& o) { float s = 0.f;
#pragma unroll
  for (int j = 0; j < 4; ++j) s += o.v[j].x * o.v[j].x + o.v[j].y * o.v[j].y + o.v[j].z * o.v[j].z + o.v[j].w * o.v[j].w;
  return wave_sum(s); }
#define ROW_FOR4(expr) _Pragma("unroll") for (int j = 0; j < 4; ++j) { { float& e = o.v[j].x; const float a = A.v[j].x, b = Bv.v[j].x, c = Cv.v[j].x; expr; } { float& e = o.v[j].y; const float a = A.v[j].y, b = Bv.v[j].y, c = Cv.v[j].y; expr; } { float& e = o.v[j].z; const float a = A.v[j].z, b = Bv.v[j].z, c = Cv.v[j].z; expr; } { float& e = o.v[j].w; const float a = A.v[j].w, b = Bv.v[j].w, c = Cv.v[j].w; expr; } }

DEVI Row16 norm_mod(const Row16& x, const float* g, const float* sc, const float* sh, int lane) {
  const float r = rsqrtf(row_sumsq(x) * (1.f / DM) + EPS);
  Row16 o = x; const Row16 A = ld_row_f32(g, lane), Bv = ld_row_f32(sc, lane), Cv = ld_row_f32(sh, lane);
  ROW_FOR4(e = e * r * a * (1.f + b) + c);
  return o;
}

DEVI void phase_prenorm0(const Params& p) {
  const int lane = ftid() & 63, gw = blockIdx.x * NWAVE + (ftid() >> 6), NGW = gridDim.x * NWAVE;
  const float* MOD = (const float*)(p.ws + WS_CTL + CTL_MOD);
  bf16_t* H = (bf16_t*)(p.ws + WS_H);
  for (int r = gw; r < NROW; r += NGW) {
    const float* src = r < NLAT ? p.in[I_X] + (size_t)r * DM : p.in[I_CTX] + (size_t)(r - NLAT) * DM;
    const float* m = MOD + (size_t)row_modrow(r) * 6144;
    const Row16 x = ld_row_f32(src, lane);
    const Row16 h = norm_mod(x, p.in[L0_GPREMIX], m + 1024, m, lane);
    st_row_bf16(H + (size_t)r * DM, lane, h);
  }
}

template <class AF, class EF>
DEVI void gemm_tile(float* lds, const bf16_t* Bt, int n0, int K, AF arow, EF epi) {
  const int tid = ftid(), ty = tid >> 4, tx = tid & 15;
  float (*As)[132] = (float (*)[132])lds;
  float (*Bs)[68] = (float (*)[68])(lds + 16 * 132);
  float acc[4][4];
#pragma unroll
  for (int i = 0; i < 4; ++i)
#pragma unroll
    for (int j = 0; j < 4; ++j) acc[i][j] = 0.f;
  const int ar = tid >> 2, ak = (tid & 3) * 4;
  const int br = tid >> 3, bk = (tid & 7) * 2;
  const bf16_t* ap = arow(ar) + ak;
  const bf16_t* bp = Bt + (size_t)(n0 + br) * K + bk;
  for (int k0 = 0; k0 < K; k0 += 16) {
    const uint2 av = *(const uint2*)(ap + k0);
    const unsigned bv = *(const unsigned*)(bp + k0);
    __syncthreads();
    As[ak + 0][ar] = __uint_as_float(av.x << 16); As[ak + 1][ar] = __uint_as_float(av.x & 0xffff0000u);
    As[ak + 2][ar] = __uint_as_float(av.y << 16); As[ak + 3][ar] = __uint_as_float(av.y & 0xffff0000u);
    Bs[bk + 0][br] = __uint_as_float(bv << 16); Bs[bk + 1][br] = __uint_as_float(bv & 0xffff0000u);
    __syncthreads();
#pragma unroll
    for (int kk = 0; kk < 16; ++kk) {
      const float4 a = *(const float4*)&As[kk][ty * 4]; const float4 b = *(const float4*)&Bs[kk][tx * 4];
      const float aa[4] = {a.x, a.y, a.z, a.w}, bb[4] = {b.x, b.y, b.z, b.w};
#pragma unroll
      for (int i = 0; i < 4; ++i)
#pragma unroll
        for (int j = 0; j < 4; ++j) acc[i][j] += aa[i] * bb[j];
    }
  }
#pragma unroll
  for (int i = 0; i < 4; ++i) epi(ty * 4 + i, n0 + tx * 4, acc[i]);
}

DEVI void rope_pair(const float* ROPE, int t, int d, float& u1, float& u2) {
  const int i = d >> 1, f = i & 15, pos = (i < 16) ? (t >> 6) : (t & 63);
  const float cs = ROPE[(pos * 16 + f) * 2], sn = ROPE[(pos * 16 + f) * 2 + 1];
  const float a = u1 * cs - u2 * sn, b = u1 * sn + u2 * cs; u1 = a; u2 = b;
}

DEVI void phase_qkv0(const Params& p, float* lds) {
  const bf16_t* H = (const bf16_t*)(p.ws + WS_H); const bf16_t* W = (const bf16_t*)(p.ws + WS_WIN0);
  bf16_t* Q = (bf16_t*)(p.ws + WS_QKV0); const float* ROPE = (const float*)(p.ws + WS_CTL + CTL_ROPE);
  constexpr int NTN = N_IN0 / 64, NTM = NROW / 128;
  for (int it = blockIdx.x; it < NTN * NTM; it += gridDim.x) {
    const int mt = it / NTN, nt = it % NTN, m0 = mt * 128;
    gemm_tile(lds, W, nt * 64, DM,
      [&](int r) { return H + (size_t)(m0 + r) * DM; },
      [&](int r, int n, float* v) {
        const int row = m0 + r;
        if (row < NLAT && n < 1024) { const int t = row & 4095; rope_pair(ROPE, t, n & 63, v[0], v[1]); rope_pair(ROPE, t, (n + 2) & 63, v[2], v[3]); }
        *(uint2*)(Q + (size_t)row * N_IN0 + n) = make_uint2(pk2(v[0], v[1]), pk2(v[2], v[3]));
      });
  }
}

template <int NS, int VJ, class KF>
DEVI void wave_attn(const float* qs, float* pl  , int* rl  , int nkeys, KF kf, const bf16_t* KV, int ld, int kcol, int vcol,
                    float sink, bool has_sink, float (&o)[NS][VJ], float (&m)[NS], float (&l)[NS], int lane) {
#pragma unroll
  for (int s = 0; s < NS; ++s) { m[s] = -INFINITY; l[s] = 0.f;
#pragma unroll
    for (int j = 0; j < VJ; ++j) o[s][j] = 0.f; }
  for (int c0 = 0; c0 < nkeys; c0 += 64) {
    const int kidx = c0 + lane; int row = -1; float bias = 0.f;
    bool valid = kidx < nkeys; if (valid) valid = kf(kidx, row, bias);
    const int rr = valid ? row : 0;
    rl[lane] = valid ? row : -1;
    float sc[NS];
#pragma unroll
    for (int s = 0; s < NS; ++s) {
      const uint4* kp = (const uint4*)(KV + (size_t)rr * ld + kcol + 64 * s); float d = 0.f;
#pragma unroll
      for (int i = 0; i < 8; ++i) { const uint4 w = kp[i]; const float* q = qs + s * 64 + i * 8;
        d += q[0] * __uint_as_float(w.x << 16) + q[1] * __uint_as_float(w.x & 0xffff0000u) + q[2] * __uint_as_float(w.y << 16) + q[3] * __uint_as_float(w.y & 0xffff0000u)
           + q[4] * __uint_as_float(w.z << 16) + q[5] * __uint_as_float(w.z & 0xffff0000u) + q[6] * __uint_as_float(w.w << 16) + q[7] * __uint_as_float(w.w & 0xffff0000u); }
      sc[s] = valid ? d + bias : -INFINITY;
    }
#pragma unroll
    for (int s = 0; s < NS; ++s) {
      const float cm = wave_max(sc[s]); const float mn = fmaxf(m[s], cm);
      float pv = 0.f, scale = 1.f;
      if (mn > -INFINITY) { pv = __expf(sc[s] - mn); scale = __expf(m[s] - mn); }
      l[s] = l[s] * scale + wave_sum(pv); m[s] = mn;
#pragma unroll
      for (int j = 0; j < VJ; ++j) o[s][j] *= scale;
      pl[s * 64 + lane] = pv;
    }
    __builtin_amdgcn_s_waitcnt(0); __builtin_amdgcn_wave_barrier();
    for (int kk = 0; kk < 64; ++kk) {
      const int rk = rl[kk]; if (rk < 0) continue;
      const bf16_t* vp = KV + (size_t)rk * ld + vcol + lane;
      float vv[VJ];
#pragma unroll
      for (int j = 0; j < VJ; ++j) vv[j] = bf2f(vp[64 * j]);
#pragma unroll
      for (int s = 0; s < NS; ++s) { const float pk = pl[s * 64 + kk];
#pragma unroll
        for (int j = 0; j < VJ; ++j) o[s][j] += pk * vv[j]; }
    }
    __builtin_amdgcn_s_waitcnt(0); __builtin_amdgcn_wave_barrier();
  }
  if (has_sink) {
#pragma unroll
    for (int s = 0; s < NS; ++s) { const float mn = fmaxf(m[s], sink); const float scale = __expf(m[s] - mn);
      l[s] = l[s] * scale + __expf(sink - mn); m[s] = mn;
#pragma unroll
      for (int j = 0; j < VJ; ++j) o[s][j] *= scale; }
  }
}

DEVI void phase_attn0(const Params& p, float* lds) {
  const int tid = ftid(), lane = tid & 63, wave = tid >> 6;
  const int gw = blockIdx.x * NWAVE + wave, NGW = gridDim.x * NWAVE;
  const bf16_t* Q = (const bf16_t*)(p.ws + WS_QKV0); bf16_t* ATT = (bf16_t*)(p.ws + WS_ATT0);
  const float lam = ((const float*)(p.ws + WS_CTL + CTL_LAM))[0];
  float* qs = lds + wave * 128; float* pl = lds + 1024 + wave * 128; int* rl = (int*)(lds + 2048) + wave * 64;
  for (long it = gw; it < (long)NROW * 12; it += NGW) {
    const int row = (int)(it / 12), hs = (int)(it % 12);
    const bool lat = row < NLAT; const int b = lat ? (row >> 12) : ((row - NLAT) >> 8), t = lat ? (row & 4095) : 0;
    __builtin_amdgcn_s_waitcnt(0); __builtin_amdgcn_wave_barrier();
    if (hs < 4) {
      const bf16_t* qp = Q + (size_t)row * N_IN0 + hs * 128;
      qs[lane] = bf2f(qp[lane]) * 0.125f; qs[64 + lane] = bf2f(qp[64 + lane]) * 0.125f;
      __builtin_amdgcn_s_waitcnt(0); __builtin_amdgcn_wave_barrier();
      float o[2][2], m[2], l[2];
      const int nkeys = lat ? SEQ + CTXL : CTXL;
      wave_attn<2, 2>(qs, pl, rl, nkeys, [&](int k, int& r, float& bias) { r = lat ? (k < SEQ ? b * SEQ + k : NLAT + b * CTXL + (k - SEQ)) : NLAT + b * CTXL + k; return true; },
                      Q, N_IN0, 512 + hs * 128, 1024 + hs * 128, 0.f, false, o, m, l, lane);
      float v0 = o[0][0] / l[0] - lam * o[1][0] / l[1], v1 = o[0][1] / l[0] - lam * o[1][1] / l[1];
      const float r = rsqrtf(wave_sum(v0 * v0 + v1 * v1) * (1.f / 128.f) + EPS);
      const float* g = p.in[L0_SUBLN];
      ATT[(size_t)row * DM + hs * 128 + lane] = f2bf(v0 * r * g[lane] * 0.8f);
      ATT[(size_t)row * DM + hs * 128 + 64 + lane] = f2bf(v1 * r * g[64 + lane] * 0.8f);
    } else {
      const int h = hs - 4;
      qs[lane] = bf2f(Q[(size_t)row * N_IN0 + 1536 + h * 64 + lane]) * 0.125f;
      __builtin_amdgcn_s_waitcnt(0); __builtin_amdgcn_wave_barrier();
      float o[1][1], m[1], l[1];
      const int qr = t >> 6, qc = t & 63;
      const int rs = min(max(qr - 4, 0), 56), cs = min(max(qc - 8, 0), 48);
      const float* rpb = p.in[L0_RPB] + h * 15 * 31;
      const int nkeys = lat ? 128 + CTXL : CTXL;
      wave_attn<1, 1>(qs, pl, rl, nkeys, [&](int k, int& r, float& bias) {
          if (!lat) { r = NLAT + b * CTXL + k; return true; }
          if (k < 128) { const int kr = rs + (k >> 4), kc = cs + (k & 15); r = b * SEQ + kr * 64 + kc; bias = rpb[(kr - qr + 7) * 31 + (kc - qc + 15)]; }
          else r = NLAT + b * CTXL + (k - 128);
          return true; },
        Q, N_IN0, 2048 + h * 64, 2560 + h * 64, 0.f, false, o, m, l, lane);
      ATT[(size_t)row * DM + 512 + h * 64 + lane] = f2bf(o[0][0] / l[0]);
    }
  }
}

DEVI void phase_outproj(const Params& p, float* lds, int layer) {
  const bf16_t* A = (const bf16_t*)(p.ws + (layer ? WS_ATT1 : WS_ATT0)); const bf16_t* W = (const bf16_t*)(p.ws + (layer ? WS_WOUT1 : WS_WOUT0));
  bf16_t* MIX = (bf16_t*)(p.ws + (layer ? WS_MIX1 : WS_MIX0));
  const int NTM = (layer ? NLAT : NROW) / 128; constexpr int NTN = DM / 64;
  for (int it = blockIdx.x; it < NTN * NTM; it += gridDim.x) {
    const int mt = it / NTN, nt = it % NTN, m0 = mt * 128;
    gemm_tile(lds, W, nt * 64, DM, [&](int r) { return A + (size_t)(m0 + r) * DM; },
      [&](int r, int n, float* v) { *(uint2*)(MIX + (size_t)(m0 + r) * DM + n) = make_uint2(pk2(v[0], v[1]), pk2(v[2], v[3])); });
  }
}

DEVI void phase_postmix(const Params& p, int layer) {
  const int lane = ftid() & 63, gw = blockIdx.x * NWAVE + (ftid() >> 6), NGW = gridDim.x * NWAVE;
  const float* MOD = (const float*)(p.ws + WS_CTL + CTL_MOD) + (size_t)layer * 9 * 6144;
  const bf16_t* MIX = (const bf16_t*)(p.ws + (layer ? WS_MIX1 : WS_MIX0));
  bf16_t* H = (bf16_t*)(p.ws + WS_H); float* AFF = (float*)(p.ws + WS_AFF); float* XC = (float*)(p.ws + WS_XC);
  const float* gpost = p.in[layer ? L1_GPOSTMIX : L0_GPOSTMIX]; const float* gpre = p.in[layer ? L1_GPREFFN : L0_GPREFFN];
  const float* wr = p.in[layer ? L1_WROUTER : L0_WROUTER];
  const int nrow = layer ? NLAT : NROW;
  for (int r = gw; r < nrow; r += NGW) {
    const float* m = MOD + (size_t)row_modrow(r) * 6144;
    const float* xin = layer ? (p.out + (size_t)r * DM) : (r < NLAT ? p.in[I_X] + (size_t)r * DM : p.in[I_CTX] + (size_t)(r - NLAT) * DM);
    float* xout = r < NLAT ? p.out + (size_t)r * DM : XC + (size_t)(r - NLAT) * DM;
    Row16 o = ld_row_bf16(MIX + (size_t)r * DM, lane);
    const float rr = rsqrtf(row_sumsq(o) * (1.f / DM) + EPS);
    { const Row16 A = ld_row_f32(gpost, lane), Bv = ld_row_f32(m + 2048, lane), Cv = ld_row_f32(xin, lane);
      ROW_FOR4(e = c + b * (e * rr * a)); }
    st_row_f32(xout, lane, o);
    const Row16 h = norm_mod(o, gpre, m + 4096, m + 3072, lane);
    st_row_bf16(H + (size_t)r * DM, lane, h);
    float lg[16];
#pragma unroll
    for (int e = 0; e < 16; ++e) lg[e] = 0.f;
#pragma unroll
    for (int j = 0; j < 4; ++j) {
      const float hv[4] = {h.v[j].x, h.v[j].y, h.v[j].z, h.v[j].w};
#pragma unroll
      for (int q = 0; q < 4; ++q) { const float4* w4 = (const float4*)(wr + (size_t)(lane * 4 + 256 * j + q) * 16);
#pragma unroll
        for (int e4 = 0; e4 < 4; ++e4) { const float4 w = w4[e4]; lg[e4 * 4] += hv[q] * w.x; lg[e4 * 4 + 1] += hv[q] * w.y; lg[e4 * 4 + 2] += hv[q] * w.z; lg[e4 * 4 + 3] += hv[q] * w.w; } }
    }
    float mx = -INFINITY;
#pragma unroll
    for (int e = 0; e < 16; ++e) { lg[e] = wave_sum(lg[e]); mx = fmaxf(mx, lg[e]); }
    float s = 0.f;
#pragma unroll
    for (int e = 0; e < 16; ++e) { lg[e] = expf(lg[e] - mx); s += lg[e]; }
    const float inv = 1.f / s;
    float mine = 0.f;
#pragma unroll
    for (int e = 0; e < 16; ++e) if (lane == e) mine = lg[e] * inv;
    if (lane < 16) AFF[(size_t)lane * NROW + r] = mine;
  }
}

DEVI void phase_topk(const Params& p, float* lds, int layer) {
  const int tid = ftid();
  const float* AFF = (const float*)(p.ws + WS_AFF); int* SLOT = (int*)(p.ws + WS_SLOT); int* IDX = (int*)(p.ws + WS_IDX); float* GV = (float*)(p.ws + WS_GATEV);
  const int erows = layer ? EROWS1 : EROWS0;
  const int nlat_items = NB * NE * 8, nitems = nlat_items + (layer ? 0 : NB * NE);
  for (int it = blockIdx.x; it < nitems; it += gridDim.x) {
    const bool lat = it < nlat_items;
    int b, e, ch, n, cap, row0, slot0;
    if (lat) { b = it / (NE * 8); e = (it / 8) % NE; ch = it % 8; n = SEQ; cap = CAP_L; row0 = b * SEQ; slot0 = b * CAP_L; }
    else { const int i2 = it - nlat_items; b = i2 / NE; e = i2 % NE; ch = 0; n = CTXL; cap = CAP_C; row0 = NLAT + b * CTXL; slot0 = NB * CAP_L + b * CAP_C; }
    __syncthreads();
    for (int i = tid; i < n; i += NT) lds[i] = AFF[(size_t)e * NROW + row0 + i];
    __syncthreads();
    const int t = ch * 512 + tid;
    if (t < n) {
      const float a = lds[t]; int rank = 0;
      for (int j = 0; j < n; ++j) { const float v = lds[j]; rank += (v > a || (v == a && j < t)) ? 1 : 0; }
      if (rank < cap) { IDX[e * erows + slot0 + rank] = row0 + t; GV[e * erows + slot0 + rank] = a; SLOT[(size_t)(row0 + t) * 16 + e] = slot0 + rank; }
      else SLOT[(size_t)(row0 + t) * 16 + e] = -1;
    }
  }
}

DEVI void phase_moe_up(const Params& p, float* lds, int layer) {
  const bf16_t* H = (const bf16_t*)(p.ws + WS_H); const bf16_t* WGU = (const bf16_t*)(p.ws + WS_WGU); bf16_t* HID = (bf16_t*)(p.ws + WS_HID);
  const int* IDX = (const int*)(p.ws + WS_IDX);
  const int erows = layer ? EROWS1 : EROWS0, NTM = erows / 128; constexpr int NTN = 2048 / 64;
  for (int it = blockIdx.x; it < NE * NTM * NTN; it += gridDim.x) {
    const int e = it / (NTM * NTN), r2 = it % (NTM * NTN), mt = r2 / NTN, nt = r2 % NTN, m0 = mt * 128;
    gemm_tile(lds, WGU + (size_t)e * 2048 * DM, nt * 64, DM, [&](int r) { return H + (size_t)IDX[e * erows + m0 + r] * DM; },
      [&](int r, int n, float* v) { *(unsigned*)(HID + ((size_t)e * erows + m0 + r) * DM + (n >> 1)) = pk2(silu_f(v[0]) * v[1], silu_f(v[2]) * v[3]); });
  }
}
DEVI void phase_moe_down(const Params& p, float* lds, int layer) {
  const bf16_t* HID = (const bf16_t*)(p.ws + WS_HID); const bf16_t* WD = (const bf16_t*)(p.ws + WS_WD); bf16_t* Y = (bf16_t*)(p.ws + WS_Y);
  const float* GV = (const float*)(p.ws + WS_GATEV);
  const int erows = layer ? EROWS1 : EROWS0, NTM = erows / 128; constexpr int NTN = DM / 64;
  for (int it = blockIdx.x; it < NE * NTM * NTN; it += gridDim.x) {
    const int e = it / (NTM * NTN), r2 = it % (NTM * NTN), mt = r2 / NTN, nt = r2 % NTN, m0 = mt * 128;
    gemm_tile(lds, WD + (size_t)e * DM * DM, nt * 64, DM, [&](int r) { return HID + ((size_t)e * erows + m0 + r) * DM; },
      [&](int r, int n, float* v) { const float g = GV[e * erows + m0 + r];
        *(uint2*)(Y + ((size_t)e * erows + m0 + r) * DM + n) = make_uint2(pk2(v[0] * g, v[1] * g), pk2(v[2] * g, v[3] * g)); });
  }
}

DEVI void phase_combine(const Params& p, float* lds, int layer) {
  const int lane = ftid() & 63, wave = ftid() >> 6, gw = blockIdx.x * NWAVE + wave, NGW = gridDim.x * NWAVE;
  const float* MOD = (const float*)(p.ws + WS_CTL + CTL_MOD);
  const bf16_t* Y = (const bf16_t*)(p.ws + WS_Y); const int* SLOT = (const int*)(p.ws + WS_SLOT);
  bf16_t* H = (bf16_t*)(p.ws + WS_H); float* XC = (float*)(p.ws + WS_XC);
  const float* gpost = p.in[layer ? L1_GPOSTFFN : L0_GPOSTFFN];
  const int nrow = layer ? NLAT : NROW, erows = layer ? EROWS1 : EROWS0;
  for (int r = gw; r < nrow; r += NGW) {
    const float* m = MOD + (size_t)(layer * 9 + row_modrow(r)) * 6144;
    float* xio = r < NLAT ? p.out + (size_t)r * DM : XC + (size_t)(r - NLAT) * DM;
    Row16 o;
#pragma unroll
    for (int j = 0; j < 4; ++j) o.v[j] = make_float4(0.f, 0.f, 0.f, 0.f);
    for (int e = 0; e < NE; ++e) {
      const int s = SLOT[(size_t)r * 16 + e];
      if (s >= 0) { const Row16 y = ld_row_bf16(Y + ((size_t)e * erows + s) * DM, lane);
#pragma unroll
        for (int j = 0; j < 4; ++j) { o.v[j].x += y.v[j].x; o.v[j].y += y.v[j].y; o.v[j].z += y.v[j].z; o.v[j].w += y.v[j].w; } }
    }
    const float rr = rsqrtf(row_sumsq(o) * (1.f / DM) + EPS);
    { const Row16 A = ld_row_f32(gpost, lane), Bv = ld_row_f32(m + 5120, lane), Cv = ld_row_f32(xio, lane);
      ROW_FOR4(e = c + b * (e * rr * a)); }
    st_row_f32(xio, lane, o);
    if (layer == 0) {
      const float* m1 = MOD + (size_t)(9 + row_modrow(r)) * 6144;
      const Row16 h = norm_mod(o, p.in[L1_GPREMIX], m1 + 1024, m1, lane);
      st_row_bf16(H + (size_t)r * DM, lane, h);
    }
  }
  if (layer == 0) { convert_moe_part(p, 1, 0, lds + wave * (64 * 33), gw, NGW, lane); convert_moe_part(p, 1, 1, lds + wave * (64 * 33), gw, NGW, lane); }
}

DEVI void phase_qkv1(const Params& p, float* lds) {
  const bf16_t* H = (const bf16_t*)(p.ws + WS_H); const bf16_t* W = (const bf16_t*)(p.ws + WS_WIN1);
  bf16_t* P1 = (bf16_t*)(p.ws + WS_P1); float* DT = (float*)(p.ws + WS_DT); const float* ROPE = (const float*)(p.ws + WS_CTL + CTL_ROPE);
  constexpr int NTN = 37, NTM = NROW / 128;
  for (int it = blockIdx.x; it < NTN * NTM; it += gridDim.x) {
    const int mt = it / NTN, nt = it % NTN, m0 = mt * 128;
    gemm_tile(lds, W, nt * 64, DM, [&](int r) { return H + (size_t)(m0 + r) * DM; },
      [&](int r, int n, float* v) {
        const int row = m0 + r;
        if (n >= 2304) { if (n < 2320) *(float4*)(DT + (size_t)row * 16 + (n - 2304)) = make_float4(v[0], v[1], v[2], v[3]); return; }
        if (row < NLAT && n < 640) { const int t = row & 4095; rope_pair(ROPE, t, n & 63, v[0], v[1]); rope_pair(ROPE, t, (n + 2) & 63, v[2], v[3]); }
        *(uint2*)(P1 + (size_t)row * 2304 + n) = make_uint2(pk2(v[0], v[1]), pk2(v[2], v[3]));
      });
  }
}

DEVI void phase_conv_swa(const Params& p, float* lds, bool do_swa) {
  const int tid = ftid(), lane = tid & 63, wave = tid >> 6;
  const int gw = blockIdx.x * NWAVE + wave, NGW = gridDim.x * NWAVE;
  const bf16_t* P1 = (const bf16_t*)(p.ws + WS_P1); bf16_t* U = (bf16_t*)(p.ws + WS_U); bf16_t* ATT = (bf16_t*)(p.ws + WS_ATT1);
  const float* cw = p.in[L1_CONVW]; const float* cb = p.in[L1_CONVB];
  for (long i = (long)blockIdx.x * NT + tid; i < (long)NROW * 1024; i += (long)gridDim.x * NT) {
    const int row = (int)(i >> 10), ch = (int)(i & 1023);
    int s0, len, t; if (row < NLAT) { s0 = row & ~4095; len = SEQ; t = row & 4095; } else { s0 = NLAT + ((row - NLAT) & ~255); len = CTXL; t = (row - NLAT) & 255; }
    float acc = cb[ch];
#pragma unroll
    for (int j = 0; j < 5; ++j) { const int tt = t + j - 2; if (tt >= 0 && tt < len) acc += cw[j * 1024 + ch] * bf2f(P1[(size_t)(s0 + tt) * 2304 + 768 + ch]); }
    U[(size_t)row * 1024 + ch] = f2bf(silu_f(acc));
  }
  if (!do_swa) return;
  float* qs = lds + wave * 128; float* pl = lds + 1024 + wave * 128; int* rl = (int*)(lds + 2048) + wave * 64;
  for (long it = gw; it < (long)NLAT * 8; it += NGW) {
    const int row = (int)(it >> 3), hq = (int)(it & 7), g = hq >> 2, b = row >> 12, t = row & 4095;
    __builtin_amdgcn_s_waitcnt(0); __builtin_amdgcn_wave_barrier();
    qs[lane] = bf2f(P1[(size_t)row * 2304 + hq * 64 + lane]) * 0.125f;
    __builtin_amdgcn_s_waitcnt(0); __builtin_amdgcn_wave_barrier();
    float o[1][1], m[1], l[1];
    wave_attn<1, 1>(qs, pl, rl, 320 + CTXL, [&](int k, int& r, float& bias) {
        if (k < 320) { const int kp = t - 128 + k; if (k > 256 || kp < 0 || kp >= SEQ) return false; r = b * SEQ + kp; return true; }
        r = NLAT + b * CTXL + (k - 320); return true; },
      P1, 2304, 512 + g * 64, 640 + g * 64, p.in[L1_SINKS][hq], true, o, m, l, lane);
    ATT[(size_t)row * DM + hq * 64 + lane] = f2bf(o[0][0] / l[0]);
  }
}

DEVI void phase_ssd(const Params& p, float* lds) {
  const int tid = ftid();
  const bf16_t* U = (const bf16_t*)(p.ws + WS_U); const float* DT = (const float*)(p.ws + WS_DT); float* YS = (float*)(p.ws + WS_YS);
  constexpr int CH = 32;
  float* xb = lds;
  float* bb = lds + CH * 64;
  float* cb = bb + CH * 128;
  float* db = cb + CH * 128;
  float* yb = db + 2 * CH;
  const int pi = tid >> 3, ns = (tid & 7) * 16;
  for (int it = blockIdx.x; it < NB * 8; it += gridDim.x) {
    const int b = it >> 3, hd = it & 7, g = hd >> 2;
    for (int dir = 0; dir < 2; ++dir) {
      const float a = -expf(p.in[dir ? L1_ALOGB : L1_ALOGF][hd]); const float dtb = p.in[dir ? L1_DTBB : L1_DTBF][hd];
      float st[16];
#pragma unroll
      for (int i = 0; i < 16; ++i) st[i] = 0.f;
      for (int seg = 0; seg < 2; ++seg) {
        const int len = seg ? SEQ : CTXL, s0 = seg ? b * SEQ : NLAT + b * CTXL;
        for (int c0 = 0; c0 < len; c0 += CH) {
          __syncthreads();
          for (int i = tid; i < CH * 320; i += NT) {
            const int st_i = i / 320, c = i % 320; const int tk = dir ? (len - 1 - (c0 + st_i)) : (c0 + st_i); const size_t r = (size_t)(s0 + tk);
            if (c < 64) xb[st_i * 64 + c] = bf2f(U[r * 1024 + hd * 64 + c]);
            else if (c < 192) bb[st_i * 128 + (c - 64)] = bf2f(U[r * 1024 + 512 + g * 128 + (c - 64)]);
            else cb[st_i * 128 + (c - 192)] = bf2f(U[r * 1024 + 768 + g * 128 + (c - 192)]);
          }
          if (tid < CH) { const int tk = dir ? (len - 1 - (c0 + tid)) : (c0 + tid); const float raw = DT[(size_t)(s0 + tk) * 16 + dir * 8 + hd] + dtb;
            const float dt = raw > 20.f ? raw : log1pf(expf(raw)); db[tid] = expf(dt * a); db[CH + tid] = dt; }
          __syncthreads();
          for (int i = 0; i < CH; ++i) {
            const float dec = db[i], dx = db[CH + i] * xb[i * 64 + pi]; float y = 0.f;
#pragma unroll
            for (int q = 0; q < 16; ++q) { st[q] = st[q] * dec + dx * bb[i * 128 + ns + q]; y += st[q] * cb[i * 128 + ns + q]; }
            y += __shfl_xor(y, 1); y += __shfl_xor(y, 2); y += __shfl_xor(y, 4);
            if ((tid & 7) == 0) yb[i * 64 + pi] = y;
          }
          __syncthreads();
          if (seg == 1) for (int i = tid; i < CH * 64; i += NT) {
            const int q = i >> 6, c = i & 63; const int tk = (dir ? (len - CH - c0) : c0) + q, st_i = dir ? (CH - 1 - q) : q;
            float* yp = YS + (size_t)(b * SEQ + tk) * 512 + hd * 64 + c;
            if (dir == 0) *yp = yb[st_i * 64 + c]; else *yp = *yp + yb[st_i * 64 + c];
          }
        }
      }
      __syncthreads(); __threadfence();
    }
  }
}

DEVI void phase_ssd_out(const Params& p) {
  const int lane = ftid() & 63, gw = blockIdx.x * NWAVE + (ftid() >> 6), NGW = gridDim.x * NWAVE;
  const bf16_t* U = (const bf16_t*)(p.ws + WS_U); const bf16_t* P1 = (const bf16_t*)(p.ws + WS_P1); const float* YS = (const float*)(p.ws + WS_YS);
  bf16_t* ATT = (bf16_t*)(p.ws + WS_ATT1);
  for (int r = gw; r < NLAT; r += NGW) {
    const int c0 = lane * 8, hd = c0 >> 6; const float dsk = p.in[L1_DSKIP][hd];
    const float4 y0 = *(const float4*)(YS + (size_t)r * 512 + c0), y1 = *(const float4*)(YS + (size_t)r * 512 + c0 + 4);
    const uint4 xw = *(const uint4*)(U + (size_t)r * 1024 + c0), zw = *(const uint4*)(P1 + (size_t)r * 2304 + 1792 + c0);
    float y[8] = {y0.x, y0.y, y0.z, y0.w, y1.x, y1.y, y1.z, y1.w};
    const unsigned xs[4] = {xw.x, xw.y, xw.z, xw.w}, zs[4] = {zw.x, zw.y, zw.z, zw.w};
    float ss = 0.f;
#pragma unroll
    for (int i = 0; i < 4; ++i) {
      const float x0 = __uint_as_float(xs[i] << 16), x1 = __uint_as_float(xs[i] & 0xffff0000u), z0 = __uint_as_float(zs[i] << 16), z1 = __uint_as_float(zs[i] & 0xffff0000u);
      y[2 * i] = (y[2 * i] + dsk * x0) * silu_f(z0); y[2 * i + 1] = (y[2 * i + 1] + dsk * x1) * silu_f(z1);
      ss += y[2 * i] * y[2 * i] + y[2 * i + 1] * y[2 * i + 1];
    }
#pragma unroll
    for (int o = 1; o < 32; o <<= 1) ss += __shfl_xor(ss, o);
    const float rr = rsqrtf(ss * (1.f / 256.f) + EPS);
    const float4 g0 = *(const float4*)(p.in[L1_GNORM] + c0), g1 = *(const float4*)(p.in[L1_GNORM] + c0 + 4);
    uint4 w; w.x = pk2(y[0] * rr * g0.x, y[1] * rr * g0.y); w.y = pk2(y[2] * rr * g0.z, y[3] * rr * g0.w); w.z = pk2(y[4] * rr * g1.x, y[5] * rr * g1.y); w.w = pk2(y[6] * rr * g1.z, y[7] * rr * g1.w);
    *(uint4*)(ATT + (size_t)r * DM + 512 + c0) = w;
  }
}

}
namespace pg8 {
#define PG8_LAS __attribute__((address_space(3)))
typedef unsigned short bf16_t;
typedef short bf16x8 __attribute__((ext_vector_type(8)));
typedef float f32x4 __attribute__((ext_vector_type(4)));
typedef unsigned u32x4 __attribute__((ext_vector_type(4)));
constexpr int BM = 256, BK = 64, HALF = 128, HTB = HALF * BK * 2  , STAGE_BYTES = 8 * HTB, NXCD = 8, WGM = 8;

__host__ __device__ __forceinline__ int lds_byte(int r, int c) { const int st = (r >> 4) * 2 + (c >> 5), rr = r & 15, cc = c & 31, ob = rr * 64 + cc * 2; return st * 1024 + (ob ^ (((ob >> 9) & 1) << 5)); }
__host__ __device__ __forceinline__ void stage_rc(int b, int& R, int& C) { const int st = b / 1024, sb = b % 1024, swz = sb ^ (((sb >> 9) & 1) << 5); R = (st >> 1) * 16 + swz / 64; C = (st & 1) * 32 + (swz % 64) / 2; }
__host__ __device__ __forceinline__ int perm32(int rho) { const int n = rho >> 4, i = rho & 15; return 8 * (i >> 2) + 4 * n + (i & 3); }

struct Unit { int pm, pn; };
struct Gemm { const bf16_t* A; const bf16_t* Bt; int M, N, K; const int* gidx = nullptr; int sw = 0x7f7f7f7f, sa = 0x7f7f7f7f; };

struct StaticOrder {
    int nM, nN, nwg, G, c;
    __host__ __device__ void init(int M, int N, int G_, int c_) { nM = M / BM; nN = N / BM; nwg = nM * nN; G = G_; c = c_; }
    __host__ __device__ bool next(int i, Unit& u) const {
        const long L = (long)i * G + c; if (L >= nwg) return false;
        int wgid = (int)L; { const int q = nwg / NXCD, r = nwg % NXCD, xcd = wgid % NXCD, off = wgid / NXCD; wgid = (xcd < r ? xcd * (q + 1) : r * (q + 1) + (xcd - r) * q) + off; }
        const int nig = WGM * nN, gid = wgid / nig, fm = gid * WGM, gsz = (nM - fm) < WGM ? (nM - fm) : WGM;
        u.pm = fm + ((wgid % nig) % gsz); u.pn = (wgid % nig) / gsz; return true;
    }
    __device__ __forceinline__ void a_ready(const Unit&) const {}
    __device__ __forceinline__ void done(const Unit&) const {}
};

template <class Epi, class Sched, bool ALIGN_EPI = false, bool SP2 = false, bool FP8 = false>
__device__ __forceinline__ void gemm_phase(PG8_LAS unsigned char* lds, const Gemm g, const Sched& S, const Epi& E) {
    const int tid = ftid(), wid = __builtin_amdgcn_readfirstlane(tid >> 6), lane = tid & 63, wr = wid >> 2, wc = wid & 3, fr = lane & 15, fq = lane >> 4;
    const int KB = g.K * (FP8 ? 1 : 2), nt = KB / (BK * 2);
    unsigned voffB[2]; int pR[2], pC[2];
#pragma unroll
    for (int i = 0; i < 2; ++i) { int R, C; stage_rc(tid * 16 + i * 8192, R, C); const int Rb = Epi::PERM ? ((R & ~31) + perm32(R & 31)) : R;
        pR[i] = R; pC[i] = C; voffB[i] = (unsigned)(Rb * KB + C * 2); }
    unsigned cvo[2][2], nvo[2][2];
#define PG8_SETVO(vo, pm_) do { _Pragma("unroll") for (int _h = 0; _h < 2; ++_h) _Pragma("unroll") for (int _i = 0; _i < 2; ++_i) { const int _r = (pm_) * BM + _h * HALF + pR[_i]; \
        const int _g = g.gidx ? g.gidx[_r] : _r; vo[_h][_i] = (unsigned)_g * (unsigned)KB + (unsigned)(pC[_i] * 2); } } while (0)
#define PG8_STAGEA(bufoff, koff, vo) do { _Pragma("unroll") for (int _i = 0; _i < 2; ++_i) \
        __builtin_amdgcn_global_load_lds((const unsigned*)((const char*)g.A + (koff) + (vo)[_i]), (PG8_LAS unsigned*)(lds + (bufoff) + ldsw + _i * 8192), 16, 0, 0); } while (0)
    const size_t kstep = (size_t)(BK * 2);
    const size_t hstep = (size_t)HALF * KB;
    const size_t tstep = 2 * hstep;
    const unsigned ldsw = (unsigned)wid * 1024u;
    const int aoff = lds_byte(wr * 64 + fr, fq * 8), boff = lds_byte(wc * 32 + fr, fq * 8);
#define PG8_SA(b, h) (((b) * 2 + (h)) * HTB)
#define PG8_SB(b, h) ((4 + (b) * 2 + (h)) * HTB)
#define PG8_STAGE(bufoff, gbase, voff) do { _Pragma("unroll") for (int _i = 0; _i < 2; ++_i) \
        __builtin_amdgcn_global_load_lds((const unsigned*)((const char*)(gbase) + (voff)[_i]), (PG8_LAS unsigned*)(lds + (bufoff) + ldsw + _i * 8192), 16, 0, 0); } while (0)
    typedef int v4i_t __attribute__((ext_vector_type(4))); typedef int v8i_t __attribute__((ext_vector_type(8)));
#define PG8_CAT8(x, y) __builtin_shufflevector(__builtin_bit_cast(v4i_t, x), __builtin_bit_cast(v4i_t, y), 0, 1, 2, 3, 4, 5, 6, 7)
#define PG8_LDA(dst, b, h) do { _Pragma("unroll") for (int m = 0; m < 4; ++m) { const bf16x8 f0_ = *(const PG8_LAS bf16x8*)(lds + PG8_SA(b, h) + aoff + m * 2048), f1_ = *(const PG8_LAS bf16x8*)(lds + PG8_SA(b, h) + aoff + m * 2048 + 1024); \
        if constexpr (FP8) dst##8[m] = PG8_CAT8(f0_, f1_); else { dst[m][0] = f0_; dst[m][1] = f1_; } } } while (0)
#define PG8_LDB(dst, b, h) do { _Pragma("unroll") for (int n = 0; n < 2; ++n) { const bf16x8 f0_ = *(const PG8_LAS bf16x8*)(lds + PG8_SB(b, h) + boff + n * 2048), f1_ = *(const PG8_LAS bf16x8*)(lds + PG8_SB(b, h) + boff + n * 2048 + 1024); \
        if constexpr (FP8) dst##8[n] = PG8_CAT8(f0_, f1_); else { dst[n][0] = f0_; dst[n][1] = f1_; } } } while (0)
typedef int v4i_t __attribute__((ext_vector_type(4))); typedef int v8i_t __attribute__((ext_vector_type(8)));
#define PG8_CAT8(x, y) __builtin_shufflevector(__builtin_bit_cast(v4i_t, x), __builtin_bit_cast(v4i_t, y), 0, 1, 2, 3, 4, 5, 6, 7)
#define PG8_MMA(ai, bj, At, Bt) do { __builtin_amdgcn_s_setprio(1); _Pragma("unroll") for (int m = 0; m < 4; ++m) _Pragma("unroll") for (int n = 0; n < 2; ++n) { \
        if constexpr (FP8) asm volatile("v_mfma_scale_f32_16x16x128_f8f6f4 %0, %1, %2, %0, %3, %4 op_sel_hi:[0,0,0]" : "+v"(acc[ai][bj][m][n]) : "v"(Bt##8[n]), "v"(At##8[m]), "v"(sw_), "v"(sa_)); \
        else { _Pragma("unroll") for (int k = 0; k < 2; ++k) acc[ai][bj][m][n] = __builtin_amdgcn_mfma_f32_16x16x32_bf16(Bt[n][k], At[m][k], acc[ai][bj][m][n], 0, 0, 0); } } \
        __builtin_amdgcn_s_setprio(0); } while (0)
#define PG8_WAIT_V(n) asm volatile("s_waitcnt vmcnt(" #n ")" ::: "memory")
#define PG8_WAIT_L(n) asm volatile("s_waitcnt lgkmcnt(" #n ")" ::: "memory")
#define PG8_BAR __builtin_amdgcn_s_barrier()
#define PG8_SCHED __builtin_amdgcn_sched_barrier(0)
    Unit cur, nxt; int ui = 0;
    if (!S.next(0, cur)) return;
    f32x4 acc[2][2][4][2];
#pragma unroll
    for (int a = 0; a < 2; ++a)
#pragma unroll
        for (int b = 0; b < 2; ++b)
#pragma unroll
            for (int m = 0; m < 4; ++m)
#pragma unroll
                for (int n = 0; n < 2; ++n) acc[a][b][m][n] = (f32x4){0.f, 0.f, 0.f, 0.f};
    const int sw_ = g.sw, sa_ = g.sa;
    bf16x8 At[4][2], B0[2][2], B1[2][2]; v8i_t At8[4], B08[2], B18[2];
    PG8_SETVO(cvo, cur.pm); const char* cB = (const char*)g.Bt + (size_t)cur.pn * tstep;
    S.a_ready(cur);
    if constexpr (SP2) {
        PG8_STAGE(PG8_SB(0, 0), cB, voffB); PG8_STAGE(PG8_SB(0, 1), cB + hstep, voffB); PG8_STAGEA(PG8_SA(0, 0), 0, cvo[0]); PG8_STAGEA(PG8_SA(0, 1), 0, cvo[1]);
        if (wr == 1) PG8_BAR;
        PG8_WAIT_V(2); PG8_BAR;
        PG8_STAGE(PG8_SB(1, 0), cB + kstep, voffB); PG8_STAGEA(PG8_SA(1, 0), kstep, cvo[0]); PG8_STAGE(PG8_SB(1, 1), cB + hstep + kstep, voffB);
        PG8_WAIT_V(6); PG8_BAR;
    } else {
        PG8_STAGE(PG8_SB(0, 0), cB, voffB); PG8_STAGEA(PG8_SA(0, 0), 0, cvo[0]); PG8_STAGE(PG8_SB(0, 1), cB + hstep, voffB); PG8_STAGEA(PG8_SA(0, 1), 0, cvo[1]);
        if (wr == 1) PG8_BAR;
        PG8_WAIT_V(4); PG8_BAR;
        PG8_STAGE(PG8_SB(1, 0), cB + kstep, voffB); PG8_STAGEA(PG8_SA(1, 0), kstep, cvo[0]); PG8_STAGE(PG8_SB(1, 1), cB + hstep + kstep, voffB);
        PG8_WAIT_V(6); PG8_BAR;
    }
    for (;;) {
        const bool has_next = S.next(ui + 1, nxt);
        if (has_next) PG8_SETVO(nvo, nxt.pm); else { nvo[0][0] = cvo[0][0]; nvo[0][1] = cvo[0][1]; nvo[1][0] = cvo[1][0]; nvo[1][1] = cvo[1][1]; }
        const char* nB = has_next ? (const char*)g.Bt + (size_t)nxt.pn * tstep : cB;
#pragma unroll 1
        for (int t = 0; t < nt; t += 2) {
            const bool last = (t == nt - 2);
            const size_t k1 = (size_t)(t + 1) * kstep;
            const size_t k2 = last ? 0 : (size_t)(t + 2) * kstep; unsigned v2[2][2];
            v2[0][0] = last ? nvo[0][0] : cvo[0][0]; v2[0][1] = last ? nvo[0][1] : cvo[0][1]; v2[1][0] = last ? nvo[1][0] : cvo[1][0]; v2[1][1] = last ? nvo[1][1] : cvo[1][1];
            const char* b2 = last ? nB : cB + (size_t)(t + 2) * kstep;
            const size_t k3 = k2 + kstep; const char* b3 = b2 + kstep;
            if (last && has_next) S.a_ready(nxt);
            if constexpr (SP2) {
            PG8_LDB(B0, 0, 0); PG8_LDB(B1, 0, 1); PG8_SCHED; PG8_LDA(At, 0, 0); PG8_STAGEA(PG8_SA(1, 1), k1, cvo[1]);
            PG8_WAIT_V(8); PG8_WAIT_L(0); PG8_BAR; PG8_MMA(0, 0, At, B0); PG8_MMA(0, 1, At, B1); PG8_BAR; PG8_SCHED;
            PG8_LDA(At, 0, 1); PG8_STAGE(PG8_SB(0, 0), b2, voffB); PG8_STAGE(PG8_SB(0, 1), b2 + hstep, voffB); PG8_STAGEA(PG8_SA(0, 0), k2, v2[0]);
            PG8_WAIT_V(8); PG8_WAIT_L(0); PG8_BAR; PG8_MMA(1, 0, At, B0); PG8_MMA(1, 1, At, B1); PG8_BAR; PG8_SCHED;
            PG8_LDB(B0, 1, 0); PG8_LDB(B1, 1, 1); PG8_SCHED; PG8_LDA(At, 1, 0); PG8_STAGEA(PG8_SA(0, 1), k2, v2[1]);
            PG8_WAIT_V(8); PG8_WAIT_L(0); PG8_BAR; PG8_MMA(0, 0, At, B0); PG8_MMA(0, 1, At, B1); PG8_BAR; PG8_SCHED;
            PG8_LDA(At, 1, 1); PG8_STAGE(PG8_SB(1, 0), b3, voffB); PG8_STAGE(PG8_SB(1, 1), b3 + hstep, voffB); PG8_STAGEA(PG8_SA(1, 0), k3, v2[0]);
            PG8_WAIT_V(8); PG8_WAIT_L(0); PG8_BAR; PG8_MMA(1, 0, At, B0); PG8_MMA(1, 1, At, B1); PG8_BAR; PG8_SCHED;
            } else {
            PG8_LDB(B0, 0, 0); PG8_SCHED; PG8_LDA(At, 0, 0); PG8_STAGEA(PG8_SA(1, 1), k1, cvo[1]);
            PG8_WAIT_L(8); PG8_BAR; PG8_WAIT_L(0); PG8_MMA(0, 0, At, B0); PG8_BAR; PG8_SCHED;
            PG8_LDB(B1, 0, 1); PG8_STAGE(PG8_SB(0, 0), b2, voffB);
            PG8_BAR; PG8_WAIT_L(0); PG8_MMA(0, 1, At, B1); PG8_BAR;
            PG8_LDA(At, 0, 1); PG8_STAGEA(PG8_SA(0, 0), k2, v2[0]);
            PG8_BAR; PG8_WAIT_L(0); PG8_MMA(1, 0, At, B0); PG8_BAR; PG8_SCHED;
            PG8_STAGE(PG8_SB(0, 1), b2 + hstep, voffB);
            PG8_WAIT_V(6); PG8_BAR; PG8_MMA(1, 1, At, B1); PG8_BAR;
            PG8_LDB(B0, 1, 0); PG8_SCHED; PG8_LDA(At, 1, 0); PG8_STAGEA(PG8_SA(0, 1), k2, v2[1]);
            PG8_WAIT_L(8); PG8_BAR; PG8_WAIT_L(0); PG8_MMA(0, 0, At, B0); PG8_BAR; PG8_SCHED;
            PG8_LDB(B1, 1, 1); PG8_STAGE(PG8_SB(1, 0), b3, voffB);
            PG8_BAR; PG8_WAIT_L(0); PG8_MMA(0, 1, At, B1); PG8_BAR;
            PG8_LDA(At, 1, 1); PG8_STAGEA(PG8_SA(1, 0), k3, v2[0]);
            PG8_BAR; PG8_WAIT_L(0); PG8_MMA(1, 0, At, B0); PG8_BAR; PG8_SCHED;
            PG8_STAGE(PG8_SB(1, 1), b3 + hstep, voffB);
            PG8_WAIT_V(6); PG8_BAR; PG8_MMA(1, 1, At, B1); PG8_BAR;
            }
        }
        if constexpr (ALIGN_EPI) { if (wr == 0) PG8_BAR; }
        if constexpr (FP8) asm volatile("s_nop 15\n\ts_nop 15" ::: "memory");
        if constexpr (!Epi::AFTER_DRAIN) { E(acc, cur, wr, wc, fr, fq); S.done(cur); }
        if (!has_next) break;
#pragma unroll
        for (int a = 0; a < 2; ++a)
#pragma unroll
            for (int b = 0; b < 2; ++b)
#pragma unroll
                for (int m = 0; m < 4; ++m)
#pragma unroll
                    for (int n = 0; n < 2; ++n) acc[a][b][m][n] = (f32x4){0.f, 0.f, 0.f, 0.f};
        cur = nxt; cvo[0][0] = nvo[0][0]; cvo[0][1] = nvo[0][1]; cvo[1][0] = nvo[1][0]; cvo[1][1] = nvo[1][1]; cB = nB; ++ui;
        if constexpr (ALIGN_EPI) { if (wr == 1) PG8_BAR; }
    }
    PG8_WAIT_V(0);
    if constexpr (!ALIGN_EPI) { if (wr == 0) PG8_BAR; }
    PG8_BAR;
    if constexpr (Epi::AFTER_DRAIN) { E.fused(acc, cur, wr, wc, fr, fq, lds, wid, lane); S.done(cur); }
#undef PG8_SA
#undef PG8_SB
#undef PG8_STAGE
#undef PG8_STAGEA
#undef PG8_SETVO
#undef PG8_LDA
#undef PG8_LDB
#undef PG8_MMA
#undef PG8_CAT8
#undef PG8_WAIT_V
#undef PG8_WAIT_L
#undef PG8_BAR
#undef PG8_SCHED
}
}
#ifndef FP8_SP2
#define FP8_SP2 true
#endif
#ifndef ATTNA_FP8
#define ATTNA_FP8 1
#endif
namespace fg {
using pg8::f32x4; using pg8::Unit;
typedef unsigned u32x4 __attribute__((ext_vector_type(4)));
typedef unsigned u32x2 __attribute__((ext_vector_type(2)));
DEVI unsigned cvtpk(float lo, float hi) { typedef float f2_t __attribute__((ext_vector_type(2))); typedef __bf16 b2_t __attribute__((ext_vector_type(2))); const f2_t v = {lo, hi}; const b2_t b = __builtin_convertvector(v, b2_t); return __builtin_bit_cast(unsigned, b); }
template <class TP> DEVI void rope8(TP ROPE, int t, int d0, f32x4& v0, f32x4& v1) {
  const int i0 = d0 >> 1, f0 = i0 & 15, pos = (i0 < 16) ? (t >> 6) : (t & 63);
  const f32x4 r0 = *(const PG8_LAS f32x4*)(ROPE + (pos * 16 + f0) * 2), r1 = *(const PG8_LAS f32x4*)(ROPE + (pos * 16 + f0) * 2 + 4);
  const f32x4 a = v0, b = v1;
  v0[0] = a[0] * r0[0] - a[1] * r0[1]; v0[1] = a[0] * r0[1] + a[1] * r0[0]; v0[2] = a[2] * r0[2] - a[3] * r0[3]; v0[3] = a[2] * r0[3] + a[3] * r0[2];
  v1[0] = b[0] * r1[0] - b[1] * r1[1]; v1[1] = b[0] * r1[1] + b[1] * r1[0]; v1[2] = b[2] * r1[2] - b[3] * r1[3]; v1[3] = b[2] * r1[3] + b[3] * r1[2];
}
#define EPI_LOOP_BEGIN const int row0 = u.pm * 256 + wr * 64 + fr; \
  _Pragma("unroll") for (int ai = 0; ai < 2; ++ai) _Pragma("unroll") for (int m = 0; m < 4; ++m) { const int row = row0 + ai * 128 + m * 16; \
  _Pragma("unroll") for (int bj = 0; bj < 2; ++bj) { f32x4 v0 = acc[ai][bj][m][0], v1 = acc[ai][bj][m][1]; const int cl = bj * 128 + wc * 32 + 8 * fq;
#define EPI_LOOP_END } }

struct EpiQKV0 { static constexpr bool PERM = true, AFTER_DRAIN = false; bf16_t* O; const PG8_LAS float* ROPE; unsigned char* VT; unsigned char* VTB;
  DEVI void operator()(const f32x4 (&acc)[2][2][4][2], const Unit& u, int wr, int wc, int fr, int fq) const {
    const int colt = u.pn * 256; const bool rope = (u.pm < NLAT / 256) && (colt < 1024);
    EPI_LOOP_BEGIN
      const int col = colt + cl;
      if (ATTNA_FP8 && colt >= 1024 && colt < 1536) {
        const int hh = (col - 1024) >> 7, dv0 = (col - 1024) & 127;
        int bb, t; if (row < NLAT) { bb = row >> 12; t = row & 4095; } else { bb = (row - NLAT) >> 8; t = 4096 + ((row - NLAT) & 255); }
        const int k = t & 31, gq = k >> 3, wq = k & 7, pos = (wq < 4) ? gq * 4 + wq : 16 + gq * 4 + (wq - 4);
        unsigned char* vp = VT + (size_t)((bb * 4 + hh) * 128 + dv0) * 4352 + (t & ~31) + pos;
        const unsigned w0 = nv::pack4_fp8(v0[0] * 4.f, v0[1] * 4.f, v0[2] * 4.f, v0[3] * 4.f), w1 = nv::pack4_fp8(v1[0] * 4.f, v1[1] * 4.f, v1[2] * 4.f, v1[3] * 4.f);
        vp[0 * 4352] = (unsigned char)w0; vp[1 * 4352] = (unsigned char)(w0 >> 8); vp[2 * 4352] = (unsigned char)(w0 >> 16); vp[3 * 4352] = (unsigned char)(w0 >> 24);
        vp[4 * 4352] = (unsigned char)w1; vp[5 * 4352] = (unsigned char)(w1 >> 8); vp[6 * 4352] = (unsigned char)(w1 >> 16); vp[7 * 4352] = (unsigned char)(w1 >> 24);
        continue;
      }
      if (ATTNA_FP8 && colt >= 2560) {
        const int hh = (col - 2560) >> 6, dv0 = (col - 2560) & 63;
        int bb, t; if (row < NLAT) { bb = row >> 12; t = row & 4095; } else { bb = (row - NLAT) >> 8; t = 4096 + ((row - NLAT) & 255); }
        const int k = t & 31, gq = k >> 3, wq = k & 7, pos = (wq < 4) ? gq * 4 + wq : 16 + gq * 4 + (wq - 4);
        unsigned char* vp = VTB + (size_t)((bb * 8 + hh) * 64 + dv0) * 4352 + (t & ~31) + pos;
        const unsigned w0 = nv::pack4_fp8(v0[0] * 4.f, v0[1] * 4.f, v0[2] * 4.f, v0[3] * 4.f), w1 = nv::pack4_fp8(v1[0] * 4.f, v1[1] * 4.f, v1[2] * 4.f, v1[3] * 4.f);
        vp[0 * 4352] = (unsigned char)w0; vp[1 * 4352] = (unsigned char)(w0 >> 8); vp[2 * 4352] = (unsigned char)(w0 >> 16); vp[3 * 4352] = (unsigned char)(w0 >> 24);
        vp[4 * 4352] = (unsigned char)w1; vp[5 * 4352] = (unsigned char)(w1 >> 8); vp[6 * 4352] = (unsigned char)(w1 >> 16); vp[7 * 4352] = (unsigned char)(w1 >> 24);
        continue;
      }
      if (rope) rope8(ROPE, row & 4095, col & 63, v0, v1);
      if (ATTNA_FP8 && (colt < 1024 || colt >= 1536)) {
        const float sc = (colt < 512 || (colt >= 1536 && colt < 2048)) ? 16.f * 0.125f * 1.4426950408889634f : 4.f;
        u32x2 w8; w8.x = nv::pack4_fp8(v0[0] * sc, v0[1] * sc, v0[2] * sc, v0[3] * sc); w8.y = nv::pack4_fp8(v1[0] * sc, v1[1] * sc, v1[2] * sc, v1[3] * sc);
        *(u32x2*)((unsigned char*)O + (size_t)row * (N_IN0 * 2) + col) = w8;
        continue;
      }
      u32x4 w; w.x = cvtpk(v0[0], v0[1]); w.y = cvtpk(v0[2], v0[3]); w.z = cvtpk(v1[0], v1[1]); w.w = cvtpk(v1[2], v1[3]);
      *(u32x4*)(O + (size_t)row * N_IN0 + col) = w;
    EPI_LOOP_END
  } };
struct EpiQKV1 { static constexpr bool PERM = true, AFTER_DRAIN = false; bf16_t* O; float* DT; const PG8_LAS float* ROPE;
  DEVI void operator()(const f32x4 (&acc)[2][2][4][2], const Unit& u, int wr, int wc, int fr, int fq) const {
    const int colt = u.pn * 256; const bool lat = (u.pm < NLAT / 256);
    EPI_LOOP_BEGIN
      const int col = colt + cl;
      if (col >= 2304) { if (col < 2320) { *(f32x4*)(DT + (size_t)row * 16 + (col - 2304)) = v0; *(f32x4*)(DT + (size_t)row * 16 + (col - 2304) + 4) = v1; } }
      else {
        if (lat && col < 640) rope8(ROPE, row & 4095, col & 63, v0, v1);
        u32x4 w; w.x = cvtpk(v0[0], v0[1]); w.y = cvtpk(v0[2], v0[3]); w.z = cvtpk(v1[0], v1[1]); w.w = cvtpk(v1[2], v1[3]);
        *(u32x4*)(O + (size_t)row * 2304 + col) = w;
      }
    EPI_LOOP_END
  } };
struct EpiPlain { static constexpr bool PERM = true, AFTER_DRAIN = false; bf16_t* O;
  DEVI void operator()(const f32x4 (&acc)[2][2][4][2], const Unit& u, int wr, int wc, int fr, int fq) const {
    const int colt = u.pn * 256;
    EPI_LOOP_BEGIN
      u32x4 w; w.x = cvtpk(v0[0], v0[1]); w.y = cvtpk(v0[2], v0[3]); w.z = cvtpk(v1[0], v1[1]); w.w = cvtpk(v1[2], v1[3]);
      *(u32x4*)(O + (size_t)row * DM + colt + cl) = w;
    EPI_LOOP_END
  } };
DEVI float silu_fast(float v) { return v * __builtin_amdgcn_rcpf(1.f + __expf(-v)); }
struct EpiSwiGLU { static constexpr bool PERM = true, AFTER_DRAIN = false; bf16_t* O;
  DEVI void operator()(const f32x4 (&acc)[2][2][4][2], const Unit& u, int wr, int wc, int fr, int fq) const {
    const int colt = (u.pn & 7) * 256;
    EPI_LOOP_BEGIN
      u32x2 w; w.x = cvtpk(silu_fast(v0[0]) * v0[1], silu_fast(v0[2]) * v0[3]); w.y = cvtpk(silu_fast(v1[0]) * v1[1], silu_fast(v1[2]) * v1[3]);
      *(u32x2*)(O + (size_t)row * DM + ((colt + cl) >> 1)) = w;
    EPI_LOOP_END
  } };
struct EpiSwiGLU8 { static constexpr bool PERM = true, AFTER_DRAIN = false; unsigned char* O;
  DEVI void operator()(const f32x4 (&acc)[2][2][4][2], const Unit& u, int wr, int wc, int fr, int fq) const {
    const int colt = (u.pn & 7) * 256;
    EPI_LOOP_BEGIN
      const unsigned w = nv::pack4_fp8(silu_fast(v0[0]) * v0[1] * nv::A8_SCALE, silu_fast(v0[2]) * v0[3] * nv::A8_SCALE, silu_fast(v1[0]) * v1[1] * nv::A8_SCALE, silu_fast(v1[2]) * v1[3] * nv::A8_SCALE);
      *(unsigned*)(O + (size_t)row * DM + ((colt + cl) >> 1)) = w;
    EPI_LOOP_END
  } };
struct EpiDown { static constexpr bool PERM = true, AFTER_DRAIN = false; bf16_t* O;
  DEVI void operator()(const f32x4 (&acc)[2][2][4][2], const Unit& u, int wr, int wc, int fr, int fq) const {
    const int colt = (u.pn & 3) * 256;
    EPI_LOOP_BEGIN
      u32x4 w; w.x = cvtpk(v0[0], v0[1]); w.y = cvtpk(v0[2], v0[3]); w.z = cvtpk(v1[0], v1[1]); w.w = cvtpk(v1[2], v1[3]);
      *(u32x4*)(O + (size_t)row * DM + colt + cl) = w;
    EPI_LOOP_END
  } };
struct ExpOrder : pg8::StaticOrder { int nMe, nNe;
  __device__ void init2(int erows, int Ne, int G_, int c_) { nMe = erows / 256; nNe = Ne / 256; init(NE * erows, Ne, G_, c_); }
  __device__ bool next(int i, Unit& u) const { if (!pg8::StaticOrder::next(i, u)) return false; u.pn += (u.pm / nMe) * nNe; return true; } };

typedef PG8_LAS unsigned char* ldsp_t;
DEVI void phase_qkv0(const Params& p, ldsp_t lds) {
  pg8::Gemm g{(const bf16_t*)(p.ws + WS_H), (const bf16_t*)(p.ws + WS_WIN0), NROW, N_IN0, DM, nullptr, nv::W8_E8M0, nv::A8_E8M0}; pg8::StaticOrder S; S.init(NROW, N_IN0, gridDim.x, blockIdx.x);
  PG8_LAS float* RL = (PG8_LAS float*)(lds + pg8::STAGE_BYTES);
  for (int i = ftid(); i < 64 * 16 * 2; i += NT) RL[i] = ((const float*)(p.ws + WS_CTL + CTL_ROPE))[i];
  __syncthreads();
  EpiQKV0 E{(bf16_t*)(p.ws + WS_QKV0), RL, (unsigned char*)(p.ws + WS_VT), (unsigned char*)(p.ws + WS_VTB)};
  pg8::gemm_phase<EpiQKV0, pg8::StaticOrder, true, true, (QKV0_FP8 != 0)>(lds, g, S, E);
}
DEVI void phase_qkv1(const Params& p, ldsp_t lds) {
  pg8::Gemm g{(const bf16_t*)(p.ws + WS_H), (const bf16_t*)(p.ws + WS_WIN1), NROW, N_IN1P, DM, nullptr, nv::W8_E8M0, nv::A8_E8M0}; pg8::StaticOrder S; S.init(NROW, N_IN1P, gridDim.x, blockIdx.x);
  PG8_LAS float* RL = (PG8_LAS float*)(lds + pg8::STAGE_BYTES);
  for (int i = ftid(); i < 64 * 16 * 2; i += NT) RL[i] = ((const float*)(p.ws + WS_CTL + CTL_ROPE))[i];
  __syncthreads();
  EpiQKV1 E{(bf16_t*)(p.ws + WS_P1), (float*)(p.ws + WS_DT), RL};
  pg8::gemm_phase<EpiQKV1, pg8::StaticOrder, true, true, (QKV1_FP8 != 0)>(lds, g, S, E);
}
DEVI void phase_outproj(const Params& p, ldsp_t lds, int layer) {
  const int M = layer ? NLAT : NROW;
  pg8::Gemm g{(const bf16_t*)(p.ws + (layer ? WS_ATT1 : WS_ATT0)), (const bf16_t*)(p.ws + (layer ? WS_WOUT1 : WS_WOUT0)), M, DM, DM, nullptr, nv::W8_E8M0, nv::A8_E8M0}; pg8::StaticOrder S; S.init(M, DM, gridDim.x, blockIdx.x);
  EpiPlain E{(bf16_t*)(p.ws + (layer ? WS_MIX1 : WS_MIX0))};
  pg8::gemm_phase<EpiPlain, pg8::StaticOrder, true, true, (OUT_FP8 != 0)>(lds, g, S, E);
}
DEVI void phase_moe_up(const Params& p, ldsp_t lds, int layer) {
  const int erows = layer ? EROWS1 : EROWS0;
  pg8::Gemm g{(const bf16_t*)(p.ws + WS_H), (const bf16_t*)(p.ws + WS_WGU), NE * erows, 2048, DM, (const int*)(p.ws + WS_IDX)}; ExpOrder S; S.init2(erows, 2048, gridDim.x, blockIdx.x);
  EpiSwiGLU E{(bf16_t*)(p.ws + WS_HID)};
  pg8::gemm_phase<EpiSwiGLU, ExpOrder, true, true>(lds, g, S, E);
}
DEVI void phase_moe_down(const Params& p, ldsp_t lds, int layer) {
  const int erows = layer ? EROWS1 : EROWS0;
  pg8::Gemm g{(const bf16_t*)(p.ws + WS_HID), (const bf16_t*)(p.ws + WS_WD), NE * erows, DM, DM}; ExpOrder S; S.init2(erows, DM, gridDim.x, blockIdx.x);
  EpiDown E{(bf16_t*)(p.ws + WS_Y)};
  pg8::gemm_phase<EpiDown, ExpOrder, true, true>(lds, g, S, E);
}
DEVI void phase_moe_up8(const Params& p, ldsp_t lds, int layer) {
  const int erows = layer ? EROWS1 : EROWS0;
  pg8::Gemm g{(const bf16_t*)(p.ws + WS_H), (const bf16_t*)(p.ws + WS_WGU), NE * erows, 2048, DM, (const int*)(p.ws + WS_IDX), nv::W8_E8M0, nv::A8_E8M0}; ExpOrder S; S.init2(erows, 2048, gridDim.x, blockIdx.x);
  EpiSwiGLU8 E{(unsigned char*)(p.ws + WS_HID)};
  pg8::gemm_phase<EpiSwiGLU8, ExpOrder, true, FP8_SP2, true>(lds, g, S, E);
}
DEVI void phase_moe_down8(const Params& p, ldsp_t lds, int layer) {
  const int erows = layer ? EROWS1 : EROWS0;
  pg8::Gemm g{(const bf16_t*)(p.ws + WS_HID), (const bf16_t*)(p.ws + WS_WD), NE * erows, DM, DM, nullptr, nv::W8_E8M0, nv::A8_E8M0}; ExpOrder S; S.init2(erows, DM, gridDim.x, blockIdx.x);
  EpiDown E{(bf16_t*)(p.ws + WS_Y)};
  pg8::gemm_phase<EpiDown, ExpOrder, true, FP8_SP2, true>(lds, g, S, E);
}
DEVI void phase_gather(const Params& p, int layer) {
  const int lane = ftid() & 63, gw = blockIdx.x * NWAVE + (ftid() >> 6), NGW = gridDim.x * NWAVE;
  const int erows = layer ? EROWS1 : EROWS0; const int* IDX = (const int*)(p.ws + WS_IDX);
  const bf16_t* H = (const bf16_t*)(p.ws + WS_H); bf16_t* XG = (bf16_t*)(p.ws + WS_XG);
  for (int r = gw; r < NE * erows; r += NGW) {
    const uint4* s = (const uint4*)(H + (size_t)IDX[r] * DM) + lane; uint4* d = (uint4*)(XG + (size_t)r * DM) + lane;
    const uint4 a = s[0], b = s[64]; d[0] = a; d[64] = b;
  }
}
}
#ifndef ATTNA_FP8
#define ATTNA_FP8 1
#endif
namespace fa {
#define FA_LAS __attribute__((address_space(3)))
typedef short bf16x8 __attribute__((ext_vector_type(8)));
typedef short s16x4 __attribute__((ext_vector_type(4)));
typedef float f32x16 __attribute__((ext_vector_type(16)));
typedef FA_LAS unsigned char* ldsp_t;
typedef unsigned u32x4 __attribute__((ext_vector_type(4)));
constexpr float LOG2E = 1.4426950408889634f, C2 = 0.125f * LOG2E;
DEVI int crow(int r, int hi) { return (r & 3) + 8 * (r >> 2) + 4 * hi; }
DEVI unsigned cvtpk(float lo, float hi) { typedef float f2_t __attribute__((ext_vector_type(2))); typedef __bf16 b2_t __attribute__((ext_vector_type(2))); const f2_t v = {lo, hi}; const b2_t b = __builtin_convertvector(v, b2_t); return __builtin_bit_cast(unsigned, b); }
DEVI s16x4 vtr(ldsp_t p) { return __builtin_bit_cast(s16x4, __builtin_amdgcn_ds_read_tr16_b64_v4i16((FA_LAS s16x4*)p)); }

DEVI float max3f(float a, float b, float c) { float r; asm("v_max3_f32 %0, %1, %2, %3" : "=v"(r) : "v"(a), "v"(b), "v"(c)); return r; }
template <int KW, int DVB> struct Geo {
  static constexpr int VW = DVB * 32;
  static constexpr int KSTR = KW * 2 + 16, VSTR = VW * 2 + 64;
  static constexpr int KBYTES = 64 * KSTR, VBYTES = 64 * VSTR, STAGE = KBYTES + VBYTES;
  static constexpr int CPR = (KW + VW) / 8, NCH = 64 * CPR / NT;
};

DEVI bf16x8 load_q8(const bf16_t* p, float sc) {
  const uint4 w = *(const uint4*)p; const unsigned u[4] = {w.x, w.y, w.z, w.w}; unsigned o[4];
#pragma unroll
  for (int i = 0; i < 4; ++i) o[i] = cvtpk(__uint_as_float(u[i] << 16) * sc, __uint_as_float(u[i] & 0xffff0000u) * sc);
  uint4 r = make_uint4(o[0], o[1], o[2], o[3]); return __builtin_bit_cast(bf16x8, r);
}

template <int KW, int DVB, class Src, class Act, class Msk>
DEVI void flash_pass(ldsp_t lds, int ntiles, const bf16_t* kv, int ld, int kcol, int vcol, const bf16x8 (&q)[4], int kofs,
                     Src src, Act act, Msk msk, f32x16 (&o)[DVB], float& m, float& l) {
  typedef Geo<KW, DVB> G;
  const int tid = ftid(), lane = tid & 63, r32 = lane & 31, hi = lane >> 5;
  u32x4 stg[G::NCH];
  int crw[G::NCH], ccol[G::NCH], cdst[G::NCH];
#pragma unroll
  for (int i = 0; i < G::NCH; ++i) { const int c = tid + NT * i, row = c / G::CPR, cc = c % G::CPR; crw[i] = row;
    if (cc < KW / 8) { ccol[i] = kcol + cc * 8; cdst[i] = row * G::KSTR + cc * 16; } else { ccol[i] = vcol + (cc - KW / 8) * 8; cdst[i] = G::KBYTES + row * G::VSTR + (cc - KW / 8) * 16; } }
#pragma unroll
  for (int i = 0; i < G::NCH; ++i) stg[i] = *(const u32x4*)(kv + (size_t)src(0, crw[i]) * ld + ccol[i]);
#pragma unroll
  for (int i = 0; i < G::NCH; ++i) *(FA_LAS u32x4*)(lds + cdst[i]) = stg[i];
  __syncthreads();
  const int kroff = r32 * G::KSTR + (kofs + 8 * hi) * 2;
  const int vroff = G::KBYTES + (4 * hi + ((lane & 15) >> 2)) * G::VSTR + 32 * ((lane >> 4) & 1) + 8 * (lane & 3);
  for (int kt = 0; kt < ntiles; ++kt) {
    const int buf = (kt & 1) * G::STAGE;
    const bool more = kt + 1 < ntiles;
    if (more) {
#pragma unroll
      for (int i = 0; i < G::NCH; ++i) stg[i] = *(const u32x4*)(kv + (size_t)src(kt + 1, crw[i]) * ld + ccol[i]);
    }
    if (act(kt)) {
      const ldsp_t kb = lds + buf + kroff;
      f32x16 p0, p1;
#pragma unroll
      for (int r = 0; r < 16; ++r) { p0[r] = 0.f; p1[r] = 0.f; }
#pragma unroll
      for (int d0 = 0; d0 < 4; ++d0) {
        const bf16x8 a0 = *(const FA_LAS bf16x8*)(kb + d0 * 32), a1 = *(const FA_LAS bf16x8*)(kb + 32 * G::KSTR + d0 * 32);
        p0 = __builtin_amdgcn_mfma_f32_32x32x16_bf16(a0, q[d0], p0, 0, 0, 0);
        p1 = __builtin_amdgcn_mfma_f32_32x32x16_bf16(a1, q[d0], p1, 0, 0, 0);
      }
      msk(kt, p0, p1);
      float mx = fmaxf(p0[0], p1[0]);
#pragma unroll
      for (int r = 1; r < 16; ++r) mx = fmaxf(mx, fmaxf(p0[r], p1[r]));
      mx = fmaxf(mx, __shfl_xor(mx, 32));
      if (__any(mx > m)) {
        const float mn = fmaxf(m, mx), alpha = __builtin_amdgcn_exp2f(m - mn);
        l *= alpha; m = mn;
#pragma unroll
        for (int b = 0; b < DVB; ++b)
#pragma unroll
          for (int r = 0; r < 16; ++r) o[b][r] *= alpha;
      }
      float ls = 0.f;
#pragma unroll
      for (int r = 0; r < 16; ++r) { p0[r] = __builtin_amdgcn_exp2f(p0[r] - m); p1[r] = __builtin_amdgcn_exp2f(p1[r] - m); ls += p0[r] + p1[r]; }
      l += ls;
      bf16x8 pa[4];
      { uint4 t;
        t = make_uint4(cvtpk(p0[0], p0[1]), cvtpk(p0[2], p0[3]), cvtpk(p0[4], p0[5]), cvtpk(p0[6], p0[7])); pa[0] = __builtin_bit_cast(bf16x8, t);
        t = make_uint4(cvtpk(p0[8], p0[9]), cvtpk(p0[10], p0[11]), cvtpk(p0[12], p0[13]), cvtpk(p0[14], p0[15])); pa[1] = __builtin_bit_cast(bf16x8, t);
        t = make_uint4(cvtpk(p1[0], p1[1]), cvtpk(p1[2], p1[3]), cvtpk(p1[4], p1[5]), cvtpk(p1[6], p1[7])); pa[2] = __builtin_bit_cast(bf16x8, t);
        t = make_uint4(cvtpk(p1[8], p1[9]), cvtpk(p1[10], p1[11]), cvtpk(p1[12], p1[13]), cvtpk(p1[14], p1[15])); pa[3] = __builtin_bit_cast(bf16x8, t); }
      const ldsp_t vb = lds + buf + vroff;
#pragma unroll
      for (int b = 0; b < DVB; ++b)
#pragma unroll
        for (int ks = 0; ks < 4; ++ks) {
          const s16x4 lo = vtr(vb + (16 * ks) * G::VSTR + b * 64), h8 = vtr(vb + (16 * ks + 8) * G::VSTR + b * 64);
          const bf16x8 vf = {lo[0], lo[1], lo[2], lo[3], h8[0], h8[1], h8[2], h8[3]};
          o[b] = __builtin_amdgcn_mfma_f32_32x32x16_bf16(vf, pa[ks], o[b], 0, 0, 0);
        }
    }
    if (more) {
      const int nb = ((kt + 1) & 1) * G::STAGE;
#pragma unroll
      for (int i = 0; i < G::NCH; ++i) *(FA_LAS u32x4*)(lds + nb + cdst[i]) = stg[i];
    }
    __syncthreads();
  }
}


template <int V> struct IC { static constexpr int value = V; };
template <int KW, int DVB, int ABL, int PF, class Src, class Msk>
DEVI void flash_pass2(ldsp_t lds, int ntiles, const bf16_t* kv, int ld, int kcol, int vcol, const bf16x8 (&q)[4], int kofs,
                      Src src, Msk msk, f32x16 (&o)[DVB], float& m, float& l) {
  typedef Geo<KW, DVB> G;
  const int tid = ftid(), lane = tid & 63, r32 = lane & 31, hi = lane >> 5;
  u32x4 stg[PF][G::NCH];
  int crw[G::NCH], ccol[G::NCH], cdst[G::NCH];
#pragma unroll
  for (int i = 0; i < G::NCH; ++i) { const int c = tid + NT * i, row = c / G::CPR, cc = c % G::CPR; crw[i] = row;
    if (cc < KW / 8) { ccol[i] = kcol + cc * 8; cdst[i] = row * G::KSTR + cc * 16; } else { ccol[i] = vcol + (cc - KW / 8) * 8; cdst[i] = G::KBYTES + row * G::VSTR + (cc - KW / 8) * 16; } }
#define FP2_LOAD(kt, set) _Pragma("unroll") for (int i = 0; i < G::NCH; ++i) stg[set][i] = *(const u32x4*)(kv + (size_t)src((kt), crw[i]) * ld + ccol[i])
#define FP2_STORE(st, set) _Pragma("unroll") for (int i = 0; i < G::NCH; ++i) *(FA_LAS u32x4*)(lds + (st) * G::STAGE + cdst[i]) = stg[set][i]
  FP2_LOAD(0, 0); FP2_STORE(0, 0);
  if (ntiles > 1) { FP2_LOAD(1, 0); FP2_STORE(1, 0); }
  __syncthreads();
  if (ntiles > 2) FP2_LOAD(2, 0);
  if (PF == 2) { if (ntiles > 3) FP2_LOAD(3, PF - 1); }
  const int kroff = r32 * G::KSTR + (kofs + 8 * hi) * 2;
  const int vroff = G::KBYTES + (4 * hi + ((lane & 15) >> 2)) * G::VSTR + 32 * ((lane >> 4) & 1) + 8 * (lane & 3);
  f32x16 c0, c1;
#pragma unroll
  for (int r = 0; r < 16; ++r) { c0[r] = 0.f; c1[r] = 0.f; }
  { const ldsp_t kb = lds + kroff;
#pragma unroll
    for (int d0 = 0; d0 < 4; ++d0) {
      const bf16x8 a0 = *(const FA_LAS bf16x8*)(kb + d0 * 32), a1 = *(const FA_LAS bf16x8*)(kb + 32 * G::KSTR + d0 * 32);
      c0 = __builtin_amdgcn_mfma_f32_32x32x16_bf16(a0, q[d0], c0, 0, 0, 0); c1 = __builtin_amdgcn_mfma_f32_32x32x16_bf16(a1, q[d0], c1, 0, 0, 0); } }
  asm volatile("s_nop 15\n\ts_nop 7" : "+v"(c0), "+v"(c1));
  int st_cur = 0, st_nxt = 1, st_fill = 2;
  auto body = [&](int kt, auto PARC) {
    constexpr int set = (PF == 2) ? decltype(PARC)::value : 0;
    msk(kt, c0, c1);
    __builtin_amdgcn_sched_barrier(0);
    f32x16 n0, n1;
#pragma unroll
    for (int r = 0; r < 16; ++r) { n0[r] = 0.f; n1[r] = 0.f; }
    const ldsp_t kb = lds + st_nxt * G::STAGE + kroff;
    bf16x8 ka[4], kb2[4];
#pragma unroll
    for (int d0 = 0; d0 < 4; ++d0) { ka[d0] = *(const FA_LAS bf16x8*)(kb + d0 * 32); kb2[d0] = *(const FA_LAS bf16x8*)(kb + 32 * G::KSTR + d0 * 32); }
#define FP2_SB() __builtin_amdgcn_sched_barrier(0)
#define FP2_MMA(acc, kf, d0) acc = __builtin_amdgcn_mfma_f32_32x32x16_bf16(kf[d0], q[d0], acc, 0, 0, 0)
#define FP2_EXP(cx, r) { if (ABL != 1) { cx[r] = __builtin_amdgcn_exp2f(cx[r] - mn); ls += cx[r]; } }
    FP2_SB(); FP2_MMA(n0, ka, 0);
    float mxa = max3f(c0[0], c0[1], c1[0]), mxb = max3f(c0[2], c0[3], c1[1]);
    mxa = max3f(mxa, c1[2], c1[3]);
    mxa = max3f(mxa, c0[4], c0[5]); mxb = max3f(mxb, c0[6], c0[7]); mxa = max3f(mxa, c1[4], c1[5]); mxb = max3f(mxb, c1[6], c1[7]);
    FP2_SB(); FP2_MMA(n1, kb2, 0);
    mxa = max3f(mxa, c0[8], c0[9]); mxb = max3f(mxb, c0[10], c0[11]); mxa = max3f(mxa, c1[8], c1[9]); mxb = max3f(mxb, c1[10], c1[11]);
    mxa = max3f(mxa, c0[12], c0[13]); mxb = max3f(mxb, c0[14], c0[15]); mxa = max3f(mxa, c1[12], c1[13]); mxb = max3f(mxb, c1[14], c1[15]);
    float mx = max3f(mxa, mxb, m);
    mx = max3f(mx, __shfl_xor(mx, 32), mx);
    const float mn = mx, alpha = __builtin_amdgcn_exp2f(m - mn);
    const bool resc = __any(mn > m);
    m = mn;
    float ls = 0.f;
    FP2_SB(); FP2_MMA(n0, ka, 1);
    FP2_EXP(c0, 0) FP2_EXP(c0, 1) FP2_EXP(c0, 2) FP2_EXP(c0, 3) FP2_EXP(c0, 4) FP2_EXP(c0, 5)
    FP2_SB(); FP2_MMA(n1, kb2, 1);
    FP2_EXP(c0, 6) FP2_EXP(c0, 7) FP2_EXP(c0, 8) FP2_EXP(c0, 9) FP2_EXP(c0, 10) FP2_EXP(c0, 11)
    FP2_SB(); FP2_MMA(n0, ka, 2);
    FP2_EXP(c0, 12) FP2_EXP(c0, 13) FP2_EXP(c0, 14) FP2_EXP(c0, 15) FP2_EXP(c1, 0) FP2_EXP(c1, 1)
    FP2_SB(); FP2_MMA(n1, kb2, 2);
    FP2_EXP(c1, 2) FP2_EXP(c1, 3) FP2_EXP(c1, 4) FP2_EXP(c1, 5) FP2_EXP(c1, 6) FP2_EXP(c1, 7)
    FP2_SB(); FP2_MMA(n0, ka, 3);
    FP2_EXP(c1, 8) FP2_EXP(c1, 9) FP2_EXP(c1, 10) FP2_EXP(c1, 11) FP2_EXP(c1, 12) FP2_EXP(c1, 13)
    FP2_SB(); FP2_MMA(n1, kb2, 3);
    FP2_EXP(c1, 14) FP2_EXP(c1, 15)
    bf16x8 pa[4];
    { u32x4 t;
      t[0] = cvtpk(c0[0], c0[1]); t[1] = cvtpk(c0[2], c0[3]); t[2] = cvtpk(c0[4], c0[5]); t[3] = cvtpk(c0[6], c0[7]); pa[0] = __builtin_bit_cast(bf16x8, t);
      t[0] = cvtpk(c0[8], c0[9]); t[1] = cvtpk(c0[10], c0[11]); t[2] = cvtpk(c0[12], c0[13]); t[3] = cvtpk(c0[14], c0[15]); pa[1] = __builtin_bit_cast(bf16x8, t);
      t[0] = cvtpk(c1[0], c1[1]); t[1] = cvtpk(c1[2], c1[3]); t[2] = cvtpk(c1[4], c1[5]); t[3] = cvtpk(c1[6], c1[7]); pa[2] = __builtin_bit_cast(bf16x8, t);
      t[0] = cvtpk(c1[8], c1[9]); t[1] = cvtpk(c1[10], c1[11]); t[2] = cvtpk(c1[12], c1[13]); t[3] = cvtpk(c1[14], c1[15]); pa[3] = __builtin_bit_cast(bf16x8, t); }
    asm volatile("" : "+v"(pa[0]), "+v"(pa[1]), "+v"(pa[2]), "+v"(pa[3]));
    FP2_SB();
    l = l * alpha + ls;
    __builtin_amdgcn_sched_barrier(0);
    if (resc) {
#pragma unroll
      for (int b = 0; b < DVB; ++b)
#pragma unroll
        for (int r = 0; r < 16; ++r) o[b][r] *= alpha;
    }
    const ldsp_t vb = lds + st_cur * G::STAGE + vroff;
    s16x4 vl[2][DVB], vh[2][DVB];
#pragma unroll
    for (int b = 0; b < DVB; ++b) { vl[0][b] = vtr(vb + b * 64); vh[0][b] = vtr(vb + 8 * G::VSTR + b * 64); }
#pragma unroll
    for (int ks = 0; ks < 4; ++ks) {
      FP2_SB();
      if (ks < 3) {
#pragma unroll
        for (int b = 0; b < DVB; ++b) { vl[(ks + 1) & 1][b] = vtr(vb + (16 * (ks + 1)) * G::VSTR + b * 64); vh[(ks + 1) & 1][b] = vtr(vb + (16 * (ks + 1) + 8) * G::VSTR + b * 64); }
      }
      FP2_SB();
#pragma unroll
      for (int b = 0; b < DVB; ++b) {
        const s16x4 lo = vl[ks & 1][b], h8 = vh[ks & 1][b];
        const bf16x8 vf = {lo[0], lo[1], lo[2], lo[3], h8[0], h8[1], h8[2], h8[3]};
        if (ABL != 2) o[b] = __builtin_amdgcn_mfma_f32_32x32x16_bf16(vf, pa[ks], o[b], 0, 0, 0); else o[b][0] += __builtin_bit_cast(float, (int)vf[0]);
      }
    }
    FP2_SB();
    if (ABL != 3) { if (kt + 2 < ntiles) FP2_STORE(st_fill, set); }
    __syncthreads();
    if (ABL != 3) { if (kt + 2 + PF < ntiles) FP2_LOAD(kt + 2 + PF, set); }
    c0 = n0; c1 = n1;
    { const int t = st_cur; st_cur = st_nxt; st_nxt = st_fill; st_fill = t; }
  };
  if (PF == 2) { for (int kt = 0; kt < ntiles; kt += 2) { body(kt, IC<0>{}); if (kt + 1 < ntiles) body(kt + 1, IC<1>{}); } }
  else { for (int kt = 0; kt < ntiles; ++kt) body(kt, IC<0>{}); }
#undef FP2_LOAD
#undef FP2_STORE
}


typedef int v8i_t __attribute__((ext_vector_type(8)));
DEVI v8i_t cat8(const u32x4& x, const u32x4& y) { return (v8i_t){(int)x[0], (int)x[1], (int)x[2], (int)x[3], (int)y[0], (int)y[1], (int)y[2], (int)y[3]}; }
template <int DVB, int KROW, int AB8 = 0, class Src, class VKey, class Msk, class Act>
DEVI void flash_pass8(ldsp_t lds, int ntiles, const unsigned char* k8, int ldb, int kcolb, const unsigned char* vt, const v8i_t& qf, int ksub, bool late,
                      Src src, VKey vkey, Msk msk, Act act, f32x16 (&o)[DVB], float& m, float& l) {
  constexpr int A8_KSTR = KROW + 16, A8_VSTR = 80, A8_KB = 64 * A8_KSTR, A8_STAGE = A8_KB + DVB * 32 * A8_VSTR;
  constexpr int KPR = KROW / 16, NKC = 64 * KPR, NCHT = (NKC + DVB * 32 * 4) / NT;
  const int tid = ftid(), lane = tid & 63, r32 = lane & 31, hi = lane >> 5;
  u32x4 stg[NCHT];
#define A8_ISK(i_, c_) ((NKC % NT == 0) ? ((i_) < NKC / NT) : ((c_) < NKC))
#define A8_LOAD(kt) do { const int sb_ = src((kt), 0), vk_ = vkey(kt); _Pragma("unroll") for (int i_ = 0; i_ < NCHT; ++i_) { const int c_ = tid + NT * i_; \
      if (A8_ISK(i_, c_)) stg[i_] = *(const u32x4*)(k8 + (size_t)(sb_ + c_ / KPR) * ldb + kcolb + (c_ % KPR) * 16); \
      else { const int cv_ = c_ - NKC; stg[i_] = *(const u32x4*)(vt + (size_t)(cv_ >> 2) * 4352 + vk_ + (cv_ & 3) * 16); } } } while (0)
#define A8_STORE(st) do { _Pragma("unroll") for (int i_ = 0; i_ < NCHT; ++i_) { const int c_ = tid + NT * i_; \
      if (A8_ISK(i_, c_)) *(FA_LAS u32x4*)(lds + (st) * A8_STAGE + (c_ / KPR) * A8_KSTR + (c_ % KPR) * 16) = stg[i_]; \
      else { const int cv_ = c_ - NKC; *(FA_LAS u32x4*)(lds + (st) * A8_STAGE + A8_KB + (cv_ >> 2) * A8_VSTR + (cv_ & 3) * 16) = stg[i_]; } } } while (0)
#define A8_SB() __builtin_amdgcn_sched_barrier(0)
#define A8_EXP(cx, r) { if (AB8 & 2) {} else { cx[r] = __builtin_amdgcn_exp2f(cx[r] - mn); ls += cx[r]; } }
#define A8_KREAD(st) do { const ldsp_t kp_ = lds + (st) * A8_STAGE + kroff; \
    kf[0] = *(const volatile FA_LAS u32x4*)kp_; kf[1] = *(const volatile FA_LAS u32x4*)(kp_ + 16); kf[2] = *(const volatile FA_LAS u32x4*)(kp_ + 32 * A8_KSTR); kf[3] = *(const volatile FA_LAS u32x4*)(kp_ + 32 * A8_KSTR + 16); } while (0)
#define A8_VREAD(st) do { const ldsp_t vb_ = lds + (st) * A8_STAGE + vroff; _Pragma("unroll") for (int b = 0; b < DVB; ++b) { \
    vf0[b] = *(const volatile FA_LAS u32x4*)(vb_ + b * 32 * A8_VSTR); vf1[b] = *(const volatile FA_LAS u32x4*)(vb_ + b * 32 * A8_VSTR + 16); } } while (0)
#define A8_QKM() do { f32x16 z_; _Pragma("unroll") for (int r_ = 0; r_ < 16; ++r_) z_[r_] = 0.f; \
    c0 = __builtin_amdgcn_mfma_scale_f32_32x32x64_f8f6f4(cat8(kf[0], kf[1]), qf, z_, 0, 0, 0, 0x7d7d7d7d  , 0, 0x7b7b7b7b  ); \
    c1 = __builtin_amdgcn_mfma_scale_f32_32x32x64_f8f6f4(cat8(kf[2], kf[3]), qf, z_, 0, 0, 0, 0x7d7d7d7d, 0, 0x7b7b7b7b); } while (0)
#define A8_PVM() do { _Pragma("unroll") for (int b = 0; b < DVB; ++b) if (!(AB8 & 16)) o[b] = __builtin_amdgcn_mfma_scale_f32_32x32x64_f8f6f4(cat8(vf0[b], vf1[b]), pb, o[b], 0, 0, 0, 0x7d7d7d7d  , 0, 0x7b7b7b7b  ); } while (0)
  A8_LOAD(0); A8_STORE(0);
  if (ntiles > 1) { A8_LOAD(1); A8_STORE(1); }
  __syncthreads();
  if (ntiles > 2) A8_LOAD(2);
  const int kroff = r32 * A8_KSTR + 64 * ksub + 32 * hi;
  const int vroff = A8_KB + r32 * A8_VSTR + 32 * hi;
  f32x16 c0, c1;
  u32x4 kf[4], vf0[DVB], vf1[DVB];
  v8i_t pb = {0, 0, 0, 0, 0, 0, 0, 0};
  if (act(0)) { A8_KREAD(0); A8_QKM(); }
  asm volatile("s_nop 15\n\ts_nop 7" : "+v"(c0), "+v"(c1));
  int st_cur = 0, st_nxt = 1, st_fill = 2;
  for (int kt = 0; kt < ntiles; ++kt) {
    const bool on = act(kt), on_nxt = kt + 1 < ntiles && act(kt + 1);
    if (late && kt > 0) {
      if (on) A8_QKM();
      if (act(kt - 1)) A8_PVM();
#pragma unroll
      for (int b = 0; b < DVB; ++b) asm volatile("" : "+v"(o[b]));
      asm volatile("s_nop 15\n\ts_nop 7" : "+v"(c0), "+v"(c1));
    }
    A8_SB();
    if (on) A8_VREAD(st_cur);
    if (on_nxt) A8_KREAD(st_nxt);
    A8_SB();
    if (on) {
    msk(kt, c0, c1);
    A8_SB();
    float mxa = 0.f, mxb = 0.f;
    if (!(AB8 & 2)) {
    mxa = max3f(c0[0], c0[1], c1[0]), mxb = max3f(c0[2], c0[3], c1[1]);
    mxa = max3f(mxa, c1[2], c1[3]);
    mxa = max3f(mxa, c0[4], c0[5]); mxb = max3f(mxb, c0[6], c0[7]); mxa = max3f(mxa, c1[4], c1[5]); mxb = max3f(mxb, c1[6], c1[7]);
    mxa = max3f(mxa, c0[8], c0[9]); mxb = max3f(mxb, c0[10], c0[11]); mxa = max3f(mxa, c1[8], c1[9]); mxb = max3f(mxb, c1[10], c1[11]);
    mxa = max3f(mxa, c0[12], c0[13]); mxb = max3f(mxb, c0[14], c0[15]); mxa = max3f(mxa, c1[12], c1[13]); mxb = max3f(mxb, c1[14], c1[15]);
    }
    float mx = max3f(mxa, mxb, mxb);
    { const auto sw = __builtin_amdgcn_permlane32_swap(__float_as_uint(mx), __float_as_uint(mx), false, false);
      mx = fmaxf(__uint_as_float(sw[0]), __uint_as_float(sw[1])); }
    const bool up = mx > m + 8.f;
    const float mn = up ? mx - 4.f : m, alpha = __builtin_amdgcn_exp2f(m - mn);
    const bool resc = __any(up);
    m = mn;
    float ls = 0.f;
    A8_SB();
#pragma unroll
    for (int r = 0; r < 16; ++r) A8_EXP(c0, r)
#pragma unroll
    for (int r = 0; r < 16; ++r) A8_EXP(c1, r)
    A8_SB();
    unsigned X[4], Y[4];
#pragma unroll
    for (int i = 0; i < 4; ++i) {
      int w, z; asm volatile("" : "=v"(w)); asm volatile("" : "=v"(z));
      w = __builtin_amdgcn_cvt_pk_fp8_f32(c0[4 * i], c0[4 * i + 1], w, false); w = __builtin_amdgcn_cvt_pk_fp8_f32(c0[4 * i + 2], c0[4 * i + 3], w, true); X[i] = (unsigned)w;
      z = __builtin_amdgcn_cvt_pk_fp8_f32(c1[4 * i], c1[4 * i + 1], z, false); z = __builtin_amdgcn_cvt_pk_fp8_f32(c1[4 * i + 2], c1[4 * i + 3], z, true); Y[i] = (unsigned)z; }
#pragma unroll
    for (int i = 0; i < 4; ++i) { const auto rr = __builtin_amdgcn_permlane32_swap(X[i], Y[i], false, false); X[i] = rr[0]; Y[i] = rr[1]; }
    pb = (v8i_t){(int)X[0], (int)X[1], (int)X[2], (int)X[3], (int)Y[0], (int)Y[1], (int)Y[2], (int)Y[3]};
    asm volatile("" : "+v"(pb));
    l = l * alpha + ls;
    A8_SB();
    if (resc) {
#pragma unroll
      for (int b = 0; b < DVB; ++b)
#pragma unroll
        for (int r = 0; r < 16; ++r) o[b][r] *= alpha;
    }
    }
    A8_SB();
    if (!late) {
      if (on_nxt) A8_QKM();
      if (on) A8_PVM();
#pragma unroll
      for (int b = 0; b < DVB; ++b) asm volatile("" : "+v"(o[b]));
      asm volatile("" : "+v"(c0), "+v"(c1));
    }
    A8_SB();
    if (!(AB8 & 4)) { if (kt + 2 < ntiles) A8_STORE(st_fill); }
    if (!(AB8 & 8)) __syncthreads();
    if (!(AB8 & 4)) { if (kt + 3 < ntiles) A8_LOAD(kt + 3); }
    { const int t = st_cur; st_cur = st_nxt; st_nxt = st_fill; st_fill = t; }
  }
  if (late && act(ntiles - 1)) A8_PVM();
  l *= 0.0625f;
#undef A8_ISK
#undef A8_LOAD
#undef A8_STORE
#undef A8_SB
#undef A8_EXP
#undef A8_KREAD
#undef A8_VREAD
#undef A8_QKM
#undef A8_PVM
}

#ifndef OUT_FP8
#define OUT_FP8 1
#endif
DEVI void st_att4(bf16_t* ATT, size_t row, int col, float a, float b, float c, float d) {
  if (OUT_FP8) *(unsigned*)((unsigned char*)ATT + row * DM + col) = nv::pack4_fp8(a * 4.f, b * 4.f, c * 4.f, d * 4.f);
  else { uint2 w; w.x = cvtpk(a, b); w.y = cvtpk(c, d); *(uint2*)(ATT + row * DM + col) = w; }
}
DEVI int vblock() { const int G = gridDim.x, bx = blockIdx.x; return (G % 8 == 0) ? (bx % 8) * (G / 8) + bx / 8 : bx; }

template <int ABL = 0> DEVI void phase_attnA(const Params& p, ldsp_t lds) {
  typedef Geo<128, 4> G;
  const int tid = ftid(), lane = tid & 63, wave = __builtin_amdgcn_readfirstlane(tid >> 6), r32 = lane & 31, hi = lane >> 5;
  const bf16_t* Q = (const bf16_t*)(p.ws + WS_QKV0); bf16_t* ATT = (bf16_t*)(p.ws + (ABL ? WS_MIX0 : WS_ATT0));
  const float lam = ((const float*)(p.ws + WS_CTL + CTL_LAM))[0];
  const int s = wave >> 2, qb = wave & 3;
  constexpr int NU_LAT = NB * 4 * 32, NU_CTX = NB * 4 * 2;
  for (int u = vblock(); u < NU_LAT + NU_CTX; u += gridDim.x) {
    int b, h, row0, ntiles; bool lat = u < NU_LAT;
    if (lat) { b = u >> 7; h = (u >> 5) & 3; row0 = b * SEQ + (u & 31) * 128; ntiles = 68; }
    else { const int v = u - NU_LAT; b = v >> 3; h = (v >> 1) & 3; row0 = NLAT + b * CTXL + (v & 1) * 128; ntiles = 4; }
    const int qrow = row0 + qb * 32 + r32;
    bf16x8 q[4];
#pragma unroll
    for (int d0 = 0; d0 < 4; ++d0) q[d0] = load_q8(Q + (size_t)qrow * N_IN0 + h * 128 + s * 64 + 16 * d0 + 8 * hi, C2);
    f32x16 o[4];
#pragma unroll
    for (int bk = 0; bk < 4; ++bk)
#pragma unroll
      for (int r = 0; r < 16; ++r) o[bk][r] = 0.f;
    float m = -1e30f, l = 0.f;
    const int cbase = NLAT + b * CTXL, lbase = b * SEQ;
#if ATTNA_FP8
    const unsigned char* QK8 = (const unsigned char*)(p.ws + WS_QKV0);
    v8i_t qf;
    { const unsigned char* qp = QK8 + (size_t)qrow * (N_IN0 * 2) + h * 128 + s * 64 + 32 * hi; const u32x4 q0_ = *(const u32x4*)qp, q1_ = *(const u32x4*)(qp + 16); qf = cat8(q0_, q1_); }
    flash_pass8<4, 128, ABL>(lds, ntiles, QK8, N_IN0 * 2, 512 + h * 128, (const unsigned char*)(p.ws + WS_VT) + (size_t)((b * 4 + h) * 128) * 4352, qf, s, s != 0,
      [&](int kt, int i) { return lat ? (kt < 64 ? lbase + kt * 64 + i : cbase + (kt - 64) * 64 + i) : cbase + kt * 64 + i; },
      [&](int kt) { return (lat ? 0 : 4096) + kt * 64; }, [&](int, f32x16&, f32x16&) {}, [&](int) { return true; }, o, m, l);
#else
    flash_pass2<128, 4, ABL, 1>(lds, ntiles, Q, N_IN0, 512 + h * 128, 1024 + h * 128, q, s * 64,
      [&](int kt, int i) { return lat ? (kt < 64 ? lbase + kt * 64 + i : cbase + (kt - 64) * 64 + i) : cbase + kt * 64 + i; },
      [&](int, f32x16&, f32x16&) {}, o, m, l);
#endif
    l += __shfl_xor(l, 32);
    const float inv = 1.f / l;
    FA_LAS float* X = (FA_LAS float*)lds;
    if (s == 1) {
#pragma unroll
      for (int bk = 0; bk < 4; ++bk)
#pragma unroll
        for (int r = 0; r < 16; ++r) X[((qb * 4 + bk) * 16 + r) * 64 + lane] = o[bk][r] * inv;
    }
    __syncthreads();
    if (s == 0) {
      float ss = 0.f;
#pragma unroll
      for (int bk = 0; bk < 4; ++bk)
#pragma unroll
        for (int r = 0; r < 16; ++r) { const float d = o[bk][r] * inv - lam * X[((qb * 4 + bk) * 16 + r) * 64 + lane]; o[bk][r] = d; ss += d * d; }
      ss += __shfl_xor(ss, 32);
      const float rr = rsqrtf(ss * (1.f / 128.f) + EPS) * 0.8f;
      const float* g = p.in[L0_SUBLN];
#pragma unroll
      for (int bk = 0; bk < 4; ++bk)
#pragma unroll
        for (int rg = 0; rg < 4; ++rg) { const int dv = bk * 32 + 8 * rg + 4 * hi; const float4 gv = *(const float4*)(g + dv);
          st_att4(ATT, (size_t)qrow, h * 128 + dv, o[bk][4 * rg] * rr * gv.x, o[bk][4 * rg + 1] * rr * gv.y, o[bk][4 * rg + 2] * rr * gv.z, o[bk][4 * rg + 3] * rr * gv.w); }
    }
    __syncthreads();
  }
}

template <int ABL = 0> DEVI void phase_attnB(const Params& p, ldsp_t lds) {
  typedef Geo<64, 2> G;
  const int tid = ftid(), lane = tid & 63, wave = __builtin_amdgcn_readfirstlane(tid >> 6), r32 = lane & 31, hi = lane >> 5;
  const bf16_t* Q = (const bf16_t*)(p.ws + WS_QKV0); bf16_t* ATT = (bf16_t*)(p.ws + (ABL ? WS_MIX0 : WS_ATT0));
  constexpr int NU_LAT = NB * 8 * 16, NU_CTX = NB * 8;
  FA_LAS float* RPB = (FA_LAS float*)(lds + 3 * (64 * 80 + 64 * 80));
  for (int u = vblock(); u < NU_LAT + NU_CTX; u += gridDim.x) {
    const bool lat = u < NU_LAT;
    int b, h, qrow_g = 0, c0 = 0, rlo = 0, nlat = 0, rs_w = 0, grow;
    if (lat) { b = u >> 7; h = (u >> 4) & 7; const int qr0 = (u & 15) * 4; qrow_g = qr0 + (wave >> 1); c0 = 32 * (wave & 1);
      rlo = min(max(qr0 - 4, 0), 56); const int rhi = min(max(qr0 - 1, 0), 56) + 7; nlat = rhi - rlo + 1; rs_w = min(max(qrow_g - 4, 0), 56);
      grow = b * SEQ + qrow_g * 64 + c0 + r32; }
    else { const int v = u - NU_LAT; b = v >> 3; h = v & 7; grow = NLAT + b * CTXL + wave * 32 + r32; }
    const int ntiles = nlat + 4;
    for (int i = tid; i < 15 * 31; i += NT) RPB[i] = p.in[L0_RPB][h * 465 + i] * LOG2E;
    const unsigned char* QK8 = (const unsigned char*)(p.ws + WS_QKV0);
    v8i_t qf;
    { const unsigned char* qp = QK8 + (size_t)grow * (N_IN0 * 2) + 1536 + h * 64 + 32 * hi; const u32x4 q0_ = *(const u32x4*)qp, q1_ = *(const u32x4*)(qp + 16); qf = cat8(q0_, q1_); }
    f32x16 o[2];
#pragma unroll
    for (int bk = 0; bk < 2; ++bk)
#pragma unroll
      for (int r = 0; r < 16; ++r) o[bk][r] = 0.f;
    float m = -1e30f, l = 0.f;
    const int cbase = NLAT + b * CTXL, lbase = b * SEQ;
    const int qc = c0 + r32, cs = min(max(qc - 8, 0), 48);
    flash_pass8<2, 64>(lds, ntiles, QK8, N_IN0 * 2, 2048 + h * 64, (const unsigned char*)(p.ws + WS_VTB) + (size_t)((b * 8 + h) * 64) * 4352, qf, 0, wave >= 4,
      [&](int kt, int i) { return kt < nlat ? lbase + (rlo + kt) * 64 + i : cbase + (kt - nlat) * 64 + i; },
      [&](int kt) { return kt < nlat ? (rlo + kt) * 64 : 4096 + (kt - nlat) * 64; },
      [&](int kt, f32x16& p0, f32x16& p1) {
        if (ABL != 1 && kt < nlat) { const int kr = rlo + kt; const bool rowok = (kr >= rs_w && kr < rs_w + 8);
          const FA_LAS float* bp = RPB + min(max(kr - qrow_g + 7, 0), 14) * 31;
          { float b0[16];
#pragma unroll
            for (int r = 0; r < 16; ++r) { const int k0 = crow(r, hi); b0[r] = bp[min(max(k0 - qc + 15, 0), 30)]; }
#pragma unroll
            for (int r = 0; r < 16; ++r) { const int k0 = crow(r, hi); const float v0 = p0[r] + b0[r]; p0[r] = (rowok && k0 >= cs && k0 < cs + 16) ? v0 : -INFINITY; } }
          asm volatile("" ::: "memory");
          { float b1[16];
#pragma unroll
            for (int r = 0; r < 16; ++r) { const int k1 = 32 + crow(r, hi); b1[r] = bp[min(max(k1 - qc + 15, 0), 30)]; }
#pragma unroll
            for (int r = 0; r < 16; ++r) { const int k1 = 32 + crow(r, hi); const float v1 = p1[r] + b1[r]; p1[r] = (rowok && k1 >= cs && k1 < cs + 16) ? v1 : -INFINITY; } } } },
      [&](int kt) { const int kr = rlo + kt; return kt >= nlat || (kr >= rs_w && kr < rs_w + 8); },
      o, m, l);
    l += __shfl_xor(l, 32);
    const float inv = 1.f / l;
#pragma unroll
    for (int bk = 0; bk < 2; ++bk)
#pragma unroll
      for (int rg = 0; rg < 4; ++rg) { const int dv = bk * 32 + 8 * rg + 4 * hi;
        st_att4(ATT, (size_t)grow, 512 + h * 64 + dv, o[bk][4 * rg] * inv, o[bk][4 * rg + 1] * inv, o[bk][4 * rg + 2] * inv, o[bk][4 * rg + 3] * inv); }
    __syncthreads();
  }
}

DEVI void phase_attnC(const Params& p, ldsp_t lds, int* ctr) {
  const int tid = ftid(), lane = tid & 63, wave = __builtin_amdgcn_readfirstlane(tid >> 6), r32 = lane & 31, hi = lane >> 5;
  const bf16_t* P1 = (const bf16_t*)(p.ws + WS_P1); bf16_t* ATT = (bf16_t*)(p.ws + WS_ATT1);
  FA_LAS int* uq = (FA_LAS int*)(lds + 3 * Geo<64, 2>::STAGE + 64);
  for (;;) {
    if (tid == 0) *uq = atomicAdd(ctr, 1);
    __syncthreads();
    const int u = *uq;
    __syncthreads();
    if (u >= NB * 2 * 64) break;
    const int b = u >> 7, g = (u >> 6) & 1, tq = u & 63, hq = g * 4 + (wave >> 1), t = tq * 64 + 32 * (wave & 1) + r32, grow = b * SEQ + t;
    const int klo = max(tq - 2, 0), khi = min(tq + 2, 63), nwin = khi - klo + 1, ntiles = nwin + 4;
    bf16x8 q[4];
#pragma unroll
    for (int d0 = 0; d0 < 4; ++d0) q[d0] = load_q8(P1 + (size_t)grow * 2304 + hq * 64 + 16 * d0 + 8 * hi, C2);
    f32x16 o[2];
#pragma unroll
    for (int bk = 0; bk < 2; ++bk)
#pragma unroll
      for (int r = 0; r < 16; ++r) o[bk][r] = 0.f;
    float m = -1e30f, l = 0.f;
    const int cbase = NLAT + b * CTXL, lbase = b * SEQ;
    flash_pass2<64, 2, 0, 2>(lds, ntiles, P1, 2304, 512 + g * 64, 640 + g * 64, q, 0,
      [&](int kt, int i) { return kt < nwin ? lbase + (klo + kt) * 64 + i : cbase + (kt - nwin) * 64 + i; },
      [&](int kt, f32x16& p0, f32x16& p1) {
        if (kt < nwin) { const int kp = (klo + kt) * 64 - t;
#pragma unroll
          for (int r = 0; r < 16; ++r) { const int d0 = kp + crow(r, hi), d1 = d0 + 32;
            if (d0 < -128 || d0 > 128) p0[r] = -INFINITY; if (d1 < -128 || d1 > 128) p1[r] = -INFINITY; } } },
      o, m, l);
    l += __shfl_xor(l, 32);
    { const float sk = p.in[L1_SINKS][hq] * LOG2E, mn = fmaxf(m, sk), alpha = __builtin_amdgcn_exp2f(m - mn);
      l = l * alpha + __builtin_amdgcn_exp2f(sk - mn);
#pragma unroll
      for (int bk = 0; bk < 2; ++bk)
#pragma unroll
        for (int r = 0; r < 16; ++r) o[bk][r] *= alpha; }
    const float inv = 1.f / l;
#pragma unroll
    for (int bk = 0; bk < 2; ++bk)
#pragma unroll
      for (int rg = 0; rg < 4; ++rg) { const int dv = bk * 32 + 8 * rg + 4 * hi;
        st_att4(ATT, (size_t)grow, hq * 64 + dv, o[bk][4 * rg] * inv, o[bk][4 * rg + 1] * inv, o[bk][4 * rg + 2] * inv, o[bk][4 * rg + 3] * inv); }
    __syncthreads();
  }
}
}
namespace fs {
using fa::bf16x8; using fa::s16x4; using fa::f32x16; using fa::ldsp_t; using fa::u32x4; using fa::cvtpk; using fa::vtr; using fa::crow; using fa::LOG2E;
typedef unsigned u32x2 __attribute__((ext_vector_type(2)));

DEVI void phase_conv(const Params& p) {
  const bf16_t* P1 = (const bf16_t*)(p.ws + WS_P1); bf16_t* U = (bf16_t*)(p.ws + WS_U);
  const float* cw = p.in[L1_CONVW]; const float* cb = p.in[L1_CONVB];
  const int nitems = (NROW / 16) * 128;
  for (int it = blockIdx.x * NT + ftid(); it < nitems; it += gridDim.x * NT) {
    const int cg = it & 127, rc = it >> 7, r0 = rc * 16, ch = cg * 8;
    int s0, len; if (r0 < NLAT) { s0 = r0 & ~4095; len = SEQ; } else { s0 = NLAT + ((r0 - NLAT) & ~255); len = CTXL; }
    const int t0 = r0 - s0;
    float w[5][8], bias[8];
#pragma unroll
    for (int j = 0; j < 5; ++j) { const float4 a = *(const float4*)(cw + j * 1024 + ch), b = *(const float4*)(cw + j * 1024 + ch + 4);
      w[j][0] = a.x; w[j][1] = a.y; w[j][2] = a.z; w[j][3] = a.w; w[j][4] = b.x; w[j][5] = b.y; w[j][6] = b.z; w[j][7] = b.w; }
    { const float4 a = *(const float4*)(cb + ch), b = *(const float4*)(cb + ch + 4); bias[0] = a.x; bias[1] = a.y; bias[2] = a.z; bias[3] = a.w; bias[4] = b.x; bias[5] = b.y; bias[6] = b.z; bias[7] = b.w; }
    float win[5][8];
    auto ldrow = [&](int t, float (&d)[8]) {
      if (t < 0 || t >= len) {
#pragma unroll
        for (int k = 0; k < 8; ++k) d[k] = 0.f; return; }
      const u32x4 v = *(const u32x4*)(P1 + (size_t)(s0 + t) * 2304 + 768 + ch);
#pragma unroll
      for (int k = 0; k < 4; ++k) { d[2 * k] = __uint_as_float(v[k] << 16); d[2 * k + 1] = __uint_as_float(v[k] & 0xffff0000u); } };
    ldrow(t0 - 2, win[0]); ldrow(t0 - 1, win[1]); ldrow(t0, win[2]); ldrow(t0 + 1, win[3]);
#pragma unroll
    for (int i = 0; i < 16; ++i) {
      ldrow(t0 + i + 2, win[(i + 4) % 5]);
      float o[8];
#pragma unroll
      for (int k = 0; k < 8; ++k) { float a = bias[k];
#pragma unroll
        for (int j = 0; j < 5; ++j) a += w[j][k] * win[(i + j) % 5][k];
        o[k] = a * __builtin_amdgcn_rcpf(1.f + __expf(-a)); }
      u32x4 ov; ov[0] = cvtpk(o[0], o[1]); ov[1] = cvtpk(o[2], o[3]); ov[2] = cvtpk(o[4], o[5]); ov[3] = cvtpk(o[6], o[7]);
      *(u32x4*)(U + (size_t)(r0 + i) * 1024 + ch) = ov;
    }
  }
}

DEVI float softplus_f(float v) { if (v > 20.f) return v; const float x = __expf(v); return x < 1e-3f ? x * (1.f - 0.5f * x) : __logf(1.f + x); }
constexpr int BSTR = 272, XSTR = 192;
constexpr int L_BM = 0, L_XD = 128 * BSTR, L_XW = L_XD + 128 * XSTR, L_HT = L_XW + 128 * XSTR, L_CUM = L_HT + 128 * XSTR, L_DTV = L_CUM + 1024, L_XCH = L_DTV + 1024, L_TOT = L_XCH + 8 * 4096;

template <int ABL = 0> DEVI void phase_ssd(const Params& p, ldsp_t lds) {
  const int tid = ftid(), lane = tid & 63, wave = __builtin_amdgcn_readfirstlane(tid >> 6), r32 = lane & 31, hi = lane >> 5;
  const int pb = wave >> 2, lb = (wave < 4) ? (wave & 3) : 3 - (wave & 3);
  const bf16_t* U = (const bf16_t*)(p.ws + WS_U); const float* DT = (const float*)(p.ws + WS_DT);
  bf16_t* YFB = (bf16_t*)(p.ws + WS_YS);
  const int trow_off = 4 * hi + ((lane & 15) >> 2), tcol_off = 32 * ((lane >> 4) & 1) + 8 * (lane & 3);
  for (int it = blockIdx.x; it < NB * 2 * 8; it += gridDim.x) {
    const int b = it >> 4, dir = (it >> 3) & 1, hd = it & 7, g = hd >> 2;
    const float a2 = -expf(p.in[dir ? L1_ALOGB : L1_ALOGF][hd]) * LOG2E; const float dtb = p.in[dir ? L1_DTBB : L1_DTBF][hd];
    auto tokrow = [&](int c, int i) { const int seg = c >= 2, len = seg ? SEQ : CTXL, j = (seg ? c - 2 : c) * 128 + i; return (seg ? b * SEQ : NLAT + b * CTXL) + (dir ? len - 1 - j : j); };
    f32x16 hacc;
#pragma unroll
    for (int r = 0; r < 16; ++r) hacc[r] = 0.f;
    for (int i = tid; i < 128 * XSTR / 4; i += NT) ((FA_LAS unsigned*)(lds + L_HT))[i] = 0u;
    u32x4 sb_[4], sx_[2]; float sdt0 = 0.f, sdt1 = 0.f; bf16x8 cfn[8];
    auto prefetch = [&](int c) {
#pragma unroll
      for (int i = 0; i < 4; ++i) { const int ch = tid + NT * i; sb_[i] = *(const u32x4*)(U + (size_t)tokrow(c, ch >> 4) * 1024 + 512 + g * 128 + (ch & 15) * 8); }
#pragma unroll
      for (int i = 0; i < 2; ++i) { const int ch = tid + NT * i; sx_[i] = *(const u32x4*)(U + (size_t)tokrow(c, ch >> 3) * 1024 + hd * 64 + (ch & 7) * 8); }
      if (tid < 64) { sdt0 = DT[(size_t)tokrow(c, 2 * tid) * 16 + dir * 8 + hd]; sdt1 = DT[(size_t)tokrow(c, 2 * tid + 1) * 16 + dir * 8 + hd]; }
      const bf16_t* crowp = U + (size_t)tokrow(c, lb * 32 + r32) * 1024 + 768 + g * 128 + 8 * hi;
#pragma unroll
      for (int ks = 0; ks < 8; ++ks) cfn[ks] = *(const bf16x8*)(crowp + 16 * ks);
    };
    auto s1 = [&](int c) {
      if (tid < 64) {
        FA_LAS float* CUMw = (FA_LAS float*)(lds + L_CUM + (c & 1) * 512); FA_LAS float* DTVw = (FA_LAS float*)(lds + L_DTV + (c & 1) * 512);
        const float r0 = sdt0 + dtb, r1 = sdt1 + dtb; const float d0 = softplus_f(r0), d1 = softplus_f(r1);
        const float a0 = d0 * a2, a1 = d1 * a2; float v = a0 + a1;
        v = wave_scan_incl(v);
        DTVw[2 * tid] = d0; DTVw[2 * tid + 1] = d1; CUMw[2 * tid] = v - a1; CUMw[2 * tid + 1] = v;
      } };
    prefetch(0);
    s1(0);
    __syncthreads();
    for (int c = 0; c < 34; ++c) {
      const FA_LAS float* CUM = (const FA_LAS float*)(lds + L_CUM + (c & 1) * 512); const FA_LAS float* DTV = (const FA_LAS float*)(lds + L_DTV + (c & 1) * 512);
      const float cl = CUM[127];
#pragma unroll
      for (int i = 0; i < 4; ++i) { const int ch = tid + NT * i; *(FA_LAS u32x4*)(lds + L_BM + (ch >> 4) * BSTR + (ch & 15) * 16) = sb_[i]; }
#pragma unroll
      for (int i = 0; i < 2; ++i) { const int ch = tid + NT * i, s = ch >> 3; const float d = DTV[s], wv = d * __builtin_amdgcn_exp2f(cl - CUM[s]);
        u32x4 xd, xw;
#pragma unroll
        for (int k = 0; k < 4; ++k) { const float x0 = __uint_as_float(sx_[i][k] << 16), x1 = __uint_as_float(sx_[i][k] & 0xffff0000u); xd[k] = cvtpk(x0 * d, x1 * d); xw[k] = cvtpk(x0 * wv, x1 * wv); }
        *(FA_LAS u32x4*)(lds + L_XD + s * XSTR + (ch & 7) * 16) = xd; *(FA_LAS u32x4*)(lds + L_XW + s * XSTR + (ch & 7) * 16) = xw; }
      bf16x8 cf[8];
#pragma unroll
      for (int ks = 0; ks < 8; ++ks) cf[ks] = cfn[ks];
      __syncthreads();
      if (ABL != 3) { if (c + 1 < 34) prefetch(c + 1); }
      if (c >= 2 && ABL != 1) {
        f32x16 y;
#pragma unroll
        for (int r = 0; r < 16; ++r) y[r] = 0.f;
        { const ldsp_t hb = lds + L_HT + (8 * hi + ((lane & 15) >> 2)) * XSTR + pb * 64 + tcol_off;
          f32x16 y2;
#pragma unroll
          for (int r = 0; r < 16; ++r) y2[r] = 0.f;
#pragma unroll
          for (int ks = 0; ks < 8; ++ks) { const s16x4 lo = vtr(hb + (16 * ks) * XSTR), h8 = vtr(hb + (16 * ks + 4) * XSTR);
            const bf16x8 hf = {lo[0], lo[1], lo[2], lo[3], h8[0], h8[1], h8[2], h8[3]};
            if (ks & 1) y2 = __builtin_amdgcn_mfma_f32_32x32x16_bf16(hf, cf[ks], y2, 0, 0, 0); else y = __builtin_amdgcn_mfma_f32_32x32x16_bf16(hf, cf[ks], y, 0, 0, 0); }
          y += y2; }
        const float cuml = CUM[lb * 32 + r32];
        { const float e = __builtin_amdgcn_exp2f(cuml);
#pragma unroll
          for (int r = 0; r < 16; ++r) y[r] *= e; }
        f32x16 yo;
#pragma unroll
        for (int r = 0; r < 16; ++r) yo[r] = 0.f;
        for (int sb = pb; sb <= lb; sb += 2) {
          f32x16 gt, gt2;
#pragma unroll
          for (int r = 0; r < 16; ++r) { gt[r] = 0.f; gt2[r] = 0.f; }
          const ldsp_t bb = lds + L_BM + (sb * 32 + r32) * BSTR + 16 * hi;
#pragma unroll
          for (int ks = 0; ks < 8; ks += 2) { gt = __builtin_amdgcn_mfma_f32_32x32x16_bf16(*(const FA_LAS bf16x8*)(bb + 32 * ks), cf[ks], gt, 0, 0, 0);
            gt2 = __builtin_amdgcn_mfma_f32_32x32x16_bf16(*(const FA_LAS bf16x8*)(bb + 32 * ks + 32), cf[ks + 1], gt2, 0, 0, 0); }
          gt += gt2;
          const bool diag = (sb == lb);
#pragma unroll
          for (int r = 0; r < 16; ++r) { const int sl = crow(r, hi); const float v = gt[r] * __builtin_amdgcn_exp2f(cuml - CUM[sb * 32 + sl]); gt[r] = (diag && sl > r32) ? 0.f : v; }
          u32x4 t0, t1;
          t0[0] = cvtpk(gt[0], gt[1]); t0[1] = cvtpk(gt[2], gt[3]); t0[2] = cvtpk(gt[4], gt[5]); t0[3] = cvtpk(gt[6], gt[7]);
          t1[0] = cvtpk(gt[8], gt[9]); t1[1] = cvtpk(gt[10], gt[11]); t1[2] = cvtpk(gt[12], gt[13]); t1[3] = cvtpk(gt[14], gt[15]);
          const bf16x8 pm0 = __builtin_bit_cast(bf16x8, t0), pm1 = __builtin_bit_cast(bf16x8, t1);
          const ldsp_t xb = lds + L_XD + (sb * 32 + trow_off) * XSTR + pb * 64 + tcol_off;
          const ldsp_t xo = lds + L_XD + (sb * 32 + trow_off) * XSTR + (1 - pb) * 64 + tcol_off;
          const s16x4 a0 = vtr(xb), a1 = vtr(xb + 8 * XSTR), a2 = vtr(xb + 16 * XSTR), a3 = vtr(xb + 24 * XSTR);
          const s16x4 b0 = vtr(xo), b1 = vtr(xo + 8 * XSTR), b2 = vtr(xo + 16 * XSTR), b3 = vtr(xo + 24 * XSTR);
          { const bf16x8 xf = {a0[0], a0[1], a0[2], a0[3], a1[0], a1[1], a1[2], a1[3]}; y = __builtin_amdgcn_mfma_f32_32x32x16_bf16(xf, pm0, y, 0, 0, 0); }
          { const bf16x8 xf = {b0[0], b0[1], b0[2], b0[3], b1[0], b1[1], b1[2], b1[3]}; yo = __builtin_amdgcn_mfma_f32_32x32x16_bf16(xf, pm0, yo, 0, 0, 0); }
          { const bf16x8 xf = {a2[0], a2[1], a2[2], a2[3], a3[0], a3[1], a3[2], a3[3]}; y = __builtin_amdgcn_mfma_f32_32x32x16_bf16(xf, pm1, y, 0, 0, 0); }
          { const bf16x8 xf = {b2[0], b2[1], b2[2], b2[3], b3[0], b3[1], b3[2], b3[3]}; yo = __builtin_amdgcn_mfma_f32_32x32x16_bf16(xf, pm1, yo, 0, 0, 0); }
        }
        { FA_LAS float* X = (FA_LAS float*)(lds + L_XCH) + (pb * 4 + lb) * 1024;
#pragma unroll
          for (int r = 0; r < 16; ++r) X[r * 64 + lane] = yo[r]; }
        __syncthreads();
        { const FA_LAS float* X = (const FA_LAS float*)(lds + L_XCH) + ((1 - pb) * 4 + lb) * 1024;
#pragma unroll
          for (int r = 0; r < 16; ++r) y[r] += X[r * 64 + lane]; }
        const int j = (c - 2) * 128 + lb * 32 + r32, tok = dir ? SEQ - 1 - j : j;
        bf16_t* yp = YFB + ((size_t)dir * NLAT + (size_t)b * SEQ + tok) * 512 + hd * 64 + pb * 32 + 4 * hi;
#pragma unroll
        for (int rg = 0; rg < 4; ++rg) { u32x2 w; w[0] = cvtpk(y[4 * rg], y[4 * rg + 1]); w[1] = cvtpk(y[4 * rg + 2], y[4 * rg + 3]); *(u32x2*)(yp + 8 * rg) = w; }
      }
      if (ABL != 2) { const float e = __builtin_amdgcn_exp2f(cl);
        f32x16 h2;
#pragma unroll
        for (int r = 0; r < 16; ++r) { hacc[r] *= e; h2[r] = 0.f; }
        const ldsp_t xb = lds + L_XW + (8 * hi + ((lane & 15) >> 2)) * XSTR + pb * 64 + tcol_off;
        const ldsp_t bb = lds + L_BM + (8 * hi + ((lane & 15) >> 2)) * BSTR + lb * 64 + tcol_off;
#pragma unroll
        for (int ks = 0; ks < 8; ++ks) {
          const s16x4 xl = vtr(xb + (16 * ks) * XSTR), xh = vtr(xb + (16 * ks + 4) * XSTR), bl = vtr(bb + (16 * ks) * BSTR), bh = vtr(bb + (16 * ks + 4) * BSTR);
          const bf16x8 xf = {xl[0], xl[1], xl[2], xl[3], xh[0], xh[1], xh[2], xh[3]}, bf = {bl[0], bl[1], bl[2], bl[3], bh[0], bh[1], bh[2], bh[3]};
          if (ks & 1) h2 = __builtin_amdgcn_mfma_f32_32x32x16_bf16(xf, bf, h2, 0, 0, 0); else hacc = __builtin_amdgcn_mfma_f32_32x32x16_bf16(xf, bf, hacc, 0, 0, 0);
        }
        hacc += h2; }
      if (c + 1 < 34) s1(c + 1);
      __syncthreads();
      { const ldsp_t hp = lds + L_HT + (lb * 32 + r32) * XSTR + (pb * 32 + 4 * hi) * 2;
#pragma unroll
        for (int rg = 0; rg < 4; ++rg) { u32x2 w; w[0] = cvtpk(hacc[4 * rg], hacc[4 * rg + 1]); w[1] = cvtpk(hacc[4 * rg + 2], hacc[4 * rg + 3]); *(FA_LAS u32x2*)(hp + 16 * rg) = w; } }
    }
    __syncthreads();
  }
}

DEVI void phase_ssd_out(const Params& p) {
  const int lane = ftid() & 63, gw = blockIdx.x * NWAVE + (ftid() >> 6), NGW = gridDim.x * NWAVE;
  const bf16_t* U = (const bf16_t*)(p.ws + WS_U); const bf16_t* P1 = (const bf16_t*)(p.ws + WS_P1); const bf16_t* YFB = (const bf16_t*)(p.ws + WS_YS);
  bf16_t* ATT = (bf16_t*)(p.ws + WS_ATT1);
  for (int r = gw; r < NLAT; r += NGW) {
    const int c0 = lane * 8, hd = c0 >> 6; const float dsk = p.in[L1_DSKIP][hd];
    const u32x4 yf = *(const u32x4*)(YFB + (size_t)r * 512 + c0), yb = *(const u32x4*)(YFB + ((size_t)NLAT + r) * 512 + c0);
    const u32x4 xw = *(const u32x4*)(U + (size_t)r * 1024 + c0), zw = *(const u32x4*)(P1 + (size_t)r * 2304 + 1792 + c0);
    float y[8]; float ss = 0.f;
#pragma unroll
    for (int i = 0; i < 4; ++i) {
      const float x0 = __uint_as_float(xw[i] << 16), x1 = __uint_as_float(xw[i] & 0xffff0000u), z0 = __uint_as_float(zw[i] << 16), z1 = __uint_as_float(zw[i] & 0xffff0000u);
      const float f0 = __uint_as_float(yf[i] << 16) + __uint_as_float(yb[i] << 16), f1 = __uint_as_float(yf[i] & 0xffff0000u) + __uint_as_float(yb[i] & 0xffff0000u);
      y[2 * i] = (f0 + dsk * x0) * silu_f(z0); y[2 * i + 1] = (f1 + dsk * x1) * silu_f(z1);
      ss += y[2 * i] * y[2 * i] + y[2 * i + 1] * y[2 * i + 1];
    }
    ss = half_sum(ss);
    const float rr = rsqrtf(ss * (1.f / 256.f) + EPS);
    const float4 g0 = *(const float4*)(p.in[L1_GNORM] + c0), g1 = *(const float4*)(p.in[L1_GNORM] + c0 + 4);
    u32x4 w; w[0] = cvtpk(y[0] * rr * g0.x, y[1] * rr * g0.y); w[1] = cvtpk(y[2] * rr * g0.z, y[3] * rr * g0.w); w[2] = cvtpk(y[4] * rr * g1.x, y[5] * rr * g1.y); w[3] = cvtpk(y[6] * rr * g1.z, y[7] * rr * g1.w);
    *(u32x4*)(ATT + (size_t)r * DM + 512 + c0) = w;
  }
}
}
#ifndef TOPK_COPY
#define TOPK_COPY false
#endif
namespace ft {
using fa::ldsp_t; using fa::u32x4;

DEVI int block_excl_scan(int v, FA_LAS int* wsum, int tid, int* tot) {
  const int lane = tid & 63, wave = tid >> 6;
  const int inc = wave_scan_incl_i(v);
  __syncthreads();
  if (lane == 63) wsum[wave] = inc;
  __syncthreads();
  int base = 0, total = 0;
#pragma unroll
  for (int w = 0; w < 8; ++w) { const int s = wsum[w]; if (w < wave) base += s; total += s; }
  *tot = total;
  return base + inc - v;
}

template <int EPT, bool GATHER_COPY>
DEVI void topk_item(const Params& p, ldsp_t lds, int e, int n, int cap, int row0, int slot0, int erows) {
  const int tid = ftid(), lane = tid & 63, wave = tid >> 6;
  const float* AFFT = (const float*)(p.ws + WS_AFF); int* SLOT = (int*)(p.ws + WS_SLOT); float* GV = (float*)(p.ws + WS_GATEV);
  const bf16_t* H = (const bf16_t*)(p.ws + WS_H); bf16_t* XG = (bf16_t*)(p.ws + WS_XG); int* IDX = (int*)(p.ws + WS_IDX);
  FA_LAS unsigned* hist = (FA_LAS unsigned*)lds;
  FA_LAS int* misc = (FA_LAS int*)(lds + 1024);
  FA_LAS int* wsum = (FA_LAS int*)(lds + 1024 + 64);
  FA_LAS int* list = (FA_LAS int*)(lds + 2048);
  const bool act = tid * EPT < n;
  unsigned key[EPT];
#pragma unroll
  for (int j = 0; j < EPT; ++j) key[j] = act ? __float_as_uint(AFFT[(size_t)e * NROW + row0 + tid * EPT + j]) : 0u;
  unsigned prefix = 0u, mask = 0u; int k = cap;
#pragma unroll 1
  for (int pass = 0; pass < 4; ++pass) {
    const int shift = 24 - 8 * pass;
    __syncthreads();
    if (tid < 256) hist[tid] = 0u;
    __syncthreads();
    if (act) {
#pragma unroll
      for (int j = 0; j < EPT; ++j) if ((key[j] & mask) == prefix) atomicAdd((unsigned*)&hist[(key[j] >> shift) & 255u], 1u);
    }
    __syncthreads();
    if (wave == 0) {
      const int h0 = hist[4 * lane], h1 = hist[4 * lane + 1], h2 = hist[4 * lane + 2], h3 = hist[4 * lane + 3];
      const int s = h0 + h1 + h2 + h3; const int pre = wave_scan_incl_i(s);
      int c = __builtin_amdgcn_readlane(pre, 63) - pre;
      const int hh[4] = {h0, h1, h2, h3};
#pragma unroll
      for (int b = 3; b >= 0; --b) { if (c < k && k <= c + hh[b]) { misc[0] = 4 * lane + b; misc[1] = k - c; } c += hh[b]; }
    }
    __syncthreads();
    prefix |= ((unsigned)misc[0]) << shift; mask |= 255u << shift; k = misc[1];
  }
  int ce = 0;
#pragma unroll
  for (int j = 0; j < EPT; ++j) ce += (act && key[j] == prefix) ? 1 : 0;
  int tot; const int eq_before = block_excl_scan(ce, wsum, tid, &tot);
  int cs = 0, eqr = eq_before; bool sel[EPT];
#pragma unroll
  for (int j = 0; j < EPT; ++j) { bool s = false; if (act) { if (key[j] > prefix) s = true; else if (key[j] == prefix) { s = eqr < k; ++eqr; } } sel[j] = s; cs += s ? 1 : 0; }
  int slot = block_excl_scan(cs, wsum, tid, &tot);
  if (act) {
#pragma unroll
    for (int j = 0; j < EPT; ++j) { const int row = row0 + tid * EPT + j;
      if (sel[j]) { if (GATHER_COPY) list[slot] = row; else IDX[e * erows + slot0 + slot] = row; GV[e * erows + slot0 + slot] = __uint_as_float(key[j]); SLOT[(size_t)row * 16 + e] = slot0 + slot; ++slot; }
      else SLOT[(size_t)row * 16 + e] = -1; }
  }
  if (GATHER_COPY) {
    __syncthreads();
    for (int s = wave; s < cap; s += NWAVE) {
      const u32x4* src = (const u32x4*)(H + (size_t)list[s] * DM) + lane; u32x4* dst = (u32x4*)(XG + ((size_t)e * erows + slot0 + s) * DM) + lane;
      const u32x4 a = src[0], b2 = src[64]; dst[0] = a; dst[64] = b2;
    }
  }
  __syncthreads();
}

DEVI void phase_topk(const Params& p, ldsp_t lds, int layer) {
  const int erows = layer ? EROWS1 : EROWS0;
  const int nlat = NB * NE, nitems = nlat + (layer ? 0 : NB * NE);
  const int G = gridDim.x;
  for (int it = blockIdx.x; it < nitems; it += G) {
    if (it < nlat) { const int b = it / NE, e = it % NE; topk_item<8, TOPK_COPY>(p, lds, e, SEQ, CAP_L, b * SEQ, b * CAP_L, erows); }
    else { const int i2 = it - nlat, b = i2 / NE, e = i2 % NE; topk_item<1, TOPK_COPY>(p, lds, e, CTXL, CAP_C, NLAT + b * CTXL, NB * CAP_L + b * CAP_C, erows); }
  }
}
}
#ifndef MOE1_FP8
#define MOE1_FP8 1
#endif
#ifndef MOE0_FP8
#define MOE0_FP8 1
#endif
namespace fr {
using fa::ldsp_t; using fa::u32x4; using fa::cvtpk;
typedef unsigned u32x2 __attribute__((ext_vector_type(2)));
typedef float f32x4 __attribute__((ext_vector_type(4)));
struct V16 { f32x4 v[4]; };
DEVI V16 ldf(const float* r, int lane) { V16 o; const f32x4* q = (const f32x4*)r + lane;
#pragma unroll
  for (int j = 0; j < 4; ++j) o.v[j] = q[64 * j]; return o; }
struct B16 { u32x2 v[4]; };
DEVI B16 ldb_raw(const bf16_t* r, int lane) { B16 o; const u32x2* q = (const u32x2*)r + lane;
#pragma unroll
  for (int j = 0; j < 4; ++j) o.v[j] = q[64 * j]; return o; }
DEVI V16 b2v(const B16& b) { V16 o;
#pragma unroll
  for (int j = 0; j < 4; ++j) { o.v[j][0] = __uint_as_float(b.v[j][0] << 16); o.v[j][1] = __uint_as_float(b.v[j][0] & 0xffff0000u); o.v[j][2] = __uint_as_float(b.v[j][1] << 16); o.v[j][3] = __uint_as_float(b.v[j][1] & 0xffff0000u); }
  return o; }
DEVI void stf(float* r, int lane, const V16& o) { f32x4* q = (f32x4*)r + lane;
#pragma unroll
  for (int j = 0; j < 4; ++j) q[64 * j] = o.v[j]; }
DEVI void stb(bf16_t* r, int lane, const V16& o) { u32x2* q = (u32x2*)r + lane;
#pragma unroll
  for (int j = 0; j < 4; ++j) { u32x2 w; w[0] = cvtpk(o.v[j][0], o.v[j][1]); w[1] = cvtpk(o.v[j][2], o.v[j][3]); q[64 * j] = w; } }
DEVI float sumsq(const V16& o) { f32x4 s = o.v[0] * o.v[0];
#pragma unroll
  for (int j = 1; j < 4; ++j) s += o.v[j] * o.v[j];
  return wave_sum((s[0] + s[1]) + (s[2] + s[3])); }

DEVI void phase_prenorm0(const Params& p) {
  const int lane = ftid() & 63, gw = blockIdx.x * NWAVE + (ftid() >> 6), NGW = gridDim.x * NWAVE;
  const float* MOD = (const float*)(p.ws + WS_CTL + CTL_MOD); bf16_t* H = (bf16_t*)(p.ws + WS_H);
  const int rpw = (NROW + NGW - 1) / NGW;
  const int r0 = gw * rpw, r1 = min(r0 + rpw, NROW);
  if (r0 >= r1) return;
  const V16 g = ldf(p.in[L0_GPREMIX], lane);
  int cur = -1; V16 gs, sh;
  auto src = [&](int r) { return r < NLAT ? p.in[I_X] + (size_t)r * DM : p.in[I_CTX] + (size_t)(r - NLAT) * DM; };
  V16 xn = ldf(src(r0), lane), xn2 = xn;
  if (r0 + 1 < r1) xn2 = ldf(src(r0 + 1), lane);
  for (int r = r0; r < r1; ++r) {
    const V16 x = xn; xn = xn2; if (r + 2 < r1) xn2 = ldf(src(r + 2), lane);
    const int mr = row_modrow(r);
    if (mr != cur) { cur = mr; const float* m = MOD + (size_t)mr * 6144; const V16 sc = ldf(m + 1024, lane); sh = ldf(m, lane);
#pragma unroll
      for (int j = 0; j < 4; ++j) gs.v[j] = g.v[j] * (sc.v[j] + 1.f); }
    const float rr = rsqrtf(sumsq(x) * (1.f / DM) + EPS);
    V16 h;
#pragma unroll
    for (int j = 0; j < 4; ++j) h.v[j] = x.v[j] * rr * gs.v[j] + sh.v[j];
    if (QKV0_FP8) {
      unsigned* q8 = (unsigned*)((unsigned char*)H + (size_t)r * DM) + lane;
#pragma unroll
      for (int j = 0; j < 4; ++j) q8[64 * j] = nv::pack4_fp8(h.v[j][0] * nv::A8_SCALE, h.v[j][1] * nv::A8_SCALE, h.v[j][2] * nv::A8_SCALE, h.v[j][3] * nv::A8_SCALE);
    } else stb(H + (size_t)r * DM, lane, h);
  }
}

template <int ABL = 0> DEVI void phase_postmix(const Params& p, ldsp_t lds, int layer) {
  const int tid = ftid(), lane = tid & 63, gw = blockIdx.x * NWAVE + (tid >> 6), NGW = gridDim.x * NWAVE;
  const float* MOD = (const float*)(p.ws + WS_CTL + CTL_MOD) + (size_t)layer * 9 * 6144;
  const bf16_t* MIX = (const bf16_t*)(p.ws + (layer ? WS_MIX1 : WS_MIX0));
  bf16_t* H = (bf16_t*)(p.ws + WS_H); float* AFFT = (float*)(p.ws + WS_AFF); float* XC = (float*)(p.ws + WS_XC);
  const float* wr = p.in[layer ? L1_WROUTER : L0_WROUTER];
  FA_LAS f32x4* WL = (FA_LAS f32x4*)lds;
  for (int i = tid; i < 1024 * 4; i += NT) { const int k = i >> 2, e4 = i & 3; const int ln = (k & 255) >> 2, q = k & 3, j = k >> 8;
    WL[((j * 4 + q) * 4 + e4) * 64 + ln] = *(const f32x4*)(wr + (size_t)k * 16 + e4 * 4); }
  __syncthreads();
  const int nrow = layer ? NLAT : NROW;
  const int rpw = (nrow + NGW - 1) / NGW;
  const int r0 = gw * rpw, r1 = min(r0 + rpw, nrow);
  if (r0 >= r1) return;
  const V16 gpost = ldf(p.in[layer ? L1_GPOSTMIX : L0_GPOSTMIX], lane), gpre = ldf(p.in[layer ? L1_GPREFFN : L0_GPREFFN], lane);
  int cur = -1; V16 gg, gs, sh;
  auto xsrc = [&](int r) { return layer ? (const float*)(p.out + (size_t)r * DM) : (r < NLAT ? p.in[I_X] + (size_t)r * DM : p.in[I_CTX] + (size_t)(r - NLAT) * DM); };
  B16 mn = ldb_raw(MIX + (size_t)r0 * DM, lane); V16 xn = ldf(xsrc(r0), lane);
  B16 mn2 = mn; V16 xn2 = xn;
  if (r0 + 1 < r1) { mn2 = ldb_raw(MIX + (size_t)(r0 + 1) * DM, lane); xn2 = ldf(xsrc(r0 + 1), lane); }
  for (int r = r0; r < r1; ++r) {
    const B16 mb = mn; const V16 x = xn;
    mn = mn2; xn = xn2;
    if (r + 2 < r1) { mn2 = ldb_raw(MIX + (size_t)(r + 2) * DM, lane); xn2 = ldf(xsrc(r + 2), lane); }
    const int mr = row_modrow(r);
    if (mr != cur) { cur = mr; const float* m = MOD + (size_t)mr * 6144; const V16 gt = ldf(m + 2048, lane), sc = ldf(m + 4096, lane); sh = ldf(m + 3072, lane);
#pragma unroll
      for (int j = 0; j < 4; ++j) { gg.v[j] = gt.v[j] * gpost.v[j]; gs.v[j] = gpre.v[j] * (sc.v[j] + 1.f); } }
    V16 o = b2v(mb);
    const float rr = rsqrtf(sumsq(o) * (1.f / DM) + EPS);
#pragma unroll
    for (int j = 0; j < 4; ++j) o.v[j] = x.v[j] + gg.v[j] * (o.v[j] * rr);
    stf(r < NLAT ? p.out + (size_t)r * DM : XC + (size_t)(r - NLAT) * DM, lane, o);
    const float r2 = rsqrtf(sumsq(o) * (1.f / DM) + EPS);
    V16 h;
#pragma unroll
    for (int j = 0; j < 4; ++j) h.v[j] = o.v[j] * r2 * gs.v[j] + sh.v[j];
    if ((layer == 1 && MOE1_FP8) || (layer == 0 && MOE0_FP8)) {
      unsigned* q8 = (unsigned*)((unsigned char*)H + (size_t)r * DM) + lane;
#pragma unroll
      for (int j = 0; j < 4; ++j) q8[64 * j] = nv::pack4_fp8(h.v[j][0] * nv::A8_SCALE, h.v[j][1] * nv::A8_SCALE, h.v[j][2] * nv::A8_SCALE, h.v[j][3] * nv::A8_SCALE);
    } else stb(H + (size_t)r * DM, lane, h);
    if (ABL == 1) continue;
    f32x4 lg[4];
    int lo = lane; asm volatile("" : "+v"(lo));
#pragma unroll
    for (int e4 = 0; e4 < 4; ++e4) lg[e4] = (f32x4){0.f, 0.f, 0.f, 0.f};
#pragma unroll
    for (int j = 0; j < 4; ++j)
#pragma unroll
      for (int q = 0; q < 4; ++q) { const float hv = h.v[j][q];
#pragma unroll
        for (int e4 = 0; e4 < 4; ++e4) lg[e4] += WL[((j * 4 + q) * 4 + e4) * 64 + lo] * hv; }
    float a8[8], b4[4], c2[2], d;
#pragma unroll
    for (int i = 0; i < 8; ++i) { const auto s = __builtin_amdgcn_permlane32_swap(__float_as_uint(lg[i >> 2][i & 3]), __float_as_uint(lg[2 + (i >> 2)][i & 3]), false, false);
      a8[i] = __uint_as_float(s[0]) + __uint_as_float(s[1]); }
#pragma unroll
    for (int i = 0; i < 4; ++i) { const auto s = __builtin_amdgcn_permlane16_swap(__float_as_uint(a8[i]), __float_as_uint(a8[i + 4]), false, false);
      b4[i] = __uint_as_float(s[0]) + __uint_as_float(s[1]); }
    { const bool b3 = (lane & 8) != 0, b2 = (lane & 4) != 0;
#pragma unroll
      for (int i = 0; i < 2; ++i) { const float keep = b3 ? b4[i + 2] : b4[i], send = b3 ? b4[i] : b4[i + 2]; c2[i] = keep + dppf<DPP_MIRROR>(send); }
      const float keep = b2 ? c2[1] : c2[0], send = b2 ? c2[0] : c2[1]; d = keep + dppf<DPP_HMIRROR>(send); }
    d += dppf<DPP_XOR1>(d); d += dppf<DPP_XOR2>(d);
    const float mx = quad_max(d), ex = expf(d - mx), ssum = quad_sum(ex);
    if ((lane & 3) == 0) AFFT[(size_t)(lane >> 2) * NROW + r] = ex / ssum;
  }
}

DEVI void phase_combine(const Params& p, int layer) {
  const int tid = ftid(), lane = tid & 63, gw = blockIdx.x * NWAVE + (tid >> 6), NGW = gridDim.x * NWAVE;
  const float* MOD = (const float*)(p.ws + WS_CTL + CTL_MOD);
  const bf16_t* Y = (const bf16_t*)(p.ws + WS_Y); const int* SLOT = (const int*)(p.ws + WS_SLOT); const float* GV = (const float*)(p.ws + WS_GATEV);
  bf16_t* H = (bf16_t*)(p.ws + WS_H); float* XC = (float*)(p.ws + WS_XC);
  const int nrow = layer ? NLAT : NROW, erows = layer ? EROWS1 : EROWS0;
  const int rpw = (nrow + NGW - 1) / NGW;
  const int r0 = gw * rpw, r1 = min(r0 + rpw, nrow);
  if (r0 >= r1) return;
  const V16 gpost = ldf(p.in[layer ? L1_GPOSTFFN : L0_GPOSTFFN], lane);
  V16 g1; if (layer == 0) g1 = ldf(p.in[L1_GPREMIX], lane);
  int cur = -1; V16 gg, gs, sh;
  int sn = (lane < 16) ? SLOT[(size_t)r0 * 16 + lane] : -1;
  for (int r = r0; r < r1; ++r) {
    const int sl = sn; if (r + 1 < r1) sn = (lane < 16) ? SLOT[(size_t)(r + 1) * 16 + lane] : -1;
    float* xio = r < NLAT ? p.out + (size_t)r * DM : XC + (size_t)(r - NLAT) * DM;
    const V16 x = ldf(xio, lane);
    const int mr = row_modrow(r);
    if (mr != cur) { cur = mr; const float* m = MOD + (size_t)(layer * 9 + mr) * 6144; const V16 gt = ldf(m + 5120, lane);
#pragma unroll
      for (int j = 0; j < 4; ++j) gg.v[j] = gt.v[j] * gpost.v[j];
      if (layer == 0) { const float* m1 = MOD + (size_t)(9 + mr) * 6144; const V16 sc = ldf(m1 + 1024, lane); sh = ldf(m1, lane);
#pragma unroll
        for (int j = 0; j < 4; ++j) gs.v[j] = g1.v[j] * (sc.v[j] + 1.f); } }
    V16 o;
#pragma unroll
    for (int j = 0; j < 4; ++j) o.v[j] = (f32x4){0.f, 0.f, 0.f, 0.f};
    unsigned long long mask = __ballot(sl >= 0);
    while (mask) {
      int e_[4], s_[4]; bool v_[4];
#pragma unroll
      for (int i = 0; i < 4; ++i) { v_[i] = mask != 0ull; e_[i] = v_[i] ? __builtin_ctzll(mask) : 0; if (v_[i]) mask &= mask - 1; s_[i] = __builtin_amdgcn_readlane(sl, e_[i]); }
      B16 yr[4]; float gt[4];
#pragma unroll
      for (int i = 0; i < 4; ++i) if (v_[i]) { gt[i] = GV[e_[i] * erows + s_[i]];
        yr[i] = ldb_raw(Y + ((size_t)e_[i] * erows + s_[i]) * DM, lane); }
#pragma unroll
      for (int i = 0; i < 4; ++i) if (v_[i]) { const V16 y = b2v(yr[i]);
#pragma unroll
        for (int j = 0; j < 4; ++j) o.v[j] += y.v[j] * gt[i]; }
    }
    const float rr = rsqrtf(sumsq(o) * (1.f / DM) + EPS);
#pragma unroll
    for (int j = 0; j < 4; ++j) o.v[j] = x.v[j] + gg.v[j] * (o.v[j] * rr);
    stf(xio, lane, o);
    if (layer == 0) {
      const float r2 = rsqrtf(sumsq(o) * (1.f / DM) + EPS);
      V16 h;
#pragma unroll
      for (int j = 0; j < 4; ++j) h.v[j] = o.v[j] * r2 * gs.v[j] + sh.v[j];
      if (QKV1_FP8) {
        unsigned* q8 = (unsigned*)((unsigned char*)H + (size_t)r * DM) + lane;
#pragma unroll
        for (int j = 0; j < 4; ++j) q8[64 * j] = nv::pack4_fp8(h.v[j][0] * nv::A8_SCALE, h.v[j][1] * nv::A8_SCALE, h.v[j][2] * nv::A8_SCALE, h.v[j][3] * nv::A8_SCALE);
      } else stb(H + (size_t)r * DM, lane, h);
    }
  }
}
}
#define LAS __attribute__((address_space(3)))
#define XB_TMO      128
#define XB_XCNT(j)  (256  + 64 * (j))
#define XB_XSUB(j)  (1280 + 64 * (j))
#define XB_XGEN(j)  (2304 + 64 * (j))
#define XB_TOP      3328
#define XB_TOPGEN   3392
#define XCD_BAR_WORDS 3456
#define XB_SPIN_CAP (1u << 18)

__device__ __forceinline__ unsigned xb_ld(unsigned* p)              { return __hip_atomic_load(p, __ATOMIC_RELAXED, __HIP_MEMORY_SCOPE_AGENT); }
__device__ __forceinline__ unsigned xb_add(unsigned* p, unsigned v) { return __hip_atomic_fetch_add(p, v, __ATOMIC_RELAXED, __HIP_MEMORY_SCOPE_AGENT); }
__device__ __forceinline__ unsigned xb_xcc_id() { return (unsigned)__builtin_amdgcn_s_getreg((3 << 11) | 20) & 0xFu; }
#define XB_SPIN(cond, bar) do { unsigned _sp = 0; while (cond) { __builtin_amdgcn_s_sleep(1); \
    if ((++_sp & 255u) == 0u) { if (xb_ld(&(bar)[XB_TMO])) break; if (_sp > XB_SPIN_CAP) { atomicAdd(&(bar)[XB_TMO], 1u); break; } } } } while (0)

struct XcdBarrier {
    unsigned* bar; unsigned x;
    volatile LAS unsigned* st;
};

__device__ __forceinline__ XcdBarrier xcd_barrier_post(unsigned* bar, volatile LAS unsigned* st) {
    XcdBarrier b; b.bar = bar; b.x = xb_xcc_id(); b.st = st;
    if (threadIdx.x == 0) (void)xb_add(&bar[XB_XCNT(b.x)], 1u);
    return b;
}
__device__ __forceinline__ void xcd_barrier_complete(unsigned* bar, unsigned x, unsigned& nloc, unsigned& nx) {
    const unsigned G = gridDim.x * gridDim.y * gridDim.z;
    unsigned sum, cnt, mine, sp = 0u;
    for (;;) {
        sum = 0u; cnt = 0u; mine = 0u;
#pragma unroll
        for (unsigned j = 0; j < 16; ++j) { const unsigned c = xb_ld(&bar[XB_XCNT(j)]); sum += c; cnt += (c > 0u) ? 1u : 0u; mine = (j == x) ? c : mine; }
        if (sum == G) break;
        __builtin_amdgcn_s_sleep(1);
        if ((++sp & 255u) == 0u) { if (xb_ld(&bar[XB_TMO])) break; if (sp > XB_SPIN_CAP) { atomicAdd(&bar[XB_TMO], 1u); break; } }
    }
    nloc = mine > 0u ? mine : 1u; nx = cnt > 0u ? cnt : 1u;
}

__device__ __forceinline__ void xcd_barrier(const XcdBarrier& b) {
    asm volatile("s_waitcnt vmcnt(0)" ::: "memory");
    __syncthreads();
    if (threadIdx.x == 0) {
        unsigned* bar = b.bar;
        __builtin_amdgcn_s_waitcnt(0);
        unsigned nloc = b.st[0], nx = b.st[1];
        if (nloc == 0u) { xcd_barrier_complete(bar, b.x, nloc, nx); b.st[0] = nloc; b.st[1] = nx; }
        const unsigned old = xb_add(&bar[XB_XSUB(b.x)], 1u);
        const unsigned gen = old / nloc;
        if (old + 1u == (gen + 1u) * nloc) {
            __builtin_amdgcn_fence(__ATOMIC_RELEASE, "agent");
            asm volatile("s_waitcnt vmcnt(0)" ::: "memory");
            const unsigned og = xb_add(&bar[XB_TOP], 1u);
            const unsigned tg = og / nx;
            if (og + 1u == (tg + 1u) * nx) xb_add(&bar[XB_TOPGEN], 1u);
            else XB_SPIN(xb_ld(&bar[XB_TOPGEN]) == tg, bar);
            __builtin_amdgcn_fence(__ATOMIC_ACQUIRE, "agent");
            xb_add(&bar[XB_XGEN(b.x)], 1u);
            asm volatile("s_waitcnt vmcnt(0)" ::: "memory");
        } else {
            XB_SPIN(xb_ld(&bar[XB_XGEN(b.x)]) == gen, bar);
            __builtin_amdgcn_fence(__ATOMIC_ACQUIRE, "agent");
            asm volatile("s_waitcnt vmcnt(0)" ::: "memory");
        }
    }
    __syncthreads();
}


__device__ __forceinline__ void flat_barrier(unsigned* ctr, unsigned& epoch) {
    asm volatile("s_waitcnt vmcnt(0)" ::: "memory");
    __syncthreads();
    if (threadIdx.x == 0) {
        __builtin_amdgcn_fence(__ATOMIC_RELEASE, "agent");
        asm volatile("s_waitcnt vmcnt(0)" ::: "memory");
        (void)__hip_atomic_fetch_add(ctr, 1u, __ATOMIC_RELAXED, __HIP_MEMORY_SCOPE_AGENT);
        const unsigned target = (epoch + 1u) * (unsigned)gridDim.x; unsigned sp = 0;
        while (__hip_atomic_load(ctr, __ATOMIC_RELAXED, __HIP_MEMORY_SCOPE_AGENT) < target) { __builtin_amdgcn_s_sleep(1); if (++sp > (1u << 22)) break; }
        __builtin_amdgcn_fence(__ATOMIC_ACQUIRE, "agent");
        asm volatile("s_waitcnt vmcnt(0)" ::: "memory");
    }
    ++epoch;
    __syncthreads();
}

__device__ __forceinline__ void xcd_barrier2(const XcdBarrier& b) {
    asm volatile("s_waitcnt vmcnt(0)" ::: "memory");
    __syncthreads();
    if (threadIdx.x == 0) {
        unsigned* bar = b.bar;
        __builtin_amdgcn_s_waitcnt(0);
        unsigned nloc = b.st[0], nx = b.st[1];
        if (nloc == 0u) { xcd_barrier_complete(bar, b.x, nloc, nx); b.st[0] = nloc; b.st[1] = nx; }
        const unsigned old = xb_add(&bar[XB_XSUB(b.x)], 1u);
        const unsigned gen = old / nloc;
        if (old + 1u == (gen + 1u) * nloc) {
            __builtin_amdgcn_fence(__ATOMIC_RELEASE, "agent");
            asm volatile("s_waitcnt vmcnt(0)" ::: "memory");
            (void)xb_add(&bar[XB_TOP], 1u);
        }
        const unsigned target = (gen + 1u) * nx;
        XB_SPIN(xb_ld(&bar[XB_TOP]) < target, bar);
        __builtin_amdgcn_fence(__ATOMIC_ACQUIRE, "agent");
        asm volatile("s_waitcnt vmcnt(0)" ::: "memory");
    }
    __syncthreads();
}
constexpr int LDS_BYTES = 147456;
#define TAILFILL 1
#ifndef FAST_GEMM
#define FAST_GEMM 1
#endif
#ifndef FAST_TOPK
#define FAST_TOPK 1
#endif
#ifndef FAST_SSD
#define FAST_SSD 1
#endif
#ifndef FAST_ATTN
#define FAST_ATTN 1
#endif
__global__ void __launch_bounds__(NT) mega(Params p) {
  extern __shared__ __attribute__((aligned(16))) unsigned char lds_raw[];
  float* lds = (float*)lds_raw;
  fg::ldsp_t ldsp = (fg::ldsp_t)lds_raw;
  cg::grid_group grid = cg::this_grid();
  volatile LAS unsigned* bst = (volatile LAS unsigned*)((LAS unsigned char*)lds_raw + (LDS_BYTES - 64));
  if (threadIdx.x < 2) bst[threadIdx.x] = 0u;
  unsigned* barw = (unsigned*)(p.ws + WS_CTL + CTL_BAR);
  if (blockIdx.x == 0) { const int t0 = ftid(); for (int i = t0; i < XCD_BAR_WORDS; i += NT) barw[i] = 0u; }
  XcdBarrier xbar; xbar.bar = barw; xbar.x = 0; xbar.st = bst;
#ifdef FLATBAR
  unsigned fb_epoch = 0; unsigned* fb_ctr = barw + XCD_BAR_WORDS - 64;
#define GSYNC() flat_barrier(fb_ctr, fb_epoch)
#elif defined(XBAR2)
#define GSYNC() xcd_barrier2(xbar)
#else
#define GSYNC() xcd_barrier(xbar)
#endif
  nv::phase0(p, lds);                 grid.sync();
  xbar = xcd_barrier_post(barw, bst);
#ifdef DUP_SYNC
  for (int i = 0; i < 20; ++i) GSYNC();
#endif
#ifdef DUP_P0
  nv::phase0(p, lds);                 GSYNC();
#endif
  fr::phase_prenorm0(p);              GSYNC();
#ifdef DUP_PRENORM
  fr::phase_prenorm0(p); GSYNC();
#endif
#if FAST_GEMM
  fg::phase_qkv0(p, ldsp); GSYNC();
#ifdef DUP_QKV0
  fg::phase_qkv0(p, ldsp); GSYNC();
#endif
#else
  nv::phase_qkv0(p, lds);             GSYNC();
#endif
#if FAST_ATTN
  fa::phase_attnA(p, ldsp); fa::phase_attnB(p, ldsp); GSYNC();
#ifdef DUP_A
  fa::phase_attnA<DUP_A>(p, ldsp); GSYNC();
#endif
#ifdef DUP_B
  fa::phase_attnB<DUP_B>(p, ldsp); GSYNC();
#endif
#else
  nv::phase_attn0(p, lds);            GSYNC();
#endif
#if FAST_GEMM
#ifdef TAILFILL
  fg::phase_outproj(p, ldsp, 0); nv::convert_moe_tail8(p, 0, 1, lds, NROW / 256 * (DM / 256)); GSYNC();
#else
  fg::phase_outproj(p, ldsp, 0); GSYNC();
#endif
#ifdef DUP_OUT0
  fg::phase_outproj(p, ldsp, 0); GSYNC();
#endif
#else
  nv::phase_outproj(p, lds, 0);       GSYNC();
#endif
  fr::phase_postmix(p, ldsp, 0);            GSYNC();
#ifdef DUP_POSTMIX0
  fr::phase_postmix<DUP_POSTMIX0>(p, ldsp, 0); GSYNC();
#endif
#if FAST_TOPK
  ft::phase_topk(p, ldsp, 0);         GSYNC();
#ifdef DUP_TOPK0
  ft::phase_topk(p, ldsp, 0);         GSYNC();
#endif
#else
  nv::phase_topk(p, lds, 0);          GSYNC();
  fg::phase_gather(p, 0);             GSYNC();
#endif
#if FAST_GEMM
  fg::phase_moe_up8(p, ldsp, 0);      GSYNC();
#ifdef DUP_UP0
  fg::phase_moe_up8(p, ldsp, 0); GSYNC();
#endif
  fg::phase_moe_down8(p, ldsp, 0);    GSYNC();
#ifdef DUP_DOWN0
  fg::phase_moe_down8(p, ldsp, 0); GSYNC();
#endif
#else
  nv::phase_moe_up(p, lds, 0);        GSYNC();
  nv::phase_moe_down(p, lds, 0);      GSYNC();
#endif
#ifdef TAILFILL
  fr::phase_combine(p, 0); GSYNC();
#else
  fr::phase_combine(p, 0); nv::convert_moe_tail(p, 1, 0, lds, 0); nv::convert_moe_tail(p, 1, 1, lds, 0); GSYNC();
#endif
#if FAST_GEMM
#ifdef TAILFILL
  fg::phase_qkv1(p, ldsp); GSYNC();
#else
  fg::phase_qkv1(p, ldsp); GSYNC();
#endif
#else
  nv::phase_qkv1(p, lds);             GSYNC();
#endif
#if FAST_ATTN
#if FAST_SSD
#ifdef TAILFILL
  fs::phase_conv(p); GSYNC();
#else
  fs::phase_conv(p); GSYNC();
#endif
#else
  nv::phase_conv_swa(p, lds, true); GSYNC();
#endif
#else
  nv::phase_conv_swa(p, lds, true);   GSYNC();
#endif
#if FAST_SSD
  fs::phase_ssd(p, ldsp); fa::phase_attnC(p, ldsp, (int*)(p.ws + WS_CTL + CTL_QC));
  nv::convert_moe_tail8(p, 1, 0, lds, NB * 2 * 8); nv::convert_moe_tail8(p, 1, 1, lds, NB * 2 * 8); GSYNC();
#ifdef DUP_SSD
  fs::phase_ssd<DUP_SSD>(p, ldsp);             GSYNC();
#endif
  fs::phase_ssd_out(p);               GSYNC();
#else
  nv::phase_ssd(p, lds);              GSYNC();
  nv::phase_ssd_out(p);               GSYNC();
#endif
#if FAST_GEMM
  fg::phase_outproj(p, ldsp, 1);      GSYNC();
#else
  nv::phase_outproj(p, lds, 1);       GSYNC();
#endif
  fr::phase_postmix(p, ldsp, 1);            GSYNC();
#if FAST_TOPK
  ft::phase_topk(p, ldsp, 1);         GSYNC();
#ifdef DUP_TOPK1
  ft::phase_topk(p, ldsp, 1);         GSYNC();
#endif
#else
  nv::phase_topk(p, lds, 1);          GSYNC();
  fg::phase_gather(p, 1);             GSYNC();
#endif
#if FAST_GEMM
  fg::phase_moe_up8(p, ldsp, 1);      GSYNC();
  fg::phase_moe_down8(p, ldsp, 1);    GSYNC();
#else
  nv::phase_moe_up(p, lds, 1);        GSYNC();
  nv::phase_moe_down(p, lds, 1);      GSYNC();
#endif
  fr::phase_combine(p, 1);
}


extern "C" void kernel_launch(void* const* d_in, const int* in_sizes, int n_in, void* d_out, int out_size,
                              void* d_ws, size_t ws_size, hipStream_t stream) {
  static int grid_blocks = 0;
  if (!grid_blocks) {
    int dev = 0, cus = 0, per_cu = 0;
    (void)hipGetDevice(&dev);
    (void)hipDeviceGetAttribute(&cus, hipDeviceAttributeMultiprocessorCount, dev);
    (void)hipFuncSetAttribute((const void*)mega, hipFuncAttributeMaxDynamicSharedMemorySize, LDS_BYTES);
    (void)hipOccupancyMaxActiveBlocksPerMultiprocessor(&per_cu, (const void*)mega, NT, LDS_BYTES);
    if (per_cu < 1) { fprintf(stderr, "kernel_launch: occupancy query says %d blocks/CU\n", per_cu); per_cu = 1; }
    grid_blocks = cus;
    if (n_in != 43 || ws_size < WS_END) fprintf(stderr, "kernel_launch: unexpected n_in %d / ws_size %zu (need %zu)\n", n_in, ws_size, (size_t)WS_END);
  }
  Params p{};
  for (int i = 0; i < 43; ++i) p.in[i] = (const float*)d_in[i];
  p.out = (float*)d_out; p.ws = (unsigned char*)d_ws;
  void* args[] = {&p};
  hipError_t e = hipLaunchCooperativeKernel((void*)mega, dim3(grid_blocks), dim3(NT), args, LDS_BYTES, stream);
  if (e != hipSuccess) fprintf(stderr, "cooperative launch failed: %s (grid %d)\n", hipGetErrorString(e), grid_blocks);
}
```

```cpp
#include <hip/hip_runtime.h>
#include <hip/hip_cooperative_groups.h>
#include <cstdio>
#include <cstdint>
namespace cg = cooperative_groups;

typedef unsigned short bf16_t;
#define DEVI __device__ __forceinline__

constexpr int NT = 512, NWAVE = 8;
constexpr int NB = 8, SEQ = 4096, DM = 1024, CTXL = 256;
constexpr int NLAT = NB * SEQ, NCTX = NB * CTXL, NROW = NLAT + NCTX;
constexpr int NE = 16;
constexpr int CAP_L = 512, CAP_C = 32;
constexpr int EROWS0 = NB * CAP_L + NB * CAP_C;
constexpr int EROWS1 = NB * CAP_L;
constexpr int N_IN0 = 3072, N_IN1 = 2320, N_IN1P = 2560;
constexpr float EPS = 1e-6f;

constexpr size_t MiB = 1u << 20;
constexpr size_t WS_CTL = 0;
constexpr size_t WS_WIN0 = 1 * MiB;
constexpr size_t WS_WIN1 = 7 * MiB;
constexpr size_t WS_WOUT0 = 12 * MiB, WS_WOUT1 = 14 * MiB;
constexpr size_t WS_WGU = 16 * MiB;
constexpr size_t WS_WD = 80 * MiB;
constexpr size_t WS_XC = 112 * MiB;
constexpr size_t WS_H = 120 * MiB;
constexpr size_t WS_AFF = 188 * MiB;
constexpr size_t WS_SLOT = 191 * MiB;
constexpr size_t WS_IDX = 194 * MiB;
constexpr size_t WS_GATEV = 195 * MiB;
constexpr size_t WS_BIG = 196 * MiB;
constexpr size_t WS_QKV0 = WS_BIG;
constexpr size_t WS_ATT0 = WS_BIG + 204 * MiB;
constexpr size_t WS_MIX0 = WS_BIG + 272 * MiB;
constexpr size_t WS_XG = WS_BIG;
constexpr size_t WS_HID = WS_BIG + 136 * MiB;
constexpr size_t WS_Y = WS_BIG;
constexpr size_t WS_P1 = WS_BIG;
constexpr size_t WS_DT = WS_BIG + 153 * MiB;
constexpr size_t WS_U = WS_BIG + 156 * MiB;
constexpr size_t WS_MIX1 = WS_U;
constexpr size_t WS_ATT1 = WS_BIG + 224 * MiB;
constexpr size_t WS_YS = WS_BIG + 292 * MiB;
constexpr size_t WS_CUMG = WS_BIG + 356 * MiB;
constexpr size_t WS_DTG = WS_BIG + 359 * MiB;
constexpr size_t WS_VT = WS_BIG + 340 * MiB;
constexpr size_t WS_VTB = WS_BIG + 362 * MiB;
constexpr size_t WS_END = WS_BIG + 380 * MiB;
constexpr size_t CTL_MOD = 4096;
constexpr size_t CTL_ROPE = CTL_MOD + 2 * 9 * 6144 * 4;
constexpr size_t CTL_LAM = CTL_ROPE + 64 * 16 * 2 * 4;
constexpr size_t CTL_QC = CTL_LAM + 64;
constexpr size_t CTL_BAR = 512 * 1024;

struct Params {
  const float* in[43];
  float* out;
  unsigned char* ws;
};

enum {
  I_X = 0, I_C, I_CTX, I_CCTX,
  L0_WMOD, L0_BMOD, L0_GPREMIX, L0_GPOSTMIX, L0_GPREFFN, L0_GPOSTFFN, L0_WIN, L0_WOUT,
  L0_LAMQ1, L0_LAMK1, L0_LAMQ2, L0_LAMK2, L0_SUBLN, L0_RPB, L0_WROUTER, L0_WGATE, L0_WUP, L0_WDOWN,
  L1_WMOD, L1_BMOD, L1_GPREMIX, L1_GPOSTMIX, L1_GPREFFN, L1_GPOSTFFN, L1_WIN, L1_WOUT,
  L1_SINKS, L1_CONVW, L1_CONVB, L1_ALOGF, L1_ALOGB, L1_DTBF, L1_DTBB, L1_DSKIP, L1_GNORM,
  L1_WROUTER, L1_WGATE, L1_WUP, L1_WDOWN
};

DEVI int ftid() { int t = threadIdx.x; asm volatile("" : "+v"(t)); return t; }
DEVI float bf2f(bf16_t v) { return __uint_as_float(((unsigned)v) << 16); }
DEVI bf16_t f2bf(float f) { unsigned u = __float_as_uint(f); return (bf16_t)((u + 0x7fffu + ((u >> 16) & 1u)) >> 16); }
DEVI unsigned pk2(float lo, float hi) { return (unsigned)f2bf(lo) | ((unsigned)f2bf(hi) << 16); }
DEVI float silu_f(float v) { return v / (1.f + __expf(-v)); }
template <int CTRL> DEVI float dppf(float v) { return __uint_as_float((unsigned)__builtin_amdgcn_update_dpp(0, (int)__float_as_uint(v), CTRL, 0xf, 0xf, true)); }
constexpr int DPP_XOR1 = 0xB1, DPP_XOR2 = 0x4E, DPP_HMIRROR = 0x141, DPP_MIRROR = 0x140;
DEVI float wave_sum(float v) {
  v += dppf<DPP_XOR1>(v); v += dppf<DPP_XOR2>(v); v += dppf<DPP_HMIRROR>(v); v += dppf<DPP_MIRROR>(v);
  { const auto s = __builtin_amdgcn_permlane16_swap(__float_as_uint(v), __float_as_uint(v), false, false); v = __uint_as_float(s[0]) + __uint_as_float(s[1]); }
  { const auto s = __builtin_amdgcn_permlane32_swap(__float_as_uint(v), __float_as_uint(v), false, false); v = __uint_as_float(s[0]) + __uint_as_float(s[1]); }
  return v;
}
DEVI float half_sum(float v) {
  v += dppf<DPP_XOR1>(v); v += dppf<DPP_XOR2>(v); v += dppf<DPP_HMIRROR>(v); v += dppf<DPP_MIRROR>(v);
  { const auto s = __builtin_amdgcn_permlane16_swap(__float_as_uint(v), __float_as_uint(v), false, false); v = __uint_as_float(s[0]) + __uint_as_float(s[1]); }
  return v;
}
template <int CTRL, int ROWMASK> DEVI float dppf0(float v) { return __uint_as_float((unsigned)__builtin_amdgcn_update_dpp(0, (int)__float_as_uint(v), CTRL, ROWMASK, 0xf, false)); }
DEVI float wave_scan_incl(float v) {
  v += dppf0<0x111, 0xf>(v); v += dppf0<0x112, 0xf>(v); v += dppf0<0x114, 0xf>(v); v += dppf0<0x118, 0xf>(v);
  v += dppf0<0x142, 0xa>(v); v += dppf0<0x143, 0xc>(v);
  return v;
}
template <int CTRL, int ROWMASK> DEVI int dppi0(int v) { return __builtin_amdgcn_update_dpp(0, v, CTRL, ROWMASK, 0xf, false); }
DEVI int wave_scan_incl_i(int v) {
  v += dppi0<0x111, 0xf>(v); v += dppi0<0x112, 0xf>(v); v += dppi0<0x114, 0xf>(v); v += dppi0<0x118, 0xf>(v);
  v += dppi0<0x142, 0xa>(v); v += dppi0<0x143, 0xc>(v);
  return v;
}
DEVI float quad_sum(float v) {
  v += dppf<DPP_HMIRROR>(v); v += dppf<DPP_MIRROR>(v);
  { const auto s = __builtin_amdgcn_permlane16_swap(__float_as_uint(v), __float_as_uint(v), false, false); v = __uint_as_float(s[0]) + __uint_as_float(s[1]); }
  { const auto s = __builtin_amdgcn_permlane32_swap(__float_as_uint(v), __float_as_uint(v), false, false); v = __uint_as_float(s[0]) + __uint_as_float(s[1]); }
  return v;
}
DEVI float quad_max(float v) {
  v = fmaxf(v, dppf<DPP_HMIRROR>(v)); v = fmaxf(v, dppf<DPP_MIRROR>(v));
  { const auto s = __builtin_amdgcn_permlane16_swap(__float_as_uint(v), __float_as_uint(v), false, false); v = fmaxf(__uint_as_float(s[0]), __uint_as_float(s[1])); }
  { const auto s = __builtin_amdgcn_permlane32_swap(__float_as_uint(v), __float_as_uint(v), false, false); v = fmaxf(__uint_as_float(s[0]), __uint_as_float(s[1])); }
  return v;
}
DEVI float wave_max(float v) {
  v = fmaxf(v, dppf<DPP_XOR1>(v)); v = fmaxf(v, dppf<DPP_XOR2>(v)); v = fmaxf(v, dppf<DPP_HMIRROR>(v)); v = fmaxf(v, dppf<DPP_MIRROR>(v));
  { const auto s = __builtin_amdgcn_permlane16_swap(__float_as_uint(v), __float_as_uint(v), false, false); v = fmaxf(__uint_as_float(s[0]), __uint_as_float(s[1])); }
  { const auto s = __builtin_amdgcn_permlane32_swap(__float_as_uint(v), __float_as_uint(v), false, false); v = fmaxf(__uint_as_float(s[0]), __uint_as_float(s[1])); }
  return v;
}
DEVI int row_modrow(int r) { return r < NLAT ? (r >> 12) : 8; }
#ifndef QKV0_FP8
#define QKV0_FP8 1
#endif
#ifndef OUT_FP8
#define OUT_FP8 0
#endif
#ifndef QKV1_FP8
#define QKV1_FP8 0
#endif
namespace nv {

DEVI void transpose_item(const float* W, int K, int N, bf16_t* WT, int row_off, int row_mul, float* scr, int item, int lane, int Npad) {
  const int nblk = Npad / 32, kb = item / nblk, nb = item % nblk, k0 = 64 * kb, n0 = 32 * nb;
  const int n = n0 + (lane & 31); const bool ok = n < N;
  const float* src = W + (size_t)(k0 + (lane >> 5)) * N + (ok ? n : 0);
  float v[32];
#pragma unroll
  for (int i = 0; i < 32; ++i) v[i] = src[(size_t)(2 * i) * N];
#pragma unroll
  for (int i = 0; i < 32; ++i) scr[(2 * i + (lane >> 5)) * 33 + (lane & 31)] = ok ? v[i] : 0.f;
  __builtin_amdgcn_s_waitcnt(0); __builtin_amdgcn_wave_barrier();
  const int c = lane & 7;
#pragma unroll
  for (int j = 0; j < 4; ++j) {
    const int nn = (lane >> 3) + 8 * j; const float* s = scr + (8 * c) * 33 + nn;
    uint4 o; o.x = pk2(s[0 * 33], s[1 * 33]); o.y = pk2(s[2 * 33], s[3 * 33]); o.z = pk2(s[4 * 33], s[5 * 33]); o.w = pk2(s[6 * 33], s[7 * 33]);
    *(uint4*)(WT + (size_t)(row_off + (n0 + nn) * row_mul) * K + k0 + 8 * c) = o;
  }
  __builtin_amdgcn_s_waitcnt(0); __builtin_amdgcn_wave_barrier();
}

DEVI void convert_moe_part(const Params& p, int layer, int which, float* scr, int gw, int NGW, int lane) {
  const float* wg = p.in[layer ? L1_WGATE : L0_WGATE]; const float* wu = p.in[layer ? L1_WUP : L0_WUP]; const float* wd = p.in[layer ? L1_WDOWN : L0_WDOWN];
  bf16_t* WGU = (bf16_t*)(p.ws + WS_WGU); bf16_t* WD = (bf16_t*)(p.ws + WS_WD);
  constexpr int IPM = 16 * 32;
  if (which == 0) {
    for (int it = gw; it < NE * 2 * IPM; it += NGW) {
      const int e = it / (2 * IPM), r = it % (2 * IPM), gu = r / IPM, item = r % IPM;
      transpose_item((gu ? wu : wg) + (size_t)e * DM * DM, DM, DM, WGU + (size_t)e * 2048 * DM, gu, 2, scr, item, lane, DM);
    }
  } else {
    for (int it = gw; it < NE * IPM; it += NGW) {
      const int e = it / IPM, item = it % IPM;
      transpose_item(wd + (size_t)e * DM * DM, DM, DM, WD + (size_t)e * DM * DM, 0, 1, scr, item, lane, DM);
    }
  }
}
DEVI void convert_moe_tail(const Params& p, int layer, int which, float* lds, int nunits) {
  const int first = nunits % (int)gridDim.x;
  if ((int)blockIdx.x < first) return;
  const int w = ftid() >> 6;
  convert_moe_part(p, layer, which, lds + w * (64 * 33), ((int)blockIdx.x - first) * NWAVE + w, ((int)gridDim.x - first) * NWAVE, ftid() & 63);
}


constexpr float W8_SCALE = 64.f, A8_SCALE = 4.f;
constexpr int W8_E8M0 = 0x79797979, A8_E8M0 = 0x7d7d7d7d;
DEVI unsigned pack4_fp8(float a, float b, float c, float d) {
  a = fminf(fmaxf(a, -448.f), 448.f); b = fminf(fmaxf(b, -448.f), 448.f); c = fminf(fmaxf(c, -448.f), 448.f); d = fminf(fmaxf(d, -448.f), 448.f);
  int w = 0; w = __builtin_amdgcn_cvt_pk_fp8_f32(a, b, w, false); w = __builtin_amdgcn_cvt_pk_fp8_f32(c, d, w, true); return (unsigned)w; }
DEVI void transpose_item8(const float* W, int K, int N, unsigned char* WT, int row_off, int row_mul, float* scr, int item, int lane, int Npad = 0) {
  if (Npad == 0) Npad = N;
  const int nblk = Npad / 32, kb = item / nblk, nb = item % nblk, k0 = 64 * kb, n0 = 32 * nb;
  const int nn0 = n0 + (lane & 31); const bool ok = nn0 < N;
  const float* src = W + (size_t)(k0 + (lane >> 5)) * N + (ok ? nn0 : 0);
  float v[32];
#pragma unroll
  for (int i = 0; i < 32; ++i) v[i] = src[(size_t)(2 * i) * N];
#pragma unroll
  for (int i = 0; i < 32; ++i) scr[(2 * i + (lane >> 5)) * 33 + (lane & 31)] = ok ? v[i] * W8_SCALE : 0.f;
  __builtin_amdgcn_s_waitcnt(0); __builtin_amdgcn_wave_barrier();
  const int c = lane & 7;
#pragma unroll
  for (int j = 0; j < 4; ++j) {
    const int nn = (lane >> 3) + 8 * j; const float* s = scr + (8 * c) * 33 + nn;
    uint2 o; o.x = pack4_fp8(s[0 * 33], s[1 * 33], s[2 * 33], s[3 * 33]); o.y = pack4_fp8(s[4 * 33], s[5 * 33], s[6 * 33], s[7 * 33]);
    *(uint2*)(WT + (size_t)(row_off + (n0 + nn) * row_mul) * K + k0 + 8 * c) = o;
  }
  __builtin_amdgcn_s_waitcnt(0); __builtin_amdgcn_wave_barrier();
}
DEVI void convert_moe_part8(const Params& p, int layer, int which, float* scr, int gw, int NGW, int lane) {
  const float* wg = p.in[layer ? L1_WGATE : L0_WGATE]; const float* wu = p.in[layer ? L1_WUP : L0_WUP]; const float* wd = p.in[layer ? L1_WDOWN : L0_WDOWN];
  unsigned char* WGU = (unsigned char*)(p.ws + WS_WGU); unsigned char* WD = (unsigned char*)(p.ws + WS_WD);
  constexpr int IPM = 16 * 32;
  if (which == 0) {
    for (int it = gw; it < NE * 2 * IPM; it += NGW) { const int e = it / (2 * IPM), r = it % (2 * IPM), gu = r / IPM, item = r % IPM;
      transpose_item8((gu ? wu : wg) + (size_t)e * DM * DM, DM, DM, WGU + (size_t)e * 2048 * DM, gu, 2, scr, item, lane); }
  } else {
    for (int it = gw; it < NE * IPM; it += NGW) { const int e = it / IPM, item = it % IPM;
      transpose_item8(wd + (size_t)e * DM * DM, DM, DM, WD + (size_t)e * DM * DM, 0, 1, scr, item, lane); }
  }
}
DEVI void convert_moe_tail8(const Params& p, int layer, int which, float* lds, int nunits) {
  const int first = nunits % (int)gridDim.x;
  if ((int)blockIdx.x < first) return;
  const int w = ftid() >> 6;
  convert_moe_part8(p, layer, which, lds + w * (64 * 33), ((int)blockIdx.x - first) * NWAVE + w, ((int)gridDim.x - first) * NWAVE, ftid() & 63);
}

DEVI void phase0(const Params& p, float* lds) {
  const int tid = ftid(), lane = tid & 63, wave = tid >> 6;
  const int gw = blockIdx.x * NWAVE + wave, NGW = gridDim.x * NWAVE;
  for (int it = blockIdx.x; it < 2 * 96; it += gridDim.x) {
    const int layer = it / 96, j0 = (it % 96) * 64;
    float* sc = lds;
    float* red = lds + 9 * 1024;
    __syncthreads();
    for (int i = tid; i < 9 * 1024; i += NT) { const int r = i >> 10, k = i & 1023; const float v = (r < 8) ? p.in[I_C][r * 1024 + k] : p.in[I_CCTX][k]; sc[i] = silu_f(v); }
    __syncthreads();
    const float* wm = p.in[layer ? L1_WMOD : L0_WMOD];
    float acc[9];
#pragma unroll
    for (int r = 0; r < 9; ++r) acc[r] = 0.f;
    for (int k0 = wave * 128; k0 < wave * 128 + 128; k0 += 16) {
      float w[16];
#pragma unroll
      for (int i = 0; i < 16; ++i) w[i] = wm[(size_t)(k0 + i) * 6144 + j0 + lane];
#pragma unroll
      for (int i = 0; i < 16; ++i)
#pragma unroll
        for (int r = 0; r < 9; ++r) acc[r] += sc[r * 1024 + k0 + i] * w[i];
    }
#pragma unroll
    for (int r = 0; r < 9; ++r) red[(wave * 9 + r) * 64 + lane] = acc[r];
    __syncthreads();
    for (int i = tid; i < 9 * 64; i += NT) {
      const int r = i >> 6, c = i & 63; float s = 0.f;
      for (int w = 0; w < 8; ++w) s += red[(w * 9 + r) * 64 + c];
      float* MOD = (float*)(p.ws + WS_CTL + CTL_MOD);
      MOD[(layer * 9 + r) * 6144 + j0 + c] = s + p.in[layer ? L1_BMOD : L0_BMOD][j0 + c];
    }
    __syncthreads();
  }
  if (blockIdx.x == gridDim.x - 1) {
    float* ROPE = (float*)(p.ws + WS_CTL + CTL_ROPE);
    for (int i = tid; i < 64 * 16; i += NT) {
      const int pos = i >> 4, f = i & 15;
      const float inv = powf(10000.f, -(float)f / 16.f);
      const float ang = (float)pos * inv;
      ROPE[2 * i] = cosf(ang); ROPE[2 * i + 1] = sinf(ang);
    }
    if (wave == 0) {
      float a = p.in[L0_LAMQ1][lane] * p.in[L0_LAMK1][lane], b = p.in[L0_LAMQ2][lane] * p.in[L0_LAMK2][lane];
      a = wave_sum(a); b = wave_sum(b);
      if (lane == 0) { float* LAM = (float*)(p.ws + WS_CTL + CTL_LAM); LAM[0] = expf(a) - expf(b) + 0.2f; *(int*)(p.ws + WS_CTL + CTL_QC) = 0; }
    }
  }
  __syncthreads();
  float* scr = lds + wave * (64 * 33);
  {
    constexpr int I_IN0 = 16 * (N_IN0 / 32), I_OUT = 16 * 32, I_IN1 = 16 * (N_IN1P / 32);
    constexpr int NITEMS = I_IN0 + I_OUT + I_IN1 + I_OUT;
    for (int it = gw; it < NITEMS; it += NGW) {
      int r = it;
      if (r < I_IN0) { if (QKV0_FP8) transpose_item8(p.in[L0_WIN], DM, N_IN0, (unsigned char*)(p.ws + WS_WIN0), 0, 1, scr, r, lane); else transpose_item(p.in[L0_WIN], DM, N_IN0, (bf16_t*)(p.ws + WS_WIN0), 0, 1, scr, r, lane, N_IN0); continue; } r -= I_IN0;
      if (r < I_OUT) { if (OUT_FP8) transpose_item8(p.in[L0_WOUT], DM, DM, (unsigned char*)(p.ws + WS_WOUT0), 0, 1, scr, r, lane); else transpose_item(p.in[L0_WOUT], DM, DM, (bf16_t*)(p.ws + WS_WOUT0), 0, 1, scr, r, lane, DM); continue; } r -= I_OUT;
      if (r < I_IN1) { if (QKV1_FP8) transpose_item8(p.in[L1_WIN], DM, N_IN1, (unsigned char*)(p.ws + WS_WIN1), 0, 1, scr, r, lane, N_IN1P); else transpose_item(p.in[L1_WIN], DM, N_IN1, (bf16_t*)(p.ws + WS_WIN1), 0, 1, scr, r, lane, N_IN1P); continue; } r -= I_IN1;
      if (OUT_FP8) transpose_item8(p.in[L1_WOUT], DM, DM, (unsigned char*)(p.ws + WS_WOUT1), 0, 1, scr, r, lane); else transpose_item(p.in[L1_WOUT], DM, DM, (bf16_t*)(p.ws + WS_WOUT1), 0, 1, scr, r, lane, DM);
    }
  }
  convert_moe_part8(p, 0, 0, scr, gw, NGW, lane);
#ifndef TAILFILL
  convert_moe_part8(p, 0, 1, scr, gw, NGW, lane);
#endif
}

struct Row16 { float4 v[4]; };
DEVI Row16 ld_row_f32(const float* r, int lane) { Row16 o; const float4* q = (const float4*)r + lane;
#pragma unroll
  for (int j = 0; j < 4; ++j) o.v[j] = q[64 * j]; return o; }
DEVI Row16 ld_row_bf16(const bf16_t* r, int lane) { Row16 o; const uint2* q = (const uint2*)r + lane;
#pragma unroll
  for (int j = 0; j < 4; ++j) { const uint2 w = q[64 * j]; o.v[j] = make_float4(__uint_as_float(w.x << 16), __uint_as_float(w.x & 0xffff0000u), __uint_as_float(w.y << 16), __uint_as_float(w.y & 0xffff0000u)); }
  return o; }
DEVI void st_row_f32(float* r, int lane, const Row16& o) { float4* q = (float4*)r + lane;
#pragma unroll
  for (int j = 0; j < 4; ++j) q[64 * j] = o.v[j]; }
DEVI void st_row_bf16(bf16_t* r, int lane, const Row16& o) { uint2* q = (uint2*)r + lane;
#pragma unroll
  for (int j = 0; j < 4; ++j) q[64 * j] = make_uint2(pk2(o.v[j].x, o.v[j].y), pk2(o.v[j].z, o.v[j].w)); }
DEVI float row_sumsq(const Row16& o) { float s = 0.f;
#pragma unroll
  for (int j = 0; j < 4; ++j) s += o.v[j].x * o.v[j].x + o.v[j].y * o.v[j].y + o.v[j].z * o.v[j].z + o.v[j].w * o.v[j].w;
  return wave_sum(s); }
#define ROW_FOR4(expr) _Pragma("unroll") for (int j = 0; j < 4; ++j) { { float& e = o.v[j].x; const float a = A.v[j].x, b = Bv.v[j].x, c = Cv.v[j].x; expr; } { float& e = o.v[j].y; const float a = A.v[j].y, b = Bv.v[j].y, c = Cv.v[j].y; expr; } { float& e = o.v[j].z; const float a = A.v[j].z, b = Bv.v[j].z, c = Cv.v[j].z; expr; } { float& e = o.v[j].w; const float a = A.v[j].w, b = Bv.v[j].w, c = Cv.v[j].w; expr; } }

DEVI Row16 norm_mod(const Row16& x, const float* g, const float* sc, const float* sh, int lane) {
  const float r = rsqrtf(row_sumsq(x) * (1.f / DM) + EPS);
  Row16 o = x; const Row16 A = ld_row_f32(g, lane), Bv = ld_row_f32(sc, lane), Cv = ld_row_f32(sh, lane);
  ROW_FOR4(e = e * r * a * (1.f + b) + c);
  return o;
}

DEVI void phase_prenorm0(const Params& p) {
  const int lane = ftid() & 63, gw = blockIdx.x * NWAVE + (ftid() >> 6), NGW = gridDim.x * NWAVE;
  const float* MOD = (const float*)(p.ws + WS_CTL + CTL_MOD);
  bf16_t* H = (bf16_t*)(p.ws + WS_H);
  for (int r = gw; r < NROW; r += NGW) {
    const float* src = r < NLAT ? p.in[I_X] + (size_t)r * DM : p.in[I_CTX] + (size_t)(r - NLAT) * DM;
    const float* m = MOD + (size_t)row_modrow(r) * 6144;
    const Row16 x = ld_row_f32(src, lane);
    const Row16 h = norm_mod(x, p.in[L0_GPREMIX], m + 1024, m, lane);
    st_row_bf16(H + (size_t)r * DM, lane, h);
  }
}

template <class AF, class EF>
DEVI void gemm_tile(float* lds, const bf16_t* Bt, int n0, int K, AF arow, EF epi) {
  const int tid = ftid(), ty = tid >> 4, tx = tid & 15;
  float (*As)[132] = (float (*)[132])lds;
  float (*Bs)[68] = (float (*)[68])(lds + 16 * 132);
  float acc[4][4];
#pragma unroll
  for (int i = 0; i < 4; ++i)
#pragma unroll
    for (int j = 0; j < 4; ++j) acc[i][j] = 0.f;
  const int ar = tid >> 2, ak = (tid & 3) * 4;
  const int br = tid >> 3, bk = (tid & 7) * 2;
  const bf16_t* ap = arow(ar) + ak;
  const bf16_t* bp = Bt + (size_t)(n0 + br) * K + bk;
  for (int k0 = 0; k0 < K; k0 += 16) {
    const uint2 av = *(const uint2*)(ap + k0);
    const unsigned bv = *(const unsigned*)(bp + k0);
    __syncthreads();
    As[ak + 0][ar] = __uint_as_float(av.x << 16); As[ak + 1][ar] = __uint_as_float(av.x & 0xffff0000u);
    As[ak + 2][ar] = __uint_as_float(av.y << 16); As[ak + 3][ar] = __uint_as_float(av.y & 0xffff0000u);
    Bs[bk + 0][br] = __uint_as_float(bv << 16); Bs[bk + 1][br] = __uint_as_float(bv & 0xffff0000u);
    __syncthreads();
#pragma unroll
    for (int kk = 0; kk < 16; ++kk) {
      const float4 a = *(const float4*)&As[kk][ty * 4]; const float4 b = *(const float4*)&Bs[kk][tx * 4];
      const float aa[4] = {a.x, a.y, a.z, a.w}, bb[4] = {b.x, b.y, b.z, b.w};
#pragma unroll
      for (int i = 0; i < 4; ++i)
#pragma unroll
        for (int j = 0; j < 4; ++j) acc[i][j] += aa[i] * bb[j];
    }
  }
#pragma unroll
  for (int i = 0; i < 4; ++i) epi(ty * 4 + i, n0 + tx * 4, acc[i]);
}

DEVI void rope_pair(const float* ROPE, int t, int d, float& u1, float& u2) {
  const int i = d >> 1, f = i & 15, pos = (i < 16) ? (t >> 6) : (t & 63);
  const float cs = ROPE[(pos * 16 + f) * 2], sn = ROPE[(pos * 16 + f) * 2 + 1];
  const float a = u1 * cs - u2 * sn, b = u1 * sn + u2 * cs; u1 = a; u2 = b;
}

DEVI void phase_qkv0(const Params& p, float* lds) {
  const bf16_t* H = (const bf16_t*)(p.ws + WS_H); const bf16_t* W = (const bf16_t*)(p.ws + WS_WIN0);
  bf16_t* Q = (bf16_t*)(p.ws + WS_QKV0); const float* ROPE = (const float*)(p.ws + WS_CTL + CTL_ROPE);
  constexpr int NTN = N_IN0 / 64, NTM = NROW / 128;
  for (int it = blockIdx.x; it < NTN * NTM; it += gridDim.x) {
    const int mt = it / NTN, nt = it % NTN, m0 = mt * 128;
    gemm_tile(lds, W, nt * 64, DM,
      [&](int r) { return H + (size_t)(m0 + r) * DM; },
      [&](int r, int n, float* v) {
        const int row = m0 + r;
        if (row < NLAT && n < 1024) { const int t = row & 4095; rope_pair(ROPE, t, n & 63, v[0], v[1]); rope_pair(ROPE, t, (n + 2) & 63, v[2], v[3]); }
        *(uint2*)(Q + (size_t)row * N_IN0 + n) = make_uint2(pk2(v[0], v[1]), pk2(v[2], v[3]));
      });
  }
}

template <int NS, int VJ, class KF>
DEVI void wave_attn(const float* qs, float* pl  , int* rl  , int nkeys, KF kf, const bf16_t* KV, int ld, int kcol, int vcol,
                    float sink, bool has_sink, float (&o)[NS][VJ], float (&m)[NS], float (&l)[NS], int lane) {
#pragma unroll
  for (int s = 0; s < NS; ++s) { m[s] = -INFINITY; l[s] = 0.f;
#pragma unroll
    for (int j = 0; j < VJ; ++j) o[s][j] = 0.f; }
  for (int c0 = 0; c0 < nkeys; c0 += 64) {
    const int kidx = c0 + lane; int row = -1; float bias = 0.f;
    bool valid = kidx < nkeys; if (valid) valid = kf(kidx, row, bias);
    const int rr = valid ? row : 0;
    rl[lane] = valid ? row : -1;
    float sc[NS];
#pragma unroll
    for (int s = 0; s < NS; ++s) {
      const uint4* kp = (const uint4*)(KV + (size_t)rr * ld + kcol + 64 * s); float d = 0.f;
#pragma unroll
      for (int i = 0; i < 8; ++i) { const uint4 w = kp[i]; const float* q = qs + s * 64 + i * 8;
        d += q[0] * __uint_as_float(w.x << 16) + q[1] * __uint_as_float(w.x & 0xffff0000u) + q[2] * __uint_as_float(w.y << 16) + q[3] * __uint_as_float(w.y & 0xffff0000u)
           + q[4] * __uint_as_float(w.z << 16) + q[5] * __uint_as_float(w.z & 0xffff0000u) + q[6] * __uint_as_float(w.w << 16) + q[7] * __uint_as_float(w.w & 0xffff0000u); }
      sc[s] = valid ? d + bias : -INFINITY;
    }
#pragma unroll
    for (int s = 0; s < NS; ++s) {
      const float cm = wave_max(sc[s]); const float mn = fmaxf(m[s], cm);
      float pv = 0.f, scale = 1.f;
      if (mn > -INFINITY) { pv = __expf(sc[s] - mn); scale = __expf(m[s] - mn); }
      l[s] = l[s] * scale + wave_sum(pv); m[s] = mn;
#pragma unroll
      for (int j = 0; j < VJ; ++j) o[s][j] *= scale;
      pl[s * 64 + lane] = pv;
    }
    __builtin_amdgcn_s_waitcnt(0); __builtin_amdgcn_wave_barrier();
    for (int kk = 0; kk < 64; ++kk) {
      const int rk = rl[kk]; if (rk < 0) continue;
      const bf16_t* vp = KV + (size_t)rk * ld + vcol + lane;
      float vv[VJ];
#pragma unroll
      for (int j = 0; j < VJ; ++j) vv[j] = bf2f(vp[64 * j]);
#pragma unroll
      for (int s = 0; s < NS; ++s) { const float pk = pl[s * 64 + kk];
#pragma unroll
        for (int j = 0; j < VJ; ++j) o[s][j] += pk * vv[j]; }
    }
    __builtin_amdgcn_s_waitcnt(0); __builtin_amdgcn_wave_barrier();
  }
  if (has_sink) {
#pragma unroll
    for (int s = 0; s < NS; ++s) { const float mn = fmaxf(m[s], sink); const float scale = __expf(m[s] - mn);
      l[s] = l[s] * scale + __expf(sink - mn); m[s] = mn;
#pragma unroll
      for (int j = 0; j < VJ; ++j) o[s][j] *= scale; }
  }
}

DEVI void phase_attn0(const Params& p, float* lds) {
  const int tid = ftid(), lane = tid & 63, wave = tid >> 6;
  const int gw = blockIdx.x * NWAVE + wave, NGW = gridDim.x * NWAVE;
  const bf16_t* Q = (const bf16_t*)(p.ws + WS_QKV0); bf16_t* ATT = (bf16_t*)(p.ws + WS_ATT0);
  const float lam = ((const float*)(p.ws + WS_CTL + CTL_LAM))[0];
  float* qs = lds + wave * 128; float* pl = lds + 1024 + wave * 128; int* rl = (int*)(lds + 2048) + wave * 64;
  for (long it = gw; it < (long)NROW * 12; it += NGW) {
    const int row = (int)(it / 12), hs = (int)(it % 12);
    const bool lat = row < NLAT; const int b = lat ? (row >> 12) : ((row - NLAT) >> 8), t = lat ? (row & 4095) : 0;
    __builtin_amdgcn_s_waitcnt(0); __builtin_amdgcn_wave_barrier();
    if (hs < 4) {
      const bf16_t* qp = Q + (size_t)row * N_IN0 + hs * 128;
      qs[lane] = bf2f(qp[lane]) * 0.125f; qs[64 + lane] = bf2f(qp[64 + lane]) * 0.125f;
      __builtin_amdgcn_s_waitcnt(0); __builtin_amdgcn_wave_barrier();
      float o[2][2], m[2], l[2];
      const int nkeys = lat ? SEQ + CTXL : CTXL;
      wave_attn<2, 2>(qs, pl, rl, nkeys, [&](int k, int& r, float& bias) { r = lat ? (k < SEQ ? b * SEQ + k : NLAT + b * CTXL + (k - SEQ)) : NLAT + b * CTXL + k; return true; },
                      Q, N_IN0, 512 + hs * 128, 1024 + hs * 128, 0.f, false, o, m, l, lane);
      float v0 = o[0][0] / l[0] - lam * o[1][0] / l[1], v1 = o[0][1] / l[0] - lam * o[1][1] / l[1];
      const float r = rsqrtf(wave_sum(v0 * v0 + v1 * v1) * (1.f / 128.f) + EPS);
      const float* g = p.in[L0_SUBLN];
      ATT[(size_t)row * DM + hs * 128 + lane] = f2bf(v0 * r * g[lane] * 0.8f);
      ATT[(size_t)row * DM + hs * 128 + 64 + lane] = f2bf(v1 * r * g[64 + lane] * 0.8f);
    } else {
      const int h = hs - 4;
      qs[lane] = bf2f(Q[(size_t)row * N_IN0 + 1536 + h * 64 + lane]) * 0.125f;
      __builtin_amdgcn_s_waitcnt(0); __builtin_amdgcn_wave_barrier();
      float o[1][1], m[1], l[1];
      const int qr = t >> 6, qc = t & 63;
      const int rs = min(max(qr - 4, 0), 56), cs = min(max(qc - 8, 0), 48);
      const float* rpb = p.in[L0_RPB] + h * 15 * 31;
      const int nkeys = lat ? 128 + CTXL : CTXL;
      wave_attn<1, 1>(qs, pl, rl, nkeys, [&](int k, int& r, float& bias) {
          if (!lat) { r = NLAT + b * CTXL + k; return true; }
          if (k < 128) { const int kr = rs + (k >> 4), kc = cs + (k & 15); r = b * SEQ + kr * 64 + kc; bias = rpb[(kr - qr + 7) * 31 + (kc - qc + 15)]; }
          else r = NLAT + b * CTXL + (k - 128);
          return true; },
        Q, N_IN0, 2048 + h * 64, 2560 + h * 64, 0.f, false, o, m, l, lane);
      ATT[(size_t)row * DM + 512 + h * 64 + lane] = f2bf(o[0][0] / l[0]);
    }
  }
}

DEVI void phase_outproj(const Params& p, float* lds, int layer) {
  const bf16_t* A = (const bf16_t*)(p.ws + (layer ? WS_ATT1 : WS_ATT0)); const bf16_t* W = (const bf16_t*)(p.ws + (layer ? WS_WOUT1 : WS_WOUT0));
  bf16_t* MIX = (bf16_t*)(p.ws + (layer ? WS_MIX1 : WS_MIX0));
  const int NTM = (layer ? NLAT : NROW) / 128; constexpr int NTN = DM / 64;
  for (int it = blockIdx.x; it < NTN * NTM; it += gridDim.x) {
    const int mt = it / NTN, nt = it % NTN, m0 = mt * 128;
    gemm_tile(lds, W, nt * 64, DM, [&](int r) { return A + (size_t)(m0 + r) * DM; },
      [&](int r, int n, float* v) { *(uint2*)(MIX + (size_t)(m0 + r) * DM + n) = make_uint2(pk2(v[0], v[1]), pk2(v[2], v[3])); });
  }
}

DEVI void phase_postmix(const Params& p, int layer) {
  const int lane = ftid() & 63, gw = blockIdx.x * NWAVE + (ftid() >> 6), NGW = gridDim.x * NWAVE;
  const float* MOD = (const float*)(p.ws + WS_CTL + CTL_MOD) + (size_t)layer * 9 * 6144;
  const bf16_t* MIX = (const bf16_t*)(p.ws + (layer ? WS_MIX1 : WS_MIX0));
  bf16_t* H = (bf16_t*)(p.ws + WS_H); float* AFF = (float*)(p.ws + WS_AFF); float* XC = (float*)(p.ws + WS_XC);
  const float* gpost = p.in[layer ? L1_GPOSTMIX : L0_GPOSTMIX]; const float* gpre = p.in[layer ? L1_GPREFFN : L0_GPREFFN];
  const float* wr = p.in[layer ? L1_WROUTER : L0_WROUTER];
  const int nrow = layer ? NLAT : NROW;
  for (int r = gw; r < nrow; r += NGW) {
    const float* m = MOD + (size_t)row_modrow(r) * 6144;
    const float* xin = layer ? (p.out + (size_t)r * DM) : (r < NLAT ? p.in[I_X] + (size_t)r * DM : p.in[I_CTX] + (size_t)(r - NLAT) * DM);
    float* xout = r < NLAT ? p.out + (size_t)r * DM : XC + (size_t)(r - NLAT) * DM;
    Row16 o = ld_row_bf16(MIX + (size_t)r * DM, lane);
    const float rr = rsqrtf(row_sumsq(o) * (1.f / DM) + EPS);
    { const Row16 A = ld_row_f32(gpost, lane), Bv = ld_row_f32(m + 2048, lane), Cv = ld_row_f32(xin, lane);
      ROW_FOR4(e = c + b * (e * rr * a)); }
    st_row_f32(xout, lane, o);
    const Row16 h = norm_mod(o, gpre, m + 4096, m + 3072, lane);
    st_row_bf16(H + (size_t)r * DM, lane, h);
    float lg[16];
#pragma unroll
    for (int e = 0; e < 16; ++e) lg[e] = 0.f;
#pragma unroll
    for (int j = 0; j < 4; ++j) {
      const float hv[4] = {h.v[j].x, h.v[j].y, h.v[j].z, h.v[j].w};
#pragma unroll
      for (int q = 0; q < 4; ++q) { const float4* w4 = (const float4*)(wr + (size_t)(lane * 4 + 256 * j + q) * 16);
#pragma unroll
        for (int e4 = 0; e4 < 4; ++e4) { const float4 w = w4[e4]; lg[e4 * 4] += hv[q] * w.x; lg[e4 * 4 + 1] += hv[q] * w.y; lg[e4 * 4 + 2] += hv[q] * w.z; lg[e4 * 4 + 3] += hv[q] * w.w; } }
    }
    float mx = -INFINITY;
#pragma unroll
    for (int e = 0; e < 16; ++e) { lg[e] = wave_sum(lg[e]); mx = fmaxf(mx, lg[e]); }
    float s = 0.f;
#pragma unroll
    for (int e = 0; e < 16; ++e) { lg[e] = expf(lg[e] - mx); s += lg[e]; }
    const float inv = 1.f / s;
    float mine = 0.f;
#pragma unroll
    for (int e = 0; e < 16; ++e) if (lane == e) mine = lg[e] * inv;
    if (lane < 16) AFF[(size_t)lane * NROW + r] = mine;
  }
}

DEVI void phase_topk(const Params& p, float* lds, int layer) {
  const int tid = ftid();
  const float* AFF = (const float*)(p.ws + WS_AFF); int* SLOT = (int*)(p.ws + WS_SLOT); int* IDX = (int*)(p.ws + WS_IDX); float* GV = (float*)(p.ws + WS_GATEV);
  const int erows = layer ? EROWS1 : EROWS0;
  const int nlat_items = NB * NE * 8, nitems = nlat_items + (layer ? 0 : NB * NE);
  for (int it = blockIdx.x; it < nitems; it += gridDim.x) {
    const bool lat = it < nlat_items;
    int b, e, ch, n, cap, row0, slot0;
    if (lat) { b = it / (NE * 8); e = (it / 8) % NE; ch = it % 8; n = SEQ; cap = CAP_L; row0 = b * SEQ; slot0 = b * CAP_L; }
    else { const int i2 = it - nlat_items; b = i2 / NE; e = i2 % NE; ch = 0; n = CTXL; cap = CAP_C; row0 = NLAT + b * CTXL; slot0 = NB * CAP_L + b * CAP_C; }
    __syncthreads();
    for (int i = tid; i < n; i += NT) lds[i] = AFF[(size_t)e * NROW + row0 + i];
    __syncthreads();
    const int t = ch * 512 + tid;
    if (t < n) {
      const float a = lds[t]; int rank = 0;
      for (int j = 0; j < n; ++j) { const float v = lds[j]; rank += (v > a || (v == a && j < t)) ? 1 : 0; }
      if (rank < cap) { IDX[e * erows + slot0 + rank] = row0 + t; GV[e * erows + slot0 + rank] = a; SLOT[(size_t)(row0 + t) * 16 + e] = slot0 + rank; }
      else SLOT[(size_t)(row0 + t) * 16 + e] = -1;
    }
  }
}

DEVI void phase_moe_up(const Params& p, float* lds, int layer) {
  const bf16_t* H = (const bf16_t*)(p.ws + WS_H); const bf16_t* WGU = (const bf16_t*)(p.ws + WS_WGU); bf16_t* HID = (bf16_t*)(p.ws + WS_HID);
  const int* IDX = (const int*)(p.ws + WS_IDX);
  const int erows = layer ? EROWS1 : EROWS0, NTM = erows / 128; constexpr int NTN = 2048 / 64;
  for (int it = blockIdx.x; it < NE * NTM * NTN; it += gridDim.x) {
    const int e = it / (NTM * NTN), r2 = it % (NTM * NTN), mt = r2 / NTN, nt = r2 % NTN, m0 = mt * 128;
    gemm_tile(lds, WGU + (size_t)e * 2048 * DM, nt * 64, DM, [&](int r) { return H + (size_t)IDX[e * erows + m0 + r] * DM; },
      [&](int r, int n, float* v) { *(unsigned*)(HID + ((size_t)e * erows + m0 + r) * DM + (n >> 1)) = pk2(silu_f(v[0]) * v[1], silu_f(v[2]) * v[3]); });
  }
}
DEVI void phase_moe_down(const Params& p, float* lds, int layer) {
  const bf16_t* HID = (const bf16_t*)(p.ws + WS_HID); const bf16_t* WD = (const bf16_t*)(p.ws + WS_WD); bf16_t* Y = (bf16_t*)(p.ws + WS_Y);
  const float* GV = (const float*)(p.ws + WS_GATEV);
  const int erows = layer ? EROWS1 : EROWS0, NTM = erows / 128; constexpr int NTN = DM / 64;
  for (int it = blockIdx.x; it < NE * NTM * NTN; it += gridDim.x) {
    const int e = it / (NTM * NTN), r2 = it % (NTM * NTN), mt = r2 / NTN, nt = r2 % NTN, m0 = mt * 128;
    gemm_tile(lds, WD + (size_t)e * DM * DM, nt * 64, DM, [&](int r) { return HID + ((size_t)e * erows + m0 + r) * DM; },
      [&](int r, int n, float* v) { const float g = GV[e * erows + m0 + r];
        *(uint2*)(Y + ((size_t)e * erows + m0 + r) * DM + n) = make_uint2(pk2(v[0] * g, v[1] * g), pk2(v[2] * g, v[3] * g)); });
  }
}

DEVI void phase_combine(const Params& p, float* lds, int layer) {
  const int lane = ftid() & 63, wave = ftid() >> 6, gw = blockIdx.x * NWAVE + wave, NGW = gridDim.x * NWAVE;
  const float* MOD = (const float*)(p.ws + WS_CTL + CTL_MOD);
  const bf16_t* Y = (const bf16_t*)(p.ws + WS_Y); const int* SLOT = (const int*)(p.ws + WS_SLOT);
  bf16_t* H = (bf16_t*)(p.ws + WS_H); float* XC = (float*)(p.ws + WS_XC);
  const float* gpost = p.in[layer ? L1_GPOSTFFN : L0_GPOSTFFN];
  const int nrow = layer ? NLAT : NROW, erows = layer ? EROWS1 : EROWS0;
  for (int r = gw; r < nrow; r += NGW) {
    const float* m = MOD + (size_t)(layer * 9 + row_modrow(r)) * 6144;
    float* xio = r < NLAT ? p.out + (size_t)r * DM : XC + (size_t)(r - NLAT) * DM;
    Row16 o;
#pragma unroll
    for (int j = 0; j < 4; ++j) o.v[j] = make_float4(0.f, 0.f, 0.f, 0.f);
    for (int e = 0; e < NE; ++e) {
      const int s = SLOT[(size_t)r * 16 + e];
      if (s >= 0) { const Row16 y = ld_row_bf16(Y + ((size_t)e * erows + s) * DM, lane);
#pragma unroll
        for (int j = 0; j < 4; ++j) { o.v[j].x += y.v[j].x; o.v[j].y += y.v[j].y; o.v[j].z += y.v[j].z; o.v[j].w += y.v[j].w; } }
    }
    const float rr = rsqrtf(row_sumsq(o) * (1.f / DM) + EPS);
    { const Row16 A = ld_row_f32(gpost, lane), Bv = ld_row_f32(m + 5120, lane), Cv = ld_row_f32(xio, lane);
      ROW_FOR4(e = c + b * (e * rr * a)); }
    st_row_f32(xio, lane, o);
    if (layer == 0) {
      const float* m1 = MOD + (size_t)(9 + row_modrow(r)) * 6144;
      const Row16 h = norm_mod(o, p.in[L1_GPREMIX], m1 + 1024, m1, lane);
      st_row_bf16(H + (size_t)r * DM, lane, h);
    }
  }
  if (layer == 0) { convert_moe_part(p, 1, 0, lds + wave * (64 * 33), gw, NGW, lane); convert_moe_part(p, 1, 1, lds + wave * (64 * 33), gw, NGW, lane); }
}

DEVI void phase_qkv1(const Params& p, float* lds) {
  const bf16_t* H = (const bf16_t*)(p.ws + WS_H); const bf16_t* W = (const bf16_t*)(p.ws + WS_WIN1);
  bf16_t* P1 = (bf16_t*)(p.ws + WS_P1); float* DT = (float*)(p.ws + WS_DT); const float* ROPE = (const float*)(p.ws + WS_CTL + CTL_ROPE);
  constexpr int NTN = 37, NTM = NROW / 128;
  for (int it = blockIdx.x; it < NTN * NTM; it += gridDim.x) {
    const int mt = it / NTN, nt = it % NTN, m0 = mt * 128;
    gemm_tile(lds, W, nt * 64, DM, [&](int r) { return H + (size_t)(m0 + r) * DM; },
      [&](int r, int n, float* v) {
        const int row = m0 + r;
        if (n >= 2304) { if (n < 2320) *(float4*)(DT + (size_t)row * 16 + (n - 2304)) = make_float4(v[0], v[1], v[2], v[3]); return; }
        if (row < NLAT && n < 640) { const int t = row & 4095; rope_pair(ROPE, t, n & 63, v[0], v[1]); rope_pair(ROPE, t, (n + 2) & 63, v[2], v[3]); }
        *(uint2*)(P1 + (size_t)row * 2304 + n) = make_uint2(pk2(v[0], v[1]), pk2(v[2], v[3]));
      });
  }
}

DEVI void phase_conv_swa(const Params& p, float* lds, bool do_swa) {
  const int tid = ftid(), lane = tid & 63, wave = tid >> 6;
  const int gw = blockIdx.x * NWAVE + wave, NGW = gridDim.x * NWAVE;
  const bf16_t* P1 = (const bf16_t*)(p.ws + WS_P1); bf16_t* U = (bf16_t*)(p.ws + WS_U); bf16_t* ATT = (bf16_t*)(p.ws + WS_ATT1);
  const float* cw = p.in[L1_CONVW]; const float* cb = p.in[L1_CONVB];
  for (long i = (long)blockIdx.x * NT + tid; i < (long)NROW * 1024; i += (long)gridDim.x * NT) {
    const int row = (int)(i >> 10), ch = (int)(i & 1023);
    int s0, len, t; if (row < NLAT) { s0 = row & ~4095; len = SEQ; t = row & 4095; } else { s0 = NLAT + ((row - NLAT) & ~255); len = CTXL; t = (row - NLAT) & 255; }
    float acc = cb[ch];
#pragma unroll
    for (int j = 0; j < 5; ++j) { const int tt = t + j - 2; if (tt >= 0 && tt < len) acc += cw[j * 1024 + ch] * bf2f(P1[(size_t)(s0 + tt) * 2304 + 768 + ch]); }
    U[(size_t)row * 1024 + ch] = f2bf(silu_f(acc));
  }
  if (!do_swa) return;
  float* qs = lds + wave * 128; float* pl = lds + 1024 + wave * 128; int* rl = (int*)(lds + 2048) + wave * 64;
  for (long it = gw; it < (long)NLAT * 8; it += NGW) {
    const int row = (int)(it >> 3), hq = (int)(it & 7), g = hq >> 2, b = row >> 12, t = row & 4095;
    __builtin_amdgcn_s_waitcnt(0); __builtin_amdgcn_wave_barrier();
    qs[lane] = bf2f(P1[(size_t)row * 2304 + hq * 64 + lane]) * 0.125f;
    __builtin_amdgcn_s_waitcnt(0); __builtin_amdgcn_wave_barrier();
    float o[1][1], m[1], l[1];
    wave_attn<1, 1>(qs, pl, rl, 320 + CTXL, [&](int k, int& r, float& bias) {
        if (k < 320) { const int kp = t - 128 + k; if (k > 256 || kp < 0 || kp >= SEQ) return false; r = b * SEQ + kp; return true; }
        r = NLAT + b * CTXL + (k - 320); return true; },
      P1, 2304, 512 + g * 64, 640 + g * 64, p.in[L1_SINKS][hq], true, o, m, l, lane);
    ATT[(size_t)row * DM + hq * 64 + lane] = f2bf(o[0][0] / l[0]);
  }
}

DEVI void phase_ssd(const Params& p, float* lds) {
  const int tid = ftid();
  const bf16_t* U = (const bf16_t*)(p.ws + WS_U); const float* DT = (const float*)(p.ws + WS_DT); float* YS = (float*)(p.ws + WS_YS);
  constexpr int CH = 32;
  float* xb = lds;
  float* bb = lds + CH * 64;
  float* cb = bb + CH * 128;
  float* db = cb + CH * 128;
  float* yb = db + 2 * CH;
  const int pi = tid >> 3, ns = (tid & 7) * 16;
  for (int it = blockIdx.x; it < NB * 8; it += gridDim.x) {
    const int b = it >> 3, hd = it & 7, g = hd >> 2;
    for (int dir = 0; dir < 2; ++dir) {
      const float a = -expf(p.in[dir ? L1_ALOGB : L1_ALOGF][hd]); const float dtb = p.in[dir ? L1_DTBB : L1_DTBF][hd];
      float st[16];
#pragma unroll
      for (int i = 0; i < 16; ++i) st[i] = 0.f;
      for (int seg = 0; seg < 2; ++seg) {
        const int len = seg ? SEQ : CTXL, s0 = seg ? b * SEQ : NLAT + b * CTXL;
        for (int c0 = 0; c0 < len; c0 += CH) {
          __syncthreads();
          for (int i = tid; i < CH * 320; i += NT) {
            const int st_i = i / 320, c = i % 320; const int tk = dir ? (len - 1 - (c0 + st_i)) : (c0 + st_i); const size_t r = (size_t)(s0 + tk);
            if (c < 64) xb[st_i * 64 + c] = bf2f(U[r * 1024 + hd * 64 + c]);
            else if (c < 192) bb[st_i * 128 + (c - 64)] = bf2f(U[r * 1024 + 512 + g * 128 + (c - 64)]);
            else cb[st_i * 128 + (c - 192)] = bf2f(U[r * 1024 + 768 + g * 128 + (c - 192)]);
          }
          if (tid < CH) { const int tk = dir ? (len - 1 - (c0 + tid)) : (c0 + tid); const float raw = DT[(size_t)(s0 + tk) * 16 + dir * 8 + hd] + dtb;
            const float dt = raw > 20.f ? raw : log1pf(expf(raw)); db[tid] = expf(dt * a); db[CH + tid] = dt; }
          __syncthreads();
          for (int i = 0; i < CH; ++i) {
            const float dec = db[i], dx = db[CH + i] * xb[i * 64 + pi]; float y = 0.f;
#pragma unroll
            for (int q = 0; q < 16; ++q) { st[q] = st[q] * dec + dx * bb[i * 128 + ns + q]; y += st[q] * cb[i * 128 + ns + q]; }
            y += __shfl_xor(y, 1); y += __shfl_xor(y, 2); y += __shfl_xor(y, 4);
            if ((tid & 7) == 0) yb[i * 64 + pi] = y;
          }
          __syncthreads();
          if (seg == 1) for (int i = tid; i < CH * 64; i += NT) {
            const int q = i >> 6, c = i & 63; const int tk = (dir ? (len - CH - c0) : c0) + q, st_i = dir ? (CH - 1 - q) : q;
            float* yp = YS + (size_t)(b * SEQ + tk) * 512 + hd * 64 + c;
            if (dir == 0) *yp = yb[st_i * 64 + c]; else *yp = *yp + yb[st_i * 64 + c];
          }
        }
      }
      __syncthreads(); __threadfence();
    }
  }
}

DEVI void phase_ssd_out(const Params& p) {
  const int lane = ftid() & 63, gw = blockIdx.x * NWAVE + (ftid() >> 6), NGW = gridDim.x * NWAVE;
  const bf16_t* U = (const bf16_t*)(p.ws + WS_U); const bf16_t* P1 = (const bf16_t*)(p.ws + WS_P1); const float* YS = (const float*)(p.ws + WS_YS);
  bf16_t* ATT = (bf16_t*)(p.ws + WS_ATT1);
  for (int r = gw; r < NLAT; r += NGW) {
    const int c0 = lane * 8, hd = c0 >> 6; const float dsk = p.in[L1_DSKIP][hd];
    const float4 y0 = *(const float4*)(YS + (size_t)r * 512 + c0), y1 = *(const float4*)(YS + (size_t)r * 512 + c0 + 4);
    const uint4 xw = *(const uint4*)(U + (size_t)r * 1024 + c0), zw = *(const uint4*)(P1 + (size_t)r * 2304 + 1792 + c0);
    float y[8] = {y0.x, y0.y, y0.z, y0.w, y1.x, y1.y, y1.z, y1.w};
    const unsigned xs[4] = {xw.x, xw.y, xw.z, xw.w}, zs[4] = {zw.x, zw.y, zw.z, zw.w};
    float ss = 0.f;
#pragma unroll
    for (int i = 0; i < 4; ++i) {
      const float x0 = __uint_as_float(xs[i] << 16), x1 = __uint_as_float(xs[i] & 0xffff0000u), z0 = __uint_as_float(zs[i] << 16), z1 = __uint_as_float(zs[i] & 0xffff0000u);
      y[2 * i] = (y[2 * i] + dsk * x0) * silu_f(z0); y[2 * i + 1] = (y[2 * i + 1] + dsk * x1) * silu_f(z1);
      ss += y[2 * i] * y[2 * i] + y[2 * i + 1] * y[2 * i + 1];
    }
#pragma unroll
    for (int o = 1; o < 32; o <<= 1) ss += __shfl_xor(ss, o);
    const float rr = rsqrtf(ss * (1.f / 256.f) + EPS);
    const float4 g0 = *(const float4*)(p.in[L1_GNORM] + c0), g1 = *(const float4*)(p.in[L1_GNORM] + c0 + 4);
    uint4 w; w.x = pk2(y[0] * rr * g0.x, y[1] * rr * g0.y); w.y = pk2(y[2] * rr * g0.z, y[3] * rr * g0.w); w.z = pk2(y[4] * rr * g1.x, y[5] * rr * g1.y); w.w = pk2(y[6] * rr * g1.z, y[7] * rr * g1.w);
    *(uint4*)(ATT + (size_t)r * DM + 512 + c0) = w;
  }
}

}
namespace pg8 {
#define PG8_LAS __attribute__((address_space(3)))
typedef unsigned short bf16_t;
typedef short bf16x8 __attribute__((ext_vector_type(8)));
typedef float f32x4 __attribute__((ext_vector_type(4)));
typedef unsigned u32x4 __attribute__((ext_vector_type(4)));
constexpr int BM = 256, BK = 64, HALF = 128, HTB = HALF * BK * 2  , STAGE_BYTES = 8 * HTB, NXCD = 8, WGM = 8;

__host__ __device__ __forceinline__ int lds_byte(int r, int c) { const int st = (r >> 4) * 2 + (c >> 5), rr = r & 15, cc = c & 31, ob = rr * 64 + cc * 2; return st * 1024 + (ob ^ (((ob >> 9) & 1) << 5)); }
__host__ __device__ __forceinline__ void stage_rc(int b, int& R, int& C) { const int st = b / 1024, sb = b % 1024, swz = sb ^ (((sb >> 9) & 1) << 5); R = (st >> 1) * 16 + swz / 64; C = (st & 1) * 32 + (swz % 64) / 2; }
__host__ __device__ __forceinline__ int perm32(int rho) { const int n = rho >> 4, i = rho & 15; return 8 * (i >> 2) + 4 * n + (i & 3); }

struct Unit { int pm, pn; };
struct Gemm { const bf16_t* A; const bf16_t* Bt; int M, N, K; const int* gidx = nullptr; int sw = 0x7f7f7f7f, sa = 0x7f7f7f7f; };

struct StaticOrder {
    int nM, nN, nwg, G, c;
    __host__ __device__ void init(int M, int N, int G_, int c_) { nM = M / BM; nN = N / BM; nwg = nM * nN; G = G_; c = c_; }
    __host__ __device__ bool next(int i, Unit& u) const {
        const long L = (long)i * G + c; if (L >= nwg) return false;
        int wgid = (int)L; { const int q = nwg / NXCD, r = nwg % NXCD, xcd = wgid % NXCD, off = wgid / NXCD; wgid = (xcd < r ? xcd * (q + 1) : r * (q + 1) + (xcd - r) * q) + off; }
        const int nig = WGM * nN, gid = wgid / nig, fm = gid * WGM, gsz = (nM - fm) < WGM ? (nM - fm) : WGM;
        u.pm = fm + ((wgid % nig) % gsz); u.pn = (wgid % nig) / gsz; return true;
    }
    __device__ __forceinline__ void a_ready(const Unit&) const {}
    __device__ __forceinline__ void done(const Unit&) const {}
};

template <class Epi, class Sched, bool ALIGN_EPI = false, bool SP2 = false, bool FP8 = false>
__device__ __forceinline__ void gemm_phase(PG8_LAS unsigned char* lds, const Gemm g, const Sched& S, const Epi& E) {
    const int tid = ftid(), wid = __builtin_amdgcn_readfirstlane(tid >> 6), lane = tid & 63, wr = wid >> 2, wc = wid & 3, fr = lane & 15, fq = lane >> 4;
    const int KB = g.K * (FP8 ? 1 : 2), nt = KB / (BK * 2);
    unsigned voffB[2]; int pR[2], pC[2];
#pragma unroll
    for (int i = 0; i < 2; ++i) { int R, C; stage_rc(tid * 16 + i * 8192, R, C); const int Rb = Epi::PERM ? ((R & ~31) + perm32(R & 31)) : R;
        pR[i] = R; pC[i] = C; voffB[i] = (unsigned)(Rb * KB + C * 2); }
    unsigned cvo[2][2], nvo[2][2];
#define PG8_SETVO(vo, pm_) do { _Pragma("unroll") for (int _h = 0; _h < 2; ++_h) _Pragma("unroll") for (int _i = 0; _i < 2; ++_i) { const int _r = (pm_) * BM + _h * HALF + pR[_i]; \
        const int _g = g.gidx ? g.gidx[_r] : _r; vo[_h][_i] = (unsigned)_g * (unsigned)KB + (unsigned)(pC[_i] * 2); } } while (0)
#define PG8_STAGEA(bufoff, koff, vo) do { _Pragma("unroll") for (int _i = 0; _i < 2; ++_i) \
        __builtin_amdgcn_global_load_lds((const unsigned*)((const char*)g.A + (koff) + (vo)[_i]), (PG8_LAS unsigned*)(lds + (bufoff) + ldsw + _i * 8192), 16, 0, 0); } while (0)
    const size_t kstep = (size_t)(BK * 2);
    const size_t hstep = (size_t)HALF * KB;
    const size_t tstep = 2 * hstep;
    const unsigned ldsw = (unsigned)wid * 1024u;
    const int aoff = lds_byte(wr * 64 + fr, fq * 8), boff = lds_byte(wc * 32 + fr, fq * 8);
#define PG8_SA(b, h) (((b) * 2 + (h)) * HTB)
#define PG8_SB(b, h) ((4 + (b) * 2 + (h)) * HTB)
#define PG8_STAGE(bufoff, gbase, voff) do { _Pragma("unroll") for (int _i = 0; _i < 2; ++_i) \
        __builtin_amdgcn_global_load_lds((const unsigned*)((const char*)(gbase) + (voff)[_i]), (PG8_LAS unsigned*)(lds + (bufoff) + ldsw + _i * 8192), 16, 0, 0); } while (0)
    typedef int v4i_t __attribute__((ext_vector_type(4))); typedef int v8i_t __attribute__((ext_vector_type(8)));
#define PG8_CAT8(x, y) __builtin_shufflevector(__builtin_bit_cast(v4i_t, x), __builtin_bit_cast(v4i_t, y), 0, 1, 2, 3, 4, 5, 6, 7)
#define PG8_LDA(dst, b, h) do { _Pragma("unroll") for (int m = 0; m < 4; ++m) { const bf16x8 f0_ = *(const PG8_LAS bf16x8*)(lds + PG8_SA(b, h) + aoff + m * 2048), f1_ = *(const PG8_LAS bf16x8*)(lds + PG8_SA(b, h) + aoff + m * 2048 + 1024); \
        if constexpr (FP8) dst##8[m] = PG8_CAT8(f0_, f1_); else { dst[m][0] = f0_; dst[m][1] = f1_; } } } while (0)
#define PG8_LDB(dst, b, h) do { _Pragma("unroll") for (int n = 0; n < 2; ++n) { const bf16x8 f0_ = *(const PG8_LAS bf16x8*)(lds + PG8_SB(b, h) + boff + n * 2048), f1_ = *(const PG8_LAS bf16x8*)(lds + PG8_SB(b, h) + boff + n * 2048 + 1024); \
        if constexpr (FP8) dst##8[n] = PG8_CAT8(f0_, f1_); else { dst[n][0] = f0_; dst[n][1] = f1_; } } } while (0)
typedef int v4i_t __attribute__((ext_vector_type(4))); typedef int v8i_t __attribute__((ext_vector_type(8)));
#define PG8_CAT8(x, y) __builtin_shufflevector(__builtin_bit_cast(v4i_t, x), __builtin_bit_cast(v4i_t, y), 0, 1, 2, 3, 4, 5, 6, 7)
#define PG8_MMA(ai, bj, At, Bt) do { __builtin_amdgcn_s_setprio(1); _Pragma("unroll") for (int m = 0; m < 4; ++m) _Pragma("unroll") for (int n = 0; n < 2; ++n) { \
        if constexpr (FP8) asm volatile("v_mfma_scale_f32_16x16x128_f8f6f4 %0, %1, %2, %0, %3, %4 op_sel_hi:[0,0,0]" : "+v"(acc[ai][bj][m][n]) : "v"(Bt##8[n]), "v"(At##8[m]), "v"(sw_), "v"(sa_)); \
        else { _Pragma("unroll") for (int k = 0; k < 2; ++k) acc[ai][bj][m][n] = __builtin_amdgcn_mfma_f32_16x16x32_bf16(Bt[n][k], At[m][k], acc[ai][bj][m][n], 0, 0, 0); } } \
        __builtin_amdgcn_s_setprio(0); } while (0)
#define PG8_WAIT_V(n) asm volatile("s_waitcnt vmcnt(" #n ")" ::: "memory")
#define PG8_WAIT_L(n) asm volatile("s_waitcnt lgkmcnt(" #n ")" ::: "memory")
#define PG8_BAR __builtin_amdgcn_s_barrier()
#define PG8_SCHED __builtin_amdgcn_sched_barrier(0)
    Unit cur, nxt; int ui = 0;
    if (!S.next(0, cur)) return;
    f32x4 acc[2][2][4][2];
#pragma unroll
    for (int a = 0; a < 2; ++a)
#pragma unroll
        for (int b = 0; b < 2; ++b)
#pragma unroll
            for (int m = 0; m < 4; ++m)
#pragma unroll
                for (int n = 0; n < 2; ++n) acc[a][b][m][n] = (f32x4){0.f, 0.f, 0.f, 0.f};
    const int sw_ = g.sw, sa_ = g.sa;
    bf16x8 At[4][2], B0[2][2], B1[2][2]; v8i_t At8[4], B08[2], B18[2];
    PG8_SETVO(cvo, cur.pm); const char* cB = (const char*)g.Bt + (size_t)cur.pn * tstep;
    S.a_ready(cur);
    if constexpr (SP2) {
        PG8_STAGE(PG8_SB(0, 0), cB, voffB); PG8_STAGE(PG8_SB(0, 1), cB + hstep, voffB); PG8_STAGEA(PG8_SA(0, 0), 0, cvo[0]); PG8_STAGEA(PG8_SA(0, 1), 0, cvo[1]);
        if (wr == 1) PG8_BAR;
        PG8_WAIT_V(2); PG8_BAR;
        PG8_STAGE(PG8_SB(1, 0), cB + kstep, voffB); PG8_STAGEA(PG8_SA(1, 0), kstep, cvo[0]); PG8_STAGE(PG8_SB(1, 1), cB + hstep + kstep, voffB);
        PG8_WAIT_V(6); PG8_BAR;
    } else {
        PG8_STAGE(PG8_SB(0, 0), cB, voffB); PG8_STAGEA(PG8_SA(0, 0), 0, cvo[0]); PG8_STAGE(PG8_SB(0, 1), cB + hstep, voffB); PG8_STAGEA(PG8_SA(0, 1), 0, cvo[1]);
        if (wr == 1) PG8_BAR;
        PG8_WAIT_V(4); PG8_BAR;
        PG8_STAGE(PG8_SB(1, 0), cB + kstep, voffB); PG8_STAGEA(PG8_SA(1, 0), kstep, cvo[0]); PG8_STAGE(PG8_SB(1, 1), cB + hstep + kstep, voffB);
        PG8_WAIT_V(6); PG8_BAR;
    }
    for (;;) {
        const bool has_next = S.next(ui + 1, nxt);
        if (has_next) PG8_SETVO(nvo, nxt.pm); else { nvo[0][0] = cvo[0][0]; nvo[0][1] = cvo[0][1]; nvo[1][0] = cvo[1][0]; nvo[1][1] = cvo[1][1]; }
        const char* nB = has_next ? (const char*)g.Bt + (size_t)nxt.pn * tstep : cB;
#pragma unroll 1
        for (int t = 0; t < nt; t += 2) {
            const bool last = (t == nt - 2);
            const size_t k1 = (size_t)(t + 1) * kstep;
            const size_t k2 = last ? 0 : (size_t)(t + 2) * kstep; unsigned v2[2][2];
            v2[0][0] = last ? nvo[0][0] : cvo[0][0]; v2[0][1] = last ? nvo[0][1] : cvo[0][1]; v2[1][0] = last ? nvo[1][0] : cvo[1][0]; v2[1][1] = last ? nvo[1][1] : cvo[1][1];
            const char* b2 = last ? nB : cB + (size_t)(t + 2) * kstep;
            const size_t k3 = k2 + kstep; const char* b3 = b2 + kstep;
            if (last && has_next) S.a_ready(nxt);
            if constexpr (SP2) {
            PG8_LDB(B0, 0, 0); PG8_LDB(B1, 0, 1); PG8_SCHED; PG8_LDA(At, 0, 0); PG8_STAGEA(PG8_SA(1, 1), k1, cvo[1]);
            PG8_WAIT_V(8); PG8_WAIT_L(0); PG8_BAR; PG8_MMA(0, 0, At, B0); PG8_MMA(0, 1, At, B1); PG8_BAR; PG8_SCHED;
            PG8_LDA(At, 0, 1); PG8_STAGE(PG8_SB(0, 0), b2, voffB); PG8_STAGE(PG8_SB(0, 1), b2 + hstep, voffB); PG8_STAGEA(PG8_SA(0, 0), k2, v2[0]);
            PG8_WAIT_V(8); PG8_WAIT_L(0); PG8_BAR; PG8_MMA(1, 0, At, B0); PG8_MMA(1, 1, At, B1); PG8_BAR; PG8_SCHED;
            PG8_LDB(B0, 1, 0); PG8_LDB(B1, 1, 1); PG8_SCHED; PG8_LDA(At, 1, 0); PG8_STAGEA(PG8_SA(0, 1), k2, v2[1]);
            PG8_WAIT_V(8); PG8_WAIT_L(0); PG8_BAR; PG8_MMA(0, 0, At, B0); PG8_MMA(0, 1, At, B1); PG8_BAR; PG8_SCHED;
            PG8_LDA(At, 1, 1); PG8_STAGE(PG8_SB(1, 0), b3, voffB); PG8_STAGE(PG8_SB(1, 1), b3 + hstep, voffB); PG8_STAGEA(PG8_SA(1, 0), k3, v2[0]);
            PG8_WAIT_V(8); PG8_WAIT_L(0); PG8_BAR; PG8_MMA(1, 0, At, B0); PG8_MMA(1, 1, At, B1); PG8_BAR; PG8_SCHED;
            } else {
            PG8_LDB(B0, 0, 0); PG8_SCHED; PG8_LDA(At, 0, 0); PG8_STAGEA(PG8_SA(1, 1), k1, cvo[1]);
            PG8_WAIT_L(8); PG8_BAR; PG8_WAIT_L(0); PG8_MMA(0, 0, At, B0); PG8_BAR; PG8_SCHED;
            PG8_LDB(B1, 0, 1); PG8_STAGE(PG8_SB(0, 0), b2, voffB);
            PG8_BAR; PG8_WAIT_L(0); PG8_MMA(0, 1, At, B1); PG8_BAR;
            PG8_LDA(At, 0, 1); PG8_STAGEA(PG8_SA(0, 0), k2, v2[0]);
            PG8_BAR; PG8_WAIT_L(0); PG8_MMA(1, 0, At, B0); PG8_BAR; PG8_SCHED;
            PG8_STAGE(PG8_SB(0, 1), b2 + hstep, voffB);
            PG8_WAIT_V(6); PG8_BAR; PG8_MMA(1, 1, At, B1); PG8_BAR;
            PG8_LDB(B0, 1, 0); PG8_SCHED; PG8_LDA(At, 1, 0); PG8_STAGEA(PG8_SA(0, 1), k2, v2[1]);
            PG8_WAIT_L(8); PG8_BAR; PG8_WAIT_L(0); PG8_MMA(0, 0, At, B0); PG8_BAR; PG8_SCHED;
            PG8_LDB(B1, 1, 1); PG8_STAGE(PG8_SB(1, 0), b3, voffB);
            PG8_BAR; PG8_WAIT_L(0); PG8_MMA(0, 1, At, B1); PG8_BAR;
            PG8_LDA(At, 1, 1); PG8_STAGEA(PG8_SA(1, 0), k3, v2[0]);
            PG8_BAR; PG8_WAIT_L(0); PG8_MMA(1, 0, At, B0); PG8_BAR; PG8_SCHED;
            PG8_STAGE(PG8_SB(1, 1), b3 + hstep, voffB);
            PG8_WAIT_V(6); PG8_BAR; PG8_MMA(1, 1, At, B1); PG8_BAR;
            }
        }
        if constexpr (ALIGN_EPI) { if (wr == 0) PG8_BAR; }
        if constexpr (FP8) asm volatile("s_nop 15\n\ts_nop 15" ::: "memory");
        if constexpr (!Epi::AFTER_DRAIN) { E(acc, cur, wr, wc, fr, fq); S.done(cur); }
        if (!has_next) break;
#pragma unroll
        for (int a = 0; a < 2; ++a)
#pragma unroll
            for (int b = 0; b < 2; ++b)
#pragma unroll
                for (int m = 0; m < 4; ++m)
#pragma unroll
                    for (int n = 0; n < 2; ++n) acc[a][b][m][n] = (f32x4){0.f, 0.f, 0.f, 0.f};
        cur = nxt; cvo[0][0] = nvo[0][0]; cvo[0][1] = nvo[0][1]; cvo[1][0] = nvo[1][0]; cvo[1][1] = nvo[1][1]; cB = nB; ++ui;
        if constexpr (ALIGN_EPI) { if (wr == 1) PG8_BAR; }
    }
    PG8_WAIT_V(0);
    if constexpr (!ALIGN_EPI) { if (wr == 0) PG8_BAR; }
    PG8_BAR;
    if constexpr (Epi::AFTER_DRAIN) { E.fused(acc, cur, wr, wc, fr, fq, lds, wid, lane); S.done(cur); }
#undef PG8_SA
#undef PG8_SB
#undef PG8_STAGE
#undef PG8_STAGEA
#undef PG8_SETVO
#undef PG8_LDA
#undef PG8_LDB
#undef PG8_MMA
#undef PG8_CAT8
#undef PG8_WAIT_V
#undef PG8_WAIT_L
#undef PG8_BAR
#undef PG8_SCHED
}
}
#ifndef FP8_SP2
#define FP8_SP2 true
#endif
#ifndef ATTNA_FP8
#define ATTNA_FP8 1
#endif
namespace fg {
using pg8::f32x4; using pg8::Unit;
typedef unsigned u32x4 __attribute__((ext_vector_type(4)));
typedef unsigned u32x2 __attribute__((ext_vector_type(2)));
DEVI unsigned cvtpk(float lo, float hi) { typedef float f2_t __attribute__((ext_vector_type(2))); typedef __bf16 b2_t __attribute__((ext_vector_type(2))); const f2_t v = {lo, hi}; const b2_t b = __builtin_convertvector(v, b2_t); return __builtin_bit_cast(unsigned, b); }
template <class TP> DEVI void rope8(TP ROPE, int t, int d0, f32x4& v0, f32x4& v1) {
  const int i0 = d0 >> 1, f0 = i0 & 15, pos = (i0 < 16) ? (t >> 6) : (t & 63);
  const f32x4 r0 = *(const PG8_LAS f32x4*)(ROPE + (pos * 16 + f0) * 2), r1 = *(const PG8_LAS f32x4*)(ROPE + (pos * 16 + f0) * 2 + 4);
  const f32x4 a = v0, b = v1;
  v0[0] = a[0] * r0[0] - a[1] * r0[1]; v0[1] = a[0] * r0[1] + a[1] * r0[0]; v0[2] = a[2] * r0[2] - a[3] * r0[3]; v0[3] = a[2] * r0[3] + a[3] * r0[2];
  v1[0] = b[0] * r1[0] - b[1] * r1[1]; v1[1] = b[0] * r1[1] + b[1] * r1[0]; v1[2] = b[2] * r1[2] - b[3] * r1[3]; v1[3] = b[2] * r1[3] + b[3] * r1[2];
}
#define EPI_LOOP_BEGIN const int row0 = u.pm * 256 + wr * 64 + fr; \
  _Pragma("unroll") for (int ai = 0; ai < 2; ++ai) _Pragma("unroll") for (int m = 0; m < 4; ++m) { const int row = row0 + ai * 128 + m * 16; \
  _Pragma("unroll") for (int bj = 0; bj < 2; ++bj) { f32x4 v0 = acc[ai][bj][m][0], v1 = acc[ai][bj][m][1]; const int cl = bj * 128 + wc * 32 + 8 * fq;
#define EPI_LOOP_END } }

struct EpiQKV0 { static constexpr bool PERM = true, AFTER_DRAIN = false; bf16_t* O; const PG8_LAS float* ROPE; unsigned char* VT; unsigned char* VTB;
  DEVI void operator()(const f32x4 (&acc)[2][2][4][2], const Unit& u, int wr, int wc, int fr, int fq) const {
    const int colt = u.pn * 256; const bool rope = (u.pm < NLAT / 256) && (colt < 1024);
    EPI_LOOP_BEGIN
      const int col = colt + cl;
      if (ATTNA_FP8 && colt >= 1024 && colt < 1536) {
        const int hh = (col - 1024) >> 7, dv0 = (col - 1024) & 127;
        int bb, t; if (row < NLAT) { bb = row >> 12; t = row & 4095; } else { bb = (row - NLAT) >> 8; t = 4096 + ((row - NLAT) & 255); }
        const int k = t & 31, gq = k >> 3, wq = k & 7, pos = (wq < 4) ? gq * 4 + wq : 16 + gq * 4 + (wq - 4);
        unsigned char* vp = VT + (size_t)((bb * 4 + hh) * 128 + dv0) * 4352 + (t & ~31) + pos;
        const unsigned w0 = nv::pack4_fp8(v0[0] * 4.f, v0[1] * 4.f, v0[2] * 4.f, v0[3] * 4.f), w1 = nv::pack4_fp8(v1[0] * 4.f, v1[1] * 4.f, v1[2] * 4.f, v1[3] * 4.f);
        vp[0 * 4352] = (unsigned char)w0; vp[1 * 4352] = (unsigned char)(w0 >> 8); vp[2 * 4352] = (unsigned char)(w0 >> 16); vp[3 * 4352] = (unsigned char)(w0 >> 24);
        vp[4 * 4352] = (unsigned char)w1; vp[5 * 4352] = (unsigned char)(w1 >> 8); vp[6 * 4352] = (unsigned char)(w1 >> 16); vp[7 * 4352] = (unsigned char)(w1 >> 24);
        continue;
      }
      if (ATTNA_FP8 && colt >= 2560) {
        const int hh = (col - 2560) >> 6, dv0 = (col - 2560) & 63;
        int bb, t; if (row < NLAT) { bb = row >> 12; t = row & 4095; } else { bb = (row - NLAT) >> 8; t = 4096 + ((row - NLAT) & 255); }
        const int k = t & 31, gq = k >> 3, wq = k & 7, pos = (wq < 4) ? gq * 4 + wq : 16 + gq * 4 + (wq - 4);
        unsigned char* vp = VTB + (size_t)((bb * 8 + hh) * 64 + dv0) * 4352 + (t & ~31) + pos;
        const unsigned w0 = nv::pack4_fp8(v0[0] * 4.f, v0[1] * 4.f, v0[2] * 4.f, v0[3] * 4.f), w1 = nv::pack4_fp8(v1[0] * 4.f, v1[1] * 4.f, v1[2] * 4.f, v1[3] * 4.f);
        vp[0 * 4352] = (unsigned char)w0; vp[1 * 4352] = (unsigned char)(w0 >> 8); vp[2 * 4352] = (unsigned char)(w0 >> 16); vp[3 * 4352] = (unsigned char)(w0 >> 24);
        vp[4 * 4352] = (unsigned char)w1; vp[5 * 4352] = (unsigned char)(w1 >> 8); vp[6 * 4352] = (unsigned char)(w1 >> 16); vp[7 * 4352] = (unsigned char)(w1 >> 24);
        continue;
      }
      if (rope) rope8(ROPE, row & 4095, col & 63, v0, v1);
      if (ATTNA_FP8 && (colt < 1024 || colt >= 1536)) {
        const float sc = (colt < 512 || (colt >= 1536 && colt < 2048)) ? 16.f * 0.125f * 1.4426950408889634f : 4.f;
        u32x2 w8; w8.x = nv::pack4_fp8(v0[0] * sc, v0[1] * sc, v0[2] * sc, v0[3] * sc); w8.y = nv::pack4_fp8(v1[0] * sc, v1[1] * sc, v1[2] * sc, v1[3] * sc);
        *(u32x2*)((unsigned char*)O + (size_t)row * (N_IN0 * 2) + col) = w8;
        continue;
      }
      u32x4 w; w.x = cvtpk(v0[0], v0[1]); w.y = cvtpk(v0[2], v0[3]); w.z = cvtpk(v1[0], v1[1]); w.w = cvtpk(v1[2], v1[3]);
      *(u32x4*)(O + (size_t)row * N_IN0 + col) = w;
    EPI_LOOP_END
  } };
struct EpiQKV1 { static constexpr bool PERM = true, AFTER_DRAIN = false; bf16_t* O; float* DT; const PG8_LAS float* ROPE;
  DEVI void operator()(const f32x4 (&acc)[2][2][4][2], const Unit& u, int wr, int wc, int fr, int fq) const {
    const int colt = u.pn * 256; const bool lat = (u.pm < NLAT / 256);
    EPI_LOOP_BEGIN
      const int col = colt + cl;
      if (col >= 2304) { if (col < 2320) { *(f32x4*)(DT + (size_t)row * 16 + (col - 2304)) = v0; *(f32x4*)(DT + (size_t)row * 16 + (col - 2304) + 4) = v1; } }
      else {
        if (lat && col < 640) rope8(ROPE, row & 4095, col & 63, v0, v1);
        u32x4 w; w.x = cvtpk(v0[0], v0[1]); w.y = cvtpk(v0[2], v0[3]); w.z = cvtpk(v1[0], v1[1]); w.w = cvtpk(v1[2], v1[3]);
        *(u32x4*)(O + (size_t)row * 2304 + col) = w;
      }
    EPI_LOOP_END
  } };
struct EpiPlain { static constexpr bool PERM = true, AFTER_DRAIN = false; bf16_t* O;
  DEVI void operator()(const f32x4 (&acc)[2][2][4][2], const Unit& u, int wr, int wc, int fr, int fq) const {
    const int colt = u.pn * 256;
    EPI_LOOP_BEGIN
      u32x4 w; w.x = cvtpk(v0[0], v0[1]); w.y = cvtpk(v0[2], v0[3]); w.z = cvtpk(v1[0], v1[1]); w.w = cvtpk(v1[2], v1[3]);
      *(u32x4*)(O + (size_t)row * DM + colt + cl) = w;
    EPI_LOOP_END
  } };
DEVI float silu_fast(float v) { return v * __builtin_amdgcn_rcpf(1.f + __expf(-v)); }
struct EpiSwiGLU { static constexpr bool PERM = true, AFTER_DRAIN = false; bf16_t* O;
  DEVI void operator()(const f32x4 (&acc)[2][2][4][2], const Unit& u, int wr, int wc, int fr, int fq) const {
    const int colt = (u.pn & 7) * 256;
    EPI_LOOP_BEGIN
      u32x2 w; w.x = cvtpk(silu_fast(v0[0]) * v0[1], silu_fast(v0[2]) * v0[3]); w.y = cvtpk(silu_fast(v1[0]) * v1[1], silu_fast(v1[2]) * v1[3]);
      *(u32x2*)(O + (size_t)row * DM + ((colt + cl) >> 1)) = w;
    EPI_LOOP_END
  } };
struct EpiSwiGLU8 { static constexpr bool PERM = true, AFTER_DRAIN = false; unsigned char* O;
  DEVI void operator()(const f32x4 (&acc)[2][2][4][2], const Unit& u, int wr, int wc, int fr, int fq) const {
    const int colt = (u.pn & 7) * 256;
    EPI_LOOP_BEGIN
      const unsigned w = nv::pack4_fp8(silu_fast(v0[0]) * v0[1] * nv::A8_SCALE, silu_fast(v0[2]) * v0[3] * nv::A8_SCALE, silu_fast(v1[0]) * v1[1] * nv::A8_SCALE, silu_fast(v1[2]) * v1[3] * nv::A8_SCALE);
      *(unsigned*)(O + (size_t)row * DM + ((colt + cl) >> 1)) = w;
    EPI_LOOP_END
  } };
struct EpiDown { static constexpr bool PERM = true, AFTER_DRAIN = false; bf16_t* O;
  DEVI void operator()(const f32x4 (&acc)[2][2][4][2], const Unit& u, int wr, int wc, int fr, int fq) const {
    const int colt = (u.pn & 3) * 256;
    EPI_LOOP_BEGIN
      u32x4 w; w.x = cvtpk(v0[0], v0[1]); w.y = cvtpk(v0[2], v0[3]); w.z = cvtpk(v1[0], v1[1]); w.w = cvtpk(v1[2], v1[3]);
      *(u32x4*)(O + (size_t)row * DM + colt + cl) = w;
    EPI_LOOP_END
  } };
struct ExpOrder : pg8::StaticOrder { int nMe, nNe;
  __device__ void init2(int erows, int Ne, int G_, int c_) { nMe = erows / 256; nNe = Ne / 256; init(NE * erows, Ne, G_, c_); }
  __device__ bool next(int i, Unit& u) const { if (!pg8::StaticOrder::next(i, u)) return false; u.pn += (u.pm / nMe) * nNe; return true; } };

typedef PG8_LAS unsigned char* ldsp_t;
DEVI void phase_qkv0(const Params& p, ldsp_t lds) {
  pg8::Gemm g{(const bf16_t*)(p.ws + WS_H), (const bf16_t*)(p.ws + WS_WIN0), NROW, N_IN0, DM, nullptr, nv::W8_E8M0, nv::A8_E8M0}; pg8::StaticOrder S; S.init(NROW, N_IN0, gridDim.x, blockIdx.x);
  PG8_LAS float* RL = (PG8_LAS float*)(lds + pg8::STAGE_BYTES);
  for (int i = ftid(); i < 64 * 16 * 2; i += NT) RL[i] = ((const float*)(p.ws + WS_CTL + CTL_ROPE))[i];
  __syncthreads();
  EpiQKV0 E{(bf16_t*)(p.ws + WS_QKV0), RL, (unsigned char*)(p.ws + WS_VT), (unsigned char*)(p.ws + WS_VTB)};
  pg8::gemm_phase<EpiQKV0, pg8::StaticOrder, true, true, (QKV0_FP8 != 0)>(lds, g, S, E);
}
DEVI void phase_qkv1(const Params& p, ldsp_t lds) {
  pg8::Gemm g{(const bf16_t*)(p.ws + WS_H), (const bf16_t*)(p.ws + WS_WIN1), NROW, N_IN1P, DM, nullptr, nv::W8_E8M0, nv::A8_E8M0}; pg8::StaticOrder S; S.init(NROW, N_IN1P, gridDim.x, blockIdx.x);
  PG8_LAS float* RL = (PG8_LAS float*)(lds + pg8::STAGE_BYTES);
  for (int i = ftid(); i < 64 * 16 * 2; i += NT) RL[i] = ((const float*)(p.ws + WS_CTL + CTL_ROPE))[i];
  __syncthreads();
  EpiQKV1 E{(bf16_t*)(p.ws + WS_P1), (float*)(p.ws + WS_DT), RL};
  pg8::gemm_phase<EpiQKV1, pg8::StaticOrder, true, true, (QKV1_FP8 != 0)>(lds, g, S, E);
}
DEVI void phase_outproj(const Params& p, ldsp_t lds, int layer) {
  const int M = layer ? NLAT : NROW;
  pg8::Gemm g{(const bf16_t*)(p.ws + (layer ? WS_ATT1 : WS_ATT0)), (const bf16_t*)(p.ws + (layer ? WS_WOUT1 : WS_WOUT0)), M, DM, DM, nullptr, nv::W8_E8M0, nv::A8_E8M0}; pg8::StaticOrder S; S.init(M, DM, gridDim.x, blockIdx.x);
  EpiPlain E{(bf16_t*)(p.ws + (layer ? WS_MIX1 : WS_MIX0))};
  pg8::gemm_phase<EpiPlain, pg8::StaticOrder, true, true, (OUT_FP8 != 0)>(lds, g, S, E);
}
DEVI void phase_moe_up(const Params& p, ldsp_t lds, int layer) {
  const int erows = layer ? EROWS1 : EROWS0;
  pg8::Gemm g{(const bf16_t*)(p.ws + WS_H), (const bf16_t*)(p.ws + WS_WGU), NE * erows, 2048, DM, (const int*)(p.ws + WS_IDX)}; ExpOrder S; S.init2(erows, 2048, gridDim.x, blockIdx.x);
  EpiSwiGLU E{(bf16_t*)(p.ws + WS_HID)};
  pg8::gemm_phase<EpiSwiGLU, ExpOrder, true, true>(lds, g, S, E);
}
DEVI void phase_moe_down(const Params& p, ldsp_t lds, int layer) {
  const int erows = layer ? EROWS1 : EROWS0;
  pg8::Gemm g{(const bf16_t*)(p.ws + WS_HID), (const bf16_t*)(p.ws + WS_WD), NE * erows, DM, DM}; ExpOrder S; S.init2(erows, DM, gridDim.x, blockIdx.x);
  EpiDown E{(bf16_t*)(p.ws + WS_Y)};
  pg8::gemm_phase<EpiDown, ExpOrder, true, true>(lds, g, S, E);
}
DEVI void phase_moe_up8(const Params& p, ldsp_t lds, int layer) {
  const int erows = layer ? EROWS1 : EROWS0;
  pg8::Gemm g{(const bf16_t*)(p.ws + WS_H), (const bf16_t*)(p.ws + WS_WGU), NE * erows, 2048, DM, (const int*)(p.ws + WS_IDX), nv::W8_E8M0, nv::A8_E8M0}; ExpOrder S; S.init2(erows, 2048, gridDim.x, blockIdx.x);
  EpiSwiGLU8 E{(unsigned char*)(p.ws + WS_HID)};
  pg8::gemm_phase<EpiSwiGLU8, ExpOrder, true, FP8_SP2, true>(lds, g, S, E);
}
DEVI void phase_moe_down8(const Params& p, ldsp_t lds, int layer) {
  const int erows = layer ? EROWS1 : EROWS0;
  pg8::Gemm g{(const bf16_t*)(p.ws + WS_HID), (const bf16_t*)(p.ws + WS_WD), NE * erows, DM, DM, nullptr, nv::W8_E8M0, nv::A8_E8M0}; ExpOrder S; S.init2(erows, DM, gridDim.x, blockIdx.x);
  EpiDown E{(bf16_t*)(p.ws + WS_Y)};
  pg8::gemm_phase<EpiDown, ExpOrder, true, FP8_SP2, true>(lds, g, S, E);
}
DEVI void phase_gather(const Params& p, int layer) {
  const int lane = ftid() & 63, gw = blockIdx.x * NWAVE + (ftid() >> 6), NGW = gridDim.x * NWAVE;
  const int erows = layer ? EROWS1 : EROWS0; const int* IDX = (const int*)(p.ws + WS_IDX);
  const bf16_t* H = (const bf16_t*)(p.ws + WS_H); bf16_t* XG = (bf16_t*)(p.ws + WS_XG);
  for (int r = gw; r < NE * erows; r += NGW) {
    const uint4* s = (const uint4*)(H + (size_t)IDX[r] * DM) + lane; uint4* d = (uint4*)(XG + (size_t)r * DM) + lane;
    const uint4 a = s[0], b = s[64]; d[0] = a; d[64] = b;
  }
}
}
#ifndef ATTNA_FP8
#define ATTNA_FP8 1
#endif
namespace fa {
#define FA_LAS __attribute__((address_space(3)))
typedef short bf16x8 __attribute__((ext_vector_type(8)));
typedef short s16x4 __attribute__((ext_vector_type(4)));
typedef float f32x16 __attribute__((ext_vector_type(16)));
typedef FA_LAS unsigned char* ldsp_t;
typedef unsigned u32x4 __attribute__((ext_vector_type(4)));
constexpr float LOG2E = 1.4426950408889634f, C2 = 0.125f * LOG2E;
DEVI int crow(int r, int hi) { return (r & 3) + 8 * (r >> 2) + 4 * hi; }
DEVI unsigned cvtpk(float lo, float hi) { typedef float f2_t __attribute__((ext_vector_type(2))); typedef __bf16 b2_t __attribute__((ext_vector_type(2))); const f2_t v = {lo, hi}; const b2_t b = __builtin_convertvector(v, b2_t); return __builtin_bit_cast(unsigned, b); }
DEVI s16x4 vtr(ldsp_t p) { return __builtin_bit_cast(s16x4, __builtin_amdgcn_ds_read_tr16_b64_v4i16((FA_LAS s16x4*)p)); }

DEVI float max3f(float a, float b, float c) { float r; asm("v_max3_f32 %0, %1, %2, %3" : "=v"(r) : "v"(a), "v"(b), "v"(c)); return r; }
template <int KW, int DVB> struct Geo {
  static constexpr int VW = DVB * 32;
  static constexpr int KSTR = KW * 2 + 16, VSTR = VW * 2 + 64;
  static constexpr int KBYTES = 64 * KSTR, VBYTES = 64 * VSTR, STAGE = KBYTES + VBYTES;
  static constexpr int CPR = (KW + VW) / 8, NCH = 64 * CPR / NT;
};

DEVI bf16x8 load_q8(const bf16_t* p, float sc) {
  const uint4 w = *(const uint4*)p; const unsigned u[4] = {w.x, w.y, w.z, w.w}; unsigned o[4];
#pragma unroll
  for (int i = 0; i < 4; ++i) o[i] = cvtpk(__uint_as_float(u[i] << 16) * sc, __uint_as_float(u[i] & 0xffff0000u) * sc);
  uint4 r = make_uint4(o[0], o[1], o[2], o[3]); return __builtin_bit_cast(bf16x8, r);
}

template <int KW, int DVB, class Src, class Act, class Msk>
DEVI void flash_pass(ldsp_t lds, int ntiles, const bf16_t* kv, int ld, int kcol, int vcol, const bf16x8 (&q)[4], int kofs,
                     Src src, Act act, Msk msk, f32x16 (&o)[DVB], float& m, float& l) {
  typedef Geo<KW, DVB> G;
  const int tid = ftid(), lane = tid & 63, r32 = lane & 31, hi = lane >> 5;
  u32x4 stg[G::NCH];
  int crw[G::NCH], ccol[G::NCH], cdst[G::NCH];
#pragma unroll
  for (int i = 0; i < G::NCH; ++i) { const int c = tid + NT * i, row = c / G::CPR, cc = c % G::CPR; crw[i] = row;
    if (cc < KW / 8) { ccol[i] = kcol + cc * 8; cdst[i] = row * G::KSTR + cc * 16; } else { ccol[i] = vcol + (cc - KW / 8) * 8; cdst[i] = G::KBYTES + row * G::VSTR + (cc - KW / 8) * 16; } }
#pragma unroll
  for (int i = 0; i < G::NCH; ++i) stg[i] = *(const u32x4*)(kv + (size_t)src(0, crw[i]) * ld + ccol[i]);
#pragma unroll
  for (int i = 0; i < G::NCH; ++i) *(FA_LAS u32x4*)(lds + cdst[i]) = stg[i];
  __syncthreads();
  const int kroff = r32 * G::KSTR + (kofs + 8 * hi) * 2;
  const int vroff = G::KBYTES + (4 * hi + ((lane & 15) >> 2)) * G::VSTR + 32 * ((lane >> 4) & 1) + 8 * (lane & 3);
  for (int kt = 0; kt < ntiles; ++kt) {
    const int buf = (kt & 1) * G::STAGE;
    const bool more = kt + 1 < ntiles;
    if (more) {
#pragma unroll
      for (int i = 0; i < G::NCH; ++i) stg[i] = *(const u32x4*)(kv + (size_t)src(kt + 1, crw[i]) * ld + ccol[i]);
    }
    if (act(kt)) {
      const ldsp_t kb = lds + buf + kroff;
      f32x16 p0, p1;
#pragma unroll
      for (int r = 0; r < 16; ++r) { p0[r] = 0.f; p1[r] = 0.f; }
#pragma unroll
      for (int d0 = 0; d0 < 4; ++d0) {
        const bf16x8 a0 = *(const FA_LAS bf16x8*)(kb + d0 * 32), a1 = *(const FA_LAS bf16x8*)(kb + 32 * G::KSTR + d0 * 32);
        p0 = __builtin_amdgcn_mfma_f32_32x32x16_bf16(a0, q[d0], p0, 0, 0, 0);
        p1 = __builtin_amdgcn_mfma_f32_32x32x16_bf16(a1, q[d0], p1, 0, 0, 0);
      }
      msk(kt, p0, p1);
      float mx = fmaxf(p0[0], p1[0]);
#pragma unroll
      for (int r = 1; r < 16; ++r) mx = fmaxf(mx, fmaxf(p0[r], p1[r]));
      mx = fmaxf(mx, __shfl_xor(mx, 32));
      if (__any(mx > m)) {
        const float mn = fmaxf(m, mx), alpha = __builtin_amdgcn_exp2f(m - mn);
        l *= alpha; m = mn;
#pragma unroll
        for (int b = 0; b < DVB; ++b)
#pragma unroll
          for (int r = 0; r < 16; ++r) o[b][r] *= alpha;
      }
      float ls = 0.f;
#pragma unroll
      for (int r = 0; r < 16; ++r) { p0[r] = __builtin_amdgcn_exp2f(p0[r] - m); p1[r] = __builtin_amdgcn_exp2f(p1[r] - m); ls += p0[r] + p1[r]; }
      l += ls;
      bf16x8 pa[4];
      { uint4 t;
        t = make_uint4(cvtpk(p0[0], p0[1]), cvtpk(p0[2], p0[3]), cvtpk(p0[4], p0[5]), cvtpk(p0[6], p0[7])); pa[0] = __builtin_bit_cast(bf16x8, t);
        t = make_uint4(cvtpk(p0[8], p0[9]), cvtpk(p0[10], p0[11]), cvtpk(p0[12], p0[13]), cvtpk(p0[14], p0[15])); pa[1] = __builtin_bit_cast(bf16x8, t);
        t = make_uint4(cvtpk(p1[0], p1[1]), cvtpk(p1[2], p1[3]), cvtpk(p1[4], p1[5]), cvtpk(p1[6], p1[7])); pa[2] = __builtin_bit_cast(bf16x8, t);
        t = make_uint4(cvtpk(p1[8], p1[9]), cvtpk(p1[10], p1[11]), cvtpk(p1[12], p1[13]), cvtpk(p1[14], p1[15])); pa[3] = __builtin_bit_cast(bf16x8, t); }
      const ldsp_t vb = lds + buf + vroff;
#pragma unroll
      for (int b = 0; b < DVB; ++b)
#pragma unroll
        for (int ks = 0; ks < 4; ++ks) {
          const s16x4 lo = vtr(vb + (16 * ks) * G::VSTR + b * 64), h8 = vtr(vb + (16 * ks + 8) * G::VSTR + b * 64);
          const bf16x8 vf = {lo[0], lo[1], lo[2], lo[3], h8[0], h8[1], h8[2], h8[3]};
          o[b] = __builtin_amdgcn_mfma_f32_32x32x16_bf16(vf, pa[ks], o[b], 0, 0, 0);
        }
    }
    if (more) {
      const int nb = ((kt + 1) & 1) * G::STAGE;
#pragma unroll
      for (int i = 0; i < G::NCH; ++i) *(FA_LAS u32x4*)(lds + nb + cdst[i]) = stg[i];
    }
    __syncthreads();
  }
}


template <int V> struct IC { static constexpr int value = V; };
template <int KW, int DVB, int ABL, int PF, class Src, class Msk>
DEVI void flash_pass2(ldsp_t lds, int ntiles, const bf16_t* kv, int ld, int kcol, int vcol, const bf16x8 (&q)[4], int kofs,
                      Src src, Msk msk, f32x16 (&o)[DVB], float& m, float& l) {
  typedef Geo<KW, DVB> G;
  const int tid = ftid(), lane = tid & 63, r32 = lane & 31, hi = lane >> 5;
  u32x4 stg[PF][G::NCH];
  int crw[G::NCH], ccol[G::NCH], cdst[G::NCH];
#pragma unroll
  for (int i = 0; i < G::NCH; ++i) { const int c = tid + NT * i, row = c / G::CPR, cc = c % G::CPR; crw[i] = row;
    if (cc < KW / 8) { ccol[i] = kcol + cc * 8; cdst[i] = row * G::KSTR + cc * 16; } else { ccol[i] = vcol + (cc - KW / 8) * 8; cdst[i] = G::KBYTES + row * G::VSTR + (cc - KW / 8) * 16; } }
#define FP2_LOAD(kt, set) _Pragma("unroll") for (int i = 0; i < G::NCH; ++i) stg[set][i] = *(const u32x4*)(kv + (size_t)src((kt), crw[i]) * ld + ccol[i])
#define FP2_STORE(st, set) _Pragma("unroll") for (int i = 0; i < G::NCH; ++i) *(FA_LAS u32x4*)(lds + (st) * G::STAGE + cdst[i]) = stg[set][i]
  FP2_LOAD(0, 0); FP2_STORE(0, 0);
  if (ntiles > 1) { FP2_LOAD(1, 0); FP2_STORE(1, 0); }
  __syncthreads();
  if (ntiles > 2) FP2_LOAD(2, 0);
  if (PF == 2) { if (ntiles > 3) FP2_LOAD(3, PF - 1); }
  const int kroff = r32 * G::KSTR + (kofs + 8 * hi) * 2;
  const int vroff = G::KBYTES + (4 * hi + ((lane & 15) >> 2)) * G::VSTR + 32 * ((lane >> 4) & 1) + 8 * (lane & 3);
  f32x16 c0, c1;
#pragma unroll
  for (int r = 0; r < 16; ++r) { c0[r] = 0.f; c1[r] = 0.f; }
  { const ldsp_t kb = lds + kroff;
#pragma unroll
    for (int d0 = 0; d0 < 4; ++d0) {
      const bf16x8 a0 = *(const FA_LAS bf16x8*)(kb + d0 * 32), a1 = *(const FA_LAS bf16x8*)(kb + 32 * G::KSTR + d0 * 32);
      c0 = __builtin_amdgcn_mfma_f32_32x32x16_bf16(a0, q[d0], c0, 0, 0, 0); c1 = __builtin_amdgcn_mfma_f32_32x32x16_bf16(a1, q[d0], c1, 0, 0, 0); } }
  asm volatile("s_nop 15\n\ts_nop 7" : "+v"(c0), "+v"(c1));
  int st_cur = 0, st_nxt = 1, st_fill = 2;
  auto body = [&](int kt, auto PARC) {
    constexpr int set = (PF == 2) ? decltype(PARC)::value : 0;
    msk(kt, c0, c1);
    __builtin_amdgcn_sched_barrier(0);
    f32x16 n0, n1;
#pragma unroll
    for (int r = 0; r < 16; ++r) { n0[r] = 0.f; n1[r] = 0.f; }
    const ldsp_t kb = lds + st_nxt * G::STAGE + kroff;
    bf16x8 ka[4], kb2[4];
#pragma unroll
    for (int d0 = 0; d0 < 4; ++d0) { ka[d0] = *(const FA_LAS bf16x8*)(kb + d0 * 32); kb2[d0] = *(const FA_LAS bf16x8*)(kb + 32 * G::KSTR + d0 * 32); }
#define FP2_SB() __builtin_amdgcn_sched_barrier(0)
#define FP2_MMA(acc, kf, d0) acc = __builtin_amdgcn_mfma_f32_32x32x16_bf16(kf[d0], q[d0], acc, 0, 0, 0)
#define FP2_EXP(cx, r) { if (ABL != 1) { cx[r] = __builtin_amdgcn_exp2f(cx[r] - mn); ls += cx[r]; } }
    FP2_SB(); FP2_MMA(n0, ka, 0);
    float mxa = max3f(c0[0], c0[1], c1[0]), mxb = max3f(c0[2], c0[3], c1[1]);
    mxa = max3f(mxa, c1[2], c1[3]);
    mxa = max3f(mxa, c0[4], c0[5]); mxb = max3f(mxb, c0[6], c0[7]); mxa = max3f(mxa, c1[4], c1[5]); mxb = max3f(mxb, c1[6], c1[7]);
    FP2_SB(); FP2_MMA(n1, kb2, 0);
    mxa = max3f(mxa, c0[8], c0[9]); mxb = max3f(mxb, c0[10], c0[11]); mxa = max3f(mxa, c1[8], c1[9]); mxb = max3f(mxb, c1[10], c1[11]);
    mxa = max3f(mxa, c0[12], c0[13]); mxb = max3f(mxb, c0[14], c0[15]); mxa = max3f(mxa, c1[12], c1[13]); mxb = max3f(mxb, c1[14], c1[15]);
    float mx = max3f(mxa, mxb, m);
    mx = max3f(mx, __shfl_xor(mx, 32), mx);
    const float mn = mx, alpha = __builtin_amdgcn_exp2f(m - mn);
    const bool resc = __any(mn > m);
    m = mn;
    float ls = 0.f;
    FP2_SB(); FP2_MMA(n0, ka, 1);
    FP2_EXP(c0, 0) FP2_EXP(c0, 1) FP2_EXP(c0, 2) FP2_EXP(c0, 3) FP2_EXP(c0, 4) FP2_EXP(c0, 5)
    FP2_SB(); FP2_MMA(n1, kb2, 1);
    FP2_EXP(c0, 6) FP2_EXP(c0, 7) FP2_EXP(c0, 8) FP2_EXP(c0, 9) FP2_EXP(c0, 10) FP2_EXP(c0, 11)
    FP2_SB(); FP2_MMA(n0, ka, 2);
    FP2_EXP(c0, 12) FP2_EXP(c0, 13) FP2_EXP(c0, 14) FP2_EXP(c0, 15) FP2_EXP(c1, 0) FP2_EXP(c1, 1)
    FP2_SB(); FP2_MMA(n1, kb2, 2);
    FP2_EXP(c1, 2) FP2_EXP(c1, 3) FP2_EXP(c1, 4) FP2_EXP(c1, 5) FP2_EXP(c1, 6) FP2_EXP(c1, 7)
    FP2_SB(); FP2_MMA(n0, ka, 3);
    FP2_EXP(c1, 8) FP2_EXP(c1, 9) FP2_EXP(c1, 10) FP2_EXP(c1, 11) FP2_EXP(c1, 12) FP2_EXP(c1, 13)
    FP2_SB(); FP2_MMA(n1, kb2, 3);
    FP2_EXP(c1, 14) FP2_EXP(c1, 15)
    bf16x8 pa[4];
    { u32x4 t;
      t[0] = cvtpk(c0[0], c0[1]); t[1] = cvtpk(c0[2], c0[3]); t[2] = cvtpk(c0[4], c0[5]); t[3] = cvtpk(c0[6], c0[7]); pa[0] = __builtin_bit_cast(bf16x8, t);
      t[0] = cvtpk(c0[8], c0[9]); t[1] = cvtpk(c0[10], c0[11]); t[2] = cvtpk(c0[12], c0[13]); t[3] = cvtpk(c0[14], c0[15]); pa[1] = __builtin_bit_cast(bf16x8, t);
      t[0] = cvtpk(c1[0], c1[1]); t[1] = cvtpk(c1[2], c1[3]); t[2] = cvtpk(c1[4], c1[5]); t[3] = cvtpk(c1[6], c1[7]); pa[2] = __builtin_bit_cast(bf16x8, t);
      t[0] = cvtpk(c1[8], c1[9]); t[1] = cvtpk(c1[10], c1[11]); t[2] = cvtpk(c1[12], c1[13]); t[3] = cvtpk(c1[14], c1[15]); pa[3] = __builtin_bit_cast(bf16x8, t); }
    asm volatile("" : "+v"(pa[0]), "+v"(pa[1]), "+v"(pa[2]), "+v"(pa[3]));
    FP2_SB();
    l = l * alpha + ls;
    __builtin_amdgcn_sched_barrier(0);
    if (resc) {
#pragma unroll
      for (int b = 0; b < DVB; ++b)
#pragma unroll
        for (int r = 0; r < 16; ++r) o[b][r] *= alpha;
    }
    const ldsp_t vb = lds + st_cur * G::STAGE + vroff;
    s16x4 vl[2][DVB], vh[2][DVB];
#pragma unroll
    for (int b = 0; b < DVB; ++b) { vl[0][b] = vtr(vb + b * 64); vh[0][b] = vtr(vb + 8 * G::VSTR + b * 64); }
#pragma unroll
    for (int ks = 0; ks < 4; ++ks) {
      FP2_SB();
      if (ks < 3) {
#pragma unroll
        for (int b = 0; b < DVB; ++b) { vl[(ks + 1) & 1][b] = vtr(vb + (16 * (ks + 1)) * G::VSTR + b * 64); vh[(ks + 1) & 1][b] = vtr(vb + (16 * (ks + 1) + 8) * G::VSTR + b * 64); }
      }
      FP2_SB();
#pragma unroll
      for (int b = 0; b < DVB; ++b) {
        const s16x4 lo = vl[ks & 1][b], h8 = vh[ks & 1][b];
        const bf16x8 vf = {lo[0], lo[1], lo[2], lo[3], h8[0], h8[1], h8[2], h8[3]};
        if (ABL != 2) o[b] = __builtin_amdgcn_mfma_f32_32x32x16_bf16(vf, pa[ks], o[b], 0, 0, 0); else o[b][0] += __builtin_bit_cast(float, (int)vf[0]);
      }
    }
    FP2_SB();
    if (ABL != 3) { if (kt + 2 < ntiles) FP2_STORE(st_fill, set); }
    __syncthreads();
    if (ABL != 3) { if (kt + 2 + PF < ntiles) FP2_LOAD(kt + 2 + PF, set); }
    c0 = n0; c1 = n1;
    { const int t = st_cur; st_cur = st_nxt; st_nxt = st_fill; st_fill = t; }
  };
  if (PF == 2) { for (int kt = 0; kt < ntiles; kt += 2) { body(kt, IC<0>{}); if (kt + 1 < ntiles) body(kt + 1, IC<1>{}); } }
  else { for (int kt = 0; kt < ntiles; ++kt) body(kt, IC<0>{}); }
#undef FP2_LOAD
#undef FP2_STORE
}


typedef int v8i_t __attribute__((ext_vector_type(8)));
DEVI v8i_t cat8(const u32x4& x, const u32x4& y) { return (v8i_t){(int)x[0], (int)x[1], (int)x[2], (int)x[3], (int)y[0], (int)y[1], (int)y[2], (int)y[3]}; }
template <int DVB, int KROW, int AB8 = 0, class Src, class VKey, class Msk, class Act>
DEVI void flash_pass8(ldsp_t lds, int ntiles, const unsigned char* k8, int ldb, int kcolb, const unsigned char* vt, const v8i_t& qf, int ksub, bool late,
                      Src src, VKey vkey, Msk msk, Act act, f32x16 (&o)[DVB], float& m, float& l) {
  constexpr int A8_KSTR = KROW + 16, A8_VSTR = 80, A8_KB = 64 * A8_KSTR, A8_STAGE = A8_KB + DVB * 32 * A8_VSTR;
  constexpr int KPR = KROW / 16, NKC = 64 * KPR, NCHT = (NKC + DVB * 32 * 4) / NT;
  const int tid = ftid(), lane = tid & 63, r32 = lane & 31, hi = lane >> 5;
  u32x4 stg[NCHT];
#define A8_ISK(i_, c_) ((NKC % NT == 0) ? ((i_) < NKC / NT) : ((c_) < NKC))
#define A8_LOAD(kt) do { const int sb_ = src((kt), 0), vk_ = vkey(kt); _Pragma("unroll") for (int i_ = 0; i_ < NCHT; ++i_) { const int c_ = tid + NT * i_; \
      if (A8_ISK(i_, c_)) stg[i_] = *(const u32x4*)(k8 + (size_t)(sb_ + c_ / KPR) * ldb + kcolb + (c_ % KPR) * 16); \
      else { const int cv_ = c_ - NKC; stg[i_] = *(const u32x4*)(vt + (size_t)(cv_ >> 2) * 4352 + vk_ + (cv_ & 3) * 16); } } } while (0)
#define A8_STORE(st) do { _Pragma("unroll") for (int i_ = 0; i_ < NCHT; ++i_) { const int c_ = tid + NT * i_; \
      if (A8_ISK(i_, c_)) *(FA_LAS u32x4*)(lds + (st) * A8_STAGE + (c_ / KPR) * A8_KSTR + (c_ % KPR) * 16) = stg[i_]; \
      else { const int cv_ = c_ - NKC; *(FA_LAS u32x4*)(lds + (st) * A8_STAGE + A8_KB + (cv_ >> 2) * A8_VSTR + (cv_ & 3) * 16) = stg[i_]; } } } while (0)
#define A8_SB() __builtin_amdgcn_sched_barrier(0)
#define A8_EXP(cx, r) { if (AB8 & 2) {} else { cx[r] = __builtin_amdgcn_exp2f(cx[r] - mn); ls += cx[r]; } }
#define A8_KREAD(st) do { const ldsp_t kp_ = lds + (st) * A8_STAGE + kroff; \
    kf[0] = *(const volatile FA_LAS u32x4*)kp_; kf[1] = *(const volatile FA_LAS u32x4*)(kp_ + 16); kf[2] = *(const volatile FA_LAS u32x4*)(kp_ + 32 * A8_KSTR); kf[3] = *(const volatile FA_LAS u32x4*)(kp_ + 32 * A8_KSTR + 16); } while (0)
#define A8_VREAD(st) do { const ldsp_t vb_ = lds + (st) * A8_STAGE + vroff; _Pragma("unroll") for (int b = 0; b < DVB; ++b) { \
    vf0[b] = *(const volatile FA_LAS u32x4*)(vb_ + b * 32 * A8_VSTR); vf1[b] = *(const volatile FA_LAS u32x4*)(vb_ + b * 32 * A8_VSTR + 16); } } while (0)
#define A8_QKM() do { f32x16 z_; _Pragma("unroll") for (int r_ = 0; r_ < 16; ++r_) z_[r_] = 0.f; \
    c0 = __builtin_amdgcn_mfma_scale_f32_32x32x64_f8f6f4(cat8(kf[0], kf[1]), qf, z_, 0, 0, 0, 0x7d7d7d7d  , 0, 0x7b7b7b7b  ); \
    c1 = __builtin_amdgcn_mfma_scale_f32_32x32x64_f8f6f4(cat8(kf[2], kf[3]), qf, z_, 0, 0, 0, 0x7d7d7d7d, 0, 0x7b7b7b7b); } while (0)
#define A8_PVM() do { _Pragma("unroll") for (int b = 0; b < DVB; ++b) if (!(AB8 & 16)) o[b] = __builtin_amdgcn_mfma_scale_f32_32x32x64_f8f6f4(cat8(vf0[b], vf1[b]), pb, o[b], 0, 0, 0, 0x7d7d7d7d  , 0, 0x7b7b7b7b  ); } while (0)
  A8_LOAD(0); A8_STORE(0);
  if (ntiles > 1) { A8_LOAD(1); A8_STORE(1); }
  __syncthreads();
  if (ntiles > 2) A8_LOAD(2);
  const int kroff = r32 * A8_KSTR + 64 * ksub + 32 * hi;
  const int vroff = A8_KB + r32 * A8_VSTR + 32 * hi;
  f32x16 c0, c1;
  u32x4 kf[4], vf0[DVB], vf1[DVB];
  v8i_t pb = {0, 0, 0, 0, 0, 0, 0, 0};
  if (act(0)) { A8_KREAD(0); A8_QKM(); }
  asm volatile("s_nop 15\n\ts_nop 7" : "+v"(c0), "+v"(c1));
  int st_cur = 0, st_nxt = 1, st_fill = 2;
  for (int kt = 0; kt < ntiles; ++kt) {
    const bool on = act(kt), on_nxt = kt + 1 < ntiles && act(kt + 1);
    if (late && kt > 0) {
      if (on) A8_QKM();
      if (act(kt - 1)) A8_PVM();
#pragma unroll
      for (int b = 0; b < DVB; ++b) asm volatile("" : "+v"(o[b]));
      asm volatile("s_nop 15\n\ts_nop 7" : "+v"(c0), "+v"(c1));
    }
    A8_SB();
    if (on) A8_VREAD(st_cur);
    if (on_nxt) A8_KREAD(st_nxt);
    A8_SB();
    if (on) {
    msk(kt, c0, c1);
    A8_SB();
    float mxa = 0.f, mxb = 0.f;
    if (!(AB8 & 2)) {
    mxa = max3f(c0[0], c0[1], c1[0]), mxb = max3f(c0[2], c0[3], c1[1]);
    mxa = max3f(mxa, c1[2], c1[3]);
    mxa = max3f(mxa, c0[4], c0[5]); mxb = max3f(mxb, c0[6], c0[7]); mxa = max3f(mxa, c1[4], c1[5]); mxb = max3f(mxb, c1[6], c1[7]);
    mxa = max3f(mxa, c0[8], c0[9]); mxb = max3f(mxb, c0[10], c0[11]); mxa = max3f(mxa, c1[8], c1[9]); mxb = max3f(mxb, c1[10], c1[11]);
    mxa = max3f(mxa, c0[12], c0[13]); mxb = max3f(mxb, c0[14], c0[15]); mxa = max3f(mxa, c1[12], c1[13]); mxb = max3f(mxb, c1[14], c1[15]);
    }
    float mx = max3f(mxa, mxb, mxb);
    { const auto sw = __builtin_amdgcn_permlane32_swap(__float_as_uint(mx), __float_as_uint(mx), false, false);
      mx = fmaxf(__uint_as_float(sw[0]), __uint_as_float(sw[1])); }
    const bool up = mx > m + 8.f;
    const float mn = up ? mx - 4.f : m, alpha = __builtin_amdgcn_exp2f(m - mn);
    const bool resc = __any(up);
    m = mn;
    float ls = 0.f;
    A8_SB();
#pragma unroll
    for (int r = 0; r < 16; ++r) A8_EXP(c0, r)
#pragma unroll
    for (int r = 0; r < 16; ++r) A8_EXP(c1, r)
    A8_SB();
    unsigned X[4], Y[4];
#pragma unroll
    for (int i = 0; i < 4; ++i) {
      int w, z; asm volatile("" : "=v"(w)); asm volatile("" : "=v"(z));
      w = __builtin_amdgcn_cvt_pk_fp8_f32(c0[4 * i], c0[4 * i + 1], w, false); w = __builtin_amdgcn_cvt_pk_fp8_f32(c0[4 * i + 2], c0[4 * i + 3], w, true); X[i] = (unsigned)w;
      z = __builtin_amdgcn_cvt_pk_fp8_f32(c1[4 * i], c1[4 * i + 1], z, false); z = __builtin_amdgcn_cvt_pk_fp8_f32(c1[4 * i + 2], c1[4 * i + 3], z, true); Y[i] = (unsigned)z; }
#pragma unroll
    for (int i = 0; i < 4; ++i) { const auto rr = __builtin_amdgcn_permlane32_swap(X[i], Y[i], false, false); X[i] = rr[0]; Y[i] = rr[1]; }
    pb = (v8i_t){(int)X[0], (int)X[1], (int)X[2], (int)X[3], (int)Y[0], (int)Y[1], (int)Y[2], (int)Y[3]};
    asm volatile("" : "+v"(pb));
    l = l * alpha + ls;
    A8_SB();
    if (resc) {
#pragma unroll
      for (int b = 0; b < DVB; ++b)
#pragma unroll
        for (int r = 0; r < 16; ++r) o[b][r] *= alpha;
    }
    }
    A8_SB();
    if (!late) {
      if (on_nxt) A8_QKM();
      if (on) A8_PVM();
#pragma unroll
      for (int b = 0; b < DVB; ++b) asm volatile("" : "+v"(o[b]));
      asm volatile("" : "+v"(c0), "+v"(c1));
    }
    A8_SB();
    if (!(AB8 & 4)) { if (kt + 2 < ntiles) A8_STORE(st_fill); }
    if (!(AB8 & 8)) __syncthreads();
    if (!(AB8 & 4)) { if (kt + 3 < ntiles) A8_LOAD(kt + 3); }
    { const int t = st_cur; st_cur = st_nxt; st_nxt = st_fill; st_fill = t; }
  }
  if (late && act(ntiles - 1)) A8_PVM();
  l *= 0.0625f;
#undef A8_ISK
#undef A8_LOAD
#undef A8_STORE
#undef A8_SB
#undef A8_EXP
#undef A8_KREAD
#undef A8_VREAD
#undef A8_QKM
#undef A8_PVM
}

#ifndef OUT_FP8
#define OUT_FP8 1
#endif
DEVI void st_att4(bf16_t* ATT, size_t row, int col, float a, float b, float c, float d) {
  if (OUT_FP8) *(unsigned*)((unsigned char*)ATT + row * DM + col) = nv::pack4_fp8(a * 4.f, b * 4.f, c * 4.f, d * 4.f);
  else { uint2 w; w.x = cvtpk(a, b); w.y = cvtpk(c, d); *(uint2*)(ATT + row * DM + col) = w; }
}
DEVI int vblock() { const int G = gridDim.x, bx = blockIdx.x; return (G % 8 == 0) ? (bx % 8) * (G / 8) + bx / 8 : bx; }

template <int ABL = 0> DEVI void phase_attnA(const Params& p, ldsp_t lds) {
  typedef Geo<128, 4> G;
  const int tid = ftid(), lane = tid & 63, wave = __builtin_amdgcn_readfirstlane(tid >> 6), r32 = lane & 31, hi = lane >> 5;
  const bf16_t* Q = (const bf16_t*)(p.ws + WS_QKV0); bf16_t* ATT = (bf16_t*)(p.ws + (ABL ? WS_MIX0 : WS_ATT0));
  const float lam = ((const float*)(p.ws + WS_CTL + CTL_LAM))[0];
  const int s = wave >> 2, qb = wave & 3;
  constexpr int NU_LAT = NB * 4 * 32, NU_CTX = NB * 4 * 2;
  for (int u = vblock(); u < NU_LAT + NU_CTX; u += gridDim.x) {
    int b, h, row0, ntiles; bool lat = u < NU_LAT;
    if (lat) { b = u >> 7; h = (u >> 5) & 3; row0 = b * SEQ + (u & 31) * 128; ntiles = 68; }
    else { const int v = u - NU_LAT; b = v >> 3; h = (v >> 1) & 3; row0 = NLAT + b * CTXL + (v & 1) * 128; ntiles = 4; }
    const int qrow = row0 + qb * 32 + r32;
    bf16x8 q[4];
#pragma unroll
    for (int d0 = 0; d0 < 4; ++d0) q[d0] = load_q8(Q + (size_t)qrow * N_IN0 + h * 128 + s * 64 + 16 * d0 + 8 * hi, C2);
    f32x16 o[4];
#pragma unroll
    for (int bk = 0; bk < 4; ++bk)
#pragma unroll
      for (int r = 0; r < 16; ++r) o[bk][r] = 0.f;
    float m = -1e30f, l = 0.f;
    const int cbase = NLAT + b * CTXL, lbase = b * SEQ;
#if ATTNA_FP8
    const unsigned char* QK8 = (const unsigned char*)(p.ws + WS_QKV0);
    v8i_t qf;
    { const unsigned char* qp = QK8 + (size_t)qrow * (N_IN0 * 2) + h * 128 + s * 64 + 32 * hi; const u32x4 q0_ = *(const u32x4*)qp, q1_ = *(const u32x4*)(qp + 16); qf = cat8(q0_, q1_); }
    flash_pass8<4, 128, ABL>(lds, ntiles, QK8, N_IN0 * 2, 512 + h * 128, (const unsigned char*)(p.ws + WS_VT) + (size_t)((b * 4 + h) * 128) * 4352, qf, s, s != 0,
      [&](int kt, int i) { return lat ? (kt < 64 ? lbase + kt * 64 + i : cbase + (kt - 64) * 64 + i) : cbase + kt * 64 + i; },
      [&](int kt) { return (lat ? 0 : 4096) + kt * 64; }, [&](int, f32x16&, f32x16&) {}, [&](int) { return true; }, o, m, l);
#else
    flash_pass2<128, 4, ABL, 1>(lds, ntiles, Q, N_IN0, 512 + h * 128, 1024 + h * 128, q, s * 64,
      [&](int kt, int i) { return lat ? (kt < 64 ? lbase + kt * 64 + i : cbase + (kt - 64) * 64 + i) : cbase + kt * 64 + i; },
      [&](int, f32x16&, f32x16&) {}, o, m, l);
#endif
    l += __shfl_xor(l, 32);
    const float inv = 1.f / l;
    FA_LAS float* X = (FA_LAS float*)lds;
    if (s == 1) {
#pragma unroll
      for (int bk = 0; bk < 4; ++bk)
#pragma unroll
        for (int r = 0; r < 16; ++r) X[((qb * 4 + bk) * 16 + r) * 64 + lane] = o[bk][r] * inv;
    }
    __syncthreads();
    if (s == 0) {
      float ss = 0.f;
#pragma unroll
      for (int bk = 0; bk < 4; ++bk)
#pragma unroll
        for (int r = 0; r < 16; ++r) { const float d = o[bk][r] * inv - lam * X[((qb * 4 + bk) * 16 + r) * 64 + lane]; o[bk][r] = d; ss += d * d; }
      ss += __shfl_xor(ss, 32);
      const float rr = rsqrtf(ss * (1.f / 128.f) + EPS) * 0.8f;
      const float* g = p.in[L0_SUBLN];
#pragma unroll
      for (int bk = 0; bk < 4; ++bk)
#pragma unroll
        for (int rg = 0; rg < 4; ++rg) { const int dv = bk * 32 + 8 * rg + 4 * hi; const float4 gv = *(const float4*)(g + dv);
          st_att4(ATT, (size_t)qrow, h * 128 + dv, o[bk][4 * rg] * rr * gv.x, o[bk][4 * rg + 1] * rr * gv.y, o[bk][4 * rg + 2] * rr * gv.z, o[bk][4 * rg + 3] * rr * gv.w); }
    }
    __syncthreads();
  }
}

template <int ABL = 0> DEVI void phase_attnB(const Params& p, ldsp_t lds) {
  typedef Geo<64, 2> G;
  const int tid = ftid(), lane = tid & 63, wave = __builtin_amdgcn_readfirstlane(tid >> 6), r32 = lane & 31, hi = lane >> 5;
  const bf16_t* Q = (const bf16_t*)(p.ws + WS_QKV0); bf16_t* ATT = (bf16_t*)(p.ws + (ABL ? WS_MIX0 : WS_ATT0));
  constexpr int NU_LAT = NB * 8 * 16, NU_CTX = NB * 8;
  FA_LAS float* RPB = (FA_LAS float*)(lds + 3 * (64 * 80 + 64 * 80));
  for (int u = vblock(); u < NU_LAT + NU_CTX; u += gridDim.x) {
    const bool lat = u < NU_LAT;
    int b, h, qrow_g = 0, c0 = 0, rlo = 0, nlat = 0, rs_w = 0, grow;
    if (lat) { b = u >> 7; h = (u >> 4) & 7; const int qr0 = (u & 15) * 4; qrow_g = qr0 + (wave >> 1); c0 = 32 * (wave & 1);
      rlo = min(max(qr0 - 4, 0), 56); const int rhi = min(max(qr0 - 1, 0), 56) + 7; nlat = rhi - rlo + 1; rs_w = min(max(qrow_g - 4, 0), 56);
      grow = b * SEQ + qrow_g * 64 + c0 + r32; }
    else { const int v = u - NU_LAT; b = v >> 3; h = v & 7; grow = NLAT + b * CTXL + wave * 32 + r32; }
    const int ntiles = nlat + 4;
    for (int i = tid; i < 15 * 31; i += NT) RPB[i] = p.in[L0_RPB][h * 465 + i] * LOG2E;
    const unsigned char* QK8 = (const unsigned char*)(p.ws + WS_QKV0);
    v8i_t qf;
    { const unsigned char* qp = QK8 + (size_t)grow * (N_IN0 * 2) + 1536 + h * 64 + 32 * hi; const u32x4 q0_ = *(const u32x4*)qp, q1_ = *(const u32x4*)(qp + 16); qf = cat8(q0_, q1_); }
    f32x16 o[2];
#pragma unroll
    for (int bk = 0; bk < 2; ++bk)
#pragma unroll
      for (int r = 0; r < 16; ++r) o[bk][r] = 0.f;
    float m = -1e30f, l = 0.f;
    const int cbase = NLAT + b * CTXL, lbase = b * SEQ;
    const int qc = c0 + r32, cs = min(max(qc - 8, 0), 48);
    flash_pass8<2, 64>(lds, ntiles, QK8, N_IN0 * 2, 2048 + h * 64, (const unsigned char*)(p.ws + WS_VTB) + (size_t)((b * 8 + h) * 64) * 4352, qf, 0, wave >= 4,
      [&](int kt, int i) { return kt < nlat ? lbase + (rlo + kt) * 64 + i : cbase + (kt - nlat) * 64 + i; },
      [&](int kt) { return kt < nlat ? (rlo + kt) * 64 : 4096 + (kt - nlat) * 64; },
      [&](int kt, f32x16& p0, f32x16& p1) {
        if (ABL != 1 && kt < nlat) { const int kr = rlo + kt; const bool rowok = (kr >= rs_w && kr < rs_w + 8);
          const FA_LAS float* bp = RPB + min(max(kr - qrow_g + 7, 0), 14) * 31;
          { float b0[16];
#pragma unroll
            for (int r = 0; r < 16; ++r) { const int k0 = crow(r, hi); b0[r] = bp[min(max(k0 - qc + 15, 0), 30)]; }
#pragma unroll
            for (int r = 0; r < 16; ++r) { const int k0 = crow(r, hi); const float v0 = p0[r] + b0[r]; p0[r] = (rowok && k0 >= cs && k0 < cs + 16) ? v0 : -INFINITY; } }
          asm volatile("" ::: "memory");
          { float b1[16];
#pragma unroll
            for (int r = 0; r < 16; ++r) { const int k1 = 32 + crow(r, hi); b1[r] = bp[min(max(k1 - qc + 15, 0), 30)]; }
#pragma unroll
            for (int r = 0; r < 16; ++r) { const int k1 = 32 + crow(r, hi); const float v1 = p1[r] + b1[r]; p1[r] = (rowok && k1 >= cs && k1 < cs + 16) ? v1 : -INFINITY; } } } },
      [&](int kt) { const int kr = rlo + kt; return kt >= nlat || (kr >= rs_w && kr < rs_w + 8); },
      o, m, l);
    l += __shfl_xor(l, 32);
    const float inv = 1.f / l;
#pragma unroll
    for (int bk = 0; bk < 2; ++bk)
#pragma unroll
      for (int rg = 0; rg < 4; ++rg) { const int dv = bk * 32 + 8 * rg + 4 * hi;
        st_att4(ATT, (size_t)grow, 512 + h * 64 + dv, o[bk][4 * rg] * inv, o[bk][4 * rg + 1] * inv, o[bk][4 * rg + 2] * inv, o[bk][4 * rg + 3] * inv); }
    __syncthreads();
  }
}

DEVI void phase_attnC(const Params& p, ldsp_t lds, int* ctr) {
  const int tid = ftid(), lane = tid & 63, wave = __builtin_amdgcn_readfirstlane(tid >> 6), r32 = lane & 31, hi = lane >> 5;
  const bf16_t* P1 = (const bf16_t*)(p.ws + WS_P1); bf16_t* ATT = (bf16_t*)(p.ws + WS_ATT1);
  FA_LAS int* uq = (FA_LAS int*)(lds + 3 * Geo<64, 2>::STAGE + 64);
  for (;;) {
    if (tid == 0) *uq = atomicAdd(ctr, 1);
    __syncthreads();
    const int u = *uq;
    __syncthreads();
    if (u >= NB * 2 * 64) break;
    const int b = u >> 7, g = (u >> 6) & 1, tq = u & 63, hq = g * 4 + (wave >> 1), t = tq * 64 + 32 * (wave & 1) + r32, grow = b * SEQ + t;
    const int klo = max(tq - 2, 0), khi = min(tq + 2, 63), nwin = khi - klo + 1, ntiles = nwin + 4;
    bf16x8 q[4];
#pragma unroll
    for (int d0 = 0; d0 < 4; ++d0) q[d0] = load_q8(P1 + (size_t)grow * 2304 + hq * 64 + 16 * d0 + 8 * hi, C2);
    f32x16 o[2];
#pragma unroll
    for (int bk = 0; bk < 2; ++bk)
#pragma unroll
      for (int r = 0; r < 16; ++r) o[bk][r] = 0.f;
    float m = -1e30f, l = 0.f;
    const int cbase = NLAT + b * CTXL, lbase = b * SEQ;
    flash_pass2<64, 2, 0, 2>(lds, ntiles, P1, 2304, 512 + g * 64, 640 + g * 64, q, 0,
      [&](int kt, int i) { return kt < nwin ? lbase + (klo + kt) * 64 + i : cbase + (kt - nwin) * 64 + i; },
      [&](int kt, f32x16& p0, f32x16& p1) {
        if (kt < nwin) { const int kp = (klo + kt) * 64 - t;
#pragma unroll
          for (int r = 0; r < 16; ++r) { const int d0 = kp + crow(r, hi), d1 = d0 + 32;
            if (d0 < -128 || d0 > 128) p0[r] = -INFINITY; if (d1 < -128 || d1 > 128) p1[r] = -INFINITY; } } },
      o, m, l);
    l += __shfl_xor(l, 32);
    { const float sk = p.in[L1_SINKS][hq] * LOG2E, mn = fmaxf(m, sk), alpha = __builtin_amdgcn_exp2f(m - mn);
      l = l * alpha + __builtin_amdgcn_exp2f(sk - mn);
#pragma unroll
      for (int bk = 0; bk < 2; ++bk)
#pragma unroll
        for (int r = 0; r < 16; ++r) o[bk][r] *= alpha; }
    const float inv = 1.f / l;
#pragma unroll
    for (int bk = 0; bk < 2; ++bk)
#pragma unroll
      for (int rg = 0; rg < 4; ++rg) { const int dv = bk * 32 + 8 * rg + 4 * hi;
        st_att4(ATT, (size_t)grow, hq * 64 + dv, o[bk][4 * rg] * inv, o[bk][4 * rg + 1] * inv, o[bk][4 * rg + 2] * inv, o[bk][4 * rg + 3] * inv); }
    __syncthreads();
  }
}
}
namespace fs {
using fa::bf16x8; using fa::s16x4; using fa::f32x16; using fa::ldsp_t; using fa::u32x4; using fa::cvtpk; using fa::vtr; using fa::crow; using fa::LOG2E;
typedef unsigned u32x2 __attribute__((ext_vector_type(2)));

DEVI void phase_conv(const Params& p) {
  const bf16_t* P1 = (const bf16_t*)(p.ws + WS_P1); bf16_t* U = (bf16_t*)(p.ws + WS_U);
  const float* cw = p.in[L1_CONVW]; const float* cb = p.in[L1_CONVB];
  const int nitems = (NROW / 16) * 128;
  for (int it = blockIdx.x * NT + ftid(); it < nitems; it += gridDim.x * NT) {
    const int cg = it & 127, rc = it >> 7, r0 = rc * 16, ch = cg * 8;
    int s0, len; if (r0 < NLAT) { s0 = r0 & ~4095; len = SEQ; } else { s0 = NLAT + ((r0 - NLAT) & ~255); len = CTXL; }
    const int t0 = r0 - s0;
    float w[5][8], bias[8];
#pragma unroll
    for (int j = 0; j < 5; ++j) { const float4 a = *(const float4*)(cw + j * 1024 + ch), b = *(const float4*)(cw + j * 1024 + ch + 4);
      w[j][0] = a.x; w[j][1] = a.y; w[j][2] = a.z; w[j][3] = a.w; w[j][4] = b.x; w[j][5] = b.y; w[j][6] = b.z; w[j][7] = b.w; }
    { const float4 a = *(const float4*)(cb + ch), b = *(const float4*)(cb + ch + 4); bias[0] = a.x; bias[1] = a.y; bias[2] = a.z; bias[3] = a.w; bias[4] = b.x; bias[5] = b.y; bias[6] = b.z; bias[7] = b.w; }
    float win[5][8];
    auto ldrow = [&](int t, float (&d)[8]) {
      if (t < 0 || t >= len) {
#pragma unroll
        for (int k = 0; k < 8; ++k) d[k] = 0.f; return; }
      const u32x4 v = *(const u32x4*)(P1 + (size_t)(s0 + t) * 2304 + 768 + ch);
#pragma unroll
      for (int k = 0; k < 4; ++k) { d[2 * k] = __uint_as_float(v[k] << 16); d[2 * k + 1] = __uint_as_float(v[k] & 0xffff0000u); } };
    ldrow(t0 - 2, win[0]); ldrow(t0 - 1, win[1]); ldrow(t0, win[2]); ldrow(t0 + 1, win[3]);
#pragma unroll
    for (int i = 0; i < 16; ++i) {
      ldrow(t0 + i + 2, win[(i + 4) % 5]);
      float o[8];
#pragma unroll
      for (int k = 0; k < 8; ++k) { float a = bias[k];
#pragma unroll
        for (int j = 0; j < 5; ++j) a += w[j][k] * win[(i + j) % 5][k];
        o[k] = a * __builtin_amdgcn_rcpf(1.f + __expf(-a)); }
      u32x4 ov; ov[0] = cvtpk(o[0], o[1]); ov[1] = cvtpk(o[2], o[3]); ov[2] = cvtpk(o[4], o[5]); ov[3] = cvtpk(o[6], o[7]);
      *(u32x4*)(U + (size_t)(r0 + i) * 1024 + ch) = ov;
    }
  }
}

DEVI float softplus_f(float v) { if (v > 20.f) return v; const float x = __expf(v); return x < 1e-3f ? x * (1.f - 0.5f * x) : __logf(1.f + x); }
constexpr int BSTR = 272, XSTR = 192;
constexpr int L_BM = 0, L_XD = 128 * BSTR, L_XW = L_XD + 128 * XSTR, L_HT = L_XW + 128 * XSTR, L_CUM = L_HT + 128 * XSTR, L_DTV = L_CUM + 1024, L_XCH = L_DTV + 1024, L_TOT = L_XCH + 8 * 4096;

template <int ABL = 0> DEVI void phase_ssd(const Params& p, ldsp_t lds) {
  const int tid = ftid(), lane = tid & 63, wave = __builtin_amdgcn_readfirstlane(tid >> 6), r32 = lane & 31, hi = lane >> 5;
  const int pb = wave >> 2, lb = (wave < 4) ? (wave & 3) : 3 - (wave & 3);
  const bf16_t* U = (const bf16_t*)(p.ws + WS_U); const float* DT = (const float*)(p.ws + WS_DT);
  bf16_t* YFB = (bf16_t*)(p.ws + WS_YS);
  const int trow_off = 4 * hi + ((lane & 15) >> 2), tcol_off = 32 * ((lane >> 4) & 1) + 8 * (lane & 3);
  for (int it = blockIdx.x; it < NB * 2 * 8; it += gridDim.x) {
    const int b = it >> 4, dir = (it >> 3) & 1, hd = it & 7, g = hd >> 2;
    const float a2 = -expf(p.in[dir ? L1_ALOGB : L1_ALOGF][hd]) * LOG2E; const float dtb = p.in[dir ? L1_DTBB : L1_DTBF][hd];
    auto tokrow = [&](int c, int i) { const int seg = c >= 2, len = seg ? SEQ : CTXL, j = (seg ? c - 2 : c) * 128 + i; return (seg ? b * SEQ : NLAT + b * CTXL) + (dir ? len - 1 - j : j); };
    f32x16 hacc;
#pragma unroll
    for (int r = 0; r < 16; ++r) hacc[r] = 0.f;
    for (int i = tid; i < 128 * XSTR / 4; i += NT) ((FA_LAS unsigned*)(lds + L_HT))[i] = 0u;
    u32x4 sb_[4], sx_[2]; float sdt0 = 0.f, sdt1 = 0.f; bf16x8 cfn[8];
    auto prefetch = [&](int c) {
#pragma unroll
      for (int i = 0; i < 4; ++i) { const int ch = tid + NT * i; sb_[i] = *(const u32x4*)(U + (size_t)tokrow(c, ch >> 4) * 1024 + 512 + g * 128 + (ch & 15) * 8); }
#pragma unroll
      for (int i = 0; i < 2; ++i) { const int ch = tid + NT * i; sx_[i] = *(const u32x4*)(U + (size_t)tokrow(c, ch >> 3) * 1024 + hd * 64 + (ch & 7) * 8); }
      if (tid < 64) { sdt0 = DT[(size_t)tokrow(c, 2 * tid) * 16 + dir * 8 + hd]; sdt1 = DT[(size_t)tokrow(c, 2 * tid + 1) * 16 + dir * 8 + hd]; }
      const bf16_t* crowp = U + (size_t)tokrow(c, lb * 32 + r32) * 1024 + 768 + g * 128 + 8 * hi;
#pragma unroll
      for (int ks = 0; ks < 8; ++ks) cfn[ks] = *(const bf16x8*)(crowp + 16 * ks);
    };
    auto s1 = [&](int c) {
      if (tid < 64) {
        FA_LAS float* CUMw = (FA_LAS float*)(lds + L_CUM + (c & 1) * 512); FA_LAS float* DTVw = (FA_LAS float*)(lds + L_DTV + (c & 1) * 512);
        const float r0 = sdt0 + dtb, r1 = sdt1 + dtb; const float d0 = softplus_f(r0), d1 = softplus_f(r1);
        const float a0 = d0 * a2, a1 = d1 * a2; float v = a0 + a1;
        v = wave_scan_incl(v);
        DTVw[2 * tid] = d0; DTVw[2 * tid + 1] = d1; CUMw[2 * tid] = v - a1; CUMw[2 * tid + 1] = v;
      } };
    prefetch(0);
    s1(0);
    __syncthreads();
    for (int c = 0; c < 34; ++c) {
      const FA_LAS float* CUM = (const FA_LAS float*)(lds + L_CUM + (c & 1) * 512); const FA_LAS float* DTV = (const FA_LAS float*)(lds + L_DTV + (c & 1) * 512);
      const float cl = CUM[127];
#pragma unroll
      for (int i = 0; i < 4; ++i) { const int ch = tid + NT * i; *(FA_LAS u32x4*)(lds + L_BM + (ch >> 4) * BSTR + (ch & 15) * 16) = sb_[i]; }
#pragma unroll
      for (int i = 0; i < 2; ++i) { const int ch = tid + NT * i, s = ch >> 3; const float d = DTV[s], wv = d * __builtin_amdgcn_exp2f(cl - CUM[s]);
        u32x4 xd, xw;
#pragma unroll
        for (int k = 0; k < 4; ++k) { const float x0 = __uint_as_float(sx_[i][k] << 16), x1 = __uint_as_float(sx_[i][k] & 0xffff0000u); xd[k] = cvtpk(x0 * d, x1 * d); xw[k] = cvtpk(x0 * wv, x1 * wv); }
        *(FA_LAS u32x4*)(lds + L_XD + s * XSTR + (ch & 7) * 16) = xd; *(FA_LAS u32x4*)(lds + L_XW + s * XSTR + (ch & 7) * 16) = xw; }
      bf16x8 cf[8];
#pragma unroll
      for (int ks = 0; ks < 8; ++ks) cf[ks] = cfn[ks];
      __syncthreads();
      if (ABL != 3) { if (c + 1 < 34) prefetch(c + 1); }
      if (c >= 2 && ABL != 1) {
        f32x16 y;
#pragma unroll
        for (int r = 0; r < 16; ++r) y[r] = 0.f;
        { const ldsp_t hb = lds + L_HT + (8 * hi + ((lane & 15) >> 2)) * XSTR + pb * 64 + tcol_off;
          f32x16 y2;
#pragma unroll
          for (int r = 0; r < 16; ++r) y2[r] = 0.f;
#pragma unroll
          for (int ks = 0; ks < 8; ++ks) { const s16x4 lo = vtr(hb + (16 * ks) * XSTR), h8 = vtr(hb + (16 * ks + 4) * XSTR);
            const bf16x8 hf = {lo[0], lo[1], lo[2], lo[3], h8[0], h8[1], h8[2], h8[3]};
            if (ks & 1) y2 = __builtin_amdgcn_mfma_f32_32x32x16_bf16(hf, cf[ks], y2, 0, 0, 0); else y = __builtin_amdgcn_mfma_f32_32x32x16_bf16(hf, cf[ks], y, 0, 0, 0); }
          y += y2; }
        const float cuml = CUM[lb * 32 + r32];
        { const float e = __builtin_amdgcn_exp2f(cuml);
#pragma unroll
          for (int r = 0; r < 16; ++r) y[r] *= e; }
        f32x16 yo;
#pragma unroll
        for (int r = 0; r < 16; ++r) yo[r] = 0.f;
        for (int sb = pb; sb <= lb; sb += 2) {
          f32x16 gt, gt2;
#pragma unroll
          for (int r = 0; r < 16; ++r) { gt[r] = 0.f; gt2[r] = 0.f; }
          const ldsp_t bb = lds + L_BM + (sb * 32 + r32) * BSTR + 16 * hi;
#pragma unroll
          for (int ks = 0; ks < 8; ks += 2) { gt = __builtin_amdgcn_mfma_f32_32x32x16_bf16(*(const FA_LAS bf16x8*)(bb + 32 * ks), cf[ks], gt, 0, 0, 0);
            gt2 = __builtin_amdgcn_mfma_f32_32x32x16_bf16(*(const FA_LAS bf16x8*)(bb + 32 * ks + 32), cf[ks + 1], gt2, 0, 0, 0); }
          gt += gt2;
          const bool diag = (sb == lb);
#pragma unroll
          for (int r = 0; r < 16; ++r) { const int sl = crow(r, hi); const float v = gt[r] * __builtin_amdgcn_exp2f(cuml - CUM[sb * 32 + sl]); gt[r] = (diag && sl > r32) ? 0.f : v; }
          u32x4 t0, t1;
          t0[0] = cvtpk(gt[0], gt[1]); t0[1] = cvtpk(gt[2], gt[3]); t0[2] = cvtpk(gt[4], gt[5]); t0[3] = cvtpk(gt[6], gt[7]);
          t1[0] = cvtpk(gt[8], gt[9]); t1[1] = cvtpk(gt[10], gt[11]); t1[2] = cvtpk(gt[12], gt[13]); t1[3] = cvtpk(gt[14], gt[15]);
          const bf16x8 pm0 = __builtin_bit_cast(bf16x8, t0), pm1 = __builtin_bit_cast(bf16x8, t1);
          const ldsp_t xb = lds + L_XD + (sb * 32 + trow_off) * XSTR + pb * 64 + tcol_off;
          const ldsp_t xo = lds + L_XD + (sb * 32 + trow_off) * XSTR + (1 - pb) * 64 + tcol_off;
          const s16x4 a0 = vtr(xb), a1 = vtr(xb + 8 * XSTR), a2 = vtr(xb + 16 * XSTR), a3 = vtr(xb + 24 * XSTR);
          const s16x4 b0 = vtr(xo), b1 = vtr(xo + 8 * XSTR), b2 = vtr(xo + 16 * XSTR), b3 = vtr(xo + 24 * XSTR);
          { const bf16x8 xf = {a0[0], a0[1], a0[2], a0[3], a1[0], a1[1], a1[2], a1[3]}; y = __builtin_amdgcn_mfma_f32_32x32x16_bf16(xf, pm0, y, 0, 0, 0); }
          { const bf16x8 xf = {b0[0], b0[1], b0[2], b0[3], b1[0], b1[1], b1[2], b1[3]}; yo = __builtin_amdgcn_mfma_f32_32x32x16_bf16(xf, pm0, yo, 0, 0, 0); }
          { const bf16x8 xf = {a2[0], a2[1], a2[2], a2[3], a3[0], a3[1], a3[2], a3[3]}; y = __builtin_amdgcn_mfma_f32_32x32x16_bf16(xf, pm1, y, 0, 0, 0); }
          { const bf16x8 xf = {b2[0], b2[1], b2[2], b2[3], b3[0], b3[1], b3[2], b3[3]}; yo = __builtin_amdgcn_mfma_f32_32x32x16_bf16(xf, pm1, yo, 0, 0, 0); }
        }
        { FA_LAS float* X = (FA_LAS float*)(lds + L_XCH) + (pb * 4 + lb) * 1024;
#pragma unroll
          for (int r = 0; r < 16; ++r) X[r * 64 + lane] = yo[r]; }
        __syncthreads();
        { const FA_LAS float* X = (const FA_LAS float*)(lds + L_XCH) + ((1 - pb) * 4 + lb) * 1024;
#pragma unroll
          for (int r = 0; r < 16; ++r) y[r] += X[r * 64 + lane]; }
        const int j = (c - 2) * 128 + lb * 32 + r32, tok = dir ? SEQ - 1 - j : j;
        bf16_t* yp = YFB + ((size_t)dir * NLAT + (size_t)b * SEQ + tok) * 512 + hd * 64 + pb * 32 + 4 * hi;
#pragma unroll
        for (int rg = 0; rg < 4; ++rg) { u32x2 w; w[0] = cvtpk(y[4 * rg], y[4 * rg + 1]); w[1] = cvtpk(y[4 * rg + 2], y[4 * rg + 3]); *(u32x2*)(yp + 8 * rg) = w; }
      }
      if (ABL != 2) { const float e = __builtin_amdgcn_exp2f(cl);
        f32x16 h2;
#pragma unroll
        for (int r = 0; r < 16; ++r) { hacc[r] *= e; h2[r] = 0.f; }
        const ldsp_t xb = lds + L_XW + (8 * hi + ((lane & 15) >> 2)) * XSTR + pb * 64 + tcol_off;
        const ldsp_t bb = lds + L_BM + (8 * hi + ((lane & 15) >> 2)) * BSTR + lb * 64 + tcol_off;
#pragma unroll
        for (int ks = 0; ks < 8; ++ks) {
          const s16x4 xl = vtr(xb + (16 * ks) * XSTR), xh = vtr(xb + (16 * ks + 4) * XSTR), bl = vtr(bb + (16 * ks) * BSTR), bh = vtr(bb + (16 * ks + 4) * BSTR);
          const bf16x8 xf = {xl[0], xl[1], xl[2], xl[3], xh[0], xh[1], xh[2], xh[3]}, bf = {bl[0], bl[1], bl[2], bl[3], bh[0], bh[1], bh[2], bh[3]};
          if (ks & 1) h2 = __builtin_amdgcn_mfma_f32_32x32x16_bf16(xf, bf, h2, 0, 0, 0); else hacc = __builtin_amdgcn_mfma_f32_32x32x16_bf16(xf, bf, hacc, 0, 0, 0);
        }
        hacc += h2; }
      if (c + 1 < 34) s1(c + 1);
      __syncthreads();
      { const ldsp_t hp = lds + L_HT + (lb * 32 + r32) * XSTR + (pb * 32 + 4 * hi) * 2;
#pragma unroll
        for (int rg = 0; rg < 4; ++rg) { u32x2 w; w[0] = cvtpk(hacc[4 * rg], hacc[4 * rg + 1]); w[1] = cvtpk(hacc[4 * rg + 2], hacc[4 * rg + 3]); *(FA_LAS u32x2*)(hp + 16 * rg) = w; } }
    }
    __syncthreads();
  }
}

DEVI void phase_ssd_out(const Params& p) {
  const int lane = ftid() & 63, gw = blockIdx.x * NWAVE + (ftid() >> 6), NGW = gridDim.x * NWAVE;
  const bf16_t* U = (const bf16_t*)(p.ws + WS_U); const bf16_t* P1 = (const bf16_t*)(p.ws + WS_P1); const bf16_t* YFB = (const bf16_t*)(p.ws + WS_YS);
  bf16_t* ATT = (bf16_t*)(p.ws + WS_ATT1);
  for (int r = gw; r < NLAT; r += NGW) {
    const int c0 = lane * 8, hd = c0 >> 6; const float dsk = p.in[L1_DSKIP][hd];
    const u32x4 yf = *(const u32x4*)(YFB + (size_t)r * 512 + c0), yb = *(const u32x4*)(YFB + ((size_t)NLAT + r) * 512 + c0);
    const u32x4 xw = *(const u32x4*)(U + (size_t)r * 1024 + c0), zw = *(const u32x4*)(P1 + (size_t)r * 2304 + 1792 + c0);
    float y[8]; float ss = 0.f;
#pragma unroll
    for (int i = 0; i < 4; ++i) {
      const float x0 = __uint_as_float(xw[i] << 16), x1 = __uint_as_float(xw[i] & 0xffff0000u), z0 = __uint_as_float(zw[i] << 16), z1 = __uint_as_float(zw[i] & 0xffff0000u);
      const float f0 = __uint_as_float(yf[i] << 16) + __uint_as_float(yb[i] << 16), f1 = __uint_as_float(yf[i] & 0xffff0000u) + __uint_as_float(yb[i] & 0xffff0000u);
      y[2 * i] = (f0 + dsk * x0) * silu_f(z0); y[2 * i + 1] = (f1 + dsk * x1) * silu_f(z1);
      ss += y[2 * i] * y[2 * i] + y[2 * i + 1] * y[2 * i + 1];
    }
    ss = half_sum(ss);
    const float rr = rsqrtf(ss * (1.f / 256.f) + EPS);
    const float4 g0 = *(const float4*)(p.in[L1_GNORM] + c0), g1 = *(const float4*)(p.in[L1_GNORM] + c0 + 4);
    u32x4 w; w[0] = cvtpk(y[0] * rr * g0.x, y[1] * rr * g0.y); w[1] = cvtpk(y[2] * rr * g0.z, y[3] * rr * g0.w); w[2] = cvtpk(y[4] * rr * g1.x, y[5] * rr * g1.y); w[3] = cvtpk(y[6] * rr * g1.z, y[7] * rr * g1.w);
    *(u32x4*)(ATT + (size_t)r * DM + 512 + c0) = w;
  }
}
}
#ifndef TOPK_COPY
#define TOPK_COPY false
#endif
namespace ft {
using fa::ldsp_t; using fa::u32x4;

DEVI int block_excl_scan(int v, FA_LAS int* wsum, int tid, int* tot) {
  const int lane = tid & 63, wave = tid >> 6;
  const int inc = wave_scan_incl_i(v);
  __syncthreads();
  if (lane == 63) wsum[wave] = inc;
  __syncthreads();
  int base = 0, total = 0;
#pragma unroll
  for (int w = 0; w < 8; ++w) { const int s = wsum[w]; if (w < wave) base += s; total += s; }
  *tot = total;
  return base + inc - v;
}

template <int EPT, bool GATHER_COPY, int ABL = 0>
DEVI void topk_item(const Params& p, ldsp_t lds, int e, int n, int cap, int row0, int slot0, int erows) {
  const int tid = ftid(), lane = tid & 63, wave = tid >> 6;
  const float* AFFT = (const float*)(p.ws + WS_AFF); int* SLOT = (int*)(p.ws + WS_SLOT); float* GV = (float*)(p.ws + WS_GATEV);
  const bf16_t* H = (const bf16_t*)(p.ws + WS_H); bf16_t* XG = (bf16_t*)(p.ws + WS_XG); int* IDX = (int*)(p.ws + WS_IDX);
  FA_LAS unsigned* hist = (FA_LAS unsigned*)lds;
  FA_LAS int* misc = (FA_LAS int*)(lds + 1024);
  FA_LAS int* wsum = (FA_LAS int*)(lds + 1024 + 64);
  FA_LAS int* list = (FA_LAS int*)(lds + 2048);
  const bool act = tid * EPT < n;
  unsigned key[EPT];
#pragma unroll
  for (int j = 0; j < EPT; ++j) key[j] = act ? __float_as_uint(AFFT[(size_t)e * NROW + row0 + tid * EPT + j]) : 0u;
  unsigned prefix = 0u, mask = 0u; int k = cap;
#pragma unroll 1
  for (int pass = 0; pass < 4; ++pass) {
    const int shift = 24 - 8 * pass;
    __syncthreads();
    if (tid < 256) hist[tid] = 0u;
    __syncthreads();
    if (act) {
#pragma unroll
      for (int j = 0; j < EPT; ++j) if ((key[j] & mask) == prefix) atomicAdd((unsigned*)&hist[(key[j] >> shift) & 255u], 1u);
    }
    __syncthreads();
    if (wave == 0) {
      const int h0 = hist[4 * lane], h1 = hist[4 * lane + 1], h2 = hist[4 * lane + 2], h3 = hist[4 * lane + 3];
      const int s = h0 + h1 + h2 + h3; const int pre = wave_scan_incl_i(s);
      int c = __builtin_amdgcn_readlane(pre, 63) - pre;
      const int hh[4] = {h0, h1, h2, h3};
#pragma unroll
      for (int b = 3; b >= 0; --b) { if (c < k && k <= c + hh[b]) { misc[0] = 4 * lane + b; misc[1] = k - c; } c += hh[b]; }
    }
    __syncthreads();
    prefix |= ((unsigned)misc[0]) << shift; mask |= 255u << shift; k = misc[1];
  }
  int ce = 0;
#pragma unroll
  for (int j = 0; j < EPT; ++j) ce += (act && key[j] == prefix) ? 1 : 0;
  int tot; const int eq_before = block_excl_scan(ce, wsum, tid, &tot);
  int cs = 0, eqr = eq_before; bool sel[EPT];
#pragma unroll
  for (int j = 0; j < EPT; ++j) { bool s = false; if (act) { if (key[j] > prefix) s = true; else if (key[j] == prefix) { s = eqr < k; ++eqr; } } sel[j] = s; cs += s ? 1 : 0; }
  int slot = block_excl_scan(cs, wsum, tid, &tot);
  if (act) {
    int sv[EPT];
#pragma unroll
    for (int j = 0; j < EPT; ++j) { const int row = row0 + tid * EPT + j;
      if (sel[j]) { if (GATHER_COPY) list[slot] = row; else IDX[e * erows + slot0 + slot] = row; GV[e * erows + slot0 + slot] = __uint_as_float(key[j]); sv[j] = slot0 + slot; ++slot; }
      else sv[j] = -1; }
    if (ABL != 1) {
      int* sp = SLOT + (size_t)e * NROW + row0 + tid * EPT;
      if (EPT == 8) { *(int4*)sp = make_int4(sv[0], sv[1 % EPT], sv[2 % EPT], sv[3 % EPT]); *(int4*)(sp + 4) = make_int4(sv[4 % EPT], sv[5 % EPT], sv[6 % EPT], sv[7 % EPT]); }
      else {
#pragma unroll
        for (int j = 0; j < EPT; ++j) sp[j] = sv[j]; }
    }
  }
  if (GATHER_COPY) {
    __syncthreads();
    for (int s = wave; s < cap; s += NWAVE) {
      const u32x4* src = (const u32x4*)(H + (size_t)list[s] * DM) + lane; u32x4* dst = (u32x4*)(XG + ((size_t)e * erows + slot0 + s) * DM) + lane;
      const u32x4 a = src[0], b2 = src[64]; dst[0] = a; dst[64] = b2;
    }
  }
  __syncthreads();
}

template <int ABL = 0> DEVI void phase_topk(const Params& p, ldsp_t lds, int layer) {
  const int erows = layer ? EROWS1 : EROWS0;
  const int nlat = NB * NE, nitems = nlat + (layer ? 0 : NB * NE);
  const int G = gridDim.x;
  for (int it = blockIdx.x; it < nitems; it += G) {
    if (it < nlat) { const int b = it / NE, e = it % NE; topk_item<8, TOPK_COPY, ABL>(p, lds, e, SEQ, CAP_L, b * SEQ, b * CAP_L, erows); }
    else { const int i2 = it - nlat, b = i2 / NE, e = i2 % NE; topk_item<1, TOPK_COPY, ABL>(p, lds, e, CTXL, CAP_C, NLAT + b * CTXL, NB * CAP_L + b * CAP_C, erows); }
  }
}
}
#ifndef MOE1_FP8
#define MOE1_FP8 1
#endif
#ifndef MOE0_FP8
#define MOE0_FP8 1
#endif
namespace fr {
using fa::ldsp_t; using fa::u32x4; using fa::cvtpk;
typedef unsigned u32x2 __attribute__((ext_vector_type(2)));
typedef float f32x4 __attribute__((ext_vector_type(4)));
struct V16 { f32x4 v[4]; };
DEVI V16 ldf(const float* r, int lane) { V16 o; const f32x4* q = (const f32x4*)r + lane;
#pragma unroll
  for (int j = 0; j < 4; ++j) o.v[j] = q[64 * j]; return o; }
struct B16 { u32x2 v[4]; };
DEVI B16 ldb_raw(const bf16_t* r, int lane) { B16 o; const u32x2* q = (const u32x2*)r + lane;
#pragma unroll
  for (int j = 0; j < 4; ++j) o.v[j] = q[64 * j]; return o; }
DEVI V16 b2v(const B16& b) { V16 o;
#pragma unroll
  for (int j = 0; j < 4; ++j) { o.v[j][0] = __uint_as_float(b.v[j][0] << 16); o.v[j][1] = __uint_as_float(b.v[j][0] & 0xffff0000u); o.v[j][2] = __uint_as_float(b.v[j][1] << 16); o.v[j][3] = __uint_as_float(b.v[j][1] & 0xffff0000u); }
  return o; }
DEVI void stf(float* r, int lane, const V16& o) { f32x4* q = (f32x4*)r + lane;
#pragma unroll
  for (int j = 0; j < 4; ++j) q[64 * j] = o.v[j]; }
DEVI void stb(bf16_t* r, int lane, const V16& o) { u32x2* q = (u32x2*)r + lane;
#pragma unroll
  for (int j = 0; j < 4; ++j) { u32x2 w; w[0] = cvtpk(o.v[j][0], o.v[j][1]); w[1] = cvtpk(o.v[j][2], o.v[j][3]); q[64 * j] = w; } }
DEVI float sumsq(const V16& o) { f32x4 s = o.v[0] * o.v[0];
#pragma unroll
  for (int j = 1; j < 4; ++j) s += o.v[j] * o.v[j];
  return wave_sum((s[0] + s[1]) + (s[2] + s[3])); }

DEVI void phase_prenorm0(const Params& p) {
  const int lane = ftid() & 63, gw = blockIdx.x * NWAVE + (ftid() >> 6), NGW = gridDim.x * NWAVE;
  const float* MOD = (const float*)(p.ws + WS_CTL + CTL_MOD); bf16_t* H = (bf16_t*)(p.ws + WS_H);
  const int rpw = (NROW + NGW - 1) / NGW;
  const int r0 = gw * rpw, r1 = min(r0 + rpw, NROW);
  if (r0 >= r1) return;
  const V16 g = ldf(p.in[L0_GPREMIX], lane);
  int cur = -1; V16 gs, sh;
  auto src = [&](int r) { return r < NLAT ? p.in[I_X] + (size_t)r * DM : p.in[I_CTX] + (size_t)(r - NLAT) * DM; };
  V16 xn = ldf(src(r0), lane), xn2 = xn;
  if (r0 + 1 < r1) xn2 = ldf(src(r0 + 1), lane);
  for (int r = r0; r < r1; ++r) {
    const V16 x = xn; xn = xn2; if (r + 2 < r1) xn2 = ldf(src(r + 2), lane);
    const int mr = row_modrow(r);
    if (mr != cur) { cur = mr; const float* m = MOD + (size_t)mr * 6144; const V16 sc = ldf(m + 1024, lane); sh = ldf(m, lane);
#pragma unroll
      for (int j = 0; j < 4; ++j) gs.v[j] = g.v[j] * (sc.v[j] + 1.f); }
    const float rr = rsqrtf(sumsq(x) * (1.f / DM) + EPS);
    V16 h;
#pragma unroll
    for (int j = 0; j < 4; ++j) h.v[j] = x.v[j] * rr * gs.v[j] + sh.v[j];
    if (QKV0_FP8) {
      unsigned* q8 = (unsigned*)((unsigned char*)H + (size_t)r * DM) + lane;
#pragma unroll
      for (int j = 0; j < 4; ++j) q8[64 * j] = nv::pack4_fp8(h.v[j][0] * nv::A8_SCALE, h.v[j][1] * nv::A8_SCALE, h.v[j][2] * nv::A8_SCALE, h.v[j][3] * nv::A8_SCALE);
    } else stb(H + (size_t)r * DM, lane, h);
  }
}

template <int ABL = 0> DEVI void phase_postmix(const Params& p, ldsp_t lds, int layer) {
  const int tid = ftid(), lane = tid & 63, gw = blockIdx.x * NWAVE + (tid >> 6), NGW = gridDim.x * NWAVE;
  const float* MOD = (const float*)(p.ws + WS_CTL + CTL_MOD) + (size_t)layer * 9 * 6144;
  const bf16_t* MIX = (const bf16_t*)(p.ws + (layer ? WS_MIX1 : WS_MIX0));
  bf16_t* H = (bf16_t*)(p.ws + WS_H); float* AFFT = (float*)(p.ws + WS_AFF); float* XC = (float*)(p.ws + WS_XC);
  const float* wr = p.in[layer ? L1_WROUTER : L0_WROUTER];
  FA_LAS f32x4* WL = (FA_LAS f32x4*)lds;
  for (int i = tid; i < 1024 * 4; i += NT) { const int k = i >> 2, e4 = i & 3; const int ln = (k & 255) >> 2, q = k & 3, j = k >> 8;
    WL[((j * 4 + q) * 4 + e4) * 64 + ln] = *(const f32x4*)(wr + (size_t)k * 16 + e4 * 4); }
  __syncthreads();
  const int nrow = layer ? NLAT : NROW;
  const int rpw = (nrow + NGW - 1) / NGW;
  const int r0 = gw * rpw, r1 = min(r0 + rpw, nrow);
  if (r0 >= r1) return;
  const V16 gpost = ldf(p.in[layer ? L1_GPOSTMIX : L0_GPOSTMIX], lane), gpre = ldf(p.in[layer ? L1_GPREFFN : L0_GPREFFN], lane);
  int cur = -1; V16 gg, gs, sh;
  auto xsrc = [&](int r) { return layer ? (const float*)(p.out + (size_t)r * DM) : (r < NLAT ? p.in[I_X] + (size_t)r * DM : p.in[I_CTX] + (size_t)(r - NLAT) * DM); };
  B16 mn = ldb_raw(MIX + (size_t)r0 * DM, lane); V16 xn = ldf(xsrc(r0), lane);
  B16 mn2 = mn; V16 xn2 = xn;
  if (r0 + 1 < r1) { mn2 = ldb_raw(MIX + (size_t)(r0 + 1) * DM, lane); xn2 = ldf(xsrc(r0 + 1), lane); }
  for (int r = r0; r < r1; ++r) {
    const B16 mb = mn; const V16 x = xn;
    mn = mn2; xn = xn2;
    if (r + 2 < r1) { mn2 = ldb_raw(MIX + (size_t)(r + 2) * DM, lane); xn2 = ldf(xsrc(r + 2), lane); }
    const int mr = row_modrow(r);
    if (mr != cur) { cur = mr; const float* m = MOD + (size_t)mr * 6144; const V16 gt = ldf(m + 2048, lane), sc = ldf(m + 4096, lane); sh = ldf(m + 3072, lane);
#pragma unroll
      for (int j = 0; j < 4; ++j) { gg.v[j] = gt.v[j] * gpost.v[j]; gs.v[j] = gpre.v[j] * (sc.v[j] + 1.f); } }
    V16 o = b2v(mb);
    const float rr = rsqrtf(sumsq(o) * (1.f / DM) + EPS);
#pragma unroll
    for (int j = 0; j < 4; ++j) o.v[j] = x.v[j] + gg.v[j] * (o.v[j] * rr);
    stf(r < NLAT ? p.out + (size_t)r * DM : XC + (size_t)(r - NLAT) * DM, lane, o);
    const float r2 = rsqrtf(sumsq(o) * (1.f / DM) + EPS);
    V16 h;
#pragma unroll
    for (int j = 0; j < 4; ++j) h.v[j] = o.v[j] * r2 * gs.v[j] + sh.v[j];
    if ((layer == 1 && MOE1_FP8) || (layer == 0 && MOE0_FP8)) {
      unsigned* q8 = (unsigned*)((unsigned char*)H + (size_t)r * DM) + lane;
#pragma unroll
      for (int j = 0; j < 4; ++j) q8[64 * j] = nv::pack4_fp8(h.v[j][0] * nv::A8_SCALE, h.v[j][1] * nv::A8_SCALE, h.v[j][2] * nv::A8_SCALE, h.v[j][3] * nv::A8_SCALE);
    } else stb(H + (size_t)r * DM, lane, h);
    if (ABL == 1) continue;
    f32x4 lg[4];
    int lo = lane; asm volatile("" : "+v"(lo));
#pragma unroll
    for (int e4 = 0; e4 < 4; ++e4) lg[e4] = (f32x4){0.f, 0.f, 0.f, 0.f};
#pragma unroll
    for (int j = 0; j < 4; ++j)
#pragma unroll
      for (int q = 0; q < 4; ++q) { const float hv = h.v[j][q];
#pragma unroll
        for (int e4 = 0; e4 < 4; ++e4) lg[e4] += WL[((j * 4 + q) * 4 + e4) * 64 + lo] * hv; }
    float a8[8], b4[4], c2[2], d;
#pragma unroll
    for (int i = 0; i < 8; ++i) { const auto s = __builtin_amdgcn_permlane32_swap(__float_as_uint(lg[i >> 2][i & 3]), __float_as_uint(lg[2 + (i >> 2)][i & 3]), false, false);
      a8[i] = __uint_as_float(s[0]) + __uint_as_float(s[1]); }
#pragma unroll
    for (int i = 0; i < 4; ++i) { const auto s = __builtin_amdgcn_permlane16_swap(__float_as_uint(a8[i]), __float_as_uint(a8[i + 4]), false, false);
      b4[i] = __uint_as_float(s[0]) + __uint_as_float(s[1]); }
    { const bool b3 = (lane & 8) != 0, b2 = (lane & 4) != 0;
#pragma unroll
      for (int i = 0; i < 2; ++i) { const float keep = b3 ? b4[i + 2] : b4[i], send = b3 ? b4[i] : b4[i + 2]; c2[i] = keep + dppf<DPP_MIRROR>(send); }
      const float keep = b2 ? c2[1] : c2[0], send = b2 ? c2[0] : c2[1]; d = keep + dppf<DPP_HMIRROR>(send); }
    d += dppf<DPP_XOR1>(d); d += dppf<DPP_XOR2>(d);
    const float mx = quad_max(d), ex = expf(d - mx), ssum = quad_sum(ex);
    if ((lane & 3) == 0) AFFT[(size_t)(lane >> 2) * NROW + r] = ex / ssum;
  }
}

DEVI void phase_combine(const Params& p, int layer) {
  const int tid = ftid(), lane = tid & 63, gw = blockIdx.x * NWAVE + (tid >> 6), NGW = gridDim.x * NWAVE;
  const float* MOD = (const float*)(p.ws + WS_CTL + CTL_MOD);
  const bf16_t* Y = (const bf16_t*)(p.ws + WS_Y); const int* SLOT = (const int*)(p.ws + WS_SLOT); const float* GV = (const float*)(p.ws + WS_GATEV);
  bf16_t* H = (bf16_t*)(p.ws + WS_H); float* XC = (float*)(p.ws + WS_XC);
  const int nrow = layer ? NLAT : NROW, erows = layer ? EROWS1 : EROWS0;
  const int rpw = (nrow + NGW - 1) / NGW;
  const int r0 = gw * rpw, r1 = min(r0 + rpw, nrow);
  if (r0 >= r1) return;
  const V16 gpost = ldf(p.in[layer ? L1_GPOSTFFN : L0_GPOSTFFN], lane);
  V16 g1; if (layer == 0) g1 = ldf(p.in[L1_GPREMIX], lane);
  int cur = -1; V16 gg, gs, sh;
  int sn = (lane < 16) ? SLOT[(size_t)lane * NROW + r0] : -1;
  for (int r = r0; r < r1; ++r) {
    const int sl = sn; if (r + 1 < r1) sn = (lane < 16) ? SLOT[(size_t)lane * NROW + r + 1] : -1;
    float* xio = r < NLAT ? p.out + (size_t)r * DM : XC + (size_t)(r - NLAT) * DM;
    const V16 x = ldf(xio, lane);
    const int mr = row_modrow(r);
    if (mr != cur) { cur = mr; const float* m = MOD + (size_t)(layer * 9 + mr) * 6144; const V16 gt = ldf(m + 5120, lane);
#pragma unroll
      for (int j = 0; j < 4; ++j) gg.v[j] = gt.v[j] * gpost.v[j];
      if (layer == 0) { const float* m1 = MOD + (size_t)(9 + mr) * 6144; const V16 sc = ldf(m1 + 1024, lane); sh = ldf(m1, lane);
#pragma unroll
        for (int j = 0; j < 4; ++j) gs.v[j] = g1.v[j] * (sc.v[j] + 1.f); } }
    V16 o;
#pragma unroll
    for (int j = 0; j < 4; ++j) o.v[j] = (f32x4){0.f, 0.f, 0.f, 0.f};
    unsigned long long mask = __ballot(sl >= 0);
    while (mask) {
      int e_[4], s_[4]; bool v_[4];
#pragma unroll
      for (int i = 0; i < 4; ++i) { v_[i] = mask != 0ull; e_[i] = v_[i] ? __builtin_ctzll(mask) : 0; if (v_[i]) mask &= mask - 1; s_[i] = __builtin_amdgcn_readlane(sl, e_[i]); }
      B16 yr[4]; float gt[4];
#pragma unroll
      for (int i = 0; i < 4; ++i) if (v_[i]) { gt[i] = GV[e_[i] * erows + s_[i]];
        yr[i] = ldb_raw(Y + ((size_t)e_[i] * erows + s_[i]) * DM, lane); }
#pragma unroll
      for (int i = 0; i < 4; ++i) if (v_[i]) { const V16 y = b2v(yr[i]);
#pragma unroll
        for (int j = 0; j < 4; ++j) o.v[j] += y.v[j] * gt[i]; }
    }
    const float rr = rsqrtf(sumsq(o) * (1.f / DM) + EPS);
#pragma unroll
    for (int j = 0; j < 4; ++j) o.v[j] = x.v[j] + gg.v[j] * (o.v[j] * rr);
    stf(xio, lane, o);
    if (layer == 0) {
      const float r2 = rsqrtf(sumsq(o) * (1.f / DM) + EPS);
      V16 h;
#pragma unroll
      for (int j = 0; j < 4; ++j) h.v[j] = o.v[j] * r2 * gs.v[j] + sh.v[j];
      if (QKV1_FP8) {
        unsigned* q8 = (unsigned*)((unsigned char*)H + (size_t)r * DM) + lane;
#pragma unroll
        for (int j = 0; j < 4; ++j) q8[64 * j] = nv::pack4_fp8(h.v[j][0] * nv::A8_SCALE, h.v[j][1] * nv::A8_SCALE, h.v[j][2] * nv::A8_SCALE, h.v[j][3] * nv::A8_SCALE);
      } else stb(H + (size_t)r * DM, lane, h);
    }
  }
}
}
#define LAS __attribute__((address_space(3)))
#define XB_TMO      128
#define XB_XCNT(j)  (256  + 64 * (j))
#define XB_XSUB(j)  (1280 + 64 * (j))
#define XB_XGEN(j)  (2304 + 64 * (j))
#define XB_TOP      3328
#define XB_TOPGEN   3392
#define XCD_BAR_WORDS 3456
#define XB_SPIN_CAP (1u << 18)

__device__ __forceinline__ unsigned xb_ld(unsigned* p)              { return __hip_atomic_load(p, __ATOMIC_RELAXED, __HIP_MEMORY_SCOPE_AGENT); }
__device__ __forceinline__ unsigned xb_add(unsigned* p, unsigned v) { return __hip_atomic_fetch_add(p, v, __ATOMIC_RELAXED, __HIP_MEMORY_SCOPE_AGENT); }
__device__ __forceinline__ unsigned xb_xcc_id() { return (unsigned)__builtin_amdgcn_s_getreg((3 << 11) | 20) & 0xFu; }
#define XB_SPIN(cond, bar) do { unsigned _sp = 0; while (cond) { __builtin_amdgcn_s_sleep(1); \
    if ((++_sp & 255u) == 0u) { if (xb_ld(&(bar)[XB_TMO])) break; if (_sp > XB_SPIN_CAP) { atomicAdd(&(bar)[XB_TMO], 1u); break; } } } } while (0)

struct XcdBarrier {
    unsigned* bar; unsigned x;
    volatile LAS unsigned* st;
};

__device__ __forceinline__ XcdBarrier xcd_barrier_post(unsigned* bar, volatile LAS unsigned* st) {
    XcdBarrier b; b.bar = bar; b.x = xb_xcc_id(); b.st = st;
    if (threadIdx.x == 0) (void)xb_add(&bar[XB_XCNT(b.x)], 1u);
    return b;
}
__device__ __forceinline__ void xcd_barrier_complete(unsigned* bar, unsigned x, unsigned& nloc, unsigned& nx) {
    const unsigned G = gridDim.x * gridDim.y * gridDim.z;
    unsigned sum, cnt, mine, sp = 0u;
    for (;;) {
        sum = 0u; cnt = 0u; mine = 0u;
#pragma unroll
        for (unsigned j = 0; j < 16; ++j) { const unsigned c = xb_ld(&bar[XB_XCNT(j)]); sum += c; cnt += (c > 0u) ? 1u : 0u; mine = (j == x) ? c : mine; }
        if (sum == G) break;
        __builtin_amdgcn_s_sleep(1);
        if ((++sp & 255u) == 0u) { if (xb_ld(&bar[XB_TMO])) break; if (sp > XB_SPIN_CAP) { atomicAdd(&bar[XB_TMO], 1u); break; } }
    }
    nloc = mine > 0u ? mine : 1u; nx = cnt > 0u ? cnt : 1u;
}

__device__ __forceinline__ void xcd_barrier(const XcdBarrier& b) {
    asm volatile("s_waitcnt vmcnt(0)" ::: "memory");
    __syncthreads();
    if (threadIdx.x == 0) {
        unsigned* bar = b.bar;
        __builtin_amdgcn_s_waitcnt(0);
        unsigned nloc = b.st[0], nx = b.st[1];
        if (nloc == 0u) { xcd_barrier_complete(bar, b.x, nloc, nx); b.st[0] = nloc; b.st[1] = nx; }
        const unsigned old = xb_add(&bar[XB_XSUB(b.x)], 1u);
        const unsigned gen = old / nloc;
        if (old + 1u == (gen + 1u) * nloc) {
            __builtin_amdgcn_fence(__ATOMIC_RELEASE, "agent");
            asm volatile("s_waitcnt vmcnt(0)" ::: "memory");
            const unsigned og = xb_add(&bar[XB_TOP], 1u);
            const unsigned tg = og / nx;
            if (og + 1u == (tg + 1u) * nx) xb_add(&bar[XB_TOPGEN], 1u);
            else XB_SPIN(xb_ld(&bar[XB_TOPGEN]) == tg, bar);
            __builtin_amdgcn_fence(__ATOMIC_ACQUIRE, "agent");
            xb_add(&bar[XB_XGEN(b.x)], 1u);
            asm volatile("s_waitcnt vmcnt(0)" ::: "memory");
        } else {
            XB_SPIN(xb_ld(&bar[XB_XGEN(b.x)]) == gen, bar);
            __builtin_amdgcn_fence(__ATOMIC_ACQUIRE, "agent");
            asm volatile("s_waitcnt vmcnt(0)" ::: "memory");
        }
    }
    __syncthreads();
}


__device__ __forceinline__ void flat_barrier(unsigned* ctr, unsigned& epoch) {
    asm volatile("s_waitcnt vmcnt(0)" ::: "memory");
    __syncthreads();
    if (threadIdx.x == 0) {
        __builtin_amdgcn_fence(__ATOMIC_RELEASE, "agent");
        asm volatile("s_waitcnt vmcnt(0)" ::: "memory");
        (void)__hip_atomic_fetch_add(ctr, 1u, __ATOMIC_RELAXED, __HIP_MEMORY_SCOPE_AGENT);
        const unsigned target = (epoch + 1u) * (unsigned)gridDim.x; unsigned sp = 0;
        while (__hip_atomic_load(ctr, __ATOMIC_RELAXED, __HIP_MEMORY_SCOPE_AGENT) < target) { __builtin_amdgcn_s_sleep(1); if (++sp > (1u << 22)) break; }
        __builtin_amdgcn_fence(__ATOMIC_ACQUIRE, "agent");
        asm volatile("s_waitcnt vmcnt(0)" ::: "memory");
    }
    ++epoch;
    __syncthreads();
}

__device__ __forceinline__ void xcd_barrier2(const XcdBarrier& b) {
    asm volatile("s_waitcnt vmcnt(0)" ::: "memory");
    __syncthreads();
    if (threadIdx.x == 0) {
        unsigned* bar = b.bar;
        __builtin_amdgcn_s_waitcnt(0);
        unsigned nloc = b.st[0], nx = b.st[1];
        if (nloc == 0u) { xcd_barrier_complete(bar, b.x, nloc, nx); b.st[0] = nloc; b.st[1] = nx; }
        const unsigned old = xb_add(&bar[XB_XSUB(b.x)], 1u);
        const unsigned gen = old / nloc;
        if (old + 1u == (gen + 1u) * nloc) {
            __builtin_amdgcn_fence(__ATOMIC_RELEASE, "agent");
            asm volatile("s_waitcnt vmcnt(0)" ::: "memory");
            (void)xb_add(&bar[XB_TOP], 1u);
        }
        const unsigned target = (gen + 1u) * nx;
        XB_SPIN(xb_ld(&bar[XB_TOP]) < target, bar);
        __builtin_amdgcn_fence(__ATOMIC_ACQUIRE, "agent");
        asm volatile("s_waitcnt vmcnt(0)" ::: "memory");
    }
    __syncthreads();
}
constexpr int LDS_BYTES = 147456;
#define TAILFILL 1
#ifndef FAST_GEMM
#define FAST_GEMM 1
#endif
#ifndef FAST_TOPK
#define FAST_TOPK 1
#endif
#ifndef FAST_SSD
#define FAST_SSD 1
#endif
#ifndef FAST_ATTN
#define FAST_ATTN 1
#endif
__global__ void __launch_bounds__(NT) mega(Params p) {
  extern __shared__ __attribute__((aligned(16))) unsigned char lds_raw[];
  float* lds = (float*)lds_raw;
  fg::ldsp_t ldsp = (fg::ldsp_t)lds_raw;
  cg::grid_group grid = cg::this_grid();
  volatile LAS unsigned* bst = (volatile LAS unsigned*)((LAS unsigned char*)lds_raw + (LDS_BYTES - 64));
  if (threadIdx.x < 2) bst[threadIdx.x] = 0u;
  unsigned* barw = (unsigned*)(p.ws + WS_CTL + CTL_BAR);
  if (blockIdx.x == 0) { const int t0 = ftid(); for (int i = t0; i < XCD_BAR_WORDS; i += NT) barw[i] = 0u; }
  XcdBarrier xbar; xbar.bar = barw; xbar.x = 0; xbar.st = bst;
#ifdef FLATBAR
  unsigned fb_epoch = 0; unsigned* fb_ctr = barw + XCD_BAR_WORDS - 64;
#define GSYNC() flat_barrier(fb_ctr, fb_epoch)
#elif defined(XBAR2)
#define GSYNC() xcd_barrier2(xbar)
#else
#define GSYNC() xcd_barrier(xbar)
#endif
  nv::phase0(p, lds);                 grid.sync();
  xbar = xcd_barrier_post(barw, bst);
#ifdef DUP_SYNC
  for (int i = 0; i < 20; ++i) GSYNC();
#endif
#ifdef DUP_P0
  nv::phase0(p, lds);                 GSYNC();
#endif
  fr::phase_prenorm0(p);              GSYNC();
#ifdef DUP_PRENORM
  fr::phase_prenorm0(p); GSYNC();
#endif
#if FAST_GEMM
  fg::phase_qkv0(p, ldsp); GSYNC();
#ifdef DUP_QKV0
  fg::phase_qkv0(p, ldsp); GSYNC();
#endif
#else
  nv::phase_qkv0(p, lds);             GSYNC();
#endif
#if FAST_ATTN
  fa::phase_attnA(p, ldsp); fa::phase_attnB(p, ldsp); GSYNC();
#ifdef DUP_A
  fa::phase_attnA<DUP_A>(p, ldsp); GSYNC();
#endif
#ifdef DUP_B
  fa::phase_attnB<DUP_B>(p, ldsp); GSYNC();
#endif
#else
  nv::phase_attn0(p, lds);            GSYNC();
#endif
#if FAST_GEMM
#ifdef TAILFILL
  fg::phase_outproj(p, ldsp, 0); nv::convert_moe_tail8(p, 0, 1, lds, NROW / 256 * (DM / 256)); GSYNC();
#else
  fg::phase_outproj(p, ldsp, 0); GSYNC();
#endif
#ifdef DUP_OUT0
  fg::phase_outproj(p, ldsp, 0); GSYNC();
#endif
#else
  nv::phase_outproj(p, lds, 0);       GSYNC();
#endif
  fr::phase_postmix(p, ldsp, 0);            GSYNC();
#ifdef DUP_POSTMIX0
  fr::phase_postmix<DUP_POSTMIX0>(p, ldsp, 0); GSYNC();
#endif
#if FAST_TOPK
  ft::phase_topk(p, ldsp, 0);         GSYNC();
#ifdef DUP_TOPK0
  ft::phase_topk(p, ldsp, 0);         GSYNC();
#endif
#else
  nv::phase_topk(p, lds, 0);          GSYNC();
  fg::phase_gather(p, 0);             GSYNC();
#endif
#if FAST_GEMM
  fg::phase_moe_up8(p, ldsp, 0);      GSYNC();
#ifdef DUP_UP0
  fg::phase_moe_up8(p, ldsp, 0); GSYNC();
#endif
  fg::phase_moe_down8(p, ldsp, 0);    GSYNC();
#ifdef DUP_DOWN0
  fg::phase_moe_down8(p, ldsp, 0); GSYNC();
#endif
#else
  nv::phase_moe_up(p, lds, 0);        GSYNC();
  nv::phase_moe_down(p, lds, 0);      GSYNC();
#endif
#ifdef TAILFILL
  fr::phase_combine(p, 0); GSYNC();
#else
  fr::phase_combine(p, 0); nv::convert_moe_tail(p, 1, 0, lds, 0); nv::convert_moe_tail(p, 1, 1, lds, 0); GSYNC();
#endif
#if FAST_GEMM
#ifdef TAILFILL
  fg::phase_qkv1(p, ldsp); GSYNC();
#else
  fg::phase_qkv1(p, ldsp); GSYNC();
#endif
#else
  nv::phase_qkv1(p, lds);             GSYNC();
#endif
#if FAST_ATTN
#if FAST_SSD
#ifdef TAILFILL
  fs::phase_conv(p); GSYNC();
#else
  fs::phase_conv(p); GSYNC();
#endif
#else
  nv::phase_conv_swa(p, lds, true); GSYNC();
#endif
#else
  nv::phase_conv_swa(p, lds, true);   GSYNC();
#endif
#if FAST_SSD
  fs::phase_ssd(p, ldsp); fa::phase_attnC(p, ldsp, (int*)(p.ws + WS_CTL + CTL_QC));
  nv::convert_moe_tail8(p, 1, 0, lds, NB * 2 * 8); nv::convert_moe_tail8(p, 1, 1, lds, NB * 2 * 8); GSYNC();
#ifdef DUP_SSD
  fs::phase_ssd<DUP_SSD>(p, ldsp);             GSYNC();
#endif
  fs::phase_ssd_out(p);               GSYNC();
#else
  nv::phase_ssd(p, lds);              GSYNC();
  nv::phase_ssd_out(p);               GSYNC();
#endif
#if FAST_GEMM
  fg::phase_outproj(p, ldsp, 1);      GSYNC();
#else
  nv::phase_outproj(p, lds, 1);       GSYNC();
#endif
  fr::phase_postmix(p, ldsp, 1);            GSYNC();
#if FAST_TOPK
  ft::phase_topk(p, ldsp, 1);         GSYNC();
#ifdef DUP_TOPK1
  ft::phase_topk(p, ldsp, 1);         GSYNC();
#endif
#else
  nv::phase_topk(p, lds, 1);          GSYNC();
  fg::phase_gather(p, 1);             GSYNC();
#endif
#if FAST_GEMM
  fg::phase_moe_up8(p, ldsp, 1);      GSYNC();
  fg::phase_moe_down8(p, ldsp, 1);    GSYNC();
#else
  nv::phase_moe_up(p, lds, 1);        GSYNC();
  nv::phase_moe_down(p, lds, 1);      GSYNC();
#endif
  fr::phase_combine(p, 1);
}


extern "C" void kernel_launch(void* const* d_in, const int* in_sizes, int n_in, void* d_out, int out_size,
                              void* d_ws, size_t ws_size, hipStream_t stream) {
  static int grid_blocks = 0;
  if (!grid_blocks) {
    int dev = 0, cus = 0, per_cu = 0;
    (void)hipGetDevice(&dev);
    (void)hipDeviceGetAttribute(&cus, hipDeviceAttributeMultiprocessorCount, dev);
    (void)hipFuncSetAttribute((const void*)mega, hipFuncAttributeMaxDynamicSharedMemorySize, LDS_BYTES);
    (void)hipOccupancyMaxActiveBlocksPerMultiprocessor(&per_cu, (const void*)mega, NT, LDS_BYTES);
    if (per_cu < 1) { fprintf(stderr, "kernel_launch: occupancy query says %d blocks/CU\n", per_cu); per_cu = 1; }
    grid_blocks = cus;
    if (n_in != 43 || ws_size < WS_END) fprintf(stderr, "kernel_launch: unexpected n_in %d / ws_size %zu (need %zu)\n", n_in, ws_size, (size_t)WS_END);
  }
  Params p{};
  for (int i = 0; i < 43; ++i) p.in[i] = (const float*)d_in[i];
  p.out = (float*)d_out; p.ws = (unsigned char*)d_ws;
  void* args[] = {&p};
  hipError_t e = hipLaunchCooperativeKernel((void*)mega, dim3(grid_blocks), dim3(NT), args, LDS_BYTES, stream);
  if (e != hipSuccess) fprintf(stderr, "cooperative launch failed: %s (grid %d)\n", hipGetErrorString(e), grid_blocks);
}
```

```cpp
#include <hip/hip_runtime.h>
#include <hip/hip_cooperative_groups.h>
#include <cstdio>
#include <cstdint>
namespace cg = cooperative_groups;

typedef unsigned short bf16_t;
#define DEVI __device__ __forceinline__

constexpr int NT = 512, NWAVE = 8;
constexpr int NB = 8, SEQ = 4096, DM = 1024, CTXL = 256;
constexpr int NLAT = NB * SEQ, NCTX = NB * CTXL, NROW = NLAT + NCTX;
constexpr int NE = 16;
constexpr int CAP_L = 512, CAP_C = 32;
constexpr int EROWS0 = NB * CAP_L + NB * CAP_C;
constexpr int EROWS1 = NB * CAP_L;
constexpr int N_IN0 = 3072, N_IN1 = 2320, N_IN1P = 2560;
constexpr float EPS = 1e-6f;

constexpr size_t MiB = 1u << 20;
constexpr size_t WS_CTL = 0;
constexpr size_t WS_WIN0 = 1 * MiB;
constexpr size_t WS_WIN1 = 7 * MiB;
constexpr size_t WS_WOUT0 = 12 * MiB, WS_WOUT1 = 14 * MiB;
constexpr size_t WS_WGU = 16 * MiB;
constexpr size_t WS_WD = 80 * MiB;
constexpr size_t WS_XC = 112 * MiB;
constexpr size_t WS_H = 120 * MiB;
constexpr size_t WS_AFF = 188 * MiB;
constexpr size_t WS_SLOT = 191 * MiB;
constexpr size_t WS_IDX = 194 * MiB;
constexpr size_t WS_GATEV = 195 * MiB;
constexpr size_t WS_BIG = 196 * MiB;
constexpr size_t WS_QKV0 = WS_BIG;
constexpr size_t WS_ATT0 = WS_BIG + 204 * MiB;
constexpr size_t WS_MIX0 = WS_BIG + 272 * MiB;
constexpr size_t WS_XG = WS_BIG;
constexpr size_t WS_HID = WS_BIG + 136 * MiB;
constexpr size_t WS_Y = WS_BIG;
constexpr size_t WS_P1 = WS_BIG;
constexpr size_t WS_DT = WS_BIG + 153 * MiB;
constexpr size_t WS_U = WS_BIG + 156 * MiB;
constexpr size_t WS_MIX1 = WS_U;
constexpr size_t WS_ATT1 = WS_BIG + 224 * MiB;
constexpr size_t WS_YS = WS_BIG + 292 * MiB;
constexpr size_t WS_CUMG = WS_BIG + 356 * MiB;
constexpr size_t WS_DTG = WS_BIG + 359 * MiB;
constexpr size_t WS_VT = WS_BIG + 340 * MiB;
constexpr size_t WS_VTB = WS_BIG + 362 * MiB;
constexpr size_t WS_END = WS_BIG + 380 * MiB;
constexpr size_t CTL_MOD = 4096;
constexpr size_t CTL_ROPE = CTL_MOD + 2 * 9 * 6144 * 4;
constexpr size_t CTL_LAM = CTL_ROPE + 64 * 16 * 2 * 4;
constexpr size_t CTL_QC = CTL_LAM + 64;
constexpr size_t CTL_BAR = 512 * 1024;

struct Params {
  const float* in[43];
  float* out;
  unsigned char* ws;
};

enum {
  I_X = 0, I_C, I_CTX, I_CCTX,
  L0_WMOD, L0_BMOD, L0_GPREMIX, L0_GPOSTMIX, L0_GPREFFN, L0_GPOSTFFN, L0_WIN, L0_WOUT,
  L0_LAMQ1, L0_LAMK1, L0_LAMQ2, L0_LAMK2, L0_SUBLN, L0_RPB, L0_WROUTER, L0_WGATE, L0_WUP, L0_WDOWN,
  L1_WMOD, L1_BMOD, L1_GPREMIX, L1_GPOSTMIX, L1_GPREFFN, L1_GPOSTFFN, L1_WIN, L1_WOUT,
  L1_SINKS, L1_CONVW, L1_CONVB, L1_ALOGF, L1_ALOGB, L1_DTBF, L1_DTBB, L1_DSKIP, L1_GNORM,
  L1_WROUTER, L1_WGATE, L1_WUP, L1_WDOWN
};

DEVI int ftid() { int t = threadIdx.x; asm volatile("" : "+v"(t)); return t; }
DEVI float bf2f(bf16_t v) { return __uint_as_float(((unsigned)v) << 16); }
DEVI bf16_t f2bf(float f) { unsigned u = __float_as_uint(f); return (bf16_t)((u + 0x7fffu + ((u >> 16) & 1u)) >> 16); }
DEVI unsigned pk2(float lo, float hi) { return (unsigned)f2bf(lo) | ((unsigned)f2bf(hi) << 16); }
DEVI float silu_f(float v) { return v / (1.f + __expf(-v)); }
template <int CTRL> DEVI float dppf(float v) { return __uint_as_float((unsigned)__builtin_amdgcn_update_dpp(0, (int)__float_as_uint(v), CTRL, 0xf, 0xf, true)); }
constexpr int DPP_XOR1 = 0xB1, DPP_XOR2 = 0x4E, DPP_HMIRROR = 0x141, DPP_MIRROR = 0x140;
DEVI float wave_sum(float v) {
  v += dppf<DPP_XOR1>(v); v += dppf<DPP_XOR2>(v); v += dppf<DPP_HMIRROR>(v); v += dppf<DPP_MIRROR>(v);
  { const auto s = __builtin_amdgcn_permlane16_swap(__float_as_uint(v), __float_as_uint(v), false, false); v = __uint_as_float(s[0]) + __uint_as_float(s[1]); }
  { const auto s = __builtin_amdgcn_permlane32_swap(__float_as_uint(v), __float_as_uint(v), false, false); v = __uint_as_float(s[0]) + __uint_as_float(s[1]); }
  return v;
}
DEVI float half_sum(float v) {
  v += dppf<DPP_XOR1>(v); v += dppf<DPP_XOR2>(v); v += dppf<DPP_HMIRROR>(v); v += dppf<DPP_MIRROR>(v);
  { const auto s = __builtin_amdgcn_permlane16_swap(__float_as_uint(v), __float_as_uint(v), false, false); v = __uint_as_float(s[0]) + __uint_as_float(s[1]); }
  return v;
}
template <int CTRL, int ROWMASK> DEVI float dppf0(float v) { return __uint_as_float((unsigned)__builtin_amdgcn_update_dpp(0, (int)__float_as_uint(v), CTRL, ROWMASK, 0xf, false)); }
DEVI float wave_scan_incl(float v) {
  v += dppf0<0x111, 0xf>(v); v += dppf0<0x112, 0xf>(v); v += dppf0<0x114, 0xf>(v); v += dppf0<0x118, 0xf>(v);
  v += dppf0<0x142, 0xa>(v); v += dppf0<0x143, 0xc>(v);
  return v;
}
template <int CTRL, int ROWMASK> DEVI int dppi0(int v) { return __builtin_amdgcn_update_dpp(0, v, CTRL, ROWMASK, 0xf, false); }
DEVI int wave_scan_incl_i(int v) {
  v += dppi0<0x111, 0xf>(v); v += dppi0<0x112, 0xf>(v); v += dppi0<0x114, 0xf>(v); v += dppi0<0x118, 0xf>(v);
  v += dppi0<0x142, 0xa>(v); v += dppi0<0x143, 0xc>(v);
  return v;
}
DEVI float quad_sum(float v) {
  v += dppf<DPP_HMIRROR>(v); v += dppf<DPP_MIRROR>(v);
  { const auto s = __builtin_amdgcn_permlane16_swap(__float_as_uint(v), __float_as_uint(v), false, false); v = __uint_as_float(s[0]) + __uint_as_float(s[1]); }
  { const auto s = __builtin_amdgcn_permlane32_swap(__float_as_uint(v), __float_as_uint(v), false, false); v = __uint_as_float(s[0]) + __uint_as_float(s[1]); }
  return v;
}
DEVI float quad_max(float v) {
  v = fmaxf(v, dppf<DPP_HMIRROR>(v)); v = fmaxf(v, dppf<DPP_MIRROR>(v));
  { const auto s = __builtin_amdgcn_permlane16_swap(__float_as_uint(v), __float_as_uint(v), false, false); v = fmaxf(__uint_as_float(s[0]), __uint_as_float(s[1])); }
  { const auto s = __builtin_amdgcn_permlane32_swap(__float_as_uint(v), __float_as_uint(v), false, false); v = fmaxf(__uint_as_float(s[0]), __uint_as_float(s[1])); }
  return v;
}
DEVI float wave_max(float v) {
  v = fmaxf(v, dppf<DPP_XOR1>(v)); v = fmaxf(v, dppf<DPP_XOR2>(v)); v = fmaxf(v, dppf<DPP_HMIRROR>(v)); v = fmaxf(v, dppf<DPP_MIRROR>(v));
  { const auto s = __builtin_amdgcn_permlane16_swap(__float_as_uint(v), __float_as_uint(v), false, false); v = fmaxf(__uint_as_float(s[0]), __uint_as_float(s[1])); }
  { const auto s = __builtin_amdgcn_permlane32_swap(__float_as_uint(v), __float_as_uint(v), false, false); v = fmaxf(__uint_as_float(s[0]), __uint_as_float(s[1])); }
  return v;
}
DEVI int row_modrow(int r) { return r < NLAT ? (r >> 12) : 8; }
#ifndef QKV0_FP8
#define QKV0_FP8 1
#endif
#ifndef OUT_FP8
#define OUT_FP8 0
#endif
#ifndef QKV1_FP8
#define QKV1_FP8 1
#endif
namespace nv {

DEVI void transpose_item(const float* W, int K, int N, bf16_t* WT, int row_off, int row_mul, float* scr, int item, int lane, int Npad) {
  const int nblk = Npad / 32, kb = item / nblk, nb = item % nblk, k0 = 64 * kb, n0 = 32 * nb;
  const int n = n0 + (lane & 31); const bool ok = n < N;
  const float* src = W + (size_t)(k0 + (lane >> 5)) * N + (ok ? n : 0);
  float v[32];
#pragma unroll
  for (int i = 0; i < 32; ++i) v[i] = src[(size_t)(2 * i) * N];
#pragma unroll
  for (int i = 0; i < 32; ++i) scr[(2 * i + (lane >> 5)) * 33 + (lane & 31)] = ok ? v[i] : 0.f;
  __builtin_amdgcn_s_waitcnt(0); __builtin_amdgcn_wave_barrier();
  const int c = lane & 7;
#pragma unroll
  for (int j = 0; j < 4; ++j) {
    const int nn = (lane >> 3) + 8 * j; const float* s = scr + (8 * c) * 33 + nn;
    uint4 o; o.x = pk2(s[0 * 33], s[1 * 33]); o.y = pk2(s[2 * 33], s[3 * 33]); o.z = pk2(s[4 * 33], s[5 * 33]); o.w = pk2(s[6 * 33], s[7 * 33]);
    *(uint4*)(WT + (size_t)(row_off + (n0 + nn) * row_mul) * K + k0 + 8 * c) = o;
  }
  __builtin_amdgcn_s_waitcnt(0); __builtin_amdgcn_wave_barrier();
}

DEVI void convert_moe_part(const Params& p, int layer, int which, float* scr, int gw, int NGW, int lane) {
  const float* wg = p.in[layer ? L1_WGATE : L0_WGATE]; const float* wu = p.in[layer ? L1_WUP : L0_WUP]; const float* wd = p.in[layer ? L1_WDOWN : L0_WDOWN];
  bf16_t* WGU = (bf16_t*)(p.ws + WS_WGU); bf16_t* WD = (bf16_t*)(p.ws + WS_WD);
  constexpr int IPM = 16 * 32;
  if (which == 0) {
    for (int it = gw; it < NE * 2 * IPM; it += NGW) {
      const int e = it / (2 * IPM), r = it % (2 * IPM), gu = r / IPM, item = r % IPM;
      transpose_item((gu ? wu : wg) + (size_t)e * DM * DM, DM, DM, WGU + (size_t)e * 2048 * DM, gu, 2, scr, item, lane, DM);
    }
  } else {
    for (int it = gw; it < NE * IPM; it += NGW) {
      const int e = it / IPM, item = it % IPM;
      transpose_item(wd + (size_t)e * DM * DM, DM, DM, WD + (size_t)e * DM * DM, 0, 1, scr, item, lane, DM);
    }
  }
}
DEVI void convert_moe_tail(const Params& p, int layer, int which, float* lds, int nunits) {
  const int first = nunits % (int)gridDim.x;
  if ((int)blockIdx.x < first) return;
  const int w = ftid() >> 6;
  convert_moe_part(p, layer, which, lds + w * (64 * 33), ((int)blockIdx.x - first) * NWAVE + w, ((int)gridDim.x - first) * NWAVE, ftid() & 63);
}


constexpr float W8_SCALE = 64.f, A8_SCALE = 4.f;
constexpr int W8_E8M0 = 0x79797979, A8_E8M0 = 0x7d7d7d7d;
DEVI unsigned pack4_fp8(float a, float b, float c, float d) {
  a = fminf(fmaxf(a, -448.f), 448.f); b = fminf(fmaxf(b, -448.f), 448.f); c = fminf(fmaxf(c, -448.f), 448.f); d = fminf(fmaxf(d, -448.f), 448.f);
  int w = 0; w = __builtin_amdgcn_cvt_pk_fp8_f32(a, b, w, false); w = __builtin_amdgcn_cvt_pk_fp8_f32(c, d, w, true); return (unsigned)w; }
DEVI void transpose_item8(const float* W, int K, int N, unsigned char* WT, int row_off, int row_mul, float* scr, int item, int lane, int Npad = 0) {
  if (Npad == 0) Npad = N;
  const int nblk = Npad / 32, kb = item / nblk, nb = item % nblk, k0 = 64 * kb, n0 = 32 * nb;
  const int nn0 = n0 + (lane & 31); const bool ok = nn0 < N;
  const float* src = W + (size_t)(k0 + (lane >> 5)) * N + (ok ? nn0 : 0);
  float v[32];
#pragma unroll
  for (int i = 0; i < 32; ++i) v[i] = src[(size_t)(2 * i) * N];
#pragma unroll
  for (int i = 0; i < 32; ++i) scr[(2 * i + (lane >> 5)) * 33 + (lane & 31)] = ok ? v[i] * W8_SCALE : 0.f;
  __builtin_amdgcn_s_waitcnt(0); __builtin_amdgcn_wave_barrier();
  const int c = lane & 7;
#pragma unroll
  for (int j = 0; j < 4; ++j) {
    const int nn = (lane >> 3) + 8 * j; const float* s = scr + (8 * c) * 33 + nn;
    uint2 o; o.x = pack4_fp8(s[0 * 33], s[1 * 33], s[2 * 33], s[3 * 33]); o.y = pack4_fp8(s[4 * 33], s[5 * 33], s[6 * 33], s[7 * 33]);
    *(uint2*)(WT + (size_t)(row_off + (n0 + nn) * row_mul) * K + k0 + 8 * c) = o;
  }
  __builtin_amdgcn_s_waitcnt(0); __builtin_amdgcn_wave_barrier();
}
DEVI void convert_moe_part8(const Params& p, int layer, int which, float* scr, int gw, int NGW, int lane) {
  const float* wg = p.in[layer ? L1_WGATE : L0_WGATE]; const float* wu = p.in[layer ? L1_WUP : L0_WUP]; const float* wd = p.in[layer ? L1_WDOWN : L0_WDOWN];
  unsigned char* WGU = (unsigned char*)(p.ws + WS_WGU); unsigned char* WD = (unsigned char*)(p.ws + WS_WD);
  constexpr int IPM = 16 * 32;
  if (which == 0) {
    for (int it = gw; it < NE * 2 * IPM; it += NGW) { const int e = it / (2 * IPM), r = it % (2 * IPM), gu = r / IPM, item = r % IPM;
      transpose_item8((gu ? wu : wg) + (size_t)e * DM * DM, DM, DM, WGU + (size_t)e * 2048 * DM, gu, 2, scr, item, lane); }
  } else {
    for (int it = gw; it < NE * IPM; it += NGW) { const int e = it / IPM, item = it % IPM;
      transpose_item8(wd + (size_t)e * DM * DM, DM, DM, WD + (size_t)e * DM * DM, 0, 1, scr, item, lane); }
  }
}
DEVI void convert_moe_tail8(const Params& p, int layer, int which, float* lds, int nunits) {
  const int first = nunits % (int)gridDim.x;
  if ((int)blockIdx.x < first) return;
  const int w = ftid() >> 6;
  convert_moe_part8(p, layer, which, lds + w * (64 * 33), ((int)blockIdx.x - first) * NWAVE + w, ((int)gridDim.x - first) * NWAVE, ftid() & 63);
}

DEVI void phase0(const Params& p, float* lds) {
  const int tid = ftid(), lane = tid & 63, wave = tid >> 6;
  const int gw = blockIdx.x * NWAVE + wave, NGW = gridDim.x * NWAVE;
  for (int it = blockIdx.x; it < 2 * 96; it += gridDim.x) {
    const int layer = it / 96, j0 = (it % 96) * 64;
    float* sc = lds;
    float* red = lds + 9 * 1024;
    __syncthreads();
    for (int i = tid; i < 9 * 1024; i += NT) { const int r = i >> 10, k = i & 1023; const float v = (r < 8) ? p.in[I_C][r * 1024 + k] : p.in[I_CCTX][k]; sc[i] = silu_f(v); }
    __syncthreads();
    const float* wm = p.in[layer ? L1_WMOD : L0_WMOD];
    float acc[9];
#pragma unroll
    for (int r = 0; r < 9; ++r) acc[r] = 0.f;
    for (int k0 = wave * 128; k0 < wave * 128 + 128; k0 += 16) {
      float w[16];
#pragma unroll
      for (int i = 0; i < 16; ++i) w[i] = wm[(size_t)(k0 + i) * 6144 + j0 + lane];
#pragma unroll
      for (int i = 0; i < 16; ++i)
#pragma unroll
        for (int r = 0; r < 9; ++r) acc[r] += sc[r * 1024 + k0 + i] * w[i];
    }
#pragma unroll
    for (int r = 0; r < 9; ++r) red[(wave * 9 + r) * 64 + lane] = acc[r];
    __syncthreads();
    for (int i = tid; i < 9 * 64; i += NT) {
      const int r = i >> 6, c = i & 63; float s = 0.f;
      for (int w = 0; w < 8; ++w) s += red[(w * 9 + r) * 64 + c];
      float* MOD = (float*)(p.ws + WS_CTL + CTL_MOD);
      MOD[(layer * 9 + r) * 6144 + j0 + c] = s + p.in[layer ? L1_BMOD : L0_BMOD][j0 + c];
    }
    __syncthreads();
  }
  if (blockIdx.x == gridDim.x - 1) {
    float* ROPE = (float*)(p.ws + WS_CTL + CTL_ROPE);
    for (int i = tid; i < 64 * 16; i += NT) {
      const int pos = i >> 4, f = i & 15;
      const float inv = powf(10000.f, -(float)f / 16.f);
      const float ang = (float)pos * inv;
      ROPE[2 * i] = cosf(ang); ROPE[2 * i + 1] = sinf(ang);
    }
    if (wave == 0) {
      float a = p.in[L0_LAMQ1][lane] * p.in[L0_LAMK1][lane], b = p.in[L0_LAMQ2][lane] * p.in[L0_LAMK2][lane];
      a = wave_sum(a); b = wave_sum(b);
      if (lane == 0) { float* LAM = (float*)(p.ws + WS_CTL + CTL_LAM); LAM[0] = expf(a) - expf(b) + 0.2f; *(int*)(p.ws + WS_CTL + CTL_QC) = 0; }
    }
  }
  __syncthreads();
  float* scr = lds + wave * (64 * 33);
  {
    constexpr int I_IN0 = 16 * (N_IN0 / 32), I_OUT = 16 * 32, I_IN1 = 16 * (N_IN1P / 32);
    constexpr int NITEMS = I_IN0 + I_OUT + I_IN1 + I_OUT;
    for (int it = gw; it < NITEMS; it += NGW) {
      int r = it;
      if (r < I_IN0) { if (QKV0_FP8) transpose_item8(p.in[L0_WIN], DM, N_IN0, (unsigned char*)(p.ws + WS_WIN0), 0, 1, scr, r, lane); else transpose_item(p.in[L0_WIN], DM, N_IN0, (bf16_t*)(p.ws + WS_WIN0), 0, 1, scr, r, lane, N_IN0); continue; } r -= I_IN0;
      if (r < I_OUT) { if (OUT_FP8) transpose_item8(p.in[L0_WOUT], DM, DM, (unsigned char*)(p.ws + WS_WOUT0), 0, 1, scr, r, lane); else transpose_item(p.in[L0_WOUT], DM, DM, (bf16_t*)(p.ws + WS_WOUT0), 0, 1, scr, r, lane, DM); continue; } r -= I_OUT;
      if (r < I_IN1) { if (QKV1_FP8) transpose_item8(p.in[L1_WIN], DM, N_IN1, (unsigned char*)(p.ws + WS_WIN1), 0, 1, scr, r, lane, N_IN1P); else transpose_item(p.in[L1_WIN], DM, N_IN1, (bf16_t*)(p.ws + WS_WIN1), 0, 1, scr, r, lane, N_IN1P); continue; } r -= I_IN1;
      if (OUT_FP8) transpose_item8(p.in[L1_WOUT], DM, DM, (unsigned char*)(p.ws + WS_WOUT1), 0, 1, scr, r, lane); else transpose_item(p.in[L1_WOUT], DM, DM, (bf16_t*)(p.ws + WS_WOUT1), 0, 1, scr, r, lane, DM);
    }
  }
  convert_moe_part8(p, 0, 0, scr, gw, NGW, lane);
#ifndef TAILFILL
  convert_moe_part8(p, 0, 1, scr, gw, NGW, lane);
#endif
}

struct Row16 { float4 v[4]; };
DEVI Row16 ld_row_f32(const float* r, int lane) { Row16 o; const float4* q = (const float4*)r + lane;
#pragma unroll
  for (int j = 0; j < 4; ++j) o.v[j] = q[64 * j]; return o; }
DEVI Row16 ld_row_bf16(const bf16_t* r, int lane) { Row16 o; const uint2* q = (const uint2*)r + lane;
#pragma unroll
  for (int j = 0; j < 4; ++j) { const uint2 w = q[64 * j]; o.v[j] = make_float4(__uint_as_float(w.x << 16), __uint_as_float(w.x & 0xffff0000u), __uint_as_float(w.y << 16), __uint_as_float(w.y & 0xffff0000u)); }
  return o; }
DEVI void st_row_f32(float* r, int lane, const Row16& o) { float4* q = (float4*)r + lane;
#pragma unroll
  for (int j = 0; j < 4; ++j) q[64 * j] = o.v[j]; }
DEVI void st_row_bf16(bf16_t* r, int lane, const Row16& o) { uint2* q = (uint2*)r + lane;
#pragma unroll
  for (int j = 0; j < 4; ++j) q[64 * j] = make_uint2(pk2(o.v[j].x, o.v[j].y), pk2(o.v[j].z, o.v[j].w)); }
DEVI float row_sumsq(const Row16& o) { float s = 0.f;
#pragma unroll
  for (int j = 0; j < 4; ++j) s += o.v[j].x * o.v[j].x + o.v[j].y * o.v[j].y + o.v[j].z * o.v[j].z + o.v[j].w * o.v[j].w;
  return wave_sum(s); }
#define ROW_FOR4(expr) _Pragma("unroll") for (int j = 0; j < 4; ++j) { { float& e = o.v[j].x; const float a = A.v[j].x, b = Bv.v[j].x, c = Cv.v[j].x; expr; } { float& e = o.v[j].y; const float a = A.v[j].y, b = Bv.v[j].y, c = Cv.v[j].y; expr; } { float& e = o.v[j].z; const float a = A.v[j].z, b = Bv.v[j].z, c = Cv.v[j].z; expr; } { float& e = o.v[j].w; const float a = A.v[j].w, b = Bv.v[j].w, c = Cv.v[j].w; expr; } }

DEVI Row16 norm_mod(const Row16& x, const float* g, const float* sc, const float* sh, int lane) {
  const float r = rsqrtf(row_sumsq(x) * (1.f / DM) + EPS);
  Row16 o = x; const Row16 A = ld_row_f32(g, lane), Bv = ld_row_f32(sc, lane), Cv = ld_row_f32(sh, lane);
  ROW_FOR4(e = e * r * a * (1.f + b) + c);
  return o;
}

DEVI void phase_prenorm0(const Params& p) {
  const int lane = ftid() & 63, gw = blockIdx.x * NWAVE + (ftid() >> 6), NGW = gridDim.x * NWAVE;
  const float* MOD = (const float*)(p.ws + WS_CTL + CTL_MOD);
  bf16_t* H = (bf16_t*)(p.ws + WS_H);
  for (int r = gw; r < NROW; r += NGW) {
    const float* src = r < NLAT ? p.in[I_X] + (size_t)r * DM : p.in[I_CTX] + (size_t)(r - NLAT) * DM;
    const float* m = MOD + (size_t)row_modrow(r) * 6144;
    const Row16 x = ld_row_f32(src, lane);
    const Row16 h = norm_mod(x, p.in[L0_GPREMIX], m + 1024, m, lane);
    st_row_bf16(H + (size_t)r * DM, lane, h);
  }
}

template <class AF, class EF>
DEVI void gemm_tile(float* lds, const bf16_t* Bt, int n0, int K, AF arow, EF epi) {
  const int tid = ftid(), ty = tid >> 4, tx = tid & 15;
  float (*As)[132] = (float (*)[132])lds;
  float (*Bs)[68] = (float (*)[68])(lds + 16 * 132);
  float acc[4][4];
#pragma unroll
  for (int i = 0; i < 4; ++i)
#pragma unroll
    for (int j = 0; j < 4; ++j) acc[i][j] = 0.f;
  const int ar = tid >> 2, ak = (tid & 3) * 4;
  const int br = tid >> 3, bk = (tid & 7) * 2;
  const bf16_t* ap = arow(ar) + ak;
  const bf16_t* bp = Bt + (size_t)(n0 + br) * K + bk;
  for (int k0 = 0; k0 < K; k0 += 16) {
    const uint2 av = *(const uint2*)(ap + k0);
    const unsigned bv = *(const unsigned*)(bp + k0);
    __syncthreads();
    As[ak + 0][ar] = __uint_as_float(av.x << 16); As[ak + 1][ar] = __uint_as_float(av.x & 0xffff0000u);
    As[ak + 2][ar] = __uint_as_float(av.y << 16); As[ak + 3][ar] = __uint_as_float(av.y & 0xffff0000u);
    Bs[bk + 0][br] = __uint_as_float(bv << 16); Bs[bk + 1][br] = __uint_as_float(bv & 0xffff0000u);
    __syncthreads();
#pragma unroll
    for (int kk = 0; kk < 16; ++kk) {
      const float4 a = *(const float4*)&As[kk][ty * 4]; const float4 b = *(const float4*)&Bs[kk][tx * 4];
      const float aa[4] = {a.x, a.y, a.z, a.w}, bb[4] = {b.x, b.y, b.z, b.w};
#pragma unroll
      for (int i = 0; i < 4; ++i)
#pragma unroll
        for (int j = 0; j < 4; ++j) acc[i][j] += aa[i] * bb[j];
    }
  }
#pragma unroll
  for (int i = 0; i < 4; ++i) epi(ty * 4 + i, n0 + tx * 4, acc[i]);
}

DEVI void rope_pair(const float* ROPE, int t, int d, float& u1, float& u2) {
  const int i = d >> 1, f = i & 15, pos = (i < 16) ? (t >> 6) : (t & 63);
  const float cs = ROPE[(pos * 16 + f) * 2], sn = ROPE[(pos * 16 + f) * 2 + 1];
  const float a = u1 * cs - u2 * sn, b = u1 * sn + u2 * cs; u1 = a; u2 = b;
}

DEVI void phase_qkv0(const Params& p, float* lds) {
  const bf16_t* H = (const bf16_t*)(p.ws + WS_H); const bf16_t* W = (const bf16_t*)(p.ws + WS_WIN0);
  bf16_t* Q = (bf16_t*)(p.ws + WS_QKV0); const float* ROPE = (const float*)(p.ws + WS_CTL + CTL_ROPE);
  constexpr int NTN = N_IN0 / 64, NTM = NROW / 128;
  for (int it = blockIdx.x; it < NTN * NTM; it += gridDim.x) {
    const int mt = it / NTN, nt = it % NTN, m0 = mt * 128;
    gemm_tile(lds, W, nt * 64, DM,
      [&](int r) { return H + (size_t)(m0 + r) * DM; },
      [&](int r, int n, float* v) {
        const int row = m0 + r;
        if (row < NLAT && n < 1024) { const int t = row & 4095; rope_pair(ROPE, t, n & 63, v[0], v[1]); rope_pair(ROPE, t, (n + 2) & 63, v[2], v[3]); }
        *(uint2*)(Q + (size_t)row * N_IN0 + n) = make_uint2(pk2(v[0], v[1]), pk2(v[2], v[3]));
      });
  }
}

template <int NS, int VJ, class KF>
DEVI void wave_attn(const float* qs, float* pl  , int* rl  , int nkeys, KF kf, const bf16_t* KV, int ld, int kcol, int vcol,
                    float sink, bool has_sink, float (&o)[NS][VJ], float (&m)[NS], float (&l)[NS], int lane) {
#pragma unroll
  for (int s = 0; s < NS; ++s) { m[s] = -INFINITY; l[s] = 0.f;
#pragma unroll
    for (int j = 0; j < VJ; ++j) o[s][j] = 0.f; }
  for (int c0 = 0; c0 < nkeys; c0 += 64) {
    const int kidx = c0 + lane; int row = -1; float bias = 0.f;
    bool valid = kidx < nkeys; if (valid) valid = kf(kidx, row, bias);
    const int rr = valid ? row : 0;
    rl[lane] = valid ? row : -1;
    float sc[NS];
#pragma unroll
    for (int s = 0; s < NS; ++s) {
      const uint4* kp = (const uint4*)(KV + (size_t)rr * ld + kcol + 64 * s); float d = 0.f;
#pragma unroll
      for (int i = 0; i < 8; ++i) { const uint4 w = kp[i]; const float* q = qs + s * 64 + i * 8;
        d += q[0] * __uint_as_float(w.x << 16) + q[1] * __uint_as_float(w.x & 0xffff0000u) + q[2] * __uint_as_float(w.y << 16) + q[3] * __uint_as_float(w.y & 0xffff0000u)
           + q[4] * __uint_as_float(w.z << 16) + q[5] * __uint_as_float(w.z & 0xffff0000u) + q[6] * __uint_as_float(w.w << 16) + q[7] * __uint_as_float(w.w & 0xffff0000u); }
      sc[s] = valid ? d + bias : -INFINITY;
    }
#pragma unroll
    for (int s = 0; s < NS; ++s) {
      const float cm = wave_max(sc[s]); const float mn = fmaxf(m[s], cm);
      float pv = 0.f, scale = 1.f;
      if (mn > -INFINITY) { pv = __expf(sc[s] - mn); scale = __expf(m[s] - mn); }
      l[s] = l[s] * scale + wave_sum(pv); m[s] = mn;
#pragma unroll
      for (int j = 0; j < VJ; ++j) o[s][j] *= scale;
      pl[s * 64 + lane] = pv;
    }
    __builtin_amdgcn_s_waitcnt(0); __builtin_amdgcn_wave_barrier();
    for (int kk = 0; kk < 64; ++kk) {
      const int rk = rl[kk]; if (rk < 0) continue;
      const bf16_t* vp = KV + (size_t)rk * ld + vcol + lane;
      float vv[VJ];
#pragma unroll
      for (int j = 0; j < VJ; ++j) vv[j] = bf2f(vp[64 * j]);
#pragma unroll
      for (int s = 0; s < NS; ++s) { const float pk = pl[s * 64 + kk];
#pragma unroll
        for (int j = 0; j < VJ; ++j) o[s][j] += pk * vv[j]; }
    }
    __builtin_amdgcn_s_waitcnt(0); __builtin_amdgcn_wave_barrier();
  }
  if (has_sink) {
#pragma unroll
    for (int s = 0; s < NS; ++s) { const float mn = fmaxf(m[s], sink); const float scale = __expf(m[s] - mn);
      l[s] = l[s] * scale + __expf(sink - mn); m[s] = mn;
#pragma unroll
      for (int j = 0; j < VJ; ++j) o[s][j] *= scale; }
  }
}

DEVI void phase_attn0(const Params& p, float* lds) {
  const int tid = ftid(), lane = tid & 63, wave = tid >> 6;
  const int gw = blockIdx.x * NWAVE + wave, NGW = gridDim.x * NWAVE;
  const bf16_t* Q = (const bf16_t*)(p.ws + WS_QKV0); bf16_t* ATT = (bf16_t*)(p.ws + WS_ATT0);
  const float lam = ((const float*)(p.ws + WS_CTL + CTL_LAM))[0];
  float* qs = lds + wave * 128; float* pl = lds + 1024 + wave * 128; int* rl = (int*)(lds + 2048) + wave * 64;
  for (long it = gw; it < (long)NROW * 12; it += NGW) {
    const int row = (int)(it / 12), hs = (int)(it % 12);
    const bool lat = row < NLAT; const int b = lat ? (row >> 12) : ((row - NLAT) >> 8), t = lat ? (row & 4095) : 0;
    __builtin_amdgcn_s_waitcnt(0); __builtin_amdgcn_wave_barrier();
    if (hs < 4) {
      const bf16_t* qp = Q + (size_t)row * N_IN0 + hs * 128;
      qs[lane] = bf2f(qp[lane]) * 0.125f; qs[64 + lane] = bf2f(qp[64 + lane]) * 0.125f;
      __builtin_amdgcn_s_waitcnt(0); __builtin_amdgcn_wave_barrier();
      float o[2][2], m[2], l[2];
      const int nkeys = lat ? SEQ + CTXL : CTXL;
      wave_attn<2, 2>(qs, pl, rl, nkeys, [&](int k, int& r, float& bias) { r = lat ? (k < SEQ ? b * SEQ + k : NLAT + b * CTXL + (k - SEQ)) : NLAT + b * CTXL + k; return true; },
                      Q, N_IN0, 512 + hs * 128, 1024 + hs * 128, 0.f, false, o, m, l, lane);
      float v0 = o[0][0] / l[0] - lam * o[1][0] / l[1], v1 = o[0][1] / l[0] - lam * o[1][1] / l[1];
      const float r = rsqrtf(wave_sum(v0 * v0 + v1 * v1) * (1.f / 128.f) + EPS);
      const float* g = p.in[L0_SUBLN];
      ATT[(size_t)row * DM + hs * 128 + lane] = f2bf(v0 * r * g[lane] * 0.8f);
      ATT[(size_t)row * DM + hs * 128 + 64 + lane] = f2bf(v1 * r * g[64 + lane] * 0.8f);
    } else {
      const int h = hs - 4;
      qs[lane] = bf2f(Q[(size_t)row * N_IN0 + 1536 + h * 64 + lane]) * 0.125f;
      __builtin_amdgcn_s_waitcnt(0); __builtin_amdgcn_wave_barrier();
      float o[1][1], m[1], l[1];
      const int qr = t >> 6, qc = t & 63;
      const int rs = min(max(qr - 4, 0), 56), cs = min(max(qc - 8, 0), 48);
      const float* rpb = p.in[L0_RPB] + h * 15 * 31;
      const int nkeys = lat ? 128 + CTXL : CTXL;
      wave_attn<1, 1>(qs, pl, rl, nkeys, [&](int k, int& r, float& bias) {
          if (!lat) { r = NLAT + b * CTXL + k; return true; }
          if (k < 128) { const int kr = rs + (k >> 4), kc = cs + (k & 15); r = b * SEQ + kr * 64 + kc; bias = rpb[(kr - qr + 7) * 31 + (kc - qc + 15)]; }
          else r = NLAT + b * CTXL + (k - 128);
          return true; },
        Q, N_IN0, 2048 + h * 64, 2560 + h * 64, 0.f, false, o, m, l, lane);
      ATT[(size_t)row * DM + 512 + h * 64 + lane] = f2bf(o[0][0] / l[0]);
    }
  }
}

DEVI void phase_outproj(const Params& p, float* lds, int layer) {
  const bf16_t* A = (const bf16_t*)(p.ws + (layer ? WS_ATT1 : WS_ATT0)); const bf16_t* W = (const bf16_t*)(p.ws + (layer ? WS_WOUT1 : WS_WOUT0));
  bf16_t* MIX = (bf16_t*)(p.ws + (layer ? WS_MIX1 : WS_MIX0));
  const int NTM = (layer ? NLAT : NROW) / 128; constexpr int NTN = DM / 64;
  for (int it = blockIdx.x; it < NTN * NTM; it += gridDim.x) {
    const int mt = it / NTN, nt = it % NTN, m0 = mt * 128;
    gemm_tile(lds, W, nt * 64, DM, [&](int r) { return A + (size_t)(m0 + r) * DM; },
      [&](int r, int n, float* v) { *(uint2*)(MIX + (size_t)(m0 + r) * DM + n) = make_uint2(pk2(v[0], v[1]), pk2(v[2], v[3])); });
  }
}

DEVI void phase_postmix(const Params& p, int layer) {
  const int lane = ftid() & 63, gw = blockIdx.x * NWAVE + (ftid() >> 6), NGW = gridDim.x * NWAVE;
  const float* MOD = (const float*)(p.ws + WS_CTL + CTL_MOD) + (size_t)layer * 9 * 6144;
  const bf16_t* MIX = (const bf16_t*)(p.ws + (layer ? WS_MIX1 : WS_MIX0));
  bf16_t* H = (bf16_t*)(p.ws + WS_H); float* AFF = (float*)(p.ws + WS_AFF); float* XC = (float*)(p.ws + WS_XC);
  const float* gpost = p.in[layer ? L1_GPOSTMIX : L0_GPOSTMIX]; const float* gpre = p.in[layer ? L1_GPREFFN : L0_GPREFFN];
  const float* wr = p.in[layer ? L1_WROUTER : L0_WROUTER];
  const int nrow = layer ? NLAT : NROW;
  for (int r = gw; r < nrow; r += NGW) {
    const float* m = MOD + (size_t)row_modrow(r) * 6144;
    const float* xin = layer ? (p.out + (size_t)r * DM) : (r < NLAT ? p.in[I_X] + (size_t)r * DM : p.in[I_CTX] + (size_t)(r - NLAT) * DM);
    float* xout = r < NLAT ? p.out + (size_t)r * DM : XC + (size_t)(r - NLAT) * DM;
    Row16 o = ld_row_bf16(MIX + (size_t)r * DM, lane);
    const float rr = rsqrtf(row_sumsq(o) * (1.f / DM) + EPS);
    { const Row16 A = ld_row_f32(gpost, lane), Bv = ld_row_f32(m + 2048, lane), Cv = ld_row_f32(xin, lane);
      ROW_FOR4(e = c + b * (e * rr * a)); }
    st_row_f32(xout, lane, o);
    const Row16 h = norm_mod(o, gpre, m + 4096, m + 3072, lane);
    st_row_bf16(H + (size_t)r * DM, lane, h);
    float lg[16];
#pragma unroll
    for (int e = 0; e < 16; ++e) lg[e] = 0.f;
#pragma unroll
    for (int j = 0; j < 4; ++j) {
      const float hv[4] = {h.v[j].x, h.v[j].y, h.v[j].z, h.v[j].w};
#pragma unroll
      for (int q = 0; q < 4; ++q) { const float4* w4 = (const float4*)(wr + (size_t)(lane * 4 + 256 * j + q) * 16);
#pragma unroll
        for (int e4 = 0; e4 < 4; ++e4) { const float4 w = w4[e4]; lg[e4 * 4] += hv[q] * w.x; lg[e4 * 4 + 1] += hv[q] * w.y; lg[e4 * 4 + 2] += hv[q] * w.z; lg[e4 * 4 + 3] += hv[q] * w.w; } }
    }
    float mx = -INFINITY;
#pragma unroll
    for (int e = 0; e < 16; ++e) { lg[e] = wave_sum(lg[e]); mx = fmaxf(mx, lg[e]); }
    float s = 0.f;
#pragma unroll
    for (int e = 0; e < 16; ++e) { lg[e] = expf(lg[e] - mx); s += lg[e]; }
    const float inv = 1.f / s;
    float mine = 0.f;
#pragma unroll
    for (int e = 0; e < 16; ++e) if (lane == e) mine = lg[e] * inv;
    if (lane < 16) AFF[(size_t)lane * NROW + r] = mine;
  }
}

DEVI void phase_topk(const Params& p, float* lds, int layer) {
  const int tid = ftid();
  const float* AFF = (const float*)(p.ws + WS_AFF); int* SLOT = (int*)(p.ws + WS_SLOT); int* IDX = (int*)(p.ws + WS_IDX); float* GV = (float*)(p.ws + WS_GATEV);
  const int erows = layer ? EROWS1 : EROWS0;
  const int nlat_items = NB * NE * 8, nitems = nlat_items + (layer ? 0 : NB * NE);
  for (int it = blockIdx.x; it < nitems; it += gridDim.x) {
    const bool lat = it < nlat_items;
    int b, e, ch, n, cap, row0, slot0;
    if (lat) { b = it / (NE * 8); e = (it / 8) % NE; ch = it % 8; n = SEQ; cap = CAP_L; row0 = b * SEQ; slot0 = b * CAP_L; }
    else { const int i2 = it - nlat_items; b = i2 / NE; e = i2 % NE; ch = 0; n = CTXL; cap = CAP_C; row0 = NLAT + b * CTXL; slot0 = NB * CAP_L + b * CAP_C; }
    __syncthreads();
    for (int i = tid; i < n; i += NT) lds[i] = AFF[(size_t)e * NROW + row0 + i];
    __syncthreads();
    const int t = ch * 512 + tid;
    if (t < n) {
      const float a = lds[t]; int rank = 0;
      for (int j = 0; j < n; ++j) { const float v = lds[j]; rank += (v > a || (v == a && j < t)) ? 1 : 0; }
      if (rank < cap) { IDX[e * erows + slot0 + rank] = row0 + t; GV[e * erows + slot0 + rank] = a; SLOT[(size_t)(row0 + t) * 16 + e] = slot0 + rank; }
      else SLOT[(size_t)(row0 + t) * 16 + e] = -1;
    }
  }
}

DEVI void phase_moe_up(const Params& p, float* lds, int layer) {
  const bf16_t* H = (const bf16_t*)(p.ws + WS_H); const bf16_t* WGU = (const bf16_t*)(p.ws + WS_WGU); bf16_t* HID = (bf16_t*)(p.ws + WS_HID);
  const int* IDX = (const int*)(p.ws + WS_IDX);
  const int erows = layer ? EROWS1 : EROWS0, NTM = erows / 128; constexpr int NTN = 2048 / 64;
  for (int it = blockIdx.x; it < NE * NTM * NTN; it += gridDim.x) {
    const int e = it / (NTM * NTN), r2 = it % (NTM * NTN), mt = r2 / NTN, nt = r2 % NTN, m0 = mt * 128;
    gemm_tile(lds, WGU + (size_t)e * 2048 * DM, nt * 64, DM, [&](int r) { return H + (size_t)IDX[e * erows + m0 + r] * DM; },
      [&](int r, int n, float* v) { *(unsigned*)(HID + ((size_t)e * erows + m0 + r) * DM + (n >> 1)) = pk2(silu_f(v[0]) * v[1], silu_f(v[2]) * v[3]); });
  }
}
DEVI void phase_moe_down(const Params& p, float* lds, int layer) {
  const bf16_t* HID = (const bf16_t*)(p.ws + WS_HID); const bf16_t* WD = (const bf16_t*)(p.ws + WS_WD); bf16_t* Y = (bf16_t*)(p.ws + WS_Y);
  const float* GV = (const float*)(p.ws + WS_GATEV);
  const int erows = layer ? EROWS1 : EROWS0, NTM = erows / 128; constexpr int NTN = DM / 64;
  for (int it = blockIdx.x; it < NE * NTM * NTN; it += gridDim.x) {
    const int e = it / (NTM * NTN), r2 = it % (NTM * NTN), mt = r2 / NTN, nt = r2 % NTN, m0 = mt * 128;
    gemm_tile(lds, WD + (size_t)e * DM * DM, nt * 64, DM, [&](int r) { return HID + ((size_t)e * erows + m0 + r) * DM; },
      [&](int r, int n, float* v) { const float g = GV[e * erows + m0 + r];
        *(uint2*)(Y + ((size_t)e * erows + m0 + r) * DM + n) = make_uint2(pk2(v[0] * g, v[1] * g), pk2(v[2] * g, v[3] * g)); });
  }
}

DEVI void phase_combine(const Params& p, float* lds, int layer) {
  const int lane = ftid() & 63, wave = ftid() >> 6, gw = blockIdx.x * NWAVE + wave, NGW = gridDim.x * NWAVE;
  const float* MOD = (const float*)(p.ws + WS_CTL + CTL_MOD);
  const bf16_t* Y = (const bf16_t*)(p.ws + WS_Y); const int* SLOT = (const int*)(p.ws + WS_SLOT);
  bf16_t* H = (bf16_t*)(p.ws + WS_H); float* XC = (float*)(p.ws + WS_XC);
  const float* gpost = p.in[layer ? L1_GPOSTFFN : L0_GPOSTFFN];
  const int nrow = layer ? NLAT : NROW, erows = layer ? EROWS1 : EROWS0;
  for (int r = gw; r < nrow; r += NGW) {
    const float* m = MOD + (size_t)(layer * 9 + row_modrow(r)) * 6144;
    float* xio = r < NLAT ? p.out + (size_t)r * DM : XC + (size_t)(r - NLAT) * DM;
    Row16 o;
#pragma unroll
    for (int j = 0; j < 4; ++j) o.v[j] = make_float4(0.f, 0.f, 0.f, 0.f);
    for (int e = 0; e < NE; ++e) {
      const int s = SLOT[(size_t)r * 16 + e];
      if (s >= 0) { const Row16 y = ld_row_bf16(Y + ((size_t)e * erows + s) * DM, lane);
#pragma unroll
        for (int j = 0; j < 4; ++j) { o.v[j].x += y.v[j].x; o.v[j].y += y.v[j].y; o.v[j].z += y.v[j].z; o.v[j].w += y.v[j].w; } }
    }
    const float rr = rsqrtf(row_sumsq(o) * (1.f / DM) + EPS);
    { const Row16 A = ld_row_f32(gpost, lane), Bv = ld_row_f32(m + 5120, lane), Cv = ld_row_f32(xio, lane);
      ROW_FOR4(e = c + b * (e * rr * a)); }
    st_row_f32(xio, lane, o);
    if (layer == 0) {
      const float* m1 = MOD + (size_t)(9 + row_modrow(r)) * 6144;
      const Row16 h = norm_mod(o, p.in[L1_GPREMIX], m1 + 1024, m1, lane);
      st_row_bf16(H + (size_t)r * DM, lane, h);
    }
  }
  if (layer == 0) { convert_moe_part(p, 1, 0, lds + wave * (64 * 33), gw, NGW, lane); convert_moe_part(p, 1, 1, lds + wave * (64 * 33), gw, NGW, lane); }
}

DEVI void phase_qkv1(const Params& p, float* lds) {
  const bf16_t* H = (const bf16_t*)(p.ws + WS_H); const bf16_t* W = (const bf16_t*)(p.ws + WS_WIN1);
  bf16_t* P1 = (bf16_t*)(p.ws + WS_P1); float* DT = (float*)(p.ws + WS_DT); const float* ROPE = (const float*)(p.ws + WS_CTL + CTL_ROPE);
  constexpr int NTN = 37, NTM = NROW / 128;
  for (int it = blockIdx.x; it < NTN * NTM; it += gridDim.x) {
    const int mt = it / NTN, nt = it % NTN, m0 = mt * 128;
    gemm_tile(lds, W, nt * 64, DM, [&](int r) { return H + (size_t)(m0 + r) * DM; },
      [&](int r, int n, float* v) {
        const int row = m0 + r;
        if (n >= 2304) { if (n < 2320) *(float4*)(DT + (size_t)row * 16 + (n - 2304)) = make_float4(v[0], v[1], v[2], v[3]); return; }
        if (row < NLAT && n < 640) { const int t = row & 4095; rope_pair(ROPE, t, n & 63, v[0], v[1]); rope_pair(ROPE, t, (n + 2) & 63, v[2], v[3]); }
        *(uint2*)(P1 + (size_t)row * 2304 + n) = make_uint2(pk2(v[0], v[1]), pk2(v[2], v[3]));
      });
  }
}

DEVI void phase_conv_swa(const Params& p, float* lds, bool do_swa) {
  const int tid = ftid(), lane = tid & 63, wave = tid >> 6;
  const int gw = blockIdx.x * NWAVE + wave, NGW = gridDim.x * NWAVE;
  const bf16_t* P1 = (const bf16_t*)(p.ws + WS_P1); bf16_t* U = (bf16_t*)(p.ws + WS_U); bf16_t* ATT = (bf16_t*)(p.ws + WS_ATT1);
  const float* cw = p.in[L1_CONVW]; const float* cb = p.in[L1_CONVB];
  for (long i = (long)blockIdx.x * NT + tid; i < (long)NROW * 1024; i += (long)gridDim.x * NT) {
    const int row = (int)(i >> 10), ch = (int)(i & 1023);
    int s0, len, t; if (row < NLAT) { s0 = row & ~4095; len = SEQ; t = row & 4095; } else { s0 = NLAT + ((row - NLAT) & ~255); len = CTXL; t = (row - NLAT) & 255; }
    float acc = cb[ch];
#pragma unroll
    for (int j = 0; j < 5; ++j) { const int tt = t + j - 2; if (tt >= 0 && tt < len) acc += cw[j * 1024 + ch] * bf2f(P1[(size_t)(s0 + tt) * 2304 + 768 + ch]); }
    U[(size_t)row * 1024 + ch] = f2bf(silu_f(acc));
  }
  if (!do_swa) return;
  float* qs = lds + wave * 128; float* pl = lds + 1024 + wave * 128; int* rl = (int*)(lds + 2048) + wave * 64;
  for (long it = gw; it < (long)NLAT * 8; it += NGW) {
    const int row = (int)(it >> 3), hq = (int)(it & 7), g = hq >> 2, b = row >> 12, t = row & 4095;
    __builtin_amdgcn_s_waitcnt(0); __builtin_amdgcn_wave_barrier();
    qs[lane] = bf2f(P1[(size_t)row * 2304 + hq * 64 + lane]) * 0.125f;
    __builtin_amdgcn_s_waitcnt(0); __builtin_amdgcn_wave_barrier();
    float o[1][1], m[1], l[1];
    wave_attn<1, 1>(qs, pl, rl, 320 + CTXL, [&](int k, int& r, float& bias) {
        if (k < 320) { const int kp = t - 128 + k; if (k > 256 || kp < 0 || kp >= SEQ) return false; r = b * SEQ + kp; return true; }
        r = NLAT + b * CTXL + (k - 320); return true; },
      P1, 2304, 512 + g * 64, 640 + g * 64, p.in[L1_SINKS][hq], true, o, m, l, lane);
    ATT[(size_t)row * DM + hq * 64 + lane] = f2bf(o[0][0] / l[0]);
  }
}

DEVI void phase_ssd(const Params& p, float* lds) {
  const int tid = ftid();
  const bf16_t* U = (const bf16_t*)(p.ws + WS_U); const float* DT = (const float*)(p.ws + WS_DT); float* YS = (float*)(p.ws + WS_YS);
  constexpr int CH = 32;
  float* xb = lds;
  float* bb = lds + CH * 64;
  float* cb = bb + CH * 128;
  float* db = cb + CH * 128;
  float* yb = db + 2 * CH;
  const int pi = tid >> 3, ns = (tid & 7) * 16;
  for (int it = blockIdx.x; it < NB * 8; it += gridDim.x) {
    const int b = it >> 3, hd = it & 7, g = hd >> 2;
    for (int dir = 0; dir < 2; ++dir) {
      const float a = -expf(p.in[dir ? L1_ALOGB : L1_ALOGF][hd]); const float dtb = p.in[dir ? L1_DTBB : L1_DTBF][hd];
      float st[16];
#pragma unroll
      for (int i = 0; i < 16; ++i) st[i] = 0.f;
      for (int seg = 0; seg < 2; ++seg) {
        const int len = seg ? SEQ : CTXL, s0 = seg ? b * SEQ : NLAT + b * CTXL;
        for (int c0 = 0; c0 < len; c0 += CH) {
          __syncthreads();
          for (int i = tid; i < CH * 320; i += NT) {
            const int st_i = i / 320, c = i % 320; const int tk = dir ? (len - 1 - (c0 + st_i)) : (c0 + st_i); const size_t r = (size_t)(s0 + tk);
            if (c < 64) xb[st_i * 64 + c] = bf2f(U[r * 1024 + hd * 64 + c]);
            else if (c < 192) bb[st_i * 128 + (c - 64)] = bf2f(U[r * 1024 + 512 + g * 128 + (c - 64)]);
            else cb[st_i * 128 + (c - 192)] = bf2f(U[r * 1024 + 768 + g * 128 + (c - 192)]);
          }
          if (tid < CH) { const int tk = dir ? (len - 1 - (c0 + tid)) : (c0 + tid); const float raw = DT[(size_t)(s0 + tk) * 16 + dir * 8 + hd] + dtb;
            const float dt = raw > 20.f ? raw : log1pf(expf(raw)); db[tid] = expf(dt * a); db[CH + tid] = dt; }
          __syncthreads();
          for (int i = 0; i < CH; ++i) {
            const float dec = db[i], dx = db[CH + i] * xb[i * 64 + pi]; float y = 0.f;
#pragma unroll
            for (int q = 0; q < 16; ++q) { st[q] = st[q] * dec + dx * bb[i * 128 + ns + q]; y += st[q] * cb[i * 128 + ns + q]; }
            y += __shfl_xor(y, 1); y += __shfl_xor(y, 2); y += __shfl_xor(y, 4);
            if ((tid & 7) == 0) yb[i * 64 + pi] = y;
          }
          __syncthreads();
          if (seg == 1) for (int i = tid; i < CH * 64; i += NT) {
            const int q = i >> 6, c = i & 63; const int tk = (dir ? (len - CH - c0) : c0) + q, st_i = dir ? (CH - 1 - q) : q;
            float* yp = YS + (size_t)(b * SEQ + tk) * 512 + hd * 64 + c;
            if (dir == 0) *yp = yb[st_i * 64 + c]; else *yp = *yp + yb[st_i * 64 + c];
          }
        }
      }
      __syncthreads(); __threadfence();
    }
  }
}

DEVI void phase_ssd_out(const Params& p) {
  const int lane = ftid() & 63, gw = blockIdx.x * NWAVE + (ftid() >> 6), NGW = gridDim.x * NWAVE;
  const bf16_t* U = (const bf16_t*)(p.ws + WS_U); const bf16_t* P1 = (const bf16_t*)(p.ws + WS_P1); const float* YS = (const float*)(p.ws + WS_YS);
  bf16_t* ATT = (bf16_t*)(p.ws + WS_ATT1);
  for (int r = gw; r < NLAT; r += NGW) {
    const int c0 = lane * 8, hd = c0 >> 6; const float dsk = p.in[L1_DSKIP][hd];
    const float4 y0 = *(const float4*)(YS + (size_t)r * 512 + c0), y1 = *(const float4*)(YS + (size_t)r * 512 + c0 + 4);
    const uint4 xw = *(const uint4*)(U + (size_t)r * 1024 + c0), zw = *(const uint4*)(P1 + (size_t)r * 2304 + 1792 + c0);
    float y[8] = {y0.x, y0.y, y0.z, y0.w, y1.x, y1.y, y1.z, y1.w};
    const unsigned xs[4] = {xw.x, xw.y, xw.z, xw.w}, zs[4] = {zw.x, zw.y, zw.z, zw.w};
    float ss = 0.f;
#pragma unroll
    for (int i = 0; i < 4; ++i) {
      const float x0 = __uint_as_float(xs[i] << 16), x1 = __uint_as_float(xs[i] & 0xffff0000u), z0 = __uint_as_float(zs[i] << 16), z1 = __uint_as_float(zs[i] & 0xffff0000u);
      y[2 * i] = (y[2 * i] + dsk * x0) * silu_f(z0); y[2 * i + 1] = (y[2 * i + 1] + dsk * x1) * silu_f(z1);
      ss += y[2 * i] * y[2 * i] + y[2 * i + 1] * y[2 * i + 1];
    }
#pragma unroll
    for (int o = 1; o < 32; o <<= 1) ss += __shfl_xor(ss, o);
    const float rr = rsqrtf(ss * (1.f / 256.f) + EPS);
    const float4 g0 = *(const float4*)(p.in[L1_GNORM] + c0), g1 = *(const float4*)(p.in[L1_GNORM] + c0 + 4);
    uint4 w; w.x = pk2(y[0] * rr * g0.x, y[1] * rr * g0.y); w.y = pk2(y[2] * rr * g0.z, y[3] * rr * g0.w); w.z = pk2(y[4] * rr * g1.x, y[5] * rr * g1.y); w.w = pk2(y[6] * rr * g1.z, y[7] * rr * g1.w);
    *(uint4*)(ATT + (size_t)r * DM + 512 + c0) = w;
  }
}

}
namespace pg8 {
#define PG8_LAS __attribute__((address_space(3)))
typedef unsigned short bf16_t;
typedef short bf16x8 __attribute__((ext_vector_type(8)));
typedef float f32x4 __attribute__((ext_vector_type(4)));
typedef unsigned u32x4 __attribute__((ext_vector_type(4)));
constexpr int BM = 256, BK = 64, HALF = 128, HTB = HALF * BK * 2  , STAGE_BYTES = 8 * HTB, NXCD = 8, WGM = 8;

__host__ __device__ __forceinline__ int lds_byte(int r, int c) { const int st = (r >> 4) * 2 + (c >> 5), rr = r & 15, cc = c & 31, ob = rr * 64 + cc * 2; return st * 1024 + (ob ^ (((ob >> 9) & 1) << 5)); }
__host__ __device__ __forceinline__ void stage_rc(int b, int& R, int& C) { const int st = b / 1024, sb = b % 1024, swz = sb ^ (((sb >> 9) & 1) << 5); R = (st >> 1) * 16 + swz / 64; C = (st & 1) * 32 + (swz % 64) / 2; }
__host__ __device__ __forceinline__ int perm32(int rho) { const int n = rho >> 4, i = rho & 15; return 8 * (i >> 2) + 4 * n + (i & 3); }

struct Unit { int pm, pn; };
struct Gemm { const bf16_t* A; const bf16_t* Bt; int M, N, K; const int* gidx = nullptr; int sw = 0x7f7f7f7f, sa = 0x7f7f7f7f; };

struct StaticOrder {
    int nM, nN, nwg, G, c;
    __host__ __device__ void init(int M, int N, int G_, int c_) { nM = M / BM; nN = N / BM; nwg = nM * nN; G = G_; c = c_; }
    __host__ __device__ bool next(int i, Unit& u) const {
        const long L = (long)i * G + c; if (L >= nwg) return false;
        int wgid = (int)L; { const int q = nwg / NXCD, r = nwg % NXCD, xcd = wgid % NXCD, off = wgid / NXCD; wgid = (xcd < r ? xcd * (q + 1) : r * (q + 1) + (xcd - r) * q) + off; }
        const int nig = WGM * nN, gid = wgid / nig, fm = gid * WGM, gsz = (nM - fm) < WGM ? (nM - fm) : WGM;
        u.pm = fm + ((wgid % nig) % gsz); u.pn = (wgid % nig) / gsz; return true;
    }
    __device__ __forceinline__ void a_ready(const Unit&) const {}
    __device__ __forceinline__ void done(const Unit&) const {}
};

template <class Epi, class Sched, bool ALIGN_EPI = false, bool SP2 = false, bool FP8 = false>
__device__ __forceinline__ void gemm_phase(PG8_LAS unsigned char* lds, const Gemm g, const Sched& S, const Epi& E) {
    const int tid = ftid(), wid = __builtin_amdgcn_readfirstlane(tid >> 6), lane = tid & 63, wr = wid >> 2, wc = wid & 3, fr = lane & 15, fq = lane >> 4;
    const int KB = g.K * (FP8 ? 1 : 2), nt = KB / (BK * 2);
    unsigned voffB[2]; int pR[2], pC[2];
#pragma unroll
    for (int i = 0; i < 2; ++i) { int R, C; stage_rc(tid * 16 + i * 8192, R, C); const int Rb = Epi::PERM ? ((R & ~31) + perm32(R & 31)) : R;
        pR[i] = R; pC[i] = C; voffB[i] = (unsigned)(Rb * KB + C * 2); }
    unsigned cvo[2][2], nvo[2][2];
#define PG8_SETVO(vo, pm_) do { _Pragma("unroll") for (int _h = 0; _h < 2; ++_h) _Pragma("unroll") for (int _i = 0; _i < 2; ++_i) { const int _r = (pm_) * BM + _h * HALF + pR[_i]; \
        const int _g = g.gidx ? g.gidx[_r] : _r; vo[_h][_i] = (unsigned)_g * (unsigned)KB + (unsigned)(pC[_i] * 2); } } while (0)
#define PG8_STAGEA(bufoff, koff, vo) do { _Pragma("unroll") for (int _i = 0; _i < 2; ++_i) \
        __builtin_amdgcn_global_load_lds((const unsigned*)((const char*)g.A + (koff) + (vo)[_i]), (PG8_LAS unsigned*)(lds + (bufoff) + ldsw + _i * 8192), 16, 0, 0); } while (0)
    const size_t kstep = (size_t)(BK * 2);
    const size_t hstep = (size_t)HALF * KB;
    const size_t tstep = 2 * hstep;
    const unsigned ldsw = (unsigned)wid * 1024u;
    const int aoff = lds_byte(wr * 64 + fr, fq * 8), boff = lds_byte(wc * 32 + fr, fq * 8);
#define PG8_SA(b, h) (((b) * 2 + (h)) * HTB)
#define PG8_SB(b, h) ((4 + (b) * 2 + (h)) * HTB)
#define PG8_STAGE(bufoff, gbase, voff) do { _Pragma("unroll") for (int _i = 0; _i < 2; ++_i) \
        __builtin_amdgcn_global_load_lds((const unsigned*)((const char*)(gbase) + (voff)[_i]), (PG8_LAS unsigned*)(lds + (bufoff) + ldsw + _i * 8192), 16, 0, 0); } while (0)
    typedef int v4i_t __attribute__((ext_vector_type(4))); typedef int v8i_t __attribute__((ext_vector_type(8)));
#define PG8_CAT8(x, y) __builtin_shufflevector(__builtin_bit_cast(v4i_t, x), __builtin_bit_cast(v4i_t, y), 0, 1, 2, 3, 4, 5, 6, 7)
#define PG8_LDA(dst, b, h) do { _Pragma("unroll") for (int m = 0; m < 4; ++m) { const bf16x8 f0_ = *(const PG8_LAS bf16x8*)(lds + PG8_SA(b, h) + aoff + m * 2048), f1_ = *(const PG8_LAS bf16x8*)(lds + PG8_SA(b, h) + aoff + m * 2048 + 1024); \
        if constexpr (FP8) dst##8[m] = PG8_CAT8(f0_, f1_); else { dst[m][0] = f0_; dst[m][1] = f1_; } } } while (0)
#define PG8_LDB(dst, b, h) do { _Pragma("unroll") for (int n = 0; n < 2; ++n) { const bf16x8 f0_ = *(const PG8_LAS bf16x8*)(lds + PG8_SB(b, h) + boff + n * 2048), f1_ = *(const PG8_LAS bf16x8*)(lds + PG8_SB(b, h) + boff + n * 2048 + 1024); \
        if constexpr (FP8) dst##8[n] = PG8_CAT8(f0_, f1_); else { dst[n][0] = f0_; dst[n][1] = f1_; } } } while (0)
typedef int v4i_t __attribute__((ext_vector_type(4))); typedef int v8i_t __attribute__((ext_vector_type(8)));
#define PG8_CAT8(x, y) __builtin_shufflevector(__builtin_bit_cast(v4i_t, x), __builtin_bit_cast(v4i_t, y), 0, 1, 2, 3, 4, 5, 6, 7)
#define PG8_MMA(ai, bj, At, Bt) do { __builtin_amdgcn_s_setprio(1); _Pragma("unroll") for (int m = 0; m < 4; ++m) _Pragma("unroll") for (int n = 0; n < 2; ++n) { \
        if constexpr (FP8) asm volatile("v_mfma_scale_f32_16x16x128_f8f6f4 %0, %1, %2, %0, %3, %4 op_sel_hi:[0,0,0]" : "+v"(acc[ai][bj][m][n]) : "v"(Bt##8[n]), "v"(At##8[m]), "v"(sw_), "v"(sa_)); \
        else { _Pragma("unroll") for (int k = 0; k < 2; ++k) acc[ai][bj][m][n] = __builtin_amdgcn_mfma_f32_16x16x32_bf16(Bt[n][k], At[m][k], acc[ai][bj][m][n], 0, 0, 0); } } \
        __builtin_amdgcn_s_setprio(0); } while (0)
#define PG8_WAIT_V(n) asm volatile("s_waitcnt vmcnt(" #n ")" ::: "memory")
#define PG8_WAIT_L(n) asm volatile("s_waitcnt lgkmcnt(" #n ")" ::: "memory")
#define PG8_BAR __builtin_amdgcn_s_barrier()
#define PG8_SCHED __builtin_amdgcn_sched_barrier(0)
    Unit cur, nxt; int ui = 0;
    if (!S.next(0, cur)) return;
    f32x4 acc[2][2][4][2];
#pragma unroll
    for (int a = 0; a < 2; ++a)
#pragma unroll
        for (int b = 0; b < 2; ++b)
#pragma unroll
            for (int m = 0; m < 4; ++m)
#pragma unroll
                for (int n = 0; n < 2; ++n) acc[a][b][m][n] = (f32x4){0.f, 0.f, 0.f, 0.f};
    const int sw_ = g.sw, sa_ = g.sa;
    bf16x8 At[4][2], B0[2][2], B1[2][2]; v8i_t At8[4], B08[2], B18[2];
    PG8_SETVO(cvo, cur.pm); const char* cB = (const char*)g.Bt + (size_t)cur.pn * tstep;
    S.a_ready(cur);
    if constexpr (SP2) {
        PG8_STAGE(PG8_SB(0, 0), cB, voffB); PG8_STAGE(PG8_SB(0, 1), cB + hstep, voffB); PG8_STAGEA(PG8_SA(0, 0), 0, cvo[0]); PG8_STAGEA(PG8_SA(0, 1), 0, cvo[1]);
        if (wr == 1) PG8_BAR;
        PG8_WAIT_V(2); PG8_BAR;
        PG8_STAGE(PG8_SB(1, 0), cB + kstep, voffB); PG8_STAGEA(PG8_SA(1, 0), kstep, cvo[0]); PG8_STAGE(PG8_SB(1, 1), cB + hstep + kstep, voffB);
        PG8_WAIT_V(6); PG8_BAR;
    } else {
        PG8_STAGE(PG8_SB(0, 0), cB, voffB); PG8_STAGEA(PG8_SA(0, 0), 0, cvo[0]); PG8_STAGE(PG8_SB(0, 1), cB + hstep, voffB); PG8_STAGEA(PG8_SA(0, 1), 0, cvo[1]);
        if (wr == 1) PG8_BAR;
        PG8_WAIT_V(4); PG8_BAR;
        PG8_STAGE(PG8_SB(1, 0), cB + kstep, voffB); PG8_STAGEA(PG8_SA(1, 0), kstep, cvo[0]); PG8_STAGE(PG8_SB(1, 1), cB + hstep + kstep, voffB);
        PG8_WAIT_V(6); PG8_BAR;
    }
    for (;;) {
        const bool has_next = S.next(ui + 1, nxt);
        if (has_next) PG8_SETVO(nvo, nxt.pm); else { nvo[0][0] = cvo[0][0]; nvo[0][1] = cvo[0][1]; nvo[1][0] = cvo[1][0]; nvo[1][1] = cvo[1][1]; }
        const char* nB = has_next ? (const char*)g.Bt + (size_t)nxt.pn * tstep : cB;
#pragma unroll 1
        for (int t = 0; t < nt; t += 2) {
            const bool last = (t == nt - 2);
            const size_t k1 = (size_t)(t + 1) * kstep;
            const size_t k2 = last ? 0 : (size_t)(t + 2) * kstep; unsigned v2[2][2];
            v2[0][0] = last ? nvo[0][0] : cvo[0][0]; v2[0][1] = last ? nvo[0][1] : cvo[0][1]; v2[1][0] = last ? nvo[1][0] : cvo[1][0]; v2[1][1] = last ? nvo[1][1] : cvo[1][1];
            const char* b2 = last ? nB : cB + (size_t)(t + 2) * kstep;
            const size_t k3 = k2 + kstep; const char* b3 = b2 + kstep;
            if (last && has_next) S.a_ready(nxt);
            if constexpr (SP2) {
            PG8_LDB(B0, 0, 0); PG8_LDB(B1, 0, 1); PG8_SCHED; PG8_LDA(At, 0, 0); PG8_STAGEA(PG8_SA(1, 1), k1, cvo[1]);
            PG8_WAIT_V(8); PG8_WAIT_L(0); PG8_BAR; PG8_MMA(0, 0, At, B0); PG8_MMA(0, 1, At, B1); PG8_BAR; PG8_SCHED;
            PG8_LDA(At, 0, 1); PG8_STAGE(PG8_SB(0, 0), b2, voffB); PG8_STAGE(PG8_SB(0, 1), b2 + hstep, voffB); PG8_STAGEA(PG8_SA(0, 0), k2, v2[0]);
            PG8_WAIT_V(8); PG8_WAIT_L(0); PG8_BAR; PG8_MMA(1, 0, At, B0); PG8_MMA(1, 1, At, B1); PG8_BAR; PG8_SCHED;
            PG8_LDB(B0, 1, 0); PG8_LDB(B1, 1, 1); PG8_SCHED; PG8_LDA(At, 1, 0); PG8_STAGEA(PG8_SA(0, 1), k2, v2[1]);
            PG8_WAIT_V(8); PG8_WAIT_L(0); PG8_BAR; PG8_MMA(0, 0, At, B0); PG8_MMA(0, 1, At, B1); PG8_BAR; PG8_SCHED;
            PG8_LDA(At, 1, 1); PG8_STAGE(PG8_SB(1, 0), b3, voffB); PG8_STAGE(PG8_SB(1, 1), b3 + hstep, voffB); PG8_STAGEA(PG8_SA(1, 0), k3, v2[0]);
            PG8_WAIT_V(8); PG8_WAIT_L(0); PG8_BAR; PG8_MMA(1, 0, At, B0); PG8_MMA(1, 1, At, B1); PG8_BAR; PG8_SCHED;
            } else {
            PG8_LDB(B0, 0, 0); PG8_SCHED; PG8_LDA(At, 0, 0); PG8_STAGEA(PG8_SA(1, 1), k1, cvo[1]);
            PG8_WAIT_L(8); PG8_BAR; PG8_WAIT_L(0); PG8_MMA(0, 0, At, B0); PG8_BAR; PG8_SCHED;
            PG8_LDB(B1, 0, 1); PG8_STAGE(PG8_SB(0, 0), b2, voffB);
            PG8_BAR; PG8_WAIT_L(0); PG8_MMA(0, 1, At, B1); PG8_BAR;
            PG8_LDA(At, 0, 1); PG8_STAGEA(PG8_SA(0, 0), k2, v2[0]);
            PG8_BAR; PG8_WAIT_L(0); PG8_MMA(1, 0, At, B0); PG8_BAR; PG8_SCHED;
            PG8_STAGE(PG8_SB(0, 1), b2 + hstep, voffB);
            PG8_WAIT_V(6); PG8_BAR; PG8_MMA(1, 1, At, B1); PG8_BAR;
            PG8_LDB(B0, 1, 0); PG8_SCHED; PG8_LDA(At, 1, 0); PG8_STAGEA(PG8_SA(0, 1), k2, v2[1]);
            PG8_WAIT_L(8); PG8_BAR; PG8_WAIT_L(0); PG8_MMA(0, 0, At, B0); PG8_BAR; PG8_SCHED;
            PG8_LDB(B1, 1, 1); PG8_STAGE(PG8_SB(1, 0), b3, voffB);
            PG8_BAR; PG8_WAIT_L(0); PG8_MMA(0, 1, At, B1); PG8_BAR;
            PG8_LDA(At, 1, 1); PG8_STAGEA(PG8_SA(1, 0), k3, v2[0]);
            PG8_BAR; PG8_WAIT_L(0); PG8_MMA(1, 0, At, B0); PG8_BAR; PG8_SCHED;
            PG8_STAGE(PG8_SB(1, 1), b3 + hstep, voffB);
            PG8_WAIT_V(6); PG8_BAR; PG8_MMA(1, 1, At, B1); PG8_BAR;
            }
        }
        if constexpr (ALIGN_EPI) { if (wr == 0) PG8_BAR; }
        if constexpr (FP8) asm volatile("s_nop 15\n\ts_nop 15" ::: "memory");
        if constexpr (!Epi::AFTER_DRAIN) { E(acc, cur, wr, wc, fr, fq); S.done(cur); }
        if (!has_next) break;
#pragma unroll
        for (int a = 0; a < 2; ++a)
#pragma unroll
            for (int b = 0; b < 2; ++b)
#pragma unroll
                for (int m = 0; m < 4; ++m)
#pragma unroll
                    for (int n = 0; n < 2; ++n) acc[a][b][m][n] = (f32x4){0.f, 0.f, 0.f, 0.f};
        cur = nxt; cvo[0][0] = nvo[0][0]; cvo[0][1] = nvo[0][1]; cvo[1][0] = nvo[1][0]; cvo[1][1] = nvo[1][1]; cB = nB; ++ui;
        if constexpr (ALIGN_EPI) { if (wr == 1) PG8_BAR; }
    }
    PG8_WAIT_V(0);
    if constexpr (!ALIGN_EPI) { if (wr == 0) PG8_BAR; }
    PG8_BAR;
    if constexpr (Epi::AFTER_DRAIN) { E.fused(acc, cur, wr, wc, fr, fq, lds, wid, lane); S.done(cur); }
#undef PG8_SA
#undef PG8_SB
#undef PG8_STAGE
#undef PG8_STAGEA
#undef PG8_SETVO
#undef PG8_LDA
#undef PG8_LDB
#undef PG8_MMA
#undef PG8_CAT8
#undef PG8_WAIT_V
#undef PG8_WAIT_L
#undef PG8_BAR
#undef PG8_SCHED
}
}
#ifndef FP8_SP2
#define FP8_SP2 true
#endif
#ifndef ATTNA_FP8
#define ATTNA_FP8 1
#endif
namespace fg {
using pg8::f32x4; using pg8::Unit;
typedef unsigned u32x4 __attribute__((ext_vector_type(4)));
typedef unsigned u32x2 __attribute__((ext_vector_type(2)));
DEVI unsigned cvtpk(float lo, float hi) { typedef float f2_t __attribute__((ext_vector_type(2))); typedef __bf16 b2_t __attribute__((ext_vector_type(2))); const f2_t v = {lo, hi}; const b2_t b = __builtin_convertvector(v, b2_t); return __builtin_bit_cast(unsigned, b); }
template <class TP> DEVI void rope8(TP ROPE, int t, int d0, f32x4& v0, f32x4& v1) {
  const int i0 = d0 >> 1, f0 = i0 & 15, pos = (i0 < 16) ? (t >> 6) : (t & 63);
  const f32x4 r0 = *(const PG8_LAS f32x4*)(ROPE + (pos * 16 + f0) * 2), r1 = *(const PG8_LAS f32x4*)(ROPE + (pos * 16 + f0) * 2 + 4);
  const f32x4 a = v0, b = v1;
  v0[0] = a[0] * r0[0] - a[1] * r0[1]; v0[1] = a[0] * r0[1] + a[1] * r0[0]; v0[2] = a[2] * r0[2] - a[3] * r0[3]; v0[3] = a[2] * r0[3] + a[3] * r0[2];
  v1[0] = b[0] * r1[0] - b[1] * r1[1]; v1[1] = b[0] * r1[1] + b[1] * r1[0]; v1[2] = b[2] * r1[2] - b[3] * r1[3]; v1[3] = b[2] * r1[3] + b[3] * r1[2];
}
#define EPI_LOOP_BEGIN const int row0 = u.pm * 256 + wr * 64 + fr; \
  _Pragma("unroll") for (int ai = 0; ai < 2; ++ai) _Pragma("unroll") for (int m = 0; m < 4; ++m) { const int row = row0 + ai * 128 + m * 16; \
  _Pragma("unroll") for (int bj = 0; bj < 2; ++bj) { f32x4 v0 = acc[ai][bj][m][0], v1 = acc[ai][bj][m][1]; const int cl = bj * 128 + wc * 32 + 8 * fq;
#define EPI_LOOP_END } }

struct EpiQKV0 { static constexpr bool PERM = true, AFTER_DRAIN = false; bf16_t* O; const PG8_LAS float* ROPE; unsigned char* VT; unsigned char* VTB;
  DEVI void operator()(const f32x4 (&acc)[2][2][4][2], const Unit& u, int wr, int wc, int fr, int fq) const {
    const int colt = u.pn * 256; const bool rope = (u.pm < NLAT / 256) && (colt < 1024);
    EPI_LOOP_BEGIN
      const int col = colt + cl;
      if (ATTNA_FP8 && colt >= 1024 && colt < 1536) {
        const int hh = (col - 1024) >> 7, dv0 = (col - 1024) & 127;
        int bb, t; if (row < NLAT) { bb = row >> 12; t = row & 4095; } else { bb = (row - NLAT) >> 8; t = 4096 + ((row - NLAT) & 255); }
        const int k = t & 31, gq = k >> 3, wq = k & 7, pos = (wq < 4) ? gq * 4 + wq : 16 + gq * 4 + (wq - 4);
        unsigned char* vp = VT + (size_t)((bb * 4 + hh) * 128 + dv0) * 4352 + (t & ~31) + pos;
        const unsigned w0 = nv::pack4_fp8(v0[0] * 4.f, v0[1] * 4.f, v0[2] * 4.f, v0[3] * 4.f), w1 = nv::pack4_fp8(v1[0] * 4.f, v1[1] * 4.f, v1[2] * 4.f, v1[3] * 4.f);
        vp[0 * 4352] = (unsigned char)w0; vp[1 * 4352] = (unsigned char)(w0 >> 8); vp[2 * 4352] = (unsigned char)(w0 >> 16); vp[3 * 4352] = (unsigned char)(w0 >> 24);
        vp[4 * 4352] = (unsigned char)w1; vp[5 * 4352] = (unsigned char)(w1 >> 8); vp[6 * 4352] = (unsigned char)(w1 >> 16); vp[7 * 4352] = (unsigned char)(w1 >> 24);
        continue;
      }
      if (ATTNA_FP8 && colt >= 2560) {
        const int hh = (col - 2560) >> 6, dv0 = (col - 2560) & 63;
        int bb, t; if (row < NLAT) { bb = row >> 12; t = row & 4095; } else { bb = (row - NLAT) >> 8; t = 4096 + ((row - NLAT) & 255); }
        const int k = t & 31, gq = k >> 3, wq = k & 7, pos = (wq < 4) ? gq * 4 + wq : 16 + gq * 4 + (wq - 4);
        unsigned char* vp = VTB + (size_t)((bb * 8 + hh) * 64 + dv0) * 4352 + (t & ~31) + pos;
        const unsigned w0 = nv::pack4_fp8(v0[0] * 4.f, v0[1] * 4.f, v0[2] * 4.f, v0[3] * 4.f), w1 = nv::pack4_fp8(v1[0] * 4.f, v1[1] * 4.f, v1[2] * 4.f, v1[3] * 4.f);
        vp[0 * 4352] = (unsigned char)w0; vp[1 * 4352] = (unsigned char)(w0 >> 8); vp[2 * 4352] = (unsigned char)(w0 >> 16); vp[3 * 4352] = (unsigned char)(w0 >> 24);
        vp[4 * 4352] = (unsigned char)w1; vp[5 * 4352] = (unsigned char)(w1 >> 8); vp[6 * 4352] = (unsigned char)(w1 >> 16); vp[7 * 4352] = (unsigned char)(w1 >> 24);
        continue;
      }
      if (rope) rope8(ROPE, row & 4095, col & 63, v0, v1);
      if (ATTNA_FP8 && (colt < 1024 || colt >= 1536)) {
        const float sc = (colt < 512 || (colt >= 1536 && colt < 2048)) ? 16.f * 0.125f * 1.4426950408889634f : 4.f;
        u32x2 w8; w8.x = nv::pack4_fp8(v0[0] * sc, v0[1] * sc, v0[2] * sc, v0[3] * sc); w8.y = nv::pack4_fp8(v1[0] * sc, v1[1] * sc, v1[2] * sc, v1[3] * sc);
        *(u32x2*)((unsigned char*)O + (size_t)row * (N_IN0 * 2) + col) = w8;
        continue;
      }
      u32x4 w; w.x = cvtpk(v0[0], v0[1]); w.y = cvtpk(v0[2], v0[3]); w.z = cvtpk(v1[0], v1[1]); w.w = cvtpk(v1[2], v1[3]);
      *(u32x4*)(O + (size_t)row * N_IN0 + col) = w;
    EPI_LOOP_END
  } };
struct EpiQKV1 { static constexpr bool PERM = true, AFTER_DRAIN = false; bf16_t* O; float* DT; const PG8_LAS float* ROPE;
  DEVI void operator()(const f32x4 (&acc)[2][2][4][2], const Unit& u, int wr, int wc, int fr, int fq) const {
    const int colt = u.pn * 256; const bool lat = (u.pm < NLAT / 256);
    EPI_LOOP_BEGIN
      const int col = colt + cl;
      if (col >= 2304) { if (col < 2320) { *(f32x4*)(DT + (size_t)row * 16 + (col - 2304)) = v0; *(f32x4*)(DT + (size_t)row * 16 + (col - 2304) + 4) = v1; } }
      else {
        if (lat && col < 640) rope8(ROPE, row & 4095, col & 63, v0, v1);
        u32x4 w; w.x = cvtpk(v0[0], v0[1]); w.y = cvtpk(v0[2], v0[3]); w.z = cvtpk(v1[0], v1[1]); w.w = cvtpk(v1[2], v1[3]);
        *(u32x4*)(O + (size_t)row * 2304 + col) = w;
      }
    EPI_LOOP_END
  } };
struct EpiPlain { static constexpr bool PERM = true, AFTER_DRAIN = false; bf16_t* O;
  DEVI void operator()(const f32x4 (&acc)[2][2][4][2], const Unit& u, int wr, int wc, int fr, int fq) const {
    const int colt = u.pn * 256;
    EPI_LOOP_BEGIN
      u32x4 w; w.x = cvtpk(v0[0], v0[1]); w.y = cvtpk(v0[2], v0[3]); w.z = cvtpk(v1[0], v1[1]); w.w = cvtpk(v1[2], v1[3]);
      *(u32x4*)(O + (size_t)row * DM + colt + cl) = w;
    EPI_LOOP_END
  } };
DEVI float silu_fast(float v) { return v * __builtin_amdgcn_rcpf(1.f + __expf(-v)); }
struct EpiSwiGLU { static constexpr bool PERM = true, AFTER_DRAIN = false; bf16_t* O;
  DEVI void operator()(const f32x4 (&acc)[2][2][4][2], const Unit& u, int wr, int wc, int fr, int fq) const {
    const int colt = (u.pn & 7) * 256;
    EPI_LOOP_BEGIN
      u32x2 w; w.x = cvtpk(silu_fast(v0[0]) * v0[1], silu_fast(v0[2]) * v0[3]); w.y = cvtpk(silu_fast(v1[0]) * v1[1], silu_fast(v1[2]) * v1[3]);
      *(u32x2*)(O + (size_t)row * DM + ((colt + cl) >> 1)) = w;
    EPI_LOOP_END
  } };
struct EpiSwiGLU8 { static constexpr bool PERM = true, AFTER_DRAIN = false; unsigned char* O;
  DEVI void operator()(const f32x4 (&acc)[2][2][4][2], const Unit& u, int wr, int wc, int fr, int fq) const {
    const int colt = (u.pn & 7) * 256;
    EPI_LOOP_BEGIN
      const unsigned w = nv::pack4_fp8(silu_fast(v0[0]) * v0[1] * nv::A8_SCALE, silu_fast(v0[2]) * v0[3] * nv::A8_SCALE, silu_fast(v1[0]) * v1[1] * nv::A8_SCALE, silu_fast(v1[2]) * v1[3] * nv::A8_SCALE);
      *(unsigned*)(O + (size_t)row * DM + ((colt + cl) >> 1)) = w;
    EPI_LOOP_END
  } };
struct EpiDown { static constexpr bool PERM = true, AFTER_DRAIN = false; bf16_t* O;
  DEVI void operator()(const f32x4 (&acc)[2][2][4][2], const Unit& u, int wr, int wc, int fr, int fq) const {
    const int colt = (u.pn & 3) * 256;
    EPI_LOOP_BEGIN
      u32x4 w; w.x = cvtpk(v0[0], v0[1]); w.y = cvtpk(v0[2], v0[3]); w.z = cvtpk(v1[0], v1[1]); w.w = cvtpk(v1[2], v1[3]);
      *(u32x4*)(O + (size_t)row * DM + colt + cl) = w;
    EPI_LOOP_END
  } };
struct ExpOrder : pg8::StaticOrder { int nMe, nNe;
  __device__ void init2(int erows, int Ne, int G_, int c_) { nMe = erows / 256; nNe = Ne / 256; init(NE * erows, Ne, G_, c_); }
  __device__ bool next(int i, Unit& u) const { if (!pg8::StaticOrder::next(i, u)) return false; u.pn += (u.pm / nMe) * nNe; return true; } };

typedef PG8_LAS unsigned char* ldsp_t;
DEVI void phase_qkv0(const Params& p, ldsp_t lds) {
  pg8::Gemm g{(const bf16_t*)(p.ws + WS_H), (const bf16_t*)(p.ws + WS_WIN0), NROW, N_IN0, DM, nullptr, nv::W8_E8M0, nv::A8_E8M0}; pg8::StaticOrder S; S.init(NROW, N_IN0, gridDim.x, blockIdx.x);
  PG8_LAS float* RL = (PG8_LAS float*)(lds + pg8::STAGE_BYTES);
  for (int i = ftid(); i < 64 * 16 * 2; i += NT) RL[i] = ((const float*)(p.ws + WS_CTL + CTL_ROPE))[i];
  __syncthreads();
  EpiQKV0 E{(bf16_t*)(p.ws + WS_QKV0), RL, (unsigned char*)(p.ws + WS_VT), (unsigned char*)(p.ws + WS_VTB)};
  pg8::gemm_phase<EpiQKV0, pg8::StaticOrder, true, true, (QKV0_FP8 != 0)>(lds, g, S, E);
}
DEVI void phase_qkv1(const Params& p, ldsp_t lds) {
  pg8::Gemm g{(const bf16_t*)(p.ws + WS_H), (const bf16_t*)(p.ws + WS_WIN1), NROW, N_IN1P, DM, nullptr, nv::W8_E8M0, nv::A8_E8M0}; pg8::StaticOrder S; S.init(NROW, N_IN1P, gridDim.x, blockIdx.x);
  PG8_LAS float* RL = (PG8_LAS float*)(lds + pg8::STAGE_BYTES);
  for (int i = ftid(); i < 64 * 16 * 2; i += NT) RL[i] = ((const float*)(p.ws + WS_CTL + CTL_ROPE))[i];
  __syncthreads();
  EpiQKV1 E{(bf16_t*)(p.ws + WS_P1), (float*)(p.ws + WS_DT), RL};
  pg8::gemm_phase<EpiQKV1, pg8::StaticOrder, true, true, (QKV1_FP8 != 0)>(lds, g, S, E);
}
DEVI void phase_outproj(const Params& p, ldsp_t lds, int layer) {
  const int M = layer ? NLAT : NROW;
  pg8::Gemm g{(const bf16_t*)(p.ws + (layer ? WS_ATT1 : WS_ATT0)), (const bf16_t*)(p.ws + (layer ? WS_WOUT1 : WS_WOUT0)), M, DM, DM, nullptr, nv::W8_E8M0, nv::A8_E8M0}; pg8::StaticOrder S; S.init(M, DM, gridDim.x, blockIdx.x);
  EpiPlain E{(bf16_t*)(p.ws + (layer ? WS_MIX1 : WS_MIX0))};
  pg8::gemm_phase<EpiPlain, pg8::StaticOrder, true, true, (OUT_FP8 != 0)>(lds, g, S, E);
}
DEVI void phase_moe_up(const Params& p, ldsp_t lds, int layer) {
  const int erows = layer ? EROWS1 : EROWS0;
  pg8::Gemm g{(const bf16_t*)(p.ws + WS_H), (const bf16_t*)(p.ws + WS_WGU), NE * erows, 2048, DM, (const int*)(p.ws + WS_IDX)}; ExpOrder S; S.init2(erows, 2048, gridDim.x, blockIdx.x);
  EpiSwiGLU E{(bf16_t*)(p.ws + WS_HID)};
  pg8::gemm_phase<EpiSwiGLU, ExpOrder, true, true>(lds, g, S, E);
}
DEVI void phase_moe_down(const Params& p, ldsp_t lds, int layer) {
  const int erows = layer ? EROWS1 : EROWS0;
  pg8::Gemm g{(const bf16_t*)(p.ws + WS_HID), (const bf16_t*)(p.ws + WS_WD), NE * erows, DM, DM}; ExpOrder S; S.init2(erows, DM, gridDim.x, blockIdx.x);
  EpiDown E{(bf16_t*)(p.ws + WS_Y)};
  pg8::gemm_phase<EpiDown, ExpOrder, true, true>(lds, g, S, E);
}
DEVI void phase_moe_up8(const Params& p, ldsp_t lds, int layer) {
  const int erows = layer ? EROWS1 : EROWS0;
  pg8::Gemm g{(const bf16_t*)(p.ws + WS_H), (const bf16_t*)(p.ws + WS_WGU), NE * erows, 2048, DM, (const int*)(p.ws + WS_IDX), nv::W8_E8M0, nv::A8_E8M0}; ExpOrder S; S.init2(erows, 2048, gridDim.x, blockIdx.x);
  EpiSwiGLU8 E{(unsigned char*)(p.ws + WS_HID)};
  pg8::gemm_phase<EpiSwiGLU8, ExpOrder, true, FP8_SP2, true>(lds, g, S, E);
}
DEVI void phase_moe_down8(const Params& p, ldsp_t lds, int layer) {
  const int erows = layer ? EROWS1 : EROWS0;
  pg8::Gemm g{(const bf16_t*)(p.ws + WS_HID), (const bf16_t*)(p.ws + WS_WD), NE * erows, DM, DM, nullptr, nv::W8_E8M0, nv::A8_E8M0}; ExpOrder S; S.init2(erows, DM, gridDim.x, blockIdx.x);
  EpiDown E{(bf16_t*)(p.ws + WS_Y)};
  pg8::gemm_phase<EpiDown, ExpOrder, true, FP8_SP2, true>(lds, g, S, E);
}
DEVI void phase_gather(const Params& p, int layer) {
  const int lane = ftid() & 63, gw = blockIdx.x * NWAVE + (ftid() >> 6), NGW = gridDim.x * NWAVE;
  const int erows = layer ? EROWS1 : EROWS0; const int* IDX = (const int*)(p.ws + WS_IDX);
  const bf16_t* H = (const bf16_t*)(p.ws + WS_H); bf16_t* XG = (bf16_t*)(p.ws + WS_XG);
  for (int r = gw; r < NE * erows; r += NGW) {
    const uint4* s = (const uint4*)(H + (size_t)IDX[r] * DM) + lane; uint4* d = (uint4*)(XG + (size_t)r * DM) + lane;
    const uint4 a = s[0], b = s[64]; d[0] = a; d[64] = b;
  }
}
}
#ifndef ATTNA_FP8
#define ATTNA_FP8 1
#endif
namespace fa {
#define FA_LAS __attribute__((address_space(3)))
typedef short bf16x8 __attribute__((ext_vector_type(8)));
typedef short s16x4 __attribute__((ext_vector_type(4)));
typedef float f32x16 __attribute__((ext_vector_type(16)));
typedef FA_LAS unsigned char* ldsp_t;
typedef unsigned u32x4 __attribute__((ext_vector_type(4)));
constexpr float LOG2E = 1.4426950408889634f, C2 = 0.125f * LOG2E;
DEVI int crow(int r, int hi) { return (r & 3) + 8 * (r >> 2) + 4 * hi; }
DEVI unsigned cvtpk(float lo, float hi) { typedef float f2_t __attribute__((ext_vector_type(2))); typedef __bf16 b2_t __attribute__((ext_vector_type(2))); const f2_t v = {lo, hi}; const b2_t b = __builtin_convertvector(v, b2_t); return __builtin_bit_cast(unsigned, b); }
DEVI s16x4 vtr(ldsp_t p) { return __builtin_bit_cast(s16x4, __builtin_amdgcn_ds_read_tr16_b64_v4i16((FA_LAS s16x4*)p)); }

DEVI float max3f(float a, float b, float c) { float r; asm("v_max3_f32 %0, %1, %2, %3" : "=v"(r) : "v"(a), "v"(b), "v"(c)); return r; }
template <int KW, int DVB> struct Geo {
  static constexpr int VW = DVB * 32;
  static constexpr int KSTR = KW * 2 + 16, VSTR = VW * 2 + 64;
  static constexpr int KBYTES = 64 * KSTR, VBYTES = 64 * VSTR, STAGE = KBYTES + VBYTES;
  static constexpr int CPR = (KW + VW) / 8, NCH = 64 * CPR / NT;
};

DEVI bf16x8 load_q8(const bf16_t* p, float sc) {
  const uint4 w = *(const uint4*)p; const unsigned u[4] = {w.x, w.y, w.z, w.w}; unsigned o[4];
#pragma unroll
  for (int i = 0; i < 4; ++i) o[i] = cvtpk(__uint_as_float(u[i] << 16) * sc, __uint_as_float(u[i] & 0xffff0000u) * sc);
  uint4 r = make_uint4(o[0], o[1], o[2], o[3]); return __builtin_bit_cast(bf16x8, r);
}

template <int KW, int DVB, class Src, class Act, class Msk>
DEVI void flash_pass(ldsp_t lds, int ntiles, const bf16_t* kv, int ld, int kcol, int vcol, const bf16x8 (&q)[4], int kofs,
                     Src src, Act act, Msk msk, f32x16 (&o)[DVB], float& m, float& l) {
  typedef Geo<KW, DVB> G;
  const int tid = ftid(), lane = tid & 63, r32 = lane & 31, hi = lane >> 5;
  u32x4 stg[G::NCH];
  int crw[G::NCH], ccol[G::NCH], cdst[G::NCH];
#pragma unroll
  for (int i = 0; i < G::NCH; ++i) { const int c = tid + NT * i, row = c / G::CPR, cc = c % G::CPR; crw[i] = row;
    if (cc < KW / 8) { ccol[i] = kcol + cc * 8; cdst[i] = row * G::KSTR + cc * 16; } else { ccol[i] = vcol + (cc - KW / 8) * 8; cdst[i] = G::KBYTES + row * G::VSTR + (cc - KW / 8) * 16; } }
#pragma unroll
  for (int i = 0; i < G::NCH; ++i) stg[i] = *(const u32x4*)(kv + (size_t)src(0, crw[i]) * ld + ccol[i]);
#pragma unroll
  for (int i = 0; i < G::NCH; ++i) *(FA_LAS u32x4*)(lds + cdst[i]) = stg[i];
  __syncthreads();
  const int kroff = r32 * G::KSTR + (kofs + 8 * hi) * 2;
  const int vroff = G::KBYTES + (4 * hi + ((lane & 15) >> 2)) * G::VSTR + 32 * ((lane >> 4) & 1) + 8 * (lane & 3);
  for (int kt = 0; kt < ntiles; ++kt) {
    const int buf = (kt & 1) * G::STAGE;
    const bool more = kt + 1 < ntiles;
    if (more) {
#pragma unroll
      for (int i = 0; i < G::NCH; ++i) stg[i] = *(const u32x4*)(kv + (size_t)src(kt + 1, crw[i]) * ld + ccol[i]);
    }
    if (act(kt)) {
      const ldsp_t kb = lds + buf + kroff;
      f32x16 p0, p1;
#pragma unroll
      for (int r = 0; r < 16; ++r) { p0[r] = 0.f; p1[r] = 0.f; }
#pragma unroll
      for (int d0 = 0; d0 < 4; ++d0) {
        const bf16x8 a0 = *(const FA_LAS bf16x8*)(kb + d0 * 32), a1 = *(const FA_LAS bf16x8*)(kb + 32 * G::KSTR + d0 * 32);
        p0 = __builtin_amdgcn_mfma_f32_32x32x16_bf16(a0, q[d0], p0, 0, 0, 0);
        p1 = __builtin_amdgcn_mfma_f32_32x32x16_bf16(a1, q[d0], p1, 0, 0, 0);
      }
      msk(kt, p0, p1);
      float mx = fmaxf(p0[0], p1[0]);
#pragma unroll
      for (int r = 1; r < 16; ++r) mx = fmaxf(mx, fmaxf(p0[r], p1[r]));
      mx = fmaxf(mx, __shfl_xor(mx, 32));
      if (__any(mx > m)) {
        const float mn = fmaxf(m, mx), alpha = __builtin_amdgcn_exp2f(m - mn);
        l *= alpha; m = mn;
#pragma unroll
        for (int b = 0; b < DVB; ++b)
#pragma unroll
          for (int r = 0; r < 16; ++r) o[b][r] *= alpha;
      }
      float ls = 0.f;
#pragma unroll
      for (int r = 0; r < 16; ++r) { p0[r] = __builtin_amdgcn_exp2f(p0[r] - m); p1[r] = __builtin_amdgcn_exp2f(p1[r] - m); ls += p0[r] + p1[r]; }
      l += ls;
      bf16x8 pa[4];
      { uint4 t;
        t = make_uint4(cvtpk(p0[0], p0[1]), cvtpk(p0[2], p0[3]), cvtpk(p0[4], p0[5]), cvtpk(p0[6], p0[7])); pa[0] = __builtin_bit_cast(bf16x8, t);
        t = make_uint4(cvtpk(p0[8], p0[9]), cvtpk(p0[10], p0[11]), cvtpk(p0[12], p0[13]), cvtpk(p0[14], p0[15])); pa[1] = __builtin_bit_cast(bf16x8, t);
        t = make_uint4(cvtpk(p1[0], p1[1]), cvtpk(p1[2], p1[3]), cvtpk(p1[4], p1[5]), cvtpk(p1[6], p1[7])); pa[2] = __builtin_bit_cast(bf16x8, t);
        t = make_uint4(cvtpk(p1[8], p1[9]), cvtpk(p1[10], p1[11]), cvtpk(p1[12], p1[13]), cvtpk(p1[14], p1[15])); pa[3] = __builtin_bit_cast(bf16x8, t); }
      const ldsp_t vb = lds + buf + vroff;
#pragma unroll
      for (int b = 0; b < DVB; ++b)
#pragma unroll
        for (int ks = 0; ks < 4; ++ks) {
          const s16x4 lo = vtr(vb + (16 * ks) * G::VSTR + b * 64), h8 = vtr(vb + (16 * ks + 8) * G::VSTR + b * 64);
          const bf16x8 vf = {lo[0], lo[1], lo[2], lo[3], h8[0], h8[1], h8[2], h8[3]};
          o[b] = __builtin_amdgcn_mfma_f32_32x32x16_bf16(vf, pa[ks], o[b], 0, 0, 0);
        }
    }
    if (more) {
      const int nb = ((kt + 1) & 1) * G::STAGE;
#pragma unroll
      for (int i = 0; i < G::NCH; ++i) *(FA_LAS u32x4*)(lds + nb + cdst[i]) = stg[i];
    }
    __syncthreads();
  }
}


template <int V> struct IC { static constexpr int value = V; };
template <int KW, int DVB, int ABL, int PF, class Src, class Msk>
DEVI void flash_pass2(ldsp_t lds, int ntiles, const bf16_t* kv, int ld, int kcol, int vcol, const bf16x8 (&q)[4], int kofs,
                      Src src, Msk msk, f32x16 (&o)[DVB], float& m, float& l) {
  typedef Geo<KW, DVB> G;
  const int tid = ftid(), lane = tid & 63, r32 = lane & 31, hi = lane >> 5;
  u32x4 stg[PF][G::NCH];
  int crw[G::NCH], ccol[G::NCH], cdst[G::NCH];
#pragma unroll
  for (int i = 0; i < G::NCH; ++i) { const int c = tid + NT * i, row = c / G::CPR, cc = c % G::CPR; crw[i] = row;
    if (cc < KW / 8) { ccol[i] = kcol + cc * 8; cdst[i] = row * G::KSTR + cc * 16; } else { ccol[i] = vcol + (cc - KW / 8) * 8; cdst[i] = G::KBYTES + row * G::VSTR + (cc - KW / 8) * 16; } }
#define FP2_LOAD(kt, set) _Pragma("unroll") for (int i = 0; i < G::NCH; ++i) stg[set][i] = *(const u32x4*)(kv + (size_t)src((kt), crw[i]) * ld + ccol[i])
#define FP2_STORE(st, set) _Pragma("unroll") for (int i = 0; i < G::NCH; ++i) *(FA_LAS u32x4*)(lds + (st) * G::STAGE + cdst[i]) = stg[set][i]
  FP2_LOAD(0, 0); FP2_STORE(0, 0);
  if (ntiles > 1) { FP2_LOAD(1, 0); FP2_STORE(1, 0); }
  __syncthreads();
  if (ntiles > 2) FP2_LOAD(2, 0);
  if (PF == 2) { if (ntiles > 3) FP2_LOAD(3, PF - 1); }
  const int kroff = r32 * G::KSTR + (kofs + 8 * hi) * 2;
  const int vroff = G::KBYTES + (4 * hi + ((lane & 15) >> 2)) * G::VSTR + 32 * ((lane >> 4) & 1) + 8 * (lane & 3);
  f32x16 c0, c1;
#pragma unroll
  for (int r = 0; r < 16; ++r) { c0[r] = 0.f; c1[r] = 0.f; }
  { const ldsp_t kb = lds + kroff;
#pragma unroll
    for (int d0 = 0; d0 < 4; ++d0) {
      const bf16x8 a0 = *(const FA_LAS bf16x8*)(kb + d0 * 32), a1 = *(const FA_LAS bf16x8*)(kb + 32 * G::KSTR + d0 * 32);
      c0 = __builtin_amdgcn_mfma_f32_32x32x16_bf16(a0, q[d0], c0, 0, 0, 0); c1 = __builtin_amdgcn_mfma_f32_32x32x16_bf16(a1, q[d0], c1, 0, 0, 0); } }
  asm volatile("s_nop 15\n\ts_nop 7" : "+v"(c0), "+v"(c1));
  int st_cur = 0, st_nxt = 1, st_fill = 2;
  auto body = [&](int kt, auto PARC) {
    constexpr int set = (PF == 2) ? decltype(PARC)::value : 0;
    msk(kt, c0, c1);
    __builtin_amdgcn_sched_barrier(0);
    f32x16 n0, n1;
#pragma unroll
    for (int r = 0; r < 16; ++r) { n0[r] = 0.f; n1[r] = 0.f; }
    const ldsp_t kb = lds + st_nxt * G::STAGE + kroff;
    bf16x8 ka[4], kb2[4];
#pragma unroll
    for (int d0 = 0; d0 < 4; ++d0) { ka[d0] = *(const FA_LAS bf16x8*)(kb + d0 * 32); kb2[d0] = *(const FA_LAS bf16x8*)(kb + 32 * G::KSTR + d0 * 32); }
#define FP2_SB() __builtin_amdgcn_sched_barrier(0)
#define FP2_MMA(acc, kf, d0) acc = __builtin_amdgcn_mfma_f32_32x32x16_bf16(kf[d0], q[d0], acc, 0, 0, 0)
#define FP2_EXP(cx, r) { if (ABL != 1) { cx[r] = __builtin_amdgcn_exp2f(cx[r] - mn); ls += cx[r]; } }
    FP2_SB(); FP2_MMA(n0, ka, 0);
    float mxa = max3f(c0[0], c0[1], c1[0]), mxb = max3f(c0[2], c0[3], c1[1]);
    mxa = max3f(mxa, c1[2], c1[3]);
    mxa = max3f(mxa, c0[4], c0[5]); mxb = max3f(mxb, c0[6], c0[7]); mxa = max3f(mxa, c1[4], c1[5]); mxb = max3f(mxb, c1[6], c1[7]);
    FP2_SB(); FP2_MMA(n1, kb2, 0);
    mxa = max3f(mxa, c0[8], c0[9]); mxb = max3f(mxb, c0[10], c0[11]); mxa = max3f(mxa, c1[8], c1[9]); mxb = max3f(mxb, c1[10], c1[11]);
    mxa = max3f(mxa, c0[12], c0[13]); mxb = max3f(mxb, c0[14], c0[15]); mxa = max3f(mxa, c1[12], c1[13]); mxb = max3f(mxb, c1[14], c1[15]);
    float mx = max3f(mxa, mxb, m);
    mx = max3f(mx, __shfl_xor(mx, 32), mx);
    const float mn = mx, alpha = __builtin_amdgcn_exp2f(m - mn);
    const bool resc = __any(mn > m);
    m = mn;
    float ls = 0.f;
    FP2_SB(); FP2_MMA(n0, ka, 1);
    FP2_EXP(c0, 0) FP2_EXP(c0, 1) FP2_EXP(c0, 2) FP2_EXP(c0, 3) FP2_EXP(c0, 4) FP2_EXP(c0, 5)
    FP2_SB(); FP2_MMA(n1, kb2, 1);
    FP2_EXP(c0, 6) FP2_EXP(c0, 7) FP2_EXP(c0, 8) FP2_EXP(c0, 9) FP2_EXP(c0, 10) FP2_EXP(c0, 11)
    FP2_SB(); FP2_MMA(n0, ka, 2);
    FP2_EXP(c0, 12) FP2_EXP(c0, 13) FP2_EXP(c0, 14) FP2_EXP(c0, 15) FP2_EXP(c1, 0) FP2_EXP(c1, 1)
    FP2_SB(); FP2_MMA(n1, kb2, 2);
    FP2_EXP(c1, 2) FP2_EXP(c1, 3) FP2_EXP(c1, 4) FP2_EXP(c1, 5) FP2_EXP(c1, 6) FP2_EXP(c1, 7)
    FP2_SB(); FP2_MMA(n0, ka, 3);
    FP2_EXP(c1, 8) FP2_EXP(c1, 9) FP2_EXP(c1, 10) FP2_EXP(c1, 11) FP2_EXP(c1, 12) FP2_EXP(c1, 13)
    FP2_SB(); FP2_MMA(n1, kb2, 3);
    FP2_EXP(c1, 14) FP2_EXP(c1, 15)
    bf16x8 pa[4];
    { u32x4 t;
      t[0] = cvtpk(c0[0], c0[1]); t[1] = cvtpk(c0[2], c0[3]); t[2] = cvtpk(c0[4], c0[5]); t[3] = cvtpk(c0[6], c0[7]); pa[0] = __builtin_bit_cast(bf16x8, t);
      t[0] = cvtpk(c0[8], c0[9]); t[1] = cvtpk(c0[10], c0[11]); t[2] = cvtpk(c0[12], c0[13]); t[3] = cvtpk(c0[14], c0[15]); pa[1] = __builtin_bit_cast(bf16x8, t);
      t[0] = cvtpk(c1[0], c1[1]); t[1] = cvtpk(c1[2], c1[3]); t[2] = cvtpk(c1[4], c1[5]); t[3] = cvtpk(c1[6], c1[7]); pa[2] = __builtin_bit_cast(bf16x8, t);
      t[0] = cvtpk(c1[8], c1[9]); t[1] = cvtpk(c1[10], c1[11]); t[2] = cvtpk(c1[12], c1[13]); t[3] = cvtpk(c1[14], c1[15]); pa[3] = __builtin_bit_cast(bf16x8, t); }
    asm volatile("" : "+v"(pa[0]), "+v"(pa[1]), "+v"(pa[2]), "+v"(pa[3]));
    FP2_SB();
    l = l * alpha + ls;
    __builtin_amdgcn_sched_barrier(0);
    if (resc) {
#pragma unroll
      for (int b = 0; b < DVB; ++b)
#pragma unroll
        for (int r = 0; r < 16; ++r) o[b][r] *= alpha;
    }
    const ldsp_t vb = lds + st_cur * G::STAGE + vroff;
    s16x4 vl[2][DVB], vh[2][DVB];
#pragma unroll
    for (int b = 0; b < DVB; ++b) { vl[0][b] = vtr(vb + b * 64); vh[0][b] = vtr(vb + 8 * G::VSTR + b * 64); }
#pragma unroll
    for (int ks = 0; ks < 4; ++ks) {
      FP2_SB();
      if (ks < 3) {
#pragma unroll
        for (int b = 0; b < DVB; ++b) { vl[(ks + 1) & 1][b] = vtr(vb + (16 * (ks + 1)) * G::VSTR + b * 64); vh[(ks + 1) & 1][b] = vtr(vb + (16 * (ks + 1) + 8) * G::VSTR + b * 64); }
      }
      FP2_SB();
#pragma unroll
      for (int b = 0; b < DVB; ++b) {
        const s16x4 lo = vl[ks & 1][b], h8 = vh[ks & 1][b];
        const bf16x8 vf = {lo[0], lo[1], lo[2], lo[3], h8[0], h8[1], h8[2], h8[3]};
        if (ABL != 2) o[b] = __builtin_amdgcn_mfma_f32_32x32x16_bf16(vf, pa[ks], o[b], 0, 0, 0); else o[b][0] += __builtin_bit_cast(float, (int)vf[0]);
      }
    }
    FP2_SB();
    if (ABL != 3) { if (kt + 2 < ntiles) FP2_STORE(st_fill, set); }
    __syncthreads();
    if (ABL != 3) { if (kt + 2 + PF < ntiles) FP2_LOAD(kt + 2 + PF, set); }
    c0 = n0; c1 = n1;
    { const int t = st_cur; st_cur = st_nxt; st_nxt = st_fill; st_fill = t; }
  };
  if (PF == 2) { for (int kt = 0; kt < ntiles; kt += 2) { body(kt, IC<0>{}); if (kt + 1 < ntiles) body(kt + 1, IC<1>{}); } }
  else { for (int kt = 0; kt < ntiles; ++kt) body(kt, IC<0>{}); }
#undef FP2_LOAD
#undef FP2_STORE
}


typedef int v8i_t __attribute__((ext_vector_type(8)));
DEVI v8i_t cat8(const u32x4& x, const u32x4& y) { return (v8i_t){(int)x[0], (int)x[1], (int)x[2], (int)x[3], (int)y[0], (int)y[1], (int)y[2], (int)y[3]}; }
template <int DVB, int KROW, int AB8 = 0, class Src, class VKey, class Msk, class Act>
DEVI void flash_pass8(ldsp_t lds, int ntiles, const unsigned char* k8, int ldb, int kcolb, const unsigned char* vt, const v8i_t& qf, int ksub, bool late,
                      Src src, VKey vkey, Msk msk, Act act, f32x16 (&o)[DVB], float& m, float& l) {
  constexpr int A8_KSTR = KROW + 16, A8_VSTR = 80, A8_KB = 64 * A8_KSTR, A8_STAGE = A8_KB + DVB * 32 * A8_VSTR;
  constexpr int KPR = KROW / 16, NKC = 64 * KPR, NCHT = (NKC + DVB * 32 * 4) / NT;
  const int tid = ftid(), lane = tid & 63, r32 = lane & 31, hi = lane >> 5;
  u32x4 stg[NCHT];
#define A8_ISK(i_, c_) ((NKC % NT == 0) ? ((i_) < NKC / NT) : ((c_) < NKC))
#define A8_LOAD(kt) do { const int sb_ = src((kt), 0), vk_ = vkey(kt); _Pragma("unroll") for (int i_ = 0; i_ < NCHT; ++i_) { const int c_ = tid + NT * i_; \
      if (A8_ISK(i_, c_)) stg[i_] = *(const u32x4*)(k8 + (size_t)(sb_ + c_ / KPR) * ldb + kcolb + (c_ % KPR) * 16); \
      else { const int cv_ = c_ - NKC; stg[i_] = *(const u32x4*)(vt + (size_t)(cv_ >> 2) * 4352 + vk_ + (cv_ & 3) * 16); } } } while (0)
#define A8_STORE(st) do { _Pragma("unroll") for (int i_ = 0; i_ < NCHT; ++i_) { const int c_ = tid + NT * i_; \
      if (A8_ISK(i_, c_)) *(FA_LAS u32x4*)(lds + (st) * A8_STAGE + (c_ / KPR) * A8_KSTR + (c_ % KPR) * 16) = stg[i_]; \
      else { const int cv_ = c_ - NKC; *(FA_LAS u32x4*)(lds + (st) * A8_STAGE + A8_KB + (cv_ >> 2) * A8_VSTR + (cv_ & 3) * 16) = stg[i_]; } } } while (0)
#define A8_SB() __builtin_amdgcn_sched_barrier(0)
#define A8_EXP(cx, r) { if (AB8 & 2) {} else { cx[r] = __builtin_amdgcn_exp2f(cx[r] - mn); ls += cx[r]; } }
#define A8_KREAD(st) do { const ldsp_t kp_ = lds + (st) * A8_STAGE + kroff; \
    kf[0] = *(const volatile FA_LAS u32x4*)kp_; kf[1] = *(const volatile FA_LAS u32x4*)(kp_ + 16); kf[2] = *(const volatile FA_LAS u32x4*)(kp_ + 32 * A8_KSTR); kf[3] = *(const volatile FA_LAS u32x4*)(kp_ + 32 * A8_KSTR + 16); } while (0)
#define A8_VREAD(st) do { const ldsp_t vb_ = lds + (st) * A8_STAGE + vroff; _Pragma("unroll") for (int b = 0; b < DVB; ++b) { \
    vf0[b] = *(const volatile FA_LAS u32x4*)(vb_ + b * 32 * A8_VSTR); vf1[b] = *(const volatile FA_LAS u32x4*)(vb_ + b * 32 * A8_VSTR + 16); } } while (0)
#define A8_QKM() do { f32x16 z_; _Pragma("unroll") for (int r_ = 0; r_ < 16; ++r_) z_[r_] = 0.f; \
    c0 = __builtin_amdgcn_mfma_scale_f32_32x32x64_f8f6f4(cat8(kf[0], kf[1]), qf, z_, 0, 0, 0, 0x7d7d7d7d  , 0, 0x7b7b7b7b  ); \
    c1 = __builtin_amdgcn_mfma_scale_f32_32x32x64_f8f6f4(cat8(kf[2], kf[3]), qf, z_, 0, 0, 0, 0x7d7d7d7d, 0, 0x7b7b7b7b); } while (0)
#define A8_PVM() do { _Pragma("unroll") for (int b = 0; b < DVB; ++b) if (!(AB8 & 16)) o[b] = __builtin_amdgcn_mfma_scale_f32_32x32x64_f8f6f4(cat8(vf0[b], vf1[b]), pb, o[b], 0, 0, 0, 0x7d7d7d7d  , 0, 0x7b7b7b7b  ); } while (0)
  A8_LOAD(0); A8_STORE(0);
  if (ntiles > 1) { A8_LOAD(1); A8_STORE(1); }
  __syncthreads();
  if (ntiles > 2) A8_LOAD(2);
  const int kroff = r32 * A8_KSTR + 64 * ksub + 32 * hi;
  const int vroff = A8_KB + r32 * A8_VSTR + 32 * hi;
  f32x16 c0, c1;
  u32x4 kf[4], vf0[DVB], vf1[DVB];
  v8i_t pb = {0, 0, 0, 0, 0, 0, 0, 0};
  if (act(0)) { A8_KREAD(0); A8_QKM(); }
  asm volatile("s_nop 15\n\ts_nop 7" : "+v"(c0), "+v"(c1));
  int st_cur = 0, st_nxt = 1, st_fill = 2;
  for (int kt = 0; kt < ntiles; ++kt) {
    const bool on = act(kt), on_nxt = kt + 1 < ntiles && act(kt + 1);
    if (late && kt > 0) {
      if (on) A8_QKM();
      if (act(kt - 1)) A8_PVM();
#pragma unroll
      for (int b = 0; b < DVB; ++b) asm volatile("" : "+v"(o[b]));
      asm volatile("s_nop 15\n\ts_nop 7" : "+v"(c0), "+v"(c1));
    }
    A8_SB();
    if (on) A8_VREAD(st_cur);
    if (on_nxt) A8_KREAD(st_nxt);
    A8_SB();
    if (on) {
    msk(kt, c0, c1);
    A8_SB();
    float mxa = 0.f, mxb = 0.f;
    if (!(AB8 & 2)) {
    mxa = max3f(c0[0], c0[1], c1[0]), mxb = max3f(c0[2], c0[3], c1[1]);
    mxa = max3f(mxa, c1[2], c1[3]);
    mxa = max3f(mxa, c0[4], c0[5]); mxb = max3f(mxb, c0[6], c0[7]); mxa = max3f(mxa, c1[4], c1[5]); mxb = max3f(mxb, c1[6], c1[7]);
    mxa = max3f(mxa, c0[8], c0[9]); mxb = max3f(mxb, c0[10], c0[11]); mxa = max3f(mxa, c1[8], c1[9]); mxb = max3f(mxb, c1[10], c1[11]);
    mxa = max3f(mxa, c0[12], c0[13]); mxb = max3f(mxb, c0[14], c0[15]); mxa = max3f(mxa, c1[12], c1[13]); mxb = max3f(mxb, c1[14], c1[15]);
    }
    float mx = max3f(mxa, mxb, mxb);
    { const auto sw = __builtin_amdgcn_permlane32_swap(__float_as_uint(mx), __float_as_uint(mx), false, false);
      mx = fmaxf(__uint_as_float(sw[0]), __uint_as_float(sw[1])); }
    const bool up = mx > m + 8.f;
    const float mn = up ? mx - 4.f : m, alpha = __builtin_amdgcn_exp2f(m - mn);
    const bool resc = __any(up);
    m = mn;
    float ls = 0.f;
    A8_SB();
#pragma unroll
    for (int r = 0; r < 16; ++r) A8_EXP(c0, r)
#pragma unroll
    for (int r = 0; r < 16; ++r) A8_EXP(c1, r)
    A8_SB();
    unsigned X[4], Y[4];
#pragma unroll
    for (int i = 0; i < 4; ++i) {
      int w, z; asm volatile("" : "=v"(w)); asm volatile("" : "=v"(z));
      w = __builtin_amdgcn_cvt_pk_fp8_f32(c0[4 * i], c0[4 * i + 1], w, false); w = __builtin_amdgcn_cvt_pk_fp8_f32(c0[4 * i + 2], c0[4 * i + 3], w, true); X[i] = (unsigned)w;
      z = __builtin_amdgcn_cvt_pk_fp8_f32(c1[4 * i], c1[4 * i + 1], z, false); z = __builtin_amdgcn_cvt_pk_fp8_f32(c1[4 * i + 2], c1[4 * i + 3], z, true); Y[i] = (unsigned)z; }
#pragma unroll
    for (int i = 0; i < 4; ++i) { const auto rr = __builtin_amdgcn_permlane32_swap(X[i], Y[i], false, false); X[i] = rr[0]; Y[i] = rr[1]; }
    pb = (v8i_t){(int)X[0], (int)X[1], (int)X[2], (int)X[3], (int)Y[0], (int)Y[1], (int)Y[2], (int)Y[3]};
    asm volatile("" : "+v"(pb));
    l = l * alpha + ls;
    A8_SB();
    if (resc) {
#pragma unroll
      for (int b = 0; b < DVB; ++b)
#pragma unroll
        for (int r = 0; r < 16; ++r) o[b][r] *= alpha;
    }
    }
    A8_SB();
    if (!late) {
      if (on_nxt) A8_QKM();
      if (on) A8_PVM();
#pragma unroll
      for (int b = 0; b < DVB; ++b) asm volatile("" : "+v"(o[b]));
      asm volatile("" : "+v"(c0), "+v"(c1));
    }
    A8_SB();
    if (!(AB8 & 4)) { if (kt + 2 < ntiles) A8_STORE(st_fill); }
    if (!(AB8 & 8)) __syncthreads();
    if (!(AB8 & 4)) { if (kt + 3 < ntiles) A8_LOAD(kt + 3); }
    { const int t = st_cur; st_cur = st_nxt; st_nxt = st_fill; st_fill = t; }
  }
  if (late && act(ntiles - 1)) A8_PVM();
  l *= 0.0625f;
#undef A8_ISK
#undef A8_LOAD
#undef A8_STORE
#undef A8_SB
#undef A8_EXP
#undef A8_KREAD
#undef A8_VREAD
#undef A8_QKM
#undef A8_PVM
}

#ifndef OUT_FP8
#define OUT_FP8 1
#endif
DEVI void st_att4(bf16_t* ATT, size_t row, int col, float a, float b, float c, float d) {
  if (OUT_FP8) *(unsigned*)((unsigned char*)ATT + row * DM + col) = nv::pack4_fp8(a * 4.f, b * 4.f, c * 4.f, d * 4.f);
  else { uint2 w; w.x = cvtpk(a, b); w.y = cvtpk(c, d); *(uint2*)(ATT + row * DM + col) = w; }
}
DEVI int vblock() { const int G = gridDim.x, bx = blockIdx.x; return (G % 8 == 0) ? (bx % 8) * (G / 8) + bx / 8 : bx; }

template <int ABL = 0> DEVI void phase_attnA(const Params& p, ldsp_t lds) {
  typedef Geo<128, 4> G;
  const int tid = ftid(), lane = tid & 63, wave = __builtin_amdgcn_readfirstlane(tid >> 6), r32 = lane & 31, hi = lane >> 5;
  const bf16_t* Q = (const bf16_t*)(p.ws + WS_QKV0); bf16_t* ATT = (bf16_t*)(p.ws + (ABL ? WS_MIX0 : WS_ATT0));
  const float lam = ((const float*)(p.ws + WS_CTL + CTL_LAM))[0];
  const int s = wave >> 2, qb = wave & 3;
  constexpr int NU_LAT = NB * 4 * 32, NU_CTX = NB * 4 * 2;
  for (int u = vblock(); u < NU_LAT + NU_CTX; u += gridDim.x) {
    int b, h, row0, ntiles; bool lat = u < NU_LAT;
    if (lat) { b = u >> 7; h = (u >> 5) & 3; row0 = b * SEQ + (u & 31) * 128; ntiles = 68; }
    else { const int v = u - NU_LAT; b = v >> 3; h = (v >> 1) & 3; row0 = NLAT + b * CTXL + (v & 1) * 128; ntiles = 4; }
    const int qrow = row0 + qb * 32 + r32;
    bf16x8 q[4];
#pragma unroll
    for (int d0 = 0; d0 < 4; ++d0) q[d0] = load_q8(Q + (size_t)qrow * N_IN0 + h * 128 + s * 64 + 16 * d0 + 8 * hi, C2);
    f32x16 o[4];
#pragma unroll
    for (int bk = 0; bk < 4; ++bk)
#pragma unroll
      for (int r = 0; r < 16; ++r) o[bk][r] = 0.f;
    float m = -1e30f, l = 0.f;
    const int cbase = NLAT + b * CTXL, lbase = b * SEQ;
#if ATTNA_FP8
    const unsigned char* QK8 = (const unsigned char*)(p.ws + WS_QKV0);
    v8i_t qf;
    { const unsigned char* qp = QK8 + (size_t)qrow * (N_IN0 * 2) + h * 128 + s * 64 + 32 * hi; const u32x4 q0_ = *(const u32x4*)qp, q1_ = *(const u32x4*)(qp + 16); qf = cat8(q0_, q1_); }
    flash_pass8<4, 128, ABL>(lds, ntiles, QK8, N_IN0 * 2, 512 + h * 128, (const unsigned char*)(p.ws + WS_VT) + (size_t)((b * 4 + h) * 128) * 4352, qf, s, s != 0,
      [&](int kt, int i) { return lat ? (kt < 64 ? lbase + kt * 64 + i : cbase + (kt - 64) * 64 + i) : cbase + kt * 64 + i; },
      [&](int kt) { return (lat ? 0 : 4096) + kt * 64; }, [&](int, f32x16&, f32x16&) {}, [&](int) { return true; }, o, m, l);
#else
    flash_pass2<128, 4, ABL, 1>(lds, ntiles, Q, N_IN0, 512 + h * 128, 1024 + h * 128, q, s * 64,
      [&](int kt, int i) { return lat ? (kt < 64 ? lbase + kt * 64 + i : cbase + (kt - 64) * 64 + i) : cbase + kt * 64 + i; },
      [&](int, f32x16&, f32x16&) {}, o, m, l);
#endif
    l += __shfl_xor(l, 32);
    const float inv = 1.f / l;
    FA_LAS float* X = (FA_LAS float*)lds;
    if (s == 1) {
#pragma unroll
      for (int bk = 0; bk < 4; ++bk)
#pragma unroll
        for (int r = 0; r < 16; ++r) X[((qb * 4 + bk) * 16 + r) * 64 + lane] = o[bk][r] * inv;
    }
    __syncthreads();
    if (s == 0) {
      float ss = 0.f;
#pragma unroll
      for (int bk = 0; bk < 4; ++bk)
#pragma unroll
        for (int r = 0; r < 16; ++r) { const float d = o[bk][r] * inv - lam * X[((qb * 4 + bk) * 16 + r) * 64 + lane]; o[bk][r] = d; ss += d * d; }
      ss += __shfl_xor(ss, 32);
      const float rr = rsqrtf(ss * (1.f / 128.f) + EPS) * 0.8f;
      const float* g = p.in[L0_SUBLN];
#pragma unroll
      for (int bk = 0; bk < 4; ++bk)
#pragma unroll
        for (int rg = 0; rg < 4; ++rg) { const int dv = bk * 32 + 8 * rg + 4 * hi; const float4 gv = *(const float4*)(g + dv);
          st_att4(ATT, (size_t)qrow, h * 128 + dv, o[bk][4 * rg] * rr * gv.x, o[bk][4 * rg + 1] * rr * gv.y, o[bk][4 * rg + 2] * rr * gv.z, o[bk][4 * rg + 3] * rr * gv.w); }
    }
    __syncthreads();
  }
}

template <int ABL = 0> DEVI void phase_attnB(const Params& p, ldsp_t lds) {
  typedef Geo<64, 2> G;
  const int tid = ftid(), lane = tid & 63, wave = __builtin_amdgcn_readfirstlane(tid >> 6), r32 = lane & 31, hi = lane >> 5;
  const bf16_t* Q = (const bf16_t*)(p.ws + WS_QKV0); bf16_t* ATT = (bf16_t*)(p.ws + (ABL ? WS_MIX0 : WS_ATT0));
  constexpr int NU_LAT = NB * 8 * 16, NU_CTX = NB * 8;
  FA_LAS float* RPB = (FA_LAS float*)(lds + 3 * (64 * 80 + 64 * 80));
  for (int u = vblock(); u < NU_LAT + NU_CTX; u += gridDim.x) {
    const bool lat = u < NU_LAT;
    int b, h, qrow_g = 0, c0 = 0, rlo = 0, nlat = 0, rs_w = 0, grow;
    if (lat) { b = u >> 7; h = (u >> 4) & 7; const int qr0 = (u & 15) * 4; qrow_g = qr0 + (wave >> 1); c0 = 32 * (wave & 1);
      rlo = min(max(qr0 - 4, 0), 56); const int rhi = min(max(qr0 - 1, 0), 56) + 7; nlat = rhi - rlo + 1; rs_w = min(max(qrow_g - 4, 0), 56);
      grow = b * SEQ + qrow_g * 64 + c0 + r32; }
    else { const int v = u - NU_LAT; b = v >> 3; h = v & 7; grow = NLAT + b * CTXL + wave * 32 + r32; }
    const int ntiles = nlat + 4;
    for (int i = tid; i < 15 * 31; i += NT) RPB[i] = p.in[L0_RPB][h * 465 + i] * LOG2E;
    const unsigned char* QK8 = (const unsigned char*)(p.ws + WS_QKV0);
    v8i_t qf;
    { const unsigned char* qp = QK8 + (size_t)grow * (N_IN0 * 2) + 1536 + h * 64 + 32 * hi; const u32x4 q0_ = *(const u32x4*)qp, q1_ = *(const u32x4*)(qp + 16); qf = cat8(q0_, q1_); }
    f32x16 o[2];
#pragma unroll
    for (int bk = 0; bk < 2; ++bk)
#pragma unroll
      for (int r = 0; r < 16; ++r) o[bk][r] = 0.f;
    float m = -1e30f, l = 0.f;
    const int cbase = NLAT + b * CTXL, lbase = b * SEQ;
    const int qc = c0 + r32, cs = min(max(qc - 8, 0), 48);
    flash_pass8<2, 64>(lds, ntiles, QK8, N_IN0 * 2, 2048 + h * 64, (const unsigned char*)(p.ws + WS_VTB) + (size_t)((b * 8 + h) * 64) * 4352, qf, 0, wave >= 4,
      [&](int kt, int i) { return kt < nlat ? lbase + (rlo + kt) * 64 + i : cbase + (kt - nlat) * 64 + i; },
      [&](int kt) { return kt < nlat ? (rlo + kt) * 64 : 4096 + (kt - nlat) * 64; },
      [&](int kt, f32x16& p0, f32x16& p1) {
        if (ABL != 1 && kt < nlat) { const int kr = rlo + kt; const bool rowok = (kr >= rs_w && kr < rs_w + 8);
          const FA_LAS float* bp = RPB + min(max(kr - qrow_g + 7, 0), 14) * 31;
          { float b0[16];
#pragma unroll
            for (int r = 0; r < 16; ++r) { const int k0 = crow(r, hi); b0[r] = bp[min(max(k0 - qc + 15, 0), 30)]; }
#pragma unroll
            for (int r = 0; r < 16; ++r) { const int k0 = crow(r, hi); const float v0 = p0[r] + b0[r]; p0[r] = (rowok && k0 >= cs && k0 < cs + 16) ? v0 : -INFINITY; } }
          asm volatile("" ::: "memory");
          { float b1[16];
#pragma unroll
            for (int r = 0; r < 16; ++r) { const int k1 = 32 + crow(r, hi); b1[r] = bp[min(max(k1 - qc + 15, 0), 30)]; }
#pragma unroll
            for (int r = 0; r < 16; ++r) { const int k1 = 32 + crow(r, hi); const float v1 = p1[r] + b1[r]; p1[r] = (rowok && k1 >= cs && k1 < cs + 16) ? v1 : -INFINITY; } } } },
      [&](int kt) { const int kr = rlo + kt; return kt >= nlat || (kr >= rs_w && kr < rs_w + 8); },
      o, m, l);
    l += __shfl_xor(l, 32);
    const float inv = 1.f / l;
#pragma unroll
    for (int bk = 0; bk < 2; ++bk)
#pragma unroll
      for (int rg = 0; rg < 4; ++rg) { const int dv = bk * 32 + 8 * rg + 4 * hi;
        st_att4(ATT, (size_t)grow, 512 + h * 64 + dv, o[bk][4 * rg] * inv, o[bk][4 * rg + 1] * inv, o[bk][4 * rg + 2] * inv, o[bk][4 * rg + 3] * inv); }
    __syncthreads();
  }
}

DEVI void phase_attnC(const Params& p, ldsp_t lds, int* ctr) {
  const int tid = ftid(), lane = tid & 63, wave = __builtin_amdgcn_readfirstlane(tid >> 6), r32 = lane & 31, hi = lane >> 5;
  const bf16_t* P1 = (const bf16_t*)(p.ws + WS_P1); bf16_t* ATT = (bf16_t*)(p.ws + WS_ATT1);
  FA_LAS int* uq = (FA_LAS int*)(lds + 3 * Geo<64, 2>::STAGE + 64);
  for (;;) {
    if (tid == 0) *uq = atomicAdd(ctr, 1);
    __syncthreads();
    const int u = *uq;
    __syncthreads();
    if (u >= NB * 2 * 64) break;
    const int b = u >> 7, g = (u >> 6) & 1, tq = u & 63, hq = g * 4 + (wave >> 1), t = tq * 64 + 32 * (wave & 1) + r32, grow = b * SEQ + t;
    const int klo = max(tq - 2, 0), khi = min(tq + 2, 63), nwin = khi - klo + 1, ntiles = nwin + 4;
    bf16x8 q[4];
#pragma unroll
    for (int d0 = 0; d0 < 4; ++d0) q[d0] = load_q8(P1 + (size_t)grow * 2304 + hq * 64 + 16 * d0 + 8 * hi, C2);
    f32x16 o[2];
#pragma unroll
    for (int bk = 0; bk < 2; ++bk)
#pragma unroll
      for (int r = 0; r < 16; ++r) o[bk][r] = 0.f;
    float m = -1e30f, l = 0.f;
    const int cbase = NLAT + b * CTXL, lbase = b * SEQ;
    flash_pass2<64, 2, 0, 2>(lds, ntiles, P1, 2304, 512 + g * 64, 640 + g * 64, q, 0,
      [&](int kt, int i) { return kt < nwin ? lbase + (klo + kt) * 64 + i : cbase + (kt - nwin) * 64 + i; },
      [&](int kt, f32x16& p0, f32x16& p1) {
        if (kt < nwin) { const int kp = (klo + kt) * 64 - t;
#pragma unroll
          for (int r = 0; r < 16; ++r) { const int d0 = kp + crow(r, hi), d1 = d0 + 32;
            if (d0 < -128 || d0 > 128) p0[r] = -INFINITY; if (d1 < -128 || d1 > 128) p1[r] = -INFINITY; } } },
      o, m, l);
    l += __shfl_xor(l, 32);
    { const float sk = p.in[L1_SINKS][hq] * LOG2E, mn = fmaxf(m, sk), alpha = __builtin_amdgcn_exp2f(m - mn);
      l = l * alpha + __builtin_amdgcn_exp2f(sk - mn);
#pragma unroll
      for (int bk = 0; bk < 2; ++bk)
#pragma unroll
        for (int r = 0; r < 16; ++r) o[bk][r] *= alpha; }
    const float inv = 1.f / l;
#pragma unroll
    for (int bk = 0; bk < 2; ++bk)
#pragma unroll
      for (int rg = 0; rg < 4; ++rg) { const int dv = bk * 32 + 8 * rg + 4 * hi;
        st_att4(ATT, (size_t)grow, hq * 64 + dv, o[bk][4 * rg] * inv, o[bk][4 * rg + 1] * inv, o[bk][4 * rg + 2] * inv, o[bk][4 * rg + 3] * inv); }
    __syncthreads();
  }
}
}
namespace fs {
using fa::bf16x8; using fa::s16x4; using fa::f32x16; using fa::ldsp_t; using fa::u32x4; using fa::cvtpk; using fa::vtr; using fa::crow; using fa::LOG2E;
typedef unsigned u32x2 __attribute__((ext_vector_type(2)));

DEVI void phase_conv(const Params& p) {
  const bf16_t* P1 = (const bf16_t*)(p.ws + WS_P1); bf16_t* U = (bf16_t*)(p.ws + WS_U);
  const float* cw = p.in[L1_CONVW]; const float* cb = p.in[L1_CONVB];
  const int nitems = (NROW / 16) * 128;
  for (int it = blockIdx.x * NT + ftid(); it < nitems; it += gridDim.x * NT) {
    const int cg = it & 127, rc = it >> 7, r0 = rc * 16, ch = cg * 8;
    int s0, len; if (r0 < NLAT) { s0 = r0 & ~4095; len = SEQ; } else { s0 = NLAT + ((r0 - NLAT) & ~255); len = CTXL; }
    const int t0 = r0 - s0;
    float w[5][8], bias[8];
#pragma unroll
    for (int j = 0; j < 5; ++j) { const float4 a = *(const float4*)(cw + j * 1024 + ch), b = *(const float4*)(cw + j * 1024 + ch + 4);
      w[j][0] = a.x; w[j][1] = a.y; w[j][2] = a.z; w[j][3] = a.w; w[j][4] = b.x; w[j][5] = b.y; w[j][6] = b.z; w[j][7] = b.w; }
    { const float4 a = *(const float4*)(cb + ch), b = *(const float4*)(cb + ch + 4); bias[0] = a.x; bias[1] = a.y; bias[2] = a.z; bias[3] = a.w; bias[4] = b.x; bias[5] = b.y; bias[6] = b.z; bias[7] = b.w; }
    float win[5][8];
    auto ldrow = [&](int t, float (&d)[8]) {
      if (t < 0 || t >= len) {
#pragma unroll
        for (int k = 0; k < 8; ++k) d[k] = 0.f; return; }
      const u32x4 v = *(const u32x4*)(P1 + (size_t)(s0 + t) * 2304 + 768 + ch);
#pragma unroll
      for (int k = 0; k < 4; ++k) { d[2 * k] = __uint_as_float(v[k] << 16); d[2 * k + 1] = __uint_as_float(v[k] & 0xffff0000u); } };
    ldrow(t0 - 2, win[0]); ldrow(t0 - 1, win[1]); ldrow(t0, win[2]); ldrow(t0 + 1, win[3]);
#pragma unroll
    for (int i = 0; i < 16; ++i) {
      ldrow(t0 + i + 2, win[(i + 4) % 5]);
      float o[8];
#pragma unroll
      for (int k = 0; k < 8; ++k) { float a = bias[k];
#pragma unroll
        for (int j = 0; j < 5; ++j) a += w[j][k] * win[(i + j) % 5][k];
        o[k] = a * __builtin_amdgcn_rcpf(1.f + __expf(-a)); }
      u32x4 ov; ov[0] = cvtpk(o[0], o[1]); ov[1] = cvtpk(o[2], o[3]); ov[2] = cvtpk(o[4], o[5]); ov[3] = cvtpk(o[6], o[7]);
      *(u32x4*)(U + (size_t)(r0 + i) * 1024 + ch) = ov;
    }
  }
}

DEVI float softplus_f(float v) { if (v > 20.f) return v; const float x = __expf(v); return x < 1e-3f ? x * (1.f - 0.5f * x) : __logf(1.f + x); }
constexpr int BSTR = 272, XSTR = 192;
constexpr int L_BM = 0, L_XD = 128 * BSTR, L_XW = L_XD + 128 * XSTR, L_HT = L_XW + 128 * XSTR, L_CUM = L_HT + 128 * XSTR, L_DTV = L_CUM + 1024, L_XCH = L_DTV + 1024, L_TOT = L_XCH + 8 * 4096;

template <int ABL = 0> DEVI void phase_ssd(const Params& p, ldsp_t lds) {
  const int tid = ftid(), lane = tid & 63, wave = __builtin_amdgcn_readfirstlane(tid >> 6), r32 = lane & 31, hi = lane >> 5;
  const int pb = wave >> 2, lb = (wave < 4) ? (wave & 3) : 3 - (wave & 3);
  const bf16_t* U = (const bf16_t*)(p.ws + WS_U); const float* DT = (const float*)(p.ws + WS_DT);
  bf16_t* YFB = (bf16_t*)(p.ws + WS_YS);
  const int trow_off = 4 * hi + ((lane & 15) >> 2), tcol_off = 32 * ((lane >> 4) & 1) + 8 * (lane & 3);
  for (int it = blockIdx.x; it < NB * 2 * 8; it += gridDim.x) {
    const int b = it >> 4, dir = (it >> 3) & 1, hd = it & 7, g = hd >> 2;
    const float a2 = -expf(p.in[dir ? L1_ALOGB : L1_ALOGF][hd]) * LOG2E; const float dtb = p.in[dir ? L1_DTBB : L1_DTBF][hd];
    auto tokrow = [&](int c, int i) { const int seg = c >= 2, len = seg ? SEQ : CTXL, j = (seg ? c - 2 : c) * 128 + i; return (seg ? b * SEQ : NLAT + b * CTXL) + (dir ? len - 1 - j : j); };
    f32x16 hacc;
#pragma unroll
    for (int r = 0; r < 16; ++r) hacc[r] = 0.f;
    for (int i = tid; i < 128 * XSTR / 4; i += NT) ((FA_LAS unsigned*)(lds + L_HT))[i] = 0u;
    u32x4 sb_[4], sx_[2]; float sdt0 = 0.f, sdt1 = 0.f; bf16x8 cfn[8];
    auto prefetch = [&](int c) {
#pragma unroll
      for (int i = 0; i < 4; ++i) { const int ch = tid + NT * i; sb_[i] = *(const u32x4*)(U + (size_t)tokrow(c, ch >> 4) * 1024 + 512 + g * 128 + (ch & 15) * 8); }
#pragma unroll
      for (int i = 0; i < 2; ++i) { const int ch = tid + NT * i; sx_[i] = *(const u32x4*)(U + (size_t)tokrow(c, ch >> 3) * 1024 + hd * 64 + (ch & 7) * 8); }
      if (tid < 64) { sdt0 = DT[(size_t)tokrow(c, 2 * tid) * 16 + dir * 8 + hd]; sdt1 = DT[(size_t)tokrow(c, 2 * tid + 1) * 16 + dir * 8 + hd]; }
      const bf16_t* crowp = U + (size_t)tokrow(c, lb * 32 + r32) * 1024 + 768 + g * 128 + 8 * hi;
#pragma unroll
      for (int ks = 0; ks < 8; ++ks) cfn[ks] = *(const bf16x8*)(crowp + 16 * ks);
    };
    auto s1 = [&](int c) {
      if (tid < 64) {
        FA_LAS float* CUMw = (FA_LAS float*)(lds + L_CUM + (c & 1) * 512); FA_LAS float* DTVw = (FA_LAS float*)(lds + L_DTV + (c & 1) * 512);
        const float r0 = sdt0 + dtb, r1 = sdt1 + dtb; const float d0 = softplus_f(r0), d1 = softplus_f(r1);
        const float a0 = d0 * a2, a1 = d1 * a2; float v = a0 + a1;
        v = wave_scan_incl(v);
        DTVw[2 * tid] = d0; DTVw[2 * tid + 1] = d1; CUMw[2 * tid] = v - a1; CUMw[2 * tid + 1] = v;
      } };
    prefetch(0);
    s1(0);
    __syncthreads();
    for (int c = 0; c < 34; ++c) {
      const FA_LAS float* CUM = (const FA_LAS float*)(lds + L_CUM + (c & 1) * 512); const FA_LAS float* DTV = (const FA_LAS float*)(lds + L_DTV + (c & 1) * 512);
      const float cl = CUM[127];
#pragma unroll
      for (int i = 0; i < 4; ++i) { const int ch = tid + NT * i; *(FA_LAS u32x4*)(lds + L_BM + (ch >> 4) * BSTR + (ch & 15) * 16) = sb_[i]; }
#pragma unroll
      for (int i = 0; i < 2; ++i) { const int ch = tid + NT * i, s = ch >> 3; const float d = DTV[s], wv = d * __builtin_amdgcn_exp2f(cl - CUM[s]);
        u32x4 xd, xw;
#pragma unroll
        for (int k = 0; k < 4; ++k) { const float x0 = __uint_as_float(sx_[i][k] << 16), x1 = __uint_as_float(sx_[i][k] & 0xffff0000u); xd[k] = cvtpk(x0 * d, x1 * d); xw[k] = cvtpk(x0 * wv, x1 * wv); }
        *(FA_LAS u32x4*)(lds + L_XD + s * XSTR + (ch & 7) * 16) = xd; *(FA_LAS u32x4*)(lds + L_XW + s * XSTR + (ch & 7) * 16) = xw; }
      bf16x8 cf[8];
#pragma unroll
      for (int ks = 0; ks < 8; ++ks) cf[ks] = cfn[ks];
      __syncthreads();
      if (ABL != 3) { if (c + 1 < 34) prefetch(c + 1); }
      if (c >= 2 && ABL != 1) {
        f32x16 y;
#pragma unroll
        for (int r = 0; r < 16; ++r) y[r] = 0.f;
        { const ldsp_t hb = lds + L_HT + (8 * hi + ((lane & 15) >> 2)) * XSTR + pb * 64 + tcol_off;
          f32x16 y2;
#pragma unroll
          for (int r = 0; r < 16; ++r) y2[r] = 0.f;
#pragma unroll
          for (int ks = 0; ks < 8; ++ks) { const s16x4 lo = vtr(hb + (16 * ks) * XSTR), h8 = vtr(hb + (16 * ks + 4) * XSTR);
            const bf16x8 hf = {lo[0], lo[1], lo[2], lo[3], h8[0], h8[1], h8[2], h8[3]};
            if (ks & 1) y2 = __builtin_amdgcn_mfma_f32_32x32x16_bf16(hf, cf[ks], y2, 0, 0, 0); else y = __builtin_amdgcn_mfma_f32_32x32x16_bf16(hf, cf[ks], y, 0, 0, 0); }
          y += y2; }
        const float cuml = CUM[lb * 32 + r32];
        { const float e = __builtin_amdgcn_exp2f(cuml);
#pragma unroll
          for (int r = 0; r < 16; ++r) y[r] *= e; }
        f32x16 yo;
#pragma unroll
        for (int r = 0; r < 16; ++r) yo[r] = 0.f;
        for (int sb = pb; sb <= lb; sb += 2) {
          f32x16 gt, gt2;
#pragma unroll
          for (int r = 0; r < 16; ++r) { gt[r] = 0.f; gt2[r] = 0.f; }
          const ldsp_t bb = lds + L_BM + (sb * 32 + r32) * BSTR + 16 * hi;
#pragma unroll
          for (int ks = 0; ks < 8; ks += 2) { gt = __builtin_amdgcn_mfma_f32_32x32x16_bf16(*(const FA_LAS bf16x8*)(bb + 32 * ks), cf[ks], gt, 0, 0, 0);
            gt2 = __builtin_amdgcn_mfma_f32_32x32x16_bf16(*(const FA_LAS bf16x8*)(bb + 32 * ks + 32), cf[ks + 1], gt2, 0, 0, 0); }
          gt += gt2;
          const bool diag = (sb == lb);
#pragma unroll
          for (int r = 0; r < 16; ++r) { const int sl = crow(r, hi); const float v = gt[r] * __builtin_amdgcn_exp2f(cuml - CUM[sb * 32 + sl]); gt[r] = (diag && sl > r32) ? 0.f : v; }
          u32x4 t0, t1;
          t0[0] = cvtpk(gt[0], gt[1]); t0[1] = cvtpk(gt[2], gt[3]); t0[2] = cvtpk(gt[4], gt[5]); t0[3] = cvtpk(gt[6], gt[7]);
          t1[0] = cvtpk(gt[8], gt[9]); t1[1] = cvtpk(gt[10], gt[11]); t1[2] = cvtpk(gt[12], gt[13]); t1[3] = cvtpk(gt[14], gt[15]);
          const bf16x8 pm0 = __builtin_bit_cast(bf16x8, t0), pm1 = __builtin_bit_cast(bf16x8, t1);
          const ldsp_t xb = lds + L_XD + (sb * 32 + trow_off) * XSTR + pb * 64 + tcol_off;
          const ldsp_t xo = lds + L_XD + (sb * 32 + trow_off) * XSTR + (1 - pb) * 64 + tcol_off;
          const s16x4 a0 = vtr(xb), a1 = vtr(xb + 8 * XSTR), a2 = vtr(xb + 16 * XSTR), a3 = vtr(xb + 24 * XSTR);
          const s16x4 b0 = vtr(xo), b1 = vtr(xo + 8 * XSTR), b2 = vtr(xo + 16 * XSTR), b3 = vtr(xo + 24 * XSTR);
          { const bf16x8 xf = {a0[0], a0[1], a0[2], a0[3], a1[0], a1[1], a1[2], a1[3]}; y = __builtin_amdgcn_mfma_f32_32x32x16_bf16(xf, pm0, y, 0, 0, 0); }
          { const bf16x8 xf = {b0[0], b0[1], b0[2], b0[3], b1[0], b1[1], b1[2], b1[3]}; yo = __builtin_amdgcn_mfma_f32_32x32x16_bf16(xf, pm0, yo, 0, 0, 0); }
          { const bf16x8 xf = {a2[0], a2[1], a2[2], a2[3], a3[0], a3[1], a3[2], a3[3]}; y = __builtin_amdgcn_mfma_f32_32x32x16_bf16(xf, pm1, y, 0, 0, 0); }
          { const bf16x8 xf = {b2[0], b2[1], b2[2], b2[3], b3[0], b3[1], b3[2], b3[3]}; yo = __builtin_amdgcn_mfma_f32_32x32x16_bf16(xf, pm1, yo, 0, 0, 0); }
        }
        { FA_LAS float* X = (FA_LAS float*)(lds + L_XCH) + (pb * 4 + lb) * 1024;
#pragma unroll
          for (int r = 0; r < 16; ++r) X[r * 64 + lane] = yo[r]; }
        __syncthreads();
        { const FA_LAS float* X = (const FA_LAS float*)(lds + L_XCH) + ((1 - pb) * 4 + lb) * 1024;
#pragma unroll
          for (int r = 0; r < 16; ++r) y[r] += X[r * 64 + lane]; }
        const int j = (c - 2) * 128 + lb * 32 + r32, tok = dir ? SEQ - 1 - j : j;
        bf16_t* yp = YFB + ((size_t)dir * NLAT + (size_t)b * SEQ + tok) * 512 + hd * 64 + pb * 32 + 4 * hi;
#pragma unroll
        for (int rg = 0; rg < 4; ++rg) { u32x2 w; w[0] = cvtpk(y[4 * rg], y[4 * rg + 1]); w[1] = cvtpk(y[4 * rg + 2], y[4 * rg + 3]); *(u32x2*)(yp + 8 * rg) = w; }
      }
      if (ABL != 2) { const float e = __builtin_amdgcn_exp2f(cl);
        f32x16 h2;
#pragma unroll
        for (int r = 0; r < 16; ++r) { hacc[r] *= e; h2[r] = 0.f; }
        const ldsp_t xb = lds + L_XW + (8 * hi + ((lane & 15) >> 2)) * XSTR + pb * 64 + tcol_off;
        const ldsp_t bb = lds + L_BM + (8 * hi + ((lane & 15) >> 2)) * BSTR + lb * 64 + tcol_off;
#pragma unroll
        for (int ks = 0; ks < 8; ++ks) {
          const s16x4 xl = vtr(xb + (16 * ks) * XSTR), xh = vtr(xb + (16 * ks + 4) * XSTR), bl = vtr(bb + (16 * ks) * BSTR), bh = vtr(bb + (16 * ks + 4) * BSTR);
          const bf16x8 xf = {xl[0], xl[1], xl[2], xl[3], xh[0], xh[1], xh[2], xh[3]}, bf = {bl[0], bl[1], bl[2], bl[3], bh[0], bh[1], bh[2], bh[3]};
          if (ks & 1) h2 = __builtin_amdgcn_mfma_f32_32x32x16_bf16(xf, bf, h2, 0, 0, 0); else hacc = __builtin_amdgcn_mfma_f32_32x32x16_bf16(xf, bf, hacc, 0, 0, 0);
        }
        hacc += h2; }
      if (c + 1 < 34) s1(c + 1);
      __syncthreads();
      { const ldsp_t hp = lds + L_HT + (lb * 32 + r32) * XSTR + (pb * 32 + 4 * hi) * 2;
#pragma unroll
        for (int rg = 0; rg < 4; ++rg) { u32x2 w; w[0] = cvtpk(hacc[4 * rg], hacc[4 * rg + 1]); w[1] = cvtpk(hacc[4 * rg + 2], hacc[4 * rg + 3]); *(FA_LAS u32x2*)(hp + 16 * rg) = w; } }
    }
    __syncthreads();
  }
}

DEVI void phase_ssd_out(const Params& p) {
  const int lane = ftid() & 63, gw = blockIdx.x * NWAVE + (ftid() >> 6), NGW = gridDim.x * NWAVE;
  const bf16_t* U = (const bf16_t*)(p.ws + WS_U); const bf16_t* P1 = (const bf16_t*)(p.ws + WS_P1); const bf16_t* YFB = (const bf16_t*)(p.ws + WS_YS);
  bf16_t* ATT = (bf16_t*)(p.ws + WS_ATT1);
  for (int r = gw; r < NLAT; r += NGW) {
    const int c0 = lane * 8, hd = c0 >> 6; const float dsk = p.in[L1_DSKIP][hd];
    const u32x4 yf = *(const u32x4*)(YFB + (size_t)r * 512 + c0), yb = *(const u32x4*)(YFB + ((size_t)NLAT + r) * 512 + c0);
    const u32x4 xw = *(const u32x4*)(U + (size_t)r * 1024 + c0), zw = *(const u32x4*)(P1 + (size_t)r * 2304 + 1792 + c0);
    float y[8]; float ss = 0.f;
#pragma unroll
    for (int i = 0; i < 4; ++i) {
      const float x0 = __uint_as_float(xw[i] << 16), x1 = __uint_as_float(xw[i] & 0xffff0000u), z0 = __uint_as_float(zw[i] << 16), z1 = __uint_as_float(zw[i] & 0xffff0000u);
      const float f0 = __uint_as_float(yf[i] << 16) + __uint_as_float(yb[i] << 16), f1 = __uint_as_float(yf[i] & 0xffff0000u) + __uint_as_float(yb[i] & 0xffff0000u);
      y[2 * i] = (f0 + dsk * x0) * silu_f(z0); y[2 * i + 1] = (f1 + dsk * x1) * silu_f(z1);
      ss += y[2 * i] * y[2 * i] + y[2 * i + 1] * y[2 * i + 1];
    }
    ss = half_sum(ss);
    const float rr = rsqrtf(ss * (1.f / 256.f) + EPS);
    const float4 g0 = *(const float4*)(p.in[L1_GNORM] + c0), g1 = *(const float4*)(p.in[L1_GNORM] + c0 + 4);
    u32x4 w; w[0] = cvtpk(y[0] * rr * g0.x, y[1] * rr * g0.y); w[1] = cvtpk(y[2] * rr * g0.z, y[3] * rr * g0.w); w[2] = cvtpk(y[4] * rr * g1.x, y[5] * rr * g1.y); w[3] = cvtpk(y[6] * rr * g1.z, y[7] * rr * g1.w);
    *(u32x4*)(ATT + (size_t)r * DM + 512 + c0) = w;
  }
}
}
#ifndef TOPK_COPY
#define TOPK_COPY false
#endif
namespace ft {
using fa::ldsp_t; using fa::u32x4;

DEVI int block_excl_scan(int v, FA_LAS int* wsum, int tid, int* tot) {
  const int lane = tid & 63, wave = tid >> 6;
  const int inc = wave_scan_incl_i(v);
  __syncthreads();
  if (lane == 63) wsum[wave] = inc;
  __syncthreads();
  int base = 0, total = 0;
#pragma unroll
  for (int w = 0; w < 8; ++w) { const int s = wsum[w]; if (w < wave) base += s; total += s; }
  *tot = total;
  return base + inc - v;
}

template <int EPT, bool GATHER_COPY, int ABL = 0>
DEVI void topk_item(const Params& p, ldsp_t lds, int e, int n, int cap, int row0, int slot0, int erows) {
  const int tid = ftid(), lane = tid & 63, wave = tid >> 6;
  const float* AFFT = (const float*)(p.ws + WS_AFF); int* SLOT = (int*)(p.ws + WS_SLOT); float* GV = (float*)(p.ws + WS_GATEV);
  const bf16_t* H = (const bf16_t*)(p.ws + WS_H); bf16_t* XG = (bf16_t*)(p.ws + WS_XG); int* IDX = (int*)(p.ws + WS_IDX);
  FA_LAS unsigned* hist = (FA_LAS unsigned*)lds;
  FA_LAS int* misc = (FA_LAS int*)(lds + 1024);
  FA_LAS int* wsum = (FA_LAS int*)(lds + 1024 + 64);
  FA_LAS int* list = (FA_LAS int*)(lds + 2048);
  const bool act = tid * EPT < n;
  unsigned key[EPT];
#pragma unroll
  for (int j = 0; j < EPT; ++j) key[j] = act ? __float_as_uint(AFFT[(size_t)e * NROW + row0 + tid * EPT + j]) : 0u;
  unsigned prefix = 0u, mask = 0u; int k = cap;
#pragma unroll 1
  for (int pass = 0; pass < 4; ++pass) {
    const int shift = 24 - 8 * pass;
    __syncthreads();
    if (tid < 256) hist[tid] = 0u;
    __syncthreads();
    if (act) {
#pragma unroll
      for (int j = 0; j < EPT; ++j) if ((key[j] & mask) == prefix) atomicAdd((unsigned*)&hist[(key[j] >> shift) & 255u], 1u);
    }
    __syncthreads();
    if (wave == 0) {
      const int h0 = hist[4 * lane], h1 = hist[4 * lane + 1], h2 = hist[4 * lane + 2], h3 = hist[4 * lane + 3];
      const int s = h0 + h1 + h2 + h3; const int pre = wave_scan_incl_i(s);
      int c = __builtin_amdgcn_readlane(pre, 63) - pre;
      const int hh[4] = {h0, h1, h2, h3};
#pragma unroll
      for (int b = 3; b >= 0; --b) { if (c < k && k <= c + hh[b]) { misc[0] = 4 * lane + b; misc[1] = k - c; } c += hh[b]; }
    }
    __syncthreads();
    prefix |= ((unsigned)misc[0]) << shift; mask |= 255u << shift; k = misc[1];
  }
  int ce = 0;
#pragma unroll
  for (int j = 0; j < EPT; ++j) ce += (act && key[j] == prefix) ? 1 : 0;
  int tot; const int eq_before = block_excl_scan(ce, wsum, tid, &tot);
  int cs = 0, eqr = eq_before; bool sel[EPT];
#pragma unroll
  for (int j = 0; j < EPT; ++j) { bool s = false; if (act) { if (key[j] > prefix) s = true; else if (key[j] == prefix) { s = eqr < k; ++eqr; } } sel[j] = s; cs += s ? 1 : 0; }
  int slot = block_excl_scan(cs, wsum, tid, &tot);
  if (act) {
    int sv[EPT];
#pragma unroll
    for (int j = 0; j < EPT; ++j) { const int row = row0 + tid * EPT + j;
      if (sel[j]) { if (GATHER_COPY) list[slot] = row; else IDX[e * erows + slot0 + slot] = row; GV[e * erows + slot0 + slot] = __uint_as_float(key[j]); sv[j] = slot0 + slot; ++slot; }
      else sv[j] = -1; }
    if (ABL != 1) {
      int* sp = SLOT + (size_t)e * NROW + row0 + tid * EPT;
      if (EPT == 8) { *(int4*)sp = make_int4(sv[0], sv[1 % EPT], sv[2 % EPT], sv[3 % EPT]); *(int4*)(sp + 4) = make_int4(sv[4 % EPT], sv[5 % EPT], sv[6 % EPT], sv[7 % EPT]); }
      else {
#pragma unroll
        for (int j = 0; j < EPT; ++j) sp[j] = sv[j]; }
    }
  }
  if (GATHER_COPY) {
    __syncthreads();
    for (int s = wave; s < cap; s += NWAVE) {
      const u32x4* src = (const u32x4*)(H + (size_t)list[s] * DM) + lane; u32x4* dst = (u32x4*)(XG + ((size_t)e * erows + slot0 + s) * DM) + lane;
      const u32x4 a = src[0], b2 = src[64]; dst[0] = a; dst[64] = b2;
    }
  }
  __syncthreads();
}

template <int ABL = 0> DEVI void phase_topk(const Params& p, ldsp_t lds, int layer) {
  const int erows = layer ? EROWS1 : EROWS0;
  const int nlat = NB * NE, nitems = nlat + (layer ? 0 : NB * NE);
  const int G = gridDim.x;
  for (int it = blockIdx.x; it < nitems; it += G) {
    if (it < nlat) { const int b = it / NE, e = it % NE; topk_item<8, TOPK_COPY, ABL>(p, lds, e, SEQ, CAP_L, b * SEQ, b * CAP_L, erows); }
    else { const int i2 = it - nlat, b = i2 / NE, e = i2 % NE; topk_item<1, TOPK_COPY, ABL>(p, lds, e, CTXL, CAP_C, NLAT + b * CTXL, NB * CAP_L + b * CAP_C, erows); }
  }
}
}
#ifndef MOE1_FP8
#define MOE1_FP8 1
#endif
#ifndef MOE0_FP8
#define MOE0_FP8 1
#endif
namespace fr {
using fa::ldsp_t; using fa::u32x4; using fa::cvtpk;
typedef unsigned u32x2 __attribute__((ext_vector_type(2)));
typedef float f32x4 __attribute__((ext_vector_type(4)));
struct V16 { f32x4 v[4]; };
DEVI V16 ldf(const float* r, int lane) { V16 o; const f32x4* q = (const f32x4*)r + lane;
#pragma unroll
  for (int j = 0; j < 4; ++j) o.v[j] = q[64 * j]; return o; }
struct B16 { u32x2 v[4]; };
DEVI B16 ldb_raw(const bf16_t* r, int lane) { B16 o; const u32x2* q = (const u32x2*)r + lane;
#pragma unroll
  for (int j = 0; j < 4; ++j) o.v[j] = q[64 * j]; return o; }
DEVI V16 b2v(const B16& b) { V16 o;
#pragma unroll
  for (int j = 0; j < 4; ++j) { o.v[j][0] = __uint_as_float(b.v[j][0] << 16); o.v[j][1] = __uint_as_float(b.v[j][0] & 0xffff0000u); o.v[j][2] = __uint_as_float(b.v[j][1] << 16); o.v[j][3] = __uint_as_float(b.v[j][1] & 0xffff0000u); }
  return o; }
DEVI void stf(float* r, int lane, const V16& o) { f32x4* q = (f32x4*)r + lane;
#pragma unroll
  for (int j = 0; j < 4; ++j) q[64 * j] = o.v[j]; }
DEVI void stb(bf16_t* r, int lane, const V16& o) { u32x2* q = (u32x2*)r + lane;
#pragma unroll
  for (int j = 0; j < 4; ++j) { u32x2 w; w[0] = cvtpk(o.v[j][0], o.v[j][1]); w[1] = cvtpk(o.v[j][2], o.v[j][3]); q[64 * j] = w; } }
DEVI float sumsq(const V16& o) { f32x4 s = o.v[0] * o.v[0];
#pragma unroll
  for (int j = 1; j < 4; ++j) s += o.v[j] * o.v[j];
  return wave_sum((s[0] + s[1]) + (s[2] + s[3])); }

DEVI void phase_prenorm0(const Params& p) {
  const int lane = ftid() & 63, gw = blockIdx.x * NWAVE + (ftid() >> 6), NGW = gridDim.x * NWAVE;
  const float* MOD = (const float*)(p.ws + WS_CTL + CTL_MOD); bf16_t* H = (bf16_t*)(p.ws + WS_H);
  const int rpw = (NROW + NGW - 1) / NGW;
  const int r0 = gw * rpw, r1 = min(r0 + rpw, NROW);
  if (r0 >= r1) return;
  const V16 g = ldf(p.in[L0_GPREMIX], lane);
  int cur = -1; V16 gs, sh;
  auto src = [&](int r) { return r < NLAT ? p.in[I_X] + (size_t)r * DM : p.in[I_CTX] + (size_t)(r - NLAT) * DM; };
  V16 xn = ldf(src(r0), lane), xn2 = xn;
  if (r0 + 1 < r1) xn2 = ldf(src(r0 + 1), lane);
  for (int r = r0; r < r1; ++r) {
    const V16 x = xn; xn = xn2; if (r + 2 < r1) xn2 = ldf(src(r + 2), lane);
    const int mr = row_modrow(r);
    if (mr != cur) { cur = mr; const float* m = MOD + (size_t)mr * 6144; const V16 sc = ldf(m + 1024, lane); sh = ldf(m, lane);
#pragma unroll
      for (int j = 0; j < 4; ++j) gs.v[j] = g.v[j] * (sc.v[j] + 1.f); }
    const float rr = rsqrtf(sumsq(x) * (1.f / DM) + EPS);
    V16 h;
#pragma unroll
    for (int j = 0; j < 4; ++j) h.v[j] = x.v[j] * rr * gs.v[j] + sh.v[j];
    if (QKV0_FP8) {
      unsigned* q8 = (unsigned*)((unsigned char*)H + (size_t)r * DM) + lane;
#pragma unroll
      for (int j = 0; j < 4; ++j) q8[64 * j] = nv::pack4_fp8(h.v[j][0] * nv::A8_SCALE, h.v[j][1] * nv::A8_SCALE, h.v[j][2] * nv::A8_SCALE, h.v[j][3] * nv::A8_SCALE);
    } else stb(H + (size_t)r * DM, lane, h);
  }
}

template <int ABL = 0> DEVI void phase_postmix(const Params& p, ldsp_t lds, int layer) {
  const int tid = ftid(), lane = tid & 63, gw = blockIdx.x * NWAVE + (tid >> 6), NGW = gridDim.x * NWAVE;
  const float* MOD = (const float*)(p.ws + WS_CTL + CTL_MOD) + (size_t)layer * 9 * 6144;
  const bf16_t* MIX = (const bf16_t*)(p.ws + (layer ? WS_MIX1 : WS_MIX0));
  bf16_t* H = (bf16_t*)(p.ws + WS_H); float* AFFT = (float*)(p.ws + WS_AFF); float* XC = (float*)(p.ws + WS_XC);
  const float* wr = p.in[layer ? L1_WROUTER : L0_WROUTER];
  FA_LAS f32x4* WL = (FA_LAS f32x4*)lds;
  for (int i = tid; i < 1024 * 4; i += NT) { const int k = i >> 2, e4 = i & 3; const int ln = (k & 255) >> 2, q = k & 3, j = k >> 8;
    WL[((j * 4 + q) * 4 + e4) * 64 + ln] = *(const f32x4*)(wr + (size_t)k * 16 + e4 * 4); }
  __syncthreads();
  const int nrow = layer ? NLAT : NROW;
  const int rpw = (nrow + NGW - 1) / NGW;
  const int r0 = gw * rpw, r1 = min(r0 + rpw, nrow);
  if (r0 >= r1) return;
  const V16 gpost = ldf(p.in[layer ? L1_GPOSTMIX : L0_GPOSTMIX], lane), gpre = ldf(p.in[layer ? L1_GPREFFN : L0_GPREFFN], lane);
  int cur = -1; V16 gg, gs, sh;
  auto xsrc = [&](int r) { return layer ? (const float*)(p.out + (size_t)r * DM) : (r < NLAT ? p.in[I_X] + (size_t)r * DM : p.in[I_CTX] + (size_t)(r - NLAT) * DM); };
  B16 mn = ldb_raw(MIX + (size_t)r0 * DM, lane); V16 xn = ldf(xsrc(r0), lane);
  B16 mn2 = mn; V16 xn2 = xn;
  if (r0 + 1 < r1) { mn2 = ldb_raw(MIX + (size_t)(r0 + 1) * DM, lane); xn2 = ldf(xsrc(r0 + 1), lane); }
  for (int r = r0; r < r1; ++r) {
    const B16 mb = mn; const V16 x = xn;
    mn = mn2; xn = xn2;
    if (r + 2 < r1) { mn2 = ldb_raw(MIX + (size_t)(r + 2) * DM, lane); xn2 = ldf(xsrc(r + 2), lane); }
    const int mr = row_modrow(r);
    if (mr != cur) { cur = mr; const float* m = MOD + (size_t)mr * 6144; const V16 gt = ldf(m + 2048, lane), sc = ldf(m + 4096, lane); sh = ldf(m + 3072, lane);
#pragma unroll
      for (int j = 0; j < 4; ++j) { gg.v[j] = gt.v[j] * gpost.v[j]; gs.v[j] = gpre.v[j] * (sc.v[j] + 1.f); } }
    V16 o = b2v(mb);
    const float rr = rsqrtf(sumsq(o) * (1.f / DM) + EPS);
#pragma unroll
    for (int j = 0; j < 4; ++j) o.v[j] = x.v[j] + gg.v[j] * (o.v[j] * rr);
    stf(r < NLAT ? p.out + (size_t)r * DM : XC + (size_t)(r - NLAT) * DM, lane, o);
    const float r2 = rsqrtf(sumsq(o) * (1.f / DM) + EPS);
    V16 h;
#pragma unroll
    for (int j = 0; j < 4; ++j) h.v[j] = o.v[j] * r2 * gs.v[j] + sh.v[j];
    if ((layer == 1 && MOE1_FP8) || (layer == 0 && MOE0_FP8)) {
      unsigned* q8 = (unsigned*)((unsigned char*)H + (size_t)r * DM) + lane;
#pragma unroll
      for (int j = 0; j < 4; ++j) q8[64 * j] = nv::pack4_fp8(h.v[j][0] * nv::A8_SCALE, h.v[j][1] * nv::A8_SCALE, h.v[j][2] * nv::A8_SCALE, h.v[j][3] * nv::A8_SCALE);
    } else stb(H + (size_t)r * DM, lane, h);
    if (ABL == 1) continue;
    f32x4 lg[4];
    int lo = lane; asm volatile("" : "+v"(lo));
#pragma unroll
    for (int e4 = 0; e4 < 4; ++e4) lg[e4] = (f32x4){0.f, 0.f, 0.f, 0.f};
#pragma unroll
    for (int j = 0; j < 4; ++j)
#pragma unroll
      for (int q = 0; q < 4; ++q) { const float hv = h.v[j][q];
#pragma unroll
        for (int e4 = 0; e4 < 4; ++e4) lg[e4] += WL[((j * 4 + q) * 4 + e4) * 64 + lo] * hv; }
    float a8[8], b4[4], c2[2], d;
#pragma unroll
    for (int i = 0; i < 8; ++i) { const auto s = __builtin_amdgcn_permlane32_swap(__float_as_uint(lg[i >> 2][i & 3]), __float_as_uint(lg[2 + (i >> 2)][i & 3]), false, false);
      a8[i] = __uint_as_float(s[0]) + __uint_as_float(s[1]); }
#pragma unroll
    for (int i = 0; i < 4; ++i) { const auto s = __builtin_amdgcn_permlane16_swap(__float_as_uint(a8[i]), __float_as_uint(a8[i + 4]), false, false);
      b4[i] = __uint_as_float(s[0]) + __uint_as_float(s[1]); }
    { const bool b3 = (lane & 8) != 0, b2 = (lane & 4) != 0;
#pragma unroll
      for (int i = 0; i < 2; ++i) { const float keep = b3 ? b4[i + 2] : b4[i], send = b3 ? b4[i] : b4[i + 2]; c2[i] = keep + dppf<DPP_MIRROR>(send); }
      const float keep = b2 ? c2[1] : c2[0], send = b2 ? c2[0] : c2[1]; d = keep + dppf<DPP_HMIRROR>(send); }
    d += dppf<DPP_XOR1>(d); d += dppf<DPP_XOR2>(d);
    const float mx = quad_max(d), ex = expf(d - mx), ssum = quad_sum(ex);
    if ((lane & 3) == 0) AFFT[(size_t)(lane >> 2) * NROW + r] = ex / ssum;
  }
}

DEVI void phase_combine(const Params& p, int layer) {
  const int tid = ftid(), lane = tid & 63, gw = blockIdx.x * NWAVE + (tid >> 6), NGW = gridDim.x * NWAVE;
  const float* MOD = (const float*)(p.ws + WS_CTL + CTL_MOD);
  const bf16_t* Y = (const bf16_t*)(p.ws + WS_Y); const int* SLOT = (const int*)(p.ws + WS_SLOT); const float* GV = (const float*)(p.ws + WS_GATEV);
  bf16_t* H = (bf16_t*)(p.ws + WS_H); float* XC = (float*)(p.ws + WS_XC);
  const int nrow = layer ? NLAT : NROW, erows = layer ? EROWS1 : EROWS0;
  const int rpw = (nrow + NGW - 1) / NGW;
  const int r0 = gw * rpw, r1 = min(r0 + rpw, nrow);
  if (r0 >= r1) return;
  const V16 gpost = ldf(p.in[layer ? L1_GPOSTFFN : L0_GPOSTFFN], lane);
  V16 g1; if (layer == 0) g1 = ldf(p.in[L1_GPREMIX], lane);
  int cur = -1; V16 gg, gs, sh;
  int sn = (lane < 16) ? SLOT[(size_t)lane * NROW + r0] : -1;
  for (int r = r0; r < r1; ++r) {
    const int sl = sn; if (r + 1 < r1) sn = (lane < 16) ? SLOT[(size_t)lane * NROW + r + 1] : -1;
    float* xio = r < NLAT ? p.out + (size_t)r * DM : XC + (size_t)(r - NLAT) * DM;
    const V16 x = ldf(xio, lane);
    const int mr = row_modrow(r);
    if (mr != cur) { cur = mr; const float* m = MOD + (size_t)(layer * 9 + mr) * 6144; const V16 gt = ldf(m + 5120, lane);
#pragma unroll
      for (int j = 0; j < 4; ++j) gg.v[j] = gt.v[j] * gpost.v[j];
      if (layer == 0) { const float* m1 = MOD + (size_t)(9 + mr) * 6144; const V16 sc = ldf(m1 + 1024, lane); sh = ldf(m1, lane);
#pragma unroll
        for (int j = 0; j < 4; ++j) gs.v[j] = g1.v[j] * (sc.v[j] + 1.f); } }
    V16 o;
#pragma unroll
    for (int j = 0; j < 4; ++j) o.v[j] = (f32x4){0.f, 0.f, 0.f, 0.f};
    unsigned long long mask = __ballot(sl >= 0);
    while (mask) {
      int e_[4], s_[4]; bool v_[4];
#pragma unroll
      for (int i = 0; i < 4; ++i) { v_[i] = mask != 0ull; e_[i] = v_[i] ? __builtin_ctzll(mask) : 0; if (v_[i]) mask &= mask - 1; s_[i] = __builtin_amdgcn_readlane(sl, e_[i]); }
      B16 yr[4]; float gt[4];
#pragma unroll
      for (int i = 0; i < 4; ++i) if (v_[i]) { gt[i] = GV[e_[i] * erows + s_[i]];
        yr[i] = ldb_raw(Y + ((size_t)e_[i] * erows + s_[i]) * DM, lane); }
#pragma unroll
      for (int i = 0; i < 4; ++i) if (v_[i]) { const V16 y = b2v(yr[i]);
#pragma unroll
        for (int j = 0; j < 4; ++j) o.v[j] += y.v[j] * gt[i]; }
    }
    const float rr = rsqrtf(sumsq(o) * (1.f / DM) + EPS);
#pragma unroll
    for (int j = 0; j < 4; ++j) o.v[j] = x.v[j] + gg.v[j] * (o.v[j] * rr);
    stf(xio, lane, o);
    if (layer == 0) {
      const float r2 = rsqrtf(sumsq(o) * (1.f / DM) + EPS);
      V16 h;
#pragma unroll
      for (int j = 0; j < 4; ++j) h.v[j] = o.v[j] * r2 * gs.v[j] + sh.v[j];
      if (QKV1_FP8) {
        unsigned* q8 = (unsigned*)((unsigned char*)H + (size_t)r * DM) + lane;
#pragma unroll
        for (int j = 0; j < 4; ++j) q8[64 * j] = nv::pack4_fp8(h.v[j][0] * nv::A8_SCALE, h.v[j][1] * nv::A8_SCALE, h.v[j][2] * nv::A8_SCALE, h.v[j][3] * nv::A8_SCALE);
      } else stb(H + (size_t)r * DM, lane, h);
    }
  }
}
}
#define LAS __attribute__((address_space(3)))
#define XB_TMO      128
#define XB_XCNT(j)  (256  + 64 * (j))
#define XB_XSUB(j)  (1280 + 64 * (j))
#define XB_XGEN(j)  (2304 + 64 * (j))
#define XB_TOP      3328
#define XB_TOPGEN   3392
#define XCD_BAR_WORDS 3456
#define XB_SPIN_CAP (1u << 18)

__device__ __forceinline__ unsigned xb_ld(unsigned* p)              { return __hip_atomic_load(p, __ATOMIC_RELAXED, __HIP_MEMORY_SCOPE_AGENT); }
__device__ __forceinline__ unsigned xb_add(unsigned* p, unsigned v) { return __hip_atomic_fetch_add(p, v, __ATOMIC_RELAXED, __HIP_MEMORY_SCOPE_AGENT); }
__device__ __forceinline__ unsigned xb_xcc_id() { return (unsigned)__builtin_amdgcn_s_getreg((3 << 11) | 20) & 0xFu; }
#define XB_SPIN(cond, bar) do { unsigned _sp = 0; while (cond) { __builtin_amdgcn_s_sleep(1); \
    if ((++_sp & 255u) == 0u) { if (xb_ld(&(bar)[XB_TMO])) break; if (_sp > XB_SPIN_CAP) { atomicAdd(&(bar)[XB_TMO], 1u); break; } } } } while (0)

struct XcdBarrier {
    unsigned* bar; unsigned x;
    volatile LAS unsigned* st;
};

__device__ __forceinline__ XcdBarrier xcd_barrier_post(unsigned* bar, volatile LAS unsigned* st) {
    XcdBarrier b; b.bar = bar; b.x = xb_xcc_id(); b.st = st;
    if (threadIdx.x == 0) (void)xb_add(&bar[XB_XCNT(b.x)], 1u);
    return b;
}
__device__ __forceinline__ void xcd_barrier_complete(unsigned* bar, unsigned x, unsigned& nloc, unsigned& nx) {
    const unsigned G = gridDim.x * gridDim.y * gridDim.z;
    unsigned sum, cnt, mine, sp = 0u;
    for (;;) {
        sum = 0u; cnt = 0u; mine = 0u;
#pragma unroll
        for (unsigned j = 0; j < 16; ++j) { const unsigned c = xb_ld(&bar[XB_XCNT(j)]); sum += c; cnt += (c > 0u) ? 1u : 0u; mine = (j == x) ? c : mine; }
        if (sum == G) break;
        __builtin_amdgcn_s_sleep(1);
        if ((++sp & 255u) == 0u) { if (xb_ld(&bar[XB_TMO])) break; if (sp > XB_SPIN_CAP) { atomicAdd(&bar[XB_TMO], 1u); break; } }
    }
    nloc = mine > 0u ? mine : 1u; nx = cnt > 0u ? cnt : 1u;
}

__device__ __forceinline__ void xcd_barrier(const XcdBarrier& b) {
    asm volatile("s_waitcnt vmcnt(0)" ::: "memory");
    __syncthreads();
    if (threadIdx.x == 0) {
        unsigned* bar = b.bar;
        __builtin_amdgcn_s_waitcnt(0);
        unsigned nloc = b.st[0], nx = b.st[1];
        if (nloc == 0u) { xcd_barrier_complete(bar, b.x, nloc, nx); b.st[0] = nloc; b.st[1] = nx; }
        const unsigned old = xb_add(&bar[XB_XSUB(b.x)], 1u);
        const unsigned gen = old / nloc;
        if (old + 1u == (gen + 1u) * nloc) {
            __builtin_amdgcn_fence(__ATOMIC_RELEASE, "agent");
            asm volatile("s_waitcnt vmcnt(0)" ::: "memory");
            const unsigned og = xb_add(&bar[XB_TOP], 1u);
            const unsigned tg = og / nx;
            if (og + 1u == (tg + 1u) * nx) xb_add(&bar[XB_TOPGEN], 1u);
            else XB_SPIN(xb_ld(&bar[XB_TOPGEN]) == tg, bar);
            __builtin_amdgcn_fence(__ATOMIC_ACQUIRE, "agent");
            xb_add(&bar[XB_XGEN(b.x)], 1u);
            asm volatile("s_waitcnt vmcnt(0)" ::: "memory");
        } else {
            XB_SPIN(xb_ld(&bar[XB_XGEN(b.x)]) == gen, bar);
            __builtin_amdgcn_fence(__ATOMIC_ACQUIRE, "agent");
            asm volatile("s_waitcnt vmcnt(0)" ::: "memory");
        }
    }
    __syncthreads();
}


__device__ __forceinline__ void flat_barrier(unsigned* ctr, unsigned& epoch) {
    asm volatile("s_waitcnt vmcnt(0)" ::: "memory");
    __syncthreads();
    if (threadIdx.x == 0) {
        __builtin_amdgcn_fence(__ATOMIC_RELEASE, "agent");
        asm volatile("s_waitcnt vmcnt(0)" ::: "memory");
        (void)__hip_atomic_fetch_add(ctr, 1u, __ATOMIC_RELAXED, __HIP_MEMORY_SCOPE_AGENT);
        const unsigned target = (epoch + 1u) * (unsigned)gridDim.x; unsigned sp = 0;
        while (__hip_atomic_load(ctr, __ATOMIC_RELAXED, __HIP_MEMORY_SCOPE_AGENT) < target) { __builtin_amdgcn_s_sleep(1); if (++sp > (1u << 22)) break; }
        __builtin_amdgcn_fence(__ATOMIC_ACQUIRE, "agent");
        asm volatile("s_waitcnt vmcnt(0)" ::: "memory");
    }
    ++epoch;
    __syncthreads();
}

__device__ __forceinline__ void xcd_barrier2(const XcdBarrier& b) {
    asm volatile("s_waitcnt vmcnt(0)" ::: "memory");
    __syncthreads();
    if (threadIdx.x == 0) {
        unsigned* bar = b.bar;
        __builtin_amdgcn_s_waitcnt(0);
        unsigned nloc = b.st[0], nx = b.st[1];
        if (nloc == 0u) { xcd_barrier_complete(bar, b.x, nloc, nx); b.st[0] = nloc; b.st[1] = nx; }
        const unsigned old = xb_add(&bar[XB_XSUB(b.x)], 1u);
        const unsigned gen = old / nloc;
        if (old + 1u == (gen + 1u) * nloc) {
            __builtin_amdgcn_fence(__ATOMIC_RELEASE, "agent");
            asm volatile("s_waitcnt vmcnt(0)" ::: "memory");
            (void)xb_add(&bar[XB_TOP], 1u);
        }
        const unsigned target = (gen + 1u) * nx;
        XB_SPIN(xb_ld(&bar[XB_TOP]) < target, bar);
        __builtin_amdgcn_fence(__ATOMIC_ACQUIRE, "agent");
        asm volatile("s_waitcnt vmcnt(0)" ::: "memory");
    }
    __syncthreads();
}
constexpr int LDS_BYTES = 147456;
#define TAILFILL 1
#ifndef FAST_GEMM
#define FAST_GEMM 1
#endif
#ifndef FAST_TOPK
#define FAST_TOPK 1
#endif
#ifndef FAST_SSD
#define FAST_SSD 1
#endif
#ifndef FAST_ATTN
#define FAST_ATTN 1
#endif
__global__ void __launch_bounds__(NT) mega(Params p) {
  extern __shared__ __attribute__((aligned(16))) unsigned char lds_raw[];
  float* lds = (float*)lds_raw;
  fg::ldsp_t ldsp = (fg::ldsp_t)lds_raw;
  cg::grid_group grid = cg::this_grid();
  volatile LAS unsigned* bst = (volatile LAS unsigned*)((LAS unsigned char*)lds_raw + (LDS_BYTES - 64));
  if (threadIdx.x < 2) bst[threadIdx.x] = 0u;
  unsigned* barw = (unsigned*)(p.ws + WS_CTL + CTL_BAR);
  if (blockIdx.x == 0) { const int t0 = ftid(); for (int i = t0; i < XCD_BAR_WORDS; i += NT) barw[i] = 0u; }
  XcdBarrier xbar; xbar.bar = barw; xbar.x = 0; xbar.st = bst;
#ifdef FLATBAR
  unsigned fb_epoch = 0; unsigned* fb_ctr = barw + XCD_BAR_WORDS - 64;
#define GSYNC() flat_barrier(fb_ctr, fb_epoch)
#elif defined(XBAR2)
#define GSYNC() xcd_barrier2(xbar)
#else
#define GSYNC() xcd_barrier(xbar)
#endif
  nv::phase0(p, lds);                 grid.sync();
  xbar = xcd_barrier_post(barw, bst);
#ifdef DUP_SYNC
  for (int i = 0; i < 20; ++i) GSYNC();
#endif
#ifdef DUP_P0
  nv::phase0(p, lds);                 GSYNC();
#endif
  fr::phase_prenorm0(p);              GSYNC();
#ifdef DUP_PRENORM
  fr::phase_prenorm0(p); GSYNC();
#endif
#if FAST_GEMM
  fg::phase_qkv0(p, ldsp); GSYNC();
#ifdef DUP_QKV0
  fg::phase_qkv0(p, ldsp); GSYNC();
#endif
#else
  nv::phase_qkv0(p, lds);             GSYNC();
#endif
#if FAST_ATTN
  fa::phase_attnA(p, ldsp); fa::phase_attnB(p, ldsp); GSYNC();
#ifdef DUP_A
  fa::phase_attnA<DUP_A>(p, ldsp); GSYNC();
#endif
#ifdef DUP_B
  fa::phase_attnB<DUP_B>(p, ldsp); GSYNC();
#endif
#else
  nv::phase_attn0(p, lds);            GSYNC();
#endif
#if FAST_GEMM
#ifdef TAILFILL
  fg::phase_outproj(p, ldsp, 0); nv::convert_moe_tail8(p, 0, 1, lds, NROW / 256 * (DM / 256)); GSYNC();
#else
  fg::phase_outproj(p, ldsp, 0); GSYNC();
#endif
#ifdef DUP_OUT0
  fg::phase_outproj(p, ldsp, 0); GSYNC();
#endif
#else
  nv::phase_outproj(p, lds, 0);       GSYNC();
#endif
  fr::phase_postmix(p, ldsp, 0);            GSYNC();
#ifdef DUP_POSTMIX0
  fr::phase_postmix<DUP_POSTMIX0>(p, ldsp, 0); GSYNC();
#endif
#if FAST_TOPK
  ft::phase_topk(p, ldsp, 0);         GSYNC();
#ifdef DUP_TOPK0
  ft::phase_topk(p, ldsp, 0);         GSYNC();
#endif
#else
  nv::phase_topk(p, lds, 0);          GSYNC();
  fg::phase_gather(p, 0);             GSYNC();
#endif
#if FAST_GEMM
  fg::phase_moe_up8(p, ldsp, 0);      GSYNC();
#ifdef DUP_UP0
  fg::phase_moe_up8(p, ldsp, 0); GSYNC();
#endif
  fg::phase_moe_down8(p, ldsp, 0);    GSYNC();
#ifdef DUP_DOWN0
  fg::phase_moe_down8(p, ldsp, 0); GSYNC();
#endif
#else
  nv::phase_moe_up(p, lds, 0);        GSYNC();
  nv::phase_moe_down(p, lds, 0);      GSYNC();
#endif
#ifdef TAILFILL
  fr::phase_combine(p, 0); GSYNC();
#else
  fr::phase_combine(p, 0); nv::convert_moe_tail(p, 1, 0, lds, 0); nv::convert_moe_tail(p, 1, 1, lds, 0); GSYNC();
#endif
#if FAST_GEMM
#ifdef TAILFILL
  fg::phase_qkv1(p, ldsp); GSYNC();
#else
  fg::phase_qkv1(p, ldsp); GSYNC();
#endif
#else
  nv::phase_qkv1(p, lds);             GSYNC();
#endif
#if FAST_ATTN
#if FAST_SSD
#ifdef TAILFILL
  fs::phase_conv(p); GSYNC();
#else
  fs::phase_conv(p); GSYNC();
#endif
#else
  nv::phase_conv_swa(p, lds, true); GSYNC();
#endif
#else
  nv::phase_conv_swa(p, lds, true);   GSYNC();
#endif
#if FAST_SSD
  fs::phase_ssd(p, ldsp); fa::phase_attnC(p, ldsp, (int*)(p.ws + WS_CTL + CTL_QC));
  nv::convert_moe_tail8(p, 1, 0, lds, NB * 2 * 8); nv::convert_moe_tail8(p, 1, 1, lds, NB * 2 * 8); GSYNC();
#ifdef DUP_SSD
  fs::phase_ssd<DUP_SSD>(p, ldsp);             GSYNC();
#endif
  fs::phase_ssd_out(p);               GSYNC();
#else
  nv::phase_ssd(p, lds);              GSYNC();
  nv::phase_ssd_out(p);               GSYNC();
#endif
#if FAST_GEMM
  fg::phase_outproj(p, ldsp, 1);      GSYNC();
#else
  nv::phase_outproj(p, lds, 1);       GSYNC();
#endif
  fr::phase_postmix(p, ldsp, 1);            GSYNC();
#if FAST_TOPK
  ft::phase_topk(p, ldsp, 1);         GSYNC();
#ifdef DUP_TOPK1
  ft::phase_topk(p, ldsp, 1);         GSYNC();
#endif
#else
  nv::phase_topk(p, lds, 1);          GSYNC();
  fg::phase_gather(p, 1);             GSYNC();
#endif
#if FAST_GEMM
  fg::phase_moe_up8(p, ldsp, 1);      GSYNC();
  fg::phase_moe_down8(p, ldsp, 1);    GSYNC();
#else
  nv::phase_moe_up(p, lds, 1);        GSYNC();
  nv::phase_moe_down(p, lds, 1);      GSYNC();
#endif
  fr::phase_combine(p, 1);
}


extern "C" void kernel_launch(void* const* d_in, const int* in_sizes, int n_in, void* d_out, int out_size,
                              void* d_ws, size_t ws_size, hipStream_t stream) {
  static int grid_blocks = 0;
  if (!grid_blocks) {
    int dev = 0, cus = 0, per_cu = 0;
    (void)hipGetDevice(&dev);
    (void)hipDeviceGetAttribute(&cus, hipDeviceAttributeMultiprocessorCount, dev);
    (void)hipFuncSetAttribute((const void*)mega, hipFuncAttributeMaxDynamicSharedMemorySize, LDS_BYTES);
    (void)hipOccupancyMaxActiveBlocksPerMultiprocessor(&per_cu, (const void*)mega, NT, LDS_BYTES);
    if (per_cu < 1) { fprintf(stderr, "kernel_launch: occupancy query says %d blocks/CU\n", per_cu); per_cu = 1; }
    grid_blocks = cus;
    if (n_in != 43 || ws_size < WS_END) fprintf(stderr, "kernel_launch: unexpected n_in %d / ws_size %zu (need %zu)\n", n_in, ws_size, (size_t)WS_END);
  }
  Params p{};
  for (int i = 0; i < 43; ++i) p.in[i] = (const float*)d_in[i];
  p.out = (float*)d_out; p.ws = (unsigned char*)d_ws;
  void* args[] = {&p};
  hipError_t e = hipLaunchCooperativeKernel((void*)mega, dim3(grid_blocks), dim3(NT), args, LDS_BYTES, stream);
  if (e != hipSuccess) fprintf(stderr, "cooperative launch failed: %s (grid %d)\n", hipGetErrorString(e), grid_blocks);
}
```

```cpp
#include <hip/hip_runtime.h>
#include <hip/hip_cooperative_groups.h>
#include <cstdio>
#include <cstdint>
namespace cg = cooperative_groups;

typedef unsigned short bf16_t;
#define DEVI __device__ __forceinline__

constexpr int NT = 512, NWAVE = 8;
constexpr int NB = 8, SEQ = 4096, DM = 1024, CTXL = 256;
constexpr int NLAT = NB * SEQ, NCTX = NB * CTXL, NROW = NLAT + NCTX;
constexpr int NE = 16;
constexpr int CAP_L = 512, CAP_C = 32;
constexpr int EROWS0 = NB * CAP_L + NB * CAP_C;
constexpr int EROWS1 = NB * CAP_L;
constexpr int N_IN0 = 3072, N_IN1 = 2320, N_IN1P = 2560;
constexpr float EPS = 1e-6f;

constexpr size_t MiB = 1u << 20;
constexpr size_t WS_CTL = 0;
constexpr size_t WS_WIN0 = 1 * MiB;
constexpr size_t WS_WIN1 = 7 * MiB;
constexpr size_t WS_WOUT0 = 12 * MiB, WS_WOUT1 = 14 * MiB;
constexpr size_t WS_WGU = 16 * MiB;
constexpr size_t WS_WD = 80 * MiB;
constexpr size_t WS_XC = 112 * MiB;
constexpr size_t WS_H = 120 * MiB;
constexpr size_t WS_AFF = 188 * MiB;
constexpr size_t WS_SLOT = 191 * MiB;
constexpr size_t WS_IDX = 194 * MiB;
constexpr size_t WS_GATEV = 195 * MiB;
constexpr size_t WS_BIG = 196 * MiB;
constexpr size_t WS_QKV0 = WS_BIG;
constexpr size_t WS_ATT0 = WS_BIG + 204 * MiB;
constexpr size_t WS_MIX0 = WS_BIG + 272 * MiB;
constexpr size_t WS_XG = WS_BIG;
constexpr size_t WS_HID = WS_BIG + 136 * MiB;
constexpr size_t WS_Y = WS_BIG;
constexpr size_t WS_P1 = WS_BIG;
constexpr size_t WS_DT = WS_BIG + 153 * MiB;
constexpr size_t WS_U = WS_BIG + 156 * MiB;
constexpr size_t WS_MIX1 = WS_U;
constexpr size_t WS_ATT1 = WS_BIG + 224 * MiB;
constexpr size_t WS_YS = WS_BIG + 292 * MiB;
constexpr size_t WS_CUMG = WS_BIG + 356 * MiB;
constexpr size_t WS_DTG = WS_BIG + 359 * MiB;
constexpr size_t WS_VT = WS_BIG + 340 * MiB;
constexpr size_t WS_VTB = WS_BIG + 362 * MiB;
constexpr size_t WS_END = WS_BIG + 380 * MiB;
constexpr size_t CTL_MOD = 4096;
constexpr size_t CTL_ROPE = CTL_MOD + 2 * 9 * 6144 * 4;
constexpr size_t CTL_LAM = CTL_ROPE + 64 * 16 * 2 * 4;
constexpr size_t CTL_QC = CTL_LAM + 64;
constexpr size_t CTL_BAR = 512 * 1024;

struct Params {
  const float* in[43];
  float* out;
  unsigned char* ws;
};

enum {
  I_X = 0, I_C, I_CTX, I_CCTX,
  L0_WMOD, L0_BMOD, L0_GPREMIX, L0_GPOSTMIX, L0_GPREFFN, L0_GPOSTFFN, L0_WIN, L0_WOUT,
  L0_LAMQ1, L0_LAMK1, L0_LAMQ2, L0_LAMK2, L0_SUBLN, L0_RPB, L0_WROUTER, L0_WGATE, L0_WUP, L0_WDOWN,
  L1_WMOD, L1_BMOD, L1_GPREMIX, L1_GPOSTMIX, L1_GPREFFN, L1_GPOSTFFN, L1_WIN, L1_WOUT,
  L1_SINKS, L1_CONVW, L1_CONVB, L1_ALOGF, L1_ALOGB, L1_DTBF, L1_DTBB, L1_DSKIP, L1_GNORM,
  L1_WROUTER, L1_WGATE, L1_WUP, L1_WDOWN
};

DEVI int ftid() { int t = threadIdx.x; asm volatile("" : "+v"(t)); return t; }
DEVI float bf2f(bf16_t v) { return __uint_as_float(((unsigned)v) << 16); }
DEVI bf16_t f2bf(float f) { unsigned u = __float_as_uint(f); return (bf16_t)((u + 0x7fffu + ((u >> 16) & 1u)) >> 16); }
DEVI unsigned pk2(float lo, float hi) { return (unsigned)f2bf(lo) | ((unsigned)f2bf(hi) << 16); }
DEVI float silu_f(float v) { return v / (1.f + __expf(-v)); }
template <int CTRL> DEVI float dppf(float v) { return __uint_as_float((unsigned)__builtin_amdgcn_update_dpp(0, (int)__float_as_uint(v), CTRL, 0xf, 0xf, true)); }
constexpr int DPP_XOR1 = 0xB1, DPP_XOR2 = 0x4E, DPP_HMIRROR = 0x141, DPP_MIRROR = 0x140;
DEVI float wave_sum(float v) {
  v += dppf<DPP_XOR1>(v); v += dppf<DPP_XOR2>(v); v += dppf<DPP_HMIRROR>(v); v += dppf<DPP_MIRROR>(v);
  { const auto s = __builtin_amdgcn_permlane16_swap(__float_as_uint(v), __float_as_uint(v), false, false); v = __uint_as_float(s[0]) + __uint_as_float(s[1]); }
  { const auto s = __builtin_amdgcn_permlane32_swap(__float_as_uint(v), __float_as_uint(v), false, false); v = __uint_as_float(s[0]) + __uint_as_float(s[1]); }
  return v;
}
DEVI float half_sum(float v) {
  v += dppf<DPP_XOR1>(v); v += dppf<DPP_XOR2>(v); v += dppf<DPP_HMIRROR>(v); v += dppf<DPP_MIRROR>(v);
  { const auto s = __builtin_amdgcn_permlane16_swap(__float_as_uint(v), __float_as_uint(v), false, false); v = __uint_as_float(s[0]) + __uint_as_float(s[1]); }
  return v;
}
template <int CTRL, int ROWMASK> DEVI float dppf0(float v) { return __uint_as_float((unsigned)__builtin_amdgcn_update_dpp(0, (int)__float_as_uint(v), CTRL, ROWMASK, 0xf, false)); }
DEVI float wave_scan_incl(float v) {
  v += dppf0<0x111, 0xf>(v); v += dppf0<0x112, 0xf>(v); v += dppf0<0x114, 0xf>(v); v += dppf0<0x118, 0xf>(v);
  v += dppf0<0x142, 0xa>(v); v += dppf0<0x143, 0xc>(v);
  return v;
}
template <int CTRL, int ROWMASK> DEVI int dppi0(int v) { return __builtin_amdgcn_update_dpp(0, v, CTRL, ROWMASK, 0xf, false); }
DEVI int wave_scan_incl_i(int v) {
  v += dppi0<0x111, 0xf>(v); v += dppi0<0x112, 0xf>(v); v += dppi0<0x114, 0xf>(v); v += dppi0<0x118, 0xf>(v);
  v += dppi0<0x142, 0xa>(v); v += dppi0<0x143, 0xc>(v);
  return v;
}
DEVI float quad_sum(float v) {
  v += dppf<DPP_HMIRROR>(v); v += dppf<DPP_MIRROR>(v);
  { const auto s = __builtin_amdgcn_permlane16_swap(__float_as_uint(v), __float_as_uint(v), false, false); v = __uint_as_float(s[0]) + __uint_as_float(s[1]); }
  { const auto s = __builtin_amdgcn_permlane32_swap(__float_as_uint(v), __float_as_uint(v), false, false); v = __uint_as_float(s[0]) + __uint_as_float(s[1]); }
  return v;
}
DEVI float quad_max(float v) {
  v = fmaxf(v, dppf<DPP_HMIRROR>(v)); v = fmaxf(v, dppf<DPP_MIRROR>(v));
  { const auto s = __builtin_amdgcn_permlane16_swap(__float_as_uint(v), __float_as_uint(v), false, false); v = fmaxf(__uint_as_float(s[0]), __uint_as_float(s[1])); }
  { const auto s = __builtin_amdgcn_permlane32_swap(__float_as_uint(v), __float_as_uint(v), false, false); v = fmaxf(__uint_as_float(s[0]), __uint_as_float(s[1])); }
  return v;
}
DEVI float wave_max(float v) {
  v = fmaxf(v, dppf<DPP_XOR1>(v)); v = fmaxf(v, dppf<DPP_XOR2>(v)); v = fmaxf(v, dppf<DPP_HMIRROR>(v)); v = fmaxf(v, dppf<DPP_MIRROR>(v));
  { const auto s = __builtin_amdgcn_permlane16_swap(__float_as_uint(v), __float_as_uint(v), false, false); v = fmaxf(__uint_as_float(s[0]), __uint_as_float(s[1])); }
  { const auto s = __builtin_amdgcn_permlane32_swap(__float_as_uint(v), __float_as_uint(v), false, false); v = fmaxf(__uint_as_float(s[0]), __uint_as_float(s[1])); }
  return v;
}
DEVI int row_modrow(int r) { return r < NLAT ? (r >> 12) : 8; }
#ifndef QKV0_FP8
#define QKV0_FP8 1
#endif
#ifndef OUT_FP8
#define OUT_FP8 0
#endif
#ifndef QKV1_FP8
#define QKV1_FP8 1
#endif
namespace nv {

DEVI void transpose_item(const float* W, int K, int N, bf16_t* WT, int row_off, int row_mul, float* scr, int item, int lane, int Npad) {
  const int nblk = Npad / 32, kb = item / nblk, nb = item % nblk, k0 = 64 * kb, n0 = 32 * nb;
  const int n = n0 + (lane & 31); const bool ok = n < N;
  const float* src = W + (size_t)(k0 + (lane >> 5)) * N + (ok ? n : 0);
  float v[32];
#pragma unroll
  for (int i = 0; i < 32; ++i) v[i] = src[(size_t)(2 * i) * N];
#pragma unroll
  for (int i = 0; i < 32; ++i) scr[(2 * i + (lane >> 5)) * 33 + (lane & 31)] = ok ? v[i] : 0.f;
  __builtin_amdgcn_s_waitcnt(0); __builtin_amdgcn_wave_barrier();
  const int c = lane & 7;
#pragma unroll
  for (int j = 0; j < 4; ++j) {
    const int nn = (lane >> 3) + 8 * j; const float* s = scr + (8 * c) * 33 + nn;
    uint4 o; o.x = pk2(s[0 * 33], s[1 * 33]); o.y = pk2(s[2 * 33], s[3 * 33]); o.z = pk2(s[4 * 33], s[5 * 33]); o.w = pk2(s[6 * 33], s[7 * 33]);
    *(uint4*)(WT + (size_t)(row_off + (n0 + nn) * row_mul) * K + k0 + 8 * c) = o;
  }
  __builtin_amdgcn_s_waitcnt(0); __builtin_amdgcn_wave_barrier();
}

DEVI void convert_moe_part(const Params& p, int layer, int which, float* scr, int gw, int NGW, int lane) {
  const float* wg = p.in[layer ? L1_WGATE : L0_WGATE]; const float* wu = p.in[layer ? L1_WUP : L0_WUP]; const float* wd = p.in[layer ? L1_WDOWN : L0_WDOWN];
  bf16_t* WGU = (bf16_t*)(p.ws + WS_WGU); bf16_t* WD = (bf16_t*)(p.ws + WS_WD);
  constexpr int IPM = 16 * 32;
  if (which == 0) {
    for (int it = gw; it < NE * 2 * IPM; it += NGW) {
      const int e = it / (2 * IPM), r = it % (2 * IPM), gu = r / IPM, item = r % IPM;
      transpose_item((gu ? wu : wg) + (size_t)e * DM * DM, DM, DM, WGU + (size_t)e * 2048 * DM, gu, 2, scr, item, lane, DM);
    }
  } else {
    for (int it = gw; it < NE * IPM; it += NGW) {
      const int e = it / IPM, item = it % IPM;
      transpose_item(wd + (size_t)e * DM * DM, DM, DM, WD + (size_t)e * DM * DM, 0, 1, scr, item, lane, DM);
    }
  }
}
DEVI void convert_moe_tail(const Params& p, int layer, int which, float* lds, int nunits) {
  const int first = nunits % (int)gridDim.x;
  if ((int)blockIdx.x < first) return;
  const int w = ftid() >> 6;
  convert_moe_part(p, layer, which, lds + w * (64 * 33), ((int)blockIdx.x - first) * NWAVE + w, ((int)gridDim.x - first) * NWAVE, ftid() & 63);
}


constexpr float W8_SCALE = 64.f, A8_SCALE = 4.f;
constexpr int W8_E8M0 = 0x79797979, A8_E8M0 = 0x7d7d7d7d;
DEVI unsigned pack4_fp8(float a, float b, float c, float d) {
  a = fminf(fmaxf(a, -448.f), 448.f); b = fminf(fmaxf(b, -448.f), 448.f); c = fminf(fmaxf(c, -448.f), 448.f); d = fminf(fmaxf(d, -448.f), 448.f);
  int w = 0; w = __builtin_amdgcn_cvt_pk_fp8_f32(a, b, w, false); w = __builtin_amdgcn_cvt_pk_fp8_f32(c, d, w, true); return (unsigned)w; }
DEVI void transpose_item8(const float* W, int K, int N, unsigned char* WT, int row_off, int row_mul, float* scr, int item, int lane, int Npad = 0) {
  if (Npad == 0) Npad = N;
  const int nblk = Npad / 32, kb = item / nblk, nb = item % nblk, k0 = 64 * kb, n0 = 32 * nb;
  const int nn0 = n0 + (lane & 31); const bool ok = nn0 < N;
  const float* src = W + (size_t)(k0 + (lane >> 5)) * N + (ok ? nn0 : 0);
  float v[32];
#pragma unroll
  for (int i = 0; i < 32; ++i) v[i] = src[(size_t)(2 * i) * N];
#pragma unroll
  for (int i = 0; i < 32; ++i) scr[(2 * i + (lane >> 5)) * 33 + (lane & 31)] = ok ? v[i] * W8_SCALE : 0.f;
  __builtin_amdgcn_s_waitcnt(0); __builtin_amdgcn_wave_barrier();
  const int c = lane & 7;
#pragma unroll
  for (int j = 0; j < 4; ++j) {
    const int nn = (lane >> 3) + 8 * j; const float* s = scr + (8 * c) * 33 + nn;
    uint2 o; o.x = pack4_fp8(s[0 * 33], s[1 * 33], s[2 * 33], s[3 * 33]); o.y = pack4_fp8(s[4 * 33], s[5 * 33], s[6 * 33], s[7 * 33]);
    *(uint2*)(WT + (size_t)(row_off + (n0 + nn) * row_mul) * K + k0 + 8 * c) = o;
  }
  __builtin_amdgcn_s_waitcnt(0); __builtin_amdgcn_wave_barrier();
}
DEVI void convert_moe_part8(const Params& p, int layer, int which, float* scr, int gw, int NGW, int lane) {
  const float* wg = p.in[layer ? L1_WGATE : L0_WGATE]; const float* wu = p.in[layer ? L1_WUP : L0_WUP]; const float* wd = p.in[layer ? L1_WDOWN : L0_WDOWN];
  unsigned char* WGU = (unsigned char*)(p.ws + WS_WGU); unsigned char* WD = (unsigned char*)(p.ws + WS_WD);
  constexpr int IPM = 16 * 32;
  if (which == 0) {
    for (int it = gw; it < NE * 2 * IPM; it += NGW) { const int e = it / (2 * IPM), r = it % (2 * IPM), gu = r / IPM, item = r % IPM;
      transpose_item8((gu ? wu : wg) + (size_t)e * DM * DM, DM, DM, WGU + (size_t)e * 2048 * DM, gu, 2, scr, item, lane); }
  } else {
    for (int it = gw; it < NE * IPM; it += NGW) { const int e = it / IPM, item = it % IPM;
      transpose_item8(wd + (size_t)e * DM * DM, DM, DM, WD + (size_t)e * DM * DM, 0, 1, scr, item, lane); }
  }
}
DEVI void convert_moe_tail8(const Params& p, int layer, int which, float* lds, int nunits) {
  const int first = nunits % (int)gridDim.x;
  if ((int)blockIdx.x < first) return;
  const int w = ftid() >> 6;
  convert_moe_part8(p, layer, which, lds + w * (64 * 33), ((int)blockIdx.x - first) * NWAVE + w, ((int)gridDim.x - first) * NWAVE, ftid() & 63);
}

DEVI void phase0(const Params& p, float* lds) {
  const int tid = ftid(), lane = tid & 63, wave = tid >> 6;
  const int gw = blockIdx.x * NWAVE + wave, NGW = gridDim.x * NWAVE;
  for (int it = blockIdx.x; it < 2 * 96; it += gridDim.x) {
    const int layer = it / 96, j0 = (it % 96) * 64;
    float* sc = lds;
    float* red = lds + 9 * 1024;
    __syncthreads();
    for (int i = tid; i < 9 * 1024; i += NT) { const int r = i >> 10, k = i & 1023; const float v = (r < 8) ? p.in[I_C][r * 1024 + k] : p.in[I_CCTX][k]; sc[i] = silu_f(v); }
    __syncthreads();
    const float* wm = p.in[layer ? L1_WMOD : L0_WMOD];
    float acc[9];
#pragma unroll
    for (int r = 0; r < 9; ++r) acc[r] = 0.f;
    for (int k0 = wave * 128; k0 < wave * 128 + 128; k0 += 16) {
      float w[16];
#pragma unroll
      for (int i = 0; i < 16; ++i) w[i] = wm[(size_t)(k0 + i) * 6144 + j0 + lane];
#pragma unroll
      for (int i = 0; i < 16; ++i)
#pragma unroll
        for (int r = 0; r < 9; ++r) acc[r] += sc[r * 1024 + k0 + i] * w[i];
    }
#pragma unroll
    for (int r = 0; r < 9; ++r) red[(wave * 9 + r) * 64 + lane] = acc[r];
    __syncthreads();
    for (int i = tid; i < 9 * 64; i += NT) {
      const int r = i >> 6, c = i & 63; float s = 0.f;
      for (int w = 0; w < 8; ++w) s += red[(w * 9 + r) * 64 + c];
      float* MOD = (float*)(p.ws + WS_CTL + CTL_MOD);
      MOD[(layer * 9 + r) * 6144 + j0 + c] = s + p.in[layer ? L1_BMOD : L0_BMOD][j0 + c];
    }
    __syncthreads();
  }
  if (blockIdx.x == gridDim.x - 1) {
    float* ROPE = (float*)(p.ws + WS_CTL + CTL_ROPE);
    for (int i = tid; i < 64 * 16; i += NT) {
      const int pos = i >> 4, f = i & 15;
      const float inv = powf(10000.f, -(float)f / 16.f);
      const float ang = (float)pos * inv;
      ROPE[2 * i] = cosf(ang); ROPE[2 * i + 1] = sinf(ang);
    }
    if (wave == 0) {
      float a = p.in[L0_LAMQ1][lane] * p.in[L0_LAMK1][lane], b = p.in[L0_LAMQ2][lane] * p.in[L0_LAMK2][lane];
      a = wave_sum(a); b = wave_sum(b);
      if (lane == 0) { float* LAM = (float*)(p.ws + WS_CTL + CTL_LAM); LAM[0] = expf(a) - expf(b) + 0.2f; *(int*)(p.ws + WS_CTL + CTL_QC) = 0; }
    }
  }
  __syncthreads();
  float* scr = lds + wave * (64 * 33);
  {
    constexpr int I_IN0 = 16 * (N_IN0 / 32), I_OUT = 16 * 32, I_IN1 = 16 * (N_IN1P / 32);
    constexpr int NITEMS = I_IN0 + I_OUT + I_IN1 + I_OUT;
    for (int it = gw; it < NITEMS; it += NGW) {
      int r = it;
      if (r < I_IN0) { if (QKV0_FP8) transpose_item8(p.in[L0_WIN], DM, N_IN0, (unsigned char*)(p.ws + WS_WIN0), 0, 1, scr, r, lane); else transpose_item(p.in[L0_WIN], DM, N_IN0, (bf16_t*)(p.ws + WS_WIN0), 0, 1, scr, r, lane, N_IN0); continue; } r -= I_IN0;
      if (r < I_OUT) { if (OUT_FP8) transpose_item8(p.in[L0_WOUT], DM, DM, (unsigned char*)(p.ws + WS_WOUT0), 0, 1, scr, r, lane); else transpose_item(p.in[L0_WOUT], DM, DM, (bf16_t*)(p.ws + WS_WOUT0), 0, 1, scr, r, lane, DM); continue; } r -= I_OUT;
      if (r < I_IN1) { if (QKV1_FP8) transpose_item8(p.in[L1_WIN], DM, N_IN1, (unsigned char*)(p.ws + WS_WIN1), 0, 1, scr, r, lane, N_IN1P); else transpose_item(p.in[L1_WIN], DM, N_IN1, (bf16_t*)(p.ws + WS_WIN1), 0, 1, scr, r, lane, N_IN1P); continue; } r -= I_IN1;
      if (OUT_FP8) transpose_item8(p.in[L1_WOUT], DM, DM, (unsigned char*)(p.ws + WS_WOUT1), 0, 1, scr, r, lane); else transpose_item(p.in[L1_WOUT], DM, DM, (bf16_t*)(p.ws + WS_WOUT1), 0, 1, scr, r, lane, DM);
    }
  }
  convert_moe_part8(p, 0, 0, scr, gw, NGW, lane);
#ifndef TAILFILL
  convert_moe_part8(p, 0, 1, scr, gw, NGW, lane);
#endif
}

struct Row16 { float4 v[4]; };
DEVI Row16 ld_row_f32(const float* r, int lane) { Row16 o; const float4* q = (const float4*)r + lane;
#pragma unroll
  for (int j = 0; j < 4; ++j) o.v[j] = q[64 * j]; return o; }
DEVI Row16 ld_row_bf16(const bf16_t* r, int lane) { Row16 o; const uint2* q = (const uint2*)r + lane;
#pragma unroll
  for (int j = 0; j < 4; ++j) { const uint2 w = q[64 * j]; o.v[j] = make_float4(__uint_as_float(w.x << 16), __uint_as_float(w.x & 0xffff0000u), __uint_as_float(w.y << 16), __uint_as_float(w.y & 0xffff0000u)); }
  return o; }
DEVI void st_row_f32(float* r, int lane, const Row16& o) { float4* q = (float4*)r + lane;
#pragma unroll
  for (int j = 0; j < 4; ++j) q[64 * j] = o.v[j]; }
DEVI void st_row_bf16(bf16_t* r, int lane, const Row16& o) { uint2* q = (uint2*)r + lane;
#pragma unroll
  for (int j = 0; j < 4; ++j) q[64 * j] = make_uint2(pk2(o.v[j].x, o.v[j].y), pk2(o.v[j].z, o.v[j].w)); }
DEVI float row_sumsq(const Row16& o) { float s = 0.f;
#pragma unroll
  for (int j = 0; j < 4; ++j) s += o.v[j].x * o.v[j].x + o.v[j].y * o.v[j].y + o.v[j].z * o.v[j].z + o.v[j].w * o.v[j].w;
  return wave_sum(s); }
#define ROW_FOR4(expr) _Pragma("unroll") for (int j = 0; j < 4; ++j) { { float& e = o.v[j].x; const float a = A.v[j].x, b = Bv.v[j].x, c = Cv.v[j].x; expr; } { float& e = o.v[j].y; const float a = A.v[j].y, b = Bv.v[j].y, c = Cv.v[j].y; expr; } { float& e = o.v[j].z; const float a = A.v[j].z, b = Bv.v[j].z, c = Cv.v[j].z; expr; } { float& e = o.v[j].w; const float a = A.v[j].w, b = Bv.v[j].w, c = Cv.v[j].w; expr; } }

DEVI Row16 norm_mod(const Row16& x, const float* g, const float* sc, const float* sh, int lane) {
  const float r = rsqrtf(row_sumsq(x) * (1.f / DM) + EPS);
  Row16 o = x; const Row16 A = ld_row_f32(g, lane), Bv = ld_row_f32(sc, lane), Cv = ld_row_f32(sh, lane);
  ROW_FOR4(e = e * r * a * (1.f + b) + c);
  return o;
}

DEVI void phase_prenorm0(const Params& p) {
  const int lane = ftid() & 63, gw = blockIdx.x * NWAVE + (ftid() >> 6), NGW = gridDim.x * NWAVE;
  const float* MOD = (const float*)(p.ws + WS_CTL + CTL_MOD);
  bf16_t* H = (bf16_t*)(p.ws + WS_H);
  for (int r = gw; r < NROW; r += NGW) {
    const float* src = r < NLAT ? p.in[I_X] + (size_t)r * DM : p.in[I_CTX] + (size_t)(r - NLAT) * DM;
    const float* m = MOD + (size_t)row_modrow(r) * 6144;
    const Row16 x = ld_row_f32(src, lane);
    const Row16 h = norm_mod(x, p.in[L0_GPREMIX], m + 1024, m, lane);
    st_row_bf16(H + (size_t)r * DM, lane, h);
  }
}

template <class AF, class EF>
DEVI void gemm_tile(float* lds, const bf16_t* Bt, int n0, int K, AF arow, EF epi) {
  const int tid = ftid(), ty = tid >> 4, tx = tid & 15;
  float (*As)[132] = (float (*)[132])lds;
  float (*Bs)[68] = (float (*)[68])(lds + 16 * 132);
  float acc[4][4];
#pragma unroll
  for (int i = 0; i < 4; ++i)
#pragma unroll
    for (int j = 0; j < 4; ++j) acc[i][j] = 0.f;
  const int ar = tid >> 2, ak = (tid & 3) * 4;
  const int br = tid >> 3, bk = (tid & 7) * 2;
  const bf16_t* ap = arow(ar) + ak;
  const bf16_t* bp = Bt + (size_t)(n0 + br) * K + bk;
  for (int k0 = 0; k0 < K; k0 += 16) {
    const uint2 av = *(const uint2*)(ap + k0);
    const unsigned bv = *(const unsigned*)(bp + k0);
    __syncthreads();
    As[ak + 0][ar] = __uint_as_float(av.x << 16); As[ak + 1][ar] = __uint_as_float(av.x & 0xffff0000u);
    As[ak + 2][ar] = __uint_as_float(av.y << 16); As[ak + 3][ar] = __uint_as_float(av.y & 0xffff0000u);
    Bs[bk + 0][br] = __uint_as_float(bv << 16); Bs[bk + 1][br] = __uint_as_float(bv & 0xffff0000u);
    __syncthreads();
#pragma unroll
    for (int kk = 0; kk < 16; ++kk) {
      const float4 a = *(const float4*)&As[kk][ty * 4]; const float4 b = *(const float4*)&Bs[kk][tx * 4];
      const float aa[4] = {a.x, a.y, a.z, a.w}, bb[4] = {b.x, b.y, b.z, b.w};
#pragma unroll
      for (int i = 0; i < 4; ++i)
#pragma unroll
        for (int j = 0; j < 4; ++j) acc[i][j] += aa[i] * bb[j];
    }
  }
#pragma unroll
  for (int i = 0; i < 4; ++i) epi(ty * 4 + i, n0 + tx * 4, acc[i]);
}

DEVI void rope_pair(const float* ROPE, int t, int d, float& u1, float& u2) {
  const int i = d >> 1, f = i & 15, pos = (i < 16) ? (t >> 6) : (t & 63);
  const float cs = ROPE[(pos * 16 + f) * 2], sn = ROPE[(pos * 16 + f) * 2 + 1];
  const float a = u1 * cs - u2 * sn, b = u1 * sn + u2 * cs; u1 = a; u2 = b;
}

DEVI void phase_qkv0(const Params& p, float* lds) {
  const bf16_t* H = (const bf16_t*)(p.ws + WS_H); const bf16_t* W = (const bf16_t*)(p.ws + WS_WIN0);
  bf16_t* Q = (bf16_t*)(p.ws + WS_QKV0); const float* ROPE = (const float*)(p.ws + WS_CTL + CTL_ROPE);
  constexpr int NTN = N_IN0 / 64, NTM = NROW / 128;
  for (int it = blockIdx.x; it < NTN * NTM; it += gridDim.x) {
    const int mt = it / NTN, nt = it % NTN, m0 = mt * 128;
    gemm_tile(lds, W, nt * 64, DM,
      [&](int r) { return H + (size_t)(m0 + r) * DM; },
      [&](int r, int n, float* v) {
        const int row = m0 + r;
        if (row < NLAT && n < 1024) { const int t = row & 4095; rope_pair(ROPE, t, n & 63, v[0], v[1]); rope_pair(ROPE, t, (n + 2) & 63, v[2], v[3]); }
        *(uint2*)(Q + (size_t)row * N_IN0 + n) = make_uint2(pk2(v[0], v[1]), pk2(v[2], v[3]));
      });
  }
}

template <int NS, int VJ, class KF>
DEVI void wave_attn(const float* qs, float* pl  , int* rl  , int nkeys, KF kf, const bf16_t* KV, int ld, int kcol, int vcol,
                    float sink, bool has_sink, float (&o)[NS][VJ], float (&m)[NS], float (&l)[NS], int lane) {
#pragma unroll
  for (int s = 0; s < NS; ++s) { m[s] = -INFINITY; l[s] = 0.f;
#pragma unroll
    for (int j = 0; j < VJ; ++j) o[s][j] = 0.f; }
  for (int c0 = 0; c0 < nkeys; c0 += 64) {
    const int kidx = c0 + lane; int row = -1; float bias = 0.f;
    bool valid = kidx < nkeys; if (valid) valid = kf(kidx, row, bias);
    const int rr = valid ? row : 0;
    rl[lane] = valid ? row : -1;
    float sc[NS];
#pragma unroll
    for (int s = 0; s < NS; ++s) {
      const uint4* kp = (const uint4*)(KV + (size_t)rr * ld + kcol + 64 * s); float d = 0.f;
#pragma unroll
      for (int i = 0; i < 8; ++i) { const uint4 w = kp[i]; const float* q = qs + s * 64 + i * 8;
        d += q[0] * __uint_as_float(w.x << 16) + q[1] * __uint_as_float(w.x & 0xffff0000u) + q[2] * __uint_as_float(w.y << 16) + q[3] * __uint_as_float(w.y & 0xffff0000u)
           + q[4] * __uint_as_float(w.z << 16) + q[5] * __uint_as_float(w.z & 0xffff0000u) + q[6] * __uint_as_float(w.w << 16) + q[7] * __uint_as_float(w.w & 0xffff0000u); }
      sc[s] = valid ? d + bias : -INFINITY;
    }
#pragma unroll
    for (int s = 0; s < NS; ++s) {
      const float cm = wave_max(sc[s]); const float mn = fmaxf(m[s], cm);
      float pv = 0.f, scale = 1.f;
      if (mn > -INFINITY) { pv = __expf(sc[s] - mn); scale = __expf(m[s] - mn); }
      l[s] = l[s] * scale + wave_sum(pv); m[s] = mn;
#pragma unroll
      for (int j = 0; j < VJ; ++j) o[s][j] *= scale;
      pl[s * 64 + lane] = pv;
    }
    __builtin_amdgcn_s_waitcnt(0); __builtin_amdgcn_wave_barrier();
    for (int kk = 0; kk < 64; ++kk) {
      const int rk = rl[kk]; if (rk < 0) continue;
      const bf16_t* vp = KV + (size_t)rk * ld + vcol + lane;
      float vv[VJ];
#pragma unroll
      for (int j = 0; j < VJ; ++j) vv[j] = bf2f(vp[64 * j]);
#pragma unroll
      for (int s = 0; s < NS; ++s) { const float pk = pl[s * 64 + kk];
#pragma unroll
        for (int j = 0; j < VJ; ++j) o[s][j] += pk * vv[j]; }
    }
    __builtin_amdgcn_s_waitcnt(0); __builtin_amdgcn_wave_barrier();
  }
  if (has_sink) {
#pragma unroll
    for (int s = 0; s < NS; ++s) { const float mn = fmaxf(m[s], sink); const float scale = __expf(m[s] - mn);
      l[s] = l[s] * scale + __expf(sink - mn); m[s] = mn;
#pragma unroll
      for (int j = 0; j < VJ; ++j) o[s][j] *= scale; }
  }
}

DEVI void phase_attn0(const Params& p, float* lds) {
  const int tid = ftid(), lane = tid & 63, wave = tid >> 6;
  const int gw = blockIdx.x * NWAVE + wave, NGW = gridDim.x * NWAVE;
  const bf16_t* Q = (const bf16_t*)(p.ws + WS_QKV0); bf16_t* ATT = (bf16_t*)(p.ws + WS_ATT0);
  const float lam = ((const float*)(p.ws + WS_CTL + CTL_LAM))[0];
  float* qs = lds + wave * 128; float* pl = lds + 1024 + wave * 128; int* rl = (int*)(lds + 2048) + wave * 64;
  for (long it = gw; it < (long)NROW * 12; it += NGW) {
    const int row = (int)(it / 12), hs = (int)(it % 12);
    const bool lat = row < NLAT; const int b = lat ? (row >> 12) : ((row - NLAT) >> 8), t = lat ? (row & 4095) : 0;
    __builtin_amdgcn_s_waitcnt(0); __builtin_amdgcn_wave_barrier();
    if (hs < 4) {
      const bf16_t* qp = Q + (size_t)row * N_IN0 + hs * 128;
      qs[lane] = bf2f(qp[lane]) * 0.125f; qs[64 + lane] = bf2f(qp[64 + lane]) * 0.125f;
      __builtin_amdgcn_s_waitcnt(0); __builtin_amdgcn_wave_barrier();
      float o[2][2], m[2], l[2];
      const int nkeys = lat ? SEQ + CTXL : CTXL;
      wave_attn<2, 2>(qs, pl, rl, nkeys, [&](int k, int& r, float& bias) { r = lat ? (k < SEQ ? b * SEQ + k : NLAT + b * CTXL + (k - SEQ)) : NLAT + b * CTXL + k; return true; },
                      Q, N_IN0, 512 + hs * 128, 1024 + hs * 128, 0.f, false, o, m, l, lane);
      float v0 = o[0][0] / l[0] - lam * o[1][0] / l[1], v1 = o[0][1] / l[0] - lam * o[1][1] / l[1];
      const float r = rsqrtf(wave_sum(v0 * v0 + v1 * v1) * (1.f / 128.f) + EPS);
      const float* g = p.in[L0_SUBLN];
      ATT[(size_t)row * DM + hs * 128 + lane] = f2bf(v0 * r * g[lane] * 0.8f);
      ATT[(size_t)row * DM + hs * 128 + 64 + lane] = f2bf(v1 * r * g[64 + lane] * 0.8f);
    } else {
      const int h = hs - 4;
      qs[lane] = bf2f(Q[(size_t)row * N_IN0 + 1536 + h * 64 + lane]) * 0.125f;
      __builtin_amdgcn_s_waitcnt(0); __builtin_amdgcn_wave_barrier();
      float o[1][1], m[1], l[1];
      const int qr = t >> 6, qc = t & 63;
      const int rs = min(max(qr - 4, 0), 56), cs = min(max(qc - 8, 0), 48);
      const float* rpb = p.in[L0_RPB] + h * 15 * 31;
      const int nkeys = lat ? 128 + CTXL : CTXL;
      wave_attn<1, 1>(qs, pl, rl, nkeys, [&](int k, int& r, float& bias) {
          if (!lat) { r = NLAT + b * CTXL + k; return true; }
          if (k < 128) { const int kr = rs + (k >> 4), kc = cs + (k & 15); r = b * SEQ + kr * 64 + kc; bias = rpb[(kr - qr + 7) * 31 + (kc - qc + 15)]; }
          else r = NLAT + b * CTXL + (k - 128);
          return true; },
        Q, N_IN0, 2048 + h * 64, 2560 + h * 64, 0.f, false, o, m, l, lane);
      ATT[(size_t)row * DM + 512 + h * 64 + lane] = f2bf(o[0][0] / l[0]);
    }
  }
}

DEVI void phase_outproj(const Params& p, float* lds, int layer) {
  const bf16_t* A = (const bf16_t*)(p.ws + (layer ? WS_ATT1 : WS_ATT0)); const bf16_t* W = (const bf16_t*)(p.ws + (layer ? WS_WOUT1 : WS_WOUT0));
  bf16_t* MIX = (bf16_t*)(p.ws + (layer ? WS_MIX1 : WS_MIX0));
  const int NTM = (layer ? NLAT : NROW) / 128; constexpr int NTN = DM / 64;
  for (int it = blockIdx.x; it < NTN * NTM; it += gridDim.x) {
    const int mt = it / NTN, nt = it % NTN, m0 = mt * 128;
    gemm_tile(lds, W, nt * 64, DM, [&](int r) { return A + (size_t)(m0 + r) * DM; },
      [&](int r, int n, float* v) { *(uint2*)(MIX + (size_t)(m0 + r) * DM + n) = make_uint2(pk2(v[0], v[1]), pk2(v[2], v[3])); });
  }
}

DEVI void phase_postmix(const Params& p, int layer) {
  const int lane = ftid() & 63, gw = blockIdx.x * NWAVE + (ftid() >> 6), NGW = gridDim.x * NWAVE;
  const float* MOD = (const float*)(p.ws + WS_CTL + CTL_MOD) + (size_t)layer * 9 * 6144;
  const bf16_t* MIX = (const bf16_t*)(p.ws + (layer ? WS_MIX1 : WS_MIX0));
  bf16_t* H = (bf16_t*)(p.ws + WS_H); float* AFF = (float*)(p.ws + WS_AFF); float* XC = (float*)(p.ws + WS_XC);
  const float* gpost = p.in[layer ? L1_GPOSTMIX : L0_GPOSTMIX]; const float* gpre = p.in[layer ? L1_GPREFFN : L0_GPREFFN];
  const float* wr = p.in[layer ? L1_WROUTER : L0_WROUTER];
  const int nrow = layer ? NLAT : NROW;
  for (int r = gw; r < nrow; r += NGW) {
    const float* m = MOD + (size_t)row_modrow(r) * 6144;
    const float* xin = layer ? (p.out + (size_t)r * DM) : (r < NLAT ? p.in[I_X] + (size_t)r * DM : p.in[I_CTX] + (size_t)(r - NLAT) * DM);
    float* xout = r < NLAT ? p.out + (size_t)r * DM : XC + (size_t)(r - NLAT) * DM;
    Row16 o = ld_row_bf16(MIX + (size_t)r * DM, lane);
    const float rr = rsqrtf(row_sumsq(o) * (1.f / DM) + EPS);
    { const Row16 A = ld_row_f32(gpost, lane), Bv = ld_row_f32(m + 2048, lane), Cv = ld_row_f32(xin, lane);
      ROW_FOR4(e = c + b * (e * rr * a)); }
    st_row_f32(xout, lane, o);
    const Row16 h = norm_mod(o, gpre, m + 4096, m + 3072, lane);
    st_row_bf16(H + (size_t)r * DM, lane, h);
    float lg[16];
#pragma unroll
    for (int e = 0; e < 16; ++e) lg[e] = 0.f;
#pragma unroll
    for (int j = 0; j < 4; ++j) {
      const float hv[4] = {h.v[j].x, h.v[j].y, h.v[j].z, h.v[j].w};
#pragma unroll
      for (int q = 0; q < 4; ++q) { const float4* w4 = (const float4*)(wr + (size_t)(lane * 4 + 256 * j + q) * 16);
#pragma unroll
        for (int e4 = 0; e4 < 4; ++e4) { const float4 w = w4[e4]; lg[e4 * 4] += hv[q] * w.x; lg[e4 * 4 + 1] += hv[q] * w.y; lg[e4 * 4 + 2] += hv[q] * w.z; lg[e4 * 4 + 3] += hv[q] * w.w; } }
    }
    float mx = -INFINITY;
#pragma unroll
    for (int e = 0; e < 16; ++e) { lg[e] = wave_sum(lg[e]); mx = fmaxf(mx, lg[e]); }
    float s = 0.f;
#pragma unroll
    for (int e = 0; e < 16; ++e) { lg[e] = expf(lg[e] - mx); s += lg[e]; }
    const float inv = 1.f / s;
    float mine = 0.f;
#pragma unroll
    for (int e = 0; e < 16; ++e) if (lane == e) mine = lg[e] * inv;
    if (lane < 16) AFF[(size_t)lane * NROW + r] = mine;
  }
}

DEVI void phase_topk(const Params& p, float* lds, int layer) {
  const int tid = ftid();
  const float* AFF = (const float*)(p.ws + WS_AFF); int* SLOT = (int*)(p.ws + WS_SLOT); int* IDX = (int*)(p.ws + WS_IDX); float* GV = (float*)(p.ws + WS_GATEV);
  const int erows = layer ? EROWS1 : EROWS0;
  const int nlat_items = NB * NE * 8, nitems = nlat_items + (layer ? 0 : NB * NE);
  for (int it = blockIdx.x; it < nitems; it += gridDim.x) {
    const bool lat = it < nlat_items;
    int b, e, ch, n, cap, row0, slot0;
    if (lat) { b = it / (NE * 8); e = (it / 8) % NE; ch = it % 8; n = SEQ; cap = CAP_L; row0 = b * SEQ; slot0 = b * CAP_L; }
    else { const int i2 = it - nlat_items; b = i2 / NE; e = i2 % NE; ch = 0; n = CTXL; cap = CAP_C; row0 = NLAT + b * CTXL; slot0 = NB * CAP_L + b * CAP_C; }
    __syncthreads();
    for (int i = tid; i < n; i += NT) lds[i] = AFF[(size_t)e * NROW + row0 + i];
    __syncthreads();
    const int t = ch * 512 + tid;
    if (t < n) {
      const float a = lds[t]; int rank = 0;
      for (int j = 0; j < n; ++j) { const float v = lds[j]; rank += (v > a || (v == a && j < t)) ? 1 : 0; }
      if (rank < cap) { IDX[e * erows + slot0 + rank] = row0 + t; GV[e * erows + slot0 + rank] = a; SLOT[(size_t)(row0 + t) * 16 + e] = slot0 + rank; }
      else SLOT[(size_t)(row0 + t) * 16 + e] = -1;
    }
  }
}

DEVI void phase_moe_up(const Params& p, float* lds, int layer) {
  const bf16_t* H = (const bf16_t*)(p.ws + WS_H); const bf16_t* WGU = (const bf16_t*)(p.ws + WS_WGU); bf16_t* HID = (bf16_t*)(p.ws + WS_HID);
  const int* IDX = (const int*)(p.ws + WS_IDX);
  const int erows = layer ? EROWS1 : EROWS0, NTM = erows / 128; constexpr int NTN = 2048 / 64;
  for (int it = blockIdx.x; it < NE * NTM * NTN; it += gridDim.x) {
    const int e = it / (NTM * NTN), r2 = it % (NTM * NTN), mt = r2 / NTN, nt = r2 % NTN, m0 = mt * 128;
    gemm_tile(lds, WGU + (size_t)e * 2048 * DM, nt * 64, DM, [&](int r) { return H + (size_t)IDX[e * erows + m0 + r] * DM; },
      [&](int r, int n, float* v) { *(unsigned*)(HID + ((size_t)e * erows + m0 + r) * DM + (n >> 1)) = pk2(silu_f(v[0]) * v[1], silu_f(v[2]) * v[3]); });
  }
}
DEVI void phase_moe_down(const Params& p, float* lds, int layer) {
  const bf16_t* HID = (const bf16_t*)(p.ws + WS_HID); const bf16_t* WD = (const bf16_t*)(p.ws + WS_WD); bf16_t* Y = (bf16_t*)(p.ws + WS_Y);
  const float* GV = (const float*)(p.ws + WS_GATEV);
  const int erows = layer ? EROWS1 : EROWS0, NTM = erows / 128; constexpr int NTN = DM / 64;
  for (int it = blockIdx.x; it < NE * NTM * NTN; it += gridDim.x) {
    const int e = it / (NTM * NTN), r2 = it % (NTM * NTN), mt = r2 / NTN, nt = r2 % NTN, m0 = mt * 128;
    gemm_tile(lds, WD + (size_t)e * DM * DM, nt * 64, DM, [&](int r) { return HID + ((size_t)e * erows + m0 + r) * DM; },
      [&](int r, int n, float* v) { const float g = GV[e * erows + m0 + r];
        *(uint2*)(Y + ((size_t)e * erows + m0 + r) * DM + n) = make_uint2(pk2(v[0] * g, v[1] * g), pk2(v[2] * g, v[3] * g)); });
  }
}

DEVI void phase_combine(const Params& p, float* lds, int layer) {
  const int lane = ftid() & 63, wave = ftid() >> 6, gw = blockIdx.x * NWAVE + wave, NGW = gridDim.x * NWAVE;
  const float* MOD = (const float*)(p.ws + WS_CTL + CTL_MOD);
  const bf16_t* Y = (const bf16_t*)(p.ws + WS_Y); const int* SLOT = (const int*)(p.ws + WS_SLOT);
  bf16_t* H = (bf16_t*)(p.ws + WS_H); float* XC = (float*)(p.ws + WS_XC);
  const float* gpost = p.in[layer ? L1_GPOSTFFN : L0_GPOSTFFN];
  const int nrow = layer ? NLAT : NROW, erows = layer ? EROWS1 : EROWS0;
  for (int r = gw; r < nrow; r += NGW) {
    const float* m = MOD + (size_t)(layer * 9 + row_modrow(r)) * 6144;
    float* xio = r < NLAT ? p.out + (size_t)r * DM : XC + (size_t)(r - NLAT) * DM;
    Row16 o;
#pragma unroll
    for (int j = 0; j < 4; ++j) o.v[j] = make_float4(0.f, 0.f, 0.f, 0.f);
    for (int e = 0; e < NE; ++e) {
      const int s = SLOT[(size_t)r * 16 + e];
      if (s >= 0) { const Row16 y = ld_row_bf16(Y + ((size_t)e * erows + s) * DM, lane);
#pragma unroll
        for (int j = 0; j < 4; ++j) { o.v[j].x += y.v[j].x; o.v[j].y += y.v[j].y; o.v[j].z += y.v[j].z; o.v[j].w += y.v[j].w; } }
    }
    const float rr = rsqrtf(row_sumsq(o) * (1.f / DM) + EPS);
    { const Row16 A = ld_row_f32(gpost, lane), Bv = ld_row_f32(m + 5120, lane), Cv = ld_row_f32(xio, lane);
      ROW_FOR4(e = c + b * (e * rr * a)); }
    st_row_f32(xio, lane, o);
    if (layer == 0) {
      const float* m1 = MOD + (size_t)(9 + row_modrow(r)) * 6144;
      const Row16 h = norm_mod(o, p.in[L1_GPREMIX], m1 + 1024, m1, lane);
      st_row_bf16(H + (size_t)r * DM, lane, h);
    }
  }
  if (layer == 0) { convert_moe_part(p, 1, 0, lds + wave * (64 * 33), gw, NGW, lane); convert_moe_part(p, 1, 1, lds + wave * (64 * 33), gw, NGW, lane); }
}

DEVI void phase_qkv1(const Params& p, float* lds) {
  const bf16_t* H = (const bf16_t*)(p.ws + WS_H); const bf16_t* W = (const bf16_t*)(p.ws + WS_WIN1);
  bf16_t* P1 = (bf16_t*)(p.ws + WS_P1); float* DT = (float*)(p.ws + WS_DT); const float* ROPE = (const float*)(p.ws + WS_CTL + CTL_ROPE);
  constexpr int NTN = 37, NTM = NROW / 128;
  for (int it = blockIdx.x; it < NTN * NTM; it += gridDim.x) {
    const int mt = it / NTN, nt = it % NTN, m0 = mt * 128;
    gemm_tile(lds, W, nt * 64, DM, [&](int r) { return H + (size_t)(m0 + r) * DM; },
      [&](int r, int n, float* v) {
        const int row = m0 + r;
        if (n >= 2304) { if (n < 2320) *(float4*)(DT + (size_t)row * 16 + (n - 2304)) = make_float4(v[0], v[1], v[2], v[3]); return; }
        if (row < NLAT && n < 640) { const int t = row & 4095; rope_pair(ROPE, t, n & 63, v[0], v[1]); rope_pair(ROPE, t, (n + 2) & 63, v[2], v[3]); }
        *(uint2*)(P1 + (size_t)row * 2304 + n) = make_uint2(pk2(v[0], v[1]), pk2(v[2], v[3]));
      });
  }
}

DEVI void phase_conv_swa(const Params& p, float* lds, bool do_swa) {
  const int tid = ftid(), lane = tid & 63, wave = tid >> 6;
  const int gw = blockIdx.x * NWAVE + wave, NGW = gridDim.x * NWAVE;
  const bf16_t* P1 = (const bf16_t*)(p.ws + WS_P1); bf16_t* U = (bf16_t*)(p.ws + WS_U); bf16_t* ATT = (bf16_t*)(p.ws + WS_ATT1);
  const float* cw = p.in[L1_CONVW]; const float* cb = p.in[L1_CONVB];
  for (long i = (long)blockIdx.x * NT + tid; i < (long)NROW * 1024; i += (long)gridDim.x * NT) {
    const int row = (int)(i >> 10), ch = (int)(i & 1023);
    int s0, len, t; if (row < NLAT) { s0 = row & ~4095; len = SEQ; t = row & 4095; } else { s0 = NLAT + ((row - NLAT) & ~255); len = CTXL; t = (row - NLAT) & 255; }
    float acc = cb[ch];
#pragma unroll
    for (int j = 0; j < 5; ++j) { const int tt = t + j - 2; if (tt >= 0 && tt < len) acc += cw[j * 1024 + ch] * bf2f(P1[(size_t)(s0 + tt) * 2304 + 768 + ch]); }
    U[(size_t)row * 1024 + ch] = f2bf(silu_f(acc));
  }
  if (!do_swa) return;
  float* qs = lds + wave * 128; float* pl = lds + 1024 + wave * 128; int* rl = (int*)(lds + 2048) + wave * 64;
  for (long it = gw; it < (long)NLAT * 8; it += NGW) {
    const int row = (int)(it >> 3), hq = (int)(it & 7), g = hq >> 2, b = row >> 12, t = row & 4095;
    __builtin_amdgcn_s_waitcnt(0); __builtin_amdgcn_wave_barrier();
    qs[lane] = bf2f(P1[(size_t)row * 2304 + hq * 64 + lane]) * 0.125f;
    __builtin_amdgcn_s_waitcnt(0); __builtin_amdgcn_wave_barrier();
    float o[1][1], m[1], l[1];
    wave_attn<1, 1>(qs, pl, rl, 320 + CTXL, [&](int k, int& r, float& bias) {
        if (k < 320) { const int kp = t - 128 + k; if (k > 256 || kp < 0 || kp >= SEQ) return false; r = b * SEQ + kp; return true; }
        r = NLAT + b * CTXL + (k - 320); return true; },
      P1, 2304, 512 + g * 64, 640 + g * 64, p.in[L1_SINKS][hq], true, o, m, l, lane);
    ATT[(size_t)row * DM + hq * 64 + lane] = f2bf(o[0][0] / l[0]);
  }
}

DEVI void phase_ssd(const Params& p, float* lds) {
  const int tid = ftid();
  const bf16_t* U = (const bf16_t*)(p.ws + WS_U); const float* DT = (const float*)(p.ws + WS_DT); float* YS = (float*)(p.ws + WS_YS);
  constexpr int CH = 32;
  float* xb = lds;
  float* bb = lds + CH * 64;
  float* cb = bb + CH * 128;
  float* db = cb + CH * 128;
  float* yb = db + 2 * CH;
  const int pi = tid >> 3, ns = (tid & 7) * 16;
  for (int it = blockIdx.x; it < NB * 8; it += gridDim.x) {
    const int b = it >> 3, hd = it & 7, g = hd >> 2;
    for (int dir = 0; dir < 2; ++dir) {
      const float a = -expf(p.in[dir ? L1_ALOGB : L1_ALOGF][hd]); const float dtb = p.in[dir ? L1_DTBB : L1_DTBF][hd];
      float st[16];
#pragma unroll
      for (int i = 0; i < 16; ++i) st[i] = 0.f;
      for (int seg = 0; seg < 2; ++seg) {
        const int len = seg ? SEQ : CTXL, s0 = seg ? b * SEQ : NLAT + b * CTXL;
        for (int c0 = 0; c0 < len; c0 += CH) {
          __syncthreads();
          for (int i = tid; i < CH * 320; i += NT) {
            const int st_i = i / 320, c = i % 320; const int tk = dir ? (len - 1 - (c0 + st_i)) : (c0 + st_i); const size_t r = (size_t)(s0 + tk);
            if (c < 64) xb[st_i * 64 + c] = bf2f(U[r * 1024 + hd * 64 + c]);
            else if (c < 192) bb[st_i * 128 + (c - 64)] = bf2f(U[r * 1024 + 512 + g * 128 + (c - 64)]);
            else cb[st_i * 128 + (c - 192)] = bf2f(U[r * 1024 + 768 + g * 128 + (c - 192)]);
          }
          if (tid < CH) { const int tk = dir ? (len - 1 - (c0 + tid)) : (c0 + tid); const float raw = DT[(size_t)(s0 + tk) * 16 + dir * 8 + hd] + dtb;
            const float dt = raw > 20.f ? raw : log1pf(expf(raw)); db[tid] = expf(dt * a); db[CH + tid] = dt; }
          __syncthreads();
          for (int i = 0; i < CH; ++i) {
            const float dec = db[i], dx = db[CH + i] * xb[i * 64 + pi]; float y = 0.f;
#pragma unroll
            for (int q = 0; q < 16; ++q) { st[q] = st[q] * dec + dx * bb[i * 128 + ns + q]; y += st[q] * cb[i * 128 + ns + q]; }
            y += __shfl_xor(y, 1); y += __shfl_xor(y, 2); y += __shfl_xor(y, 4);
            if ((tid & 7) == 0) yb[i * 64 + pi] = y;
          }
          __syncthreads();
          if (seg == 1) for (int i = tid; i < CH * 64; i += NT) {
            const int q = i >> 6, c = i & 63; const int tk = (dir ? (len - CH - c0) : c0) + q, st_i = dir ? (CH - 1 - q) : q;
            float* yp = YS + (size_t)(b * SEQ + tk) * 512 + hd * 64 + c;
            if (dir == 0) *yp = yb[st_i * 64 + c]; else *yp = *yp + yb[st_i * 64 + c];
          }
        }
      }
      __syncthreads(); __threadfence();
    }
  }
}

DEVI void phase_ssd_out(const Params& p) {
  const int lane = ftid() & 63, gw = blockIdx.x * NWAVE + (ftid() >> 6), NGW = gridDim.x * NWAVE;
  const bf16_t* U = (const bf16_t*)(p.ws + WS_U); const bf16_t* P1 = (const bf16_t*)(p.ws + WS_P1); const float* YS = (const float*)(p.ws + WS_YS);
  bf16_t* ATT = (bf16_t*)(p.ws + WS_ATT1);
  for (int r = gw; r < NLAT; r += NGW) {
    const int c0 = lane * 8, hd = c0 >> 6; const float dsk = p.in[L1_DSKIP][hd];
    const float4 y0 = *(const float4*)(YS + (size_t)r * 512 + c0), y1 = *(const float4*)(YS + (size_t)r * 512 + c0 + 4);
    const uint4 xw = *(const uint4*)(U + (size_t)r * 1024 + c0), zw = *(const uint4*)(P1 + (size_t)r * 2304 + 1792 + c0);
    float y[8] = {y0.x, y0.y, y0.z, y0.w, y1.x, y1.y, y1.z, y1.w};
    const unsigned xs[4] = {xw.x, xw.y, xw.z, xw.w}, zs[4] = {zw.x, zw.y, zw.z, zw.w};
    float ss = 0.f;
#pragma unroll
    for (int i = 0; i < 4; ++i) {
      const float x0 = __uint_as_float(xs[i] << 16), x1 = __uint_as_float(xs[i] & 0xffff0000u), z0 = __uint_as_float(zs[i] << 16), z1 = __uint_as_float(zs[i] & 0xffff0000u);
      y[2 * i] = (y[2 * i] + dsk * x0) * silu_f(z0); y[2 * i + 1] = (y[2 * i + 1] + dsk * x1) * silu_f(z1);
      ss += y[2 * i] * y[2 * i] + y[2 * i + 1] * y[2 * i + 1];
    }
#pragma unroll
    for (int o = 1; o < 32; o <<= 1) ss += __shfl_xor(ss, o);
    const float rr = rsqrtf(ss * (1.f / 256.f) + EPS);
    const float4 g0 = *(const float4*)(p.in[L1_GNORM] + c0), g1 = *(const float4*)(p.in[L1_GNORM] + c0 + 4);
    uint4 w; w.x = pk2(y[0] * rr * g0.x, y[1] * rr * g0.y); w.y = pk2(y[2] * rr * g0.z, y[3] * rr * g0.w); w.z = pk2(y[4] * rr * g1.x, y[5] * rr * g1.y); w.w = pk2(y[6] * rr * g1.z, y[7] * rr * g1.w);
    *(uint4*)(ATT + (size_t)r * DM + 512 + c0) = w;
  }
}

}
namespace pg8 {
#define PG8_LAS __attribute__((address_space(3)))
typedef unsigned short bf16_t;
typedef short bf16x8 __attribute__((ext_vector_type(8)));
typedef float f32x4 __attribute__((ext_vector_type(4)));
typedef unsigned u32x4 __attribute__((ext_vector_type(4)));
constexpr int BM = 256, BK = 64, HALF = 128, HTB = HALF * BK * 2  , STAGE_BYTES = 8 * HTB, NXCD = 8, WGM = 8;

__host__ __device__ __forceinline__ int lds_byte(int r, int c) { const int st = (r >> 4) * 2 + (c >> 5), rr = r & 15, cc = c & 31, ob = rr * 64 + cc * 2; return st * 1024 + (ob ^ (((ob >> 9) & 1) << 5)); }
__host__ __device__ __forceinline__ void stage_rc(int b, int& R, int& C) { const int st = b / 1024, sb = b % 1024, swz = sb ^ (((sb >> 9) & 1) << 5); R = (st >> 1) * 16 + swz / 64; C = (st & 1) * 32 + (swz % 64) / 2; }
__host__ __device__ __forceinline__ int perm32(int rho) { const int n = rho >> 4, i = rho & 15; return 8 * (i >> 2) + 4 * n + (i & 3); }

struct Unit { int pm, pn; };
struct Gemm { const bf16_t* A; const bf16_t* Bt; int M, N, K; const int* gidx = nullptr; int sw = 0x7f7f7f7f, sa = 0x7f7f7f7f; };

struct StaticOrder {
    int nM, nN, nwg, G, c;
    __host__ __device__ void init(int M, int N, int G_, int c_) { nM = M / BM; nN = N / BM; nwg = nM * nN; G = G_; c = c_; }
    __host__ __device__ bool next(int i, Unit& u) const {
        const long L = (long)i * G + c; if (L >= nwg) return false;
        int wgid = (int)L; { const int q = nwg / NXCD, r = nwg % NXCD, xcd = wgid % NXCD, off = wgid / NXCD; wgid = (xcd < r ? xcd * (q + 1) : r * (q + 1) + (xcd - r) * q) + off; }
        const int nig = WGM * nN, gid = wgid / nig, fm = gid * WGM, gsz = (nM - fm) < WGM ? (nM - fm) : WGM;
        u.pm = fm + ((wgid % nig) % gsz); u.pn = (wgid % nig) / gsz; return true;
    }
    __device__ __forceinline__ void a_ready(const Unit&) const {}
    __device__ __forceinline__ void done(const Unit&) const {}
};

template <class Epi, class Sched, bool ALIGN_EPI = false, bool SP2 = false, bool FP8 = false>
__device__ __forceinline__ void gemm_phase(PG8_LAS unsigned char* lds, const Gemm g, const Sched& S, const Epi& E) {
    const int tid = ftid(), wid = __builtin_amdgcn_readfirstlane(tid >> 6), lane = tid & 63, wr = wid >> 2, wc = wid & 3, fr = lane & 15, fq = lane >> 4;
    const int KB = g.K * (FP8 ? 1 : 2), nt = KB / (BK * 2);
    unsigned voffB[2]; int pR[2], pC[2];
#pragma unroll
    for (int i = 0; i < 2; ++i) { int R, C; stage_rc(tid * 16 + i * 8192, R, C); const int Rb = Epi::PERM ? ((R & ~31) + perm32(R & 31)) : R;
        pR[i] = R; pC[i] = C; voffB[i] = (unsigned)(Rb * KB + C * 2); }
    unsigned cvo[2][2], nvo[2][2];
#define PG8_SETVO(vo, pm_) do { _Pragma("unroll") for (int _h = 0; _h < 2; ++_h) _Pragma("unroll") for (int _i = 0; _i < 2; ++_i) { const int _r = (pm_) * BM + _h * HALF + pR[_i]; \
        const int _g = g.gidx ? g.gidx[_r] : _r; vo[_h][_i] = (unsigned)_g * (unsigned)KB + (unsigned)(pC[_i] * 2); } } while (0)
#define PG8_STAGEA(bufoff, koff, vo) do { _Pragma("unroll") for (int _i = 0; _i < 2; ++_i) \
        __builtin_amdgcn_global_load_lds((const unsigned*)((const char*)g.A + (koff) + (vo)[_i]), (PG8_LAS unsigned*)(lds + (bufoff) + ldsw + _i * 8192), 16, 0, 0); } while (0)
    const size_t kstep = (size_t)(BK * 2);
    const size_t hstep = (size_t)HALF * KB;
    const size_t tstep = 2 * hstep;
    const unsigned ldsw = (unsigned)wid * 1024u;
    const int aoff = lds_byte(wr * 64 + fr, fq * 8), boff = lds_byte(wc * 32 + fr, fq * 8);
#define PG8_SA(b, h) (((b) * 2 + (h)) * HTB)
#define PG8_SB(b, h) ((4 + (b) * 2 + (h)) * HTB)
#define PG8_STAGE(bufoff, gbase, voff) do { _Pragma("unroll") for (int _i = 0; _i < 2; ++_i) \
        __builtin_amdgcn_global_load_lds((const unsigned*)((const char*)(gbase) + (voff)[_i]), (PG8_LAS unsigned*)(lds + (bufoff) + ldsw + _i * 8192), 16, 0, 0); } while (0)
    typedef int v4i_t __attribute__((ext_vector_type(4))); typedef int v8i_t __attribute__((ext_vector_type(8)));
#define PG8_CAT8(x, y) __builtin_shufflevector(__builtin_bit_cast(v4i_t, x), __builtin_bit_cast(v4i_t, y), 0, 1, 2, 3, 4, 5, 6, 7)
#define PG8_LDA(dst, b, h) do { _Pragma("unroll") for (int m = 0; m < 4; ++m) { const bf16x8 f0_ = *(const PG8_LAS bf16x8*)(lds + PG8_SA(b, h) + aoff + m * 2048), f1_ = *(const PG8_LAS bf16x8*)(lds + PG8_SA(b, h) + aoff + m * 2048 + 1024); \
        if constexpr (FP8) dst##8[m] = PG8_CAT8(f0_, f1_); else { dst[m][0] = f0_; dst[m][1] = f1_; } } } while (0)
#define PG8_LDB(dst, b, h) do { _Pragma("unroll") for (int n = 0; n < 2; ++n) { const bf16x8 f0_ = *(const PG8_LAS bf16x8*)(lds + PG8_SB(b, h) + boff + n * 2048), f1_ = *(const PG8_LAS bf16x8*)(lds + PG8_SB(b, h) + boff + n * 2048 + 1024); \
        if constexpr (FP8) dst##8[n] = PG8_CAT8(f0_, f1_); else { dst[n][0] = f0_; dst[n][1] = f1_; } } } while (0)
typedef int v4i_t __attribute__((ext_vector_type(4))); typedef int v8i_t __attribute__((ext_vector_type(8)));
#define PG8_CAT8(x, y) __builtin_shufflevector(__builtin_bit_cast(v4i_t, x), __builtin_bit_cast(v4i_t, y), 0, 1, 2, 3, 4, 5, 6, 7)
#define PG8_MMA(ai, bj, At, Bt) do { __builtin_amdgcn_s_setprio(1); _Pragma("unroll") for (int m = 0; m < 4; ++m) _Pragma("unroll") for (int n = 0; n < 2; ++n) { \
        if constexpr (FP8) asm volatile("v_mfma_scale_f32_16x16x128_f8f6f4 %0, %1, %2, %0, %3, %4 op_sel_hi:[0,0,0]" : "+v"(acc[ai][bj][m][n]) : "v"(Bt##8[n]), "v"(At##8[m]), "v"(sw_), "v"(sa_)); \
        else { _Pragma("unroll") for (int k = 0; k < 2; ++k) acc[ai][bj][m][n] = __builtin_amdgcn_mfma_f32_16x16x32_bf16(Bt[n][k], At[m][k], acc[ai][bj][m][n], 0, 0, 0); } } \
        __builtin_amdgcn_s_setprio(0); } while (0)
#define PG8_WAIT_V(n) asm volatile("s_waitcnt vmcnt(" #n ")" ::: "memory")
#define PG8_WAIT_L(n) asm volatile("s_waitcnt lgkmcnt(" #n ")" ::: "memory")
#define PG8_BAR __builtin_amdgcn_s_barrier()
#define PG8_SCHED __builtin_amdgcn_sched_barrier(0)
    Unit cur, nxt; int ui = 0;
    if (!S.next(0, cur)) return;
    f32x4 acc[2][2][4][2];
#pragma unroll
    for (int a = 0; a < 2; ++a)
#pragma unroll
        for (int b = 0; b < 2; ++b)
#pragma unroll
            for (int m = 0; m < 4; ++m)
#pragma unroll
                for (int n = 0; n < 2; ++n) acc[a][b][m][n] = (f32x4){0.f, 0.f, 0.f, 0.f};
    const int sw_ = g.sw, sa_ = g.sa;
    bf16x8 At[4][2], B0[2][2], B1[2][2]; v8i_t At8[4], B08[2], B18[2];
    PG8_SETVO(cvo, cur.pm); const char* cB = (const char*)g.Bt + (size_t)cur.pn * tstep;
    S.a_ready(cur);
    if constexpr (SP2) {
        PG8_STAGE(PG8_SB(0, 0), cB, voffB); PG8_STAGE(PG8_SB(0, 1), cB + hstep, voffB); PG8_STAGEA(PG8_SA(0, 0), 0, cvo[0]); PG8_STAGEA(PG8_SA(0, 1), 0, cvo[1]);
        if (wr == 1) PG8_BAR;
        PG8_WAIT_V(2); PG8_BAR;
        PG8_STAGE(PG8_SB(1, 0), cB + kstep, voffB); PG8_STAGEA(PG8_SA(1, 0), kstep, cvo[0]); PG8_STAGE(PG8_SB(1, 1), cB + hstep + kstep, voffB);
        PG8_WAIT_V(6); PG8_BAR;
    } else {
        PG8_STAGE(PG8_SB(0, 0), cB, voffB); PG8_STAGEA(PG8_SA(0, 0), 0, cvo[0]); PG8_STAGE(PG8_SB(0, 1), cB + hstep, voffB); PG8_STAGEA(PG8_SA(0, 1), 0, cvo[1]);
        if (wr == 1) PG8_BAR;
        PG8_WAIT_V(4); PG8_BAR;
        PG8_STAGE(PG8_SB(1, 0), cB + kstep, voffB); PG8_STAGEA(PG8_SA(1, 0), kstep, cvo[0]); PG8_STAGE(PG8_SB(1, 1), cB + hstep + kstep, voffB);
        PG8_WAIT_V(6); PG8_BAR;
    }
    for (;;) {
        const bool has_next = S.next(ui + 1, nxt);
        if (has_next) PG8_SETVO(nvo, nxt.pm); else { nvo[0][0] = cvo[0][0]; nvo[0][1] = cvo[0][1]; nvo[1][0] = cvo[1][0]; nvo[1][1] = cvo[1][1]; }
        const char* nB = has_next ? (const char*)g.Bt + (size_t)nxt.pn * tstep : cB;
#pragma unroll 1
        for (int t = 0; t < nt; t += 2) {
            const bool last = (t == nt - 2);
            const size_t k1 = (size_t)(t + 1) * kstep;
            const size_t k2 = last ? 0 : (size_t)(t + 2) * kstep; unsigned v2[2][2];
            v2[0][0] = last ? nvo[0][0] : cvo[0][0]; v2[0][1] = last ? nvo[0][1] : cvo[0][1]; v2[1][0] = last ? nvo[1][0] : cvo[1][0]; v2[1][1] = last ? nvo[1][1] : cvo[1][1];
            const char* b2 = last ? nB : cB + (size_t)(t + 2) * kstep;
            const size_t k3 = k2 + kstep; const char* b3 = b2 + kstep;
            if (last && has_next) S.a_ready(nxt);
            if constexpr (SP2) {
            PG8_LDB(B0, 0, 0); PG8_LDB(B1, 0, 1); PG8_SCHED; PG8_LDA(At, 0, 0); PG8_STAGEA(PG8_SA(1, 1), k1, cvo[1]);
            PG8_WAIT_V(8); PG8_WAIT_L(0); PG8_BAR; PG8_MMA(0, 0, At, B0); PG8_MMA(0, 1, At, B1); PG8_BAR; PG8_SCHED;
            PG8_LDA(At, 0, 1); PG8_STAGE(PG8_SB(0, 0), b2, voffB); PG8_STAGE(PG8_SB(0, 1), b2 + hstep, voffB); PG8_STAGEA(PG8_SA(0, 0), k2, v2[0]);
            PG8_WAIT_V(8); PG8_WAIT_L(0); PG8_BAR; PG8_MMA(1, 0, At, B0); PG8_MMA(1, 1, At, B1); PG8_BAR; PG8_SCHED;
            PG8_LDB(B0, 1, 0); PG8_LDB(B1, 1, 1); PG8_SCHED; PG8_LDA(At, 1, 0); PG8_STAGEA(PG8_SA(0, 1), k2, v2[1]);
            PG8_WAIT_V(8); PG8_WAIT_L(0); PG8_BAR; PG8_MMA(0, 0, At, B0); PG8_MMA(0, 1, At, B1); PG8_BAR; PG8_SCHED;
            PG8_LDA(At, 1, 1); PG8_STAGE(PG8_SB(1, 0), b3, voffB); PG8_STAGE(PG8_SB(1, 1), b3 + hstep, voffB); PG8_STAGEA(PG8_SA(1, 0), k3, v2[0]);
            PG8_WAIT_V(8); PG8_WAIT_L(0); PG8_BAR; PG8_MMA(1, 0, At, B0); PG8_MMA(1, 1, At, B1); PG8_BAR; PG8_SCHED;
            } else {
            PG8_LDB(B0, 0, 0); PG8_SCHED; PG8_LDA(At, 0, 0); PG8_STAGEA(PG8_SA(1, 1), k1, cvo[1]);
            PG8_WAIT_L(8); PG8_BAR; PG8_WAIT_L(0); PG8_MMA(0, 0, At, B0); PG8_BAR; PG8_SCHED;
            PG8_LDB(B1, 0, 1); PG8_STAGE(PG8_SB(0, 0), b2, voffB);
            PG8_BAR; PG8_WAIT_L(0); PG8_MMA(0, 1, At, B1); PG8_BAR;
            PG8_LDA(At, 0, 1); PG8_STAGEA(PG8_SA(0, 0), k2, v2[0]);
            PG8_BAR; PG8_WAIT_L(0); PG8_MMA(1, 0, At, B0); PG8_BAR; PG8_SCHED;
            PG8_STAGE(PG8_SB(0, 1), b2 + hstep, voffB);
            PG8_WAIT_V(6); PG8_BAR; PG8_MMA(1, 1, At, B1); PG8_BAR;
            PG8_LDB(B0, 1, 0); PG8_SCHED; PG8_LDA(At, 1, 0); PG8_STAGEA(PG8_SA(0, 1), k2, v2[1]);
            PG8_WAIT_L(8); PG8_BAR; PG8_WAIT_L(0); PG8_MMA(0, 0, At, B0); PG8_BAR; PG8_SCHED;
            PG8_LDB(B1, 1, 1); PG8_STAGE(PG8_SB(1, 0), b3, voffB);
            PG8_BAR; PG8_WAIT_L(0); PG8_MMA(0, 1, At, B1); PG8_BAR;
            PG8_LDA(At, 1, 1); PG8_STAGEA(PG8_SA(1, 0), k3, v2[0]);
            PG8_BAR; PG8_WAIT_L(0); PG8_MMA(1, 0, At, B0); PG8_BAR; PG8_SCHED;
            PG8_STAGE(PG8_SB(1, 1), b3 + hstep, voffB);
            PG8_WAIT_V(6); PG8_BAR; PG8_MMA(1, 1, At, B1); PG8_BAR;
            }
        }
        if constexpr (ALIGN_EPI) { if (wr == 0) PG8_BAR; }
        if constexpr (FP8) asm volatile("s_nop 15\n\ts_nop 15" ::: "memory");
        if constexpr (!Epi::AFTER_DRAIN) { E(acc, cur, wr, wc, fr, fq); S.done(cur); }
        if (!has_next) break;
#pragma unroll
        for (int a = 0; a < 2; ++a)
#pragma unroll
            for (int b = 0; b < 2; ++b)
#pragma unroll
                for (int m = 0; m < 4; ++m)
#pragma unroll
                    for (int n = 0; n < 2; ++n) acc[a][b][m][n] = (f32x4){0.f, 0.f, 0.f, 0.f};
        cur = nxt; cvo[0][0] = nvo[0][0]; cvo[0][1] = nvo[0][1]; cvo[1][0] = nvo[1][0]; cvo[1][1] = nvo[1][1]; cB = nB; ++ui;
        if constexpr (ALIGN_EPI) { if (wr == 1) PG8_BAR; }
    }
    PG8_WAIT_V(0);
    if constexpr (!ALIGN_EPI) { if (wr == 0) PG8_BAR; }
    PG8_BAR;
    if constexpr (Epi::AFTER_DRAIN) { E.fused(acc, cur, wr, wc, fr, fq, lds, wid, lane); S.done(cur); }
#undef PG8_SA
#undef PG8_SB
#undef PG8_STAGE
#undef PG8_STAGEA
#undef PG8_SETVO
#undef PG8_LDA
#undef PG8_LDB
#undef PG8_MMA
#undef PG8_CAT8
#undef PG8_WAIT_V
#undef PG8_WAIT_L
#undef PG8_BAR
#undef PG8_SCHED
}
}
#ifndef FP8_SP2
#define FP8_SP2 true
#endif
#ifndef ATTNA_FP8
#define ATTNA_FP8 1
#endif
namespace fg {
using pg8::f32x4; using pg8::Unit;
typedef unsigned u32x4 __attribute__((ext_vector_type(4)));
typedef unsigned u32x2 __attribute__((ext_vector_type(2)));
DEVI unsigned cvtpk(float lo, float hi) { typedef float f2_t __attribute__((ext_vector_type(2))); typedef __bf16 b2_t __attribute__((ext_vector_type(2))); const f2_t v = {lo, hi}; const b2_t b = __builtin_convertvector(v, b2_t); return __builtin_bit_cast(unsigned, b); }
template <class TP> DEVI void rope8(TP ROPE, int t, int d0, f32x4& v0, f32x4& v1) {
  const int i0 = d0 >> 1, f0 = i0 & 15, pos = (i0 < 16) ? (t >> 6) : (t & 63);
  const f32x4 r0 = *(const PG8_LAS f32x4*)(ROPE + (pos * 16 + f0) * 2), r1 = *(const PG8_LAS f32x4*)(ROPE + (pos * 16 + f0) * 2 + 4);
  const f32x4 a = v0, b = v1;
  v0[0] = a[0] * r0[0] - a[1] * r0[1]; v0[1] = a[0] * r0[1] + a[1] * r0[0]; v0[2] = a[2] * r0[2] - a[3] * r0[3]; v0[3] = a[2] * r0[3] + a[3] * r0[2];
  v1[0] = b[0] * r1[0] - b[1] * r1[1]; v1[1] = b[0] * r1[1] + b[1] * r1[0]; v1[2] = b[2] * r1[2] - b[3] * r1[3]; v1[3] = b[2] * r1[3] + b[3] * r1[2];
}
#define EPI_LOOP_BEGIN const int row0 = u.pm * 256 + wr * 64 + fr; \
  _Pragma("unroll") for (int ai = 0; ai < 2; ++ai) _Pragma("unroll") for (int m = 0; m < 4; ++m) { const int row = row0 + ai * 128 + m * 16; \
  _Pragma("unroll") for (int bj = 0; bj < 2; ++bj) { f32x4 v0 = acc[ai][bj][m][0], v1 = acc[ai][bj][m][1]; const int cl = bj * 128 + wc * 32 + 8 * fq;
#define EPI_LOOP_END } }

struct EpiQKV0 { static constexpr bool PERM = true, AFTER_DRAIN = false; bf16_t* O; const PG8_LAS float* ROPE; unsigned char* VT; unsigned char* VTB;
  DEVI void operator()(const f32x4 (&acc)[2][2][4][2], const Unit& u, int wr, int wc, int fr, int fq) const {
    const int colt = u.pn * 256; const bool rope = (u.pm < NLAT / 256) && (colt < 1024);
    EPI_LOOP_BEGIN
      const int col = colt + cl;
      if (ATTNA_FP8 && colt >= 1024 && colt < 1536) {
        const int hh = (col - 1024) >> 7, dv0 = (col - 1024) & 127;
        int bb, t; if (row < NLAT) { bb = row >> 12; t = row & 4095; } else { bb = (row - NLAT) >> 8; t = 4096 + ((row - NLAT) & 255); }
        const int k = t & 31, gq = k >> 3, wq = k & 7, pos = (wq < 4) ? gq * 4 + wq : 16 + gq * 4 + (wq - 4);
        unsigned char* vp = VT + (size_t)((bb * 4 + hh) * 128 + dv0) * 4352 + (t & ~31) + pos;
        const unsigned w0 = nv::pack4_fp8(v0[0] * 4.f, v0[1] * 4.f, v0[2] * 4.f, v0[3] * 4.f), w1 = nv::pack4_fp8(v1[0] * 4.f, v1[1] * 4.f, v1[2] * 4.f, v1[3] * 4.f);
        vp[0 * 4352] = (unsigned char)w0; vp[1 * 4352] = (unsigned char)(w0 >> 8); vp[2 * 4352] = (unsigned char)(w0 >> 16); vp[3 * 4352] = (unsigned char)(w0 >> 24);
        vp[4 * 4352] = (unsigned char)w1; vp[5 * 4352] = (unsigned char)(w1 >> 8); vp[6 * 4352] = (unsigned char)(w1 >> 16); vp[7 * 4352] = (unsigned char)(w1 >> 24);
        continue;
      }
      if (ATTNA_FP8 && colt >= 2560) {
        const int hh = (col - 2560) >> 6, dv0 = (col - 2560) & 63;
        int bb, t; if (row < NLAT) { bb = row >> 12; t = row & 4095; } else { bb = (row - NLAT) >> 8; t = 4096 + ((row - NLAT) & 255); }
        const int k = t & 31, gq = k >> 3, wq = k & 7, pos = (wq < 4) ? gq * 4 + wq : 16 + gq * 4 + (wq - 4);
        unsigned char* vp = VTB + (size_t)((bb * 8 + hh) * 64 + dv0) * 4352 + (t & ~31) + pos;
        const unsigned w0 = nv::pack4_fp8(v0[0] * 4.f, v0[1] * 4.f, v0[2] * 4.f, v0[3] * 4.f), w1 = nv::pack4_fp8(v1[0] * 4.f, v1[1] * 4.f, v1[2] * 4.f, v1[3] * 4.f);
        vp[0 * 4352] = (unsigned char)w0; vp[1 * 4352] = (unsigned char)(w0 >> 8); vp[2 * 4352] = (unsigned char)(w0 >> 16); vp[3 * 4352] = (unsigned char)(w0 >> 24);
        vp[4 * 4352] = (unsigned char)w1; vp[5 * 4352] = (unsigned char)(w1 >> 8); vp[6 * 4352] = (unsigned char)(w1 >> 16); vp[7 * 4352] = (unsigned char)(w1 >> 24);
        continue;
      }
      if (rope) rope8(ROPE, row & 4095, col & 63, v0, v1);
      if (ATTNA_FP8 && (colt < 1024 || colt >= 1536)) {
        const float sc = (colt < 512 || (colt >= 1536 && colt < 2048)) ? 16.f * 0.125f * 1.4426950408889634f : 4.f;
        u32x2 w8; w8.x = nv::pack4_fp8(v0[0] * sc, v0[1] * sc, v0[2] * sc, v0[3] * sc); w8.y = nv::pack4_fp8(v1[0] * sc, v1[1] * sc, v1[2] * sc, v1[3] * sc);
        *(u32x2*)((unsigned char*)O + (size_t)row * (N_IN0 * 2) + col) = w8;
        continue;
      }
      u32x4 w; w.x = cvtpk(v0[0], v0[1]); w.y = cvtpk(v0[2], v0[3]); w.z = cvtpk(v1[0], v1[1]); w.w = cvtpk(v1[2], v1[3]);
      *(u32x4*)(O + (size_t)row * N_IN0 + col) = w;
    EPI_LOOP_END
  } };
struct EpiQKV1 { static constexpr bool PERM = true, AFTER_DRAIN = false; bf16_t* O; float* DT; const PG8_LAS float* ROPE;
  DEVI void operator()(const f32x4 (&acc)[2][2][4][2], const Unit& u, int wr, int wc, int fr, int fq) const {
    const int colt = u.pn * 256; const bool lat = (u.pm < NLAT / 256);
    EPI_LOOP_BEGIN
      const int col = colt + cl;
      if (col >= 2304) { if (col < 2320) { *(f32x4*)(DT + (size_t)row * 16 + (col - 2304)) = v0; *(f32x4*)(DT + (size_t)row * 16 + (col - 2304) + 4) = v1; } }
      else {
        if (lat && col < 640) rope8(ROPE, row & 4095, col & 63, v0, v1);
        u32x4 w; w.x = cvtpk(v0[0], v0[1]); w.y = cvtpk(v0[2], v0[3]); w.z = cvtpk(v1[0], v1[1]); w.w = cvtpk(v1[2], v1[3]);
        *(u32x4*)(O + (size_t)row * 2304 + col) = w;
      }
    EPI_LOOP_END
  } };
struct EpiPlain { static constexpr bool PERM = true, AFTER_DRAIN = false; bf16_t* O;
  DEVI void operator()(const f32x4 (&acc)[2][2][4][2], const Unit& u, int wr, int wc, int fr, int fq) const {
    const int colt = u.pn * 256;
    EPI_LOOP_BEGIN
      u32x4 w; w.x = cvtpk(v0[0], v0[1]); w.y = cvtpk(v0[2], v0[3]); w.z = cvtpk(v1[0], v1[1]); w.w = cvtpk(v1[2], v1[3]);
      *(u32x4*)(O + (size_t)row * DM + colt + cl) = w;
    EPI_LOOP_END
  } };
DEVI float silu_fast(float v) { return v * __builtin_amdgcn_rcpf(1.f + __expf(-v)); }
struct EpiSwiGLU { static constexpr bool PERM = true, AFTER_DRAIN = false; bf16_t* O;
  DEVI void operator()(const f32x4 (&acc)[2][2][4][2], const Unit& u, int wr, int wc, int fr, int fq) const {
    const int colt = (u.pn & 7) * 256;
    EPI_LOOP_BEGIN
      u32x2 w; w.x = cvtpk(silu_fast(v0[0]) * v0[1], silu_fast(v0[2]) * v0[3]); w.y = cvtpk(silu_fast(v1[0]) * v1[1], silu_fast(v1[2]) * v1[3]);
      *(u32x2*)(O + (size_t)row * DM + ((colt + cl) >> 1)) = w;
    EPI_LOOP_END
  } };
struct EpiSwiGLU8 { static constexpr bool PERM = true, AFTER_DRAIN = false; unsigned char* O;
  DEVI void operator()(const f32x4 (&acc)[2][2][4][2], const Unit& u, int wr, int wc, int fr, int fq) const {
    const int colt = (u.pn & 7) * 256;
    EPI_LOOP_BEGIN
      const unsigned w = nv::pack4_fp8(silu_fast(v0[0]) * v0[1] * nv::A8_SCALE, silu_fast(v0[2]) * v0[3] * nv::A8_SCALE, silu_fast(v1[0]) * v1[1] * nv::A8_SCALE, silu_fast(v1[2]) * v1[3] * nv::A8_SCALE);
      *(unsigned*)(O + (size_t)row * DM + ((colt + cl) >> 1)) = w;
    EPI_LOOP_END
  } };
struct EpiDown { static constexpr bool PERM = true, AFTER_DRAIN = false; bf16_t* O;
  DEVI void operator()(const f32x4 (&acc)[2][2][4][2], const Unit& u, int wr, int wc, int fr, int fq) const {
    const int colt = (u.pn & 3) * 256;
    EPI_LOOP_BEGIN
      u32x4 w; w.x = cvtpk(v0[0], v0[1]); w.y = cvtpk(v0[2], v0[3]); w.z = cvtpk(v1[0], v1[1]); w.w = cvtpk(v1[2], v1[3]);
      *(u32x4*)(O + (size_t)row * DM + colt + cl) = w;
    EPI_LOOP_END
  } };
struct ExpOrder : pg8::StaticOrder { int nMe, nNe;
  __device__ void init2(int erows, int Ne, int G_, int c_) { nMe = erows / 256; nNe = Ne / 256; init(NE * erows, Ne, G_, c_); }
  __device__ bool next(int i, Unit& u) const { if (!pg8::StaticOrder::next(i, u)) return false; u.pn += (u.pm / nMe) * nNe; return true; } };

typedef PG8_LAS unsigned char* ldsp_t;
DEVI void phase_qkv0(const Params& p, ldsp_t lds) {
  pg8::Gemm g{(const bf16_t*)(p.ws + WS_H), (const bf16_t*)(p.ws + WS_WIN0), NROW, N_IN0, DM, nullptr, nv::W8_E8M0, nv::A8_E8M0}; pg8::StaticOrder S; S.init(NROW, N_IN0, gridDim.x, blockIdx.x);
  PG8_LAS float* RL = (PG8_LAS float*)(lds + pg8::STAGE_BYTES);
  for (int i = ftid(); i < 64 * 16 * 2; i += NT) RL[i] = ((const float*)(p.ws + WS_CTL + CTL_ROPE))[i];
  __syncthreads();
  EpiQKV0 E{(bf16_t*)(p.ws + WS_QKV0), RL, (unsigned char*)(p.ws + WS_VT), (unsigned char*)(p.ws + WS_VTB)};
  pg8::gemm_phase<EpiQKV0, pg8::StaticOrder, true, true, (QKV0_FP8 != 0)>(lds, g, S, E);
}
DEVI void phase_qkv1(const Params& p, ldsp_t lds) {
  pg8::Gemm g{(const bf16_t*)(p.ws + WS_H), (const bf16_t*)(p.ws + WS_WIN1), NROW, N_IN1P, DM, nullptr, nv::W8_E8M0, nv::A8_E8M0}; pg8::StaticOrder S; S.init(NROW, N_IN1P, gridDim.x, blockIdx.x);
  PG8_LAS float* RL = (PG8_LAS float*)(lds + pg8::STAGE_BYTES);
  for (int i = ftid(); i < 64 * 16 * 2; i += NT) RL[i] = ((const float*)(p.ws + WS_CTL + CTL_ROPE))[i];
  __syncthreads();
  EpiQKV1 E{(bf16_t*)(p.ws + WS_P1), (float*)(p.ws + WS_DT), RL};
  pg8::gemm_phase<EpiQKV1, pg8::StaticOrder, true, true, (QKV1_FP8 != 0)>(lds, g, S, E);
}
DEVI void phase_outproj(const Params& p, ldsp_t lds, int layer) {
  const int M = layer ? NLAT : NROW;
  pg8::Gemm g{(const bf16_t*)(p.ws + (layer ? WS_ATT1 : WS_ATT0)), (const bf16_t*)(p.ws + (layer ? WS_WOUT1 : WS_WOUT0)), M, DM, DM, nullptr, nv::W8_E8M0, nv::A8_E8M0}; pg8::StaticOrder S; S.init(M, DM, gridDim.x, blockIdx.x);
  EpiPlain E{(bf16_t*)(p.ws + (layer ? WS_MIX1 : WS_MIX0))};
  pg8::gemm_phase<EpiPlain, pg8::StaticOrder, true, true, (OUT_FP8 != 0)>(lds, g, S, E);
}
DEVI void phase_moe_up(const Params& p, ldsp_t lds, int layer) {
  const int erows = layer ? EROWS1 : EROWS0;
  pg8::Gemm g{(const bf16_t*)(p.ws + WS_H), (const bf16_t*)(p.ws + WS_WGU), NE * erows, 2048, DM, (const int*)(p.ws + WS_IDX)}; ExpOrder S; S.init2(erows, 2048, gridDim.x, blockIdx.x);
  EpiSwiGLU E{(bf16_t*)(p.ws + WS_HID)};
  pg8::gemm_phase<EpiSwiGLU, ExpOrder, true, true>(lds, g, S, E);
}
DEVI void phase_moe_down(const Params& p, ldsp_t lds, int layer) {
  const int erows = layer ? EROWS1 : EROWS0;
  pg8::Gemm g{(const bf16_t*)(p.ws + WS_HID), (const bf16_t*)(p.ws + WS_WD), NE * erows, DM, DM}; ExpOrder S; S.init2(erows, DM, gridDim.x, blockIdx.x);
  EpiDown E{(bf16_t*)(p.ws + WS_Y)};
  pg8::gemm_phase<EpiDown, ExpOrder, true, true>(lds, g, S, E);
}
DEVI void phase_moe_up8(const Params& p, ldsp_t lds, int layer) {
  const int erows = layer ? EROWS1 : EROWS0;
  pg8::Gemm g{(const bf16_t*)(p.ws + WS_H), (const bf16_t*)(p.ws + WS_WGU), NE * erows, 2048, DM, (const int*)(p.ws + WS_IDX), nv::W8_E8M0, nv::A8_E8M0}; ExpOrder S; S.init2(erows, 2048, gridDim.x, blockIdx.x);
  EpiSwiGLU8 E{(unsigned char*)(p.ws + WS_HID)};
  pg8::gemm_phase<EpiSwiGLU8, ExpOrder, true, FP8_SP2, true>(lds, g, S, E);
}
DEVI void phase_moe_down8(const Params& p, ldsp_t lds, int layer) {
  const int erows = layer ? EROWS1 : EROWS0;
  pg8::Gemm g{(const bf16_t*)(p.ws + WS_HID), (const bf16_t*)(p.ws + WS_WD), NE * erows, DM, DM, nullptr, nv::W8_E8M0, nv::A8_E8M0}; ExpOrder S; S.init2(erows, DM, gridDim.x, blockIdx.x);
  EpiDown E{(bf16_t*)(p.ws + WS_Y)};
  pg8::gemm_phase<EpiDown, ExpOrder, true, FP8_SP2, true>(lds, g, S, E);
}
DEVI void phase_gather(const Params& p, int layer) {
  const int lane = ftid() & 63, gw = blockIdx.x * NWAVE + (ftid() >> 6), NGW = gridDim.x * NWAVE;
  const int erows = layer ? EROWS1 : EROWS0; const int* IDX = (const int*)(p.ws + WS_IDX);
  const bf16_t* H = (const bf16_t*)(p.ws + WS_H); bf16_t* XG = (bf16_t*)(p.ws + WS_XG);
  for (int r = gw; r < NE * erows; r += NGW) {
    const uint4* s = (const uint4*)(H + (size_t)IDX[r] * DM) + lane; uint4* d = (uint4*)(XG + (size_t)r * DM) + lane;
    const uint4 a = s[0], b = s[64]; d[0] = a; d[64] = b;
  }
}
}
#ifndef ATTNA_FP8
#define ATTNA_FP8 1
#endif
namespace fa {
#define FA_LAS __attribute__((address_space(3)))
typedef short bf16x8 __attribute__((ext_vector_type(8)));
typedef short s16x4 __attribute__((ext_vector_type(4)));
typedef float f32x16 __attribute__((ext_vector_type(16)));
typedef FA_LAS unsigned char* ldsp_t;
typedef unsigned u32x4 __attribute__((ext_vector_type(4)));
constexpr float LOG2E = 1.4426950408889634f, C2 = 0.125f * LOG2E;
DEVI int crow(int r, int hi) { return (r & 3) + 8 * (r >> 2) + 4 * hi; }
DEVI unsigned cvtpk(float lo, float hi) { typedef float f2_t __attribute__((ext_vector_type(2))); typedef __bf16 b2_t __attribute__((ext_vector_type(2))); const f2_t v = {lo, hi}; const b2_t b = __builtin_convertvector(v, b2_t); return __builtin_bit_cast(unsigned, b); }
DEVI s16x4 vtr(ldsp_t p) { return __builtin_bit_cast(s16x4, __builtin_amdgcn_ds_read_tr16_b64_v4i16((FA_LAS s16x4*)p)); }

DEVI float max3f(float a, float b, float c) { float r; asm("v_max3_f32 %0, %1, %2, %3" : "=v"(r) : "v"(a), "v"(b), "v"(c)); return r; }
template <int KW, int DVB> struct Geo {
  static constexpr int VW = DVB * 32;
  static constexpr int KSTR = KW * 2 + 16, VSTR = VW * 2 + 64;
  static constexpr int KBYTES = 64 * KSTR, VBYTES = 64 * VSTR, STAGE = KBYTES + VBYTES;
  static constexpr int CPR = (KW + VW) / 8, NCH = 64 * CPR / NT;
};

DEVI bf16x8 load_q8(const bf16_t* p, float sc) {
  const uint4 w = *(const uint4*)p; const unsigned u[4] = {w.x, w.y, w.z, w.w}; unsigned o[4];
#pragma unroll
  for (int i = 0; i < 4; ++i) o[i] = cvtpk(__uint_as_float(u[i] << 16) * sc, __uint_as_float(u[i] & 0xffff0000u) * sc);
  uint4 r = make_uint4(o[0], o[1], o[2], o[3]); return __builtin_bit_cast(bf16x8, r);
}

template <int KW, int DVB, class Src, class Act, class Msk>
DEVI void flash_pass(ldsp_t lds, int ntiles, const bf16_t* kv, int ld, int kcol, int vcol, const bf16x8 (&q)[4], int kofs,
                     Src src, Act act, Msk msk, f32x16 (&o)[DVB], float& m, float& l) {
  typedef Geo<KW, DVB> G;
  const int tid = ftid(), lane = tid & 63, r32 = lane & 31, hi = lane >> 5;
  u32x4 stg[G::NCH];
  int crw[G::NCH], ccol[G::NCH], cdst[G::NCH];
#pragma unroll
  for (int i = 0; i < G::NCH; ++i) { const int c = tid + NT * i, row = c / G::CPR, cc = c % G::CPR; crw[i] = row;
    if (cc < KW / 8) { ccol[i] = kcol + cc * 8; cdst[i] = row * G::KSTR + cc * 16; } else { ccol[i] = vcol + (cc - KW / 8) * 8; cdst[i] = G::KBYTES + row * G::VSTR + (cc - KW / 8) * 16; } }
#pragma unroll
  for (int i = 0; i < G::NCH; ++i) stg[i] = *(const u32x4*)(kv + (size_t)src(0, crw[i]) * ld + ccol[i]);
#pragma unroll
  for (int i = 0; i < G::NCH; ++i) *(FA_LAS u32x4*)(lds + cdst[i]) = stg[i];
  __syncthreads();
  const int kroff = r32 * G::KSTR + (kofs + 8 * hi) * 2;
  const int vroff = G::KBYTES + (4 * hi + ((lane & 15) >> 2)) * G::VSTR + 32 * ((lane >> 4) & 1) + 8 * (lane & 3);
  for (int kt = 0; kt < ntiles; ++kt) {
    const int buf = (kt & 1) * G::STAGE;
    const bool more = kt + 1 < ntiles;
    if (more) {
#pragma unroll
      for (int i = 0; i < G::NCH; ++i) stg[i] = *(const u32x4*)(kv + (size_t)src(kt + 1, crw[i]) * ld + ccol[i]);
    }
    if (act(kt)) {
      const ldsp_t kb = lds + buf + kroff;
      f32x16 p0, p1;
#pragma unroll
      for (int r = 0; r < 16; ++r) { p0[r] = 0.f; p1[r] = 0.f; }
#pragma unroll
      for (int d0 = 0; d0 < 4; ++d0) {
        const bf16x8 a0 = *(const FA_LAS bf16x8*)(kb + d0 * 32), a1 = *(const FA_LAS bf16x8*)(kb + 32 * G::KSTR + d0 * 32);
        p0 = __builtin_amdgcn_mfma_f32_32x32x16_bf16(a0, q[d0], p0, 0, 0, 0);
        p1 = __builtin_amdgcn_mfma_f32_32x32x16_bf16(a1, q[d0], p1, 0, 0, 0);
      }
      msk(kt, p0, p1);
      float mx = fmaxf(p0[0], p1[0]);
#pragma unroll
      for (int r = 1; r < 16; ++r) mx = fmaxf(mx, fmaxf(p0[r], p1[r]));
      mx = fmaxf(mx, __shfl_xor(mx, 32));
      if (__any(mx > m)) {
        const float mn = fmaxf(m, mx), alpha = __builtin_amdgcn_exp2f(m - mn);
        l *= alpha; m = mn;
#pragma unroll
        for (int b = 0; b < DVB; ++b)
#pragma unroll
          for (int r = 0; r < 16; ++r) o[b][r] *= alpha;
      }
      float ls = 0.f;
#pragma unroll
      for (int r = 0; r < 16; ++r) { p0[r] = __builtin_amdgcn_exp2f(p0[r] - m); p1[r] = __builtin_amdgcn_exp2f(p1[r] - m); ls += p0[r] + p1[r]; }
      l += ls;
      bf16x8 pa[4];
      { uint4 t;
        t = make_uint4(cvtpk(p0[0], p0[1]), cvtpk(p0[2], p0[3]), cvtpk(p0[4], p0[5]), cvtpk(p0[6], p0[7])); pa[0] = __builtin_bit_cast(bf16x8, t);
        t = make_uint4(cvtpk(p0[8], p0[9]), cvtpk(p0[10], p0[11]), cvtpk(p0[12], p0[13]), cvtpk(p0[14], p0[15])); pa[1] = __builtin_bit_cast(bf16x8, t);
        t = make_uint4(cvtpk(p1[0], p1[1]), cvtpk(p1[2], p1[3]), cvtpk(p1[4], p1[5]), cvtpk(p1[6], p1[7])); pa[2] = __builtin_bit_cast(bf16x8, t);
        t = make_uint4(cvtpk(p1[8], p1[9]), cvtpk(p1[10], p1[11]), cvtpk(p1[12], p1[13]), cvtpk(p1[14], p1[15])); pa[3] = __builtin_bit_cast(bf16x8, t); }
      const ldsp_t vb = lds + buf + vroff;
#pragma unroll
      for (int b = 0; b < DVB; ++b)
#pragma unroll
        for (int ks = 0; ks < 4; ++ks) {
          const s16x4 lo = vtr(vb + (16 * ks) * G::VSTR + b * 64), h8 = vtr(vb + (16 * ks + 8) * G::VSTR + b * 64);
          const bf16x8 vf = {lo[0], lo[1], lo[2], lo[3], h8[0], h8[1], h8[2], h8[3]};
          o[b] = __builtin_amdgcn_mfma_f32_32x32x16_bf16(vf, pa[ks], o[b], 0, 0, 0);
        }
    }
    if (more) {
      const int nb = ((kt + 1) & 1) * G::STAGE;
#pragma unroll
      for (int i = 0; i < G::NCH; ++i) *(FA_LAS u32x4*)(lds + nb + cdst[i]) = stg[i];
    }
    __syncthreads();
  }
}


template <int V> struct IC { static constexpr int value = V; };
template <int KW, int DVB, int ABL, int PF, class Src, class Msk>
DEVI void flash_pass2(ldsp_t lds, int ntiles, const bf16_t* kv, int ld, int kcol, int vcol, const bf16x8 (&q)[4], int kofs,
                      Src src, Msk msk, f32x16 (&o)[DVB], float& m, float& l) {
  typedef Geo<KW, DVB> G;
  const int tid = ftid(), lane = tid & 63, r32 = lane & 31, hi = lane >> 5;
  u32x4 stg[PF][G::NCH];
  int crw[G::NCH], ccol[G::NCH], cdst[G::NCH];
#pragma unroll
  for (int i = 0; i < G::NCH; ++i) { const int c = tid + NT * i, row = c / G::CPR, cc = c % G::CPR; crw[i] = row;
    if (cc < KW / 8) { ccol[i] = kcol + cc * 8; cdst[i] = row * G::KSTR + cc * 16; } else { ccol[i] = vcol + (cc - KW / 8) * 8; cdst[i] = G::KBYTES + row * G::VSTR + (cc - KW / 8) * 16; } }
#define FP2_LOAD(kt, set) _Pragma("unroll") for (int i = 0; i < G::NCH; ++i) stg[set][i] = *(const u32x4*)(kv + (size_t)src((kt), crw[i]) * ld + ccol[i])
#define FP2_STORE(st, set) _Pragma("unroll") for (int i = 0; i < G::NCH; ++i) *(FA_LAS u32x4*)(lds + (st) * G::STAGE + cdst[i]) = stg[set][i]
  FP2_LOAD(0, 0); FP2_STORE(0, 0);
  if (ntiles > 1) { FP2_LOAD(1, 0); FP2_STORE(1, 0); }
  __syncthreads();
  if (ntiles > 2) FP2_LOAD(2, 0);
  if (PF == 2) { if (ntiles > 3) FP2_LOAD(3, PF - 1); }
  const int kroff = r32 * G::KSTR + (kofs + 8 * hi) * 2;
  const int vroff = G::KBYTES + (4 * hi + ((lane & 15) >> 2)) * G::VSTR + 32 * ((lane >> 4) & 1) + 8 * (lane & 3);
  f32x16 c0, c1;
#pragma unroll
  for (int r = 0; r < 16; ++r) { c0[r] = 0.f; c1[r] = 0.f; }
  { const ldsp_t kb = lds + kroff;
#pragma unroll
    for (int d0 = 0; d0 < 4; ++d0) {
      const bf16x8 a0 = *(const FA_LAS bf16x8*)(kb + d0 * 32), a1 = *(const FA_LAS bf16x8*)(kb + 32 * G::KSTR + d0 * 32);
      c0 = __builtin_amdgcn_mfma_f32_32x32x16_bf16(a0, q[d0], c0, 0, 0, 0); c1 = __builtin_amdgcn_mfma_f32_32x32x16_bf16(a1, q[d0], c1, 0, 0, 0); } }
  asm volatile("s_nop 15\n\ts_nop 7" : "+v"(c0), "+v"(c1));
  int st_cur = 0, st_nxt = 1, st_fill = 2;
  auto body = [&](int kt, auto PARC) {
    constexpr int set = (PF == 2) ? decltype(PARC)::value : 0;
    msk(kt, c0, c1);
    __builtin_amdgcn_sched_barrier(0);
    f32x16 n0, n1;
#pragma unroll
    for (int r = 0; r < 16; ++r) { n0[r] = 0.f; n1[r] = 0.f; }
    const ldsp_t kb = lds + st_nxt * G::STAGE + kroff;
    bf16x8 ka[4], kb2[4];
#pragma unroll
    for (int d0 = 0; d0 < 4; ++d0) { ka[d0] = *(const FA_LAS bf16x8*)(kb + d0 * 32); kb2[d0] = *(const FA_LAS bf16x8*)(kb + 32 * G::KSTR + d0 * 32); }
#define FP2_SB() __builtin_amdgcn_sched_barrier(0)
#define FP2_MMA(acc, kf, d0) acc = __builtin_amdgcn_mfma_f32_32x32x16_bf16(kf[d0], q[d0], acc, 0, 0, 0)
#define FP2_EXP(cx, r) { if (ABL != 1) { cx[r] = __builtin_amdgcn_exp2f(cx[r] - mn); ls += cx[r]; } }
    FP2_SB(); FP2_MMA(n0, ka, 0);
    float mxa = max3f(c0[0], c0[1], c1[0]), mxb = max3f(c0[2], c0[3], c1[1]);
    mxa = max3f(mxa, c1[2], c1[3]);
    mxa = max3f(mxa, c0[4], c0[5]); mxb = max3f(mxb, c0[6], c0[7]); mxa = max3f(mxa, c1[4], c1[5]); mxb = max3f(mxb, c1[6], c1[7]);
    FP2_SB(); FP2_MMA(n1, kb2, 0);
    mxa = max3f(mxa, c0[8], c0[9]); mxb = max3f(mxb, c0[10], c0[11]); mxa = max3f(mxa, c1[8], c1[9]); mxb = max3f(mxb, c1[10], c1[11]);
    mxa = max3f(mxa, c0[12], c0[13]); mxb = max3f(mxb, c0[14], c0[15]); mxa = max3f(mxa, c1[12], c1[13]); mxb = max3f(mxb, c1[14], c1[15]);
    float mx = max3f(mxa, mxb, m);
    mx = max3f(mx, __shfl_xor(mx, 32), mx);
    const float mn = mx, alpha = __builtin_amdgcn_exp2f(m - mn);
    const bool resc = __any(mn > m);
    m = mn;
    float ls = 0.f;
    FP2_SB(); FP2_MMA(n0, ka, 1);
    FP2_EXP(c0, 0) FP2_EXP(c0, 1) FP2_EXP(c0, 2) FP2_EXP(c0, 3) FP2_EXP(c0, 4) FP2_EXP(c0, 5)
    FP2_SB(); FP2_MMA(n1, kb2, 1);
    FP2_EXP(c0, 6) FP2_EXP(c0, 7) FP2_EXP(c0, 8) FP2_EXP(c0, 9) FP2_EXP(c0, 10) FP2_EXP(c0, 11)
    FP2_SB(); FP2_MMA(n0, ka, 2);
    FP2_EXP(c0, 12) FP2_EXP(c0, 13) FP2_EXP(c0, 14) FP2_EXP(c0, 15) FP2_EXP(c1, 0) FP2_EXP(c1, 1)
    FP2_SB(); FP2_MMA(n1, kb2, 2);
    FP2_EXP(c1, 2) FP2_EXP(c1, 3) FP2_EXP(c1, 4) FP2_EXP(c1, 5) FP2_EXP(c1, 6) FP2_EXP(c1, 7)
    FP2_SB(); FP2_MMA(n0, ka, 3);
    FP2_EXP(c1, 8) FP2_EXP(c1, 9) FP2_EXP(c1, 10) FP2_EXP(c1, 11) FP2_EXP(c1, 12) FP2_EXP(c1, 13)
    FP2_SB(); FP2_MMA(n1, kb2, 3);
    FP2_EXP(c1, 14) FP2_EXP(c1, 15)
    bf16x8 pa[4];
    { u32x4 t;
      t[0] = cvtpk(c0[0], c0[1]); t[1] = cvtpk(c0[2], c0[3]); t[2] = cvtpk(c0[4], c0[5]); t[3] = cvtpk(c0[6], c0[7]); pa[0] = __builtin_bit_cast(bf16x8, t);
      t[0] = cvtpk(c0[8], c0[9]); t[1] = cvtpk(c0[10], c0[11]); t[2] = cvtpk(c0[12], c0[13]); t[3] = cvtpk(c0[14], c0[15]); pa[1] = __builtin_bit_cast(bf16x8, t);
      t[0] = cvtpk(c1[0], c1[1]); t[1] = cvtpk(c1[2], c1[3]); t[2] = cvtpk(c1[4], c1[5]); t[3] = cvtpk(c1[6], c1[7]); pa[2] = __builtin_bit_cast(bf16x8, t);
      t[0] = cvtpk(c1[8], c1[9]); t[1] = cvtpk(c1[10], c1[11]); t[2] = cvtpk(c1[12], c1[13]); t[3] = cvtpk(c1[14], c1[15]); pa[3] = __builtin_bit_cast(bf16x8, t); }
    asm volatile("" : "+v"(pa[0]), "+v"(pa[1]), "+v"(pa[2]), "+v"(pa[3]));
    FP2_SB();
    l = l * alpha + ls;
    __builtin_amdgcn_sched_barrier(0);
    if (resc) {
#pragma unroll
      for (int b = 0; b < DVB; ++b)
#pragma unroll
        for (int r = 0; r < 16; ++r) o[b][r] *= alpha;
    }
    const ldsp_t vb = lds + st_cur * G::STAGE + vroff;
    s16x4 vl[2][DVB], vh[2][DVB];
#pragma unroll
    for (int b = 0; b < DVB; ++b) { vl[0][b] = vtr(vb + b * 64); vh[0][b] = vtr(vb + 8 * G::VSTR + b * 64); }
#pragma unroll
    for (int ks = 0; ks < 4; ++ks) {
      FP2_SB();
      if (ks < 3) {
#pragma unroll
        for (int b = 0; b < DVB; ++b) { vl[(ks + 1) & 1][b] = vtr(vb + (16 * (ks + 1)) * G::VSTR + b * 64); vh[(ks + 1) & 1][b] = vtr(vb + (16 * (ks + 1) + 8) * G::VSTR + b * 64); }
      }
      FP2_SB();
#pragma unroll
      for (int b = 0; b < DVB; ++b) {
        const s16x4 lo = vl[ks & 1][b], h8 = vh[ks & 1][b];
        const bf16x8 vf = {lo[0], lo[1], lo[2], lo[3], h8[0], h8[1], h8[2], h8[3]};
        if (ABL != 2) o[b] = __builtin_amdgcn_mfma_f32_32x32x16_bf16(vf, pa[ks], o[b], 0, 0, 0); else o[b][0] += __builtin_bit_cast(float, (int)vf[0]);
      }
    }
    FP2_SB();
    if (ABL != 3) { if (kt + 2 < ntiles) FP2_STORE(st_fill, set); }
    __syncthreads();
    if (ABL != 3) { if (kt + 2 + PF < ntiles) FP2_LOAD(kt + 2 + PF, set); }
    c0 = n0; c1 = n1;
    { const int t = st_cur; st_cur = st_nxt; st_nxt = st_fill; st_fill = t; }
  };
  if (PF == 2) { for (int kt = 0; kt < ntiles; kt += 2) { body(kt, IC<0>{}); if (kt + 1 < ntiles) body(kt + 1, IC<1>{}); } }
  else { for (int kt = 0; kt < ntiles; ++kt) body(kt, IC<0>{}); }
#undef FP2_LOAD
#undef FP2_STORE
}


typedef int v8i_t __attribute__((ext_vector_type(8)));
DEVI v8i_t cat8(const u32x4& x, const u32x4& y) { return (v8i_t){(int)x[0], (int)x[1], (int)x[2], (int)x[3], (int)y[0], (int)y[1], (int)y[2], (int)y[3]}; }
template <int DVB, int KROW, int AB8 = 0, class Src, class VKey, class Msk, class Act>
DEVI void flash_pass8(ldsp_t lds, int ntiles, const unsigned char* k8, int ldb, int kcolb, const unsigned char* vt, const v8i_t& qf, int ksub, bool late,
                      Src src, VKey vkey, Msk msk, Act act, f32x16 (&o)[DVB], float& m, float& l) {
  constexpr int A8_KSTR = KROW + 16, A8_VSTR = 80, A8_KB = 64 * A8_KSTR, A8_STAGE = A8_KB + DVB * 32 * A8_VSTR;
  constexpr int KPR = KROW / 16, NKC = 64 * KPR, NCHT = (NKC + DVB * 32 * 4) / NT;
  const int tid = ftid(), lane = tid & 63, r32 = lane & 31, hi = lane >> 5;
  u32x4 stg[NCHT];
#define A8_ISK(i_, c_) ((NKC % NT == 0) ? ((i_) < NKC / NT) : ((c_) < NKC))
#define A8_LOAD(kt) do { const int sb_ = src((kt), 0), vk_ = vkey(kt); _Pragma("unroll") for (int i_ = 0; i_ < NCHT; ++i_) { const int c_ = tid + NT * i_; \
      if (A8_ISK(i_, c_)) stg[i_] = *(const u32x4*)(k8 + (size_t)(sb_ + c_ / KPR) * ldb + kcolb + (c_ % KPR) * 16); \
      else { const int cv_ = c_ - NKC; stg[i_] = *(const u32x4*)(vt + (size_t)(cv_ >> 2) * 4352 + vk_ + (cv_ & 3) * 16); } } } while (0)
#define A8_STORE(st) do { _Pragma("unroll") for (int i_ = 0; i_ < NCHT; ++i_) { const int c_ = tid + NT * i_; \
      if (A8_ISK(i_, c_)) *(FA_LAS u32x4*)(lds + (st) * A8_STAGE + (c_ / KPR) * A8_KSTR + (c_ % KPR) * 16) = stg[i_]; \
      else { const int cv_ = c_ - NKC; *(FA_LAS u32x4*)(lds + (st) * A8_STAGE + A8_KB + (cv_ >> 2) * A8_VSTR + (cv_ & 3) * 16) = stg[i_]; } } } while (0)
#define A8_SB() __builtin_amdgcn_sched_barrier(0)
#define A8_EXP(cx, r) { if (AB8 & 2) {} else { cx[r] = __builtin_amdgcn_exp2f(cx[r] - mn); ls += cx[r]; } }
#define A8_KREAD(st) do { const ldsp_t kp_ = lds + (st) * A8_STAGE + kroff; \
    kf[0] = *(const volatile FA_LAS u32x4*)kp_; kf[1] = *(const volatile FA_LAS u32x4*)(kp_ + 16); kf[2] = *(const volatile FA_LAS u32x4*)(kp_ + 32 * A8_KSTR); kf[3] = *(const volatile FA_LAS u32x4*)(kp_ + 32 * A8_KSTR + 16); } while (0)
#define A8_VREAD(st) do { const ldsp_t vb_ = lds + (st) * A8_STAGE + vroff; _Pragma("unroll") for (int b = 0; b < DVB; ++b) { \
    vf0[b] = *(const volatile FA_LAS u32x4*)(vb_ + b * 32 * A8_VSTR); vf1[b] = *(const volatile FA_LAS u32x4*)(vb_ + b * 32 * A8_VSTR + 16); } } while (0)
#define A8_QKM() do { f32x16 z_; _Pragma("unroll") for (int r_ = 0; r_ < 16; ++r_) z_[r_] = 0.f; \
    c0 = __builtin_amdgcn_mfma_scale_f32_32x32x64_f8f6f4(cat8(kf[0], kf[1]), qf, z_, 0, 0, 0, 0x7d7d7d7d  , 0, 0x7b7b7b7b  ); \
    c1 = __builtin_amdgcn_mfma_scale_f32_32x32x64_f8f6f4(cat8(kf[2], kf[3]), qf, z_, 0, 0, 0, 0x7d7d7d7d, 0, 0x7b7b7b7b); } while (0)
#define A8_PVM() do { _Pragma("unroll") for (int b = 0; b < DVB; ++b) if (!(AB8 & 16)) o[b] = __builtin_amdgcn_mfma_scale_f32_32x32x64_f8f6f4(cat8(vf0[b], vf1[b]), pb, o[b], 0, 0, 0, 0x7d7d7d7d  , 0, 0x7b7b7b7b  ); } while (0)
  A8_LOAD(0); A8_STORE(0);
  if (ntiles > 1) { A8_LOAD(1); A8_STORE(1); }
  __syncthreads();
  if (ntiles > 2) A8_LOAD(2);
  const int kroff = r32 * A8_KSTR + 64 * ksub + 32 * hi;
  const int vroff = A8_KB + r32 * A8_VSTR + 32 * hi;
  f32x16 c0, c1;
  u32x4 kf[4], vf0[DVB], vf1[DVB];
  v8i_t pb = {0, 0, 0, 0, 0, 0, 0, 0};
  if (act(0)) { A8_KREAD(0); A8_QKM(); }
  asm volatile("s_nop 15\n\ts_nop 7" : "+v"(c0), "+v"(c1));
  int st_cur = 0, st_nxt = 1, st_fill = 2;
  for (int kt = 0; kt < ntiles; ++kt) {
    const bool on = act(kt), on_nxt = kt + 1 < ntiles && act(kt + 1);
    if (late && kt > 0) {
      if (on) A8_QKM();
      if (act(kt - 1)) A8_PVM();
#pragma unroll
      for (int b = 0; b < DVB; ++b) asm volatile("" : "+v"(o[b]));
      asm volatile("s_nop 15\n\ts_nop 7" : "+v"(c0), "+v"(c1));
    }
    A8_SB();
    if (on) A8_VREAD(st_cur);
    if (on_nxt) A8_KREAD(st_nxt);
    A8_SB();
    if (on) {
    msk(kt, c0, c1);
    A8_SB();
    float mxa = 0.f, mxb = 0.f;
    if (!(AB8 & 2)) {
    mxa = max3f(c0[0], c0[1], c1[0]), mxb = max3f(c0[2], c0[3], c1[1]);
    mxa = max3f(mxa, c1[2], c1[3]);
    mxa = max3f(mxa, c0[4], c0[5]); mxb = max3f(mxb, c0[6], c0[7]); mxa = max3f(mxa, c1[4], c1[5]); mxb = max3f(mxb, c1[6], c1[7]);
    mxa = max3f(mxa, c0[8], c0[9]); mxb = max3f(mxb, c0[10], c0[11]); mxa = max3f(mxa, c1[8], c1[9]); mxb = max3f(mxb, c1[10], c1[11]);
    mxa = max3f(mxa, c0[12], c0[13]); mxb = max3f(mxb, c0[14], c0[15]); mxa = max3f(mxa, c1[12], c1[13]); mxb = max3f(mxb, c1[14], c1[15]);
    }
    float mx = max3f(mxa, mxb, mxb);
    { const auto sw = __builtin_amdgcn_permlane32_swap(__float_as_uint(mx), __float_as_uint(mx), false, false);
      mx = fmaxf(__uint_as_float(sw[0]), __uint_as_float(sw[1])); }
    const bool up = mx > m + 8.f;
    const float mn = up ? mx - 4.f : m, alpha = __builtin_amdgcn_exp2f(m - mn);
    const bool resc = __any(up);
    m = mn;
    float ls = 0.f;
    A8_SB();
#pragma unroll
    for (int r = 0; r < 16; ++r) A8_EXP(c0, r)
#pragma unroll
    for (int r = 0; r < 16; ++r) A8_EXP(c1, r)
    A8_SB();
    unsigned X[4], Y[4];
#pragma unroll
    for (int i = 0; i < 4; ++i) {
      int w, z; asm volatile("" : "=v"(w)); asm volatile("" : "=v"(z));
      w = __builtin_amdgcn_cvt_pk_fp8_f32(c0[4 * i], c0[4 * i + 1], w, false); w = __builtin_amdgcn_cvt_pk_fp8_f32(c0[4 * i + 2], c0[4 * i + 3], w, true); X[i] = (unsigned)w;
      z = __builtin_amdgcn_cvt_pk_fp8_f32(c1[4 * i], c1[4 * i + 1], z, false); z = __builtin_amdgcn_cvt_pk_fp8_f32(c1[4 * i + 2], c1[4 * i + 3], z, true); Y[i] = (unsigned)z; }
#pragma unroll
    for (int i = 0; i < 4; ++i) { const auto rr = __builtin_amdgcn_permlane32_swap(X[i], Y[i], false, false); X[i] = rr[0]; Y[i] = rr[1]; }
    pb = (v8i_t){(int)X[0], (int)X[1], (int)X[2], (int)X[3], (int)Y[0], (int)Y[1], (int)Y[2], (int)Y[3]};
    asm volatile("" : "+v"(pb));
    l = l * alpha + ls;
    A8_SB();
    if (resc) {
#pragma unroll
      for (int b = 0; b < DVB; ++b)
#pragma unroll
        for (int r = 0; r < 16; ++r) o[b][r] *= alpha;
    }
    }
    A8_SB();
    if (!late) {
      if (on_nxt) A8_QKM();
      if (on) A8_PVM();
#pragma unroll
      for (int b = 0; b < DVB; ++b) asm volatile("" : "+v"(o[b]));
      asm volatile("" : "+v"(c0), "+v"(c1));
    }
    A8_SB();
    if (!(AB8 & 4)) { if (kt + 2 < ntiles) A8_STORE(st_fill); }
    if (!(AB8 & 8)) __syncthreads();
    if (!(AB8 & 4)) { if (kt + 3 < ntiles) A8_LOAD(kt + 3); }
    { const int t = st_cur; st_cur = st_nxt; st_nxt = st_fill; st_fill = t; }
  }
  if (late && act(ntiles - 1)) A8_PVM();
  l *= 0.0625f;
#undef A8_ISK
#undef A8_LOAD
#undef A8_STORE
#undef A8_SB
#undef A8_EXP
#undef A8_KREAD
#undef A8_VREAD
#undef A8_QKM
#undef A8_PVM
}

#ifndef OUT_FP8
#define OUT_FP8 1
#endif
DEVI void st_att4(bf16_t* ATT, size_t row, int col, float a, float b, float c, float d) {
  if (OUT_FP8) *(unsigned*)((unsigned char*)ATT + row * DM + col) = nv::pack4_fp8(a * 4.f, b * 4.f, c * 4.f, d * 4.f);
  else { uint2 w; w.x = cvtpk(a, b); w.y = cvtpk(c, d); *(uint2*)(ATT + row * DM + col) = w; }
}
DEVI int vblock() { const int G = gridDim.x, bx = blockIdx.x; return (G % 8 == 0) ? (bx % 8) * (G / 8) + bx / 8 : bx; }

template <int ABL = 0> DEVI void phase_attnA(const Params& p, ldsp_t lds) {
  typedef Geo<128, 4> G;
  const int tid = ftid(), lane = tid & 63, wave = __builtin_amdgcn_readfirstlane(tid >> 6), r32 = lane & 31, hi = lane >> 5;
  const bf16_t* Q = (const bf16_t*)(p.ws + WS_QKV0); bf16_t* ATT = (bf16_t*)(p.ws + (ABL ? WS_MIX0 : WS_ATT0));
  const float lam = ((const float*)(p.ws + WS_CTL + CTL_LAM))[0];
  const int s = wave >> 2, qb = wave & 3;
  constexpr int NU_LAT = NB * 4 * 32, NU_CTX = NB * 4 * 2;
  for (int u = vblock(); u < NU_LAT + NU_CTX; u += gridDim.x) {
    int b, h, row0, ntiles; bool lat = u < NU_LAT;
    if (lat) { b = u >> 7; h = (u >> 5) & 3; row0 = b * SEQ + (u & 31) * 128; ntiles = 68; }
    else { const int v = u - NU_LAT; b = v >> 3; h = (v >> 1) & 3; row0 = NLAT + b * CTXL + (v & 1) * 128; ntiles = 4; }
    const int qrow = row0 + qb * 32 + r32;
    bf16x8 q[4];
#pragma unroll
    for (int d0 = 0; d0 < 4; ++d0) q[d0] = load_q8(Q + (size_t)qrow * N_IN0 + h * 128 + s * 64 + 16 * d0 + 8 * hi, C2);
    f32x16 o[4];
#pragma unroll
    for (int bk = 0; bk < 4; ++bk)
#pragma unroll
      for (int r = 0; r < 16; ++r) o[bk][r] = 0.f;
    float m = -1e30f, l = 0.f;
    const int cbase = NLAT + b * CTXL, lbase = b * SEQ;
#if ATTNA_FP8
    const unsigned char* QK8 = (const unsigned char*)(p.ws + WS_QKV0);
    v8i_t qf;
    { const unsigned char* qp = QK8 + (size_t)qrow * (N_IN0 * 2) + h * 128 + s * 64 + 32 * hi; const u32x4 q0_ = *(const u32x4*)qp, q1_ = *(const u32x4*)(qp + 16); qf = cat8(q0_, q1_); }
    flash_pass8<4, 128, ABL>(lds, ntiles, QK8, N_IN0 * 2, 512 + h * 128, (const unsigned char*)(p.ws + WS_VT) + (size_t)((b * 4 + h) * 128) * 4352, qf, s, s != 0,
      [&](int kt, int i) { return lat ? (kt < 64 ? lbase + kt * 64 + i : cbase + (kt - 64) * 64 + i) : cbase + kt * 64 + i; },
      [&](int kt) { return (lat ? 0 : 4096) + kt * 64; }, [&](int, f32x16&, f32x16&) {}, [&](int) { return true; }, o, m, l);
#else
    flash_pass2<128, 4, ABL, 1>(lds, ntiles, Q, N_IN0, 512 + h * 128, 1024 + h * 128, q, s * 64,
      [&](int kt, int i) { return lat ? (kt < 64 ? lbase + kt * 64 + i : cbase + (kt - 64) * 64 + i) : cbase + kt * 64 + i; },
      [&](int, f32x16&, f32x16&) {}, o, m, l);
#endif
    l += __shfl_xor(l, 32);
    const float inv = 1.f / l;
    FA_LAS float* X = (FA_LAS float*)lds;
    if (s == 1) {
#pragma unroll
      for (int bk = 0; bk < 4; ++bk)
#pragma unroll
        for (int r = 0; r < 16; ++r) X[((qb * 4 + bk) * 16 + r) * 64 + lane] = o[bk][r] * inv;
    }
    __syncthreads();
    if (s == 0) {
      float ss = 0.f;
#pragma unroll
      for (int bk = 0; bk < 4; ++bk)
#pragma unroll
        for (int r = 0; r < 16; ++r) { const float d = o[bk][r] * inv - lam * X[((qb * 4 + bk) * 16 + r) * 64 + lane]; o[bk][r] = d; ss += d * d; }
      ss += __shfl_xor(ss, 32);
      const float rr = rsqrtf(ss * (1.f / 128.f) + EPS) * 0.8f;
      const float* g = p.in[L0_SUBLN];
#pragma unroll
      for (int bk = 0; bk < 4; ++bk)
#pragma unroll
        for (int rg = 0; rg < 4; ++rg) { const int dv = bk * 32 + 8 * rg + 4 * hi; const float4 gv = *(const float4*)(g + dv);
          st_att4(ATT, (size_t)qrow, h * 128 + dv, o[bk][4 * rg] * rr * gv.x, o[bk][4 * rg + 1] * rr * gv.y, o[bk][4 * rg + 2] * rr * gv.z, o[bk][4 * rg + 3] * rr * gv.w); }
    }
    __syncthreads();
  }
}

template <int ABL = 0> DEVI void phase_attnB(const Params& p, ldsp_t lds) {
  typedef Geo<64, 2> G;
  const int tid = ftid(), lane = tid & 63, wave = __builtin_amdgcn_readfirstlane(tid >> 6), r32 = lane & 31, hi = lane >> 5;
  const bf16_t* Q = (const bf16_t*)(p.ws + WS_QKV0); bf16_t* ATT = (bf16_t*)(p.ws + (ABL ? WS_MIX0 : WS_ATT0));
  constexpr int NU_LAT = NB * 8 * 16, NU_CTX = NB * 8;
  FA_LAS float* RPB = (FA_LAS float*)(lds + 3 * (64 * 80 + 64 * 80));
  for (int u = vblock(); u < NU_LAT + NU_CTX; u += gridDim.x) {
    const bool lat = u < NU_LAT;
    int b, h, qrow_g = 0, c0 = 0, rlo = 0, nlat = 0, rs_w = 0, grow;
    if (lat) { b = u >> 7; h = (u >> 4) & 7; const int qr0 = (u & 15) * 4; qrow_g = qr0 + (wave >> 1); c0 = 32 * (wave & 1);
      rlo = min(max(qr0 - 4, 0), 56); const int rhi = min(max(qr0 - 1, 0), 56) + 7; nlat = rhi - rlo + 1; rs_w = min(max(qrow_g - 4, 0), 56);
      grow = b * SEQ + qrow_g * 64 + c0 + r32; }
    else { const int v = u - NU_LAT; b = v >> 3; h = v & 7; grow = NLAT + b * CTXL + wave * 32 + r32; }
    const int ntiles = nlat + 4;
    for (int i = tid; i < 15 * 31; i += NT) RPB[i] = p.in[L0_RPB][h * 465 + i] * LOG2E;
    const unsigned char* QK8 = (const unsigned char*)(p.ws + WS_QKV0);
    v8i_t qf;
    { const unsigned char* qp = QK8 + (size_t)grow * (N_IN0 * 2) + 1536 + h * 64 + 32 * hi; const u32x4 q0_ = *(const u32x4*)qp, q1_ = *(const u32x4*)(qp + 16); qf = cat8(q0_, q1_); }
    f32x16 o[2];
#pragma unroll
    for (int bk = 0; bk < 2; ++bk)
#pragma unroll
      for (int r = 0; r < 16; ++r) o[bk][r] = 0.f;
    float m = -1e30f, l = 0.f;
    const int cbase = NLAT + b * CTXL, lbase = b * SEQ;
    const int qc = c0 + r32, cs = min(max(qc - 8, 0), 48);
    flash_pass8<2, 64>(lds, ntiles, QK8, N_IN0 * 2, 2048 + h * 64, (const unsigned char*)(p.ws + WS_VTB) + (size_t)((b * 8 + h) * 64) * 4352, qf, 0, wave >= 4,
      [&](int kt, int i) { return kt < nlat ? lbase + (rlo + kt) * 64 + i : cbase + (kt - nlat) * 64 + i; },
      [&](int kt) { return kt < nlat ? (rlo + kt) * 64 : 4096 + (kt - nlat) * 64; },
      [&](int kt, f32x16& p0, f32x16& p1) {
        if (ABL != 1 && kt < nlat) { const int kr = rlo + kt;
          const FA_LAS float* bl = RPB + min(max(kr - qrow_g + 7, 0), 14) * 31 + (4 * hi - qc + 15);
          const unsigned dl = (unsigned)(4 * hi - cs);
          { float b0[16];
#pragma unroll
            for (int r = 0; r < 16; ++r) b0[r] = bl[crow(r, 0)];
#pragma unroll
            for (int r = 0; r < 16; ++r) { const float v0 = p0[r] + b0[r]; p0[r] = (dl + (unsigned)crow(r, 0) < 16u) ? v0 : -INFINITY; } }
          asm volatile("" ::: "memory");
          { float b1[16];
#pragma unroll
            for (int r = 0; r < 16; ++r) b1[r] = bl[32 + crow(r, 0)];
#pragma unroll
            for (int r = 0; r < 16; ++r) { const float v1 = p1[r] + b1[r]; p1[r] = (dl + (unsigned)(32 + crow(r, 0)) < 16u) ? v1 : -INFINITY; } } } },
      [&](int kt) { const int kr = rlo + kt; return kt >= nlat || (kr >= rs_w && kr < rs_w + 8); },
      o, m, l);
    l += __shfl_xor(l, 32);
    const float inv = 1.f / l;
#pragma unroll
    for (int bk = 0; bk < 2; ++bk)
#pragma unroll
      for (int rg = 0; rg < 4; ++rg) { const int dv = bk * 32 + 8 * rg + 4 * hi;
        st_att4(ATT, (size_t)grow, 512 + h * 64 + dv, o[bk][4 * rg] * inv, o[bk][4 * rg + 1] * inv, o[bk][4 * rg + 2] * inv, o[bk][4 * rg + 3] * inv); }
    __syncthreads();
  }
}

DEVI void phase_attnC(const Params& p, ldsp_t lds, int* ctr) {
  const int tid = ftid(), lane = tid & 63, wave = __builtin_amdgcn_readfirstlane(tid >> 6), r32 = lane & 31, hi = lane >> 5;
  const bf16_t* P1 = (const bf16_t*)(p.ws + WS_P1); bf16_t* ATT = (bf16_t*)(p.ws + WS_ATT1);
  FA_LAS int* uq = (FA_LAS int*)(lds + 3 * Geo<64, 2>::STAGE + 64);
  for (;;) {
    if (tid == 0) *uq = atomicAdd(ctr, 1);
    __syncthreads();
    const int u = *uq;
    __syncthreads();
    if (u >= NB * 2 * 64) break;
    const int b = u >> 7, g = (u >> 6) & 1, tq = u & 63, hq = g * 4 + (wave >> 1), t = tq * 64 + 32 * (wave & 1) + r32, grow = b * SEQ + t;
    const int klo = max(tq - 2, 0), khi = min(tq + 2, 63), nwin = khi - klo + 1, ntiles = nwin + 4;
    bf16x8 q[4];
#pragma unroll
    for (int d0 = 0; d0 < 4; ++d0) q[d0] = load_q8(P1 + (size_t)grow * 2304 + hq * 64 + 16 * d0 + 8 * hi, C2);
    f32x16 o[2];
#pragma unroll
    for (int bk = 0; bk < 2; ++bk)
#pragma unroll
      for (int r = 0; r < 16; ++r) o[bk][r] = 0.f;
    float m = -1e30f, l = 0.f;
    const int cbase = NLAT + b * CTXL, lbase = b * SEQ;
    flash_pass2<64, 2, 0, 2>(lds, ntiles, P1, 2304, 512 + g * 64, 640 + g * 64, q, 0,
      [&](int kt, int i) { return kt < nwin ? lbase + (klo + kt) * 64 + i : cbase + (kt - nwin) * 64 + i; },
      [&](int kt, f32x16& p0, f32x16& p1) {
        if (kt < nwin) { const int kp = (klo + kt) * 64 - t;
#pragma unroll
          for (int r = 0; r < 16; ++r) { const int d0 = kp + crow(r, hi), d1 = d0 + 32;
            if (d0 < -128 || d0 > 128) p0[r] = -INFINITY; if (d1 < -128 || d1 > 128) p1[r] = -INFINITY; } } },
      o, m, l);
    l += __shfl_xor(l, 32);
    { const float sk = p.in[L1_SINKS][hq] * LOG2E, mn = fmaxf(m, sk), alpha = __builtin_amdgcn_exp2f(m - mn);
      l = l * alpha + __builtin_amdgcn_exp2f(sk - mn);
#pragma unroll
      for (int bk = 0; bk < 2; ++bk)
#pragma unroll
        for (int r = 0; r < 16; ++r) o[bk][r] *= alpha; }
    const float inv = 1.f / l;
#pragma unroll
    for (int bk = 0; bk < 2; ++bk)
#pragma unroll
      for (int rg = 0; rg < 4; ++rg) { const int dv = bk * 32 + 8 * rg + 4 * hi;
        st_att4(ATT, (size_t)grow, hq * 64 + dv, o[bk][4 * rg] * inv, o[bk][4 * rg + 1] * inv, o[bk][4 * rg + 2] * inv, o[bk][4 * rg + 3] * inv); }
    __syncthreads();
  }
}
}
namespace fs {
using fa::bf16x8; using fa::s16x4; using fa::f32x16; using fa::ldsp_t; using fa::u32x4; using fa::cvtpk; using fa::vtr; using fa::crow; using fa::LOG2E;
typedef unsigned u32x2 __attribute__((ext_vector_type(2)));

DEVI void phase_conv(const Params& p) {
  const bf16_t* P1 = (const bf16_t*)(p.ws + WS_P1); bf16_t* U = (bf16_t*)(p.ws + WS_U);
  const float* cw = p.in[L1_CONVW]; const float* cb = p.in[L1_CONVB];
  const int nitems = (NROW / 16) * 128;
  for (int it = blockIdx.x * NT + ftid(); it < nitems; it += gridDim.x * NT) {
    const int cg = it & 127, rc = it >> 7, r0 = rc * 16, ch = cg * 8;
    int s0, len; if (r0 < NLAT) { s0 = r0 & ~4095; len = SEQ; } else { s0 = NLAT + ((r0 - NLAT) & ~255); len = CTXL; }
    const int t0 = r0 - s0;
    float w[5][8], bias[8];
#pragma unroll
    for (int j = 0; j < 5; ++j) { const float4 a = *(const float4*)(cw + j * 1024 + ch), b = *(const float4*)(cw + j * 1024 + ch + 4);
      w[j][0] = a.x; w[j][1] = a.y; w[j][2] = a.z; w[j][3] = a.w; w[j][4] = b.x; w[j][5] = b.y; w[j][6] = b.z; w[j][7] = b.w; }
    { const float4 a = *(const float4*)(cb + ch), b = *(const float4*)(cb + ch + 4); bias[0] = a.x; bias[1] = a.y; bias[2] = a.z; bias[3] = a.w; bias[4] = b.x; bias[5] = b.y; bias[6] = b.z; bias[7] = b.w; }
    float win[5][8];
    auto ldrow = [&](int t, float (&d)[8]) {
      if (t < 0 || t >= len) {
#pragma unroll
        for (int k = 0; k < 8; ++k) d[k] = 0.f; return; }
      const u32x4 v = *(const u32x4*)(P1 + (size_t)(s0 + t) * 2304 + 768 + ch);
#pragma unroll
      for (int k = 0; k < 4; ++k) { d[2 * k] = __uint_as_float(v[k] << 16); d[2 * k + 1] = __uint_as_float(v[k] & 0xffff0000u); } };
    ldrow(t0 - 2, win[0]); ldrow(t0 - 1, win[1]); ldrow(t0, win[2]); ldrow(t0 + 1, win[3]);
#pragma unroll
    for (int i = 0; i < 16; ++i) {
      ldrow(t0 + i + 2, win[(i + 4) % 5]);
      float o[8];
#pragma unroll
      for (int k = 0; k < 8; ++k) { float a = bias[k];
#pragma unroll
        for (int j = 0; j < 5; ++j) a += w[j][k] * win[(i + j) % 5][k];
        o[k] = a * __builtin_amdgcn_rcpf(1.f + __expf(-a)); }
      u32x4 ov; ov[0] = cvtpk(o[0], o[1]); ov[1] = cvtpk(o[2], o[3]); ov[2] = cvtpk(o[4], o[5]); ov[3] = cvtpk(o[6], o[7]);
      *(u32x4*)(U + (size_t)(r0 + i) * 1024 + ch) = ov;
    }
  }
}

DEVI float softplus_f(float v) { if (v > 20.f) return v; const float x = __expf(v); return x < 1e-3f ? x * (1.f - 0.5f * x) : __logf(1.f + x); }
constexpr int BSTR = 272, XSTR = 192;
constexpr int L_BM = 0, L_XD = 128 * BSTR, L_XW = L_XD + 128 * XSTR, L_HT = L_XW + 128 * XSTR, L_CUM = L_HT + 128 * XSTR, L_DTV = L_CUM + 1024, L_XCH = L_DTV + 1024, L_TOT = L_XCH + 8 * 4096;

template <int ABL = 0> DEVI void phase_ssd(const Params& p, ldsp_t lds) {
  const int tid = ftid(), lane = tid & 63, wave = __builtin_amdgcn_readfirstlane(tid >> 6), r32 = lane & 31, hi = lane >> 5;
  const int pb = wave >> 2, lb = (wave < 4) ? (wave & 3) : 3 - (wave & 3);
  const bf16_t* U = (const bf16_t*)(p.ws + WS_U); const float* DT = (const float*)(p.ws + WS_DT);
  bf16_t* YFB = (bf16_t*)(p.ws + WS_YS);
  const int trow_off = 4 * hi + ((lane & 15) >> 2), tcol_off = 32 * ((lane >> 4) & 1) + 8 * (lane & 3);
  for (int it = blockIdx.x; it < NB * 2 * 8; it += gridDim.x) {
    const int b = it >> 4, dir = (it >> 3) & 1, hd = it & 7, g = hd >> 2;
    const float a2 = -expf(p.in[dir ? L1_ALOGB : L1_ALOGF][hd]) * LOG2E; const float dtb = p.in[dir ? L1_DTBB : L1_DTBF][hd];
    auto tokrow = [&](int c, int i) { const int seg = c >= 2, len = seg ? SEQ : CTXL, j = (seg ? c - 2 : c) * 128 + i; return (seg ? b * SEQ : NLAT + b * CTXL) + (dir ? len - 1 - j : j); };
    f32x16 hacc;
#pragma unroll
    for (int r = 0; r < 16; ++r) hacc[r] = 0.f;
    for (int i = tid; i < 128 * XSTR / 4; i += NT) ((FA_LAS unsigned*)(lds + L_HT))[i] = 0u;
    u32x4 sb_[4], sx_[2]; float sdt0 = 0.f, sdt1 = 0.f; bf16x8 cfn[8];
    auto prefetch = [&](int c) {
#pragma unroll
      for (int i = 0; i < 4; ++i) { const int ch = tid + NT * i; sb_[i] = *(const u32x4*)(U + (size_t)tokrow(c, ch >> 4) * 1024 + 512 + g * 128 + (ch & 15) * 8); }
#pragma unroll
      for (int i = 0; i < 2; ++i) { const int ch = tid + NT * i; sx_[i] = *(const u32x4*)(U + (size_t)tokrow(c, ch >> 3) * 1024 + hd * 64 + (ch & 7) * 8); }
      if (tid < 64) { sdt0 = DT[(size_t)tokrow(c, 2 * tid) * 16 + dir * 8 + hd]; sdt1 = DT[(size_t)tokrow(c, 2 * tid + 1) * 16 + dir * 8 + hd]; }
      const bf16_t* crowp = U + (size_t)tokrow(c, lb * 32 + r32) * 1024 + 768 + g * 128 + 8 * hi;
#pragma unroll
      for (int ks = 0; ks < 8; ++ks) cfn[ks] = *(const bf16x8*)(crowp + 16 * ks);
    };
    auto s1 = [&](int c) {
      if (tid < 64) {
        FA_LAS float* CUMw = (FA_LAS float*)(lds + L_CUM + (c & 1) * 512); FA_LAS float* DTVw = (FA_LAS float*)(lds + L_DTV + (c & 1) * 512);
        const float r0 = sdt0 + dtb, r1 = sdt1 + dtb; const float d0 = softplus_f(r0), d1 = softplus_f(r1);
        const float a0 = d0 * a2, a1 = d1 * a2; float v = a0 + a1;
        v = wave_scan_incl(v);
        DTVw[2 * tid] = d0; DTVw[2 * tid + 1] = d1; CUMw[2 * tid] = v - a1; CUMw[2 * tid + 1] = v;
      } };
    prefetch(0);
    s1(0);
    __syncthreads();
    for (int c = 0; c < 34; ++c) {
      const FA_LAS float* CUM = (const FA_LAS float*)(lds + L_CUM + (c & 1) * 512); const FA_LAS float* DTV = (const FA_LAS float*)(lds + L_DTV + (c & 1) * 512);
      const float cl = CUM[127];
#pragma unroll
      for (int i = 0; i < 4; ++i) { const int ch = tid + NT * i; *(FA_LAS u32x4*)(lds + L_BM + (ch >> 4) * BSTR + (ch & 15) * 16) = sb_[i]; }
#pragma unroll
      for (int i = 0; i < 2; ++i) { const int ch = tid + NT * i, s = ch >> 3; const float d = DTV[s], wv = d * __builtin_amdgcn_exp2f(cl - CUM[s]);
        u32x4 xd, xw;
#pragma unroll
        for (int k = 0; k < 4; ++k) { const float x0 = __uint_as_float(sx_[i][k] << 16), x1 = __uint_as_float(sx_[i][k] & 0xffff0000u); xd[k] = cvtpk(x0 * d, x1 * d); xw[k] = cvtpk(x0 * wv, x1 * wv); }
        *(FA_LAS u32x4*)(lds + L_XD + s * XSTR + (ch & 7) * 16) = xd; *(FA_LAS u32x4*)(lds + L_XW + s * XSTR + (ch & 7) * 16) = xw; }
      bf16x8 cf[8];
#pragma unroll
      for (int ks = 0; ks < 8; ++ks) cf[ks] = cfn[ks];
      __syncthreads();
      if (ABL != 3) { if (c + 1 < 34) prefetch(c + 1); }
      if (c >= 2 && ABL != 1) {
        f32x16 y;
#pragma unroll
        for (int r = 0; r < 16; ++r) y[r] = 0.f;
        { const ldsp_t hb = lds + L_HT + (8 * hi + ((lane & 15) >> 2)) * XSTR + pb * 64 + tcol_off;
          f32x16 y2;
#pragma unroll
          for (int r = 0; r < 16; ++r) y2[r] = 0.f;
#pragma unroll
          for (int ks = 0; ks < 8; ++ks) { const s16x4 lo = vtr(hb + (16 * ks) * XSTR), h8 = vtr(hb + (16 * ks + 4) * XSTR);
            const bf16x8 hf = {lo[0], lo[1], lo[2], lo[3], h8[0], h8[1], h8[2], h8[3]};
            if (ks & 1) y2 = __builtin_amdgcn_mfma_f32_32x32x16_bf16(hf, cf[ks], y2, 0, 0, 0); else y = __builtin_amdgcn_mfma_f32_32x32x16_bf16(hf, cf[ks], y, 0, 0, 0); }
          y += y2; }
        const float cuml = CUM[lb * 32 + r32];
        { const float e = __builtin_amdgcn_exp2f(cuml);
#pragma unroll
          for (int r = 0; r < 16; ++r) y[r] *= e; }
        f32x16 yo;
#pragma unroll
        for (int r = 0; r < 16; ++r) yo[r] = 0.f;
        for (int sb = pb; sb <= lb; sb += 2) {
          f32x16 gt, gt2;
#pragma unroll
          for (int r = 0; r < 16; ++r) { gt[r] = 0.f; gt2[r] = 0.f; }
          const ldsp_t bb = lds + L_BM + (sb * 32 + r32) * BSTR + 16 * hi;
#pragma unroll
          for (int ks = 0; ks < 8; ks += 2) { gt = __builtin_amdgcn_mfma_f32_32x32x16_bf16(*(const FA_LAS bf16x8*)(bb + 32 * ks), cf[ks], gt, 0, 0, 0);
            gt2 = __builtin_amdgcn_mfma_f32_32x32x16_bf16(*(const FA_LAS bf16x8*)(bb + 32 * ks + 32), cf[ks + 1], gt2, 0, 0, 0); }
          gt += gt2;
          const bool diag = (sb == lb);
#pragma unroll
          for (int r = 0; r < 16; ++r) { const int sl = crow(r, hi); const float v = gt[r] * __builtin_amdgcn_exp2f(cuml - CUM[sb * 32 + sl]); gt[r] = (diag && sl > r32) ? 0.f : v; }
          u32x4 t0, t1;
          t0[0] = cvtpk(gt[0], gt[1]); t0[1] = cvtpk(gt[2], gt[3]); t0[2] = cvtpk(gt[4], gt[5]); t0[3] = cvtpk(gt[6], gt[7]);
          t1[0] = cvtpk(gt[8], gt[9]); t1[1] = cvtpk(gt[10], gt[11]); t1[2] = cvtpk(gt[12], gt[13]); t1[3] = cvtpk(gt[14], gt[15]);
          const bf16x8 pm0 = __builtin_bit_cast(bf16x8, t0), pm1 = __builtin_bit_cast(bf16x8, t1);
          const ldsp_t xb = lds + L_XD + (sb * 32 + trow_off) * XSTR + pb * 64 + tcol_off;
          const ldsp_t xo = lds + L_XD + (sb * 32 + trow_off) * XSTR + (1 - pb) * 64 + tcol_off;
          const s16x4 a0 = vtr(xb), a1 = vtr(xb + 8 * XSTR), a2 = vtr(xb + 16 * XSTR), a3 = vtr(xb + 24 * XSTR);
          const s16x4 b0 = vtr(xo), b1 = vtr(xo + 8 * XSTR), b2 = vtr(xo + 16 * XSTR), b3 = vtr(xo + 24 * XSTR);
          { const bf16x8 xf = {a0[0], a0[1], a0[2], a0[3], a1[0], a1[1], a1[2], a1[3]}; y = __builtin_amdgcn_mfma_f32_32x32x16_bf16(xf, pm0, y, 0, 0, 0); }
          { const bf16x8 xf = {b0[0], b0[1], b0[2], b0[3], b1[0], b1[1], b1[2], b1[3]}; yo = __builtin_amdgcn_mfma_f32_32x32x16_bf16(xf, pm0, yo, 0, 0, 0); }
          { const bf16x8 xf = {a2[0], a2[1], a2[2], a2[3], a3[0], a3[1], a3[2], a3[3]}; y = __builtin_amdgcn_mfma_f32_32x32x16_bf16(xf, pm1, y, 0, 0, 0); }
          { const bf16x8 xf = {b2[0], b2[1], b2[2], b2[3], b3[0], b3[1], b3[2], b3[3]}; yo = __builtin_amdgcn_mfma_f32_32x32x16_bf16(xf, pm1, yo, 0, 0, 0); }
        }
        { FA_LAS float* X = (FA_LAS float*)(lds + L_XCH) + (pb * 4 + lb) * 1024;
#pragma unroll
          for (int r = 0; r < 16; ++r) X[r * 64 + lane] = yo[r]; }
        __syncthreads();
        { const FA_LAS float* X = (const FA_LAS float*)(lds + L_XCH) + ((1 - pb) * 4 + lb) * 1024;
#pragma unroll
          for (int r = 0; r < 16; ++r) y[r] += X[r * 64 + lane]; }
        const int j = (c - 2) * 128 + lb * 32 + r32, tok = dir ? SEQ - 1 - j : j;
        bf16_t* yp = YFB + ((size_t)dir * NLAT + (size_t)b * SEQ + tok) * 512 + hd * 64 + pb * 32 + 4 * hi;
#pragma unroll
        for (int rg = 0; rg < 4; ++rg) { u32x2 w; w[0] = cvtpk(y[4 * rg], y[4 * rg + 1]); w[1] = cvtpk(y[4 * rg + 2], y[4 * rg + 3]); *(u32x2*)(yp + 8 * rg) = w; }
      }
      if (ABL != 2) { const float e = __builtin_amdgcn_exp2f(cl);
        f32x16 h2;
#pragma unroll
        for (int r = 0; r < 16; ++r) { hacc[r] *= e; h2[r] = 0.f; }
        const ldsp_t xb = lds + L_XW + (8 * hi + ((lane & 15) >> 2)) * XSTR + pb * 64 + tcol_off;
        const ldsp_t bb = lds + L_BM + (8 * hi + ((lane & 15) >> 2)) * BSTR + lb * 64 + tcol_off;
#pragma unroll
        for (int ks = 0; ks < 8; ++ks) {
          const s16x4 xl = vtr(xb + (16 * ks) * XSTR), xh = vtr(xb + (16 * ks + 4) * XSTR), bl = vtr(bb + (16 * ks) * BSTR), bh = vtr(bb + (16 * ks + 4) * BSTR);
          const bf16x8 xf = {xl[0], xl[1], xl[2], xl[3], xh[0], xh[1], xh[2], xh[3]}, bf = {bl[0], bl[1], bl[2], bl[3], bh[0], bh[1], bh[2], bh[3]};
          if (ks & 1) h2 = __builtin_amdgcn_mfma_f32_32x32x16_bf16(xf, bf, h2, 0, 0, 0); else hacc = __builtin_amdgcn_mfma_f32_32x32x16_bf16(xf, bf, hacc, 0, 0, 0);
        }
        hacc += h2; }
      if (c + 1 < 34) s1(c + 1);
      __syncthreads();
      { const ldsp_t hp = lds + L_HT + (lb * 32 + r32) * XSTR + (pb * 32 + 4 * hi) * 2;
#pragma unroll
        for (int rg = 0; rg < 4; ++rg) { u32x2 w; w[0] = cvtpk(hacc[4 * rg], hacc[4 * rg + 1]); w[1] = cvtpk(hacc[4 * rg + 2], hacc[4 * rg + 3]); *(FA_LAS u32x2*)(hp + 16 * rg) = w; } }
    }
    __syncthreads();
  }
}

DEVI void phase_ssd_out(const Params& p) {
  const int lane = ftid() & 63, gw = blockIdx.x * NWAVE + (ftid() >> 6), NGW = gridDim.x * NWAVE;
  const bf16_t* U = (const bf16_t*)(p.ws + WS_U); const bf16_t* P1 = (const bf16_t*)(p.ws + WS_P1); const bf16_t* YFB = (const bf16_t*)(p.ws + WS_YS);
  bf16_t* ATT = (bf16_t*)(p.ws + WS_ATT1);
  for (int r = gw; r < NLAT; r += NGW) {
    const int c0 = lane * 8, hd = c0 >> 6; const float dsk = p.in[L1_DSKIP][hd];
    const u32x4 yf = *(const u32x4*)(YFB + (size_t)r * 512 + c0), yb = *(const u32x4*)(YFB + ((size_t)NLAT + r) * 512 + c0);
    const u32x4 xw = *(const u32x4*)(U + (size_t)r * 1024 + c0), zw = *(const u32x4*)(P1 + (size_t)r * 2304 + 1792 + c0);
    float y[8]; float ss = 0.f;
#pragma unroll
    for (int i = 0; i < 4; ++i) {
      const float x0 = __uint_as_float(xw[i] << 16), x1 = __uint_as_float(xw[i] & 0xffff0000u), z0 = __uint_as_float(zw[i] << 16), z1 = __uint_as_float(zw[i] & 0xffff0000u);
      const float f0 = __uint_as_float(yf[i] << 16) + __uint_as_float(yb[i] << 16), f1 = __uint_as_float(yf[i] & 0xffff0000u) + __uint_as_float(yb[i] & 0xffff0000u);
      y[2 * i] = (f0 + dsk * x0) * silu_f(z0); y[2 * i + 1] = (f1 + dsk * x1) * silu_f(z1);
      ss += y[2 * i] * y[2 * i] + y[2 * i + 1] * y[2 * i + 1];
    }
    ss = half_sum(ss);
    const float rr = rsqrtf(ss * (1.f / 256.f) + EPS);
    const float4 g0 = *(const float4*)(p.in[L1_GNORM] + c0), g1 = *(const float4*)(p.in[L1_GNORM] + c0 + 4);
    u32x4 w; w[0] = cvtpk(y[0] * rr * g0.x, y[1] * rr * g0.y); w[1] = cvtpk(y[2] * rr * g0.z, y[3] * rr * g0.w); w[2] = cvtpk(y[4] * rr * g1.x, y[5] * rr * g1.y); w[3] = cvtpk(y[6] * rr * g1.z, y[7] * rr * g1.w);
    *(u32x4*)(ATT + (size_t)r * DM + 512 + c0) = w;
  }
}
}
#ifndef TOPK_COPY
#define TOPK_COPY false
#endif
namespace ft {
using fa::ldsp_t; using fa::u32x4;

DEVI int block_excl_scan(int v, FA_LAS int* wsum, int tid, int* tot) {
  const int lane = tid & 63, wave = tid >> 6;
  const int inc = wave_scan_incl_i(v);
  __syncthreads();
  if (lane == 63) wsum[wave] = inc;
  __syncthreads();
  int base = 0, total = 0;
#pragma unroll
  for (int w = 0; w < 8; ++w) { const int s = wsum[w]; if (w < wave) base += s; total += s; }
  *tot = total;
  return base + inc - v;
}

template <int EPT, bool GATHER_COPY, int ABL = 0>
DEVI void topk_item(const Params& p, ldsp_t lds, int e, int n, int cap, int row0, int slot0, int erows) {
  const int tid = ftid(), lane = tid & 63, wave = tid >> 6;
  const float* AFFT = (const float*)(p.ws + WS_AFF); int* SLOT = (int*)(p.ws + WS_SLOT); float* GV = (float*)(p.ws + WS_GATEV);
  const bf16_t* H = (const bf16_t*)(p.ws + WS_H); bf16_t* XG = (bf16_t*)(p.ws + WS_XG); int* IDX = (int*)(p.ws + WS_IDX);
  FA_LAS unsigned* hist = (FA_LAS unsigned*)lds;
  FA_LAS int* misc = (FA_LAS int*)(lds + 1024);
  FA_LAS int* wsum = (FA_LAS int*)(lds + 1024 + 64);
  FA_LAS int* list = (FA_LAS int*)(lds + 2048);
  const bool act = tid * EPT < n;
  unsigned key[EPT];
#pragma unroll
  for (int j = 0; j < EPT; ++j) key[j] = act ? __float_as_uint(AFFT[(size_t)e * NROW + row0 + tid * EPT + j]) : 0u;
  unsigned prefix = 0u, mask = 0u; int k = cap;
#pragma unroll 1
  for (int pass = 0; pass < 4; ++pass) {
    const int shift = 24 - 8 * pass;
    __syncthreads();
    if (tid < 256) hist[tid] = 0u;
    __syncthreads();
    if (act) {
#pragma unroll
      for (int j = 0; j < EPT; ++j) if ((key[j] & mask) == prefix) atomicAdd((unsigned*)&hist[(key[j] >> shift) & 255u], 1u);
    }
    __syncthreads();
    if (wave == 0) {
      const int h0 = hist[4 * lane], h1 = hist[4 * lane + 1], h2 = hist[4 * lane + 2], h3 = hist[4 * lane + 3];
      const int s = h0 + h1 + h2 + h3; const int pre = wave_scan_incl_i(s);
      int c = __builtin_amdgcn_readlane(pre, 63) - pre;
      const int hh[4] = {h0, h1, h2, h3};
#pragma unroll
      for (int b = 3; b >= 0; --b) { if (c < k && k <= c + hh[b]) { misc[0] = 4 * lane + b; misc[1] = k - c; } c += hh[b]; }
    }
    __syncthreads();
    prefix |= ((unsigned)misc[0]) << shift; mask |= 255u << shift; k = misc[1];
  }
  int ce = 0;
#pragma unroll
  for (int j = 0; j < EPT; ++j) ce += (act && key[j] == prefix) ? 1 : 0;
  int tot; const int eq_before = block_excl_scan(ce, wsum, tid, &tot);
  int cs = 0, eqr = eq_before; bool sel[EPT];
#pragma unroll
  for (int j = 0; j < EPT; ++j) { bool s = false; if (act) { if (key[j] > prefix) s = true; else if (key[j] == prefix) { s = eqr < k; ++eqr; } } sel[j] = s; cs += s ? 1 : 0; }
  int slot = block_excl_scan(cs, wsum, tid, &tot);
  if (act) {
    int sv[EPT];
#pragma unroll
    for (int j = 0; j < EPT; ++j) { const int row = row0 + tid * EPT + j;
      if (sel[j]) { if (GATHER_COPY) list[slot] = row; else IDX[e * erows + slot0 + slot] = row; GV[e * erows + slot0 + slot] = __uint_as_float(key[j]); sv[j] = slot0 + slot; ++slot; }
      else sv[j] = -1; }
    if (ABL != 1) {
      int* sp = SLOT + (size_t)e * NROW + row0 + tid * EPT;
      if (EPT == 8) { *(int4*)sp = make_int4(sv[0], sv[1 % EPT], sv[2 % EPT], sv[3 % EPT]); *(int4*)(sp + 4) = make_int4(sv[4 % EPT], sv[5 % EPT], sv[6 % EPT], sv[7 % EPT]); }
      else {
#pragma unroll
        for (int j = 0; j < EPT; ++j) sp[j] = sv[j]; }
    }
  }
  if (GATHER_COPY) {
    __syncthreads();
    for (int s = wave; s < cap; s += NWAVE) {
      const u32x4* src = (const u32x4*)(H + (size_t)list[s] * DM) + lane; u32x4* dst = (u32x4*)(XG + ((size_t)e * erows + slot0 + s) * DM) + lane;
      const u32x4 a = src[0], b2 = src[64]; dst[0] = a; dst[64] = b2;
    }
  }
  __syncthreads();
}

template <int ABL = 0> DEVI void phase_topk(const Params& p, ldsp_t lds, int layer) {
  const int erows = layer ? EROWS1 : EROWS0;
  const int nlat = NB * NE, nitems = nlat + (layer ? 0 : NB * NE);
  const int G = gridDim.x;
  for (int it = blockIdx.x; it < nitems; it += G) {
    if (it < nlat) { const int b = it / NE, e = it % NE; topk_item<8, TOPK_COPY, ABL>(p, lds, e, SEQ, CAP_L, b * SEQ, b * CAP_L, erows); }
    else { const int i2 = it - nlat, b = i2 / NE, e = i2 % NE; topk_item<1, TOPK_COPY, ABL>(p, lds, e, CTXL, CAP_C, NLAT + b * CTXL, NB * CAP_L + b * CAP_C, erows); }
  }
}
}
#ifndef MOE1_FP8
#define MOE1_FP8 1
#endif
#ifndef MOE0_FP8
#define MOE0_FP8 1
#endif
namespace fr {
using fa::ldsp_t; using fa::u32x4; using fa::cvtpk;
typedef unsigned u32x2 __attribute__((ext_vector_type(2)));
typedef float f32x4 __attribute__((ext_vector_type(4)));
struct V16 { f32x4 v[4]; };
DEVI V16 ldf(const float* r, int lane) { V16 o; const f32x4* q = (const f32x4*)r + lane;
#pragma unroll
  for (int j = 0; j < 4; ++j) o.v[j] = q[64 * j]; return o; }
struct B16 { u32x2 v[4]; };
DEVI B16 ldb_raw(const bf16_t* r, int lane) { B16 o; const u32x2* q = (const u32x2*)r + lane;
#pragma unroll
  for (int j = 0; j < 4; ++j) o.v[j] = q[64 * j]; return o; }
DEVI V16 b2v(const B16& b) { V16 o;
#pragma unroll
  for (int j = 0; j < 4; ++j) { o.v[j][0] = __uint_as_float(b.v[j][0] << 16); o.v[j][1] = __uint_as_float(b.v[j][0] & 0xffff0000u); o.v[j][2] = __uint_as_float(b.v[j][1] << 16); o.v[j][3] = __uint_as_float(b.v[j][1] & 0xffff0000u); }
  return o; }
DEVI void stf(float* r, int lane, const V16& o) { f32x4* q = (f32x4*)r + lane;
#pragma unroll
  for (int j = 0; j < 4; ++j) q[64 * j] = o.v[j]; }
DEVI void stb(bf16_t* r, int lane, const V16& o) { u32x2* q = (u32x2*)r + lane;
#pragma unroll
  for (int j = 0; j < 4; ++j) { u32x2 w; w[0] = cvtpk(o.v[j][0], o.v[j][1]); w[1] = cvtpk(o.v[j][2], o.v[j][3]); q[64 * j] = w; } }
DEVI float sumsq(const V16& o) { f32x4 s = o.v[0] * o.v[0];
#pragma unroll
  for (int j = 1; j < 4; ++j) s += o.v[j] * o.v[j];
  return wave_sum((s[0] + s[1]) + (s[2] + s[3])); }

DEVI void phase_prenorm0(const Params& p) {
  const int lane = ftid() & 63, gw = blockIdx.x * NWAVE + (ftid() >> 6), NGW = gridDim.x * NWAVE;
  const float* MOD = (const float*)(p.ws + WS_CTL + CTL_MOD); bf16_t* H = (bf16_t*)(p.ws + WS_H);
  const int rpw = (NROW + NGW - 1) / NGW;
  const int r0 = gw * rpw, r1 = min(r0 + rpw, NROW);
  if (r0 >= r1) return;
  const V16 g = ldf(p.in[L0_GPREMIX], lane);
  int cur = -1; V16 gs, sh;
  auto src = [&](int r) { return r < NLAT ? p.in[I_X] + (size_t)r * DM : p.in[I_CTX] + (size_t)(r - NLAT) * DM; };
  V16 xn = ldf(src(r0), lane), xn2 = xn;
  if (r0 + 1 < r1) xn2 = ldf(src(r0 + 1), lane);
  for (int r = r0; r < r1; ++r) {
    const V16 x = xn; xn = xn2; if (r + 2 < r1) xn2 = ldf(src(r + 2), lane);
    const int mr = row_modrow(r);
    if (mr != cur) { cur = mr; const float* m = MOD + (size_t)mr * 6144; const V16 sc = ldf(m + 1024, lane); sh = ldf(m, lane);
#pragma unroll
      for (int j = 0; j < 4; ++j) gs.v[j] = g.v[j] * (sc.v[j] + 1.f); }
    const float rr = rsqrtf(sumsq(x) * (1.f / DM) + EPS);
    V16 h;
#pragma unroll
    for (int j = 0; j < 4; ++j) h.v[j] = x.v[j] * rr * gs.v[j] + sh.v[j];
    if (QKV0_FP8) {
      unsigned* q8 = (unsigned*)((unsigned char*)H + (size_t)r * DM) + lane;
#pragma unroll
      for (int j = 0; j < 4; ++j) q8[64 * j] = nv::pack4_fp8(h.v[j][0] * nv::A8_SCALE, h.v[j][1] * nv::A8_SCALE, h.v[j][2] * nv::A8_SCALE, h.v[j][3] * nv::A8_SCALE);
    } else stb(H + (size_t)r * DM, lane, h);
  }
}

template <int ABL = 0> DEVI void phase_postmix(const Params& p, ldsp_t lds, int layer) {
  const int tid = ftid(), lane = tid & 63, gw = blockIdx.x * NWAVE + (tid >> 6), NGW = gridDim.x * NWAVE;
  const float* MOD = (const float*)(p.ws + WS_CTL + CTL_MOD) + (size_t)layer * 9 * 6144;
  const bf16_t* MIX = (const bf16_t*)(p.ws + (layer ? WS_MIX1 : WS_MIX0));
  bf16_t* H = (bf16_t*)(p.ws + WS_H); float* AFFT = (float*)(p.ws + WS_AFF); float* XC = (float*)(p.ws + WS_XC);
  const float* wr = p.in[layer ? L1_WROUTER : L0_WROUTER];
  FA_LAS f32x4* WL = (FA_LAS f32x4*)lds;
  for (int i = tid; i < 1024 * 4; i += NT) { const int k = i >> 2, e4 = i & 3; const int ln = (k & 255) >> 2, q = k & 3, j = k >> 8;
    WL[((j * 4 + q) * 4 + e4) * 64 + ln] = *(const f32x4*)(wr + (size_t)k * 16 + e4 * 4); }
  __syncthreads();
  const int nrow = layer ? NLAT : NROW;
  const int rpw = (nrow + NGW - 1) / NGW;
  const int r0 = gw * rpw, r1 = min(r0 + rpw, nrow);
  if (r0 >= r1) return;
  const V16 gpost = ldf(p.in[layer ? L1_GPOSTMIX : L0_GPOSTMIX], lane), gpre = ldf(p.in[layer ? L1_GPREFFN : L0_GPREFFN], lane);
  int cur = -1; V16 gg, gs, sh;
  auto xsrc = [&](int r) { return layer ? (const float*)(p.out + (size_t)r * DM) : (r < NLAT ? p.in[I_X] + (size_t)r * DM : p.in[I_CTX] + (size_t)(r - NLAT) * DM); };
  B16 mn = ldb_raw(MIX + (size_t)r0 * DM, lane); V16 xn = ldf(xsrc(r0), lane);
  B16 mn2 = mn; V16 xn2 = xn;
  if (r0 + 1 < r1) { mn2 = ldb_raw(MIX + (size_t)(r0 + 1) * DM, lane); xn2 = ldf(xsrc(r0 + 1), lane); }
  for (int r = r0; r < r1; ++r) {
    const B16 mb = mn; const V16 x = xn;
    mn = mn2; xn = xn2;
    if (r + 2 < r1) { mn2 = ldb_raw(MIX + (size_t)(r + 2) * DM, lane); xn2 = ldf(xsrc(r + 2), lane); }
    const int mr = row_modrow(r);
    if (mr != cur) { cur = mr; const float* m = MOD + (size_t)mr * 6144; const V16 gt = ldf(m + 2048, lane), sc = ldf(m + 4096, lane); sh = ldf(m + 3072, lane);
#pragma unroll
      for (int j = 0; j < 4; ++j) { gg.v[j] = gt.v[j] * gpost.v[j]; gs.v[j] = gpre.v[j] * (sc.v[j] + 1.f); } }
    V16 o = b2v(mb);
    const float rr = rsqrtf(sumsq(o) * (1.f / DM) + EPS);
#pragma unroll
    for (int j = 0; j < 4; ++j) o.v[j] = x.v[j] + gg.v[j] * (o.v[j] * rr);
    stf(r < NLAT ? p.out + (size_t)r * DM : XC + (size_t)(r - NLAT) * DM, lane, o);
    const float r2 = rsqrtf(sumsq(o) * (1.f / DM) + EPS);
    V16 h;
#pragma unroll
    for (int j = 0; j < 4; ++j) h.v[j] = o.v[j] * r2 * gs.v[j] + sh.v[j];
    if ((layer == 1 && MOE1_FP8) || (layer == 0 && MOE0_FP8)) {
      unsigned* q8 = (unsigned*)((unsigned char*)H + (size_t)r * DM) + lane;
#pragma unroll
      for (int j = 0; j < 4; ++j) q8[64 * j] = nv::pack4_fp8(h.v[j][0] * nv::A8_SCALE, h.v[j][1] * nv::A8_SCALE, h.v[j][2] * nv::A8_SCALE, h.v[j][3] * nv::A8_SCALE);
    } else stb(H + (size_t)r * DM, lane, h);
    if (ABL == 1) continue;
    f32x4 lg[4];
    int lo = lane; asm volatile("" : "+v"(lo));
#pragma unroll
    for (int e4 = 0; e4 < 4; ++e4) lg[e4] = (f32x4){0.f, 0.f, 0.f, 0.f};
#pragma unroll
    for (int j = 0; j < 4; ++j)
#pragma unroll
      for (int q = 0; q < 4; ++q) { const float hv = h.v[j][q];
#pragma unroll
        for (int e4 = 0; e4 < 4; ++e4) lg[e4] += WL[((j * 4 + q) * 4 + e4) * 64 + lo] * hv; }
    float a8[8], b4[4], c2[2], d;
#pragma unroll
    for (int i = 0; i < 8; ++i) { const auto s = __builtin_amdgcn_permlane32_swap(__float_as_uint(lg[i >> 2][i & 3]), __float_as_uint(lg[2 + (i >> 2)][i & 3]), false, false);
      a8[i] = __uint_as_float(s[0]) + __uint_as_float(s[1]); }
#pragma unroll
    for (int i = 0; i < 4; ++i) { const auto s = __builtin_amdgcn_permlane16_swap(__float_as_uint(a8[i]), __float_as_uint(a8[i + 4]), false, false);
      b4[i] = __uint_as_float(s[0]) + __uint_as_float(s[1]); }
    { const bool b3 = (lane & 8) != 0, b2 = (lane & 4) != 0;
#pragma unroll
      for (int i = 0; i < 2; ++i) { const float keep = b3 ? b4[i + 2] : b4[i], send = b3 ? b4[i] : b4[i + 2]; c2[i] = keep + dppf<DPP_MIRROR>(send); }
      const float keep = b2 ? c2[1] : c2[0], send = b2 ? c2[0] : c2[1]; d = keep + dppf<DPP_HMIRROR>(send); }
    d += dppf<DPP_XOR1>(d); d += dppf<DPP_XOR2>(d);
    const float mx = quad_max(d), ex = expf(d - mx), ssum = quad_sum(ex);
    if ((lane & 3) == 0) AFFT[(size_t)(lane >> 2) * NROW + r] = ex / ssum;
  }
}

DEVI void phase_combine(const Params& p, int layer) {
  const int tid = ftid(), lane = tid & 63, gw = blockIdx.x * NWAVE + (tid >> 6), NGW = gridDim.x * NWAVE;
  const float* MOD = (const float*)(p.ws + WS_CTL + CTL_MOD);
  const bf16_t* Y = (const bf16_t*)(p.ws + WS_Y); const int* SLOT = (const int*)(p.ws + WS_SLOT); const float* GV = (const float*)(p.ws + WS_GATEV);
  bf16_t* H = (bf16_t*)(p.ws + WS_H); float* XC = (float*)(p.ws + WS_XC);
  const int nrow = layer ? NLAT : NROW, erows = layer ? EROWS1 : EROWS0;
  const int rpw = (nrow + NGW - 1) / NGW;
  const int r0 = gw * rpw, r1 = min(r0 + rpw, nrow);
  if (r0 >= r1) return;
  const V16 gpost = ldf(p.in[layer ? L1_GPOSTFFN : L0_GPOSTFFN], lane);
  V16 g1; if (layer == 0) g1 = ldf(p.in[L1_GPREMIX], lane);
  int cur = -1; V16 gg, gs, sh;
  int sn = (lane < 16) ? SLOT[(size_t)lane * NROW + r0] : -1;
  for (int r = r0; r < r1; ++r) {
    const int sl = sn; if (r + 1 < r1) sn = (lane < 16) ? SLOT[(size_t)lane * NROW + r + 1] : -1;
    float* xio = r < NLAT ? p.out + (size_t)r * DM : XC + (size_t)(r - NLAT) * DM;
    const V16 x = ldf(xio, lane);
    const int mr = row_modrow(r);
    if (mr != cur) { cur = mr; const float* m = MOD + (size_t)(layer * 9 + mr) * 6144; const V16 gt = ldf(m + 5120, lane);
#pragma unroll
      for (int j = 0; j < 4; ++j) gg.v[j] = gt.v[j] * gpost.v[j];
      if (layer == 0) { const float* m1 = MOD + (size_t)(9 + mr) * 6144; const V16 sc = ldf(m1 + 1024, lane); sh = ldf(m1, lane);
#pragma unroll
        for (int j = 0; j < 4; ++j) gs.v[j] = g1.v[j] * (sc.v[j] + 1.f); } }
    V16 o;
#pragma unroll
    for (int j = 0; j < 4; ++j) o.v[j] = (f32x4){0.f, 0.f, 0.f, 0.f};
    unsigned long long mask = __ballot(sl >= 0);
    while (mask) {
      int e_[4], s_[4]; bool v_[4];
#pragma unroll
      for (int i = 0; i < 4; ++i) { v_[i] = mask != 0ull; e_[i] = v_[i] ? __builtin_ctzll(mask) : 0; if (v_[i]) mask &= mask - 1; s_[i] = __builtin_amdgcn_readlane(sl, e_[i]); }
      B16 yr[4]; float gt[4];
#pragma unroll
      for (int i = 0; i < 4; ++i) if (v_[i]) { gt[i] = GV[e_[i] * erows + s_[i]];
        yr[i] = ldb_raw(Y + ((size_t)e_[i] * erows + s_[i]) * DM, lane); }
#pragma unroll
      for (int i = 0; i < 4; ++i) if (v_[i]) { const V16 y = b2v(yr[i]);
#pragma unroll
        for (int j = 0; j < 4; ++j) o.v[j] += y.v[j] * gt[i]; }
    }
    const float rr = rsqrtf(sumsq(o) * (1.f / DM) + EPS);
#pragma unroll
    for (int j = 0; j < 4; ++j) o.v[j] = x.v[j] + gg.v[j] * (o.v[j] * rr);
    stf(xio, lane, o);
    if (layer == 0) {
      const float r2 = rsqrtf(sumsq(o) * (1.f / DM) + EPS);
      V16 h;
#pragma unroll
      for (int j = 0; j < 4; ++j) h.v[j] = o.v[j] * r2 * gs.v[j] + sh.v[j];
      if (QKV1_FP8) {
        unsigned* q8 = (unsigned*)((unsigned char*)H + (size_t)r * DM) + lane;
#pragma unroll
        for (int j = 0; j < 4; ++j) q8[64 * j] = nv::pack4_fp8(h.v[j][0] * nv::A8_SCALE, h.v[j][1] * nv::A8_SCALE, h.v[j][2] * nv::A8_SCALE, h.v[j][3] * nv::A8_SCALE);
      } else stb(H + (size_t)r * DM, lane, h);
    }
  }
}
}
#define LAS __attribute__((address_space(3)))
#define XB_TMO      128
#define XB_XCNT(j)  (256  + 64 * (j))
#define XB_XSUB(j)  (1280 + 64 * (j))
#define XB_XGEN(j)  (2304 + 64 * (j))
#define XB_TOP      3328
#define XB_TOPGEN   3392
#define XCD_BAR_WORDS 3456
#define XB_SPIN_CAP (1u << 18)

__device__ __forceinline__ unsigned xb_ld(unsigned* p)              { return __hip_atomic_load(p, __ATOMIC_RELAXED, __HIP_MEMORY_SCOPE_AGENT); }
__device__ __forceinline__ unsigned xb_add(unsigned* p, unsigned v) { return __hip_atomic_fetch_add(p, v, __ATOMIC_RELAXED, __HIP_MEMORY_SCOPE_AGENT); }
__device__ __forceinline__ unsigned xb_xcc_id() { return (unsigned)__builtin_amdgcn_s_getreg((3 << 11) | 20) & 0xFu; }
#define XB_SPIN(cond, bar) do { unsigned _sp = 0; while (cond) { __builtin_amdgcn_s_sleep(1); \
    if ((++_sp & 255u) == 0u) { if (xb_ld(&(bar)[XB_TMO])) break; if (_sp > XB_SPIN_CAP) { atomicAdd(&(bar)[XB_TMO], 1u); break; } } } } while (0)

struct XcdBarrier {
    unsigned* bar; unsigned x;
    volatile LAS unsigned* st;
};

__device__ __forceinline__ XcdBarrier xcd_barrier_post(unsigned* bar, volatile LAS unsigned* st) {
    XcdBarrier b; b.bar = bar; b.x = xb_xcc_id(); b.st = st;
    if (threadIdx.x == 0) (void)xb_add(&bar[XB_XCNT(b.x)], 1u);
    return b;
}
__device__ __forceinline__ void xcd_barrier_complete(unsigned* bar, unsigned x, unsigned& nloc, unsigned& nx) {
    const unsigned G = gridDim.x * gridDim.y * gridDim.z;
    unsigned sum, cnt, mine, sp = 0u;
    for (;;) {
        sum = 0u; cnt = 0u; mine = 0u;
#pragma unroll
        for (unsigned j = 0; j < 16; ++j) { const unsigned c = xb_ld(&bar[XB_XCNT(j)]); sum += c; cnt += (c > 0u) ? 1u : 0u; mine = (j == x) ? c : mine; }
        if (sum == G) break;
        __builtin_amdgcn_s_sleep(1);
        if ((++sp & 255u) == 0u) { if (xb_ld(&bar[XB_TMO])) break; if (sp > XB_SPIN_CAP) { atomicAdd(&bar[XB_TMO], 1u); break; } }
    }
    nloc = mine > 0u ? mine : 1u; nx = cnt > 0u ? cnt : 1u;
}

__device__ __forceinline__ void xcd_barrier(const XcdBarrier& b) {
    asm volatile("s_waitcnt vmcnt(0)" ::: "memory");
    __syncthreads();
    if (threadIdx.x == 0) {
        unsigned* bar = b.bar;
        __builtin_amdgcn_s_waitcnt(0);
        unsigned nloc = b.st[0], nx = b.st[1];
        if (nloc == 0u) { xcd_barrier_complete(bar, b.x, nloc, nx); b.st[0] = nloc; b.st[1] = nx; }
        const unsigned old = xb_add(&bar[XB_XSUB(b.x)], 1u);
        const unsigned gen = old / nloc;
        if (old + 1u == (gen + 1u) * nloc) {
            __builtin_amdgcn_fence(__ATOMIC_RELEASE, "agent");
            asm volatile("s_waitcnt vmcnt(0)" ::: "memory");
            const unsigned og = xb_add(&bar[XB_TOP], 1u);
            const unsigned tg = og / nx;
            if (og + 1u == (tg + 1u) * nx) xb_add(&bar[XB_TOPGEN], 1u);
            else XB_SPIN(xb_ld(&bar[XB_TOPGEN]) == tg, bar);
            __builtin_amdgcn_fence(__ATOMIC_ACQUIRE, "agent");
            xb_add(&bar[XB_XGEN(b.x)], 1u);
            asm volatile("s_waitcnt vmcnt(0)" ::: "memory");
        } else {
            XB_SPIN(xb_ld(&bar[XB_XGEN(b.x)]) == gen, bar);
            __builtin_amdgcn_fence(__ATOMIC_ACQUIRE, "agent");
            asm volatile("s_waitcnt vmcnt(0)" ::: "memory");
        }
    }
    __syncthreads();
}


__device__ __forceinline__ void flat_barrier(unsigned* ctr, unsigned& epoch) {
    asm volatile("s_waitcnt vmcnt(0)" ::: "memory");
    __syncthreads();
    if (threadIdx.x == 0) {
        __builtin_amdgcn_fence(__ATOMIC_RELEASE, "agent");
        asm volatile("s_waitcnt vmcnt(0)" ::: "memory");
        (void)__hip_atomic_fetch_add(ctr, 1u, __ATOMIC_RELAXED, __HIP_MEMORY_SCOPE_AGENT);
        const unsigned target = (epoch + 1u) * (unsigned)gridDim.x; unsigned sp = 0;
        while (__hip_atomic_load(ctr, __ATOMIC_RELAXED, __HIP_MEMORY_SCOPE_AGENT) < target) { __builtin_amdgcn_s_sleep(1); if (++sp > (1u << 22)) break; }
        __builtin_amdgcn_fence(__ATOMIC_ACQUIRE, "agent");
        asm volatile("s_waitcnt vmcnt(0)" ::: "memory");
    }
    ++epoch;
    __syncthreads();
}

__device__ __forceinline__ void xcd_barrier2(const XcdBarrier& b) {
    asm volatile("s_waitcnt vmcnt(0)" ::: "memory");
    __syncthreads();
    if (threadIdx.x == 0) {
        unsigned* bar = b.bar;
        __builtin_amdgcn_s_waitcnt(0);
        unsigned nloc = b.st[0], nx = b.st[1];
        if (nloc == 0u) { xcd_barrier_complete(bar, b.x, nloc, nx); b.st[0] = nloc; b.st[1] = nx; }
        const unsigned old = xb_add(&bar[XB_XSUB(b.x)], 1u);
        const unsigned gen = old / nloc;
        if (old + 1u == (gen + 1u) * nloc) {
            __builtin_amdgcn_fence(__ATOMIC_RELEASE, "agent");
            asm volatile("s_waitcnt vmcnt(0)" ::: "memory");
            (void)xb_add(&bar[XB_TOP], 1u);
        }
        const unsigned target = (gen + 1u) * nx;
        XB_SPIN(xb_ld(&bar[XB_TOP]) < target, bar);
        __builtin_amdgcn_fence(__ATOMIC_ACQUIRE, "agent");
        asm volatile("s_waitcnt vmcnt(0)" ::: "memory");
    }
    __syncthreads();
}
constexpr int LDS_BYTES = 147456;
#define TAILFILL 1
#ifndef FAST_GEMM
#define FAST_GEMM 1
#endif
#ifndef FAST_TOPK
#define FAST_TOPK 1
#endif
#ifndef FAST_SSD
#define FAST_SSD 1
#endif
#ifndef FAST_ATTN
#define FAST_ATTN 1
#endif
__global__ void __launch_bounds__(NT) mega(Params p) {
  extern __shared__ __attribute__((aligned(16))) unsigned char lds_raw[];
  float* lds = (float*)lds_raw;
  fg::ldsp_t ldsp = (fg::ldsp_t)lds_raw;
  cg::grid_group grid = cg::this_grid();
  volatile LAS unsigned* bst = (volatile LAS unsigned*)((LAS unsigned char*)lds_raw + (LDS_BYTES - 64));
  if (threadIdx.x < 2) bst[threadIdx.x] = 0u;
  unsigned* barw = (unsigned*)(p.ws + WS_CTL + CTL_BAR);
  if (blockIdx.x == 0) { const int t0 = ftid(); for (int i = t0; i < XCD_BAR_WORDS; i += NT) barw[i] = 0u; }
  XcdBarrier xbar; xbar.bar = barw; xbar.x = 0; xbar.st = bst;
#ifdef FLATBAR
  unsigned fb_epoch = 0; unsigned* fb_ctr = barw + XCD_BAR_WORDS - 64;
#define GSYNC() flat_barrier(fb_ctr, fb_epoch)
#elif defined(XBAR2)
#define GSYNC() xcd_barrier2(xbar)
#else
#define GSYNC() xcd_barrier(xbar)
#endif
  nv::phase0(p, lds);                 grid.sync();
  xbar = xcd_barrier_post(barw, bst);
#ifdef DUP_SYNC
  for (int i = 0; i < 20; ++i) GSYNC();
#endif
#ifdef DUP_P0
  nv::phase0(p, lds);                 GSYNC();
#endif
  fr::phase_prenorm0(p);              GSYNC();
#ifdef DUP_PRENORM
  fr::phase_prenorm0(p); GSYNC();
#endif
#if FAST_GEMM
  fg::phase_qkv0(p, ldsp); GSYNC();
#ifdef DUP_QKV0
  fg::phase_qkv0(p, ldsp); GSYNC();
#endif
#else
  nv::phase_qkv0(p, lds);             GSYNC();
#endif
#if FAST_ATTN
  fa::phase_attnA(p, ldsp); fa::phase_attnB(p, ldsp); GSYNC();
#ifdef DUP_A
  fa::phase_attnA<DUP_A>(p, ldsp); GSYNC();
#endif
#ifdef DUP_B
  fa::phase_attnB<DUP_B>(p, ldsp); GSYNC();
#endif
#else
  nv::phase_attn0(p, lds);            GSYNC();
#endif
#if FAST_GEMM
#ifdef TAILFILL
  fg::phase_outproj(p, ldsp, 0); nv::convert_moe_tail8(p, 0, 1, lds, NROW / 256 * (DM / 256)); GSYNC();
#else
  fg::phase_outproj(p, ldsp, 0); GSYNC();
#endif
#ifdef DUP_OUT0
  fg::phase_outproj(p, ldsp, 0); GSYNC();
#endif
#else
  nv::phase_outproj(p, lds, 0);       GSYNC();
#endif
  fr::phase_postmix(p, ldsp, 0);            GSYNC();
#ifdef DUP_POSTMIX0
  fr::phase_postmix<DUP_POSTMIX0>(p, ldsp, 0); GSYNC();
#endif
#if FAST_TOPK
  ft::phase_topk(p, ldsp, 0);         GSYNC();
#ifdef DUP_TOPK0
  ft::phase_topk(p, ldsp, 0);         GSYNC();
#endif
#else
  nv::phase_topk(p, lds, 0);          GSYNC();
  fg::phase_gather(p, 0);             GSYNC();
#endif
#if FAST_GEMM
  fg::phase_moe_up8(p, ldsp, 0);      GSYNC();
#ifdef DUP_UP0
  fg::phase_moe_up8(p, ldsp, 0); GSYNC();
#endif
  fg::phase_moe_down8(p, ldsp, 0);    GSYNC();
#ifdef DUP_DOWN0
  fg::phase_moe_down8(p, ldsp, 0); GSYNC();
#endif
#else
  nv::phase_moe_up(p, lds, 0);        GSYNC();
  nv::phase_moe_down(p, lds, 0);      GSYNC();
#endif
#ifdef TAILFILL
  fr::phase_combine(p, 0); GSYNC();
#else
  fr::phase_combine(p, 0); nv::convert_moe_tail(p, 1, 0, lds, 0); nv::convert_moe_tail(p, 1, 1, lds, 0); GSYNC();
#endif
#if FAST_GEMM
#ifdef TAILFILL
  fg::phase_qkv1(p, ldsp); GSYNC();
#else
  fg::phase_qkv1(p, ldsp); GSYNC();
#endif
#else
  nv::phase_qkv1(p, lds);             GSYNC();
#endif
#if FAST_ATTN
#if FAST_SSD
#ifdef TAILFILL
  fs::phase_conv(p); GSYNC();
#else
  fs::phase_conv(p); GSYNC();
#endif
#else
  nv::phase_conv_swa(p, lds, true); GSYNC();
#endif
#else
  nv::phase_conv_swa(p, lds, true);   GSYNC();
#endif
#if FAST_SSD
  fs::phase_ssd(p, ldsp); fa::phase_attnC(p, ldsp, (int*)(p.ws + WS_CTL + CTL_QC));
  nv::convert_moe_tail8(p, 1, 0, lds, NB * 2 * 8); nv::convert_moe_tail8(p, 1, 1, lds, NB * 2 * 8); GSYNC();
#ifdef DUP_SSD
  fs::phase_ssd<DUP_SSD>(p, ldsp);             GSYNC();
#endif
  fs::phase_ssd_out(p);               GSYNC();
#else
  nv::phase_ssd(p, lds);              GSYNC();
  nv::phase_ssd_out(p);               GSYNC();
#endif
#if FAST_GEMM
  fg::phase_outproj(p, ldsp, 1);      GSYNC();
#else
  nv::phase_outproj(p, lds, 1);       GSYNC();
#endif
  fr::phase_postmix(p, ldsp, 1);            GSYNC();
#if FAST_TOPK
  ft::phase_topk(p, ldsp, 1);         GSYNC();
#ifdef DUP_TOPK1
  ft::phase_topk(p, ldsp, 1);         GSYNC();
#endif
#else
  nv::phase_topk(p, lds, 1);          GSYNC();
  fg::phase_gather(p, 1);             GSYNC();
#endif
#if FAST_GEMM
  fg::phase_moe_up8(p, ldsp, 1);      GSYNC();
  fg::phase_moe_down8(p, ldsp, 1);    GSYNC();
#else
  nv::phase_moe_up(p, lds, 1);        GSYNC();
  nv::phase_moe_down(p, lds, 1);      GSYNC();
#endif
  fr::phase_combine(p, 1);
}


extern "C" void kernel_launch(void* const* d_in, const int* in_sizes, int n_in, void* d_out, int out_size,
                              void* d_ws, size_t ws_size, hipStream_t stream) {
  static int grid_blocks = 0;
  if (!grid_blocks) {
    int dev = 0, cus = 0, per_cu = 0;
    (void)hipGetDevice(&dev);
    (void)hipDeviceGetAttribute(&cus, hipDeviceAttributeMultiprocessorCount, dev);
    (void)hipFuncSetAttribute((const void*)mega, hipFuncAttributeMaxDynamicSharedMemorySize, LDS_BYTES);
    (void)hipOccupancyMaxActiveBlocksPerMultiprocessor(&per_cu, (const void*)mega, NT, LDS_BYTES);
    if (per_cu < 1) { fprintf(stderr, "kernel_launch: occupancy query says %d blocks/CU\n", per_cu); per_cu = 1; }
    grid_blocks = cus;
    if (n_in != 43 || ws_size < WS_END) fprintf(stderr, "kernel_launch: unexpected n_in %d / ws_size %zu (need %zu)\n", n_in, ws_size, (size_t)WS_END);
  }
  Params p{};
  for (int i = 0; i < 43; ++i) p.in[i] = (const float*)d_in[i];
  p.out = (float*)d_out; p.ws = (unsigned char*)d_ws;
  void* args[] = {&p};
  hipError_t e = hipLaunchCooperativeKernel((void*)mega, dim3(grid_blocks), dim3(NT), args, LDS_BYTES, stream);
  if (e != hipSuccess) fprintf(stderr, "cooperative launch failed: %s (grid %d)\n", hipGetErrorString(e), grid_blocks);
}
```
